# Optimizing an MI355X kernel written in HIP

```python
import jax
import jax.numpy as jnp
from jax import lax
import numpy as np

D_MODEL = 1024
BATCH = 8
SEQ = 4096
DEPTH = 2

GRID_W = 64
CTX_LEN = 256
HEAD_DIM = 64
N_Q_HEADS = 8
N_KV_HEADS = 2
Q_PER_KV = N_Q_HEADS // N_KV_HEADS
ATT_Q_W = N_Q_HEADS * HEAD_DIM
ATT_KV_W = N_KV_HEADS * HEAD_DIM
ATT_SCALE = HEAD_DIM ** -0.5
ROPE_THETA = 10000.0
ROPE_AXIS_DIM = HEAD_DIM // 2
QBLK = 128
WINDOW = 128
SPAN = QBLK + 2 * WINDOW
N_FOURIER_GROUPS = 4
FOURIER_GROUP_W = D_MODEL // 8
FOURIER_W = N_FOURIER_GROUPS * FOURIER_GROUP_W
POOL_WINDOWS = (2, 4, 8, 16)
POOL_GROUP_W = D_MODEL // 8
POOL_W = len(POOL_WINDOWS) * POOL_GROUP_W
N_BRANCHES = 4
BRANCH_W = ATT_Q_W
IN_SPLITS = (FOURIER_W, POOL_W, ATT_Q_W, ATT_KV_W, ATT_KV_W, ATT_Q_W, ATT_KV_W, ATT_KV_W)
IN_W = sum(IN_SPLITS)
IN_OFFSETS = tuple(sum(IN_SPLITS[:i + 1]) for i in range(len(IN_SPLITS) - 1))
N_EXPERTS = 16
N_EXPERT_GROUPS = 4
EXPERTS_PER_GROUP = N_EXPERTS // N_EXPERT_GROUPS
TOP_K = 2
EXPERT_FF = D_MODEL // 2
EPS = 1e-6

kernel_name = 'hybrid_parallel_dit_block'


def rms_norm(x, gain):
    xf = x.astype(jnp.float32)
    y = xf * lax.rsqrt(jnp.mean(xf * xf, axis=-1, keepdims=True) + EPS)
    return (y * gain.astype(jnp.float32)).astype(x.dtype)


def modulate(x, shift, scale):
    return x * (1 + scale) + shift


def rope_tables(n_tokens):
    rows = n_tokens // GRID_W
    row = jnp.repeat(jnp.arange(rows, dtype=jnp.float32), GRID_W)
    col = jnp.tile(jnp.arange(GRID_W, dtype=jnp.float32), rows)
    inv_freq = ROPE_THETA ** (-jnp.arange(0, ROPE_AXIS_DIM, 2, dtype=jnp.float32) / ROPE_AXIS_DIM)
    ang = jnp.stack([row[:, None] * inv_freq, col[:, None] * inv_freq], axis=1)
    return jnp.cos(ang), jnp.sin(ang)


def apply_rope_2d(x, cos, sin):
    xs = x.astype(jnp.float32).reshape(*x.shape[:-1], 2, 2, ROPE_AXIS_DIM // 2)
    x1, x2 = xs[..., 0, :], xs[..., 1, :]
    c, s = cos[:, None], sin[:, None]
    out = jnp.stack([x1 * c - x2 * s, x2 * c + x1 * s], axis=-2)
    return out.reshape(x.shape).astype(x.dtype)


def heads(a, n):
    return a.reshape(a.shape[0], a.shape[1], n, HEAD_DIM)


def group_q(q):
    return q.reshape(q.shape[0], q.shape[1], N_KV_HEADS, Q_PER_KV, HEAD_DIM)


def to_blocks(q):
    b, t = q.shape[:2]
    return q.reshape(b, t // QBLK, QBLK, *q.shape[2:]).swapaxes(0, 1)


def from_blocks(o):
    o = o.swapaxes(0, 1)
    return o.reshape(o.shape[0], -1, ATT_Q_W)


def sink_softmax(s, sink):
    col = jnp.broadcast_to(sink.astype(jnp.float32)[None, :, :, None, None], s.shape[:-1] + (1,))
    p = jax.nn.softmax(jnp.concatenate([s, col], axis=-1), axis=-1)
    return p[..., :-1]


def context_attention(qc, kc, vc, sink=None):
    s = jnp.einsum('bqgrd,bkgd->bgrqk', qc, kc).astype(jnp.float32) * ATT_SCALE
    p = jax.nn.softmax(s, axis=-1) if sink is None else sink_softmax(s, sink)
    o = jnp.einsum('bgrqk,bkgd->bqgrd', p.astype(vc.dtype), vc)
    return o.reshape(o.shape[0], o.shape[1], ATT_Q_W)


def global_attention(q, k, v, kc, vc):
    k_all = jnp.concatenate([kc, k], axis=1)
    v_all = jnp.concatenate([vc, v], axis=1)

    def one_block(qb):
        s = jnp.einsum('bqgrd,bkgd->bgrqk', qb, k_all).astype(jnp.float32) * ATT_SCALE
        p = jax.nn.softmax(s, axis=-1).astype(v_all.dtype)
        return jnp.einsum('bgrqk,bkgd->bqgrd', p, v_all)

    return from_blocks(lax.map(one_block, to_blocks(q)))


def window_attention(q, k, v, kc, vc, sink):
    t = q.shape[1]
    n_ctx = kc.shape[1]
    pad = ((0, 0), (WINDOW, WINDOW), (0, 0), (0, 0))
    kp, vp = jnp.pad(k, pad), jnp.pad(v, pad)
    qi = jnp.arange(QBLK)[:, None]
    kj = jnp.arange(SPAN)[None, :]
    in_band = jnp.abs(kj - WINDOW - qi) <= WINDOW

    def one_block(args):
        qb, blk = args
        start = blk * QBLK
        kw = lax.dynamic_slice_in_dim(kp, start, SPAN, axis=1)
        vw = lax.dynamic_slice_in_dim(vp, start, SPAN, axis=1)
        kpos = start - WINDOW + kj
        valid = in_band & (kpos >= 0) & (kpos < t)
        s_ctx = jnp.einsum('bqgrd,bkgd->bgrqk', qb, kc).astype(jnp.float32)
        s_win = jnp.where(valid, jnp.einsum('bqgrd,bkgd->bgrqk', qb, kw).astype(jnp.float32), -jnp.inf)
        p = sink_softmax(jnp.concatenate([s_ctx, s_win], axis=-1) * ATT_SCALE, sink).astype(v.dtype)
        return (jnp.einsum('bgrqk,bkgd->bqgrd', p[..., :n_ctx], vc)
                + jnp.einsum('bgrqk,bkgd->bqgrd', p[..., n_ctx:], vw))

    return from_blocks(lax.map(one_block, (to_blocks(q), jnp.arange(t // QBLK))))


def fourier_mix(u):
    b, t = u.shape[:2]
    g = u.astype(jnp.float32).reshape(b, t, N_FOURIER_GROUPS, FOURIER_GROUP_W)
    f = jnp.fft.fft2(g, axes=(1, 3), norm='ortho').real
    return f.reshape(b, t, FOURIER_W).astype(u.dtype)


def pool_mix(u, pool_w, pool_scale):
    b, t = u.shape[:2]
    g = u.astype(jnp.float32).reshape(b, t, len(POOL_WINDOWS), POOL_GROUP_W)
    cs = jnp.pad(jnp.cumsum(g, axis=1), ((0, 0), (1, 0), (0, 0), (0, 0)))
    pos = jnp.arange(t)
    outs = []
    for gi, w in enumerate(POOL_WINDOWS):
        lo = jnp.clip(pos - w // 2, 0, t)
        hi = jnp.clip(pos + w // 2, 0, t)
        cs_g = cs[:, :, gi]
        mean = (cs_g[:, hi] - cs_g[:, lo]) / (hi - lo).astype(jnp.float32)[:, None]
        outs.append(mean - g[:, :, gi])
    pooled = jnp.stack(outs, axis=2).astype(u.dtype)
    mixed = jnp.einsum('btgc,gce->btge', pooled, pool_w)
    return mixed.reshape(b, t, POOL_W) * pool_scale


def branch_merge(h, branches, w_branch, w_gate, b_gate, w_out):
    merged = jnp.zeros_like(h)
    for i, br in enumerate(branches):
        gate = jax.nn.sigmoid(h @ w_gate[i] + b_gate[i])
        merged = merged + gate * (br @ w_branch[i])
    return merged @ w_out


def token_mixer(h, hc, cos, sin, w_in, q_gain, k_gain, sink, pool_w, pool_scale,
                w_branch, w_gate, b_gate, w_out, need_ctx_out):
    f_in, p_in, qb, kb, vb, qw, kw, vw = jnp.split(h @ w_in, IN_OFFSETS, axis=-1)
    fc_in, pc_in, qbc, kbc, vbc, qwc, kwc, vwc = jnp.split(hc @ w_in, IN_OFFSETS, axis=-1)
    q_b = apply_rope_2d(rms_norm(heads(qb, N_Q_HEADS), q_gain), cos, sin)
    k_b = apply_rope_2d(rms_norm(heads(kb, N_KV_HEADS), k_gain), cos, sin)
    v_b = heads(vb, N_KV_HEADS)
    k_bc = rms_norm(heads(kbc, N_KV_HEADS), k_gain)
    v_bc = heads(vbc, N_KV_HEADS)
    out_b = global_attention(group_q(q_b), k_b, v_b, k_bc, v_bc)
    sink_gr = sink.reshape(N_KV_HEADS, Q_PER_KV)
    q_c = apply_rope_2d(heads(qw, N_Q_HEADS), cos, sin)
    k_c = apply_rope_2d(heads(kw, N_KV_HEADS), cos, sin)
    v_c = heads(vw, N_KV_HEADS)
    k_cc = heads(kwc, N_KV_HEADS)
    v_cc = heads(vwc, N_KV_HEADS)
    out_c = window_attention(group_q(q_c), k_c, v_c, k_cc, v_cc, sink_gr)
    out_a = fourier_mix(f_in)
    out_d = pool_mix(p_in, pool_w, pool_scale)
    y = branch_merge(h, (out_a, out_b, out_c, out_d), w_branch, w_gate, b_gate, w_out)
    yc = None
    if need_ctx_out:
        oc_b = context_attention(group_q(rms_norm(heads(qbc, N_Q_HEADS), q_gain)), k_bc, v_bc)
        oc_c = context_attention(group_q(heads(qwc, N_Q_HEADS)), k_cc, v_cc, sink_gr)
        oc_a = fourier_mix(fc_in)
        oc_d = pool_mix(pc_in, pool_w, pool_scale)
        yc = branch_merge(hc, (oc_a, oc_b, oc_c, oc_d), w_branch, w_gate, b_gate, w_out)
    return y, yc


def moe_ffn(h, router_w, router_bias, w1, w3, w2):
    shape = h.shape
    tok = h.reshape(-1, D_MODEL)
    aff = jax.nn.sigmoid((tok @ router_w).astype(jnp.float32))
    sel = aff + router_bias.astype(jnp.float32)
    grp = sel.reshape(-1, N_EXPERT_GROUPS, EXPERTS_PER_GROUP)
    group_score = lax.top_k(grp, TOP_K)[0].sum(-1)
    best = jnp.argmax(group_score, axis=-1)
    in_group = best[:, None] == (jnp.arange(N_EXPERTS) // EXPERTS_PER_GROUP)[None, :]
    _, top_idx = lax.top_k(jnp.where(in_group, sel, -jnp.inf), TOP_K)
    w_top = jnp.take_along_axis(aff, top_idx, axis=-1)
    w_top = w_top / jnp.sum(w_top, axis=-1, keepdims=True)
    combine = jnp.sum(jax.nn.one_hot(top_idx, N_EXPERTS, dtype=jnp.float32) * w_top[..., None], axis=1)
    combine = combine.astype(h.dtype)
    out = jnp.zeros_like(tok)
    for e in range(N_EXPERTS):
        hid = jax.nn.silu(tok @ w1[e]) * (tok @ w3[e])
        out = out + combine[:, e:e + 1] * (hid @ w2[e])
    return out.reshape(shape)


def trunk_layer(x, xc, mod, mod_c, cos, sin, norm1, norm2, w_in, q_gain, k_gain, sink,
                pool_w, pool_scale, w_branch, w_gate, b_gate, w_out,
                router_w, router_bias, w1, w3, w2, need_ctx_out):
    sh1, sc1, g1, sh2, sc2, g2 = jnp.split(mod[:, None, :], 6, axis=-1)
    sh1c, sc1c, g1c, sh2c, sc2c, g2c = jnp.split(mod_c, 6)
    h = modulate(rms_norm(x, norm1), sh1, sc1)
    hc = modulate(rms_norm(xc, norm1), sh1c, sc1c)
    y, yc = token_mixer(h, hc, cos, sin, w_in, q_gain, k_gain, sink, pool_w, pool_scale,
                        w_branch, w_gate, b_gate, w_out, need_ctx_out)
    x = x + g1 * y
    x = x + g2 * moe_ffn(modulate(rms_norm(x, norm2), sh2, sc2), router_w, router_bias, w1, w3, w2)
    if need_ctx_out:
        xc = xc + g1c * yc
        xc = xc + g2c * moe_ffn(modulate(rms_norm(xc, norm2), sh2c, sc2c), router_w, router_bias, w1, w3, w2)
    return x, xc


def setup_inputs(seed: int = 0) -> dict:
    key = jax.random.key(seed)
    ks = jax.random.split(key, 24)
    f32 = jnp.float32

    def nrm(k, shape, scale):
        return jax.random.normal(k, shape, f32) * scale

    return {
        'x': nrm(ks[0], (BATCH, SEQ, D_MODEL), 1.0),
        'c': nrm(ks[1], (BATCH, D_MODEL), 1.0),
        'ctx': nrm(ks[2], (BATCH, CTX_LEN, D_MODEL), 1.0),
        'c_ctx': nrm(ks[3], (D_MODEL,), 1.0),
        'w_ada': nrm(ks[4], (DEPTH, D_MODEL, 6 * D_MODEL), 0.5 * D_MODEL ** -0.5),
        'b_ada': nrm(ks[5], (DEPTH, 6 * D_MODEL), 0.02),
        'norm1': 1.0 + nrm(ks[6], (DEPTH, D_MODEL), 0.05),
        'norm2': 1.0 + nrm(ks[7], (DEPTH, D_MODEL), 0.05),
        'w_in': nrm(ks[8], (DEPTH, D_MODEL, IN_W), D_MODEL ** -0.5),
        'q_gain': 1.0 + nrm(ks[9], (DEPTH, HEAD_DIM), 0.05),
        'k_gain': 1.0 + nrm(ks[10], (DEPTH, HEAD_DIM), 0.05),
        'sink': nrm(ks[11], (DEPTH, N_Q_HEADS), 0.5),
        'pool_w': nrm(ks[12], (DEPTH, len(POOL_WINDOWS), POOL_GROUP_W, POOL_GROUP_W), POOL_GROUP_W ** -0.5),
        'pool_scale': 1.0 + nrm(ks[13], (DEPTH, POOL_W), 0.1),
        'w_branch': nrm(ks[14], (DEPTH, N_BRANCHES, BRANCH_W, D_MODEL), BRANCH_W ** -0.5),
        'w_gate': nrm(ks[15], (DEPTH, N_BRANCHES, D_MODEL, D_MODEL), D_MODEL ** -0.5),
        'b_gate': nrm(ks[16], (DEPTH, N_BRANCHES, D_MODEL), 0.02),
        'w_out': nrm(ks[17], (DEPTH, D_MODEL, D_MODEL), D_MODEL ** -0.5),
        'router_w': nrm(ks[18], (D_MODEL, N_EXPERTS), D_MODEL ** -0.5),
        'router_bias': nrm(ks[19], (N_EXPERTS,), 0.01),
        'w1': nrm(ks[20], (DEPTH, N_EXPERTS, D_MODEL, EXPERT_FF), D_MODEL ** -0.5),
        'w3': nrm(ks[21], (DEPTH, N_EXPERTS, D_MODEL, EXPERT_FF), D_MODEL ** -0.5),
        'w2': nrm(ks[22], (DEPTH, N_EXPERTS, EXPERT_FF, D_MODEL), EXPERT_FF ** -0.5),
        'norm_f': 1.0 + nrm(ks[23], (D_MODEL,), 0.05),
    }


def reference(x, c, ctx, c_ctx, w_ada, b_ada, norm1, norm2, w_in, q_gain, k_gain, sink,
              pool_w, pool_scale, w_branch, w_gate, b_gate, w_out, router_w, router_bias,
              w1, w3, w2, norm_f):
    cos, sin = rope_tables(x.shape[1])
    xc = ctx
    for l in range(DEPTH):
        mod = jax.nn.silu(c) @ w_ada[l] + b_ada[l]
        mod_c = jax.nn.silu(c_ctx) @ w_ada[l] + b_ada[l]
        x, xc = trunk_layer(x, xc, mod, mod_c, cos, sin, norm1[l], norm2[l], w_in[l],
                            q_gain[l], k_gain[l], sink[l], pool_w[l], pool_scale[l],
                            w_branch[l], w_gate[l], b_gate[l], w_out[l],
                            router_w, router_bias, w1[l], w3[l], w2[l],
                            need_ctx_out=(l < DEPTH - 1))
    return rms_norm(x, norm_f)
```

```cpp
#include <hip/hip_runtime.h>
#include <cstdio>
#include <cstdint>

typedef unsigned short bf16_t;
typedef short bf16x8 __attribute__((ext_vector_type(8)));
typedef float f32x4 __attribute__((ext_vector_type(4)));
typedef unsigned u32x4 __attribute__((ext_vector_type(4)));
typedef unsigned u32x2 __attribute__((ext_vector_type(2)));

constexpr int D = 1024, NB = 8, T = 4096, TC = 256;
constexpr int RL = NB * T, RC = NB * TC, R = RL + RC;
constexpr int NIN = 3072;
constexpr int C_ZR = 0, C_ZI = 512, C_P = 1024, C_QB = 1536, C_KB = 2048, C_VB = 2176, C_QW = 2304, C_KW = 2816, C_VW = 2944;
constexpr int NBR = 2048;
constexpr int NE = 16, FF = 512;
constexpr int MAXROWS = 73728;
constexpr float EPS = 1e-6f;
constexpr float QSCALE = 0.125f * 1.4426950408889634f;
constexpr float LOG2E = 1.4426950408889634f;

constexpr size_t MiB = 1u << 20;
constexpr size_t WS_CTL = 0;
constexpr size_t WS_MOD = 1 * MiB;
constexpr size_t WS_ROPE = 1 * MiB + 512 * 1024;
constexpr size_t WS_COS = WS_ROPE + 16 * 1024;
constexpr size_t WS_ROUTE = 2 * MiB;
constexpr size_t WS_ROWMAP = 3 * MiB;
constexpr size_t WS_ROWW = 3 * MiB + 512 * 1024;
constexpr size_t WS_XC = 9 * MiB;
constexpr size_t WS_WB = 17 * MiB;
constexpr size_t WB_IN = 0, WB_GATE = 6 * MiB, WB_BR = 14 * MiB, WB_OUT = 18 * MiB, WB_13 = 20 * MiB, WB_2 = 52 * MiB;
constexpr size_t WS_H = 85 * MiB;
constexpr size_t WS_ARENA = 153 * MiB;
constexpr size_t WS_U = WS_ARENA;
constexpr size_t WS_BR = WS_ARENA + 204 * MiB;
constexpr size_t WS_GT = WS_ARENA;
constexpr size_t WS_MG = WS_ARENA + 136 * MiB;
constexpr size_t WS_AS = WS_ARENA;
constexpr size_t WS_HID = WS_ARENA + 144 * MiB;
constexpr size_t WS_MO = WS_ARENA + 216 * MiB;
constexpr size_t WS_END = 512 * MiB;
static_assert(WS_BR + (size_t)R * NBR * 2 <= WS_END && WS_MO + (size_t)2 * R * D * 2 <= WS_END && WS_MG + (size_t)R * D * 2 <= WS_BR, "ws map");
constexpr int CW_CNT = 1024;

__device__ __forceinline__ float bf2f(bf16_t b) { return __uint_as_float(((unsigned)b) << 16); }
__device__ __forceinline__ unsigned f2bf(float f) { unsigned u = __float_as_uint(f); return (u + 0x7fffu + ((u >> 16) & 1u)) >> 16; }
__device__ __forceinline__ unsigned pk2(float lo, float hi) { return f2bf(lo) | (f2bf(hi) << 16); }
__device__ __forceinline__ float lo16(unsigned w) { return __uint_as_float(w << 16); }
__device__ __forceinline__ float hi16(unsigned w) { return __uint_as_float(w & 0xffff0000u); }
__device__ __forceinline__ float wave_sum(float v) {
#pragma unroll
    for (int o = 1; o < 64; o <<= 1) v += __shfl_xor(v, o);
    return v;
}
__device__ __forceinline__ int row_bb(int r) { return r < RL ? (r >> 12) : 8; }

struct Ptrs {
    const float *x, *c, *ctx, *c_ctx, *w_ada, *b_ada, *norm1, *norm2, *w_in, *q_gain, *k_gain, *sink, *pool_w, *pool_scale,
        *w_branch, *w_gate, *b_gate, *w_out, *router_w, *router_bias, *w1, *w3, *w2, *norm_f;
    float* out; unsigned char* ws;
};
__device__ __forceinline__ const float* xin_row(const Ptrs& P, int r) { return r < RL ? P.x + (size_t)r * D : P.ctx + (size_t)(r - RL) * D; }
__device__ __forceinline__ float* x1_row(const Ptrs& P, int r) { return r < RL ? P.out + (size_t)r * D : (float*)(P.ws + WS_XC) + (size_t)(r - RL) * D; }
__device__ __forceinline__ const float* mod_vec(const Ptrs& P, int l, int bb, int which) { return (const float*)(P.ws + WS_MOD) + ((size_t)(l * 9 + bb) * 6 + which) * D; }

__global__ void k_tables(Ptrs P) {
    float* rc = (float*)(P.ws + WS_ROPE); float* rs = rc + 1024; float* ct = (float*)(P.ws + WS_COS);
    int i = blockIdx.x * blockDim.x + threadIdx.x;
    if (i < 1024) { int pos = i >> 4, f = i & 15; float inv = exp2f(-(float)f * (13.287712379549449f / 16.0f));
        float rev = (float)pos * inv * 0.15915494309189535f; rev = rev - floorf(rev);
        rc[i] = __builtin_amdgcn_cosf(rev); rs[i] = __builtin_amdgcn_sinf(rev); }
    if (i < 4096) ct[i] = __builtin_amdgcn_cosf((float)i * (1.0f / 4096.0f));
}

__global__ __launch_bounds__(256) void k_mod(Ptrs P) {
    __shared__ float s[9][1024];
    __shared__ float red[4][9][64];
    const int l = blockIdx.y, j0 = blockIdx.x * 64, tid = threadIdx.x;
    for (int i = tid; i < 9 * 1024; i += 256) { int bb = i >> 10, k = i & 1023; float v = bb < 8 ? P.c[bb * 1024 + k] : P.c_ctx[k]; s[bb][k] = v / (1.f + expf(-v)); }
    __syncthreads();
    const int kc = tid >> 6, jj = tid & 63; float acc[9];
#pragma unroll
    for (int b = 0; b < 9; ++b) acc[b] = 0.f;
    const float* w = P.w_ada + (size_t)l * 1024 * 6144 + j0 + jj;
    for (int k = kc * 256; k < kc * 256 + 256; ++k) { const float wv = w[(size_t)k * 6144];
#pragma unroll
        for (int b = 0; b < 9; ++b) acc[b] += s[b][k] * wv; }
#pragma unroll
    for (int b = 0; b < 9; ++b) red[kc][b][jj] = acc[b];
    __syncthreads();
    float* mod = (float*)(P.ws + WS_MOD);
    for (int i = tid; i < 9 * 64; i += 256) { int b = i >> 6, j = i & 63;
        mod[(size_t)(l * 9 + b) * 6144 + j0 + j] = red[0][b][j] + red[1][b][j] + red[2][b][j] + red[3][b][j] + P.b_ada[l * 6144 + j0 + j]; }
}

__device__ __forceinline__ void conv_tile(const float* src, int ldsrc, int k0, int c0, bf16_t* dst, int lddst, int drow0, int rowmode, int cl0, float (*tile)[65]) {
    const int tid = threadIdx.x;
    { const int n = tid & 63, kk = tid >> 6;
#pragma unroll
      for (int i = 0; i < 16; ++i) tile[kk + 4 * i][n] = src[(size_t)(k0 + kk + 4 * i) * ldsrc + c0 + n]; }
    __syncthreads();
    { const int n = tid >> 2, kq = tid & 3; const int c = cl0 + n; const int drow = rowmode ? drow0 + 256 * (c >> 7) + (c & 127) : drow0 + c;
      u32x4 a, b;
      a.x = pk2(tile[kq * 16 + 0][n], tile[kq * 16 + 1][n]); a.y = pk2(tile[kq * 16 + 2][n], tile[kq * 16 + 3][n]); a.z = pk2(tile[kq * 16 + 4][n], tile[kq * 16 + 5][n]); a.w = pk2(tile[kq * 16 + 6][n], tile[kq * 16 + 7][n]);
      b.x = pk2(tile[kq * 16 + 8][n], tile[kq * 16 + 9][n]); b.y = pk2(tile[kq * 16 + 10][n], tile[kq * 16 + 11][n]); b.z = pk2(tile[kq * 16 + 12][n], tile[kq * 16 + 13][n]); b.w = pk2(tile[kq * 16 + 14][n], tile[kq * 16 + 15][n]);
      u32x4* d = (u32x4*)(dst + (size_t)drow * lddst + k0 + kq * 16); d[0] = a; d[1] = b; }
    __syncthreads();
}
__global__ __launch_bounds__(256) void k_conv(const float* src, int ldsrc, int K, int c0, int ncols, bf16_t* dst, int lddst, int drow0, int rowmode, size_t sstride, size_t dstride) {
    __shared__ float tile[64][65];
    const int nct = ncols / 64, kt = blockIdx.x / nct, ct = blockIdx.x % nct;
    conv_tile(src + blockIdx.z * sstride, ldsrc, kt * 64, c0 + ct * 64, dst + blockIdx.z * dstride, lddst, drow0, rowmode, ct * 64, tile);
}
__global__ __launch_bounds__(256) void k_fold_dft(const float* w_in  , bf16_t* Bt_in) {
    __shared__ float Wl[64][128];
    __shared__ float ct[128];
    const int kt = blockIdx.x, g = blockIdx.y, tid = threadIdx.x, k0 = kt * 64;
    if (tid < 128) ct[tid] = __builtin_amdgcn_cosf((float)tid * (1.0f / 128.0f));
    for (int i = tid; i < 64 * 128; i += 256) { int k = i >> 7, c = i & 127; Wl[k][c] = w_in[(size_t)(k0 + k) * 2560 + g * 128 + c]; }
    __syncthreads();
    const int part = tid >> 7, m = tid & 127; const float sc = 0.08838834764831845f;
    bf16_t* drow = Bt_in + (size_t)(part * 512 + g * 128 + m) * 1024 + k0;
    for (int kb = 0; kb < 64; kb += 8) { float acc[8];
#pragma unroll
        for (int j = 0; j < 8; ++j) acc[j] = 0.f;
        for (int c = 0; c < 128; ++c) { const int idx = (c * m) & 127; const float tw = part ? -ct[(idx - 32) & 127] : ct[idx];
#pragma unroll
            for (int j = 0; j < 8; ++j) acc[j] += Wl[kb + j][c] * tw; }
        u32x4 o; o.x = pk2(acc[0] * sc, acc[1] * sc); o.y = pk2(acc[2] * sc, acc[3] * sc); o.z = pk2(acc[4] * sc, acc[5] * sc); o.w = pk2(acc[6] * sc, acc[7] * sc);
        *(u32x4*)(drow + kb) = o; }
}
__global__ __launch_bounds__(256) void k_fold_pool(const float* pool_w, const float* pool_scale, const float* wb3, bf16_t* Bt) {
    __shared__ float Wb[128][64];
    const int g = blockIdx.y, n0 = blockIdx.x * 64, tid = threadIdx.x;
    for (int i = tid; i < 128 * 64; i += 256) { int e = i >> 6, n = i & 63; Wb[e][n] = pool_scale[g * 128 + e] * wb3[(size_t)(g * 128 + e) * 1024 + n0 + n]; }
    __syncthreads();
    const int c = tid & 127, nh = tid >> 7; const float* pw = pool_w + (size_t)(g * 128 + c) * 128;
    float acc[32];
#pragma unroll
    for (int j = 0; j < 32; ++j) acc[j] = 0.f;
    for (int e = 0; e < 128; ++e) { const float p = pw[e];
#pragma unroll
        for (int j = 0; j < 32; ++j) acc[j] += p * Wb[e][nh * 32 + j]; }
#pragma unroll
    for (int j = 0; j < 32; ++j) Bt[(size_t)(n0 + nh * 32 + j) * 512 + g * 128 + c] = (bf16_t)f2bf(acc[j]);
}

template <int MODE> __global__ __launch_bounds__(256) void k_norm(Ptrs P, int l, int nrows) {
    const int lane = threadIdx.x & 63, r = blockIdx.x * 4 + (threadIdx.x >> 6);
    if (r >= nrows) return;
    const int bb = row_bb(r);
    f32x4 v[4];
    if (MODE == 0) { const f32x4* xr = (const f32x4*)xin_row(P, r) + lane;
#pragma unroll
        for (int j = 0; j < 4; ++j) v[j] = xr[64 * j]; }
    else { f32x4* xr = (f32x4*)x1_row(P, r) + lane;
#pragma unroll
        for (int j = 0; j < 4; ++j) v[j] = xr[64 * j];
        if (MODE == 1) { const f32x4* g2 = (const f32x4*)mod_vec(P, l - 1, bb, 5) + lane;
            const u32x2* m0 = (const u32x2*)((const bf16_t*)(P.ws + WS_MO) + (size_t)r * D) + lane; const u32x2* m1 = (const u32x2*)((const bf16_t*)(P.ws + WS_MO) + (size_t)(R + r) * D) + lane;
#pragma unroll
            for (int j = 0; j < 4; ++j) { const u32x2 a = m0[64 * j], b = m1[64 * j]; const f32x4 g = g2[64 * j];
                v[j].x += g.x * (lo16(a.x) + lo16(b.x)); v[j].y += g.y * (hi16(a.x) + hi16(b.x)); v[j].z += g.z * (lo16(a.y) + lo16(b.y)); v[j].w += g.w * (hi16(a.y) + hi16(b.y));
                xr[64 * j] = v[j]; } } }
    float ss = 0.f;
#pragma unroll
    for (int j = 0; j < 4; ++j) ss += (v[j].x * v[j].x + v[j].y * v[j].y) + (v[j].z * v[j].z + v[j].w * v[j].w);
    const float rstd = 1.0f / sqrtf(wave_sum(ss) * (1.0f / D) + EPS);
    const f32x4* gn = (const f32x4*)((MODE == 2 ? P.norm2 : P.norm1) + (size_t)l * D) + lane;
    const f32x4* sh = (const f32x4*)mod_vec(P, l, bb, MODE == 2 ? 3 : 0) + lane;
    const f32x4* sc = (const f32x4*)mod_vec(P, l, bb, MODE == 2 ? 4 : 1) + lane;
    u32x2* o = (u32x2*)((bf16_t*)(P.ws + WS_H) + (size_t)r * D) + lane;
#pragma unroll
    for (int j = 0; j < 4; ++j) { const f32x4 g = gn[64 * j], a = sh[64 * j], b = sc[64 * j];
        v[j] = (v[j] * rstd * g) * (b + 1.0f) + a;
        u32x2 w; w.x = pk2(v[j].x, v[j].y); w.y = pk2(v[j].z, v[j].w); o[64 * j] = w; }
    if (MODE == 2) {
        float lg[16];
#pragma unroll
        for (int e = 0; e < 16; ++e) lg[e] = 0.f;
#pragma unroll
        for (int j = 0; j < 4; ++j) {
#pragma unroll
            for (int i = 0; i < 4; ++i) { const float hv = v[j][i]; const f32x4* rw = (const f32x4*)(P.router_w + (size_t)(4 * lane + 256 * j + i) * 16);
#pragma unroll
                for (int q = 0; q < 4; ++q) { const f32x4 w = rw[q]; lg[4 * q] += hv * w.x; lg[4 * q + 1] += hv * w.y; lg[4 * q + 2] += hv * w.z; lg[4 * q + 3] += hv * w.w; } } }
#pragma unroll
        for (int e = 0; e < 16; ++e) lg[e] = wave_sum(lg[e]);
        float bestscore = -INFINITY; int be0 = 0, be1 = 1; float ba0 = 0.f, ba1 = 0.f;
#pragma unroll
        for (int g = 0; g < 4; ++g) {
            float aff[4], sel[4];
#pragma unroll
            for (int i = 0; i < 4; ++i) { aff[i] = 1.0f / (1.0f + expf(-lg[4 * g + i])); sel[i] = aff[i] + P.router_bias[4 * g + i]; }
            int i1 = 0; float m1 = sel[0], a1 = aff[0];
#pragma unroll
            for (int i = 1; i < 4; ++i) if (sel[i] > m1) { m1 = sel[i]; a1 = aff[i]; i1 = i; }
            int i2 = -1; float m2 = -INFINITY, a2 = 0.f;
#pragma unroll
            for (int i = 0; i < 4; ++i) if (i != i1 && sel[i] > m2) { m2 = sel[i]; a2 = aff[i]; i2 = i; }
            const float score = m1 + m2;
            if (score > bestscore) { bestscore = score; be0 = 4 * g + i1; be1 = 4 * g + i2; ba0 = a1; ba1 = a2; }
        }
        if (lane == 0) {
            unsigned* cnt = (unsigned*)(P.ws + WS_CTL) + CW_CNT + 64 * l;
            const int p0 = (int)atomicAdd(cnt + be0, 1u), p1 = (int)atomicAdd(cnt + be1, 1u);
            int* rt = (int*)(P.ws + WS_ROUTE) + (size_t)r * 6; const float inv = 1.0f / (ba0 + ba1);
            rt[0] = be0; rt[1] = p0; rt[2] = be1; rt[3] = p1; ((float*)rt)[4] = ba0 * inv; ((float*)rt)[5] = ba1 * inv;
        }
    }
}

struct EpiStore { bf16_t* C; int ldc;
    __device__ __forceinline__ void operator()(int row, int col, f32x4 v) const { u32x2 w; w.x = pk2(v.x, v.y); w.y = pk2(v.z, v.w); *(u32x2*)(C + (size_t)row * ldc + col) = w; } };
struct EpiGate { bf16_t* G; const float* bias;
    __device__ __forceinline__ void operator()(int row, int col, f32x4 v) const { const f32x4 b = *(const f32x4*)(bias + col);
        u32x2 w; w.x = pk2(1.f / (1.f + __expf(-(v.x + b.x))), 1.f / (1.f + __expf(-(v.y + b.y)))); w.y = pk2(1.f / (1.f + __expf(-(v.z + b.z))), 1.f / (1.f + __expf(-(v.w + b.w))));
        *(u32x2*)(G + (size_t)row * D + col) = w; } };
struct EpiMerge { bf16_t* MG; const bf16_t* G; int first;
    __device__ __forceinline__ void operator()(int row, int col, f32x4 v) const { const size_t o = (size_t)row * D + col; const u32x2 g = *(const u32x2*)(G + o);
        f32x4 m = (f32x4){lo16(g.x) * v.x, hi16(g.x) * v.y, lo16(g.y) * v.z, hi16(g.y) * v.w};
        if (!first) { const u32x2 p = *(const u32x2*)(MG + o); m.x += lo16(p.x); m.y += hi16(p.x); m.z += lo16(p.y); m.w += hi16(p.y); }
        u32x2 w; w.x = pk2(m.x, m.y); w.y = pk2(m.z, m.w); *(u32x2*)(MG + o) = w; } };
struct EpiOut { Ptrs P; int l;
    __device__ __forceinline__ void operator()(int row, int col, f32x4 v) const { const int bb = row_bb(row);
        const f32x4 g = *(const f32x4*)(mod_vec(P, l, bb, 2) + col); float* xo = x1_row(P, row) + col;
        const f32x4 xp = l == 0 ? *(const f32x4*)(xin_row(P, row) + col) : *(const f32x4*)xo;
        *(f32x4*)xo = xp + g * v; } };
struct EpiMoe1 { bf16_t* HID;
    __device__ __forceinline__ void operator()(int row, int hc, f32x4 a, f32x4 b) const {
        f32x4 h; h.x = a.x / (1.f + __expf(-a.x)) * b.x; h.y = a.y / (1.f + __expf(-a.y)) * b.y; h.z = a.z / (1.f + __expf(-a.z)) * b.z; h.w = a.w / (1.f + __expf(-a.w)) * b.w;
        u32x2 w; w.x = pk2(h.x, h.y); w.y = pk2(h.z, h.w); *(u32x2*)(HID + (size_t)row * FF + hc) = w; } };
struct EpiMoe2 { bf16_t* MO; const int* rowmap; const float* roww;
    __device__ __forceinline__ void operator()(int row, int col, f32x4 v) const { const int t = rowmap[row]; if (t < 0) return; const float w = roww[row];
        u32x2 o; o.x = pk2(v.x * w, v.y * w); o.y = pk2(v.z * w, v.w * w); *(u32x2*)(MO + ((size_t)(t & 1) * R + (t >> 1)) * D + col) = o; } };

__device__ __forceinline__ int moe_expert_of_row(const unsigned* cnt, int row0, int& total) {
    int off = 0, e_found = -1;
#pragma unroll
    for (int e = 0; e < 16; ++e) { const int n = ((int)cnt[e] + 255) & ~255; if (row0 >= off && row0 < off + n) e_found = e; off += n; }
    total = off; return e_found;
}

template <class Epi, bool DUAL> __global__ __launch_bounds__(256) void k_gemm(const bf16_t* A, int lda, const bf16_t* Bt, int ldb, int K, Epi E, const unsigned* cnt, size_t bstride) {
    const int lane = threadIdx.x & 63, w = threadIdx.x >> 6, r16 = lane & 15, kq = lane >> 4;
    const int m0 = blockIdx.y * 128 + (w >> 1) * 64, n0 = blockIdx.x * 128 + (w & 1) * 64;
    if (cnt) { int total; const int e = moe_expert_of_row(cnt, blockIdx.y * 128, total); if (e < 0) return; Bt += (size_t)e * bstride; }
    f32x4 acc[4][4], acc2[DUAL ? 4 : 1][4];
#pragma unroll
    for (int i = 0; i < 4; ++i)
#pragma unroll
        for (int j = 0; j < 4; ++j) { acc[i][j] = (f32x4){0.f, 0.f, 0.f, 0.f}; if constexpr (DUAL) acc2[i][j] = (f32x4){0.f, 0.f, 0.f, 0.f}; }
    const int brow1 = DUAL ? 256 * (n0 >> 7) + (n0 & 127) : n0;
    const bf16_t* ap = A + (size_t)(m0 + r16) * lda + 8 * kq; const bf16_t* bp = Bt + (size_t)(brow1 + r16) * ldb + 8 * kq;
    for (int k0 = 0; k0 < K; k0 += 32) {
        bf16x8 af[4], bf[4], bf2[DUAL ? 4 : 1];
#pragma unroll
        for (int i = 0; i < 4; ++i) af[i] = *(const bf16x8*)(ap + (size_t)(16 * i) * lda + k0);
#pragma unroll
        for (int j = 0; j < 4; ++j) { bf[j] = *(const bf16x8*)(bp + (size_t)(16 * j) * ldb + k0); if constexpr (DUAL) bf2[j] = *(const bf16x8*)(bp + (size_t)(128 + 16 * j) * ldb + k0); }
#pragma unroll
        for (int i = 0; i < 4; ++i)
#pragma unroll
            for (int j = 0; j < 4; ++j) { acc[i][j] = __builtin_amdgcn_mfma_f32_16x16x32_bf16(bf[j], af[i], acc[i][j], 0, 0, 0);
                if constexpr (DUAL) acc2[i][j] = __builtin_amdgcn_mfma_f32_16x16x32_bf16(bf2[j], af[i], acc2[i][j], 0, 0, 0); }
    }
#pragma unroll
    for (int i = 0; i < 4; ++i)
#pragma unroll
        for (int j = 0; j < 4; ++j) { if constexpr (DUAL) E(m0 + 16 * i + r16, n0 + 16 * j + 4 * kq, acc[i][j], acc2[i][j]); else E(m0 + 16 * i + r16, n0 + 16 * j + 4 * kq, acc[i][j]); }
}

__global__ __launch_bounds__(256) void k_qkprep(Ptrs P, int l) {
    const int lane = threadIdx.x & 63, r = blockIdx.x * 4 + (threadIdx.x >> 6);
    bf16_t* u = (bf16_t*)(P.ws + WS_U) + (size_t)r * NIN;
    const bool lat = r < RL; const int t = r & (T - 1);
    const float* rc = (const float*)(P.ws + WS_ROPE); const float* rs = rc + 1024;
    const int a = lane >> 5, pos = a ? (t & 63) : (t >> 6), fi = lane & 15; const bool second = (lane & 16) != 0;
    const float cs = rc[pos * 16 + fi], sn = rs[pos * 16 + fi];
    const float qg = P.q_gain[l * 64 + lane], kg = P.k_gain[l * 64 + lane];
    for (int hh = 0; hh < 20; ++hh) {
        const int col = hh < 8 ? C_QB + hh * 64 : hh < 10 ? C_KB + (hh - 8) * 64 : hh < 18 ? C_QW + (hh - 10) * 64 : C_KW + (hh - 18) * 64;
        float x = bf2f(u[col + lane]);
        if (hh < 10) { const float ss = wave_sum(x * x); x = x * (1.0f / sqrtf(ss * (1.0f / 64.0f) + EPS)) * (hh < 8 ? qg : kg); }
        if (lat) { const float y = __shfl_xor(x, 16); x = second ? x * cs + y * sn : x * cs - y * sn; }
        if (hh < 8 || (hh >= 10 && hh < 18)) x *= QSCALE;
        u[col + lane] = (bf16_t)f2bf(x);
    }
}

template <int MODE> __global__ __launch_bounds__(256) void k_attn(Ptrs P, int l) {
    __shared__ float Ks[64][64];
    __shared__ float Vs[64][64];
    const int tid = threadIdx.x, h = blockIdx.y, b = blockIdx.z, g = h >> 2;
    const bf16_t* U = (const bf16_t*)(P.ws + WS_U);
    const bool latq = MODE < 2; const bool winm = (MODE == 1 || MODE == 3);
    const int t = blockIdx.x * 256 + tid;
    const int qrow = latq ? b * T + t : RL + b * TC + t;
    const int qcol = (winm ? C_QW : C_QB) + h * 64, kcol = (winm ? C_KW : C_KB) + g * 64, vcol = (winm ? C_VW : C_VB) + g * 64;
    float q[64], o[64];
    { const u32x4* qp = (const u32x4*)(U + (size_t)qrow * NIN + qcol);
#pragma unroll
      for (int i = 0; i < 8; ++i) { const u32x4 w = qp[i]; q[8 * i] = lo16(w.x); q[8 * i + 1] = hi16(w.x); q[8 * i + 2] = lo16(w.y); q[8 * i + 3] = hi16(w.y); q[8 * i + 4] = lo16(w.z); q[8 * i + 5] = hi16(w.z); q[8 * i + 6] = lo16(w.w); q[8 * i + 7] = hi16(w.w); } }
#pragma unroll
    for (int d = 0; d < 64; ++d) o[d] = 0.f;
    float m = -INFINITY, lsum = 0.f;
    int lt_lo = 0, lt_hi = 0;
    if (MODE == 0) { lt_lo = 0; lt_hi = T / 64; }
    if (MODE == 1) { const int q0 = blockIdx.x * 256; lt_lo = (q0 - 128 < 0 ? 0 : q0 - 128) / 64; lt_hi = (q0 + 384 > T ? T : q0 + 384) / 64; }
    const int ntiles = 4 + (lt_hi - lt_lo);
    for (int ti = 0; ti < ntiles; ++ti) {
        const bool isctx = ti < 4; const int kpos0 = isctx ? ti * 64 : (lt_lo + ti - 4) * 64;
        const int krow0 = isctx ? RL + b * TC + kpos0 : b * T + kpos0;
        __syncthreads();
        { const int j = tid >> 2, part = tid & 3; const bf16_t* kp = U + (size_t)(krow0 + j) * NIN + kcol + part * 16; const bf16_t* vp = U + (size_t)(krow0 + j) * NIN + vcol + part * 16;
#pragma unroll
          for (int i = 0; i < 2; ++i) { const u32x4 kw = ((const u32x4*)kp)[i], vw = ((const u32x4*)vp)[i]; float* kd = &Ks[j][part * 16 + 8 * i]; float* vd = &Vs[j][part * 16 + 8 * i];
              kd[0] = lo16(kw.x); kd[1] = hi16(kw.x); kd[2] = lo16(kw.y); kd[3] = hi16(kw.y); kd[4] = lo16(kw.z); kd[5] = hi16(kw.z); kd[6] = lo16(kw.w); kd[7] = hi16(kw.w);
              vd[0] = lo16(vw.x); vd[1] = hi16(vw.x); vd[2] = lo16(vw.y); vd[3] = hi16(vw.y); vd[4] = lo16(vw.z); vd[5] = hi16(vw.z); vd[6] = lo16(vw.w); vd[7] = hi16(vw.w); } }
        __syncthreads();
        for (int c = 0; c < 4; ++c) {
            float s[16]; float cmax = -INFINITY;
#pragma unroll
            for (int jj = 0; jj < 16; ++jj) { float a = 0.f; const f32x4* kr = (const f32x4*)&Ks[c * 16 + jj][0];
#pragma unroll
                for (int d4 = 0; d4 < 16; ++d4) { const f32x4 kv = kr[d4]; a += q[4 * d4] * kv.x + q[4 * d4 + 1] * kv.y + q[4 * d4 + 2] * kv.z + q[4 * d4 + 3] * kv.w; }
                if (MODE == 1 && !isctx) { const int kp = kpos0 + c * 16 + jj; const int dlt = kp - t; if (dlt > 128 || dlt < -128) a = -INFINITY; }
                s[jj] = a; cmax = fmaxf(cmax, a); }
            const float mn = fmaxf(m, cmax);
            if (mn == -INFINITY) continue;
            const float scl = exp2f(m - mn); m = mn; lsum *= scl;
#pragma unroll
            for (int d = 0; d < 64; ++d) o[d] *= scl;
#pragma unroll
            for (int jj = 0; jj < 16; ++jj) { const float p = exp2f(s[jj] - mn); lsum += p; const f32x4* vr = (const f32x4*)&Vs[c * 16 + jj][0];
#pragma unroll
                for (int d4 = 0; d4 < 16; ++d4) { const f32x4 vv = vr[d4]; o[4 * d4] += p * vv.x; o[4 * d4 + 1] += p * vv.y; o[4 * d4 + 2] += p * vv.z; o[4 * d4 + 3] += p * vv.w; } }
        }
    }
    if (winm) lsum += exp2f(P.sink[l * 8 + h] * LOG2E - m);
    const float inv = 1.0f / lsum;
    u32x4* op = (u32x4*)((bf16_t*)(P.ws + WS_BR) + (size_t)qrow * NBR + (winm ? 1024 : 512) + h * 64);
#pragma unroll
    for (int i = 0; i < 8; ++i) { u32x4 w; w.x = pk2(o[8 * i] * inv, o[8 * i + 1] * inv); w.y = pk2(o[8 * i + 2] * inv, o[8 * i + 3] * inv); w.z = pk2(o[8 * i + 4] * inv, o[8 * i + 5] * inv); w.w = pk2(o[8 * i + 6] * inv, o[8 * i + 7] * inv); op[i] = w; }
}

__global__ __launch_bounds__(256) void k_fourier(Ptrs P, int Ts, int latent) {
    __shared__ float Zr[16][64], Zi[16][64], Ct[64][17], St[64][17];
    const int tid = threadIdx.x, k0 = blockIdx.x * 64, ch0 = blockIdx.y * 64, b = blockIdx.z;
    const int rbase = latent ? b * T : RL + b * TC; const int step = 4096 / Ts;
    const bf16_t* U = (const bf16_t*)(P.ws + WS_U); const float* ct = (const float*)(P.ws + WS_COS);
    const int tk = tid >> 4, tc = tid & 15;
    float acc[4][4];
#pragma unroll
    for (int i = 0; i < 4; ++i)
#pragma unroll
        for (int j = 0; j < 4; ++j) acc[i][j] = 0.f;
    for (int t0 = 0; t0 < Ts; t0 += 16) {
        __syncthreads();
        { const int tt = tid >> 4, c4 = (tid & 15) * 4; const bf16_t* zp = U + (size_t)(rbase + t0 + tt) * NIN + ch0 + c4;
          const u32x2 a = *(const u32x2*)(zp + C_ZR), bq = *(const u32x2*)(zp + C_ZI);
          Zr[tt][c4] = lo16(a.x); Zr[tt][c4 + 1] = hi16(a.x); Zr[tt][c4 + 2] = lo16(a.y); Zr[tt][c4 + 3] = hi16(a.y);
          Zi[tt][c4] = lo16(bq.x); Zi[tt][c4 + 1] = hi16(bq.x); Zi[tt][c4 + 2] = lo16(bq.y); Zi[tt][c4 + 3] = hi16(bq.y); }
#pragma unroll
        for (int i = 0; i < 4; ++i) { const int e = tid * 4 + i, k = e >> 4, tt = e & 15; const int ang = (((k0 + k) * (t0 + tt)) & (Ts - 1)) * step;
            Ct[k][tt] = ct[ang]; St[k][tt] = ct[(ang - 1024) & 4095]; }
        __syncthreads();
#pragma unroll
        for (int tt = 0; tt < 16; ++tt) { float zr[4], zi[4];
#pragma unroll
            for (int j = 0; j < 4; ++j) { zr[j] = Zr[tt][tc * 4 + j]; zi[j] = Zi[tt][tc * 4 + j]; }
#pragma unroll
            for (int i = 0; i < 4; ++i) { const float c = Ct[tk * 4 + i][tt], s = St[tk * 4 + i][tt];
#pragma unroll
                for (int j = 0; j < 4; ++j) acc[i][j] += c * zr[j] + s * zi[j]; } }
    }
    const float sc = 1.0f / sqrtf((float)Ts);
    bf16_t* BR = (bf16_t*)(P.ws + WS_BR);
#pragma unroll
    for (int i = 0; i < 4; ++i) { u32x2 w; w.x = pk2(acc[i][0] * sc, acc[i][1] * sc); w.y = pk2(acc[i][2] * sc, acc[i][3] * sc);
        *(u32x2*)(BR + (size_t)(rbase + k0 + tk * 4 + i) * NBR + ch0 + tc * 4) = w; }
}

__global__ __launch_bounds__(256) void k_pool(Ptrs P, int nrows) {
    const int i = blockIdx.x * 256 + threadIdx.x; const int r = i >> 6, c8 = (i & 63) * 8;
    if (r >= nrows) return;
    const bool lat = r < RL; const int Ts = lat ? T : TC; const int t = lat ? (r & (T - 1)) : ((r - RL) & (TC - 1)); const int r0 = r - t;
    const int g = c8 >> 7, hw = 1 << g;
    const int lo = t - hw < 0 ? 0 : t - hw, hi = t + hw > Ts ? Ts : t + hw;
    const bf16_t* U = (const bf16_t*)(P.ws + WS_U) + C_P + c8;
    float s[8];
#pragma unroll
    for (int j = 0; j < 8; ++j) s[j] = 0.f;
    for (int tt = lo; tt < hi; ++tt) { const u32x4 w = *(const u32x4*)(U + (size_t)(r0 + tt) * NIN);
        s[0] += lo16(w.x); s[1] += hi16(w.x); s[2] += lo16(w.y); s[3] += hi16(w.y); s[4] += lo16(w.z); s[5] += hi16(w.z); s[6] += lo16(w.w); s[7] += hi16(w.w); }
    const u32x4 w = *(const u32x4*)(U + (size_t)r * NIN); const float inv = 1.0f / (float)(hi - lo);
    u32x4 o; o.x = pk2(s[0] * inv - lo16(w.x), s[1] * inv - hi16(w.x)); o.y = pk2(s[2] * inv - lo16(w.y), s[3] * inv - hi16(w.y));
    o.z = pk2(s[4] * inv - lo16(w.z), s[5] * inv - hi16(w.z)); o.w = pk2(s[6] * inv - lo16(w.w), s[7] * inv - hi16(w.w));
    *(u32x4*)((bf16_t*)(P.ws + WS_BR) + (size_t)r * NBR + 1536 + c8) = o;
}

__global__ __launch_bounds__(256) void k_moe_gather(Ptrs P, int l, int nrows) {
    const unsigned* cnt = (const unsigned*)(P.ws + WS_CTL) + CW_CNT + 64 * l;
    int* rowmap = (int*)(P.ws + WS_ROWMAP); float* roww = (float*)(P.ws + WS_ROWW);
    const int lane = threadIdx.x & 63, wv = blockIdx.x * 4 + (threadIdx.x >> 6);
    if (wv < 2 * nrows) {
        const int r = wv >> 1, s = wv & 1; const int* rt = (const int*)(P.ws + WS_ROUTE) + (size_t)r * 6;
        const int e = rt[2 * s], pos = rt[2 * s + 1]; const float w = ((const float*)rt)[4 + s];
        int off = 0;
#pragma unroll
        for (int q = 0; q < 16; ++q) { const int n = ((int)cnt[q] + 255) & ~255; if (q < e) off += n; }
        const int dst = off + pos;
        const u32x4* src = (const u32x4*)((const bf16_t*)(P.ws + WS_H) + (size_t)r * D); u32x4* d = (u32x4*)((bf16_t*)(P.ws + WS_AS) + (size_t)dst * D);
        d[lane] = src[lane]; d[lane + 64] = src[lane + 64];
        if (lane == 0) { rowmap[dst] = wv; roww[dst] = w; }
    } else {
        const int i = (wv - 2 * nrows) * 64 + lane;
        if (i < 16 * 256) { const int e = i >> 8, p = i & 255; int off = 0;
#pragma unroll
            for (int q = 0; q < 16; ++q) { const int n = ((int)cnt[q] + 255) & ~255; if (q < e) off += n; }
            const int c = (int)cnt[e]; if (c + p < ((c + 255) & ~255)) rowmap[off + c + p] = -1; }
    }
}

__global__ __launch_bounds__(256) void k_final(Ptrs P) {
    const int lane = threadIdx.x & 63, r = blockIdx.x * 4 + (threadIdx.x >> 6); const int bb = row_bb(r);
    f32x4* xr = (f32x4*)(P.out + (size_t)r * D) + lane; f32x4 v[4];
    const f32x4* g2 = (const f32x4*)mod_vec(P, 1, bb, 5) + lane;
    const u32x2* m0 = (const u32x2*)((const bf16_t*)(P.ws + WS_MO) + (size_t)r * D) + lane; const u32x2* m1 = (const u32x2*)((const bf16_t*)(P.ws + WS_MO) + (size_t)(R + r) * D) + lane;
    float ss = 0.f;
#pragma unroll
    for (int j = 0; j < 4; ++j) { v[j] = xr[64 * j]; const u32x2 a = m0[64 * j], b = m1[64 * j]; const f32x4 g = g2[64 * j];
        v[j].x += g.x * (lo16(a.x) + lo16(b.x)); v[j].y += g.y * (hi16(a.x) + hi16(b.x)); v[j].z += g.z * (lo16(a.y) + lo16(b.y)); v[j].w += g.w * (hi16(a.y) + hi16(b.y));
        ss += (v[j].x * v[j].x + v[j].y * v[j].y) + (v[j].z * v[j].z + v[j].w * v[j].w); }
    const float rstd = 1.0f / sqrtf(wave_sum(ss) * (1.0f / D) + EPS);
    const f32x4* gn = (const f32x4*)P.norm_f + lane;
#pragma unroll
    for (int j = 0; j < 4; ++j) xr[64 * j] = v[j] * rstd * gn[64 * j];
}

extern "C" void kernel_launch(void* const* d_in, const int* in_sizes, int n_in, void* d_out, int out_size, void* d_ws, size_t ws_size, hipStream_t stream) {
    if (n_in != 24 || ws_size < WS_END || out_size != RL * D) { fprintf(stderr, "kernel_launch: unexpected sizes n_in %d ws %zu out %d\n", n_in, ws_size, out_size); return; }
    Ptrs P{};
    const float** pp = (const float**)&P;
    for (int i = 0; i < 24; ++i) pp[i] = (const float*)d_in[i];
    P.out = (float*)d_out; P.ws = (unsigned char*)d_ws;
    unsigned char* ws = P.ws;
    hipMemsetAsync(ws + WS_CTL, 0, 1 * MiB, stream);
    k_tables<<<16, 256, 0, stream>>>(P);
    k_mod<<<dim3(96, 2), 256, 0, stream>>>(P);
    bf16_t* WB = (bf16_t*)(ws + WS_WB);
    bf16_t* Bt_in = (bf16_t*)(ws + WS_WB + WB_IN); bf16_t* Bt_gate = (bf16_t*)(ws + WS_WB + WB_GATE); bf16_t* Bt_br = (bf16_t*)(ws + WS_WB + WB_BR);
    bf16_t* Bt_out = (bf16_t*)(ws + WS_WB + WB_OUT); bf16_t* Bt_13 = (bf16_t*)(ws + WS_WB + WB_13); bf16_t* Bt_2 = (bf16_t*)(ws + WS_WB + WB_2);
    (void)WB;
    bf16_t* H = (bf16_t*)(ws + WS_H); bf16_t* U = (bf16_t*)(ws + WS_U); bf16_t* BR = (bf16_t*)(ws + WS_BR);
    bf16_t* GT = (bf16_t*)(ws + WS_GT); bf16_t* MG = (bf16_t*)(ws + WS_MG); bf16_t* AS = (bf16_t*)(ws + WS_AS); bf16_t* HID = (bf16_t*)(ws + WS_HID); bf16_t* MO = (bf16_t*)(ws + WS_MO);
    for (int l = 0; l < 2; ++l) {
        const int M = l == 0 ? R : RL;
        const float* w_in = P.w_in + (size_t)l * 1024 * 2560;
        k_conv<<<dim3(16 * 32, 1, 1), 256, 0, stream>>>(w_in, 2560, 1024, 512, 2048, Bt_in, 1024, 1024, 0, 0, 0);
        k_fold_dft<<<dim3(16, 4), 256, 0, stream>>>(w_in, Bt_in);
        k_conv<<<dim3(16 * 16, 1, 4), 256, 0, stream>>>(P.w_gate + (size_t)l * 4 * 1024 * 1024, 1024, 1024, 0, 1024, Bt_gate, 1024, 0, 0, (size_t)1024 * 1024, (size_t)1024 * 1024);
        k_conv<<<dim3(8 * 16, 1, 3), 256, 0, stream>>>(P.w_branch + (size_t)l * 4 * 512 * 1024, 1024, 512, 0, 1024, Bt_br, 512, 0, 0, (size_t)512 * 1024, (size_t)1024 * 512);
        k_fold_pool<<<dim3(16, 4), 256, 0, stream>>>(P.pool_w + (size_t)l * 4 * 128 * 128, P.pool_scale + (size_t)l * 512, P.w_branch + ((size_t)l * 4 + 3) * 512 * 1024, Bt_br + (size_t)3 * 1024 * 512);
        k_conv<<<dim3(16 * 16, 1, 1), 256, 0, stream>>>(P.w_out + (size_t)l * 1024 * 1024, 1024, 1024, 0, 1024, Bt_out, 1024, 0, 0, 0, 0);
        k_conv<<<dim3(16 * 8, 1, 16), 256, 0, stream>>>(P.w1 + (size_t)l * 16 * 1024 * 512, 512, 1024, 0, 512, Bt_13, 1024, 0, 1, (size_t)1024 * 512, (size_t)1024 * 1024);
        k_conv<<<dim3(16 * 8, 1, 16), 256, 0, stream>>>(P.w3 + (size_t)l * 16 * 1024 * 512, 512, 1024, 0, 512, Bt_13, 1024, 128, 1, (size_t)1024 * 512, (size_t)1024 * 1024);
        k_conv<<<dim3(8 * 16, 1, 16), 256, 0, stream>>>(P.w2 + (size_t)l * 16 * 512 * 1024, 1024, 512, 0, 1024, Bt_2, 512, 0, 0, (size_t)512 * 1024, (size_t)1024 * 512);
        if (l == 0) k_norm<0><<<R / 4, 256, 0, stream>>>(P, l, R); else k_norm<1><<<R / 4, 256, 0, stream>>>(P, l, R);
        k_gemm<EpiStore, false><<<dim3(NIN / 128, R / 128), 256, 0, stream>>>(H, D, Bt_in, D, D, EpiStore{U, NIN}, nullptr, 0);
        k_qkprep<<<R / 4, 256, 0, stream>>>(P, l);
        k_attn<0><<<dim3(16, 8, 8), 256, 0, stream>>>(P, l);
        k_attn<1><<<dim3(16, 8, 8), 256, 0, stream>>>(P, l);
        k_fourier<<<dim3(64, 8, 8), 256, 0, stream>>>(P, T, 1);
        if (l == 0) { k_attn<2><<<dim3(1, 8, 8), 256, 0, stream>>>(P, l); k_attn<3><<<dim3(1, 8, 8), 256, 0, stream>>>(P, l); k_fourier<<<dim3(4, 8, 8), 256, 0, stream>>>(P, TC, 0); }
        k_pool<<<M * 64 / 256, 256, 0, stream>>>(P, M);
        for (int i = 0; i < 4; ++i) {
            bf16_t* Gi = GT + (size_t)(i & 1) * R * D;
            k_gemm<EpiGate, false><<<dim3(D / 128, M / 128), 256, 0, stream>>>(H, D, Bt_gate + (size_t)i * 1024 * 1024, D, D, EpiGate{Gi, P.b_gate + ((size_t)l * 4 + i) * D}, nullptr, 0);
            k_gemm<EpiMerge, false><<<dim3(D / 128, M / 128), 256, 0, stream>>>(BR + i * 512, NBR, Bt_br + (size_t)i * 1024 * 512, 512, 512, EpiMerge{MG, Gi, i == 0}, nullptr, 0);
        }
        k_gemm<EpiOut, false><<<dim3(D / 128, M / 128), 256, 0, stream>>>(MG, D, Bt_out, D, D, EpiOut{P, l}, nullptr, 0);
        k_norm<2><<<M / 4, 256, 0, stream>>>(P, l, M);
        k_moe_gather<<<(2 * M + 64) / 4, 256, 0, stream>>>(P, l, M);
        const unsigned* cnt = (const unsigned*)(ws + WS_CTL) + CW_CNT + 64 * l;
        k_gemm<EpiMoe1, true><<<dim3(FF / 128, MAXROWS / 128), 256, 0, stream>>>(AS, D, Bt_13, D, D, EpiMoe1{HID}, cnt, (size_t)1024 * 1024);
        k_gemm<EpiMoe2, false><<<dim3(D / 128, MAXROWS / 128), 256, 0, stream>>>(HID, FF, Bt_2, FF, FF, EpiMoe2{MO, (const int*)(ws + WS_ROWMAP), (const float*)(ws + WS_ROWW)}, cnt, (size_t)1024 * 512);
    }
    k_final<<<RL / 4, 256, 0, stream>>>(P);
}
```

```cpp
#include <hip/hip_runtime.h>
#include <cstdio>
#include <cstdint>

typedef unsigned short bf16_t;
typedef short bf16x8 __attribute__((ext_vector_type(8)));
typedef float f32x4 __attribute__((ext_vector_type(4)));
typedef unsigned u32x4 __attribute__((ext_vector_type(4)));
typedef unsigned u32x2 __attribute__((ext_vector_type(2)));

constexpr int D = 1024, NB = 8, T = 4096, TC = 256;
constexpr int RL = NB * T, RC = NB * TC, R = RL + RC;
constexpr int NIN = 3072;
constexpr int C_ZR = 0, C_ZI = 512, C_P = 1024, C_QB = 1536, C_KB = 2048, C_VB = 2176, C_QW = 2304, C_KW = 2816, C_VW = 2944;
constexpr int NBR = 2048;
constexpr int NE = 16, FF = 512;
constexpr int MAXROWS = 73728;
constexpr float EPS = 1e-6f;
constexpr float QSCALE = 0.125f * 1.4426950408889634f;
constexpr float LOG2E = 1.4426950408889634f;

constexpr size_t MiB = 1u << 20;
constexpr size_t WS_CTL = 0;
constexpr size_t WS_MOD = 1 * MiB;
constexpr size_t WS_ROPE = 1 * MiB + 512 * 1024;
constexpr size_t WS_COS = WS_ROPE + 16 * 1024;
constexpr size_t WS_ROUTE = 2 * MiB;
constexpr size_t WS_ROWMAP = 3 * MiB;
constexpr size_t WS_ROWW = 3 * MiB + 512 * 1024;
constexpr size_t WS_XC = 9 * MiB;
constexpr size_t WS_WB = 17 * MiB;
constexpr size_t WB_IN = 0, WB_GATE = 6 * MiB, WB_BR = 14 * MiB, WB_OUT = 18 * MiB, WB_13 = 20 * MiB, WB_2 = 52 * MiB;
constexpr size_t WS_H = 85 * MiB;
constexpr size_t WS_ARENA = 153 * MiB;
constexpr size_t WS_U = WS_ARENA;
constexpr size_t WS_BR = WS_ARENA + 204 * MiB;
constexpr size_t WS_GT = WS_ARENA;
constexpr size_t WS_MG = WS_ARENA + 136 * MiB;
constexpr size_t WS_AS = WS_ARENA;
constexpr size_t WS_HID = WS_ARENA + 144 * MiB;
constexpr size_t WS_MO = WS_ARENA + 216 * MiB;
constexpr size_t WS_END = 512 * MiB;
static_assert(WS_BR + (size_t)R * NBR * 2 <= WS_END && WS_MO + (size_t)2 * R * D * 2 <= WS_END && WS_MG + (size_t)R * D * 2 <= WS_BR, "ws map");
constexpr int CW_CNT = 1024;

__device__ __forceinline__ float bf2f(bf16_t b) { return __uint_as_float(((unsigned)b) << 16); }
__device__ __forceinline__ unsigned f2bf(float f) { unsigned u = __float_as_uint(f); return (u + 0x7fffu + ((u >> 16) & 1u)) >> 16; }
__device__ __forceinline__ unsigned pk2(float lo, float hi) { return f2bf(lo) | (f2bf(hi) << 16); }
__device__ __forceinline__ float lo16(unsigned w) { return __uint_as_float(w << 16); }
__device__ __forceinline__ float hi16(unsigned w) { return __uint_as_float(w & 0xffff0000u); }
__device__ __forceinline__ float shfl_xor_l(float v, int o, int lane) { return __int_as_float(__builtin_amdgcn_ds_bpermute((lane ^ o) << 2, __float_as_int(v))); }
__device__ __forceinline__ float wave_sum_l(float v, int lane) {
#pragma unroll
    for (int o = 1; o < 64; o <<= 1) v += shfl_xor_l(v, o, lane);
    return v;
}
__device__ __forceinline__ int row_bb(int r) { return r < RL ? (r >> 12) : 8; }

struct Ptrs {
    const float *x, *c, *ctx, *c_ctx, *w_ada, *b_ada, *norm1, *norm2, *w_in, *q_gain, *k_gain, *sink, *pool_w, *pool_scale,
        *w_branch, *w_gate, *b_gate, *w_out, *router_w, *router_bias, *w1, *w3, *w2, *norm_f;
    float* out; unsigned char* ws;
};
__device__ __forceinline__ const float* xin_row(const Ptrs& P, int r) { return r < RL ? P.x + (size_t)r * D : P.ctx + (size_t)(r - RL) * D; }
__device__ __forceinline__ float* x1_row(const Ptrs& P, int r) { return r < RL ? P.out + (size_t)r * D : (float*)(P.ws + WS_XC) + (size_t)(r - RL) * D; }
__device__ __forceinline__ const float* mod_vec(const Ptrs& P, int l, int bb, int which) { return (const float*)(P.ws + WS_MOD) + ((size_t)(l * 9 + bb) * 6 + which) * D; }

struct EpiOut { Ptrs P; int l;
    __device__ __forceinline__ void operator()(int row, int col, f32x4 v) const { const int bb = row_bb(row);
        const f32x4 g = *(const f32x4*)(mod_vec(P, l, bb, 2) + col); float* xo = x1_row(P, row) + col;
        const f32x4 xp = l == 0 ? *(const f32x4*)(xin_row(P, row) + col) : *(const f32x4*)xo;
        *(f32x4*)xo = xp + g * v; } };

#define LAS __attribute__((address_space(3)))
#define GAS __attribute__((address_space(1)))
#define LDS_WAIT() asm volatile("s_waitcnt lgkmcnt(0)" ::: "memory")
__device__ __forceinline__ int fresh_lane() { int l; asm volatile("v_mbcnt_lo_u32_b32 %0, -1, 0\n\tv_mbcnt_hi_u32_b32 %0, -1, %0" : "=v"(l)); return l; }
constexpr int NWAVES = 8;
constexpr int RING_BYTES = 131072, LDSCTL_OFF = RING_BYTES, MISC_OFF = LDSCTL_OFF + 320, LDS_BYTES = 147456;
constexpr int CW_BAR = 4096;
constexpr int NPH = 15, PH_FINAL = 2 * NPH;

#define XB_TMO      128
#define XB_XCNT(j)  (256  + 64 * (j))
#define XB_XSUB(j)  (1280 + 64 * (j))
#define XB_XGEN(j)  (2304 + 64 * (j))
#define XB_TOP      3328
#define XB_TOPGEN   3392
#define XCD_BAR_WORDS 3456
#define XB_SPIN_CAP (1u << 21)
__device__ __forceinline__ unsigned xb_ld(unsigned* p)              { return __hip_atomic_load(p, __ATOMIC_RELAXED, __HIP_MEMORY_SCOPE_AGENT); }
__device__ __forceinline__ unsigned xb_add(unsigned* p, unsigned v) { return __hip_atomic_fetch_add(p, v, __ATOMIC_RELAXED, __HIP_MEMORY_SCOPE_AGENT); }
__device__ __forceinline__ unsigned xb_xcc_id() { return (unsigned)__builtin_amdgcn_s_getreg((3 << 11) | 20) & 0xFu; }
#define XB_SPIN(cond, bar) do { unsigned _sp = 0; while (cond) { __builtin_amdgcn_s_sleep(1); \
    if ((++_sp & 255u) == 0u) { if (xb_ld(&(bar)[XB_TMO])) break; if (_sp > XB_SPIN_CAP) { atomicAdd(&(bar)[XB_TMO], 1u); break; } } } } while (0)
struct XcdBarrier { unsigned* bar; unsigned x; volatile LAS unsigned* st; int wave; };
__device__ __forceinline__ XcdBarrier xcd_barrier_post(unsigned* bar, volatile LAS unsigned* st, int wave) {
    XcdBarrier b; b.bar = bar; b.x = xb_xcc_id(); b.st = st; b.wave = wave;
    if (wave == 0 && fresh_lane() == 0) (void)xb_add(&bar[XB_XCNT(b.x)], 1u);
    return b;
}
__device__ __forceinline__ void xcd_barrier_complete(unsigned* bar, unsigned x, unsigned& nloc, unsigned& nx) {
    const unsigned G = gridDim.x * gridDim.y * gridDim.z;
    unsigned sum, cnt, mine, sp = 0u;
    for (;;) {
        sum = 0u; cnt = 0u; mine = 0u;
#pragma unroll
        for (unsigned j = 0; j < 16; ++j) { const unsigned c = xb_ld(&bar[XB_XCNT(j)]); sum += c; cnt += (c > 0u) ? 1u : 0u; mine = (j == x) ? c : mine; }
        if (sum == G) break;
        __builtin_amdgcn_s_sleep(1);
        if ((++sp & 255u) == 0u) { if (xb_ld(&bar[XB_TMO])) break; if (sp > XB_SPIN_CAP) { atomicAdd(&bar[XB_TMO], 1u); break; } }
    }
    nloc = mine > 0u ? mine : 1u; nx = cnt > 0u ? cnt : 1u;
}
__device__ __forceinline__ void xcd_barrier(const XcdBarrier& b) {
    asm volatile("s_waitcnt vmcnt(0)" ::: "memory");
    __syncthreads();
    if (b.wave == 0 && fresh_lane() == 0) {
        unsigned* bar = b.bar;
        __builtin_amdgcn_s_waitcnt(0);
        unsigned nloc = b.st[0], nx = b.st[1];
        if (nloc == 0u) { xcd_barrier_complete(bar, b.x, nloc, nx); b.st[0] = nloc; b.st[1] = nx; }
        const unsigned old = xb_add(&bar[XB_XSUB(b.x)], 1u);
        const unsigned gen = old / nloc;
        if (old + 1u == (gen + 1u) * nloc) {
            __builtin_amdgcn_fence(__ATOMIC_RELEASE, "agent");
            asm volatile("s_waitcnt vmcnt(0)" ::: "memory");
            const unsigned og = xb_add(&bar[XB_TOP], 1u);
            const unsigned tg = og / nx;
            if (og + 1u == (tg + 1u) * nx) xb_add(&bar[XB_TOPGEN], 1u);
            else XB_SPIN(xb_ld(&bar[XB_TOPGEN]) == tg, bar);
            __builtin_amdgcn_fence(__ATOMIC_ACQUIRE, "agent");
            xb_add(&bar[XB_XGEN(b.x)], 1u);
            asm volatile("s_waitcnt vmcnt(0)" ::: "memory");
        } else {
            XB_SPIN(xb_ld(&bar[XB_XGEN(b.x)]) == gen, bar);
            __builtin_amdgcn_fence(__ATOMIC_ACQUIRE, "agent");
            asm volatile("s_waitcnt vmcnt(0)" ::: "memory");
        }
    }
    __syncthreads();
}

namespace pg8 {
constexpr int BM = 256, BK = 64, HALF = 128, HTB = HALF * BK * 2, STAGE_BYTES = 8 * HTB, NXCD = 8, WGM = 8;
__host__ __device__ __forceinline__ int lds_byte(int r, int c) { const int st = (r >> 4) * 2 + (c >> 5), rr = r & 15, cc = c & 31, ob = rr * 64 + cc * 2; return st * 1024 + (ob ^ (((ob >> 9) & 1) << 5)); }
__host__ __device__ __forceinline__ void stage_rc(int b, int& Rr, int& C) { const int st = b / 1024, sb = b % 1024, swz = sb ^ (((sb >> 9) & 1) << 5); Rr = (st >> 1) * 16 + swz / 64; C = (st & 1) * 32 + (swz % 64) / 2; }
__host__ __device__ __forceinline__ int perm32(int rho) { const int n = rho >> 4, i = rho & 15; return 8 * (i >> 2) + 4 * n + (i & 3); }
struct Unit { int pm, pn; const char* a; const char* b; };

struct StaticOrder {
    int nM, nN, nwg, G, c; const char* A; const char* Bt; size_t astep, bstep;
    __device__ void init(int M, int N, int G_, int c_, const bf16_t* A_, int lda, const bf16_t* Bt_, int ldb) { nM = M / BM; nN = N / BM; nwg = nM * nN; G = G_; c = c_; A = (const char*)A_; Bt = (const char*)Bt_; astep = (size_t)BM * lda * 2; bstep = (size_t)BM * ldb * 2; }
    __device__ bool next(int i, Unit& u) const {
        const long L = (long)i * G + c; if (L >= nwg) return false;
        int wgid = (int)L; { const int q = nwg / NXCD, r = nwg % NXCD, xcd = wgid % NXCD, off = wgid / NXCD; wgid = (xcd < r ? xcd * (q + 1) : r * (q + 1) + (xcd - r) * q) + off; }
        const int nig = WGM * nN, gid = wgid / nig, fm = gid * WGM, gsz = (nM - fm) < WGM ? (nM - fm) : WGM;
        u.pm = fm + ((wgid % nig) % gsz); u.pn = (wgid % nig) / gsz; u.a = A + (size_t)u.pm * astep; u.b = Bt + (size_t)u.pn * bstep; return true;
    }
};
struct MoeOrder {
    int nN, G, c; const char* A; const char* Bt; size_t astep, bstep, bexp; const int* ptab;
    __device__ bool next(int i, Unit& u) const {
        const int L = i * G + c; const int total = ptab[16] * nN; if (L >= total) return false;
        u.pm = L / nN; u.pn = L % nN; int e = 0;
#pragma unroll
        for (int q = 1; q < 16; ++q) e += (u.pm >= ptab[q]) ? 1 : 0;
        u.a = A + (size_t)u.pm * astep; u.b = Bt + (size_t)e * bexp + (size_t)u.pn * bstep; return true;
    }
};

template <class Epi, class Sched, bool ALIGN_EPI = true, bool SP2 = true>
__device__ __forceinline__ void gemm_phase(LAS unsigned char* lds, const int wid, const int lda, const int ldb, const int K, const Sched& S, const Epi& E) {
    const int lane = fresh_lane(), tid = wid * 64 + lane, wr = wid >> 2, wc = wid & 3, fr = lane & 15, fq = lane >> 4;
    const int nt = K / BK;
    unsigned voffA[2], voffB[2];
#pragma unroll
    for (int i = 0; i < 2; ++i) { int Rr, C; stage_rc(tid * 16 + i * 8192, Rr, C); const int Rb = Epi::PERM ? ((Rr & ~31) + perm32(Rr & 31)) : Rr;
        voffA[i] = (unsigned)(Rr * lda + C) * 2u; voffB[i] = (unsigned)(Rb * ldb + C) * 2u; }
    const size_t kstep = (size_t)(BK * 2);
    const size_t hstepA = (size_t)HALF * lda * 2, hstepB = (size_t)HALF * ldb * 2;
    const unsigned ldsw = (unsigned)wid * 1024u;
    const int aoff = lds_byte(wr * 64 + fr, fq * 8), boff = lds_byte(wc * 32 + fr, fq * 8);
#define PG8_SA(b, h) (((b) * 2 + (h)) * HTB)
#define PG8_SB(b, h) ((4 + (b) * 2 + (h)) * HTB)
#define PG8_STAGE(bufoff, gbase, voff) do { _Pragma("unroll") for (int _i = 0; _i < 2; ++_i) \
        __builtin_amdgcn_global_load_lds((const unsigned*)((const char*)(gbase) + (voff)[_i]), (LAS unsigned*)(lds + (bufoff) + ldsw + _i * 8192), 16, 0, 0); } while (0)
#define PG8_LDA(dst, b, h) do { _Pragma("unroll") for (int m = 0; m < 4; ++m) _Pragma("unroll") for (int k = 0; k < 2; ++k) dst[m][k] = *(const LAS bf16x8*)(lds + PG8_SA(b, h) + aoff + m * 2048 + k * 1024); } while (0)
#define PG8_LDB(dst, b, h) do { _Pragma("unroll") for (int n = 0; n < 2; ++n) _Pragma("unroll") for (int k = 0; k < 2; ++k) dst[n][k] = *(const LAS bf16x8*)(lds + PG8_SB(b, h) + boff + n * 2048 + k * 1024); } while (0)
#define PG8_MMA(ai, bj, At, Bt) do { __builtin_amdgcn_s_setprio(1); _Pragma("unroll") for (int m = 0; m < 4; ++m) _Pragma("unroll") for (int n = 0; n < 2; ++n) _Pragma("unroll") for (int k = 0; k < 2; ++k) \
        acc[ai][bj][m][n] = __builtin_amdgcn_mfma_f32_16x16x32_bf16(Bt[n][k], At[m][k], acc[ai][bj][m][n], 0, 0, 0); __builtin_amdgcn_s_setprio(0); } while (0)
#define PG8_WAIT_V(n) asm volatile("s_waitcnt vmcnt(" #n ")" ::: "memory")
#define PG8_WAIT_L(n) asm volatile("s_waitcnt lgkmcnt(" #n ")" ::: "memory")
#define PG8_BAR __builtin_amdgcn_s_barrier()
#define PG8_SCHED __builtin_amdgcn_sched_barrier(0)
    Unit cur, nxt; int ui = 0;
    if (!S.next(0, cur)) return;
    f32x4 acc[2][2][4][2];
#pragma unroll
    for (int a = 0; a < 2; ++a)
#pragma unroll
        for (int b = 0; b < 2; ++b)
#pragma unroll
            for (int m = 0; m < 4; ++m)
#pragma unroll
                for (int n = 0; n < 2; ++n) acc[a][b][m][n] = (f32x4){0.f, 0.f, 0.f, 0.f};
    bf16x8 At[4][2], B0[2][2], B1[2][2];
    const char* cA = cur.a; const char* cB = cur.b;
    if constexpr (SP2) {
        PG8_STAGE(PG8_SB(0, 0), cB, voffB); PG8_STAGE(PG8_SB(0, 1), cB + hstepB, voffB); PG8_STAGE(PG8_SA(0, 0), cA, voffA); PG8_STAGE(PG8_SA(0, 1), cA + hstepA, voffA);
        if (wr == 1) PG8_BAR;
        PG8_WAIT_V(2); PG8_BAR;
        PG8_STAGE(PG8_SB(1, 0), cB + kstep, voffB); PG8_STAGE(PG8_SA(1, 0), cA + kstep, voffA); PG8_STAGE(PG8_SB(1, 1), cB + hstepB + kstep, voffB);
        PG8_WAIT_V(6); PG8_BAR;
    } else {
        PG8_STAGE(PG8_SB(0, 0), cB, voffB); PG8_STAGE(PG8_SA(0, 0), cA, voffA); PG8_STAGE(PG8_SB(0, 1), cB + hstepB, voffB); PG8_STAGE(PG8_SA(0, 1), cA + hstepA, voffA);
        if (wr == 1) PG8_BAR;
        PG8_WAIT_V(4); PG8_BAR;
        PG8_STAGE(PG8_SB(1, 0), cB + kstep, voffB); PG8_STAGE(PG8_SA(1, 0), cA + kstep, voffA); PG8_STAGE(PG8_SB(1, 1), cB + hstepB + kstep, voffB);
        PG8_WAIT_V(6); PG8_BAR;
    }
    for (;;) {
        const bool has_next = S.next(ui + 1, nxt);
        const char* nA = has_next ? nxt.a : cA; const char* nB = has_next ? nxt.b : cB;
        for (int t = 0; t < nt; t += 2) {
            const bool last = (t == nt - 2);
            const char* a1 = cA + (size_t)(t + 1) * kstep;
            const char* a2 = last ? nA : cA + (size_t)(t + 2) * kstep; const char* b2 = last ? nB : cB + (size_t)(t + 2) * kstep;
            const char* a3 = a2 + kstep; const char* b3 = b2 + kstep;
            if constexpr (SP2) {
            PG8_LDB(B0, 0, 0); PG8_LDB(B1, 0, 1); PG8_SCHED; PG8_LDA(At, 0, 0); PG8_STAGE(PG8_SA(1, 1), a1 + hstepA, voffA);
            PG8_WAIT_V(8); PG8_WAIT_L(0); PG8_BAR; PG8_MMA(0, 0, At, B0); PG8_MMA(0, 1, At, B1); PG8_BAR; PG8_SCHED;
            PG8_LDA(At, 0, 1); PG8_STAGE(PG8_SB(0, 0), b2, voffB); PG8_STAGE(PG8_SB(0, 1), b2 + hstepB, voffB); PG8_STAGE(PG8_SA(0, 0), a2, voffA);
            PG8_WAIT_V(8); PG8_WAIT_L(0); PG8_BAR; PG8_MMA(1, 0, At, B0); PG8_MMA(1, 1, At, B1); PG8_BAR; PG8_SCHED;
            PG8_LDB(B0, 1, 0); PG8_LDB(B1, 1, 1); PG8_SCHED; PG8_LDA(At, 1, 0); PG8_STAGE(PG8_SA(0, 1), a2 + hstepA, voffA);
            PG8_WAIT_V(8); PG8_WAIT_L(0); PG8_BAR; PG8_MMA(0, 0, At, B0); PG8_MMA(0, 1, At, B1); PG8_BAR; PG8_SCHED;
            PG8_LDA(At, 1, 1); PG8_STAGE(PG8_SB(1, 0), b3, voffB); PG8_STAGE(PG8_SB(1, 1), b3 + hstepB, voffB); PG8_STAGE(PG8_SA(1, 0), a3, voffA);
            PG8_WAIT_V(8); PG8_WAIT_L(0); PG8_BAR; PG8_MMA(1, 0, At, B0); PG8_MMA(1, 1, At, B1); PG8_BAR; PG8_SCHED;
            } else {
            PG8_LDB(B0, 0, 0); PG8_SCHED; PG8_LDA(At, 0, 0); PG8_STAGE(PG8_SA(1, 1), a1 + hstepA, voffA);
            PG8_WAIT_L(8); PG8_BAR; PG8_WAIT_L(0); PG8_MMA(0, 0, At, B0); PG8_BAR; PG8_SCHED;
            PG8_LDB(B1, 0, 1); PG8_STAGE(PG8_SB(0, 0), b2, voffB);
            PG8_BAR; PG8_WAIT_L(0); PG8_MMA(0, 1, At, B1); PG8_BAR;
            PG8_LDA(At, 0, 1); PG8_STAGE(PG8_SA(0, 0), a2, voffA);
            PG8_BAR; PG8_WAIT_L(0); PG8_MMA(1, 0, At, B0); PG8_BAR; PG8_SCHED;
            PG8_STAGE(PG8_SB(0, 1), b2 + hstepB, voffB);
            PG8_WAIT_V(6); PG8_BAR; PG8_MMA(1, 1, At, B1); PG8_BAR;
            PG8_LDB(B0, 1, 0); PG8_SCHED; PG8_LDA(At, 1, 0); PG8_STAGE(PG8_SA(0, 1), a2 + hstepA, voffA);
            PG8_WAIT_L(8); PG8_BAR; PG8_WAIT_L(0); PG8_MMA(0, 0, At, B0); PG8_BAR; PG8_SCHED;
            PG8_LDB(B1, 1, 1); PG8_STAGE(PG8_SB(1, 0), b3, voffB);
            PG8_BAR; PG8_WAIT_L(0); PG8_MMA(0, 1, At, B1); PG8_BAR;
            PG8_LDA(At, 1, 1); PG8_STAGE(PG8_SA(1, 0), a3, voffA);
            PG8_BAR; PG8_WAIT_L(0); PG8_MMA(1, 0, At, B0); PG8_BAR; PG8_SCHED;
            PG8_STAGE(PG8_SB(1, 1), b3 + hstepB, voffB);
            PG8_WAIT_V(6); PG8_BAR; PG8_MMA(1, 1, At, B1); PG8_BAR;
            }
        }
        if constexpr (ALIGN_EPI) { if (wr == 0) PG8_BAR; }
        E(acc, cur, wr, wc, fr, fq);
        if (!has_next) break;
#pragma unroll
        for (int a = 0; a < 2; ++a)
#pragma unroll
            for (int b = 0; b < 2; ++b)
#pragma unroll
                for (int m = 0; m < 4; ++m)
#pragma unroll
                    for (int n = 0; n < 2; ++n) acc[a][b][m][n] = (f32x4){0.f, 0.f, 0.f, 0.f};
        cur = nxt; cA = nA; cB = nB; ++ui;
        if constexpr (ALIGN_EPI) { if (wr == 1) PG8_BAR; }
    }
    PG8_WAIT_V(0);
    if constexpr (!ALIGN_EPI) { if (wr == 0) PG8_BAR; }
    PG8_BAR;
#undef PG8_SA
#undef PG8_SB
#undef PG8_STAGE
#undef PG8_LDA
#undef PG8_LDB
#undef PG8_MMA
#undef PG8_WAIT_V
#undef PG8_WAIT_L
#undef PG8_BAR
#undef PG8_SCHED
}
template <class F> struct EpiV4 { static constexpr bool PERM = false; F f;
    __device__ __forceinline__ void operator()(const f32x4 (&acc)[2][2][4][2], const Unit& u, int wr, int wc, int fr, int fq) const {
        const int row0 = u.pm * BM + wr * 64 + fr, col0 = u.pn * BM + wc * 32 + 4 * fq;
#pragma unroll
        for (int ai = 0; ai < 2; ++ai)
#pragma unroll
            for (int m = 0; m < 4; ++m) {
#pragma unroll
                for (int bj = 0; bj < 2; ++bj)
#pragma unroll
                    for (int n = 0; n < 2; ++n) f(row0 + ai * HALF + m * 16, col0 + bj * HALF + n * 16, acc[ai][bj][m][n]);
                asm volatile("" ::: "memory"); }
    } };
template <class F> struct EpiV8 { static constexpr bool PERM = true; F f;
    __device__ __forceinline__ void operator()(const f32x4 (&acc)[2][2][4][2], const Unit& u, int wr, int wc, int fr, int fq) const {
        const int row0 = u.pm * BM + wr * 64 + fr, col0 = u.pn * BM + wc * 32 + 8 * fq;
#pragma unroll
        for (int ai = 0; ai < 2; ++ai)
#pragma unroll
            for (int m = 0; m < 4; ++m) {
#pragma unroll
                for (int bj = 0; bj < 2; ++bj) f.apply8(row0 + ai * HALF + m * 16, col0 + bj * HALF, acc[ai][bj][m][0], acc[ai][bj][m][1]);
                asm volatile("" ::: "memory"); }
    } };
template <class F> struct EpiDual { static constexpr bool PERM = true; F f;
    __device__ __forceinline__ void operator()(const f32x4 (&acc)[2][2][4][2], const Unit& u, int wr, int wc, int fr, int fq) const {
        const int row0 = u.pm * BM + wr * 64 + fr, hc0 = u.pn * HALF + wc * 32 + 8 * fq;
#pragma unroll
        for (int ai = 0; ai < 2; ++ai)
#pragma unroll
            for (int m = 0; m < 4; ++m) f.apply8(row0 + ai * HALF + m * 16, hc0, acc[ai][0][m][0], acc[ai][0][m][1], acc[ai][1][m][0], acc[ai][1][m][1]);
    } };
}

__device__ __forceinline__ u32x4 pack8(f32x4 a, f32x4 b) { u32x4 w; w.x = pk2(a.x, a.y); w.y = pk2(a.z, a.w); w.z = pk2(b.x, b.y); w.w = pk2(b.z, b.w); return w; }
__device__ __forceinline__ f32x4 sigm4(f32x4 v) { f32x4 r; r.x = 1.f / (1.f + __expf(-v.x)); r.y = 1.f / (1.f + __expf(-v.y)); r.z = 1.f / (1.f + __expf(-v.z)); r.w = 1.f / (1.f + __expf(-v.w)); return r; }
struct FStore8 { bf16_t* C; int ldc;
    __device__ __forceinline__ void apply8(int row, int col, f32x4 a, f32x4 b) const { *(u32x4*)(C + (size_t)row * ldc + col) = pack8(a, b); } };
struct FGate8 { bf16_t* G; const float* bias;
    __device__ __forceinline__ void apply8(int row, int col, f32x4 a, f32x4 b) const { const f32x4 b0 = *(const f32x4*)(bias + col), b1 = *(const f32x4*)(bias + col + 4);
        *(u32x4*)(G + (size_t)row * D + col) = pack8(sigm4(a + b0), sigm4(b + b1)); } };
struct FMerge8 { bf16_t* MG; const bf16_t* G; int first;
    __device__ __forceinline__ void apply8(int row, int col, f32x4 a, f32x4 b) const { const size_t o = (size_t)row * D + col; const u32x4 g = *(const u32x4*)(G + o);
        a = a * (f32x4){lo16(g.x), hi16(g.x), lo16(g.y), hi16(g.y)}; b = b * (f32x4){lo16(g.z), hi16(g.z), lo16(g.w), hi16(g.w)};
        if (!first) { const u32x4 p = *(const u32x4*)(MG + o); a += (f32x4){lo16(p.x), hi16(p.x), lo16(p.y), hi16(p.y)}; b += (f32x4){lo16(p.z), hi16(p.z), lo16(p.w), hi16(p.w)}; }
        *(u32x4*)(MG + o) = pack8(a, b); } };
struct FMoe1 { bf16_t* HID;
    __device__ __forceinline__ void apply8(int row, int hc, f32x4 a0, f32x4 a1, f32x4 b0, f32x4 b1) const {
        *(u32x4*)(HID + (size_t)row * FF + hc) = pack8(a0 * sigm4(a0) * b0, a1 * sigm4(a1) * b1); } };
struct FMoe2 { bf16_t* MO; const int* rowmap; const float* roww;
    __device__ __forceinline__ void apply8(int row, int col, f32x4 a, f32x4 b) const { const int t = rowmap[row]; if (t < 0) return; const float w = roww[row];
        *(u32x4*)(MO + ((size_t)(t & 1) * R + (t >> 1)) * D + col) = pack8(a * w, b * w); } };

struct Frame { LAS unsigned char* lds; int wave, vcu, G; };
#define fresh_tid() (F.wave * 64 + fresh_lane())
__device__ __forceinline__ void tr_item(const float* W, int ldw, int k0, int csrc0, bf16_t* WT, int ldt, int drow0, LAS float* scr, int lane) {
#pragma unroll 8
    for (int i = 0; i < 32; ++i) { const int kk = 2 * i + (lane >> 5); scr[kk * 33 + (lane & 31)] = W[(size_t)(k0 + kk) * ldw + csrc0 + (lane & 31)]; }
    LDS_WAIT(); asm volatile("" ::: "memory");
    const int c = lane & 7;
#pragma unroll
    for (int j = 0; j < 4; ++j) { const int n = (lane >> 3) + 8 * j; const LAS float* s = scr + (8 * c) * 33 + n;
        u32x4 o; o.x = pk2(s[0 * 33], s[1 * 33]); o.y = pk2(s[2 * 33], s[3 * 33]); o.z = pk2(s[4 * 33], s[5 * 33]); o.w = pk2(s[6 * 33], s[7 * 33]);
        *(u32x4*)(WT + (size_t)(drow0 + n) * ldt + k0 + 8 * c) = o; }
    LDS_WAIT(); asm volatile("" ::: "memory");
}
__device__ __forceinline__ void ph_weights(const Frame& F, const Ptrs& P, int l) {
    const int tid0 = fresh_tid(), lane0 = tid0 & 63;
    LAS float* scr = (LAS float*)(F.lds + F.wave * 16384);
    const int gw = F.vcu * NWAVES + F.wave, NGW = F.G * NWAVES;
    unsigned char* wb = P.ws + WS_WB;
    constexpr int I0 = 1024, I1 = I0 + 2048, I2 = I1 + 768, I3 = I2 + 512, I4 = I3 + 4096, I5 = I4 + 4096, I6 = I5 + 4096;
    for (int it = gw; it < I6; it += NGW) {
        if (it < I0) { const int kb = it >> 6, nb = it & 63; tr_item(P.w_in + (size_t)l * 1024 * 2560, 2560, kb * 64, 512 + nb * 32, (bf16_t*)(wb + WB_IN), 1024, 1024 + nb * 32, scr, lane0); }
        else if (it < I1) { const int r = it - I0, i = r >> 9, q = r & 511, kb = q >> 5, nb = q & 31; tr_item(P.w_gate + ((size_t)l * 4 + i) * 1024 * 1024, 1024, kb * 64, nb * 32, (bf16_t*)(wb + WB_GATE) + (size_t)i * 1024 * 1024, 1024, nb * 32, scr, lane0); }
        else if (it < I2) { const int r = it - I1, i = r >> 8, q = r & 255, kb = q >> 5, nb = q & 31; tr_item(P.w_branch + ((size_t)l * 4 + i) * 512 * 1024, 1024, kb * 64, nb * 32, (bf16_t*)(wb + WB_BR) + (size_t)i * 1024 * 512, 512, nb * 32, scr, lane0); }
        else if (it < I3) { const int q = it - I2, kb = q >> 5, nb = q & 31; tr_item(P.w_out + (size_t)l * 1024 * 1024, 1024, kb * 64, nb * 32, (bf16_t*)(wb + WB_OUT), 1024, nb * 32, scr, lane0); }
        else if (it < I5) { const int w3 = it >= I4; const int r = it - (w3 ? I4 : I3), e = r >> 8, q = r & 255, kb = q >> 4, nb = q & 15, c = nb * 32;
            tr_item((w3 ? P.w3 : P.w1) + ((size_t)l * 16 + e) * 1024 * 512, 512, kb * 64, c, (bf16_t*)(wb + WB_13) + (size_t)e * 1024 * 1024, 1024, 256 * (c >> 7) + (c & 127) + (w3 ? 128 : 0), scr, lane0); }
        else { const int r = it - I5, e = r >> 8, q = r & 255, kb = q >> 5, nb = q & 31; tr_item(P.w2 + ((size_t)l * 16 + e) * 512 * 1024, 1024, kb * 64, nb * 32, (bf16_t*)(wb + WB_2) + (size_t)e * 1024 * 512, 512, nb * 32, scr, lane0); }
    }
    __syncthreads();
    for (int u = F.vcu; u < 64; u += F.G) {
        LAS float* Wl = (LAS float*)F.lds; LAS float* ct = Wl + 64 * 128;
        const int kt = u >> 2, g = u & 3, k0 = kt * 64, tid = tid0; const float* w_in = P.w_in + (size_t)l * 1024 * 2560;
        if (tid < 128) ct[tid] = __builtin_amdgcn_cosf((float)tid * (1.0f / 128.0f));
        for (int i = tid; i < 64 * 128; i += 512) { const int k = i >> 7, c = i & 127; Wl[k * 128 + c] = w_in[(size_t)(k0 + k) * 2560 + g * 128 + c]; }
        __syncthreads();
        const int part = (tid >> 7) & 1, m = tid & 127, kh = tid >> 8; const float sc = 0.08838834764831845f;
        bf16_t* drow = (bf16_t*)(wb + WB_IN) + (size_t)(part * 512 + g * 128 + m) * 1024 + k0;
        for (int kb = kh * 32; kb < kh * 32 + 32; kb += 8) { float acc[8];
#pragma unroll
            for (int j = 0; j < 8; ++j) acc[j] = 0.f;
            for (int c = 0; c < 128; ++c) { const int idx = (c * m) & 127; const float tw = part ? -ct[(idx - 32) & 127] : ct[idx];
#pragma unroll
                for (int j = 0; j < 8; ++j) acc[j] += Wl[(kb + j) * 128 + c] * tw; }
            u32x4 o; o.x = pk2(acc[0] * sc, acc[1] * sc); o.y = pk2(acc[2] * sc, acc[3] * sc); o.z = pk2(acc[4] * sc, acc[5] * sc); o.w = pk2(acc[6] * sc, acc[7] * sc);
            *(u32x4*)(drow + kb) = o; }
        __syncthreads();
    }
    for (int u = F.G - 1 - F.vcu; u < 64; u += F.G) {
        LAS float* Wb = (LAS float*)F.lds;
        const int g = u >> 4, n0 = (u & 15) * 64, tid = tid0;
        const float* ps = P.pool_scale + (size_t)l * 512; const float* wb3 = P.w_branch + ((size_t)l * 4 + 3) * 512 * 1024; const float* pwl = P.pool_w + (size_t)l * 4 * 128 * 128;
        for (int i = tid; i < 128 * 64; i += 512) { const int e = i >> 6, n = i & 63; Wb[e * 64 + n] = ps[g * 128 + e] * wb3[(size_t)(g * 128 + e) * 1024 + n0 + n]; }
        __syncthreads();
        const int c = tid & 127, nh = tid >> 7; const float* pw = pwl + (size_t)(g * 128 + c) * 128;
        float acc[16];
#pragma unroll
        for (int j = 0; j < 16; ++j) acc[j] = 0.f;
        for (int e = 0; e < 128; ++e) { const float p = pw[e];
#pragma unroll
            for (int j = 0; j < 16; ++j) acc[j] += p * Wb[e * 64 + nh * 16 + j]; }
        bf16_t* Bt = (bf16_t*)(wb + WB_BR) + (size_t)3 * 1024 * 512;
#pragma unroll
        for (int j = 0; j < 16; ++j) Bt[(size_t)(n0 + nh * 16 + j) * 512 + g * 128 + c] = (bf16_t)f2bf(acc[j]);
        __syncthreads();
    }
}
__device__ __forceinline__ void ph_tables_mod(const Frame& F, const Ptrs& P) {
    const int tid0 = fresh_tid();
    { float* rc = (float*)(P.ws + WS_ROPE); float* rs = rc + 1024; float* ct = (float*)(P.ws + WS_COS);
      const int i = F.vcu * 512 + tid0;
      if (i < 1024) { const int pos = i >> 4, f = i & 15; const float inv = exp2f(-(float)f * (13.287712379549449f / 16.0f));
          float rev = (float)pos * inv * 0.15915494309189535f; rev = rev - floorf(rev);
          rc[i] = __builtin_amdgcn_cosf(rev); rs[i] = __builtin_amdgcn_sinf(rev); }
      if (i < 4096) ct[i] = __builtin_amdgcn_cosf((float)i * (1.0f / 4096.0f)); }
    for (int u = F.vcu; u < 192; u += F.G) {
        LAS float* s = (LAS float*)F.lds; LAS float* red = s + 9 * 1024;
        const int l = u / 96, j0 = (u % 96) * 64, tid = tid0;
        for (int i = tid; i < 9 * 1024; i += 512) { const int bb = i >> 10, k = i & 1023; const float v = bb < 8 ? P.c[bb * 1024 + k] : P.c_ctx[k]; s[i] = v / (1.f + expf(-v)); }
        __syncthreads();
        const int kc = tid >> 6, jj = tid & 63; float acc[9];
#pragma unroll
        for (int b = 0; b < 9; ++b) acc[b] = 0.f;
        const float* w = P.w_ada + (size_t)l * 1024 * 6144 + j0 + jj;
        for (int k = kc * 128; k < kc * 128 + 128; ++k) { const float wv = w[(size_t)k * 6144];
#pragma unroll
            for (int b = 0; b < 9; ++b) acc[b] += s[b * 1024 + k] * wv; }
#pragma unroll
        for (int b = 0; b < 9; ++b) red[(kc * 9 + b) * 64 + jj] = acc[b];
        __syncthreads();
        float* mod = (float*)(P.ws + WS_MOD);
        for (int i = tid; i < 9 * 64; i += 512) { const int b = i >> 6, j = i & 63; float v = P.b_ada[l * 6144 + j0 + j];
#pragma unroll
            for (int q = 0; q < 8; ++q) v += red[(q * 9 + b) * 64 + j];
            mod[(size_t)(l * 9 + b) * 6144 + j0 + j] = v; }
        __syncthreads();
    }
}
template <int MODE> __device__ __forceinline__ void ph_norm(const Frame& F, const Ptrs& P, int l, int nrows) {
    const int lane = fresh_tid() & 63;
    for (int r = F.vcu * NWAVES + F.wave; r < nrows; r += F.G * NWAVES) {
        const int bb = row_bb(r);
        f32x4 v[4];
        if (MODE == 0) { const f32x4* xr = (const f32x4*)xin_row(P, r) + lane;
#pragma unroll
            for (int j = 0; j < 4; ++j) v[j] = xr[64 * j]; }
        else { f32x4* xr = (f32x4*)x1_row(P, r) + lane;
#pragma unroll
            for (int j = 0; j < 4; ++j) v[j] = xr[64 * j];
            if (MODE == 1) { const f32x4* g2 = (const f32x4*)mod_vec(P, l - 1, bb, 5) + lane;
                const u32x2* m0 = (const u32x2*)((const bf16_t*)(P.ws + WS_MO) + (size_t)r * D) + lane; const u32x2* m1 = (const u32x2*)((const bf16_t*)(P.ws + WS_MO) + (size_t)(R + r) * D) + lane;
#pragma unroll
                for (int j = 0; j < 4; ++j) { const u32x2 a = m0[64 * j], b = m1[64 * j]; const f32x4 g = g2[64 * j];
                    v[j].x += g.x * (lo16(a.x) + lo16(b.x)); v[j].y += g.y * (hi16(a.x) + hi16(b.x)); v[j].z += g.z * (lo16(a.y) + lo16(b.y)); v[j].w += g.w * (hi16(a.y) + hi16(b.y));
                    xr[64 * j] = v[j]; } } }
        float ss = 0.f;
#pragma unroll
        for (int j = 0; j < 4; ++j) ss += (v[j].x * v[j].x + v[j].y * v[j].y) + (v[j].z * v[j].z + v[j].w * v[j].w);
        const float rstd = 1.0f / sqrtf(wave_sum_l(ss, lane) * (1.0f / D) + EPS);
        const f32x4* gn = (const f32x4*)((MODE == 2 ? P.norm2 : P.norm1) + (size_t)l * D) + lane;
        const f32x4* sh = (const f32x4*)mod_vec(P, l, bb, MODE == 2 ? 3 : 0) + lane;
        const f32x4* sc = (const f32x4*)mod_vec(P, l, bb, MODE == 2 ? 4 : 1) + lane;
        u32x2* o = (u32x2*)((bf16_t*)(P.ws + WS_H) + (size_t)r * D) + lane;
#pragma unroll
        for (int j = 0; j < 4; ++j) { const f32x4 g = gn[64 * j], a = sh[64 * j], b = sc[64 * j];
            v[j] = (v[j] * rstd * g) * (b + 1.0f) + a;
            u32x2 w; w.x = pk2(v[j].x, v[j].y); w.y = pk2(v[j].z, v[j].w); o[64 * j] = w; }
        if (MODE == 2) {
            float lg[16];
#pragma unroll
            for (int e = 0; e < 16; ++e) lg[e] = 0.f;
#pragma unroll
            for (int j = 0; j < 4; ++j) {
#pragma unroll
                for (int i = 0; i < 4; ++i) { const float hv = v[j][i]; const f32x4* rw = (const f32x4*)(P.router_w + (size_t)(4 * lane + 256 * j + i) * 16);
#pragma unroll
                    for (int q = 0; q < 4; ++q) { const f32x4 w = rw[q]; lg[4 * q] += hv * w.x; lg[4 * q + 1] += hv * w.y; lg[4 * q + 2] += hv * w.z; lg[4 * q + 3] += hv * w.w; } } }
#pragma unroll
            for (int e = 0; e < 16; ++e) lg[e] = wave_sum_l(lg[e], lane);
            float bestscore = -INFINITY; int be0 = 0, be1 = 1; float ba0 = 0.f, ba1 = 0.f;
#pragma unroll
            for (int g = 0; g < 4; ++g) {
                float aff[4], sel[4];
#pragma unroll
                for (int i = 0; i < 4; ++i) { aff[i] = 1.0f / (1.0f + expf(-lg[4 * g + i])); sel[i] = aff[i] + P.router_bias[4 * g + i]; }
                int i1 = 0; float m1 = sel[0], a1 = aff[0];
#pragma unroll
                for (int i = 1; i < 4; ++i) if (sel[i] > m1) { m1 = sel[i]; a1 = aff[i]; i1 = i; }
                int i2 = -1; float m2 = -INFINITY, a2 = 0.f;
#pragma unroll
                for (int i = 0; i < 4; ++i) if (i != i1 && sel[i] > m2) { m2 = sel[i]; a2 = aff[i]; i2 = i; }
                const float score = m1 + m2;
                if (score > bestscore) { bestscore = score; be0 = 4 * g + i1; be1 = 4 * g + i2; ba0 = a1; ba1 = a2; }
            }
            if (lane == 0) {
                unsigned* cnt = (unsigned*)(P.ws + WS_CTL) + CW_CNT + 64 * l;
                const int p0 = (int)atomicAdd(cnt + be0, 1u), p1 = (int)atomicAdd(cnt + be1, 1u);
                int* rt = (int*)(P.ws + WS_ROUTE) + (size_t)r * 6; const float inv = 1.0f / (ba0 + ba1);
                rt[0] = be0; rt[1] = p0; rt[2] = be1; rt[3] = p1; ((float*)rt)[4] = ba0 * inv; ((float*)rt)[5] = ba1 * inv;
            }
        }
    }
}
__device__ __forceinline__ void ph_qkprep(const Frame& F, const Ptrs& P, int l) {
    const int lane = fresh_tid() & 63;
    const float* rc = (const float*)(P.ws + WS_ROPE); const float* rs = rc + 1024;
    const float qg = P.q_gain[l * 64 + lane], kg = P.k_gain[l * 64 + lane];
    const int a = lane >> 5, fi = lane & 15; const bool second = (lane & 16) != 0;
    for (int r = F.vcu * NWAVES + F.wave; r < R; r += F.G * NWAVES) {
        bf16_t* u = (bf16_t*)(P.ws + WS_U) + (size_t)r * NIN;
        const bool lat = r < RL; const int t = r & (T - 1);
        const int pos = a ? (t & 63) : (t >> 6);
        const float cs = rc[pos * 16 + fi], sn = rs[pos * 16 + fi];
        for (int hh = 0; hh < 20; ++hh) {
            const int col = hh < 8 ? C_QB + hh * 64 : hh < 10 ? C_KB + (hh - 8) * 64 : hh < 18 ? C_QW + (hh - 10) * 64 : C_KW + (hh - 18) * 64;
            float x = bf2f(u[col + lane]);
            if (hh < 10) { const float ss = wave_sum_l(x * x, lane); x = x * (1.0f / sqrtf(ss * (1.0f / 64.0f) + EPS)) * (hh < 8 ? qg : kg); }
            if (lat) { const float y = shfl_xor_l(x, 16, lane); x = second ? x * cs + y * sn : x * cs - y * sn; }
            if (hh < 8 || (hh >= 10 && hh < 18)) x *= QSCALE;
            u[col + lane] = (bf16_t)f2bf(x);
        }
    }
}
__device__ __forceinline__ void ph_pool(const Frame& F, const Ptrs& P, int nrows) {
    const int tid0 = fresh_tid();
    for (int i = F.vcu * 512 + tid0; i < nrows * 64; i += F.G * 512) {
        const int r = i >> 6, c8 = (i & 63) * 8;
        const bool lat = r < RL; const int Ts = lat ? T : TC; const int t = lat ? (r & (T - 1)) : ((r - RL) & (TC - 1)); const int r0 = r - t;
        const int g = c8 >> 7, hw = 1 << g;
        const int lo = t - hw < 0 ? 0 : t - hw, hi = t + hw > Ts ? Ts : t + hw;
        const bf16_t* U = (const bf16_t*)(P.ws + WS_U) + C_P + c8;
        float s[8];
#pragma unroll
        for (int j = 0; j < 8; ++j) s[j] = 0.f;
        for (int tt = lo; tt < hi; ++tt) { const u32x4 w = *(const u32x4*)(U + (size_t)(r0 + tt) * NIN);
            s[0] += lo16(w.x); s[1] += hi16(w.x); s[2] += lo16(w.y); s[3] += hi16(w.y); s[4] += lo16(w.z); s[5] += hi16(w.z); s[6] += lo16(w.w); s[7] += hi16(w.w); }
        const u32x4 w = *(const u32x4*)(U + (size_t)r * NIN); const float inv = 1.0f / (float)(hi - lo);
        u32x4 o; o.x = pk2(s[0] * inv - lo16(w.x), s[1] * inv - hi16(w.x)); o.y = pk2(s[2] * inv - lo16(w.y), s[3] * inv - hi16(w.y));
        o.z = pk2(s[4] * inv - lo16(w.z), s[5] * inv - hi16(w.z)); o.w = pk2(s[6] * inv - lo16(w.w), s[7] * inv - hi16(w.w));
        *(u32x4*)((bf16_t*)(P.ws + WS_BR) + (size_t)r * NBR + 1536 + c8) = o;
    }
}
__device__ __forceinline__ void ph_gather(const Frame& F, const Ptrs& P, int l, int nrows) {
    const unsigned* cnt = (const unsigned*)(P.ws + WS_CTL) + CW_CNT + 64 * l;
    int* rowmap = (int*)(P.ws + WS_ROWMAP); float* roww = (float*)(P.ws + WS_ROWW);
    const int lane = fresh_tid() & 63;
    for (int wv = F.vcu * NWAVES + F.wave; wv < 2 * nrows + 64; wv += F.G * NWAVES) {
        if (wv < 2 * nrows) {
            const int r = wv >> 1, s = wv & 1; const int* rt = (const int*)(P.ws + WS_ROUTE) + (size_t)r * 6;
            const int e = rt[2 * s], pos = rt[2 * s + 1]; const float w = ((const float*)rt)[4 + s];
            int off = 0;
#pragma unroll
            for (int q = 0; q < 16; ++q) { const int n = ((int)cnt[q] + 255) & ~255; if (q < e) off += n; }
            const int dst = off + pos;
            const u32x4* src = (const u32x4*)((const bf16_t*)(P.ws + WS_H) + (size_t)r * D); u32x4* d = (u32x4*)((bf16_t*)(P.ws + WS_AS) + (size_t)dst * D);
            d[lane] = src[lane]; d[lane + 64] = src[lane + 64];
            if (lane == 0) { rowmap[dst] = wv; roww[dst] = w; }
        } else {
            const int i = (wv - 2 * nrows) * 64 + lane;
            const int e = i >> 8, p = i & 255; int off = 0;
#pragma unroll
            for (int q = 0; q < 16; ++q) { const int n = ((int)cnt[q] + 255) & ~255; if (q < e) off += n; }
            const int c = (int)cnt[e]; if (c + p < ((c + 255) & ~255)) rowmap[off + c + p] = -1;
        }
    }
}
__device__ __forceinline__ void ph_final(const Frame& F, const Ptrs& P) {
    const int lane = fresh_tid() & 63;
    for (int r = F.vcu * NWAVES + F.wave; r < RL; r += F.G * NWAVES) {
        const int bb = row_bb(r);
        f32x4* xr = (f32x4*)(P.out + (size_t)r * D) + lane; f32x4 v[4];
        const f32x4* g2 = (const f32x4*)mod_vec(P, 1, bb, 5) + lane;
        const u32x2* m0 = (const u32x2*)((const bf16_t*)(P.ws + WS_MO) + (size_t)r * D) + lane; const u32x2* m1 = (const u32x2*)((const bf16_t*)(P.ws + WS_MO) + (size_t)(R + r) * D) + lane;
        float ss = 0.f;
#pragma unroll
        for (int j = 0; j < 4; ++j) { v[j] = xr[64 * j]; const u32x2 a = m0[64 * j], b = m1[64 * j]; const f32x4 g = g2[64 * j];
            v[j].x += g.x * (lo16(a.x) + lo16(b.x)); v[j].y += g.y * (hi16(a.x) + hi16(b.x)); v[j].z += g.z * (lo16(a.y) + lo16(b.y)); v[j].w += g.w * (hi16(a.y) + hi16(b.y));
            ss += (v[j].x * v[j].x + v[j].y * v[j].y) + (v[j].z * v[j].z + v[j].w * v[j].w); }
        const float rstd = 1.0f / sqrtf(wave_sum_l(ss, lane) * (1.0f / D) + EPS);
        const f32x4* gn = (const f32x4*)P.norm_f + lane;
#pragma unroll
        for (int j = 0; j < 4; ++j) xr[64 * j] = v[j] * rstd * gn[64 * j];
    }
}

template <int MODE> __device__ __forceinline__ void ph_attn_ref(const Frame& F, const Ptrs& P, int l) {
    const int tid = fresh_tid();
    LAS float* Ks = (LAS float*)F.lds; LAS float* Vs = Ks + 64 * 64;
    const bf16_t* U = (const bf16_t*)(P.ws + WS_U);
    const bool latq = MODE < 2; const bool winm = (MODE == 1 || MODE == 3);
    const int NU = latq ? 1024 : 64; const int half = tid & 1;
    for (int u = F.vcu; u < NU; u += F.G) {
        const int qb = latq ? (u & 15) : 0, h = latq ? ((u >> 4) & 7) : (u & 7), b = latq ? (u >> 7) : (u >> 3), g = h >> 2;
        const int tq = qb * 256 + (tid >> 1);
        const int qrow = latq ? b * T + tq : RL + b * TC + tq;
        const int qcol = (winm ? C_QW : C_QB) + h * 64 + half * 32, kcol = (winm ? C_KW : C_KB) + g * 64, vcol = (winm ? C_VW : C_VB) + g * 64;
        unsigned q[16]; float o[32];
        { const u32x4* qp = (const u32x4*)(U + (size_t)qrow * NIN + qcol);
#pragma unroll
          for (int i = 0; i < 4; ++i) { const u32x4 w = qp[i]; q[4 * i] = w.x; q[4 * i + 1] = w.y; q[4 * i + 2] = w.z; q[4 * i + 3] = w.w; } }
#pragma unroll
        for (int d = 0; d < 32; ++d) o[d] = 0.f;
        float m = -INFINITY, lsum = 0.f;
        int lt_lo = 0, lt_hi = 0;
        if (MODE == 0) { lt_lo = 0; lt_hi = T / 64; }
        if (MODE == 1) { const int q0 = qb * 256; lt_lo = (q0 - 128 < 0 ? 0 : q0 - 128) / 64; lt_hi = (q0 + 384 > T ? T : q0 + 384) / 64; }
        const int ntiles = 4 + (lt_hi - lt_lo);
        for (int ti = 0; ti < ntiles; ++ti) {
            const bool isctx = ti < 4; const int kpos0 = isctx ? ti * 64 : (lt_lo + ti - 4) * 64;
            const int krow0 = isctx ? RL + b * TC + kpos0 : b * T + kpos0;
            __syncthreads();
            { const int j = tid >> 3, part = tid & 7; const u32x4 kw = *(const u32x4*)(U + (size_t)(krow0 + j) * NIN + kcol + part * 8), vw = *(const u32x4*)(U + (size_t)(krow0 + j) * NIN + vcol + part * 8);
              LAS float* kd = Ks + j * 64 + part * 8; LAS float* vd = Vs + j * 64 + part * 8;
              kd[0] = lo16(kw.x); kd[1] = hi16(kw.x); kd[2] = lo16(kw.y); kd[3] = hi16(kw.y); kd[4] = lo16(kw.z); kd[5] = hi16(kw.z); kd[6] = lo16(kw.w); kd[7] = hi16(kw.w);
              vd[0] = lo16(vw.x); vd[1] = hi16(vw.x); vd[2] = lo16(vw.y); vd[3] = hi16(vw.y); vd[4] = lo16(vw.z); vd[5] = hi16(vw.z); vd[6] = lo16(vw.w); vd[7] = hi16(vw.w); }
            __syncthreads();
#pragma unroll 1
            for (int jk = 0; jk < 64; ++jk) {
                float a = 0.f; const LAS f32x4* kr = (const LAS f32x4*)(Ks + jk * 64 + half * 32);
#pragma unroll
                for (int d4 = 0; d4 < 8; ++d4) { const f32x4 kv = kr[d4]; a += lo16(q[2 * d4]) * kv.x + hi16(q[2 * d4]) * kv.y + lo16(q[2 * d4 + 1]) * kv.z + hi16(q[2 * d4 + 1]) * kv.w; }
                a += shfl_xor_l(a, 1, tid & 63);
                if (MODE == 1 && !isctx) { const int dlt = kpos0 + jk - tq; if (dlt > 128 || dlt < -128) a = -INFINITY; }
                if (a != -INFINITY) {
                    if (a > m) { const float scl = exp2f(m - a); m = a; lsum *= scl;
#pragma unroll
                        for (int d = 0; d < 32; ++d) o[d] *= scl; }
                    const float p = exp2f(a - m); lsum += p; const LAS f32x4* vr = (const LAS f32x4*)(Vs + jk * 64 + half * 32);
#pragma unroll
                    for (int d4 = 0; d4 < 8; ++d4) { const f32x4 vv = vr[d4]; o[4 * d4] += p * vv.x; o[4 * d4 + 1] += p * vv.y; o[4 * d4 + 2] += p * vv.z; o[4 * d4 + 3] += p * vv.w; }
                }
            }
        }
        if (winm) lsum += exp2f(P.sink[l * 8 + h] * LOG2E - m);
        const float inv = 1.0f / lsum;
        { u32x4* op = (u32x4*)((bf16_t*)(P.ws + WS_BR) + (size_t)qrow * NBR + (winm ? 1024 : 512) + h * 64 + half * 32);
#pragma unroll
          for (int i = 0; i < 4; ++i) { u32x4 w; w.x = pk2(o[8 * i] * inv, o[8 * i + 1] * inv); w.y = pk2(o[8 * i + 2] * inv, o[8 * i + 3] * inv); w.z = pk2(o[8 * i + 4] * inv, o[8 * i + 5] * inv); w.w = pk2(o[8 * i + 6] * inv, o[8 * i + 7] * inv); op[i] = w; } }
        __syncthreads();
    }
}
__device__ __forceinline__ void ph_fourier_ref(const Frame& F, const Ptrs& P, int Ts, int latent) {
    const int tid = fresh_tid();
    LAS float* Zr = (LAS float*)F.lds; LAS float* Zi = Zr + 16 * 64; LAS float* Ct = Zi + 16 * 64; LAS float* St = Ct + 128 * 17;
    const bf16_t* U = (const bf16_t*)(P.ws + WS_U); const float* ct = (const float*)(P.ws + WS_COS);
    const int nkt = Ts / 128, NU = 8 * nkt * 8, step = 4096 / Ts;
    const int tk = tid >> 4, tc = tid & 15;
    for (int u = F.vcu; u < NU; u += F.G) {
        const int cht = u & 7, kt = (u >> 3) % nkt, b = (u >> 3) / nkt, k0 = kt * 128, ch0 = cht * 64;
        const int rbase = latent ? b * T : RL + b * TC;
        float acc[4][4];
#pragma unroll
        for (int i = 0; i < 4; ++i)
#pragma unroll
            for (int j = 0; j < 4; ++j) acc[i][j] = 0.f;
        for (int t0 = 0; t0 < Ts; t0 += 16) {
            __syncthreads();
            if (tid < 256) { const int tt = tid >> 4, c4 = (tid & 15) * 4; const bf16_t* zp = U + (size_t)(rbase + t0 + tt) * NIN + ch0 + c4;
              const u32x2 a = *(const u32x2*)(zp + C_ZR), bq = *(const u32x2*)(zp + C_ZI);
              Zr[tt * 64 + c4] = lo16(a.x); Zr[tt * 64 + c4 + 1] = hi16(a.x); Zr[tt * 64 + c4 + 2] = lo16(a.y); Zr[tt * 64 + c4 + 3] = hi16(a.y);
              Zi[tt * 64 + c4] = lo16(bq.x); Zi[tt * 64 + c4 + 1] = hi16(bq.x); Zi[tt * 64 + c4 + 2] = lo16(bq.y); Zi[tt * 64 + c4 + 3] = hi16(bq.y); }
#pragma unroll
            for (int i = 0; i < 4; ++i) { const int e = tid * 4 + i, k = e >> 4, tt = e & 15; const int ang = (((k0 + k) * (t0 + tt)) & (Ts - 1)) * step;
                Ct[k * 17 + tt] = ct[ang]; St[k * 17 + tt] = ct[(ang - 1024) & 4095]; }
            __syncthreads();
#pragma unroll 2
            for (int tt = 0; tt < 16; ++tt) { float zr[4], zi[4];
#pragma unroll
                for (int j = 0; j < 4; ++j) { zr[j] = Zr[tt * 64 + tc * 4 + j]; zi[j] = Zi[tt * 64 + tc * 4 + j]; }
#pragma unroll
                for (int i = 0; i < 4; ++i) { const float c = Ct[(tk * 4 + i) * 17 + tt], sn = St[(tk * 4 + i) * 17 + tt];
#pragma unroll
                    for (int j = 0; j < 4; ++j) acc[i][j] += c * zr[j] + sn * zi[j]; } }
        }
        const float sc = 1.0f / sqrtf((float)Ts);
        bf16_t* BR = (bf16_t*)(P.ws + WS_BR);
#pragma unroll
        for (int i = 0; i < 4; ++i) { u32x2 w; w.x = pk2(acc[i][0] * sc, acc[i][1] * sc); w.y = pk2(acc[i][2] * sc, acc[i][3] * sc);
            *(u32x2*)(BR + (size_t)(rbase + k0 + tk * 4 + i) * NBR + ch0 + tc * 4) = w; }
        __syncthreads();
    }
}

struct MegaArgs { Ptrs P; int ph_lo, ph_hi, li, pad; };
__global__ void __launch_bounds__(NWAVES * 64, 2) mega(MegaArgs args) {
    extern __shared__ __attribute__((aligned(16))) unsigned char lds_raw[];
    Frame F; F.lds = (LAS unsigned char*)lds_raw;
    F.wave = __builtin_amdgcn_readfirstlane(threadIdx.x >> 6);
    F.G = gridDim.x; { const int bx = blockIdx.x; F.vcu = (F.G % 8 == 0) ? (bx % 8) * (F.G / 8) + bx / 8 : bx; }
    const Ptrs& P = args.P;
    for (int u = fresh_tid(); u < (LDS_BYTES - LDSCTL_OFF) / 4; u += NWAVES * 64) ((LAS unsigned*)(F.lds + LDSCTL_OFF))[u] = 0u;
    __syncthreads();
    volatile LAS unsigned* MISC = (volatile LAS unsigned*)(F.lds + MISC_OFF);
    XcdBarrier bar = xcd_barrier_post((unsigned*)(P.ws + WS_CTL) + CW_BAR + args.li * XCD_BAR_WORDS, MISC + 8, F.wave);
    const int lo = args.ph_lo, hi = args.ph_hi;
    unsigned char* ws = P.ws;
    bf16_t* H = (bf16_t*)(ws + WS_H); bf16_t* U = (bf16_t*)(ws + WS_U); bf16_t* BR = (bf16_t*)(ws + WS_BR);
    bf16_t* GT = (bf16_t*)(ws + WS_GT); bf16_t* MG = (bf16_t*)(ws + WS_MG); bf16_t* AS = (bf16_t*)(ws + WS_AS); bf16_t* HID = (bf16_t*)(ws + WS_HID); bf16_t* MO = (bf16_t*)(ws + WS_MO);
    const bf16_t* Bt_in = (const bf16_t*)(ws + WS_WB + WB_IN); const bf16_t* Bt_gate = (const bf16_t*)(ws + WS_WB + WB_GATE); const bf16_t* Bt_br = (const bf16_t*)(ws + WS_WB + WB_BR);
    const bf16_t* Bt_out = (const bf16_t*)(ws + WS_WB + WB_OUT); const bf16_t* Bt_13 = (const bf16_t*)(ws + WS_WB + WB_13); const bf16_t* Bt_2 = (const bf16_t*)(ws + WS_WB + WB_2);
#define IN(g) (lo <= (g) && (g) < hi)
#define SEAM(g) do { if ((g) + 1 < hi) xcd_barrier(bar); } while (0)
    for (int l = 0; l < 2; ++l) {
        const int pb = l * NPH; const int M = l == 0 ? R : RL;
        if (IN(pb + 0)) { if (l == 0) ph_tables_mod(F, P); ph_weights(F, P, l); SEAM(pb + 0); }
        if (IN(pb + 1)) { if (l == 0) ph_norm<0>(F, P, l, R); else ph_norm<1>(F, P, l, R); SEAM(pb + 1); }
        if (IN(pb + 2)) {
            pg8::StaticOrder S; S.init(R, NIN, F.G, (int)blockIdx.x, H, D, Bt_in, D);
            pg8::EpiV8<FStore8> E{FStore8{U, NIN}};
            pg8::gemm_phase(F.lds, F.wave, D, D, D, S, E);
            SEAM(pb + 2);
        }
        if (IN(pb + 3)) { ph_qkprep(F, P, l); ph_pool(F, P, M); SEAM(pb + 3); }
        if (IN(pb + 4)) {
            ph_attn_ref<0>(F, P, l); ph_attn_ref<1>(F, P, l); ph_fourier_ref(F, P, T, 1);
            if (l == 0) { ph_attn_ref<2>(F, P, l); ph_attn_ref<3>(F, P, l); ph_fourier_ref(F, P, TC, 0); }
            SEAM(pb + 4);
        }
        for (int i = 0; i <= 4; ++i) {
            if (IN(pb + 5 + i)) {
                if (i >= 1) { const int j = i - 1;
                    pg8::StaticOrder S; S.init(M, D, F.G, (int)blockIdx.x, BR + j * 512, NBR, Bt_br + (size_t)j * 1024 * 512, 512);
                    pg8::EpiV8<FMerge8> E{FMerge8{MG, GT + (size_t)(j & 1) * R * D, j == 0}};
                    pg8::gemm_phase(F.lds, F.wave, NBR, 512, 512, S, E); }
                if (i <= 3) {
                    pg8::StaticOrder S; S.init(M, D, F.G, (int)blockIdx.x, H, D, Bt_gate + (size_t)i * 1024 * 1024, D);
                    pg8::EpiV8<FGate8> E{FGate8{GT + (size_t)(i & 1) * R * D, P.b_gate + ((size_t)l * 4 + i) * D}};
                    pg8::gemm_phase(F.lds, F.wave, D, D, D, S, E); }
                SEAM(pb + 5 + i);
            }
        }
        if (IN(pb + 10)) {
            pg8::StaticOrder S; S.init(M, D, F.G, (int)blockIdx.x, MG, D, Bt_out, D);
            pg8::EpiV4<EpiOut> E{EpiOut{P, l}};
            pg8::gemm_phase(F.lds, F.wave, D, D, D, S, E);
            SEAM(pb + 10);
        }
        if (IN(pb + 11)) { ph_norm<2>(F, P, l, M); SEAM(pb + 11); }
        if (IN(pb + 12)) { ph_gather(F, P, l, M); SEAM(pb + 12); }
        if (IN(pb + 13) || IN(pb + 14)) {
            LAS int* ptab = (LAS int*)(F.lds + LDSCTL_OFF);
            if (fresh_tid() == 0) { const unsigned* cnt = (const unsigned*)(ws + WS_CTL) + CW_CNT + 64 * l; int off = 0;
                for (int e = 0; e < 16; ++e) { ptab[e] = off; off += ((int)cnt[e] + 255) >> 8; } ptab[16] = off; }
            __syncthreads();
            if (IN(pb + 13)) {
                pg8::MoeOrder S; S.nN = 4; S.G = F.G; S.c = (int)blockIdx.x; S.A = (const char*)AS; S.Bt = (const char*)Bt_13; S.astep = (size_t)256 * D * 2; S.bstep = (size_t)256 * D * 2; S.bexp = (size_t)1024 * 1024 * 2; S.ptab = (const int*)ptab;
                pg8::EpiDual<FMoe1> E{FMoe1{HID}};
                pg8::gemm_phase(F.lds, F.wave, D, D, D, S, E);
                SEAM(pb + 13);
            }
            if (IN(pb + 14)) {
                pg8::MoeOrder S; S.nN = 4; S.G = F.G; S.c = (int)blockIdx.x; S.A = (const char*)HID; S.Bt = (const char*)Bt_2; S.astep = (size_t)256 * FF * 2; S.bstep = (size_t)256 * FF * 2; S.bexp = (size_t)1024 * 512 * 2; S.ptab = (const int*)ptab;
                pg8::EpiV8<FMoe2> E{FMoe2{MO, (const int*)(ws + WS_ROWMAP), (const float*)(ws + WS_ROWW)}};
                pg8::gemm_phase(F.lds, F.wave, FF, FF, FF, S, E);
                SEAM(pb + 14);
            }
        }
    }
    if (IN(PH_FINAL)) ph_final(F, P);
#undef IN
#undef SEAM
}

extern "C" void kernel_launch(void* const* d_in, const int* in_sizes, int n_in, void* d_out, int out_size, void* d_ws, size_t ws_size, hipStream_t stream) {
    if (n_in != 24 || ws_size < WS_END || out_size != RL * D) { fprintf(stderr, "kernel_launch: unexpected sizes n_in %d ws %zu out %d\n", n_in, ws_size, out_size); return; }
    static int grid = 0;
    if (grid == 0) {
        int dev = 0, cus = 0;
        if (hipGetDevice(&dev) != hipSuccess || hipDeviceGetAttribute(&cus, hipDeviceAttributeMultiprocessorCount, dev) != hipSuccess) { grid = -1; return; }
        if (hipFuncSetAttribute((const void*)mega, hipFuncAttributeMaxDynamicSharedMemorySize, LDS_BYTES) != hipSuccess) { fprintf(stderr, "kernel_launch: hipFuncSetAttribute failed\n"); grid = -1; return; }
        int per_cu = 0;
        if (hipOccupancyMaxActiveBlocksPerMultiprocessor(&per_cu, (const void*)mega, NWAVES * 64, LDS_BYTES) != hipSuccess || per_cu < 1) fprintf(stderr, "kernel_launch: occupancy query says %d\n", per_cu);
        (void)hipGetLastError();
        grid = cus;
    }
    if (grid < 0) return;
    MegaArgs a{};
    const float** pp = (const float**)&a.P;
    for (int i = 0; i < 24; ++i) pp[i] = (const float*)d_in[i];
    a.P.out = (float*)d_out; a.P.ws = (unsigned char*)d_ws;
    (void)hipMemsetAsync((unsigned char*)d_ws + WS_CTL, 0, 1 * MiB, stream);
    a.ph_lo = 0; a.ph_hi = PH_FINAL + 1; a.li = 0;
    hipLaunchKernelGGL(mega, dim3(grid), dim3(NWAVES * 64), LDS_BYTES, stream, a);
}
```

```cpp
#include <hip/hip_runtime.h>
#include <cstdio>
#include <cstdint>

typedef unsigned short bf16_t;
typedef short bf16x8 __attribute__((ext_vector_type(8)));
typedef float f32x4 __attribute__((ext_vector_type(4)));
typedef unsigned u32x4 __attribute__((ext_vector_type(4)));
typedef unsigned u32x2 __attribute__((ext_vector_type(2)));

constexpr int D = 1024, NB = 8, T = 4096, TC = 256;
constexpr int RL = NB * T, RC = NB * TC, R = RL + RC;
constexpr int NIN = 3072;
constexpr int C_ZR = 0, C_ZI = 512, C_P = 1024, C_QB = 1536, C_KB = 2048, C_VB = 2176, C_QW = 2304, C_KW = 2816, C_VW = 2944;
constexpr int NBR = 2048;
constexpr int NE = 16, FF = 512;
constexpr int MAXROWS = 73728;
constexpr float EPS = 1e-6f;
constexpr float QSCALE = 0.125f * 1.4426950408889634f;
constexpr float LOG2E = 1.4426950408889634f;

constexpr size_t MiB = 1u << 20;
constexpr size_t WS_CTL = 0;
constexpr size_t WS_MOD = 1 * MiB;
constexpr size_t WS_ROPE = 1 * MiB + 512 * 1024;
constexpr size_t WS_COS = WS_ROPE + 16 * 1024;
constexpr size_t WS_DFTM = WS_ROPE + 64 * 1024;
constexpr size_t WS_ROUTE = 2 * MiB;
constexpr size_t WS_ROWMAP = 3 * MiB;
constexpr size_t WS_ROWW = 3 * MiB + 512 * 1024;
constexpr size_t WS_XC = 9 * MiB;
constexpr size_t WS_WB = 17 * MiB;
constexpr size_t WB_IN = 0, WB_GATE = 6 * MiB, WB_BR = 14 * MiB, WB_OUT = 18 * MiB, WB_13 = 20 * MiB, WB_2 = 52 * MiB;
constexpr size_t WS_H = 85 * MiB;
constexpr size_t WS_ARENA = 153 * MiB;
constexpr size_t WS_U = WS_ARENA;
constexpr size_t WS_BR = WS_ARENA + 204 * MiB;
constexpr size_t WS_GT = WS_ARENA;
constexpr size_t WS_MG = WS_ARENA + 136 * MiB;
constexpr size_t WS_AS = WS_ARENA;
constexpr size_t WS_HID = WS_ARENA + 144 * MiB;
constexpr size_t WS_MO = WS_ARENA + 216 * MiB;
constexpr size_t WS_END = 512 * MiB;
static_assert(WS_BR + (size_t)R * NBR * 2 <= WS_END && WS_MO + (size_t)2 * R * D * 2 <= WS_END && WS_MG + (size_t)R * D * 2 <= WS_BR, "ws map");
constexpr int CW_CNT = 1024;

__device__ __forceinline__ float bf2f(bf16_t b) { return __uint_as_float(((unsigned)b) << 16); }
__device__ __forceinline__ unsigned f2bf(float f) { unsigned u = __float_as_uint(f); return (u + 0x7fffu + ((u >> 16) & 1u)) >> 16; }
__device__ __forceinline__ unsigned pk2(float lo, float hi) { return f2bf(lo) | (f2bf(hi) << 16); }
__device__ __forceinline__ float lo16(unsigned w) { return __uint_as_float(w << 16); }
__device__ __forceinline__ float hi16(unsigned w) { return __uint_as_float(w & 0xffff0000u); }
__device__ __forceinline__ float shfl_xor_l(float v, int o, int lane) { return __int_as_float(__builtin_amdgcn_ds_bpermute((lane ^ o) << 2, __float_as_int(v))); }
__device__ __forceinline__ float wave_sum_l(float v, int lane) {
#pragma unroll
    for (int o = 1; o < 64; o <<= 1) v += shfl_xor_l(v, o, lane);
    return v;
}
__device__ __forceinline__ int row_bb(int r) { return r < RL ? (r >> 12) : 8; }

struct Ptrs {
    const float *x, *c, *ctx, *c_ctx, *w_ada, *b_ada, *norm1, *norm2, *w_in, *q_gain, *k_gain, *sink, *pool_w, *pool_scale,
        *w_branch, *w_gate, *b_gate, *w_out, *router_w, *router_bias, *w1, *w3, *w2, *norm_f;
    float* out; unsigned char* ws;
};
__device__ __forceinline__ const float* xin_row(const Ptrs& P, int r) { return r < RL ? P.x + (size_t)r * D : P.ctx + (size_t)(r - RL) * D; }
__device__ __forceinline__ float* x1_row(const Ptrs& P, int r) { return r < RL ? P.out + (size_t)r * D : (float*)(P.ws + WS_XC) + (size_t)(r - RL) * D; }
__device__ __forceinline__ const float* mod_vec(const Ptrs& P, int l, int bb, int which) { return (const float*)(P.ws + WS_MOD) + ((size_t)(l * 9 + bb) * 6 + which) * D; }

struct EpiOut { Ptrs P; int l;
    __device__ __forceinline__ void operator()(int row, int col, f32x4 v) const { const int bb = row_bb(row);
        const f32x4 g = *(const f32x4*)(mod_vec(P, l, bb, 2) + col); float* xo = x1_row(P, row) + col;
        const f32x4 xp = l == 0 ? *(const f32x4*)(xin_row(P, row) + col) : *(const f32x4*)xo;
        *(f32x4*)xo = xp + g * v; } };

#define LAS __attribute__((address_space(3)))
#define GAS __attribute__((address_space(1)))
#define LDS_WAIT() asm volatile("s_waitcnt lgkmcnt(0)" ::: "memory")
__device__ __forceinline__ int fresh_lane() { int l; asm volatile("v_mbcnt_lo_u32_b32 %0, -1, 0\n\tv_mbcnt_hi_u32_b32 %0, -1, %0" : "=v"(l)); return l; }
constexpr int NWAVES = 8;
constexpr int RING_BYTES = 131072, LDSCTL_OFF = RING_BYTES, MISC_OFF = LDSCTL_OFF + 320, LDS_BYTES = 147456;
constexpr int CW_BAR = 4096;
constexpr int NPH = 15, PH_FINAL = 2 * NPH;

#define XB_TMO      128
#define XB_XCNT(j)  (256  + 64 * (j))
#define XB_XSUB(j)  (1280 + 64 * (j))
#define XB_XGEN(j)  (2304 + 64 * (j))
#define XB_TOP      3328
#define XB_TOPGEN   3392
#define XCD_BAR_WORDS 3456
#define XB_SPIN_CAP (1u << 21)
__device__ __forceinline__ unsigned xb_ld(unsigned* p)              { return __hip_atomic_load(p, __ATOMIC_RELAXED, __HIP_MEMORY_SCOPE_AGENT); }
__device__ __forceinline__ unsigned xb_add(unsigned* p, unsigned v) { return __hip_atomic_fetch_add(p, v, __ATOMIC_RELAXED, __HIP_MEMORY_SCOPE_AGENT); }
__device__ __forceinline__ unsigned xb_xcc_id() { return (unsigned)__builtin_amdgcn_s_getreg((3 << 11) | 20) & 0xFu; }
#define XB_SPIN(cond, bar) do { unsigned _sp = 0; while (cond) { __builtin_amdgcn_s_sleep(1); \
    if ((++_sp & 255u) == 0u) { if (xb_ld(&(bar)[XB_TMO])) break; if (_sp > XB_SPIN_CAP) { atomicAdd(&(bar)[XB_TMO], 1u); break; } } } } while (0)
struct XcdBarrier { unsigned* bar; unsigned x; volatile LAS unsigned* st; int wave; };
__device__ __forceinline__ XcdBarrier xcd_barrier_post(unsigned* bar, volatile LAS unsigned* st, int wave) {
    XcdBarrier b; b.bar = bar; b.x = xb_xcc_id(); b.st = st; b.wave = wave;
    if (wave == 0 && fresh_lane() == 0) (void)xb_add(&bar[XB_XCNT(b.x)], 1u);
    return b;
}
__device__ __forceinline__ void xcd_barrier_complete(unsigned* bar, unsigned x, unsigned& nloc, unsigned& nx) {
    const unsigned G = gridDim.x * gridDim.y * gridDim.z;
    unsigned sum, cnt, mine, sp = 0u;
    for (;;) {
        sum = 0u; cnt = 0u; mine = 0u;
#pragma unroll
        for (unsigned j = 0; j < 16; ++j) { const unsigned c = xb_ld(&bar[XB_XCNT(j)]); sum += c; cnt += (c > 0u) ? 1u : 0u; mine = (j == x) ? c : mine; }
        if (sum == G) break;
        __builtin_amdgcn_s_sleep(1);
        if ((++sp & 255u) == 0u) { if (xb_ld(&bar[XB_TMO])) break; if (sp > XB_SPIN_CAP) { atomicAdd(&bar[XB_TMO], 1u); break; } }
    }
    nloc = mine > 0u ? mine : 1u; nx = cnt > 0u ? cnt : 1u;
}
__device__ __forceinline__ void xcd_barrier(const XcdBarrier& b) {
    asm volatile("s_waitcnt vmcnt(0)" ::: "memory");
    __syncthreads();
    if (b.wave == 0 && fresh_lane() == 0) {
        unsigned* bar = b.bar;
        __builtin_amdgcn_s_waitcnt(0);
        unsigned nloc = b.st[0], nx = b.st[1];
        if (nloc == 0u) { xcd_barrier_complete(bar, b.x, nloc, nx); b.st[0] = nloc; b.st[1] = nx; }
        const unsigned old = xb_add(&bar[XB_XSUB(b.x)], 1u);
        const unsigned gen = old / nloc;
        if (old + 1u == (gen + 1u) * nloc) {
            __builtin_amdgcn_fence(__ATOMIC_RELEASE, "agent");
            asm volatile("s_waitcnt vmcnt(0)" ::: "memory");
            const unsigned og = xb_add(&bar[XB_TOP], 1u);
            const unsigned tg = og / nx;
            if (og + 1u == (tg + 1u) * nx) xb_add(&bar[XB_TOPGEN], 1u);
            else XB_SPIN(xb_ld(&bar[XB_TOPGEN]) == tg, bar);
            __builtin_amdgcn_fence(__ATOMIC_ACQUIRE, "agent");
            xb_add(&bar[XB_XGEN(b.x)], 1u);
            asm volatile("s_waitcnt vmcnt(0)" ::: "memory");
        } else {
            XB_SPIN(xb_ld(&bar[XB_XGEN(b.x)]) == gen, bar);
            __builtin_amdgcn_fence(__ATOMIC_ACQUIRE, "agent");
            asm volatile("s_waitcnt vmcnt(0)" ::: "memory");
        }
    }
    __syncthreads();
}

namespace pg8 {
constexpr int BM = 256, BK = 64, HALF = 128, HTB = HALF * BK * 2, STAGE_BYTES = 8 * HTB, NXCD = 8, WGM = 8;
__host__ __device__ __forceinline__ int lds_byte(int r, int c) { const int st = (r >> 4) * 2 + (c >> 5), rr = r & 15, cc = c & 31, ob = rr * 64 + cc * 2; return st * 1024 + (ob ^ (((ob >> 9) & 1) << 5)); }
__host__ __device__ __forceinline__ void stage_rc(int b, int& Rr, int& C) { const int st = b / 1024, sb = b % 1024, swz = sb ^ (((sb >> 9) & 1) << 5); Rr = (st >> 1) * 16 + swz / 64; C = (st & 1) * 32 + (swz % 64) / 2; }
__host__ __device__ __forceinline__ int perm32(int rho) { const int n = rho >> 4, i = rho & 15; return 8 * (i >> 2) + 4 * n + (i & 3); }
struct Unit { int pm, pn; const char* a; const char* b; };

struct StaticOrder {
    int nM, nN, nwg, G, c; const char* A; const char* Bt; size_t astep, bstep;
    __device__ void init(int M, int N, int G_, int c_, const bf16_t* A_, int lda, const bf16_t* Bt_, int ldb) { nM = M / BM; nN = N / BM; nwg = nM * nN; G = G_; c = c_; A = (const char*)A_; Bt = (const char*)Bt_; astep = (size_t)BM * lda * 2; bstep = (size_t)BM * ldb * 2; }
    __device__ bool next(int i, Unit& u) const {
        const long L = (long)i * G + c; if (L >= nwg) return false;
        int wgid = (int)L; { const int q = nwg / NXCD, r = nwg % NXCD, xcd = wgid % NXCD, off = wgid / NXCD; wgid = (xcd < r ? xcd * (q + 1) : r * (q + 1) + (xcd - r) * q) + off; }
        const int nig = WGM * nN, gid = wgid / nig, fm = gid * WGM, gsz = (nM - fm) < WGM ? (nM - fm) : WGM;
        u.pm = fm + ((wgid % nig) % gsz); u.pn = (wgid % nig) / gsz; u.a = A + (size_t)u.pm * astep; u.b = Bt + (size_t)u.pn * bstep; return true;
    }
};
struct MoeOrder {
    int nN, G, c; const char* A; const char* Bt; size_t astep, bstep, bexp; const int* ptab;
    __device__ bool next(int i, Unit& u) const {
        const int L = i * G + c; const int total = ptab[16] * nN; if (L >= total) return false;
        u.pm = L / nN; u.pn = L % nN; int e = 0;
#pragma unroll
        for (int q = 1; q < 16; ++q) e += (u.pm >= ptab[q]) ? 1 : 0;
        u.a = A + (size_t)u.pm * astep; u.b = Bt + (size_t)e * bexp + (size_t)u.pn * bstep; return true;
    }
};

template <class Epi, class Sched, bool ALIGN_EPI = true, bool SP2 = true>
__device__ __forceinline__ void gemm_phase(LAS unsigned char* lds, const int wid, const int lda, const int ldb, const int K, const Sched& S, const Epi& E) {
    const int lane = fresh_lane(), tid = wid * 64 + lane, wr = wid >> 2, wc = wid & 3, fr = lane & 15, fq = lane >> 4;
    const int nt = K / BK;
    unsigned voffA[2], voffB[2];
#pragma unroll
    for (int i = 0; i < 2; ++i) { int Rr, C; stage_rc(tid * 16 + i * 8192, Rr, C); const int Rb = Epi::PERM ? ((Rr & ~31) + perm32(Rr & 31)) : Rr;
        voffA[i] = (unsigned)(Rr * lda + C) * 2u; voffB[i] = (unsigned)(Rb * ldb + C) * 2u; }
    const size_t kstep = (size_t)(BK * 2);
    const size_t hstepA = (size_t)HALF * lda * 2, hstepB = (size_t)HALF * ldb * 2;
    const unsigned ldsw = (unsigned)wid * 1024u;
    const int aoff = lds_byte(wr * 64 + fr, fq * 8), boff = lds_byte(wc * 32 + fr, fq * 8);
#define PG8_SA(b, h) (((b) * 2 + (h)) * HTB)
#define PG8_SB(b, h) ((4 + (b) * 2 + (h)) * HTB)
#define PG8_STAGE(bufoff, gbase, voff) do { _Pragma("unroll") for (int _i = 0; _i < 2; ++_i) \
        __builtin_amdgcn_global_load_lds((const unsigned*)((const char*)(gbase) + (voff)[_i]), (LAS unsigned*)(lds + (bufoff) + ldsw + _i * 8192), 16, 0, 0); } while (0)
#define PG8_LDA(dst, b, h) do { _Pragma("unroll") for (int m = 0; m < 4; ++m) _Pragma("unroll") for (int k = 0; k < 2; ++k) dst[m][k] = *(const LAS bf16x8*)(lds + PG8_SA(b, h) + aoff + m * 2048 + k * 1024); } while (0)
#define PG8_LDB(dst, b, h) do { _Pragma("unroll") for (int n = 0; n < 2; ++n) _Pragma("unroll") for (int k = 0; k < 2; ++k) dst[n][k] = *(const LAS bf16x8*)(lds + PG8_SB(b, h) + boff + n * 2048 + k * 1024); } while (0)
#define PG8_MMA(ai, bj, At, Bt) do { __builtin_amdgcn_s_setprio(1); _Pragma("unroll") for (int m = 0; m < 4; ++m) _Pragma("unroll") for (int n = 0; n < 2; ++n) _Pragma("unroll") for (int k = 0; k < 2; ++k) \
        acc[ai][bj][m][n] = __builtin_amdgcn_mfma_f32_16x16x32_bf16(Bt[n][k], At[m][k], acc[ai][bj][m][n], 0, 0, 0); __builtin_amdgcn_s_setprio(0); } while (0)
#define PG8_WAIT_V(n) asm volatile("s_waitcnt vmcnt(" #n ")" ::: "memory")
#define PG8_WAIT_L(n) asm volatile("s_waitcnt lgkmcnt(" #n ")" ::: "memory")
#define PG8_BAR __builtin_amdgcn_s_barrier()
#define PG8_SCHED __builtin_amdgcn_sched_barrier(0)
    Unit cur, nxt; int ui = 0;
    if (!S.next(0, cur)) return;
    f32x4 acc[2][2][4][2];
#pragma unroll
    for (int a = 0; a < 2; ++a)
#pragma unroll
        for (int b = 0; b < 2; ++b)
#pragma unroll
            for (int m = 0; m < 4; ++m)
#pragma unroll
                for (int n = 0; n < 2; ++n) acc[a][b][m][n] = (f32x4){0.f, 0.f, 0.f, 0.f};
    bf16x8 At[4][2], B0[2][2], B1[2][2];
    const char* cA = cur.a; const char* cB = cur.b;
    if constexpr (SP2) {
        PG8_STAGE(PG8_SB(0, 0), cB, voffB); PG8_STAGE(PG8_SB(0, 1), cB + hstepB, voffB); PG8_STAGE(PG8_SA(0, 0), cA, voffA); PG8_STAGE(PG8_SA(0, 1), cA + hstepA, voffA);
        if (wr == 1) PG8_BAR;
        PG8_WAIT_V(2); PG8_BAR;
        PG8_STAGE(PG8_SB(1, 0), cB + kstep, voffB); PG8_STAGE(PG8_SA(1, 0), cA + kstep, voffA); PG8_STAGE(PG8_SB(1, 1), cB + hstepB + kstep, voffB);
        PG8_WAIT_V(6); PG8_BAR;
    } else {
        PG8_STAGE(PG8_SB(0, 0), cB, voffB); PG8_STAGE(PG8_SA(0, 0), cA, voffA); PG8_STAGE(PG8_SB(0, 1), cB + hstepB, voffB); PG8_STAGE(PG8_SA(0, 1), cA + hstepA, voffA);
        if (wr == 1) PG8_BAR;
        PG8_WAIT_V(4); PG8_BAR;
        PG8_STAGE(PG8_SB(1, 0), cB + kstep, voffB); PG8_STAGE(PG8_SA(1, 0), cA + kstep, voffA); PG8_STAGE(PG8_SB(1, 1), cB + hstepB + kstep, voffB);
        PG8_WAIT_V(6); PG8_BAR;
    }
    for (;;) {
        const bool has_next = S.next(ui + 1, nxt);
        const char* nA = has_next ? nxt.a : cA; const char* nB = has_next ? nxt.b : cB;
        for (int t = 0; t < nt; t += 2) {
            const bool last = (t == nt - 2);
            const char* a1 = cA + (size_t)(t + 1) * kstep;
            const char* a2 = last ? nA : cA + (size_t)(t + 2) * kstep; const char* b2 = last ? nB : cB + (size_t)(t + 2) * kstep;
            const char* a3 = a2 + kstep; const char* b3 = b2 + kstep;
            if constexpr (SP2) {
            PG8_LDB(B0, 0, 0); PG8_LDB(B1, 0, 1); PG8_SCHED; PG8_LDA(At, 0, 0); PG8_STAGE(PG8_SA(1, 1), a1 + hstepA, voffA);
            PG8_WAIT_V(8); PG8_WAIT_L(0); PG8_BAR; PG8_MMA(0, 0, At, B0); PG8_MMA(0, 1, At, B1); PG8_BAR; PG8_SCHED;
            PG8_LDA(At, 0, 1); PG8_STAGE(PG8_SB(0, 0), b2, voffB); PG8_STAGE(PG8_SB(0, 1), b2 + hstepB, voffB); PG8_STAGE(PG8_SA(0, 0), a2, voffA);
            PG8_WAIT_V(8); PG8_WAIT_L(0); PG8_BAR; PG8_MMA(1, 0, At, B0); PG8_MMA(1, 1, At, B1); PG8_BAR; PG8_SCHED;
            PG8_LDB(B0, 1, 0); PG8_LDB(B1, 1, 1); PG8_SCHED; PG8_LDA(At, 1, 0); PG8_STAGE(PG8_SA(0, 1), a2 + hstepA, voffA);
            PG8_WAIT_V(8); PG8_WAIT_L(0); PG8_BAR; PG8_MMA(0, 0, At, B0); PG8_MMA(0, 1, At, B1); PG8_BAR; PG8_SCHED;
            PG8_LDA(At, 1, 1); PG8_STAGE(PG8_SB(1, 0), b3, voffB); PG8_STAGE(PG8_SB(1, 1), b3 + hstepB, voffB); PG8_STAGE(PG8_SA(1, 0), a3, voffA);
            PG8_WAIT_V(8); PG8_WAIT_L(0); PG8_BAR; PG8_MMA(1, 0, At, B0); PG8_MMA(1, 1, At, B1); PG8_BAR; PG8_SCHED;
            } else {
            PG8_LDB(B0, 0, 0); PG8_SCHED; PG8_LDA(At, 0, 0); PG8_STAGE(PG8_SA(1, 1), a1 + hstepA, voffA);
            PG8_WAIT_L(8); PG8_BAR; PG8_WAIT_L(0); PG8_MMA(0, 0, At, B0); PG8_BAR; PG8_SCHED;
            PG8_LDB(B1, 0, 1); PG8_STAGE(PG8_SB(0, 0), b2, voffB);
            PG8_BAR; PG8_WAIT_L(0); PG8_MMA(0, 1, At, B1); PG8_BAR;
            PG8_LDA(At, 0, 1); PG8_STAGE(PG8_SA(0, 0), a2, voffA);
            PG8_BAR; PG8_WAIT_L(0); PG8_MMA(1, 0, At, B0); PG8_BAR; PG8_SCHED;
            PG8_STAGE(PG8_SB(0, 1), b2 + hstepB, voffB);
            PG8_WAIT_V(6); PG8_BAR; PG8_MMA(1, 1, At, B1); PG8_BAR;
            PG8_LDB(B0, 1, 0); PG8_SCHED; PG8_LDA(At, 1, 0); PG8_STAGE(PG8_SA(0, 1), a2 + hstepA, voffA);
            PG8_WAIT_L(8); PG8_BAR; PG8_WAIT_L(0); PG8_MMA(0, 0, At, B0); PG8_BAR; PG8_SCHED;
            PG8_LDB(B1, 1, 1); PG8_STAGE(PG8_SB(1, 0), b3, voffB);
            PG8_BAR; PG8_WAIT_L(0); PG8_MMA(0, 1, At, B1); PG8_BAR;
            PG8_LDA(At, 1, 1); PG8_STAGE(PG8_SA(1, 0), a3, voffA);
            PG8_BAR; PG8_WAIT_L(0); PG8_MMA(1, 0, At, B0); PG8_BAR; PG8_SCHED;
            PG8_STAGE(PG8_SB(1, 1), b3 + hstepB, voffB);
            PG8_WAIT_V(6); PG8_BAR; PG8_MMA(1, 1, At, B1); PG8_BAR;
            }
        }
        if constexpr (ALIGN_EPI) { if (wr == 0) PG8_BAR; }
        E(acc, cur, wr, wc, fr, fq);
        if (!has_next) break;
#pragma unroll
        for (int a = 0; a < 2; ++a)
#pragma unroll
            for (int b = 0; b < 2; ++b)
#pragma unroll
                for (int m = 0; m < 4; ++m)
#pragma unroll
                    for (int n = 0; n < 2; ++n) acc[a][b][m][n] = (f32x4){0.f, 0.f, 0.f, 0.f};
        cur = nxt; cA = nA; cB = nB; ++ui;
        if constexpr (ALIGN_EPI) { if (wr == 1) PG8_BAR; }
    }
    PG8_WAIT_V(0);
    if constexpr (!ALIGN_EPI) { if (wr == 0) PG8_BAR; }
    PG8_BAR;
#undef PG8_SA
#undef PG8_SB
#undef PG8_STAGE
#undef PG8_LDA
#undef PG8_LDB
#undef PG8_MMA
#undef PG8_WAIT_V
#undef PG8_WAIT_L
#undef PG8_BAR
#undef PG8_SCHED
}
template <class F> struct EpiV4 { static constexpr bool PERM = false; F f;
    __device__ __forceinline__ void operator()(const f32x4 (&acc)[2][2][4][2], const Unit& u, int wr, int wc, int fr, int fq) const {
        const int row0 = u.pm * BM + wr * 64 + fr, col0 = u.pn * BM + wc * 32 + 4 * fq;
#pragma unroll
        for (int ai = 0; ai < 2; ++ai)
#pragma unroll
            for (int m = 0; m < 4; ++m) {
#pragma unroll
                for (int bj = 0; bj < 2; ++bj)
#pragma unroll
                    for (int n = 0; n < 2; ++n) f(row0 + ai * HALF + m * 16, col0 + bj * HALF + n * 16, acc[ai][bj][m][n]);
                asm volatile("" ::: "memory"); }
    } };
template <class F> struct EpiV8 { static constexpr bool PERM = true; F f;
    __device__ __forceinline__ void operator()(const f32x4 (&acc)[2][2][4][2], const Unit& u, int wr, int wc, int fr, int fq) const {
        const int row0 = u.pm * BM + wr * 64 + fr, col0 = u.pn * BM + wc * 32 + 8 * fq;
#pragma unroll
        for (int ai = 0; ai < 2; ++ai)
#pragma unroll
            for (int m = 0; m < 4; ++m) {
#pragma unroll
                for (int bj = 0; bj < 2; ++bj) f.apply8(row0 + ai * HALF + m * 16, col0 + bj * HALF, acc[ai][bj][m][0], acc[ai][bj][m][1]);
                asm volatile("" ::: "memory"); }
    } };
template <class F> struct EpiDual { static constexpr bool PERM = true; F f;
    __device__ __forceinline__ void operator()(const f32x4 (&acc)[2][2][4][2], const Unit& u, int wr, int wc, int fr, int fq) const {
        const int row0 = u.pm * BM + wr * 64 + fr, hc0 = u.pn * HALF + wc * 32 + 8 * fq;
#pragma unroll
        for (int ai = 0; ai < 2; ++ai)
#pragma unroll
            for (int m = 0; m < 4; ++m) f.apply8(row0 + ai * HALF + m * 16, hc0, acc[ai][0][m][0], acc[ai][0][m][1], acc[ai][1][m][0], acc[ai][1][m][1]);
    } };
}

__device__ __forceinline__ u32x4 pack8(f32x4 a, f32x4 b) { u32x4 w; w.x = pk2(a.x, a.y); w.y = pk2(a.z, a.w); w.z = pk2(b.x, b.y); w.w = pk2(b.z, b.w); return w; }
__device__ __forceinline__ f32x4 sigm4(f32x4 v) { f32x4 r; r.x = 1.f / (1.f + __expf(-v.x)); r.y = 1.f / (1.f + __expf(-v.y)); r.z = 1.f / (1.f + __expf(-v.z)); r.w = 1.f / (1.f + __expf(-v.w)); return r; }
struct FStore8 { bf16_t* C; int ldc;
    __device__ __forceinline__ void apply8(int row, int col, f32x4 a, f32x4 b) const { *(u32x4*)(C + (size_t)row * ldc + col) = pack8(a, b); } };
struct FGate8 { bf16_t* G; const float* bias;
    __device__ __forceinline__ void apply8(int row, int col, f32x4 a, f32x4 b) const { const f32x4 b0 = *(const f32x4*)(bias + col), b1 = *(const f32x4*)(bias + col + 4);
        *(u32x4*)(G + (size_t)row * D + col) = pack8(sigm4(a + b0), sigm4(b + b1)); } };
struct FMerge8 { bf16_t* MG; const bf16_t* G; int first;
    __device__ __forceinline__ void apply8(int row, int col, f32x4 a, f32x4 b) const { const size_t o = (size_t)row * D + col; const u32x4 g = *(const u32x4*)(G + o);
        a = a * (f32x4){lo16(g.x), hi16(g.x), lo16(g.y), hi16(g.y)}; b = b * (f32x4){lo16(g.z), hi16(g.z), lo16(g.w), hi16(g.w)};
        if (!first) { const u32x4 p = *(const u32x4*)(MG + o); a += (f32x4){lo16(p.x), hi16(p.x), lo16(p.y), hi16(p.y)}; b += (f32x4){lo16(p.z), hi16(p.z), lo16(p.w), hi16(p.w)}; }
        *(u32x4*)(MG + o) = pack8(a, b); } };
struct FMoe1 { bf16_t* HID;
    __device__ __forceinline__ void apply8(int row, int hc, f32x4 a0, f32x4 a1, f32x4 b0, f32x4 b1) const {
        *(u32x4*)(HID + (size_t)row * FF + hc) = pack8(a0 * sigm4(a0) * b0, a1 * sigm4(a1) * b1); } };
struct FMoe2 { bf16_t* MO; const int* rowmap; const float* roww;
    __device__ __forceinline__ void apply8(int row, int col, f32x4 a, f32x4 b) const { const int t = rowmap[row]; if (t < 0) return; const float w = roww[row];
        *(u32x4*)(MO + ((size_t)(t & 1) * R + (t >> 1)) * D + col) = pack8(a * w, b * w); } };

struct Frame { LAS unsigned char* lds; int wave, vcu, G; };
#define fresh_tid() (F.wave * 64 + fresh_lane())
__device__ __forceinline__ void tr_item(const float* W, int ldw, int k0, int csrc0, bf16_t* WT, int ldt, int drow0, LAS float* scr, int lane) {
#pragma unroll 8
    for (int i = 0; i < 32; ++i) { const int kk = 2 * i + (lane >> 5); scr[kk * 33 + (lane & 31)] = W[(size_t)(k0 + kk) * ldw + csrc0 + (lane & 31)]; }
    LDS_WAIT(); asm volatile("" ::: "memory");
    const int c = lane & 7;
#pragma unroll
    for (int j = 0; j < 4; ++j) { const int n = (lane >> 3) + 8 * j; const LAS float* s = scr + (8 * c) * 33 + n;
        u32x4 o; o.x = pk2(s[0 * 33], s[1 * 33]); o.y = pk2(s[2 * 33], s[3 * 33]); o.z = pk2(s[4 * 33], s[5 * 33]); o.w = pk2(s[6 * 33], s[7 * 33]);
        *(u32x4*)(WT + (size_t)(drow0 + n) * ldt + k0 + 8 * c) = o; }
    LDS_WAIT(); asm volatile("" ::: "memory");
}
__device__ __forceinline__ void ph_weights(const Frame& F, const Ptrs& P, int l) {
    const int tid0 = fresh_tid(), lane0 = tid0 & 63;
    LAS float* scr = (LAS float*)(F.lds + F.wave * 16384);
    const int gw = F.vcu * NWAVES + F.wave, NGW = F.G * NWAVES;
    unsigned char* wb = P.ws + WS_WB;
    constexpr int I0 = 1024, I1 = I0 + 2048, I2 = I1 + 768, I3 = I2 + 512, I4 = I3 + 4096, I5 = I4 + 4096, I6 = I5 + 4096;
    for (int it = gw; it < I6; it += NGW) {
        if (it < I0) { const int kb = it >> 6, nb = it & 63; tr_item(P.w_in + (size_t)l * 1024 * 2560, 2560, kb * 64, 512 + nb * 32, (bf16_t*)(wb + WB_IN), 1024, 1024 + nb * 32, scr, lane0); }
        else if (it < I1) { const int r = it - I0, i = r >> 9, q = r & 511, kb = q >> 5, nb = q & 31; tr_item(P.w_gate + ((size_t)l * 4 + i) * 1024 * 1024, 1024, kb * 64, nb * 32, (bf16_t*)(wb + WB_GATE) + (size_t)i * 1024 * 1024, 1024, nb * 32, scr, lane0); }
        else if (it < I2) { const int r = it - I1, i = r >> 8, q = r & 255, kb = q >> 5, nb = q & 31; tr_item(P.w_branch + ((size_t)l * 4 + i) * 512 * 1024, 1024, kb * 64, nb * 32, (bf16_t*)(wb + WB_BR) + (size_t)i * 1024 * 512, 512, nb * 32, scr, lane0); }
        else if (it < I3) { const int q = it - I2, kb = q >> 5, nb = q & 31; tr_item(P.w_out + (size_t)l * 1024 * 1024, 1024, kb * 64, nb * 32, (bf16_t*)(wb + WB_OUT), 1024, nb * 32, scr, lane0); }
        else if (it < I5) { const int w3 = it >= I4; const int r = it - (w3 ? I4 : I3), e = r >> 8, q = r & 255, kb = q >> 4, nb = q & 15, c = nb * 32;
            tr_item((w3 ? P.w3 : P.w1) + ((size_t)l * 16 + e) * 1024 * 512, 512, kb * 64, c, (bf16_t*)(wb + WB_13) + (size_t)e * 1024 * 1024, 1024, 256 * (c >> 7) + (c & 127) + (w3 ? 128 : 0), scr, lane0); }
        else { const int r = it - I5, e = r >> 8, q = r & 255, kb = q >> 5, nb = q & 31; tr_item(P.w2 + ((size_t)l * 16 + e) * 512 * 1024, 1024, kb * 64, nb * 32, (bf16_t*)(wb + WB_2) + (size_t)e * 1024 * 512, 512, nb * 32, scr, lane0); }
    }
    __syncthreads();
    for (int u = F.vcu; u < 64; u += F.G) {
        LAS float* Wl = (LAS float*)F.lds; LAS float* ct = Wl + 64 * 128;
        const int kt = u >> 2, g = u & 3, k0 = kt * 64, tid = tid0; const float* w_in = P.w_in + (size_t)l * 1024 * 2560;
        if (tid < 128) ct[tid] = __builtin_amdgcn_cosf((float)tid * (1.0f / 128.0f));
        for (int i = tid; i < 64 * 128; i += 512) { const int k = i >> 7, c = i & 127; Wl[k * 128 + c] = w_in[(size_t)(k0 + k) * 2560 + g * 128 + c]; }
        __syncthreads();
        const int part = (tid >> 7) & 1, m = tid & 127, kh = tid >> 8; const float sc = 0.08838834764831845f;
        bf16_t* drow = (bf16_t*)(wb + WB_IN) + (size_t)(part * 512 + g * 128 + m) * 1024 + k0;
        for (int kb = kh * 32; kb < kh * 32 + 32; kb += 8) { float acc[8];
#pragma unroll
            for (int j = 0; j < 8; ++j) acc[j] = 0.f;
            for (int c = 0; c < 128; ++c) { const int idx = (c * m) & 127; const float tw = part ? -ct[(idx - 32) & 127] : ct[idx];
#pragma unroll
                for (int j = 0; j < 8; ++j) acc[j] += Wl[(kb + j) * 128 + c] * tw; }
            u32x4 o; o.x = pk2(acc[0] * sc, acc[1] * sc); o.y = pk2(acc[2] * sc, acc[3] * sc); o.z = pk2(acc[4] * sc, acc[5] * sc); o.w = pk2(acc[6] * sc, acc[7] * sc);
            *(u32x4*)(drow + kb) = o; }
        __syncthreads();
    }
    for (int u = F.G - 1 - F.vcu; u < 64; u += F.G) {
        LAS float* Wb = (LAS float*)F.lds;
        const int g = u >> 4, n0 = (u & 15) * 64, tid = tid0;
        const float* ps = P.pool_scale + (size_t)l * 512; const float* wb3 = P.w_branch + ((size_t)l * 4 + 3) * 512 * 1024; const float* pwl = P.pool_w + (size_t)l * 4 * 128 * 128;
        for (int i = tid; i < 128 * 64; i += 512) { const int e = i >> 6, n = i & 63; Wb[e * 64 + n] = ps[g * 128 + e] * wb3[(size_t)(g * 128 + e) * 1024 + n0 + n]; }
        __syncthreads();
        const int c = tid & 127, nh = tid >> 7; const float* pw = pwl + (size_t)(g * 128 + c) * 128;
        float acc[16];
#pragma unroll
        for (int j = 0; j < 16; ++j) acc[j] = 0.f;
        for (int e = 0; e < 128; ++e) { const float p = pw[e];
#pragma unroll
            for (int j = 0; j < 16; ++j) acc[j] += p * Wb[e * 64 + nh * 16 + j]; }
        bf16_t* Bt = (bf16_t*)(wb + WB_BR) + (size_t)3 * 1024 * 512;
#pragma unroll
        for (int j = 0; j < 16; ++j) Bt[(size_t)(n0 + nh * 16 + j) * 512 + g * 128 + c] = (bf16_t)f2bf(acc[j]);
        __syncthreads();
    }
}
__device__ __forceinline__ void ph_tables_mod(const Frame& F, const Ptrs& P) {
    const int tid0 = fresh_tid();
    { float* rc = (float*)(P.ws + WS_ROPE); float* rs = rc + 1024; float* ct = (float*)(P.ws + WS_COS);
      const int i = F.vcu * 512 + tid0;
      if (i < 1024) { const int pos = i >> 4, f = i & 15; const float inv = exp2f(-(float)f * (13.287712379549449f / 16.0f));
          float rev = (float)pos * inv * 0.15915494309189535f; rev = rev - floorf(rev);
          rc[i] = __builtin_amdgcn_cosf(rev); rs[i] = __builtin_amdgcn_sinf(rev); }
      if (i < 4096) ct[i] = __builtin_amdgcn_cosf((float)i * (1.0f / 4096.0f));
      if (i < 16384) { const int mm = i >> 7, k = i & 127, pp = mm >> 6, k1 = mm & 63, pk = k >> 6, t1 = k & 63; const float rev = (float)((k1 * t1) & 63) * (1.0f / 64.0f);
          const float c = __builtin_amdgcn_cosf(rev), sn = __builtin_amdgcn_sinf(rev);
          ((bf16_t*)(P.ws + WS_DFTM))[i] = (bf16_t)f2bf(pp == pk ? c : (pp == 0 ? sn : -sn)); } }
    for (int u = F.vcu; u < 192; u += F.G) {
        LAS float* s = (LAS float*)F.lds; LAS float* red = s + 9 * 1024;
        const int l = u / 96, j0 = (u % 96) * 64, tid = tid0;
        for (int i = tid; i < 9 * 1024; i += 512) { const int bb = i >> 10, k = i & 1023; const float v = bb < 8 ? P.c[bb * 1024 + k] : P.c_ctx[k]; s[i] = v / (1.f + expf(-v)); }
        __syncthreads();
        const int kc = tid >> 6, jj = tid & 63; float acc[9];
#pragma unroll
        for (int b = 0; b < 9; ++b) acc[b] = 0.f;
        const float* w = P.w_ada + (size_t)l * 1024 * 6144 + j0 + jj;
        for (int k = kc * 128; k < kc * 128 + 128; ++k) { const float wv = w[(size_t)k * 6144];
#pragma unroll
            for (int b = 0; b < 9; ++b) acc[b] += s[b * 1024 + k] * wv; }
#pragma unroll
        for (int b = 0; b < 9; ++b) red[(kc * 9 + b) * 64 + jj] = acc[b];
        __syncthreads();
        float* mod = (float*)(P.ws + WS_MOD);
        for (int i = tid; i < 9 * 64; i += 512) { const int b = i >> 6, j = i & 63; float v = P.b_ada[l * 6144 + j0 + j];
#pragma unroll
            for (int q = 0; q < 8; ++q) v += red[(q * 9 + b) * 64 + j];
            mod[(size_t)(l * 9 + b) * 6144 + j0 + j] = v; }
        __syncthreads();
    }
}
template <int MODE> __device__ __forceinline__ void ph_norm(const Frame& F, const Ptrs& P, int l, int nrows) {
    const int lane = fresh_tid() & 63;
    for (int r = F.vcu * NWAVES + F.wave; r < nrows; r += F.G * NWAVES) {
        const int bb = row_bb(r);
        f32x4 v[4];
        if (MODE == 0) { const f32x4* xr = (const f32x4*)xin_row(P, r) + lane;
#pragma unroll
            for (int j = 0; j < 4; ++j) v[j] = xr[64 * j]; }
        else { f32x4* xr = (f32x4*)x1_row(P, r) + lane;
#pragma unroll
            for (int j = 0; j < 4; ++j) v[j] = xr[64 * j];
            if (MODE == 1) { const f32x4* g2 = (const f32x4*)mod_vec(P, l - 1, bb, 5) + lane;
                const u32x2* m0 = (const u32x2*)((const bf16_t*)(P.ws + WS_MO) + (size_t)r * D) + lane; const u32x2* m1 = (const u32x2*)((const bf16_t*)(P.ws + WS_MO) + (size_t)(R + r) * D) + lane;
#pragma unroll
                for (int j = 0; j < 4; ++j) { const u32x2 a = m0[64 * j], b = m1[64 * j]; const f32x4 g = g2[64 * j];
                    v[j].x += g.x * (lo16(a.x) + lo16(b.x)); v[j].y += g.y * (hi16(a.x) + hi16(b.x)); v[j].z += g.z * (lo16(a.y) + lo16(b.y)); v[j].w += g.w * (hi16(a.y) + hi16(b.y));
                    xr[64 * j] = v[j]; } } }
        float ss = 0.f;
#pragma unroll
        for (int j = 0; j < 4; ++j) ss += (v[j].x * v[j].x + v[j].y * v[j].y) + (v[j].z * v[j].z + v[j].w * v[j].w);
        const float rstd = 1.0f / sqrtf(wave_sum_l(ss, lane) * (1.0f / D) + EPS);
        const f32x4* gn = (const f32x4*)((MODE == 2 ? P.norm2 : P.norm1) + (size_t)l * D) + lane;
        const f32x4* sh = (const f32x4*)mod_vec(P, l, bb, MODE == 2 ? 3 : 0) + lane;
        const f32x4* sc = (const f32x4*)mod_vec(P, l, bb, MODE == 2 ? 4 : 1) + lane;
        u32x2* o = (u32x2*)((bf16_t*)(P.ws + WS_H) + (size_t)r * D) + lane;
#pragma unroll
        for (int j = 0; j < 4; ++j) { const f32x4 g = gn[64 * j], a = sh[64 * j], b = sc[64 * j];
            v[j] = (v[j] * rstd * g) * (b + 1.0f) + a;
            u32x2 w; w.x = pk2(v[j].x, v[j].y); w.y = pk2(v[j].z, v[j].w); o[64 * j] = w; }
        if (MODE == 2) {
            float lg[16];
#pragma unroll
            for (int e = 0; e < 16; ++e) lg[e] = 0.f;
#pragma unroll
            for (int j = 0; j < 4; ++j) {
#pragma unroll
                for (int i = 0; i < 4; ++i) { const float hv = v[j][i]; const f32x4* rw = (const f32x4*)(P.router_w + (size_t)(4 * lane + 256 * j + i) * 16);
#pragma unroll
                    for (int q = 0; q < 4; ++q) { const f32x4 w = rw[q]; lg[4 * q] += hv * w.x; lg[4 * q + 1] += hv * w.y; lg[4 * q + 2] += hv * w.z; lg[4 * q + 3] += hv * w.w; } } }
#pragma unroll
            for (int e = 0; e < 16; ++e) lg[e] = wave_sum_l(lg[e], lane);
            float bestscore = -INFINITY; int be0 = 0, be1 = 1; float ba0 = 0.f, ba1 = 0.f;
#pragma unroll
            for (int g = 0; g < 4; ++g) {
                float aff[4], sel[4];
#pragma unroll
                for (int i = 0; i < 4; ++i) { aff[i] = 1.0f / (1.0f + expf(-lg[4 * g + i])); sel[i] = aff[i] + P.router_bias[4 * g + i]; }
                int i1 = 0; float m1 = sel[0], a1 = aff[0];
#pragma unroll
                for (int i = 1; i < 4; ++i) if (sel[i] > m1) { m1 = sel[i]; a1 = aff[i]; i1 = i; }
                int i2 = -1; float m2 = -INFINITY, a2 = 0.f;
#pragma unroll
                for (int i = 0; i < 4; ++i) if (i != i1 && sel[i] > m2) { m2 = sel[i]; a2 = aff[i]; i2 = i; }
                const float score = m1 + m2;
                if (score > bestscore) { bestscore = score; be0 = 4 * g + i1; be1 = 4 * g + i2; ba0 = a1; ba1 = a2; }
            }
            if (lane == 0) {
                unsigned* cnt = (unsigned*)(P.ws + WS_CTL) + CW_CNT + 64 * l;
                const int p0 = (int)atomicAdd(cnt + be0, 1u), p1 = (int)atomicAdd(cnt + be1, 1u);
                int* rt = (int*)(P.ws + WS_ROUTE) + (size_t)r * 6; const float inv = 1.0f / (ba0 + ba1);
                rt[0] = be0; rt[1] = p0; rt[2] = be1; rt[3] = p1; ((float*)rt)[4] = ba0 * inv; ((float*)rt)[5] = ba1 * inv;
            }
        }
    }
}
__device__ __forceinline__ void ph_qkprep(const Frame& F, const Ptrs& P, int l) {
    const int lane = fresh_tid() & 63;
    const float* rc = (const float*)(P.ws + WS_ROPE); const float* rs = rc + 1024;
    const float qg = P.q_gain[l * 64 + lane], kg = P.k_gain[l * 64 + lane];
    const int a = lane >> 5, fi = lane & 15; const bool second = (lane & 16) != 0;
    for (int r = F.vcu * NWAVES + F.wave; r < R; r += F.G * NWAVES) {
        bf16_t* u = (bf16_t*)(P.ws + WS_U) + (size_t)r * NIN;
        const bool lat = r < RL; const int t = r & (T - 1);
        const int pos = a ? (t & 63) : (t >> 6);
        const float cs = rc[pos * 16 + fi], sn = rs[pos * 16 + fi];
        for (int hh = 0; hh < 20; ++hh) {
            const int col = hh < 8 ? C_QB + hh * 64 : hh < 10 ? C_KB + (hh - 8) * 64 : hh < 18 ? C_QW + (hh - 10) * 64 : C_KW + (hh - 18) * 64;
            float x = bf2f(u[col + lane]);
            if (hh < 10) { const float ss = wave_sum_l(x * x, lane); x = x * (1.0f / sqrtf(ss * (1.0f / 64.0f) + EPS)) * (hh < 8 ? qg : kg); }
            if (lat) { const float y = shfl_xor_l(x, 16, lane); x = second ? x * cs + y * sn : x * cs - y * sn; }
            if (hh < 8 || (hh >= 10 && hh < 18)) x *= QSCALE;
            u[col + lane] = (bf16_t)f2bf(x);
        }
    }
}
__device__ __forceinline__ void ph_pool(const Frame& F, const Ptrs& P, int nrows) {
    const int tid0 = fresh_tid();
    for (int i = F.vcu * 512 + tid0; i < nrows * 64; i += F.G * 512) {
        const int r = i >> 6, c8 = (i & 63) * 8;
        const bool lat = r < RL; const int Ts = lat ? T : TC; const int t = lat ? (r & (T - 1)) : ((r - RL) & (TC - 1)); const int r0 = r - t;
        const int g = c8 >> 7, hw = 1 << g;
        const int lo = t - hw < 0 ? 0 : t - hw, hi = t + hw > Ts ? Ts : t + hw;
        const bf16_t* U = (const bf16_t*)(P.ws + WS_U) + C_P + c8;
        float s[8];
#pragma unroll
        for (int j = 0; j < 8; ++j) s[j] = 0.f;
        for (int tt = lo; tt < hi; ++tt) { const u32x4 w = *(const u32x4*)(U + (size_t)(r0 + tt) * NIN);
            s[0] += lo16(w.x); s[1] += hi16(w.x); s[2] += lo16(w.y); s[3] += hi16(w.y); s[4] += lo16(w.z); s[5] += hi16(w.z); s[6] += lo16(w.w); s[7] += hi16(w.w); }
        const u32x4 w = *(const u32x4*)(U + (size_t)r * NIN); const float inv = 1.0f / (float)(hi - lo);
        u32x4 o; o.x = pk2(s[0] * inv - lo16(w.x), s[1] * inv - hi16(w.x)); o.y = pk2(s[2] * inv - lo16(w.y), s[3] * inv - hi16(w.y));
        o.z = pk2(s[4] * inv - lo16(w.z), s[5] * inv - hi16(w.z)); o.w = pk2(s[6] * inv - lo16(w.w), s[7] * inv - hi16(w.w));
        *(u32x4*)((bf16_t*)(P.ws + WS_BR) + (size_t)r * NBR + 1536 + c8) = o;
    }
}
__device__ __forceinline__ void ph_gather(const Frame& F, const Ptrs& P, int l, int nrows) {
    const unsigned* cnt = (const unsigned*)(P.ws + WS_CTL) + CW_CNT + 64 * l;
    int* rowmap = (int*)(P.ws + WS_ROWMAP); float* roww = (float*)(P.ws + WS_ROWW);
    const int lane = fresh_tid() & 63;
    for (int wv = F.vcu * NWAVES + F.wave; wv < 2 * nrows + 64; wv += F.G * NWAVES) {
        if (wv < 2 * nrows) {
            const int r = wv >> 1, s = wv & 1; const int* rt = (const int*)(P.ws + WS_ROUTE) + (size_t)r * 6;
            const int e = rt[2 * s], pos = rt[2 * s + 1]; const float w = ((const float*)rt)[4 + s];
            int off = 0;
#pragma unroll
            for (int q = 0; q < 16; ++q) { const int n = ((int)cnt[q] + 255) & ~255; if (q < e) off += n; }
            const int dst = off + pos;
            const u32x4* src = (const u32x4*)((const bf16_t*)(P.ws + WS_H) + (size_t)r * D); u32x4* d = (u32x4*)((bf16_t*)(P.ws + WS_AS) + (size_t)dst * D);
            d[lane] = src[lane]; d[lane + 64] = src[lane + 64];
            if (lane == 0) { rowmap[dst] = wv; roww[dst] = w; }
        } else {
            const int i = (wv - 2 * nrows) * 64 + lane;
            const int e = i >> 8, p = i & 255; int off = 0;
#pragma unroll
            for (int q = 0; q < 16; ++q) { const int n = ((int)cnt[q] + 255) & ~255; if (q < e) off += n; }
            const int c = (int)cnt[e]; if (c + p < ((c + 255) & ~255)) rowmap[off + c + p] = -1;
        }
    }
}
__device__ __forceinline__ void ph_final(const Frame& F, const Ptrs& P) {
    const int lane = fresh_tid() & 63;
    for (int r = F.vcu * NWAVES + F.wave; r < RL; r += F.G * NWAVES) {
        const int bb = row_bb(r);
        f32x4* xr = (f32x4*)(P.out + (size_t)r * D) + lane; f32x4 v[4];
        const f32x4* g2 = (const f32x4*)mod_vec(P, 1, bb, 5) + lane;
        const u32x2* m0 = (const u32x2*)((const bf16_t*)(P.ws + WS_MO) + (size_t)r * D) + lane; const u32x2* m1 = (const u32x2*)((const bf16_t*)(P.ws + WS_MO) + (size_t)(R + r) * D) + lane;
        float ss = 0.f;
#pragma unroll
        for (int j = 0; j < 4; ++j) { v[j] = xr[64 * j]; const u32x2 a = m0[64 * j], b = m1[64 * j]; const f32x4 g = g2[64 * j];
            v[j].x += g.x * (lo16(a.x) + lo16(b.x)); v[j].y += g.y * (hi16(a.x) + hi16(b.x)); v[j].z += g.z * (lo16(a.y) + lo16(b.y)); v[j].w += g.w * (hi16(a.y) + hi16(b.y));
            ss += (v[j].x * v[j].x + v[j].y * v[j].y) + (v[j].z * v[j].z + v[j].w * v[j].w); }
        const float rstd = 1.0f / sqrtf(wave_sum_l(ss, lane) * (1.0f / D) + EPS);
        const f32x4* gn = (const f32x4*)P.norm_f + lane;
#pragma unroll
        for (int j = 0; j < 4; ++j) xr[64 * j] = v[j] * rstd * gn[64 * j];
    }
}

template <int MODE> __device__ __forceinline__ void ph_attn_ref(const Frame& F, const Ptrs& P, int l) {
    const int tid = fresh_tid();
    LAS float* Ks = (LAS float*)F.lds; LAS float* Vs = Ks + 64 * 64;
    const bf16_t* U = (const bf16_t*)(P.ws + WS_U);
    const bool latq = MODE < 2; const bool winm = (MODE == 1 || MODE == 3);
    const int NU = latq ? 1024 : 64; const int half = tid & 1;
    for (int u = F.vcu; u < NU; u += F.G) {
        const int qb = latq ? (u & 15) : 0, h = latq ? ((u >> 4) & 7) : (u & 7), b = latq ? (u >> 7) : (u >> 3), g = h >> 2;
        const int tq = qb * 256 + (tid >> 1);
        const int qrow = latq ? b * T + tq : RL + b * TC + tq;
        const int qcol = (winm ? C_QW : C_QB) + h * 64 + half * 32, kcol = (winm ? C_KW : C_KB) + g * 64, vcol = (winm ? C_VW : C_VB) + g * 64;
        unsigned q[16]; float o[32];
        { const u32x4* qp = (const u32x4*)(U + (size_t)qrow * NIN + qcol);
#pragma unroll
          for (int i = 0; i < 4; ++i) { const u32x4 w = qp[i]; q[4 * i] = w.x; q[4 * i + 1] = w.y; q[4 * i + 2] = w.z; q[4 * i + 3] = w.w; } }
#pragma unroll
        for (int d = 0; d < 32; ++d) o[d] = 0.f;
        float m = -INFINITY, lsum = 0.f;
        int lt_lo = 0, lt_hi = 0;
        if (MODE == 0) { lt_lo = 0; lt_hi = T / 64; }
        if (MODE == 1) { const int q0 = qb * 256; lt_lo = (q0 - 128 < 0 ? 0 : q0 - 128) / 64; lt_hi = (q0 + 384 > T ? T : q0 + 384) / 64; }
        const int ntiles = 4 + (lt_hi - lt_lo);
        for (int ti = 0; ti < ntiles; ++ti) {
            const bool isctx = ti < 4; const int kpos0 = isctx ? ti * 64 : (lt_lo + ti - 4) * 64;
            const int krow0 = isctx ? RL + b * TC + kpos0 : b * T + kpos0;
            __syncthreads();
            { const int j = tid >> 3, part = tid & 7; const u32x4 kw = *(const u32x4*)(U + (size_t)(krow0 + j) * NIN + kcol + part * 8), vw = *(const u32x4*)(U + (size_t)(krow0 + j) * NIN + vcol + part * 8);
              LAS float* kd = Ks + j * 64 + part * 8; LAS float* vd = Vs + j * 64 + part * 8;
              kd[0] = lo16(kw.x); kd[1] = hi16(kw.x); kd[2] = lo16(kw.y); kd[3] = hi16(kw.y); kd[4] = lo16(kw.z); kd[5] = hi16(kw.z); kd[6] = lo16(kw.w); kd[7] = hi16(kw.w);
              vd[0] = lo16(vw.x); vd[1] = hi16(vw.x); vd[2] = lo16(vw.y); vd[3] = hi16(vw.y); vd[4] = lo16(vw.z); vd[5] = hi16(vw.z); vd[6] = lo16(vw.w); vd[7] = hi16(vw.w); }
            __syncthreads();
#pragma unroll 1
            for (int jk = 0; jk < 64; ++jk) {
                float a = 0.f; const LAS f32x4* kr = (const LAS f32x4*)(Ks + jk * 64 + half * 32);
#pragma unroll
                for (int d4 = 0; d4 < 8; ++d4) { const f32x4 kv = kr[d4]; a += lo16(q[2 * d4]) * kv.x + hi16(q[2 * d4]) * kv.y + lo16(q[2 * d4 + 1]) * kv.z + hi16(q[2 * d4 + 1]) * kv.w; }
                a += shfl_xor_l(a, 1, tid & 63);
                if (MODE == 1 && !isctx) { const int dlt = kpos0 + jk - tq; if (dlt > 128 || dlt < -128) a = -INFINITY; }
                if (a != -INFINITY) {
                    if (a > m) { const float scl = exp2f(m - a); m = a; lsum *= scl;
#pragma unroll
                        for (int d = 0; d < 32; ++d) o[d] *= scl; }
                    const float p = exp2f(a - m); lsum += p; const LAS f32x4* vr = (const LAS f32x4*)(Vs + jk * 64 + half * 32);
#pragma unroll
                    for (int d4 = 0; d4 < 8; ++d4) { const f32x4 vv = vr[d4]; o[4 * d4] += p * vv.x; o[4 * d4 + 1] += p * vv.y; o[4 * d4 + 2] += p * vv.z; o[4 * d4 + 3] += p * vv.w; }
                }
            }
        }
        if (winm) lsum += exp2f(P.sink[l * 8 + h] * LOG2E - m);
        const float inv = 1.0f / lsum;
        { u32x4* op = (u32x4*)((bf16_t*)(P.ws + WS_BR) + (size_t)qrow * NBR + (winm ? 1024 : 512) + h * 64 + half * 32);
#pragma unroll
          for (int i = 0; i < 4; ++i) { u32x4 w; w.x = pk2(o[8 * i] * inv, o[8 * i + 1] * inv); w.y = pk2(o[8 * i + 2] * inv, o[8 * i + 3] * inv); w.z = pk2(o[8 * i + 4] * inv, o[8 * i + 5] * inv); w.w = pk2(o[8 * i + 6] * inv, o[8 * i + 7] * inv); op[i] = w; } }
        __syncthreads();
    }
}
__device__ __forceinline__ void ph_fourier_ref(const Frame& F, const Ptrs& P, int Ts, int latent) {
    const int tid = fresh_tid();
    LAS float* Zr = (LAS float*)F.lds; LAS float* Zi = Zr + 16 * 64; LAS float* Ct = Zi + 16 * 64; LAS float* St = Ct + 128 * 17;
    const bf16_t* U = (const bf16_t*)(P.ws + WS_U); const float* ct = (const float*)(P.ws + WS_COS);
    const int nkt = Ts / 128, NU = 8 * nkt * 8, step = 4096 / Ts;
    const int tk = tid >> 4, tc = tid & 15;
    for (int u = F.vcu; u < NU; u += F.G) {
        const int cht = u & 7, kt = (u >> 3) % nkt, b = (u >> 3) / nkt, k0 = kt * 128, ch0 = cht * 64;
        const int rbase = latent ? b * T : RL + b * TC;
        float acc[4][4];
#pragma unroll
        for (int i = 0; i < 4; ++i)
#pragma unroll
            for (int j = 0; j < 4; ++j) acc[i][j] = 0.f;
        for (int t0 = 0; t0 < Ts; t0 += 16) {
            __syncthreads();
            if (tid < 256) { const int tt = tid >> 4, c4 = (tid & 15) * 4; const bf16_t* zp = U + (size_t)(rbase + t0 + tt) * NIN + ch0 + c4;
              const u32x2 a = *(const u32x2*)(zp + C_ZR), bq = *(const u32x2*)(zp + C_ZI);
              Zr[tt * 64 + c4] = lo16(a.x); Zr[tt * 64 + c4 + 1] = hi16(a.x); Zr[tt * 64 + c4 + 2] = lo16(a.y); Zr[tt * 64 + c4 + 3] = hi16(a.y);
              Zi[tt * 64 + c4] = lo16(bq.x); Zi[tt * 64 + c4 + 1] = hi16(bq.x); Zi[tt * 64 + c4 + 2] = lo16(bq.y); Zi[tt * 64 + c4 + 3] = hi16(bq.y); }
#pragma unroll
            for (int i = 0; i < 4; ++i) { const int e = tid * 4 + i, k = e >> 4, tt = e & 15; const int ang = (((k0 + k) * (t0 + tt)) & (Ts - 1)) * step;
                Ct[k * 17 + tt] = ct[ang]; St[k * 17 + tt] = ct[(ang - 1024) & 4095]; }
            __syncthreads();
#pragma unroll 2
            for (int tt = 0; tt < 16; ++tt) { float zr[4], zi[4];
#pragma unroll
                for (int j = 0; j < 4; ++j) { zr[j] = Zr[tt * 64 + tc * 4 + j]; zi[j] = Zi[tt * 64 + tc * 4 + j]; }
#pragma unroll
                for (int i = 0; i < 4; ++i) { const float c = Ct[(tk * 4 + i) * 17 + tt], sn = St[(tk * 4 + i) * 17 + tt];
#pragma unroll
                    for (int j = 0; j < 4; ++j) acc[i][j] += c * zr[j] + sn * zi[j]; } }
        }
        const float sc = 1.0f / sqrtf((float)Ts);
        bf16_t* BR = (bf16_t*)(P.ws + WS_BR);
#pragma unroll
        for (int i = 0; i < 4; ++i) { u32x2 w; w.x = pk2(acc[i][0] * sc, acc[i][1] * sc); w.y = pk2(acc[i][2] * sc, acc[i][3] * sc);
            *(u32x2*)(BR + (size_t)(rbase + k0 + tk * 4 + i) * NBR + ch0 + tc * 4) = w; }
        __syncthreads();
    }
}

typedef float f32x16 __attribute__((ext_vector_type(16)));
typedef short v4i16_t __attribute__((ext_vector_type(4)));
typedef __bf16 bf16x2_t __attribute__((ext_vector_type(2)));
typedef float f32x2_t __attribute__((ext_vector_type(2)));
__device__ __forceinline__ unsigned cvtpk(float lo, float hi) { f32x2_t v = {lo, hi}; bf16x2_t b = __builtin_convertvector(v, bf16x2_t); return __builtin_bit_cast(unsigned, b); }
constexpr int AT_ROWB = 144, AT_TILEB = 64 * AT_ROWB;
template <int MODE> __device__ __forceinline__ void ph_attn(const Frame& F, const Ptrs& P, int l) {
    const int lane = fresh_lane(), tid = F.wave * 64 + lane, r32 = lane & 31, hi = lane >> 5;
    const bf16_t* U = (const bf16_t*)(P.ws + WS_U);
    const bool latq = MODE < 2; const bool winm = (MODE == 1 || MODE == 3);
    const int NU = latq ? 1024 : 64;
    LAS unsigned char* Kb = F.lds; LAS unsigned char* Vb = F.lds + 2 * AT_TILEB;
    const int st_off = (tid >> 3) * AT_ROWB + (tid & 7) * 16;
    const int kf_off = r32 * AT_ROWB + hi * 16;
    const int vf_off = (4 * hi + ((lane & 15) >> 2)) * AT_ROWB + (((lane >> 4) & 1) * 16 + (lane & 3) * 4) * 2;
    for (int u = F.vcu; u < NU; u += F.G) {
        const int qb = latq ? (u & 63) : (u & 3), g = latq ? ((u >> 6) & 1) : ((u >> 2) & 1), b = latq ? (u >> 7) : (u >> 3);
        const int tq0 = qb * 64, hq = 4 * g + (F.wave >> 1), tq = tq0 + 32 * (F.wave & 1) + r32;
        const int qrow = latq ? b * T + tq : RL + b * TC + tq;
        const int qcol = (winm ? C_QW : C_QB) + hq * 64, kcol = (winm ? C_KW : C_KB) + g * 64, vcol = (winm ? C_VW : C_VB) + g * 64;
        int lt_lo = 0, lt_hi = 0;
        if (MODE == 0) { lt_lo = 0; lt_hi = T / 64; }
        if (MODE == 1) { lt_lo = (tq0 - 128 < 0 ? 0 : tq0 - 128) / 64; lt_hi = (tq0 + 192 > T ? T : tq0 + 192) / 64; }
        const int ntiles = 4 + (lt_hi - lt_lo);
        bf16x8 qr[4];
#pragma unroll
        for (int d0 = 0; d0 < 4; ++d0) qr[d0] = *(const bf16x8*)(U + (size_t)qrow * NIN + qcol + d0 * 16 + hi * 8);
        f32x16 o0, o1;
#pragma unroll
        for (int r = 0; r < 16; ++r) { o0[r] = 0.f; o1[r] = 0.f; }
        float m = -INFINITY, lsum = 0.f;
        { const size_t kr = (size_t)(RL + b * TC + (tid >> 3)) * NIN + (tid & 7) * 8;
          const u32x4 kw = *(const u32x4*)(U + kr + kcol), vw = *(const u32x4*)(U + kr + vcol);
          *(LAS u32x4*)(Kb + st_off) = kw; *(LAS u32x4*)(Vb + st_off) = vw; }
        __syncthreads();
        for (int ti = 0; ti < ntiles; ++ti) {
            const int cur = (ti & 1) * AT_TILEB, nxt = AT_TILEB - cur;
            const bool more = ti + 1 < ntiles;
            u32x4 kw, vw;
            if (more) { const int tn = ti + 1; const int krow0 = tn < 4 ? RL + b * TC + tn * 64 : b * T + (lt_lo + tn - 4) * 64;
                const size_t kr = (size_t)(krow0 + (tid >> 3)) * NIN + (tid & 7) * 8;
                kw = *(const u32x4*)(U + kr + kcol); vw = *(const u32x4*)(U + kr + vcol); }
            f32x16 p0, p1;
#pragma unroll
            for (int r = 0; r < 16; ++r) { p0[r] = 0.f; p1[r] = 0.f; }
#pragma unroll
            for (int d0 = 0; d0 < 4; ++d0) {
                const bf16x8 k0 = *(const LAS bf16x8*)(Kb + cur + kf_off + d0 * 32);
                const bf16x8 k1 = *(const LAS bf16x8*)(Kb + cur + kf_off + 32 * AT_ROWB + d0 * 32);
                p0 = __builtin_amdgcn_mfma_f32_32x32x16_bf16(k0, qr[d0], p0, 0, 0, 0);
                p1 = __builtin_amdgcn_mfma_f32_32x32x16_bf16(k1, qr[d0], p1, 0, 0, 0);
            }
            if (MODE == 1 && ti >= 4) {
                const int kp0 = (lt_lo + ti - 4) * 64 + 4 * hi - tq;
#pragma unroll
                for (int r = 0; r < 16; ++r) { const int dl = kp0 + (r & 3) + 8 * (r >> 2);
                    if (dl > 128 || dl < -128) p0[r] = -INFINITY;
                    if (dl + 32 > 128 || dl + 32 < -128) p1[r] = -INFINITY; }
            }
            float mx = fmaxf(p0[0], p1[0]);
#pragma unroll
            for (int r = 1; r < 16; ++r) mx = fmaxf(mx, fmaxf(p0[r], p1[r]));
            mx = fmaxf(mx, shfl_xor_l(mx, 32, lane));
            const float mn = fmaxf(m, mx);
            const float alpha = exp2f(m - mn); m = mn;
            float rs = 0.f;
#pragma unroll
            for (int r = 0; r < 16; ++r) { p0[r] = exp2f(p0[r] - mn); p1[r] = exp2f(p1[r] - mn); rs += p0[r] + p1[r]; }
            lsum = lsum * alpha + rs;
#pragma unroll
            for (int r = 0; r < 16; ++r) { o0[r] *= alpha; o1[r] *= alpha; }
#pragma unroll
            for (int kb = 0; kb < 2; ++kb)
#pragma unroll
                for (int sx = 0; sx < 2; ++sx) {
                    u32x4 pw;
                    if (kb == 0) { pw.x = cvtpk(p0[8 * sx], p0[8 * sx + 1]); pw.y = cvtpk(p0[8 * sx + 2], p0[8 * sx + 3]); pw.z = cvtpk(p0[8 * sx + 4], p0[8 * sx + 5]); pw.w = cvtpk(p0[8 * sx + 6], p0[8 * sx + 7]); }
                    else         { pw.x = cvtpk(p1[8 * sx], p1[8 * sx + 1]); pw.y = cvtpk(p1[8 * sx + 2], p1[8 * sx + 3]); pw.z = cvtpk(p1[8 * sx + 4], p1[8 * sx + 5]); pw.w = cvtpk(p1[8 * sx + 6], p1[8 * sx + 7]); }
                    const bf16x8 pf = __builtin_bit_cast(bf16x8, pw);
                    const LAS unsigned char* vp = Vb + cur + vf_off + (kb * 32 + 16 * sx) * AT_ROWB;
#pragma unroll
                    for (int db = 0; db < 2; ++db) {
                        const v4i16_t lo4 = __builtin_amdgcn_ds_read_tr16_b64_v4i16((LAS v4i16_t*)(vp + db * 64));
                        const v4i16_t hi4 = __builtin_amdgcn_ds_read_tr16_b64_v4i16((LAS v4i16_t*)(vp + 8 * AT_ROWB + db * 64));
                        const bf16x8 vf = (bf16x8){lo4[0], lo4[1], lo4[2], lo4[3], hi4[0], hi4[1], hi4[2], hi4[3]};
                        if (db == 0) o0 = __builtin_amdgcn_mfma_f32_32x32x16_bf16(vf, pf, o0, 0, 0, 0);
                        else         o1 = __builtin_amdgcn_mfma_f32_32x32x16_bf16(vf, pf, o1, 0, 0, 0);
                    }
                }
            if (more) { *(LAS u32x4*)(Kb + nxt + st_off) = kw; *(LAS u32x4*)(Vb + nxt + st_off) = vw; }
            __syncthreads();
        }
        lsum += shfl_xor_l(lsum, 32, lane);
        if (winm) lsum += exp2f(P.sink[l * 8 + hq] * LOG2E - m);
        const float inv = 1.0f / lsum;
        bf16_t* op = (bf16_t*)(P.ws + WS_BR) + (size_t)qrow * NBR + (winm ? 1024 : 512) + hq * 64 + 4 * hi;
#pragma unroll
        for (int gq = 0; gq < 4; ++gq) {
            u32x2 w0, w1; w0.x = cvtpk(o0[4 * gq] * inv, o0[4 * gq + 1] * inv); w0.y = cvtpk(o0[4 * gq + 2] * inv, o0[4 * gq + 3] * inv);
            w1.x = cvtpk(o1[4 * gq] * inv, o1[4 * gq + 1] * inv); w1.y = cvtpk(o1[4 * gq + 2] * inv, o1[4 * gq + 3] * inv);
            *(u32x2*)(op + 8 * gq) = w0; *(u32x2*)(op + 32 + 8 * gq) = w1; }
    }
}

constexpr int DF_ROWB = 528;
template <int STAGE> __device__ __forceinline__ void ph_dft(const Frame& F, const Ptrs& P) {
    const int lane = fresh_lane(), tid = F.wave * 64 + lane, r32 = lane & 31, hi = lane >> 5, w = F.wave;
    bf16_t* U = (bf16_t*)(P.ws + WS_U); bf16_t* BR = (bf16_t*)(P.ws + WS_BR); const bf16_t* Wm = (const bf16_t*)(P.ws + WS_DFTM);
    LAS unsigned char* Xl = F.lds;
    const int xf_off = (8 * hi + ((lane & 15) >> 2)) * DF_ROWB + (32 * w + ((lane >> 4) & 1) * 16 + (lane & 3) * 4) * 2;
    constexpr int NMB = STAGE == 2 ? 4 : 2;
    for (int u = F.vcu; u < 1024; u += F.G) {
        const int chb = u & 1, sidx = (u >> 1) & 63, b = u >> 7;
        { const int seg = tid >> 2, part = tid & 3, pp = seg >> 6, j = seg & 63;
          const int grow = STAGE == 2 ? b * T + 64 * j + sidx : b * T + 64 * sidx + j;
          const u32x4* src = (const u32x4*)(U + (size_t)grow * NIN + pp * 512 + chb * 256 + part * 64);
          u32x4 v[8];
#pragma unroll
          for (int i = 0; i < 8; ++i) v[i] = src[i];
#pragma unroll
          for (int i = 0; i < 8; ++i) *(LAS u32x4*)(Xl + seg * DF_ROWB + part * 128 + i * 16) = v[i]; }
        __syncthreads();
        f32x16 acc[NMB];
#pragma unroll
        for (int mb = 0; mb < NMB; ++mb)
#pragma unroll
            for (int r = 0; r < 16; ++r) acc[mb][r] = 0.f;
#pragma unroll
        for (int ks = 0; ks < 8; ++ks) {
            const v4i16_t lo4 = __builtin_amdgcn_ds_read_tr16_b64_v4i16((LAS v4i16_t*)(Xl + xf_off + (16 * ks) * DF_ROWB));
            const v4i16_t hi4 = __builtin_amdgcn_ds_read_tr16_b64_v4i16((LAS v4i16_t*)(Xl + xf_off + (16 * ks + 4) * DF_ROWB));
            const bf16x8 xf = (bf16x8){lo4[0], lo4[1], lo4[2], lo4[3], hi4[0], hi4[1], hi4[2], hi4[3]};
#pragma unroll
            for (int mb = 0; mb < NMB; ++mb) { const bf16x8 wf = *(const bf16x8*)(Wm + (mb * 32 + r32) * 128 + 16 * ks + 8 * hi);
                acc[mb] = __builtin_amdgcn_mfma_f32_32x32x16_bf16(xf, wf, acc[mb], 0, 0, 0); }
        }
        LAS unsigned char* ob = Xl + (32 * w + 4 * hi) * 2;
        if (STAGE == 2) {
#pragma unroll
            for (int mb = 0; mb < 2; ++mb) { const int k1 = mb * 32 + r32; const float rev = (float)((k1 * sidx) & 4095) * (1.0f / 4096.0f);
                const float ct = __builtin_amdgcn_cosf(rev), st = __builtin_amdgcn_sinf(rev);
#pragma unroll
                for (int gq = 0; gq < 4; ++gq) { u32x2 wr, wi; float yr[4], yi[4];
#pragma unroll
                    for (int i = 0; i < 4; ++i) { const float a = acc[mb][4 * gq + i], bq = acc[mb + 2][4 * gq + i]; yr[i] = a * ct + bq * st; yi[i] = bq * ct - a * st; }
                    wr.x = cvtpk(yr[0], yr[1]); wr.y = cvtpk(yr[2], yr[3]); wi.x = cvtpk(yi[0], yi[1]); wi.y = cvtpk(yi[2], yi[3]);
                    *(LAS u32x2*)(ob + k1 * DF_ROWB + 16 * gq) = wr; *(LAS u32x2*)(ob + (64 + k1) * DF_ROWB + 16 * gq) = wi; } }
        } else {
#pragma unroll
            for (int mb = 0; mb < 2; ++mb) { const int k2 = mb * 32 + r32;
#pragma unroll
                for (int gq = 0; gq < 4; ++gq) { u32x2 wr; wr.x = cvtpk(acc[mb][4 * gq] * 0.015625f, acc[mb][4 * gq + 1] * 0.015625f); wr.y = cvtpk(acc[mb][4 * gq + 2] * 0.015625f, acc[mb][4 * gq + 3] * 0.015625f);
                    *(LAS u32x2*)(ob + k2 * DF_ROWB + 16 * gq) = wr; } }
        }
        __syncthreads();
        if (STAGE == 2) { const int seg = tid >> 2, part = tid & 3, pp = seg >> 6, j = seg & 63;
            u32x4* dst = (u32x4*)(U + (size_t)(b * T + 64 * j + sidx) * NIN + pp * 512 + chb * 256 + part * 64);
#pragma unroll
            for (int i = 0; i < 8; ++i) dst[i] = *(const LAS u32x4*)(Xl + seg * DF_ROWB + part * 128 + i * 16);
        } else { const int k2 = tid >> 3, part = tid & 7;
            u32x4* dst = (u32x4*)(BR + (size_t)(b * T + 64 * k2 + sidx) * NBR + chb * 256 + part * 32);
#pragma unroll
            for (int i = 0; i < 4; ++i) dst[i] = *(const LAS u32x4*)(Xl + k2 * DF_ROWB + part * 64 + i * 16); }
        __syncthreads();
    }
}

struct MegaArgs { Ptrs P; int ph_lo, ph_hi, li, pad; };
__global__ void __launch_bounds__(NWAVES * 64, 2) mega(MegaArgs args) {
    extern __shared__ __attribute__((aligned(16))) unsigned char lds_raw[];
    Frame F; F.lds = (LAS unsigned char*)lds_raw;
    F.wave = __builtin_amdgcn_readfirstlane(threadIdx.x >> 6);
    F.G = gridDim.x; { const int bx = blockIdx.x; F.vcu = (F.G % 8 == 0) ? (bx % 8) * (F.G / 8) + bx / 8 : bx; }
    const Ptrs& P = args.P;
    for (int u = fresh_tid(); u < (LDS_BYTES - LDSCTL_OFF) / 4; u += NWAVES * 64) ((LAS unsigned*)(F.lds + LDSCTL_OFF))[u] = 0u;
    __syncthreads();
    volatile LAS unsigned* MISC = (volatile LAS unsigned*)(F.lds + MISC_OFF);
    XcdBarrier bar = xcd_barrier_post((unsigned*)(P.ws + WS_CTL) + CW_BAR + args.li * XCD_BAR_WORDS, MISC + 8, F.wave);
    const int lo = args.ph_lo, hi = args.ph_hi;
    unsigned char* ws = P.ws;
    bf16_t* H = (bf16_t*)(ws + WS_H); bf16_t* U = (bf16_t*)(ws + WS_U); bf16_t* BR = (bf16_t*)(ws + WS_BR);
    bf16_t* GT = (bf16_t*)(ws + WS_GT); bf16_t* MG = (bf16_t*)(ws + WS_MG); bf16_t* AS = (bf16_t*)(ws + WS_AS); bf16_t* HID = (bf16_t*)(ws + WS_HID); bf16_t* MO = (bf16_t*)(ws + WS_MO);
    const bf16_t* Bt_in = (const bf16_t*)(ws + WS_WB + WB_IN); const bf16_t* Bt_gate = (const bf16_t*)(ws + WS_WB + WB_GATE); const bf16_t* Bt_br = (const bf16_t*)(ws + WS_WB + WB_BR);
    const bf16_t* Bt_out = (const bf16_t*)(ws + WS_WB + WB_OUT); const bf16_t* Bt_13 = (const bf16_t*)(ws + WS_WB + WB_13); const bf16_t* Bt_2 = (const bf16_t*)(ws + WS_WB + WB_2);
#define IN(g) (lo <= (g) && (g) < hi)
#define SEAM(g) do { if ((g) + 1 < hi) xcd_barrier(bar); } while (0)
    for (int l = 0; l < 2; ++l) {
        const int pb = l * NPH; const int M = l == 0 ? R : RL;
        if (IN(pb + 0)) { if (l == 0) ph_tables_mod(F, P); ph_weights(F, P, l); SEAM(pb + 0); }
        if (IN(pb + 1)) { if (l == 0) ph_norm<0>(F, P, l, R); else ph_norm<1>(F, P, l, R); SEAM(pb + 1); }
        if (IN(pb + 2)) {
            pg8::StaticOrder S; S.init(R, NIN, F.G, (int)blockIdx.x, H, D, Bt_in, D);
            pg8::EpiV8<FStore8> E{FStore8{U, NIN}};
            pg8::gemm_phase(F.lds, F.wave, D, D, D, S, E);
            SEAM(pb + 2);
        }
        if (IN(pb + 3)) { ph_qkprep(F, P, l); ph_pool(F, P, M); SEAM(pb + 3); }
        if (IN(pb + 4)) {
            ph_dft<2>(F, P); ph_attn<1>(F, P, l);
            if (l == 0) { ph_attn<2>(F, P, l); ph_attn<3>(F, P, l); ph_fourier_ref(F, P, TC, 0); }
            xcd_barrier(bar);
            ph_dft<3>(F, P); ph_attn<0>(F, P, l);
            SEAM(pb + 4);
        }
        for (int i = 0; i <= 4; ++i) {
            if (IN(pb + 5 + i)) {
                if (i >= 1) { const int j = i - 1;
                    pg8::StaticOrder S; S.init(M, D, F.G, (int)blockIdx.x, BR + j * 512, NBR, Bt_br + (size_t)j * 1024 * 512, 512);
                    pg8::EpiV8<FMerge8> E{FMerge8{MG, GT + (size_t)(j & 1) * R * D, j == 0}};
                    pg8::gemm_phase(F.lds, F.wave, NBR, 512, 512, S, E); }
                if (i <= 3) {
                    pg8::StaticOrder S; S.init(M, D, F.G, (int)blockIdx.x, H, D, Bt_gate + (size_t)i * 1024 * 1024, D);
                    pg8::EpiV8<FGate8> E{FGate8{GT + (size_t)(i & 1) * R * D, P.b_gate + ((size_t)l * 4 + i) * D}};
                    pg8::gemm_phase(F.lds, F.wave, D, D, D, S, E); }
                SEAM(pb + 5 + i);
            }
        }
        if (IN(pb + 10)) {
            pg8::StaticOrder S; S.init(M, D, F.G, (int)blockIdx.x, MG, D, Bt_out, D);
            pg8::EpiV4<EpiOut> E{EpiOut{P, l}};
            pg8::gemm_phase(F.lds, F.wave, D, D, D, S, E);
            SEAM(pb + 10);
        }
        if (IN(pb + 11)) { ph_norm<2>(F, P, l, M); SEAM(pb + 11); }
        if (IN(pb + 12)) { ph_gather(F, P, l, M); SEAM(pb + 12); }
        if (IN(pb + 13) || IN(pb + 14)) {
            LAS int* ptab = (LAS int*)(F.lds + LDSCTL_OFF);
            if (fresh_tid() == 0) { const unsigned* cnt = (const unsigned*)(ws + WS_CTL) + CW_CNT + 64 * l; int off = 0;
                for (int e = 0; e < 16; ++e) { ptab[e] = off; off += ((int)cnt[e] + 255) >> 8; } ptab[16] = off; }
            __syncthreads();
            if (IN(pb + 13)) {
                pg8::MoeOrder S; S.nN = 4; S.G = F.G; S.c = (int)blockIdx.x; S.A = (const char*)AS; S.Bt = (const char*)Bt_13; S.astep = (size_t)256 * D * 2; S.bstep = (size_t)256 * D * 2; S.bexp = (size_t)1024 * 1024 * 2; S.ptab = (const int*)ptab;
                pg8::EpiDual<FMoe1> E{FMoe1{HID}};
                pg8::gemm_phase(F.lds, F.wave, D, D, D, S, E);
                SEAM(pb + 13);
            }
            if (IN(pb + 14)) {
                pg8::MoeOrder S; S.nN = 4; S.G = F.G; S.c = (int)blockIdx.x; S.A = (const char*)HID; S.Bt = (const char*)Bt_2; S.astep = (size_t)256 * FF * 2; S.bstep = (size_t)256 * FF * 2; S.bexp = (size_t)1024 * 512 * 2; S.ptab = (const int*)ptab;
                pg8::EpiV8<FMoe2> E{FMoe2{MO, (const int*)(ws + WS_ROWMAP), (const float*)(ws + WS_ROWW)}};
                pg8::gemm_phase(F.lds, F.wave, FF, FF, FF, S, E);
                SEAM(pb + 14);
            }
        }
    }
    if (IN(PH_FINAL)) ph_final(F, P);
#undef IN
#undef SEAM
}

extern "C" void kernel_launch(void* const* d_in, const int* in_sizes, int n_in, void* d_out, int out_size, void* d_ws, size_t ws_size, hipStream_t stream) {
    if (n_in != 24 || ws_size < WS_END || out_size != RL * D) { fprintf(stderr, "kernel_launch: unexpected sizes n_in %d ws %zu out %d\n", n_in, ws_size, out_size); return; }
    static int grid = 0;
    if (grid == 0) {
        int dev = 0, cus = 0;
        if (hipGetDevice(&dev) != hipSuccess || hipDeviceGetAttribute(&cus, hipDeviceAttributeMultiprocessorCount, dev) != hipSuccess) { grid = -1; return; }
        if (hipFuncSetAttribute((const void*)mega, hipFuncAttributeMaxDynamicSharedMemorySize, LDS_BYTES) != hipSuccess) { fprintf(stderr, "kernel_launch: hipFuncSetAttribute failed\n"); grid = -1; return; }
        int per_cu = 0;
        if (hipOccupancyMaxActiveBlocksPerMultiprocessor(&per_cu, (const void*)mega, NWAVES * 64, LDS_BYTES) != hipSuccess || per_cu < 1) fprintf(stderr, "kernel_launch: occupancy query says %d\n", per_cu);
        (void)hipGetLastError();
        grid = cus;
    }
    if (grid < 0) return;
    MegaArgs a{};
    const float** pp = (const float**)&a.P;
    for (int i = 0; i < 24; ++i) pp[i] = (const float*)d_in[i];
    a.P.out = (float*)d_out; a.P.ws = (unsigned char*)d_ws;
    (void)hipMemsetAsync((unsigned char*)d_ws + WS_CTL, 0, 1 * MiB, stream);
    a.ph_lo = 0; a.ph_hi = PH_FINAL + 1; a.li = 0;
    hipLaunchKernelGGL(mega, dim3(grid), dim3(NWAVES * 64), LDS_BYTES, stream, a);
}
```

```cpp
#include <hip/hip_runtime.h>
#include <cstdio>
#include <cstdint>

typedef unsigned short bf16_t;
typedef short bf16x8 __attribute__((ext_vector_type(8)));
typedef float f32x4 __attribute__((ext_vector_type(4)));
typedef unsigned u32x4 __attribute__((ext_vector_type(4)));
typedef unsigned u32x2 __attribute__((ext_vector_type(2)));

constexpr int D = 1024, NB = 8, T = 4096, TC = 256;
constexpr int RL = NB * T, RC = NB * TC, R = RL + RC;
constexpr int NIN = 3072;
constexpr int C_ZR = 0, C_ZI = 512, C_P = 1024, C_QB = 1536, C_KB = 2048, C_VB = 2176, C_QW = 2304, C_KW = 2816, C_VW = 2944;
constexpr int NBR = 2048;
constexpr int NE = 16, FF = 512;
constexpr int MAXROWS = 73728;
constexpr float EPS = 1e-6f;
constexpr float QSCALE = 0.125f * 1.4426950408889634f;
constexpr float LOG2E = 1.4426950408889634f;

constexpr size_t MiB = 1u << 20;
constexpr size_t WS_CTL = 0;
constexpr size_t WS_MOD = 1 * MiB;
constexpr size_t WS_ROPE = 1 * MiB + 512 * 1024;
constexpr size_t WS_COS = WS_ROPE + 16 * 1024;
constexpr size_t WS_DFTM = WS_ROPE + 64 * 1024;
constexpr size_t WS_ROUTE = 2 * MiB;
constexpr size_t WS_ROWMAP = 3 * MiB;
constexpr size_t WS_ROWW = 3 * MiB + 512 * 1024;
constexpr size_t WS_XC = 9 * MiB;
constexpr size_t WS_WB = 17 * MiB;
constexpr size_t WB_IN = 0, WB_GATE = 6 * MiB, WB_BR = 14 * MiB, WB_OUT = 18 * MiB, WB_13 = 20 * MiB, WB_2 = 52 * MiB;
constexpr size_t WS_H = 85 * MiB;
constexpr size_t WS_ARENA = 153 * MiB;
constexpr size_t WS_U = WS_ARENA;
constexpr size_t WS_BR = WS_ARENA + 204 * MiB;
constexpr size_t WS_GT = WS_ARENA;
constexpr size_t WS_MG = WS_ARENA + 136 * MiB;
constexpr size_t WS_AS = WS_ARENA;
constexpr size_t WS_HID = WS_ARENA + 144 * MiB;
constexpr size_t WS_MO = WS_ARENA + 216 * MiB;
constexpr size_t WS_END = 512 * MiB;
static_assert(WS_BR + (size_t)R * NBR * 2 <= WS_END && WS_MO + (size_t)2 * R * D * 2 <= WS_END && WS_MG + (size_t)R * D * 2 <= WS_BR, "ws map");
constexpr int CW_CNT = 8192;

__device__ __forceinline__ float bf2f(bf16_t b) { return __uint_as_float(((unsigned)b) << 16); }
__device__ __forceinline__ unsigned f2bf(float f) { unsigned u = __float_as_uint(f); return (u + 0x7fffu + ((u >> 16) & 1u)) >> 16; }
__device__ __forceinline__ unsigned pk2(float lo, float hi) { return f2bf(lo) | (f2bf(hi) << 16); }
typedef __bf16 bf16x2_t __attribute__((ext_vector_type(2)));
typedef float f32x2_t __attribute__((ext_vector_type(2)));
__device__ __forceinline__ unsigned cvtpk(float lo, float hi) { f32x2_t v = {lo, hi}; bf16x2_t b = __builtin_convertvector(v, bf16x2_t); return __builtin_bit_cast(unsigned, b); }
__device__ __forceinline__ float lo16(unsigned w) { return __uint_as_float(w << 16); }
__device__ __forceinline__ float hi16(unsigned w) { return __uint_as_float(w & 0xffff0000u); }
__device__ __forceinline__ float shfl_xor_l(float v, int o, int lane) { return __int_as_float(__builtin_amdgcn_ds_bpermute((lane ^ o) << 2, __float_as_int(v))); }
__device__ __forceinline__ float wave_sum_l(float v, int lane) {
#pragma unroll
    for (int o = 1; o < 64; o <<= 1) v += shfl_xor_l(v, o, lane);
    return v;
}
__device__ __forceinline__ int row_bb(int r) { return r < RL ? (r >> 12) : 8; }

struct Ptrs {
    const float *x, *c, *ctx, *c_ctx, *w_ada, *b_ada, *norm1, *norm2, *w_in, *q_gain, *k_gain, *sink, *pool_w, *pool_scale,
        *w_branch, *w_gate, *b_gate, *w_out, *router_w, *router_bias, *w1, *w3, *w2, *norm_f;
    float* out; unsigned char* ws;
};
__device__ __forceinline__ const float* xin_row(const Ptrs& P, int r) { return r < RL ? P.x + (size_t)r * D : P.ctx + (size_t)(r - RL) * D; }
__device__ __forceinline__ float* x1_row(const Ptrs& P, int r) { return r < RL ? P.out + (size_t)r * D : (float*)(P.ws + WS_XC) + (size_t)(r - RL) * D; }
__device__ __forceinline__ const float* mod_vec(const Ptrs& P, int l, int bb, int which) { return (const float*)(P.ws + WS_MOD) + ((size_t)(l * 9 + bb) * 6 + which) * D; }

struct EpiOut { Ptrs P; int l;
    __device__ __forceinline__ void operator()(int row, int col, f32x4 v) const { const int bb = row_bb(row);
        const f32x4 g = *(const f32x4*)(mod_vec(P, l, bb, 2) + col); float* xo = x1_row(P, row) + col;
        const f32x4 xp = l == 0 ? *(const f32x4*)(xin_row(P, row) + col) : *(const f32x4*)xo;
        *(f32x4*)xo = xp + g * v; } };

#define LAS __attribute__((address_space(3)))
#define GAS __attribute__((address_space(1)))
#define LDS_WAIT() asm volatile("s_waitcnt lgkmcnt(0)" ::: "memory")
__device__ __forceinline__ int fresh_lane() { int l; asm volatile("v_mbcnt_lo_u32_b32 %0, -1, 0\n\tv_mbcnt_hi_u32_b32 %0, -1, %0" : "=v"(l)); return l; }
constexpr int NWAVES = 8;
constexpr int RING_BYTES = 131072, LDSCTL_OFF = RING_BYTES, MISC_OFF = LDSCTL_OFF + 320, LDS_BYTES = 147456;
constexpr int CW_BAR = 16384;
constexpr int NPH = 15, PH_FINAL = 2 * NPH;

#define XB_TMO      128
#define XB_XCNT(j)  (256  + 64 * (j))
#define XB_XSUB(j)  (1280 + 64 * (j))
#define XB_XGEN(j)  (2304 + 64 * (j))
#define XB_TOP      3328
#define XB_TOPGEN   3392
#define XCD_BAR_WORDS 3456
#define XB_SPIN_CAP (1u << 21)
__device__ __forceinline__ unsigned xb_ld(unsigned* p)              { return __hip_atomic_load(p, __ATOMIC_RELAXED, __HIP_MEMORY_SCOPE_AGENT); }
__device__ __forceinline__ unsigned xb_add(unsigned* p, unsigned v) { return __hip_atomic_fetch_add(p, v, __ATOMIC_RELAXED, __HIP_MEMORY_SCOPE_AGENT); }
__device__ __forceinline__ unsigned xb_xcc_id() { return (unsigned)__builtin_amdgcn_s_getreg((3 << 11) | 20) & 0xFu; }
#define XB_SPIN(cond, bar) do { unsigned _sp = 0; while (cond) { __builtin_amdgcn_s_sleep(1); \
    if ((++_sp & 255u) == 0u) { if (xb_ld(&(bar)[XB_TMO])) break; if (_sp > XB_SPIN_CAP) { atomicAdd(&(bar)[XB_TMO], 1u); break; } } } } while (0)
struct XcdBarrier { unsigned* bar; unsigned x; volatile LAS unsigned* st; int wave; };
__device__ __forceinline__ XcdBarrier xcd_barrier_post(unsigned* bar, volatile LAS unsigned* st, int wave) {
    XcdBarrier b; b.bar = bar; b.x = xb_xcc_id(); b.st = st; b.wave = wave;
    if (wave == 0 && fresh_lane() == 0) (void)xb_add(&bar[XB_XCNT(b.x)], 1u);
    return b;
}
__device__ __forceinline__ void xcd_barrier_complete(unsigned* bar, unsigned x, unsigned& nloc, unsigned& nx) {
    const unsigned G = gridDim.x * gridDim.y * gridDim.z;
    unsigned sum, cnt, mine, sp = 0u;
    for (;;) {
        sum = 0u; cnt = 0u; mine = 0u;
#pragma unroll
        for (unsigned j = 0; j < 16; ++j) { const unsigned c = xb_ld(&bar[XB_XCNT(j)]); sum += c; cnt += (c > 0u) ? 1u : 0u; mine = (j == x) ? c : mine; }
        if (sum == G) break;
        __builtin_amdgcn_s_sleep(1);
        if ((++sp & 255u) == 0u) { if (xb_ld(&bar[XB_TMO])) break; if (sp > XB_SPIN_CAP) { atomicAdd(&bar[XB_TMO], 1u); break; } }
    }
    nloc = mine > 0u ? mine : 1u; nx = cnt > 0u ? cnt : 1u;
}
__device__ __forceinline__ void xcd_barrier(const XcdBarrier& b) {
    asm volatile("s_waitcnt vmcnt(0)" ::: "memory");
    __syncthreads();
    if (b.wave == 0 && fresh_lane() == 0) {
        unsigned* bar = b.bar;
        __builtin_amdgcn_s_waitcnt(0);
        unsigned nloc = b.st[0], nx = b.st[1];
        if (nloc == 0u) { xcd_barrier_complete(bar, b.x, nloc, nx); b.st[0] = nloc; b.st[1] = nx; }
        const unsigned old = xb_add(&bar[XB_XSUB(b.x)], 1u);
        const unsigned gen = old / nloc;
        if (old + 1u == (gen + 1u) * nloc) {
            __builtin_amdgcn_fence(__ATOMIC_RELEASE, "agent");
            asm volatile("s_waitcnt vmcnt(0)" ::: "memory");
            const unsigned og = xb_add(&bar[XB_TOP], 1u);
            const unsigned tg = og / nx;
            if (og + 1u == (tg + 1u) * nx) xb_add(&bar[XB_TOPGEN], 1u);
            else XB_SPIN(xb_ld(&bar[XB_TOPGEN]) == tg, bar);
            __builtin_amdgcn_fence(__ATOMIC_ACQUIRE, "agent");
            xb_add(&bar[XB_XGEN(b.x)], 1u);
            asm volatile("s_waitcnt vmcnt(0)" ::: "memory");
        } else {
            XB_SPIN(xb_ld(&bar[XB_XGEN(b.x)]) == gen, bar);
            __builtin_amdgcn_fence(__ATOMIC_ACQUIRE, "agent");
            asm volatile("s_waitcnt vmcnt(0)" ::: "memory");
        }
    }
    __syncthreads();
}

namespace pg8 {
constexpr int BM = 256, BK = 64, HALF = 128, HTB = HALF * BK * 2, STAGE_BYTES = 8 * HTB, NXCD = 8, WGM = 8;
__host__ __device__ __forceinline__ int lds_byte(int r, int c) { const int st = (r >> 4) * 2 + (c >> 5), rr = r & 15, cc = c & 31, ob = rr * 64 + cc * 2; return st * 1024 + (ob ^ (((ob >> 9) & 1) << 5)); }
__host__ __device__ __forceinline__ void stage_rc(int b, int& Rr, int& C) { const int st = b / 1024, sb = b % 1024, swz = sb ^ (((sb >> 9) & 1) << 5); Rr = (st >> 1) * 16 + swz / 64; C = (st & 1) * 32 + (swz % 64) / 2; }
__host__ __device__ __forceinline__ int perm32(int rho) { const int n = rho >> 4, i = rho & 15; return 8 * (i >> 2) + 4 * n + (i & 3); }
struct Unit { int pm, pn; const char* a; const char* b; };

struct StaticOrder {
    int nM, nN, nwg, G, c; const char* A; const char* Bt; size_t astep, bstep;
    __device__ void init(int M, int N, int G_, int c_, const bf16_t* A_, int lda, const bf16_t* Bt_, int ldb) { nM = M / BM; nN = N / BM; nwg = nM * nN; G = G_; c = c_; A = (const char*)A_; Bt = (const char*)Bt_; astep = (size_t)BM * lda * 2; bstep = (size_t)BM * ldb * 2; }
    __device__ bool next(int i, Unit& u) const {
        const long L = (long)i * G + c; if (L >= nwg) return false;
        int wgid = (int)L; { const int q = nwg / NXCD, r = nwg % NXCD, xcd = wgid % NXCD, off = wgid / NXCD; wgid = (xcd < r ? xcd * (q + 1) : r * (q + 1) + (xcd - r) * q) + off; }
        const int nig = WGM * nN, gid = wgid / nig, fm = gid * WGM, gsz = (nM - fm) < WGM ? (nM - fm) : WGM;
        u.pm = fm + ((wgid % nig) % gsz); u.pn = (wgid % nig) / gsz; u.a = A + (size_t)u.pm * astep; u.b = Bt + (size_t)u.pn * bstep; return true;
    }
};
struct MoeOrder {
    int nN, G, c; const char* A; const char* Bt; size_t astep, bstep, bexp; const int* ptab;
    __device__ bool next(int i, Unit& u) const {
        const int L = i * G + c; const int total = ptab[16] * nN; if (L >= total) return false;
        u.pm = L / nN; u.pn = L % nN; int e = 0;
#pragma unroll
        for (int q = 1; q < 16; ++q) e += (u.pm >= ptab[q]) ? 1 : 0;
        u.a = A + (size_t)u.pm * astep; u.b = Bt + (size_t)e * bexp + (size_t)u.pn * bstep; return true;
    }
};

template <class Epi, class Sched, bool ALIGN_EPI = true, bool SP2 = true>
__device__ __forceinline__ void gemm_phase(LAS unsigned char* lds, const int wid, const int lda, const int ldb, const int K, const Sched& S, const Epi& E) {
    const int lane = fresh_lane(), tid = wid * 64 + lane, wr = wid >> 2, wc = wid & 3, fr = lane & 15, fq = lane >> 4;
    const int nt = K / BK;
    unsigned voffA[2], voffB[2];
#pragma unroll
    for (int i = 0; i < 2; ++i) { int Rr, C; stage_rc(tid * 16 + i * 8192, Rr, C); const int Rb = Epi::PERM ? ((Rr & ~31) + perm32(Rr & 31)) : Rr;
        voffA[i] = (unsigned)(Rr * lda + C) * 2u; voffB[i] = (unsigned)(Rb * ldb + C) * 2u; }
    const size_t kstep = (size_t)(BK * 2);
    const size_t hstepA = (size_t)HALF * lda * 2, hstepB = (size_t)HALF * ldb * 2;
    const unsigned ldsw = (unsigned)wid * 1024u;
    const int aoff = lds_byte(wr * 64 + fr, fq * 8), boff = lds_byte(wc * 32 + fr, fq * 8);
#define PG8_SA(b, h) (((b) * 2 + (h)) * HTB)
#define PG8_SB(b, h) ((4 + (b) * 2 + (h)) * HTB)
#define PG8_STAGE(bufoff, gbase, voff) do { _Pragma("unroll") for (int _i = 0; _i < 2; ++_i) \
        __builtin_amdgcn_global_load_lds((const unsigned*)((const char*)(gbase) + (voff)[_i]), (LAS unsigned*)(lds + (bufoff) + ldsw + _i * 8192), 16, 0, 0); } while (0)
#define PG8_LDA(dst, b, h) do { _Pragma("unroll") for (int m = 0; m < 4; ++m) _Pragma("unroll") for (int k = 0; k < 2; ++k) dst[m][k] = *(const LAS bf16x8*)(lds + PG8_SA(b, h) + aoff + m * 2048 + k * 1024); } while (0)
#define PG8_LDB(dst, b, h) do { _Pragma("unroll") for (int n = 0; n < 2; ++n) _Pragma("unroll") for (int k = 0; k < 2; ++k) dst[n][k] = *(const LAS bf16x8*)(lds + PG8_SB(b, h) + boff + n * 2048 + k * 1024); } while (0)
#define PG8_MMA(ai, bj, At, Bt) do { __builtin_amdgcn_s_setprio(1); _Pragma("unroll") for (int m = 0; m < 4; ++m) _Pragma("unroll") for (int n = 0; n < 2; ++n) _Pragma("unroll") for (int k = 0; k < 2; ++k) \
        acc[ai][bj][m][n] = __builtin_amdgcn_mfma_f32_16x16x32_bf16(Bt[n][k], At[m][k], acc[ai][bj][m][n], 0, 0, 0); __builtin_amdgcn_s_setprio(0); } while (0)
#define PG8_WAIT_V(n) asm volatile("s_waitcnt vmcnt(" #n ")" ::: "memory")
#define PG8_WAIT_L(n) asm volatile("s_waitcnt lgkmcnt(" #n ")" ::: "memory")
#define PG8_BAR __builtin_amdgcn_s_barrier()
#define PG8_SCHED __builtin_amdgcn_sched_barrier(0)
    Unit cur, nxt; int ui = 0;
    if (!S.next(0, cur)) return;
    f32x4 acc[2][2][4][2];
#pragma unroll
    for (int a = 0; a < 2; ++a)
#pragma unroll
        for (int b = 0; b < 2; ++b)
#pragma unroll
            for (int m = 0; m < 4; ++m)
#pragma unroll
                for (int n = 0; n < 2; ++n) acc[a][b][m][n] = (f32x4){0.f, 0.f, 0.f, 0.f};
    bf16x8 At[4][2], B0[2][2], B1[2][2];
    const char* cA = cur.a; const char* cB = cur.b;
    if constexpr (SP2) {
        PG8_STAGE(PG8_SB(0, 0), cB, voffB); PG8_STAGE(PG8_SB(0, 1), cB + hstepB, voffB); PG8_STAGE(PG8_SA(0, 0), cA, voffA); PG8_STAGE(PG8_SA(0, 1), cA + hstepA, voffA);
        if (wr == 1) PG8_BAR;
        PG8_WAIT_V(2); PG8_BAR;
        PG8_STAGE(PG8_SB(1, 0), cB + kstep, voffB); PG8_STAGE(PG8_SA(1, 0), cA + kstep, voffA); PG8_STAGE(PG8_SB(1, 1), cB + hstepB + kstep, voffB);
        PG8_WAIT_V(6); PG8_BAR;
    } else {
        PG8_STAGE(PG8_SB(0, 0), cB, voffB); PG8_STAGE(PG8_SA(0, 0), cA, voffA); PG8_STAGE(PG8_SB(0, 1), cB + hstepB, voffB); PG8_STAGE(PG8_SA(0, 1), cA + hstepA, voffA);
        if (wr == 1) PG8_BAR;
        PG8_WAIT_V(4); PG8_BAR;
        PG8_STAGE(PG8_SB(1, 0), cB + kstep, voffB); PG8_STAGE(PG8_SA(1, 0), cA + kstep, voffA); PG8_STAGE(PG8_SB(1, 1), cB + hstepB + kstep, voffB);
        PG8_WAIT_V(6); PG8_BAR;
    }
    for (;;) {
        const bool has_next = S.next(ui + 1, nxt);
        const char* nA = has_next ? nxt.a : cA; const char* nB = has_next ? nxt.b : cB;
        for (int t = 0; t < nt; t += 2) {
            const bool last = (t == nt - 2);
            const char* a1 = cA + (size_t)(t + 1) * kstep;
            const char* a2 = last ? nA : cA + (size_t)(t + 2) * kstep; const char* b2 = last ? nB : cB + (size_t)(t + 2) * kstep;
            const char* a3 = a2 + kstep; const char* b3 = b2 + kstep;
            if constexpr (SP2) {
            PG8_LDB(B0, 0, 0); PG8_LDB(B1, 0, 1); PG8_SCHED; PG8_LDA(At, 0, 0); PG8_STAGE(PG8_SA(1, 1), a1 + hstepA, voffA);
            PG8_WAIT_V(8); PG8_WAIT_L(0); PG8_BAR; PG8_MMA(0, 0, At, B0); PG8_MMA(0, 1, At, B1); PG8_BAR; PG8_SCHED;
            PG8_LDA(At, 0, 1); PG8_STAGE(PG8_SB(0, 0), b2, voffB); PG8_STAGE(PG8_SB(0, 1), b2 + hstepB, voffB); PG8_STAGE(PG8_SA(0, 0), a2, voffA);
            PG8_WAIT_V(8); PG8_WAIT_L(0); PG8_BAR; PG8_MMA(1, 0, At, B0); PG8_MMA(1, 1, At, B1); PG8_BAR; PG8_SCHED;
            PG8_LDB(B0, 1, 0); PG8_LDB(B1, 1, 1); PG8_SCHED; PG8_LDA(At, 1, 0); PG8_STAGE(PG8_SA(0, 1), a2 + hstepA, voffA);
            PG8_WAIT_V(8); PG8_WAIT_L(0); PG8_BAR; PG8_MMA(0, 0, At, B0); PG8_MMA(0, 1, At, B1); PG8_BAR; PG8_SCHED;
            PG8_LDA(At, 1, 1); PG8_STAGE(PG8_SB(1, 0), b3, voffB); PG8_STAGE(PG8_SB(1, 1), b3 + hstepB, voffB); PG8_STAGE(PG8_SA(1, 0), a3, voffA);
            PG8_WAIT_V(8); PG8_WAIT_L(0); PG8_BAR; PG8_MMA(1, 0, At, B0); PG8_MMA(1, 1, At, B1); PG8_BAR; PG8_SCHED;
            } else {
            PG8_LDB(B0, 0, 0); PG8_SCHED; PG8_LDA(At, 0, 0); PG8_STAGE(PG8_SA(1, 1), a1 + hstepA, voffA);
            PG8_WAIT_L(8); PG8_BAR; PG8_WAIT_L(0); PG8_MMA(0, 0, At, B0); PG8_BAR; PG8_SCHED;
            PG8_LDB(B1, 0, 1); PG8_STAGE(PG8_SB(0, 0), b2, voffB);
            PG8_BAR; PG8_WAIT_L(0); PG8_MMA(0, 1, At, B1); PG8_BAR;
            PG8_LDA(At, 0, 1); PG8_STAGE(PG8_SA(0, 0), a2, voffA);
            PG8_BAR; PG8_WAIT_L(0); PG8_MMA(1, 0, At, B0); PG8_BAR; PG8_SCHED;
            PG8_STAGE(PG8_SB(0, 1), b2 + hstepB, voffB);
            PG8_WAIT_V(6); PG8_BAR; PG8_MMA(1, 1, At, B1); PG8_BAR;
            PG8_LDB(B0, 1, 0); PG8_SCHED; PG8_LDA(At, 1, 0); PG8_STAGE(PG8_SA(0, 1), a2 + hstepA, voffA);
            PG8_WAIT_L(8); PG8_BAR; PG8_WAIT_L(0); PG8_MMA(0, 0, At, B0); PG8_BAR; PG8_SCHED;
            PG8_LDB(B1, 1, 1); PG8_STAGE(PG8_SB(1, 0), b3, voffB);
            PG8_BAR; PG8_WAIT_L(0); PG8_MMA(0, 1, At, B1); PG8_BAR;
            PG8_LDA(At, 1, 1); PG8_STAGE(PG8_SA(1, 0), a3, voffA);
            PG8_BAR; PG8_WAIT_L(0); PG8_MMA(1, 0, At, B0); PG8_BAR; PG8_SCHED;
            PG8_STAGE(PG8_SB(1, 1), b3 + hstepB, voffB);
            PG8_WAIT_V(6); PG8_BAR; PG8_MMA(1, 1, At, B1); PG8_BAR;
            }
        }
        if constexpr (ALIGN_EPI) { if (wr == 0) PG8_BAR; }
        E(acc, cur, wr, wc, fr, fq);
        if (!has_next) break;
#pragma unroll
        for (int a = 0; a < 2; ++a)
#pragma unroll
            for (int b = 0; b < 2; ++b)
#pragma unroll
                for (int m = 0; m < 4; ++m)
#pragma unroll
                    for (int n = 0; n < 2; ++n) acc[a][b][m][n] = (f32x4){0.f, 0.f, 0.f, 0.f};
        cur = nxt; cA = nA; cB = nB; ++ui;
        if constexpr (ALIGN_EPI) { if (wr == 1) PG8_BAR; }
    }
    PG8_WAIT_V(0);
    if constexpr (!ALIGN_EPI) { if (wr == 0) PG8_BAR; }
    PG8_BAR;
#undef PG8_SA
#undef PG8_SB
#undef PG8_STAGE
#undef PG8_LDA
#undef PG8_LDB
#undef PG8_MMA
#undef PG8_WAIT_V
#undef PG8_WAIT_L
#undef PG8_BAR
#undef PG8_SCHED
}
template <class F> struct EpiV4 { static constexpr bool PERM = false; F f;
    __device__ __forceinline__ void operator()(const f32x4 (&acc)[2][2][4][2], const Unit& u, int wr, int wc, int fr, int fq) const {
        const int row0 = u.pm * BM + wr * 64 + fr, col0 = u.pn * BM + wc * 32 + 4 * fq;
#pragma unroll
        for (int ai = 0; ai < 2; ++ai)
#pragma unroll
            for (int m = 0; m < 4; ++m) {
#pragma unroll
                for (int bj = 0; bj < 2; ++bj)
#pragma unroll
                    for (int n = 0; n < 2; ++n) f(row0 + ai * HALF + m * 16, col0 + bj * HALF + n * 16, acc[ai][bj][m][n]);
                asm volatile("" ::: "memory"); }
    } };
template <class F> struct EpiV8 { static constexpr bool PERM = true; F f;
    __device__ __forceinline__ void operator()(const f32x4 (&acc)[2][2][4][2], const Unit& u, int wr, int wc, int fr, int fq) const {
        const int row0 = u.pm * BM + wr * 64 + fr, col0 = u.pn * BM + wc * 32 + 8 * fq;
#pragma unroll
        for (int ai = 0; ai < 2; ++ai)
#pragma unroll
            for (int m = 0; m < 4; ++m) {
#pragma unroll
                for (int bj = 0; bj < 2; ++bj) f.apply8(row0 + ai * HALF + m * 16, col0 + bj * HALF, acc[ai][bj][m][0], acc[ai][bj][m][1]);
                asm volatile("" ::: "memory"); }
    } };
template <class F> struct EpiDual { static constexpr bool PERM = true; F f;
    __device__ __forceinline__ void operator()(const f32x4 (&acc)[2][2][4][2], const Unit& u, int wr, int wc, int fr, int fq) const {
        const int row0 = u.pm * BM + wr * 64 + fr, hc0 = u.pn * HALF + wc * 32 + 8 * fq;
#pragma unroll
        for (int ai = 0; ai < 2; ++ai)
#pragma unroll
            for (int m = 0; m < 4; ++m) f.apply8(row0 + ai * HALF + m * 16, hc0, acc[ai][0][m][0], acc[ai][0][m][1], acc[ai][1][m][0], acc[ai][1][m][1]);
    } };
}

__device__ __forceinline__ u32x4 pack8(f32x4 a, f32x4 b) { u32x4 w; w.x = pk2(a.x, a.y); w.y = pk2(a.z, a.w); w.z = pk2(b.x, b.y); w.w = pk2(b.z, b.w); return w; }
__device__ __forceinline__ f32x4 sigm4(f32x4 v) { f32x4 r; r.x = 1.f / (1.f + __expf(-v.x)); r.y = 1.f / (1.f + __expf(-v.y)); r.z = 1.f / (1.f + __expf(-v.z)); r.w = 1.f / (1.f + __expf(-v.w)); return r; }
struct FStore8 { bf16_t* C; int ldc;
    __device__ __forceinline__ void apply8(int row, int col, f32x4 a, f32x4 b) const { *(u32x4*)(C + (size_t)row * ldc + col) = pack8(a, b); } };
struct FGate8 { bf16_t* G; const float* bias;
    __device__ __forceinline__ void apply8(int row, int col, f32x4 a, f32x4 b) const { const f32x4 b0 = *(const f32x4*)(bias + col), b1 = *(const f32x4*)(bias + col + 4);
        *(u32x4*)(G + (size_t)row * D + col) = pack8(sigm4(a + b0), sigm4(b + b1)); } };
struct FMerge8 { bf16_t* MG; const bf16_t* G; int first;
    __device__ __forceinline__ void apply8(int row, int col, f32x4 a, f32x4 b) const { const size_t o = (size_t)row * D + col; const u32x4 g = *(const u32x4*)(G + o);
        a = a * (f32x4){lo16(g.x), hi16(g.x), lo16(g.y), hi16(g.y)}; b = b * (f32x4){lo16(g.z), hi16(g.z), lo16(g.w), hi16(g.w)};
        if (!first) { const u32x4 p = *(const u32x4*)(MG + o); a += (f32x4){lo16(p.x), hi16(p.x), lo16(p.y), hi16(p.y)}; b += (f32x4){lo16(p.z), hi16(p.z), lo16(p.w), hi16(p.w)}; }
        *(u32x4*)(MG + o) = pack8(a, b); } };
struct FMoe1 { bf16_t* HID;
    __device__ __forceinline__ void apply8(int row, int hc, f32x4 a0, f32x4 a1, f32x4 b0, f32x4 b1) const {
        *(u32x4*)(HID + (size_t)row * FF + hc) = pack8(a0 * sigm4(a0) * b0, a1 * sigm4(a1) * b1); } };
struct FMoe2 { bf16_t* MO; const int* rowmap; const float* roww;
    __device__ __forceinline__ void apply8(int row, int col, f32x4 a, f32x4 b) const { const int t = rowmap[row]; if (t < 0) return; const float w = roww[row];
        *(u32x4*)(MO + ((size_t)(t & 1) * R + (t >> 1)) * D + col) = pack8(a * w, b * w); } };

struct Frame { LAS unsigned char* lds; int wave, vcu, G; };
#define fresh_tid() (F.wave * 64 + fresh_lane())
__device__ __forceinline__ void tr_item(const float* W, int ldw, int k0, int csrc0, bf16_t* WT, int ldt, int drow0, LAS float* scr, int lane) {
#pragma unroll 8
    for (int i = 0; i < 32; ++i) { const int kk = 2 * i + (lane >> 5); scr[kk * 33 + (lane & 31)] = W[(size_t)(k0 + kk) * ldw + csrc0 + (lane & 31)]; }
    LDS_WAIT(); asm volatile("" ::: "memory");
    const int c = lane & 7;
#pragma unroll
    for (int j = 0; j < 4; ++j) { const int n = (lane >> 3) + 8 * j; const LAS float* s = scr + (8 * c) * 33 + n;
        u32x4 o; o.x = pk2(s[0 * 33], s[1 * 33]); o.y = pk2(s[2 * 33], s[3 * 33]); o.z = pk2(s[4 * 33], s[5 * 33]); o.w = pk2(s[6 * 33], s[7 * 33]);
        *(u32x4*)(WT + (size_t)(drow0 + n) * ldt + k0 + 8 * c) = o; }
    LDS_WAIT(); asm volatile("" ::: "memory");
}
__device__ __forceinline__ void ph_weights(const Frame& F, const Ptrs& P, int l) {
    const int tid0 = fresh_tid(), lane0 = tid0 & 63;
    LAS float* scr = (LAS float*)(F.lds + F.wave * 16384);
    const int gw = F.vcu * NWAVES + F.wave, NGW = F.G * NWAVES;
    unsigned char* wb = P.ws + WS_WB;
    constexpr int I0 = 1024, I1 = I0 + 2048, I2 = I1 + 768, I3 = I2 + 512, I4 = I3 + 4096, I5 = I4 + 4096, I6 = I5 + 4096;
    for (int it = gw; it < I6; it += NGW) {
        if (it < I0) { const int kb = it >> 6, nb = it & 63; tr_item(P.w_in + (size_t)l * 1024 * 2560, 2560, kb * 64, 512 + nb * 32, (bf16_t*)(wb + WB_IN), 1024, 1024 + nb * 32, scr, lane0); }
        else if (it < I1) { const int r = it - I0, i = r >> 9, q = r & 511, kb = q >> 5, nb = q & 31; tr_item(P.w_gate + ((size_t)l * 4 + i) * 1024 * 1024, 1024, kb * 64, nb * 32, (bf16_t*)(wb + WB_GATE) + (size_t)i * 1024 * 1024, 1024, nb * 32, scr, lane0); }
        else if (it < I2) { const int r = it - I1, i = r >> 8, q = r & 255, kb = q >> 5, nb = q & 31; tr_item(P.w_branch + ((size_t)l * 4 + i) * 512 * 1024, 1024, kb * 64, nb * 32, (bf16_t*)(wb + WB_BR) + (size_t)i * 1024 * 512, 512, nb * 32, scr, lane0); }
        else if (it < I3) { const int q = it - I2, kb = q >> 5, nb = q & 31; tr_item(P.w_out + (size_t)l * 1024 * 1024, 1024, kb * 64, nb * 32, (bf16_t*)(wb + WB_OUT), 1024, nb * 32, scr, lane0); }
        else if (it < I5) { const int w3 = it >= I4; const int r = it - (w3 ? I4 : I3), e = r >> 8, q = r & 255, kb = q >> 4, nb = q & 15, c = nb * 32;
            tr_item((w3 ? P.w3 : P.w1) + ((size_t)l * 16 + e) * 1024 * 512, 512, kb * 64, c, (bf16_t*)(wb + WB_13) + (size_t)e * 1024 * 1024, 1024, 256 * (c >> 7) + (c & 127) + (w3 ? 128 : 0), scr, lane0); }
        else { const int r = it - I5, e = r >> 8, q = r & 255, kb = q >> 5, nb = q & 31; tr_item(P.w2 + ((size_t)l * 16 + e) * 512 * 1024, 1024, kb * 64, nb * 32, (bf16_t*)(wb + WB_2) + (size_t)e * 1024 * 512, 512, nb * 32, scr, lane0); }
    }
    __syncthreads();
    for (int u = F.vcu; u < 64; u += F.G) {
        LAS float* Wl = (LAS float*)F.lds; LAS float* ct = Wl + 64 * 128;
        const int kt = u >> 2, g = u & 3, k0 = kt * 64, tid = tid0; const float* w_in = P.w_in + (size_t)l * 1024 * 2560;
        if (tid < 128) ct[tid] = __builtin_amdgcn_cosf((float)tid * (1.0f / 128.0f));
        for (int i = tid; i < 64 * 128; i += 512) { const int k = i >> 7, c = i & 127; Wl[k * 128 + c] = w_in[(size_t)(k0 + k) * 2560 + g * 128 + c]; }
        __syncthreads();
        const int part = (tid >> 7) & 1, m = tid & 127, kh = tid >> 8; const float sc = 0.08838834764831845f;
        bf16_t* drow = (bf16_t*)(wb + WB_IN) + (size_t)(part * 512 + g * 128 + m) * 1024 + k0;
        for (int kb = kh * 32; kb < kh * 32 + 32; kb += 8) { float acc[8];
#pragma unroll
            for (int j = 0; j < 8; ++j) acc[j] = 0.f;
            for (int c = 0; c < 128; ++c) { const int idx = (c * m) & 127; const float tw = part ? -ct[(idx - 32) & 127] : ct[idx];
#pragma unroll
                for (int j = 0; j < 8; ++j) acc[j] += Wl[(kb + j) * 128 + c] * tw; }
            u32x4 o; o.x = pk2(acc[0] * sc, acc[1] * sc); o.y = pk2(acc[2] * sc, acc[3] * sc); o.z = pk2(acc[4] * sc, acc[5] * sc); o.w = pk2(acc[6] * sc, acc[7] * sc);
            *(u32x4*)(drow + kb) = o; }
        __syncthreads();
    }
    for (int u = F.G - 1 - F.vcu; u < 64; u += F.G) {
        LAS float* Wb = (LAS float*)F.lds;
        const int g = u >> 4, n0 = (u & 15) * 64, tid = tid0;
        const float* ps = P.pool_scale + (size_t)l * 512; const float* wb3 = P.w_branch + ((size_t)l * 4 + 3) * 512 * 1024; const float* pwl = P.pool_w + (size_t)l * 4 * 128 * 128;
        for (int i = tid; i < 128 * 64; i += 512) { const int e = i >> 6, n = i & 63; Wb[e * 64 + n] = ps[g * 128 + e] * wb3[(size_t)(g * 128 + e) * 1024 + n0 + n]; }
        __syncthreads();
        const int c = tid & 127, nh = tid >> 7; const float* pw = pwl + (size_t)(g * 128 + c) * 128;
        float acc[16];
#pragma unroll
        for (int j = 0; j < 16; ++j) acc[j] = 0.f;
        for (int e = 0; e < 128; ++e) { const float p = pw[e];
#pragma unroll
            for (int j = 0; j < 16; ++j) acc[j] += p * Wb[e * 64 + nh * 16 + j]; }
        bf16_t* Bt = (bf16_t*)(wb + WB_BR) + (size_t)3 * 1024 * 512;
#pragma unroll
        for (int j = 0; j < 16; ++j) Bt[(size_t)(n0 + nh * 16 + j) * 512 + g * 128 + c] = (bf16_t)f2bf(acc[j]);
        __syncthreads();
    }
}
__device__ __forceinline__ void ph_tables_mod(const Frame& F, const Ptrs& P) {
    const int tid0 = fresh_tid();
    { float* rc = (float*)(P.ws + WS_ROPE); float* rs = rc + 1024; float* ct = (float*)(P.ws + WS_COS);
      const int i = F.vcu * 512 + tid0;
      if (i < 1024) { const int pos = i >> 4, f = i & 15; const float inv = exp2f(-(float)f * (13.287712379549449f / 16.0f));
          float rev = (float)pos * inv * 0.15915494309189535f; rev = rev - floorf(rev);
          rc[i] = __builtin_amdgcn_cosf(rev); rs[i] = __builtin_amdgcn_sinf(rev); }
      if (i < 4096) ct[i] = __builtin_amdgcn_cosf((float)i * (1.0f / 4096.0f));
      if (i < 16384) { const int mm = i >> 7, k = i & 127, pp = mm >> 6, k1 = mm & 63, pk = k >> 6, t1 = k & 63; const float rev = (float)((k1 * t1) & 63) * (1.0f / 64.0f);
          const float c = __builtin_amdgcn_cosf(rev), sn = __builtin_amdgcn_sinf(rev);
          ((bf16_t*)(P.ws + WS_DFTM))[i] = (bf16_t)f2bf(pp == pk ? c : (pp == 0 ? sn : -sn)); } }
    for (int u = F.vcu; u < 192; u += F.G) {
        LAS float* s = (LAS float*)F.lds; LAS float* red = s + 9 * 1024;
        const int l = u / 96, j0 = (u % 96) * 64, tid = tid0;
        for (int i = tid; i < 9 * 1024; i += 512) { const int bb = i >> 10, k = i & 1023; const float v = bb < 8 ? P.c[bb * 1024 + k] : P.c_ctx[k]; s[i] = v / (1.f + expf(-v)); }
        __syncthreads();
        const int kc = tid >> 6, jj = tid & 63; float acc[9];
#pragma unroll
        for (int b = 0; b < 9; ++b) acc[b] = 0.f;
        const float* w = P.w_ada + (size_t)l * 1024 * 6144 + j0 + jj;
        for (int k = kc * 128; k < kc * 128 + 128; ++k) { const float wv = w[(size_t)k * 6144];
#pragma unroll
            for (int b = 0; b < 9; ++b) acc[b] += s[b * 1024 + k] * wv; }
#pragma unroll
        for (int b = 0; b < 9; ++b) red[(kc * 9 + b) * 64 + jj] = acc[b];
        __syncthreads();
        float* mod = (float*)(P.ws + WS_MOD);
        for (int i = tid; i < 9 * 64; i += 512) { const int b = i >> 6, j = i & 63; float v = P.b_ada[l * 6144 + j0 + j];
#pragma unroll
            for (int q = 0; q < 8; ++q) v += red[(q * 9 + b) * 64 + j];
            mod[(size_t)(l * 9 + b) * 6144 + j0 + j] = v; }
        __syncthreads();
    }
}
__device__ __forceinline__ void route_row(const Ptrs& P, int r, const f32x4 (&h)[4], int lane, bool publish, LAS unsigned* lcnt, LAS int* rec) {
    float lg[16];
#pragma unroll
    for (int e = 0; e < 16; ++e) lg[e] = 0.f;
#pragma unroll
    for (int j = 0; j < 4; ++j) {
#pragma unroll
        for (int i = 0; i < 4; ++i) { const f32x4* rw = (const f32x4*)(P.router_w + (size_t)(4 * lane + 256 * j + i) * 16); const float hv = h[j][i];
#pragma unroll
            for (int qd = 0; qd < 4; ++qd) { const f32x4 w = rw[qd]; lg[4 * qd] += hv * w.x; lg[4 * qd + 1] += hv * w.y; lg[4 * qd + 2] += hv * w.z; lg[4 * qd + 3] += hv * w.w; } }
        __builtin_amdgcn_sched_barrier(0); }
    float v8[8], v4[4], v2[2], v1;
    { const bool bit = (lane & 32) != 0;
#pragma unroll
      for (int i = 0; i < 8; ++i) { const float a = lg[i], b = lg[i + 8]; v8[i] = (bit ? b : a) + shfl_xor_l(bit ? a : b, 32, lane); } }
    { const bool bit = (lane & 16) != 0;
#pragma unroll
      for (int i = 0; i < 4; ++i) { const float a = v8[i], b = v8[i + 4]; v4[i] = (bit ? b : a) + shfl_xor_l(bit ? a : b, 16, lane); } }
    { const bool bit = (lane & 8) != 0;
#pragma unroll
      for (int i = 0; i < 2; ++i) { const float a = v4[i], b = v4[i + 2]; v2[i] = (bit ? b : a) + shfl_xor_l(bit ? a : b, 8, lane); } }
    { const bool bit = (lane & 4) != 0; const float a = v2[0], b = v2[1]; v1 = (bit ? b : a) + shfl_xor_l(bit ? a : b, 4, lane); }
    v1 += shfl_xor_l(v1, 2, lane); v1 += shfl_xor_l(v1, 1, lane);
    float bestscore = -INFINITY; int be0 = 0, be1 = 1; float ba0 = 0.f, ba1 = 0.f;
#pragma unroll
    for (int g = 0; g < 4; ++g) {
        float aff[4], sel[4];
#pragma unroll
        for (int i = 0; i < 4; ++i) { const float t = __int_as_float(__builtin_amdgcn_ds_bpermute((4 * g + i) << 4, __float_as_int(v1))); aff[i] = 1.0f / (1.0f + expf(-t)); sel[i] = aff[i] + P.router_bias[4 * g + i]; }
        int i1 = 0; float m1 = sel[0], a1 = aff[0];
#pragma unroll
        for (int i = 1; i < 4; ++i) if (sel[i] > m1) { m1 = sel[i]; a1 = aff[i]; i1 = i; }
        int i2 = -1; float m2 = -INFINITY, a2 = 0.f;
#pragma unroll
        for (int i = 0; i < 4; ++i) if (i != i1 && sel[i] > m2) { m2 = sel[i]; a2 = aff[i]; i2 = i; }
        const float score = m1 + m2;
        if (score > bestscore) { bestscore = score; be0 = 4 * g + i1; be1 = 4 * g + i2; ba0 = a1; ba1 = a2; }
    }
    if (lane == 0 && publish) {
        const int p0 = (int)__hip_atomic_fetch_add(lcnt + be0, 1u, __ATOMIC_RELAXED, __HIP_MEMORY_SCOPE_WORKGROUP), p1 = (int)__hip_atomic_fetch_add(lcnt + be1, 1u, __ATOMIC_RELAXED, __HIP_MEMORY_SCOPE_WORKGROUP);
        const float inv = 1.0f / (ba0 + ba1);
        rec[0] = r; rec[1] = be0; rec[2] = p0; rec[3] = be1; rec[4] = p1; rec[5] = __float_as_int(ba0 * inv); rec[6] = __float_as_int(ba1 * inv);
    }
}
template <int MODE> __device__ __forceinline__ void ph_norm(const Frame& F, const Ptrs& P, int l, int nrows) {
    const int lane = fresh_lane();
    const int stride = F.G * NWAVES;
    LAS unsigned* lcnt = (LAS unsigned*)F.lds; LAS unsigned* gbase = lcnt + 16; LAS int* recs = (LAS int*)(F.lds + 256);
    if (MODE == 2) { if (F.wave == 0 && lane < 16) lcnt[lane] = 0u; __syncthreads(); }
    int it = 0;
    for (int rb = F.vcu * NWAVES + F.wave; rb < nrows; rb += 2 * stride, ++it) {
        int rr[2]; rr[0] = rb; rr[1] = rb + stride < nrows ? rb + stride : rb;
        f32x4 v[2][4];
#pragma unroll
        for (int q = 0; q < 2; ++q) { const int r = rr[q];
            if (MODE == 0) { const f32x4* xr = (const f32x4*)xin_row(P, r) + lane;
#pragma unroll
                for (int j = 0; j < 4; ++j) v[q][j] = xr[64 * j]; }
            else { const f32x4* xr = (const f32x4*)x1_row(P, r) + lane;
#pragma unroll
                for (int j = 0; j < 4; ++j) v[q][j] = xr[64 * j]; } }
        if (MODE == 1) {
#pragma unroll
            for (int q = 0; q < 2; ++q) { const int r = rr[q]; const int bb = row_bb(r); const f32x4* g2 = (const f32x4*)mod_vec(P, l - 1, bb, 5) + lane;
                const u32x2* m0 = (const u32x2*)((const bf16_t*)(P.ws + WS_MO) + (size_t)r * D) + lane; const u32x2* m1 = (const u32x2*)((const bf16_t*)(P.ws + WS_MO) + (size_t)(R + r) * D) + lane;
#pragma unroll
                for (int j = 0; j < 4; ++j) { const u32x2 a = m0[64 * j], b = m1[64 * j]; const f32x4 g = g2[64 * j];
                    v[q][j].x += g.x * (lo16(a.x) + lo16(b.x)); v[q][j].y += g.y * (hi16(a.x) + hi16(b.x)); v[q][j].z += g.z * (lo16(a.y) + lo16(b.y)); v[q][j].w += g.w * (hi16(a.y) + hi16(b.y)); } }
            if (rr[1] != rr[0]) { f32x4* xr = (f32x4*)x1_row(P, rr[1]) + lane;
#pragma unroll
                for (int j = 0; j < 4; ++j) xr[64 * j] = v[1][j]; }
            { f32x4* xr = (f32x4*)x1_row(P, rr[0]) + lane;
#pragma unroll
              for (int j = 0; j < 4; ++j) xr[64 * j] = v[0][j]; }
        }
        float ss[2];
#pragma unroll
        for (int q = 0; q < 2; ++q) { ss[q] = 0.f;
#pragma unroll
            for (int j = 0; j < 4; ++j) ss[q] += (v[q][j].x * v[q][j].x + v[q][j].y * v[q][j].y) + (v[q][j].z * v[q][j].z + v[q][j].w * v[q][j].w); }
#pragma unroll
        for (int o = 1; o < 64; o <<= 1) { ss[0] += shfl_xor_l(ss[0], o, lane); ss[1] += shfl_xor_l(ss[1], o, lane); }
        const f32x4* gn = (const f32x4*)((MODE == 2 ? P.norm2 : P.norm1) + (size_t)l * D) + lane;
#pragma unroll
        for (int q = 0; q < 2; ++q) { const int r = rr[q]; const int bb = row_bb(r);
            const float rstd = 1.0f / sqrtf(ss[q] * (1.0f / D) + EPS);
            const f32x4* sh = (const f32x4*)mod_vec(P, l, bb, MODE == 2 ? 3 : 0) + lane;
            const f32x4* sc = (const f32x4*)mod_vec(P, l, bb, MODE == 2 ? 4 : 1) + lane;
            u32x2* o = (u32x2*)((bf16_t*)(P.ws + WS_H) + (size_t)r * D) + lane;
#pragma unroll
            for (int j = 0; j < 4; ++j) { const f32x4 g = gn[64 * j], a = sh[64 * j], b = sc[64 * j];
                v[q][j] = (v[q][j] * rstd * g) * (b + 1.0f) + a;
                u32x2 w; w.x = cvtpk(v[q][j].x, v[q][j].y); w.y = cvtpk(v[q][j].z, v[q][j].w); o[64 * j] = w; } }
        if (MODE == 2) { LAS int* rec = recs + (F.wave * 24 + 2 * it) * 8;
            route_row(P, rr[0], v[0], lane, true, lcnt, rec); __builtin_amdgcn_sched_barrier(0);
            if (lane == 0 && rr[1] == rr[0]) rec[8] = -1;
            route_row(P, rr[1], v[1], lane, rr[1] != rr[0], lcnt, rec + 8); }
    }
    if (MODE == 2) {
        __syncthreads();
        const int tid = F.wave * 64 + lane;
        if (tid < 16) { const unsigned c = lcnt[tid]; gbase[tid] = c ? atomicAdd((unsigned*)(P.ws + WS_CTL) + CW_CNT + 1024 * l + 64 * tid, c) : 0u; }
        __syncthreads();
        if (lane == 0) for (int k = 0; k < 2 * it; ++k) { const LAS int* rec = recs + (F.wave * 24 + k) * 8; const int r = rec[0]; if (r < 0) continue;
            int* rt = (int*)(P.ws + WS_ROUTE) + (size_t)r * 6; rt[0] = rec[1]; rt[1] = rec[2] + (int)gbase[rec[1]]; rt[2] = rec[3]; rt[3] = rec[4] + (int)gbase[rec[3]]; rt[4] = rec[5]; rt[5] = rec[6]; }
        __syncthreads();
    }
}
__device__ __forceinline__ void ph_kprep(const Frame& F, const Ptrs& P, int l) {
    const int lane = fresh_lane();
    const float* rc = (const float*)(P.ws + WS_ROPE); const float* rs = rc + 1024;
    const int hs = (lane >> 3) & 3, chunk = lane & 7, col = (hs < 2 ? C_KB + hs * 64 : C_KW + (hs - 2) * 64) + chunk * 8;
    const f32x4 g0 = *(const f32x4*)(P.k_gain + l * 64 + chunk * 8), g1 = *(const f32x4*)(P.k_gain + l * 64 + chunk * 8 + 4);
    const int a = chunk >> 2, fi = (chunk & 1) * 8; const bool second = (chunk & 2) != 0;
    const int npair = R / 2, stride = F.G * NWAVES;
    for (int pr0 = F.vcu * NWAVES + F.wave; pr0 < npair; pr0 += 4 * stride) {
        u32x4 w[4];
#pragma unroll
        for (int q = 0; q < 4; ++q) { const int pr = pr0 + q * stride; const int r = 2 * (pr < npair ? pr : pr0) + (lane >> 5); w[q] = *(const u32x4*)((const bf16_t*)(P.ws + WS_U) + (size_t)r * NIN + col); }
#pragma unroll
        for (int q = 0; q < 4; ++q) { const int pr = pr0 + q * stride; if (pr >= npair) break;
            const int r = 2 * pr + (lane >> 5);
            float x[8] = {lo16(w[q].x), hi16(w[q].x), lo16(w[q].y), hi16(w[q].y), lo16(w[q].z), hi16(w[q].z), lo16(w[q].w), hi16(w[q].w)};
            if (hs < 2) { float ss = 0.f;
#pragma unroll
                for (int j = 0; j < 8; ++j) ss += x[j] * x[j];
                ss += shfl_xor_l(ss, 1, lane); ss += shfl_xor_l(ss, 2, lane); ss += shfl_xor_l(ss, 4, lane);
                const float rstd = 1.0f / sqrtf(ss * (1.0f / 64.0f) + EPS);
                x[0] *= rstd * g0.x; x[1] *= rstd * g0.y; x[2] *= rstd * g0.z; x[3] *= rstd * g0.w; x[4] *= rstd * g1.x; x[5] *= rstd * g1.y; x[6] *= rstd * g1.z; x[7] *= rstd * g1.w; }
            if (r < RL) { const int t = r & (T - 1), pos = a ? (t & 63) : (t >> 6);
                const f32x4 c0 = *(const f32x4*)(rc + pos * 16 + fi), c1 = *(const f32x4*)(rc + pos * 16 + fi + 4), s0 = *(const f32x4*)(rs + pos * 16 + fi), s1 = *(const f32x4*)(rs + pos * 16 + fi + 4);
                const float cs[8] = {c0.x, c0.y, c0.z, c0.w, c1.x, c1.y, c1.z, c1.w}, sn[8] = {s0.x, s0.y, s0.z, s0.w, s1.x, s1.y, s1.z, s1.w};
#pragma unroll
                for (int j = 0; j < 8; ++j) { const float y = shfl_xor_l(x[j], 2, lane); x[j] = second ? x[j] * cs[j] + y * sn[j] : x[j] * cs[j] - y * sn[j]; } }
            u32x4 o; o.x = cvtpk(x[0], x[1]); o.y = cvtpk(x[2], x[3]); o.z = cvtpk(x[4], x[5]); o.w = cvtpk(x[6], x[7]);
            *(u32x4*)((bf16_t*)(P.ws + WS_U) + (size_t)r * NIN + col) = o; }
    }
}
__device__ __forceinline__ void ph_pool(const Frame& F, const Ptrs& P, int nrows) {
    const int tid0 = fresh_tid();
    for (int i = F.vcu * 512 + tid0; i < nrows * 64; i += F.G * 512) {
        const int r = i >> 6, c8 = (i & 63) * 8;
        const bool lat = r < RL; const int Ts = lat ? T : TC; const int t = lat ? (r & (T - 1)) : ((r - RL) & (TC - 1)); const int r0 = r - t;
        const int g = c8 >> 7, hw = 1 << g;
        const int lo = t - hw < 0 ? 0 : t - hw, hi = t + hw > Ts ? Ts : t + hw;
        const bf16_t* U = (const bf16_t*)(P.ws + WS_U) + C_P + c8;
        u32x4 wv[16];
#pragma unroll
        for (int k = 0; k < 16; ++k) { const int tt = t - 8 + k; const bool ok = tt >= lo && tt < hi; wv[k] = *(const u32x4*)(U + (size_t)(r0 + (ok ? tt : t)) * NIN); }
        float s[8];
#pragma unroll
        for (int j = 0; j < 8; ++j) s[j] = 0.f;
#pragma unroll
        for (int k = 0; k < 16; ++k) { const int tt = t - 8 + k; const float f = (tt >= lo && tt < hi) ? 1.f : 0.f; const u32x4 w = wv[k];
            s[0] += f * lo16(w.x); s[1] += f * hi16(w.x); s[2] += f * lo16(w.y); s[3] += f * hi16(w.y); s[4] += f * lo16(w.z); s[5] += f * hi16(w.z); s[6] += f * lo16(w.w); s[7] += f * hi16(w.w); }
        const u32x4 w = wv[8]; const float inv = 1.0f / (float)(hi - lo);
        u32x4 o; o.x = cvtpk(s[0] * inv - lo16(w.x), s[1] * inv - hi16(w.x)); o.y = cvtpk(s[2] * inv - lo16(w.y), s[3] * inv - hi16(w.y));
        o.z = cvtpk(s[4] * inv - lo16(w.z), s[5] * inv - hi16(w.z)); o.w = cvtpk(s[6] * inv - lo16(w.w), s[7] * inv - hi16(w.w));
        *(u32x4*)((bf16_t*)(P.ws + WS_BR) + (size_t)r * NBR + 1536 + c8) = o;
    }
}
__device__ __forceinline__ void ph_gather(const Frame& F, const Ptrs& P, int l, int nrows) {
    const unsigned* cnt = (const unsigned*)(P.ws + WS_CTL) + CW_CNT + 1024 * l;
    int* rowmap = (int*)(P.ws + WS_ROWMAP); float* roww = (float*)(P.ws + WS_ROWW);
    const int lane = fresh_tid() & 63;
    for (int wv = F.vcu * NWAVES + F.wave; wv < 2 * nrows + 64; wv += F.G * NWAVES) {
        if (wv < 2 * nrows) {
            const int r = wv >> 1, s = wv & 1; const int* rt = (const int*)(P.ws + WS_ROUTE) + (size_t)r * 6;
            const int e = rt[2 * s], pos = rt[2 * s + 1]; const float w = ((const float*)rt)[4 + s];
            int off = 0;
#pragma unroll
            for (int q = 0; q < 16; ++q) { const int n = ((int)cnt[64 * q] + 255) & ~255; if (q < e) off += n; }
            const int dst = off + pos;
            const u32x4* src = (const u32x4*)((const bf16_t*)(P.ws + WS_H) + (size_t)r * D); u32x4* d = (u32x4*)((bf16_t*)(P.ws + WS_AS) + (size_t)dst * D);
            d[lane] = src[lane]; d[lane + 64] = src[lane + 64];
            if (lane == 0) { rowmap[dst] = wv; roww[dst] = w; }
        } else {
            const int i = (wv - 2 * nrows) * 64 + lane;
            const int e = i >> 8, p = i & 255; int off = 0;
#pragma unroll
            for (int q = 0; q < 16; ++q) { const int n = ((int)cnt[64 * q] + 255) & ~255; if (q < e) off += n; }
            const int c = (int)cnt[64 * e]; if (c + p < ((c + 255) & ~255)) rowmap[off + c + p] = -1;
        }
    }
}
__device__ __forceinline__ void ph_final(const Frame& F, const Ptrs& P) {
    const int lane = fresh_tid() & 63;
    for (int r = F.vcu * NWAVES + F.wave; r < RL; r += F.G * NWAVES) {
        const int bb = row_bb(r);
        f32x4* xr = (f32x4*)(P.out + (size_t)r * D) + lane; f32x4 v[4];
        const f32x4* g2 = (const f32x4*)mod_vec(P, 1, bb, 5) + lane;
        const u32x2* m0 = (const u32x2*)((const bf16_t*)(P.ws + WS_MO) + (size_t)r * D) + lane; const u32x2* m1 = (const u32x2*)((const bf16_t*)(P.ws + WS_MO) + (size_t)(R + r) * D) + lane;
        float ss = 0.f;
#pragma unroll
        for (int j = 0; j < 4; ++j) { v[j] = xr[64 * j]; const u32x2 a = m0[64 * j], b = m1[64 * j]; const f32x4 g = g2[64 * j];
            v[j].x += g.x * (lo16(a.x) + lo16(b.x)); v[j].y += g.y * (hi16(a.x) + hi16(b.x)); v[j].z += g.z * (lo16(a.y) + lo16(b.y)); v[j].w += g.w * (hi16(a.y) + hi16(b.y));
            ss += (v[j].x * v[j].x + v[j].y * v[j].y) + (v[j].z * v[j].z + v[j].w * v[j].w); }
        const float rstd = 1.0f / sqrtf(wave_sum_l(ss, lane) * (1.0f / D) + EPS);
        const f32x4* gn = (const f32x4*)P.norm_f + lane;
#pragma unroll
        for (int j = 0; j < 4; ++j) xr[64 * j] = v[j] * rstd * gn[64 * j];
    }
}

template <int MODE> __device__ __forceinline__ void ph_attn_ref(const Frame& F, const Ptrs& P, int l) {
    const int tid = fresh_tid();
    LAS float* Ks = (LAS float*)F.lds; LAS float* Vs = Ks + 64 * 64;
    const bf16_t* U = (const bf16_t*)(P.ws + WS_U);
    const bool latq = MODE < 2; const bool winm = (MODE == 1 || MODE == 3);
    const int NU = latq ? 1024 : 64; const int half = tid & 1;
    for (int u = F.vcu; u < NU; u += F.G) {
        const int qb = latq ? (u & 15) : 0, h = latq ? ((u >> 4) & 7) : (u & 7), b = latq ? (u >> 7) : (u >> 3), g = h >> 2;
        const int tq = qb * 256 + (tid >> 1);
        const int qrow = latq ? b * T + tq : RL + b * TC + tq;
        const int qcol = (winm ? C_QW : C_QB) + h * 64 + half * 32, kcol = (winm ? C_KW : C_KB) + g * 64, vcol = (winm ? C_VW : C_VB) + g * 64;
        unsigned q[16]; float o[32];
        { const u32x4* qp = (const u32x4*)(U + (size_t)qrow * NIN + qcol);
#pragma unroll
          for (int i = 0; i < 4; ++i) { const u32x4 w = qp[i]; q[4 * i] = w.x; q[4 * i + 1] = w.y; q[4 * i + 2] = w.z; q[4 * i + 3] = w.w; } }
#pragma unroll
        for (int d = 0; d < 32; ++d) o[d] = 0.f;
        float m = -INFINITY, lsum = 0.f;
        int lt_lo = 0, lt_hi = 0;
        if (MODE == 0) { lt_lo = 0; lt_hi = T / 64; }
        if (MODE == 1) { const int q0 = qb * 256; lt_lo = (q0 - 128 < 0 ? 0 : q0 - 128) / 64; lt_hi = (q0 + 384 > T ? T : q0 + 384) / 64; }
        const int ntiles = 4 + (lt_hi - lt_lo);
        for (int ti = 0; ti < ntiles; ++ti) {
            const bool isctx = ti < 4; const int kpos0 = isctx ? ti * 64 : (lt_lo + ti - 4) * 64;
            const int krow0 = isctx ? RL + b * TC + kpos0 : b * T + kpos0;
            __syncthreads();
            { const int j = tid >> 3, part = tid & 7; const u32x4 kw = *(const u32x4*)(U + (size_t)(krow0 + j) * NIN + kcol + part * 8), vw = *(const u32x4*)(U + (size_t)(krow0 + j) * NIN + vcol + part * 8);
              LAS float* kd = Ks + j * 64 + part * 8; LAS float* vd = Vs + j * 64 + part * 8;
              kd[0] = lo16(kw.x); kd[1] = hi16(kw.x); kd[2] = lo16(kw.y); kd[3] = hi16(kw.y); kd[4] = lo16(kw.z); kd[5] = hi16(kw.z); kd[6] = lo16(kw.w); kd[7] = hi16(kw.w);
              vd[0] = lo16(vw.x); vd[1] = hi16(vw.x); vd[2] = lo16(vw.y); vd[3] = hi16(vw.y); vd[4] = lo16(vw.z); vd[5] = hi16(vw.z); vd[6] = lo16(vw.w); vd[7] = hi16(vw.w); }
            __syncthreads();
#pragma unroll 1
            for (int jk = 0; jk < 64; ++jk) {
                float a = 0.f; const LAS f32x4* kr = (const LAS f32x4*)(Ks + jk * 64 + half * 32);
#pragma unroll
                for (int d4 = 0; d4 < 8; ++d4) { const f32x4 kv = kr[d4]; a += lo16(q[2 * d4]) * kv.x + hi16(q[2 * d4]) * kv.y + lo16(q[2 * d4 + 1]) * kv.z + hi16(q[2 * d4 + 1]) * kv.w; }
                a += shfl_xor_l(a, 1, tid & 63);
                if (MODE == 1 && !isctx) { const int dlt = kpos0 + jk - tq; if (dlt > 128 || dlt < -128) a = -INFINITY; }
                if (a != -INFINITY) {
                    if (a > m) { const float scl = exp2f(m - a); m = a; lsum *= scl;
#pragma unroll
                        for (int d = 0; d < 32; ++d) o[d] *= scl; }
                    const float p = exp2f(a - m); lsum += p; const LAS f32x4* vr = (const LAS f32x4*)(Vs + jk * 64 + half * 32);
#pragma unroll
                    for (int d4 = 0; d4 < 8; ++d4) { const f32x4 vv = vr[d4]; o[4 * d4] += p * vv.x; o[4 * d4 + 1] += p * vv.y; o[4 * d4 + 2] += p * vv.z; o[4 * d4 + 3] += p * vv.w; }
                }
            }
        }
        if (winm) lsum += exp2f(P.sink[l * 8 + h] * LOG2E - m);
        const float inv = 1.0f / lsum;
        { u32x4* op = (u32x4*)((bf16_t*)(P.ws + WS_BR) + (size_t)qrow * NBR + (winm ? 1024 : 512) + h * 64 + half * 32);
#pragma unroll
          for (int i = 0; i < 4; ++i) { u32x4 w; w.x = pk2(o[8 * i] * inv, o[8 * i + 1] * inv); w.y = pk2(o[8 * i + 2] * inv, o[8 * i + 3] * inv); w.z = pk2(o[8 * i + 4] * inv, o[8 * i + 5] * inv); w.w = pk2(o[8 * i + 6] * inv, o[8 * i + 7] * inv); op[i] = w; } }
        __syncthreads();
    }
}
__device__ __forceinline__ void ph_fourier_ref(const Frame& F, const Ptrs& P, int Ts, int latent) {
    const int tid = fresh_tid();
    LAS float* Zr = (LAS float*)F.lds; LAS float* Zi = Zr + 16 * 64; LAS float* Ct = Zi + 16 * 64; LAS float* St = Ct + 128 * 17;
    const bf16_t* U = (const bf16_t*)(P.ws + WS_U); const float* ct = (const float*)(P.ws + WS_COS);
    const int nkt = Ts / 128, NU = 8 * nkt * 8, step = 4096 / Ts;
    const int tk = tid >> 4, tc = tid & 15;
    for (int u = F.vcu; u < NU; u += F.G) {
        const int cht = u & 7, kt = (u >> 3) % nkt, b = (u >> 3) / nkt, k0 = kt * 128, ch0 = cht * 64;
        const int rbase = latent ? b * T : RL + b * TC;
        float acc[4][4];
#pragma unroll
        for (int i = 0; i < 4; ++i)
#pragma unroll
            for (int j = 0; j < 4; ++j) acc[i][j] = 0.f;
        for (int t0 = 0; t0 < Ts; t0 += 16) {
            __syncthreads();
            if (tid < 256) { const int tt = tid >> 4, c4 = (tid & 15) * 4; const bf16_t* zp = U + (size_t)(rbase + t0 + tt) * NIN + ch0 + c4;
              const u32x2 a = *(const u32x2*)(zp + C_ZR), bq = *(const u32x2*)(zp + C_ZI);
              Zr[tt * 64 + c4] = lo16(a.x); Zr[tt * 64 + c4 + 1] = hi16(a.x); Zr[tt * 64 + c4 + 2] = lo16(a.y); Zr[tt * 64 + c4 + 3] = hi16(a.y);
              Zi[tt * 64 + c4] = lo16(bq.x); Zi[tt * 64 + c4 + 1] = hi16(bq.x); Zi[tt * 64 + c4 + 2] = lo16(bq.y); Zi[tt * 64 + c4 + 3] = hi16(bq.y); }
#pragma unroll
            for (int i = 0; i < 4; ++i) { const int e = tid * 4 + i, k = e >> 4, tt = e & 15; const int ang = (((k0 + k) * (t0 + tt)) & (Ts - 1)) * step;
                Ct[k * 17 + tt] = ct[ang]; St[k * 17 + tt] = ct[(ang - 1024) & 4095]; }
            __syncthreads();
#pragma unroll 2
            for (int tt = 0; tt < 16; ++tt) { float zr[4], zi[4];
#pragma unroll
                for (int j = 0; j < 4; ++j) { zr[j] = Zr[tt * 64 + tc * 4 + j]; zi[j] = Zi[tt * 64 + tc * 4 + j]; }
#pragma unroll
                for (int i = 0; i < 4; ++i) { const float c = Ct[(tk * 4 + i) * 17 + tt], sn = St[(tk * 4 + i) * 17 + tt];
#pragma unroll
                    for (int j = 0; j < 4; ++j) acc[i][j] += c * zr[j] + sn * zi[j]; } }
        }
        const float sc = 1.0f / sqrtf((float)Ts);
        bf16_t* BR = (bf16_t*)(P.ws + WS_BR);
#pragma unroll
        for (int i = 0; i < 4; ++i) { u32x2 w; w.x = pk2(acc[i][0] * sc, acc[i][1] * sc); w.y = pk2(acc[i][2] * sc, acc[i][3] * sc);
            *(u32x2*)(BR + (size_t)(rbase + k0 + tk * 4 + i) * NBR + ch0 + tc * 4) = w; }
        __syncthreads();
    }
}

typedef float f32x16 __attribute__((ext_vector_type(16)));
typedef short v4i16_t __attribute__((ext_vector_type(4)));
constexpr int AT_ROWB = 144, AT_TILEB = 64 * AT_ROWB;
template <int MODE> __device__ __forceinline__ void ph_attn(const Frame& F, const Ptrs& P, int l) {
    const int lane = fresh_lane(), tid = F.wave * 64 + lane, r32 = lane & 31, hi = lane >> 5;
    const bf16_t* U = (const bf16_t*)(P.ws + WS_U);
    const bool latq = MODE < 2; const bool winm = (MODE == 1 || MODE == 3);
    const int NU = latq ? 1024 : 64;
    LAS unsigned char* Kb = F.lds; LAS unsigned char* Vb = F.lds + 2 * AT_TILEB;
    const int st_off = (tid >> 3) * AT_ROWB + (tid & 7) * 16;
    const int kf_off = r32 * AT_ROWB + hi * 16;
    const int vf_off = (4 * hi + ((lane & 15) >> 2)) * AT_ROWB + (((lane >> 4) & 1) * 16 + (lane & 3) * 4) * 2;
    for (int u = F.vcu; u < NU; u += F.G) {
        const int qb = latq ? (u & 63) : (u & 3), g = latq ? ((u >> 6) & 1) : ((u >> 2) & 1), b = latq ? (u >> 7) : (u >> 3);
        const int tq0 = qb * 64, hq = 4 * g + (F.wave >> 1), tq = tq0 + 32 * (F.wave & 1) + r32;
        const int qrow = latq ? b * T + tq : RL + b * TC + tq;
        const int qcol = (winm ? C_QW : C_QB) + hq * 64, kcol = (winm ? C_KW : C_KB) + g * 64, vcol = (winm ? C_VW : C_VB) + g * 64;
        int lt_lo = 0, lt_hi = 0;
        if (MODE == 0) { lt_lo = 0; lt_hi = T / 64; }
        if (MODE == 1) { lt_lo = (tq0 - 128 < 0 ? 0 : tq0 - 128) / 64; lt_hi = (tq0 + 192 > T ? T : tq0 + 192) / 64; }
        const int ntiles = 4 + (lt_hi - lt_lo);
        bf16x8 qr[4];
        {
            float x[4][8];
#pragma unroll
            for (int d0 = 0; d0 < 4; ++d0) { const u32x4 wq = *(const u32x4*)(U + (size_t)qrow * NIN + qcol + d0 * 16 + hi * 8);
                x[d0][0] = lo16(wq.x); x[d0][1] = hi16(wq.x); x[d0][2] = lo16(wq.y); x[d0][3] = hi16(wq.y); x[d0][4] = lo16(wq.z); x[d0][5] = hi16(wq.z); x[d0][6] = lo16(wq.w); x[d0][7] = hi16(wq.w); }
            if (!winm) { float ss = 0.f;
#pragma unroll
                for (int d0 = 0; d0 < 4; ++d0)
#pragma unroll
                    for (int j = 0; j < 8; ++j) ss += x[d0][j] * x[d0][j];
                ss += shfl_xor_l(ss, 32, lane);
                const float rstd = 1.0f / sqrtf(ss * (1.0f / 64.0f) + EPS);
#pragma unroll
                for (int d0 = 0; d0 < 4; ++d0) { const f32x4 ga = *(const f32x4*)(P.q_gain + l * 64 + d0 * 16 + hi * 8), gb = *(const f32x4*)(P.q_gain + l * 64 + d0 * 16 + hi * 8 + 4);
                    x[d0][0] *= rstd * ga.x; x[d0][1] *= rstd * ga.y; x[d0][2] *= rstd * ga.z; x[d0][3] *= rstd * ga.w; x[d0][4] *= rstd * gb.x; x[d0][5] *= rstd * gb.y; x[d0][6] *= rstd * gb.z; x[d0][7] *= rstd * gb.w; } }
            if (latq) { const float* rc = (const float*)(P.ws + WS_ROPE); const float* rs = rc + 1024;
#pragma unroll
                for (int a = 0; a < 2; ++a) { const int pos = a ? (tq & 63) : (tq >> 6);
                    const f32x4 c0 = *(const f32x4*)(rc + pos * 16 + hi * 8), c1 = *(const f32x4*)(rc + pos * 16 + hi * 8 + 4), s0 = *(const f32x4*)(rs + pos * 16 + hi * 8), s1 = *(const f32x4*)(rs + pos * 16 + hi * 8 + 4);
                    const float cs[8] = {c0.x, c0.y, c0.z, c0.w, c1.x, c1.y, c1.z, c1.w}, sn[8] = {s0.x, s0.y, s0.z, s0.w, s1.x, s1.y, s1.z, s1.w};
#pragma unroll
                    for (int j = 0; j < 8; ++j) { const float x1 = x[2 * a][j], x2 = x[2 * a + 1][j]; x[2 * a][j] = x1 * cs[j] - x2 * sn[j]; x[2 * a + 1][j] = x2 * cs[j] + x1 * sn[j]; } } }
#pragma unroll
            for (int d0 = 0; d0 < 4; ++d0) { u32x4 wq; wq.x = cvtpk(x[d0][0] * QSCALE, x[d0][1] * QSCALE); wq.y = cvtpk(x[d0][2] * QSCALE, x[d0][3] * QSCALE); wq.z = cvtpk(x[d0][4] * QSCALE, x[d0][5] * QSCALE); wq.w = cvtpk(x[d0][6] * QSCALE, x[d0][7] * QSCALE);
                qr[d0] = __builtin_bit_cast(bf16x8, wq); }
        }
        f32x16 o0, o1;
#pragma unroll
        for (int r = 0; r < 16; ++r) { o0[r] = 0.f; o1[r] = 0.f; }
        float m = -INFINITY, lsum = 0.f;
        { const size_t kr = (size_t)(RL + b * TC + (tid >> 3)) * NIN + (tid & 7) * 8;
          const u32x4 kw = *(const u32x4*)(U + kr + kcol), vw = *(const u32x4*)(U + kr + vcol);
          *(LAS u32x4*)(Kb + st_off) = kw; *(LAS u32x4*)(Vb + st_off) = vw; }
        __syncthreads();
        for (int ti = 0; ti < ntiles; ++ti) {
            const int cur = (ti & 1) * AT_TILEB, nxt = AT_TILEB - cur;
            const bool more = ti + 1 < ntiles;
            u32x4 kw, vw;
            if (more) { const int tn = ti + 1; const int krow0 = tn < 4 ? RL + b * TC + tn * 64 : b * T + (lt_lo + tn - 4) * 64;
                const size_t kr = (size_t)(krow0 + (tid >> 3)) * NIN + (tid & 7) * 8;
                kw = *(const u32x4*)(U + kr + kcol); vw = *(const u32x4*)(U + kr + vcol); }
            f32x16 p0, p1;
#pragma unroll
            for (int r = 0; r < 16; ++r) { p0[r] = 0.f; p1[r] = 0.f; }
#pragma unroll
            for (int d0 = 0; d0 < 4; ++d0) {
                const bf16x8 k0 = *(const LAS bf16x8*)(Kb + cur + kf_off + d0 * 32);
                const bf16x8 k1 = *(const LAS bf16x8*)(Kb + cur + kf_off + 32 * AT_ROWB + d0 * 32);
                p0 = __builtin_amdgcn_mfma_f32_32x32x16_bf16(k0, qr[d0], p0, 0, 0, 0);
                p1 = __builtin_amdgcn_mfma_f32_32x32x16_bf16(k1, qr[d0], p1, 0, 0, 0);
            }
            if (MODE == 1 && ti >= 4) {
                const int kp0 = (lt_lo + ti - 4) * 64 + 4 * hi - tq;
#pragma unroll
                for (int r = 0; r < 16; ++r) { const int dl = kp0 + (r & 3) + 8 * (r >> 2);
                    if (dl > 128 || dl < -128) p0[r] = -INFINITY;
                    if (dl + 32 > 128 || dl + 32 < -128) p1[r] = -INFINITY; }
            }
            float mx = fmaxf(p0[0], p1[0]);
#pragma unroll
            for (int r = 1; r < 16; ++r) mx = fmaxf(mx, fmaxf(p0[r], p1[r]));
            mx = fmaxf(mx, shfl_xor_l(mx, 32, lane));
            const float mn = fmaxf(m, mx);
            const float alpha = exp2f(m - mn); m = mn;
            float rs = 0.f;
#pragma unroll
            for (int r = 0; r < 16; ++r) { p0[r] = exp2f(p0[r] - mn); p1[r] = exp2f(p1[r] - mn); rs += p0[r] + p1[r]; }
            lsum = lsum * alpha + rs;
#pragma unroll
            for (int r = 0; r < 16; ++r) { o0[r] *= alpha; o1[r] *= alpha; }
#pragma unroll
            for (int kb = 0; kb < 2; ++kb)
#pragma unroll
                for (int sx = 0; sx < 2; ++sx) {
                    u32x4 pw;
                    if (kb == 0) { pw.x = cvtpk(p0[8 * sx], p0[8 * sx + 1]); pw.y = cvtpk(p0[8 * sx + 2], p0[8 * sx + 3]); pw.z = cvtpk(p0[8 * sx + 4], p0[8 * sx + 5]); pw.w = cvtpk(p0[8 * sx + 6], p0[8 * sx + 7]); }
                    else         { pw.x = cvtpk(p1[8 * sx], p1[8 * sx + 1]); pw.y = cvtpk(p1[8 * sx + 2], p1[8 * sx + 3]); pw.z = cvtpk(p1[8 * sx + 4], p1[8 * sx + 5]); pw.w = cvtpk(p1[8 * sx + 6], p1[8 * sx + 7]); }
                    const bf16x8 pf = __builtin_bit_cast(bf16x8, pw);
                    const LAS unsigned char* vp = Vb + cur + vf_off + (kb * 32 + 16 * sx) * AT_ROWB;
#pragma unroll
                    for (int db = 0; db < 2; ++db) {
                        const v4i16_t lo4 = __builtin_amdgcn_ds_read_tr16_b64_v4i16((LAS v4i16_t*)(vp + db * 64));
                        const v4i16_t hi4 = __builtin_amdgcn_ds_read_tr16_b64_v4i16((LAS v4i16_t*)(vp + 8 * AT_ROWB + db * 64));
                        const bf16x8 vf = (bf16x8){lo4[0], lo4[1], lo4[2], lo4[3], hi4[0], hi4[1], hi4[2], hi4[3]};
                        if (db == 0) o0 = __builtin_amdgcn_mfma_f32_32x32x16_bf16(vf, pf, o0, 0, 0, 0);
                        else         o1 = __builtin_amdgcn_mfma_f32_32x32x16_bf16(vf, pf, o1, 0, 0, 0);
                    }
                }
            if (more) { *(LAS u32x4*)(Kb + nxt + st_off) = kw; *(LAS u32x4*)(Vb + nxt + st_off) = vw; }
            __syncthreads();
        }
        lsum += shfl_xor_l(lsum, 32, lane);
        if (winm) lsum += exp2f(P.sink[l * 8 + hq] * LOG2E - m);
        const float inv = 1.0f / lsum;
        bf16_t* op = (bf16_t*)(P.ws + WS_BR) + (size_t)qrow * NBR + (winm ? 1024 : 512) + hq * 64 + 4 * hi;
#pragma unroll
        for (int gq = 0; gq < 4; ++gq) {
            u32x2 w0, w1; w0.x = cvtpk(o0[4 * gq] * inv, o0[4 * gq + 1] * inv); w0.y = cvtpk(o0[4 * gq + 2] * inv, o0[4 * gq + 3] * inv);
            w1.x = cvtpk(o1[4 * gq] * inv, o1[4 * gq + 1] * inv); w1.y = cvtpk(o1[4 * gq + 2] * inv, o1[4 * gq + 3] * inv);
            *(u32x2*)(op + 8 * gq) = w0; *(u32x2*)(op + 32 + 8 * gq) = w1; }
    }
}

constexpr int DF_ROWB = 528;
template <int STAGE> __device__ __forceinline__ void ph_dft(const Frame& F, const Ptrs& P) {
    const int lane = fresh_lane(), tid = F.wave * 64 + lane, r32 = lane & 31, hi = lane >> 5, w = F.wave;
    bf16_t* U = (bf16_t*)(P.ws + WS_U); bf16_t* BR = (bf16_t*)(P.ws + WS_BR); const bf16_t* Wm = (const bf16_t*)(P.ws + WS_DFTM);
    LAS unsigned char* Xl = F.lds;
    const int xf_off = (8 * hi + ((lane & 15) >> 2)) * DF_ROWB + (32 * w + ((lane >> 4) & 1) * 16 + (lane & 3) * 4) * 2;
    constexpr int NMB = STAGE == 2 ? 4 : 2;
    for (int u = F.vcu; u < 1024; u += F.G) {
        const int chb = u & 1, sidx = (u >> 1) & 63, b = u >> 7;
        { const int seg = tid >> 2, part = tid & 3, pp = seg >> 6, j = seg & 63;
          const int grow = STAGE == 2 ? b * T + 64 * j + sidx : b * T + 64 * sidx + j;
          const u32x4* src = (const u32x4*)(U + (size_t)grow * NIN + pp * 512 + chb * 256 + part * 64);
          u32x4 v[8];
#pragma unroll
          for (int i = 0; i < 8; ++i) v[i] = src[i];
#pragma unroll
          for (int i = 0; i < 8; ++i) *(LAS u32x4*)(Xl + seg * DF_ROWB + part * 128 + i * 16) = v[i]; }
        __syncthreads();
        f32x16 acc[NMB];
#pragma unroll
        for (int mb = 0; mb < NMB; ++mb)
#pragma unroll
            for (int r = 0; r < 16; ++r) acc[mb][r] = 0.f;
#pragma unroll
        for (int ks = 0; ks < 8; ++ks) {
            const v4i16_t lo4 = __builtin_amdgcn_ds_read_tr16_b64_v4i16((LAS v4i16_t*)(Xl + xf_off + (16 * ks) * DF_ROWB));
            const v4i16_t hi4 = __builtin_amdgcn_ds_read_tr16_b64_v4i16((LAS v4i16_t*)(Xl + xf_off + (16 * ks + 4) * DF_ROWB));
            const bf16x8 xf = (bf16x8){lo4[0], lo4[1], lo4[2], lo4[3], hi4[0], hi4[1], hi4[2], hi4[3]};
#pragma unroll
            for (int mb = 0; mb < NMB; ++mb) { const bf16x8 wf = *(const bf16x8*)(Wm + (mb * 32 + r32) * 128 + 16 * ks + 8 * hi);
                acc[mb] = __builtin_amdgcn_mfma_f32_32x32x16_bf16(xf, wf, acc[mb], 0, 0, 0); }
        }
        LAS unsigned char* ob = Xl + (32 * w + 4 * hi) * 2;
        if (STAGE == 2) {
#pragma unroll
            for (int mb = 0; mb < 2; ++mb) { const int k1 = mb * 32 + r32; const float rev = (float)((k1 * sidx) & 4095) * (1.0f / 4096.0f);
                const float ct = __builtin_amdgcn_cosf(rev), st = __builtin_amdgcn_sinf(rev);
#pragma unroll
                for (int gq = 0; gq < 4; ++gq) { u32x2 wr, wi; float yr[4], yi[4];
#pragma unroll
                    for (int i = 0; i < 4; ++i) { const float a = acc[mb][4 * gq + i], bq = acc[mb + 2][4 * gq + i]; yr[i] = a * ct + bq * st; yi[i] = bq * ct - a * st; }
                    wr.x = cvtpk(yr[0], yr[1]); wr.y = cvtpk(yr[2], yr[3]); wi.x = cvtpk(yi[0], yi[1]); wi.y = cvtpk(yi[2], yi[3]);
                    *(LAS u32x2*)(ob + k1 * DF_ROWB + 16 * gq) = wr; *(LAS u32x2*)(ob + (64 + k1) * DF_ROWB + 16 * gq) = wi; } }
        } else {
#pragma unroll
            for (int mb = 0; mb < 2; ++mb) { const int k2 = mb * 32 + r32;
#pragma unroll
                for (int gq = 0; gq < 4; ++gq) { u32x2 wr; wr.x = cvtpk(acc[mb][4 * gq] * 0.015625f, acc[mb][4 * gq + 1] * 0.015625f); wr.y = cvtpk(acc[mb][4 * gq + 2] * 0.015625f, acc[mb][4 * gq + 3] * 0.015625f);
                    *(LAS u32x2*)(ob + k2 * DF_ROWB + 16 * gq) = wr; } }
        }
        __syncthreads();
        if (STAGE == 2) { const int seg = tid >> 2, part = tid & 3, pp = seg >> 6, j = seg & 63;
            u32x4* dst = (u32x4*)(U + (size_t)(b * T + 64 * j + sidx) * NIN + pp * 512 + chb * 256 + part * 64);
#pragma unroll
            for (int i = 0; i < 8; ++i) dst[i] = *(const LAS u32x4*)(Xl + seg * DF_ROWB + part * 128 + i * 16);
        } else { const int k2 = tid >> 3, part = tid & 7;
            u32x4* dst = (u32x4*)(BR + (size_t)(b * T + 64 * k2 + sidx) * NBR + chb * 256 + part * 32);
#pragma unroll
            for (int i = 0; i < 4; ++i) dst[i] = *(const LAS u32x4*)(Xl + k2 * DF_ROWB + part * 64 + i * 16); }
        __syncthreads();
    }
}

struct MegaArgs { Ptrs P; int ph_lo, ph_hi, li, pad; };
__global__ void __launch_bounds__(NWAVES * 64, 2) mega(MegaArgs args) {
    extern __shared__ __attribute__((aligned(16))) unsigned char lds_raw[];
    Frame F; F.lds = (LAS unsigned char*)lds_raw;
    F.wave = __builtin_amdgcn_readfirstlane(threadIdx.x >> 6);
    F.G = gridDim.x; { const int bx = blockIdx.x; F.vcu = (F.G % 8 == 0) ? (bx % 8) * (F.G / 8) + bx / 8 : bx; }
    const Ptrs& P = args.P;
    for (int u = fresh_tid(); u < (LDS_BYTES - LDSCTL_OFF) / 4; u += NWAVES * 64) ((LAS unsigned*)(F.lds + LDSCTL_OFF))[u] = 0u;
    __syncthreads();
    volatile LAS unsigned* MISC = (volatile LAS unsigned*)(F.lds + MISC_OFF);
    XcdBarrier bar = xcd_barrier_post((unsigned*)(P.ws + WS_CTL) + CW_BAR + args.li * XCD_BAR_WORDS, MISC + 8, F.wave);
    const int lo = args.ph_lo, hi = args.ph_hi;
    unsigned char* ws = P.ws;
    bf16_t* H = (bf16_t*)(ws + WS_H); bf16_t* U = (bf16_t*)(ws + WS_U); bf16_t* BR = (bf16_t*)(ws + WS_BR);
    bf16_t* GT = (bf16_t*)(ws + WS_GT); bf16_t* MG = (bf16_t*)(ws + WS_MG); bf16_t* AS = (bf16_t*)(ws + WS_AS); bf16_t* HID = (bf16_t*)(ws + WS_HID); bf16_t* MO = (bf16_t*)(ws + WS_MO);
    const bf16_t* Bt_in = (const bf16_t*)(ws + WS_WB + WB_IN); const bf16_t* Bt_gate = (const bf16_t*)(ws + WS_WB + WB_GATE); const bf16_t* Bt_br = (const bf16_t*)(ws + WS_WB + WB_BR);
    const bf16_t* Bt_out = (const bf16_t*)(ws + WS_WB + WB_OUT); const bf16_t* Bt_13 = (const bf16_t*)(ws + WS_WB + WB_13); const bf16_t* Bt_2 = (const bf16_t*)(ws + WS_WB + WB_2);
#define IN(g) (lo <= (g) && (g) < hi)
#define SEAM(g) do { if ((g) + 1 < hi) xcd_barrier(bar); } while (0)
    for (int l = 0; l < 2; ++l) {
        const int pb = l * NPH; const int M = l == 0 ? R : RL;
        if (IN(pb + 0)) { if (l == 0) ph_tables_mod(F, P); ph_weights(F, P, l); SEAM(pb + 0); }
        if (IN(pb + 1)) { if (l == 0) ph_norm<0>(F, P, l, R); else ph_norm<1>(F, P, l, R); SEAM(pb + 1); }
        if (IN(pb + 2)) {
            pg8::StaticOrder S; S.init(R, NIN, F.G, (int)blockIdx.x, H, D, Bt_in, D);
            pg8::EpiV8<FStore8> E{FStore8{U, NIN}};
            pg8::gemm_phase(F.lds, F.wave, D, D, D, S, E);
            SEAM(pb + 2);
        }
        if (IN(pb + 3)) { ph_kprep(F, P, l); ph_pool(F, P, M); SEAM(pb + 3); }
        if (IN(pb + 4)) {
            ph_dft<2>(F, P); ph_attn<1>(F, P, l);
            if (l == 0) { ph_attn<2>(F, P, l); ph_attn<3>(F, P, l); ph_fourier_ref(F, P, TC, 0); }
            xcd_barrier(bar);
            ph_dft<3>(F, P); ph_attn<0>(F, P, l);
            SEAM(pb + 4);
        }
        for (int i = 0; i <= 4; ++i) {
            if (IN(pb + 5 + i)) {
                if (i >= 1) { const int j = i - 1;
                    pg8::StaticOrder S; S.init(M, D, F.G, (int)blockIdx.x, BR + j * 512, NBR, Bt_br + (size_t)j * 1024 * 512, 512);
                    pg8::EpiV8<FMerge8> E{FMerge8{MG, GT + (size_t)(j & 1) * R * D, j == 0}};
                    pg8::gemm_phase(F.lds, F.wave, NBR, 512, 512, S, E); }
                if (i <= 3) {
                    pg8::StaticOrder S; S.init(M, D, F.G, (int)blockIdx.x, H, D, Bt_gate + (size_t)i * 1024 * 1024, D);
                    pg8::EpiV8<FGate8> E{FGate8{GT + (size_t)(i & 1) * R * D, P.b_gate + ((size_t)l * 4 + i) * D}};
                    pg8::gemm_phase(F.lds, F.wave, D, D, D, S, E); }
                SEAM(pb + 5 + i);
            }
        }
        if (IN(pb + 10)) {
            pg8::StaticOrder S; S.init(M, D, F.G, (int)blockIdx.x, MG, D, Bt_out, D);
            pg8::EpiV4<EpiOut> E{EpiOut{P, l}};
            pg8::gemm_phase(F.lds, F.wave, D, D, D, S, E);
            SEAM(pb + 10);
        }
        if (IN(pb + 11)) { ph_norm<2>(F, P, l, M); SEAM(pb + 11); }
        if (IN(pb + 12)) { ph_gather(F, P, l, M); SEAM(pb + 12); }
        if (IN(pb + 13) || IN(pb + 14)) {
            LAS int* ptab = (LAS int*)(F.lds + LDSCTL_OFF);
            if (fresh_tid() == 0) { const unsigned* cnt = (const unsigned*)(ws + WS_CTL) + CW_CNT + 1024 * l; int off = 0;
                for (int e = 0; e < 16; ++e) { ptab[e] = off; off += ((int)cnt[64 * e] + 255) >> 8; } ptab[16] = off; }
            __syncthreads();
            if (IN(pb + 13)) {
                pg8::MoeOrder S; S.nN = 4; S.G = F.G; S.c = (int)blockIdx.x; S.A = (const char*)AS; S.Bt = (const char*)Bt_13; S.astep = (size_t)256 * D * 2; S.bstep = (size_t)256 * D * 2; S.bexp = (size_t)1024 * 1024 * 2; S.ptab = (const int*)ptab;
                pg8::EpiDual<FMoe1> E{FMoe1{HID}};
                pg8::gemm_phase(F.lds, F.wave, D, D, D, S, E);
                SEAM(pb + 13);
            }
            if (IN(pb + 14)) {
                pg8::MoeOrder S; S.nN = 4; S.G = F.G; S.c = (int)blockIdx.x; S.A = (const char*)HID; S.Bt = (const char*)Bt_2; S.astep = (size_t)256 * FF * 2; S.bstep = (size_t)256 * FF * 2; S.bexp = (size_t)1024 * 512 * 2; S.ptab = (const int*)ptab;
                pg8::EpiV8<FMoe2> E{FMoe2{MO, (const int*)(ws + WS_ROWMAP), (const float*)(ws + WS_ROWW)}};
                pg8::gemm_phase(F.lds, F.wave, FF, FF, FF, S, E);
                SEAM(pb + 14);
            }
        }
    }
    if (IN(PH_FINAL)) ph_final(F, P);
#undef IN
#undef SEAM
}

extern "C" void kernel_launch(void* const* d_in, const int* in_sizes, int n_in, void* d_out, int out_size, void* d_ws, size_t ws_size, hipStream_t stream) {
    if (n_in != 24 || ws_size < WS_END || out_size != RL * D) { fprintf(stderr, "kernel_launch: unexpected sizes n_in %d ws %zu out %d\n", n_in, ws_size, out_size); return; }
    static int grid = 0;
    if (grid == 0) {
        int dev = 0, cus = 0;
        if (hipGetDevice(&dev) != hipSuccess || hipDeviceGetAttribute(&cus, hipDeviceAttributeMultiprocessorCount, dev) != hipSuccess) { grid = -1; return; }
        if (hipFuncSetAttribute((const void*)mega, hipFuncAttributeMaxDynamicSharedMemorySize, LDS_BYTES) != hipSuccess) { fprintf(stderr, "kernel_launch: hipFuncSetAttribute failed\n"); grid = -1; return; }
        int per_cu = 0;
        if (hipOccupancyMaxActiveBlocksPerMultiprocessor(&per_cu, (const void*)mega, NWAVES * 64, LDS_BYTES) != hipSuccess || per_cu < 1) fprintf(stderr, "kernel_launch: occupancy query says %d\n", per_cu);
        (void)hipGetLastError();
        grid = cus;
    }
    if (grid < 0) return;
    MegaArgs a{};
    const float** pp = (const float**)&a.P;
    for (int i = 0; i < 24; ++i) pp[i] = (const float*)d_in[i];
    a.P.out = (float*)d_out; a.P.ws = (unsigned char*)d_ws;
    (void)hipMemsetAsync((unsigned char*)d_ws + WS_CTL, 0, 1 * MiB, stream);
    a.ph_lo = 0; a.ph_hi = PH_FINAL + 1; a.li = 0;
    hipLaunchKernelGGL(mega, dim3(grid), dim3(NWAVES * 64), LDS_BYTES, stream, a);
}
```

```cpp
#include <hip/hip_runtime.h>
#include <cstdio>
#include <cstdint>

typedef unsigned short bf16_t;
typedef short bf16x8 __attribute__((ext_vector_type(8)));
typedef float f32x4 __attribute__((ext_vector_type(4)));
typedef unsigned u32x4 __attribute__((ext_vector_type(4)));
typedef unsigned u32x2 __attribute__((ext_vector_type(2)));

constexpr int D = 1024, NB = 8, T = 4096, TC = 256;
constexpr int RL = NB * T, RC = NB * TC, R = RL + RC;
constexpr int NIN = 3072;
constexpr int C_ZR = 0, C_ZI = 512, C_P = 1024, C_QB = 1536, C_KB = 2048, C_VB = 2176, C_QW = 2304, C_KW = 2816, C_VW = 2944;
constexpr int NBR = 2048;
constexpr int NE = 16, FF = 512;
constexpr int MAXROWS = 73728;
constexpr float EPS = 1e-6f;
constexpr float QSCALE = 0.125f * 1.4426950408889634f;
constexpr float LOG2E = 1.4426950408889634f;

constexpr size_t MiB = 1u << 20;
constexpr size_t WS_CTL = 0;
constexpr size_t WS_MOD = 1 * MiB;
constexpr size_t WS_ROPE = 1 * MiB + 512 * 1024;
constexpr size_t WS_COS = WS_ROPE + 16 * 1024;
constexpr size_t WS_DFTM = WS_ROPE + 64 * 1024;
constexpr size_t WS_TOKL = 2 * MiB;
constexpr size_t WS_WL = 4 * MiB + 512 * 1024;
constexpr size_t WS_XC = 9 * MiB;
constexpr size_t WS_WB = 17 * MiB;
constexpr size_t WB_IN = 0, WB_GATE = 6 * MiB, WB_BR = 14 * MiB, WB_OUT = 18 * MiB, WB_13 = 20 * MiB, WB_2 = 52 * MiB;
constexpr size_t WS_H = 85 * MiB;
constexpr size_t WS_ARENA = 153 * MiB;
constexpr size_t WS_U = WS_ARENA;
constexpr size_t WS_BR = WS_ARENA + 204 * MiB;
constexpr size_t WS_GT = WS_ARENA;
constexpr size_t WS_MG = WS_ARENA + 136 * MiB;
constexpr size_t WS_AS = WS_ARENA;
constexpr size_t WS_HID = WS_ARENA + 144 * MiB;
constexpr size_t WS_MO = WS_ARENA + 216 * MiB;
constexpr size_t WS_END = 512 * MiB;
static_assert(WS_BR + (size_t)R * NBR * 2 <= WS_END && WS_MO + (size_t)2 * R * D * 2 <= WS_END && WS_MG + (size_t)R * D * 2 <= WS_BR, "ws map");
constexpr int CW_CNT = 8192;

__device__ __forceinline__ float bf2f(bf16_t b) { return __uint_as_float(((unsigned)b) << 16); }
__device__ __forceinline__ unsigned f2bf(float f) { unsigned u = __float_as_uint(f); return (u + 0x7fffu + ((u >> 16) & 1u)) >> 16; }
__device__ __forceinline__ unsigned pk2(float lo, float hi) { return f2bf(lo) | (f2bf(hi) << 16); }
typedef __bf16 bf16x2_t __attribute__((ext_vector_type(2)));
typedef float f32x2_t __attribute__((ext_vector_type(2)));
__device__ __forceinline__ unsigned cvtpk(float lo, float hi) { f32x2_t v = {lo, hi}; bf16x2_t b = __builtin_convertvector(v, bf16x2_t); return __builtin_bit_cast(unsigned, b); }
__device__ __forceinline__ float lo16(unsigned w) { return __uint_as_float(w << 16); }
__device__ __forceinline__ float hi16(unsigned w) { return __uint_as_float(w & 0xffff0000u); }
__device__ __forceinline__ float shfl_xor_l(float v, int o, int lane) { return __int_as_float(__builtin_amdgcn_ds_bpermute((lane ^ o) << 2, __float_as_int(v))); }
__device__ __forceinline__ float wave_sum_l(float v, int lane) {
#pragma unroll
    for (int o = 1; o < 64; o <<= 1) v += shfl_xor_l(v, o, lane);
    return v;
}
__device__ __forceinline__ int row_bb(int r) { return r < RL ? (r >> 12) : 8; }

struct Ptrs {
    const float *x, *c, *ctx, *c_ctx, *w_ada, *b_ada, *norm1, *norm2, *w_in, *q_gain, *k_gain, *sink, *pool_w, *pool_scale,
        *w_branch, *w_gate, *b_gate, *w_out, *router_w, *router_bias, *w1, *w3, *w2, *norm_f;
    float* out; unsigned char* ws;
};
__device__ __forceinline__ const float* xin_row(const Ptrs& P, int r) { return r < RL ? P.x + (size_t)r * D : P.ctx + (size_t)(r - RL) * D; }
__device__ __forceinline__ float* x1_row(const Ptrs& P, int r) { return r < RL ? P.out + (size_t)r * D : (float*)(P.ws + WS_XC) + (size_t)(r - RL) * D; }
__device__ __forceinline__ const float* mod_vec(const Ptrs& P, int l, int bb, int which) { return (const float*)(P.ws + WS_MOD) + ((size_t)(l * 9 + bb) * 6 + which) * D; }

struct EpiOut { Ptrs P; int l;
    __device__ __forceinline__ void operator()(int row, int col, f32x4 v) const { const int bb = row_bb(row);
        const f32x4 g = *(const f32x4*)(mod_vec(P, l, bb, 2) + col); float* xo = x1_row(P, row) + col;
        const f32x4 xp = l == 0 ? *(const f32x4*)(xin_row(P, row) + col) : *(const f32x4*)xo;
        *(f32x4*)xo = xp + g * v; } };

#define LAS __attribute__((address_space(3)))
#define GAS __attribute__((address_space(1)))
#define LDS_WAIT() asm volatile("s_waitcnt lgkmcnt(0)" ::: "memory")
__device__ __forceinline__ int fresh_lane() { int l; asm volatile("v_mbcnt_lo_u32_b32 %0, -1, 0\n\tv_mbcnt_hi_u32_b32 %0, -1, %0" : "=v"(l)); return l; }
constexpr int NWAVES = 8;
constexpr int RING_BYTES = 131072, LDSCTL_OFF = RING_BYTES, MISC_OFF = LDSCTL_OFF + 320, LDS_BYTES = 147456;
constexpr int CW_BAR = 16384;
constexpr int NPH = 15, PH_FINAL = 2 * NPH;

#define XB_TMO      128
#define XB_XCNT(j)  (256  + 64 * (j))
#define XB_XSUB(j)  (1280 + 64 * (j))
#define XB_XGEN(j)  (2304 + 64 * (j))
#define XB_TOP      3328
#define XB_TOPGEN   3392
#define XCD_BAR_WORDS 3456
#define XB_SPIN_CAP (1u << 21)
__device__ __forceinline__ unsigned xb_ld(unsigned* p)              { return __hip_atomic_load(p, __ATOMIC_RELAXED, __HIP_MEMORY_SCOPE_AGENT); }
__device__ __forceinline__ unsigned xb_add(unsigned* p, unsigned v) { return __hip_atomic_fetch_add(p, v, __ATOMIC_RELAXED, __HIP_MEMORY_SCOPE_AGENT); }
__device__ __forceinline__ unsigned xb_xcc_id() { return (unsigned)__builtin_amdgcn_s_getreg((3 << 11) | 20) & 0xFu; }
#define XB_SPIN(cond, bar) do { unsigned _sp = 0; while (cond) { __builtin_amdgcn_s_sleep(1); \
    if ((++_sp & 255u) == 0u) { if (xb_ld(&(bar)[XB_TMO])) break; if (_sp > XB_SPIN_CAP) { atomicAdd(&(bar)[XB_TMO], 1u); break; } } } } while (0)
struct XcdBarrier { unsigned* bar; unsigned x; volatile LAS unsigned* st; int wave; };
__device__ __forceinline__ XcdBarrier xcd_barrier_post(unsigned* bar, volatile LAS unsigned* st, int wave) {
    XcdBarrier b; b.bar = bar; b.x = xb_xcc_id(); b.st = st; b.wave = wave;
    if (wave == 0 && fresh_lane() == 0) (void)xb_add(&bar[XB_XCNT(b.x)], 1u);
    return b;
}
__device__ __forceinline__ void xcd_barrier_complete(unsigned* bar, unsigned x, unsigned& nloc, unsigned& nx) {
    const unsigned G = gridDim.x * gridDim.y * gridDim.z;
    unsigned sum, cnt, mine, sp = 0u;
    for (;;) {
        sum = 0u; cnt = 0u; mine = 0u;
#pragma unroll
        for (unsigned j = 0; j < 16; ++j) { const unsigned c = xb_ld(&bar[XB_XCNT(j)]); sum += c; cnt += (c > 0u) ? 1u : 0u; mine = (j == x) ? c : mine; }
        if (sum == G) break;
        __builtin_amdgcn_s_sleep(1);
        if ((++sp & 255u) == 0u) { if (xb_ld(&bar[XB_TMO])) break; if (sp > XB_SPIN_CAP) { atomicAdd(&bar[XB_TMO], 1u); break; } }
    }
    nloc = mine > 0u ? mine : 1u; nx = cnt > 0u ? cnt : 1u;
}
__device__ __forceinline__ void xcd_barrier(const XcdBarrier& b) {
    asm volatile("s_waitcnt vmcnt(0)" ::: "memory");
    __syncthreads();
    if (b.wave == 0 && fresh_lane() == 0) {
        unsigned* bar = b.bar;
        __builtin_amdgcn_s_waitcnt(0);
        unsigned nloc = b.st[0], nx = b.st[1];
        if (nloc == 0u) { xcd_barrier_complete(bar, b.x, nloc, nx); b.st[0] = nloc; b.st[1] = nx; }
        const unsigned old = xb_add(&bar[XB_XSUB(b.x)], 1u);
        const unsigned gen = old / nloc;
        if (old + 1u == (gen + 1u) * nloc) {
            __builtin_amdgcn_fence(__ATOMIC_RELEASE, "agent");
            asm volatile("s_waitcnt vmcnt(0)" ::: "memory");
            const unsigned og = xb_add(&bar[XB_TOP], 1u);
            const unsigned tg = og / nx;
            if (og + 1u == (tg + 1u) * nx) xb_add(&bar[XB_TOPGEN], 1u);
            else XB_SPIN(xb_ld(&bar[XB_TOPGEN]) == tg, bar);
            __builtin_amdgcn_fence(__ATOMIC_ACQUIRE, "agent");
            xb_add(&bar[XB_XGEN(b.x)], 1u);
            asm volatile("s_waitcnt vmcnt(0)" ::: "memory");
        } else {
            XB_SPIN(xb_ld(&bar[XB_XGEN(b.x)]) == gen, bar);
            __builtin_amdgcn_fence(__ATOMIC_ACQUIRE, "agent");
            asm volatile("s_waitcnt vmcnt(0)" ::: "memory");
        }
    }
    __syncthreads();
}

namespace pg8 {
constexpr int BM = 256, BK = 64, HALF = 128, HTB = HALF * BK * 2, STAGE_BYTES = 8 * HTB, NXCD = 8, WGM = 8;
__host__ __device__ __forceinline__ int lds_byte(int r, int c) { const int st = (r >> 4) * 2 + (c >> 5), rr = r & 15, cc = c & 31, ob = rr * 64 + cc * 2; return st * 1024 + (ob ^ (((ob >> 9) & 1) << 5)); }
__host__ __device__ __forceinline__ void stage_rc(int b, int& Rr, int& C) { const int st = b / 1024, sb = b % 1024, swz = sb ^ (((sb >> 9) & 1) << 5); Rr = (st >> 1) * 16 + swz / 64; C = (st & 1) * 32 + (swz % 64) / 2; }
__host__ __device__ __forceinline__ int perm32(int rho) { const int n = rho >> 4, i = rho & 15; return 8 * (i >> 2) + 4 * n + (i & 3); }
struct Unit { int pm, pn; const char* a; const char* b; int e, p0, ce; };

struct StaticOrder {
    static constexpr bool GATHER = false;
    int nM, nN, nwg, G, c; const char* A; const char* Bt; size_t astep, bstep;
    __device__ void init(int M, int N, int G_, int c_, const bf16_t* A_, int lda, const bf16_t* Bt_, int ldb) { nM = M / BM; nN = N / BM; nwg = nM * nN; G = G_; c = c_; A = (const char*)A_; Bt = (const char*)Bt_; astep = (size_t)BM * lda * 2; bstep = (size_t)BM * ldb * 2; }
    __device__ bool next(int i, Unit& u) const {
        const long L = (long)i * G + c; if (L >= nwg) return false;
        int wgid = (int)L; { const int q = nwg / NXCD, r = nwg % NXCD, xcd = wgid % NXCD, off = wgid / NXCD; wgid = (xcd < r ? xcd * (q + 1) : r * (q + 1) + (xcd - r) * q) + off; }
        const int nig = WGM * nN, gid = wgid / nig, fm = gid * WGM, gsz = (nM - fm) < WGM ? (nM - fm) : WGM;
        u.pm = fm + ((wgid % nig) % gsz); u.pn = (wgid % nig) / gsz; u.a = A + (size_t)u.pm * astep; u.b = Bt + (size_t)u.pn * bstep; u.e = 0; u.p0 = 0; u.ce = 0; return true;
    }
};
template <bool GATHER_> struct MoeOrder {
    static constexpr bool GATHER = GATHER_;
    int nN, G, c; const char* A; const char* Bt; size_t astep, bstep, bexp; const int* tab; const int* tokl;
    __device__ bool next(int i, Unit& u) const {
        const int L = i * G + c; const int total = tab[16] * nN; if (L >= total) return false;
        u.pm = L / nN; u.pn = L % nN; int e = 0;
#pragma unroll
        for (int q = 1; q < 16; ++q) e += (u.pm >= tab[q]) ? 1 : 0;
        u.e = e; u.p0 = (u.pm - tab[e]) * BM; u.ce = tab[17 + e];
        u.a = GATHER_ ? A : A + (size_t)u.pm * astep; u.b = Bt + (size_t)e * bexp + (size_t)u.pn * bstep; return true;
    }
    __device__ __forceinline__ void aoffs(const Unit& u, const int (&Rr)[2], const int (&Cc)[2], int lda, unsigned (&off)[2][2]) const {
#pragma unroll
        for (int h = 0; h < 2; ++h)
#pragma unroll
            for (int i = 0; i < 2; ++i) { const int pos = u.p0 + h * HALF + Rr[i]; const int tok = pos < u.ce ? (tokl[(size_t)u.e * R + pos] >> 1) : 0; off[h][i] = (unsigned)(tok * lda + Cc[i]) * 2u; }
    }
};

template <class Epi, class Sched, bool ALIGN_EPI = true>
__device__ __forceinline__ void gemm_phase(LAS unsigned char* lds, const int wid, const int lda, const int ldb, const int K, const Sched& S, const Epi& E) {
    const int lane = fresh_lane(), tid = wid * 64 + lane, wr = wid >> 2, wc = wid & 3, fr = lane & 15, fq = lane >> 4;
    const int nt = K / BK;
    unsigned voffA[2], voffB[2]; int Rr2[2], Cc2[2];
#pragma unroll
    for (int i = 0; i < 2; ++i) { int Rr, C; stage_rc(tid * 16 + i * 8192, Rr, C); const int Rb = Epi::PERM ? ((Rr & ~31) + perm32(Rr & 31)) : Rr; Rr2[i] = Rr; Cc2[i] = C;
        voffA[i] = (unsigned)(Rr * lda + C) * 2u; voffB[i] = (unsigned)(Rb * ldb + C) * 2u; }
    const size_t kstep = (size_t)(BK * 2);
    const size_t hstepA = Sched::GATHER ? 0 : (size_t)HALF * lda * 2, hstepB = (size_t)HALF * ldb * 2;
    const unsigned ldsw = (unsigned)wid * 1024u;
    const int aoff = lds_byte(wr * 64 + fr, fq * 8), boff = lds_byte(wc * 32 + fr, fq * 8);
#define PG8_SA(b, h) (((b) * 2 + (h)) * HTB)
#define PG8_SB(b, h) ((4 + (b) * 2 + (h)) * HTB)
#define PG8_STAGE(bufoff, gbase, voff) do { _Pragma("unroll") for (int _i = 0; _i < 2; ++_i) \
        __builtin_amdgcn_global_load_lds((const unsigned*)((const char*)(gbase) + (voff)[_i]), (LAS unsigned*)(lds + (bufoff) + ldsw + _i * 8192), 16, 0, 0); } while (0)
#define PG8_STAGE_A(b, h, kp, OFFS) do { if constexpr (Sched::GATHER) { PG8_STAGE(PG8_SA(b, h), kp, OFFS[h]); } else { PG8_STAGE(PG8_SA(b, h), (kp) + (h) * hstepA, voffA); } } while (0)
#define PG8_LDA(dst, b, h) do { _Pragma("unroll") for (int m = 0; m < 4; ++m) _Pragma("unroll") for (int k = 0; k < 2; ++k) dst[m][k] = *(const LAS bf16x8*)(lds + PG8_SA(b, h) + aoff + m * 2048 + k * 1024); } while (0)
#define PG8_LDB(dst, b, h) do { _Pragma("unroll") for (int n = 0; n < 2; ++n) _Pragma("unroll") for (int k = 0; k < 2; ++k) dst[n][k] = *(const LAS bf16x8*)(lds + PG8_SB(b, h) + boff + n * 2048 + k * 1024); } while (0)
#define PG8_MMA(ai, bj, At, Bt) do { __builtin_amdgcn_s_setprio(1); _Pragma("unroll") for (int m = 0; m < 4; ++m) _Pragma("unroll") for (int n = 0; n < 2; ++n) _Pragma("unroll") for (int k = 0; k < 2; ++k) \
        acc[ai][bj][m][n] = __builtin_amdgcn_mfma_f32_16x16x32_bf16(Bt[n][k], At[m][k], acc[ai][bj][m][n], 0, 0, 0); __builtin_amdgcn_s_setprio(0); } while (0)
#define PG8_WAIT_V(n) asm volatile("s_waitcnt vmcnt(" #n ")" ::: "memory")
#define PG8_WAIT_L(n) asm volatile("s_waitcnt lgkmcnt(" #n ")" ::: "memory")
#define PG8_BAR __builtin_amdgcn_s_barrier()
#define PG8_SCHED __builtin_amdgcn_sched_barrier(0)
    Unit cur, nxt; int ui = 0;
    if (!S.next(0, cur)) return;
    f32x4 acc[2][2][4][2];
#pragma unroll
    for (int a = 0; a < 2; ++a)
#pragma unroll
        for (int b = 0; b < 2; ++b)
#pragma unroll
            for (int m = 0; m < 4; ++m)
#pragma unroll
                for (int n = 0; n < 2; ++n) acc[a][b][m][n] = (f32x4){0.f, 0.f, 0.f, 0.f};
    bf16x8 At[4][2], B0[2][2], B1[2][2];
    unsigned goffC[2][2], goffN[2][2];
    if constexpr (Sched::GATHER) { S.aoffs(cur, Rr2, Cc2, lda, goffC);
#pragma unroll
        for (int h = 0; h < 2; ++h)
#pragma unroll
            for (int i = 0; i < 2; ++i) goffN[h][i] = goffC[h][i]; }
    const char* cA = cur.a; const char* cB = cur.b;
    PG8_STAGE(PG8_SB(0, 0), cB, voffB); PG8_STAGE(PG8_SB(0, 1), cB + hstepB, voffB); PG8_STAGE_A(0, 0, cA, goffC); PG8_STAGE_A(0, 1, cA, goffC);
    if (wr == 1) PG8_BAR;
    PG8_WAIT_V(2); PG8_BAR;
    PG8_STAGE(PG8_SB(1, 0), cB + kstep, voffB); PG8_STAGE_A(1, 0, cA + kstep, goffC); PG8_STAGE(PG8_SB(1, 1), cB + hstepB + kstep, voffB);
    PG8_WAIT_V(6); PG8_BAR;
    for (;;) {
        const bool has_next = S.next(ui + 1, nxt);
        if constexpr (Sched::GATHER) { if (has_next) S.aoffs(nxt, Rr2, Cc2, lda, goffN); }
        const char* nA = has_next ? nxt.a : cA; const char* nB = has_next ? nxt.b : cB;
        for (int t = 0; t < nt; t += 2) {
            const bool last = (t == nt - 2);
            const char* a1 = cA + (size_t)(t + 1) * kstep;
            const char* a2 = last ? nA : cA + (size_t)(t + 2) * kstep; const char* b2 = last ? nB : cB + (size_t)(t + 2) * kstep;
            const char* a3 = a2 + kstep; const char* b3 = b2 + kstep;
            unsigned gx[2][2];
            if constexpr (Sched::GATHER) {
#pragma unroll
                for (int h = 0; h < 2; ++h)
#pragma unroll
                    for (int i = 0; i < 2; ++i) gx[h][i] = (last && has_next) ? goffN[h][i] : goffC[h][i]; }
            PG8_LDB(B0, 0, 0); PG8_LDB(B1, 0, 1); PG8_SCHED; PG8_LDA(At, 0, 0); PG8_STAGE_A(1, 1, a1, goffC);
            PG8_WAIT_V(8); PG8_WAIT_L(0); PG8_BAR; PG8_MMA(0, 0, At, B0); PG8_MMA(0, 1, At, B1); PG8_BAR; PG8_SCHED;
            PG8_LDA(At, 0, 1); PG8_STAGE(PG8_SB(0, 0), b2, voffB); PG8_STAGE(PG8_SB(0, 1), b2 + hstepB, voffB); PG8_STAGE_A(0, 0, a2, gx);
            PG8_WAIT_V(8); PG8_WAIT_L(0); PG8_BAR; PG8_MMA(1, 0, At, B0); PG8_MMA(1, 1, At, B1); PG8_BAR; PG8_SCHED;
            PG8_LDB(B0, 1, 0); PG8_LDB(B1, 1, 1); PG8_SCHED; PG8_LDA(At, 1, 0); PG8_STAGE_A(0, 1, a2, gx);
            PG8_WAIT_V(8); PG8_WAIT_L(0); PG8_BAR; PG8_MMA(0, 0, At, B0); PG8_MMA(0, 1, At, B1); PG8_BAR; PG8_SCHED;
            PG8_LDA(At, 1, 1); PG8_STAGE(PG8_SB(1, 0), b3, voffB); PG8_STAGE(PG8_SB(1, 1), b3 + hstepB, voffB); PG8_STAGE_A(1, 0, a3, gx);
            PG8_WAIT_V(8); PG8_WAIT_L(0); PG8_BAR; PG8_MMA(1, 0, At, B0); PG8_MMA(1, 1, At, B1); PG8_BAR; PG8_SCHED;
        }
        if constexpr (ALIGN_EPI) { if (wr == 0) PG8_BAR; }
        E(acc, cur, wr, wc, fr, fq);
        if (!has_next) break;
#pragma unroll
        for (int a = 0; a < 2; ++a)
#pragma unroll
            for (int b = 0; b < 2; ++b)
#pragma unroll
                for (int m = 0; m < 4; ++m)
#pragma unroll
                    for (int n = 0; n < 2; ++n) acc[a][b][m][n] = (f32x4){0.f, 0.f, 0.f, 0.f};
        cur = nxt; cA = nA; cB = nB; ++ui;
        if constexpr (Sched::GATHER) {
#pragma unroll
            for (int h = 0; h < 2; ++h)
#pragma unroll
                for (int i = 0; i < 2; ++i) goffC[h][i] = goffN[h][i]; }
        if constexpr (ALIGN_EPI) { if (wr == 1) PG8_BAR; }
    }
    PG8_WAIT_V(0);
    if constexpr (!ALIGN_EPI) { if (wr == 0) PG8_BAR; }
    PG8_BAR;
#undef PG8_SA
#undef PG8_SB
#undef PG8_STAGE
#undef PG8_STAGE_A
#undef PG8_LDA
#undef PG8_LDB
#undef PG8_MMA
#undef PG8_WAIT_V
#undef PG8_WAIT_L
#undef PG8_BAR
#undef PG8_SCHED
}
template <class F> struct EpiV4 { static constexpr bool PERM = false; F f;
    __device__ __forceinline__ void operator()(const f32x4 (&acc)[2][2][4][2], const Unit& u, int wr, int wc, int, int) const {
        const int ln = fresh_lane(), fr = ln & 15, fq = ln >> 4;
        const int row0 = u.pm * BM + wr * 64 + fr, col0 = u.pn * BM + wc * 32 + 4 * fq;
        typename F::UnitPre up = f.unit(u, col0);
#pragma unroll
        for (int ai = 0; ai < 2; ++ai) {
            typename F::Pre pre[4][2][2];
#pragma unroll
            for (int m = 0; m < 4; ++m)
#pragma unroll
                for (int bj = 0; bj < 2; ++bj)
#pragma unroll
                    for (int n = 0; n < 2; ++n) pre[m][bj][n] = f.load(u, row0 + ai * HALF + m * 16, col0 + bj * HALF + n * 16);
#pragma unroll
            for (int m = 0; m < 4; ++m)
#pragma unroll
                for (int bj = 0; bj < 2; ++bj)
#pragma unroll
                    for (int n = 0; n < 2; ++n) f.fin(u, row0 + ai * HALF + m * 16, col0 + bj * HALF + n * 16, acc[ai][bj][m][n], pre[m][bj][n], up, bj * 2 + n);
            asm volatile("" ::: "memory"); }
    } };
template <class F> struct EpiV8 { static constexpr bool PERM = true; F f;
    __device__ __forceinline__ void operator()(const f32x4 (&acc)[2][2][4][2], const Unit& u, int wr, int wc, int, int) const {
        const int ln = fresh_lane(), fr = ln & 15, fq = ln >> 4;
        const int row0 = u.pm * BM + wr * 64 + fr, col0 = u.pn * BM + wc * 32 + 8 * fq;
#pragma unroll
        for (int ai = 0; ai < 2; ++ai) {
            typename F::Pre pre[4][2];
#pragma unroll
            for (int m = 0; m < 4; ++m)
#pragma unroll
                for (int bj = 0; bj < 2; ++bj) pre[m][bj] = f.load(u, row0 + ai * HALF + m * 16, col0 + bj * HALF);
#pragma unroll
            for (int m = 0; m < 4; ++m)
#pragma unroll
                for (int bj = 0; bj < 2; ++bj) f.fin(u, row0 + ai * HALF + m * 16, col0 + bj * HALF, acc[ai][bj][m][0], acc[ai][bj][m][1], pre[m][bj]);
            asm volatile("" ::: "memory"); }
    } };
template <class F> struct EpiDual { static constexpr bool PERM = true; F f;
    __device__ __forceinline__ void operator()(const f32x4 (&acc)[2][2][4][2], const Unit& u, int wr, int wc, int, int) const {
        const int ln = fresh_lane(), fr = ln & 15, fq = ln >> 4;
        const int row0 = u.pm * BM + wr * 64 + fr, hc0 = u.pn * HALF + wc * 32 + 8 * fq;
#pragma unroll
        for (int ai = 0; ai < 2; ++ai)
#pragma unroll
            for (int m = 0; m < 4; ++m) f.apply8(row0 + ai * HALF + m * 16, hc0, acc[ai][0][m][0], acc[ai][0][m][1], acc[ai][1][m][0], acc[ai][1][m][1]);
    } };
}

__device__ __forceinline__ u32x4 pack8(f32x4 a, f32x4 b) { u32x4 w; w.x = cvtpk(a.x, a.y); w.y = cvtpk(a.z, a.w); w.z = cvtpk(b.x, b.y); w.w = cvtpk(b.z, b.w); return w; }
__device__ __forceinline__ float sigm1(float x) { return __builtin_amdgcn_rcpf(1.0f + __builtin_amdgcn_exp2f(-1.4426950408889634f * x)); }
__device__ __forceinline__ f32x4 sigm4(f32x4 v) { f32x4 r; r.x = sigm1(v.x); r.y = sigm1(v.y); r.z = sigm1(v.z); r.w = sigm1(v.w); return r; }
struct NoPre {};
struct FStore8 { bf16_t* C; int ldc; typedef NoPre Pre;
    __device__ __forceinline__ Pre load(const pg8::Unit&, int, int) const { return Pre{}; }
    __device__ __forceinline__ void fin(const pg8::Unit&, int row, int col, f32x4 a, f32x4 b, const Pre&) const { *(u32x4*)(C + (size_t)row * ldc + col) = pack8(a, b); } };
struct FGate8 { bf16_t* G; const float* bias; typedef NoPre Pre;
    __device__ __forceinline__ Pre load(const pg8::Unit&, int, int) const { return Pre{}; }
    __device__ __forceinline__ void fin(const pg8::Unit&, int row, int col, f32x4 a, f32x4 b, const Pre&) const { const f32x4 b0 = *(const f32x4*)(bias + col), b1 = *(const f32x4*)(bias + col + 4);
        *(u32x4*)(G + (size_t)row * D + col) = pack8(sigm4(a + b0), sigm4(b + b1)); } };
struct FMerge8 { bf16_t* MG; const bf16_t* G; int first; struct Pre { u32x4 g, p; };
    __device__ __forceinline__ Pre load(const pg8::Unit&, int row, int col) const { const size_t o = (size_t)row * D + col; Pre r; r.g = *(const u32x4*)(G + o); r.p = first ? (u32x4){0u, 0u, 0u, 0u} : *(const u32x4*)(MG + o); return r; }
    __device__ __forceinline__ void fin(const pg8::Unit&, int row, int col, f32x4 a, f32x4 b, const Pre& q) const { const size_t o = (size_t)row * D + col;
        a = a * (f32x4){lo16(q.g.x), hi16(q.g.x), lo16(q.g.y), hi16(q.g.y)} + (f32x4){lo16(q.p.x), hi16(q.p.x), lo16(q.p.y), hi16(q.p.y)};
        b = b * (f32x4){lo16(q.g.z), hi16(q.g.z), lo16(q.g.w), hi16(q.g.w)} + (f32x4){lo16(q.p.z), hi16(q.p.z), lo16(q.p.w), hi16(q.p.w)};
        *(u32x4*)(MG + o) = pack8(a, b); } };
struct FMoe1 { bf16_t* HID;
    __device__ __forceinline__ void apply8(int row, int hc, f32x4 a0, f32x4 a1, f32x4 b0, f32x4 b1) const {
        *(u32x4*)(HID + (size_t)row * FF + hc) = pack8(a0 * sigm4(a0) * b0, a1 * sigm4(a1) * b1); } };
struct FMoe2 { bf16_t* MO; const int* tokl; const float* wl; struct Pre { int t; float w; };
    __device__ __forceinline__ Pre load(const pg8::Unit& u, int row, int) const { Pre r; const int pos = u.p0 + (row - u.pm * 256); r.t = -1; r.w = 0.f;
        if (pos < u.ce) { r.t = tokl[(size_t)u.e * R + pos]; r.w = wl[(size_t)u.e * R + pos]; } return r; }
    __device__ __forceinline__ void fin(const pg8::Unit&, int, int col, f32x4 a, f32x4 b, const Pre& q) const { if (q.t < 0) return;
        *(u32x4*)(MO + ((size_t)(q.t & 1) * R + (q.t >> 1)) * D + col) = pack8(a * q.w, b * q.w); } };
struct FOut { Ptrs P; int l; typedef f32x4 Pre; struct UnitPre { f32x4 g[4]; };
    __device__ __forceinline__ UnitPre unit(const pg8::Unit& u, int col0) const { UnitPre r; const float* g = mod_vec(P, l, row_bb(u.pm * 256), 2) + col0;
#pragma unroll
        for (int q = 0; q < 4; ++q) r.g[q] = *(const f32x4*)(g + (q >> 1) * 128 + (q & 1) * 16);
        return r; }
    __device__ __forceinline__ Pre load(const pg8::Unit&, int row, int col) const { return l == 0 ? *(const f32x4*)(xin_row(P, row) + col) : *(const f32x4*)(x1_row(P, row) + col); }
    __device__ __forceinline__ void fin(const pg8::Unit&, int row, int col, f32x4 v, const Pre& xp, const UnitPre& up, int q) const { *(f32x4*)(x1_row(P, row) + col) = xp + up.g[q] * v; } };

struct Frame { LAS unsigned char* lds; int wave, vcu, G; };
#define fresh_tid() (F.wave * 64 + fresh_lane())
__device__ __forceinline__ void tr_item(const float* W, int ldw, int k0, int csrc0, bf16_t* WT, int ldt, int drow0, LAS float* scr, int lane) {
#pragma unroll 8
    for (int i = 0; i < 32; ++i) { const int kk = 2 * i + (lane >> 5); scr[kk * 33 + (lane & 31)] = W[(size_t)(k0 + kk) * ldw + csrc0 + (lane & 31)]; }
    LDS_WAIT(); asm volatile("" ::: "memory");
    const int c = lane & 7;
#pragma unroll
    for (int j = 0; j < 4; ++j) { const int n = (lane >> 3) + 8 * j; const LAS float* s = scr + (8 * c) * 33 + n;
        u32x4 o; o.x = pk2(s[0 * 33], s[1 * 33]); o.y = pk2(s[2 * 33], s[3 * 33]); o.z = pk2(s[4 * 33], s[5 * 33]); o.w = pk2(s[6 * 33], s[7 * 33]);
        *(u32x4*)(WT + (size_t)(drow0 + n) * ldt + k0 + 8 * c) = o; }
    LDS_WAIT(); asm volatile("" ::: "memory");
}
__device__ __forceinline__ void ph_weights(const Frame& F, const Ptrs& P, int l) {
    const int tid0 = fresh_tid(), lane0 = tid0 & 63;
    LAS float* scr = (LAS float*)(F.lds + F.wave * 16384);
    const int gw = F.vcu * NWAVES + F.wave, NGW = F.G * NWAVES;
    unsigned char* wb = P.ws + WS_WB;
    constexpr int I0 = 1024, I1 = I0 + 2048, I2 = I1 + 768, I3 = I2 + 512, I4 = I3 + 4096, I5 = I4 + 4096, I6 = I5 + 4096;
    for (int it = gw; it < I6; it += NGW) {
        if (it < I0) { const int kb = it >> 6, nb = it & 63; tr_item(P.w_in + (size_t)l * 1024 * 2560, 2560, kb * 64, 512 + nb * 32, (bf16_t*)(wb + WB_IN), 1024, 1024 + nb * 32, scr, lane0); }
        else if (it < I1) { const int r = it - I0, i = r >> 9, q = r & 511, kb = q >> 5, nb = q & 31; tr_item(P.w_gate + ((size_t)l * 4 + i) * 1024 * 1024, 1024, kb * 64, nb * 32, (bf16_t*)(wb + WB_GATE) + (size_t)i * 1024 * 1024, 1024, nb * 32, scr, lane0); }
        else if (it < I2) { const int r = it - I1, i = r >> 8, q = r & 255, kb = q >> 5, nb = q & 31; tr_item(P.w_branch + ((size_t)l * 4 + i) * 512 * 1024, 1024, kb * 64, nb * 32, (bf16_t*)(wb + WB_BR) + (size_t)i * 1024 * 512, 512, nb * 32, scr, lane0); }
        else if (it < I3) { const int q = it - I2, kb = q >> 5, nb = q & 31; tr_item(P.w_out + (size_t)l * 1024 * 1024, 1024, kb * 64, nb * 32, (bf16_t*)(wb + WB_OUT), 1024, nb * 32, scr, lane0); }
        else if (it < I5) { const int w3 = it >= I4; const int r = it - (w3 ? I4 : I3), e = r >> 8, q = r & 255, kb = q >> 4, nb = q & 15, c = nb * 32;
            tr_item((w3 ? P.w3 : P.w1) + ((size_t)l * 16 + e) * 1024 * 512, 512, kb * 64, c, (bf16_t*)(wb + WB_13) + (size_t)e * 1024 * 1024, 1024, 256 * (c >> 7) + (c & 127) + (w3 ? 128 : 0), scr, lane0); }
        else { const int r = it - I5, e = r >> 8, q = r & 255, kb = q >> 5, nb = q & 31; tr_item(P.w2 + ((size_t)l * 16 + e) * 512 * 1024, 1024, kb * 64, nb * 32, (bf16_t*)(wb + WB_2) + (size_t)e * 1024 * 512, 512, nb * 32, scr, lane0); }
    }
    __syncthreads();
    for (int u = F.vcu; u < 64; u += F.G) {
        LAS float* Wl = (LAS float*)F.lds; LAS float* ct = Wl + 64 * 128;
        const int kt = u >> 2, g = u & 3, k0 = kt * 64, tid = tid0; const float* w_in = P.w_in + (size_t)l * 1024 * 2560;
        if (tid < 128) ct[tid] = __builtin_amdgcn_cosf((float)tid * (1.0f / 128.0f));
        for (int i = tid; i < 64 * 128; i += 512) { const int k = i >> 7, c = i & 127; Wl[k * 128 + c] = w_in[(size_t)(k0 + k) * 2560 + g * 128 + c]; }
        __syncthreads();
        const int part = (tid >> 7) & 1, m = tid & 127, kh = tid >> 8; const float sc = 0.08838834764831845f;
        bf16_t* drow = (bf16_t*)(wb + WB_IN) + (size_t)(part * 512 + g * 128 + m) * 1024 + k0;
        for (int kb = kh * 32; kb < kh * 32 + 32; kb += 8) { float acc[8];
#pragma unroll
            for (int j = 0; j < 8; ++j) acc[j] = 0.f;
            for (int c = 0; c < 128; ++c) { const int idx = (c * m) & 127; const float tw = part ? -ct[(idx - 32) & 127] : ct[idx];
#pragma unroll
                for (int j = 0; j < 8; ++j) acc[j] += Wl[(kb + j) * 128 + c] * tw; }
            u32x4 o; o.x = pk2(acc[0] * sc, acc[1] * sc); o.y = pk2(acc[2] * sc, acc[3] * sc); o.z = pk2(acc[4] * sc, acc[5] * sc); o.w = pk2(acc[6] * sc, acc[7] * sc);
            *(u32x4*)(drow + kb) = o; }
        __syncthreads();
    }
    for (int u = F.G - 1 - F.vcu; u < 64; u += F.G) {
        LAS float* Wb = (LAS float*)F.lds;
        const int g = u >> 4, n0 = (u & 15) * 64, tid = tid0;
        const float* ps = P.pool_scale + (size_t)l * 512; const float* wb3 = P.w_branch + ((size_t)l * 4 + 3) * 512 * 1024; const float* pwl = P.pool_w + (size_t)l * 4 * 128 * 128;
        for (int i = tid; i < 128 * 64; i += 512) { const int e = i >> 6, n = i & 63; Wb[e * 64 + n] = ps[g * 128 + e] * wb3[(size_t)(g * 128 + e) * 1024 + n0 + n]; }
        __syncthreads();
        const int c = tid & 127, nh = tid >> 7; const float* pw = pwl + (size_t)(g * 128 + c) * 128;
        float acc[16];
#pragma unroll
        for (int j = 0; j < 16; ++j) acc[j] = 0.f;
        for (int e = 0; e < 128; ++e) { const float p = pw[e];
#pragma unroll
            for (int j = 0; j < 16; ++j) acc[j] += p * Wb[e * 64 + nh * 16 + j]; }
        bf16_t* Bt = (bf16_t*)(wb + WB_BR) + (size_t)3 * 1024 * 512;
#pragma unroll
        for (int j = 0; j < 16; ++j) Bt[(size_t)(n0 + nh * 16 + j) * 512 + g * 128 + c] = (bf16_t)f2bf(acc[j]);
        __syncthreads();
    }
}
__device__ __forceinline__ void ph_tables_mod(const Frame& F, const Ptrs& P) {
    const int tid0 = fresh_tid();
    { float* rc = (float*)(P.ws + WS_ROPE); float* rs = rc + 1024; float* ct = (float*)(P.ws + WS_COS);
      const int i = F.vcu * 512 + tid0;
      if (i < 1024) { const int pos = i >> 4, f = i & 15; const float inv = exp2f(-(float)f * (13.287712379549449f / 16.0f));
          float rev = (float)pos * inv * 0.15915494309189535f; rev = rev - floorf(rev);
          rc[i] = __builtin_amdgcn_cosf(rev); rs[i] = __builtin_amdgcn_sinf(rev); }
      if (i < 4096) ct[i] = __builtin_amdgcn_cosf((float)i * (1.0f / 4096.0f));
      if (i < 16384) { const int mm = i >> 7, k = i & 127, pp = mm >> 6, k1 = mm & 63, pk = k >> 6, t1 = k & 63; const float rev = (float)((k1 * t1) & 63) * (1.0f / 64.0f);
          const float c = __builtin_amdgcn_cosf(rev), sn = __builtin_amdgcn_sinf(rev);
          ((bf16_t*)(P.ws + WS_DFTM))[i] = (bf16_t)f2bf(pp == pk ? c : (pp == 0 ? sn : -sn)); } }
    for (int u = F.vcu; u < 192; u += F.G) {
        LAS float* s = (LAS float*)F.lds; LAS float* red = s + 9 * 1024;
        const int l = u / 96, j0 = (u % 96) * 64, tid = tid0;
        for (int i = tid; i < 9 * 1024; i += 512) { const int bb = i >> 10, k = i & 1023; const float v = bb < 8 ? P.c[bb * 1024 + k] : P.c_ctx[k]; s[i] = v / (1.f + expf(-v)); }
        __syncthreads();
        const int kc = tid >> 6, jj = tid & 63; float acc[9];
#pragma unroll
        for (int b = 0; b < 9; ++b) acc[b] = 0.f;
        const float* w = P.w_ada + (size_t)l * 1024 * 6144 + j0 + jj;
        for (int k = kc * 128; k < kc * 128 + 128; ++k) { const float wv = w[(size_t)k * 6144];
#pragma unroll
            for (int b = 0; b < 9; ++b) acc[b] += s[b * 1024 + k] * wv; }
#pragma unroll
        for (int b = 0; b < 9; ++b) red[(kc * 9 + b) * 64 + jj] = acc[b];
        __syncthreads();
        float* mod = (float*)(P.ws + WS_MOD);
        for (int i = tid; i < 9 * 64; i += 512) { const int b = i >> 6, j = i & 63; float v = P.b_ada[l * 6144 + j0 + j];
#pragma unroll
            for (int q = 0; q < 8; ++q) v += red[(q * 9 + b) * 64 + j];
            mod[(size_t)(l * 9 + b) * 6144 + j0 + j] = v; }
        __syncthreads();
    }
}
__device__ __forceinline__ void route_row(const Ptrs& P, int r, const f32x4 (&h)[4], int lane, bool publish, LAS unsigned* lcnt, LAS int* rec) {
    float lg[16];
#pragma unroll
    for (int e = 0; e < 16; ++e) lg[e] = 0.f;
#pragma unroll
    for (int j = 0; j < 4; ++j) {
#pragma unroll
        for (int i = 0; i < 4; ++i) { const f32x4* rw = (const f32x4*)(P.router_w + (size_t)(4 * lane + 256 * j + i) * 16); const float hv = h[j][i];
#pragma unroll
            for (int qd = 0; qd < 4; ++qd) { const f32x4 w = rw[qd]; lg[4 * qd] += hv * w.x; lg[4 * qd + 1] += hv * w.y; lg[4 * qd + 2] += hv * w.z; lg[4 * qd + 3] += hv * w.w; } }
        __builtin_amdgcn_sched_barrier(0); }
    float v8[8], v4[4], v2[2], v1;
    { const bool bit = (lane & 32) != 0;
#pragma unroll
      for (int i = 0; i < 8; ++i) { const float a = lg[i], b = lg[i + 8]; v8[i] = (bit ? b : a) + shfl_xor_l(bit ? a : b, 32, lane); } }
    { const bool bit = (lane & 16) != 0;
#pragma unroll
      for (int i = 0; i < 4; ++i) { const float a = v8[i], b = v8[i + 4]; v4[i] = (bit ? b : a) + shfl_xor_l(bit ? a : b, 16, lane); } }
    { const bool bit = (lane & 8) != 0;
#pragma unroll
      for (int i = 0; i < 2; ++i) { const float a = v4[i], b = v4[i + 2]; v2[i] = (bit ? b : a) + shfl_xor_l(bit ? a : b, 8, lane); } }
    { const bool bit = (lane & 4) != 0; const float a = v2[0], b = v2[1]; v1 = (bit ? b : a) + shfl_xor_l(bit ? a : b, 4, lane); }
    v1 += shfl_xor_l(v1, 2, lane); v1 += shfl_xor_l(v1, 1, lane);
    float bestscore = -INFINITY; int be0 = 0, be1 = 1; float ba0 = 0.f, ba1 = 0.f;
#pragma unroll
    for (int g = 0; g < 4; ++g) {
        float aff[4], sel[4];
#pragma unroll
        for (int i = 0; i < 4; ++i) { const float t = __int_as_float(__builtin_amdgcn_ds_bpermute((4 * g + i) << 4, __float_as_int(v1))); aff[i] = 1.0f / (1.0f + expf(-t)); sel[i] = aff[i] + P.router_bias[4 * g + i]; }
        int i1 = 0; float m1 = sel[0], a1 = aff[0];
#pragma unroll
        for (int i = 1; i < 4; ++i) if (sel[i] > m1) { m1 = sel[i]; a1 = aff[i]; i1 = i; }
        int i2 = -1; float m2 = -INFINITY, a2 = 0.f;
#pragma unroll
        for (int i = 0; i < 4; ++i) if (i != i1 && sel[i] > m2) { m2 = sel[i]; a2 = aff[i]; i2 = i; }
        const float score = m1 + m2;
        if (score > bestscore) { bestscore = score; be0 = 4 * g + i1; be1 = 4 * g + i2; ba0 = a1; ba1 = a2; }
    }
    if (lane == 0 && publish) {
        const int p0 = (int)__hip_atomic_fetch_add(lcnt + be0, 1u, __ATOMIC_RELAXED, __HIP_MEMORY_SCOPE_WORKGROUP), p1 = (int)__hip_atomic_fetch_add(lcnt + be1, 1u, __ATOMIC_RELAXED, __HIP_MEMORY_SCOPE_WORKGROUP);
        const float inv = 1.0f / (ba0 + ba1);
        rec[0] = r; rec[1] = be0; rec[2] = p0; rec[3] = be1; rec[4] = p1; rec[5] = __float_as_int(ba0 * inv); rec[6] = __float_as_int(ba1 * inv);
    }
}
template <int MODE> __device__ __forceinline__ void ph_norm(const Frame& F, const Ptrs& P, int l, int nrows) {
    const int lane = fresh_lane();
    const int stride = F.G * NWAVES;
    LAS unsigned* lcnt = (LAS unsigned*)F.lds; LAS unsigned* gbase = lcnt + 16; LAS int* recs = (LAS int*)(F.lds + 256);
    if (MODE == 2) { if (F.wave == 0 && lane < 16) lcnt[lane] = 0u; __syncthreads(); }
    int it = 0;
    for (int rb = F.vcu * NWAVES + F.wave; rb < nrows; rb += 2 * stride, ++it) {
        int rr[2]; rr[0] = rb; rr[1] = rb + stride < nrows ? rb + stride : rb;
        f32x4 v[2][4];
#pragma unroll
        for (int q = 0; q < 2; ++q) { const int r = rr[q];
            if (MODE == 0) { const f32x4* xr = (const f32x4*)xin_row(P, r) + lane;
#pragma unroll
                for (int j = 0; j < 4; ++j) v[q][j] = xr[64 * j]; }
            else { const f32x4* xr = (const f32x4*)x1_row(P, r) + lane;
#pragma unroll
                for (int j = 0; j < 4; ++j) v[q][j] = xr[64 * j]; } }
        if (MODE == 1) {
#pragma unroll
            for (int q = 0; q < 2; ++q) { const int r = rr[q]; const int bb = row_bb(r); const f32x4* g2 = (const f32x4*)mod_vec(P, l - 1, bb, 5) + lane;
                const u32x2* m0 = (const u32x2*)((const bf16_t*)(P.ws + WS_MO) + (size_t)r * D) + lane; const u32x2* m1 = (const u32x2*)((const bf16_t*)(P.ws + WS_MO) + (size_t)(R + r) * D) + lane;
#pragma unroll
                for (int j = 0; j < 4; ++j) { const u32x2 a = m0[64 * j], b = m1[64 * j]; const f32x4 g = g2[64 * j];
                    v[q][j].x += g.x * (lo16(a.x) + lo16(b.x)); v[q][j].y += g.y * (hi16(a.x) + hi16(b.x)); v[q][j].z += g.z * (lo16(a.y) + lo16(b.y)); v[q][j].w += g.w * (hi16(a.y) + hi16(b.y)); } }
            if (rr[1] != rr[0]) { f32x4* xr = (f32x4*)x1_row(P, rr[1]) + lane;
#pragma unroll
                for (int j = 0; j < 4; ++j) xr[64 * j] = v[1][j]; }
            { f32x4* xr = (f32x4*)x1_row(P, rr[0]) + lane;
#pragma unroll
              for (int j = 0; j < 4; ++j) xr[64 * j] = v[0][j]; }
        }
        float ss[2];
#pragma unroll
        for (int q = 0; q < 2; ++q) { ss[q] = 0.f;
#pragma unroll
            for (int j = 0; j < 4; ++j) ss[q] += (v[q][j].x * v[q][j].x + v[q][j].y * v[q][j].y) + (v[q][j].z * v[q][j].z + v[q][j].w * v[q][j].w); }
#pragma unroll
        for (int o = 1; o < 64; o <<= 1) { ss[0] += shfl_xor_l(ss[0], o, lane); ss[1] += shfl_xor_l(ss[1], o, lane); }
        const f32x4* gn = (const f32x4*)((MODE == 2 ? P.norm2 : P.norm1) + (size_t)l * D) + lane;
#pragma unroll
        for (int q = 0; q < 2; ++q) { const int r = rr[q]; const int bb = row_bb(r);
            const float rstd = 1.0f / sqrtf(ss[q] * (1.0f / D) + EPS);
            const f32x4* sh = (const f32x4*)mod_vec(P, l, bb, MODE == 2 ? 3 : 0) + lane;
            const f32x4* sc = (const f32x4*)mod_vec(P, l, bb, MODE == 2 ? 4 : 1) + lane;
            u32x2* o = (u32x2*)((bf16_t*)(P.ws + WS_H) + (size_t)r * D) + lane;
#pragma unroll
            for (int j = 0; j < 4; ++j) { const f32x4 g = gn[64 * j], a = sh[64 * j], b = sc[64 * j];
                v[q][j] = (v[q][j] * rstd * g) * (b + 1.0f) + a;
                u32x2 w; w.x = cvtpk(v[q][j].x, v[q][j].y); w.y = cvtpk(v[q][j].z, v[q][j].w); o[64 * j] = w; } }
        if (MODE == 2) { LAS int* rec = recs + (F.wave * 24 + 2 * it) * 8;
            route_row(P, rr[0], v[0], lane, true, lcnt, rec); __builtin_amdgcn_sched_barrier(0);
            if (lane == 0 && rr[1] == rr[0]) rec[8] = -1;
            route_row(P, rr[1], v[1], lane, rr[1] != rr[0], lcnt, rec + 8); }
    }
    if (MODE == 2) {
        __syncthreads();
        const int tid = F.wave * 64 + lane;
        if (tid < 16) { const unsigned c = lcnt[tid]; gbase[tid] = c ? atomicAdd((unsigned*)(P.ws + WS_CTL) + CW_CNT + 1024 * l + 64 * tid, c) : 0u; }
        __syncthreads();
        if (lane == 0) for (int k = 0; k < 2 * it; ++k) { const LAS int* rec = recs + (F.wave * 24 + k) * 8; const int r = rec[0]; if (r < 0) continue;
            int* tokl = (int*)(P.ws + WS_TOKL); float* wl = (float*)(P.ws + WS_WL);
            const size_t i0 = (size_t)rec[1] * R + rec[2] + gbase[rec[1]], i1 = (size_t)rec[3] * R + rec[4] + gbase[rec[3]];
            tokl[i0] = 2 * r; wl[i0] = __int_as_float(rec[5]); tokl[i1] = 2 * r + 1; wl[i1] = __int_as_float(rec[6]); }
        __syncthreads();
    }
}
__device__ __forceinline__ void ph_kprep(const Frame& F, const Ptrs& P, int l) {
    const int lane = fresh_lane();
    const float* rc = (const float*)(P.ws + WS_ROPE); const float* rs = rc + 1024;
    const int hs = (lane >> 3) & 3, chunk = lane & 7, col = (hs < 2 ? C_KB + hs * 64 : C_KW + (hs - 2) * 64) + chunk * 8;
    const f32x4 g0 = *(const f32x4*)(P.k_gain + l * 64 + chunk * 8), g1 = *(const f32x4*)(P.k_gain + l * 64 + chunk * 8 + 4);
    const int a = chunk >> 2, fi = (chunk & 1) * 8; const bool second = (chunk & 2) != 0;
    const int npair = R / 2, stride = F.G * NWAVES;
    for (int pr0 = F.vcu * NWAVES + F.wave; pr0 < npair; pr0 += 4 * stride) {
        u32x4 w[4];
#pragma unroll
        for (int q = 0; q < 4; ++q) { const int pr = pr0 + q * stride; const int r = 2 * (pr < npair ? pr : pr0) + (lane >> 5); w[q] = *(const u32x4*)((const bf16_t*)(P.ws + WS_U) + (size_t)r * NIN + col); }
#pragma unroll
        for (int q = 0; q < 4; ++q) { const int pr = pr0 + q * stride; if (pr >= npair) break;
            const int r = 2 * pr + (lane >> 5);
            float x[8] = {lo16(w[q].x), hi16(w[q].x), lo16(w[q].y), hi16(w[q].y), lo16(w[q].z), hi16(w[q].z), lo16(w[q].w), hi16(w[q].w)};
            if (hs < 2) { float ss = 0.f;
#pragma unroll
                for (int j = 0; j < 8; ++j) ss += x[j] * x[j];
                ss += shfl_xor_l(ss, 1, lane); ss += shfl_xor_l(ss, 2, lane); ss += shfl_xor_l(ss, 4, lane);
                const float rstd = 1.0f / sqrtf(ss * (1.0f / 64.0f) + EPS);
                x[0] *= rstd * g0.x; x[1] *= rstd * g0.y; x[2] *= rstd * g0.z; x[3] *= rstd * g0.w; x[4] *= rstd * g1.x; x[5] *= rstd * g1.y; x[6] *= rstd * g1.z; x[7] *= rstd * g1.w; }
            if (r < RL) { const int t = r & (T - 1), pos = a ? (t & 63) : (t >> 6);
                const f32x4 c0 = *(const f32x4*)(rc + pos * 16 + fi), c1 = *(const f32x4*)(rc + pos * 16 + fi + 4), s0 = *(const f32x4*)(rs + pos * 16 + fi), s1 = *(const f32x4*)(rs + pos * 16 + fi + 4);
                const float cs[8] = {c0.x, c0.y, c0.z, c0.w, c1.x, c1.y, c1.z, c1.w}, sn[8] = {s0.x, s0.y, s0.z, s0.w, s1.x, s1.y, s1.z, s1.w};
#pragma unroll
                for (int j = 0; j < 8; ++j) { const float y = shfl_xor_l(x[j], 2, lane); x[j] = second ? x[j] * cs[j] + y * sn[j] : x[j] * cs[j] - y * sn[j]; } }
            u32x4 o; o.x = cvtpk(x[0], x[1]); o.y = cvtpk(x[2], x[3]); o.z = cvtpk(x[4], x[5]); o.w = cvtpk(x[6], x[7]);
            *(u32x4*)((bf16_t*)(P.ws + WS_U) + (size_t)r * NIN + col) = o; }
    }
}
__device__ __forceinline__ void ph_pool(const Frame& F, const Ptrs& P, int nrows) {
    const int tid0 = fresh_tid();
    for (int i = F.vcu * 512 + tid0; i < nrows * 64; i += F.G * 512) {
        const int r = i >> 6, c8 = (i & 63) * 8;
        const bool lat = r < RL; const int Ts = lat ? T : TC; const int t = lat ? (r & (T - 1)) : ((r - RL) & (TC - 1)); const int r0 = r - t;
        const int g = c8 >> 7, hw = 1 << g;
        const int lo = t - hw < 0 ? 0 : t - hw, hi = t + hw > Ts ? Ts : t + hw;
        const bf16_t* U = (const bf16_t*)(P.ws + WS_U) + C_P + c8;
        u32x4 wv[16];
#pragma unroll
        for (int k = 0; k < 16; ++k) { const int tt = t - 8 + k; const bool ok = tt >= lo && tt < hi; wv[k] = *(const u32x4*)(U + (size_t)(r0 + (ok ? tt : t)) * NIN); }
        float s[8];
#pragma unroll
        for (int j = 0; j < 8; ++j) s[j] = 0.f;
#pragma unroll
        for (int k = 0; k < 16; ++k) { const int tt = t - 8 + k; const float f = (tt >= lo && tt < hi) ? 1.f : 0.f; const u32x4 w = wv[k];
            s[0] += f * lo16(w.x); s[1] += f * hi16(w.x); s[2] += f * lo16(w.y); s[3] += f * hi16(w.y); s[4] += f * lo16(w.z); s[5] += f * hi16(w.z); s[6] += f * lo16(w.w); s[7] += f * hi16(w.w); }
        const u32x4 w = wv[8]; const float inv = 1.0f / (float)(hi - lo);
        u32x4 o; o.x = cvtpk(s[0] * inv - lo16(w.x), s[1] * inv - hi16(w.x)); o.y = cvtpk(s[2] * inv - lo16(w.y), s[3] * inv - hi16(w.y));
        o.z = cvtpk(s[4] * inv - lo16(w.z), s[5] * inv - hi16(w.z)); o.w = cvtpk(s[6] * inv - lo16(w.w), s[7] * inv - hi16(w.w));
        *(u32x4*)((bf16_t*)(P.ws + WS_BR) + (size_t)r * NBR + 1536 + c8) = o;
    }
}
__device__ __forceinline__ void ph_final(const Frame& F, const Ptrs& P) {
    const int lane = fresh_tid() & 63;
    for (int r = F.vcu * NWAVES + F.wave; r < RL; r += F.G * NWAVES) {
        const int bb = row_bb(r);
        f32x4* xr = (f32x4*)(P.out + (size_t)r * D) + lane; f32x4 v[4];
        const f32x4* g2 = (const f32x4*)mod_vec(P, 1, bb, 5) + lane;
        const u32x2* m0 = (const u32x2*)((const bf16_t*)(P.ws + WS_MO) + (size_t)r * D) + lane; const u32x2* m1 = (const u32x2*)((const bf16_t*)(P.ws + WS_MO) + (size_t)(R + r) * D) + lane;
        float ss = 0.f;
#pragma unroll
        for (int j = 0; j < 4; ++j) { v[j] = xr[64 * j]; const u32x2 a = m0[64 * j], b = m1[64 * j]; const f32x4 g = g2[64 * j];
            v[j].x += g.x * (lo16(a.x) + lo16(b.x)); v[j].y += g.y * (hi16(a.x) + hi16(b.x)); v[j].z += g.z * (lo16(a.y) + lo16(b.y)); v[j].w += g.w * (hi16(a.y) + hi16(b.y));
            ss += (v[j].x * v[j].x + v[j].y * v[j].y) + (v[j].z * v[j].z + v[j].w * v[j].w); }
        const float rstd = 1.0f / sqrtf(wave_sum_l(ss, lane) * (1.0f / D) + EPS);
        const f32x4* gn = (const f32x4*)P.norm_f + lane;
#pragma unroll
        for (int j = 0; j < 4; ++j) xr[64 * j] = v[j] * rstd * gn[64 * j];
    }
}

template <int MODE> __device__ __forceinline__ void ph_attn_ref(const Frame& F, const Ptrs& P, int l) {
    const int tid = fresh_tid();
    LAS float* Ks = (LAS float*)F.lds; LAS float* Vs = Ks + 64 * 64;
    const bf16_t* U = (const bf16_t*)(P.ws + WS_U);
    const bool latq = MODE < 2; const bool winm = (MODE == 1 || MODE == 3);
    const int NU = latq ? 1024 : 64; const int half = tid & 1;
    for (int u = F.vcu; u < NU; u += F.G) {
        const int qb = latq ? (u & 15) : 0, h = latq ? ((u >> 4) & 7) : (u & 7), b = latq ? (u >> 7) : (u >> 3), g = h >> 2;
        const int tq = qb * 256 + (tid >> 1);
        const int qrow = latq ? b * T + tq : RL + b * TC + tq;
        const int qcol = (winm ? C_QW : C_QB) + h * 64 + half * 32, kcol = (winm ? C_KW : C_KB) + g * 64, vcol = (winm ? C_VW : C_VB) + g * 64;
        unsigned q[16]; float o[32];
        { const u32x4* qp = (const u32x4*)(U + (size_t)qrow * NIN + qcol);
#pragma unroll
          for (int i = 0; i < 4; ++i) { const u32x4 w = qp[i]; q[4 * i] = w.x; q[4 * i + 1] = w.y; q[4 * i + 2] = w.z; q[4 * i + 3] = w.w; } }
#pragma unroll
        for (int d = 0; d < 32; ++d) o[d] = 0.f;
        float m = -INFINITY, lsum = 0.f;
        int lt_lo = 0, lt_hi = 0;
        if (MODE == 0) { lt_lo = 0; lt_hi = T / 64; }
        if (MODE == 1) { const int q0 = qb * 256; lt_lo = (q0 - 128 < 0 ? 0 : q0 - 128) / 64; lt_hi = (q0 + 384 > T ? T : q0 + 384) / 64; }
        const int ntiles = 4 + (lt_hi - lt_lo);
        for (int ti = 0; ti < ntiles; ++ti) {
            const bool isctx = ti < 4; const int kpos0 = isctx ? ti * 64 : (lt_lo + ti - 4) * 64;
            const int krow0 = isctx ? RL + b * TC + kpos0 : b * T + kpos0;
            __syncthreads();
            { const int j = tid >> 3, part = tid & 7; const u32x4 kw = *(const u32x4*)(U + (size_t)(krow0 + j) * NIN + kcol + part * 8), vw = *(const u32x4*)(U + (size_t)(krow0 + j) * NIN + vcol + part * 8);
              LAS float* kd = Ks + j * 64 + part * 8; LAS float* vd = Vs + j * 64 + part * 8;
              kd[0] = lo16(kw.x); kd[1] = hi16(kw.x); kd[2] = lo16(kw.y); kd[3] = hi16(kw.y); kd[4] = lo16(kw.z); kd[5] = hi16(kw.z); kd[6] = lo16(kw.w); kd[7] = hi16(kw.w);
              vd[0] = lo16(vw.x); vd[1] = hi16(vw.x); vd[2] = lo16(vw.y); vd[3] = hi16(vw.y); vd[4] = lo16(vw.z); vd[5] = hi16(vw.z); vd[6] = lo16(vw.w); vd[7] = hi16(vw.w); }
            __syncthreads();
#pragma unroll 1
            for (int jk = 0; jk < 64; ++jk) {
                float a = 0.f; const LAS f32x4* kr = (const LAS f32x4*)(Ks + jk * 64 + half * 32);
#pragma unroll
                for (int d4 = 0; d4 < 8; ++d4) { const f32x4 kv = kr[d4]; a += lo16(q[2 * d4]) * kv.x + hi16(q[2 * d4]) * kv.y + lo16(q[2 * d4 + 1]) * kv.z + hi16(q[2 * d4 + 1]) * kv.w; }
                a += shfl_xor_l(a, 1, tid & 63);
                if (MODE == 1 && !isctx) { const int dlt = kpos0 + jk - tq; if (dlt > 128 || dlt < -128) a = -INFINITY; }
                if (a != -INFINITY) {
                    if (a > m) { const float scl = exp2f(m - a); m = a; lsum *= scl;
#pragma unroll
                        for (int d = 0; d < 32; ++d) o[d] *= scl; }
                    const float p = exp2f(a - m); lsum += p; const LAS f32x4* vr = (const LAS f32x4*)(Vs + jk * 64 + half * 32);
#pragma unroll
                    for (int d4 = 0; d4 < 8; ++d4) { const f32x4 vv = vr[d4]; o[4 * d4] += p * vv.x; o[4 * d4 + 1] += p * vv.y; o[4 * d4 + 2] += p * vv.z; o[4 * d4 + 3] += p * vv.w; }
                }
            }
        }
        if (winm) lsum += exp2f(P.sink[l * 8 + h] * LOG2E - m);
        const float inv = 1.0f / lsum;
        { u32x4* op = (u32x4*)((bf16_t*)(P.ws + WS_BR) + (size_t)qrow * NBR + (winm ? 1024 : 512) + h * 64 + half * 32);
#pragma unroll
          for (int i = 0; i < 4; ++i) { u32x4 w; w.x = pk2(o[8 * i] * inv, o[8 * i + 1] * inv); w.y = pk2(o[8 * i + 2] * inv, o[8 * i + 3] * inv); w.z = pk2(o[8 * i + 4] * inv, o[8 * i + 5] * inv); w.w = pk2(o[8 * i + 6] * inv, o[8 * i + 7] * inv); op[i] = w; } }
        __syncthreads();
    }
}
__device__ __forceinline__ void ph_fourier_ref(const Frame& F, const Ptrs& P, int Ts, int latent) {
    const int tid = fresh_tid();
    LAS float* Zr = (LAS float*)F.lds; LAS float* Zi = Zr + 16 * 64; LAS float* Ct = Zi + 16 * 64; LAS float* St = Ct + 128 * 17;
    const bf16_t* U = (const bf16_t*)(P.ws + WS_U); const float* ct = (const float*)(P.ws + WS_COS);
    const int nkt = Ts / 128, NU = 8 * nkt * 8, step = 4096 / Ts;
    const int tk = tid >> 4, tc = tid & 15;
    for (int u = F.vcu; u < NU; u += F.G) {
        const int cht = u & 7, kt = (u >> 3) % nkt, b = (u >> 3) / nkt, k0 = kt * 128, ch0 = cht * 64;
        const int rbase = latent ? b * T : RL + b * TC;
        float acc[4][4];
#pragma unroll
        for (int i = 0; i < 4; ++i)
#pragma unroll
            for (int j = 0; j < 4; ++j) acc[i][j] = 0.f;
        for (int t0 = 0; t0 < Ts; t0 += 16) {
            __syncthreads();
            if (tid < 256) { const int tt = tid >> 4, c4 = (tid & 15) * 4; const bf16_t* zp = U + (size_t)(rbase + t0 + tt) * NIN + ch0 + c4;
              const u32x2 a = *(const u32x2*)(zp + C_ZR), bq = *(const u32x2*)(zp + C_ZI);
              Zr[tt * 64 + c4] = lo16(a.x); Zr[tt * 64 + c4 + 1] = hi16(a.x); Zr[tt * 64 + c4 + 2] = lo16(a.y); Zr[tt * 64 + c4 + 3] = hi16(a.y);
              Zi[tt * 64 + c4] = lo16(bq.x); Zi[tt * 64 + c4 + 1] = hi16(bq.x); Zi[tt * 64 + c4 + 2] = lo16(bq.y); Zi[tt * 64 + c4 + 3] = hi16(bq.y); }
#pragma unroll
            for (int i = 0; i < 4; ++i) { const int e = tid * 4 + i, k = e >> 4, tt = e & 15; const int ang = (((k0 + k) * (t0 + tt)) & (Ts - 1)) * step;
                Ct[k * 17 + tt] = ct[ang]; St[k * 17 + tt] = ct[(ang - 1024) & 4095]; }
            __syncthreads();
#pragma unroll 2
            for (int tt = 0; tt < 16; ++tt) { float zr[4], zi[4];
#pragma unroll
                for (int j = 0; j < 4; ++j) { zr[j] = Zr[tt * 64 + tc * 4 + j]; zi[j] = Zi[tt * 64 + tc * 4 + j]; }
#pragma unroll
                for (int i = 0; i < 4; ++i) { const float c = Ct[(tk * 4 + i) * 17 + tt], sn = St[(tk * 4 + i) * 17 + tt];
#pragma unroll
                    for (int j = 0; j < 4; ++j) acc[i][j] += c * zr[j] + sn * zi[j]; } }
        }
        const float sc = 1.0f / sqrtf((float)Ts);
        bf16_t* BR = (bf16_t*)(P.ws + WS_BR);
#pragma unroll
        for (int i = 0; i < 4; ++i) { u32x2 w; w.x = pk2(acc[i][0] * sc, acc[i][1] * sc); w.y = pk2(acc[i][2] * sc, acc[i][3] * sc);
            *(u32x2*)(BR + (size_t)(rbase + k0 + tk * 4 + i) * NBR + ch0 + tc * 4) = w; }
        __syncthreads();
    }
}

typedef float f32x16 __attribute__((ext_vector_type(16)));
typedef short v4i16_t __attribute__((ext_vector_type(4)));
constexpr float ATT_THR = 4.0f;
constexpr int AT_ROWB = 144, AT_TILEB = 64 * AT_ROWB;
template <int MODE> __device__ __forceinline__ void ph_attn(const Frame& F, const Ptrs& P, int l) {
    const int lane = fresh_lane(), tid = F.wave * 64 + lane, r32 = lane & 31, hi = lane >> 5;
    const bf16_t* U = (const bf16_t*)(P.ws + WS_U);
    const bool latq = MODE < 2; const bool winm = (MODE == 1 || MODE == 3);
    const int NU = latq ? 1024 : 64;
    LAS unsigned char* Kb = F.lds; LAS unsigned char* Vb = F.lds + 2 * AT_TILEB;
    const int st_off = (tid >> 3) * AT_ROWB + (tid & 7) * 16;
    const int kf_off = r32 * AT_ROWB + hi * 16;
    const int vf_off = (4 * hi + ((lane & 15) >> 2)) * AT_ROWB + (((lane >> 4) & 1) * 16 + (lane & 3) * 4) * 2;
    for (int u = F.vcu; u < NU; u += F.G) {
        const int qb = latq ? (u & 63) : (u & 3), g = latq ? ((u >> 6) & 1) : ((u >> 2) & 1), b = latq ? (u >> 7) : (u >> 3);
        const int tq0 = qb * 64, hq = 4 * g + (F.wave >> 1), tq = tq0 + 32 * (F.wave & 1) + r32;
        const int qrow = latq ? b * T + tq : RL + b * TC + tq;
        const int qcol = (winm ? C_QW : C_QB) + hq * 64, kcol = (winm ? C_KW : C_KB) + g * 64, vcol = (winm ? C_VW : C_VB) + g * 64;
        int lt_lo = 0, lt_hi = 0;
        if (MODE == 0) { lt_lo = 0; lt_hi = T / 64; }
        if (MODE == 1) { lt_lo = (tq0 - 128 < 0 ? 0 : tq0 - 128) / 64; lt_hi = (tq0 + 192 > T ? T : tq0 + 192) / 64; }
        const int ntiles = 4 + (lt_hi - lt_lo);
        bf16x8 qr[4];
        {
            float x[4][8];
#pragma unroll
            for (int d0 = 0; d0 < 4; ++d0) { const u32x4 wq = *(const u32x4*)(U + (size_t)qrow * NIN + qcol + d0 * 16 + hi * 8);
                x[d0][0] = lo16(wq.x); x[d0][1] = hi16(wq.x); x[d0][2] = lo16(wq.y); x[d0][3] = hi16(wq.y); x[d0][4] = lo16(wq.z); x[d0][5] = hi16(wq.z); x[d0][6] = lo16(wq.w); x[d0][7] = hi16(wq.w); }
            if (!winm) { float ss = 0.f;
#pragma unroll
                for (int d0 = 0; d0 < 4; ++d0)
#pragma unroll
                    for (int j = 0; j < 8; ++j) ss += x[d0][j] * x[d0][j];
                ss += shfl_xor_l(ss, 32, lane);
                const float rstd = 1.0f / sqrtf(ss * (1.0f / 64.0f) + EPS);
#pragma unroll
                for (int d0 = 0; d0 < 4; ++d0) { const f32x4 ga = *(const f32x4*)(P.q_gain + l * 64 + d0 * 16 + hi * 8), gb = *(const f32x4*)(P.q_gain + l * 64 + d0 * 16 + hi * 8 + 4);
                    x[d0][0] *= rstd * ga.x; x[d0][1] *= rstd * ga.y; x[d0][2] *= rstd * ga.z; x[d0][3] *= rstd * ga.w; x[d0][4] *= rstd * gb.x; x[d0][5] *= rstd * gb.y; x[d0][6] *= rstd * gb.z; x[d0][7] *= rstd * gb.w; } }
            if (latq) { const float* rc = (const float*)(P.ws + WS_ROPE); const float* rs = rc + 1024;
#pragma unroll
                for (int a = 0; a < 2; ++a) { const int pos = a ? (tq & 63) : (tq >> 6);
                    const f32x4 c0 = *(const f32x4*)(rc + pos * 16 + hi * 8), c1 = *(const f32x4*)(rc + pos * 16 + hi * 8 + 4), s0 = *(const f32x4*)(rs + pos * 16 + hi * 8), s1 = *(const f32x4*)(rs + pos * 16 + hi * 8 + 4);
                    const float cs[8] = {c0.x, c0.y, c0.z, c0.w, c1.x, c1.y, c1.z, c1.w}, sn[8] = {s0.x, s0.y, s0.z, s0.w, s1.x, s1.y, s1.z, s1.w};
#pragma unroll
                    for (int j = 0; j < 8; ++j) { const float x1 = x[2 * a][j], x2 = x[2 * a + 1][j]; x[2 * a][j] = x1 * cs[j] - x2 * sn[j]; x[2 * a + 1][j] = x2 * cs[j] + x1 * sn[j]; } } }
#pragma unroll
            for (int d0 = 0; d0 < 4; ++d0) { u32x4 wq; wq.x = cvtpk(x[d0][0] * QSCALE, x[d0][1] * QSCALE); wq.y = cvtpk(x[d0][2] * QSCALE, x[d0][3] * QSCALE); wq.z = cvtpk(x[d0][4] * QSCALE, x[d0][5] * QSCALE); wq.w = cvtpk(x[d0][6] * QSCALE, x[d0][7] * QSCALE);
                qr[d0] = __builtin_bit_cast(bf16x8, wq); }
        }
        f32x16 o0, o1;
#pragma unroll
        for (int r = 0; r < 16; ++r) { o0[r] = 0.f; o1[r] = 0.f; }
        float mhat = 0.f, lsum = 0.f; f32x16 negm;
#pragma unroll
        for (int r = 0; r < 16; ++r) negm[r] = 0.f;
        { const size_t kr = (size_t)(RL + b * TC + (tid >> 3)) * NIN + (tid & 7) * 8;
          const u32x4 kw = *(const u32x4*)(U + kr + kcol), vw = *(const u32x4*)(U + kr + vcol);
          *(LAS u32x4*)(Kb + st_off) = kw; *(LAS u32x4*)(Vb + st_off) = vw; }
        __syncthreads();
        for (int ti = 0; ti < ntiles; ++ti) {
            const int cur = (ti & 1) * AT_TILEB, nxt = AT_TILEB - cur;
            const bool more = ti + 1 < ntiles;
            u32x4 kw, vw;
            if (more) { const int tn = ti + 1; const int krow0 = tn < 4 ? RL + b * TC + tn * 64 : b * T + (lt_lo + tn - 4) * 64;
                const size_t kr = (size_t)(krow0 + (tid >> 3)) * NIN + (tid & 7) * 8;
                kw = *(const u32x4*)(U + kr + kcol); vw = *(const u32x4*)(U + kr + vcol); }
            f32x16 p0, p1;
            {   const bf16x8 k0 = *(const LAS bf16x8*)(Kb + cur + kf_off);
                const bf16x8 k1 = *(const LAS bf16x8*)(Kb + cur + kf_off + 32 * AT_ROWB);
                p0 = __builtin_amdgcn_mfma_f32_32x32x16_bf16(k0, qr[0], negm, 0, 0, 0);
                p1 = __builtin_amdgcn_mfma_f32_32x32x16_bf16(k1, qr[0], negm, 0, 0, 0); }
#pragma unroll
            for (int d0 = 1; d0 < 4; ++d0) {
                const bf16x8 k0 = *(const LAS bf16x8*)(Kb + cur + kf_off + d0 * 32);
                const bf16x8 k1 = *(const LAS bf16x8*)(Kb + cur + kf_off + 32 * AT_ROWB + d0 * 32);
                p0 = __builtin_amdgcn_mfma_f32_32x32x16_bf16(k0, qr[d0], p0, 0, 0, 0);
                p1 = __builtin_amdgcn_mfma_f32_32x32x16_bf16(k1, qr[d0], p1, 0, 0, 0);
            }
            if (MODE == 1 && ti >= 4) {
                const int kb0 = (lt_lo + ti - 4) * 64, qlo = tq0 + 32 * (F.wave & 1);
                if (kb0 + 63 - qlo > 128 || qlo + 31 - kb0 > 128) {
                    const int kp0 = kb0 + 4 * hi - tq;
#pragma unroll
                    for (int r = 0; r < 16; ++r) { const int dl = kp0 + (r & 3) + 8 * (r >> 2);
                        if (dl > 128 || dl < -128) p0[r] = -INFINITY;
                        if (dl + 32 > 128 || dl + 32 < -128) p1[r] = -INFINITY; }
                }
            }
            float mx = fmaxf(fmaxf(p0[0], p1[0]), fmaxf(p0[1], p1[1]));
#pragma unroll
            for (int r = 2; r < 16; r += 2) mx = fmaxf(mx, fmaxf(fmaxf(p0[r], p1[r]), fmaxf(p0[r + 1], p1[r + 1])));
            mx = fmaxf(mx, shfl_xor_l(mx, 32, lane));
            if (ti == 0 || __any(mx > ATT_THR)) {
                const float dl = ti == 0 ? mx : fmaxf(mx, 0.f);
                mhat += dl;
                const float alpha = __builtin_amdgcn_exp2f(-dl); lsum *= alpha;
#pragma unroll
                for (int r = 0; r < 16; ++r) { p0[r] -= dl; p1[r] -= dl; o0[r] *= alpha; o1[r] *= alpha; negm[r] = -mhat; }
            }
            float rs = 0.f;
#pragma unroll
            for (int r = 0; r < 16; ++r) { p0[r] = __builtin_amdgcn_exp2f(p0[r]); p1[r] = __builtin_amdgcn_exp2f(p1[r]); rs += p0[r] + p1[r]; }
            lsum += rs;
#pragma unroll
            for (int kb = 0; kb < 2; ++kb)
#pragma unroll
                for (int sx = 0; sx < 2; ++sx) {
                    u32x4 pw;
                    if (kb == 0) { pw.x = cvtpk(p0[8 * sx], p0[8 * sx + 1]); pw.y = cvtpk(p0[8 * sx + 2], p0[8 * sx + 3]); pw.z = cvtpk(p0[8 * sx + 4], p0[8 * sx + 5]); pw.w = cvtpk(p0[8 * sx + 6], p0[8 * sx + 7]); }
                    else         { pw.x = cvtpk(p1[8 * sx], p1[8 * sx + 1]); pw.y = cvtpk(p1[8 * sx + 2], p1[8 * sx + 3]); pw.z = cvtpk(p1[8 * sx + 4], p1[8 * sx + 5]); pw.w = cvtpk(p1[8 * sx + 6], p1[8 * sx + 7]); }
                    const bf16x8 pf = __builtin_bit_cast(bf16x8, pw);
                    const LAS unsigned char* vp = Vb + cur + vf_off + (kb * 32 + 16 * sx) * AT_ROWB;
#pragma unroll
                    for (int db = 0; db < 2; ++db) {
                        const v4i16_t lo4 = __builtin_amdgcn_ds_read_tr16_b64_v4i16((LAS v4i16_t*)(vp + db * 64));
                        const v4i16_t hi4 = __builtin_amdgcn_ds_read_tr16_b64_v4i16((LAS v4i16_t*)(vp + 8 * AT_ROWB + db * 64));
                        const bf16x8 vf = (bf16x8){lo4[0], lo4[1], lo4[2], lo4[3], hi4[0], hi4[1], hi4[2], hi4[3]};
                        if (db == 0) o0 = __builtin_amdgcn_mfma_f32_32x32x16_bf16(vf, pf, o0, 0, 0, 0);
                        else         o1 = __builtin_amdgcn_mfma_f32_32x32x16_bf16(vf, pf, o1, 0, 0, 0);
                    }
                }
            if (more) { *(LAS u32x4*)(Kb + nxt + st_off) = kw; *(LAS u32x4*)(Vb + nxt + st_off) = vw; }
            __syncthreads();
        }
        lsum += shfl_xor_l(lsum, 32, lane);
        if (winm) lsum += exp2f(P.sink[l * 8 + hq] * LOG2E - mhat);
        const float inv = 1.0f / lsum;
        bf16_t* op = (bf16_t*)(P.ws + WS_BR) + (size_t)qrow * NBR + (winm ? 1024 : 512) + hq * 64 + 4 * hi;
#pragma unroll
        for (int gq = 0; gq < 4; ++gq) {
            u32x2 w0, w1; w0.x = cvtpk(o0[4 * gq] * inv, o0[4 * gq + 1] * inv); w0.y = cvtpk(o0[4 * gq + 2] * inv, o0[4 * gq + 3] * inv);
            w1.x = cvtpk(o1[4 * gq] * inv, o1[4 * gq + 1] * inv); w1.y = cvtpk(o1[4 * gq + 2] * inv, o1[4 * gq + 3] * inv);
            *(u32x2*)(op + 8 * gq) = w0; *(u32x2*)(op + 32 + 8 * gq) = w1; }
    }
}

constexpr int DF_ROWB = 528;
template <int STAGE> __device__ __forceinline__ void ph_dft(const Frame& F, const Ptrs& P) {
    const int lane = fresh_lane(), tid = F.wave * 64 + lane, r32 = lane & 31, hi = lane >> 5, w = F.wave;
    bf16_t* U = (bf16_t*)(P.ws + WS_U); bf16_t* BR = (bf16_t*)(P.ws + WS_BR); const bf16_t* Wm = (const bf16_t*)(P.ws + WS_DFTM);
    LAS unsigned char* Xl = F.lds;
    const int xf_off = (8 * hi + ((lane & 15) >> 2)) * DF_ROWB + (32 * w + ((lane >> 4) & 1) * 16 + (lane & 3) * 4) * 2;
    constexpr int NMB = STAGE == 2 ? 4 : 2;
    for (int u = F.vcu; u < 1024; u += F.G) {
        const int chb = u & 1, sidx = (u >> 1) & 63, b = u >> 7;
        { const int seg = tid >> 2, part = tid & 3, pp = seg >> 6, j = seg & 63;
          const int grow = STAGE == 2 ? b * T + 64 * j + sidx : b * T + 64 * sidx + j;
          const u32x4* src = (const u32x4*)(U + (size_t)grow * NIN + pp * 512 + chb * 256 + part * 64);
          u32x4 v[8];
#pragma unroll
          for (int i = 0; i < 8; ++i) v[i] = src[i];
#pragma unroll
          for (int i = 0; i < 8; ++i) *(LAS u32x4*)(Xl + seg * DF_ROWB + part * 128 + i * 16) = v[i]; }
        __syncthreads();
        f32x16 acc[NMB];
#pragma unroll
        for (int mb = 0; mb < NMB; ++mb)
#pragma unroll
            for (int r = 0; r < 16; ++r) acc[mb][r] = 0.f;
#pragma unroll
        for (int ks = 0; ks < 8; ++ks) {
            const v4i16_t lo4 = __builtin_amdgcn_ds_read_tr16_b64_v4i16((LAS v4i16_t*)(Xl + xf_off + (16 * ks) * DF_ROWB));
            const v4i16_t hi4 = __builtin_amdgcn_ds_read_tr16_b64_v4i16((LAS v4i16_t*)(Xl + xf_off + (16 * ks + 4) * DF_ROWB));
            const bf16x8 xf = (bf16x8){lo4[0], lo4[1], lo4[2], lo4[3], hi4[0], hi4[1], hi4[2], hi4[3]};
#pragma unroll
            for (int mb = 0; mb < NMB; ++mb) { const bf16x8 wf = *(const bf16x8*)(Wm + (mb * 32 + r32) * 128 + 16 * ks + 8 * hi);
                acc[mb] = __builtin_amdgcn_mfma_f32_32x32x16_bf16(xf, wf, acc[mb], 0, 0, 0); }
        }
        LAS unsigned char* ob = Xl + (32 * w + 4 * hi) * 2;
        if (STAGE == 2) {
#pragma unroll
            for (int mb = 0; mb < 2; ++mb) { const int k1 = mb * 32 + r32; const float rev = (float)((k1 * sidx) & 4095) * (1.0f / 4096.0f);
                const float ct = __builtin_amdgcn_cosf(rev), st = __builtin_amdgcn_sinf(rev);
#pragma unroll
                for (int gq = 0; gq < 4; ++gq) { u32x2 wr, wi; float yr[4], yi[4];
#pragma unroll
                    for (int i = 0; i < 4; ++i) { const float a = acc[mb][4 * gq + i], bq = acc[mb + 2][4 * gq + i]; yr[i] = a * ct + bq * st; yi[i] = bq * ct - a * st; }
                    wr.x = cvtpk(yr[0], yr[1]); wr.y = cvtpk(yr[2], yr[3]); wi.x = cvtpk(yi[0], yi[1]); wi.y = cvtpk(yi[2], yi[3]);
                    *(LAS u32x2*)(ob + k1 * DF_ROWB + 16 * gq) = wr; *(LAS u32x2*)(ob + (64 + k1) * DF_ROWB + 16 * gq) = wi; } }
        } else {
#pragma unroll
            for (int mb = 0; mb < 2; ++mb) { const int k2 = mb * 32 + r32;
#pragma unroll
                for (int gq = 0; gq < 4; ++gq) { u32x2 wr; wr.x = cvtpk(acc[mb][4 * gq] * 0.015625f, acc[mb][4 * gq + 1] * 0.015625f); wr.y = cvtpk(acc[mb][4 * gq + 2] * 0.015625f, acc[mb][4 * gq + 3] * 0.015625f);
                    *(LAS u32x2*)(ob + k2 * DF_ROWB + 16 * gq) = wr; } }
        }
        __syncthreads();
        if (STAGE == 2) { const int seg = tid >> 2, part = tid & 3, pp = seg >> 6, j = seg & 63;
            u32x4* dst = (u32x4*)(U + (size_t)(b * T + 64 * j + sidx) * NIN + pp * 512 + chb * 256 + part * 64);
#pragma unroll
            for (int i = 0; i < 8; ++i) dst[i] = *(const LAS u32x4*)(Xl + seg * DF_ROWB + part * 128 + i * 16);
        } else { const int k2 = tid >> 3, part = tid & 7;
            u32x4* dst = (u32x4*)(BR + (size_t)(b * T + 64 * k2 + sidx) * NBR + chb * 256 + part * 32);
#pragma unroll
            for (int i = 0; i < 4; ++i) dst[i] = *(const LAS u32x4*)(Xl + k2 * DF_ROWB + part * 64 + i * 16); }
        __syncthreads();
    }
}

struct MegaArgs { Ptrs P; int ph_lo, ph_hi, li, pad; };
__global__ void __launch_bounds__(NWAVES * 64, 2) mega(MegaArgs args) {
    extern __shared__ __attribute__((aligned(16))) unsigned char lds_raw[];
    Frame F; F.lds = (LAS unsigned char*)lds_raw;
    F.wave = __builtin_amdgcn_readfirstlane(threadIdx.x >> 6);
    F.G = gridDim.x; { const int bx = blockIdx.x; F.vcu = (F.G % 8 == 0) ? (bx % 8) * (F.G / 8) + bx / 8 : bx; }
    const Ptrs& P = args.P;
    for (int u = fresh_tid(); u < (LDS_BYTES - LDSCTL_OFF) / 4; u += NWAVES * 64) ((LAS unsigned*)(F.lds + LDSCTL_OFF))[u] = 0u;
    __syncthreads();
    volatile LAS unsigned* MISC = (volatile LAS unsigned*)(F.lds + MISC_OFF);
    XcdBarrier bar = xcd_barrier_post((unsigned*)(P.ws + WS_CTL) + CW_BAR + args.li * XCD_BAR_WORDS, MISC + 8, F.wave);
    const int lo = args.ph_lo, hi = args.ph_hi;
    unsigned char* ws = P.ws;
    bf16_t* H = (bf16_t*)(ws + WS_H); bf16_t* U = (bf16_t*)(ws + WS_U); bf16_t* BR = (bf16_t*)(ws + WS_BR);
    bf16_t* GT = (bf16_t*)(ws + WS_GT); bf16_t* MG = (bf16_t*)(ws + WS_MG); bf16_t* AS = (bf16_t*)(ws + WS_AS); bf16_t* HID = (bf16_t*)(ws + WS_HID); bf16_t* MO = (bf16_t*)(ws + WS_MO);
    const bf16_t* Bt_in = (const bf16_t*)(ws + WS_WB + WB_IN); const bf16_t* Bt_gate = (const bf16_t*)(ws + WS_WB + WB_GATE); const bf16_t* Bt_br = (const bf16_t*)(ws + WS_WB + WB_BR);
    const bf16_t* Bt_out = (const bf16_t*)(ws + WS_WB + WB_OUT); const bf16_t* Bt_13 = (const bf16_t*)(ws + WS_WB + WB_13); const bf16_t* Bt_2 = (const bf16_t*)(ws + WS_WB + WB_2);
#define IN(g) (lo <= (g) && (g) < hi)
#define SEAM(g) do { if ((g) + 1 < hi) xcd_barrier(bar); } while (0)
    for (int l = 0; l < 2; ++l) {
        const int pb = l * NPH; const int M = l == 0 ? R : RL;
        if (IN(pb + 0)) { if (l == 0) ph_tables_mod(F, P); ph_weights(F, P, l); SEAM(pb + 0); }
        if (IN(pb + 1)) { if (l == 0) ph_norm<0>(F, P, l, R); else ph_norm<1>(F, P, l, R); SEAM(pb + 1); }
        if (IN(pb + 2)) {
            pg8::StaticOrder S; S.init(R, NIN, F.G, (int)blockIdx.x, H, D, Bt_in, D);
            pg8::EpiV8<FStore8> E{FStore8{U, NIN}};
            pg8::gemm_phase(F.lds, F.wave, D, D, D, S, E);
            SEAM(pb + 2);
        }
        if (IN(pb + 3)) { ph_kprep(F, P, l); ph_pool(F, P, M); SEAM(pb + 3); }
        if (IN(pb + 4)) {
            ph_dft<2>(F, P); ph_attn<1>(F, P, l);
            if (l == 0) { ph_attn<2>(F, P, l); ph_attn<3>(F, P, l); ph_fourier_ref(F, P, TC, 0); }
            xcd_barrier(bar);
            ph_dft<3>(F, P); ph_attn<0>(F, P, l);
            SEAM(pb + 4);
        }
        for (int i = 0; i <= 4; ++i) {
            if (IN(pb + 5 + i)) {
                if (i >= 1) { const int j = i - 1;
                    pg8::StaticOrder S; S.init(M, D, F.G, (int)blockIdx.x, BR + j * 512, NBR, Bt_br + (size_t)j * 1024 * 512, 512);
                    pg8::EpiV8<FMerge8> E{FMerge8{MG, GT + (size_t)(j & 1) * R * D, j == 0}};
                    pg8::gemm_phase(F.lds, F.wave, NBR, 512, 512, S, E); }
                if (i <= 3) {
                    pg8::StaticOrder S; S.init(M, D, F.G, (int)blockIdx.x, H, D, Bt_gate + (size_t)i * 1024 * 1024, D);
                    pg8::EpiV8<FGate8> E{FGate8{GT + (size_t)(i & 1) * R * D, P.b_gate + ((size_t)l * 4 + i) * D}};
                    pg8::gemm_phase(F.lds, F.wave, D, D, D, S, E); }
                SEAM(pb + 5 + i);
            }
        }
        if (IN(pb + 10)) {
            pg8::StaticOrder S; S.init(M, D, F.G, (int)blockIdx.x, MG, D, Bt_out, D);
            pg8::EpiV4<FOut> E{FOut{P, l}};
            pg8::gemm_phase(F.lds, F.wave, D, D, D, S, E);
            SEAM(pb + 10);
        }
        if (IN(pb + 11)) { ph_norm<2>(F, P, l, M); xcd_barrier(bar); }
        if (IN(pb + 13) || IN(pb + 14)) {
            LAS int* ptab = (LAS int*)(F.lds + LDSCTL_OFF);
            if (fresh_tid() == 0) { const unsigned* cnt = (const unsigned*)(ws + WS_CTL) + CW_CNT + 1024 * l; int off = 0;
                for (int e = 0; e < 16; ++e) { const int c = (int)cnt[64 * e]; ptab[e] = off; ptab[17 + e] = c; off += (c + 255) >> 8; } ptab[16] = off; }
            __syncthreads();
            if (IN(pb + 13)) {
                pg8::MoeOrder<true> S; S.nN = 4; S.G = F.G; S.c = (int)blockIdx.x; S.A = (const char*)H; S.Bt = (const char*)Bt_13; S.astep = 0; S.bstep = (size_t)256 * D * 2; S.bexp = (size_t)1024 * 1024 * 2; S.tab = (const int*)ptab; S.tokl = (const int*)(ws + WS_TOKL);
                pg8::EpiDual<FMoe1> E{FMoe1{HID}};
                pg8::gemm_phase(F.lds, F.wave, D, D, D, S, E);
                SEAM(pb + 13);
            }
            if (IN(pb + 14)) {
                pg8::MoeOrder<false> S; S.nN = 4; S.G = F.G; S.c = (int)blockIdx.x; S.A = (const char*)HID; S.Bt = (const char*)Bt_2; S.astep = (size_t)256 * FF * 2; S.bstep = (size_t)256 * FF * 2; S.bexp = (size_t)1024 * 512 * 2; S.tab = (const int*)ptab; S.tokl = nullptr;
                pg8::EpiV8<FMoe2> E{FMoe2{MO, (const int*)(ws + WS_TOKL), (const float*)(ws + WS_WL)}};
                pg8::gemm_phase(F.lds, F.wave, FF, FF, FF, S, E);
                SEAM(pb + 14);
            }
        }
    }
    if (IN(PH_FINAL)) ph_final(F, P);
#undef IN
#undef SEAM
}

extern "C" void kernel_launch(void* const* d_in, const int* in_sizes, int n_in, void* d_out, int out_size, void* d_ws, size_t ws_size, hipStream_t stream) {
    if (n_in != 24 || ws_size < WS_END || out_size != RL * D) { fprintf(stderr, "kernel_launch: unexpected sizes n_in %d ws %zu out %d\n", n_in, ws_size, out_size); return; }
    static int grid = 0;
    if (grid == 0) {
        int dev = 0, cus = 0;
        if (hipGetDevice(&dev) != hipSuccess || hipDeviceGetAttribute(&cus, hipDeviceAttributeMultiprocessorCount, dev) != hipSuccess) { grid = -1; return; }
        if (hipFuncSetAttribute((const void*)mega, hipFuncAttributeMaxDynamicSharedMemorySize, LDS_BYTES) != hipSuccess) { fprintf(stderr, "kernel_launch: hipFuncSetAttribute failed\n"); grid = -1; return; }
        int per_cu = 0;
        if (hipOccupancyMaxActiveBlocksPerMultiprocessor(&per_cu, (const void*)mega, NWAVES * 64, LDS_BYTES) != hipSuccess || per_cu < 1) fprintf(stderr, "kernel_launch: occupancy query says %d\n", per_cu);
        (void)hipGetLastError();
        grid = cus;
    }
    if (grid < 0) return;
    MegaArgs a{};
    const float** pp = (const float**)&a.P;
    for (int i = 0; i < 24; ++i) pp[i] = (const float*)d_in[i];
    a.P.out = (float*)d_out; a.P.ws = (unsigned char*)d_ws;
    (void)hipMemsetAsync((unsigned char*)d_ws + WS_CTL, 0, 1 * MiB, stream);
    a.ph_lo = 0; a.ph_hi = PH_FINAL + 1; a.li = 0;
    hipLaunchKernelGGL(mega, dim3(grid), dim3(NWAVES * 64), LDS_BYTES, stream, a);
}
```

```cpp
#include <hip/hip_runtime.h>
#include <cstdio>
#include <cstdint>

typedef unsigned short bf16_t;
typedef short bf16x8 __attribute__((ext_vector_type(8)));
typedef float f32x4 __attribute__((ext_vector_type(4)));
typedef unsigned u32x4 __attribute__((ext_vector_type(4)));
typedef unsigned u32x2 __attribute__((ext_vector_type(2)));

constexpr int D = 1024, NB = 8, T = 4096, TC = 256;
constexpr int RL = NB * T, RC = NB * TC, R = RL + RC;
constexpr int NIN = 3072;
constexpr int C_ZR = 0, C_ZI = 512, C_P = 1024, C_QB = 1536, C_KB = 2048, C_VB = 2176, C_QW = 2304, C_KW = 2816, C_VW = 2944;
constexpr int NBR = 2048;
constexpr int NE = 16, FF = 512;
constexpr int MAXROWS = 73728;
constexpr float EPS = 1e-6f;
constexpr float QSCALE = 0.125f * 1.4426950408889634f;
constexpr float LOG2E = 1.4426950408889634f;

constexpr size_t MiB = 1u << 20;
constexpr size_t WS_CTL = 0;
constexpr size_t WS_MOD = 1 * MiB;
constexpr size_t WS_ROPE = 1 * MiB + 512 * 1024;
constexpr size_t WS_COS = WS_ROPE + 16 * 1024;
constexpr size_t WS_DFTM = WS_ROPE + 64 * 1024;
constexpr size_t WS_TOKL = 2 * MiB;
constexpr size_t WS_WL = 4 * MiB + 512 * 1024;
constexpr size_t WS_XC = 9 * MiB;
constexpr size_t WS_WB = 17 * MiB;
constexpr size_t WB_IN = 0, WB_GATE = 6 * MiB, WB_BR = 14 * MiB, WB_OUT = 18 * MiB, WB_13 = 20 * MiB, WB_2 = 52 * MiB;
constexpr size_t WS_H = 85 * MiB;
constexpr size_t WS_ARENA = 153 * MiB;
constexpr size_t WS_U = WS_ARENA;
constexpr size_t WS_BR = WS_ARENA + 204 * MiB;
constexpr size_t WS_GT = WS_ARENA;
constexpr size_t WS_MG = WS_ARENA + 136 * MiB;
constexpr size_t WS_AS = WS_ARENA;
constexpr size_t WS_HID = WS_ARENA + 144 * MiB;
constexpr size_t WS_MO = WS_ARENA + 216 * MiB;
constexpr size_t WS_END = 512 * MiB;
static_assert(WS_BR + (size_t)R * NBR * 2 <= WS_END && WS_MO + (size_t)2 * R * D * 2 <= WS_END && WS_MG + (size_t)R * D * 2 <= WS_BR, "ws map");
constexpr int CW_CNT = 8192;

__device__ __forceinline__ float bf2f(bf16_t b) { return __uint_as_float(((unsigned)b) << 16); }
__device__ __forceinline__ unsigned f2bf(float f) { unsigned u = __float_as_uint(f); return (u + 0x7fffu + ((u >> 16) & 1u)) >> 16; }
__device__ __forceinline__ unsigned pk2(float lo, float hi) { return f2bf(lo) | (f2bf(hi) << 16); }
typedef __bf16 bf16x2_t __attribute__((ext_vector_type(2)));
typedef float f32x2_t __attribute__((ext_vector_type(2)));
__device__ __forceinline__ unsigned cvtpk(float lo, float hi) { f32x2_t v = {lo, hi}; bf16x2_t b = __builtin_convertvector(v, bf16x2_t); return __builtin_bit_cast(unsigned, b); }
__device__ __forceinline__ float lo16(unsigned w) { return __uint_as_float(w << 16); }
__device__ __forceinline__ float hi16(unsigned w) { return __uint_as_float(w & 0xffff0000u); }
__device__ __forceinline__ float shfl_xor_l(float v, int o, int lane) { return __int_as_float(__builtin_amdgcn_ds_bpermute((lane ^ o) << 2, __float_as_int(v))); }
__device__ __forceinline__ float wave_sum_l(float v, int lane) {
#pragma unroll
    for (int o = 1; o < 64; o <<= 1) v += shfl_xor_l(v, o, lane);
    return v;
}
__device__ __forceinline__ int row_bb(int r) { return r < RL ? (r >> 12) : 8; }

struct Ptrs {
    const float *x, *c, *ctx, *c_ctx, *w_ada, *b_ada, *norm1, *norm2, *w_in, *q_gain, *k_gain, *sink, *pool_w, *pool_scale,
        *w_branch, *w_gate, *b_gate, *w_out, *router_w, *router_bias, *w1, *w3, *w2, *norm_f;
    float* out; unsigned char* ws;
};
__device__ __forceinline__ const float* xin_row(const Ptrs& P, int r) { return r < RL ? P.x + (size_t)r * D : P.ctx + (size_t)(r - RL) * D; }
__device__ __forceinline__ float* x1_row(const Ptrs& P, int r) { return r < RL ? P.out + (size_t)r * D : (float*)(P.ws + WS_XC) + (size_t)(r - RL) * D; }
__device__ __forceinline__ const float* mod_vec(const Ptrs& P, int l, int bb, int which) { return (const float*)(P.ws + WS_MOD) + ((size_t)(l * 9 + bb) * 6 + which) * D; }

struct EpiOut { Ptrs P; int l;
    __device__ __forceinline__ void operator()(int row, int col, f32x4 v) const { const int bb = row_bb(row);
        const f32x4 g = *(const f32x4*)(mod_vec(P, l, bb, 2) + col); float* xo = x1_row(P, row) + col;
        const f32x4 xp = l == 0 ? *(const f32x4*)(xin_row(P, row) + col) : *(const f32x4*)xo;
        *(f32x4*)xo = xp + g * v; } };

#define LAS __attribute__((address_space(3)))
#define GAS __attribute__((address_space(1)))
#define LDS_WAIT() asm volatile("s_waitcnt lgkmcnt(0)" ::: "memory")
__device__ __forceinline__ int fresh_lane() { int l; asm volatile("v_mbcnt_lo_u32_b32 %0, -1, 0\n\tv_mbcnt_hi_u32_b32 %0, -1, %0" : "=v"(l)); return l; }
constexpr int NWAVES = 8;
constexpr int RING_BYTES = 131072, LDSCTL_OFF = RING_BYTES, MISC_OFF = LDSCTL_OFF + 320, LDS_BYTES = 147456;
constexpr int CW_BAR = 16384;
constexpr int NPH = 15, PH_FINAL = 2 * NPH;

#define XB_TMO      128
#define XB_XCNT(j)  (256  + 64 * (j))
#define XB_XSUB(j)  (1280 + 64 * (j))
#define XB_XGEN(j)  (2304 + 64 * (j))
#define XB_TOP      3328
#define XB_TOPGEN   3392
#define XCD_BAR_WORDS 3456
#define XB_SPIN_CAP (1u << 21)
__device__ __forceinline__ unsigned xb_ld(unsigned* p)              { return __hip_atomic_load(p, __ATOMIC_RELAXED, __HIP_MEMORY_SCOPE_AGENT); }
__device__ __forceinline__ unsigned xb_add(unsigned* p, unsigned v) { return __hip_atomic_fetch_add(p, v, __ATOMIC_RELAXED, __HIP_MEMORY_SCOPE_AGENT); }
__device__ __forceinline__ unsigned xb_xcc_id() { return (unsigned)__builtin_amdgcn_s_getreg((3 << 11) | 20) & 0xFu; }
#define XB_SPIN(cond, bar) do { unsigned _sp = 0; while (cond) { __builtin_amdgcn_s_sleep(1); \
    if ((++_sp & 255u) == 0u) { if (xb_ld(&(bar)[XB_TMO])) break; if (_sp > XB_SPIN_CAP) { atomicAdd(&(bar)[XB_TMO], 1u); break; } } } } while (0)
struct XcdBarrier { unsigned* bar; unsigned x; volatile LAS unsigned* st; int wave; };
__device__ __forceinline__ XcdBarrier xcd_barrier_post(unsigned* bar, volatile LAS unsigned* st, int wave) {
    XcdBarrier b; b.bar = bar; b.x = xb_xcc_id(); b.st = st; b.wave = wave;
    if (wave == 0 && fresh_lane() == 0) (void)xb_add(&bar[XB_XCNT(b.x)], 1u);
    return b;
}
__device__ __forceinline__ void xcd_barrier_complete(unsigned* bar, unsigned x, unsigned& nloc, unsigned& nx) {
    const unsigned G = gridDim.x * gridDim.y * gridDim.z;
    unsigned sum, cnt, mine, sp = 0u;
    for (;;) {
        sum = 0u; cnt = 0u; mine = 0u;
#pragma unroll
        for (unsigned j = 0; j < 16; ++j) { const unsigned c = xb_ld(&bar[XB_XCNT(j)]); sum += c; cnt += (c > 0u) ? 1u : 0u; mine = (j == x) ? c : mine; }
        if (sum == G) break;
        __builtin_amdgcn_s_sleep(1);
        if ((++sp & 255u) == 0u) { if (xb_ld(&bar[XB_TMO])) break; if (sp > XB_SPIN_CAP) { atomicAdd(&bar[XB_TMO], 1u); break; } }
    }
    nloc = mine > 0u ? mine : 1u; nx = cnt > 0u ? cnt : 1u;
}
__device__ __forceinline__ void xcd_barrier(const XcdBarrier& b) {
    asm volatile("s_waitcnt vmcnt(0)" ::: "memory");
    __syncthreads();
    if (b.wave == 0 && fresh_lane() == 0) {
        unsigned* bar = b.bar;
        __builtin_amdgcn_s_waitcnt(0);
        unsigned nloc = b.st[0], nx = b.st[1];
        if (nloc == 0u) { xcd_barrier_complete(bar, b.x, nloc, nx); b.st[0] = nloc; b.st[1] = nx; }
        const unsigned old = xb_add(&bar[XB_XSUB(b.x)], 1u);
        const unsigned gen = old / nloc;
        if (old + 1u == (gen + 1u) * nloc) {
            __builtin_amdgcn_fence(__ATOMIC_RELEASE, "agent");
            asm volatile("s_waitcnt vmcnt(0)" ::: "memory");
            const unsigned og = xb_add(&bar[XB_TOP], 1u);
            const unsigned tg = og / nx;
            if (og + 1u == (tg + 1u) * nx) xb_add(&bar[XB_TOPGEN], 1u);
            else XB_SPIN(xb_ld(&bar[XB_TOPGEN]) == tg, bar);
            __builtin_amdgcn_fence(__ATOMIC_ACQUIRE, "agent");
            xb_add(&bar[XB_XGEN(b.x)], 1u);
            asm volatile("s_waitcnt vmcnt(0)" ::: "memory");
        } else {
            XB_SPIN(xb_ld(&bar[XB_XGEN(b.x)]) == gen, bar);
            __builtin_amdgcn_fence(__ATOMIC_ACQUIRE, "agent");
            asm volatile("s_waitcnt vmcnt(0)" ::: "memory");
        }
    }
    __syncthreads();
}

namespace pg8 {
constexpr int BM = 256, BK = 64, HALF = 128, HTB = HALF * BK * 2, STAGE_BYTES = 8 * HTB, NXCD = 8, WGM = 8;
__host__ __device__ __forceinline__ int lds_byte(int r, int c) { const int st = (r >> 4) * 2 + (c >> 5), rr = r & 15, cc = c & 31, ob = rr * 64 + cc * 2; return st * 1024 + (ob ^ (((ob >> 9) & 1) << 5)); }
__host__ __device__ __forceinline__ void stage_rc(int b, int& Rr, int& C) { const int st = b / 1024, sb = b % 1024, swz = sb ^ (((sb >> 9) & 1) << 5); Rr = (st >> 1) * 16 + swz / 64; C = (st & 1) * 32 + (swz % 64) / 2; }
__host__ __device__ __forceinline__ int perm32(int rho) { const int n = rho >> 4, i = rho & 15; return 8 * (i >> 2) + 4 * n + (i & 3); }
struct Unit { int pm, pn; const char* a; const char* b; int e, p0, ce; };

struct StaticOrder {
    static constexpr bool GATHER = false;
    int nM, nN, nwg, G, c; const char* A; const char* Bt; size_t astep, bstep;
    __device__ void init(int M, int N, int G_, int c_, const bf16_t* A_, int lda, const bf16_t* Bt_, int ldb) { nM = M / BM; nN = N / BM; nwg = nM * nN; G = G_; c = c_; A = (const char*)A_; Bt = (const char*)Bt_; astep = (size_t)BM * lda * 2; bstep = (size_t)BM * ldb * 2; }
    __device__ bool next(int i, Unit& u) const {
        const long L = (long)i * G + c; if (L >= nwg) return false;
        int wgid = (int)L; { const int q = nwg / NXCD, r = nwg % NXCD, xcd = wgid % NXCD, off = wgid / NXCD; wgid = (xcd < r ? xcd * (q + 1) : r * (q + 1) + (xcd - r) * q) + off; }
        const int nig = WGM * nN, gid = wgid / nig, fm = gid * WGM, gsz = (nM - fm) < WGM ? (nM - fm) : WGM;
        u.pm = fm + ((wgid % nig) % gsz); u.pn = (wgid % nig) / gsz; u.a = A + (size_t)u.pm * astep; u.b = Bt + (size_t)u.pn * bstep; u.e = 0; u.p0 = 0; u.ce = 0; return true;
    }
};
template <bool GATHER_> struct MoeOrder {
    static constexpr bool GATHER = GATHER_;
    int nN, G, c; const char* A; const char* Bt; size_t astep, bstep, bexp; const int* tab; const int* tokl;
    __device__ bool next(int i, Unit& u) const {
        const int L = i * G + c; const int total = tab[16] * nN; if (L >= total) return false;
        u.pm = L / nN; u.pn = L % nN; int e = 0;
#pragma unroll
        for (int q = 1; q < 16; ++q) e += (u.pm >= tab[q]) ? 1 : 0;
        u.e = e; u.p0 = (u.pm - tab[e]) * BM; u.ce = tab[17 + e];
        u.a = GATHER_ ? A : A + (size_t)u.pm * astep; u.b = Bt + (size_t)e * bexp + (size_t)u.pn * bstep; return true;
    }
    __device__ __forceinline__ void aoffs(const Unit& u, const int (&Rr)[2], const int (&Cc)[2], int lda, unsigned (&off)[2][2]) const {
#pragma unroll
        for (int h = 0; h < 2; ++h)
#pragma unroll
            for (int i = 0; i < 2; ++i) { const int pos = u.p0 + h * HALF + Rr[i]; const int tok = pos < u.ce ? (tokl[(size_t)u.e * R + pos] >> 1) : 0; off[h][i] = (unsigned)(tok * lda + Cc[i]) * 2u; }
    }
};

template <class Epi, class Sched, bool ALIGN_EPI = true>
__device__ __forceinline__ void gemm_phase(LAS unsigned char* lds, const int wid, const int lda, const int ldb, const int K, const Sched& S, const Epi& E) {
    const int lane = fresh_lane(), tid = wid * 64 + lane, wr = wid >> 2, wc = wid & 3, fr = lane & 15, fq = lane >> 4;
    const int nt = K / BK;
    unsigned voffA[2], voffB[2]; int Rr2[2], Cc2[2];
#pragma unroll
    for (int i = 0; i < 2; ++i) { int Rr, C; stage_rc(tid * 16 + i * 8192, Rr, C); const int Rb = Epi::PERM ? ((Rr & ~31) + perm32(Rr & 31)) : Rr; Rr2[i] = Rr; Cc2[i] = C;
        voffA[i] = (unsigned)(Rr * lda + C) * 2u; voffB[i] = (unsigned)(Rb * ldb + C) * 2u; }
    const size_t kstep = (size_t)(BK * 2);
    const size_t hstepA = Sched::GATHER ? 0 : (size_t)HALF * lda * 2, hstepB = (size_t)HALF * ldb * 2;
    const unsigned ldsw = (unsigned)wid * 1024u;
    const int aoff = lds_byte(wr * 64 + fr, fq * 8), boff = lds_byte(wc * 32 + fr, fq * 8);
#define PG8_SA(b, h) (((b) * 2 + (h)) * HTB)
#define PG8_SB(b, h) ((4 + (b) * 2 + (h)) * HTB)
#define PG8_STAGE(bufoff, gbase, voff) do { _Pragma("unroll") for (int _i = 0; _i < 2; ++_i) \
        __builtin_amdgcn_global_load_lds((const unsigned*)((const char*)(gbase) + (voff)[_i]), (LAS unsigned*)(lds + (bufoff) + ldsw + _i * 8192), 16, 0, 0); } while (0)
#define PG8_STAGE_A(b, h, kp, OFFS) do { if constexpr (Sched::GATHER) { PG8_STAGE(PG8_SA(b, h), kp, OFFS[h]); } else { PG8_STAGE(PG8_SA(b, h), (kp) + (h) * hstepA, voffA); } } while (0)
#define PG8_LDA(dst, b, h) do { _Pragma("unroll") for (int m = 0; m < 4; ++m) _Pragma("unroll") for (int k = 0; k < 2; ++k) dst[m][k] = *(const LAS bf16x8*)(lds + PG8_SA(b, h) + aoff + m * 2048 + k * 1024); } while (0)
#define PG8_LDB(dst, b, h) do { _Pragma("unroll") for (int n = 0; n < 2; ++n) _Pragma("unroll") for (int k = 0; k < 2; ++k) dst[n][k] = *(const LAS bf16x8*)(lds + PG8_SB(b, h) + boff + n * 2048 + k * 1024); } while (0)
#define PG8_MMA(ai, bj, At, Bt) do { __builtin_amdgcn_s_setprio(1); _Pragma("unroll") for (int m = 0; m < 4; ++m) _Pragma("unroll") for (int n = 0; n < 2; ++n) _Pragma("unroll") for (int k = 0; k < 2; ++k) \
        acc[ai][bj][m][n] = __builtin_amdgcn_mfma_f32_16x16x32_bf16(Bt[n][k], At[m][k], acc[ai][bj][m][n], 0, 0, 0); __builtin_amdgcn_s_setprio(0); } while (0)
#define PG8_WAIT_V(n) asm volatile("s_waitcnt vmcnt(" #n ")" ::: "memory")
#define PG8_WAIT_L(n) asm volatile("s_waitcnt lgkmcnt(" #n ")" ::: "memory")
#define PG8_BAR __builtin_amdgcn_s_barrier()
#define PG8_SCHED __builtin_amdgcn_sched_barrier(0)
    Unit cur, nxt; int ui = 0;
    if (!S.next(0, cur)) return;
    f32x4 acc[2][2][4][2];
#pragma unroll
    for (int a = 0; a < 2; ++a)
#pragma unroll
        for (int b = 0; b < 2; ++b)
#pragma unroll
            for (int m = 0; m < 4; ++m)
#pragma unroll
                for (int n = 0; n < 2; ++n) acc[a][b][m][n] = (f32x4){0.f, 0.f, 0.f, 0.f};
    bf16x8 At[4][2], B0[2][2], B1[2][2];
    unsigned goffC[2][2], goffN[2][2];
    if constexpr (Sched::GATHER) { S.aoffs(cur, Rr2, Cc2, lda, goffC);
#pragma unroll
        for (int h = 0; h < 2; ++h)
#pragma unroll
            for (int i = 0; i < 2; ++i) goffN[h][i] = goffC[h][i]; }
    const char* cA = cur.a; const char* cB = cur.b;
    PG8_STAGE(PG8_SB(0, 0), cB, voffB); PG8_STAGE(PG8_SB(0, 1), cB + hstepB, voffB); PG8_STAGE_A(0, 0, cA, goffC); PG8_STAGE_A(0, 1, cA, goffC);
    if (wr == 1) PG8_BAR;
    PG8_WAIT_V(2); PG8_BAR;
    PG8_STAGE(PG8_SB(1, 0), cB + kstep, voffB); PG8_STAGE_A(1, 0, cA + kstep, goffC); PG8_STAGE(PG8_SB(1, 1), cB + hstepB + kstep, voffB);
    PG8_WAIT_V(6); PG8_BAR;
    for (;;) {
        const bool has_next = S.next(ui + 1, nxt);
        if constexpr (Sched::GATHER) { if (has_next) S.aoffs(nxt, Rr2, Cc2, lda, goffN); }
        const char* nA = has_next ? nxt.a : cA; const char* nB = has_next ? nxt.b : cB;
        for (int t = 0; t < nt; t += 2) {
            const bool last = (t == nt - 2);
            const char* a1 = cA + (size_t)(t + 1) * kstep;
            const char* a2 = last ? nA : cA + (size_t)(t + 2) * kstep; const char* b2 = last ? nB : cB + (size_t)(t + 2) * kstep;
            const char* a3 = a2 + kstep; const char* b3 = b2 + kstep;
            unsigned gx[2][2];
            if constexpr (Sched::GATHER) {
#pragma unroll
                for (int h = 0; h < 2; ++h)
#pragma unroll
                    for (int i = 0; i < 2; ++i) gx[h][i] = (last && has_next) ? goffN[h][i] : goffC[h][i]; }
            PG8_LDB(B0, 0, 0); PG8_LDB(B1, 0, 1); PG8_SCHED; PG8_LDA(At, 0, 0); PG8_STAGE_A(1, 1, a1, goffC);
            PG8_WAIT_V(8); PG8_WAIT_L(0); PG8_BAR; PG8_MMA(0, 0, At, B0); PG8_MMA(0, 1, At, B1); PG8_BAR; PG8_SCHED;
            PG8_LDA(At, 0, 1); PG8_STAGE(PG8_SB(0, 0), b2, voffB); PG8_STAGE(PG8_SB(0, 1), b2 + hstepB, voffB); PG8_STAGE_A(0, 0, a2, gx);
            PG8_WAIT_V(8); PG8_WAIT_L(0); PG8_BAR; PG8_MMA(1, 0, At, B0); PG8_MMA(1, 1, At, B1); PG8_BAR; PG8_SCHED;
            PG8_LDB(B0, 1, 0); PG8_LDB(B1, 1, 1); PG8_SCHED; PG8_LDA(At, 1, 0); PG8_STAGE_A(0, 1, a2, gx);
            PG8_WAIT_V(8); PG8_WAIT_L(0); PG8_BAR; PG8_MMA(0, 0, At, B0); PG8_MMA(0, 1, At, B1); PG8_BAR; PG8_SCHED;
            PG8_LDA(At, 1, 1); PG8_STAGE(PG8_SB(1, 0), b3, voffB); PG8_STAGE(PG8_SB(1, 1), b3 + hstepB, voffB); PG8_STAGE_A(1, 0, a3, gx);
            PG8_WAIT_V(8); PG8_WAIT_L(0); PG8_BAR; PG8_MMA(1, 0, At, B0); PG8_MMA(1, 1, At, B1); PG8_BAR; PG8_SCHED;
            if constexpr (Epi::MID) { if (((t + 2) & (Epi::MID_EVERY - 1)) == 0 && !last) E.mid(acc, cur, wr, wc, (t + 2) / Epi::MID_EVERY - 1); }
        }
        if constexpr (ALIGN_EPI) { if (wr == 0) PG8_BAR; }
        E(acc, cur, wr, wc, fr, fq);
        if (!has_next) break;
#pragma unroll
        for (int a = 0; a < 2; ++a)
#pragma unroll
            for (int b = 0; b < 2; ++b)
#pragma unroll
                for (int m = 0; m < 4; ++m)
#pragma unroll
                    for (int n = 0; n < 2; ++n) acc[a][b][m][n] = (f32x4){0.f, 0.f, 0.f, 0.f};
        cur = nxt; cA = nA; cB = nB; ++ui;
        if constexpr (Sched::GATHER) {
#pragma unroll
            for (int h = 0; h < 2; ++h)
#pragma unroll
                for (int i = 0; i < 2; ++i) goffC[h][i] = goffN[h][i]; }
        if constexpr (ALIGN_EPI) { if (wr == 1) PG8_BAR; }
    }
    PG8_WAIT_V(0);
    if constexpr (!ALIGN_EPI) { if (wr == 0) PG8_BAR; }
    PG8_BAR;
#undef PG8_SA
#undef PG8_SB
#undef PG8_STAGE
#undef PG8_STAGE_A
#undef PG8_LDA
#undef PG8_LDB
#undef PG8_MMA
#undef PG8_WAIT_V
#undef PG8_WAIT_L
#undef PG8_BAR
#undef PG8_SCHED
}
template <class F> struct EpiV4 { static constexpr bool PERM = false, MID = false; static constexpr int MID_EVERY = 1; F f;
    __device__ __forceinline__ void operator()(const f32x4 (&acc)[2][2][4][2], const Unit& u, int wr, int wc, int, int) const {
        const int ln = fresh_lane(), fr = ln & 15, fq = ln >> 4;
        const int row0 = u.pm * BM + wr * 64 + fr, col0 = u.pn * BM + wc * 32 + 4 * fq;
        typename F::UnitPre up = f.unit(u, col0);
#pragma unroll
        for (int ai = 0; ai < 2; ++ai) {
            typename F::Pre pre[4][2][2];
#pragma unroll
            for (int m = 0; m < 4; ++m)
#pragma unroll
                for (int bj = 0; bj < 2; ++bj)
#pragma unroll
                    for (int n = 0; n < 2; ++n) pre[m][bj][n] = f.load(u, row0 + ai * HALF + m * 16, col0 + bj * HALF + n * 16);
#pragma unroll
            for (int m = 0; m < 4; ++m)
#pragma unroll
                for (int bj = 0; bj < 2; ++bj)
#pragma unroll
                    for (int n = 0; n < 2; ++n) f.fin(u, row0 + ai * HALF + m * 16, col0 + bj * HALF + n * 16, acc[ai][bj][m][n], pre[m][bj][n], up, bj * 2 + n);
            asm volatile("" ::: "memory"); }
    } };
template <class F> struct EpiV8 { static constexpr bool PERM = true, MID = false; static constexpr int MID_EVERY = 1; F f;
    __device__ __forceinline__ void operator()(const f32x4 (&acc)[2][2][4][2], const Unit& u, int wr, int wc, int, int) const {
        const int ln = fresh_lane(), fr = ln & 15, fq = ln >> 4;
        const int row0 = u.pm * BM + wr * 64 + fr, col0 = u.pn * BM + wc * 32 + 8 * fq;
#pragma unroll
        for (int ai = 0; ai < 2; ++ai) {
            typename F::Pre pre[4][2];
#pragma unroll
            for (int m = 0; m < 4; ++m)
#pragma unroll
                for (int bj = 0; bj < 2; ++bj) pre[m][bj] = f.load(u, row0 + ai * HALF + m * 16, col0 + bj * HALF);
#pragma unroll
            for (int m = 0; m < 4; ++m)
#pragma unroll
                for (int bj = 0; bj < 2; ++bj) f.fin(u, row0 + ai * HALF + m * 16, col0 + bj * HALF, acc[ai][bj][m][0], acc[ai][bj][m][1], pre[m][bj]);
            asm volatile("" ::: "memory"); }
    } };
template <class F> struct EpiDual { static constexpr bool PERM = true, MID = false; static constexpr int MID_EVERY = 1; F f;
    __device__ __forceinline__ void operator()(const f32x4 (&acc)[2][2][4][2], const Unit& u, int wr, int wc, int, int) const {
        const int ln = fresh_lane(), fr = ln & 15, fq = ln >> 4;
        const int row0 = u.pm * BM + wr * 64 + fr, hc0 = u.pn * HALF + wc * 32 + 8 * fq;
#pragma unroll
        for (int ai = 0; ai < 2; ++ai)
#pragma unroll
            for (int m = 0; m < 4; ++m) f.apply8(row0 + ai * HALF + m * 16, hc0, acc[ai][0][m][0], acc[ai][0][m][1], acc[ai][1][m][0], acc[ai][1][m][1]);
    } };
struct EpiMergeS { static constexpr bool PERM = true, MID = true; static constexpr int MID_EVERY = 8;
    const unsigned char* G8; bf16_t* MG;
    __device__ __forceinline__ void mid(f32x4 (&acc)[2][2][4][2], const Unit& u, int wr, int wc, int i) const {
        const int ln = fresh_lane(), fr = ln & 15, fq = ln >> 4;
        const int row0 = u.pm * BM + wr * 64 + fr, col0 = u.pn * BM + wc * 32 + 8 * fq;
#pragma unroll
        for (int ai = 0; ai < 2; ++ai) {
            u32x2 gi[4][2], gn[4][2];
#pragma unroll
            for (int m = 0; m < 4; ++m)
#pragma unroll
                for (int bj = 0; bj < 2; ++bj) { const unsigned char* gp = G8 + (size_t)(row0 + ai * HALF + m * 16) * 4096 + i * 1024 + col0 + bj * HALF;
                    gi[m][bj] = *(const u32x2*)gp; gn[m][bj] = *(const u32x2*)(gp + 1024); }
#pragma unroll
            for (int m = 0; m < 4; ++m)
#pragma unroll
                for (int bj = 0; bj < 2; ++bj) {
#pragma unroll
                    for (int j = 0; j < 4; ++j) {
                        acc[ai][bj][m][0][j] *= (float)((gi[m][bj].x >> (8 * j)) & 255u) * __builtin_amdgcn_rcpf((float)((gn[m][bj].x >> (8 * j)) & 255u));
                        acc[ai][bj][m][1][j] *= (float)((gi[m][bj].y >> (8 * j)) & 255u) * __builtin_amdgcn_rcpf((float)((gn[m][bj].y >> (8 * j)) & 255u)); } }
        }
    }
    __device__ __forceinline__ void operator()(const f32x4 (&acc)[2][2][4][2], const Unit& u, int wr, int wc, int, int) const {
        const int ln = fresh_lane(), fr = ln & 15, fq = ln >> 4;
        const int row0 = u.pm * BM + wr * 64 + fr, col0 = u.pn * BM + wc * 32 + 8 * fq;
#pragma unroll
        for (int ai = 0; ai < 2; ++ai) {
            u32x2 g3[4][2];
#pragma unroll
            for (int m = 0; m < 4; ++m)
#pragma unroll
                for (int bj = 0; bj < 2; ++bj) g3[m][bj] = *(const u32x2*)(G8 + (size_t)(row0 + ai * HALF + m * 16) * 4096 + 3 * 1024 + col0 + bj * HALF);
#pragma unroll
            for (int m = 0; m < 4; ++m)
#pragma unroll
                for (int bj = 0; bj < 2; ++bj) { f32x4 a = acc[ai][bj][m][0], b = acc[ai][bj][m][1];
#pragma unroll
                    for (int j = 0; j < 4; ++j) { a[j] *= (float)((g3[m][bj].x >> (8 * j)) & 255u) * (1.0f / 255.0f); b[j] *= (float)((g3[m][bj].y >> (8 * j)) & 255u) * (1.0f / 255.0f); }
                    u32x4 w; w.x = cvtpk(a.x, a.y); w.y = cvtpk(a.z, a.w); w.z = cvtpk(b.x, b.y); w.w = cvtpk(b.z, b.w);
                    *(u32x4*)(MG + (size_t)(row0 + ai * HALF + m * 16) * D + col0 + bj * HALF) = w; }
        }
    }
};
}

__device__ __forceinline__ u32x4 pack8(f32x4 a, f32x4 b) { u32x4 w; w.x = cvtpk(a.x, a.y); w.y = cvtpk(a.z, a.w); w.z = cvtpk(b.x, b.y); w.w = cvtpk(b.z, b.w); return w; }
__device__ __forceinline__ float sigm1(float x) { return __builtin_amdgcn_rcpf(1.0f + __builtin_amdgcn_exp2f(-1.4426950408889634f * x)); }
__device__ __forceinline__ f32x4 sigm4(f32x4 v) { f32x4 r; r.x = sigm1(v.x); r.y = sigm1(v.y); r.z = sigm1(v.z); r.w = sigm1(v.w); return r; }
struct NoPre {};
struct FStore8 { bf16_t* C; int ldc; typedef NoPre Pre;
    __device__ __forceinline__ Pre load(const pg8::Unit&, int, int) const { return Pre{}; }
    __device__ __forceinline__ void fin(const pg8::Unit&, int row, int col, f32x4 a, f32x4 b, const Pre&) const { *(u32x4*)(C + (size_t)row * ldc + col) = pack8(a, b); } };
struct FGateU8 { unsigned char* G8; const float* bias; typedef NoPre Pre;
    __device__ __forceinline__ Pre load(const pg8::Unit&, int, int) const { return Pre{}; }
    __device__ __forceinline__ void fin(const pg8::Unit&, int row, int col, f32x4 a, f32x4 b, const Pre&) const { const f32x4 b0 = *(const f32x4*)(bias + col), b1 = *(const f32x4*)(bias + col + 4);
        const f32x4 ga = sigm4(a + b0) * 255.0f + 0.5f, gb = sigm4(b + b1) * 255.0f + 0.5f;
        unsigned q[8] = {(unsigned)ga.x, (unsigned)ga.y, (unsigned)ga.z, (unsigned)ga.w, (unsigned)gb.x, (unsigned)gb.y, (unsigned)gb.z, (unsigned)gb.w};
#pragma unroll
        for (int k = 0; k < 8; ++k) q[k] = q[k] < 1u ? 1u : (q[k] > 255u ? 255u : q[k]);
        u32x2 w; w.x = q[0] | (q[1] << 8) | (q[2] << 16) | (q[3] << 24); w.y = q[4] | (q[5] << 8) | (q[6] << 16) | (q[7] << 24);
        *(u32x2*)(G8 + (size_t)row * 4096 + col) = w; } };
struct FMoe1 { bf16_t* HID;
    __device__ __forceinline__ void apply8(int row, int hc, f32x4 a0, f32x4 a1, f32x4 b0, f32x4 b1) const {
        *(u32x4*)(HID + (size_t)row * FF + hc) = pack8(a0 * sigm4(a0) * b0, a1 * sigm4(a1) * b1); } };
struct FMoe2 { bf16_t* MO; const int* tokl; const float* wl; struct Pre { int t; float w; };
    __device__ __forceinline__ Pre load(const pg8::Unit& u, int row, int) const { Pre r; const int pos = u.p0 + (row - u.pm * 256); r.t = -1; r.w = 0.f;
        if (pos < u.ce) { r.t = tokl[(size_t)u.e * R + pos]; r.w = wl[(size_t)u.e * R + pos]; } return r; }
    __device__ __forceinline__ void fin(const pg8::Unit&, int, int col, f32x4 a, f32x4 b, const Pre& q) const { if (q.t < 0) return;
        *(u32x4*)(MO + ((size_t)(q.t & 1) * R + (q.t >> 1)) * D + col) = pack8(a * q.w, b * q.w); } };
struct FOut { Ptrs P; int l; typedef f32x4 Pre; struct UnitPre { f32x4 g[4]; };
    __device__ __forceinline__ UnitPre unit(const pg8::Unit& u, int col0) const { UnitPre r; const float* g = mod_vec(P, l, row_bb(u.pm * 256), 2) + col0;
#pragma unroll
        for (int q = 0; q < 4; ++q) r.g[q] = *(const f32x4*)(g + (q >> 1) * 128 + (q & 1) * 16);
        return r; }
    __device__ __forceinline__ Pre load(const pg8::Unit&, int row, int col) const { return l == 0 ? *(const f32x4*)(xin_row(P, row) + col) : *(const f32x4*)(x1_row(P, row) + col); }
    __device__ __forceinline__ void fin(const pg8::Unit&, int row, int col, f32x4 v, const Pre& xp, const UnitPre& up, int q) const { *(f32x4*)(x1_row(P, row) + col) = xp + up.g[q] * v; } };

struct Frame { LAS unsigned char* lds; int wave, vcu, G; };
#define fresh_tid() (F.wave * 64 + fresh_lane())
__device__ __forceinline__ void tr_item(const float* W, int ldw, int k0, int csrc0, bf16_t* WT, int ldt, int drow0, LAS float* scr, int lane) {
    f32x4 v[8];
#pragma unroll
    for (int i = 0; i < 8; ++i) v[i] = *(const f32x4*)(W + (size_t)(k0 + (lane >> 3) + 8 * i) * ldw + csrc0 + (lane & 7) * 4);
#pragma unroll
    for (int i = 0; i < 8; ++i) { LAS float* d = scr + ((lane >> 3) + 8 * i) * 33 + (lane & 7) * 4; d[0] = v[i].x; d[1] = v[i].y; d[2] = v[i].z; d[3] = v[i].w; }
    LDS_WAIT(); asm volatile("" ::: "memory");
    const int c = lane & 7;
#pragma unroll
    for (int j = 0; j < 4; ++j) { const int n = (lane >> 3) + 8 * j; const LAS float* s = scr + (8 * c) * 33 + n;
        u32x4 o; o.x = cvtpk(s[0 * 33], s[1 * 33]); o.y = cvtpk(s[2 * 33], s[3 * 33]); o.z = cvtpk(s[4 * 33], s[5 * 33]); o.w = cvtpk(s[6 * 33], s[7 * 33]);
        *(u32x4*)(WT + (size_t)(drow0 + n) * ldt + k0 + 8 * c) = o; }
    LDS_WAIT(); asm volatile("" ::: "memory");
}
__device__ __forceinline__ void ph_weights(const Frame& F, const Ptrs& P, int l) {
    const int tid0 = fresh_tid(), lane0 = tid0 & 63;
    LAS float* scr = (LAS float*)(F.lds + F.wave * 16384);
    const int gw = F.vcu * NWAVES + F.wave, NGW = F.G * NWAVES;
    unsigned char* wb = P.ws + WS_WB;
    constexpr int I0 = 1024, I1 = I0 + 2048, I2 = I1 + 768, I3 = I2 + 512, I4 = I3 + 4096, I5 = I4 + 4096, I6 = I5 + 4096;
    for (int it = gw; it < I6; it += NGW) {
        if (it < I0) { const int kb = it >> 6, nb = it & 63; tr_item(P.w_in + (size_t)l * 1024 * 2560, 2560, kb * 64, 512 + nb * 32, (bf16_t*)(wb + WB_IN), 1024, 1024 + nb * 32, scr, lane0); }
        else if (it < I1) { const int r = it - I0, i = r >> 9, q = r & 511, kb = q >> 5, nb = q & 31; tr_item(P.w_gate + ((size_t)l * 4 + i) * 1024 * 1024, 1024, kb * 64, nb * 32, (bf16_t*)(wb + WB_GATE) + (size_t)i * 1024 * 1024, 1024, nb * 32, scr, lane0); }
        else if (it < I2) { const int r = it - I1, i = r >> 8, q = r & 255, kb = q >> 5, nb = q & 31; tr_item(P.w_branch + ((size_t)l * 4 + i) * 512 * 1024, 1024, kb * 64, nb * 32, (bf16_t*)(wb + WB_BR) + i * 512, 2048, nb * 32, scr, lane0); }
        else if (it < I3) { const int q = it - I2, kb = q >> 5, nb = q & 31; tr_item(P.w_out + (size_t)l * 1024 * 1024, 1024, kb * 64, nb * 32, (bf16_t*)(wb + WB_OUT), 1024, nb * 32, scr, lane0); }
        else if (it < I5) { const int w3 = it >= I4; const int r = it - (w3 ? I4 : I3), e = r >> 8, q = r & 255, kb = q >> 4, nb = q & 15, c = nb * 32;
            tr_item((w3 ? P.w3 : P.w1) + ((size_t)l * 16 + e) * 1024 * 512, 512, kb * 64, c, (bf16_t*)(wb + WB_13) + (size_t)e * 1024 * 1024, 1024, 256 * (c >> 7) + (c & 127) + (w3 ? 128 : 0), scr, lane0); }
        else { const int r = it - I5, e = r >> 8, q = r & 255, kb = q >> 5, nb = q & 31; tr_item(P.w2 + ((size_t)l * 16 + e) * 512 * 1024, 1024, kb * 64, nb * 32, (bf16_t*)(wb + WB_2) + (size_t)e * 1024 * 512, 512, nb * 32, scr, lane0); }
    }
    __syncthreads();
    for (int u = F.vcu; u < 64; u += F.G) {
        LAS float* Wl = (LAS float*)F.lds; LAS float* ct = Wl + 64 * 128;
        const int kt = u >> 2, g = u & 3, k0 = kt * 64, tid = tid0; const float* w_in = P.w_in + (size_t)l * 1024 * 2560;
        if (tid < 128) ct[tid] = __builtin_amdgcn_cosf((float)tid * (1.0f / 128.0f));
        for (int i = tid; i < 64 * 128; i += 512) { const int k = i >> 7, c = i & 127; Wl[k * 128 + c] = w_in[(size_t)(k0 + k) * 2560 + g * 128 + c]; }
        __syncthreads();
        const int part = (tid >> 7) & 1, m = tid & 127, kh = tid >> 8; const float sc = 0.08838834764831845f;
        bf16_t* drow = (bf16_t*)(wb + WB_IN) + (size_t)(part * 512 + g * 128 + m) * 1024 + k0;
        for (int kb = kh * 32; kb < kh * 32 + 32; kb += 8) { float acc[8];
#pragma unroll
            for (int j = 0; j < 8; ++j) acc[j] = 0.f;
            for (int c = 0; c < 128; ++c) { const int idx = (c * m) & 127; const float tw = part ? -ct[(idx - 32) & 127] : ct[idx];
#pragma unroll
                for (int j = 0; j < 8; ++j) acc[j] += Wl[(kb + j) * 128 + c] * tw; }
            u32x4 o; o.x = pk2(acc[0] * sc, acc[1] * sc); o.y = pk2(acc[2] * sc, acc[3] * sc); o.z = pk2(acc[4] * sc, acc[5] * sc); o.w = pk2(acc[6] * sc, acc[7] * sc);
            *(u32x4*)(drow + kb) = o; }
        __syncthreads();
    }
    for (int u = F.G - 1 - F.vcu; u < 64; u += F.G) {
        LAS float* Wb = (LAS float*)F.lds;
        const int g = u >> 4, n0 = (u & 15) * 64, tid = tid0;
        const float* ps = P.pool_scale + (size_t)l * 512; const float* wb3 = P.w_branch + ((size_t)l * 4 + 3) * 512 * 1024; const float* pwl = P.pool_w + (size_t)l * 4 * 128 * 128;
        for (int i = tid; i < 128 * 64; i += 512) { const int e = i >> 6, n = i & 63; Wb[e * 64 + n] = ps[g * 128 + e] * wb3[(size_t)(g * 128 + e) * 1024 + n0 + n]; }
        __syncthreads();
        const int c = tid & 127, nh = tid >> 7; const float* pw = pwl + (size_t)(g * 128 + c) * 128;
        float acc[16];
#pragma unroll
        for (int j = 0; j < 16; ++j) acc[j] = 0.f;
        for (int e = 0; e < 128; ++e) { const float p = pw[e];
#pragma unroll
            for (int j = 0; j < 16; ++j) acc[j] += p * Wb[e * 64 + nh * 16 + j]; }
        bf16_t* Bt = (bf16_t*)(wb + WB_BR) + 3 * 512;
#pragma unroll
        for (int j = 0; j < 16; ++j) Bt[(size_t)(n0 + nh * 16 + j) * 2048 + g * 128 + c] = (bf16_t)f2bf(acc[j]);
        __syncthreads();
    }
}
__device__ __forceinline__ void ph_tables_mod(const Frame& F, const Ptrs& P) {
    const int tid0 = fresh_tid();
    { float* rc = (float*)(P.ws + WS_ROPE); float* rs = rc + 1024; float* ct = (float*)(P.ws + WS_COS);
      const int i = F.vcu * 512 + tid0;
      if (i < 1024) { const int pos = i >> 4, f = i & 15; const float inv = exp2f(-(float)f * (13.287712379549449f / 16.0f));
          float rev = (float)pos * inv * 0.15915494309189535f; rev = rev - floorf(rev);
          rc[i] = __builtin_amdgcn_cosf(rev); rs[i] = __builtin_amdgcn_sinf(rev); }
      if (i < 4096) ct[i] = __builtin_amdgcn_cosf((float)i * (1.0f / 4096.0f));
      if (i < 16384) { const int mm = i >> 7, k = i & 127, pp = mm >> 6, k1 = mm & 63, pk = k >> 6, t1 = k & 63; const float rev = (float)((k1 * t1) & 63) * (1.0f / 64.0f);
          const float c = __builtin_amdgcn_cosf(rev), sn = __builtin_amdgcn_sinf(rev);
          ((bf16_t*)(P.ws + WS_DFTM))[i] = (bf16_t)f2bf(pp == pk ? c : (pp == 0 ? sn : -sn)); } }
    for (int u = F.vcu; u < 192; u += F.G) {
        LAS float* s = (LAS float*)F.lds; LAS float* red = s + 9 * 1024;
        const int l = u / 96, j0 = (u % 96) * 64, tid = tid0;
        for (int i = tid; i < 9 * 1024; i += 512) { const int bb = i >> 10, k = i & 1023; const float v = bb < 8 ? P.c[bb * 1024 + k] : P.c_ctx[k]; s[i] = v / (1.f + expf(-v)); }
        __syncthreads();
        const int kc = tid >> 6, jj = tid & 63; float acc[9];
#pragma unroll
        for (int b = 0; b < 9; ++b) acc[b] = 0.f;
        const float* w = P.w_ada + (size_t)l * 1024 * 6144 + j0 + jj;
        for (int k = kc * 128; k < kc * 128 + 128; k += 8) { float wv[8];
#pragma unroll
            for (int q = 0; q < 8; ++q) wv[q] = w[(size_t)(k + q) * 6144];
#pragma unroll
            for (int q = 0; q < 8; ++q)
#pragma unroll
                for (int b = 0; b < 9; ++b) acc[b] += s[b * 1024 + k + q] * wv[q]; }
#pragma unroll
        for (int b = 0; b < 9; ++b) red[(kc * 9 + b) * 64 + jj] = acc[b];
        __syncthreads();
        float* mod = (float*)(P.ws + WS_MOD);
        for (int i = tid; i < 9 * 64; i += 512) { const int b = i >> 6, j = i & 63; float v = P.b_ada[l * 6144 + j0 + j];
#pragma unroll
            for (int q = 0; q < 8; ++q) v += red[(q * 9 + b) * 64 + j];
            mod[(size_t)(l * 9 + b) * 6144 + j0 + j] = v; }
        __syncthreads();
    }
}
__device__ __forceinline__ void route_row(const Ptrs& P, int r, const f32x4 (&h)[4], int lane, bool publish, LAS unsigned* lcnt, LAS int* rec, const LAS float* rwl) {
    float lg[16];
#pragma unroll
    for (int e = 0; e < 16; ++e) lg[e] = 0.f;
#pragma unroll
    for (int j = 0; j < 4; ++j) {
#pragma unroll
        for (int i = 0; i < 4; ++i) { const int kk = 4 * lane + 256 * j + i; const LAS f32x4* rw = (const LAS f32x4*)(rwl + kk * 16 + (kk >> 2) * 4); const float hv = h[j][i];
#pragma unroll
            for (int qd = 0; qd < 4; ++qd) { const f32x4 w = rw[qd]; lg[4 * qd] += hv * w.x; lg[4 * qd + 1] += hv * w.y; lg[4 * qd + 2] += hv * w.z; lg[4 * qd + 3] += hv * w.w; } }
        __builtin_amdgcn_sched_barrier(0); }
    float v8[8], v4[4], v2[2], v1;
    { const bool bit = (lane & 32) != 0;
#pragma unroll
      for (int i = 0; i < 8; ++i) { const float a = lg[i], b = lg[i + 8]; v8[i] = (bit ? b : a) + shfl_xor_l(bit ? a : b, 32, lane); } }
    { const bool bit = (lane & 16) != 0;
#pragma unroll
      for (int i = 0; i < 4; ++i) { const float a = v8[i], b = v8[i + 4]; v4[i] = (bit ? b : a) + shfl_xor_l(bit ? a : b, 16, lane); } }
    { const bool bit = (lane & 8) != 0;
#pragma unroll
      for (int i = 0; i < 2; ++i) { const float a = v4[i], b = v4[i + 2]; v2[i] = (bit ? b : a) + shfl_xor_l(bit ? a : b, 8, lane); } }
    { const bool bit = (lane & 4) != 0; const float a = v2[0], b = v2[1]; v1 = (bit ? b : a) + shfl_xor_l(bit ? a : b, 4, lane); }
    v1 += shfl_xor_l(v1, 2, lane); v1 += shfl_xor_l(v1, 1, lane);
    float bestscore = -INFINITY; int be0 = 0, be1 = 1; float ba0 = 0.f, ba1 = 0.f;
#pragma unroll
    for (int g = 0; g < 4; ++g) {
        float aff[4], sel[4];
#pragma unroll
        for (int i = 0; i < 4; ++i) { const float t = __int_as_float(__builtin_amdgcn_ds_bpermute((4 * g + i) << 4, __float_as_int(v1))); aff[i] = 1.0f / (1.0f + expf(-t)); sel[i] = aff[i] + P.router_bias[4 * g + i]; }
        int i1 = 0; float m1 = sel[0], a1 = aff[0];
#pragma unroll
        for (int i = 1; i < 4; ++i) if (sel[i] > m1) { m1 = sel[i]; a1 = aff[i]; i1 = i; }
        int i2 = -1; float m2 = -INFINITY, a2 = 0.f;
#pragma unroll
        for (int i = 0; i < 4; ++i) if (i != i1 && sel[i] > m2) { m2 = sel[i]; a2 = aff[i]; i2 = i; }
        const float score = m1 + m2;
        if (score > bestscore) { bestscore = score; be0 = 4 * g + i1; be1 = 4 * g + i2; ba0 = a1; ba1 = a2; }
    }
    if (lane == 0 && publish) {
        const int p0 = (int)__hip_atomic_fetch_add(lcnt + be0, 1u, __ATOMIC_RELAXED, __HIP_MEMORY_SCOPE_WORKGROUP), p1 = (int)__hip_atomic_fetch_add(lcnt + be1, 1u, __ATOMIC_RELAXED, __HIP_MEMORY_SCOPE_WORKGROUP);
        const float inv = 1.0f / (ba0 + ba1);
        rec[0] = r; rec[1] = be0; rec[2] = p0; rec[3] = be1; rec[4] = p1; rec[5] = __float_as_int(ba0 * inv); rec[6] = __float_as_int(ba1 * inv);
    }
}
template <int MODE> __device__ __forceinline__ void ph_norm(const Frame& F, const Ptrs& P, int l, int nrows) {
    const int lane = fresh_lane();
    const int stride = F.G * NWAVES;
    LAS unsigned* lcnt = (LAS unsigned*)F.lds; LAS unsigned* gbase = lcnt + 16; LAS int* recs = (LAS int*)(F.lds + 256);
    const LAS float* rwl = (const LAS float*)(F.lds + 8192);
    if (MODE == 2) { if (F.wave == 0 && lane < 16) lcnt[lane] = 0u;
        { const int tid = F.wave * 64 + lane; LAS f32x4* d = (LAS f32x4*)(F.lds + 8192);
#pragma unroll
          for (int i = 0; i < 8; ++i) { const int idx = tid + 512 * i, kk = idx >> 2; d[idx + (kk >> 2)] = ((const f32x4*)P.router_w)[idx]; } }
        __syncthreads(); }
    int it = 0;
    for (int rb = F.vcu * NWAVES + F.wave; rb < nrows; rb += 2 * stride, ++it) {
        int rr[2]; rr[0] = rb; rr[1] = rb + stride < nrows ? rb + stride : rb;
        f32x4 v[2][4];
#pragma unroll
        for (int q = 0; q < 2; ++q) { const int r = rr[q];
            if (MODE == 0) { const f32x4* xr = (const f32x4*)xin_row(P, r) + lane;
#pragma unroll
                for (int j = 0; j < 4; ++j) v[q][j] = xr[64 * j]; }
            else { const f32x4* xr = (const f32x4*)x1_row(P, r) + lane;
#pragma unroll
                for (int j = 0; j < 4; ++j) v[q][j] = xr[64 * j]; } }
        if (MODE == 1) {
#pragma unroll
            for (int q = 0; q < 2; ++q) { const int r = rr[q]; const int bb = row_bb(r); const f32x4* g2 = (const f32x4*)mod_vec(P, l - 1, bb, 5) + lane;
                const u32x2* m0 = (const u32x2*)((const bf16_t*)(P.ws + WS_MO) + (size_t)r * D) + lane; const u32x2* m1 = (const u32x2*)((const bf16_t*)(P.ws + WS_MO) + (size_t)(R + r) * D) + lane;
#pragma unroll
                for (int j = 0; j < 4; ++j) { const u32x2 a = m0[64 * j], b = m1[64 * j]; const f32x4 g = g2[64 * j];
                    v[q][j].x += g.x * (lo16(a.x) + lo16(b.x)); v[q][j].y += g.y * (hi16(a.x) + hi16(b.x)); v[q][j].z += g.z * (lo16(a.y) + lo16(b.y)); v[q][j].w += g.w * (hi16(a.y) + hi16(b.y)); } }
            if (rr[1] != rr[0]) { f32x4* xr = (f32x4*)x1_row(P, rr[1]) + lane;
#pragma unroll
                for (int j = 0; j < 4; ++j) xr[64 * j] = v[1][j]; }
            { f32x4* xr = (f32x4*)x1_row(P, rr[0]) + lane;
#pragma unroll
              for (int j = 0; j < 4; ++j) xr[64 * j] = v[0][j]; }
        }
        float ss[2];
#pragma unroll
        for (int q = 0; q < 2; ++q) { ss[q] = 0.f;
#pragma unroll
            for (int j = 0; j < 4; ++j) ss[q] += (v[q][j].x * v[q][j].x + v[q][j].y * v[q][j].y) + (v[q][j].z * v[q][j].z + v[q][j].w * v[q][j].w); }
#pragma unroll
        for (int o = 1; o < 64; o <<= 1) { ss[0] += shfl_xor_l(ss[0], o, lane); ss[1] += shfl_xor_l(ss[1], o, lane); }
        const f32x4* gn = (const f32x4*)((MODE == 2 ? P.norm2 : P.norm1) + (size_t)l * D) + lane;
#pragma unroll
        for (int q = 0; q < 2; ++q) { const int r = rr[q]; const int bb = row_bb(r);
            const float rstd = 1.0f / sqrtf(ss[q] * (1.0f / D) + EPS);
            const f32x4* sh = (const f32x4*)mod_vec(P, l, bb, MODE == 2 ? 3 : 0) + lane;
            const f32x4* sc = (const f32x4*)mod_vec(P, l, bb, MODE == 2 ? 4 : 1) + lane;
            u32x2* o = (u32x2*)((bf16_t*)(P.ws + WS_H) + (size_t)r * D) + lane;
#pragma unroll
            for (int j = 0; j < 4; ++j) { const f32x4 g = gn[64 * j], a = sh[64 * j], b = sc[64 * j];
                v[q][j] = (v[q][j] * rstd * g) * (b + 1.0f) + a;
                u32x2 w; w.x = cvtpk(v[q][j].x, v[q][j].y); w.y = cvtpk(v[q][j].z, v[q][j].w); o[64 * j] = w; } }
        if (MODE == 2) { LAS int* rec = recs + (F.wave * 24 + 2 * it) * 8;
            route_row(P, rr[0], v[0], lane, true, lcnt, rec, rwl); __builtin_amdgcn_sched_barrier(0);
            if (lane == 0 && rr[1] == rr[0]) rec[8] = -1;
            route_row(P, rr[1], v[1], lane, rr[1] != rr[0], lcnt, rec + 8, rwl); }
    }
    if (MODE == 2) {
        __syncthreads();
        const int tid = F.wave * 64 + lane;
        if (tid < 16) { const unsigned c = lcnt[tid]; gbase[tid] = c ? atomicAdd((unsigned*)(P.ws + WS_CTL) + CW_CNT + 1024 * l + 64 * tid, c) : 0u; }
        __syncthreads();
        if (lane == 0) for (int k = 0; k < 2 * it; ++k) { const LAS int* rec = recs + (F.wave * 24 + k) * 8; const int r = rec[0]; if (r < 0) continue;
            int* tokl = (int*)(P.ws + WS_TOKL); float* wl = (float*)(P.ws + WS_WL);
            const size_t i0 = (size_t)rec[1] * R + rec[2] + gbase[rec[1]], i1 = (size_t)rec[3] * R + rec[4] + gbase[rec[3]];
            tokl[i0] = 2 * r; wl[i0] = __int_as_float(rec[5]); tokl[i1] = 2 * r + 1; wl[i1] = __int_as_float(rec[6]); }
        __syncthreads();
    }
}
__device__ __forceinline__ void ph_kprep(const Frame& F, const Ptrs& P, int l) {
    const int lane = fresh_lane();
    const float* rc = (const float*)(P.ws + WS_ROPE); const float* rs = rc + 1024;
    const int hs = (lane >> 3) & 3, chunk = lane & 7, col = (hs < 2 ? C_KB + hs * 64 : C_KW + (hs - 2) * 64) + chunk * 8;
    const f32x4 g0 = *(const f32x4*)(P.k_gain + l * 64 + chunk * 8), g1 = *(const f32x4*)(P.k_gain + l * 64 + chunk * 8 + 4);
    const int a = chunk >> 2, fi = (chunk & 1) * 8; const bool second = (chunk & 2) != 0;
    const int npair = R / 2, stride = F.G * NWAVES;
    for (int pr0 = F.vcu * NWAVES + F.wave; pr0 < npair; pr0 += 4 * stride) {
        u32x4 w[4];
#pragma unroll
        for (int q = 0; q < 4; ++q) { const int pr = pr0 + q * stride; const int r = 2 * (pr < npair ? pr : pr0) + (lane >> 5); w[q] = *(const u32x4*)((const bf16_t*)(P.ws + WS_U) + (size_t)r * NIN + col); }
#pragma unroll
        for (int q = 0; q < 4; ++q) { const int pr = pr0 + q * stride; if (pr >= npair) break;
            const int r = 2 * pr + (lane >> 5);
            float x[8] = {lo16(w[q].x), hi16(w[q].x), lo16(w[q].y), hi16(w[q].y), lo16(w[q].z), hi16(w[q].z), lo16(w[q].w), hi16(w[q].w)};
            if (hs < 2) { float ss = 0.f;
#pragma unroll
                for (int j = 0; j < 8; ++j) ss += x[j] * x[j];
                ss += shfl_xor_l(ss, 1, lane); ss += shfl_xor_l(ss, 2, lane); ss += shfl_xor_l(ss, 4, lane);
                const float rstd = 1.0f / sqrtf(ss * (1.0f / 64.0f) + EPS);
                x[0] *= rstd * g0.x; x[1] *= rstd * g0.y; x[2] *= rstd * g0.z; x[3] *= rstd * g0.w; x[4] *= rstd * g1.x; x[5] *= rstd * g1.y; x[6] *= rstd * g1.z; x[7] *= rstd * g1.w; }
            if (r < RL) { const int t = r & (T - 1), pos = a ? (t & 63) : (t >> 6);
                const f32x4 c0 = *(const f32x4*)(rc + pos * 16 + fi), c1 = *(const f32x4*)(rc + pos * 16 + fi + 4), s0 = *(const f32x4*)(rs + pos * 16 + fi), s1 = *(const f32x4*)(rs + pos * 16 + fi + 4);
                const float cs[8] = {c0.x, c0.y, c0.z, c0.w, c1.x, c1.y, c1.z, c1.w}, sn[8] = {s0.x, s0.y, s0.z, s0.w, s1.x, s1.y, s1.z, s1.w};
#pragma unroll
                for (int j = 0; j < 8; ++j) { const float y = shfl_xor_l(x[j], 2, lane); x[j] = second ? x[j] * cs[j] + y * sn[j] : x[j] * cs[j] - y * sn[j]; } }
            u32x4 o; o.x = cvtpk(x[0], x[1]); o.y = cvtpk(x[2], x[3]); o.z = cvtpk(x[4], x[5]); o.w = cvtpk(x[6], x[7]);
            *(u32x4*)((bf16_t*)(P.ws + WS_U) + (size_t)r * NIN + col) = o; }
    }
}
__device__ __forceinline__ void ph_pool(const Frame& F, const Ptrs& P, int nrows) {
    const int tid0 = fresh_tid();
    for (int i = F.vcu * 512 + tid0; i < nrows * 64; i += F.G * 512) {
        const int r = i >> 6, c8 = (i & 63) * 8;
        const bool lat = r < RL; const int Ts = lat ? T : TC; const int t = lat ? (r & (T - 1)) : ((r - RL) & (TC - 1)); const int r0 = r - t;
        const int g = c8 >> 7, hw = 1 << g;
        const int lo = t - hw < 0 ? 0 : t - hw, hi = t + hw > Ts ? Ts : t + hw;
        const bf16_t* U = (const bf16_t*)(P.ws + WS_U) + C_P + c8;
        u32x4 wv[16];
#pragma unroll
        for (int k = 0; k < 16; ++k) { const int tt = t - 8 + k; const bool ok = tt >= lo && tt < hi; wv[k] = *(const u32x4*)(U + (size_t)(r0 + (ok ? tt : t)) * NIN); }
        float s[8];
#pragma unroll
        for (int j = 0; j < 8; ++j) s[j] = 0.f;
#pragma unroll
        for (int k = 0; k < 16; ++k) { const int tt = t - 8 + k; const float f = (tt >= lo && tt < hi) ? 1.f : 0.f; const u32x4 w = wv[k];
            s[0] += f * lo16(w.x); s[1] += f * hi16(w.x); s[2] += f * lo16(w.y); s[3] += f * hi16(w.y); s[4] += f * lo16(w.z); s[5] += f * hi16(w.z); s[6] += f * lo16(w.w); s[7] += f * hi16(w.w); }
        const u32x4 w = wv[8]; const float inv = 1.0f / (float)(hi - lo);
        u32x4 o; o.x = cvtpk(s[0] * inv - lo16(w.x), s[1] * inv - hi16(w.x)); o.y = cvtpk(s[2] * inv - lo16(w.y), s[3] * inv - hi16(w.y));
        o.z = cvtpk(s[4] * inv - lo16(w.z), s[5] * inv - hi16(w.z)); o.w = cvtpk(s[6] * inv - lo16(w.w), s[7] * inv - hi16(w.w));
        *(u32x4*)((bf16_t*)(P.ws + WS_BR) + (size_t)r * NBR + 1536 + c8) = o;
    }
}
__device__ __forceinline__ void ph_final(const Frame& F, const Ptrs& P) {
    const int lane = fresh_tid() & 63;
    for (int r = F.vcu * NWAVES + F.wave; r < RL; r += F.G * NWAVES) {
        const int bb = row_bb(r);
        f32x4* xr = (f32x4*)(P.out + (size_t)r * D) + lane; f32x4 v[4];
        const f32x4* g2 = (const f32x4*)mod_vec(P, 1, bb, 5) + lane;
        const u32x2* m0 = (const u32x2*)((const bf16_t*)(P.ws + WS_MO) + (size_t)r * D) + lane; const u32x2* m1 = (const u32x2*)((const bf16_t*)(P.ws + WS_MO) + (size_t)(R + r) * D) + lane;
        float ss = 0.f;
#pragma unroll
        for (int j = 0; j < 4; ++j) { v[j] = xr[64 * j]; const u32x2 a = m0[64 * j], b = m1[64 * j]; const f32x4 g = g2[64 * j];
            v[j].x += g.x * (lo16(a.x) + lo16(b.x)); v[j].y += g.y * (hi16(a.x) + hi16(b.x)); v[j].z += g.z * (lo16(a.y) + lo16(b.y)); v[j].w += g.w * (hi16(a.y) + hi16(b.y));
            ss += (v[j].x * v[j].x + v[j].y * v[j].y) + (v[j].z * v[j].z + v[j].w * v[j].w); }
        const float rstd = 1.0f / sqrtf(wave_sum_l(ss, lane) * (1.0f / D) + EPS);
        const f32x4* gn = (const f32x4*)P.norm_f + lane;
#pragma unroll
        for (int j = 0; j < 4; ++j) xr[64 * j] = v[j] * rstd * gn[64 * j];
    }
}

template <int MODE> __device__ __forceinline__ void ph_attn_ref(const Frame& F, const Ptrs& P, int l) {
    const int tid = fresh_tid();
    LAS float* Ks = (LAS float*)F.lds; LAS float* Vs = Ks + 64 * 64;
    const bf16_t* U = (const bf16_t*)(P.ws + WS_U);
    const bool latq = MODE < 2; const bool winm = (MODE == 1 || MODE == 3);
    const int NU = latq ? 1024 : 64; const int half = tid & 1;
    for (int u = F.vcu; u < NU; u += F.G) {
        const int qb = latq ? (u & 15) : 0, h = latq ? ((u >> 4) & 7) : (u & 7), b = latq ? (u >> 7) : (u >> 3), g = h >> 2;
        const int tq = qb * 256 + (tid >> 1);
        const int qrow = latq ? b * T + tq : RL + b * TC + tq;
        const int qcol = (winm ? C_QW : C_QB) + h * 64 + half * 32, kcol = (winm ? C_KW : C_KB) + g * 64, vcol = (winm ? C_VW : C_VB) + g * 64;
        unsigned q[16]; float o[32];
        { const u32x4* qp = (const u32x4*)(U + (size_t)qrow * NIN + qcol);
#pragma unroll
          for (int i = 0; i < 4; ++i) { const u32x4 w = qp[i]; q[4 * i] = w.x; q[4 * i + 1] = w.y; q[4 * i + 2] = w.z; q[4 * i + 3] = w.w; } }
#pragma unroll
        for (int d = 0; d < 32; ++d) o[d] = 0.f;
        float m = -INFINITY, lsum = 0.f;
        int lt_lo = 0, lt_hi = 0;
        if (MODE == 0) { lt_lo = 0; lt_hi = T / 64; }
        if (MODE == 1) { const int q0 = qb * 256; lt_lo = (q0 - 128 < 0 ? 0 : q0 - 128) / 64; lt_hi = (q0 + 384 > T ? T : q0 + 384) / 64; }
        const int ntiles = 4 + (lt_hi - lt_lo);
        for (int ti = 0; ti < ntiles; ++ti) {
            const bool isctx = ti < 4; const int kpos0 = isctx ? ti * 64 : (lt_lo + ti - 4) * 64;
            const int krow0 = isctx ? RL + b * TC + kpos0 : b * T + kpos0;
            __syncthreads();
            { const int j = tid >> 3, part = tid & 7; const u32x4 kw = *(const u32x4*)(U + (size_t)(krow0 + j) * NIN + kcol + part * 8), vw = *(const u32x4*)(U + (size_t)(krow0 + j) * NIN + vcol + part * 8);
              LAS float* kd = Ks + j * 64 + part * 8; LAS float* vd = Vs + j * 64 + part * 8;
              kd[0] = lo16(kw.x); kd[1] = hi16(kw.x); kd[2] = lo16(kw.y); kd[3] = hi16(kw.y); kd[4] = lo16(kw.z); kd[5] = hi16(kw.z); kd[6] = lo16(kw.w); kd[7] = hi16(kw.w);
              vd[0] = lo16(vw.x); vd[1] = hi16(vw.x); vd[2] = lo16(vw.y); vd[3] = hi16(vw.y); vd[4] = lo16(vw.z); vd[5] = hi16(vw.z); vd[6] = lo16(vw.w); vd[7] = hi16(vw.w); }
            __syncthreads();
#pragma unroll 1
            for (int jk = 0; jk < 64; ++jk) {
                float a = 0.f; const LAS f32x4* kr = (const LAS f32x4*)(Ks + jk * 64 + half * 32);
#pragma unroll
                for (int d4 = 0; d4 < 8; ++d4) { const f32x4 kv = kr[d4]; a += lo16(q[2 * d4]) * kv.x + hi16(q[2 * d4]) * kv.y + lo16(q[2 * d4 + 1]) * kv.z + hi16(q[2 * d4 + 1]) * kv.w; }
                a += shfl_xor_l(a, 1, tid & 63);
                if (MODE == 1 && !isctx) { const int dlt = kpos0 + jk - tq; if (dlt > 128 || dlt < -128) a = -INFINITY; }
                if (a != -INFINITY) {
                    if (a > m) { const float scl = exp2f(m - a); m = a; lsum *= scl;
#pragma unroll
                        for (int d = 0; d < 32; ++d) o[d] *= scl; }
                    const float p = exp2f(a - m); lsum += p; const LAS f32x4* vr = (const LAS f32x4*)(Vs + jk * 64 + half * 32);
#pragma unroll
                    for (int d4 = 0; d4 < 8; ++d4) { const f32x4 vv = vr[d4]; o[4 * d4] += p * vv.x; o[4 * d4 + 1] += p * vv.y; o[4 * d4 + 2] += p * vv.z; o[4 * d4 + 3] += p * vv.w; }
                }
            }
        }
        if (winm) lsum += exp2f(P.sink[l * 8 + h] * LOG2E - m);
        const float inv = 1.0f / lsum;
        { u32x4* op = (u32x4*)((bf16_t*)(P.ws + WS_BR) + (size_t)qrow * NBR + (winm ? 1024 : 512) + h * 64 + half * 32);
#pragma unroll
          for (int i = 0; i < 4; ++i) { u32x4 w; w.x = pk2(o[8 * i] * inv, o[8 * i + 1] * inv); w.y = pk2(o[8 * i + 2] * inv, o[8 * i + 3] * inv); w.z = pk2(o[8 * i + 4] * inv, o[8 * i + 5] * inv); w.w = pk2(o[8 * i + 6] * inv, o[8 * i + 7] * inv); op[i] = w; } }
        __syncthreads();
    }
}
__device__ __forceinline__ void ph_fourier_ref(const Frame& F, const Ptrs& P, int Ts, int latent) {
    const int tid = fresh_tid();
    LAS float* Zr = (LAS float*)F.lds; LAS float* Zi = Zr + 16 * 64; LAS float* Ct = Zi + 16 * 64; LAS float* St = Ct + 128 * 17;
    const bf16_t* U = (const bf16_t*)(P.ws + WS_U); const float* ct = (const float*)(P.ws + WS_COS);
    const int nkt = Ts / 128, NU = 8 * nkt * 8, step = 4096 / Ts;
    const int tk = tid >> 4, tc = tid & 15;
    for (int u = F.vcu; u < NU; u += F.G) {
        const int cht = u & 7, kt = (u >> 3) % nkt, b = (u >> 3) / nkt, k0 = kt * 128, ch0 = cht * 64;
        const int rbase = latent ? b * T : RL + b * TC;
        float acc[4][4];
#pragma unroll
        for (int i = 0; i < 4; ++i)
#pragma unroll
            for (int j = 0; j < 4; ++j) acc[i][j] = 0.f;
        for (int t0 = 0; t0 < Ts; t0 += 16) {
            __syncthreads();
            if (tid < 256) { const int tt = tid >> 4, c4 = (tid & 15) * 4; const bf16_t* zp = U + (size_t)(rbase + t0 + tt) * NIN + ch0 + c4;
              const u32x2 a = *(const u32x2*)(zp + C_ZR), bq = *(const u32x2*)(zp + C_ZI);
              Zr[tt * 64 + c4] = lo16(a.x); Zr[tt * 64 + c4 + 1] = hi16(a.x); Zr[tt * 64 + c4 + 2] = lo16(a.y); Zr[tt * 64 + c4 + 3] = hi16(a.y);
              Zi[tt * 64 + c4] = lo16(bq.x); Zi[tt * 64 + c4 + 1] = hi16(bq.x); Zi[tt * 64 + c4 + 2] = lo16(bq.y); Zi[tt * 64 + c4 + 3] = hi16(bq.y); }
#pragma unroll
            for (int i = 0; i < 4; ++i) { const int e = tid * 4 + i, k = e >> 4, tt = e & 15; const int ang = (((k0 + k) * (t0 + tt)) & (Ts - 1)) * step;
                Ct[k * 17 + tt] = ct[ang]; St[k * 17 + tt] = ct[(ang - 1024) & 4095]; }
            __syncthreads();
#pragma unroll 2
            for (int tt = 0; tt < 16; ++tt) { float zr[4], zi[4];
#pragma unroll
                for (int j = 0; j < 4; ++j) { zr[j] = Zr[tt * 64 + tc * 4 + j]; zi[j] = Zi[tt * 64 + tc * 4 + j]; }
#pragma unroll
                for (int i = 0; i < 4; ++i) { const float c = Ct[(tk * 4 + i) * 17 + tt], sn = St[(tk * 4 + i) * 17 + tt];
#pragma unroll
                    for (int j = 0; j < 4; ++j) acc[i][j] += c * zr[j] + sn * zi[j]; } }
        }
        const float sc = 1.0f / sqrtf((float)Ts);
        bf16_t* BR = (bf16_t*)(P.ws + WS_BR);
#pragma unroll
        for (int i = 0; i < 4; ++i) { u32x2 w; w.x = pk2(acc[i][0] * sc, acc[i][1] * sc); w.y = pk2(acc[i][2] * sc, acc[i][3] * sc);
            *(u32x2*)(BR + (size_t)(rbase + k0 + tk * 4 + i) * NBR + ch0 + tc * 4) = w; }
        __syncthreads();
    }
}

typedef float f32x16 __attribute__((ext_vector_type(16)));
typedef short v4i16_t __attribute__((ext_vector_type(4)));
constexpr float ATT_THR = 4.0f;
constexpr int AT_ROWB = 144, AT_TILEB = 64 * AT_ROWB;
template <int MODE> __device__ __forceinline__ void ph_attn(const Frame& F, const Ptrs& P, int l) {
    const int lane = fresh_lane(), tid = F.wave * 64 + lane, r32 = lane & 31, hi = lane >> 5;
    const bf16_t* U = (const bf16_t*)(P.ws + WS_U);
    const bool latq = MODE < 2; const bool winm = (MODE == 1 || MODE == 3);
    const int NU = latq ? 1024 : 64;
    LAS unsigned char* Kb = F.lds; LAS unsigned char* Vb = F.lds + 2 * AT_TILEB;
    const int st_off = (tid >> 3) * AT_ROWB + (tid & 7) * 16;
    const int kf_off = r32 * AT_ROWB + hi * 16;
    const int vf_off = (4 * hi + ((lane & 15) >> 2)) * AT_ROWB + (((lane >> 4) & 1) * 16 + (lane & 3) * 4) * 2;
    for (int u = F.vcu; u < NU; u += F.G) {
        const int qb = latq ? (u & 63) : (u & 3), g = latq ? ((u >> 6) & 1) : ((u >> 2) & 1), b = latq ? (u >> 7) : (u >> 3);
        const int tq0 = qb * 64, hq = 4 * g + (F.wave >> 1), tq = tq0 + 32 * (F.wave & 1) + r32;
        const int qrow = latq ? b * T + tq : RL + b * TC + tq;
        const int qcol = (winm ? C_QW : C_QB) + hq * 64, kcol = (winm ? C_KW : C_KB) + g * 64, vcol = (winm ? C_VW : C_VB) + g * 64;
        int lt_lo = 0, lt_hi = 0;
        if (MODE == 0) { lt_lo = 0; lt_hi = T / 64; }
        if (MODE == 1) { lt_lo = (tq0 - 128 < 0 ? 0 : tq0 - 128) / 64; lt_hi = (tq0 + 192 > T ? T : tq0 + 192) / 64; }
        const int ntiles = 4 + (lt_hi - lt_lo);
        bf16x8 qr[4];
        {
            float x[4][8];
#pragma unroll
            for (int d0 = 0; d0 < 4; ++d0) { const u32x4 wq = *(const u32x4*)(U + (size_t)qrow * NIN + qcol + d0 * 16 + hi * 8);
                x[d0][0] = lo16(wq.x); x[d0][1] = hi16(wq.x); x[d0][2] = lo16(wq.y); x[d0][3] = hi16(wq.y); x[d0][4] = lo16(wq.z); x[d0][5] = hi16(wq.z); x[d0][6] = lo16(wq.w); x[d0][7] = hi16(wq.w); }
            if (!winm) { float ss = 0.f;
#pragma unroll
                for (int d0 = 0; d0 < 4; ++d0)
#pragma unroll
                    for (int j = 0; j < 8; ++j) ss += x[d0][j] * x[d0][j];
                ss += shfl_xor_l(ss, 32, lane);
                const float rstd = 1.0f / sqrtf(ss * (1.0f / 64.0f) + EPS);
#pragma unroll
                for (int d0 = 0; d0 < 4; ++d0) { const f32x4 ga = *(const f32x4*)(P.q_gain + l * 64 + d0 * 16 + hi * 8), gb = *(const f32x4*)(P.q_gain + l * 64 + d0 * 16 + hi * 8 + 4);
                    x[d0][0] *= rstd * ga.x; x[d0][1] *= rstd * ga.y; x[d0][2] *= rstd * ga.z; x[d0][3] *= rstd * ga.w; x[d0][4] *= rstd * gb.x; x[d0][5] *= rstd * gb.y; x[d0][6] *= rstd * gb.z; x[d0][7] *= rstd * gb.w; } }
            if (latq) { const float* rc = (const float*)(P.ws + WS_ROPE); const float* rs = rc + 1024;
#pragma unroll
                for (int a = 0; a < 2; ++a) { const int pos = a ? (tq & 63) : (tq >> 6);
                    const f32x4 c0 = *(const f32x4*)(rc + pos * 16 + hi * 8), c1 = *(const f32x4*)(rc + pos * 16 + hi * 8 + 4), s0 = *(const f32x4*)(rs + pos * 16 + hi * 8), s1 = *(const f32x4*)(rs + pos * 16 + hi * 8 + 4);
                    const float cs[8] = {c0.x, c0.y, c0.z, c0.w, c1.x, c1.y, c1.z, c1.w}, sn[8] = {s0.x, s0.y, s0.z, s0.w, s1.x, s1.y, s1.z, s1.w};
#pragma unroll
                    for (int j = 0; j < 8; ++j) { const float x1 = x[2 * a][j], x2 = x[2 * a + 1][j]; x[2 * a][j] = x1 * cs[j] - x2 * sn[j]; x[2 * a + 1][j] = x2 * cs[j] + x1 * sn[j]; } } }
#pragma unroll
            for (int d0 = 0; d0 < 4; ++d0) { u32x4 wq; wq.x = cvtpk(x[d0][0] * QSCALE, x[d0][1] * QSCALE); wq.y = cvtpk(x[d0][2] * QSCALE, x[d0][3] * QSCALE); wq.z = cvtpk(x[d0][4] * QSCALE, x[d0][5] * QSCALE); wq.w = cvtpk(x[d0][6] * QSCALE, x[d0][7] * QSCALE);
                qr[d0] = __builtin_bit_cast(bf16x8, wq); }
        }
        f32x16 o0, o1;
#pragma unroll
        for (int r = 0; r < 16; ++r) { o0[r] = 0.f; o1[r] = 0.f; }
        float mhat = 0.f, lsum = 0.f; f32x16 negm;
#pragma unroll
        for (int r = 0; r < 16; ++r) negm[r] = 0.f;
        { const size_t kr = (size_t)(RL + b * TC + (tid >> 3)) * NIN + (tid & 7) * 8;
          const u32x4 kw = *(const u32x4*)(U + kr + kcol), vw = *(const u32x4*)(U + kr + vcol);
          *(LAS u32x4*)(Kb + st_off) = kw; *(LAS u32x4*)(Vb + st_off) = vw; }
        __syncthreads();
        for (int ti = 0; ti < ntiles; ++ti) {
            const int cur = (ti & 1) * AT_TILEB, nxt = AT_TILEB - cur;
            const bool more = ti + 1 < ntiles;
            u32x4 kw, vw;
            if (more) { const int tn = ti + 1; const int krow0 = tn < 4 ? RL + b * TC + tn * 64 : b * T + (lt_lo + tn - 4) * 64;
                const size_t kr = (size_t)(krow0 + (tid >> 3)) * NIN + (tid & 7) * 8;
                kw = *(const u32x4*)(U + kr + kcol); vw = *(const u32x4*)(U + kr + vcol); }
            f32x16 p0, p1;
            {   const bf16x8 k0 = *(const LAS bf16x8*)(Kb + cur + kf_off);
                const bf16x8 k1 = *(const LAS bf16x8*)(Kb + cur + kf_off + 32 * AT_ROWB);
                p0 = __builtin_amdgcn_mfma_f32_32x32x16_bf16(k0, qr[0], negm, 0, 0, 0);
                p1 = __builtin_amdgcn_mfma_f32_32x32x16_bf16(k1, qr[0], negm, 0, 0, 0); }
#pragma unroll
            for (int d0 = 1; d0 < 4; ++d0) {
                const bf16x8 k0 = *(const LAS bf16x8*)(Kb + cur + kf_off + d0 * 32);
                const bf16x8 k1 = *(const LAS bf16x8*)(Kb + cur + kf_off + 32 * AT_ROWB + d0 * 32);
                p0 = __builtin_amdgcn_mfma_f32_32x32x16_bf16(k0, qr[d0], p0, 0, 0, 0);
                p1 = __builtin_amdgcn_mfma_f32_32x32x16_bf16(k1, qr[d0], p1, 0, 0, 0);
            }
            if (MODE == 1 && ti >= 4) {
                const int kb0 = (lt_lo + ti - 4) * 64, qlo = tq0 + 32 * (F.wave & 1);
                if (kb0 + 63 - qlo > 128 || qlo + 31 - kb0 > 128) {
                    const int kp0 = kb0 + 4 * hi - tq;
#pragma unroll
                    for (int r = 0; r < 16; ++r) { const int dl = kp0 + (r & 3) + 8 * (r >> 2);
                        if (dl > 128 || dl < -128) p0[r] = -INFINITY;
                        if (dl + 32 > 128 || dl + 32 < -128) p1[r] = -INFINITY; }
                }
            }
            float mx = fmaxf(fmaxf(p0[0], p1[0]), fmaxf(p0[1], p1[1]));
#pragma unroll
            for (int r = 2; r < 16; r += 2) mx = fmaxf(mx, fmaxf(fmaxf(p0[r], p1[r]), fmaxf(p0[r + 1], p1[r + 1])));
            mx = fmaxf(mx, shfl_xor_l(mx, 32, lane));
            if (ti == 0 || __any(mx > ATT_THR)) {
                const float dl = ti == 0 ? mx : fmaxf(mx, 0.f);
                mhat += dl;
                const float alpha = __builtin_amdgcn_exp2f(-dl); lsum *= alpha;
#pragma unroll
                for (int r = 0; r < 16; ++r) { p0[r] -= dl; p1[r] -= dl; o0[r] *= alpha; o1[r] *= alpha; negm[r] = -mhat; }
            }
            float rs = 0.f;
#pragma unroll
            for (int r = 0; r < 16; ++r) { p0[r] = __builtin_amdgcn_exp2f(p0[r]); p1[r] = __builtin_amdgcn_exp2f(p1[r]); rs += p0[r] + p1[r]; }
            lsum += rs;
#pragma unroll
            for (int kb = 0; kb < 2; ++kb)
#pragma unroll
                for (int sx = 0; sx < 2; ++sx) {
                    u32x4 pw;
                    if (kb == 0) { pw.x = cvtpk(p0[8 * sx], p0[8 * sx + 1]); pw.y = cvtpk(p0[8 * sx + 2], p0[8 * sx + 3]); pw.z = cvtpk(p0[8 * sx + 4], p0[8 * sx + 5]); pw.w = cvtpk(p0[8 * sx + 6], p0[8 * sx + 7]); }
                    else         { pw.x = cvtpk(p1[8 * sx], p1[8 * sx + 1]); pw.y = cvtpk(p1[8 * sx + 2], p1[8 * sx + 3]); pw.z = cvtpk(p1[8 * sx + 4], p1[8 * sx + 5]); pw.w = cvtpk(p1[8 * sx + 6], p1[8 * sx + 7]); }
                    const bf16x8 pf = __builtin_bit_cast(bf16x8, pw);
                    const LAS unsigned char* vp = Vb + cur + vf_off + (kb * 32 + 16 * sx) * AT_ROWB;
#pragma unroll
                    for (int db = 0; db < 2; ++db) {
                        const v4i16_t lo4 = __builtin_amdgcn_ds_read_tr16_b64_v4i16((LAS v4i16_t*)(vp + db * 64));
                        const v4i16_t hi4 = __builtin_amdgcn_ds_read_tr16_b64_v4i16((LAS v4i16_t*)(vp + 8 * AT_ROWB + db * 64));
                        const bf16x8 vf = (bf16x8){lo4[0], lo4[1], lo4[2], lo4[3], hi4[0], hi4[1], hi4[2], hi4[3]};
                        if (db == 0) o0 = __builtin_amdgcn_mfma_f32_32x32x16_bf16(vf, pf, o0, 0, 0, 0);
                        else         o1 = __builtin_amdgcn_mfma_f32_32x32x16_bf16(vf, pf, o1, 0, 0, 0);
                    }
                }
            if (more) { *(LAS u32x4*)(Kb + nxt + st_off) = kw; *(LAS u32x4*)(Vb + nxt + st_off) = vw; }
            __syncthreads();
        }
        lsum += shfl_xor_l(lsum, 32, lane);
        if (winm) lsum += exp2f(P.sink[l * 8 + hq] * LOG2E - mhat);
        const float inv = 1.0f / lsum;
        bf16_t* op = (bf16_t*)(P.ws + WS_BR) + (size_t)qrow * NBR + (winm ? 1024 : 512) + hq * 64 + 4 * hi;
#pragma unroll
        for (int gq = 0; gq < 4; ++gq) {
            u32x2 w0, w1; w0.x = cvtpk(o0[4 * gq] * inv, o0[4 * gq + 1] * inv); w0.y = cvtpk(o0[4 * gq + 2] * inv, o0[4 * gq + 3] * inv);
            w1.x = cvtpk(o1[4 * gq] * inv, o1[4 * gq + 1] * inv); w1.y = cvtpk(o1[4 * gq + 2] * inv, o1[4 * gq + 3] * inv);
            *(u32x2*)(op + 8 * gq) = w0; *(u32x2*)(op + 32 + 8 * gq) = w1; }
    }
}

constexpr int DF_ROWB = 528;
template <int STAGE> __device__ __forceinline__ void ph_dft(const Frame& F, const Ptrs& P) {
    const int lane = fresh_lane(), tid = F.wave * 64 + lane, r32 = lane & 31, hi = lane >> 5, w = F.wave;
    bf16_t* U = (bf16_t*)(P.ws + WS_U); bf16_t* BR = (bf16_t*)(P.ws + WS_BR); const bf16_t* Wm = (const bf16_t*)(P.ws + WS_DFTM);
    LAS unsigned char* Xl = F.lds;
    const int xf_off = (8 * hi + ((lane & 15) >> 2)) * DF_ROWB + (32 * w + ((lane >> 4) & 1) * 16 + (lane & 3) * 4) * 2;
    constexpr int NMB = STAGE == 2 ? 4 : 2;
    const int seg = tid >> 2, part = tid & 3, pp = seg >> 6, jj = seg & 63;
    u32x4 pf[8];
    if (F.vcu < 1024) { const int u = F.vcu; const int chb = u & 1, sidx = (u >> 1) & 63, b = u >> 7;
        const int grow = STAGE == 2 ? b * T + 64 * jj + sidx : b * T + 64 * sidx + jj;
        const u32x4* src = (const u32x4*)(U + (size_t)grow * NIN + pp * 512 + chb * 256 + part * 64);
#pragma unroll
        for (int i = 0; i < 8; ++i) pf[i] = src[i]; }
    for (int u = F.vcu; u < 1024; u += F.G) {
        const int chb = u & 1, sidx = (u >> 1) & 63, b = u >> 7;
#pragma unroll
        for (int i = 0; i < 8; ++i) *(LAS u32x4*)(Xl + seg * DF_ROWB + part * 128 + i * 16) = pf[i];
        if (u + F.G < 1024) { const int un = u + F.G; const int chbn = un & 1, sn = (un >> 1) & 63, bn = un >> 7;
            const int grow = STAGE == 2 ? bn * T + 64 * jj + sn : bn * T + 64 * sn + jj;
            const u32x4* src = (const u32x4*)(U + (size_t)grow * NIN + pp * 512 + chbn * 256 + part * 64);
#pragma unroll
            for (int i = 0; i < 8; ++i) pf[i] = src[i]; }
        __syncthreads();
        f32x16 acc[NMB];
#pragma unroll
        for (int mb = 0; mb < NMB; ++mb)
#pragma unroll
            for (int r = 0; r < 16; ++r) acc[mb][r] = 0.f;
#pragma unroll
        for (int ks = 0; ks < 8; ++ks) {
            const v4i16_t lo4 = __builtin_amdgcn_ds_read_tr16_b64_v4i16((LAS v4i16_t*)(Xl + xf_off + (16 * ks) * DF_ROWB));
            const v4i16_t hi4 = __builtin_amdgcn_ds_read_tr16_b64_v4i16((LAS v4i16_t*)(Xl + xf_off + (16 * ks + 4) * DF_ROWB));
            const bf16x8 xf = (bf16x8){lo4[0], lo4[1], lo4[2], lo4[3], hi4[0], hi4[1], hi4[2], hi4[3]};
#pragma unroll
            for (int mb = 0; mb < NMB; ++mb) { const bf16x8 wf = *(const bf16x8*)(Wm + (mb * 32 + r32) * 128 + 16 * ks + 8 * hi);
                acc[mb] = __builtin_amdgcn_mfma_f32_32x32x16_bf16(xf, wf, acc[mb], 0, 0, 0); }
        }
        LAS unsigned char* ob = Xl + (32 * w + 4 * hi) * 2;
        if (STAGE == 2) {
#pragma unroll
            for (int mb = 0; mb < 2; ++mb) { const int k1 = mb * 32 + r32; const float rev = (float)((k1 * sidx) & 4095) * (1.0f / 4096.0f);
                const float ct = __builtin_amdgcn_cosf(rev), st = __builtin_amdgcn_sinf(rev);
#pragma unroll
                for (int gq = 0; gq < 4; ++gq) { u32x2 wr, wi; float yr[4], yi[4];
#pragma unroll
                    for (int i = 0; i < 4; ++i) { const float a = acc[mb][4 * gq + i], bq = acc[mb + 2][4 * gq + i]; yr[i] = a * ct + bq * st; yi[i] = bq * ct - a * st; }
                    wr.x = cvtpk(yr[0], yr[1]); wr.y = cvtpk(yr[2], yr[3]); wi.x = cvtpk(yi[0], yi[1]); wi.y = cvtpk(yi[2], yi[3]);
                    *(LAS u32x2*)(ob + k1 * DF_ROWB + 16 * gq) = wr; *(LAS u32x2*)(ob + (64 + k1) * DF_ROWB + 16 * gq) = wi; } }
        } else {
#pragma unroll
            for (int mb = 0; mb < 2; ++mb) { const int k2 = mb * 32 + r32;
#pragma unroll
                for (int gq = 0; gq < 4; ++gq) { u32x2 wr; wr.x = cvtpk(acc[mb][4 * gq] * 0.015625f, acc[mb][4 * gq + 1] * 0.015625f); wr.y = cvtpk(acc[mb][4 * gq + 2] * 0.015625f, acc[mb][4 * gq + 3] * 0.015625f);
                    *(LAS u32x2*)(ob + k2 * DF_ROWB + 16 * gq) = wr; } }
        }
        __syncthreads();
        if (STAGE == 2) {
            u32x4* dst = (u32x4*)(U + (size_t)(b * T + 64 * jj + sidx) * NIN + pp * 512 + chb * 256 + part * 64);
#pragma unroll
            for (int i = 0; i < 8; ++i) dst[i] = *(const LAS u32x4*)(Xl + seg * DF_ROWB + part * 128 + i * 16);
        } else { const int k2 = tid >> 3, part8 = tid & 7;
            u32x4* dst = (u32x4*)(BR + (size_t)(b * T + 64 * k2 + sidx) * NBR + chb * 256 + part8 * 32);
#pragma unroll
            for (int i = 0; i < 4; ++i) dst[i] = *(const LAS u32x4*)(Xl + k2 * DF_ROWB + part8 * 64 + i * 16); }
        __syncthreads();
    }
}

struct MegaArgs { Ptrs P; int ph_lo, ph_hi, li, pad; };
__global__ void __launch_bounds__(NWAVES * 64, 2) mega(MegaArgs args) {
    extern __shared__ __attribute__((aligned(16))) unsigned char lds_raw[];
    Frame F; F.lds = (LAS unsigned char*)lds_raw;
    F.wave = __builtin_amdgcn_readfirstlane(threadIdx.x >> 6);
    F.G = gridDim.x; { const int bx = blockIdx.x; F.vcu = (F.G % 8 == 0) ? (bx % 8) * (F.G / 8) + bx / 8 : bx; }
    const Ptrs& P = args.P;
    for (int u = fresh_tid(); u < (LDS_BYTES - LDSCTL_OFF) / 4; u += NWAVES * 64) ((LAS unsigned*)(F.lds + LDSCTL_OFF))[u] = 0u;
    __syncthreads();
    volatile LAS unsigned* MISC = (volatile LAS unsigned*)(F.lds + MISC_OFF);
    XcdBarrier bar = xcd_barrier_post((unsigned*)(P.ws + WS_CTL) + CW_BAR + args.li * XCD_BAR_WORDS, MISC + 8, F.wave);
    const int lo = args.ph_lo, hi = args.ph_hi;
    unsigned char* ws = P.ws;
    bf16_t* H = (bf16_t*)(ws + WS_H); bf16_t* U = (bf16_t*)(ws + WS_U); bf16_t* BR = (bf16_t*)(ws + WS_BR);
    bf16_t* MG = (bf16_t*)(ws + WS_MG); bf16_t* AS = (bf16_t*)(ws + WS_AS); bf16_t* HID = (bf16_t*)(ws + WS_HID); bf16_t* MO = (bf16_t*)(ws + WS_MO);
    const bf16_t* Bt_in = (const bf16_t*)(ws + WS_WB + WB_IN); const bf16_t* Bt_gate = (const bf16_t*)(ws + WS_WB + WB_GATE); const bf16_t* Bt_br = (const bf16_t*)(ws + WS_WB + WB_BR);
    const bf16_t* Bt_out = (const bf16_t*)(ws + WS_WB + WB_OUT); const bf16_t* Bt_13 = (const bf16_t*)(ws + WS_WB + WB_13); const bf16_t* Bt_2 = (const bf16_t*)(ws + WS_WB + WB_2);
#define IN(g) (lo <= (g) && (g) < hi)
#define SEAM(g) do { if ((g) + 1 < hi) xcd_barrier(bar); } while (0)
    for (int l = 0; l < 2; ++l) {
        const int pb = l * NPH; const int M = l == 0 ? R : RL;
        if (IN(pb + 0)) { if (l == 0) ph_tables_mod(F, P); ph_weights(F, P, l); SEAM(pb + 0); }
        if (IN(pb + 1)) { if (l == 0) ph_norm<0>(F, P, l, R); else ph_norm<1>(F, P, l, R); SEAM(pb + 1); }
        if (IN(pb + 2)) {
            pg8::StaticOrder S; S.init(R, NIN, F.G, (int)blockIdx.x, H, D, Bt_in, D);
            pg8::EpiV8<FStore8> E{FStore8{U, NIN}};
            pg8::gemm_phase(F.lds, F.wave, D, D, D, S, E);
            SEAM(pb + 2);
        }
        if (IN(pb + 3)) { ph_kprep(F, P, l); ph_pool(F, P, M); SEAM(pb + 3); }
        if (IN(pb + 4)) {
            ph_dft<2>(F, P); ph_attn<1>(F, P, l);
            if (l == 0) { ph_attn<2>(F, P, l); ph_attn<3>(F, P, l); ph_fourier_ref(F, P, TC, 0); }
            xcd_barrier(bar);
            ph_dft<3>(F, P); ph_attn<0>(F, P, l);
            SEAM(pb + 4);
        }
        if (IN(pb + 5)) {
            pg8::StaticOrder S; S.init(M, 4096, F.G, (int)blockIdx.x, H, D, Bt_gate, D);
            pg8::EpiV8<FGateU8> E{FGateU8{(unsigned char*)(ws + WS_GT), P.b_gate + (size_t)l * 4096}};
            pg8::gemm_phase(F.lds, F.wave, D, D, D, S, E);
            SEAM(pb + 5);
        }
        if (IN(pb + 6)) {
            pg8::StaticOrder S; S.init(M, D, F.G, (int)blockIdx.x, BR, NBR, Bt_br, NBR);
            pg8::EpiMergeS E{(const unsigned char*)(ws + WS_GT), MG};
            pg8::gemm_phase(F.lds, F.wave, NBR, NBR, NBR, S, E);
            xcd_barrier(bar);
        }
        if (IN(pb + 10)) {
            pg8::StaticOrder S; S.init(M, D, F.G, (int)blockIdx.x, MG, D, Bt_out, D);
            pg8::EpiV4<FOut> E{FOut{P, l}};
            pg8::gemm_phase(F.lds, F.wave, D, D, D, S, E);
            SEAM(pb + 10);
        }
        if (IN(pb + 11)) { ph_norm<2>(F, P, l, M); xcd_barrier(bar); }
        if (IN(pb + 13) || IN(pb + 14)) {
            LAS int* ptab = (LAS int*)(F.lds + LDSCTL_OFF);
            if (fresh_tid() == 0) { const unsigned* cnt = (const unsigned*)(ws + WS_CTL) + CW_CNT + 1024 * l; int off = 0;
                for (int e = 0; e < 16; ++e) { const int c = (int)cnt[64 * e]; ptab[e] = off; ptab[17 + e] = c; off += (c + 255) >> 8; } ptab[16] = off; }
            __syncthreads();
            if (IN(pb + 13)) {
                pg8::MoeOrder<true> S; S.nN = 4; S.G = F.G; S.c = (int)blockIdx.x; S.A = (const char*)H; S.Bt = (const char*)Bt_13; S.astep = 0; S.bstep = (size_t)256 * D * 2; S.bexp = (size_t)1024 * 1024 * 2; S.tab = (const int*)ptab; S.tokl = (const int*)(ws + WS_TOKL);
                pg8::EpiDual<FMoe1> E{FMoe1{HID}};
                pg8::gemm_phase(F.lds, F.wave, D, D, D, S, E);
                SEAM(pb + 13);
            }
            if (IN(pb + 14)) {
                pg8::MoeOrder<false> S; S.nN = 4; S.G = F.G; S.c = (int)blockIdx.x; S.A = (const char*)HID; S.Bt = (const char*)Bt_2; S.astep = (size_t)256 * FF * 2; S.bstep = (size_t)256 * FF * 2; S.bexp = (size_t)1024 * 512 * 2; S.tab = (const int*)ptab; S.tokl = nullptr;
                pg8::EpiV8<FMoe2> E{FMoe2{MO, (const int*)(ws + WS_TOKL), (const float*)(ws + WS_WL)}};
                pg8::gemm_phase(F.lds, F.wave, FF, FF, FF, S, E);
                SEAM(pb + 14);
            }
        }
    }
    if (IN(PH_FINAL)) ph_final(F, P);
#undef IN
#undef SEAM
}

extern "C" void kernel_launch(void* const* d_in, const int* in_sizes, int n_in, void* d_out, int out_size, void* d_ws, size_t ws_size, hipStream_t stream) {
    if (n_in != 24 || ws_size < WS_END || out_size != RL * D) { fprintf(stderr, "kernel_launch: unexpected sizes n_in %d ws %zu out %d\n", n_in, ws_size, out_size); return; }
    static int grid = 0;
    if (grid == 0) {
        int dev = 0, cus = 0;
        if (hipGetDevice(&dev) != hipSuccess || hipDeviceGetAttribute(&cus, hipDeviceAttributeMultiprocessorCount, dev) != hipSuccess) { grid = -1; return; }
        if (hipFuncSetAttribute((const void*)mega, hipFuncAttributeMaxDynamicSharedMemorySize, LDS_BYTES) != hipSuccess) { fprintf(stderr, "kernel_launch: hipFuncSetAttribute failed\n"); grid = -1; return; }
        int per_cu = 0;
        if (hipOccupancyMaxActiveBlocksPerMultiprocessor(&per_cu, (const void*)mega, NWAVES * 64, LDS_BYTES) != hipSuccess || per_cu < 1) fprintf(stderr, "kernel_launch: occupancy query says %d\n", per_cu);
        (void)hipGetLastError();
        grid = cus;
    }
    if (grid < 0) return;
    MegaArgs a{};
    const float** pp = (const float**)&a.P;
    for (int i = 0; i < 24; ++i) pp[i] = (const float*)d_in[i];
    a.P.out = (float*)d_out; a.P.ws = (unsigned char*)d_ws;
    (void)hipMemsetAsync((unsigned char*)d_ws + WS_CTL, 0, 1 * MiB, stream);
    a.ph_lo = 0; a.ph_hi = PH_FINAL + 1; a.li = 0;
    hipLaunchKernelGGL(mega, dim3(grid), dim3(NWAVES * 64), LDS_BYTES, stream, a);
}
```

```cpp
#include <hip/hip_runtime.h>
#include <cstdio>
#include <cstdint>

typedef unsigned short bf16_t;
typedef short bf16x8 __attribute__((ext_vector_type(8)));
typedef float f32x4 __attribute__((ext_vector_type(4)));
typedef unsigned u32x4 __attribute__((ext_vector_type(4)));
typedef unsigned u32x2 __attribute__((ext_vector_type(2)));

constexpr int D = 1024, NB = 8, T = 4096, TC = 256;
constexpr int RL = NB * T, RC = NB * TC, R = RL + RC;
constexpr int NIN = 3072;
constexpr int C_ZR = 0, C_ZI = 512, C_P = 1024, C_QB = 1536, C_KB = 2048, C_VB = 2176, C_QW = 2304, C_KW = 2816, C_VW = 2944;
constexpr int NBR = 2048;
constexpr int NE = 16, FF = 512;
constexpr int MAXROWS = 73728;
constexpr float EPS = 1e-6f;
constexpr float QSCALE = 0.125f * 1.4426950408889634f;
constexpr float LOG2E = 1.4426950408889634f;

constexpr size_t MiB = 1u << 20;
constexpr size_t WS_CTL = 0;
constexpr size_t WS_MOD = 1 * MiB;
constexpr size_t WS_ROPE = 1 * MiB + 512 * 1024;
constexpr size_t WS_COS = WS_ROPE + 16 * 1024;
constexpr size_t WS_DFTM = WS_ROPE + 64 * 1024;
constexpr size_t WS_TOKL = 2 * MiB;
constexpr size_t WS_WL = 4 * MiB + 512 * 1024;
constexpr size_t WS_XC = 9 * MiB;
constexpr size_t WS_WB = 17 * MiB;
constexpr size_t WB_IN = 0, WB_GATE = 6 * MiB, WB_BR = 14 * MiB, WB_OUT = 18 * MiB, WB_13 = 20 * MiB, WB_2 = 52 * MiB;
constexpr size_t WS_H = 85 * MiB;
constexpr size_t WS_ARENA = 153 * MiB;
constexpr size_t WS_U = WS_ARENA;
constexpr size_t WS_BR = WS_ARENA + 204 * MiB;
constexpr size_t WS_GT = WS_ARENA;
constexpr size_t WS_MG = WS_ARENA + 136 * MiB;
constexpr size_t WS_AS = WS_ARENA;
constexpr size_t WS_HID = WS_ARENA + 144 * MiB;
constexpr size_t WS_MO = WS_ARENA + 216 * MiB;
constexpr size_t WS_END = 512 * MiB;
static_assert(WS_BR + (size_t)R * NBR * 2 <= WS_END && WS_MO + (size_t)2 * R * D * 2 <= WS_END && WS_MG + (size_t)R * D * 2 <= WS_BR, "ws map");
constexpr int CW_CNT = 8192;

__device__ __forceinline__ float bf2f(bf16_t b) { return __uint_as_float(((unsigned)b) << 16); }
__device__ __forceinline__ unsigned f2bf(float f) { unsigned u = __float_as_uint(f); return (u + 0x7fffu + ((u >> 16) & 1u)) >> 16; }
__device__ __forceinline__ unsigned pk2(float lo, float hi) { return f2bf(lo) | (f2bf(hi) << 16); }
typedef __bf16 bf16x2_t __attribute__((ext_vector_type(2)));
typedef float f32x2_t __attribute__((ext_vector_type(2)));
__device__ __forceinline__ unsigned cvtpk(float lo, float hi) { f32x2_t v = {lo, hi}; bf16x2_t b = __builtin_convertvector(v, bf16x2_t); return __builtin_bit_cast(unsigned, b); }
__device__ __forceinline__ float lo16(unsigned w) { return __uint_as_float(w << 16); }
__device__ __forceinline__ float hi16(unsigned w) { return __uint_as_float(w & 0xffff0000u); }
__device__ __forceinline__ float shfl_xor_l(float v, int o, int lane) { return __int_as_float(__builtin_amdgcn_ds_bpermute((lane ^ o) << 2, __float_as_int(v))); }
__device__ __forceinline__ float wave_sum_l(float v, int lane) {
#pragma unroll
    for (int o = 1; o < 64; o <<= 1) v += shfl_xor_l(v, o, lane);
    return v;
}
__device__ __forceinline__ int row_bb(int r) { return r < RL ? (r >> 12) : 8; }

struct Ptrs {
    const float *x, *c, *ctx, *c_ctx, *w_ada, *b_ada, *norm1, *norm2, *w_in, *q_gain, *k_gain, *sink, *pool_w, *pool_scale,
        *w_branch, *w_gate, *b_gate, *w_out, *router_w, *router_bias, *w1, *w3, *w2, *norm_f;
    float* out; unsigned char* ws;
};
__device__ __forceinline__ const float* xin_row(const Ptrs& P, int r) { return r < RL ? P.x + (size_t)r * D : P.ctx + (size_t)(r - RL) * D; }
__device__ __forceinline__ float* x1_row(const Ptrs& P, int r) { return r < RL ? P.out + (size_t)r * D : (float*)(P.ws + WS_XC) + (size_t)(r - RL) * D; }
__device__ __forceinline__ const float* mod_vec(const Ptrs& P, int l, int bb, int which) { return (const float*)(P.ws + WS_MOD) + ((size_t)(l * 9 + bb) * 6 + which) * D; }

struct EpiOut { Ptrs P; int l;
    __device__ __forceinline__ void operator()(int row, int col, f32x4 v) const { const int bb = row_bb(row);
        const f32x4 g = *(const f32x4*)(mod_vec(P, l, bb, 2) + col); float* xo = x1_row(P, row) + col;
        const f32x4 xp = l == 0 ? *(const f32x4*)(xin_row(P, row) + col) : *(const f32x4*)xo;
        *(f32x4*)xo = xp + g * v; } };

#define LAS __attribute__((address_space(3)))
#define GAS __attribute__((address_space(1)))
#define LDS_WAIT() asm volatile("s_waitcnt lgkmcnt(0)" ::: "memory")
__device__ __forceinline__ int fresh_lane() { int l; asm volatile("v_mbcnt_lo_u32_b32 %0, -1, 0\n\tv_mbcnt_hi_u32_b32 %0, -1, %0" : "=v"(l)); return l; }
constexpr int NWAVES = 8;
constexpr int RING_BYTES = 131072, LDSCTL_OFF = RING_BYTES, MISC_OFF = LDSCTL_OFF + 320, LDS_BYTES = 147456;
constexpr int CW_BAR = 16384;
constexpr int NPH = 15, PH_FINAL = 2 * NPH;

#define XB_TMO      128
#define XB_XCNT(j)  (256  + 64 * (j))
#define XB_XSUB(j)  (1280 + 64 * (j))
#define XB_XGEN(j)  (2304 + 64 * (j))
#define XB_TOP      3328
#define XB_TOPGEN   3392
#define XCD_BAR_WORDS 3456
#define XB_SPIN_CAP (1u << 21)
__device__ __forceinline__ unsigned xb_ld(unsigned* p)              { return __hip_atomic_load(p, __ATOMIC_RELAXED, __HIP_MEMORY_SCOPE_AGENT); }
__device__ __forceinline__ unsigned xb_add(unsigned* p, unsigned v) { return __hip_atomic_fetch_add(p, v, __ATOMIC_RELAXED, __HIP_MEMORY_SCOPE_AGENT); }
__device__ __forceinline__ unsigned xb_xcc_id() { return (unsigned)__builtin_amdgcn_s_getreg((3 << 11) | 20) & 0xFu; }
#define XB_SPIN(cond, bar) do { unsigned _sp = 0; while (cond) { __builtin_amdgcn_s_sleep(1); \
    if ((++_sp & 255u) == 0u) { if (xb_ld(&(bar)[XB_TMO])) break; if (_sp > XB_SPIN_CAP) { atomicAdd(&(bar)[XB_TMO], 1u); break; } } } } while (0)
struct XcdBarrier { unsigned* bar; unsigned x; volatile LAS unsigned* st; int wave; };
__device__ __forceinline__ XcdBarrier xcd_barrier_post(unsigned* bar, volatile LAS unsigned* st, int wave) {
    XcdBarrier b; b.bar = bar; b.x = xb_xcc_id(); b.st = st; b.wave = wave;
    if (wave == 0 && fresh_lane() == 0) (void)xb_add(&bar[XB_XCNT(b.x)], 1u);
    return b;
}
__device__ __forceinline__ void xcd_barrier_complete(unsigned* bar, unsigned x, unsigned& nloc, unsigned& nx) {
    const unsigned G = gridDim.x * gridDim.y * gridDim.z;
    unsigned sum, cnt, mine, sp = 0u;
    for (;;) {
        sum = 0u; cnt = 0u; mine = 0u;
#pragma unroll
        for (unsigned j = 0; j < 16; ++j) { const unsigned c = xb_ld(&bar[XB_XCNT(j)]); sum += c; cnt += (c > 0u) ? 1u : 0u; mine = (j == x) ? c : mine; }
        if (sum == G) break;
        __builtin_amdgcn_s_sleep(1);
        if ((++sp & 255u) == 0u) { if (xb_ld(&bar[XB_TMO])) break; if (sp > XB_SPIN_CAP) { atomicAdd(&bar[XB_TMO], 1u); break; } }
    }
    nloc = mine > 0u ? mine : 1u; nx = cnt > 0u ? cnt : 1u;
}
__device__ __forceinline__ void xcd_barrier(const XcdBarrier& b) {
    asm volatile("s_waitcnt vmcnt(0)" ::: "memory");
    __syncthreads();
    if (b.wave == 0 && fresh_lane() == 0) {
        unsigned* bar = b.bar;
        __builtin_amdgcn_s_waitcnt(0);
        unsigned nloc = b.st[0], nx = b.st[1];
        if (nloc == 0u) { xcd_barrier_complete(bar, b.x, nloc, nx); b.st[0] = nloc; b.st[1] = nx; }
        const unsigned old = xb_add(&bar[XB_XSUB(b.x)], 1u);
        const unsigned gen = old / nloc;
        if (old + 1u == (gen + 1u) * nloc) {
            __builtin_amdgcn_fence(__ATOMIC_RELEASE, "agent");
            asm volatile("s_waitcnt vmcnt(0)" ::: "memory");
            const unsigned og = xb_add(&bar[XB_TOP], 1u);
            const unsigned tg = og / nx;
            if (og + 1u == (tg + 1u) * nx) xb_add(&bar[XB_TOPGEN], 1u);
            else XB_SPIN(xb_ld(&bar[XB_TOPGEN]) == tg, bar);
            __builtin_amdgcn_fence(__ATOMIC_ACQUIRE, "agent");
            xb_add(&bar[XB_XGEN(b.x)], 1u);
            asm volatile("s_waitcnt vmcnt(0)" ::: "memory");
        } else {
            XB_SPIN(xb_ld(&bar[XB_XGEN(b.x)]) == gen, bar);
            __builtin_amdgcn_fence(__ATOMIC_ACQUIRE, "agent");
            asm volatile("s_waitcnt vmcnt(0)" ::: "memory");
        }
    }
    __syncthreads();
}

namespace pg8 {
constexpr int BM = 256, BK = 64, HALF = 128, HTB = HALF * BK * 2, STAGE_BYTES = 8 * HTB, NXCD = 8, WGM = 8;
__host__ __device__ __forceinline__ int lds_byte(int r, int c) { const int st = (r >> 4) * 2 + (c >> 5), rr = r & 15, cc = c & 31, ob = rr * 64 + cc * 2; return st * 1024 + (ob ^ (((ob >> 9) & 1) << 5)); }
__host__ __device__ __forceinline__ void stage_rc(int b, int& Rr, int& C) { const int st = b / 1024, sb = b % 1024, swz = sb ^ (((sb >> 9) & 1) << 5); Rr = (st >> 1) * 16 + swz / 64; C = (st & 1) * 32 + (swz % 64) / 2; }
__host__ __device__ __forceinline__ int perm32(int rho) { const int n = rho >> 4, i = rho & 15; return 8 * (i >> 2) + 4 * n + (i & 3); }
struct Unit { int pm, pn; const char* a; const char* b; int e, p0, ce; };

struct StaticOrder {
    static constexpr bool GATHER = false;
    int nM, nN, nwg, G, c; const char* A; const char* Bt; size_t astep, bstep;
    __device__ void init(int M, int N, int G_, int c_, const bf16_t* A_, int lda, const bf16_t* Bt_, int ldb) { nM = M / BM; nN = N / BM; nwg = nM * nN; G = G_; c = c_; A = (const char*)A_; Bt = (const char*)Bt_; astep = (size_t)BM * lda * 2; bstep = (size_t)BM * ldb * 2; }
    __device__ bool next(int i, Unit& u) const {
        const long L = (long)i * G + c; if (L >= nwg) return false;
        int wgid = (int)L; { const int q = nwg / NXCD, r = nwg % NXCD, xcd = wgid % NXCD, off = wgid / NXCD; wgid = (xcd < r ? xcd * (q + 1) : r * (q + 1) + (xcd - r) * q) + off; }
        const int nig = WGM * nN, gid = wgid / nig, fm = gid * WGM, gsz = (nM - fm) < WGM ? (nM - fm) : WGM;
        u.pm = fm + ((wgid % nig) % gsz); u.pn = (wgid % nig) / gsz; u.a = A + (size_t)u.pm * astep; u.b = Bt + (size_t)u.pn * bstep; u.e = 0; u.p0 = 0; u.ce = 0; return true;
    }
};
template <bool GATHER_> struct MoeOrder {
    static constexpr bool GATHER = GATHER_;
    int nN, G, c; const char* A; const char* Bt; size_t astep, bstep, bexp; const int* tab; const int* tokl;
    __device__ bool next(int i, Unit& u) const {
        const int L = i * G + c; const int total = tab[16] * nN; if (L >= total) return false;
        u.pm = L / nN; u.pn = L % nN; int e = 0;
#pragma unroll
        for (int q = 1; q < 16; ++q) e += (u.pm >= tab[q]) ? 1 : 0;
        u.e = e; u.p0 = (u.pm - tab[e]) * BM; u.ce = tab[17 + e];
        u.a = GATHER_ ? A : A + (size_t)u.pm * astep; u.b = Bt + (size_t)e * bexp + (size_t)u.pn * bstep; return true;
    }
    __device__ __forceinline__ void aoffs(const Unit& u, const int (&Rr)[2], const int (&Cc)[2], int lda, unsigned (&off)[2][2]) const {
#pragma unroll
        for (int h = 0; h < 2; ++h)
#pragma unroll
            for (int i = 0; i < 2; ++i) { const int pos = u.p0 + h * HALF + Rr[i]; const int tok = pos < u.ce ? (tokl[(size_t)u.e * R + pos] >> 1) : 0; off[h][i] = (unsigned)(tok * lda + Cc[i]) * 2u; }
    }
};

template <class Epi, class Sched, bool ALIGN_EPI = true>
__device__ __forceinline__ void gemm_phase(LAS unsigned char* lds, const int wid, const int lda, const int ldb, const int K, const Sched& S, const Epi& E) {
    const int lane = fresh_lane(), tid = wid * 64 + lane, wr = wid >> 2, wc = wid & 3, fr = lane & 15, fq = lane >> 4;
    const int nt = K / BK;
    unsigned voffA[2], voffB[2]; int Rr2[2], Cc2[2];
#pragma unroll
    for (int i = 0; i < 2; ++i) { int Rr, C; stage_rc(tid * 16 + i * 8192, Rr, C); const int Rb = Epi::PERM ? ((Rr & ~31) + perm32(Rr & 31)) : Rr; Rr2[i] = Rr; Cc2[i] = C;
        voffA[i] = (unsigned)(Rr * lda + C) * 2u; voffB[i] = (unsigned)(Rb * ldb + C) * 2u; }
    const size_t kstep = (size_t)(BK * 2);
    const size_t hstepA = Sched::GATHER ? 0 : (size_t)HALF * lda * 2, hstepB = (size_t)HALF * ldb * 2;
    const unsigned ldsw = (unsigned)wid * 1024u;
    const int aoff = lds_byte(wr * 64 + fr, fq * 8), boff = lds_byte(wc * 32 + fr, fq * 8);
#define PG8_SA(b, h) (((b) * 2 + (h)) * HTB)
#define PG8_SB(b, h) ((4 + (b) * 2 + (h)) * HTB)
#define PG8_STAGE(bufoff, gbase, voff) do { _Pragma("unroll") for (int _i = 0; _i < 2; ++_i) \
        __builtin_amdgcn_global_load_lds((const unsigned*)((const char*)(gbase) + (voff)[_i]), (LAS unsigned*)(lds + (bufoff) + ldsw + _i * 8192), 16, 0, 0); } while (0)
#define PG8_STAGE_A(b, h, kp, OFFS) do { if constexpr (Sched::GATHER) { PG8_STAGE(PG8_SA(b, h), kp, OFFS[h]); } else { PG8_STAGE(PG8_SA(b, h), (kp) + (h) * hstepA, voffA); } } while (0)
#define PG8_LDA(dst, b, h) do { _Pragma("unroll") for (int m = 0; m < 4; ++m) _Pragma("unroll") for (int k = 0; k < 2; ++k) dst[m][k] = *(const LAS bf16x8*)(lds + PG8_SA(b, h) + aoff + m * 2048 + k * 1024); } while (0)
#define PG8_LDB(dst, b, h) do { _Pragma("unroll") for (int n = 0; n < 2; ++n) _Pragma("unroll") for (int k = 0; k < 2; ++k) dst[n][k] = *(const LAS bf16x8*)(lds + PG8_SB(b, h) + boff + n * 2048 + k * 1024); } while (0)
#define PG8_MMA(ai, bj, At, Bt) do { __builtin_amdgcn_s_setprio(1); _Pragma("unroll") for (int m = 0; m < 4; ++m) _Pragma("unroll") for (int n = 0; n < 2; ++n) _Pragma("unroll") for (int k = 0; k < 2; ++k) \
        acc[ai][bj][m][n] = __builtin_amdgcn_mfma_f32_16x16x32_bf16(Bt[n][k], At[m][k], acc[ai][bj][m][n], 0, 0, 0); __builtin_amdgcn_s_setprio(0); } while (0)
#define PG8_WAIT_V(n) asm volatile("s_waitcnt vmcnt(" #n ")" ::: "memory")
#define PG8_WAIT_L(n) asm volatile("s_waitcnt lgkmcnt(" #n ")" ::: "memory")
#define PG8_BAR __builtin_amdgcn_s_barrier()
#define PG8_SCHED __builtin_amdgcn_sched_barrier(0)
    Unit cur, nxt; int ui = 0;
    if (!S.next(0, cur)) return;
    f32x4 acc[2][2][4][2];
#pragma unroll
    for (int a = 0; a < 2; ++a)
#pragma unroll
        for (int b = 0; b < 2; ++b)
#pragma unroll
            for (int m = 0; m < 4; ++m)
#pragma unroll
                for (int n = 0; n < 2; ++n) acc[a][b][m][n] = (f32x4){0.f, 0.f, 0.f, 0.f};
    bf16x8 At[4][2], B0[2][2], B1[2][2];
    unsigned goffC[2][2], goffN[2][2];
    if constexpr (Sched::GATHER) { S.aoffs(cur, Rr2, Cc2, lda, goffC);
#pragma unroll
        for (int h = 0; h < 2; ++h)
#pragma unroll
            for (int i = 0; i < 2; ++i) goffN[h][i] = goffC[h][i]; }
    const char* cA = cur.a; const char* cB = cur.b;
    PG8_STAGE(PG8_SB(0, 0), cB, voffB); PG8_STAGE(PG8_SB(0, 1), cB + hstepB, voffB); PG8_STAGE_A(0, 0, cA, goffC); PG8_STAGE_A(0, 1, cA, goffC);
    if (wr == 1) PG8_BAR;
    PG8_WAIT_V(2); PG8_BAR;
    PG8_STAGE(PG8_SB(1, 0), cB + kstep, voffB); PG8_STAGE_A(1, 0, cA + kstep, goffC); PG8_STAGE(PG8_SB(1, 1), cB + hstepB + kstep, voffB);
    PG8_WAIT_V(6); PG8_BAR;
    for (;;) {
        const bool has_next = S.next(ui + 1, nxt);
        if constexpr (Sched::GATHER) { if (has_next) S.aoffs(nxt, Rr2, Cc2, lda, goffN); }
        const char* nA = has_next ? nxt.a : cA; const char* nB = has_next ? nxt.b : cB;
        for (int t = 0; t < nt; t += 2) {
            const bool last = (t == nt - 2);
            const char* a1 = cA + (size_t)(t + 1) * kstep;
            const char* a2 = last ? nA : cA + (size_t)(t + 2) * kstep; const char* b2 = last ? nB : cB + (size_t)(t + 2) * kstep;
            const char* a3 = a2 + kstep; const char* b3 = b2 + kstep;
            unsigned gx[2][2];
            if constexpr (Sched::GATHER) {
#pragma unroll
                for (int h = 0; h < 2; ++h)
#pragma unroll
                    for (int i = 0; i < 2; ++i) gx[h][i] = (last && has_next) ? goffN[h][i] : goffC[h][i]; }
            PG8_LDB(B0, 0, 0); PG8_LDB(B1, 0, 1); PG8_SCHED; PG8_LDA(At, 0, 0); PG8_STAGE_A(1, 1, a1, goffC);
            PG8_WAIT_V(8); PG8_WAIT_L(0); PG8_BAR; PG8_MMA(0, 0, At, B0); PG8_MMA(0, 1, At, B1); PG8_BAR; PG8_SCHED;
            PG8_LDA(At, 0, 1); PG8_STAGE(PG8_SB(0, 0), b2, voffB); PG8_STAGE(PG8_SB(0, 1), b2 + hstepB, voffB); PG8_STAGE_A(0, 0, a2, gx);
            PG8_WAIT_V(8); PG8_WAIT_L(0); PG8_BAR; PG8_MMA(1, 0, At, B0); PG8_MMA(1, 1, At, B1); PG8_BAR; PG8_SCHED;
            PG8_LDB(B0, 1, 0); PG8_LDB(B1, 1, 1); PG8_SCHED; PG8_LDA(At, 1, 0); PG8_STAGE_A(0, 1, a2, gx);
            PG8_WAIT_V(8); PG8_WAIT_L(0); PG8_BAR; PG8_MMA(0, 0, At, B0); PG8_MMA(0, 1, At, B1); PG8_BAR; PG8_SCHED;
            PG8_LDA(At, 1, 1); PG8_STAGE(PG8_SB(1, 0), b3, voffB); PG8_STAGE(PG8_SB(1, 1), b3 + hstepB, voffB); PG8_STAGE_A(1, 0, a3, gx);
            PG8_WAIT_V(8); PG8_WAIT_L(0); PG8_BAR; PG8_MMA(1, 0, At, B0); PG8_MMA(1, 1, At, B1); PG8_BAR; PG8_SCHED;
            if constexpr (Epi::MID) { if (((t + 2) & (Epi::MID_EVERY - 1)) == 0 && !last) E.mid(acc, cur, wr, wc, (t + 2) / Epi::MID_EVERY - 1); }
        }
        if constexpr (ALIGN_EPI) { if (wr == 0) PG8_BAR; }
        E(acc, cur, wr, wc, fr, fq);
        if (!has_next) break;
#pragma unroll
        for (int a = 0; a < 2; ++a)
#pragma unroll
            for (int b = 0; b < 2; ++b)
#pragma unroll
                for (int m = 0; m < 4; ++m)
#pragma unroll
                    for (int n = 0; n < 2; ++n) acc[a][b][m][n] = (f32x4){0.f, 0.f, 0.f, 0.f};
        cur = nxt; cA = nA; cB = nB; ++ui;
        if constexpr (Sched::GATHER) {
#pragma unroll
            for (int h = 0; h < 2; ++h)
#pragma unroll
                for (int i = 0; i < 2; ++i) goffC[h][i] = goffN[h][i]; }
        if constexpr (ALIGN_EPI) { if (wr == 1) PG8_BAR; }
    }
    PG8_WAIT_V(0);
    if constexpr (!ALIGN_EPI) { if (wr == 0) PG8_BAR; }
    PG8_BAR;
#undef PG8_SA
#undef PG8_SB
#undef PG8_STAGE
#undef PG8_STAGE_A
#undef PG8_LDA
#undef PG8_LDB
#undef PG8_MMA
#undef PG8_WAIT_V
#undef PG8_WAIT_L
#undef PG8_BAR
#undef PG8_SCHED
}
template <class F> struct EpiV4 { static constexpr bool PERM = false, MID = false; static constexpr int MID_EVERY = 1; F f;
    __device__ __forceinline__ void operator()(const f32x4 (&acc)[2][2][4][2], const Unit& u, int wr, int wc, int, int) const {
        const int ln = fresh_lane(), fr = ln & 15, fq = ln >> 4;
        const int row0 = u.pm * BM + wr * 64 + fr, col0 = u.pn * BM + wc * 32 + 4 * fq;
        typename F::UnitPre up = f.unit(u, col0);
#pragma unroll
        for (int ai = 0; ai < 2; ++ai) {
            typename F::Pre pre[4][2][2];
#pragma unroll
            for (int m = 0; m < 4; ++m)
#pragma unroll
                for (int bj = 0; bj < 2; ++bj)
#pragma unroll
                    for (int n = 0; n < 2; ++n) pre[m][bj][n] = f.load(u, row0 + ai * HALF + m * 16, col0 + bj * HALF + n * 16);
#pragma unroll
            for (int m = 0; m < 4; ++m)
#pragma unroll
                for (int bj = 0; bj < 2; ++bj)
#pragma unroll
                    for (int n = 0; n < 2; ++n) f.fin(u, row0 + ai * HALF + m * 16, col0 + bj * HALF + n * 16, acc[ai][bj][m][n], pre[m][bj][n], up, bj * 2 + n);
            asm volatile("" ::: "memory"); }
    } };
template <class F> struct EpiV8 { static constexpr bool PERM = true, MID = false; static constexpr int MID_EVERY = 1; F f;
    __device__ __forceinline__ void operator()(const f32x4 (&acc)[2][2][4][2], const Unit& u, int wr, int wc, int, int) const {
        const int ln = fresh_lane(), fr = ln & 15, fq = ln >> 4;
        const int row0 = u.pm * BM + wr * 64 + fr, col0 = u.pn * BM + wc * 32 + 8 * fq;
#pragma unroll
        for (int ai = 0; ai < 2; ++ai) {
            typename F::Pre pre[4][2];
#pragma unroll
            for (int m = 0; m < 4; ++m)
#pragma unroll
                for (int bj = 0; bj < 2; ++bj) pre[m][bj] = f.load(u, row0 + ai * HALF + m * 16, col0 + bj * HALF);
#pragma unroll
            for (int m = 0; m < 4; ++m)
#pragma unroll
                for (int bj = 0; bj < 2; ++bj) f.fin(u, row0 + ai * HALF + m * 16, col0 + bj * HALF, acc[ai][bj][m][0], acc[ai][bj][m][1], pre[m][bj]);
            asm volatile("" ::: "memory"); }
    } };
template <class F> struct EpiDual { static constexpr bool PERM = true, MID = false; static constexpr int MID_EVERY = 1; F f;
    __device__ __forceinline__ void operator()(const f32x4 (&acc)[2][2][4][2], const Unit& u, int wr, int wc, int, int) const {
        const int ln = fresh_lane(), fr = ln & 15, fq = ln >> 4;
        const int row0 = u.pm * BM + wr * 64 + fr, hc0 = u.pn * HALF + wc * 32 + 8 * fq;
#pragma unroll
        for (int ai = 0; ai < 2; ++ai)
#pragma unroll
            for (int m = 0; m < 4; ++m) f.apply8(row0 + ai * HALF + m * 16, hc0, acc[ai][0][m][0], acc[ai][0][m][1], acc[ai][1][m][0], acc[ai][1][m][1]);
    } };
struct EpiMergeS { static constexpr bool PERM = true, MID = true; static constexpr int MID_EVERY = 8;
    const unsigned char* G8; bf16_t* MG;
    __device__ __forceinline__ void mid(f32x4 (&acc)[2][2][4][2], const Unit& u, int wr, int wc, int i) const {
        const int ln = fresh_lane(), fr = ln & 15, fq = ln >> 4;
        const int row0 = u.pm * BM + wr * 64 + fr, col0 = u.pn * BM + wc * 32 + 8 * fq;
#pragma unroll
        for (int ai = 0; ai < 2; ++ai) {
            u32x2 gi[4][2], gn[4][2];
#pragma unroll
            for (int m = 0; m < 4; ++m)
#pragma unroll
                for (int bj = 0; bj < 2; ++bj) { const unsigned char* gp = G8 + (size_t)(row0 + ai * HALF + m * 16) * 4096 + i * 1024 + col0 + bj * HALF;
                    gi[m][bj] = *(const u32x2*)gp; gn[m][bj] = *(const u32x2*)(gp + 1024); }
#pragma unroll
            for (int m = 0; m < 4; ++m)
#pragma unroll
                for (int bj = 0; bj < 2; ++bj) {
#pragma unroll
                    for (int j = 0; j < 4; ++j) {
                        acc[ai][bj][m][0][j] *= (float)((gi[m][bj].x >> (8 * j)) & 255u) * __builtin_amdgcn_rcpf((float)((gn[m][bj].x >> (8 * j)) & 255u));
                        acc[ai][bj][m][1][j] *= (float)((gi[m][bj].y >> (8 * j)) & 255u) * __builtin_amdgcn_rcpf((float)((gn[m][bj].y >> (8 * j)) & 255u)); } }
        }
    }
    __device__ __forceinline__ void operator()(const f32x4 (&acc)[2][2][4][2], const Unit& u, int wr, int wc, int, int) const {
        const int ln = fresh_lane(), fr = ln & 15, fq = ln >> 4;
        const int row0 = u.pm * BM + wr * 64 + fr, col0 = u.pn * BM + wc * 32 + 8 * fq;
#pragma unroll
        for (int ai = 0; ai < 2; ++ai) {
            u32x2 g3[4][2];
#pragma unroll
            for (int m = 0; m < 4; ++m)
#pragma unroll
                for (int bj = 0; bj < 2; ++bj) g3[m][bj] = *(const u32x2*)(G8 + (size_t)(row0 + ai * HALF + m * 16) * 4096 + 3 * 1024 + col0 + bj * HALF);
#pragma unroll
            for (int m = 0; m < 4; ++m)
#pragma unroll
                for (int bj = 0; bj < 2; ++bj) { f32x4 a = acc[ai][bj][m][0], b = acc[ai][bj][m][1];
#pragma unroll
                    for (int j = 0; j < 4; ++j) { a[j] *= (float)((g3[m][bj].x >> (8 * j)) & 255u) * (1.0f / 255.0f); b[j] *= (float)((g3[m][bj].y >> (8 * j)) & 255u) * (1.0f / 255.0f); }
                    u32x4 w; w.x = cvtpk(a.x, a.y); w.y = cvtpk(a.z, a.w); w.z = cvtpk(b.x, b.y); w.w = cvtpk(b.z, b.w);
                    *(u32x4*)(MG + (size_t)(row0 + ai * HALF + m * 16) * D + col0 + bj * HALF) = w; }
        }
    }
};
}

__device__ __forceinline__ u32x4 pack8(f32x4 a, f32x4 b) { u32x4 w; w.x = cvtpk(a.x, a.y); w.y = cvtpk(a.z, a.w); w.z = cvtpk(b.x, b.y); w.w = cvtpk(b.z, b.w); return w; }
__device__ __forceinline__ float sigm1(float x) { return __builtin_amdgcn_rcpf(1.0f + __builtin_amdgcn_exp2f(-1.4426950408889634f * x)); }
__device__ __forceinline__ f32x4 sigm4(f32x4 v) { f32x4 r; r.x = sigm1(v.x); r.y = sigm1(v.y); r.z = sigm1(v.z); r.w = sigm1(v.w); return r; }
struct NoPre {};
struct FStore8 { bf16_t* C; int ldc; typedef NoPre Pre;
    __device__ __forceinline__ Pre load(const pg8::Unit&, int, int) const { return Pre{}; }
    __device__ __forceinline__ void fin(const pg8::Unit&, int row, int col, f32x4 a, f32x4 b, const Pre&) const { *(u32x4*)(C + (size_t)row * ldc + col) = pack8(a, b); } };
struct FGateU8 { unsigned char* G8; const float* bias; typedef NoPre Pre;
    __device__ __forceinline__ Pre load(const pg8::Unit&, int, int) const { return Pre{}; }
    __device__ __forceinline__ void fin(const pg8::Unit&, int row, int col, f32x4 a, f32x4 b, const Pre&) const { const f32x4 b0 = *(const f32x4*)(bias + col), b1 = *(const f32x4*)(bias + col + 4);
        const f32x4 ga = sigm4(a + b0) * 255.0f + 0.5f, gb = sigm4(b + b1) * 255.0f + 0.5f;
        unsigned q[8] = {(unsigned)ga.x, (unsigned)ga.y, (unsigned)ga.z, (unsigned)ga.w, (unsigned)gb.x, (unsigned)gb.y, (unsigned)gb.z, (unsigned)gb.w};
#pragma unroll
        for (int k = 0; k < 8; ++k) q[k] = q[k] < 1u ? 1u : (q[k] > 255u ? 255u : q[k]);
        u32x2 w; w.x = q[0] | (q[1] << 8) | (q[2] << 16) | (q[3] << 24); w.y = q[4] | (q[5] << 8) | (q[6] << 16) | (q[7] << 24);
        *(u32x2*)(G8 + (size_t)row * 4096 + col) = w; } };
struct FMoe1 { bf16_t* HID;
    __device__ __forceinline__ void apply8(int row, int hc, f32x4 a0, f32x4 a1, f32x4 b0, f32x4 b1) const {
        *(u32x4*)(HID + (size_t)row * FF + hc) = pack8(a0 * sigm4(a0) * b0, a1 * sigm4(a1) * b1); } };
struct FMoe2 { bf16_t* MO; const int* tokl; const float* wl; struct Pre { int t; float w; };
    __device__ __forceinline__ Pre load(const pg8::Unit& u, int row, int) const { Pre r; const int pos = u.p0 + (row - u.pm * 256); r.t = -1; r.w = 0.f;
        if (pos < u.ce) { r.t = tokl[(size_t)u.e * R + pos]; r.w = wl[(size_t)u.e * R + pos]; } return r; }
    __device__ __forceinline__ void fin(const pg8::Unit&, int, int col, f32x4 a, f32x4 b, const Pre& q) const { if (q.t < 0) return;
        *(u32x4*)(MO + ((size_t)(q.t & 1) * R + (q.t >> 1)) * D + col) = pack8(a * q.w, b * q.w); } };
struct FOut { Ptrs P; int l; typedef f32x4 Pre; struct UnitPre { f32x4 g[4]; };
    __device__ __forceinline__ UnitPre unit(const pg8::Unit& u, int col0) const { UnitPre r; const float* g = mod_vec(P, l, row_bb(u.pm * 256), 2) + col0;
#pragma unroll
        for (int q = 0; q < 4; ++q) r.g[q] = *(const f32x4*)(g + (q >> 1) * 128 + (q & 1) * 16);
        return r; }
    __device__ __forceinline__ Pre load(const pg8::Unit&, int row, int col) const { return l == 0 ? *(const f32x4*)(xin_row(P, row) + col) : *(const f32x4*)(x1_row(P, row) + col); }
    __device__ __forceinline__ void fin(const pg8::Unit&, int row, int col, f32x4 v, const Pre& xp, const UnitPre& up, int q) const { *(f32x4*)(x1_row(P, row) + col) = xp + up.g[q] * v; } };

struct Frame { LAS unsigned char* lds; int wave, vcu, G; };
#define fresh_tid() (F.wave * 64 + fresh_lane())
__device__ __forceinline__ void tr_item(const float* W, int ldw, int k0, int csrc0, bf16_t* WT, int ldt, int drow0, LAS float* scr, int lane) {
    f32x4 v[8];
#pragma unroll
    for (int i = 0; i < 8; ++i) v[i] = *(const f32x4*)(W + (size_t)(k0 + (lane >> 3) + 8 * i) * ldw + csrc0 + (lane & 7) * 4);
#pragma unroll
    for (int i = 0; i < 8; ++i) { LAS float* d = scr + ((lane >> 3) + 8 * i) * 33 + (lane & 7) * 4; d[0] = v[i].x; d[1] = v[i].y; d[2] = v[i].z; d[3] = v[i].w; }
    LDS_WAIT(); asm volatile("" ::: "memory");
    const int c = lane & 7;
#pragma unroll
    for (int j = 0; j < 4; ++j) { const int n = (lane >> 3) + 8 * j; const LAS float* s = scr + (8 * c) * 33 + n;
        u32x4 o; o.x = cvtpk(s[0 * 33], s[1 * 33]); o.y = cvtpk(s[2 * 33], s[3 * 33]); o.z = cvtpk(s[4 * 33], s[5 * 33]); o.w = cvtpk(s[6 * 33], s[7 * 33]);
        *(u32x4*)(WT + (size_t)(drow0 + n) * ldt + k0 + 8 * c) = o; }
    LDS_WAIT(); asm volatile("" ::: "memory");
}
__device__ __forceinline__ void ph_weights(const Frame& F, const Ptrs& P, int l) {
    const int tid0 = fresh_tid(), lane0 = tid0 & 63;
    LAS float* scr = (LAS float*)(F.lds + F.wave * 16384);
    const int gw = F.vcu * NWAVES + F.wave, NGW = F.G * NWAVES;
    unsigned char* wb = P.ws + WS_WB;
    constexpr int I0 = 1024, I1 = I0 + 2048, I2 = I1 + 768, I3 = I2 + 512, I4 = I3 + 4096, I5 = I4 + 4096, I6 = I5 + 4096;
    for (int it = gw; it < I6; it += NGW) {
        if (it < I0) { const int kb = it >> 6, nb = it & 63; tr_item(P.w_in + (size_t)l * 1024 * 2560, 2560, kb * 64, 512 + nb * 32, (bf16_t*)(wb + WB_IN), 1024, 1024 + nb * 32, scr, lane0); }
        else if (it < I1) { const int r = it - I0, i = r >> 9, q = r & 511, kb = q >> 5, nb = q & 31; tr_item(P.w_gate + ((size_t)l * 4 + i) * 1024 * 1024, 1024, kb * 64, nb * 32, (bf16_t*)(wb + WB_GATE) + (size_t)i * 1024 * 1024, 1024, nb * 32, scr, lane0); }
        else if (it < I2) { const int r = it - I1, i = r >> 8, q = r & 255, kb = q >> 5, nb = q & 31; tr_item(P.w_branch + ((size_t)l * 4 + i) * 512 * 1024, 1024, kb * 64, nb * 32, (bf16_t*)(wb + WB_BR) + i * 512, 2048, nb * 32, scr, lane0); }
        else if (it < I3) { const int q = it - I2, kb = q >> 5, nb = q & 31; tr_item(P.w_out + (size_t)l * 1024 * 1024, 1024, kb * 64, nb * 32, (bf16_t*)(wb + WB_OUT), 1024, nb * 32, scr, lane0); }
        else if (it < I5) { const int w3 = it >= I4; const int r = it - (w3 ? I4 : I3), e = r >> 8, q = r & 255, kb = q >> 4, nb = q & 15, c = nb * 32;
            tr_item((w3 ? P.w3 : P.w1) + ((size_t)l * 16 + e) * 1024 * 512, 512, kb * 64, c, (bf16_t*)(wb + WB_13) + (size_t)e * 1024 * 1024, 1024, 256 * (c >> 7) + (c & 127) + (w3 ? 128 : 0), scr, lane0); }
        else { const int r = it - I5, e = r >> 8, q = r & 255, kb = q >> 5, nb = q & 31; tr_item(P.w2 + ((size_t)l * 16 + e) * 512 * 1024, 1024, kb * 64, nb * 32, (bf16_t*)(wb + WB_2) + (size_t)e * 1024 * 512, 512, nb * 32, scr, lane0); }
    }
    __syncthreads();
    for (int u = F.vcu; u < 64; u += F.G) {
        LAS float* Wl = (LAS float*)F.lds; LAS float* ct = Wl + 64 * 128;
        const int kt = u >> 2, g = u & 3, k0 = kt * 64, tid = tid0; const float* w_in = P.w_in + (size_t)l * 1024 * 2560;
        if (tid < 128) ct[tid] = __builtin_amdgcn_cosf((float)tid * (1.0f / 128.0f));
        for (int i = tid; i < 64 * 128; i += 512) { const int k = i >> 7, c = i & 127; Wl[k * 128 + c] = w_in[(size_t)(k0 + k) * 2560 + g * 128 + c]; }
        __syncthreads();
        const int part = (tid >> 7) & 1, m = tid & 127, kh = tid >> 8; const float sc = 0.08838834764831845f;
        bf16_t* drow = (bf16_t*)(wb + WB_IN) + (size_t)(part * 512 + g * 128 + m) * 1024 + k0;
        for (int kb = kh * 32; kb < kh * 32 + 32; kb += 8) { float acc[8];
#pragma unroll
            for (int j = 0; j < 8; ++j) acc[j] = 0.f;
            for (int c = 0; c < 128; ++c) { const int idx = (c * m) & 127; const float tw = part ? -ct[(idx - 32) & 127] : ct[idx];
#pragma unroll
                for (int j = 0; j < 8; ++j) acc[j] += Wl[(kb + j) * 128 + c] * tw; }
            u32x4 o; o.x = pk2(acc[0] * sc, acc[1] * sc); o.y = pk2(acc[2] * sc, acc[3] * sc); o.z = pk2(acc[4] * sc, acc[5] * sc); o.w = pk2(acc[6] * sc, acc[7] * sc);
            *(u32x4*)(drow + kb) = o; }
        __syncthreads();
    }
    for (int u = F.G - 1 - F.vcu; u < 64; u += F.G) {
        LAS float* Wb = (LAS float*)F.lds;
        const int g = u >> 4, n0 = (u & 15) * 64, tid = tid0;
        const float* ps = P.pool_scale + (size_t)l * 512; const float* wb3 = P.w_branch + ((size_t)l * 4 + 3) * 512 * 1024; const float* pwl = P.pool_w + (size_t)l * 4 * 128 * 128;
        for (int i = tid; i < 128 * 64; i += 512) { const int e = i >> 6, n = i & 63; Wb[e * 64 + n] = ps[g * 128 + e] * wb3[(size_t)(g * 128 + e) * 1024 + n0 + n]; }
        __syncthreads();
        const int c = tid & 127, nh = tid >> 7; const float* pw = pwl + (size_t)(g * 128 + c) * 128;
        float acc[16];
#pragma unroll
        for (int j = 0; j < 16; ++j) acc[j] = 0.f;
        for (int e = 0; e < 128; ++e) { const float p = pw[e];
#pragma unroll
            for (int j = 0; j < 16; ++j) acc[j] += p * Wb[e * 64 + nh * 16 + j]; }
        bf16_t* Bt = (bf16_t*)(wb + WB_BR) + 3 * 512;
#pragma unroll
        for (int j = 0; j < 16; ++j) Bt[(size_t)(n0 + nh * 16 + j) * 2048 + g * 128 + c] = (bf16_t)f2bf(acc[j]);
        __syncthreads();
    }
}
__device__ __forceinline__ void ph_tables_mod(const Frame& F, const Ptrs& P) {
    const int tid0 = fresh_tid();
    { float* rc = (float*)(P.ws + WS_ROPE); float* rs = rc + 1024; float* ct = (float*)(P.ws + WS_COS);
      const int i = F.vcu * 512 + tid0;
      if (i < 1024) { const int pos = i >> 4, f = i & 15; const float inv = exp2f(-(float)f * (13.287712379549449f / 16.0f));
          float rev = (float)pos * inv * 0.15915494309189535f; rev = rev - floorf(rev);
          rc[i] = __builtin_amdgcn_cosf(rev); rs[i] = __builtin_amdgcn_sinf(rev); }
      if (i < 4096) ct[i] = __builtin_amdgcn_cosf((float)i * (1.0f / 4096.0f));
      if (i < 16384) { const int mm = i >> 7, k = i & 127, pp = mm >> 6, k1 = mm & 63, pk = k >> 6, t1 = k & 63; const float rev = (float)((k1 * t1) & 63) * (1.0f / 64.0f);
          const float c = __builtin_amdgcn_cosf(rev), sn = __builtin_amdgcn_sinf(rev);
          ((bf16_t*)(P.ws + WS_DFTM))[i] = (bf16_t)f2bf(pp == pk ? c : (pp == 0 ? sn : -sn)); } }
    for (int u = F.vcu; u < 192; u += F.G) {
        LAS float* s = (LAS float*)F.lds; LAS float* red = s + 9 * 1024;
        const int l = u / 96, j0 = (u % 96) * 64, tid = tid0;
        for (int i = tid; i < 9 * 1024; i += 512) { const int bb = i >> 10, k = i & 1023; const float v = bb < 8 ? P.c[bb * 1024 + k] : P.c_ctx[k]; s[i] = v / (1.f + expf(-v)); }
        __syncthreads();
        const int kc = tid >> 6, jj = tid & 63; float acc[9];
#pragma unroll
        for (int b = 0; b < 9; ++b) acc[b] = 0.f;
        const float* w = P.w_ada + (size_t)l * 1024 * 6144 + j0 + jj;
        for (int k = kc * 128; k < kc * 128 + 128; k += 8) { float wv[8];
#pragma unroll
            for (int q = 0; q < 8; ++q) wv[q] = w[(size_t)(k + q) * 6144];
#pragma unroll
            for (int q = 0; q < 8; ++q)
#pragma unroll
                for (int b = 0; b < 9; ++b) acc[b] += s[b * 1024 + k + q] * wv[q]; }
#pragma unroll
        for (int b = 0; b < 9; ++b) red[(kc * 9 + b) * 64 + jj] = acc[b];
        __syncthreads();
        float* mod = (float*)(P.ws + WS_MOD);
        for (int i = tid; i < 9 * 64; i += 512) { const int b = i >> 6, j = i & 63; float v = P.b_ada[l * 6144 + j0 + j];
#pragma unroll
            for (int q = 0; q < 8; ++q) v += red[(q * 9 + b) * 64 + j];
            mod[(size_t)(l * 9 + b) * 6144 + j0 + j] = v; }
        __syncthreads();
    }
}
__device__ __forceinline__ void route_row(const Ptrs& P, int r, const f32x4 (&h)[4], int lane, bool publish, LAS unsigned* lcnt, LAS int* rec, const LAS float* rwl) {
    float lg[16];
#pragma unroll
    for (int e = 0; e < 16; ++e) lg[e] = 0.f;
#pragma unroll
    for (int j = 0; j < 4; ++j) {
#pragma unroll
        for (int i = 0; i < 4; ++i) { const int kk = 4 * lane + 256 * j + i; const LAS f32x4* rw = (const LAS f32x4*)(rwl + kk * 16 + (kk >> 2) * 4); const float hv = h[j][i];
#pragma unroll
            for (int qd = 0; qd < 4; ++qd) { const f32x4 w = rw[qd]; lg[4 * qd] += hv * w.x; lg[4 * qd + 1] += hv * w.y; lg[4 * qd + 2] += hv * w.z; lg[4 * qd + 3] += hv * w.w; } }
        __builtin_amdgcn_sched_barrier(0); }
    float v8[8], v4[4], v2[2], v1;
    { const bool bit = (lane & 32) != 0;
#pragma unroll
      for (int i = 0; i < 8; ++i) { const float a = lg[i], b = lg[i + 8]; v8[i] = (bit ? b : a) + shfl_xor_l(bit ? a : b, 32, lane); } }
    { const bool bit = (lane & 16) != 0;
#pragma unroll
      for (int i = 0; i < 4; ++i) { const float a = v8[i], b = v8[i + 4]; v4[i] = (bit ? b : a) + shfl_xor_l(bit ? a : b, 16, lane); } }
    { const bool bit = (lane & 8) != 0;
#pragma unroll
      for (int i = 0; i < 2; ++i) { const float a = v4[i], b = v4[i + 2]; v2[i] = (bit ? b : a) + shfl_xor_l(bit ? a : b, 8, lane); } }
    { const bool bit = (lane & 4) != 0; const float a = v2[0], b = v2[1]; v1 = (bit ? b : a) + shfl_xor_l(bit ? a : b, 4, lane); }
    v1 += shfl_xor_l(v1, 2, lane); v1 += shfl_xor_l(v1, 1, lane);
    float bestscore = -INFINITY; int be0 = 0, be1 = 1; float ba0 = 0.f, ba1 = 0.f;
#pragma unroll
    for (int g = 0; g < 4; ++g) {
        float aff[4], sel[4];
#pragma unroll
        for (int i = 0; i < 4; ++i) { const float t = __int_as_float(__builtin_amdgcn_ds_bpermute((4 * g + i) << 4, __float_as_int(v1))); aff[i] = 1.0f / (1.0f + expf(-t)); sel[i] = aff[i] + P.router_bias[4 * g + i]; }
        int i1 = 0; float m1 = sel[0], a1 = aff[0];
#pragma unroll
        for (int i = 1; i < 4; ++i) if (sel[i] > m1) { m1 = sel[i]; a1 = aff[i]; i1 = i; }
        int i2 = -1; float m2 = -INFINITY, a2 = 0.f;
#pragma unroll
        for (int i = 0; i < 4; ++i) if (i != i1 && sel[i] > m2) { m2 = sel[i]; a2 = aff[i]; i2 = i; }
        const float score = m1 + m2;
        if (score > bestscore) { bestscore = score; be0 = 4 * g + i1; be1 = 4 * g + i2; ba0 = a1; ba1 = a2; }
    }
    if (lane == 0 && publish) {
        const int p0 = (int)__hip_atomic_fetch_add(lcnt + be0, 1u, __ATOMIC_RELAXED, __HIP_MEMORY_SCOPE_WORKGROUP), p1 = (int)__hip_atomic_fetch_add(lcnt + be1, 1u, __ATOMIC_RELAXED, __HIP_MEMORY_SCOPE_WORKGROUP);
        const float inv = 1.0f / (ba0 + ba1);
        rec[0] = r; rec[1] = be0; rec[2] = p0; rec[3] = be1; rec[4] = p1; rec[5] = __float_as_int(ba0 * inv); rec[6] = __float_as_int(ba1 * inv);
    }
}
template <int MODE> __device__ __forceinline__ void ph_norm(const Frame& F, const Ptrs& P, int l, int nrows) {
    const int lane = fresh_lane();
    const int stride = F.G * NWAVES;
    LAS unsigned* lcnt = (LAS unsigned*)F.lds; LAS unsigned* gbase = lcnt + 16; LAS int* recs = (LAS int*)(F.lds + 256);
    const LAS float* rwl = (const LAS float*)(F.lds + 8192);
    if (MODE == 2) { if (F.wave == 0 && lane < 16) lcnt[lane] = 0u;
        { const int tid = F.wave * 64 + lane; LAS f32x4* d = (LAS f32x4*)(F.lds + 8192);
#pragma unroll
          for (int i = 0; i < 8; ++i) { const int idx = tid + 512 * i, kk = idx >> 2; d[idx + (kk >> 2)] = ((const f32x4*)P.router_w)[idx]; } }
        __syncthreads(); }
    int it = 0;
    for (int rb = F.vcu * NWAVES + F.wave; rb < nrows; rb += 2 * stride, ++it) {
        int rr[2]; rr[0] = rb; rr[1] = rb + stride < nrows ? rb + stride : rb;
        f32x4 v[2][4];
#pragma unroll
        for (int q = 0; q < 2; ++q) { const int r = rr[q];
            if (MODE == 0) { const f32x4* xr = (const f32x4*)xin_row(P, r) + lane;
#pragma unroll
                for (int j = 0; j < 4; ++j) v[q][j] = xr[64 * j]; }
            else { const f32x4* xr = (const f32x4*)x1_row(P, r) + lane;
#pragma unroll
                for (int j = 0; j < 4; ++j) v[q][j] = xr[64 * j]; } }
        if (MODE == 1) {
#pragma unroll
            for (int q = 0; q < 2; ++q) { const int r = rr[q]; const int bb = row_bb(r); const f32x4* g2 = (const f32x4*)mod_vec(P, l - 1, bb, 5) + lane;
                const u32x2* m0 = (const u32x2*)((const bf16_t*)(P.ws + WS_MO) + (size_t)r * D) + lane; const u32x2* m1 = (const u32x2*)((const bf16_t*)(P.ws + WS_MO) + (size_t)(R + r) * D) + lane;
#pragma unroll
                for (int j = 0; j < 4; ++j) { const u32x2 a = m0[64 * j], b = m1[64 * j]; const f32x4 g = g2[64 * j];
                    v[q][j].x += g.x * (lo16(a.x) + lo16(b.x)); v[q][j].y += g.y * (hi16(a.x) + hi16(b.x)); v[q][j].z += g.z * (lo16(a.y) + lo16(b.y)); v[q][j].w += g.w * (hi16(a.y) + hi16(b.y)); } }
            if (rr[1] != rr[0]) { f32x4* xr = (f32x4*)x1_row(P, rr[1]) + lane;
#pragma unroll
                for (int j = 0; j < 4; ++j) xr[64 * j] = v[1][j]; }
            { f32x4* xr = (f32x4*)x1_row(P, rr[0]) + lane;
#pragma unroll
              for (int j = 0; j < 4; ++j) xr[64 * j] = v[0][j]; }
        }
        float ss[2];
#pragma unroll
        for (int q = 0; q < 2; ++q) { ss[q] = 0.f;
#pragma unroll
            for (int j = 0; j < 4; ++j) ss[q] += (v[q][j].x * v[q][j].x + v[q][j].y * v[q][j].y) + (v[q][j].z * v[q][j].z + v[q][j].w * v[q][j].w); }
#pragma unroll
        for (int o = 1; o < 64; o <<= 1) { ss[0] += shfl_xor_l(ss[0], o, lane); ss[1] += shfl_xor_l(ss[1], o, lane); }
        const f32x4* gn = (const f32x4*)((MODE == 2 ? P.norm2 : P.norm1) + (size_t)l * D) + lane;
#pragma unroll
        for (int q = 0; q < 2; ++q) { const int r = rr[q]; const int bb = row_bb(r);
            const float rstd = 1.0f / sqrtf(ss[q] * (1.0f / D) + EPS);
            const f32x4* sh = (const f32x4*)mod_vec(P, l, bb, MODE == 2 ? 3 : 0) + lane;
            const f32x4* sc = (const f32x4*)mod_vec(P, l, bb, MODE == 2 ? 4 : 1) + lane;
            u32x2* o = (u32x2*)((bf16_t*)(P.ws + WS_H) + (size_t)r * D) + lane;
#pragma unroll
            for (int j = 0; j < 4; ++j) { const f32x4 g = gn[64 * j], a = sh[64 * j], b = sc[64 * j];
                v[q][j] = (v[q][j] * rstd * g) * (b + 1.0f) + a;
                u32x2 w; w.x = cvtpk(v[q][j].x, v[q][j].y); w.y = cvtpk(v[q][j].z, v[q][j].w); o[64 * j] = w; } }
        if (MODE == 2) { LAS int* rec = recs + (F.wave * 24 + 2 * it) * 8;
            route_row(P, rr[0], v[0], lane, true, lcnt, rec, rwl); __builtin_amdgcn_sched_barrier(0);
            if (lane == 0 && rr[1] == rr[0]) rec[8] = -1;
            route_row(P, rr[1], v[1], lane, rr[1] != rr[0], lcnt, rec + 8, rwl); }
    }
    if (MODE == 2) {
        __syncthreads();
        const int tid = F.wave * 64 + lane;
        if (tid < 16) { const unsigned c = lcnt[tid]; gbase[tid] = c ? atomicAdd((unsigned*)(P.ws + WS_CTL) + CW_CNT + 1024 * l + 64 * tid, c) : 0u; }
        __syncthreads();
        if (lane == 0) for (int k = 0; k < 2 * it; ++k) { const LAS int* rec = recs + (F.wave * 24 + k) * 8; const int r = rec[0]; if (r < 0) continue;
            int* tokl = (int*)(P.ws + WS_TOKL); float* wl = (float*)(P.ws + WS_WL);
            const size_t i0 = (size_t)rec[1] * R + rec[2] + gbase[rec[1]], i1 = (size_t)rec[3] * R + rec[4] + gbase[rec[3]];
            tokl[i0] = 2 * r; wl[i0] = __int_as_float(rec[5]); tokl[i1] = 2 * r + 1; wl[i1] = __int_as_float(rec[6]); }
        __syncthreads();
    }
}
__device__ __forceinline__ void ph_kprep(const Frame& F, const Ptrs& P, int l) {
    const int lane = fresh_lane();
    const float* rc = (const float*)(P.ws + WS_ROPE); const float* rs = rc + 1024;
    const int hs = (lane >> 3) & 3, chunk = lane & 7, col = (hs < 2 ? C_KB + hs * 64 : C_KW + (hs - 2) * 64) + chunk * 8;
    const f32x4 g0 = *(const f32x4*)(P.k_gain + l * 64 + chunk * 8), g1 = *(const f32x4*)(P.k_gain + l * 64 + chunk * 8 + 4);
    const int a = chunk >> 2, fi = (chunk & 1) * 8; const bool second = (chunk & 2) != 0;
    const int npair = R / 2, stride = F.G * NWAVES;
    for (int pr0 = F.vcu * NWAVES + F.wave; pr0 < npair; pr0 += 4 * stride) {
        u32x4 w[4];
#pragma unroll
        for (int q = 0; q < 4; ++q) { const int pr = pr0 + q * stride; const int r = 2 * (pr < npair ? pr : pr0) + (lane >> 5); w[q] = *(const u32x4*)((const bf16_t*)(P.ws + WS_U) + (size_t)r * NIN + col); }
#pragma unroll
        for (int q = 0; q < 4; ++q) { const int pr = pr0 + q * stride; if (pr >= npair) break;
            const int r = 2 * pr + (lane >> 5);
            float x[8] = {lo16(w[q].x), hi16(w[q].x), lo16(w[q].y), hi16(w[q].y), lo16(w[q].z), hi16(w[q].z), lo16(w[q].w), hi16(w[q].w)};
            if (hs < 2) { float ss = 0.f;
#pragma unroll
                for (int j = 0; j < 8; ++j) ss += x[j] * x[j];
                ss += shfl_xor_l(ss, 1, lane); ss += shfl_xor_l(ss, 2, lane); ss += shfl_xor_l(ss, 4, lane);
                const float rstd = 1.0f / sqrtf(ss * (1.0f / 64.0f) + EPS);
                x[0] *= rstd * g0.x; x[1] *= rstd * g0.y; x[2] *= rstd * g0.z; x[3] *= rstd * g0.w; x[4] *= rstd * g1.x; x[5] *= rstd * g1.y; x[6] *= rstd * g1.z; x[7] *= rstd * g1.w; }
            if (r < RL) { const int t = r & (T - 1), pos = a ? (t & 63) : (t >> 6);
                const f32x4 c0 = *(const f32x4*)(rc + pos * 16 + fi), c1 = *(const f32x4*)(rc + pos * 16 + fi + 4), s0 = *(const f32x4*)(rs + pos * 16 + fi), s1 = *(const f32x4*)(rs + pos * 16 + fi + 4);
                const float cs[8] = {c0.x, c0.y, c0.z, c0.w, c1.x, c1.y, c1.z, c1.w}, sn[8] = {s0.x, s0.y, s0.z, s0.w, s1.x, s1.y, s1.z, s1.w};
#pragma unroll
                for (int j = 0; j < 8; ++j) { const float y = shfl_xor_l(x[j], 2, lane); x[j] = second ? x[j] * cs[j] + y * sn[j] : x[j] * cs[j] - y * sn[j]; } }
            u32x4 o; o.x = cvtpk(x[0], x[1]); o.y = cvtpk(x[2], x[3]); o.z = cvtpk(x[4], x[5]); o.w = cvtpk(x[6], x[7]);
            *(u32x4*)((bf16_t*)(P.ws + WS_U) + (size_t)r * NIN + col) = o; }
    }
}
__device__ __forceinline__ void ph_pool(const Frame& F, const Ptrs& P, int nrows) {
    const int tid0 = fresh_tid();
    for (int i = F.vcu * 512 + tid0; i < nrows * 64; i += F.G * 512) {
        const int r = i >> 6, c8 = (i & 63) * 8;
        const bool lat = r < RL; const int Ts = lat ? T : TC; const int t = lat ? (r & (T - 1)) : ((r - RL) & (TC - 1)); const int r0 = r - t;
        const int g = c8 >> 7, hw = 1 << g;
        const int lo = t - hw < 0 ? 0 : t - hw, hi = t + hw > Ts ? Ts : t + hw;
        const bf16_t* U = (const bf16_t*)(P.ws + WS_U) + C_P + c8;
        u32x4 wv[16];
#pragma unroll
        for (int k = 0; k < 16; ++k) { const int tt = t - 8 + k; const bool ok = tt >= lo && tt < hi; wv[k] = *(const u32x4*)(U + (size_t)(r0 + (ok ? tt : t)) * NIN); }
        float s[8];
#pragma unroll
        for (int j = 0; j < 8; ++j) s[j] = 0.f;
#pragma unroll
        for (int k = 0; k < 16; ++k) { const int tt = t - 8 + k; const float f = (tt >= lo && tt < hi) ? 1.f : 0.f; const u32x4 w = wv[k];
            s[0] += f * lo16(w.x); s[1] += f * hi16(w.x); s[2] += f * lo16(w.y); s[3] += f * hi16(w.y); s[4] += f * lo16(w.z); s[5] += f * hi16(w.z); s[6] += f * lo16(w.w); s[7] += f * hi16(w.w); }
        const u32x4 w = wv[8]; const float inv = 1.0f / (float)(hi - lo);
        u32x4 o; o.x = cvtpk(s[0] * inv - lo16(w.x), s[1] * inv - hi16(w.x)); o.y = cvtpk(s[2] * inv - lo16(w.y), s[3] * inv - hi16(w.y));
        o.z = cvtpk(s[4] * inv - lo16(w.z), s[5] * inv - hi16(w.z)); o.w = cvtpk(s[6] * inv - lo16(w.w), s[7] * inv - hi16(w.w));
        *(u32x4*)((bf16_t*)(P.ws + WS_BR) + (size_t)r * NBR + 1536 + c8) = o;
    }
}
__device__ __forceinline__ void ph_final(const Frame& F, const Ptrs& P) {
    const int lane = fresh_tid() & 63;
    for (int r = F.vcu * NWAVES + F.wave; r < RL; r += F.G * NWAVES) {
        const int bb = row_bb(r);
        f32x4* xr = (f32x4*)(P.out + (size_t)r * D) + lane; f32x4 v[4];
        const f32x4* g2 = (const f32x4*)mod_vec(P, 1, bb, 5) + lane;
        const u32x2* m0 = (const u32x2*)((const bf16_t*)(P.ws + WS_MO) + (size_t)r * D) + lane; const u32x2* m1 = (const u32x2*)((const bf16_t*)(P.ws + WS_MO) + (size_t)(R + r) * D) + lane;
        float ss = 0.f;
#pragma unroll
        for (int j = 0; j < 4; ++j) { v[j] = xr[64 * j]; const u32x2 a = m0[64 * j], b = m1[64 * j]; const f32x4 g = g2[64 * j];
            v[j].x += g.x * (lo16(a.x) + lo16(b.x)); v[j].y += g.y * (hi16(a.x) + hi16(b.x)); v[j].z += g.z * (lo16(a.y) + lo16(b.y)); v[j].w += g.w * (hi16(a.y) + hi16(b.y));
            ss += (v[j].x * v[j].x + v[j].y * v[j].y) + (v[j].z * v[j].z + v[j].w * v[j].w); }
        const float rstd = 1.0f / sqrtf(wave_sum_l(ss, lane) * (1.0f / D) + EPS);
        const f32x4* gn = (const f32x4*)P.norm_f + lane;
#pragma unroll
        for (int j = 0; j < 4; ++j) xr[64 * j] = v[j] * rstd * gn[64 * j];
    }
}

template <int MODE> __device__ __forceinline__ void ph_attn_ref(const Frame& F, const Ptrs& P, int l) {
    const int tid = fresh_tid();
    LAS float* Ks = (LAS float*)F.lds; LAS float* Vs = Ks + 64 * 64;
    const bf16_t* U = (const bf16_t*)(P.ws + WS_U);
    const bool latq = MODE < 2; const bool winm = (MODE == 1 || MODE == 3);
    const int NU = latq ? 1024 : 64; const int half = tid & 1;
    for (int u = F.vcu; u < NU; u += F.G) {
        const int qb = latq ? (u & 15) : 0, h = latq ? ((u >> 4) & 7) : (u & 7), b = latq ? (u >> 7) : (u >> 3), g = h >> 2;
        const int tq = qb * 256 + (tid >> 1);
        const int qrow = latq ? b * T + tq : RL + b * TC + tq;
        const int qcol = (winm ? C_QW : C_QB) + h * 64 + half * 32, kcol = (winm ? C_KW : C_KB) + g * 64, vcol = (winm ? C_VW : C_VB) + g * 64;
        unsigned q[16]; float o[32];
        { const u32x4* qp = (const u32x4*)(U + (size_t)qrow * NIN + qcol);
#pragma unroll
          for (int i = 0; i < 4; ++i) { const u32x4 w = qp[i]; q[4 * i] = w.x; q[4 * i + 1] = w.y; q[4 * i + 2] = w.z; q[4 * i + 3] = w.w; } }
#pragma unroll
        for (int d = 0; d < 32; ++d) o[d] = 0.f;
        float m = -INFINITY, lsum = 0.f;
        int lt_lo = 0, lt_hi = 0;
        if (MODE == 0) { lt_lo = 0; lt_hi = T / 64; }
        if (MODE == 1) { const int q0 = qb * 256; lt_lo = (q0 - 128 < 0 ? 0 : q0 - 128) / 64; lt_hi = (q0 + 384 > T ? T : q0 + 384) / 64; }
        const int ntiles = 4 + (lt_hi - lt_lo);
        for (int ti = 0; ti < ntiles; ++ti) {
            const bool isctx = ti < 4; const int kpos0 = isctx ? ti * 64 : (lt_lo + ti - 4) * 64;
            const int krow0 = isctx ? RL + b * TC + kpos0 : b * T + kpos0;
            __syncthreads();
            { const int j = tid >> 3, part = tid & 7; const u32x4 kw = *(const u32x4*)(U + (size_t)(krow0 + j) * NIN + kcol + part * 8), vw = *(const u32x4*)(U + (size_t)(krow0 + j) * NIN + vcol + part * 8);
              LAS float* kd = Ks + j * 64 + part * 8; LAS float* vd = Vs + j * 64 + part * 8;
              kd[0] = lo16(kw.x); kd[1] = hi16(kw.x); kd[2] = lo16(kw.y); kd[3] = hi16(kw.y); kd[4] = lo16(kw.z); kd[5] = hi16(kw.z); kd[6] = lo16(kw.w); kd[7] = hi16(kw.w);
              vd[0] = lo16(vw.x); vd[1] = hi16(vw.x); vd[2] = lo16(vw.y); vd[3] = hi16(vw.y); vd[4] = lo16(vw.z); vd[5] = hi16(vw.z); vd[6] = lo16(vw.w); vd[7] = hi16(vw.w); }
            __syncthreads();
#pragma unroll 1
            for (int jk = 0; jk < 64; ++jk) {
                float a = 0.f; const LAS f32x4* kr = (const LAS f32x4*)(Ks + jk * 64 + half * 32);
#pragma unroll
                for (int d4 = 0; d4 < 8; ++d4) { const f32x4 kv = kr[d4]; a += lo16(q[2 * d4]) * kv.x + hi16(q[2 * d4]) * kv.y + lo16(q[2 * d4 + 1]) * kv.z + hi16(q[2 * d4 + 1]) * kv.w; }
                a += shfl_xor_l(a, 1, tid & 63);
                if (MODE == 1 && !isctx) { const int dlt = kpos0 + jk - tq; if (dlt > 128 || dlt < -128) a = -INFINITY; }
                if (a != -INFINITY) {
                    if (a > m) { const float scl = exp2f(m - a); m = a; lsum *= scl;
#pragma unroll
                        for (int d = 0; d < 32; ++d) o[d] *= scl; }
                    const float p = exp2f(a - m); lsum += p; const LAS f32x4* vr = (const LAS f32x4*)(Vs + jk * 64 + half * 32);
#pragma unroll
                    for (int d4 = 0; d4 < 8; ++d4) { const f32x4 vv = vr[d4]; o[4 * d4] += p * vv.x; o[4 * d4 + 1] += p * vv.y; o[4 * d4 + 2] += p * vv.z; o[4 * d4 + 3] += p * vv.w; }
                }
            }
        }
        if (winm) lsum += exp2f(P.sink[l * 8 + h] * LOG2E - m);
        const float inv = 1.0f / lsum;
        { u32x4* op = (u32x4*)((bf16_t*)(P.ws + WS_BR) + (size_t)qrow * NBR + (winm ? 1024 : 512) + h * 64 + half * 32);
#pragma unroll
          for (int i = 0; i < 4; ++i) { u32x4 w; w.x = pk2(o[8 * i] * inv, o[8 * i + 1] * inv); w.y = pk2(o[8 * i + 2] * inv, o[8 * i + 3] * inv); w.z = pk2(o[8 * i + 4] * inv, o[8 * i + 5] * inv); w.w = pk2(o[8 * i + 6] * inv, o[8 * i + 7] * inv); op[i] = w; } }
        __syncthreads();
    }
}
__device__ __forceinline__ void ph_fourier_ref(const Frame& F, const Ptrs& P, int Ts, int latent) {
    const int tid = fresh_tid();
    LAS float* Zr = (LAS float*)F.lds; LAS float* Zi = Zr + 16 * 64; LAS float* Ct = Zi + 16 * 64; LAS float* St = Ct + 128 * 17;
    const bf16_t* U = (const bf16_t*)(P.ws + WS_U); const float* ct = (const float*)(P.ws + WS_COS);
    const int nkt = Ts / 128, NU = 8 * nkt * 8, step = 4096 / Ts;
    const int tk = tid >> 4, tc = tid & 15;
    for (int u = F.vcu; u < NU; u += F.G) {
        const int cht = u & 7, kt = (u >> 3) % nkt, b = (u >> 3) / nkt, k0 = kt * 128, ch0 = cht * 64;
        const int rbase = latent ? b * T : RL + b * TC;
        float acc[4][4];
#pragma unroll
        for (int i = 0; i < 4; ++i)
#pragma unroll
            for (int j = 0; j < 4; ++j) acc[i][j] = 0.f;
        for (int t0 = 0; t0 < Ts; t0 += 16) {
            __syncthreads();
            if (tid < 256) { const int tt = tid >> 4, c4 = (tid & 15) * 4; const bf16_t* zp = U + (size_t)(rbase + t0 + tt) * NIN + ch0 + c4;
              const u32x2 a = *(const u32x2*)(zp + C_ZR), bq = *(const u32x2*)(zp + C_ZI);
              Zr[tt * 64 + c4] = lo16(a.x); Zr[tt * 64 + c4 + 1] = hi16(a.x); Zr[tt * 64 + c4 + 2] = lo16(a.y); Zr[tt * 64 + c4 + 3] = hi16(a.y);
              Zi[tt * 64 + c4] = lo16(bq.x); Zi[tt * 64 + c4 + 1] = hi16(bq.x); Zi[tt * 64 + c4 + 2] = lo16(bq.y); Zi[tt * 64 + c4 + 3] = hi16(bq.y); }
#pragma unroll
            for (int i = 0; i < 4; ++i) { const int e = tid * 4 + i, k = e >> 4, tt = e & 15; const int ang = (((k0 + k) * (t0 + tt)) & (Ts - 1)) * step;
                Ct[k * 17 + tt] = ct[ang]; St[k * 17 + tt] = ct[(ang - 1024) & 4095]; }
            __syncthreads();
#pragma unroll 2
            for (int tt = 0; tt < 16; ++tt) { float zr[4], zi[4];
#pragma unroll
                for (int j = 0; j < 4; ++j) { zr[j] = Zr[tt * 64 + tc * 4 + j]; zi[j] = Zi[tt * 64 + tc * 4 + j]; }
#pragma unroll
                for (int i = 0; i < 4; ++i) { const float c = Ct[(tk * 4 + i) * 17 + tt], sn = St[(tk * 4 + i) * 17 + tt];
#pragma unroll
                    for (int j = 0; j < 4; ++j) acc[i][j] += c * zr[j] + sn * zi[j]; } }
        }
        const float sc = 1.0f / sqrtf((float)Ts);
        bf16_t* BR = (bf16_t*)(P.ws + WS_BR);
#pragma unroll
        for (int i = 0; i < 4; ++i) { u32x2 w; w.x = pk2(acc[i][0] * sc, acc[i][1] * sc); w.y = pk2(acc[i][2] * sc, acc[i][3] * sc);
            *(u32x2*)(BR + (size_t)(rbase + k0 + tk * 4 + i) * NBR + ch0 + tc * 4) = w; }
        __syncthreads();
    }
}

typedef float f32x16 __attribute__((ext_vector_type(16)));
typedef short v4i16_t __attribute__((ext_vector_type(4)));
constexpr float ATT_THR = 4.0f;
constexpr int AT_ROWB = 144, AT_TILEB = 64 * AT_ROWB;
constexpr int AT_VROWB = 192, AT_VTILEB = 64 * AT_VROWB;
constexpr int AT_STAGEB = 2 * AT_TILEB + 2 * AT_VTILEB;
#define AT_SB() __builtin_amdgcn_sched_barrier(0)
__device__ __forceinline__ void at_qk2(const LAS unsigned char* Ka, const LAS unsigned char* Kb, int kf_off, const bf16x8 (&qr)[4], const f32x16& negm, f32x16& pa0, f32x16& pa1, f32x16& pb0, f32x16& pb1) {
    bf16x8 ka[8], kb[8];
#pragma unroll
    for (int d0 = 0; d0 < 4; ++d0) { ka[2 * d0] = *(const LAS bf16x8*)(Ka + kf_off + d0 * 32); ka[2 * d0 + 1] = *(const LAS bf16x8*)(Ka + kf_off + 32 * AT_ROWB + d0 * 32); }
    AT_SB();
#pragma unroll
    for (int d0 = 0; d0 < 4; ++d0) {
        kb[2 * d0] = *(const LAS bf16x8*)(Kb + kf_off + d0 * 32); kb[2 * d0 + 1] = *(const LAS bf16x8*)(Kb + kf_off + 32 * AT_ROWB + d0 * 32);
        AT_SB();
        if (d0 == 0) { pa0 = __builtin_amdgcn_mfma_f32_32x32x16_bf16(ka[0], qr[0], negm, 0, 0, 0); pa1 = __builtin_amdgcn_mfma_f32_32x32x16_bf16(ka[1], qr[0], negm, 0, 0, 0); }
        else { pa0 = __builtin_amdgcn_mfma_f32_32x32x16_bf16(ka[2 * d0], qr[d0], pa0, 0, 0, 0); pa1 = __builtin_amdgcn_mfma_f32_32x32x16_bf16(ka[2 * d0 + 1], qr[d0], pa1, 0, 0, 0); }
        AT_SB();
    }
    pb0 = __builtin_amdgcn_mfma_f32_32x32x16_bf16(kb[0], qr[0], negm, 0, 0, 0); pb1 = __builtin_amdgcn_mfma_f32_32x32x16_bf16(kb[1], qr[0], negm, 0, 0, 0);
#pragma unroll
    for (int d0 = 1; d0 < 4; ++d0) { pb0 = __builtin_amdgcn_mfma_f32_32x32x16_bf16(kb[2 * d0], qr[d0], pb0, 0, 0, 0); pb1 = __builtin_amdgcn_mfma_f32_32x32x16_bf16(kb[2 * d0 + 1], qr[d0], pb1, 0, 0, 0); }
}
__device__ __forceinline__ void at_vread(const LAS unsigned char* vp, v4i16_t (&f)[4]) {
    f[0] = __builtin_amdgcn_ds_read_tr16_b64_v4i16((LAS v4i16_t*)(vp)); f[1] = __builtin_amdgcn_ds_read_tr16_b64_v4i16((LAS v4i16_t*)(vp + 8 * AT_VROWB));
    f[2] = __builtin_amdgcn_ds_read_tr16_b64_v4i16((LAS v4i16_t*)(vp + 64)); f[3] = __builtin_amdgcn_ds_read_tr16_b64_v4i16((LAS v4i16_t*)(vp + 8 * AT_VROWB + 64));
}
__device__ __forceinline__ bf16x8 at_ppack(const f32x16& p, int sx) { u32x4 pw; pw.x = cvtpk(p[8 * sx], p[8 * sx + 1]); pw.y = cvtpk(p[8 * sx + 2], p[8 * sx + 3]); pw.z = cvtpk(p[8 * sx + 4], p[8 * sx + 5]); pw.w = cvtpk(p[8 * sx + 6], p[8 * sx + 7]); return __builtin_bit_cast(bf16x8, pw); }
__device__ __forceinline__ void at_pvmm(const v4i16_t (&f)[4], const bf16x8 pf, f32x16& o0, f32x16& o1) {
    const bf16x8 v0 = (bf16x8){f[0][0], f[0][1], f[0][2], f[0][3], f[1][0], f[1][1], f[1][2], f[1][3]}, v1 = (bf16x8){f[2][0], f[2][1], f[2][2], f[2][3], f[3][0], f[3][1], f[3][2], f[3][3]};
    o0 = __builtin_amdgcn_mfma_f32_32x32x16_bf16(v0, pf, o0, 0, 0, 0); o1 = __builtin_amdgcn_mfma_f32_32x32x16_bf16(v1, pf, o1, 0, 0, 0);
}
__device__ __forceinline__ float at_exp8(f32x16& p, int sx) { float rs = 0.f;
#pragma unroll
    for (int j = 0; j < 8; ++j) { p[8 * sx + j] = __builtin_amdgcn_exp2f(p[8 * sx + j]); rs += p[8 * sx + j]; }
    return rs; }
__device__ __forceinline__ float at_exp_pv2(const LAS unsigned char* Va, const LAS unsigned char* Vb, int vf_off, f32x16& pa0, f32x16& pa1, f32x16& pb0, f32x16& pb1, f32x16& o0, f32x16& o1) {
    v4i16_t fA[4], fB[4]; float rs;
    at_vread(Va + vf_off, fA); rs = at_exp8(pa0, 0); AT_SB();
    at_vread(Va + vf_off + 16 * AT_VROWB, fB); at_pvmm(fA, at_ppack(pa0, 0), o0, o1); rs += at_exp8(pa0, 1); AT_SB();
    at_vread(Va + vf_off + 32 * AT_VROWB, fA); at_pvmm(fB, at_ppack(pa0, 1), o0, o1); rs += at_exp8(pa1, 0); AT_SB();
    at_vread(Va + vf_off + 48 * AT_VROWB, fB); at_pvmm(fA, at_ppack(pa1, 0), o0, o1); rs += at_exp8(pa1, 1); AT_SB();
    at_vread(Vb + vf_off, fA);                 at_pvmm(fB, at_ppack(pa1, 1), o0, o1); rs += at_exp8(pb0, 0); AT_SB();
    at_vread(Vb + vf_off + 16 * AT_VROWB, fB); at_pvmm(fA, at_ppack(pb0, 0), o0, o1); rs += at_exp8(pb0, 1); AT_SB();
    at_vread(Vb + vf_off + 32 * AT_VROWB, fA); at_pvmm(fB, at_ppack(pb0, 1), o0, o1); rs += at_exp8(pb1, 0); AT_SB();
    at_vread(Vb + vf_off + 48 * AT_VROWB, fB); at_pvmm(fA, at_ppack(pb1, 0), o0, o1); rs += at_exp8(pb1, 1); AT_SB();
    at_pvmm(fB, at_ppack(pb1, 1), o0, o1);
    return rs;
}
template <int MODE> __device__ __forceinline__ void ph_attn(const Frame& F, const Ptrs& P, int l) {
    const int lane = fresh_lane(), tid = F.wave * 64 + lane, r32 = lane & 31, hi = lane >> 5;
    const bf16_t* U = (const bf16_t*)(P.ws + WS_U);
    const bool latq = MODE < 2; const bool winm = (MODE == 1 || MODE == 3);
    const int NU = latq ? 1024 : 64;
    LAS unsigned char* Lb = F.lds;
    const int st_off = (tid >> 3) * AT_ROWB + (tid & 7) * 16;
    const int kf_off = r32 * AT_ROWB + hi * 16;
    const int sv_off = (tid >> 3) * AT_VROWB + (tid & 7) * 16;
    const int vf_off = (4 * hi + ((lane & 15) >> 2)) * AT_VROWB + (((lane >> 4) & 1) * 16 + (lane & 3) * 4) * 2;
    for (int u = F.vcu; u < NU; u += F.G) {
        const int qb = latq ? (u & 63) : (u & 3), g = latq ? ((u >> 6) & 1) : ((u >> 2) & 1), b = latq ? (u >> 7) : (u >> 3);
        const int tq0 = qb * 64, hq = 4 * g + (F.wave >> 1), tq = tq0 + 32 * (F.wave & 1) + r32;
        const int qrow = latq ? b * T + tq : RL + b * TC + tq;
        const int qcol = (winm ? C_QW : C_QB) + hq * 64, kcol = (winm ? C_KW : C_KB) + g * 64, vcol = (winm ? C_VW : C_VB) + g * 64;
        int lt_lo = 0, lt_hi = 0;
        if (MODE == 0) { lt_lo = 0; lt_hi = T / 64; }
        if (MODE == 1) { lt_lo = (tq0 - 128 < 0 ? 0 : tq0 - 128) / 64; lt_hi = (tq0 + 192 > T ? T : tq0 + 192) / 64; }
        const int ntiles = 4 + (lt_hi - lt_lo), npairs = (ntiles + 1) >> 1;
        bf16x8 qr[4];
        {
            float x[4][8];
#pragma unroll
            for (int d0 = 0; d0 < 4; ++d0) { const u32x4 wq = *(const u32x4*)(U + (size_t)qrow * NIN + qcol + d0 * 16 + hi * 8);
                x[d0][0] = lo16(wq.x); x[d0][1] = hi16(wq.x); x[d0][2] = lo16(wq.y); x[d0][3] = hi16(wq.y); x[d0][4] = lo16(wq.z); x[d0][5] = hi16(wq.z); x[d0][6] = lo16(wq.w); x[d0][7] = hi16(wq.w); }
            if (!winm) { float ss = 0.f;
#pragma unroll
                for (int d0 = 0; d0 < 4; ++d0)
#pragma unroll
                    for (int j = 0; j < 8; ++j) ss += x[d0][j] * x[d0][j];
                ss += shfl_xor_l(ss, 32, lane);
                const float rstd = 1.0f / sqrtf(ss * (1.0f / 64.0f) + EPS);
#pragma unroll
                for (int d0 = 0; d0 < 4; ++d0) { const f32x4 ga = *(const f32x4*)(P.q_gain + l * 64 + d0 * 16 + hi * 8), gb = *(const f32x4*)(P.q_gain + l * 64 + d0 * 16 + hi * 8 + 4);
                    x[d0][0] *= rstd * ga.x; x[d0][1] *= rstd * ga.y; x[d0][2] *= rstd * ga.z; x[d0][3] *= rstd * ga.w; x[d0][4] *= rstd * gb.x; x[d0][5] *= rstd * gb.y; x[d0][6] *= rstd * gb.z; x[d0][7] *= rstd * gb.w; } }
            if (latq) { const float* rc = (const float*)(P.ws + WS_ROPE); const float* rs = rc + 1024;
#pragma unroll
                for (int a = 0; a < 2; ++a) { const int pos = a ? (tq & 63) : (tq >> 6);
                    const f32x4 c0 = *(const f32x4*)(rc + pos * 16 + hi * 8), c1 = *(const f32x4*)(rc + pos * 16 + hi * 8 + 4), s0 = *(const f32x4*)(rs + pos * 16 + hi * 8), s1 = *(const f32x4*)(rs + pos * 16 + hi * 8 + 4);
                    const float cs[8] = {c0.x, c0.y, c0.z, c0.w, c1.x, c1.y, c1.z, c1.w}, sn[8] = {s0.x, s0.y, s0.z, s0.w, s1.x, s1.y, s1.z, s1.w};
#pragma unroll
                    for (int j = 0; j < 8; ++j) { const float x1 = x[2 * a][j], x2 = x[2 * a + 1][j]; x[2 * a][j] = x1 * cs[j] - x2 * sn[j]; x[2 * a + 1][j] = x2 * cs[j] + x1 * sn[j]; } } }
#pragma unroll
            for (int d0 = 0; d0 < 4; ++d0) { u32x4 wq; wq.x = cvtpk(x[d0][0] * QSCALE, x[d0][1] * QSCALE); wq.y = cvtpk(x[d0][2] * QSCALE, x[d0][3] * QSCALE); wq.z = cvtpk(x[d0][4] * QSCALE, x[d0][5] * QSCALE); wq.w = cvtpk(x[d0][6] * QSCALE, x[d0][7] * QSCALE);
                qr[d0] = __builtin_bit_cast(bf16x8, wq); }
        }
        f32x16 o0, o1, negm;
#pragma unroll
        for (int r = 0; r < 16; ++r) { o0[r] = 0.f; o1[r] = 0.f; negm[r] = 0.f; }
        float mhat = 0.f, lsum = 0.f;
#define AT_KROW(ti) ((ti) < 4 ? RL + b * TC + (ti) * 64 : b * T + (lt_lo + (ti) - 4) * 64)
        u32x4 ka, va, kb2, vb2;
        { const int r0 = AT_KROW(0) + (tid >> 3), r1 = AT_KROW(1) + (tid >> 3); const int co = (tid & 7) * 8;
          ka = *(const u32x4*)(U + (size_t)r0 * NIN + kcol + co); va = *(const u32x4*)(U + (size_t)r0 * NIN + vcol + co);
          kb2 = *(const u32x4*)(U + (size_t)r1 * NIN + kcol + co); vb2 = *(const u32x4*)(U + (size_t)r1 * NIN + vcol + co);
          *(LAS u32x4*)(Lb + st_off) = ka; *(LAS u32x4*)(Lb + AT_TILEB + st_off) = kb2; *(LAS u32x4*)(Lb + 2 * AT_TILEB + sv_off) = va; *(LAS u32x4*)(Lb + 2 * AT_TILEB + AT_VTILEB + sv_off) = vb2; }
        __syncthreads();
        for (int tp = 0; tp < npairs; ++tp) {
            const int cur = (tp & 1) * AT_STAGEB, nxt = AT_STAGEB - cur;
            const bool more = tp + 1 < npairs;
            const int ta = 2 * tp, tb = 2 * tp + 1; const bool hasb = tb < ntiles;
            if (more) { const int na = 2 * tp + 2, nb = (2 * tp + 3 < ntiles) ? 2 * tp + 3 : na;
                const int r0 = AT_KROW(na) + (tid >> 3), r1 = AT_KROW(nb) + (tid >> 3); const int co = (tid & 7) * 8;
                ka = *(const u32x4*)(U + (size_t)r0 * NIN + kcol + co); va = *(const u32x4*)(U + (size_t)r0 * NIN + vcol + co);
                kb2 = *(const u32x4*)(U + (size_t)r1 * NIN + kcol + co); vb2 = *(const u32x4*)(U + (size_t)r1 * NIN + vcol + co); }
            f32x16 pa0, pa1, pb0, pb1;
            at_qk2(Lb + cur, Lb + cur + AT_TILEB, kf_off, qr, negm, pa0, pa1, pb0, pb1);
            if (MODE == 1) {
                const int qlo = tq0 + 32 * (F.wave & 1);
                if (ta >= 4) { const int kb0 = (lt_lo + ta - 4) * 64;
                    if (kb0 + 63 - qlo > 128 || qlo + 31 - kb0 > 128) { const int kp0 = kb0 + 4 * hi - tq;
#pragma unroll
                        for (int r = 0; r < 16; ++r) { const int dl = kp0 + (r & 3) + 8 * (r >> 2);
                            if (dl > 128 || dl < -128) pa0[r] = -INFINITY;
                            if (dl + 32 > 128 || dl + 32 < -128) pa1[r] = -INFINITY; } } }
                if (tb >= 4 && hasb) { const int kb0 = (lt_lo + tb - 4) * 64;
                    if (kb0 + 63 - qlo > 128 || qlo + 31 - kb0 > 128) { const int kp0 = kb0 + 4 * hi - tq;
#pragma unroll
                        for (int r = 0; r < 16; ++r) { const int dl = kp0 + (r & 3) + 8 * (r >> 2);
                            if (dl > 128 || dl < -128) pb0[r] = -INFINITY;
                            if (dl + 32 > 128 || dl + 32 < -128) pb1[r] = -INFINITY; } } }
                if (!hasb) {
#pragma unroll
                    for (int r = 0; r < 16; ++r) { pb0[r] = -INFINITY; pb1[r] = -INFINITY; } }
            }
            float mx = fmaxf(fmaxf(pa0[0], pa1[0]), fmaxf(pb0[0], pb1[0]));
#pragma unroll
            for (int r = 1; r < 16; ++r) mx = fmaxf(mx, fmaxf(fmaxf(pa0[r], pa1[r]), fmaxf(pb0[r], pb1[r])));
            mx = fmaxf(mx, shfl_xor_l(mx, 32, lane));
            if (tp == 0 || __any(mx > ATT_THR)) {
                const float dl = tp == 0 ? mx : fmaxf(mx, 0.f);
                mhat += dl;
                const float alpha = __builtin_amdgcn_exp2f(-dl); lsum *= alpha;
#pragma unroll
                for (int r = 0; r < 16; ++r) { pa0[r] -= dl; pa1[r] -= dl; pb0[r] -= dl; pb1[r] -= dl; o0[r] *= alpha; o1[r] *= alpha; negm[r] = -mhat; }
            }
            lsum += at_exp_pv2(Lb + cur + 2 * AT_TILEB, Lb + cur + 2 * AT_TILEB + AT_VTILEB, vf_off, pa0, pa1, pb0, pb1, o0, o1);
            if (more) { *(LAS u32x4*)(Lb + nxt + st_off) = ka; *(LAS u32x4*)(Lb + nxt + AT_TILEB + st_off) = kb2; *(LAS u32x4*)(Lb + nxt + 2 * AT_TILEB + sv_off) = va; *(LAS u32x4*)(Lb + nxt + 2 * AT_TILEB + AT_VTILEB + sv_off) = vb2; }
            __syncthreads();
        }
#undef AT_KROW
        lsum += shfl_xor_l(lsum, 32, lane);
        if (winm) lsum += exp2f(P.sink[l * 8 + hq] * LOG2E - mhat);
        const float inv = 1.0f / lsum;
        bf16_t* op = (bf16_t*)(P.ws + WS_BR) + (size_t)qrow * NBR + (winm ? 1024 : 512) + hq * 64 + 4 * hi;
#pragma unroll
        for (int gq = 0; gq < 4; ++gq) {
            u32x2 w0, w1; w0.x = cvtpk(o0[4 * gq] * inv, o0[4 * gq + 1] * inv); w0.y = cvtpk(o0[4 * gq + 2] * inv, o0[4 * gq + 3] * inv);
            w1.x = cvtpk(o1[4 * gq] * inv, o1[4 * gq + 1] * inv); w1.y = cvtpk(o1[4 * gq + 2] * inv, o1[4 * gq + 3] * inv);
            *(u32x2*)(op + 8 * gq) = w0; *(u32x2*)(op + 32 + 8 * gq) = w1; }
    }
}

constexpr int DF_ROWB = 528;
template <int STAGE> __device__ __forceinline__ void ph_dft(const Frame& F, const Ptrs& P) {
    const int lane = fresh_lane(), tid = F.wave * 64 + lane, r32 = lane & 31, hi = lane >> 5, w = F.wave;
    bf16_t* U = (bf16_t*)(P.ws + WS_U); bf16_t* BR = (bf16_t*)(P.ws + WS_BR); const bf16_t* Wm = (const bf16_t*)(P.ws + WS_DFTM);
    LAS unsigned char* Xl = F.lds;
    const int xf_off = (8 * hi + ((lane & 15) >> 2)) * DF_ROWB + (32 * w + ((lane >> 4) & 1) * 16 + (lane & 3) * 4) * 2;
    constexpr int NMB = STAGE == 2 ? 4 : 2;
    const int seg = tid >> 2, part = tid & 3, pp = seg >> 6, jj = seg & 63;
    u32x4 pf[8];
    if (F.vcu < 1024) { const int u = F.vcu; const int chb = u & 1, sidx = (u >> 1) & 63, b = u >> 7;
        const int grow = STAGE == 2 ? b * T + 64 * jj + sidx : b * T + 64 * sidx + jj;
        const u32x4* src = (const u32x4*)(U + (size_t)grow * NIN + pp * 512 + chb * 256 + part * 64);
#pragma unroll
        for (int i = 0; i < 8; ++i) pf[i] = src[i]; }
    for (int u = F.vcu; u < 1024; u += F.G) {
        const int chb = u & 1, sidx = (u >> 1) & 63, b = u >> 7;
#pragma unroll
        for (int i = 0; i < 8; ++i) *(LAS u32x4*)(Xl + seg * DF_ROWB + part * 128 + i * 16) = pf[i];
        if (u + F.G < 1024) { const int un = u + F.G; const int chbn = un & 1, sn = (un >> 1) & 63, bn = un >> 7;
            const int grow = STAGE == 2 ? bn * T + 64 * jj + sn : bn * T + 64 * sn + jj;
            const u32x4* src = (const u32x4*)(U + (size_t)grow * NIN + pp * 512 + chbn * 256 + part * 64);
#pragma unroll
            for (int i = 0; i < 8; ++i) pf[i] = src[i]; }
        __syncthreads();
        f32x16 acc[NMB];
#pragma unroll
        for (int mb = 0; mb < NMB; ++mb)
#pragma unroll
            for (int r = 0; r < 16; ++r) acc[mb][r] = 0.f;
#pragma unroll
        for (int ks = 0; ks < 8; ++ks) {
            const v4i16_t lo4 = __builtin_amdgcn_ds_read_tr16_b64_v4i16((LAS v4i16_t*)(Xl + xf_off + (16 * ks) * DF_ROWB));
            const v4i16_t hi4 = __builtin_amdgcn_ds_read_tr16_b64_v4i16((LAS v4i16_t*)(Xl + xf_off + (16 * ks + 4) * DF_ROWB));
            const bf16x8 xf = (bf16x8){lo4[0], lo4[1], lo4[2], lo4[3], hi4[0], hi4[1], hi4[2], hi4[3]};
#pragma unroll
            for (int mb = 0; mb < NMB; ++mb) { const bf16x8 wf = *(const bf16x8*)(Wm + (mb * 32 + r32) * 128 + 16 * ks + 8 * hi);
                acc[mb] = __builtin_amdgcn_mfma_f32_32x32x16_bf16(xf, wf, acc[mb], 0, 0, 0); }
        }
        LAS unsigned char* ob = Xl + (32 * w + 4 * hi) * 2;
        if (STAGE == 2) {
#pragma unroll
            for (int mb = 0; mb < 2; ++mb) { const int k1 = mb * 32 + r32; const float rev = (float)((k1 * sidx) & 4095) * (1.0f / 4096.0f);
                const float ct = __builtin_amdgcn_cosf(rev), st = __builtin_amdgcn_sinf(rev);
#pragma unroll
                for (int gq = 0; gq < 4; ++gq) { u32x2 wr, wi; float yr[4], yi[4];
#pragma unroll
                    for (int i = 0; i < 4; ++i) { const float a = acc[mb][4 * gq + i], bq = acc[mb + 2][4 * gq + i]; yr[i] = a * ct + bq * st; yi[i] = bq * ct - a * st; }
                    wr.x = cvtpk(yr[0], yr[1]); wr.y = cvtpk(yr[2], yr[3]); wi.x = cvtpk(yi[0], yi[1]); wi.y = cvtpk(yi[2], yi[3]);
                    *(LAS u32x2*)(ob + k1 * DF_ROWB + 16 * gq) = wr; *(LAS u32x2*)(ob + (64 + k1) * DF_ROWB + 16 * gq) = wi; } }
        } else {
#pragma unroll
            for (int mb = 0; mb < 2; ++mb) { const int k2 = mb * 32 + r32;
#pragma unroll
                for (int gq = 0; gq < 4; ++gq) { u32x2 wr; wr.x = cvtpk(acc[mb][4 * gq] * 0.015625f, acc[mb][4 * gq + 1] * 0.015625f); wr.y = cvtpk(acc[mb][4 * gq + 2] * 0.015625f, acc[mb][4 * gq + 3] * 0.015625f);
                    *(LAS u32x2*)(ob + k2 * DF_ROWB + 16 * gq) = wr; } }
        }
        __syncthreads();
        if (STAGE == 2) {
            u32x4* dst = (u32x4*)(U + (size_t)(b * T + 64 * jj + sidx) * NIN + pp * 512 + chb * 256 + part * 64);
#pragma unroll
            for (int i = 0; i < 8; ++i) dst[i] = *(const LAS u32x4*)(Xl + seg * DF_ROWB + part * 128 + i * 16);
        } else { const int k2 = tid >> 3, part8 = tid & 7;
            u32x4* dst = (u32x4*)(BR + (size_t)(b * T + 64 * k2 + sidx) * NBR + chb * 256 + part8 * 32);
#pragma unroll
            for (int i = 0; i < 4; ++i) dst[i] = *(const LAS u32x4*)(Xl + k2 * DF_ROWB + part8 * 64 + i * 16); }
        __syncthreads();
    }
}

struct MegaArgs { Ptrs P; int ph_lo, ph_hi, li, pad; };
__global__ void __launch_bounds__(NWAVES * 64, 2) mega(MegaArgs args) {
    extern __shared__ __attribute__((aligned(16))) unsigned char lds_raw[];
    Frame F; F.lds = (LAS unsigned char*)lds_raw;
    F.wave = __builtin_amdgcn_readfirstlane(threadIdx.x >> 6);
    F.G = gridDim.x; { const int bx = blockIdx.x; F.vcu = (F.G % 8 == 0) ? (bx % 8) * (F.G / 8) + bx / 8 : bx; }
    const Ptrs& P = args.P;
    for (int u = fresh_tid(); u < (LDS_BYTES - LDSCTL_OFF) / 4; u += NWAVES * 64) ((LAS unsigned*)(F.lds + LDSCTL_OFF))[u] = 0u;
    __syncthreads();
    volatile LAS unsigned* MISC = (volatile LAS unsigned*)(F.lds + MISC_OFF);
    XcdBarrier bar = xcd_barrier_post((unsigned*)(P.ws + WS_CTL) + CW_BAR + args.li * XCD_BAR_WORDS, MISC + 8, F.wave);
    const int lo = args.ph_lo, hi = args.ph_hi;
    unsigned char* ws = P.ws;
    bf16_t* H = (bf16_t*)(ws + WS_H); bf16_t* U = (bf16_t*)(ws + WS_U); bf16_t* BR = (bf16_t*)(ws + WS_BR);
    bf16_t* MG = (bf16_t*)(ws + WS_MG); bf16_t* AS = (bf16_t*)(ws + WS_AS); bf16_t* HID = (bf16_t*)(ws + WS_HID); bf16_t* MO = (bf16_t*)(ws + WS_MO);
    const bf16_t* Bt_in = (const bf16_t*)(ws + WS_WB + WB_IN); const bf16_t* Bt_gate = (const bf16_t*)(ws + WS_WB + WB_GATE); const bf16_t* Bt_br = (const bf16_t*)(ws + WS_WB + WB_BR);
    const bf16_t* Bt_out = (const bf16_t*)(ws + WS_WB + WB_OUT); const bf16_t* Bt_13 = (const bf16_t*)(ws + WS_WB + WB_13); const bf16_t* Bt_2 = (const bf16_t*)(ws + WS_WB + WB_2);
#define IN(g) (lo <= (g) && (g) < hi)
#define SEAM(g) do { if ((g) + 1 < hi) xcd_barrier(bar); } while (0)
    for (int l = 0; l < 2; ++l) {
        const int pb = l * NPH; const int M = l == 0 ? R : RL;
        if (IN(pb + 0)) { if (l == 0) ph_tables_mod(F, P); ph_weights(F, P, l); if (l == 0) SEAM(pb + 0); }
        if (IN(pb + 1)) { if (l == 0) ph_norm<0>(F, P, l, R); else ph_norm<1>(F, P, l, R); SEAM(pb + 1); }
        if (IN(pb + 2)) {
            pg8::StaticOrder S; S.init(R, NIN, F.G, (int)blockIdx.x, H, D, Bt_in, D);
            pg8::EpiV8<FStore8> E{FStore8{U, NIN}};
            pg8::gemm_phase(F.lds, F.wave, D, D, D, S, E);
            SEAM(pb + 2);
        }
        if (IN(pb + 3)) { ph_kprep(F, P, l); ph_pool(F, P, M); SEAM(pb + 3); }
        if (IN(pb + 4)) {
            ph_dft<2>(F, P); ph_attn<1>(F, P, l);
            if (l == 0) { ph_attn<2>(F, P, l); ph_attn<3>(F, P, l); ph_fourier_ref(F, P, TC, 0); }
            xcd_barrier(bar);
            ph_dft<3>(F, P); ph_attn<0>(F, P, l);
            SEAM(pb + 4);
        }
        if (IN(pb + 5)) {
            pg8::StaticOrder S; S.init(M, 4096, F.G, (int)blockIdx.x, H, D, Bt_gate, D);
            pg8::EpiV8<FGateU8> E{FGateU8{(unsigned char*)(ws + WS_GT), P.b_gate + (size_t)l * 4096}};
            pg8::gemm_phase(F.lds, F.wave, D, D, D, S, E);
            SEAM(pb + 5);
        }
        if (IN(pb + 6)) {
            pg8::StaticOrder S; S.init(M, D, F.G, (int)blockIdx.x, BR, NBR, Bt_br, NBR);
            pg8::EpiMergeS E{(const unsigned char*)(ws + WS_GT), MG};
            pg8::gemm_phase(F.lds, F.wave, NBR, NBR, NBR, S, E);
            xcd_barrier(bar);
        }
        if (IN(pb + 10)) {
            pg8::StaticOrder S; S.init(M, D, F.G, (int)blockIdx.x, MG, D, Bt_out, D);
            pg8::EpiV4<FOut> E{FOut{P, l}};
            pg8::gemm_phase(F.lds, F.wave, D, D, D, S, E);
            SEAM(pb + 10);
        }
        if (IN(pb + 11)) { ph_norm<2>(F, P, l, M); xcd_barrier(bar); }
        if (IN(pb + 13) || IN(pb + 14)) {
            LAS int* ptab = (LAS int*)(F.lds + LDSCTL_OFF);
            if (fresh_tid() == 0) { const unsigned* cnt = (const unsigned*)(ws + WS_CTL) + CW_CNT + 1024 * l; int off = 0;
                for (int e = 0; e < 16; ++e) { const int c = (int)cnt[64 * e]; ptab[e] = off; ptab[17 + e] = c; off += (c + 255) >> 8; } ptab[16] = off; }
            __syncthreads();
            if (IN(pb + 13)) {
                pg8::MoeOrder<true> S; S.nN = 4; S.G = F.G; S.c = (int)blockIdx.x; S.A = (const char*)H; S.Bt = (const char*)Bt_13; S.astep = 0; S.bstep = (size_t)256 * D * 2; S.bexp = (size_t)1024 * 1024 * 2; S.tab = (const int*)ptab; S.tokl = (const int*)(ws + WS_TOKL);
                pg8::EpiDual<FMoe1> E{FMoe1{HID}};
                pg8::gemm_phase(F.lds, F.wave, D, D, D, S, E);
                SEAM(pb + 13);
            }
            if (IN(pb + 14)) {
                pg8::MoeOrder<false> S; S.nN = 4; S.G = F.G; S.c = (int)blockIdx.x; S.A = (const char*)HID; S.Bt = (const char*)Bt_2; S.astep = (size_t)256 * FF * 2; S.bstep = (size_t)256 * FF * 2; S.bexp = (size_t)1024 * 512 * 2; S.tab = (const int*)ptab; S.tokl = nullptr;
                pg8::EpiV8<FMoe2> E{FMoe2{MO, (const int*)(ws + WS_TOKL), (const float*)(ws + WS_WL)}};
                pg8::gemm_phase(F.lds, F.wave, FF, FF, FF, S, E);
                SEAM(pb + 14);
            }
        }
    }
    if (IN(PH_FINAL)) ph_final(F, P);
#undef IN
#undef SEAM
}

extern "C" void kernel_launch(void* const* d_in, const int* in_sizes, int n_in, void* d_out, int out_size, void* d_ws, size_t ws_size, hipStream_t stream) {
    if (n_in != 24 || ws_size < WS_END || out_size != RL * D) { fprintf(stderr, "kernel_launch: unexpected sizes n_in %d ws %zu out %d\n", n_in, ws_size, out_size); return; }
    static int grid = 0;
    if (grid == 0) {
        int dev = 0, cus = 0;
        if (hipGetDevice(&dev) != hipSuccess || hipDeviceGetAttribute(&cus, hipDeviceAttributeMultiprocessorCount, dev) != hipSuccess) { grid = -1; return; }
        if (hipFuncSetAttribute((const void*)mega, hipFuncAttributeMaxDynamicSharedMemorySize, LDS_BYTES) != hipSuccess) { fprintf(stderr, "kernel_launch: hipFuncSetAttribute failed\n"); grid = -1; return; }
        int per_cu = 0;
        if (hipOccupancyMaxActiveBlocksPerMultiprocessor(&per_cu, (const void*)mega, NWAVES * 64, LDS_BYTES) != hipSuccess || per_cu < 1) fprintf(stderr, "kernel_launch: occupancy query says %d\n", per_cu);
        (void)hipGetLastError();
        grid = cus;
    }
    if (grid < 0) return;
    MegaArgs a{};
    const float** pp = (const float**)&a.P;
    for (int i = 0; i < 24; ++i) pp[i] = (const float*)d_in[i];
    a.P.out = (float*)d_out; a.P.ws = (unsigned char*)d_ws;
    (void)hipMemsetAsync((unsigned char*)d_ws + WS_CTL, 0, 1 * MiB, stream);
    a.ph_lo = 0; a.ph_hi = PH_FINAL + 1; a.li = 0;
    hipLaunchKernelGGL(mega, dim3(grid), dim3(NWAVES * 64), LDS_BYTES, stream, a);
}
```

```cpp
#include <hip/hip_runtime.h>
#include <cstdio>
#include <cstdint>

typedef unsigned short bf16_t;
typedef short bf16x8 __attribute__((ext_vector_type(8)));
typedef float f32x4 __attribute__((ext_vector_type(4)));
typedef unsigned u32x4 __attribute__((ext_vector_type(4)));
typedef unsigned u32x2 __attribute__((ext_vector_type(2)));

constexpr int D = 1024, NB = 8, T = 4096, TC = 256;
constexpr int RL = NB * T, RC = NB * TC, R = RL + RC;
constexpr int NIN = 3072;
constexpr int C_ZR = 0, C_ZI = 512, C_P = 1024, C_QB = 1536, C_KB = 2048, C_VB = 2176, C_QW = 2304, C_KW = 2816, C_VW = 2944;
constexpr int NBR = 2048;
constexpr int NE = 16, FF = 512;
constexpr int MAXROWS = 73728;
constexpr float EPS = 1e-6f;
constexpr float QSCALE = 0.125f * 1.4426950408889634f;
constexpr float LOG2E = 1.4426950408889634f;

constexpr size_t MiB = 1u << 20;
constexpr size_t WS_CTL = 0;
constexpr size_t WS_MOD = 1 * MiB;
constexpr size_t WS_ROPE = 1 * MiB + 512 * 1024;
constexpr size_t WS_COS = WS_ROPE + 16 * 1024;
constexpr size_t WS_DFTM = WS_ROPE + 64 * 1024;
constexpr size_t WS_TOKL = 2 * MiB;
constexpr size_t WS_WL = 4 * MiB + 512 * 1024;
constexpr size_t WS_XC = 9 * MiB;
constexpr size_t WS_WB = 17 * MiB;
constexpr size_t WB_IN = 0, WB_GATE = 6 * MiB, WB_BR = 14 * MiB, WB_OUT = 18 * MiB, WB_13 = 20 * MiB, WB_2 = 52 * MiB;
constexpr size_t WS_H = 85 * MiB;
constexpr size_t WS_ARENA = 153 * MiB;
constexpr size_t WS_U = WS_ARENA;
constexpr size_t WS_BR = WS_ARENA + 204 * MiB;
constexpr size_t WS_GT = WS_ARENA;
constexpr size_t WS_MG = WS_ARENA + 136 * MiB;
constexpr size_t WS_AS = WS_ARENA;
constexpr size_t WS_HID = WS_ARENA + 144 * MiB;
constexpr size_t WS_MO = WS_ARENA + 216 * MiB;
constexpr size_t WS_END = 512 * MiB;
static_assert(WS_BR + (size_t)R * NBR * 2 <= WS_END && WS_MO + (size_t)2 * R * D * 2 <= WS_END && WS_MG + (size_t)R * D * 2 <= WS_BR, "ws map");
constexpr int CW_CNT = 8192;

__device__ __forceinline__ float bf2f(bf16_t b) { return __uint_as_float(((unsigned)b) << 16); }
__device__ __forceinline__ unsigned f2bf(float f) { unsigned u = __float_as_uint(f); return (u + 0x7fffu + ((u >> 16) & 1u)) >> 16; }
__device__ __forceinline__ unsigned pk2(float lo, float hi) { return f2bf(lo) | (f2bf(hi) << 16); }
typedef __bf16 bf16x2_t __attribute__((ext_vector_type(2)));
typedef float f32x2_t __attribute__((ext_vector_type(2)));
__device__ __forceinline__ unsigned cvtpk(float lo, float hi) { f32x2_t v = {lo, hi}; bf16x2_t b = __builtin_convertvector(v, bf16x2_t); return __builtin_bit_cast(unsigned, b); }
__device__ __forceinline__ float lo16(unsigned w) { return __uint_as_float(w << 16); }
__device__ __forceinline__ float hi16(unsigned w) { return __uint_as_float(w & 0xffff0000u); }
__device__ __forceinline__ float shfl_xor_l(float v, int o, int lane) { return __int_as_float(__builtin_amdgcn_ds_bpermute((lane ^ o) << 2, __float_as_int(v))); }
__device__ __forceinline__ float wave_sum_l(float v, int lane) {
#pragma unroll
    for (int o = 1; o < 64; o <<= 1) v += shfl_xor_l(v, o, lane);
    return v;
}
__device__ __forceinline__ int row_bb(int r) { return r < RL ? (r >> 12) : 8; }

struct Ptrs {
    const float *x, *c, *ctx, *c_ctx, *w_ada, *b_ada, *norm1, *norm2, *w_in, *q_gain, *k_gain, *sink, *pool_w, *pool_scale,
        *w_branch, *w_gate, *b_gate, *w_out, *router_w, *router_bias, *w1, *w3, *w2, *norm_f;
    float* out; unsigned char* ws;
};
__device__ __forceinline__ const float* xin_row(const Ptrs& P, int r) { return r < RL ? P.x + (size_t)r * D : P.ctx + (size_t)(r - RL) * D; }
__device__ __forceinline__ float* x1_row(const Ptrs& P, int r) { return r < RL ? P.out + (size_t)r * D : (float*)(P.ws + WS_XC) + (size_t)(r - RL) * D; }
__device__ __forceinline__ const float* mod_vec(const Ptrs& P, int l, int bb, int which) { return (const float*)(P.ws + WS_MOD) + ((size_t)(l * 9 + bb) * 6 + which) * D; }

struct EpiOut { Ptrs P; int l;
    __device__ __forceinline__ void operator()(int row, int col, f32x4 v) const { const int bb = row_bb(row);
        const f32x4 g = *(const f32x4*)(mod_vec(P, l, bb, 2) + col); float* xo = x1_row(P, row) + col;
        const f32x4 xp = l == 0 ? *(const f32x4*)(xin_row(P, row) + col) : *(const f32x4*)xo;
        *(f32x4*)xo = xp + g * v; } };

#define LAS __attribute__((address_space(3)))
#define GAS __attribute__((address_space(1)))
#define LDS_WAIT() asm volatile("s_waitcnt lgkmcnt(0)" ::: "memory")
__device__ __forceinline__ int fresh_lane() { int l; asm volatile("v_mbcnt_lo_u32_b32 %0, -1, 0\n\tv_mbcnt_hi_u32_b32 %0, -1, %0" : "=v"(l)); return l; }
constexpr int NWAVES = 8;
constexpr int RING_BYTES = 131072, LDSCTL_OFF = RING_BYTES, MISC_OFF = LDSCTL_OFF + 320, LDS_BYTES = 147456;
constexpr int CW_BAR = 16384;
constexpr int NPH = 15, PH_FINAL = 2 * NPH;

#define XB_TMO      128
#define XB_XCNT(j)  (256  + 64 * (j))
#define XB_XSUB(j)  (1280 + 64 * (j))
#define XB_XGEN(j)  (2304 + 64 * (j))
#define XB_TOP      3328
#define XB_TOPGEN   3392
#define XCD_BAR_WORDS 3456
#define XB_SPIN_CAP (1u << 21)
__device__ __forceinline__ unsigned xb_ld(unsigned* p)              { return __hip_atomic_load(p, __ATOMIC_RELAXED, __HIP_MEMORY_SCOPE_AGENT); }
__device__ __forceinline__ unsigned xb_add(unsigned* p, unsigned v) { return __hip_atomic_fetch_add(p, v, __ATOMIC_RELAXED, __HIP_MEMORY_SCOPE_AGENT); }
__device__ __forceinline__ unsigned xb_xcc_id() { return (unsigned)__builtin_amdgcn_s_getreg((3 << 11) | 20) & 0xFu; }
#define XB_SPIN(cond, bar) do { unsigned _sp = 0; while (cond) { __builtin_amdgcn_s_sleep(1); \
    if ((++_sp & 255u) == 0u) { if (xb_ld(&(bar)[XB_TMO])) break; if (_sp > XB_SPIN_CAP) { atomicAdd(&(bar)[XB_TMO], 1u); break; } } } } while (0)
struct XcdBarrier { unsigned* bar; unsigned x; volatile LAS unsigned* st; int wave; };
__device__ __forceinline__ XcdBarrier xcd_barrier_post(unsigned* bar, volatile LAS unsigned* st, int wave) {
    XcdBarrier b; b.bar = bar; b.x = xb_xcc_id(); b.st = st; b.wave = wave;
    if (wave == 0 && fresh_lane() == 0) (void)xb_add(&bar[XB_XCNT(b.x)], 1u);
    return b;
}
__device__ __forceinline__ void xcd_barrier_complete(unsigned* bar, unsigned x, unsigned& nloc, unsigned& nx) {
    const unsigned G = gridDim.x * gridDim.y * gridDim.z;
    unsigned sum, cnt, mine, sp = 0u;
    for (;;) {
        sum = 0u; cnt = 0u; mine = 0u;
#pragma unroll
        for (unsigned j = 0; j < 16; ++j) { const unsigned c = xb_ld(&bar[XB_XCNT(j)]); sum += c; cnt += (c > 0u) ? 1u : 0u; mine = (j == x) ? c : mine; }
        if (sum == G) break;
        __builtin_amdgcn_s_sleep(1);
        if ((++sp & 255u) == 0u) { if (xb_ld(&bar[XB_TMO])) break; if (sp > XB_SPIN_CAP) { atomicAdd(&bar[XB_TMO], 1u); break; } }
    }
    nloc = mine > 0u ? mine : 1u; nx = cnt > 0u ? cnt : 1u;
}
__device__ __forceinline__ void xcd_barrier(const XcdBarrier& b) {
    asm volatile("s_waitcnt vmcnt(0)" ::: "memory");
    __syncthreads();
    if (b.wave == 0 && fresh_lane() == 0) {
        unsigned* bar = b.bar;
        __builtin_amdgcn_s_waitcnt(0);
        unsigned nloc = b.st[0], nx = b.st[1];
        if (nloc == 0u) { xcd_barrier_complete(bar, b.x, nloc, nx); b.st[0] = nloc; b.st[1] = nx; }
        const unsigned old = xb_add(&bar[XB_XSUB(b.x)], 1u);
        const unsigned gen = old / nloc;
        if (old + 1u == (gen + 1u) * nloc) {
            __builtin_amdgcn_fence(__ATOMIC_RELEASE, "agent");
            asm volatile("s_waitcnt vmcnt(0)" ::: "memory");
            const unsigned og = xb_add(&bar[XB_TOP], 1u);
            const unsigned tg = og / nx;
            if (og + 1u == (tg + 1u) * nx) xb_add(&bar[XB_TOPGEN], 1u);
            else XB_SPIN(xb_ld(&bar[XB_TOPGEN]) == tg, bar);
            __builtin_amdgcn_fence(__ATOMIC_ACQUIRE, "agent");
            xb_add(&bar[XB_XGEN(b.x)], 1u);
            asm volatile("s_waitcnt vmcnt(0)" ::: "memory");
        } else {
            XB_SPIN(xb_ld(&bar[XB_XGEN(b.x)]) == gen, bar);
            __builtin_amdgcn_fence(__ATOMIC_ACQUIRE, "agent");
            asm volatile("s_waitcnt vmcnt(0)" ::: "memory");
        }
    }
    __syncthreads();
}

namespace pg8 {
constexpr int BM = 256, BK = 64, HALF = 128, HTB = HALF * BK * 2, STAGE_BYTES = 8 * HTB, NXCD = 8, WGM = 8;
__host__ __device__ __forceinline__ int lds_byte(int r, int c) { const int st = (r >> 4) * 2 + (c >> 5), rr = r & 15, cc = c & 31, ob = rr * 64 + cc * 2; return st * 1024 + (ob ^ (((ob >> 9) & 1) << 5)); }
__host__ __device__ __forceinline__ void stage_rc(int b, int& Rr, int& C) { const int st = b / 1024, sb = b % 1024, swz = sb ^ (((sb >> 9) & 1) << 5); Rr = (st >> 1) * 16 + swz / 64; C = (st & 1) * 32 + (swz % 64) / 2; }
__host__ __device__ __forceinline__ int perm32(int rho) { const int n = rho >> 4, i = rho & 15; return 8 * (i >> 2) + 4 * n + (i & 3); }
struct Unit { int pm, pn; const char* a; const char* b; int e, p0, ce; };

struct StaticOrder {
    static constexpr bool GATHER = false;
    int nM, nN, nwg, G, c; const char* A; const char* Bt; size_t astep, bstep;
    __device__ void init(int M, int N, int G_, int c_, const bf16_t* A_, int lda, const bf16_t* Bt_, int ldb) { nM = M / BM; nN = N / BM; nwg = nM * nN; G = G_; c = c_; A = (const char*)A_; Bt = (const char*)Bt_; astep = (size_t)BM * lda * 2; bstep = (size_t)BM * ldb * 2; }
    __device__ bool next(int i, Unit& u) const {
        const long L = (long)i * G + c; if (L >= nwg) return false;
        int wgid = (int)L; { const int q = nwg / NXCD, r = nwg % NXCD, xcd = wgid % NXCD, off = wgid / NXCD; wgid = (xcd < r ? xcd * (q + 1) : r * (q + 1) + (xcd - r) * q) + off; }
        const int nig = WGM * nN, gid = wgid / nig, fm = gid * WGM, gsz = (nM - fm) < WGM ? (nM - fm) : WGM;
        u.pm = fm + ((wgid % nig) % gsz); u.pn = (wgid % nig) / gsz; u.a = A + (size_t)u.pm * astep; u.b = Bt + (size_t)u.pn * bstep; u.e = 0; u.p0 = 0; u.ce = 0; return true;
    }
};
template <bool GATHER_> struct MoeOrder {
    static constexpr bool GATHER = GATHER_;
    int nN, G, c; const char* A; const char* Bt; size_t astep, bstep, bexp; const int* tab; const int* tokl;
    __device__ bool next(int i, Unit& u) const {
        const int L = i * G + c; const int total = tab[16] * nN; if (L >= total) return false;
        u.pm = L / nN; u.pn = L % nN; int e = 0;
#pragma unroll
        for (int q = 1; q < 16; ++q) e += (u.pm >= tab[q]) ? 1 : 0;
        u.e = e; u.p0 = (u.pm - tab[e]) * BM; u.ce = tab[17 + e];
        u.a = GATHER_ ? A : A + (size_t)u.pm * astep; u.b = Bt + (size_t)e * bexp + (size_t)u.pn * bstep; return true;
    }
    __device__ __forceinline__ void aoffs(const Unit& u, const int (&Rr)[2], const int (&Cc)[2], int lda, unsigned (&off)[2][2]) const {
#pragma unroll
        for (int h = 0; h < 2; ++h)
#pragma unroll
            for (int i = 0; i < 2; ++i) { const int pos = u.p0 + h * HALF + Rr[i]; const int tok = pos < u.ce ? (tokl[(size_t)u.e * R + pos] >> 1) : 0; off[h][i] = (unsigned)(tok * lda + Cc[i]) * 2u; }
    }
};

template <class Epi, class Sched, bool ALIGN_EPI = true>
__device__ __forceinline__ void gemm_phase(LAS unsigned char* lds, const int wid, const int lda, const int ldb, const int K, const Sched& S, const Epi& E) {
    const int lane = fresh_lane(), tid = wid * 64 + lane, wr = wid >> 2, wc = wid & 3, fr = lane & 15, fq = lane >> 4;
    const int nt = K / BK;
    unsigned voffA[2], voffB[2]; int Rr2[2], Cc2[2];
#pragma unroll
    for (int i = 0; i < 2; ++i) { int Rr, C; stage_rc(tid * 16 + i * 8192, Rr, C); const int Rb = Epi::PERM ? ((Rr & ~31) + perm32(Rr & 31)) : Rr; Rr2[i] = Rr; Cc2[i] = C;
        voffA[i] = (unsigned)(Rr * lda + C) * 2u; voffB[i] = (unsigned)(Rb * ldb + C) * 2u; }
    const size_t kstep = (size_t)(BK * 2);
    const size_t hstepA = Sched::GATHER ? 0 : (size_t)HALF * lda * 2, hstepB = (size_t)HALF * ldb * 2;
    const unsigned ldsw = (unsigned)wid * 1024u;
    const int aoff = lds_byte(wr * 64 + fr, fq * 8), boff = lds_byte(wc * 32 + fr, fq * 8);
#define PG8_SA(b, h) (((b) * 2 + (h)) * HTB)
#define PG8_SB(b, h) ((4 + (b) * 2 + (h)) * HTB)
#define PG8_STAGE(bufoff, gbase, voff) do { _Pragma("unroll") for (int _i = 0; _i < 2; ++_i) \
        __builtin_amdgcn_global_load_lds((const unsigned*)((const char*)(gbase) + (voff)[_i]), (LAS unsigned*)(lds + (bufoff) + ldsw + _i * 8192), 16, 0, 0); } while (0)
#define PG8_STAGE_A(b, h, kp, OFFS) do { if constexpr (Sched::GATHER) { PG8_STAGE(PG8_SA(b, h), kp, OFFS[h]); } else { PG8_STAGE(PG8_SA(b, h), (kp) + (h) * hstepA, voffA); } } while (0)
#define PG8_LDA(dst, b, h) do { _Pragma("unroll") for (int m = 0; m < 4; ++m) _Pragma("unroll") for (int k = 0; k < 2; ++k) dst[m][k] = *(const LAS bf16x8*)(lds + PG8_SA(b, h) + aoff + m * 2048 + k * 1024); } while (0)
#define PG8_LDB(dst, b, h) do { _Pragma("unroll") for (int n = 0; n < 2; ++n) _Pragma("unroll") for (int k = 0; k < 2; ++k) dst[n][k] = *(const LAS bf16x8*)(lds + PG8_SB(b, h) + boff + n * 2048 + k * 1024); } while (0)
#define PG8_MMA(ai, bj, At, Bt) do { __builtin_amdgcn_s_setprio(1); _Pragma("unroll") for (int m = 0; m < 4; ++m) _Pragma("unroll") for (int n = 0; n < 2; ++n) _Pragma("unroll") for (int k = 0; k < 2; ++k) \
        acc[ai][bj][m][n] = __builtin_amdgcn_mfma_f32_16x16x32_bf16(Bt[n][k], At[m][k], acc[ai][bj][m][n], 0, 0, 0); __builtin_amdgcn_s_setprio(0); } while (0)
#define PG8_WAIT_V(n) asm volatile("s_waitcnt vmcnt(" #n ")" ::: "memory")
#define PG8_WAIT_L(n) asm volatile("s_waitcnt lgkmcnt(" #n ")" ::: "memory")
#define PG8_BAR __builtin_amdgcn_s_barrier()
#define PG8_SCHED __builtin_amdgcn_sched_barrier(0)
    Unit cur, nxt; int ui = 0;
    if (!S.next(0, cur)) return;
    f32x4 acc[2][2][4][2];
#pragma unroll
    for (int a = 0; a < 2; ++a)
#pragma unroll
        for (int b = 0; b < 2; ++b)
#pragma unroll
            for (int m = 0; m < 4; ++m)
#pragma unroll
                for (int n = 0; n < 2; ++n) acc[a][b][m][n] = (f32x4){0.f, 0.f, 0.f, 0.f};
    bf16x8 At[4][2], B0[2][2], B1[2][2];
    unsigned goffC[2][2], goffN[2][2];
    if constexpr (Sched::GATHER) { S.aoffs(cur, Rr2, Cc2, lda, goffC);
#pragma unroll
        for (int h = 0; h < 2; ++h)
#pragma unroll
            for (int i = 0; i < 2; ++i) goffN[h][i] = goffC[h][i]; }
    const char* cA = cur.a; const char* cB = cur.b;
    PG8_STAGE(PG8_SB(0, 0), cB, voffB); PG8_STAGE(PG8_SB(0, 1), cB + hstepB, voffB); PG8_STAGE_A(0, 0, cA, goffC); PG8_STAGE_A(0, 1, cA, goffC);
    if (wr == 1) PG8_BAR;
    PG8_WAIT_V(2); PG8_BAR;
    PG8_STAGE(PG8_SB(1, 0), cB + kstep, voffB); PG8_STAGE_A(1, 0, cA + kstep, goffC); PG8_STAGE(PG8_SB(1, 1), cB + hstepB + kstep, voffB);
    PG8_WAIT_V(6); PG8_BAR;
    for (;;) {
        const bool has_next = S.next(ui + 1, nxt);
        if constexpr (Sched::GATHER) { if (has_next) S.aoffs(nxt, Rr2, Cc2, lda, goffN); }
        const char* nA = has_next ? nxt.a : cA; const char* nB = has_next ? nxt.b : cB;
        for (int t = 0; t < nt; t += 2) {
            const bool last = (t == nt - 2);
            const char* a1 = cA + (size_t)(t + 1) * kstep;
            const char* a2 = last ? nA : cA + (size_t)(t + 2) * kstep; const char* b2 = last ? nB : cB + (size_t)(t + 2) * kstep;
            const char* a3 = a2 + kstep; const char* b3 = b2 + kstep;
            unsigned gx[2][2];
            if constexpr (Sched::GATHER) {
#pragma unroll
                for (int h = 0; h < 2; ++h)
#pragma unroll
                    for (int i = 0; i < 2; ++i) gx[h][i] = (last && has_next) ? goffN[h][i] : goffC[h][i]; }
            PG8_LDB(B0, 0, 0); PG8_LDB(B1, 0, 1); PG8_SCHED; PG8_LDA(At, 0, 0); PG8_STAGE_A(1, 1, a1, goffC);
            PG8_WAIT_V(8); PG8_WAIT_L(0); PG8_BAR; PG8_MMA(0, 0, At, B0); PG8_MMA(0, 1, At, B1); PG8_BAR; PG8_SCHED;
            PG8_LDA(At, 0, 1); PG8_STAGE(PG8_SB(0, 0), b2, voffB); PG8_STAGE(PG8_SB(0, 1), b2 + hstepB, voffB); PG8_STAGE_A(0, 0, a2, gx);
            PG8_WAIT_V(8); PG8_WAIT_L(0); PG8_BAR; PG8_MMA(1, 0, At, B0); PG8_MMA(1, 1, At, B1); PG8_BAR; PG8_SCHED;
            PG8_LDB(B0, 1, 0); PG8_LDB(B1, 1, 1); PG8_SCHED; PG8_LDA(At, 1, 0); PG8_STAGE_A(0, 1, a2, gx);
            PG8_WAIT_V(8); PG8_WAIT_L(0); PG8_BAR; PG8_MMA(0, 0, At, B0); PG8_MMA(0, 1, At, B1); PG8_BAR; PG8_SCHED;
            PG8_LDA(At, 1, 1); PG8_STAGE(PG8_SB(1, 0), b3, voffB); PG8_STAGE(PG8_SB(1, 1), b3 + hstepB, voffB); PG8_STAGE_A(1, 0, a3, gx);
            PG8_WAIT_V(8); PG8_WAIT_L(0); PG8_BAR; PG8_MMA(1, 0, At, B0); PG8_MMA(1, 1, At, B1); PG8_BAR; PG8_SCHED;
            if constexpr (Epi::MID) { if (((t + 2) & (Epi::MID_EVERY - 1)) == 0 && !last) E.mid(acc, cur, wr, wc, (t + 2) / Epi::MID_EVERY - 1); }
        }
        if constexpr (ALIGN_EPI) { if (wr == 0) PG8_BAR; }
        E(acc, cur, wr, wc, fr, fq);
        if (!has_next) break;
#pragma unroll
        for (int a = 0; a < 2; ++a)
#pragma unroll
            for (int b = 0; b < 2; ++b)
#pragma unroll
                for (int m = 0; m < 4; ++m)
#pragma unroll
                    for (int n = 0; n < 2; ++n) acc[a][b][m][n] = (f32x4){0.f, 0.f, 0.f, 0.f};
        cur = nxt; cA = nA; cB = nB; ++ui;
        if constexpr (Sched::GATHER) {
#pragma unroll
            for (int h = 0; h < 2; ++h)
#pragma unroll
                for (int i = 0; i < 2; ++i) goffC[h][i] = goffN[h][i]; }
        if constexpr (ALIGN_EPI) { if (wr == 1) PG8_BAR; }
    }
    PG8_WAIT_V(0);
    if constexpr (!ALIGN_EPI) { if (wr == 0) PG8_BAR; }
    PG8_BAR;
#undef PG8_SA
#undef PG8_SB
#undef PG8_STAGE
#undef PG8_STAGE_A
#undef PG8_LDA
#undef PG8_LDB
#undef PG8_MMA
#undef PG8_WAIT_V
#undef PG8_WAIT_L
#undef PG8_BAR
#undef PG8_SCHED
}
template <class F> struct EpiV4 { static constexpr bool PERM = false, MID = false; static constexpr int MID_EVERY = 1; F f;
    __device__ __forceinline__ void operator()(const f32x4 (&acc)[2][2][4][2], const Unit& u, int wr, int wc, int, int) const {
        const int ln = fresh_lane(), fr = ln & 15, fq = ln >> 4;
        const int row0 = u.pm * BM + wr * 64 + fr, col0 = u.pn * BM + wc * 32 + 4 * fq;
        typename F::UnitPre up = f.unit(u, col0);
#pragma unroll
        for (int ai = 0; ai < 2; ++ai) {
            typename F::Pre pre[4][2][2];
#pragma unroll
            for (int m = 0; m < 4; ++m)
#pragma unroll
                for (int bj = 0; bj < 2; ++bj)
#pragma unroll
                    for (int n = 0; n < 2; ++n) pre[m][bj][n] = f.load(u, row0 + ai * HALF + m * 16, col0 + bj * HALF + n * 16);
#pragma unroll
            for (int m = 0; m < 4; ++m)
#pragma unroll
                for (int bj = 0; bj < 2; ++bj)
#pragma unroll
                    for (int n = 0; n < 2; ++n) f.fin(u, row0 + ai * HALF + m * 16, col0 + bj * HALF + n * 16, acc[ai][bj][m][n], pre[m][bj][n], up, bj * 2 + n);
            asm volatile("" ::: "memory"); }
    } };
template <class F> struct EpiV8 { static constexpr bool PERM = true, MID = false; static constexpr int MID_EVERY = 1; F f;
    __device__ __forceinline__ void operator()(const f32x4 (&acc)[2][2][4][2], const Unit& u, int wr, int wc, int, int) const {
        const int ln = fresh_lane(), fr = ln & 15, fq = ln >> 4;
        const int row0 = u.pm * BM + wr * 64 + fr, col0 = u.pn * BM + wc * 32 + 8 * fq;
#pragma unroll
        for (int ai = 0; ai < 2; ++ai) {
            typename F::Pre pre[4][2];
#pragma unroll
            for (int m = 0; m < 4; ++m)
#pragma unroll
                for (int bj = 0; bj < 2; ++bj) pre[m][bj] = f.load(u, row0 + ai * HALF + m * 16, col0 + bj * HALF);
#pragma unroll
            for (int m = 0; m < 4; ++m)
#pragma unroll
                for (int bj = 0; bj < 2; ++bj) f.fin(u, row0 + ai * HALF + m * 16, col0 + bj * HALF, acc[ai][bj][m][0], acc[ai][bj][m][1], pre[m][bj]);
            asm volatile("" ::: "memory"); }
    } };
template <class F> struct EpiDual { static constexpr bool PERM = true, MID = false; static constexpr int MID_EVERY = 1; F f;
    __device__ __forceinline__ void operator()(const f32x4 (&acc)[2][2][4][2], const Unit& u, int wr, int wc, int, int) const {
        const int ln = fresh_lane(), fr = ln & 15, fq = ln >> 4;
        const int row0 = u.pm * BM + wr * 64 + fr, hc0 = u.pn * HALF + wc * 32 + 8 * fq;
#pragma unroll
        for (int ai = 0; ai < 2; ++ai)
#pragma unroll
            for (int m = 0; m < 4; ++m) f.apply8(row0 + ai * HALF + m * 16, hc0, acc[ai][0][m][0], acc[ai][0][m][1], acc[ai][1][m][0], acc[ai][1][m][1]);
    } };
struct EpiMergeS { static constexpr bool PERM = true, MID = true; static constexpr int MID_EVERY = 8;
    const unsigned char* G8; bf16_t* MG;
    __device__ __forceinline__ void mid(f32x4 (&acc)[2][2][4][2], const Unit& u, int wr, int wc, int i) const {
        const int ln = fresh_lane(), fr = ln & 15, fq = ln >> 4;
        const int row0 = u.pm * BM + wr * 64 + fr, col0 = u.pn * BM + wc * 32 + 8 * fq;
#pragma unroll
        for (int ai = 0; ai < 2; ++ai) {
            u32x2 gi[4][2], gn[4][2];
#pragma unroll
            for (int m = 0; m < 4; ++m)
#pragma unroll
                for (int bj = 0; bj < 2; ++bj) { const unsigned char* gp = G8 + (size_t)(row0 + ai * HALF + m * 16) * 4096 + i * 1024 + col0 + bj * HALF;
                    gi[m][bj] = *(const u32x2*)gp; gn[m][bj] = *(const u32x2*)(gp + 1024); }
#pragma unroll
            for (int m = 0; m < 4; ++m)
#pragma unroll
                for (int bj = 0; bj < 2; ++bj) {
#pragma unroll
                    for (int j = 0; j < 4; ++j) {
                        acc[ai][bj][m][0][j] *= (float)((gi[m][bj].x >> (8 * j)) & 255u) * __builtin_amdgcn_rcpf((float)((gn[m][bj].x >> (8 * j)) & 255u));
                        acc[ai][bj][m][1][j] *= (float)((gi[m][bj].y >> (8 * j)) & 255u) * __builtin_amdgcn_rcpf((float)((gn[m][bj].y >> (8 * j)) & 255u)); } }
        }
    }
    __device__ __forceinline__ void operator()(const f32x4 (&acc)[2][2][4][2], const Unit& u, int wr, int wc, int, int) const {
        const int ln = fresh_lane(), fr = ln & 15, fq = ln >> 4;
        const int row0 = u.pm * BM + wr * 64 + fr, col0 = u.pn * BM + wc * 32 + 8 * fq;
#pragma unroll
        for (int ai = 0; ai < 2; ++ai) {
            u32x2 g3[4][2];
#pragma unroll
            for (int m = 0; m < 4; ++m)
#pragma unroll
                for (int bj = 0; bj < 2; ++bj) g3[m][bj] = *(const u32x2*)(G8 + (size_t)(row0 + ai * HALF + m * 16) * 4096 + 3 * 1024 + col0 + bj * HALF);
#pragma unroll
            for (int m = 0; m < 4; ++m)
#pragma unroll
                for (int bj = 0; bj < 2; ++bj) { f32x4 a = acc[ai][bj][m][0], b = acc[ai][bj][m][1];
#pragma unroll
                    for (int j = 0; j < 4; ++j) { a[j] *= (float)((g3[m][bj].x >> (8 * j)) & 255u) * (1.0f / 255.0f); b[j] *= (float)((g3[m][bj].y >> (8 * j)) & 255u) * (1.0f / 255.0f); }
                    u32x4 w; w.x = cvtpk(a.x, a.y); w.y = cvtpk(a.z, a.w); w.z = cvtpk(b.x, b.y); w.w = cvtpk(b.z, b.w);
                    *(u32x4*)(MG + (size_t)(row0 + ai * HALF + m * 16) * D + col0 + bj * HALF) = w; }
        }
    }
};
}

__device__ __forceinline__ u32x4 pack8(f32x4 a, f32x4 b) { u32x4 w; w.x = cvtpk(a.x, a.y); w.y = cvtpk(a.z, a.w); w.z = cvtpk(b.x, b.y); w.w = cvtpk(b.z, b.w); return w; }
__device__ __forceinline__ float sigm1(float x) { return __builtin_amdgcn_rcpf(1.0f + __builtin_amdgcn_exp2f(-1.4426950408889634f * x)); }
__device__ __forceinline__ f32x4 sigm4(f32x4 v) { f32x4 r; r.x = sigm1(v.x); r.y = sigm1(v.y); r.z = sigm1(v.z); r.w = sigm1(v.w); return r; }
struct NoPre {};
struct FStore8 { bf16_t* C; int ldc; typedef NoPre Pre;
    __device__ __forceinline__ Pre load(const pg8::Unit&, int, int) const { return Pre{}; }
    __device__ __forceinline__ void fin(const pg8::Unit&, int row, int col, f32x4 a, f32x4 b, const Pre&) const { *(u32x4*)(C + (size_t)row * ldc + col) = pack8(a, b); } };
struct FGateU8 { unsigned char* G8; const float* bias; typedef NoPre Pre;
    __device__ __forceinline__ Pre load(const pg8::Unit&, int, int) const { return Pre{}; }
    __device__ __forceinline__ void fin(const pg8::Unit&, int row, int col, f32x4 a, f32x4 b, const Pre&) const { const f32x4 b0 = *(const f32x4*)(bias + col), b1 = *(const f32x4*)(bias + col + 4);
        const f32x4 ga = sigm4(a + b0) * 255.0f + 0.5f, gb = sigm4(b + b1) * 255.0f + 0.5f;
        unsigned q[8] = {(unsigned)ga.x, (unsigned)ga.y, (unsigned)ga.z, (unsigned)ga.w, (unsigned)gb.x, (unsigned)gb.y, (unsigned)gb.z, (unsigned)gb.w};
#pragma unroll
        for (int k = 0; k < 8; ++k) q[k] = q[k] < 1u ? 1u : (q[k] > 255u ? 255u : q[k]);
        u32x2 w; w.x = q[0] | (q[1] << 8) | (q[2] << 16) | (q[3] << 24); w.y = q[4] | (q[5] << 8) | (q[6] << 16) | (q[7] << 24);
        *(u32x2*)(G8 + (size_t)row * 4096 + col) = w; } };
struct FMoe1 { bf16_t* HID;
    __device__ __forceinline__ void apply8(int row, int hc, f32x4 a0, f32x4 a1, f32x4 b0, f32x4 b1) const {
        *(u32x4*)(HID + (size_t)row * FF + hc) = pack8(a0 * sigm4(a0) * b0, a1 * sigm4(a1) * b1); } };
struct FMoe2 { bf16_t* MO; const int* tokl; const float* wl; struct Pre { int t; float w; };
    __device__ __forceinline__ Pre load(const pg8::Unit& u, int row, int) const { Pre r; const int pos = u.p0 + (row - u.pm * 256); r.t = -1; r.w = 0.f;
        if (pos < u.ce) { r.t = tokl[(size_t)u.e * R + pos]; r.w = wl[(size_t)u.e * R + pos]; } return r; }
    __device__ __forceinline__ void fin(const pg8::Unit&, int, int col, f32x4 a, f32x4 b, const Pre& q) const { if (q.t < 0) return;
        *(u32x4*)(MO + ((size_t)(q.t & 1) * R + (q.t >> 1)) * D + col) = pack8(a * q.w, b * q.w); } };
struct FOut { Ptrs P; int l; typedef f32x4 Pre; struct UnitPre { f32x4 g[4]; };
    __device__ __forceinline__ UnitPre unit(const pg8::Unit& u, int col0) const { UnitPre r; const float* g = mod_vec(P, l, row_bb(u.pm * 256), 2) + col0;
#pragma unroll
        for (int q = 0; q < 4; ++q) r.g[q] = *(const f32x4*)(g + (q >> 1) * 128 + (q & 1) * 16);
        return r; }
    __device__ __forceinline__ Pre load(const pg8::Unit&, int row, int col) const { return l == 0 ? *(const f32x4*)(xin_row(P, row) + col) : *(const f32x4*)(x1_row(P, row) + col); }
    __device__ __forceinline__ void fin(const pg8::Unit&, int row, int col, f32x4 v, const Pre& xp, const UnitPre& up, int q) const { *(f32x4*)(x1_row(P, row) + col) = xp + up.g[q] * v; } };

struct Frame { LAS unsigned char* lds; int wave, vcu, G; };
#define fresh_tid() (F.wave * 64 + fresh_lane())
__device__ __forceinline__ void tr_item(const float* W, int ldw, int k0, int csrc0, bf16_t* WT, int ldt, int drow0, LAS float* scr, int lane) {
    f32x4 v[8];
#pragma unroll
    for (int i = 0; i < 8; ++i) v[i] = *(const f32x4*)(W + (size_t)(k0 + (lane >> 3) + 8 * i) * ldw + csrc0 + (lane & 7) * 4);
#pragma unroll
    for (int i = 0; i < 8; ++i) { LAS float* d = scr + ((lane >> 3) + 8 * i) * 33 + (lane & 7) * 4; d[0] = v[i].x; d[1] = v[i].y; d[2] = v[i].z; d[3] = v[i].w; }
    LDS_WAIT(); asm volatile("" ::: "memory");
    const int c = lane & 7;
#pragma unroll
    for (int j = 0; j < 4; ++j) { const int n = (lane >> 3) + 8 * j; const LAS float* s = scr + (8 * c) * 33 + n;
        u32x4 o; o.x = cvtpk(s[0 * 33], s[1 * 33]); o.y = cvtpk(s[2 * 33], s[3 * 33]); o.z = cvtpk(s[4 * 33], s[5 * 33]); o.w = cvtpk(s[6 * 33], s[7 * 33]);
        *(u32x4*)(WT + (size_t)(drow0 + n) * ldt + k0 + 8 * c) = o; }
    LDS_WAIT(); asm volatile("" ::: "memory");
}
__device__ __forceinline__ void ph_weights(const Frame& F, const Ptrs& P, int l) {
    const int tid0 = fresh_tid(), lane0 = tid0 & 63;
    LAS float* scr = (LAS float*)(F.lds + F.wave * 16384);
    const int gw = F.vcu * NWAVES + F.wave, NGW = F.G * NWAVES;
    unsigned char* wb = P.ws + WS_WB;
    constexpr int I0 = 1024, I1 = I0 + 2048, I2 = I1 + 768, I3 = I2 + 512, I4 = I3 + 4096, I5 = I4 + 4096, I6 = I5 + 4096;
    for (int it = gw; it < I6; it += NGW) {
        if (it < I0) { const int kb = it >> 6, nb = it & 63; tr_item(P.w_in + (size_t)l * 1024 * 2560, 2560, kb * 64, 512 + nb * 32, (bf16_t*)(wb + WB_IN), 1024, 1024 + nb * 32, scr, lane0); }
        else if (it < I1) { const int r = it - I0, i = r >> 9, q = r & 511, kb = q >> 5, nb = q & 31; tr_item(P.w_gate + ((size_t)l * 4 + i) * 1024 * 1024, 1024, kb * 64, nb * 32, (bf16_t*)(wb + WB_GATE) + (size_t)i * 1024 * 1024, 1024, nb * 32, scr, lane0); }
        else if (it < I2) { const int r = it - I1, i = r >> 8, q = r & 255, kb = q >> 5, nb = q & 31; tr_item(P.w_branch + ((size_t)l * 4 + i) * 512 * 1024, 1024, kb * 64, nb * 32, (bf16_t*)(wb + WB_BR) + i * 512, 2048, nb * 32, scr, lane0); }
        else if (it < I3) { const int q = it - I2, kb = q >> 5, nb = q & 31; tr_item(P.w_out + (size_t)l * 1024 * 1024, 1024, kb * 64, nb * 32, (bf16_t*)(wb + WB_OUT), 1024, nb * 32, scr, lane0); }
        else if (it < I5) { const int w3 = it >= I4; const int r = it - (w3 ? I4 : I3), e = r >> 8, q = r & 255, kb = q >> 4, nb = q & 15, c = nb * 32;
            tr_item((w3 ? P.w3 : P.w1) + ((size_t)l * 16 + e) * 1024 * 512, 512, kb * 64, c, (bf16_t*)(wb + WB_13) + (size_t)e * 1024 * 1024, 1024, 256 * (c >> 7) + (c & 127) + (w3 ? 128 : 0), scr, lane0); }
        else { const int r = it - I5, e = r >> 8, q = r & 255, kb = q >> 5, nb = q & 31; tr_item(P.w2 + ((size_t)l * 16 + e) * 512 * 1024, 1024, kb * 64, nb * 32, (bf16_t*)(wb + WB_2) + (size_t)e * 1024 * 512, 512, nb * 32, scr, lane0); }
    }
    __syncthreads();
    for (int u = F.vcu; u < 64; u += F.G) {
        LAS float* Wl = (LAS float*)F.lds; LAS float* ct = Wl + 64 * 128;
        const int kt = u >> 2, g = u & 3, k0 = kt * 64, tid = tid0; const float* w_in = P.w_in + (size_t)l * 1024 * 2560;
        if (tid < 128) ct[tid] = __builtin_amdgcn_cosf((float)tid * (1.0f / 128.0f));
        for (int i = tid; i < 64 * 128; i += 512) { const int k = i >> 7, c = i & 127; Wl[k * 128 + c] = w_in[(size_t)(k0 + k) * 2560 + g * 128 + c]; }
        __syncthreads();
        const int part = (tid >> 7) & 1, m = tid & 127, kh = tid >> 8; const float sc = 0.08838834764831845f;
        bf16_t* drow = (bf16_t*)(wb + WB_IN) + (size_t)(part * 512 + g * 128 + m) * 1024 + k0;
        for (int kb = kh * 32; kb < kh * 32 + 32; kb += 8) { float acc[8];
#pragma unroll
            for (int j = 0; j < 8; ++j) acc[j] = 0.f;
            for (int c = 0; c < 128; ++c) { const int idx = (c * m) & 127; const float tw = part ? -ct[(idx - 32) & 127] : ct[idx];
#pragma unroll
                for (int j = 0; j < 8; ++j) acc[j] += Wl[(kb + j) * 128 + c] * tw; }
            u32x4 o; o.x = pk2(acc[0] * sc, acc[1] * sc); o.y = pk2(acc[2] * sc, acc[3] * sc); o.z = pk2(acc[4] * sc, acc[5] * sc); o.w = pk2(acc[6] * sc, acc[7] * sc);
            *(u32x4*)(drow + kb) = o; }
        __syncthreads();
    }
    for (int u = F.G - 1 - F.vcu; u < 64; u += F.G) {
        LAS float* Wb = (LAS float*)F.lds;
        const int g = u >> 4, n0 = (u & 15) * 64, tid = tid0;
        const float* ps = P.pool_scale + (size_t)l * 512; const float* wb3 = P.w_branch + ((size_t)l * 4 + 3) * 512 * 1024; const float* pwl = P.pool_w + (size_t)l * 4 * 128 * 128;
        for (int i = tid; i < 128 * 64; i += 512) { const int e = i >> 6, n = i & 63; Wb[e * 64 + n] = ps[g * 128 + e] * wb3[(size_t)(g * 128 + e) * 1024 + n0 + n]; }
        __syncthreads();
        const int c = tid & 127, nh = tid >> 7; const float* pw = pwl + (size_t)(g * 128 + c) * 128;
        float acc[16];
#pragma unroll
        for (int j = 0; j < 16; ++j) acc[j] = 0.f;
        for (int e = 0; e < 128; ++e) { const float p = pw[e];
#pragma unroll
            for (int j = 0; j < 16; ++j) acc[j] += p * Wb[e * 64 + nh * 16 + j]; }
        bf16_t* Bt = (bf16_t*)(wb + WB_BR) + 3 * 512;
#pragma unroll
        for (int j = 0; j < 16; ++j) Bt[(size_t)(n0 + nh * 16 + j) * 2048 + g * 128 + c] = (bf16_t)f2bf(acc[j]);
        __syncthreads();
    }
}
__device__ __forceinline__ void ph_tables_mod(const Frame& F, const Ptrs& P) {
    const int tid0 = fresh_tid();
    { float* rc = (float*)(P.ws + WS_ROPE); float* rs = rc + 1024; float* ct = (float*)(P.ws + WS_COS);
      const int i = F.vcu * 512 + tid0;
      if (i < 1024) { const int pos = i >> 4, f = i & 15; const float inv = exp2f(-(float)f * (13.287712379549449f / 16.0f));
          float rev = (float)pos * inv * 0.15915494309189535f; rev = rev - floorf(rev);
          rc[i] = __builtin_amdgcn_cosf(rev); rs[i] = __builtin_amdgcn_sinf(rev); }
      if (i < 4096) ct[i] = __builtin_amdgcn_cosf((float)i * (1.0f / 4096.0f));
      if (i < 16384) { const int mm = i >> 7, k = i & 127, pp = mm >> 6, k1 = mm & 63, pk = k >> 6, t1 = k & 63; const float rev = (float)((k1 * t1) & 63) * (1.0f / 64.0f);
          const float c = __builtin_amdgcn_cosf(rev), sn = __builtin_amdgcn_sinf(rev);
          ((bf16_t*)(P.ws + WS_DFTM))[i] = (bf16_t)f2bf(pp == pk ? c : (pp == 0 ? sn : -sn)); } }
    for (int u = F.vcu; u < 192; u += F.G) {
        LAS float* s = (LAS float*)F.lds; LAS float* red = s + 9 * 1024;
        const int l = u / 96, j0 = (u % 96) * 64, tid = tid0;
        for (int i = tid; i < 9 * 1024; i += 512) { const int bb = i >> 10, k = i & 1023; const float v = bb < 8 ? P.c[bb * 1024 + k] : P.c_ctx[k]; s[i] = v / (1.f + expf(-v)); }
        __syncthreads();
        const int kc = tid >> 6, jj = tid & 63; float acc[9];
#pragma unroll
        for (int b = 0; b < 9; ++b) acc[b] = 0.f;
        const float* w = P.w_ada + (size_t)l * 1024 * 6144 + j0 + jj;
        for (int k = kc * 128; k < kc * 128 + 128; k += 8) { float wv[8];
#pragma unroll
            for (int q = 0; q < 8; ++q) wv[q] = w[(size_t)(k + q) * 6144];
#pragma unroll
            for (int q = 0; q < 8; ++q)
#pragma unroll
                for (int b = 0; b < 9; ++b) acc[b] += s[b * 1024 + k + q] * wv[q]; }
#pragma unroll
        for (int b = 0; b < 9; ++b) red[(kc * 9 + b) * 64 + jj] = acc[b];
        __syncthreads();
        float* mod = (float*)(P.ws + WS_MOD);
        for (int i = tid; i < 9 * 64; i += 512) { const int b = i >> 6, j = i & 63; float v = P.b_ada[l * 6144 + j0 + j];
#pragma unroll
            for (int q = 0; q < 8; ++q) v += red[(q * 9 + b) * 64 + j];
            mod[(size_t)(l * 9 + b) * 6144 + j0 + j] = v; }
        __syncthreads();
    }
}
__device__ __forceinline__ void route_row(const Ptrs& P, int r, const f32x4 (&h)[4], int lane, bool publish, LAS unsigned* lcnt, LAS int* rec, const LAS float* rwl) {
    float lg[16];
#pragma unroll
    for (int e = 0; e < 16; ++e) lg[e] = 0.f;
#pragma unroll
    for (int j = 0; j < 4; ++j) {
#pragma unroll
        for (int i = 0; i < 4; ++i) { const int kk = 4 * lane + 256 * j + i; const LAS f32x4* rw = (const LAS f32x4*)(rwl + kk * 16 + (kk >> 2) * 4); const float hv = h[j][i];
#pragma unroll
            for (int qd = 0; qd < 4; ++qd) { const f32x4 w = rw[qd]; lg[4 * qd] += hv * w.x; lg[4 * qd + 1] += hv * w.y; lg[4 * qd + 2] += hv * w.z; lg[4 * qd + 3] += hv * w.w; } }
        __builtin_amdgcn_sched_barrier(0); }
    float v8[8], v4[4], v2[2], v1;
    { const bool bit = (lane & 32) != 0;
#pragma unroll
      for (int i = 0; i < 8; ++i) { const float a = lg[i], b = lg[i + 8]; v8[i] = (bit ? b : a) + shfl_xor_l(bit ? a : b, 32, lane); } }
    { const bool bit = (lane & 16) != 0;
#pragma unroll
      for (int i = 0; i < 4; ++i) { const float a = v8[i], b = v8[i + 4]; v4[i] = (bit ? b : a) + shfl_xor_l(bit ? a : b, 16, lane); } }
    { const bool bit = (lane & 8) != 0;
#pragma unroll
      for (int i = 0; i < 2; ++i) { const float a = v4[i], b = v4[i + 2]; v2[i] = (bit ? b : a) + shfl_xor_l(bit ? a : b, 8, lane); } }
    { const bool bit = (lane & 4) != 0; const float a = v2[0], b = v2[1]; v1 = (bit ? b : a) + shfl_xor_l(bit ? a : b, 4, lane); }
    v1 += shfl_xor_l(v1, 2, lane); v1 += shfl_xor_l(v1, 1, lane);
    float bestscore = -INFINITY; int be0 = 0, be1 = 1; float ba0 = 0.f, ba1 = 0.f;
#pragma unroll
    for (int g = 0; g < 4; ++g) {
        float aff[4], sel[4];
#pragma unroll
        for (int i = 0; i < 4; ++i) { const float t = __int_as_float(__builtin_amdgcn_ds_bpermute((4 * g + i) << 4, __float_as_int(v1))); aff[i] = 1.0f / (1.0f + expf(-t)); sel[i] = aff[i] + P.router_bias[4 * g + i]; }
        int i1 = 0; float m1 = sel[0], a1 = aff[0];
#pragma unroll
        for (int i = 1; i < 4; ++i) if (sel[i] > m1) { m1 = sel[i]; a1 = aff[i]; i1 = i; }
        int i2 = -1; float m2 = -INFINITY, a2 = 0.f;
#pragma unroll
        for (int i = 0; i < 4; ++i) if (i != i1 && sel[i] > m2) { m2 = sel[i]; a2 = aff[i]; i2 = i; }
        const float score = m1 + m2;
        if (score > bestscore) { bestscore = score; be0 = 4 * g + i1; be1 = 4 * g + i2; ba0 = a1; ba1 = a2; }
    }
    if (lane == 0 && publish) {
        const int p0 = (int)__hip_atomic_fetch_add(lcnt + be0, 1u, __ATOMIC_RELAXED, __HIP_MEMORY_SCOPE_WORKGROUP), p1 = (int)__hip_atomic_fetch_add(lcnt + be1, 1u, __ATOMIC_RELAXED, __HIP_MEMORY_SCOPE_WORKGROUP);
        const float inv = 1.0f / (ba0 + ba1);
        rec[0] = r; rec[1] = be0; rec[2] = p0; rec[3] = be1; rec[4] = p1; rec[5] = __float_as_int(ba0 * inv); rec[6] = __float_as_int(ba1 * inv);
    }
}
template <int MODE> __device__ __forceinline__ void ph_norm(const Frame& F, const Ptrs& P, int l, int nrows) {
    constexpr int NRW = MODE == 2 ? 2 : 4;
    const int lane = fresh_lane();
    const int stride = F.G * NWAVES;
    LAS unsigned* lcnt = (LAS unsigned*)F.lds; LAS unsigned* gbase = lcnt + 16; LAS int* recs = (LAS int*)(F.lds + 256);
    const LAS float* rwl = (const LAS float*)(F.lds + 8192);
    if (MODE == 2) { if (F.wave == 0 && lane < 16) lcnt[lane] = 0u;
        { const int tid = F.wave * 64 + lane; LAS f32x4* d = (LAS f32x4*)(F.lds + 8192);
#pragma unroll
          for (int i = 0; i < 8; ++i) { const int idx = tid + 512 * i, kk = idx >> 2; d[idx + (kk >> 2)] = ((const f32x4*)P.router_w)[idx]; } }
        __syncthreads(); }
    int it = 0;
    for (int rb = F.vcu * NWAVES + F.wave; rb < nrows; rb += NRW * stride, ++it) {
        int rr[NRW];
#pragma unroll
        for (int q = 0; q < NRW; ++q) rr[q] = rb + q * stride < nrows ? rb + q * stride : rb;
        f32x4 v[NRW][4];
#pragma unroll
        for (int q = 0; q < NRW; ++q) { const int r = rr[q];
            if (MODE == 0) { const f32x4* xr = (const f32x4*)xin_row(P, r) + lane;
#pragma unroll
                for (int j = 0; j < 4; ++j) v[q][j] = xr[64 * j]; }
            else { const f32x4* xr = (const f32x4*)x1_row(P, r) + lane;
#pragma unroll
                for (int j = 0; j < 4; ++j) v[q][j] = xr[64 * j]; } }
        if (MODE == 1) {
#pragma unroll
            for (int q = 0; q < NRW; ++q) { const int r = rr[q]; const int bb = row_bb(r); const f32x4* g2 = (const f32x4*)mod_vec(P, l - 1, bb, 5) + lane;
                const u32x2* m0 = (const u32x2*)((const bf16_t*)(P.ws + WS_MO) + (size_t)r * D) + lane; const u32x2* m1 = (const u32x2*)((const bf16_t*)(P.ws + WS_MO) + (size_t)(R + r) * D) + lane;
#pragma unroll
                for (int j = 0; j < 4; ++j) { const u32x2 a = m0[64 * j], b = m1[64 * j]; const f32x4 g = g2[64 * j];
                    v[q][j].x += g.x * (lo16(a.x) + lo16(b.x)); v[q][j].y += g.y * (hi16(a.x) + hi16(b.x)); v[q][j].z += g.z * (lo16(a.y) + lo16(b.y)); v[q][j].w += g.w * (hi16(a.y) + hi16(b.y)); } }
#pragma unroll
            for (int q = 0; q < NRW; ++q) if (q == 0 || rr[q] != rr[0]) { f32x4* xr = (f32x4*)x1_row(P, rr[q]) + lane;
#pragma unroll
                for (int j = 0; j < 4; ++j) xr[64 * j] = v[q][j]; }
        }
        float ss[NRW];
#pragma unroll
        for (int q = 0; q < NRW; ++q) { ss[q] = 0.f;
#pragma unroll
            for (int j = 0; j < 4; ++j) ss[q] += (v[q][j].x * v[q][j].x + v[q][j].y * v[q][j].y) + (v[q][j].z * v[q][j].z + v[q][j].w * v[q][j].w); }
#pragma unroll
        for (int o = 1; o < 64; o <<= 1) {
#pragma unroll
            for (int q = 0; q < NRW; ++q) ss[q] += shfl_xor_l(ss[q], o, lane); }
        const f32x4* gn = (const f32x4*)((MODE == 2 ? P.norm2 : P.norm1) + (size_t)l * D) + lane;
#pragma unroll
        for (int q = 0; q < NRW; ++q) { const int r = rr[q]; const int bb = row_bb(r);
            if (q > 0 && r == rr[0]) continue;
            const float rstd = 1.0f / sqrtf(ss[q] * (1.0f / D) + EPS);
            const f32x4* sh = (const f32x4*)mod_vec(P, l, bb, MODE == 2 ? 3 : 0) + lane;
            const f32x4* sc = (const f32x4*)mod_vec(P, l, bb, MODE == 2 ? 4 : 1) + lane;
            u32x2* o = (u32x2*)((bf16_t*)(P.ws + WS_H) + (size_t)r * D) + lane;
#pragma unroll
            for (int j = 0; j < 4; ++j) { const f32x4 g = gn[64 * j], a = sh[64 * j], b = sc[64 * j];
                v[q][j] = (v[q][j] * rstd * g) * (b + 1.0f) + a;
                u32x2 w; w.x = cvtpk(v[q][j].x, v[q][j].y); w.y = cvtpk(v[q][j].z, v[q][j].w); o[64 * j] = w; } }
        if (MODE == 2) { LAS int* rec = recs + (F.wave * 24 + 2 * it) * 8;
            route_row(P, rr[0], v[0], lane, true, lcnt, rec, rwl); __builtin_amdgcn_sched_barrier(0);
            if (lane == 0 && rr[1] == rr[0]) rec[8] = -1;
            route_row(P, rr[1], v[1], lane, rr[1] != rr[0], lcnt, rec + 8, rwl); }
    }
    if (MODE == 2) {
        __syncthreads();
        const int tid = F.wave * 64 + lane;
        if (tid < 16) { const unsigned c = lcnt[tid]; gbase[tid] = c ? atomicAdd((unsigned*)(P.ws + WS_CTL) + CW_CNT + 1024 * l + 64 * tid, c) : 0u; }
        __syncthreads();
        if (lane == 0) for (int k = 0; k < 2 * it; ++k) { const LAS int* rec = recs + (F.wave * 24 + k) * 8; const int r = rec[0]; if (r < 0) continue;
            int* tokl = (int*)(P.ws + WS_TOKL); float* wl = (float*)(P.ws + WS_WL);
            const size_t i0 = (size_t)rec[1] * R + rec[2] + gbase[rec[1]], i1 = (size_t)rec[3] * R + rec[4] + gbase[rec[3]];
            tokl[i0] = 2 * r; wl[i0] = __int_as_float(rec[5]); tokl[i1] = 2 * r + 1; wl[i1] = __int_as_float(rec[6]); }
        __syncthreads();
    }
}
__device__ __forceinline__ void ph_kprep(const Frame& F, const Ptrs& P, int l) {
    const int lane = fresh_lane();
    const float* rc = (const float*)(P.ws + WS_ROPE); const float* rs = rc + 1024;
    const int hs = (lane >> 3) & 3, chunk = lane & 7, col = (hs < 2 ? C_KB + hs * 64 : C_KW + (hs - 2) * 64) + chunk * 8;
    const f32x4 g0 = *(const f32x4*)(P.k_gain + l * 64 + chunk * 8), g1 = *(const f32x4*)(P.k_gain + l * 64 + chunk * 8 + 4);
    const int a = chunk >> 2, fi = (chunk & 1) * 8; const bool second = (chunk & 2) != 0;
    const int npair = R / 2, stride = F.G * NWAVES;
    for (int pr0 = F.vcu * NWAVES + F.wave; pr0 < npair; pr0 += 4 * stride) {
        u32x4 w[4];
#pragma unroll
        for (int q = 0; q < 4; ++q) { const int pr = pr0 + q * stride; const int r = 2 * (pr < npair ? pr : pr0) + (lane >> 5); w[q] = *(const u32x4*)((const bf16_t*)(P.ws + WS_U) + (size_t)r * NIN + col); }
#pragma unroll
        for (int q = 0; q < 4; ++q) { const int pr = pr0 + q * stride; if (pr >= npair) break;
            const int r = 2 * pr + (lane >> 5);
            float x[8] = {lo16(w[q].x), hi16(w[q].x), lo16(w[q].y), hi16(w[q].y), lo16(w[q].z), hi16(w[q].z), lo16(w[q].w), hi16(w[q].w)};
            if (hs < 2) { float ss = 0.f;
#pragma unroll
                for (int j = 0; j < 8; ++j) ss += x[j] * x[j];
                ss += shfl_xor_l(ss, 1, lane); ss += shfl_xor_l(ss, 2, lane); ss += shfl_xor_l(ss, 4, lane);
                const float rstd = 1.0f / sqrtf(ss * (1.0f / 64.0f) + EPS);
                x[0] *= rstd * g0.x; x[1] *= rstd * g0.y; x[2] *= rstd * g0.z; x[3] *= rstd * g0.w; x[4] *= rstd * g1.x; x[5] *= rstd * g1.y; x[6] *= rstd * g1.z; x[7] *= rstd * g1.w; }
            if (r < RL) { const int t = r & (T - 1), pos = a ? (t & 63) : (t >> 6);
                const f32x4 c0 = *(const f32x4*)(rc + pos * 16 + fi), c1 = *(const f32x4*)(rc + pos * 16 + fi + 4), s0 = *(const f32x4*)(rs + pos * 16 + fi), s1 = *(const f32x4*)(rs + pos * 16 + fi + 4);
                const float cs[8] = {c0.x, c0.y, c0.z, c0.w, c1.x, c1.y, c1.z, c1.w}, sn[8] = {s0.x, s0.y, s0.z, s0.w, s1.x, s1.y, s1.z, s1.w};
#pragma unroll
                for (int j = 0; j < 8; ++j) { const float y = shfl_xor_l(x[j], 2, lane); x[j] = second ? x[j] * cs[j] + y * sn[j] : x[j] * cs[j] - y * sn[j]; } }
            u32x4 o; o.x = cvtpk(x[0], x[1]); o.y = cvtpk(x[2], x[3]); o.z = cvtpk(x[4], x[5]); o.w = cvtpk(x[6], x[7]);
            *(u32x4*)((bf16_t*)(P.ws + WS_U) + (size_t)r * NIN + col) = o; }
    }
}
__device__ __forceinline__ void ph_pool(const Frame& F, const Ptrs& P, int nrows) {
    const int tid0 = fresh_tid();
    for (int i = F.vcu * 512 + tid0; i < nrows * 64; i += F.G * 512) {
        const int r = i >> 6, c8 = (i & 63) * 8;
        const bool lat = r < RL; const int Ts = lat ? T : TC; const int t = lat ? (r & (T - 1)) : ((r - RL) & (TC - 1)); const int r0 = r - t;
        const int g = c8 >> 7, hw = 1 << g;
        const int lo = t - hw < 0 ? 0 : t - hw, hi = t + hw > Ts ? Ts : t + hw;
        const bf16_t* U = (const bf16_t*)(P.ws + WS_U) + C_P + c8;
        u32x4 wv[16];
#pragma unroll
        for (int k = 0; k < 16; ++k) { const int tt = t - 8 + k; const bool ok = tt >= lo && tt < hi; wv[k] = *(const u32x4*)(U + (size_t)(r0 + (ok ? tt : t)) * NIN); }
        float s[8];
#pragma unroll
        for (int j = 0; j < 8; ++j) s[j] = 0.f;
#pragma unroll
        for (int k = 0; k < 16; ++k) { const int tt = t - 8 + k; const float f = (tt >= lo && tt < hi) ? 1.f : 0.f; const u32x4 w = wv[k];
            s[0] += f * lo16(w.x); s[1] += f * hi16(w.x); s[2] += f * lo16(w.y); s[3] += f * hi16(w.y); s[4] += f * lo16(w.z); s[5] += f * hi16(w.z); s[6] += f * lo16(w.w); s[7] += f * hi16(w.w); }
        const u32x4 w = wv[8]; const float inv = 1.0f / (float)(hi - lo);
        u32x4 o; o.x = cvtpk(s[0] * inv - lo16(w.x), s[1] * inv - hi16(w.x)); o.y = cvtpk(s[2] * inv - lo16(w.y), s[3] * inv - hi16(w.y));
        o.z = cvtpk(s[4] * inv - lo16(w.z), s[5] * inv - hi16(w.z)); o.w = cvtpk(s[6] * inv - lo16(w.w), s[7] * inv - hi16(w.w));
        *(u32x4*)((bf16_t*)(P.ws + WS_BR) + (size_t)r * NBR + 1536 + c8) = o;
    }
}
__device__ __forceinline__ void ph_final(const Frame& F, const Ptrs& P) {
    const int lane = fresh_lane(); const int stride = F.G * NWAVES;
    for (int rb = F.vcu * NWAVES + F.wave; rb < RL; rb += 4 * stride) {
        f32x4 v[4][4]; float ss[4];
#pragma unroll
        for (int q = 0; q < 4; ++q) { const int r = rb + q * stride < RL ? rb + q * stride : rb; const int bb = row_bb(r);
            const f32x4* xr = (const f32x4*)(P.out + (size_t)r * D) + lane; const f32x4* g2 = (const f32x4*)mod_vec(P, 1, bb, 5) + lane;
            const u32x2* m0 = (const u32x2*)((const bf16_t*)(P.ws + WS_MO) + (size_t)r * D) + lane; const u32x2* m1 = (const u32x2*)((const bf16_t*)(P.ws + WS_MO) + (size_t)(R + r) * D) + lane;
            ss[q] = 0.f;
#pragma unroll
            for (int j = 0; j < 4; ++j) { v[q][j] = xr[64 * j]; const u32x2 a = m0[64 * j], b = m1[64 * j]; const f32x4 g = g2[64 * j];
                v[q][j].x += g.x * (lo16(a.x) + lo16(b.x)); v[q][j].y += g.y * (hi16(a.x) + hi16(b.x)); v[q][j].z += g.z * (lo16(a.y) + lo16(b.y)); v[q][j].w += g.w * (hi16(a.y) + hi16(b.y));
                ss[q] += (v[q][j].x * v[q][j].x + v[q][j].y * v[q][j].y) + (v[q][j].z * v[q][j].z + v[q][j].w * v[q][j].w); } }
#pragma unroll
        for (int o = 1; o < 64; o <<= 1) {
#pragma unroll
            for (int q = 0; q < 4; ++q) ss[q] += shfl_xor_l(ss[q], o, lane); }
        const f32x4* gn = (const f32x4*)P.norm_f + lane;
#pragma unroll
        for (int q = 0; q < 4; ++q) { const int r = rb + q * stride; if (r >= RL) continue;
            const float rstd = 1.0f / sqrtf(ss[q] * (1.0f / D) + EPS); f32x4* xr = (f32x4*)(P.out + (size_t)r * D) + lane;
#pragma unroll
            for (int j = 0; j < 4; ++j) xr[64 * j] = v[q][j] * rstd * gn[64 * j]; }
    }
}

template <int MODE> __device__ __forceinline__ void ph_attn_ref(const Frame& F, const Ptrs& P, int l) {
    const int tid = fresh_tid();
    LAS float* Ks = (LAS float*)F.lds; LAS float* Vs = Ks + 64 * 64;
    const bf16_t* U = (const bf16_t*)(P.ws + WS_U);
    const bool latq = MODE < 2; const bool winm = (MODE == 1 || MODE == 3);
    const int NU = latq ? 1024 : 64; const int half = tid & 1;
    for (int u = F.vcu; u < NU; u += F.G) {
        const int qb = latq ? (u & 15) : 0, h = latq ? ((u >> 4) & 7) : (u & 7), b = latq ? (u >> 7) : (u >> 3), g = h >> 2;
        const int tq = qb * 256 + (tid >> 1);
        const int qrow = latq ? b * T + tq : RL + b * TC + tq;
        const int qcol = (winm ? C_QW : C_QB) + h * 64 + half * 32, kcol = (winm ? C_KW : C_KB) + g * 64, vcol = (winm ? C_VW : C_VB) + g * 64;
        unsigned q[16]; float o[32];
        { const u32x4* qp = (const u32x4*)(U + (size_t)qrow * NIN + qcol);
#pragma unroll
          for (int i = 0; i < 4; ++i) { const u32x4 w = qp[i]; q[4 * i] = w.x; q[4 * i + 1] = w.y; q[4 * i + 2] = w.z; q[4 * i + 3] = w.w; } }
#pragma unroll
        for (int d = 0; d < 32; ++d) o[d] = 0.f;
        float m = -INFINITY, lsum = 0.f;
        int lt_lo = 0, lt_hi = 0;
        if (MODE == 0) { lt_lo = 0; lt_hi = T / 64; }
        if (MODE == 1) { const int q0 = qb * 256; lt_lo = (q0 - 128 < 0 ? 0 : q0 - 128) / 64; lt_hi = (q0 + 384 > T ? T : q0 + 384) / 64; }
        const int ntiles = 4 + (lt_hi - lt_lo);
        for (int ti = 0; ti < ntiles; ++ti) {
            const bool isctx = ti < 4; const int kpos0 = isctx ? ti * 64 : (lt_lo + ti - 4) * 64;
            const int krow0 = isctx ? RL + b * TC + kpos0 : b * T + kpos0;
            __syncthreads();
            { const int j = tid >> 3, part = tid & 7; const u32x4 kw = *(const u32x4*)(U + (size_t)(krow0 + j) * NIN + kcol + part * 8), vw = *(const u32x4*)(U + (size_t)(krow0 + j) * NIN + vcol + part * 8);
              LAS float* kd = Ks + j * 64 + part * 8; LAS float* vd = Vs + j * 64 + part * 8;
              kd[0] = lo16(kw.x); kd[1] = hi16(kw.x); kd[2] = lo16(kw.y); kd[3] = hi16(kw.y); kd[4] = lo16(kw.z); kd[5] = hi16(kw.z); kd[6] = lo16(kw.w); kd[7] = hi16(kw.w);
              vd[0] = lo16(vw.x); vd[1] = hi16(vw.x); vd[2] = lo16(vw.y); vd[3] = hi16(vw.y); vd[4] = lo16(vw.z); vd[5] = hi16(vw.z); vd[6] = lo16(vw.w); vd[7] = hi16(vw.w); }
            __syncthreads();
#pragma unroll 1
            for (int jk = 0; jk < 64; ++jk) {
                float a = 0.f; const LAS f32x4* kr = (const LAS f32x4*)(Ks + jk * 64 + half * 32);
#pragma unroll
                for (int d4 = 0; d4 < 8; ++d4) { const f32x4 kv = kr[d4]; a += lo16(q[2 * d4]) * kv.x + hi16(q[2 * d4]) * kv.y + lo16(q[2 * d4 + 1]) * kv.z + hi16(q[2 * d4 + 1]) * kv.w; }
                a += shfl_xor_l(a, 1, tid & 63);
                if (MODE == 1 && !isctx) { const int dlt = kpos0 + jk - tq; if (dlt > 128 || dlt < -128) a = -INFINITY; }
                if (a != -INFINITY) {
                    if (a > m) { const float scl = exp2f(m - a); m = a; lsum *= scl;
#pragma unroll
                        for (int d = 0; d < 32; ++d) o[d] *= scl; }
                    const float p = exp2f(a - m); lsum += p; const LAS f32x4* vr = (const LAS f32x4*)(Vs + jk * 64 + half * 32);
#pragma unroll
                    for (int d4 = 0; d4 < 8; ++d4) { const f32x4 vv = vr[d4]; o[4 * d4] += p * vv.x; o[4 * d4 + 1] += p * vv.y; o[4 * d4 + 2] += p * vv.z; o[4 * d4 + 3] += p * vv.w; }
                }
            }
        }
        if (winm) lsum += exp2f(P.sink[l * 8 + h] * LOG2E - m);
        const float inv = 1.0f / lsum;
        { u32x4* op = (u32x4*)((bf16_t*)(P.ws + WS_BR) + (size_t)qrow * NBR + (winm ? 1024 : 512) + h * 64 + half * 32);
#pragma unroll
          for (int i = 0; i < 4; ++i) { u32x4 w; w.x = pk2(o[8 * i] * inv, o[8 * i + 1] * inv); w.y = pk2(o[8 * i + 2] * inv, o[8 * i + 3] * inv); w.z = pk2(o[8 * i + 4] * inv, o[8 * i + 5] * inv); w.w = pk2(o[8 * i + 6] * inv, o[8 * i + 7] * inv); op[i] = w; } }
        __syncthreads();
    }
}
__device__ __forceinline__ void ph_fourier_ref(const Frame& F, const Ptrs& P, int Ts, int latent) {
    const int tid = fresh_tid();
    LAS float* Zr = (LAS float*)F.lds; LAS float* Zi = Zr + 16 * 64; LAS float* Ct = Zi + 16 * 64; LAS float* St = Ct + 64 * 17;
    const bf16_t* U = (const bf16_t*)(P.ws + WS_U); const float* ct = (const float*)(P.ws + WS_COS);
    const int nkt = Ts / 64, NU = 8 * nkt * 8, step = 4096 / Ts;
    const int tk = tid >> 4, tc = tid & 15;
    for (int u = F.vcu; u < NU; u += F.G) {
        const int cht = u & 7, kt = (u >> 3) % nkt, b = (u >> 3) / nkt, k0 = kt * 64, ch0 = cht * 64;
        const int rbase = latent ? b * T : RL + b * TC;
        float acc[2][4];
#pragma unroll
        for (int i = 0; i < 2; ++i)
#pragma unroll
            for (int j = 0; j < 4; ++j) acc[i][j] = 0.f;
        for (int t0 = 0; t0 < Ts; t0 += 16) {
            __syncthreads();
            if (tid < 256) { const int tt = tid >> 4, c4 = (tid & 15) * 4; const bf16_t* zp = U + (size_t)(rbase + t0 + tt) * NIN + ch0 + c4;
              const u32x2 a = *(const u32x2*)(zp + C_ZR), bq = *(const u32x2*)(zp + C_ZI);
              Zr[tt * 64 + c4] = lo16(a.x); Zr[tt * 64 + c4 + 1] = hi16(a.x); Zr[tt * 64 + c4 + 2] = lo16(a.y); Zr[tt * 64 + c4 + 3] = hi16(a.y);
              Zi[tt * 64 + c4] = lo16(bq.x); Zi[tt * 64 + c4 + 1] = hi16(bq.x); Zi[tt * 64 + c4 + 2] = lo16(bq.y); Zi[tt * 64 + c4 + 3] = hi16(bq.y); }
#pragma unroll
            for (int i = 0; i < 2; ++i) { const int e = tid * 2 + i, k = e >> 4, tt = e & 15; const int ang = (((k0 + k) * (t0 + tt)) & (Ts - 1)) * step;
                Ct[k * 17 + tt] = ct[ang]; St[k * 17 + tt] = ct[(ang - 1024) & 4095]; }
            __syncthreads();
#pragma unroll 2
            for (int tt = 0; tt < 16; ++tt) { float zr[4], zi[4];
#pragma unroll
                for (int j = 0; j < 4; ++j) { zr[j] = Zr[tt * 64 + tc * 4 + j]; zi[j] = Zi[tt * 64 + tc * 4 + j]; }
#pragma unroll
                for (int i = 0; i < 2; ++i) { const float c = Ct[(tk * 2 + i) * 17 + tt], sn = St[(tk * 2 + i) * 17 + tt];
#pragma unroll
                    for (int j = 0; j < 4; ++j) acc[i][j] += c * zr[j] + sn * zi[j]; } }
        }
        const float sc = 1.0f / sqrtf((float)Ts);
        bf16_t* BR = (bf16_t*)(P.ws + WS_BR);
#pragma unroll
        for (int i = 0; i < 2; ++i) { u32x2 w; w.x = pk2(acc[i][0] * sc, acc[i][1] * sc); w.y = pk2(acc[i][2] * sc, acc[i][3] * sc);
            *(u32x2*)(BR + (size_t)(rbase + k0 + tk * 2 + i) * NBR + ch0 + tc * 4) = w; }
        __syncthreads();
    }
}

typedef float f32x16 __attribute__((ext_vector_type(16)));
typedef short v4i16_t __attribute__((ext_vector_type(4)));
constexpr float ATT_THR = 4.0f;
constexpr int AT_ROWB = 144, AT_TILEB = 64 * AT_ROWB;
constexpr int AT_VROWB = 192, AT_VTILEB = 64 * AT_VROWB;
constexpr int AT_STAGEB = 2 * AT_TILEB + 2 * AT_VTILEB;
#define AT_SB() __builtin_amdgcn_sched_barrier(0)
__device__ __forceinline__ void at_qk2(const LAS unsigned char* Ka, const LAS unsigned char* Kb, int kf_off, const bf16x8 (&qr)[4], const f32x16& negm, f32x16& pa0, f32x16& pa1, f32x16& pb0, f32x16& pb1) {
    bf16x8 ka[8], kb[8];
#pragma unroll
    for (int d0 = 0; d0 < 4; ++d0) { ka[2 * d0] = *(const LAS bf16x8*)(Ka + kf_off + d0 * 32); ka[2 * d0 + 1] = *(const LAS bf16x8*)(Ka + kf_off + 32 * AT_ROWB + d0 * 32); }
    AT_SB();
#pragma unroll
    for (int d0 = 0; d0 < 4; ++d0) {
        kb[2 * d0] = *(const LAS bf16x8*)(Kb + kf_off + d0 * 32); kb[2 * d0 + 1] = *(const LAS bf16x8*)(Kb + kf_off + 32 * AT_ROWB + d0 * 32);
        AT_SB();
        if (d0 == 0) { pa0 = __builtin_amdgcn_mfma_f32_32x32x16_bf16(ka[0], qr[0], negm, 0, 0, 0); pa1 = __builtin_amdgcn_mfma_f32_32x32x16_bf16(ka[1], qr[0], negm, 0, 0, 0); }
        else { pa0 = __builtin_amdgcn_mfma_f32_32x32x16_bf16(ka[2 * d0], qr[d0], pa0, 0, 0, 0); pa1 = __builtin_amdgcn_mfma_f32_32x32x16_bf16(ka[2 * d0 + 1], qr[d0], pa1, 0, 0, 0); }
        AT_SB();
    }
    pb0 = __builtin_amdgcn_mfma_f32_32x32x16_bf16(kb[0], qr[0], negm, 0, 0, 0); pb1 = __builtin_amdgcn_mfma_f32_32x32x16_bf16(kb[1], qr[0], negm, 0, 0, 0);
#pragma unroll
    for (int d0 = 1; d0 < 4; ++d0) { pb0 = __builtin_amdgcn_mfma_f32_32x32x16_bf16(kb[2 * d0], qr[d0], pb0, 0, 0, 0); pb1 = __builtin_amdgcn_mfma_f32_32x32x16_bf16(kb[2 * d0 + 1], qr[d0], pb1, 0, 0, 0); }
}
__device__ __forceinline__ void at_vread(const LAS unsigned char* vp, v4i16_t (&f)[4]) {
    f[0] = __builtin_amdgcn_ds_read_tr16_b64_v4i16((LAS v4i16_t*)(vp)); f[1] = __builtin_amdgcn_ds_read_tr16_b64_v4i16((LAS v4i16_t*)(vp + 8 * AT_VROWB));
    f[2] = __builtin_amdgcn_ds_read_tr16_b64_v4i16((LAS v4i16_t*)(vp + 64)); f[3] = __builtin_amdgcn_ds_read_tr16_b64_v4i16((LAS v4i16_t*)(vp + 8 * AT_VROWB + 64));
}
__device__ __forceinline__ bf16x8 at_ppack(const f32x16& p, int sx) { u32x4 pw; pw.x = cvtpk(p[8 * sx], p[8 * sx + 1]); pw.y = cvtpk(p[8 * sx + 2], p[8 * sx + 3]); pw.z = cvtpk(p[8 * sx + 4], p[8 * sx + 5]); pw.w = cvtpk(p[8 * sx + 6], p[8 * sx + 7]); return __builtin_bit_cast(bf16x8, pw); }
__device__ __forceinline__ void at_pvmm(const v4i16_t (&f)[4], const bf16x8 pf, f32x16& o0, f32x16& o1) {
    const bf16x8 v0 = (bf16x8){f[0][0], f[0][1], f[0][2], f[0][3], f[1][0], f[1][1], f[1][2], f[1][3]}, v1 = (bf16x8){f[2][0], f[2][1], f[2][2], f[2][3], f[3][0], f[3][1], f[3][2], f[3][3]};
    o0 = __builtin_amdgcn_mfma_f32_32x32x16_bf16(v0, pf, o0, 0, 0, 0); o1 = __builtin_amdgcn_mfma_f32_32x32x16_bf16(v1, pf, o1, 0, 0, 0);
}
__device__ __forceinline__ float at_exp8(f32x16& p, int sx) { float rs = 0.f;
#pragma unroll
    for (int j = 0; j < 8; ++j) { p[8 * sx + j] = __builtin_amdgcn_exp2f(p[8 * sx + j]); rs += p[8 * sx + j]; }
    return rs; }
__device__ __forceinline__ float at_exp_pv2(const LAS unsigned char* Va, const LAS unsigned char* Vb, int vf_off, f32x16& pa0, f32x16& pa1, f32x16& pb0, f32x16& pb1, f32x16& o0, f32x16& o1) {
    v4i16_t fA[4], fB[4]; float rs;
    at_vread(Va + vf_off, fA); rs = at_exp8(pa0, 0); AT_SB();
    at_vread(Va + vf_off + 16 * AT_VROWB, fB); at_pvmm(fA, at_ppack(pa0, 0), o0, o1); rs += at_exp8(pa0, 1); AT_SB();
    at_vread(Va + vf_off + 32 * AT_VROWB, fA); at_pvmm(fB, at_ppack(pa0, 1), o0, o1); rs += at_exp8(pa1, 0); AT_SB();
    at_vread(Va + vf_off + 48 * AT_VROWB, fB); at_pvmm(fA, at_ppack(pa1, 0), o0, o1); rs += at_exp8(pa1, 1); AT_SB();
    at_vread(Vb + vf_off, fA);                 at_pvmm(fB, at_ppack(pa1, 1), o0, o1); rs += at_exp8(pb0, 0); AT_SB();
    at_vread(Vb + vf_off + 16 * AT_VROWB, fB); at_pvmm(fA, at_ppack(pb0, 0), o0, o1); rs += at_exp8(pb0, 1); AT_SB();
    at_vread(Vb + vf_off + 32 * AT_VROWB, fA); at_pvmm(fB, at_ppack(pb0, 1), o0, o1); rs += at_exp8(pb1, 0); AT_SB();
    at_vread(Vb + vf_off + 48 * AT_VROWB, fB); at_pvmm(fA, at_ppack(pb1, 0), o0, o1); rs += at_exp8(pb1, 1); AT_SB();
    at_pvmm(fB, at_ppack(pb1, 1), o0, o1);
    return rs;
}
template <int MODE> __device__ __forceinline__ void ph_attn(const Frame& F, const Ptrs& P, int l) {
    const int lane = fresh_lane(), tid = F.wave * 64 + lane, r32 = lane & 31, hi = lane >> 5;
    const bf16_t* U = (const bf16_t*)(P.ws + WS_U);
    const bool latq = MODE < 2; const bool winm = (MODE == 1 || MODE == 3);
    const int NU = latq ? 1024 : 64;
    LAS unsigned char* Lb = F.lds;
    const int st_off = (tid >> 3) * AT_ROWB + (tid & 7) * 16;
    const int kf_off = r32 * AT_ROWB + hi * 16;
    const int sv_off = (tid >> 3) * AT_VROWB + (tid & 7) * 16;
    const int vf_off = (4 * hi + ((lane & 15) >> 2)) * AT_VROWB + (((lane >> 4) & 1) * 16 + (lane & 3) * 4) * 2;
    for (int u = F.vcu; u < NU; u += F.G) {
        const int qb = latq ? (u & 63) : (u & 3), g = latq ? ((u >> 6) & 1) : ((u >> 2) & 1), b = latq ? (u >> 7) : (u >> 3);
        const int tq0 = qb * 64, hq = 4 * g + (F.wave >> 1), tq = tq0 + 32 * (F.wave & 1) + r32;
        const int qrow = latq ? b * T + tq : RL + b * TC + tq;
        const int qcol = (winm ? C_QW : C_QB) + hq * 64, kcol = (winm ? C_KW : C_KB) + g * 64, vcol = (winm ? C_VW : C_VB) + g * 64;
        int lt_lo = 0, lt_hi = 0;
        if (MODE == 0) { lt_lo = 0; lt_hi = T / 64; }
        if (MODE == 1) { lt_lo = (tq0 - 128 < 0 ? 0 : tq0 - 128) / 64; lt_hi = (tq0 + 192 > T ? T : tq0 + 192) / 64; }
        const int ntiles = 4 + (lt_hi - lt_lo), npairs = (ntiles + 1) >> 1;
        bf16x8 qr[4];
        {
            float x[4][8];
#pragma unroll
            for (int d0 = 0; d0 < 4; ++d0) { const u32x4 wq = *(const u32x4*)(U + (size_t)qrow * NIN + qcol + d0 * 16 + hi * 8);
                x[d0][0] = lo16(wq.x); x[d0][1] = hi16(wq.x); x[d0][2] = lo16(wq.y); x[d0][3] = hi16(wq.y); x[d0][4] = lo16(wq.z); x[d0][5] = hi16(wq.z); x[d0][6] = lo16(wq.w); x[d0][7] = hi16(wq.w); }
            if (!winm) { float ss = 0.f;
#pragma unroll
                for (int d0 = 0; d0 < 4; ++d0)
#pragma unroll
                    for (int j = 0; j < 8; ++j) ss += x[d0][j] * x[d0][j];
                ss += shfl_xor_l(ss, 32, lane);
                const float rstd = 1.0f / sqrtf(ss * (1.0f / 64.0f) + EPS);
#pragma unroll
                for (int d0 = 0; d0 < 4; ++d0) { const f32x4 ga = *(const f32x4*)(P.q_gain + l * 64 + d0 * 16 + hi * 8), gb = *(const f32x4*)(P.q_gain + l * 64 + d0 * 16 + hi * 8 + 4);
                    x[d0][0] *= rstd * ga.x; x[d0][1] *= rstd * ga.y; x[d0][2] *= rstd * ga.z; x[d0][3] *= rstd * ga.w; x[d0][4] *= rstd * gb.x; x[d0][5] *= rstd * gb.y; x[d0][6] *= rstd * gb.z; x[d0][7] *= rstd * gb.w; } }
            if (latq) { const float* rc = (const float*)(P.ws + WS_ROPE); const float* rs = rc + 1024;
#pragma unroll
                for (int a = 0; a < 2; ++a) { const int pos = a ? (tq & 63) : (tq >> 6);
                    const f32x4 c0 = *(const f32x4*)(rc + pos * 16 + hi * 8), c1 = *(const f32x4*)(rc + pos * 16 + hi * 8 + 4), s0 = *(const f32x4*)(rs + pos * 16 + hi * 8), s1 = *(const f32x4*)(rs + pos * 16 + hi * 8 + 4);
                    const float cs[8] = {c0.x, c0.y, c0.z, c0.w, c1.x, c1.y, c1.z, c1.w}, sn[8] = {s0.x, s0.y, s0.z, s0.w, s1.x, s1.y, s1.z, s1.w};
#pragma unroll
                    for (int j = 0; j < 8; ++j) { const float x1 = x[2 * a][j], x2 = x[2 * a + 1][j]; x[2 * a][j] = x1 * cs[j] - x2 * sn[j]; x[2 * a + 1][j] = x2 * cs[j] + x1 * sn[j]; } } }
#pragma unroll
            for (int d0 = 0; d0 < 4; ++d0) { u32x4 wq; wq.x = cvtpk(x[d0][0] * QSCALE, x[d0][1] * QSCALE); wq.y = cvtpk(x[d0][2] * QSCALE, x[d0][3] * QSCALE); wq.z = cvtpk(x[d0][4] * QSCALE, x[d0][5] * QSCALE); wq.w = cvtpk(x[d0][6] * QSCALE, x[d0][7] * QSCALE);
                qr[d0] = __builtin_bit_cast(bf16x8, wq); }
        }
        f32x16 o0, o1, negm;
#pragma unroll
        for (int r = 0; r < 16; ++r) { o0[r] = 0.f; o1[r] = 0.f; negm[r] = 0.f; }
        float mhat = 0.f, lsum = 0.f;
#define AT_KROW(ti) ((ti) < 4 ? RL + b * TC + (ti) * 64 : b * T + (lt_lo + (ti) - 4) * 64)
        u32x4 ka, va, kb2, vb2;
        { const int r0 = AT_KROW(0) + (tid >> 3), r1 = AT_KROW(1) + (tid >> 3); const int co = (tid & 7) * 8;
          ka = *(const u32x4*)(U + (size_t)r0 * NIN + kcol + co); va = *(const u32x4*)(U + (size_t)r0 * NIN + vcol + co);
          kb2 = *(const u32x4*)(U + (size_t)r1 * NIN + kcol + co); vb2 = *(const u32x4*)(U + (size_t)r1 * NIN + vcol + co);
          *(LAS u32x4*)(Lb + st_off) = ka; *(LAS u32x4*)(Lb + AT_TILEB + st_off) = kb2; *(LAS u32x4*)(Lb + 2 * AT_TILEB + sv_off) = va; *(LAS u32x4*)(Lb + 2 * AT_TILEB + AT_VTILEB + sv_off) = vb2; }
        __syncthreads();
        for (int tp = 0; tp < npairs; ++tp) {
            const int cur = (tp & 1) * AT_STAGEB, nxt = AT_STAGEB - cur;
            const bool more = tp + 1 < npairs;
            const int ta = 2 * tp, tb = 2 * tp + 1; const bool hasb = tb < ntiles;
            if (more) { const int na = 2 * tp + 2, nb = (2 * tp + 3 < ntiles) ? 2 * tp + 3 : na;
                const int r0 = AT_KROW(na) + (tid >> 3), r1 = AT_KROW(nb) + (tid >> 3); const int co = (tid & 7) * 8;
                ka = *(const u32x4*)(U + (size_t)r0 * NIN + kcol + co); va = *(const u32x4*)(U + (size_t)r0 * NIN + vcol + co);
                kb2 = *(const u32x4*)(U + (size_t)r1 * NIN + kcol + co); vb2 = *(const u32x4*)(U + (size_t)r1 * NIN + vcol + co); }
            f32x16 pa0, pa1, pb0, pb1;
            at_qk2(Lb + cur, Lb + cur + AT_TILEB, kf_off, qr, negm, pa0, pa1, pb0, pb1);
            if (MODE == 1) {
                const int qlo = tq0 + 32 * (F.wave & 1);
                if (ta >= 4) { const int kb0 = (lt_lo + ta - 4) * 64;
                    if (kb0 + 63 - qlo > 128 || qlo + 31 - kb0 > 128) { const int kp0 = kb0 + 4 * hi - tq;
#pragma unroll
                        for (int r = 0; r < 16; ++r) { const int dl = kp0 + (r & 3) + 8 * (r >> 2);
                            if (dl > 128 || dl < -128) pa0[r] = -INFINITY;
                            if (dl + 32 > 128 || dl + 32 < -128) pa1[r] = -INFINITY; } } }
                if (tb >= 4 && hasb) { const int kb0 = (lt_lo + tb - 4) * 64;
                    if (kb0 + 63 - qlo > 128 || qlo + 31 - kb0 > 128) { const int kp0 = kb0 + 4 * hi - tq;
#pragma unroll
                        for (int r = 0; r < 16; ++r) { const int dl = kp0 + (r & 3) + 8 * (r >> 2);
                            if (dl > 128 || dl < -128) pb0[r] = -INFINITY;
                            if (dl + 32 > 128 || dl + 32 < -128) pb1[r] = -INFINITY; } } }
                if (!hasb) {
#pragma unroll
                    for (int r = 0; r < 16; ++r) { pb0[r] = -INFINITY; pb1[r] = -INFINITY; } }
            }
            float mx = fmaxf(fmaxf(pa0[0], pa1[0]), fmaxf(pb0[0], pb1[0]));
#pragma unroll
            for (int r = 1; r < 16; ++r) mx = fmaxf(mx, fmaxf(fmaxf(pa0[r], pa1[r]), fmaxf(pb0[r], pb1[r])));
            mx = fmaxf(mx, shfl_xor_l(mx, 32, lane));
            if (tp == 0 || __any(mx > ATT_THR)) {
                const float dl = tp == 0 ? mx : fmaxf(mx, 0.f);
                mhat += dl;
                const float alpha = __builtin_amdgcn_exp2f(-dl); lsum *= alpha;
#pragma unroll
                for (int r = 0; r < 16; ++r) { pa0[r] -= dl; pa1[r] -= dl; pb0[r] -= dl; pb1[r] -= dl; o0[r] *= alpha; o1[r] *= alpha; negm[r] = -mhat; }
            }
            lsum += at_exp_pv2(Lb + cur + 2 * AT_TILEB, Lb + cur + 2 * AT_TILEB + AT_VTILEB, vf_off, pa0, pa1, pb0, pb1, o0, o1);
            if (more) { *(LAS u32x4*)(Lb + nxt + st_off) = ka; *(LAS u32x4*)(Lb + nxt + AT_TILEB + st_off) = kb2; *(LAS u32x4*)(Lb + nxt + 2 * AT_TILEB + sv_off) = va; *(LAS u32x4*)(Lb + nxt + 2 * AT_TILEB + AT_VTILEB + sv_off) = vb2; }
            __syncthreads();
        }
#undef AT_KROW
        lsum += shfl_xor_l(lsum, 32, lane);
        if (winm) lsum += exp2f(P.sink[l * 8 + hq] * LOG2E - mhat);
        const float inv = 1.0f / lsum;
        bf16_t* op = (bf16_t*)(P.ws + WS_BR) + (size_t)qrow * NBR + (winm ? 1024 : 512) + hq * 64 + 4 * hi;
#pragma unroll
        for (int gq = 0; gq < 4; ++gq) {
            u32x2 w0, w1; w0.x = cvtpk(o0[4 * gq] * inv, o0[4 * gq + 1] * inv); w0.y = cvtpk(o0[4 * gq + 2] * inv, o0[4 * gq + 3] * inv);
            w1.x = cvtpk(o1[4 * gq] * inv, o1[4 * gq + 1] * inv); w1.y = cvtpk(o1[4 * gq + 2] * inv, o1[4 * gq + 3] * inv);
            *(u32x2*)(op + 8 * gq) = w0; *(u32x2*)(op + 32 + 8 * gq) = w1; }
    }
}

constexpr int DF_ROWB = 528;
template <int STAGE> __device__ __forceinline__ void ph_dft(const Frame& F, const Ptrs& P) {
    const int lane = fresh_lane(), tid = F.wave * 64 + lane, r32 = lane & 31, hi = lane >> 5, w = F.wave;
    bf16_t* U = (bf16_t*)(P.ws + WS_U); bf16_t* BR = (bf16_t*)(P.ws + WS_BR); const bf16_t* Wm = (const bf16_t*)(P.ws + WS_DFTM);
    LAS unsigned char* Xl = F.lds;
    const int xf_off = (8 * hi + ((lane & 15) >> 2)) * DF_ROWB + (32 * w + ((lane >> 4) & 1) * 16 + (lane & 3) * 4) * 2;
    constexpr int NMB = STAGE == 2 ? 4 : 2;
    const int seg = tid >> 2, part = tid & 3, pp = seg >> 6, jj = seg & 63;
    u32x4 pf[8];
    if (F.vcu < 1024) { const int u = F.vcu; const int chb = u & 1, sidx = (u >> 1) & 63, b = u >> 7;
        const int grow = STAGE == 2 ? b * T + 64 * jj + sidx : b * T + 64 * sidx + jj;
        const u32x4* src = (const u32x4*)(U + (size_t)grow * NIN + pp * 512 + chb * 256 + part * 64);
#pragma unroll
        for (int i = 0; i < 8; ++i) pf[i] = src[i]; }
    for (int u = F.vcu; u < 1024; u += F.G) {
        const int chb = u & 1, sidx = (u >> 1) & 63, b = u >> 7;
#pragma unroll
        for (int i = 0; i < 8; ++i) *(LAS u32x4*)(Xl + seg * DF_ROWB + part * 128 + i * 16) = pf[i];
        if (u + F.G < 1024) { const int un = u + F.G; const int chbn = un & 1, sn = (un >> 1) & 63, bn = un >> 7;
            const int grow = STAGE == 2 ? bn * T + 64 * jj + sn : bn * T + 64 * sn + jj;
            const u32x4* src = (const u32x4*)(U + (size_t)grow * NIN + pp * 512 + chbn * 256 + part * 64);
#pragma unroll
            for (int i = 0; i < 8; ++i) pf[i] = src[i]; }
        __syncthreads();
        f32x16 acc[NMB];
#pragma unroll
        for (int mb = 0; mb < NMB; ++mb)
#pragma unroll
            for (int r = 0; r < 16; ++r) acc[mb][r] = 0.f;
#pragma unroll
        for (int ks = 0; ks < 8; ++ks) {
            const v4i16_t lo4 = __builtin_amdgcn_ds_read_tr16_b64_v4i16((LAS v4i16_t*)(Xl + xf_off + (16 * ks) * DF_ROWB));
            const v4i16_t hi4 = __builtin_amdgcn_ds_read_tr16_b64_v4i16((LAS v4i16_t*)(Xl + xf_off + (16 * ks + 4) * DF_ROWB));
            const bf16x8 xf = (bf16x8){lo4[0], lo4[1], lo4[2], lo4[3], hi4[0], hi4[1], hi4[2], hi4[3]};
#pragma unroll
            for (int mb = 0; mb < NMB; ++mb) { const bf16x8 wf = *(const bf16x8*)(Wm + (mb * 32 + r32) * 128 + 16 * ks + 8 * hi);
                acc[mb] = __builtin_amdgcn_mfma_f32_32x32x16_bf16(xf, wf, acc[mb], 0, 0, 0); }
        }
        LAS unsigned char* ob = Xl + (32 * w + 4 * hi) * 2;
        if (STAGE == 2) {
#pragma unroll
            for (int mb = 0; mb < 2; ++mb) { const int k1 = mb * 32 + r32; const float rev = (float)((k1 * sidx) & 4095) * (1.0f / 4096.0f);
                const float ct = __builtin_amdgcn_cosf(rev), st = __builtin_amdgcn_sinf(rev);
#pragma unroll
                for (int gq = 0; gq < 4; ++gq) { u32x2 wr, wi; float yr[4], yi[4];
#pragma unroll
                    for (int i = 0; i < 4; ++i) { const float a = acc[mb][4 * gq + i], bq = acc[mb + 2][4 * gq + i]; yr[i] = a * ct + bq * st; yi[i] = bq * ct - a * st; }
                    wr.x = cvtpk(yr[0], yr[1]); wr.y = cvtpk(yr[2], yr[3]); wi.x = cvtpk(yi[0], yi[1]); wi.y = cvtpk(yi[2], yi[3]);
                    *(LAS u32x2*)(ob + k1 * DF_ROWB + 16 * gq) = wr; *(LAS u32x2*)(ob + (64 + k1) * DF_ROWB + 16 * gq) = wi; } }
        } else {
#pragma unroll
            for (int mb = 0; mb < 2; ++mb) { const int k2 = mb * 32 + r32;
#pragma unroll
                for (int gq = 0; gq < 4; ++gq) { u32x2 wr; wr.x = cvtpk(acc[mb][4 * gq] * 0.015625f, acc[mb][4 * gq + 1] * 0.015625f); wr.y = cvtpk(acc[mb][4 * gq + 2] * 0.015625f, acc[mb][4 * gq + 3] * 0.015625f);
                    *(LAS u32x2*)(ob + k2 * DF_ROWB + 16 * gq) = wr; } }
        }
        __syncthreads();
        if (STAGE == 2) {
            u32x4* dst = (u32x4*)(U + (size_t)(b * T + 64 * jj + sidx) * NIN + pp * 512 + chb * 256 + part * 64);
#pragma unroll
            for (int i = 0; i < 8; ++i) dst[i] = *(const LAS u32x4*)(Xl + seg * DF_ROWB + part * 128 + i * 16);
        } else { const int k2 = tid >> 3, part8 = tid & 7;
            u32x4* dst = (u32x4*)(BR + (size_t)(b * T + 64 * k2 + sidx) * NBR + chb * 256 + part8 * 32);
#pragma unroll
            for (int i = 0; i < 4; ++i) dst[i] = *(const LAS u32x4*)(Xl + k2 * DF_ROWB + part8 * 64 + i * 16); }
        __syncthreads();
    }
}

struct MegaArgs { Ptrs P; int ph_lo, ph_hi, li, pad; };
__global__ void __launch_bounds__(NWAVES * 64, 2) mega(MegaArgs args) {
    extern __shared__ __attribute__((aligned(16))) unsigned char lds_raw[];
    Frame F; F.lds = (LAS unsigned char*)lds_raw;
    F.wave = __builtin_amdgcn_readfirstlane(threadIdx.x >> 6);
    F.G = gridDim.x; { const int bx = blockIdx.x; F.vcu = (F.G % 8 == 0) ? (bx % 8) * (F.G / 8) + bx / 8 : bx; }
    const Ptrs& P = args.P;
    for (int u = fresh_tid(); u < (LDS_BYTES - LDSCTL_OFF) / 4; u += NWAVES * 64) ((LAS unsigned*)(F.lds + LDSCTL_OFF))[u] = 0u;
    __syncthreads();
    volatile LAS unsigned* MISC = (volatile LAS unsigned*)(F.lds + MISC_OFF);
    XcdBarrier bar = xcd_barrier_post((unsigned*)(P.ws + WS_CTL) + CW_BAR + args.li * XCD_BAR_WORDS, MISC + 8, F.wave);
    const int lo = args.ph_lo, hi = args.ph_hi;
    unsigned char* ws = P.ws;
    bf16_t* H = (bf16_t*)(ws + WS_H); bf16_t* U = (bf16_t*)(ws + WS_U); bf16_t* BR = (bf16_t*)(ws + WS_BR);
    bf16_t* MG = (bf16_t*)(ws + WS_MG); bf16_t* AS = (bf16_t*)(ws + WS_AS); bf16_t* HID = (bf16_t*)(ws + WS_HID); bf16_t* MO = (bf16_t*)(ws + WS_MO);
    const bf16_t* Bt_in = (const bf16_t*)(ws + WS_WB + WB_IN); const bf16_t* Bt_gate = (const bf16_t*)(ws + WS_WB + WB_GATE); const bf16_t* Bt_br = (const bf16_t*)(ws + WS_WB + WB_BR);
    const bf16_t* Bt_out = (const bf16_t*)(ws + WS_WB + WB_OUT); const bf16_t* Bt_13 = (const bf16_t*)(ws + WS_WB + WB_13); const bf16_t* Bt_2 = (const bf16_t*)(ws + WS_WB + WB_2);
#define IN(g) (lo <= (g) && (g) < hi)
#define SEAM(g) do { if ((g) + 1 < hi) xcd_barrier(bar); } while (0)
    for (int l = 0; l < 2; ++l) {
        const int pb = l * NPH; const int M = l == 0 ? R : RL;
        if (IN(pb + 0)) { if (l == 0) ph_tables_mod(F, P); ph_weights(F, P, l); if (l == 0) SEAM(pb + 0); }
        if (IN(pb + 1)) { if (l == 0) ph_norm<0>(F, P, l, R); else ph_norm<1>(F, P, l, R); SEAM(pb + 1); }
        if (IN(pb + 2)) {
            pg8::StaticOrder S; S.init(R, NIN, F.G, (int)blockIdx.x, H, D, Bt_in, D);
            pg8::EpiV8<FStore8> E{FStore8{U, NIN}};
            pg8::gemm_phase(F.lds, F.wave, D, D, D, S, E);
            SEAM(pb + 2);
        }
        if (IN(pb + 3)) { ph_kprep(F, P, l); ph_pool(F, P, M); SEAM(pb + 3); }
        if (IN(pb + 4)) {
            ph_dft<2>(F, P); ph_attn<1>(F, P, l);
            if (l == 0) { ph_attn<2>(F, P, l); ph_attn<3>(F, P, l); ph_fourier_ref(F, P, TC, 0); }
            xcd_barrier(bar);
            ph_dft<3>(F, P); ph_attn<0>(F, P, l);
            SEAM(pb + 4);
        }
        if (IN(pb + 5)) {
            pg8::StaticOrder S; S.init(M, 4096, F.G, (int)blockIdx.x, H, D, Bt_gate, D);
            pg8::EpiV8<FGateU8> E{FGateU8{(unsigned char*)(ws + WS_GT), P.b_gate + (size_t)l * 4096}};
            pg8::gemm_phase(F.lds, F.wave, D, D, D, S, E);
            SEAM(pb + 5);
        }
        if (IN(pb + 6)) {
            pg8::StaticOrder S; S.init(M, D, F.G, (int)blockIdx.x, BR, NBR, Bt_br, NBR);
            pg8::EpiMergeS E{(const unsigned char*)(ws + WS_GT), MG};
            pg8::gemm_phase(F.lds, F.wave, NBR, NBR, NBR, S, E);
            xcd_barrier(bar);
        }
        if (IN(pb + 10)) {
            pg8::StaticOrder S; S.init(M, D, F.G, (int)blockIdx.x, MG, D, Bt_out, D);
            pg8::EpiV4<FOut> E{FOut{P, l}};
            pg8::gemm_phase(F.lds, F.wave, D, D, D, S, E);
            SEAM(pb + 10);
        }
        if (IN(pb + 11)) { ph_norm<2>(F, P, l, M); xcd_barrier(bar); }
        if (IN(pb + 13) || IN(pb + 14)) {
            LAS int* ptab = (LAS int*)(F.lds + LDSCTL_OFF);
            if (fresh_tid() == 0) { const unsigned* cnt = (const unsigned*)(ws + WS_CTL) + CW_CNT + 1024 * l; int off = 0;
                for (int e = 0; e < 16; ++e) { const int c = (int)cnt[64 * e]; ptab[e] = off; ptab[17 + e] = c; off += (c + 255) >> 8; } ptab[16] = off; }
            __syncthreads();
            if (IN(pb + 13)) {
                pg8::MoeOrder<true> S; S.nN = 4; S.G = F.G; S.c = F.vcu; S.A = (const char*)H; S.Bt = (const char*)Bt_13; S.astep = 0; S.bstep = (size_t)256 * D * 2; S.bexp = (size_t)1024 * 1024 * 2; S.tab = (const int*)ptab; S.tokl = (const int*)(ws + WS_TOKL);
                pg8::EpiDual<FMoe1> E{FMoe1{HID}};
                pg8::gemm_phase(F.lds, F.wave, D, D, D, S, E);
                SEAM(pb + 13);
            }
            if (IN(pb + 14)) {
                pg8::MoeOrder<false> S; S.nN = 4; S.G = F.G; S.c = F.vcu; S.A = (const char*)HID; S.Bt = (const char*)Bt_2; S.astep = (size_t)256 * FF * 2; S.bstep = (size_t)256 * FF * 2; S.bexp = (size_t)1024 * 512 * 2; S.tab = (const int*)ptab; S.tokl = nullptr;
                pg8::EpiV8<FMoe2> E{FMoe2{MO, (const int*)(ws + WS_TOKL), (const float*)(ws + WS_WL)}};
                pg8::gemm_phase(F.lds, F.wave, FF, FF, FF, S, E);
                SEAM(pb + 14);
            }
        }
    }
    if (IN(PH_FINAL)) ph_final(F, P);
#undef IN
#undef SEAM
}

extern "C" void kernel_launch(void* const* d_in, const int* in_sizes, int n_in, void* d_out, int out_size, void* d_ws, size_t ws_size, hipStream_t stream) {
    if (n_in != 24 || ws_size < WS_END || out_size != RL * D) { fprintf(stderr, "kernel_launch: unexpected sizes n_in %d ws %zu out %d\n", n_in, ws_size, out_size); return; }
    static int grid = 0;
    if (grid == 0) {
        int dev = 0, cus = 0;
        if (hipGetDevice(&dev) != hipSuccess || hipDeviceGetAttribute(&cus, hipDeviceAttributeMultiprocessorCount, dev) != hipSuccess) { grid = -1; return; }
        if (hipFuncSetAttribute((const void*)mega, hipFuncAttributeMaxDynamicSharedMemorySize, LDS_BYTES) != hipSuccess) { fprintf(stderr, "kernel_launch: hipFuncSetAttribute failed\n"); grid = -1; return; }
        int per_cu = 0;
        if (hipOccupancyMaxActiveBlocksPerMultiprocessor(&per_cu, (const void*)mega, NWAVES * 64, LDS_BYTES) != hipSuccess || per_cu < 1) fprintf(stderr, "kernel_launch: occupancy query says %d\n", per_cu);
        (void)hipGetLastError();
        grid = cus;
    }
    if (grid < 0) return;
    MegaArgs a{};
    const float** pp = (const float**)&a.P;
    for (int i = 0; i < 24; ++i) pp[i] = (const float*)d_in[i];
    a.P.out = (float*)d_out; a.P.ws = (unsigned char*)d_ws;
    (void)hipMemsetAsync((unsigned char*)d_ws + WS_CTL, 0, 128 * 1024, stream);
    a.ph_lo = 0; a.ph_hi = PH_FINAL + 1; a.li = 0;
    hipLaunchKernelGGL(mega, dim3(grid), dim3(NWAVES * 64), LDS_BYTES, stream, a);
}
```

```cpp
#include <hip/hip_runtime.h>
#include <cstdio>
#include <cstdint>

typedef unsigned short bf16_t;
typedef short bf16x8 __attribute__((ext_vector_type(8)));
typedef float f32x4 __attribute__((ext_vector_type(4)));
typedef unsigned u32x4 __attribute__((ext_vector_type(4)));
typedef unsigned u32x2 __attribute__((ext_vector_type(2)));

constexpr int D = 1024, NB = 8, T = 4096, TC = 256;
constexpr int RL = NB * T, RC = NB * TC, R = RL + RC;
constexpr int NIN = 3072;
constexpr int C_ZR = 0, C_ZI = 512, C_P = 1024, C_QB = 1536, C_KB = 2048, C_VB = 2176, C_QW = 2304, C_KW = 2816, C_VW = 2944;
constexpr int NBR = 2048;
constexpr int NE = 16, FF = 512;
constexpr int MAXROWS = 73728;
constexpr float EPS = 1e-6f;
constexpr float QSCALE = 0.125f * 1.4426950408889634f;
constexpr float LOG2E = 1.4426950408889634f;

constexpr size_t MiB = 1u << 20;
constexpr size_t WS_CTL = 0;
constexpr size_t WS_MOD = 1 * MiB;
constexpr size_t WS_ROPE = 1 * MiB + 512 * 1024;
constexpr size_t WS_COS = WS_ROPE + 16 * 1024;
constexpr size_t WS_DFTM = WS_ROPE + 64 * 1024;
constexpr size_t WS_TOKL = 2 * MiB;
constexpr size_t WS_WL = 4 * MiB + 512 * 1024;
constexpr size_t WS_XC = 9 * MiB;
constexpr size_t WS_WB = 17 * MiB;
constexpr size_t WB_IN = 0, WB_GATE = 6 * MiB, WB_BR = 14 * MiB, WB_OUT = 18 * MiB, WB_13 = 20 * MiB, WB_2 = 52 * MiB;
constexpr size_t WS_H = 85 * MiB;
constexpr size_t WS_ARENA = 153 * MiB;
constexpr size_t WS_U = WS_ARENA;
constexpr size_t WS_BR = WS_ARENA + 204 * MiB;
constexpr size_t WS_GT = WS_ARENA;
constexpr size_t WS_MG = WS_ARENA + 136 * MiB;
constexpr size_t WS_HID = WS_ARENA + 144 * MiB;
constexpr size_t WS_MO = WS_ARENA + 216 * MiB;
constexpr size_t WS_END = 512 * MiB;
static_assert(WS_BR + (size_t)R * NBR * 2 <= WS_END && WS_MO + (size_t)2 * R * D * 2 <= WS_END && WS_MG + (size_t)R * D * 2 <= WS_BR, "ws map");
constexpr int CW_CNT = 8192;

__device__ __forceinline__ float bf2f(bf16_t b) { return __uint_as_float(((unsigned)b) << 16); }
__device__ __forceinline__ unsigned f2bf(float f) { unsigned u = __float_as_uint(f); return (u + 0x7fffu + ((u >> 16) & 1u)) >> 16; }
__device__ __forceinline__ unsigned pk2(float lo, float hi) { return f2bf(lo) | (f2bf(hi) << 16); }
typedef __bf16 bf16x2_t __attribute__((ext_vector_type(2)));
typedef float f32x2_t __attribute__((ext_vector_type(2)));
__device__ __forceinline__ unsigned cvtpk(float lo, float hi) { f32x2_t v = {lo, hi}; bf16x2_t b = __builtin_convertvector(v, bf16x2_t); return __builtin_bit_cast(unsigned, b); }
__device__ __forceinline__ float lo16(unsigned w) { return __uint_as_float(w << 16); }
__device__ __forceinline__ float hi16(unsigned w) { return __uint_as_float(w & 0xffff0000u); }
__device__ __forceinline__ float shfl_xor_l(float v, int o, int lane) { return __int_as_float(__builtin_amdgcn_ds_bpermute((lane ^ o) << 2, __float_as_int(v))); }
__device__ __forceinline__ float wave_sum_l(float v, int lane) {
#pragma unroll
    for (int o = 1; o < 64; o <<= 1) v += shfl_xor_l(v, o, lane);
    return v;
}
__device__ __forceinline__ int row_bb(int r) { return r < RL ? (r >> 12) : 8; }

struct Ptrs {
    const float *x, *c, *ctx, *c_ctx, *w_ada, *b_ada, *norm1, *norm2, *w_in, *q_gain, *k_gain, *sink, *pool_w, *pool_scale,
        *w_branch, *w_gate, *b_gate, *w_out, *router_w, *router_bias, *w1, *w3, *w2, *norm_f;
    float* out; unsigned char* ws;
};
__device__ __forceinline__ const float* xin_row(const Ptrs& P, int r) { return r < RL ? P.x + (size_t)r * D : P.ctx + (size_t)(r - RL) * D; }
__device__ __forceinline__ float* x1_row(const Ptrs& P, int r) { return r < RL ? P.out + (size_t)r * D : (float*)(P.ws + WS_XC) + (size_t)(r - RL) * D; }
__device__ __forceinline__ const float* mod_vec(const Ptrs& P, int l, int bb, int which) { return (const float*)(P.ws + WS_MOD) + ((size_t)(l * 9 + bb) * 6 + which) * D; }

#define LAS __attribute__((address_space(3)))
#define GAS __attribute__((address_space(1)))
#define LDS_WAIT() asm volatile("s_waitcnt lgkmcnt(0)" ::: "memory")
__device__ __forceinline__ int fresh_lane() { int l; asm volatile("v_mbcnt_lo_u32_b32 %0, -1, 0\n\tv_mbcnt_hi_u32_b32 %0, -1, %0" : "=v"(l)); return l; }
constexpr int NWAVES = 8;
constexpr int RING_BYTES = 131072, LDSCTL_OFF = RING_BYTES, MISC_OFF = LDSCTL_OFF + 320, LDS_BYTES = 147456;
constexpr int CW_BAR = 16384;
constexpr int NPH = 15, PH_FINAL = 2 * NPH;

#define XB_TMO      128
#define XB_XCNT(j)  (256  + 64 * (j))
#define XB_XSUB(j)  (1280 + 64 * (j))
#define XB_XGEN(j)  (2304 + 64 * (j))
#define XB_TOP      3328
#define XB_TOPGEN   3392
#define XCD_BAR_WORDS 3456
#define XB_SPIN_CAP (1u << 21)
__device__ __forceinline__ unsigned xb_ld(unsigned* p)              { return __hip_atomic_load(p, __ATOMIC_RELAXED, __HIP_MEMORY_SCOPE_AGENT); }
__device__ __forceinline__ unsigned xb_add(unsigned* p, unsigned v) { return __hip_atomic_fetch_add(p, v, __ATOMIC_RELAXED, __HIP_MEMORY_SCOPE_AGENT); }
__device__ __forceinline__ unsigned xb_xcc_id() { return (unsigned)__builtin_amdgcn_s_getreg((3 << 11) | 20) & 0xFu; }
#define XB_SPIN(cond, bar) do { unsigned _sp = 0; while (cond) { __builtin_amdgcn_s_sleep(1); \
    if ((++_sp & 255u) == 0u) { if (xb_ld(&(bar)[XB_TMO])) break; if (_sp > XB_SPIN_CAP) { atomicAdd(&(bar)[XB_TMO], 1u); break; } } } } while (0)
struct XcdBarrier { unsigned* bar; unsigned x; volatile LAS unsigned* st; int wave; };
__device__ __forceinline__ XcdBarrier xcd_barrier_post(unsigned* bar, volatile LAS unsigned* st, int wave) {
    XcdBarrier b; b.bar = bar; b.x = xb_xcc_id(); b.st = st; b.wave = wave;
    if (wave == 0 && fresh_lane() == 0) (void)xb_add(&bar[XB_XCNT(b.x)], 1u);
    return b;
}
__device__ __forceinline__ void xcd_barrier_complete(unsigned* bar, unsigned x, unsigned& nloc, unsigned& nx) {
    const unsigned G = gridDim.x * gridDim.y * gridDim.z;
    unsigned sum, cnt, mine, sp = 0u;
    for (;;) {
        sum = 0u; cnt = 0u; mine = 0u;
#pragma unroll
        for (unsigned j = 0; j < 16; ++j) { const unsigned c = xb_ld(&bar[XB_XCNT(j)]); sum += c; cnt += (c > 0u) ? 1u : 0u; mine = (j == x) ? c : mine; }
        if (sum == G) break;
        __builtin_amdgcn_s_sleep(1);
        if ((++sp & 255u) == 0u) { if (xb_ld(&bar[XB_TMO])) break; if (sp > XB_SPIN_CAP) { atomicAdd(&bar[XB_TMO], 1u); break; } }
    }
    nloc = mine > 0u ? mine : 1u; nx = cnt > 0u ? cnt : 1u;
}
__device__ __forceinline__ void xcd_barrier(const XcdBarrier& b) {
    asm volatile("s_waitcnt vmcnt(0)" ::: "memory");
    __syncthreads();
    if (b.wave == 0 && fresh_lane() == 0) {
        unsigned* bar = b.bar;
        __builtin_amdgcn_s_waitcnt(0);
        unsigned nloc = b.st[0], nx = b.st[1];
        if (nloc == 0u) { xcd_barrier_complete(bar, b.x, nloc, nx); b.st[0] = nloc; b.st[1] = nx; }
        const unsigned old = xb_add(&bar[XB_XSUB(b.x)], 1u);
        const unsigned gen = old / nloc;
        if (old + 1u == (gen + 1u) * nloc) {
            __builtin_amdgcn_fence(__ATOMIC_RELEASE, "agent");
            asm volatile("s_waitcnt vmcnt(0)" ::: "memory");
            const unsigned og = xb_add(&bar[XB_TOP], 1u);
            const unsigned tg = og / nx;
            if (og + 1u == (tg + 1u) * nx) xb_add(&bar[XB_TOPGEN], 1u);
            else XB_SPIN(xb_ld(&bar[XB_TOPGEN]) == tg, bar);
            __builtin_amdgcn_fence(__ATOMIC_ACQUIRE, "agent");
            xb_add(&bar[XB_XGEN(b.x)], 1u);
            asm volatile("s_waitcnt vmcnt(0)" ::: "memory");
        } else {
            XB_SPIN(xb_ld(&bar[XB_XGEN(b.x)]) == gen, bar);
            __builtin_amdgcn_fence(__ATOMIC_ACQUIRE, "agent");
            asm volatile("s_waitcnt vmcnt(0)" ::: "memory");
        }
    }
    __syncthreads();
}

namespace pg8 {
constexpr int BM = 256, BK = 64, HALF = 128, HTB = HALF * BK * 2, STAGE_BYTES = 8 * HTB, NXCD = 8, WGM = 8;
__host__ __device__ __forceinline__ int lds_byte(int r, int c) { const int st = (r >> 4) * 2 + (c >> 5), rr = r & 15, cc = c & 31, ob = rr * 64 + cc * 2; return st * 1024 + (ob ^ (((ob >> 9) & 1) << 5)); }
__host__ __device__ __forceinline__ void stage_rc(int b, int& Rr, int& C) { const int st = b / 1024, sb = b % 1024, swz = sb ^ (((sb >> 9) & 1) << 5); Rr = (st >> 1) * 16 + swz / 64; C = (st & 1) * 32 + (swz % 64) / 2; }
__host__ __device__ __forceinline__ int perm32(int rho) { const int n = rho >> 4, i = rho & 15; return 8 * (i >> 2) + 4 * n + (i & 3); }
struct Unit { int pm, pn; const char* a; const char* b; int e, p0, ce; };

struct StaticOrder {
    static constexpr bool GATHER = false;
    int nM, nN, nwg, G, c; const char* A; const char* Bt; size_t astep, bstep;
    __device__ void init(int M, int N, int G_, int c_, const bf16_t* A_, int lda, const bf16_t* Bt_, int ldb) { nM = M / BM; nN = N / BM; nwg = nM * nN; G = G_; c = c_; A = (const char*)A_; Bt = (const char*)Bt_; astep = (size_t)BM * lda * 2; bstep = (size_t)BM * ldb * 2; }
    __device__ bool next(int i, Unit& u) const {
        const long L = (long)i * G + c; if (L >= nwg) return false;
        int wgid = (int)L; { const int q = nwg / NXCD, r = nwg % NXCD, xcd = wgid % NXCD, off = wgid / NXCD; wgid = (xcd < r ? xcd * (q + 1) : r * (q + 1) + (xcd - r) * q) + off; }
        const int nig = WGM * nN, gid = wgid / nig, fm = gid * WGM, gsz = (nM - fm) < WGM ? (nM - fm) : WGM;
        u.pm = fm + ((wgid % nig) % gsz); u.pn = (wgid % nig) / gsz; u.a = A + (size_t)u.pm * astep; u.b = Bt + (size_t)u.pn * bstep; u.e = 0; u.p0 = 0; u.ce = 0; return true;
    }
};
template <bool GATHER_> struct MoeOrder {
    static constexpr bool GATHER = GATHER_;
    int nN, G, c; const char* A; const char* Bt; size_t astep, bstep, bexp; const int* tab; const int* tokl;
    __device__ bool next(int i, Unit& u) const {
        const int L = i * G + c; const int total = __builtin_amdgcn_readfirstlane(tab[16]) * nN; if (L >= total) return false;
        u.pm = L / nN; u.pn = L % nN; int e = 0;
#pragma unroll
        for (int q = 1; q < 16; ++q) e += (u.pm >= tab[q]) ? 1 : 0;
        e = __builtin_amdgcn_readfirstlane(e);
        u.e = e; u.p0 = __builtin_amdgcn_readfirstlane((u.pm - tab[e]) * BM); u.ce = __builtin_amdgcn_readfirstlane(tab[17 + e]);
        u.a = GATHER_ ? A : A + (size_t)u.pm * astep; u.b = Bt + (size_t)e * bexp + (size_t)u.pn * bstep; return true;
    }
    __device__ __forceinline__ void aoffs(const Unit& u, int wid, int lda, unsigned (&off)[2][2]) const {
        const int tid = wid * 64 + fresh_lane();
#pragma unroll
        for (int i = 0; i < 2; ++i) { int Rr, C; stage_rc(tid * 16 + i * 8192, Rr, C);
#pragma unroll
            for (int h = 0; h < 2; ++h) { const int pos = u.p0 + h * HALF + Rr; const int tok = pos < u.ce ? (tokl[(size_t)u.e * R + pos] >> 1) : 0; off[h][i] = (unsigned)(tok * lda + C) * 2u; } }
    }
};

template <class Epi, class Sched, bool ALIGN_EPI = true>
__device__ __forceinline__ void gemm_phase(LAS unsigned char* lds, const int wid, const int lda, const int ldb, const int K, const Sched& S, const Epi& E) {
    const int lane = fresh_lane(), tid = wid * 64 + lane, wr = wid >> 2, wc = wid & 3, fr = lane & 15, fq = lane >> 4;
    const int nt = K / BK;
    unsigned voffA[2], voffB[2];
#pragma unroll
    for (int i = 0; i < 2; ++i) { int Rr, C; stage_rc(tid * 16 + i * 8192, Rr, C); const int Rb = Epi::PERM ? ((Rr & ~31) + perm32(Rr & 31)) : Rr;
        voffA[i] = (unsigned)(Rr * lda + C) * 2u; voffB[i] = (unsigned)(Rb * ldb + C) * 2u; }
    const size_t kstep = (size_t)(BK * 2);
    const size_t hstepA = Sched::GATHER ? 0 : (size_t)HALF * lda * 2, hstepB = (size_t)HALF * ldb * 2;
    const unsigned ldsw = (unsigned)wid * 1024u;
    const int aoff = lds_byte(wr * 64 + fr, fq * 8), boff = lds_byte(wc * 32 + fr, fq * 8);
#define PG8_SA(b, h) (((b) * 2 + (h)) * HTB)
#define PG8_SB(b, h) ((4 + (b) * 2 + (h)) * HTB)
#define PG8_STAGE(bufoff, gbase, voff) do { _Pragma("unroll") for (int _i = 0; _i < 2; ++_i) \
        __builtin_amdgcn_global_load_lds((const unsigned*)((const char*)(gbase) + (voff)[_i]), (LAS unsigned*)(lds + (bufoff) + ldsw + _i * 8192), 16, 0, 0); } while (0)
#define PG8_STAGE_A(b, h, kp, OFFS) do { if constexpr (Sched::GATHER) { PG8_STAGE(PG8_SA(b, h), kp, OFFS[h]); } else { PG8_STAGE(PG8_SA(b, h), (kp) + (h) * hstepA, voffA); } } while (0)
#define PG8_LDA(dst, b, h) do { _Pragma("unroll") for (int m = 0; m < 4; ++m) _Pragma("unroll") for (int k = 0; k < 2; ++k) dst[m][k] = *(const LAS bf16x8*)(lds + PG8_SA(b, h) + aoff + m * 2048 + k * 1024); } while (0)
#define PG8_LDB(dst, b, h) do { _Pragma("unroll") for (int n = 0; n < 2; ++n) _Pragma("unroll") for (int k = 0; k < 2; ++k) dst[n][k] = *(const LAS bf16x8*)(lds + PG8_SB(b, h) + boff + n * 2048 + k * 1024); } while (0)
#define PG8_MMA(ai, bj, At, Bt) do { __builtin_amdgcn_s_setprio(1); _Pragma("unroll") for (int m = 0; m < 4; ++m) _Pragma("unroll") for (int n = 0; n < 2; ++n) _Pragma("unroll") for (int k = 0; k < 2; ++k) \
        acc[ai][bj][m][n] = __builtin_amdgcn_mfma_f32_16x16x32_bf16(Bt[n][k], At[m][k], acc[ai][bj][m][n], 0, 0, 0); __builtin_amdgcn_s_setprio(0); } while (0)
#define PG8_WAIT_V(n) asm volatile("s_waitcnt vmcnt(" #n ")" ::: "memory")
#define PG8_WAIT_L(n) asm volatile("s_waitcnt lgkmcnt(" #n ")" ::: "memory")
#define PG8_BAR __builtin_amdgcn_s_barrier()
#define PG8_SCHED __builtin_amdgcn_sched_barrier(0)
    Unit cur, nxt; int ui = 0;
    if (!S.next(0, cur)) return;
    f32x4 acc[2][2][4][2];
#pragma unroll
    for (int a = 0; a < 2; ++a)
#pragma unroll
        for (int b = 0; b < 2; ++b)
#pragma unroll
            for (int m = 0; m < 4; ++m)
#pragma unroll
                for (int n = 0; n < 2; ++n) acc[a][b][m][n] = (f32x4){0.f, 0.f, 0.f, 0.f};
    bf16x8 At[4][2], B0[2][2], B1[2][2];
    unsigned goffC[2][2], goffN[2][2];
    if constexpr (Sched::GATHER) { S.aoffs(cur, wid, lda, goffC);
#pragma unroll
        for (int h = 0; h < 2; ++h)
#pragma unroll
            for (int i = 0; i < 2; ++i) goffN[h][i] = goffC[h][i]; }
    const char* cA = cur.a; const char* cB = cur.b;
    PG8_STAGE(PG8_SB(0, 0), cB, voffB); PG8_STAGE(PG8_SB(0, 1), cB + hstepB, voffB); PG8_STAGE_A(0, 0, cA, goffC); PG8_STAGE_A(0, 1, cA, goffC);
    if (wr == 1) PG8_BAR;
    PG8_WAIT_V(2); PG8_BAR;
    PG8_STAGE(PG8_SB(1, 0), cB + kstep, voffB); PG8_STAGE_A(1, 0, cA + kstep, goffC); PG8_STAGE(PG8_SB(1, 1), cB + hstepB + kstep, voffB);
    PG8_WAIT_V(6); PG8_BAR;
    for (;;) {
        const bool has_next = S.next(ui + 1, nxt);
        if constexpr (Sched::GATHER) { if (has_next) S.aoffs(nxt, wid, lda, goffN); }
        const char* nA = has_next ? nxt.a : cA; const char* nB = has_next ? nxt.b : cB;
        for (int t = 0; t < nt; t += 2) {
            const bool last = (t == nt - 2);
            const char* a1 = cA + (size_t)(t + 1) * kstep;
            const char* a2 = last ? nA : cA + (size_t)(t + 2) * kstep; const char* b2 = last ? nB : cB + (size_t)(t + 2) * kstep;
            const char* a3 = a2 + kstep; const char* b3 = b2 + kstep;
            unsigned gx[2][2];
            if constexpr (Sched::GATHER) {
#pragma unroll
                for (int h = 0; h < 2; ++h)
#pragma unroll
                    for (int i = 0; i < 2; ++i) gx[h][i] = (last && has_next) ? goffN[h][i] : goffC[h][i]; }
            PG8_LDB(B0, 0, 0); PG8_LDB(B1, 0, 1); PG8_SCHED; PG8_LDA(At, 0, 0); PG8_STAGE_A(1, 1, a1, goffC);
            PG8_WAIT_V(8); PG8_WAIT_L(0); PG8_BAR; PG8_MMA(0, 0, At, B0); PG8_MMA(0, 1, At, B1); PG8_BAR; PG8_SCHED;
            PG8_LDA(At, 0, 1); PG8_STAGE(PG8_SB(0, 0), b2, voffB); PG8_STAGE(PG8_SB(0, 1), b2 + hstepB, voffB); PG8_STAGE_A(0, 0, a2, gx);
            PG8_WAIT_V(8); PG8_WAIT_L(0); PG8_BAR; PG8_MMA(1, 0, At, B0); PG8_MMA(1, 1, At, B1); PG8_BAR; PG8_SCHED;
            PG8_LDB(B0, 1, 0); PG8_LDB(B1, 1, 1); PG8_SCHED; PG8_LDA(At, 1, 0); PG8_STAGE_A(0, 1, a2, gx);
            PG8_WAIT_V(8); PG8_WAIT_L(0); PG8_BAR; PG8_MMA(0, 0, At, B0); PG8_MMA(0, 1, At, B1); PG8_BAR; PG8_SCHED;
            PG8_LDA(At, 1, 1); PG8_STAGE(PG8_SB(1, 0), b3, voffB); PG8_STAGE(PG8_SB(1, 1), b3 + hstepB, voffB); PG8_STAGE_A(1, 0, a3, gx);
            PG8_WAIT_V(8); PG8_WAIT_L(0); PG8_BAR; PG8_MMA(1, 0, At, B0); PG8_MMA(1, 1, At, B1); PG8_BAR; PG8_SCHED;
            if constexpr (Epi::MID) { if (((t + 2) & (Epi::MID_EVERY - 1)) == 0 && !last) E.mid(acc, cur, wr, wc, (t + 2) / Epi::MID_EVERY - 1); }
        }
        if constexpr (ALIGN_EPI) { if (wr == 0) PG8_BAR; }
        E(acc, cur, wr, wc, fr, fq);
        if (!has_next) break;
#pragma unroll
        for (int a = 0; a < 2; ++a)
#pragma unroll
            for (int b = 0; b < 2; ++b)
#pragma unroll
                for (int m = 0; m < 4; ++m)
#pragma unroll
                    for (int n = 0; n < 2; ++n) acc[a][b][m][n] = (f32x4){0.f, 0.f, 0.f, 0.f};
        cur = nxt; cA = nA; cB = nB; ++ui;
        if constexpr (Sched::GATHER) {
#pragma unroll
            for (int h = 0; h < 2; ++h)
#pragma unroll
                for (int i = 0; i < 2; ++i) goffC[h][i] = goffN[h][i]; }
        if constexpr (ALIGN_EPI) { if (wr == 1) PG8_BAR; }
    }
    PG8_WAIT_V(0);
    if constexpr (!ALIGN_EPI) { if (wr == 0) PG8_BAR; }
    PG8_BAR;
#undef PG8_SA
#undef PG8_SB
#undef PG8_STAGE
#undef PG8_STAGE_A
#undef PG8_LDA
#undef PG8_LDB
#undef PG8_MMA
#undef PG8_WAIT_V
#undef PG8_WAIT_L
#undef PG8_BAR
#undef PG8_SCHED
}
template <class F> struct EpiV4 { static constexpr bool PERM = false, MID = false; static constexpr int MID_EVERY = 1; F f;
    __device__ __forceinline__ void operator()(const f32x4 (&acc)[2][2][4][2], const Unit& u, int wr, int wc, int, int) const {
        const int ln = fresh_lane(), fr = ln & 15, fq = ln >> 4;
        const int row0 = u.pm * BM + wr * 64 + fr, col0 = u.pn * BM + wc * 32 + 4 * fq;
        typename F::UnitPre up = f.unit(u, col0);
#pragma unroll
        for (int ai = 0; ai < 2; ++ai) {
            typename F::Pre pre[4][2][2];
#pragma unroll
            for (int m = 0; m < 4; ++m)
#pragma unroll
                for (int bj = 0; bj < 2; ++bj)
#pragma unroll
                    for (int n = 0; n < 2; ++n) pre[m][bj][n] = f.load(u, row0 + ai * HALF + m * 16, col0 + bj * HALF + n * 16);
#pragma unroll
            for (int m = 0; m < 4; ++m)
#pragma unroll
                for (int bj = 0; bj < 2; ++bj)
#pragma unroll
                    for (int n = 0; n < 2; ++n) f.fin(u, row0 + ai * HALF + m * 16, col0 + bj * HALF + n * 16, acc[ai][bj][m][n], pre[m][bj][n], up, bj * 2 + n);
            asm volatile("" ::: "memory"); }
    } };
template <class F> struct EpiV8 { static constexpr bool PERM = true, MID = false; static constexpr int MID_EVERY = 1; F f;
    __device__ __forceinline__ void operator()(const f32x4 (&acc)[2][2][4][2], const Unit& u, int wr, int wc, int, int) const {
        const int ln = fresh_lane(), fr = ln & 15, fq = ln >> 4;
        const int row0 = u.pm * BM + wr * 64 + fr, col0 = u.pn * BM + wc * 32 + 8 * fq;
#pragma unroll
        for (int ai = 0; ai < 2; ++ai) {
            typename F::Pre pre[4][2];
#pragma unroll
            for (int m = 0; m < 4; ++m)
#pragma unroll
                for (int bj = 0; bj < 2; ++bj) pre[m][bj] = f.load(u, row0 + ai * HALF + m * 16, col0 + bj * HALF);
#pragma unroll
            for (int m = 0; m < 4; ++m)
#pragma unroll
                for (int bj = 0; bj < 2; ++bj) f.fin(u, row0 + ai * HALF + m * 16, col0 + bj * HALF, acc[ai][bj][m][0], acc[ai][bj][m][1], pre[m][bj]);
            asm volatile("" ::: "memory"); }
    } };
template <class F> struct EpiDual { static constexpr bool PERM = true, MID = false; static constexpr int MID_EVERY = 1; F f;
    __device__ __forceinline__ void operator()(const f32x4 (&acc)[2][2][4][2], const Unit& u, int wr, int wc, int, int) const {
        const int ln = fresh_lane(), fr = ln & 15, fq = ln >> 4;
        const int row0 = u.pm * BM + wr * 64 + fr, hc0 = u.pn * HALF + wc * 32 + 8 * fq;
#pragma unroll
        for (int ai = 0; ai < 2; ++ai)
#pragma unroll
            for (int m = 0; m < 4; ++m) f.apply8(row0 + ai * HALF + m * 16, hc0, acc[ai][0][m][0], acc[ai][0][m][1], acc[ai][1][m][0], acc[ai][1][m][1]);
    } };
struct EpiMergeS { static constexpr bool PERM = true, MID = true; static constexpr int MID_EVERY = 8;
    const unsigned char* G8; bf16_t* MG;
    __device__ __forceinline__ void mid(f32x4 (&acc)[2][2][4][2], const Unit& u, int wr, int wc, int i) const {
        const int ln = fresh_lane(), fr = ln & 15, fq = ln >> 4;
        const int row0 = u.pm * BM + wr * 64 + fr, col0 = u.pn * BM + wc * 32 + 8 * fq;
#pragma unroll
        for (int ai = 0; ai < 2; ++ai) {
            u32x2 gi[4][2], gn[4][2];
#pragma unroll
            for (int m = 0; m < 4; ++m)
#pragma unroll
                for (int bj = 0; bj < 2; ++bj) { const unsigned char* gp = G8 + (size_t)(row0 + ai * HALF + m * 16) * 4096 + i * 1024 + col0 + bj * HALF;
                    gi[m][bj] = *(const u32x2*)gp; gn[m][bj] = *(const u32x2*)(gp + 1024); }
#pragma unroll
            for (int m = 0; m < 4; ++m)
#pragma unroll
                for (int bj = 0; bj < 2; ++bj) {
#pragma unroll
                    for (int j = 0; j < 4; ++j) {
                        acc[ai][bj][m][0][j] *= (float)((gi[m][bj].x >> (8 * j)) & 255u) * __builtin_amdgcn_rcpf((float)((gn[m][bj].x >> (8 * j)) & 255u));
                        acc[ai][bj][m][1][j] *= (float)((gi[m][bj].y >> (8 * j)) & 255u) * __builtin_amdgcn_rcpf((float)((gn[m][bj].y >> (8 * j)) & 255u)); } }
        }
    }
    __device__ __forceinline__ void operator()(const f32x4 (&acc)[2][2][4][2], const Unit& u, int wr, int wc, int, int) const {
        const int ln = fresh_lane(), fr = ln & 15, fq = ln >> 4;
        const int row0 = u.pm * BM + wr * 64 + fr, col0 = u.pn * BM + wc * 32 + 8 * fq;
#pragma unroll
        for (int ai = 0; ai < 2; ++ai) {
            u32x2 g3[4][2];
#pragma unroll
            for (int m = 0; m < 4; ++m)
#pragma unroll
                for (int bj = 0; bj < 2; ++bj) g3[m][bj] = *(const u32x2*)(G8 + (size_t)(row0 + ai * HALF + m * 16) * 4096 + 3 * 1024 + col0 + bj * HALF);
#pragma unroll
            for (int m = 0; m < 4; ++m)
#pragma unroll
                for (int bj = 0; bj < 2; ++bj) { f32x4 a = acc[ai][bj][m][0], b = acc[ai][bj][m][1];
#pragma unroll
                    for (int j = 0; j < 4; ++j) { a[j] *= (float)((g3[m][bj].x >> (8 * j)) & 255u) * (1.0f / 255.0f); b[j] *= (float)((g3[m][bj].y >> (8 * j)) & 255u) * (1.0f / 255.0f); }
                    u32x4 w; w.x = cvtpk(a.x, a.y); w.y = cvtpk(a.z, a.w); w.z = cvtpk(b.x, b.y); w.w = cvtpk(b.z, b.w);
                    *(u32x4*)(MG + (size_t)(row0 + ai * HALF + m * 16) * D + col0 + bj * HALF) = w; }
        }
    }
};
}

__device__ __forceinline__ u32x4 pack8(f32x4 a, f32x4 b) { u32x4 w; w.x = cvtpk(a.x, a.y); w.y = cvtpk(a.z, a.w); w.z = cvtpk(b.x, b.y); w.w = cvtpk(b.z, b.w); return w; }
__device__ __forceinline__ float sigm1(float x) { return __builtin_amdgcn_rcpf(1.0f + __builtin_amdgcn_exp2f(-1.4426950408889634f * x)); }
__device__ __forceinline__ f32x4 sigm4(f32x4 v) { f32x4 r; r.x = sigm1(v.x); r.y = sigm1(v.y); r.z = sigm1(v.z); r.w = sigm1(v.w); return r; }
struct NoPre {};
struct FStore8 { bf16_t* C; int ldc; typedef NoPre Pre;
    __device__ __forceinline__ Pre load(const pg8::Unit&, int, int) const { return Pre{}; }
    __device__ __forceinline__ void fin(const pg8::Unit&, int row, int col, f32x4 a, f32x4 b, const Pre&) const { *(u32x4*)(C + (size_t)row * ldc + col) = pack8(a, b); } };
struct FGateU8 { unsigned char* G8; const float* bias; typedef NoPre Pre;
    __device__ __forceinline__ Pre load(const pg8::Unit&, int, int) const { return Pre{}; }
    __device__ __forceinline__ void fin(const pg8::Unit&, int row, int col, f32x4 a, f32x4 b, const Pre&) const { const f32x4 b0 = *(const f32x4*)(bias + col), b1 = *(const f32x4*)(bias + col + 4);
        const f32x4 ga = sigm4(a + b0) * 255.0f + 0.5f, gb = sigm4(b + b1) * 255.0f + 0.5f;
        unsigned q[8] = {(unsigned)ga.x, (unsigned)ga.y, (unsigned)ga.z, (unsigned)ga.w, (unsigned)gb.x, (unsigned)gb.y, (unsigned)gb.z, (unsigned)gb.w};
#pragma unroll
        for (int k = 0; k < 8; ++k) q[k] = q[k] < 1u ? 1u : (q[k] > 255u ? 255u : q[k]);
        u32x2 w; w.x = q[0] | (q[1] << 8) | (q[2] << 16) | (q[3] << 24); w.y = q[4] | (q[5] << 8) | (q[6] << 16) | (q[7] << 24);
        *(u32x2*)(G8 + (size_t)row * 4096 + col) = w; } };
struct FMoe1 { bf16_t* HID;
    __device__ __forceinline__ void apply8(int row, int hc, f32x4 a0, f32x4 a1, f32x4 b0, f32x4 b1) const {
        *(u32x4*)(HID + (size_t)row * FF + hc) = pack8(a0 * sigm4(a0) * b0, a1 * sigm4(a1) * b1); } };
struct FMoe2 { bf16_t* MO; const int* tokl; const float* wl; struct Pre { int t; float w; };
    __device__ __forceinline__ Pre load(const pg8::Unit& u, int row, int) const { Pre r; const int pos = u.p0 + (row - u.pm * 256); r.t = -1; r.w = 0.f;
        if (pos < u.ce) { r.t = tokl[(size_t)u.e * R + pos]; r.w = wl[(size_t)u.e * R + pos]; } return r; }
    __device__ __forceinline__ void fin(const pg8::Unit&, int, int col, f32x4 a, f32x4 b, const Pre& q) const { if (q.t < 0) return;
        *(u32x4*)(MO + ((size_t)(q.t & 1) * R + (q.t >> 1)) * D + col) = pack8(a * q.w, b * q.w); } };
struct FOut { Ptrs P; int l; typedef f32x4 Pre; struct UnitPre { f32x4 g[4]; };
    __device__ __forceinline__ UnitPre unit(const pg8::Unit& u, int col0) const { UnitPre r; const float* g = mod_vec(P, l, row_bb(u.pm * 256), 2) + col0;
#pragma unroll
        for (int q = 0; q < 4; ++q) r.g[q] = *(const f32x4*)(g + (q >> 1) * 128 + (q & 1) * 16);
        return r; }
    __device__ __forceinline__ Pre load(const pg8::Unit&, int row, int col) const { return l == 0 ? *(const f32x4*)(xin_row(P, row) + col) : *(const f32x4*)(x1_row(P, row) + col); }
    __device__ __forceinline__ void fin(const pg8::Unit&, int row, int col, f32x4 v, const Pre& xp, const UnitPre& up, int q) const { *(f32x4*)(x1_row(P, row) + col) = xp + up.g[q] * v; } };

struct Frame { LAS unsigned char* lds; int wave, vcu, G; };
#define fresh_tid() (F.wave * 64 + fresh_lane())
__device__ __forceinline__ void tr_item(const float* W, int ldw, int k0, int csrc0, bf16_t* WT, int ldt, int drow0, LAS float* scr, int lane) {
    f32x4 v[8];
#pragma unroll
    for (int i = 0; i < 8; ++i) v[i] = *(const f32x4*)(W + (size_t)(k0 + (lane >> 3) + 8 * i) * ldw + csrc0 + (lane & 7) * 4);
#pragma unroll
    for (int i = 0; i < 8; ++i) { LAS float* d = scr + ((lane >> 3) + 8 * i) * 33 + (lane & 7) * 4; d[0] = v[i].x; d[1] = v[i].y; d[2] = v[i].z; d[3] = v[i].w; }
    LDS_WAIT(); asm volatile("" ::: "memory");
    const int c = lane & 7;
#pragma unroll
    for (int j = 0; j < 4; ++j) { const int n = (lane >> 3) + 8 * j; const LAS float* s = scr + (8 * c) * 33 + n;
        u32x4 o; o.x = cvtpk(s[0 * 33], s[1 * 33]); o.y = cvtpk(s[2 * 33], s[3 * 33]); o.z = cvtpk(s[4 * 33], s[5 * 33]); o.w = cvtpk(s[6 * 33], s[7 * 33]);
        *(u32x4*)(WT + (size_t)(drow0 + n) * ldt + k0 + 8 * c) = o; }
    LDS_WAIT(); asm volatile("" ::: "memory");
}
__device__ __forceinline__ void ph_weights(const Frame& F, const Ptrs& P, int l) {
    const int tid0 = fresh_tid(), lane0 = tid0 & 63;
    LAS float* scr = (LAS float*)(F.lds + F.wave * 16384);
    const int gw = F.vcu * NWAVES + F.wave, NGW = F.G * NWAVES;
    unsigned char* wb = P.ws + WS_WB;
    constexpr int I0 = 1024, I1 = I0 + 2048, I2 = I1 + 768, I3 = I2 + 512, I4 = I3 + 4096, I5 = I4 + 4096, I6 = I5 + 4096;
    for (int it = gw; it < I6; it += NGW) {
        if (it < I0) { const int kb = it >> 6, nb = it & 63; tr_item(P.w_in + (size_t)l * 1024 * 2560, 2560, kb * 64, 512 + nb * 32, (bf16_t*)(wb + WB_IN), 1024, 1024 + nb * 32, scr, lane0); }
        else if (it < I1) { const int r = it - I0, i = r >> 9, q = r & 511, kb = q >> 5, nb = q & 31; tr_item(P.w_gate + ((size_t)l * 4 + i) * 1024 * 1024, 1024, kb * 64, nb * 32, (bf16_t*)(wb + WB_GATE) + (size_t)i * 1024 * 1024, 1024, nb * 32, scr, lane0); }
        else if (it < I2) { const int r = it - I1, i = r >> 8, q = r & 255, kb = q >> 5, nb = q & 31; tr_item(P.w_branch + ((size_t)l * 4 + i) * 512 * 1024, 1024, kb * 64, nb * 32, (bf16_t*)(wb + WB_BR) + i * 512, 2048, nb * 32, scr, lane0); }
        else if (it < I3) { const int q = it - I2, kb = q >> 5, nb = q & 31; tr_item(P.w_out + (size_t)l * 1024 * 1024, 1024, kb * 64, nb * 32, (bf16_t*)(wb + WB_OUT), 1024, nb * 32, scr, lane0); }
        else if (it < I5) { const int w3 = it >= I4; const int r = it - (w3 ? I4 : I3), e = r >> 8, q = r & 255, kb = q >> 4, nb = q & 15, c = nb * 32;
            tr_item((w3 ? P.w3 : P.w1) + ((size_t)l * 16 + e) * 1024 * 512, 512, kb * 64, c, (bf16_t*)(wb + WB_13) + (size_t)e * 1024 * 1024, 1024, 256 * (c >> 7) + (c & 127) + (w3 ? 128 : 0), scr, lane0); }
        else { const int r = it - I5, e = r >> 8, q = r & 255, kb = q >> 5, nb = q & 31; tr_item(P.w2 + ((size_t)l * 16 + e) * 512 * 1024, 1024, kb * 64, nb * 32, (bf16_t*)(wb + WB_2) + (size_t)e * 1024 * 512, 512, nb * 32, scr, lane0); }
    }
    __syncthreads();
    for (int u = F.vcu; u < 64; u += F.G) {
        LAS float* Wl = (LAS float*)F.lds; LAS float* ct = Wl + 64 * 128;
        const int kt = u >> 2, g = u & 3, k0 = kt * 64, tid = tid0; const float* w_in = P.w_in + (size_t)l * 1024 * 2560;
        if (tid < 128) ct[tid] = __builtin_amdgcn_cosf((float)tid * (1.0f / 128.0f));
        for (int i = tid; i < 64 * 128; i += 512) { const int k = i >> 7, c = i & 127; Wl[k * 128 + c] = w_in[(size_t)(k0 + k) * 2560 + g * 128 + c]; }
        __syncthreads();
        const int part = (tid >> 7) & 1, m = tid & 127, kh = tid >> 8; const float sc = 0.08838834764831845f;
        bf16_t* drow = (bf16_t*)(wb + WB_IN) + (size_t)(part * 512 + g * 128 + m) * 1024 + k0;
        for (int kb = kh * 32; kb < kh * 32 + 32; kb += 8) { float acc[8];
#pragma unroll
            for (int j = 0; j < 8; ++j) acc[j] = 0.f;
            for (int c = 0; c < 128; ++c) { const int idx = (c * m) & 127; const float tw = part ? -ct[(idx - 32) & 127] : ct[idx];
#pragma unroll
                for (int j = 0; j < 8; ++j) acc[j] += Wl[(kb + j) * 128 + c] * tw; }
            u32x4 o; o.x = pk2(acc[0] * sc, acc[1] * sc); o.y = pk2(acc[2] * sc, acc[3] * sc); o.z = pk2(acc[4] * sc, acc[5] * sc); o.w = pk2(acc[6] * sc, acc[7] * sc);
            *(u32x4*)(drow + kb) = o; }
        __syncthreads();
    }
    for (int u = F.G - 1 - F.vcu; u < 64; u += F.G) {
        LAS float* Wb = (LAS float*)F.lds;
        const int g = u >> 4, n0 = (u & 15) * 64, tid = tid0;
        const float* ps = P.pool_scale + (size_t)l * 512; const float* wb3 = P.w_branch + ((size_t)l * 4 + 3) * 512 * 1024; const float* pwl = P.pool_w + (size_t)l * 4 * 128 * 128;
        for (int i = tid; i < 128 * 64; i += 512) { const int e = i >> 6, n = i & 63; Wb[e * 64 + n] = ps[g * 128 + e] * wb3[(size_t)(g * 128 + e) * 1024 + n0 + n]; }
        __syncthreads();
        const int c = tid & 127, nh = tid >> 7; const float* pw = pwl + (size_t)(g * 128 + c) * 128;
        float acc[16];
#pragma unroll
        for (int j = 0; j < 16; ++j) acc[j] = 0.f;
        for (int e = 0; e < 128; ++e) { const float p = pw[e];
#pragma unroll
            for (int j = 0; j < 16; ++j) acc[j] += p * Wb[e * 64 + nh * 16 + j]; }
        bf16_t* Bt = (bf16_t*)(wb + WB_BR) + 3 * 512;
#pragma unroll
        for (int j = 0; j < 16; ++j) Bt[(size_t)(n0 + nh * 16 + j) * 2048 + g * 128 + c] = (bf16_t)f2bf(acc[j]);
        __syncthreads();
    }
}
__device__ __forceinline__ void ph_tables_mod(const Frame& F, const Ptrs& P) {
    const int tid0 = fresh_tid();
    { float* rc = (float*)(P.ws + WS_ROPE); float* rs = rc + 1024; float* ct = (float*)(P.ws + WS_COS);
      const int i = F.vcu * 512 + tid0;
      if (i < 1024) { const int pos = i >> 4, f = i & 15; const float inv = exp2f(-(float)f * (13.287712379549449f / 16.0f));
          float rev = (float)pos * inv * 0.15915494309189535f; rev = rev - floorf(rev);
          rc[i] = __builtin_amdgcn_cosf(rev); rs[i] = __builtin_amdgcn_sinf(rev); }
      if (i < 4096) ct[i] = __builtin_amdgcn_cosf((float)i * (1.0f / 4096.0f));
      if (i < 16384) { const int mm = i >> 7, k = i & 127, pp = mm >> 6, k1 = mm & 63, pk = k >> 6, t1 = k & 63; const float rev = (float)((k1 * t1) & 63) * (1.0f / 64.0f);
          const float c = __builtin_amdgcn_cosf(rev), sn = __builtin_amdgcn_sinf(rev);
          ((bf16_t*)(P.ws + WS_DFTM))[i] = (bf16_t)f2bf(pp == pk ? c : (pp == 0 ? sn : -sn)); } }
    for (int u = F.vcu; u < 192; u += F.G) {
        LAS float* s = (LAS float*)F.lds; LAS float* red = s + 9 * 1024;
        const int l = u / 96, j0 = (u % 96) * 64, tid = tid0;
        for (int i = tid; i < 9 * 1024; i += 512) { const int bb = i >> 10, k = i & 1023; const float v = bb < 8 ? P.c[bb * 1024 + k] : P.c_ctx[k]; s[i] = v / (1.f + expf(-v)); }
        __syncthreads();
        const int kc = tid >> 6, jj = tid & 63; float acc[9];
#pragma unroll
        for (int b = 0; b < 9; ++b) acc[b] = 0.f;
        const float* w = P.w_ada + (size_t)l * 1024 * 6144 + j0 + jj;
        for (int k = kc * 128; k < kc * 128 + 128; k += 8) { float wv[8];
#pragma unroll
            for (int q = 0; q < 8; ++q) wv[q] = w[(size_t)(k + q) * 6144];
#pragma unroll
            for (int q = 0; q < 8; ++q)
#pragma unroll
                for (int b = 0; b < 9; ++b) acc[b] += s[b * 1024 + k + q] * wv[q]; }
#pragma unroll
        for (int b = 0; b < 9; ++b) red[(kc * 9 + b) * 64 + jj] = acc[b];
        __syncthreads();
        float* mod = (float*)(P.ws + WS_MOD);
        for (int i = tid; i < 9 * 64; i += 512) { const int b = i >> 6, j = i & 63; float v = P.b_ada[l * 6144 + j0 + j];
#pragma unroll
            for (int q = 0; q < 8; ++q) v += red[(q * 9 + b) * 64 + j];
            mod[(size_t)(l * 9 + b) * 6144 + j0 + j] = v; }
        __syncthreads();
    }
}
__device__ __forceinline__ void route_row(const Ptrs& P, int r, const f32x4 (&h)[4], int lane, bool publish, LAS unsigned* lcnt, LAS int* rec, const LAS float* rwl) {
    float lg[16];
#pragma unroll
    for (int e = 0; e < 16; ++e) lg[e] = 0.f;
#pragma unroll
    for (int j = 0; j < 4; ++j) {
#pragma unroll
        for (int i = 0; i < 4; ++i) { const int kk = 4 * lane + 256 * j + i; const LAS f32x4* rw = (const LAS f32x4*)(rwl + kk * 16 + (kk >> 2) * 4); const float hv = h[j][i];
#pragma unroll
            for (int qd = 0; qd < 4; ++qd) { const f32x4 w = rw[qd]; lg[4 * qd] += hv * w.x; lg[4 * qd + 1] += hv * w.y; lg[4 * qd + 2] += hv * w.z; lg[4 * qd + 3] += hv * w.w; } }
        __builtin_amdgcn_sched_barrier(0); }
    float v8[8], v4[4], v2[2], v1;
    { const bool bit = (lane & 32) != 0;
#pragma unroll
      for (int i = 0; i < 8; ++i) { const float a = lg[i], b = lg[i + 8]; v8[i] = (bit ? b : a) + shfl_xor_l(bit ? a : b, 32, lane); } }
    { const bool bit = (lane & 16) != 0;
#pragma unroll
      for (int i = 0; i < 4; ++i) { const float a = v8[i], b = v8[i + 4]; v4[i] = (bit ? b : a) + shfl_xor_l(bit ? a : b, 16, lane); } }
    { const bool bit = (lane & 8) != 0;
#pragma unroll
      for (int i = 0; i < 2; ++i) { const float a = v4[i], b = v4[i + 2]; v2[i] = (bit ? b : a) + shfl_xor_l(bit ? a : b, 8, lane); } }
    { const bool bit = (lane & 4) != 0; const float a = v2[0], b = v2[1]; v1 = (bit ? b : a) + shfl_xor_l(bit ? a : b, 4, lane); }
    v1 += shfl_xor_l(v1, 2, lane); v1 += shfl_xor_l(v1, 1, lane);
    float bestscore = -INFINITY; int be0 = 0, be1 = 1; float ba0 = 0.f, ba1 = 0.f;
#pragma unroll
    for (int g = 0; g < 4; ++g) {
        float aff[4], sel[4];
#pragma unroll
        for (int i = 0; i < 4; ++i) { const float t = __int_as_float(__builtin_amdgcn_ds_bpermute((4 * g + i) << 4, __float_as_int(v1))); aff[i] = 1.0f / (1.0f + expf(-t)); sel[i] = aff[i] + P.router_bias[4 * g + i]; }
        int i1 = 0; float m1 = sel[0], a1 = aff[0];
#pragma unroll
        for (int i = 1; i < 4; ++i) if (sel[i] > m1) { m1 = sel[i]; a1 = aff[i]; i1 = i; }
        int i2 = -1; float m2 = -INFINITY, a2 = 0.f;
#pragma unroll
        for (int i = 0; i < 4; ++i) if (i != i1 && sel[i] > m2) { m2 = sel[i]; a2 = aff[i]; i2 = i; }
        const float score = m1 + m2;
        if (score > bestscore) { bestscore = score; be0 = 4 * g + i1; be1 = 4 * g + i2; ba0 = a1; ba1 = a2; }
    }
    if (lane == 0 && publish) {
        const int p0 = (int)__hip_atomic_fetch_add(lcnt + be0, 1u, __ATOMIC_RELAXED, __HIP_MEMORY_SCOPE_WORKGROUP), p1 = (int)__hip_atomic_fetch_add(lcnt + be1, 1u, __ATOMIC_RELAXED, __HIP_MEMORY_SCOPE_WORKGROUP);
        const float inv = 1.0f / (ba0 + ba1);
        rec[0] = r; rec[1] = be0; rec[2] = p0; rec[3] = be1; rec[4] = p1; rec[5] = __float_as_int(ba0 * inv); rec[6] = __float_as_int(ba1 * inv);
    }
}
template <int MODE> __device__ __forceinline__ void ph_norm(const Frame& F, const Ptrs& P, int l, int nrows) {
    constexpr int NRW = MODE == 2 ? 2 : 4;
    const int lane = fresh_lane();
    const int stride = F.G * NWAVES;
    LAS unsigned* lcnt = (LAS unsigned*)F.lds; LAS unsigned* gbase = lcnt + 16; LAS int* recs = (LAS int*)(F.lds + 256);
    const LAS float* rwl = (const LAS float*)(F.lds + 8192);
    if (MODE == 2) { if (F.wave == 0 && lane < 16) lcnt[lane] = 0u;
        { const int tid = F.wave * 64 + lane; LAS f32x4* d = (LAS f32x4*)(F.lds + 8192);
#pragma unroll
          for (int i = 0; i < 8; ++i) { const int idx = tid + 512 * i, kk = idx >> 2; d[idx + (kk >> 2)] = ((const f32x4*)P.router_w)[idx]; } }
        __syncthreads(); }
    int it = 0;
    for (int rb = F.vcu * NWAVES + F.wave; rb < nrows; rb += NRW * stride, ++it) {
        int rr[NRW];
#pragma unroll
        for (int q = 0; q < NRW; ++q) rr[q] = rb + q * stride < nrows ? rb + q * stride : rb;
        f32x4 v[NRW][4];
#pragma unroll
        for (int q = 0; q < NRW; ++q) { const int r = rr[q];
            if (MODE == 0) { const f32x4* xr = (const f32x4*)xin_row(P, r) + lane;
#pragma unroll
                for (int j = 0; j < 4; ++j) v[q][j] = xr[64 * j]; }
            else { const f32x4* xr = (const f32x4*)x1_row(P, r) + lane;
#pragma unroll
                for (int j = 0; j < 4; ++j) v[q][j] = xr[64 * j]; } }
        if (MODE == 1) {
#pragma unroll
            for (int q = 0; q < NRW; ++q) { const int r = rr[q]; const int bb = row_bb(r); const f32x4* g2 = (const f32x4*)mod_vec(P, l - 1, bb, 5) + lane;
                const u32x2* m0 = (const u32x2*)((const bf16_t*)(P.ws + WS_MO) + (size_t)r * D) + lane; const u32x2* m1 = (const u32x2*)((const bf16_t*)(P.ws + WS_MO) + (size_t)(R + r) * D) + lane;
#pragma unroll
                for (int j = 0; j < 4; ++j) { const u32x2 a = m0[64 * j], b = m1[64 * j]; const f32x4 g = g2[64 * j];
                    v[q][j].x += g.x * (lo16(a.x) + lo16(b.x)); v[q][j].y += g.y * (hi16(a.x) + hi16(b.x)); v[q][j].z += g.z * (lo16(a.y) + lo16(b.y)); v[q][j].w += g.w * (hi16(a.y) + hi16(b.y)); } }
#pragma unroll
            for (int q = 0; q < NRW; ++q) if (q == 0 || rr[q] != rr[0]) { f32x4* xr = (f32x4*)x1_row(P, rr[q]) + lane;
#pragma unroll
                for (int j = 0; j < 4; ++j) xr[64 * j] = v[q][j]; }
        }
        float ss[NRW];
#pragma unroll
        for (int q = 0; q < NRW; ++q) { ss[q] = 0.f;
#pragma unroll
            for (int j = 0; j < 4; ++j) ss[q] += (v[q][j].x * v[q][j].x + v[q][j].y * v[q][j].y) + (v[q][j].z * v[q][j].z + v[q][j].w * v[q][j].w); }
#pragma unroll
        for (int o = 1; o < 64; o <<= 1) {
#pragma unroll
            for (int q = 0; q < NRW; ++q) ss[q] += shfl_xor_l(ss[q], o, lane); }
        const f32x4* gn = (const f32x4*)((MODE == 2 ? P.norm2 : P.norm1) + (size_t)l * D) + lane;
#pragma unroll
        for (int q = 0; q < NRW; ++q) { const int r = rr[q]; const int bb = row_bb(r);
            if (q > 0 && r == rr[0]) continue;
            const float rstd = 1.0f / sqrtf(ss[q] * (1.0f / D) + EPS);
            const f32x4* sh = (const f32x4*)mod_vec(P, l, bb, MODE == 2 ? 3 : 0) + lane;
            const f32x4* sc = (const f32x4*)mod_vec(P, l, bb, MODE == 2 ? 4 : 1) + lane;
            u32x2* o = (u32x2*)((bf16_t*)(P.ws + WS_H) + (size_t)r * D) + lane;
#pragma unroll
            for (int j = 0; j < 4; ++j) { const f32x4 g = gn[64 * j], a = sh[64 * j], b = sc[64 * j];
                v[q][j] = (v[q][j] * rstd * g) * (b + 1.0f) + a;
                u32x2 w; w.x = cvtpk(v[q][j].x, v[q][j].y); w.y = cvtpk(v[q][j].z, v[q][j].w); o[64 * j] = w; } }
        if (MODE == 2) { LAS int* rec = recs + (F.wave * 24 + 2 * it) * 8;
            route_row(P, rr[0], v[0], lane, true, lcnt, rec, rwl); __builtin_amdgcn_sched_barrier(0);
            if (lane == 0 && rr[1] == rr[0]) rec[8] = -1;
            route_row(P, rr[1], v[1], lane, rr[1] != rr[0], lcnt, rec + 8, rwl); }
    }
    if (MODE == 2) {
        __syncthreads();
        const int tid = F.wave * 64 + lane;
        if (tid < 16) { const unsigned c = lcnt[tid]; gbase[tid] = c ? atomicAdd((unsigned*)(P.ws + WS_CTL) + CW_CNT + 1024 * l + 64 * tid, c) : 0u; }
        __syncthreads();
        if (lane == 0) for (int k = 0; k < 2 * it; ++k) { const LAS int* rec = recs + (F.wave * 24 + k) * 8; const int r = rec[0]; if (r < 0) continue;
            int* tokl = (int*)(P.ws + WS_TOKL); float* wl = (float*)(P.ws + WS_WL);
            const size_t i0 = (size_t)rec[1] * R + rec[2] + gbase[rec[1]], i1 = (size_t)rec[3] * R + rec[4] + gbase[rec[3]];
            tokl[i0] = 2 * r; wl[i0] = __int_as_float(rec[5]); tokl[i1] = 2 * r + 1; wl[i1] = __int_as_float(rec[6]); }
        __syncthreads();
    }
}
__device__ __forceinline__ void ph_kprep(const Frame& F, const Ptrs& P, int l) {
    const int lane = fresh_lane();
    const float* rc = (const float*)(P.ws + WS_ROPE); const float* rs = rc + 1024;
    const int hs = (lane >> 3) & 3, chunk = lane & 7, col = (hs < 2 ? C_KB + hs * 64 : C_KW + (hs - 2) * 64) + chunk * 8;
    const f32x4 g0 = *(const f32x4*)(P.k_gain + l * 64 + chunk * 8), g1 = *(const f32x4*)(P.k_gain + l * 64 + chunk * 8 + 4);
    const int a = chunk >> 2, fi = (chunk & 1) * 8; const bool second = (chunk & 2) != 0;
    const int npair = R / 2, stride = F.G * NWAVES;
    for (int pr0 = F.vcu * NWAVES + F.wave; pr0 < npair; pr0 += 4 * stride) {
        u32x4 w[4];
#pragma unroll
        for (int q = 0; q < 4; ++q) { const int pr = pr0 + q * stride; const int r = 2 * (pr < npair ? pr : pr0) + (lane >> 5); w[q] = *(const u32x4*)((const bf16_t*)(P.ws + WS_U) + (size_t)r * NIN + col); }
#pragma unroll
        for (int q = 0; q < 4; ++q) { const int pr = pr0 + q * stride; if (pr >= npair) break;
            const int r = 2 * pr + (lane >> 5);
            float x[8] = {lo16(w[q].x), hi16(w[q].x), lo16(w[q].y), hi16(w[q].y), lo16(w[q].z), hi16(w[q].z), lo16(w[q].w), hi16(w[q].w)};
            if (hs < 2) { float ss = 0.f;
#pragma unroll
                for (int j = 0; j < 8; ++j) ss += x[j] * x[j];
                ss += shfl_xor_l(ss, 1, lane); ss += shfl_xor_l(ss, 2, lane); ss += shfl_xor_l(ss, 4, lane);
                const float rstd = 1.0f / sqrtf(ss * (1.0f / 64.0f) + EPS);
                x[0] *= rstd * g0.x; x[1] *= rstd * g0.y; x[2] *= rstd * g0.z; x[3] *= rstd * g0.w; x[4] *= rstd * g1.x; x[5] *= rstd * g1.y; x[6] *= rstd * g1.z; x[7] *= rstd * g1.w; }
            if (r < RL) { const int t = r & (T - 1), pos = a ? (t & 63) : (t >> 6);
                const f32x4 c0 = *(const f32x4*)(rc + pos * 16 + fi), c1 = *(const f32x4*)(rc + pos * 16 + fi + 4), s0 = *(const f32x4*)(rs + pos * 16 + fi), s1 = *(const f32x4*)(rs + pos * 16 + fi + 4);
                const float cs[8] = {c0.x, c0.y, c0.z, c0.w, c1.x, c1.y, c1.z, c1.w}, sn[8] = {s0.x, s0.y, s0.z, s0.w, s1.x, s1.y, s1.z, s1.w};
#pragma unroll
                for (int j = 0; j < 8; ++j) { const float y = shfl_xor_l(x[j], 2, lane); x[j] = second ? x[j] * cs[j] + y * sn[j] : x[j] * cs[j] - y * sn[j]; } }
            u32x4 o; o.x = cvtpk(x[0], x[1]); o.y = cvtpk(x[2], x[3]); o.z = cvtpk(x[4], x[5]); o.w = cvtpk(x[6], x[7]);
            *(u32x4*)((bf16_t*)(P.ws + WS_U) + (size_t)r * NIN + col) = o; }
    }
}
__device__ __forceinline__ void ph_pool(const Frame& F, const Ptrs& P, int nrows) {
    const int tid0 = fresh_tid();
    for (int i = F.vcu * 512 + tid0; i < nrows * 64; i += F.G * 512) {
        const int r = i >> 6, c8 = (i & 63) * 8;
        const bool lat = r < RL; const int Ts = lat ? T : TC; const int t = lat ? (r & (T - 1)) : ((r - RL) & (TC - 1)); const int r0 = r - t;
        const int g = c8 >> 7, hw = 1 << g;
        const int lo = t - hw < 0 ? 0 : t - hw, hi = t + hw > Ts ? Ts : t + hw;
        const bf16_t* U = (const bf16_t*)(P.ws + WS_U) + C_P + c8;
        u32x4 wv[16];
#pragma unroll
        for (int k = 0; k < 16; ++k) { const int tt = t - 8 + k; const bool ok = tt >= lo && tt < hi; wv[k] = *(const u32x4*)(U + (size_t)(r0 + (ok ? tt : t)) * NIN); }
        float s[8];
#pragma unroll
        for (int j = 0; j < 8; ++j) s[j] = 0.f;
#pragma unroll
        for (int k = 0; k < 16; ++k) { const int tt = t - 8 + k; const float f = (tt >= lo && tt < hi) ? 1.f : 0.f; const u32x4 w = wv[k];
            s[0] += f * lo16(w.x); s[1] += f * hi16(w.x); s[2] += f * lo16(w.y); s[3] += f * hi16(w.y); s[4] += f * lo16(w.z); s[5] += f * hi16(w.z); s[6] += f * lo16(w.w); s[7] += f * hi16(w.w); }
        const u32x4 w = wv[8]; const float inv = 1.0f / (float)(hi - lo);
        u32x4 o; o.x = cvtpk(s[0] * inv - lo16(w.x), s[1] * inv - hi16(w.x)); o.y = cvtpk(s[2] * inv - lo16(w.y), s[3] * inv - hi16(w.y));
        o.z = cvtpk(s[4] * inv - lo16(w.z), s[5] * inv - hi16(w.z)); o.w = cvtpk(s[6] * inv - lo16(w.w), s[7] * inv - hi16(w.w));
        *(u32x4*)((bf16_t*)(P.ws + WS_BR) + (size_t)r * NBR + 1536 + c8) = o;
    }
}
__device__ __forceinline__ void ph_final(const Frame& F, const Ptrs& P) {
    const int lane = fresh_lane(); const int stride = F.G * NWAVES;
    for (int rb = F.vcu * NWAVES + F.wave; rb < RL; rb += 4 * stride) {
        f32x4 v[4][4]; float ss[4];
#pragma unroll
        for (int q = 0; q < 4; ++q) { const int r = rb + q * stride < RL ? rb + q * stride : rb; const int bb = row_bb(r);
            const f32x4* xr = (const f32x4*)(P.out + (size_t)r * D) + lane; const f32x4* g2 = (const f32x4*)mod_vec(P, 1, bb, 5) + lane;
            const u32x2* m0 = (const u32x2*)((const bf16_t*)(P.ws + WS_MO) + (size_t)r * D) + lane; const u32x2* m1 = (const u32x2*)((const bf16_t*)(P.ws + WS_MO) + (size_t)(R + r) * D) + lane;
            ss[q] = 0.f;
#pragma unroll
            for (int j = 0; j < 4; ++j) { v[q][j] = xr[64 * j]; const u32x2 a = m0[64 * j], b = m1[64 * j]; const f32x4 g = g2[64 * j];
                v[q][j].x += g.x * (lo16(a.x) + lo16(b.x)); v[q][j].y += g.y * (hi16(a.x) + hi16(b.x)); v[q][j].z += g.z * (lo16(a.y) + lo16(b.y)); v[q][j].w += g.w * (hi16(a.y) + hi16(b.y));
                ss[q] += (v[q][j].x * v[q][j].x + v[q][j].y * v[q][j].y) + (v[q][j].z * v[q][j].z + v[q][j].w * v[q][j].w); } }
#pragma unroll
        for (int o = 1; o < 64; o <<= 1) {
#pragma unroll
            for (int q = 0; q < 4; ++q) ss[q] += shfl_xor_l(ss[q], o, lane); }
        const f32x4* gn = (const f32x4*)P.norm_f + lane;
#pragma unroll
        for (int q = 0; q < 4; ++q) { const int r = rb + q * stride; if (r >= RL) continue;
            const float rstd = 1.0f / sqrtf(ss[q] * (1.0f / D) + EPS); f32x4* xr = (f32x4*)(P.out + (size_t)r * D) + lane;
#pragma unroll
            for (int j = 0; j < 4; ++j) xr[64 * j] = v[q][j] * rstd * gn[64 * j]; }
    }
}

__device__ __forceinline__ void ph_fourier_ref(const Frame& F, const Ptrs& P, int Ts, int latent) {
    const int tid = fresh_tid();
    LAS float* Zr = (LAS float*)F.lds; LAS float* Zi = Zr + 16 * 64; LAS float* Ct = Zi + 16 * 64; LAS float* St = Ct + 64 * 17;
    const bf16_t* U = (const bf16_t*)(P.ws + WS_U); const float* ct = (const float*)(P.ws + WS_COS);
    const int nkt = Ts / 64, NU = 8 * nkt * 8, step = 4096 / Ts;
    const int tk = tid >> 4, tc = tid & 15;
    for (int u = F.vcu; u < NU; u += F.G) {
        const int cht = u & 7, kt = (u >> 3) % nkt, b = (u >> 3) / nkt, k0 = kt * 64, ch0 = cht * 64;
        const int rbase = latent ? b * T : RL + b * TC;
        float acc[2][4];
#pragma unroll
        for (int i = 0; i < 2; ++i)
#pragma unroll
            for (int j = 0; j < 4; ++j) acc[i][j] = 0.f;
        for (int t0 = 0; t0 < Ts; t0 += 16) {
            __syncthreads();
            if (tid < 256) { const int tt = tid >> 4, c4 = (tid & 15) * 4; const bf16_t* zp = U + (size_t)(rbase + t0 + tt) * NIN + ch0 + c4;
              const u32x2 a = *(const u32x2*)(zp + C_ZR), bq = *(const u32x2*)(zp + C_ZI);
              Zr[tt * 64 + c4] = lo16(a.x); Zr[tt * 64 + c4 + 1] = hi16(a.x); Zr[tt * 64 + c4 + 2] = lo16(a.y); Zr[tt * 64 + c4 + 3] = hi16(a.y);
              Zi[tt * 64 + c4] = lo16(bq.x); Zi[tt * 64 + c4 + 1] = hi16(bq.x); Zi[tt * 64 + c4 + 2] = lo16(bq.y); Zi[tt * 64 + c4 + 3] = hi16(bq.y); }
#pragma unroll
            for (int i = 0; i < 2; ++i) { const int e = tid * 2 + i, k = e >> 4, tt = e & 15; const int ang = (((k0 + k) * (t0 + tt)) & (Ts - 1)) * step;
                Ct[k * 17 + tt] = ct[ang]; St[k * 17 + tt] = ct[(ang - 1024) & 4095]; }
            __syncthreads();
#pragma unroll 2
            for (int tt = 0; tt < 16; ++tt) { float zr[4], zi[4];
#pragma unroll
                for (int j = 0; j < 4; ++j) { zr[j] = Zr[tt * 64 + tc * 4 + j]; zi[j] = Zi[tt * 64 + tc * 4 + j]; }
#pragma unroll
                for (int i = 0; i < 2; ++i) { const float c = Ct[(tk * 2 + i) * 17 + tt], sn = St[(tk * 2 + i) * 17 + tt];
#pragma unroll
                    for (int j = 0; j < 4; ++j) acc[i][j] += c * zr[j] + sn * zi[j]; } }
        }
        const float sc = 1.0f / sqrtf((float)Ts);
        bf16_t* BR = (bf16_t*)(P.ws + WS_BR);
#pragma unroll
        for (int i = 0; i < 2; ++i) { u32x2 w; w.x = pk2(acc[i][0] * sc, acc[i][1] * sc); w.y = pk2(acc[i][2] * sc, acc[i][3] * sc);
            *(u32x2*)(BR + (size_t)(rbase + k0 + tk * 2 + i) * NBR + ch0 + tc * 4) = w; }
        __syncthreads();
    }
}

typedef float f32x16 __attribute__((ext_vector_type(16)));
typedef short v4i16_t __attribute__((ext_vector_type(4)));
constexpr float ATT_THR = 4.0f;
constexpr int AT_ROWB = 144, AT_TILEB = 64 * AT_ROWB;
constexpr int AT_VROWB = 192, AT_VTILEB = 64 * AT_VROWB;
constexpr int AT_STAGEB = 2 * AT_TILEB + 2 * AT_VTILEB;
#define AT_SB() __builtin_amdgcn_sched_barrier(0)
__device__ __forceinline__ void at_qk2(const LAS unsigned char* Ka, const LAS unsigned char* Kb, int kf_off, const bf16x8 (&qr)[4], const f32x16& negm, f32x16& pa0, f32x16& pa1, f32x16& pb0, f32x16& pb1) {
    bf16x8 ka[8], kb[8];
#pragma unroll
    for (int d0 = 0; d0 < 4; ++d0) { ka[2 * d0] = *(const LAS bf16x8*)(Ka + kf_off + d0 * 32); ka[2 * d0 + 1] = *(const LAS bf16x8*)(Ka + kf_off + 32 * AT_ROWB + d0 * 32); }
    AT_SB();
#pragma unroll
    for (int d0 = 0; d0 < 4; ++d0) {
        kb[2 * d0] = *(const LAS bf16x8*)(Kb + kf_off + d0 * 32); kb[2 * d0 + 1] = *(const LAS bf16x8*)(Kb + kf_off + 32 * AT_ROWB + d0 * 32);
        AT_SB();
        if (d0 == 0) { pa0 = __builtin_amdgcn_mfma_f32_32x32x16_bf16(ka[0], qr[0], negm, 0, 0, 0); pa1 = __builtin_amdgcn_mfma_f32_32x32x16_bf16(ka[1], qr[0], negm, 0, 0, 0); }
        else { pa0 = __builtin_amdgcn_mfma_f32_32x32x16_bf16(ka[2 * d0], qr[d0], pa0, 0, 0, 0); pa1 = __builtin_amdgcn_mfma_f32_32x32x16_bf16(ka[2 * d0 + 1], qr[d0], pa1, 0, 0, 0); }
        AT_SB();
    }
    pb0 = __builtin_amdgcn_mfma_f32_32x32x16_bf16(kb[0], qr[0], negm, 0, 0, 0); pb1 = __builtin_amdgcn_mfma_f32_32x32x16_bf16(kb[1], qr[0], negm, 0, 0, 0);
#pragma unroll
    for (int d0 = 1; d0 < 4; ++d0) { pb0 = __builtin_amdgcn_mfma_f32_32x32x16_bf16(kb[2 * d0], qr[d0], pb0, 0, 0, 0); pb1 = __builtin_amdgcn_mfma_f32_32x32x16_bf16(kb[2 * d0 + 1], qr[d0], pb1, 0, 0, 0); }
}
__device__ __forceinline__ void at_vread(const LAS unsigned char* vp, v4i16_t (&f)[4]) {
    f[0] = __builtin_amdgcn_ds_read_tr16_b64_v4i16((LAS v4i16_t*)(vp)); f[1] = __builtin_amdgcn_ds_read_tr16_b64_v4i16((LAS v4i16_t*)(vp + 8 * AT_VROWB));
    f[2] = __builtin_amdgcn_ds_read_tr16_b64_v4i16((LAS v4i16_t*)(vp + 64)); f[3] = __builtin_amdgcn_ds_read_tr16_b64_v4i16((LAS v4i16_t*)(vp + 8 * AT_VROWB + 64));
}
__device__ __forceinline__ bf16x8 at_ppack(const f32x16& p, int sx) { u32x4 pw; pw.x = cvtpk(p[8 * sx], p[8 * sx + 1]); pw.y = cvtpk(p[8 * sx + 2], p[8 * sx + 3]); pw.z = cvtpk(p[8 * sx + 4], p[8 * sx + 5]); pw.w = cvtpk(p[8 * sx + 6], p[8 * sx + 7]); return __builtin_bit_cast(bf16x8, pw); }
__device__ __forceinline__ void at_pvmm(const v4i16_t (&f)[4], const bf16x8 pf, f32x16& o0, f32x16& o1) {
    const bf16x8 v0 = (bf16x8){f[0][0], f[0][1], f[0][2], f[0][3], f[1][0], f[1][1], f[1][2], f[1][3]}, v1 = (bf16x8){f[2][0], f[2][1], f[2][2], f[2][3], f[3][0], f[3][1], f[3][2], f[3][3]};
    o0 = __builtin_amdgcn_mfma_f32_32x32x16_bf16(v0, pf, o0, 0, 0, 0); o1 = __builtin_amdgcn_mfma_f32_32x32x16_bf16(v1, pf, o1, 0, 0, 0);
}
__device__ __forceinline__ float at_exp8(f32x16& p, int sx) { float rs = 0.f;
#pragma unroll
    for (int j = 0; j < 8; ++j) { p[8 * sx + j] = __builtin_amdgcn_exp2f(p[8 * sx + j]); rs += p[8 * sx + j]; }
    return rs; }
__device__ __forceinline__ float at_exp_pv2(const LAS unsigned char* Va, const LAS unsigned char* Vb, int vf_off, f32x16& pa0, f32x16& pa1, f32x16& pb0, f32x16& pb1, f32x16& o0, f32x16& o1) {
    v4i16_t fA[4], fB[4]; float rs;
    at_vread(Va + vf_off, fA); rs = at_exp8(pa0, 0); AT_SB();
    at_vread(Va + vf_off + 16 * AT_VROWB, fB); at_pvmm(fA, at_ppack(pa0, 0), o0, o1); rs += at_exp8(pa0, 1); AT_SB();
    at_vread(Va + vf_off + 32 * AT_VROWB, fA); at_pvmm(fB, at_ppack(pa0, 1), o0, o1); rs += at_exp8(pa1, 0); AT_SB();
    at_vread(Va + vf_off + 48 * AT_VROWB, fB); at_pvmm(fA, at_ppack(pa1, 0), o0, o1); rs += at_exp8(pa1, 1); AT_SB();
    at_vread(Vb + vf_off, fA);                 at_pvmm(fB, at_ppack(pa1, 1), o0, o1); rs += at_exp8(pb0, 0); AT_SB();
    at_vread(Vb + vf_off + 16 * AT_VROWB, fB); at_pvmm(fA, at_ppack(pb0, 0), o0, o1); rs += at_exp8(pb0, 1); AT_SB();
    at_vread(Vb + vf_off + 32 * AT_VROWB, fA); at_pvmm(fB, at_ppack(pb0, 1), o0, o1); rs += at_exp8(pb1, 0); AT_SB();
    at_vread(Vb + vf_off + 48 * AT_VROWB, fB); at_pvmm(fA, at_ppack(pb1, 0), o0, o1); rs += at_exp8(pb1, 1); AT_SB();
    at_pvmm(fB, at_ppack(pb1, 1), o0, o1);
    return rs;
}
template <int MODE> __device__ __forceinline__ void ph_attn(const Frame& F, const Ptrs& P, int l) {
    const int lane = fresh_lane(), tid = F.wave * 64 + lane, r32 = lane & 31, hi = lane >> 5;
    const bf16_t* U = (const bf16_t*)(P.ws + WS_U);
    const bool latq = MODE < 2; const bool winm = (MODE == 1 || MODE == 3);
    const int NU = latq ? 1024 : 64;
    LAS unsigned char* Lb = F.lds;
    const int st_off = (tid >> 3) * AT_ROWB + (tid & 7) * 16;
    const int kf_off = r32 * AT_ROWB + hi * 16;
    const int sv_off = (tid >> 3) * AT_VROWB + (tid & 7) * 16;
    const int vf_off = (4 * hi + ((lane & 15) >> 2)) * AT_VROWB + (((lane >> 4) & 1) * 16 + (lane & 3) * 4) * 2;
    for (int u = F.vcu; u < NU; u += F.G) {
        const int qb = latq ? (u & 63) : (u & 3), g = latq ? ((u >> 6) & 1) : ((u >> 2) & 1), b = latq ? (u >> 7) : (u >> 3);
        const int tq0 = qb * 64, hq = 4 * g + (F.wave >> 1), tq = tq0 + 32 * (F.wave & 1) + r32;
        const int qrow = latq ? b * T + tq : RL + b * TC + tq;
        const int qcol = (winm ? C_QW : C_QB) + hq * 64, kcol = (winm ? C_KW : C_KB) + g * 64, vcol = (winm ? C_VW : C_VB) + g * 64;
        int lt_lo = 0, lt_hi = 0;
        if (MODE == 0) { lt_lo = 0; lt_hi = T / 64; }
        if (MODE == 1) { lt_lo = (tq0 - 128 < 0 ? 0 : tq0 - 128) / 64; lt_hi = (tq0 + 192 > T ? T : tq0 + 192) / 64; }
        const int ntiles = 4 + (lt_hi - lt_lo), npairs = (ntiles + 1) >> 1;
        bf16x8 qr[4];
        {
            float x[4][8];
#pragma unroll
            for (int d0 = 0; d0 < 4; ++d0) { const u32x4 wq = *(const u32x4*)(U + (size_t)qrow * NIN + qcol + d0 * 16 + hi * 8);
                x[d0][0] = lo16(wq.x); x[d0][1] = hi16(wq.x); x[d0][2] = lo16(wq.y); x[d0][3] = hi16(wq.y); x[d0][4] = lo16(wq.z); x[d0][5] = hi16(wq.z); x[d0][6] = lo16(wq.w); x[d0][7] = hi16(wq.w); }
            if (!winm) { float ss = 0.f;
#pragma unroll
                for (int d0 = 0; d0 < 4; ++d0)
#pragma unroll
                    for (int j = 0; j < 8; ++j) ss += x[d0][j] * x[d0][j];
                ss += shfl_xor_l(ss, 32, lane);
                const float rstd = 1.0f / sqrtf(ss * (1.0f / 64.0f) + EPS);
#pragma unroll
                for (int d0 = 0; d0 < 4; ++d0) { const f32x4 ga = *(const f32x4*)(P.q_gain + l * 64 + d0 * 16 + hi * 8), gb = *(const f32x4*)(P.q_gain + l * 64 + d0 * 16 + hi * 8 + 4);
                    x[d0][0] *= rstd * ga.x; x[d0][1] *= rstd * ga.y; x[d0][2] *= rstd * ga.z; x[d0][3] *= rstd * ga.w; x[d0][4] *= rstd * gb.x; x[d0][5] *= rstd * gb.y; x[d0][6] *= rstd * gb.z; x[d0][7] *= rstd * gb.w; } }
            if (latq) { const float* rc = (const float*)(P.ws + WS_ROPE); const float* rs = rc + 1024;
#pragma unroll
                for (int a = 0; a < 2; ++a) { const int pos = a ? (tq & 63) : (tq >> 6);
                    const f32x4 c0 = *(const f32x4*)(rc + pos * 16 + hi * 8), c1 = *(const f32x4*)(rc + pos * 16 + hi * 8 + 4), s0 = *(const f32x4*)(rs + pos * 16 + hi * 8), s1 = *(const f32x4*)(rs + pos * 16 + hi * 8 + 4);
                    const float cs[8] = {c0.x, c0.y, c0.z, c0.w, c1.x, c1.y, c1.z, c1.w}, sn[8] = {s0.x, s0.y, s0.z, s0.w, s1.x, s1.y, s1.z, s1.w};
#pragma unroll
                    for (int j = 0; j < 8; ++j) { const float x1 = x[2 * a][j], x2 = x[2 * a + 1][j]; x[2 * a][j] = x1 * cs[j] - x2 * sn[j]; x[2 * a + 1][j] = x2 * cs[j] + x1 * sn[j]; } } }
#pragma unroll
            for (int d0 = 0; d0 < 4; ++d0) { u32x4 wq; wq.x = cvtpk(x[d0][0] * QSCALE, x[d0][1] * QSCALE); wq.y = cvtpk(x[d0][2] * QSCALE, x[d0][3] * QSCALE); wq.z = cvtpk(x[d0][4] * QSCALE, x[d0][5] * QSCALE); wq.w = cvtpk(x[d0][6] * QSCALE, x[d0][7] * QSCALE);
                qr[d0] = __builtin_bit_cast(bf16x8, wq); }
        }
        f32x16 o0, o1, negm;
#pragma unroll
        for (int r = 0; r < 16; ++r) { o0[r] = 0.f; o1[r] = 0.f; negm[r] = 0.f; }
        float mhat = 0.f, lsum = 0.f;
#define AT_KROW(ti) ((ti) < 4 ? RL + b * TC + (ti) * 64 : b * T + (lt_lo + (ti) - 4) * 64)
        u32x4 ka, va, kb2, vb2;
        { const int r0 = AT_KROW(0) + (tid >> 3), r1 = AT_KROW(1) + (tid >> 3); const int co = (tid & 7) * 8;
          ka = *(const u32x4*)(U + (size_t)r0 * NIN + kcol + co); va = *(const u32x4*)(U + (size_t)r0 * NIN + vcol + co);
          kb2 = *(const u32x4*)(U + (size_t)r1 * NIN + kcol + co); vb2 = *(const u32x4*)(U + (size_t)r1 * NIN + vcol + co);
          *(LAS u32x4*)(Lb + st_off) = ka; *(LAS u32x4*)(Lb + AT_TILEB + st_off) = kb2; *(LAS u32x4*)(Lb + 2 * AT_TILEB + sv_off) = va; *(LAS u32x4*)(Lb + 2 * AT_TILEB + AT_VTILEB + sv_off) = vb2; }
        __syncthreads();
        for (int tp = 0; tp < npairs; ++tp) {
            const int cur = (tp & 1) * AT_STAGEB, nxt = AT_STAGEB - cur;
            const bool more = tp + 1 < npairs;
            const int ta = 2 * tp, tb = 2 * tp + 1; const bool hasb = tb < ntiles;
            if (more) { const int na = 2 * tp + 2, nb = (2 * tp + 3 < ntiles) ? 2 * tp + 3 : na;
                const int r0 = AT_KROW(na) + (tid >> 3), r1 = AT_KROW(nb) + (tid >> 3); const int co = (tid & 7) * 8;
                ka = *(const u32x4*)(U + (size_t)r0 * NIN + kcol + co); va = *(const u32x4*)(U + (size_t)r0 * NIN + vcol + co);
                kb2 = *(const u32x4*)(U + (size_t)r1 * NIN + kcol + co); vb2 = *(const u32x4*)(U + (size_t)r1 * NIN + vcol + co); }
            f32x16 pa0, pa1, pb0, pb1;
            at_qk2(Lb + cur, Lb + cur + AT_TILEB, kf_off, qr, negm, pa0, pa1, pb0, pb1);
            if (MODE == 1) {
                const int qlo = tq0 + 32 * (F.wave & 1);
                if (ta >= 4) { const int kb0 = (lt_lo + ta - 4) * 64;
                    if (kb0 + 63 - qlo > 128 || qlo + 31 - kb0 > 128) { const int kp0 = kb0 + 4 * hi - tq;
#pragma unroll
                        for (int r = 0; r < 16; ++r) { const int dl = kp0 + (r & 3) + 8 * (r >> 2);
                            if (dl > 128 || dl < -128) pa0[r] = -INFINITY;
                            if (dl + 32 > 128 || dl + 32 < -128) pa1[r] = -INFINITY; } } }
                if (tb >= 4 && hasb) { const int kb0 = (lt_lo + tb - 4) * 64;
                    if (kb0 + 63 - qlo > 128 || qlo + 31 - kb0 > 128) { const int kp0 = kb0 + 4 * hi - tq;
#pragma unroll
                        for (int r = 0; r < 16; ++r) { const int dl = kp0 + (r & 3) + 8 * (r >> 2);
                            if (dl > 128 || dl < -128) pb0[r] = -INFINITY;
                            if (dl + 32 > 128 || dl + 32 < -128) pb1[r] = -INFINITY; } } }
                if (!hasb) {
#pragma unroll
                    for (int r = 0; r < 16; ++r) { pb0[r] = -INFINITY; pb1[r] = -INFINITY; } }
            }
            float mx = fmaxf(fmaxf(pa0[0], pa1[0]), fmaxf(pb0[0], pb1[0]));
#pragma unroll
            for (int r = 1; r < 16; ++r) mx = fmaxf(mx, fmaxf(fmaxf(pa0[r], pa1[r]), fmaxf(pb0[r], pb1[r])));
            mx = fmaxf(mx, shfl_xor_l(mx, 32, lane));
            if (tp == 0 || __any(mx > ATT_THR)) {
                const float dl = tp == 0 ? mx : fmaxf(mx, 0.f);
                mhat += dl;
                const float alpha = __builtin_amdgcn_exp2f(-dl); lsum *= alpha;
#pragma unroll
                for (int r = 0; r < 16; ++r) { pa0[r] -= dl; pa1[r] -= dl; pb0[r] -= dl; pb1[r] -= dl; o0[r] *= alpha; o1[r] *= alpha; negm[r] = -mhat; }
            }
            lsum += at_exp_pv2(Lb + cur + 2 * AT_TILEB, Lb + cur + 2 * AT_TILEB + AT_VTILEB, vf_off, pa0, pa1, pb0, pb1, o0, o1);
            if (more) { *(LAS u32x4*)(Lb + nxt + st_off) = ka; *(LAS u32x4*)(Lb + nxt + AT_TILEB + st_off) = kb2; *(LAS u32x4*)(Lb + nxt + 2 * AT_TILEB + sv_off) = va; *(LAS u32x4*)(Lb + nxt + 2 * AT_TILEB + AT_VTILEB + sv_off) = vb2; }
            __syncthreads();
        }
#undef AT_KROW
        lsum += shfl_xor_l(lsum, 32, lane);
        if (winm) lsum += exp2f(P.sink[l * 8 + hq] * LOG2E - mhat);
        const float inv = 1.0f / lsum;
        bf16_t* op = (bf16_t*)(P.ws + WS_BR) + (size_t)qrow * NBR + (winm ? 1024 : 512) + hq * 64 + 4 * hi;
#pragma unroll
        for (int gq = 0; gq < 4; ++gq) {
            u32x2 w0, w1; w0.x = cvtpk(o0[4 * gq] * inv, o0[4 * gq + 1] * inv); w0.y = cvtpk(o0[4 * gq + 2] * inv, o0[4 * gq + 3] * inv);
            w1.x = cvtpk(o1[4 * gq] * inv, o1[4 * gq + 1] * inv); w1.y = cvtpk(o1[4 * gq + 2] * inv, o1[4 * gq + 3] * inv);
            *(u32x2*)(op + 8 * gq) = w0; *(u32x2*)(op + 32 + 8 * gq) = w1; }
    }
}

constexpr int DF_ROWB = 528;
template <int STAGE> __device__ __forceinline__ void ph_dft(const Frame& F, const Ptrs& P) {
    const int lane = fresh_lane(), tid = F.wave * 64 + lane, r32 = lane & 31, hi = lane >> 5, w = F.wave;
    bf16_t* U = (bf16_t*)(P.ws + WS_U); bf16_t* BR = (bf16_t*)(P.ws + WS_BR); const bf16_t* Wm = (const bf16_t*)(P.ws + WS_DFTM);
    LAS unsigned char* Xl = F.lds;
    const int xf_off = (8 * hi + ((lane & 15) >> 2)) * DF_ROWB + (32 * w + ((lane >> 4) & 1) * 16 + (lane & 3) * 4) * 2;
    constexpr int NMB = STAGE == 2 ? 4 : 2;
    const int seg = tid >> 2, part = tid & 3, pp = seg >> 6, jj = seg & 63;
    u32x4 pf[8];
    if (F.vcu < 1024) { const int u = F.vcu; const int chb = u & 1, sidx = (u >> 1) & 63, b = u >> 7;
        const int grow = STAGE == 2 ? b * T + 64 * jj + sidx : b * T + 64 * sidx + jj;
        const u32x4* src = (const u32x4*)(U + (size_t)grow * NIN + pp * 512 + chb * 256 + part * 64);
#pragma unroll
        for (int i = 0; i < 8; ++i) pf[i] = src[i]; }
    for (int u = F.vcu; u < 1024; u += F.G) {
        const int chb = u & 1, sidx = (u >> 1) & 63, b = u >> 7;
#pragma unroll
        for (int i = 0; i < 8; ++i) *(LAS u32x4*)(Xl + seg * DF_ROWB + part * 128 + i * 16) = pf[i];
        if (u + F.G < 1024) { const int un = u + F.G; const int chbn = un & 1, sn = (un >> 1) & 63, bn = un >> 7;
            const int grow = STAGE == 2 ? bn * T + 64 * jj + sn : bn * T + 64 * sn + jj;
            const u32x4* src = (const u32x4*)(U + (size_t)grow * NIN + pp * 512 + chbn * 256 + part * 64);
#pragma unroll
            for (int i = 0; i < 8; ++i) pf[i] = src[i]; }
        __syncthreads();
        f32x16 acc[NMB];
#pragma unroll
        for (int mb = 0; mb < NMB; ++mb)
#pragma unroll
            for (int r = 0; r < 16; ++r) acc[mb][r] = 0.f;
#pragma unroll
        for (int ks = 0; ks < 8; ++ks) {
            const v4i16_t lo4 = __builtin_amdgcn_ds_read_tr16_b64_v4i16((LAS v4i16_t*)(Xl + xf_off + (16 * ks) * DF_ROWB));
            const v4i16_t hi4 = __builtin_amdgcn_ds_read_tr16_b64_v4i16((LAS v4i16_t*)(Xl + xf_off + (16 * ks + 4) * DF_ROWB));
            const bf16x8 xf = (bf16x8){lo4[0], lo4[1], lo4[2], lo4[3], hi4[0], hi4[1], hi4[2], hi4[3]};
#pragma unroll
            for (int mb = 0; mb < NMB; ++mb) { const bf16x8 wf = *(const bf16x8*)(Wm + (mb * 32 + r32) * 128 + 16 * ks + 8 * hi);
                acc[mb] = __builtin_amdgcn_mfma_f32_32x32x16_bf16(xf, wf, acc[mb], 0, 0, 0); }
        }
        LAS unsigned char* ob = Xl + (32 * w + 4 * hi) * 2;
        if (STAGE == 2) {
#pragma unroll
            for (int mb = 0; mb < 2; ++mb) { const int k1 = mb * 32 + r32; const float rev = (float)((k1 * sidx) & 4095) * (1.0f / 4096.0f);
                const float ct = __builtin_amdgcn_cosf(rev), st = __builtin_amdgcn_sinf(rev);
#pragma unroll
                for (int gq = 0; gq < 4; ++gq) { u32x2 wr, wi; float yr[4], yi[4];
#pragma unroll
                    for (int i = 0; i < 4; ++i) { const float a = acc[mb][4 * gq + i], bq = acc[mb + 2][4 * gq + i]; yr[i] = a * ct + bq * st; yi[i] = bq * ct - a * st; }
                    wr.x = cvtpk(yr[0], yr[1]); wr.y = cvtpk(yr[2], yr[3]); wi.x = cvtpk(yi[0], yi[1]); wi.y = cvtpk(yi[2], yi[3]);
                    *(LAS u32x2*)(ob + k1 * DF_ROWB + 16 * gq) = wr; *(LAS u32x2*)(ob + (64 + k1) * DF_ROWB + 16 * gq) = wi; } }
        } else {
#pragma unroll
            for (int mb = 0; mb < 2; ++mb) { const int k2 = mb * 32 + r32;
#pragma unroll
                for (int gq = 0; gq < 4; ++gq) { u32x2 wr; wr.x = cvtpk(acc[mb][4 * gq] * 0.015625f, acc[mb][4 * gq + 1] * 0.015625f); wr.y = cvtpk(acc[mb][4 * gq + 2] * 0.015625f, acc[mb][4 * gq + 3] * 0.015625f);
                    *(LAS u32x2*)(ob + k2 * DF_ROWB + 16 * gq) = wr; } }
        }
        __syncthreads();
        if (STAGE == 2) {
            u32x4* dst = (u32x4*)(U + (size_t)(b * T + 64 * jj + sidx) * NIN + pp * 512 + chb * 256 + part * 64);
#pragma unroll
            for (int i = 0; i < 8; ++i) dst[i] = *(const LAS u32x4*)(Xl + seg * DF_ROWB + part * 128 + i * 16);
        } else { const int k2 = tid >> 3, part8 = tid & 7;
            u32x4* dst = (u32x4*)(BR + (size_t)(b * T + 64 * k2 + sidx) * NBR + chb * 256 + part8 * 32);
#pragma unroll
            for (int i = 0; i < 4; ++i) dst[i] = *(const LAS u32x4*)(Xl + k2 * DF_ROWB + part8 * 64 + i * 16); }
        __syncthreads();
    }
}

struct MegaArgs { Ptrs P; int ph_lo, ph_hi, li, pad; };
__global__ void __launch_bounds__(NWAVES * 64, 2) mega(MegaArgs args) {
    extern __shared__ __attribute__((aligned(16))) unsigned char lds_raw[];
    Frame F; F.lds = (LAS unsigned char*)lds_raw;
    F.wave = __builtin_amdgcn_readfirstlane(threadIdx.x >> 6);
    F.G = gridDim.x; { const int bx = blockIdx.x; F.vcu = (F.G % 8 == 0) ? (bx % 8) * (F.G / 8) + bx / 8 : bx; }
    const Ptrs& P = args.P;
    for (int u = fresh_tid(); u < (LDS_BYTES - LDSCTL_OFF) / 4; u += NWAVES * 64) ((LAS unsigned*)(F.lds + LDSCTL_OFF))[u] = 0u;
    __syncthreads();
    volatile LAS unsigned* MISC = (volatile LAS unsigned*)(F.lds + MISC_OFF);
    XcdBarrier bar = xcd_barrier_post((unsigned*)(P.ws + WS_CTL) + CW_BAR + args.li * XCD_BAR_WORDS, MISC + 8, F.wave);
    const int lo = args.ph_lo, hi = args.ph_hi;
    unsigned char* ws = P.ws;
    bf16_t* H = (bf16_t*)(ws + WS_H); bf16_t* U = (bf16_t*)(ws + WS_U); bf16_t* BR = (bf16_t*)(ws + WS_BR);
    bf16_t* MG = (bf16_t*)(ws + WS_MG); bf16_t* HID = (bf16_t*)(ws + WS_HID); bf16_t* MO = (bf16_t*)(ws + WS_MO);
    const bf16_t* Bt_in = (const bf16_t*)(ws + WS_WB + WB_IN); const bf16_t* Bt_gate = (const bf16_t*)(ws + WS_WB + WB_GATE); const bf16_t* Bt_br = (const bf16_t*)(ws + WS_WB + WB_BR);
    const bf16_t* Bt_out = (const bf16_t*)(ws + WS_WB + WB_OUT); const bf16_t* Bt_13 = (const bf16_t*)(ws + WS_WB + WB_13); const bf16_t* Bt_2 = (const bf16_t*)(ws + WS_WB + WB_2);
#define IN(g) (lo <= (g) && (g) < hi)
#define SEAM(g) do { if ((g) + 1 < hi) xcd_barrier(bar); } while (0)
    for (int l = 0; l < 2; ++l) {
        const int pb = l * NPH; const int M = l == 0 ? R : RL;
        if (IN(pb + 0)) { if (l == 0) ph_tables_mod(F, P); ph_weights(F, P, l); if (l == 0) SEAM(pb + 0); }
        if (IN(pb + 1)) { if (l == 0) ph_norm<0>(F, P, l, R); else ph_norm<1>(F, P, l, R); SEAM(pb + 1); }
        if (IN(pb + 2)) {
            pg8::StaticOrder S; S.init(R, NIN, F.G, (int)blockIdx.x, H, D, Bt_in, D);
            pg8::EpiV8<FStore8> E{FStore8{U, NIN}};
            pg8::gemm_phase(F.lds, F.wave, D, D, D, S, E);
            SEAM(pb + 2);
        }
        if (IN(pb + 3)) { ph_kprep(F, P, l); ph_pool(F, P, M); SEAM(pb + 3); }
        if (IN(pb + 4)) {
            ph_dft<2>(F, P); ph_attn<1>(F, P, l);
            if (l == 0) { ph_attn<2>(F, P, l); ph_attn<3>(F, P, l); ph_fourier_ref(F, P, TC, 0); }
            xcd_barrier(bar);
            ph_dft<3>(F, P); ph_attn<0>(F, P, l);
            SEAM(pb + 4);
        }
        if (IN(pb + 5)) {
            pg8::StaticOrder S; S.init(M, 4096, F.G, (int)blockIdx.x, H, D, Bt_gate, D);
            pg8::EpiV8<FGateU8> E{FGateU8{(unsigned char*)(ws + WS_GT), P.b_gate + (size_t)l * 4096}};
            pg8::gemm_phase(F.lds, F.wave, D, D, D, S, E);
            SEAM(pb + 5);
        }
        if (IN(pb + 6)) {
            pg8::StaticOrder S; S.init(M, D, F.G, (int)blockIdx.x, BR, NBR, Bt_br, NBR);
            pg8::EpiMergeS E{(const unsigned char*)(ws + WS_GT), MG};
            pg8::gemm_phase(F.lds, F.wave, NBR, NBR, NBR, S, E);
            xcd_barrier(bar);
        }
        if (IN(pb + 10)) {
            pg8::StaticOrder S; S.init(M, D, F.G, (int)blockIdx.x, MG, D, Bt_out, D);
            pg8::EpiV4<FOut> E{FOut{P, l}};
            pg8::gemm_phase(F.lds, F.wave, D, D, D, S, E);
            SEAM(pb + 10);
        }
        if (IN(pb + 11)) { ph_norm<2>(F, P, l, M); xcd_barrier(bar); }
        if (IN(pb + 13) || IN(pb + 14)) {
            LAS int* ptab = (LAS int*)(F.lds + LDSCTL_OFF);
            if (fresh_tid() == 0) { const unsigned* cnt = (const unsigned*)(ws + WS_CTL) + CW_CNT + 1024 * l; int off = 0;
                for (int e = 0; e < 16; ++e) { const int c = (int)cnt[64 * e]; ptab[e] = off; ptab[17 + e] = c; off += (c + 255) >> 8; } ptab[16] = off; }
            __syncthreads();
            if (IN(pb + 13)) {
                pg8::MoeOrder<true> S; S.nN = 4; S.G = F.G; S.c = F.vcu; S.A = (const char*)H; S.Bt = (const char*)Bt_13; S.astep = 0; S.bstep = (size_t)256 * D * 2; S.bexp = (size_t)1024 * 1024 * 2; S.tab = (const int*)ptab; S.tokl = (const int*)(ws + WS_TOKL);
                pg8::EpiDual<FMoe1> E{FMoe1{HID}};
                pg8::gemm_phase(F.lds, F.wave, D, D, D, S, E);
                SEAM(pb + 13);
            }
            if (IN(pb + 14)) {
                pg8::MoeOrder<false> S; S.nN = 4; S.G = F.G; S.c = F.vcu; S.A = (const char*)HID; S.Bt = (const char*)Bt_2; S.astep = (size_t)256 * FF * 2; S.bstep = (size_t)256 * FF * 2; S.bexp = (size_t)1024 * 512 * 2; S.tab = (const int*)ptab; S.tokl = nullptr;
                pg8::EpiV8<FMoe2> E{FMoe2{MO, (const int*)(ws + WS_TOKL), (const float*)(ws + WS_WL)}};
                pg8::gemm_phase(F.lds, F.wave, FF, FF, FF, S, E);
                SEAM(pb + 14);
            }
        }
    }
    if (IN(PH_FINAL)) ph_final(F, P);
#undef IN
#undef SEAM
}

extern "C" void kernel_launch(void* const* d_in, const int* in_sizes, int n_in, void* d_out, int out_size, void* d_ws, size_t ws_size, hipStream_t stream) {
    if (n_in != 24 || ws_size < WS_END || out_size != RL * D) { fprintf(stderr, "kernel_launch: unexpected sizes n_in %d ws %zu out %d\n", n_in, ws_size, out_size); return; }
    static int grid = 0;
    if (grid == 0) {
        int dev = 0, cus = 0;
        if (hipGetDevice(&dev) != hipSuccess || hipDeviceGetAttribute(&cus, hipDeviceAttributeMultiprocessorCount, dev) != hipSuccess) { grid = -1; return; }
        if (hipFuncSetAttribute((const void*)mega, hipFuncAttributeMaxDynamicSharedMemorySize, LDS_BYTES) != hipSuccess) { fprintf(stderr, "kernel_launch: hipFuncSetAttribute failed\n"); grid = -1; return; }
        int per_cu = 0;
        if (hipOccupancyMaxActiveBlocksPerMultiprocessor(&per_cu, (const void*)mega, NWAVES * 64, LDS_BYTES) != hipSuccess || per_cu < 1) fprintf(stderr, "kernel_launch: occupancy query says %d\n", per_cu);
        (void)hipGetLastError();
        grid = cus;
    }
    if (grid < 0) return;
    MegaArgs a{};
    const float** pp = (const float**)&a.P;
    for (int i = 0; i < 24; ++i) pp[i] = (const float*)d_in[i];
    a.P.out = (float*)d_out; a.P.ws = (unsigned char*)d_ws;
    (void)hipMemsetAsync((unsigned char*)d_ws + WS_CTL, 0, 128 * 1024, stream);
    a.ph_lo = 0; a.ph_hi = PH_FINAL + 1; a.li = 0;
    hipLaunchKernelGGL(mega, dim3(grid), dim3(NWAVES * 64), LDS_BYTES, stream, a);
}
```

```cpp
#include <hip/hip_runtime.h>
#include <cstdio>
#include <cstdint>

typedef unsigned short bf16_t;
typedef short bf16x8 __attribute__((ext_vector_type(8)));
typedef float f32x4 __attribute__((ext_vector_type(4)));
typedef unsigned u32x4 __attribute__((ext_vector_type(4)));
typedef unsigned u32x2 __attribute__((ext_vector_type(2)));

constexpr int D = 1024, NB = 8, T = 4096, TC = 256;
constexpr int RL = NB * T, RC = NB * TC, R = RL + RC;
constexpr int NIN = 3072;
constexpr int C_ZR = 0, C_ZI = 512, C_P = 1024, C_QB = 1536, C_KB = 2048, C_VB = 2176, C_QW = 2304, C_KW = 2816, C_VW = 2944;
constexpr int NBR = 2048;
constexpr int NE = 16, FF = 512;
constexpr int MAXROWS = 73728;
constexpr float EPS = 1e-6f;
constexpr float QSCALE = 0.125f * 1.4426950408889634f;
constexpr float LOG2E = 1.4426950408889634f;

constexpr size_t MiB = 1u << 20;
constexpr size_t WS_CTL = 0;
constexpr size_t WS_MOD = 1 * MiB;
constexpr size_t WS_ROPE = 1 * MiB + 512 * 1024;
constexpr size_t WS_COS = WS_ROPE + 16 * 1024;
constexpr size_t WS_DFTM = WS_ROPE + 64 * 1024;
constexpr size_t WS_TOKL = 2 * MiB;
constexpr size_t WS_WL = 4 * MiB + 512 * 1024;
constexpr size_t WS_XC = 9 * MiB;
constexpr size_t WS_WB = 17 * MiB;
constexpr size_t WB_IN = 0, WB_GATE = 6 * MiB, WB_BR = 14 * MiB, WB_OUT = 18 * MiB, WB_13 = 20 * MiB, WB_2 = 52 * MiB;
constexpr size_t WS_H = 85 * MiB;
constexpr size_t WS_ARENA = 153 * MiB;
constexpr size_t WS_U = WS_ARENA;
constexpr size_t WS_BR = WS_ARENA + 204 * MiB;
constexpr size_t WS_GT = WS_ARENA;
constexpr size_t WS_MG = WS_ARENA + 136 * MiB;
constexpr size_t WS_HID = WS_ARENA + 144 * MiB;
constexpr size_t WS_MO = WS_ARENA + 216 * MiB;
constexpr size_t WS_END = 512 * MiB;
static_assert(WS_BR + (size_t)R * NBR * 2 <= WS_END && WS_MO + (size_t)2 * R * D * 2 <= WS_END && WS_MG + (size_t)R * D * 2 <= WS_BR, "ws map");
constexpr int CW_CNT = 8192;

__device__ __forceinline__ float bf2f(bf16_t b) { return __uint_as_float(((unsigned)b) << 16); }
__device__ __forceinline__ unsigned f2bf(float f) { unsigned u = __float_as_uint(f); return (u + 0x7fffu + ((u >> 16) & 1u)) >> 16; }
__device__ __forceinline__ unsigned pk2(float lo, float hi) { return f2bf(lo) | (f2bf(hi) << 16); }
typedef __bf16 bf16x2_t __attribute__((ext_vector_type(2)));
typedef float f32x2_t __attribute__((ext_vector_type(2)));
__device__ __forceinline__ unsigned cvtpk(float lo, float hi) { f32x2_t v = {lo, hi}; bf16x2_t b = __builtin_convertvector(v, bf16x2_t); return __builtin_bit_cast(unsigned, b); }
__device__ __forceinline__ float lo16(unsigned w) { return __uint_as_float(w << 16); }
__device__ __forceinline__ float hi16(unsigned w) { return __uint_as_float(w & 0xffff0000u); }
__device__ __forceinline__ float shfl_xor_l(float v, int o, int lane) { return __int_as_float(__builtin_amdgcn_ds_bpermute((lane ^ o) << 2, __float_as_int(v))); }
__device__ __forceinline__ float wave_sum_l(float v, int lane) {
#pragma unroll
    for (int o = 1; o < 64; o <<= 1) v += shfl_xor_l(v, o, lane);
    return v;
}
__device__ __forceinline__ int row_bb(int r) { return r < RL ? (r >> 12) : 8; }

struct Ptrs {
    const float *x, *c, *ctx, *c_ctx, *w_ada, *b_ada, *norm1, *norm2, *w_in, *q_gain, *k_gain, *sink, *pool_w, *pool_scale,
        *w_branch, *w_gate, *b_gate, *w_out, *router_w, *router_bias, *w1, *w3, *w2, *norm_f;
    float* out; unsigned char* ws;
};
__device__ __forceinline__ const float* xin_row(const Ptrs& P, int r) { return r < RL ? P.x + (size_t)r * D : P.ctx + (size_t)(r - RL) * D; }
__device__ __forceinline__ float* x1_row(const Ptrs& P, int r) { return r < RL ? P.out + (size_t)r * D : (float*)(P.ws + WS_XC) + (size_t)(r - RL) * D; }
__device__ __forceinline__ const float* mod_vec(const Ptrs& P, int l, int bb, int which) { return (const float*)(P.ws + WS_MOD) + ((size_t)(l * 9 + bb) * 6 + which) * D; }

#define LAS __attribute__((address_space(3)))
#define GAS __attribute__((address_space(1)))
#define LDS_WAIT() asm volatile("s_waitcnt lgkmcnt(0)" ::: "memory")
__device__ __forceinline__ int fresh_lane() { int l; asm volatile("v_mbcnt_lo_u32_b32 %0, -1, 0\n\tv_mbcnt_hi_u32_b32 %0, -1, %0" : "=v"(l)); return l; }
constexpr int NWAVES = 8;
constexpr int RING_BYTES = 131072, LDSCTL_OFF = RING_BYTES, MISC_OFF = LDSCTL_OFF + 320, LDS_BYTES = 147456;
constexpr int CW_BAR = 16384;
constexpr int NPH = 15, PH_FINAL = 2 * NPH;

#define XB_TMO      128
#define XB_XCNT(j)  (256  + 64 * (j))
#define XB_XSUB(j)  (1280 + 64 * (j))
#define XB_XGEN(j)  (2304 + 64 * (j))
#define XB_TOP      3328
#define XB_TOPGEN   3392
#define XCD_BAR_WORDS 3456
#define XB_SPIN_CAP (1u << 21)
__device__ __forceinline__ unsigned xb_ld(unsigned* p)              { return __hip_atomic_load(p, __ATOMIC_RELAXED, __HIP_MEMORY_SCOPE_AGENT); }
__device__ __forceinline__ unsigned xb_add(unsigned* p, unsigned v) { return __hip_atomic_fetch_add(p, v, __ATOMIC_RELAXED, __HIP_MEMORY_SCOPE_AGENT); }
__device__ __forceinline__ unsigned xb_xcc_id() { return (unsigned)__builtin_amdgcn_s_getreg((3 << 11) | 20) & 0xFu; }
#define XB_SPIN(cond, bar) do { unsigned _sp = 0; while (cond) { __builtin_amdgcn_s_sleep(1); \
    if ((++_sp & 255u) == 0u) { if (xb_ld(&(bar)[XB_TMO])) break; if (_sp > XB_SPIN_CAP) { atomicAdd(&(bar)[XB_TMO], 1u); break; } } } } while (0)
struct XcdBarrier { unsigned* bar; unsigned x; volatile LAS unsigned* st; int wave; };
__device__ __forceinline__ XcdBarrier xcd_barrier_post(unsigned* bar, volatile LAS unsigned* st, int wave) {
    XcdBarrier b; b.bar = bar; b.x = xb_xcc_id(); b.st = st; b.wave = wave;
    if (wave == 0 && fresh_lane() == 0) (void)xb_add(&bar[XB_XCNT(b.x)], 1u);
    return b;
}
__device__ __forceinline__ void xcd_barrier_complete(unsigned* bar, unsigned x, unsigned& nloc, unsigned& nx) {
    const unsigned G = gridDim.x * gridDim.y * gridDim.z;
    unsigned sum, cnt, mine, sp = 0u;
    for (;;) {
        sum = 0u; cnt = 0u; mine = 0u;
#pragma unroll
        for (unsigned j = 0; j < 16; ++j) { const unsigned c = xb_ld(&bar[XB_XCNT(j)]); sum += c; cnt += (c > 0u) ? 1u : 0u; mine = (j == x) ? c : mine; }
        if (sum == G) break;
        __builtin_amdgcn_s_sleep(1);
        if ((++sp & 255u) == 0u) { if (xb_ld(&bar[XB_TMO])) break; if (sp > XB_SPIN_CAP) { atomicAdd(&bar[XB_TMO], 1u); break; } }
    }
    nloc = mine > 0u ? mine : 1u; nx = cnt > 0u ? cnt : 1u;
}
__device__ __forceinline__ void xcd_barrier(const XcdBarrier& b) {
    asm volatile("s_waitcnt vmcnt(0)" ::: "memory");
    __syncthreads();
    if (b.wave == 0 && fresh_lane() == 0) {
        unsigned* bar = b.bar;
        __builtin_amdgcn_s_waitcnt(0);
        unsigned nloc = b.st[0], nx = b.st[1];
        if (nloc == 0u) { xcd_barrier_complete(bar, b.x, nloc, nx); b.st[0] = nloc; b.st[1] = nx; }
        const unsigned old = xb_add(&bar[XB_XSUB(b.x)], 1u);
        const unsigned gen = old / nloc;
        if (old + 1u == (gen + 1u) * nloc) {
            __builtin_amdgcn_fence(__ATOMIC_RELEASE, "agent");
            asm volatile("s_waitcnt vmcnt(0)" ::: "memory");
            const unsigned og = xb_add(&bar[XB_TOP], 1u);
            const unsigned tg = og / nx;
            if (og + 1u == (tg + 1u) * nx) xb_add(&bar[XB_TOPGEN], 1u);
            else XB_SPIN(xb_ld(&bar[XB_TOPGEN]) == tg, bar);
            __builtin_amdgcn_fence(__ATOMIC_ACQUIRE, "agent");
            xb_add(&bar[XB_XGEN(b.x)], 1u);
            asm volatile("s_waitcnt vmcnt(0)" ::: "memory");
        } else {
            XB_SPIN(xb_ld(&bar[XB_XGEN(b.x)]) == gen, bar);
            __builtin_amdgcn_fence(__ATOMIC_ACQUIRE, "agent");
            asm volatile("s_waitcnt vmcnt(0)" ::: "memory");
        }
    }
    __syncthreads();
}

namespace pg8 {
constexpr int BM = 256, BK = 64, HALF = 128, HTB = HALF * BK * 2, STAGE_BYTES = 8 * HTB, NXCD = 8, WGM = 8;
__host__ __device__ __forceinline__ int lds_byte(int r, int c) { const int st = (r >> 4) * 2 + (c >> 5), rr = r & 15, cc = c & 31, ob = rr * 64 + cc * 2; return st * 1024 + (ob ^ (((ob >> 9) & 1) << 5)); }
__host__ __device__ __forceinline__ void stage_rc(int b, int& Rr, int& C) { const int st = b / 1024, sb = b % 1024, swz = sb ^ (((sb >> 9) & 1) << 5); Rr = (st >> 1) * 16 + swz / 64; C = (st & 1) * 32 + (swz % 64) / 2; }
__host__ __device__ __forceinline__ int perm32(int rho) { const int n = rho >> 4, i = rho & 15; return 8 * (i >> 2) + 4 * n + (i & 3); }
struct Unit { int pm, pn; const char* a; const char* b; int e, p0, ce; };

struct StaticOrder {
    static constexpr bool GATHER = false;
    int nM, nN, nwg, G, c; const char* A; const char* Bt; size_t astep, bstep;
    __device__ void init(int M, int N, int G_, int c_, const bf16_t* A_, int lda, const bf16_t* Bt_, int ldb) { nM = M / BM; nN = N / BM; nwg = nM * nN; G = G_; c = c_; A = (const char*)A_; Bt = (const char*)Bt_; astep = (size_t)BM * lda * 2; bstep = (size_t)BM * ldb * 2; }
    __device__ bool next(int i, Unit& u) const {
        const long L = (long)i * G + c; if (L >= nwg) return false;
        int wgid = (int)L; { const int q = nwg / NXCD, r = nwg % NXCD, xcd = wgid % NXCD, off = wgid / NXCD; wgid = (xcd < r ? xcd * (q + 1) : r * (q + 1) + (xcd - r) * q) + off; }
        const int nig = WGM * nN, gid = wgid / nig, fm = gid * WGM, gsz = (nM - fm) < WGM ? (nM - fm) : WGM;
        u.pm = fm + ((wgid % nig) % gsz); u.pn = (wgid % nig) / gsz; u.a = A + (size_t)u.pm * astep; u.b = Bt + (size_t)u.pn * bstep; u.e = 0; u.p0 = 0; u.ce = 0; return true;
    }
};
template <bool GATHER_> struct MoeOrder {
    static constexpr bool GATHER = GATHER_;
    int nN, G, c; const char* A; const char* Bt; size_t astep, bstep, bexp; const int* tab; const int* tokl;
    __device__ bool next(int i, Unit& u) const {
        const int L = i * G + c; const int total = __builtin_amdgcn_readfirstlane(tab[16]) * nN; if (L >= total) return false;
        u.pm = L / nN; u.pn = L % nN; int e = 0;
#pragma unroll
        for (int q = 1; q < 16; ++q) e += (u.pm >= tab[q]) ? 1 : 0;
        e = __builtin_amdgcn_readfirstlane(e);
        u.e = e; u.p0 = __builtin_amdgcn_readfirstlane((u.pm - tab[e]) * BM); u.ce = __builtin_amdgcn_readfirstlane(tab[17 + e]);
        u.a = GATHER_ ? A : A + (size_t)u.pm * astep; u.b = Bt + (size_t)e * bexp + (size_t)u.pn * bstep; return true;
    }
    __device__ __forceinline__ void aoffs(const Unit& u, int wid, int lda, unsigned (&off)[2][2]) const {
        const int tid = wid * 64 + fresh_lane();
#pragma unroll
        for (int i = 0; i < 2; ++i) { int Rr, C; stage_rc(tid * 16 + i * 8192, Rr, C);
#pragma unroll
            for (int h = 0; h < 2; ++h) { const int pos = u.p0 + h * HALF + Rr; const int tok = pos < u.ce ? (tokl[(size_t)u.e * R + pos] >> 1) : 0; off[h][i] = (unsigned)(tok * lda + C) * 2u; } }
    }
};

template <class Epi, class Sched, bool ALIGN_EPI = true>
__device__ __forceinline__ void gemm_phase(LAS unsigned char* lds, const int wid, const int lda, const int ldb, const int K, const Sched& S, const Epi& E) {
    const int lane = fresh_lane(), tid = wid * 64 + lane, wr = wid >> 2, wc = wid & 3, fr = lane & 15, fq = lane >> 4;
    const int nt = K / BK;
    unsigned voffA[2], voffB[2];
#pragma unroll
    for (int i = 0; i < 2; ++i) { int Rr, C; stage_rc(tid * 16 + i * 8192, Rr, C); const int Rb = Epi::PERM ? ((Rr & ~31) + perm32(Rr & 31)) : Rr;
        voffA[i] = (unsigned)(Rr * lda + C) * 2u; voffB[i] = (unsigned)(Rb * ldb + C) * 2u; }
    const size_t kstep = (size_t)(BK * 2);
    const size_t hstepA = Sched::GATHER ? 0 : (size_t)HALF * lda * 2, hstepB = (size_t)HALF * ldb * 2;
    const unsigned ldsw = (unsigned)wid * 1024u;
    const int aoff = lds_byte(wr * 64 + fr, fq * 8), boff = lds_byte(wc * 32 + fr, fq * 8);
#define PG8_SA(b, h) (((b) * 2 + (h)) * HTB)
#define PG8_SB(b, h) ((4 + (b) * 2 + (h)) * HTB)
#define PG8_STAGE(bufoff, gbase, voff) do { _Pragma("unroll") for (int _i = 0; _i < 2; ++_i) \
        __builtin_amdgcn_global_load_lds((const unsigned*)((const char*)(gbase) + (voff)[_i]), (LAS unsigned*)(lds + (bufoff) + ldsw + _i * 8192), 16, 0, 0); } while (0)
#define PG8_STAGE_A(b, h, kp, OFFS) do { if constexpr (Sched::GATHER) { PG8_STAGE(PG8_SA(b, h), kp, OFFS[h]); } else { PG8_STAGE(PG8_SA(b, h), (kp) + (h) * hstepA, voffA); } } while (0)
#define PG8_LDA(dst, b, h) do { _Pragma("unroll") for (int m = 0; m < 4; ++m) _Pragma("unroll") for (int k = 0; k < 2; ++k) dst[m][k] = *(const LAS bf16x8*)(lds + PG8_SA(b, h) + aoff + m * 2048 + k * 1024); } while (0)
#define PG8_LDB(dst, b, h) do { _Pragma("unroll") for (int n = 0; n < 2; ++n) _Pragma("unroll") for (int k = 0; k < 2; ++k) dst[n][k] = *(const LAS bf16x8*)(lds + PG8_SB(b, h) + boff + n * 2048 + k * 1024); } while (0)
#define PG8_MMA(ai, bj, At, Bt) do { __builtin_amdgcn_s_setprio(1); _Pragma("unroll") for (int m = 0; m < 4; ++m) _Pragma("unroll") for (int n = 0; n < 2; ++n) _Pragma("unroll") for (int k = 0; k < 2; ++k) \
        acc[ai][bj][m][n] = __builtin_amdgcn_mfma_f32_16x16x32_bf16(Bt[n][k], At[m][k], acc[ai][bj][m][n], 0, 0, 0); __builtin_amdgcn_s_setprio(0); } while (0)
#define PG8_WAIT_V(n) asm volatile("s_waitcnt vmcnt(" #n ")" ::: "memory")
#define PG8_WAIT_L(n) asm volatile("s_waitcnt lgkmcnt(" #n ")" ::: "memory")
#define PG8_BAR __builtin_amdgcn_s_barrier()
#define PG8_SCHED __builtin_amdgcn_sched_barrier(0)
    Unit cur, nxt; int ui = 0;
    if (!S.next(0, cur)) return;
    f32x4 acc[2][2][4][2];
#pragma unroll
    for (int a = 0; a < 2; ++a)
#pragma unroll
        for (int b = 0; b < 2; ++b)
#pragma unroll
            for (int m = 0; m < 4; ++m)
#pragma unroll
                for (int n = 0; n < 2; ++n) acc[a][b][m][n] = (f32x4){0.f, 0.f, 0.f, 0.f};
    bf16x8 At[4][2], B0[2][2], B1[2][2];
    unsigned goffC[2][2], goffN[2][2];
    if constexpr (Sched::GATHER) { S.aoffs(cur, wid, lda, goffC);
#pragma unroll
        for (int h = 0; h < 2; ++h)
#pragma unroll
            for (int i = 0; i < 2; ++i) goffN[h][i] = goffC[h][i]; }
    const char* cA = cur.a; const char* cB = cur.b;
    PG8_STAGE(PG8_SB(0, 0), cB, voffB); PG8_STAGE(PG8_SB(0, 1), cB + hstepB, voffB); PG8_STAGE_A(0, 0, cA, goffC); PG8_STAGE_A(0, 1, cA, goffC);
    if (wr == 1) PG8_BAR;
    PG8_WAIT_V(2); PG8_BAR;
    PG8_STAGE(PG8_SB(1, 0), cB + kstep, voffB); PG8_STAGE_A(1, 0, cA + kstep, goffC); PG8_STAGE(PG8_SB(1, 1), cB + hstepB + kstep, voffB);
    PG8_WAIT_V(6); PG8_BAR;
    for (;;) {
        const bool has_next = S.next(ui + 1, nxt);
        if constexpr (Sched::GATHER) { if (has_next) S.aoffs(nxt, wid, lda, goffN); }
        const char* nA = has_next ? nxt.a : cA; const char* nB = has_next ? nxt.b : cB;
        for (int t = 0; t < nt; t += 2) {
            const bool last = (t == nt - 2);
            const char* a1 = cA + (size_t)(t + 1) * kstep;
            const char* a2 = last ? nA : cA + (size_t)(t + 2) * kstep; const char* b2 = last ? nB : cB + (size_t)(t + 2) * kstep;
            const char* a3 = a2 + kstep; const char* b3 = b2 + kstep;
            unsigned gx[2][2];
            if constexpr (Sched::GATHER) {
#pragma unroll
                for (int h = 0; h < 2; ++h)
#pragma unroll
                    for (int i = 0; i < 2; ++i) gx[h][i] = (last && has_next) ? goffN[h][i] : goffC[h][i]; }
            PG8_LDB(B0, 0, 0); PG8_LDB(B1, 0, 1); PG8_SCHED; PG8_LDA(At, 0, 0); PG8_STAGE_A(1, 1, a1, goffC);
            PG8_WAIT_V(8); PG8_WAIT_L(0); PG8_BAR; PG8_MMA(0, 0, At, B0); PG8_MMA(0, 1, At, B1); PG8_BAR; PG8_SCHED;
            PG8_LDA(At, 0, 1); PG8_STAGE(PG8_SB(0, 0), b2, voffB); PG8_STAGE(PG8_SB(0, 1), b2 + hstepB, voffB); PG8_STAGE_A(0, 0, a2, gx);
            PG8_WAIT_V(8); PG8_WAIT_L(0); PG8_BAR; PG8_MMA(1, 0, At, B0); PG8_MMA(1, 1, At, B1); PG8_BAR; PG8_SCHED;
            PG8_LDB(B0, 1, 0); PG8_LDB(B1, 1, 1); PG8_SCHED; PG8_LDA(At, 1, 0); PG8_STAGE_A(0, 1, a2, gx);
            PG8_WAIT_V(8); PG8_WAIT_L(0); PG8_BAR; PG8_MMA(0, 0, At, B0); PG8_MMA(0, 1, At, B1); PG8_BAR; PG8_SCHED;
            PG8_LDA(At, 1, 1); PG8_STAGE(PG8_SB(1, 0), b3, voffB); PG8_STAGE(PG8_SB(1, 1), b3 + hstepB, voffB); PG8_STAGE_A(1, 0, a3, gx);
            PG8_WAIT_V(8); PG8_WAIT_L(0); PG8_BAR; PG8_MMA(1, 0, At, B0); PG8_MMA(1, 1, At, B1); PG8_BAR; PG8_SCHED;
            if constexpr (Epi::MID) { if (((t + 2) & (Epi::MID_EVERY - 1)) == 0 && !last) E.mid(acc, cur, wr, wc, (t + 2) / Epi::MID_EVERY - 1); }
        }
        if constexpr (ALIGN_EPI) { if (wr == 0) PG8_BAR; }
        E(acc, cur, wr, wc, fr, fq);
        if (!has_next) break;
#pragma unroll
        for (int a = 0; a < 2; ++a)
#pragma unroll
            for (int b = 0; b < 2; ++b)
#pragma unroll
                for (int m = 0; m < 4; ++m)
#pragma unroll
                    for (int n = 0; n < 2; ++n) acc[a][b][m][n] = (f32x4){0.f, 0.f, 0.f, 0.f};
        cur = nxt; cA = nA; cB = nB; ++ui;
        if constexpr (Sched::GATHER) {
#pragma unroll
            for (int h = 0; h < 2; ++h)
#pragma unroll
                for (int i = 0; i < 2; ++i) goffC[h][i] = goffN[h][i]; }
        if constexpr (ALIGN_EPI) { if (wr == 1) PG8_BAR; }
    }
    PG8_WAIT_V(0);
    if constexpr (!ALIGN_EPI) { if (wr == 0) PG8_BAR; }
    PG8_BAR;
#undef PG8_SA
#undef PG8_SB
#undef PG8_STAGE
#undef PG8_STAGE_A
#undef PG8_LDA
#undef PG8_LDB
#undef PG8_MMA
#undef PG8_WAIT_V
#undef PG8_WAIT_L
#undef PG8_BAR
#undef PG8_SCHED
}
template <class F> struct EpiV4 { static constexpr bool PERM = false, MID = false; static constexpr int MID_EVERY = 1; F f;
    __device__ __forceinline__ void operator()(const f32x4 (&acc)[2][2][4][2], const Unit& u, int wr, int wc, int, int) const {
        const int ln = fresh_lane(), fr = ln & 15, fq = ln >> 4;
        const int row0 = u.pm * BM + wr * 64 + fr, col0 = u.pn * BM + wc * 32 + 4 * fq;
        typename F::UnitPre up = f.unit(u, col0);
#pragma unroll
        for (int ai = 0; ai < 2; ++ai) {
            typename F::Pre pre[4][2][2];
#pragma unroll
            for (int m = 0; m < 4; ++m)
#pragma unroll
                for (int bj = 0; bj < 2; ++bj)
#pragma unroll
                    for (int n = 0; n < 2; ++n) pre[m][bj][n] = f.load(u, row0 + ai * HALF + m * 16, col0 + bj * HALF + n * 16);
#pragma unroll
            for (int m = 0; m < 4; ++m)
#pragma unroll
                for (int bj = 0; bj < 2; ++bj)
#pragma unroll
                    for (int n = 0; n < 2; ++n) f.fin(u, row0 + ai * HALF + m * 16, col0 + bj * HALF + n * 16, acc[ai][bj][m][n], pre[m][bj][n], up, bj * 2 + n);
            asm volatile("" ::: "memory"); }
    } };
template <class F> struct EpiV8 { static constexpr bool PERM = true, MID = false; static constexpr int MID_EVERY = 1; F f;
    __device__ __forceinline__ void operator()(const f32x4 (&acc)[2][2][4][2], const Unit& u, int wr, int wc, int, int) const {
        const int ln = fresh_lane(), fr = ln & 15, fq = ln >> 4;
        const int row0 = u.pm * BM + wr * 64 + fr, col0 = u.pn * BM + wc * 32 + 8 * fq;
#pragma unroll
        for (int ai = 0; ai < 2; ++ai) {
            typename F::Pre pre[4][2];
#pragma unroll
            for (int m = 0; m < 4; ++m)
#pragma unroll
                for (int bj = 0; bj < 2; ++bj) pre[m][bj] = f.load(u, row0 + ai * HALF + m * 16, col0 + bj * HALF);
#pragma unroll
            for (int m = 0; m < 4; ++m)
#pragma unroll
                for (int bj = 0; bj < 2; ++bj) f.fin(u, row0 + ai * HALF + m * 16, col0 + bj * HALF, acc[ai][bj][m][0], acc[ai][bj][m][1], pre[m][bj]);
            asm volatile("" ::: "memory"); }
    } };
template <class F> struct EpiDual { static constexpr bool PERM = true, MID = false; static constexpr int MID_EVERY = 1; F f;
    __device__ __forceinline__ void operator()(const f32x4 (&acc)[2][2][4][2], const Unit& u, int wr, int wc, int, int) const {
        const int ln = fresh_lane(), fr = ln & 15, fq = ln >> 4;
        const int row0 = u.pm * BM + wr * 64 + fr, hc0 = u.pn * HALF + wc * 32 + 8 * fq;
#pragma unroll
        for (int ai = 0; ai < 2; ++ai)
#pragma unroll
            for (int m = 0; m < 4; ++m) f.apply8(row0 + ai * HALF + m * 16, hc0, acc[ai][0][m][0], acc[ai][0][m][1], acc[ai][1][m][0], acc[ai][1][m][1]);
    } };
struct EpiMergeS { static constexpr bool PERM = true, MID = true; static constexpr int MID_EVERY = 8;
    const unsigned char* G8; bf16_t* MG;
    __device__ __forceinline__ void mid(f32x4 (&acc)[2][2][4][2], const Unit& u, int wr, int wc, int i) const {
        const int ln = fresh_lane(), fr = ln & 15, fq = ln >> 4;
        const int row0 = u.pm * BM + wr * 64 + fr, col0 = u.pn * BM + wc * 32 + 8 * fq;
#pragma unroll
        for (int ai = 0; ai < 2; ++ai) {
            u32x2 gi[4][2], gn[4][2];
#pragma unroll
            for (int m = 0; m < 4; ++m)
#pragma unroll
                for (int bj = 0; bj < 2; ++bj) { const unsigned char* gp = G8 + (size_t)(row0 + ai * HALF + m * 16) * 4096 + i * 1024 + col0 + bj * HALF;
                    gi[m][bj] = *(const u32x2*)gp; gn[m][bj] = *(const u32x2*)(gp + 1024); }
#pragma unroll
            for (int m = 0; m < 4; ++m)
#pragma unroll
                for (int bj = 0; bj < 2; ++bj) {
#pragma unroll
                    for (int j = 0; j < 4; ++j) {
                        acc[ai][bj][m][0][j] *= (float)((gi[m][bj].x >> (8 * j)) & 255u) * __builtin_amdgcn_rcpf((float)((gn[m][bj].x >> (8 * j)) & 255u));
                        acc[ai][bj][m][1][j] *= (float)((gi[m][bj].y >> (8 * j)) & 255u) * __builtin_amdgcn_rcpf((float)((gn[m][bj].y >> (8 * j)) & 255u)); } }
        }
    }
    __device__ __forceinline__ void operator()(const f32x4 (&acc)[2][2][4][2], const Unit& u, int wr, int wc, int, int) const {
        const int ln = fresh_lane(), fr = ln & 15, fq = ln >> 4;
        const int row0 = u.pm * BM + wr * 64 + fr, col0 = u.pn * BM + wc * 32 + 8 * fq;
#pragma unroll
        for (int ai = 0; ai < 2; ++ai) {
            u32x2 g3[4][2];
#pragma unroll
            for (int m = 0; m < 4; ++m)
#pragma unroll
                for (int bj = 0; bj < 2; ++bj) g3[m][bj] = *(const u32x2*)(G8 + (size_t)(row0 + ai * HALF + m * 16) * 4096 + 3 * 1024 + col0 + bj * HALF);
#pragma unroll
            for (int m = 0; m < 4; ++m)
#pragma unroll
                for (int bj = 0; bj < 2; ++bj) { f32x4 a = acc[ai][bj][m][0], b = acc[ai][bj][m][1];
#pragma unroll
                    for (int j = 0; j < 4; ++j) { a[j] *= (float)((g3[m][bj].x >> (8 * j)) & 255u) * (1.0f / 255.0f); b[j] *= (float)((g3[m][bj].y >> (8 * j)) & 255u) * (1.0f / 255.0f); }
                    u32x4 w; w.x = cvtpk(a.x, a.y); w.y = cvtpk(a.z, a.w); w.z = cvtpk(b.x, b.y); w.w = cvtpk(b.z, b.w);
                    *(u32x4*)(MG + (size_t)(row0 + ai * HALF + m * 16) * D + col0 + bj * HALF) = w; }
        }
    }
};
}

__device__ __forceinline__ u32x4 pack8(f32x4 a, f32x4 b) { u32x4 w; w.x = cvtpk(a.x, a.y); w.y = cvtpk(a.z, a.w); w.z = cvtpk(b.x, b.y); w.w = cvtpk(b.z, b.w); return w; }
__device__ __forceinline__ float sigm1(float x) { return __builtin_amdgcn_rcpf(1.0f + __builtin_amdgcn_exp2f(-1.4426950408889634f * x)); }
__device__ __forceinline__ f32x4 sigm4(f32x4 v) { f32x4 r; r.x = sigm1(v.x); r.y = sigm1(v.y); r.z = sigm1(v.z); r.w = sigm1(v.w); return r; }
struct NoPre {};
struct FStore8 { bf16_t* C; int ldc; typedef NoPre Pre;
    __device__ __forceinline__ Pre load(const pg8::Unit&, int, int) const { return Pre{}; }
    __device__ __forceinline__ void fin(const pg8::Unit&, int row, int col, f32x4 a, f32x4 b, const Pre&) const { *(u32x4*)(C + (size_t)row * ldc + col) = pack8(a, b); } };
struct FGateU8 { unsigned char* G8; const float* bias; typedef NoPre Pre;
    __device__ __forceinline__ Pre load(const pg8::Unit&, int, int) const { return Pre{}; }
    __device__ __forceinline__ void fin(const pg8::Unit&, int row, int col, f32x4 a, f32x4 b, const Pre&) const { const f32x4 b0 = *(const f32x4*)(bias + col), b1 = *(const f32x4*)(bias + col + 4);
        const f32x4 ga = sigm4(a + b0) * 255.0f + 0.5f, gb = sigm4(b + b1) * 255.0f + 0.5f;
        unsigned q[8] = {(unsigned)ga.x, (unsigned)ga.y, (unsigned)ga.z, (unsigned)ga.w, (unsigned)gb.x, (unsigned)gb.y, (unsigned)gb.z, (unsigned)gb.w};
#pragma unroll
        for (int k = 0; k < 8; ++k) q[k] = q[k] < 1u ? 1u : (q[k] > 255u ? 255u : q[k]);
        u32x2 w; w.x = q[0] | (q[1] << 8) | (q[2] << 16) | (q[3] << 24); w.y = q[4] | (q[5] << 8) | (q[6] << 16) | (q[7] << 24);
        *(u32x2*)(G8 + (size_t)row * 4096 + col) = w; } };
struct FMoe1 { bf16_t* HID;
    __device__ __forceinline__ void apply8(int row, int hc, f32x4 a0, f32x4 a1, f32x4 b0, f32x4 b1) const {
        *(u32x4*)(HID + (size_t)row * FF + hc) = pack8(a0 * sigm4(a0) * b0, a1 * sigm4(a1) * b1); } };
struct FMoe2 { bf16_t* MO; const int* tokl; const float* wl; struct Pre { int t; float w; };
    __device__ __forceinline__ Pre load(const pg8::Unit& u, int row, int) const { Pre r; const int pos = u.p0 + (row - u.pm * 256); r.t = -1; r.w = 0.f;
        if (pos < u.ce) { r.t = tokl[(size_t)u.e * R + pos]; r.w = wl[(size_t)u.e * R + pos]; } return r; }
    __device__ __forceinline__ void fin(const pg8::Unit&, int, int col, f32x4 a, f32x4 b, const Pre& q) const { if (q.t < 0) return;
        *(u32x4*)(MO + ((size_t)(q.t & 1) * R + (q.t >> 1)) * D + col) = pack8(a * q.w, b * q.w); } };
struct FOut { Ptrs P; int l; typedef f32x4 Pre; struct UnitPre { f32x4 g[4]; };
    __device__ __forceinline__ UnitPre unit(const pg8::Unit& u, int col0) const { UnitPre r; const float* g = mod_vec(P, l, row_bb(u.pm * 256), 2) + col0;
#pragma unroll
        for (int q = 0; q < 4; ++q) r.g[q] = *(const f32x4*)(g + (q >> 1) * 128 + (q & 1) * 16);
        return r; }
    __device__ __forceinline__ Pre load(const pg8::Unit&, int row, int col) const { return l == 0 ? *(const f32x4*)(xin_row(P, row) + col) : *(const f32x4*)(x1_row(P, row) + col); }
    __device__ __forceinline__ void fin(const pg8::Unit&, int row, int col, f32x4 v, const Pre& xp, const UnitPre& up, int q) const { *(f32x4*)(x1_row(P, row) + col) = xp + up.g[q] * v; } };

struct Frame { LAS unsigned char* lds; int wave, vcu, G; };
#define fresh_tid() (F.wave * 64 + fresh_lane())
__device__ __forceinline__ void tr_item(const float* W, int ldw, int k0, int csrc0, bf16_t* WT, int ldt, int drow0, LAS float* scr, int lane) {
    f32x4 v[8];
#pragma unroll
    for (int i = 0; i < 8; ++i) v[i] = *(const f32x4*)(W + (size_t)(k0 + (lane >> 3) + 8 * i) * ldw + csrc0 + (lane & 7) * 4);
#pragma unroll
    for (int i = 0; i < 8; ++i) { LAS float* d = scr + ((lane >> 3) + 8 * i) * 33 + (lane & 7) * 4; d[0] = v[i].x; d[1] = v[i].y; d[2] = v[i].z; d[3] = v[i].w; }
    LDS_WAIT(); asm volatile("" ::: "memory");
    const int c = lane & 7;
#pragma unroll
    for (int j = 0; j < 4; ++j) { const int n = (lane >> 3) + 8 * j; const LAS float* s = scr + (8 * c) * 33 + n;
        u32x4 o; o.x = cvtpk(s[0 * 33], s[1 * 33]); o.y = cvtpk(s[2 * 33], s[3 * 33]); o.z = cvtpk(s[4 * 33], s[5 * 33]); o.w = cvtpk(s[6 * 33], s[7 * 33]);
        *(u32x4*)(WT + (size_t)(drow0 + n) * ldt + k0 + 8 * c) = o; }
    LDS_WAIT(); asm volatile("" ::: "memory");
}
__device__ __forceinline__ void ph_weights(const Frame& F, const Ptrs& P, int l) {
    const int tid0 = fresh_tid(), lane0 = tid0 & 63;
    LAS float* scr = (LAS float*)(F.lds + F.wave * 16384);
    const int gw = F.vcu * NWAVES + F.wave, NGW = F.G * NWAVES;
    unsigned char* wb = P.ws + WS_WB;
    constexpr int I0 = 1024, I1 = I0 + 2048, I2 = I1 + 768, I3 = I2 + 512, I4 = I3 + 4096, I5 = I4 + 4096, I6 = I5 + 4096;
    for (int it = gw; it < I6; it += NGW) {
        if (it < I0) { const int kb = it >> 6, nb = it & 63; tr_item(P.w_in + (size_t)l * 1024 * 2560, 2560, kb * 64, 512 + nb * 32, (bf16_t*)(wb + WB_IN), 1024, 1024 + nb * 32, scr, lane0); }
        else if (it < I1) { const int r = it - I0, i = r >> 9, q = r & 511, kb = q >> 5, nb = q & 31; tr_item(P.w_gate + ((size_t)l * 4 + i) * 1024 * 1024, 1024, kb * 64, nb * 32, (bf16_t*)(wb + WB_GATE) + (size_t)i * 1024 * 1024, 1024, nb * 32, scr, lane0); }
        else if (it < I2) { const int r = it - I1, i = r >> 8, q = r & 255, kb = q >> 5, nb = q & 31; tr_item(P.w_branch + ((size_t)l * 4 + i) * 512 * 1024, 1024, kb * 64, nb * 32, (bf16_t*)(wb + WB_BR) + i * 512, 2048, nb * 32, scr, lane0); }
        else if (it < I3) { const int q = it - I2, kb = q >> 5, nb = q & 31; tr_item(P.w_out + (size_t)l * 1024 * 1024, 1024, kb * 64, nb * 32, (bf16_t*)(wb + WB_OUT), 1024, nb * 32, scr, lane0); }
        else if (it < I5) { const int w3 = it >= I4; const int r = it - (w3 ? I4 : I3), e = r >> 8, q = r & 255, kb = q >> 4, nb = q & 15, c = nb * 32;
            tr_item((w3 ? P.w3 : P.w1) + ((size_t)l * 16 + e) * 1024 * 512, 512, kb * 64, c, (bf16_t*)(wb + WB_13) + (size_t)e * 1024 * 1024, 1024, 256 * (c >> 7) + (c & 127) + (w3 ? 128 : 0), scr, lane0); }
        else { const int r = it - I5, e = r >> 8, q = r & 255, kb = q >> 5, nb = q & 31; tr_item(P.w2 + ((size_t)l * 16 + e) * 512 * 1024, 1024, kb * 64, nb * 32, (bf16_t*)(wb + WB_2) + (size_t)e * 1024 * 512, 512, nb * 32, scr, lane0); }
    }
    __syncthreads();
    for (int u = F.vcu; u < 64; u += F.G) {
        LAS float* Wl = (LAS float*)F.lds; LAS float* ct = Wl + 64 * 128;
        const int kt = u >> 2, g = u & 3, k0 = kt * 64, tid = tid0; const float* w_in = P.w_in + (size_t)l * 1024 * 2560;
        if (tid < 128) ct[tid] = __builtin_amdgcn_cosf((float)tid * (1.0f / 128.0f));
        for (int i = tid; i < 64 * 128; i += 512) { const int k = i >> 7, c = i & 127; Wl[k * 128 + c] = w_in[(size_t)(k0 + k) * 2560 + g * 128 + c]; }
        __syncthreads();
        const int part = (tid >> 7) & 1, m = tid & 127, kh = tid >> 8; const float sc = 0.08838834764831845f;
        bf16_t* drow = (bf16_t*)(wb + WB_IN) + (size_t)(part * 512 + g * 128 + m) * 1024 + k0;
        for (int kb = kh * 32; kb < kh * 32 + 32; kb += 8) { float acc[8];
#pragma unroll
            for (int j = 0; j < 8; ++j) acc[j] = 0.f;
            for (int c = 0; c < 128; ++c) { const int idx = (c * m) & 127; const float tw = part ? -ct[(idx - 32) & 127] : ct[idx];
#pragma unroll
                for (int j = 0; j < 8; ++j) acc[j] += Wl[(kb + j) * 128 + c] * tw; }
            u32x4 o; o.x = pk2(acc[0] * sc, acc[1] * sc); o.y = pk2(acc[2] * sc, acc[3] * sc); o.z = pk2(acc[4] * sc, acc[5] * sc); o.w = pk2(acc[6] * sc, acc[7] * sc);
            *(u32x4*)(drow + kb) = o; }
        __syncthreads();
    }
    for (int u = F.G - 1 - F.vcu; u < 64; u += F.G) {
        LAS float* Wb = (LAS float*)F.lds;
        const int g = u >> 4, n0 = (u & 15) * 64, tid = tid0;
        const float* ps = P.pool_scale + (size_t)l * 512; const float* wb3 = P.w_branch + ((size_t)l * 4 + 3) * 512 * 1024; const float* pwl = P.pool_w + (size_t)l * 4 * 128 * 128;
        for (int i = tid; i < 128 * 64; i += 512) { const int e = i >> 6, n = i & 63; Wb[e * 64 + n] = ps[g * 128 + e] * wb3[(size_t)(g * 128 + e) * 1024 + n0 + n]; }
        __syncthreads();
        const int c = tid & 127, nh = tid >> 7; const float* pw = pwl + (size_t)(g * 128 + c) * 128;
        float acc[16];
#pragma unroll
        for (int j = 0; j < 16; ++j) acc[j] = 0.f;
        for (int e = 0; e < 128; ++e) { const float p = pw[e];
#pragma unroll
            for (int j = 0; j < 16; ++j) acc[j] += p * Wb[e * 64 + nh * 16 + j]; }
        bf16_t* Bt = (bf16_t*)(wb + WB_BR) + 3 * 512;
#pragma unroll
        for (int j = 0; j < 16; ++j) Bt[(size_t)(n0 + nh * 16 + j) * 2048 + g * 128 + c] = (bf16_t)f2bf(acc[j]);
        __syncthreads();
    }
}
__device__ __forceinline__ void ph_tables_mod(const Frame& F, const Ptrs& P) {
    const int tid0 = fresh_tid();
    { float* rc = (float*)(P.ws + WS_ROPE); float* rs = rc + 1024; float* ct = (float*)(P.ws + WS_COS);
      const int i = F.vcu * 512 + tid0;
      if (i < 1024) { const int pos = i >> 4, f = i & 15; const float inv = exp2f(-(float)f * (13.287712379549449f / 16.0f));
          float rev = (float)pos * inv * 0.15915494309189535f; rev = rev - floorf(rev);
          rc[i] = __builtin_amdgcn_cosf(rev); rs[i] = __builtin_amdgcn_sinf(rev); }
      if (i < 4096) ct[i] = __builtin_amdgcn_cosf((float)i * (1.0f / 4096.0f));
      if (i < 16384) { const int mm = i >> 7, k = i & 127, pp = mm >> 6, k1 = mm & 63, pk = k >> 6, t1 = k & 63; const float rev = (float)((k1 * t1) & 63) * (1.0f / 64.0f);
          const float c = __builtin_amdgcn_cosf(rev), sn = __builtin_amdgcn_sinf(rev);
          ((bf16_t*)(P.ws + WS_DFTM))[i] = (bf16_t)f2bf(pp == pk ? c : (pp == 0 ? sn : -sn)); } }
    for (int u = F.vcu; u < 192; u += F.G) {
        LAS float* s = (LAS float*)F.lds; LAS float* red = s + 9 * 1024;
        const int l = u / 96, j0 = (u % 96) * 64, tid = tid0;
        for (int i = tid; i < 9 * 1024; i += 512) { const int bb = i >> 10, k = i & 1023; const float v = bb < 8 ? P.c[bb * 1024 + k] : P.c_ctx[k]; s[i] = v / (1.f + expf(-v)); }
        __syncthreads();
        const int kc = tid >> 6, jj = tid & 63; float acc[9];
#pragma unroll
        for (int b = 0; b < 9; ++b) acc[b] = 0.f;
        const float* w = P.w_ada + (size_t)l * 1024 * 6144 + j0 + jj;
        for (int k = kc * 128; k < kc * 128 + 128; k += 8) { float wv[8];
#pragma unroll
            for (int q = 0; q < 8; ++q) wv[q] = w[(size_t)(k + q) * 6144];
#pragma unroll
            for (int q = 0; q < 8; ++q)
#pragma unroll
                for (int b = 0; b < 9; ++b) acc[b] += s[b * 1024 + k + q] * wv[q]; }
#pragma unroll
        for (int b = 0; b < 9; ++b) red[(kc * 9 + b) * 64 + jj] = acc[b];
        __syncthreads();
        float* mod = (float*)(P.ws + WS_MOD);
        for (int i = tid; i < 9 * 64; i += 512) { const int b = i >> 6, j = i & 63; float v = P.b_ada[l * 6144 + j0 + j];
#pragma unroll
            for (int q = 0; q < 8; ++q) v += red[(q * 9 + b) * 64 + j];
            mod[(size_t)(l * 9 + b) * 6144 + j0 + j] = v; }
        __syncthreads();
    }
}
__device__ __forceinline__ void route_row(const Ptrs& P, int r, const f32x4 (&h)[4], int lane, bool publish, LAS unsigned* lcnt, LAS int* rec, const LAS float* rwl) {
    float lg[16];
#pragma unroll
    for (int e = 0; e < 16; ++e) lg[e] = 0.f;
#pragma unroll
    for (int j = 0; j < 4; ++j) {
#pragma unroll
        for (int i = 0; i < 4; ++i) { const int kk = 4 * lane + 256 * j + i; const LAS f32x4* rw = (const LAS f32x4*)(rwl + kk * 16 + (kk >> 2) * 4); const float hv = h[j][i];
#pragma unroll
            for (int qd = 0; qd < 4; ++qd) { const f32x4 w = rw[qd]; lg[4 * qd] += hv * w.x; lg[4 * qd + 1] += hv * w.y; lg[4 * qd + 2] += hv * w.z; lg[4 * qd + 3] += hv * w.w; } }
        __builtin_amdgcn_sched_barrier(0); }
    float v8[8], v4[4], v2[2], v1;
    { const bool bit = (lane & 32) != 0;
#pragma unroll
      for (int i = 0; i < 8; ++i) { const float a = lg[i], b = lg[i + 8]; v8[i] = (bit ? b : a) + shfl_xor_l(bit ? a : b, 32, lane); } }
    { const bool bit = (lane & 16) != 0;
#pragma unroll
      for (int i = 0; i < 4; ++i) { const float a = v8[i], b = v8[i + 4]; v4[i] = (bit ? b : a) + shfl_xor_l(bit ? a : b, 16, lane); } }
    { const bool bit = (lane & 8) != 0;
#pragma unroll
      for (int i = 0; i < 2; ++i) { const float a = v4[i], b = v4[i + 2]; v2[i] = (bit ? b : a) + shfl_xor_l(bit ? a : b, 8, lane); } }
    { const bool bit = (lane & 4) != 0; const float a = v2[0], b = v2[1]; v1 = (bit ? b : a) + shfl_xor_l(bit ? a : b, 4, lane); }
    v1 += shfl_xor_l(v1, 2, lane); v1 += shfl_xor_l(v1, 1, lane);
    float bestscore = -INFINITY; int be0 = 0, be1 = 1; float ba0 = 0.f, ba1 = 0.f;
#pragma unroll
    for (int g = 0; g < 4; ++g) {
        float aff[4], sel[4];
#pragma unroll
        for (int i = 0; i < 4; ++i) { const float t = __int_as_float(__builtin_amdgcn_ds_bpermute((4 * g + i) << 4, __float_as_int(v1))); aff[i] = 1.0f / (1.0f + expf(-t)); sel[i] = aff[i] + P.router_bias[4 * g + i]; }
        int i1 = 0; float m1 = sel[0], a1 = aff[0];
#pragma unroll
        for (int i = 1; i < 4; ++i) if (sel[i] > m1) { m1 = sel[i]; a1 = aff[i]; i1 = i; }
        int i2 = -1; float m2 = -INFINITY, a2 = 0.f;
#pragma unroll
        for (int i = 0; i < 4; ++i) if (i != i1 && sel[i] > m2) { m2 = sel[i]; a2 = aff[i]; i2 = i; }
        const float score = m1 + m2;
        if (score > bestscore) { bestscore = score; be0 = 4 * g + i1; be1 = 4 * g + i2; ba0 = a1; ba1 = a2; }
    }
    if (lane == 0 && publish) {
        const int p0 = (int)__hip_atomic_fetch_add(lcnt + be0, 1u, __ATOMIC_RELAXED, __HIP_MEMORY_SCOPE_WORKGROUP), p1 = (int)__hip_atomic_fetch_add(lcnt + be1, 1u, __ATOMIC_RELAXED, __HIP_MEMORY_SCOPE_WORKGROUP);
        const float inv = 1.0f / (ba0 + ba1);
        rec[0] = r; rec[1] = be0; rec[2] = p0; rec[3] = be1; rec[4] = p1; rec[5] = __float_as_int(ba0 * inv); rec[6] = __float_as_int(ba1 * inv);
    }
}
template <int MODE> __device__ __forceinline__ void ph_norm(const Frame& F, const Ptrs& P, int l, int nrows) {
    constexpr int NRW = MODE == 2 ? 2 : 4;
    const int lane = fresh_lane();
    const int stride = F.G * NWAVES;
    LAS unsigned* lcnt = (LAS unsigned*)F.lds; LAS unsigned* gbase = lcnt + 16; LAS int* recs = (LAS int*)(F.lds + 256);
    const LAS float* rwl = (const LAS float*)(F.lds + 8192);
    if (MODE == 2) { if (F.wave == 0 && lane < 16) lcnt[lane] = 0u;
        { const int tid = F.wave * 64 + lane; LAS f32x4* d = (LAS f32x4*)(F.lds + 8192);
#pragma unroll
          for (int i = 0; i < 8; ++i) { const int idx = tid + 512 * i, kk = idx >> 2; d[idx + (kk >> 2)] = ((const f32x4*)P.router_w)[idx]; } }
        __syncthreads(); }
    int it = 0;
    for (int rb = F.vcu * NWAVES + F.wave; rb < nrows; rb += NRW * stride, ++it) {
        int rr[NRW];
#pragma unroll
        for (int q = 0; q < NRW; ++q) rr[q] = rb + q * stride < nrows ? rb + q * stride : rb;
        f32x4 v[NRW][4];
#pragma unroll
        for (int q = 0; q < NRW; ++q) { const int r = rr[q];
            if (MODE == 0) { const f32x4* xr = (const f32x4*)xin_row(P, r) + lane;
#pragma unroll
                for (int j = 0; j < 4; ++j) v[q][j] = xr[64 * j]; }
            else { const f32x4* xr = (const f32x4*)x1_row(P, r) + lane;
#pragma unroll
                for (int j = 0; j < 4; ++j) v[q][j] = xr[64 * j]; } }
        if (MODE == 1) {
#pragma unroll
            for (int q = 0; q < NRW; ++q) { const int r = rr[q]; const int bb = row_bb(r); const f32x4* g2 = (const f32x4*)mod_vec(P, l - 1, bb, 5) + lane;
                const u32x2* m0 = (const u32x2*)((const bf16_t*)(P.ws + WS_MO) + (size_t)r * D) + lane; const u32x2* m1 = (const u32x2*)((const bf16_t*)(P.ws + WS_MO) + (size_t)(R + r) * D) + lane;
#pragma unroll
                for (int j = 0; j < 4; ++j) { const u32x2 a = m0[64 * j], b = m1[64 * j]; const f32x4 g = g2[64 * j];
                    v[q][j].x += g.x * (lo16(a.x) + lo16(b.x)); v[q][j].y += g.y * (hi16(a.x) + hi16(b.x)); v[q][j].z += g.z * (lo16(a.y) + lo16(b.y)); v[q][j].w += g.w * (hi16(a.y) + hi16(b.y)); } }
#pragma unroll
            for (int q = 0; q < NRW; ++q) if (q == 0 || rr[q] != rr[0]) { f32x4* xr = (f32x4*)x1_row(P, rr[q]) + lane;
#pragma unroll
                for (int j = 0; j < 4; ++j) xr[64 * j] = v[q][j]; }
        }
        float ss[NRW];
#pragma unroll
        for (int q = 0; q < NRW; ++q) { ss[q] = 0.f;
#pragma unroll
            for (int j = 0; j < 4; ++j) ss[q] += (v[q][j].x * v[q][j].x + v[q][j].y * v[q][j].y) + (v[q][j].z * v[q][j].z + v[q][j].w * v[q][j].w); }
#pragma unroll
        for (int o = 1; o < 64; o <<= 1) {
#pragma unroll
            for (int q = 0; q < NRW; ++q) ss[q] += shfl_xor_l(ss[q], o, lane); }
        const f32x4* gn = (const f32x4*)((MODE == 2 ? P.norm2 : P.norm1) + (size_t)l * D) + lane;
#pragma unroll
        for (int q = 0; q < NRW; ++q) { const int r = rr[q]; const int bb = row_bb(r);
            if (q > 0 && r == rr[0]) continue;
            const float rstd = 1.0f / sqrtf(ss[q] * (1.0f / D) + EPS);
            const f32x4* sh = (const f32x4*)mod_vec(P, l, bb, MODE == 2 ? 3 : 0) + lane;
            const f32x4* sc = (const f32x4*)mod_vec(P, l, bb, MODE == 2 ? 4 : 1) + lane;
            u32x2* o = (u32x2*)((bf16_t*)(P.ws + WS_H) + (size_t)r * D) + lane;
#pragma unroll
            for (int j = 0; j < 4; ++j) { const f32x4 g = gn[64 * j], a = sh[64 * j], b = sc[64 * j];
                v[q][j] = (v[q][j] * rstd * g) * (b + 1.0f) + a;
                u32x2 w; w.x = cvtpk(v[q][j].x, v[q][j].y); w.y = cvtpk(v[q][j].z, v[q][j].w); o[64 * j] = w; } }
        if (MODE == 2) { LAS int* rec = recs + (F.wave * 24 + 2 * it) * 8;
            route_row(P, rr[0], v[0], lane, true, lcnt, rec, rwl); __builtin_amdgcn_sched_barrier(0);
            if (lane == 0 && rr[1] == rr[0]) rec[8] = -1;
            route_row(P, rr[1], v[1], lane, rr[1] != rr[0], lcnt, rec + 8, rwl); }
    }
    if (MODE == 2) {
        __syncthreads();
        const int tid = F.wave * 64 + lane;
        if (tid < 16) { const unsigned c = lcnt[tid]; gbase[tid] = c ? atomicAdd((unsigned*)(P.ws + WS_CTL) + CW_CNT + 1024 * l + 64 * tid, c) : 0u; }
        __syncthreads();
        if (lane == 0) for (int k = 0; k < 2 * it; ++k) { const LAS int* rec = recs + (F.wave * 24 + k) * 8; const int r = rec[0]; if (r < 0) continue;
            int* tokl = (int*)(P.ws + WS_TOKL); float* wl = (float*)(P.ws + WS_WL);
            const size_t i0 = (size_t)rec[1] * R + rec[2] + gbase[rec[1]], i1 = (size_t)rec[3] * R + rec[4] + gbase[rec[3]];
            tokl[i0] = 2 * r; wl[i0] = __int_as_float(rec[5]); tokl[i1] = 2 * r + 1; wl[i1] = __int_as_float(rec[6]); }
        __syncthreads();
    }
}
__device__ __forceinline__ void ph_kprep(const Frame& F, const Ptrs& P, int l) {
    const int lane = fresh_lane();
    const float* rc = (const float*)(P.ws + WS_ROPE); const float* rs = rc + 1024;
    const int hs = (lane >> 3) & 3, chunk = lane & 7, col = (hs < 2 ? C_KB + hs * 64 : C_KW + (hs - 2) * 64) + chunk * 8;
    const f32x4 g0 = *(const f32x4*)(P.k_gain + l * 64 + chunk * 8), g1 = *(const f32x4*)(P.k_gain + l * 64 + chunk * 8 + 4);
    const int a = chunk >> 2, fi = (chunk & 1) * 8; const bool second = (chunk & 2) != 0;
    const int npair = R / 2, stride = F.G * NWAVES;
    for (int pr0 = F.vcu * NWAVES + F.wave; pr0 < npair; pr0 += 4 * stride) {
        u32x4 w[4];
#pragma unroll
        for (int q = 0; q < 4; ++q) { const int pr = pr0 + q * stride; const int r = 2 * (pr < npair ? pr : pr0) + (lane >> 5); w[q] = *(const u32x4*)((const bf16_t*)(P.ws + WS_U) + (size_t)r * NIN + col); }
#pragma unroll
        for (int q = 0; q < 4; ++q) { const int pr = pr0 + q * stride; if (pr >= npair) break;
            const int r = 2 * pr + (lane >> 5);
            float x[8] = {lo16(w[q].x), hi16(w[q].x), lo16(w[q].y), hi16(w[q].y), lo16(w[q].z), hi16(w[q].z), lo16(w[q].w), hi16(w[q].w)};
            if (hs < 2) { float ss = 0.f;
#pragma unroll
                for (int j = 0; j < 8; ++j) ss += x[j] * x[j];
                ss += shfl_xor_l(ss, 1, lane); ss += shfl_xor_l(ss, 2, lane); ss += shfl_xor_l(ss, 4, lane);
                const float rstd = 1.0f / sqrtf(ss * (1.0f / 64.0f) + EPS);
                x[0] *= rstd * g0.x; x[1] *= rstd * g0.y; x[2] *= rstd * g0.z; x[3] *= rstd * g0.w; x[4] *= rstd * g1.x; x[5] *= rstd * g1.y; x[6] *= rstd * g1.z; x[7] *= rstd * g1.w; }
            if (r < RL) { const int t = r & (T - 1), pos = a ? (t & 63) : (t >> 6);
                const f32x4 c0 = *(const f32x4*)(rc + pos * 16 + fi), c1 = *(const f32x4*)(rc + pos * 16 + fi + 4), s0 = *(const f32x4*)(rs + pos * 16 + fi), s1 = *(const f32x4*)(rs + pos * 16 + fi + 4);
                const float cs[8] = {c0.x, c0.y, c0.z, c0.w, c1.x, c1.y, c1.z, c1.w}, sn[8] = {s0.x, s0.y, s0.z, s0.w, s1.x, s1.y, s1.z, s1.w};
#pragma unroll
                for (int j = 0; j < 8; ++j) { const float y = shfl_xor_l(x[j], 2, lane); x[j] = second ? x[j] * cs[j] + y * sn[j] : x[j] * cs[j] - y * sn[j]; } }
            u32x4 o; o.x = cvtpk(x[0], x[1]); o.y = cvtpk(x[2], x[3]); o.z = cvtpk(x[4], x[5]); o.w = cvtpk(x[6], x[7]);
            *(u32x4*)((bf16_t*)(P.ws + WS_U) + (size_t)r * NIN + col) = o; }
    }
}
__device__ __forceinline__ void ph_pool(const Frame& F, const Ptrs& P, int nrows) {
    const int tid0 = fresh_tid();
    for (int i = F.vcu * 512 + tid0; i < nrows * 64; i += F.G * 512) {
        const int r = i >> 6, c8 = (i & 63) * 8;
        const bool lat = r < RL; const int Ts = lat ? T : TC; const int t = lat ? (r & (T - 1)) : ((r - RL) & (TC - 1)); const int r0 = r - t;
        const int g = c8 >> 7, hw = 1 << g;
        const int lo = t - hw < 0 ? 0 : t - hw, hi = t + hw > Ts ? Ts : t + hw;
        const bf16_t* U = (const bf16_t*)(P.ws + WS_U) + C_P + c8;
        u32x4 wv[16];
#pragma unroll
        for (int k = 0; k < 16; ++k) { const int tt = t - 8 + k; const bool ok = tt >= lo && tt < hi; wv[k] = *(const u32x4*)(U + (size_t)(r0 + (ok ? tt : t)) * NIN); }
        float s[8];
#pragma unroll
        for (int j = 0; j < 8; ++j) s[j] = 0.f;
#pragma unroll
        for (int k = 0; k < 16; ++k) { const int tt = t - 8 + k; const float f = (tt >= lo && tt < hi) ? 1.f : 0.f; const u32x4 w = wv[k];
            s[0] += f * lo16(w.x); s[1] += f * hi16(w.x); s[2] += f * lo16(w.y); s[3] += f * hi16(w.y); s[4] += f * lo16(w.z); s[5] += f * hi16(w.z); s[6] += f * lo16(w.w); s[7] += f * hi16(w.w); }
        const u32x4 w = wv[8]; const float inv = 1.0f / (float)(hi - lo);
        u32x4 o; o.x = cvtpk(s[0] * inv - lo16(w.x), s[1] * inv - hi16(w.x)); o.y = cvtpk(s[2] * inv - lo16(w.y), s[3] * inv - hi16(w.y));
        o.z = cvtpk(s[4] * inv - lo16(w.z), s[5] * inv - hi16(w.z)); o.w = cvtpk(s[6] * inv - lo16(w.w), s[7] * inv - hi16(w.w));
        *(u32x4*)((bf16_t*)(P.ws + WS_BR) + (size_t)r * NBR + 1536 + c8) = o;
    }
}
__device__ __forceinline__ void ph_final(const Frame& F, const Ptrs& P) {
    const int lane = fresh_lane(); const int stride = F.G * NWAVES;
    for (int rb = F.vcu * NWAVES + F.wave; rb < RL; rb += 4 * stride) {
        f32x4 v[4][4]; float ss[4];
#pragma unroll
        for (int q = 0; q < 4; ++q) { const int r = rb + q * stride < RL ? rb + q * stride : rb; const int bb = row_bb(r);
            const f32x4* xr = (const f32x4*)(P.out + (size_t)r * D) + lane; const f32x4* g2 = (const f32x4*)mod_vec(P, 1, bb, 5) + lane;
            const u32x2* m0 = (const u32x2*)((const bf16_t*)(P.ws + WS_MO) + (size_t)r * D) + lane; const u32x2* m1 = (const u32x2*)((const bf16_t*)(P.ws + WS_MO) + (size_t)(R + r) * D) + lane;
            ss[q] = 0.f;
#pragma unroll
            for (int j = 0; j < 4; ++j) { v[q][j] = xr[64 * j]; const u32x2 a = m0[64 * j], b = m1[64 * j]; const f32x4 g = g2[64 * j];
                v[q][j].x += g.x * (lo16(a.x) + lo16(b.x)); v[q][j].y += g.y * (hi16(a.x) + hi16(b.x)); v[q][j].z += g.z * (lo16(a.y) + lo16(b.y)); v[q][j].w += g.w * (hi16(a.y) + hi16(b.y));
                ss[q] += (v[q][j].x * v[q][j].x + v[q][j].y * v[q][j].y) + (v[q][j].z * v[q][j].z + v[q][j].w * v[q][j].w); } }
#pragma unroll
        for (int o = 1; o < 64; o <<= 1) {
#pragma unroll
            for (int q = 0; q < 4; ++q) ss[q] += shfl_xor_l(ss[q], o, lane); }
        const f32x4* gn = (const f32x4*)P.norm_f + lane;
#pragma unroll
        for (int q = 0; q < 4; ++q) { const int r = rb + q * stride; if (r >= RL) continue;
            const float rstd = 1.0f / sqrtf(ss[q] * (1.0f / D) + EPS); f32x4* xr = (f32x4*)(P.out + (size_t)r * D) + lane;
#pragma unroll
            for (int j = 0; j < 4; ++j) xr[64 * j] = v[q][j] * rstd * gn[64 * j]; }
    }
}

__device__ __forceinline__ void ph_fourier_ref(const Frame& F, const Ptrs& P, int Ts, int latent) {
    const int tid = fresh_tid();
    LAS float* Zr = (LAS float*)F.lds; LAS float* Zi = Zr + 16 * 64; LAS float* Ct = Zi + 16 * 64; LAS float* St = Ct + 64 * 17;
    const bf16_t* U = (const bf16_t*)(P.ws + WS_U); const float* ct = (const float*)(P.ws + WS_COS);
    const int nkt = Ts / 64, NU = 8 * nkt * 8, step = 4096 / Ts;
    const int tk = tid >> 4, tc = tid & 15;
    for (int u = F.vcu; u < NU; u += F.G) {
        const int cht = u & 7, kt = (u >> 3) % nkt, b = (u >> 3) / nkt, k0 = kt * 64, ch0 = cht * 64;
        const int rbase = latent ? b * T : RL + b * TC;
        float acc[2][4];
#pragma unroll
        for (int i = 0; i < 2; ++i)
#pragma unroll
            for (int j = 0; j < 4; ++j) acc[i][j] = 0.f;
        for (int t0 = 0; t0 < Ts; t0 += 16) {
            __syncthreads();
            if (tid < 256) { const int tt = tid >> 4, c4 = (tid & 15) * 4; const bf16_t* zp = U + (size_t)(rbase + t0 + tt) * NIN + ch0 + c4;
              const u32x2 a = *(const u32x2*)(zp + C_ZR), bq = *(const u32x2*)(zp + C_ZI);
              Zr[tt * 64 + c4] = lo16(a.x); Zr[tt * 64 + c4 + 1] = hi16(a.x); Zr[tt * 64 + c4 + 2] = lo16(a.y); Zr[tt * 64 + c4 + 3] = hi16(a.y);
              Zi[tt * 64 + c4] = lo16(bq.x); Zi[tt * 64 + c4 + 1] = hi16(bq.x); Zi[tt * 64 + c4 + 2] = lo16(bq.y); Zi[tt * 64 + c4 + 3] = hi16(bq.y); }
#pragma unroll
            for (int i = 0; i < 2; ++i) { const int e = tid * 2 + i, k = e >> 4, tt = e & 15; const int ang = (((k0 + k) * (t0 + tt)) & (Ts - 1)) * step;
                Ct[k * 17 + tt] = ct[ang]; St[k * 17 + tt] = ct[(ang - 1024) & 4095]; }
            __syncthreads();
#pragma unroll 2
            for (int tt = 0; tt < 16; ++tt) { float zr[4], zi[4];
#pragma unroll
                for (int j = 0; j < 4; ++j) { zr[j] = Zr[tt * 64 + tc * 4 + j]; zi[j] = Zi[tt * 64 + tc * 4 + j]; }
#pragma unroll
                for (int i = 0; i < 2; ++i) { const float c = Ct[(tk * 2 + i) * 17 + tt], sn = St[(tk * 2 + i) * 17 + tt];
#pragma unroll
                    for (int j = 0; j < 4; ++j) acc[i][j] += c * zr[j] + sn * zi[j]; } }
        }
        const float sc = 1.0f / sqrtf((float)Ts);
        bf16_t* BR = (bf16_t*)(P.ws + WS_BR);
#pragma unroll
        for (int i = 0; i < 2; ++i) { u32x2 w; w.x = pk2(acc[i][0] * sc, acc[i][1] * sc); w.y = pk2(acc[i][2] * sc, acc[i][3] * sc);
            *(u32x2*)(BR + (size_t)(rbase + k0 + tk * 2 + i) * NBR + ch0 + tc * 4) = w; }
        __syncthreads();
    }
}

typedef float f32x16 __attribute__((ext_vector_type(16)));
typedef short v4i16_t __attribute__((ext_vector_type(4)));
constexpr float ATT_THR = 4.0f;
constexpr int AT_ROWB = 144, AT_TILEB = 64 * AT_ROWB;
constexpr int AT_VROWB = 192, AT_VTILEB = 64 * AT_VROWB;
constexpr int AT_STAGEB = 2 * AT_TILEB + 2 * AT_VTILEB;
#define AT_SB() __builtin_amdgcn_sched_barrier(0)
template <bool FIXED> __device__ __forceinline__ void at_qk1(const LAS unsigned char* Kt, int kf_off, const bf16x8 (&qr)[4], const f32x16& negm_, f32x16& p0, f32x16& p1) {
    f32x16 zc;
#pragma unroll
    for (int r = 0; r < 16; ++r) zc[r] = 0.f;
    const f32x16& negm = FIXED ? zc : negm_;
    bf16x8 ka[8];
#pragma unroll
    for (int d0 = 0; d0 < 4; ++d0) { ka[2 * d0] = *(const LAS bf16x8*)(Kt + kf_off + d0 * 32); ka[2 * d0 + 1] = *(const LAS bf16x8*)(Kt + kf_off + 32 * AT_ROWB + d0 * 32); }
    p0 = __builtin_amdgcn_mfma_f32_32x32x16_bf16(ka[0], qr[0], negm, 0, 0, 0); p1 = __builtin_amdgcn_mfma_f32_32x32x16_bf16(ka[1], qr[0], negm, 0, 0, 0);
#pragma unroll
    for (int d0 = 1; d0 < 4; ++d0) { p0 = __builtin_amdgcn_mfma_f32_32x32x16_bf16(ka[2 * d0], qr[d0], p0, 0, 0, 0); p1 = __builtin_amdgcn_mfma_f32_32x32x16_bf16(ka[2 * d0 + 1], qr[d0], p1, 0, 0, 0); }
}
__device__ __forceinline__ void at_vread(const LAS unsigned char* vp, v4i16_t (&f)[4]) {
    f[0] = __builtin_amdgcn_ds_read_tr16_b64_v4i16((LAS v4i16_t*)(vp)); f[1] = __builtin_amdgcn_ds_read_tr16_b64_v4i16((LAS v4i16_t*)(vp + 8 * AT_VROWB));
    f[2] = __builtin_amdgcn_ds_read_tr16_b64_v4i16((LAS v4i16_t*)(vp + 64)); f[3] = __builtin_amdgcn_ds_read_tr16_b64_v4i16((LAS v4i16_t*)(vp + 8 * AT_VROWB + 64));
}
__device__ __forceinline__ bf16x8 at_ppack(const f32x16& p, int sx) { u32x4 pw; pw.x = cvtpk(p[8 * sx], p[8 * sx + 1]); pw.y = cvtpk(p[8 * sx + 2], p[8 * sx + 3]); pw.z = cvtpk(p[8 * sx + 4], p[8 * sx + 5]); pw.w = cvtpk(p[8 * sx + 6], p[8 * sx + 7]); return __builtin_bit_cast(bf16x8, pw); }
__device__ __forceinline__ void at_pvmm(const v4i16_t (&f)[4], const bf16x8 pf, f32x16& o0, f32x16& o1) {
    const bf16x8 v0 = (bf16x8){f[0][0], f[0][1], f[0][2], f[0][3], f[1][0], f[1][1], f[1][2], f[1][3]}, v1 = (bf16x8){f[2][0], f[2][1], f[2][2], f[2][3], f[3][0], f[3][1], f[3][2], f[3][3]};
    o0 = __builtin_amdgcn_mfma_f32_32x32x16_bf16(v0, pf, o0, 0, 0, 0); o1 = __builtin_amdgcn_mfma_f32_32x32x16_bf16(v1, pf, o1, 0, 0, 0);
}
__device__ __forceinline__ float at_exp8(f32x16& p, int sx) { float rs = 0.f;
#pragma unroll
    for (int j = 0; j < 8; ++j) { p[8 * sx + j] = __builtin_amdgcn_exp2f(p[8 * sx + j]); rs += p[8 * sx + j]; }
    return rs; }
template <bool FIXED> __device__ __forceinline__ float at_slot(const LAS unsigned char* Vt, const LAS unsigned char* Kn, const bool hasnext, int kf_off, int vf_off, const bf16x8 (&qr)[4], const f32x16& negm_,
                                         f32x16& pc0, f32x16& pc1, f32x16& pn0, f32x16& pn1, f32x16& o0, f32x16& o1) {
    f32x16 zc;
#pragma unroll
    for (int r = 0; r < 16; ++r) zc[r] = 0.f;
    const f32x16& negm = FIXED ? zc : negm_;
    v4i16_t fA[4], fB[4]; bf16x8 ka0, ka1, kb0, kb1; float rs;
#define AT_KLD(A0, A1, d0) do { A0 = *(const LAS bf16x8*)(Kn + kf_off + (d0) * 32); A1 = *(const LAS bf16x8*)(Kn + kf_off + 32 * AT_ROWB + (d0) * 32); } while (0)
    if (FIXED) AT_KLD(ka0, ka1, 0);
    at_vread(Vt + vf_off, fA); rs = at_exp8(pc0, 0); AT_SB();
    at_vread(Vt + vf_off + 16 * AT_VROWB, fB); if (FIXED) AT_KLD(kb0, kb1, 1); else AT_KLD(ka0, ka1, 0);
    if (hasnext) { pn0 = __builtin_amdgcn_mfma_f32_32x32x16_bf16(ka0, qr[0], negm, 0, 0, 0); pn1 = __builtin_amdgcn_mfma_f32_32x32x16_bf16(ka1, qr[0], negm, 0, 0, 0); }
    at_pvmm(fA, at_ppack(pc0, 0), o0, o1); rs += at_exp8(pc0, 1); AT_SB();
    at_vread(Vt + vf_off + 32 * AT_VROWB, fA); if (FIXED) AT_KLD(ka0, ka1, 2); else AT_KLD(kb0, kb1, 1);
    if (hasnext) { pn0 = __builtin_amdgcn_mfma_f32_32x32x16_bf16(kb0, qr[1], pn0, 0, 0, 0); pn1 = __builtin_amdgcn_mfma_f32_32x32x16_bf16(kb1, qr[1], pn1, 0, 0, 0); }
    at_pvmm(fB, at_ppack(pc0, 1), o0, o1); rs += at_exp8(pc1, 0); AT_SB();
    at_vread(Vt + vf_off + 48 * AT_VROWB, fB); if (FIXED) AT_KLD(kb0, kb1, 3); else AT_KLD(ka0, ka1, 2);
    if (hasnext) { pn0 = __builtin_amdgcn_mfma_f32_32x32x16_bf16(ka0, qr[2], pn0, 0, 0, 0); pn1 = __builtin_amdgcn_mfma_f32_32x32x16_bf16(ka1, qr[2], pn1, 0, 0, 0); }
    at_pvmm(fA, at_ppack(pc1, 0), o0, o1); rs += at_exp8(pc1, 1); AT_SB();
    if (!FIXED) AT_KLD(kb0, kb1, 3);
    if (hasnext) { pn0 = __builtin_amdgcn_mfma_f32_32x32x16_bf16(kb0, qr[3], pn0, 0, 0, 0); pn1 = __builtin_amdgcn_mfma_f32_32x32x16_bf16(kb1, qr[3], pn1, 0, 0, 0); }
    at_pvmm(fB, at_ppack(pc1, 1), o0, o1);
#undef AT_KLD
    return rs;
}
template <int MODE, bool FIXED> __device__ __forceinline__ void ph_attn_impl(const Frame& F, const Ptrs& P, int l) {
    const bool latq = MODE < 2; const bool winm = (MODE == 1 || MODE == 3);
    const int NU = latq ? 1024 : 64;
    LAS unsigned char* Lb = F.lds;
    constexpr bool fixedref = FIXED;
    for (int u = F.vcu; u < NU; u += F.G) {
        const int lane = fresh_lane(), tid = F.wave * 64 + lane, r32 = lane & 31, hi = lane >> 5;
        const bf16_t* U = (const bf16_t*)(P.ws + WS_U);
        const int st_off = (tid >> 3) * AT_ROWB + (tid & 7) * 16;
        const int kf_off = r32 * AT_ROWB + hi * 16;
        const int sv_off = (tid >> 3) * AT_VROWB + (tid & 7) * 16;
        const int vf_off = (4 * hi + ((lane & 15) >> 2)) * AT_VROWB + (((lane >> 4) & 1) * 16 + (lane & 3) * 4) * 2;
        const int qb = latq ? (u & 63) : (u & 3), g = latq ? ((u >> 6) & 1) : ((u >> 2) & 1), b = latq ? (u >> 7) : (u >> 3);
        const int tq0 = qb * 64, hq = 4 * g + (F.wave >> 1), tq = tq0 + 32 * (F.wave & 1) + r32;
        const int qrow = latq ? b * T + tq : RL + b * TC + tq;
        const int qcol = (winm ? C_QW : C_QB) + hq * 64, kcol = (winm ? C_KW : C_KB) + g * 64, vcol = (winm ? C_VW : C_VB) + g * 64;
        int lt_lo = 0, lt_hi = 0;
        if (MODE == 0) { lt_lo = 0; lt_hi = T / 64; }
        if (MODE == 1) { lt_lo = (tq0 - 128 < 0 ? 0 : tq0 - 128) / 64; lt_hi = (tq0 + 192 > T ? T : tq0 + 192) / 64; }
        const int ntiles = 4 + (lt_hi - lt_lo), npairs = (ntiles + 1) >> 1;
        bf16x8 qr[4];
        {
            float x[4][8];
#pragma unroll
            for (int d0 = 0; d0 < 4; ++d0) { const u32x4 wq = *(const u32x4*)(U + (size_t)qrow * NIN + qcol + d0 * 16 + hi * 8);
                x[d0][0] = lo16(wq.x); x[d0][1] = hi16(wq.x); x[d0][2] = lo16(wq.y); x[d0][3] = hi16(wq.y); x[d0][4] = lo16(wq.z); x[d0][5] = hi16(wq.z); x[d0][6] = lo16(wq.w); x[d0][7] = hi16(wq.w); }
            if (!winm) { float ss = 0.f;
#pragma unroll
                for (int d0 = 0; d0 < 4; ++d0)
#pragma unroll
                    for (int j = 0; j < 8; ++j) ss += x[d0][j] * x[d0][j];
                ss += shfl_xor_l(ss, 32, lane);
                const float rstd = 1.0f / sqrtf(ss * (1.0f / 64.0f) + EPS);
#pragma unroll
                for (int d0 = 0; d0 < 4; ++d0) { const f32x4 ga = *(const f32x4*)(P.q_gain + l * 64 + d0 * 16 + hi * 8), gb = *(const f32x4*)(P.q_gain + l * 64 + d0 * 16 + hi * 8 + 4);
                    x[d0][0] *= rstd * ga.x; x[d0][1] *= rstd * ga.y; x[d0][2] *= rstd * ga.z; x[d0][3] *= rstd * ga.w; x[d0][4] *= rstd * gb.x; x[d0][5] *= rstd * gb.y; x[d0][6] *= rstd * gb.z; x[d0][7] *= rstd * gb.w; } }
            if (latq) { const float* rc = (const float*)(P.ws + WS_ROPE); const float* rs = rc + 1024;
#pragma unroll
                for (int a = 0; a < 2; ++a) { const int pos = a ? (tq & 63) : (tq >> 6);
                    const f32x4 c0 = *(const f32x4*)(rc + pos * 16 + hi * 8), c1 = *(const f32x4*)(rc + pos * 16 + hi * 8 + 4), s0 = *(const f32x4*)(rs + pos * 16 + hi * 8), s1 = *(const f32x4*)(rs + pos * 16 + hi * 8 + 4);
                    const float cs[8] = {c0.x, c0.y, c0.z, c0.w, c1.x, c1.y, c1.z, c1.w}, sn[8] = {s0.x, s0.y, s0.z, s0.w, s1.x, s1.y, s1.z, s1.w};
#pragma unroll
                    for (int j = 0; j < 8; ++j) { const float x1 = x[2 * a][j], x2 = x[2 * a + 1][j]; x[2 * a][j] = x1 * cs[j] - x2 * sn[j]; x[2 * a + 1][j] = x2 * cs[j] + x1 * sn[j]; } } }
#pragma unroll
            for (int d0 = 0; d0 < 4; ++d0) { u32x4 wq; wq.x = cvtpk(x[d0][0] * QSCALE, x[d0][1] * QSCALE); wq.y = cvtpk(x[d0][2] * QSCALE, x[d0][3] * QSCALE); wq.z = cvtpk(x[d0][4] * QSCALE, x[d0][5] * QSCALE); wq.w = cvtpk(x[d0][6] * QSCALE, x[d0][7] * QSCALE);
                qr[d0] = __builtin_bit_cast(bf16x8, wq); }
        }
        f32x16 o0, o1, negm;
#pragma unroll
        for (int r = 0; r < 16; ++r) { o0[r] = 0.f; o1[r] = 0.f; negm[r] = 0.f; }
        float mhat = 0.f, lsum = 0.f;
#define AT_KROW(ti) ((ti) < 4 ? RL + b * TC + (ti) * 64 : b * T + (lt_lo + (ti) - 4) * 64)
        u32x4 ka, va, kb2, vb2;
#define AT_LOADPAIR(pp) do { const int na_ = 2 * (pp), nb_ = (2 * (pp) + 1 < ntiles) ? 2 * (pp) + 1 : na_; \
            const int r0_ = AT_KROW(na_) + (tid >> 3), r1_ = AT_KROW(nb_) + (tid >> 3); const int co_ = (tid & 7) * 8; \
            ka = *(const u32x4*)(U + (size_t)r0_ * NIN + kcol + co_); va = *(const u32x4*)(U + (size_t)r0_ * NIN + vcol + co_); \
            kb2 = *(const u32x4*)(U + (size_t)r1_ * NIN + kcol + co_); vb2 = *(const u32x4*)(U + (size_t)r1_ * NIN + vcol + co_); } while (0)
#define AT_WRITEPAIR(off) do { *(LAS u32x4*)(Lb + (off) + st_off) = ka; *(LAS u32x4*)(Lb + (off) + AT_TILEB + st_off) = kb2; \
            *(LAS u32x4*)(Lb + (off) + 2 * AT_TILEB + sv_off) = va; *(LAS u32x4*)(Lb + (off) + 2 * AT_TILEB + AT_VTILEB + sv_off) = vb2; } while (0)
#define AT_MASK(ti, P0, P1) do { if (MODE == 1) { if ((ti) >= ntiles) { _Pragma("unroll") for (int r = 0; r < 16; ++r) { P0[r] = -INFINITY; P1[r] = -INFINITY; } } \
            else if ((ti) >= 4) { const int kb0_ = (lt_lo + (ti) - 4) * 64, qlo_ = tq0 + 32 * (F.wave & 1); \
                if (kb0_ + 63 - qlo_ > 128 || qlo_ + 31 - kb0_ > 128) { const int kp0_ = kb0_ + 4 * hi - tq; \
                    _Pragma("unroll") for (int r = 0; r < 16; ++r) { const int dl_ = kp0_ + (r & 3) + 8 * (r >> 2); \
                        if (dl_ > 128 || dl_ < -128) P0[r] = -INFINITY; if (dl_ + 32 > 128 || dl_ + 32 < -128) P1[r] = -INFINITY; } } } } } while (0)
#define AT_REF(first, P0, P1) do { if (!fixedref) { float mx_ = fmaxf(P0[0], P1[0]); \
            _Pragma("unroll") for (int r = 1; r < 16; ++r) mx_ = fmaxf(mx_, fmaxf(P0[r], P1[r])); \
            mx_ = fmaxf(mx_, shfl_xor_l(mx_, 32, lane)); \
            if ((first) || __any(mx_ > ATT_THR)) { const float dl_ = (first) ? mx_ : fmaxf(mx_, 0.f); mhat += dl_; \
                const float al_ = __builtin_amdgcn_exp2f(-dl_); lsum *= al_; \
                _Pragma("unroll") for (int r = 0; r < 16; ++r) { P0[r] -= dl_; P1[r] -= dl_; o0[r] *= al_; o1[r] *= al_; negm[r] = -mhat; } } } } while (0)
        AT_LOADPAIR(0); AT_WRITEPAIR(0);
        if (npairs > 1) { AT_LOADPAIR(1); AT_WRITEPAIR(AT_STAGEB); }
        if (npairs > 2) AT_LOADPAIR(2);
        __syncthreads();
        f32x16 pc0, pc1, pn0, pn1;
        at_qk1<FIXED>(Lb, kf_off, qr, negm, pc0, pc1);
        AT_REF(true, pc0, pc1);
#pragma unroll
        for (int r = 0; r < 16; ++r) { pn0[r] = 0.f; pn1[r] = 0.f; }
        int scur = 0, snxt = AT_STAGEB, swr = 2 * AT_STAGEB;
        for (int tp = 0; tp < npairs; ++tp) {
            if (tp + 2 < npairs) { AT_WRITEPAIR(swr); if (tp + 3 < npairs) AT_LOADPAIR(tp + 3); }
            lsum += at_slot<FIXED>(Lb + scur + 2 * AT_TILEB, Lb + scur + AT_TILEB, true, kf_off, vf_off, qr, negm, pc0, pc1, pn0, pn1, o0, o1);
            AT_MASK(2 * tp + 1, pn0, pn1);
            AT_REF(false, pn0, pn1);
            const bool more = tp + 1 < npairs;
            lsum += at_slot<FIXED>(Lb + scur + 2 * AT_TILEB + AT_VTILEB, Lb + snxt, more, kf_off, vf_off, qr, negm, pn0, pn1, pc0, pc1, o0, o1);
            if (more) { AT_MASK(2 * tp + 2, pc0, pc1); AT_REF(false, pc0, pc1); }
            __syncthreads();
            { const int t_ = scur; scur = snxt; snxt = swr; swr = t_; }
        }
#undef AT_KROW
#undef AT_LOADPAIR
#undef AT_WRITEPAIR
#undef AT_MASK
#undef AT_REF
        lsum += shfl_xor_l(lsum, 32, lane);
        if (winm) lsum += exp2f(P.sink[l * 8 + hq] * LOG2E - mhat);
        const float inv = 1.0f / lsum;
        bf16_t* op = (bf16_t*)(P.ws + WS_BR) + (size_t)qrow * NBR + (winm ? 1024 : 512) + hq * 64 + 4 * hi;
#pragma unroll
        for (int gq = 0; gq < 4; ++gq) {
            u32x2 w0, w1; w0.x = cvtpk(o0[4 * gq] * inv, o0[4 * gq + 1] * inv); w0.y = cvtpk(o0[4 * gq + 2] * inv, o0[4 * gq + 3] * inv);
            w1.x = cvtpk(o1[4 * gq] * inv, o1[4 * gq + 1] * inv); w1.y = cvtpk(o1[4 * gq + 2] * inv, o1[4 * gq + 3] * inv);
            *(u32x2*)(op + 8 * gq) = w0; *(u32x2*)(op + 32 + 8 * gq) = w1; }
    }
}

template <int MODE> __device__ __forceinline__ void ph_attn(const Frame& F, const Ptrs& P, int l) {
    if (MODE == 1 || MODE == 3) { ph_attn_impl<MODE, false>(F, P, l); return; }
    const int lane = fresh_lane();
    float mq = fabsf(P.q_gain[l * 64 + lane]), mk = fabsf(P.k_gain[l * 64 + lane]);
#pragma unroll
    for (int o = 1; o < 64; o <<= 1) { mq = fmaxf(mq, shfl_xor_l(mq, o, lane)); mk = fmaxf(mk, shfl_xor_l(mk, o, lane)); }
    const float sbound = 64.0f * QSCALE * 1.02f * mq * mk;
    if (__builtin_amdgcn_readfirstlane(sbound < 48.0f ? 1 : 0)) ph_attn_impl<MODE, true>(F, P, l); else ph_attn_impl<MODE, false>(F, P, l);
}

constexpr int DF_ROWB = 528;
template <int STAGE> __device__ __forceinline__ void ph_dft(const Frame& F, const Ptrs& P) {
    const int lane = fresh_lane(), tid = F.wave * 64 + lane, r32 = lane & 31, hi = lane >> 5, w = F.wave;
    bf16_t* U = (bf16_t*)(P.ws + WS_U); bf16_t* BR = (bf16_t*)(P.ws + WS_BR); const bf16_t* Wm = (const bf16_t*)(P.ws + WS_DFTM);
    LAS unsigned char* Xl = F.lds;
    const int xf_off = (8 * hi + ((lane & 15) >> 2)) * DF_ROWB + (32 * w + ((lane >> 4) & 1) * 16 + (lane & 3) * 4) * 2;
    constexpr int NMB = STAGE == 2 ? 4 : 2;
    const int seg = tid >> 2, part = tid & 3, pp = seg >> 6, jj = seg & 63;
    u32x4 pf[8];
    if (F.vcu < 1024) { const int u = F.vcu; const int chb = u & 1, sidx = (u >> 1) & 63, b = u >> 7;
        const int grow = STAGE == 2 ? b * T + 64 * jj + sidx : b * T + 64 * sidx + jj;
        const u32x4* src = (const u32x4*)(U + (size_t)grow * NIN + pp * 512 + chb * 256 + part * 64);
#pragma unroll
        for (int i = 0; i < 8; ++i) pf[i] = src[i]; }
    for (int u = F.vcu; u < 1024; u += F.G) {
        const int chb = u & 1, sidx = (u >> 1) & 63, b = u >> 7;
#pragma unroll
        for (int i = 0; i < 8; ++i) *(LAS u32x4*)(Xl + seg * DF_ROWB + part * 128 + i * 16) = pf[i];
        if (u + F.G < 1024) { const int un = u + F.G; const int chbn = un & 1, sn = (un >> 1) & 63, bn = un >> 7;
            const int grow = STAGE == 2 ? bn * T + 64 * jj + sn : bn * T + 64 * sn + jj;
            const u32x4* src = (const u32x4*)(U + (size_t)grow * NIN + pp * 512 + chbn * 256 + part * 64);
#pragma unroll
            for (int i = 0; i < 8; ++i) pf[i] = src[i]; }
        __syncthreads();
        f32x16 acc[NMB];
#pragma unroll
        for (int mb = 0; mb < NMB; ++mb)
#pragma unroll
            for (int r = 0; r < 16; ++r) acc[mb][r] = 0.f;
#pragma unroll
        for (int ks = 0; ks < 8; ++ks) {
            const v4i16_t lo4 = __builtin_amdgcn_ds_read_tr16_b64_v4i16((LAS v4i16_t*)(Xl + xf_off + (16 * ks) * DF_ROWB));
            const v4i16_t hi4 = __builtin_amdgcn_ds_read_tr16_b64_v4i16((LAS v4i16_t*)(Xl + xf_off + (16 * ks + 4) * DF_ROWB));
            const bf16x8 xf = (bf16x8){lo4[0], lo4[1], lo4[2], lo4[3], hi4[0], hi4[1], hi4[2], hi4[3]};
#pragma unroll
            for (int mb = 0; mb < NMB; ++mb) { const bf16x8 wf = *(const bf16x8*)(Wm + (mb * 32 + r32) * 128 + 16 * ks + 8 * hi);
                acc[mb] = __builtin_amdgcn_mfma_f32_32x32x16_bf16(xf, wf, acc[mb], 0, 0, 0); }
        }
        LAS unsigned char* ob = Xl + (32 * w + 4 * hi) * 2;
        if (STAGE == 2) {
#pragma unroll
            for (int mb = 0; mb < 2; ++mb) { const int k1 = mb * 32 + r32; const float rev = (float)((k1 * sidx) & 4095) * (1.0f / 4096.0f);
                const float ct = __builtin_amdgcn_cosf(rev), st = __builtin_amdgcn_sinf(rev);
#pragma unroll
                for (int gq = 0; gq < 4; ++gq) { u32x2 wr, wi; float yr[4], yi[4];
#pragma unroll
                    for (int i = 0; i < 4; ++i) { const float a = acc[mb][4 * gq + i], bq = acc[mb + 2][4 * gq + i]; yr[i] = a * ct + bq * st; yi[i] = bq * ct - a * st; }
                    wr.x = cvtpk(yr[0], yr[1]); wr.y = cvtpk(yr[2], yr[3]); wi.x = cvtpk(yi[0], yi[1]); wi.y = cvtpk(yi[2], yi[3]);
                    *(LAS u32x2*)(ob + k1 * DF_ROWB + 16 * gq) = wr; *(LAS u32x2*)(ob + (64 + k1) * DF_ROWB + 16 * gq) = wi; } }
        } else {
#pragma unroll
            for (int mb = 0; mb < 2; ++mb) { const int k2 = mb * 32 + r32;
#pragma unroll
                for (int gq = 0; gq < 4; ++gq) { u32x2 wr; wr.x = cvtpk(acc[mb][4 * gq] * 0.015625f, acc[mb][4 * gq + 1] * 0.015625f); wr.y = cvtpk(acc[mb][4 * gq + 2] * 0.015625f, acc[mb][4 * gq + 3] * 0.015625f);
                    *(LAS u32x2*)(ob + k2 * DF_ROWB + 16 * gq) = wr; } }
        }
        __syncthreads();
        if (STAGE == 2) {
            u32x4* dst = (u32x4*)(U + (size_t)(b * T + 64 * jj + sidx) * NIN + pp * 512 + chb * 256 + part * 64);
#pragma unroll
            for (int i = 0; i < 8; ++i) dst[i] = *(const LAS u32x4*)(Xl + seg * DF_ROWB + part * 128 + i * 16);
        } else { const int k2 = tid >> 3, part8 = tid & 7;
            u32x4* dst = (u32x4*)(BR + (size_t)(b * T + 64 * k2 + sidx) * NBR + chb * 256 + part8 * 32);
#pragma unroll
            for (int i = 0; i < 4; ++i) dst[i] = *(const LAS u32x4*)(Xl + k2 * DF_ROWB + part8 * 64 + i * 16); }
        __syncthreads();
    }
}

struct MegaArgs { Ptrs P; int ph_lo, ph_hi, li, pad; };
__global__ void __launch_bounds__(NWAVES * 64, 2) mega(MegaArgs args) {
    extern __shared__ __attribute__((aligned(16))) unsigned char lds_raw[];
    Frame F; F.lds = (LAS unsigned char*)lds_raw;
    F.wave = __builtin_amdgcn_readfirstlane(threadIdx.x >> 6);
    F.G = gridDim.x; { const int bx = blockIdx.x; F.vcu = (F.G % 8 == 0) ? (bx % 8) * (F.G / 8) + bx / 8 : bx; }
    for (int u = fresh_tid(); u < (LDS_BYTES - LDSCTL_OFF) / 4; u += NWAVES * 64) ((LAS unsigned*)(F.lds + LDSCTL_OFF))[u] = 0u;
    __syncthreads();
    volatile LAS unsigned* MISC = (volatile LAS unsigned*)(F.lds + MISC_OFF);
    const Ptrs& P = args.P;
    XcdBarrier bar = xcd_barrier_post((unsigned*)(P.ws + WS_CTL) + CW_BAR + args.li * XCD_BAR_WORDS, MISC + 8, F.wave);
    const int lo = args.ph_lo, hi = args.ph_hi;
    unsigned char* ws = P.ws;
    bf16_t* H = (bf16_t*)(ws + WS_H); bf16_t* U = (bf16_t*)(ws + WS_U); bf16_t* BR = (bf16_t*)(ws + WS_BR);
    bf16_t* MG = (bf16_t*)(ws + WS_MG); bf16_t* HID = (bf16_t*)(ws + WS_HID); bf16_t* MO = (bf16_t*)(ws + WS_MO);
    const bf16_t* Bt_in = (const bf16_t*)(ws + WS_WB + WB_IN); const bf16_t* Bt_gate = (const bf16_t*)(ws + WS_WB + WB_GATE); const bf16_t* Bt_br = (const bf16_t*)(ws + WS_WB + WB_BR);
    const bf16_t* Bt_out = (const bf16_t*)(ws + WS_WB + WB_OUT); const bf16_t* Bt_13 = (const bf16_t*)(ws + WS_WB + WB_13); const bf16_t* Bt_2 = (const bf16_t*)(ws + WS_WB + WB_2);
#define IN(g) (lo <= (g) && (g) < hi)
#define SEAM(g) do { if ((g) + 1 < hi) xcd_barrier(bar); } while (0)
    for (int l = 0; l < 2; ++l) {
        const int pb = l * NPH; const int M = l == 0 ? R : RL;
        if (IN(pb + 0)) { if (l == 0) ph_tables_mod(F, P); ph_weights(F, P, l); if (l == 0) SEAM(pb + 0); }
        if (IN(pb + 1)) { if (l == 0) ph_norm<0>(F, P, l, R); else ph_norm<1>(F, P, l, R); SEAM(pb + 1); }
        if (IN(pb + 2)) {
            pg8::StaticOrder S; S.init(R, NIN, F.G, (int)blockIdx.x, H, D, Bt_in, D);
            pg8::EpiV8<FStore8> E{FStore8{U, NIN}};
            pg8::gemm_phase(F.lds, F.wave, D, D, D, S, E);
            SEAM(pb + 2);
        }
        if (IN(pb + 3)) { ph_kprep(F, P, l); ph_pool(F, P, M); SEAM(pb + 3); }
        if (IN(pb + 4)) {
            ph_dft<2>(F, P); ph_attn<1>(F, P, l);
            if (l == 0) { ph_attn<2>(F, P, l); ph_attn<3>(F, P, l); ph_fourier_ref(F, P, TC, 0); }
            xcd_barrier(bar);
            ph_dft<3>(F, P); ph_attn<0>(F, P, l);
            SEAM(pb + 4);
        }
        if (IN(pb + 5)) {
            pg8::StaticOrder S; S.init(M, 4096, F.G, (int)blockIdx.x, H, D, Bt_gate, D);
            pg8::EpiV8<FGateU8> E{FGateU8{(unsigned char*)(ws + WS_GT), P.b_gate + (size_t)l * 4096}};
            pg8::gemm_phase(F.lds, F.wave, D, D, D, S, E);
            SEAM(pb + 5);
        }
        if (IN(pb + 6)) {
            pg8::StaticOrder S; S.init(M, D, F.G, (int)blockIdx.x, BR, NBR, Bt_br, NBR);
            pg8::EpiMergeS E{(const unsigned char*)(ws + WS_GT), MG};
            pg8::gemm_phase(F.lds, F.wave, NBR, NBR, NBR, S, E);
            xcd_barrier(bar);
        }
        if (IN(pb + 10)) {
            pg8::StaticOrder S; S.init(M, D, F.G, (int)blockIdx.x, MG, D, Bt_out, D);
            pg8::EpiV4<FOut> E{FOut{P, l}};
            pg8::gemm_phase(F.lds, F.wave, D, D, D, S, E);
            SEAM(pb + 10);
        }
        if (IN(pb + 11)) { ph_norm<2>(F, P, l, M); xcd_barrier(bar); }
        if (IN(pb + 13) || IN(pb + 14)) {
            LAS int* ptab = (LAS int*)(F.lds + LDSCTL_OFF);
            if (fresh_tid() == 0) { const unsigned* cnt = (const unsigned*)(ws + WS_CTL) + CW_CNT + 1024 * l; int off = 0;
                for (int e = 0; e < 16; ++e) { const int c = (int)cnt[64 * e]; ptab[e] = off; ptab[17 + e] = c; off += (c + 255) >> 8; } ptab[16] = off; }
            __syncthreads();
            if (IN(pb + 13)) {
                pg8::MoeOrder<true> S; S.nN = 4; S.G = F.G; S.c = F.vcu; S.A = (const char*)H; S.Bt = (const char*)Bt_13; S.astep = 0; S.bstep = (size_t)256 * D * 2; S.bexp = (size_t)1024 * 1024 * 2; S.tab = (const int*)ptab; S.tokl = (const int*)(ws + WS_TOKL);
                pg8::EpiDual<FMoe1> E{FMoe1{HID}};
                pg8::gemm_phase(F.lds, F.wave, D, D, D, S, E);
                SEAM(pb + 13);
            }
            if (IN(pb + 14)) {
                pg8::MoeOrder<false> S; S.nN = 4; S.G = F.G; S.c = F.vcu; S.A = (const char*)HID; S.Bt = (const char*)Bt_2; S.astep = (size_t)256 * FF * 2; S.bstep = (size_t)256 * FF * 2; S.bexp = (size_t)1024 * 512 * 2; S.tab = (const int*)ptab; S.tokl = nullptr;
                pg8::EpiV8<FMoe2> E{FMoe2{MO, (const int*)(ws + WS_TOKL), (const float*)(ws + WS_WL)}};
                pg8::gemm_phase(F.lds, F.wave, FF, FF, FF, S, E);
                SEAM(pb + 14);
            }
        }
    }
    if (IN(PH_FINAL)) ph_final(F, P);
#undef IN
#undef SEAM
}

extern "C" void kernel_launch(void* const* d_in, const int* in_sizes, int n_in, void* d_out, int out_size, void* d_ws, size_t ws_size, hipStream_t stream) {
    if (n_in != 24 || ws_size < WS_END || out_size != RL * D) { fprintf(stderr, "kernel_launch: unexpected sizes n_in %d ws %zu out %d\n", n_in, ws_size, out_size); return; }
    static int grid = 0;
    if (grid == 0) {
        int dev = 0, cus = 0;
        if (hipGetDevice(&dev) != hipSuccess || hipDeviceGetAttribute(&cus, hipDeviceAttributeMultiprocessorCount, dev) != hipSuccess) { grid = -1; return; }
        if (hipFuncSetAttribute((const void*)mega, hipFuncAttributeMaxDynamicSharedMemorySize, LDS_BYTES) != hipSuccess) { fprintf(stderr, "kernel_launch: hipFuncSetAttribute failed\n"); grid = -1; return; }
        int per_cu = 0;
        if (hipOccupancyMaxActiveBlocksPerMultiprocessor(&per_cu, (const void*)mega, NWAVES * 64, LDS_BYTES) != hipSuccess || per_cu < 1) fprintf(stderr, "kernel_launch: occupancy query says %d\n", per_cu);
        (void)hipGetLastError();
        grid = cus;
    }
    if (grid < 0) return;
    MegaArgs a{};
    const float** pp = (const float**)&a.P;
    for (int i = 0; i < 24; ++i) pp[i] = (const float*)d_in[i];
    a.P.out = (float*)d_out; a.P.ws = (unsigned char*)d_ws;
    (void)hipMemsetAsync((unsigned char*)d_ws + WS_CTL, 0, 128 * 1024, stream);
    a.ph_lo = 0; a.ph_hi = PH_FINAL + 1; a.li = 0;
    hipLaunchKernelGGL(mega, dim3(grid), dim3(NWAVES * 64), LDS_BYTES, stream, a);
}
```

```cpp
#include <hip/hip_runtime.h>
#include <cstdio>
#include <cstdint>

typedef unsigned short bf16_t;
typedef short bf16x8 __attribute__((ext_vector_type(8)));
typedef float f32x4 __attribute__((ext_vector_type(4)));
typedef unsigned u32x4 __attribute__((ext_vector_type(4)));
typedef unsigned u32x2 __attribute__((ext_vector_type(2)));

constexpr int D = 1024, NB = 8, T = 4096, TC = 256;
constexpr int RL = NB * T, RC = NB * TC, R = RL + RC;
constexpr int NIN = 3072;
constexpr int C_ZR = 0, C_ZI = 512, C_P = 1024, C_QB = 1536, C_KB = 2048, C_VB = 2176, C_QW = 2304, C_KW = 2816, C_VW = 2944;
constexpr int NBR = 2048;
constexpr int NE = 16, FF = 512;
constexpr int MAXROWS = 73728;
constexpr float EPS = 1e-6f;
constexpr float QSCALE = 0.125f * 1.4426950408889634f;
constexpr float LOG2E = 1.4426950408889634f;

constexpr size_t MiB = 1u << 20;
constexpr size_t WS_CTL = 0;
constexpr size_t WS_MOD = 1 * MiB;
constexpr size_t WS_ROPE = 1 * MiB + 512 * 1024;
constexpr size_t WS_COS = WS_ROPE + 16 * 1024;
constexpr size_t WS_DFTM = WS_ROPE + 64 * 1024;
constexpr size_t WS_TOKL = 2 * MiB;
constexpr size_t WS_WL = 4 * MiB + 512 * 1024;
constexpr size_t WS_XC = 9 * MiB;
constexpr size_t WS_WB = 17 * MiB;
constexpr size_t WB_IN = 0, WB_GATE = 6 * MiB, WB_BR = 14 * MiB, WB_OUT = 18 * MiB, WB_13 = 20 * MiB, WB_2 = 52 * MiB;
constexpr size_t WS_H = 85 * MiB;
constexpr size_t WS_ARENA = 153 * MiB;
constexpr size_t WS_U = WS_ARENA;
constexpr size_t WS_BR = WS_ARENA + 204 * MiB;
constexpr size_t WS_GT = WS_ARENA;
constexpr size_t WS_MG = WS_ARENA + 136 * MiB;
constexpr size_t WS_HID = WS_ARENA + 144 * MiB;
constexpr size_t WS_MO = WS_ARENA + 216 * MiB;
constexpr size_t WS_END = 512 * MiB;
static_assert(WS_BR + (size_t)R * NBR * 2 <= WS_END && WS_MO + (size_t)2 * R * D * 2 <= WS_END && WS_MG + (size_t)R * D * 2 <= WS_BR, "ws map");
constexpr int CW_CNT = 8192;

__device__ __forceinline__ float bf2f(bf16_t b) { return __uint_as_float(((unsigned)b) << 16); }
__device__ __forceinline__ unsigned f2bf(float f) { unsigned u = __float_as_uint(f); return (u + 0x7fffu + ((u >> 16) & 1u)) >> 16; }
__device__ __forceinline__ unsigned pk2(float lo, float hi) { return f2bf(lo) | (f2bf(hi) << 16); }
typedef __bf16 bf16x2_t __attribute__((ext_vector_type(2)));
typedef float f32x2_t __attribute__((ext_vector_type(2)));
__device__ __forceinline__ unsigned cvtpk(float lo, float hi) { f32x2_t v = {lo, hi}; bf16x2_t b = __builtin_convertvector(v, bf16x2_t); return __builtin_bit_cast(unsigned, b); }
__device__ __forceinline__ float lo16(unsigned w) { return __uint_as_float(w << 16); }
__device__ __forceinline__ float hi16(unsigned w) { return __uint_as_float(w & 0xffff0000u); }
__device__ __forceinline__ float shfl_xor_l(float v, int o, int lane) { return __int_as_float(__builtin_amdgcn_ds_bpermute((lane ^ o) << 2, __float_as_int(v))); }
__device__ __forceinline__ float wave_sum_l(float v, int lane) {
#pragma unroll
    for (int o = 1; o < 64; o <<= 1) v += shfl_xor_l(v, o, lane);
    return v;
}
__device__ __forceinline__ int row_bb(int r) { return r < RL ? (r >> 12) : 8; }

struct Ptrs {
    const float *x, *c, *ctx, *c_ctx, *w_ada, *b_ada, *norm1, *norm2, *w_in, *q_gain, *k_gain, *sink, *pool_w, *pool_scale,
        *w_branch, *w_gate, *b_gate, *w_out, *router_w, *router_bias, *w1, *w3, *w2, *norm_f;
    float* out; unsigned char* ws;
};
__device__ __forceinline__ const float* xin_row(const Ptrs& P, int r) { return r < RL ? P.x + (size_t)r * D : P.ctx + (size_t)(r - RL) * D; }
__device__ __forceinline__ float* x1_row(const Ptrs& P, int r) { return r < RL ? P.out + (size_t)r * D : (float*)(P.ws + WS_XC) + (size_t)(r - RL) * D; }
__device__ __forceinline__ const float* mod_vec(const Ptrs& P, int l, int bb, int which) { return (const float*)(P.ws + WS_MOD) + ((size_t)(l * 9 + bb) * 6 + which) * D; }

#define LAS __attribute__((address_space(3)))
#define GAS __attribute__((address_space(1)))
#define LDS_WAIT() asm volatile("s_waitcnt lgkmcnt(0)" ::: "memory")
__device__ __forceinline__ int fresh_lane() { int l; asm volatile("v_mbcnt_lo_u32_b32 %0, -1, 0\n\tv_mbcnt_hi_u32_b32 %0, -1, %0" : "=v"(l)); return l; }
constexpr int NWAVES = 8;
constexpr int RING_BYTES = 131072, LDSCTL_OFF = RING_BYTES, MISC_OFF = LDSCTL_OFF + 320, LDS_BYTES = 147456;
constexpr int CW_BAR = 16384;
constexpr int NPH = 15, PH_FINAL = 2 * NPH;

#define XB_TMO      128
#define XB_XCNT(j)  (256  + 64 * (j))
#define XB_XSUB(j)  (1280 + 64 * (j))
#define XB_XGEN(j)  (2304 + 64 * (j))
#define XB_TOP      3328
#define XB_TOPGEN   3392
#define XCD_BAR_WORDS 3456
#define XB_SPIN_CAP (1u << 21)
__device__ __forceinline__ unsigned xb_ld(unsigned* p)              { return __hip_atomic_load(p, __ATOMIC_RELAXED, __HIP_MEMORY_SCOPE_AGENT); }
__device__ __forceinline__ unsigned xb_add(unsigned* p, unsigned v) { return __hip_atomic_fetch_add(p, v, __ATOMIC_RELAXED, __HIP_MEMORY_SCOPE_AGENT); }
__device__ __forceinline__ unsigned xb_xcc_id() { return (unsigned)__builtin_amdgcn_s_getreg((3 << 11) | 20) & 0xFu; }
#define XB_SPIN(cond, bar) do { unsigned _sp = 0; while (cond) { __builtin_amdgcn_s_sleep(1); \
    if ((++_sp & 255u) == 0u) { if (xb_ld(&(bar)[XB_TMO])) break; if (_sp > XB_SPIN_CAP) { atomicAdd(&(bar)[XB_TMO], 1u); break; } } } } while (0)
struct XcdBarrier { unsigned* bar; unsigned x; volatile LAS unsigned* st; int wave; };
__device__ __forceinline__ XcdBarrier xcd_barrier_post(unsigned* bar, volatile LAS unsigned* st, int wave) {
    XcdBarrier b; b.bar = bar; b.x = xb_xcc_id(); b.st = st; b.wave = wave;
    if (wave == 0 && fresh_lane() == 0) (void)xb_add(&bar[XB_XCNT(b.x)], 1u);
    return b;
}
__device__ __forceinline__ void xcd_barrier_complete(unsigned* bar, unsigned x, unsigned& nloc, unsigned& nx) {
    const unsigned G = gridDim.x * gridDim.y * gridDim.z;
    unsigned sum, cnt, mine, sp = 0u;
    for (;;) {
        sum = 0u; cnt = 0u; mine = 0u;
#pragma unroll
        for (unsigned j = 0; j < 16; ++j) { const unsigned c = xb_ld(&bar[XB_XCNT(j)]); sum += c; cnt += (c > 0u) ? 1u : 0u; mine = (j == x) ? c : mine; }
        if (sum == G) break;
        __builtin_amdgcn_s_sleep(1);
        if ((++sp & 255u) == 0u) { if (xb_ld(&bar[XB_TMO])) break; if (sp > XB_SPIN_CAP) { atomicAdd(&bar[XB_TMO], 1u); break; } }
    }
    nloc = mine > 0u ? mine : 1u; nx = cnt > 0u ? cnt : 1u;
}
__device__ __forceinline__ void xcd_barrier(const XcdBarrier& b) {
    asm volatile("s_waitcnt vmcnt(0)" ::: "memory");
    __syncthreads();
    if (b.wave == 0 && fresh_lane() == 0) {
        unsigned* bar = b.bar;
        __builtin_amdgcn_s_waitcnt(0);
        unsigned nloc = b.st[0], nx = b.st[1];
        if (nloc == 0u) { xcd_barrier_complete(bar, b.x, nloc, nx); b.st[0] = nloc; b.st[1] = nx; }
        const unsigned old = xb_add(&bar[XB_XSUB(b.x)], 1u);
        const unsigned gen = old / nloc;
        if (old + 1u == (gen + 1u) * nloc) {
            __builtin_amdgcn_fence(__ATOMIC_RELEASE, "agent");
            asm volatile("s_waitcnt vmcnt(0)" ::: "memory");
            const unsigned og = xb_add(&bar[XB_TOP], 1u);
            const unsigned tg = og / nx;
            if (og + 1u == (tg + 1u) * nx) xb_add(&bar[XB_TOPGEN], 1u);
            else XB_SPIN(xb_ld(&bar[XB_TOPGEN]) == tg, bar);
            __builtin_amdgcn_fence(__ATOMIC_ACQUIRE, "agent");
            xb_add(&bar[XB_XGEN(b.x)], 1u);
            asm volatile("s_waitcnt vmcnt(0)" ::: "memory");
        } else {
            XB_SPIN(xb_ld(&bar[XB_XGEN(b.x)]) == gen, bar);
            __builtin_amdgcn_fence(__ATOMIC_ACQUIRE, "agent");
            asm volatile("s_waitcnt vmcnt(0)" ::: "memory");
        }
    }
    __syncthreads();
}

namespace pg8 {
constexpr int BM = 256, BK = 64, HALF = 128, HTB = HALF * BK * 2, STAGE_BYTES = 8 * HTB, NXCD = 8, WGM = 4;
__host__ __device__ __forceinline__ int lds_byte(int r, int c) { const int st = (r >> 4) * 2 + (c >> 5), rr = r & 15, cc = c & 31, ob = rr * 64 + cc * 2; return st * 1024 + (ob ^ (((ob >> 9) & 1) << 5)); }
__host__ __device__ __forceinline__ void stage_rc(int b, int& Rr, int& C) { const int st = b / 1024, sb = b % 1024, swz = sb ^ (((sb >> 9) & 1) << 5); Rr = (st >> 1) * 16 + swz / 64; C = (st & 1) * 32 + (swz % 64) / 2; }
__host__ __device__ __forceinline__ int perm32(int rho) { const int n = rho >> 4, i = rho & 15; return 8 * (i >> 2) + 4 * n + (i & 3); }
struct Unit { int pm, pn; const char* a; const char* b; int e, p0, ce; };

struct StaticOrder {
    static constexpr bool GATHER = false;
    int nM, nN, nwg, G, c; const char* A; const char* Bt; size_t astep, bstep;
    __device__ void init(int M, int N, int G_, int c_, const bf16_t* A_, int lda, const bf16_t* Bt_, int ldb) { nM = M / BM; nN = N / BM; nwg = nM * nN; G = G_; c = c_; A = (const char*)A_; Bt = (const char*)Bt_; astep = (size_t)BM * lda * 2; bstep = (size_t)BM * ldb * 2; }
    __device__ bool next(int i, Unit& u) const {
        const long L = (long)i * G + c; if (L >= nwg) return false;
        int wgid = (int)L; { const int q = nwg / NXCD, r = nwg % NXCD, xcd = wgid % NXCD, off = wgid / NXCD; wgid = (xcd < r ? xcd * (q + 1) : r * (q + 1) + (xcd - r) * q) + off; }
        const int nig = WGM * nN, gid = wgid / nig, fm = gid * WGM, gsz = (nM - fm) < WGM ? (nM - fm) : WGM;
        u.pm = fm + ((wgid % nig) % gsz); u.pn = (wgid % nig) / gsz; u.a = A + (size_t)u.pm * astep; u.b = Bt + (size_t)u.pn * bstep; u.e = 0; u.p0 = 0; u.ce = 0; return true;
    }
};
template <bool GATHER_> struct MoeOrder {
    static constexpr bool GATHER = GATHER_;
    int nN, G, c; const char* A; const char* Bt; size_t astep, bstep, bexp; const int* tab; const int* tokl;
    __device__ bool next(int i, Unit& u) const {
        const int L = i * G + c; const int total = __builtin_amdgcn_readfirstlane(tab[16]) * nN; if (L >= total) return false;
        u.pm = L / nN; u.pn = L % nN; int e = 0;
#pragma unroll
        for (int q = 1; q < 16; ++q) e += (u.pm >= tab[q]) ? 1 : 0;
        e = __builtin_amdgcn_readfirstlane(e);
        u.e = e; u.p0 = __builtin_amdgcn_readfirstlane((u.pm - tab[e]) * BM); u.ce = __builtin_amdgcn_readfirstlane(tab[17 + e]);
        u.a = GATHER_ ? A : A + (size_t)u.pm * astep; u.b = Bt + (size_t)e * bexp + (size_t)u.pn * bstep; return true;
    }
    __device__ __forceinline__ void aoffs(const Unit& u, int wid, int lda, unsigned (&off)[2][2]) const {
        const int tid = wid * 64 + fresh_lane();
#pragma unroll
        for (int i = 0; i < 2; ++i) { int Rr, C; stage_rc(tid * 16 + i * 8192, Rr, C);
#pragma unroll
            for (int h = 0; h < 2; ++h) { const int pos = u.p0 + h * HALF + Rr; const int tok = pos < u.ce ? (tokl[(size_t)u.e * R + pos] >> 1) : 0; off[h][i] = (unsigned)(tok * lda + C) * 2u; } }
    }
};

template <class Epi, class Sched, bool ALIGN_EPI = true>
__device__ __forceinline__ void gemm_phase(LAS unsigned char* lds, const int wid, const int lda, const int ldb, const int K, const Sched& S, const Epi& E) {
    const int lane = fresh_lane(), tid = wid * 64 + lane, wr = wid >> 2, wc = wid & 3, fr = lane & 15, fq = lane >> 4;
    const int nt = K / BK;
    unsigned voffA[2], voffB[2];
#pragma unroll
    for (int i = 0; i < 2; ++i) { int Rr, C; stage_rc(tid * 16 + i * 8192, Rr, C); const int Rb = Epi::PERM ? ((Rr & ~31) + perm32(Rr & 31)) : Rr;
        voffA[i] = (unsigned)(Rr * lda + C) * 2u; voffB[i] = (unsigned)(Rb * ldb + C) * 2u; }
    const size_t kstep = (size_t)(BK * 2);
    const size_t hstepA = Sched::GATHER ? 0 : (size_t)HALF * lda * 2, hstepB = (size_t)HALF * ldb * 2;
    const unsigned ldsw = (unsigned)wid * 1024u;
    const int aoff = lds_byte(wr * 64 + fr, fq * 8), boff = lds_byte(wc * 32 + fr, fq * 8);
#define PG8_SA(b, h) (((b) * 2 + (h)) * HTB)
#define PG8_SB(b, h) ((4 + (b) * 2 + (h)) * HTB)
#define PG8_STAGE(bufoff, gbase, voff) do { _Pragma("unroll") for (int _i = 0; _i < 2; ++_i) \
        __builtin_amdgcn_global_load_lds((const unsigned*)((const char*)(gbase) + (voff)[_i]), (LAS unsigned*)(lds + (bufoff) + ldsw + _i * 8192), 16, 0, 0); } while (0)
#define PG8_STAGE_A(b, h, kp, OFFS) do { if constexpr (Sched::GATHER) { PG8_STAGE(PG8_SA(b, h), kp, OFFS[h]); } else { PG8_STAGE(PG8_SA(b, h), (kp) + (h) * hstepA, voffA); } } while (0)
#define PG8_LDA(dst, b, h) do { _Pragma("unroll") for (int m = 0; m < 4; ++m) _Pragma("unroll") for (int k = 0; k < 2; ++k) dst[m][k] = *(const LAS bf16x8*)(lds + PG8_SA(b, h) + aoff + m * 2048 + k * 1024); } while (0)
#define PG8_LDB(dst, b, h) do { _Pragma("unroll") for (int n = 0; n < 2; ++n) _Pragma("unroll") for (int k = 0; k < 2; ++k) dst[n][k] = *(const LAS bf16x8*)(lds + PG8_SB(b, h) + boff + n * 2048 + k * 1024); } while (0)
#define PG8_MMA(ai, bj, At, Bt) do { __builtin_amdgcn_s_setprio(1); _Pragma("unroll") for (int m = 0; m < 4; ++m) _Pragma("unroll") for (int n = 0; n < 2; ++n) _Pragma("unroll") for (int k = 0; k < 2; ++k) \
        acc[ai][bj][m][n] = __builtin_amdgcn_mfma_f32_16x16x32_bf16(Bt[n][k], At[m][k], acc[ai][bj][m][n], 0, 0, 0); __builtin_amdgcn_s_setprio(0); } while (0)
#define PG8_WAIT_V(n) asm volatile("s_waitcnt vmcnt(" #n ")" ::: "memory")
#define PG8_WAIT_L(n) asm volatile("s_waitcnt lgkmcnt(" #n ")" ::: "memory")
#define PG8_BAR __builtin_amdgcn_s_barrier()
#define PG8_SCHED __builtin_amdgcn_sched_barrier(0)
    Unit cur, nxt; int ui = 0;
    if (!S.next(0, cur)) return;
    f32x4 acc[2][2][4][2];
#pragma unroll
    for (int a = 0; a < 2; ++a)
#pragma unroll
        for (int b = 0; b < 2; ++b)
#pragma unroll
            for (int m = 0; m < 4; ++m)
#pragma unroll
                for (int n = 0; n < 2; ++n) acc[a][b][m][n] = (f32x4){0.f, 0.f, 0.f, 0.f};
    bf16x8 At[4][2], B0[2][2], B1[2][2];
    unsigned goffC[2][2], goffN[2][2];
    if constexpr (Sched::GATHER) { S.aoffs(cur, wid, lda, goffC);
#pragma unroll
        for (int h = 0; h < 2; ++h)
#pragma unroll
            for (int i = 0; i < 2; ++i) goffN[h][i] = goffC[h][i]; }
    const char* cA = cur.a; const char* cB = cur.b;
    PG8_STAGE(PG8_SB(0, 0), cB, voffB); PG8_STAGE(PG8_SB(0, 1), cB + hstepB, voffB); PG8_STAGE_A(0, 0, cA, goffC); PG8_STAGE_A(0, 1, cA, goffC);
    if (wr == 1) PG8_BAR;
    PG8_WAIT_V(2); PG8_BAR;
    PG8_STAGE(PG8_SB(1, 0), cB + kstep, voffB); PG8_STAGE_A(1, 0, cA + kstep, goffC); PG8_STAGE(PG8_SB(1, 1), cB + hstepB + kstep, voffB);
    PG8_WAIT_V(6); PG8_BAR;
    for (;;) {
        const bool has_next = S.next(ui + 1, nxt);
        if constexpr (Sched::GATHER) { if (has_next) S.aoffs(nxt, wid, lda, goffN); }
        const char* nA = has_next ? nxt.a : cA; const char* nB = has_next ? nxt.b : cB;
        for (int t = 0; t < nt; t += 2) {
            const bool last = (t == nt - 2);
            const char* a1 = cA + (size_t)(t + 1) * kstep;
            const char* a2 = last ? nA : cA + (size_t)(t + 2) * kstep; const char* b2 = last ? nB : cB + (size_t)(t + 2) * kstep;
            const char* a3 = a2 + kstep; const char* b3 = b2 + kstep;
            unsigned gx[2][2];
            if constexpr (Sched::GATHER) {
#pragma unroll
                for (int h = 0; h < 2; ++h)
#pragma unroll
                    for (int i = 0; i < 2; ++i) gx[h][i] = (last && has_next) ? goffN[h][i] : goffC[h][i]; }
            PG8_LDB(B0, 0, 0); PG8_LDB(B1, 0, 1); PG8_SCHED; PG8_LDA(At, 0, 0); PG8_STAGE_A(1, 1, a1, goffC);
            PG8_WAIT_V(8); PG8_WAIT_L(0); PG8_BAR; PG8_MMA(0, 0, At, B0); PG8_MMA(0, 1, At, B1); PG8_BAR; PG8_SCHED;
            PG8_LDA(At, 0, 1); PG8_STAGE(PG8_SB(0, 0), b2, voffB); PG8_STAGE(PG8_SB(0, 1), b2 + hstepB, voffB); PG8_STAGE_A(0, 0, a2, gx);
            PG8_WAIT_V(8); PG8_WAIT_L(0); PG8_BAR; PG8_MMA(1, 0, At, B0); PG8_MMA(1, 1, At, B1); PG8_BAR; PG8_SCHED;
            PG8_LDB(B0, 1, 0); PG8_LDB(B1, 1, 1); PG8_SCHED; PG8_LDA(At, 1, 0); PG8_STAGE_A(0, 1, a2, gx);
            PG8_WAIT_V(8); PG8_WAIT_L(0); PG8_BAR; PG8_MMA(0, 0, At, B0); PG8_MMA(0, 1, At, B1); PG8_BAR; PG8_SCHED;
            PG8_LDA(At, 1, 1); PG8_STAGE(PG8_SB(1, 0), b3, voffB); PG8_STAGE(PG8_SB(1, 1), b3 + hstepB, voffB); PG8_STAGE_A(1, 0, a3, gx);
            PG8_WAIT_V(8); PG8_WAIT_L(0); PG8_BAR; PG8_MMA(1, 0, At, B0); PG8_MMA(1, 1, At, B1); PG8_BAR; PG8_SCHED;
            if constexpr (Epi::MID) { if (((t + 2) & (Epi::MID_EVERY - 1)) == 0 && !last) E.mid(acc, cur, wr, wc, (t + 2) / Epi::MID_EVERY - 1); }
        }
        if constexpr (ALIGN_EPI) { if (wr == 0) PG8_BAR; }
        E(acc, cur, wr, wc, fr, fq);
        if (!has_next) break;
#pragma unroll
        for (int a = 0; a < 2; ++a)
#pragma unroll
            for (int b = 0; b < 2; ++b)
#pragma unroll
                for (int m = 0; m < 4; ++m)
#pragma unroll
                    for (int n = 0; n < 2; ++n) acc[a][b][m][n] = (f32x4){0.f, 0.f, 0.f, 0.f};
        cur = nxt; cA = nA; cB = nB; ++ui;
        if constexpr (Sched::GATHER) {
#pragma unroll
            for (int h = 0; h < 2; ++h)
#pragma unroll
                for (int i = 0; i < 2; ++i) goffC[h][i] = goffN[h][i]; }
        if constexpr (ALIGN_EPI) { if (wr == 1) PG8_BAR; }
    }
    PG8_WAIT_V(0);
    if constexpr (!ALIGN_EPI) { if (wr == 0) PG8_BAR; }
    PG8_BAR;
#undef PG8_SA
#undef PG8_SB
#undef PG8_STAGE
#undef PG8_STAGE_A
#undef PG8_LDA
#undef PG8_LDB
#undef PG8_MMA
#undef PG8_WAIT_V
#undef PG8_WAIT_L
#undef PG8_BAR
#undef PG8_SCHED
}
template <class F> struct EpiV4 { static constexpr bool PERM = false, MID = false; static constexpr int MID_EVERY = 1; F f;
    __device__ __forceinline__ void operator()(const f32x4 (&acc)[2][2][4][2], const Unit& u, int wr, int wc, int, int) const {
        const int ln = fresh_lane(), fr = ln & 15, fq = ln >> 4;
        const int row0 = u.pm * BM + wr * 64 + fr, col0 = u.pn * BM + wc * 32 + 4 * fq;
        typename F::UnitPre up = f.unit(u, col0);
#pragma unroll
        for (int ai = 0; ai < 2; ++ai) {
            typename F::Pre pre[4][2][2];
#pragma unroll
            for (int m = 0; m < 4; ++m)
#pragma unroll
                for (int bj = 0; bj < 2; ++bj)
#pragma unroll
                    for (int n = 0; n < 2; ++n) pre[m][bj][n] = f.load(u, row0 + ai * HALF + m * 16, col0 + bj * HALF + n * 16);
#pragma unroll
            for (int m = 0; m < 4; ++m)
#pragma unroll
                for (int bj = 0; bj < 2; ++bj)
#pragma unroll
                    for (int n = 0; n < 2; ++n) f.fin(u, row0 + ai * HALF + m * 16, col0 + bj * HALF + n * 16, acc[ai][bj][m][n], pre[m][bj][n], up, bj * 2 + n);
            asm volatile("" ::: "memory"); }
    } };
template <class F> struct EpiV8 { static constexpr bool PERM = true, MID = false; static constexpr int MID_EVERY = 1; F f;
    __device__ __forceinline__ void operator()(const f32x4 (&acc)[2][2][4][2], const Unit& u, int wr, int wc, int, int) const {
        const int ln = fresh_lane(), fr = ln & 15, fq = ln >> 4;
        const int row0 = u.pm * BM + wr * 64 + fr, col0 = u.pn * BM + wc * 32 + 8 * fq;
#pragma unroll
        for (int ai = 0; ai < 2; ++ai) {
            typename F::Pre pre[4][2];
#pragma unroll
            for (int m = 0; m < 4; ++m)
#pragma unroll
                for (int bj = 0; bj < 2; ++bj) pre[m][bj] = f.load(u, row0 + ai * HALF + m * 16, col0 + bj * HALF);
#pragma unroll
            for (int m = 0; m < 4; ++m)
#pragma unroll
                for (int bj = 0; bj < 2; ++bj) f.fin(u, row0 + ai * HALF + m * 16, col0 + bj * HALF, acc[ai][bj][m][0], acc[ai][bj][m][1], pre[m][bj]);
            asm volatile("" ::: "memory"); }
    } };
template <class F> struct EpiDual { static constexpr bool PERM = true, MID = false; static constexpr int MID_EVERY = 1; F f;
    __device__ __forceinline__ void operator()(const f32x4 (&acc)[2][2][4][2], const Unit& u, int wr, int wc, int, int) const {
        const int ln = fresh_lane(), fr = ln & 15, fq = ln >> 4;
        const int row0 = u.pm * BM + wr * 64 + fr, hc0 = u.pn * HALF + wc * 32 + 8 * fq;
#pragma unroll
        for (int ai = 0; ai < 2; ++ai)
#pragma unroll
            for (int m = 0; m < 4; ++m) f.apply8(row0 + ai * HALF + m * 16, hc0, acc[ai][0][m][0], acc[ai][0][m][1], acc[ai][1][m][0], acc[ai][1][m][1]);
    } };
struct EpiMergeS { static constexpr bool PERM = true, MID = true; static constexpr int MID_EVERY = 8;
    const unsigned char* G8; bf16_t* MG;
    __device__ __forceinline__ void mid(f32x4 (&acc)[2][2][4][2], const Unit& u, int wr, int wc, int i) const {
        const int ln = fresh_lane(), fr = ln & 15, fq = ln >> 4;
        const int row0 = u.pm * BM + wr * 64 + fr, col0 = u.pn * BM + wc * 32 + 8 * fq;
#pragma unroll
        for (int ai = 0; ai < 2; ++ai) {
            u32x2 gi[4][2], gn[4][2];
#pragma unroll
            for (int m = 0; m < 4; ++m)
#pragma unroll
                for (int bj = 0; bj < 2; ++bj) { const unsigned char* gp = G8 + (size_t)(row0 + ai * HALF + m * 16) * 4096 + i * 1024 + col0 + bj * HALF;
                    gi[m][bj] = *(const u32x2*)gp; gn[m][bj] = *(const u32x2*)(gp + 1024); }
#pragma unroll
            for (int m = 0; m < 4; ++m)
#pragma unroll
                for (int bj = 0; bj < 2; ++bj) {
#pragma unroll
                    for (int j = 0; j < 4; ++j) {
                        acc[ai][bj][m][0][j] *= (float)((gi[m][bj].x >> (8 * j)) & 255u) * __builtin_amdgcn_rcpf((float)((gn[m][bj].x >> (8 * j)) & 255u));
                        acc[ai][bj][m][1][j] *= (float)((gi[m][bj].y >> (8 * j)) & 255u) * __builtin_amdgcn_rcpf((float)((gn[m][bj].y >> (8 * j)) & 255u)); } }
        }
    }
    __device__ __forceinline__ void operator()(const f32x4 (&acc)[2][2][4][2], const Unit& u, int wr, int wc, int, int) const {
        const int ln = fresh_lane(), fr = ln & 15, fq = ln >> 4;
        const int row0 = u.pm * BM + wr * 64 + fr, col0 = u.pn * BM + wc * 32 + 8 * fq;
#pragma unroll
        for (int ai = 0; ai < 2; ++ai) {
            u32x2 g3[4][2];
#pragma unroll
            for (int m = 0; m < 4; ++m)
#pragma unroll
                for (int bj = 0; bj < 2; ++bj) g3[m][bj] = *(const u32x2*)(G8 + (size_t)(row0 + ai * HALF + m * 16) * 4096 + 3 * 1024 + col0 + bj * HALF);
#pragma unroll
            for (int m = 0; m < 4; ++m)
#pragma unroll
                for (int bj = 0; bj < 2; ++bj) { f32x4 a = acc[ai][bj][m][0], b = acc[ai][bj][m][1];
#pragma unroll
                    for (int j = 0; j < 4; ++j) { a[j] *= (float)((g3[m][bj].x >> (8 * j)) & 255u) * (1.0f / 255.0f); b[j] *= (float)((g3[m][bj].y >> (8 * j)) & 255u) * (1.0f / 255.0f); }
                    u32x4 w; w.x = cvtpk(a.x, a.y); w.y = cvtpk(a.z, a.w); w.z = cvtpk(b.x, b.y); w.w = cvtpk(b.z, b.w);
                    *(u32x4*)(MG + (size_t)(row0 + ai * HALF + m * 16) * D + col0 + bj * HALF) = w; }
        }
    }
};
}

__device__ __forceinline__ u32x4 pack8(f32x4 a, f32x4 b) { u32x4 w; w.x = cvtpk(a.x, a.y); w.y = cvtpk(a.z, a.w); w.z = cvtpk(b.x, b.y); w.w = cvtpk(b.z, b.w); return w; }
__device__ __forceinline__ float sigm1(float x) { return __builtin_amdgcn_rcpf(1.0f + __builtin_amdgcn_exp2f(-1.4426950408889634f * x)); }
__device__ __forceinline__ f32x4 sigm4(f32x4 v) { f32x4 r; r.x = sigm1(v.x); r.y = sigm1(v.y); r.z = sigm1(v.z); r.w = sigm1(v.w); return r; }
struct NoPre {};
struct FStore8 { bf16_t* C; int ldc; typedef NoPre Pre;
    __device__ __forceinline__ Pre load(const pg8::Unit&, int, int) const { return Pre{}; }
    __device__ __forceinline__ void fin(const pg8::Unit&, int row, int col, f32x4 a, f32x4 b, const Pre&) const { *(u32x4*)(C + (size_t)row * ldc + col) = pack8(a, b); } };
struct FGateU8 { unsigned char* G8; const float* bias; typedef NoPre Pre;
    __device__ __forceinline__ Pre load(const pg8::Unit&, int, int) const { return Pre{}; }
    __device__ __forceinline__ void fin(const pg8::Unit&, int row, int col, f32x4 a, f32x4 b, const Pre&) const { const f32x4 b0 = *(const f32x4*)(bias + col), b1 = *(const f32x4*)(bias + col + 4);
        const f32x4 ga = sigm4(a + b0) * 255.0f + 0.5f, gb = sigm4(b + b1) * 255.0f + 0.5f;
        unsigned q[8] = {(unsigned)ga.x, (unsigned)ga.y, (unsigned)ga.z, (unsigned)ga.w, (unsigned)gb.x, (unsigned)gb.y, (unsigned)gb.z, (unsigned)gb.w};
#pragma unroll
        for (int k = 0; k < 8; ++k) q[k] = q[k] < 1u ? 1u : (q[k] > 255u ? 255u : q[k]);
        u32x2 w; w.x = q[0] | (q[1] << 8) | (q[2] << 16) | (q[3] << 24); w.y = q[4] | (q[5] << 8) | (q[6] << 16) | (q[7] << 24);
        *(u32x2*)(G8 + (size_t)row * 4096 + col) = w; } };
struct FMoe1 { bf16_t* HID;
    __device__ __forceinline__ void apply8(int row, int hc, f32x4 a0, f32x4 a1, f32x4 b0, f32x4 b1) const {
        *(u32x4*)(HID + (size_t)row * FF + hc) = pack8(a0 * sigm4(a0) * b0, a1 * sigm4(a1) * b1); } };
struct FMoe2 { bf16_t* MO; const int* tokl; const float* wl; struct Pre { int t; float w; };
    __device__ __forceinline__ Pre load(const pg8::Unit& u, int row, int) const { Pre r; const int pos = u.p0 + (row - u.pm * 256); r.t = -1; r.w = 0.f;
        if (pos < u.ce) { r.t = tokl[(size_t)u.e * R + pos]; r.w = wl[(size_t)u.e * R + pos]; } return r; }
    __device__ __forceinline__ void fin(const pg8::Unit&, int, int col, f32x4 a, f32x4 b, const Pre& q) const { if (q.t < 0) return;
        *(u32x4*)(MO + ((size_t)(q.t & 1) * R + (q.t >> 1)) * D + col) = pack8(a * q.w, b * q.w); } };
struct FOut { Ptrs P; int l; typedef f32x4 Pre; struct UnitPre { f32x4 g[4]; };
    __device__ __forceinline__ UnitPre unit(const pg8::Unit& u, int col0) const { UnitPre r; const float* g = mod_vec(P, l, row_bb(u.pm * 256), 2) + col0;
#pragma unroll
        for (int q = 0; q < 4; ++q) r.g[q] = *(const f32x4*)(g + (q >> 1) * 128 + (q & 1) * 16);
        return r; }
    __device__ __forceinline__ Pre load(const pg8::Unit&, int row, int col) const { return l == 0 ? *(const f32x4*)(xin_row(P, row) + col) : *(const f32x4*)(x1_row(P, row) + col); }
    __device__ __forceinline__ void fin(const pg8::Unit&, int row, int col, f32x4 v, const Pre& xp, const UnitPre& up, int q) const { *(f32x4*)(x1_row(P, row) + col) = xp + up.g[q] * v; } };

struct Frame { LAS unsigned char* lds; int wave, vcu, G; };
#define fresh_tid() (F.wave * 64 + fresh_lane())
__device__ __forceinline__ void tr_item(const float* W, int ldw, int k0, int csrc0, bf16_t* WT, int ldt, int drow0, LAS float* scr, int lane) {
    f32x4 v[8];
#pragma unroll
    for (int i = 0; i < 8; ++i) v[i] = *(const f32x4*)(W + (size_t)(k0 + (lane >> 3) + 8 * i) * ldw + csrc0 + (lane & 7) * 4);
#pragma unroll
    for (int i = 0; i < 8; ++i) { LAS float* d = scr + ((lane >> 3) + 8 * i) * 33 + (lane & 7) * 4; d[0] = v[i].x; d[1] = v[i].y; d[2] = v[i].z; d[3] = v[i].w; }
    LDS_WAIT(); asm volatile("" ::: "memory");
    const int c = lane & 7;
#pragma unroll
    for (int j = 0; j < 4; ++j) { const int n = (lane >> 3) + 8 * j; const LAS float* s = scr + (8 * c) * 33 + n;
        u32x4 o; o.x = cvtpk(s[0 * 33], s[1 * 33]); o.y = cvtpk(s[2 * 33], s[3 * 33]); o.z = cvtpk(s[4 * 33], s[5 * 33]); o.w = cvtpk(s[6 * 33], s[7 * 33]);
        *(u32x4*)(WT + (size_t)(drow0 + n) * ldt + k0 + 8 * c) = o; }
    LDS_WAIT(); asm volatile("" ::: "memory");
}
__device__ __forceinline__ void ph_weights(const Frame& F, const Ptrs& P, int l) {
    const int tid0 = fresh_tid(), lane0 = tid0 & 63;
    LAS float* scr = (LAS float*)(F.lds + F.wave * 16384);
    const int gw = F.vcu * NWAVES + F.wave, NGW = F.G * NWAVES;
    unsigned char* wb = P.ws + WS_WB;
    constexpr int I0 = 1024, I1 = I0 + 2048, I2 = I1 + 768, I3 = I2 + 512, I4 = I3 + 4096, I5 = I4 + 4096, I6 = I5 + 4096;
    for (int it = gw; it < I6; it += NGW) {
        if (it < I0) { const int kb = it >> 6, nb = it & 63; tr_item(P.w_in + (size_t)l * 1024 * 2560, 2560, kb * 64, 512 + nb * 32, (bf16_t*)(wb + WB_IN), 1024, 1024 + nb * 32, scr, lane0); }
        else if (it < I1) { const int r = it - I0, i = r >> 9, q = r & 511, kb = q >> 5, nb = q & 31; tr_item(P.w_gate + ((size_t)l * 4 + i) * 1024 * 1024, 1024, kb * 64, nb * 32, (bf16_t*)(wb + WB_GATE) + (size_t)i * 1024 * 1024, 1024, nb * 32, scr, lane0); }
        else if (it < I2) { const int r = it - I1, i = r >> 8, q = r & 255, kb = q >> 5, nb = q & 31; tr_item(P.w_branch + ((size_t)l * 4 + i) * 512 * 1024, 1024, kb * 64, nb * 32, (bf16_t*)(wb + WB_BR) + i * 512, 2048, nb * 32, scr, lane0); }
        else if (it < I3) { const int q = it - I2, kb = q >> 5, nb = q & 31; tr_item(P.w_out + (size_t)l * 1024 * 1024, 1024, kb * 64, nb * 32, (bf16_t*)(wb + WB_OUT), 1024, nb * 32, scr, lane0); }
        else if (it < I5) { const int w3 = it >= I4; const int r = it - (w3 ? I4 : I3), e = r >> 8, q = r & 255, kb = q >> 4, nb = q & 15, c = nb * 32;
            tr_item((w3 ? P.w3 : P.w1) + ((size_t)l * 16 + e) * 1024 * 512, 512, kb * 64, c, (bf16_t*)(wb + WB_13) + (size_t)e * 1024 * 1024, 1024, 256 * (c >> 7) + (c & 127) + (w3 ? 128 : 0), scr, lane0); }
        else { const int r = it - I5, e = r >> 8, q = r & 255, kb = q >> 5, nb = q & 31; tr_item(P.w2 + ((size_t)l * 16 + e) * 512 * 1024, 1024, kb * 64, nb * 32, (bf16_t*)(wb + WB_2) + (size_t)e * 1024 * 512, 512, nb * 32, scr, lane0); }
    }
    __syncthreads();
    for (int u = F.vcu; u < 256; u += F.G) {
        LAS float* Wl = (LAS float*)F.lds; LAS float* ct = Wl + 16 * 128;
        const int kt = u >> 2, g = u & 3, k0 = kt * 16, tid = tid0; const float* w_in = P.w_in + (size_t)l * 1024 * 2560;
        if (tid < 128) ct[tid] = __builtin_amdgcn_cosf((float)tid * (1.0f / 128.0f));
        for (int i = tid; i < 16 * 128; i += 512) { const int k = i >> 7, c = i & 127; Wl[k * 128 + c] = w_in[(size_t)(k0 + k) * 2560 + g * 128 + c]; }
        __syncthreads();
        const int part = (tid >> 7) & 1, m = tid & 127, kh = tid >> 8; const float sc = 0.08838834764831845f;
        bf16_t* drow = (bf16_t*)(wb + WB_IN) + (size_t)(part * 512 + g * 128 + m) * 1024 + k0;
        { const int kb = kh * 8; float acc[8];
#pragma unroll
            for (int j = 0; j < 8; ++j) acc[j] = 0.f;
            for (int c = 0; c < 128; ++c) { const int idx = (c * m) & 127; const float tw = part ? -ct[(idx - 32) & 127] : ct[idx];
#pragma unroll
                for (int j = 0; j < 8; ++j) acc[j] += Wl[(kb + j) * 128 + c] * tw; }
            u32x4 o; o.x = pk2(acc[0] * sc, acc[1] * sc); o.y = pk2(acc[2] * sc, acc[3] * sc); o.z = pk2(acc[4] * sc, acc[5] * sc); o.w = pk2(acc[6] * sc, acc[7] * sc);
            *(u32x4*)(drow + kb) = o; }
        __syncthreads();
    }
    for (int u = F.vcu; u < 256; u += F.G) {
        LAS float* Wb = (LAS float*)F.lds;
        const int g = u >> 6, n0 = (u & 63) * 16, tid = tid0;
        const float* ps = P.pool_scale + (size_t)l * 512; const float* wb3 = P.w_branch + ((size_t)l * 4 + 3) * 512 * 1024; const float* pwl = P.pool_w + (size_t)l * 4 * 128 * 128;
        for (int i = tid; i < 128 * 16; i += 512) { const int e = i >> 4, n = i & 15; Wb[e * 16 + n] = ps[g * 128 + e] * wb3[(size_t)(g * 128 + e) * 1024 + n0 + n]; }
        __syncthreads();
        const int c = tid & 127, nh = tid >> 7; const float* pw = pwl + (size_t)(g * 128 + c) * 128;
        float acc[4];
#pragma unroll
        for (int j = 0; j < 4; ++j) acc[j] = 0.f;
        for (int e = 0; e < 128; e += 4) { const f32x4 p4 = *(const f32x4*)(pw + e);
#pragma unroll
            for (int q = 0; q < 4; ++q)
#pragma unroll
                for (int j = 0; j < 4; ++j) acc[j] += p4[q] * Wb[(e + q) * 16 + nh * 4 + j]; }
        bf16_t* Bt = (bf16_t*)(wb + WB_BR) + 3 * 512;
#pragma unroll
        for (int j = 0; j < 4; ++j) Bt[(size_t)(n0 + nh * 4 + j) * 2048 + g * 128 + c] = (bf16_t)f2bf(acc[j]);
        __syncthreads();
    }
}
__device__ __forceinline__ void ph_tables_mod(const Frame& F, const Ptrs& P) {
    const int tid0 = fresh_tid();
    { float* rc = (float*)(P.ws + WS_ROPE); float* rs = rc + 1024; float* ct = (float*)(P.ws + WS_COS);
      const int i = F.vcu * 512 + tid0;
      if (i < 1024) { const int pos = i >> 4, f = i & 15; const float inv = exp2f(-(float)f * (13.287712379549449f / 16.0f));
          float rev = (float)pos * inv * 0.15915494309189535f; rev = rev - floorf(rev);
          rc[i] = __builtin_amdgcn_cosf(rev); rs[i] = __builtin_amdgcn_sinf(rev); }
      if (i < 4096) ct[i] = __builtin_amdgcn_cosf((float)i * (1.0f / 4096.0f));
      if (i < 16384) { const int mm = i >> 7, k = i & 127, pp = mm >> 6, k1 = mm & 63, pk = k >> 6, t1 = k & 63; const float rev = (float)((k1 * t1) & 63) * (1.0f / 64.0f);
          const float c = __builtin_amdgcn_cosf(rev), sn = __builtin_amdgcn_sinf(rev);
          ((bf16_t*)(P.ws + WS_DFTM))[i] = (bf16_t)f2bf(pp == pk ? c : (pp == 0 ? sn : -sn)); } }
    for (int u = F.vcu; u < 192; u += F.G) {
        LAS float* s = (LAS float*)F.lds; LAS float* red = s + 9 * 1024;
        const int l = u / 96, j0 = (u % 96) * 64, tid = tid0;
        for (int i = tid; i < 9 * 1024; i += 512) { const int bb = i >> 10, k = i & 1023; const float v = bb < 8 ? P.c[bb * 1024 + k] : P.c_ctx[k]; s[i] = v / (1.f + expf(-v)); }
        __syncthreads();
        const int kc = tid >> 6, jj = tid & 63; float acc[9];
#pragma unroll
        for (int b = 0; b < 9; ++b) acc[b] = 0.f;
        const float* w = P.w_ada + (size_t)l * 1024 * 6144 + j0 + jj;
        for (int k = kc * 128; k < kc * 128 + 128; k += 8) { float wv[8];
#pragma unroll
            for (int q = 0; q < 8; ++q) wv[q] = w[(size_t)(k + q) * 6144];
#pragma unroll
            for (int q = 0; q < 8; ++q)
#pragma unroll
                for (int b = 0; b < 9; ++b) acc[b] += s[b * 1024 + k + q] * wv[q]; }
#pragma unroll
        for (int b = 0; b < 9; ++b) red[(kc * 9 + b) * 64 + jj] = acc[b];
        __syncthreads();
        float* mod = (float*)(P.ws + WS_MOD);
        for (int i = tid; i < 9 * 64; i += 512) { const int b = i >> 6, j = i & 63; float v = P.b_ada[l * 6144 + j0 + j];
#pragma unroll
            for (int q = 0; q < 8; ++q) v += red[(q * 9 + b) * 64 + j];
            mod[(size_t)(l * 9 + b) * 6144 + j0 + j] = v; }
        __syncthreads();
    }
}
__device__ __forceinline__ void route_row(const Ptrs& P, int r, const f32x4 (&h)[4], int lane, bool publish, LAS unsigned* lcnt, LAS int* rec, const LAS float* rwl) {
    float lg[16];
#pragma unroll
    for (int e = 0; e < 16; ++e) lg[e] = 0.f;
#pragma unroll
    for (int j = 0; j < 4; ++j) {
#pragma unroll
        for (int i = 0; i < 4; ++i) { const int kk = 4 * lane + 256 * j + i; const LAS f32x4* rw = (const LAS f32x4*)(rwl + kk * 16 + (kk >> 2) * 4); const float hv = h[j][i];
#pragma unroll
            for (int qd = 0; qd < 4; ++qd) { const f32x4 w = rw[qd]; lg[4 * qd] += hv * w.x; lg[4 * qd + 1] += hv * w.y; lg[4 * qd + 2] += hv * w.z; lg[4 * qd + 3] += hv * w.w; } }
        __builtin_amdgcn_sched_barrier(0); }
    float v8[8], v4[4], v2[2], v1;
    { const bool bit = (lane & 32) != 0;
#pragma unroll
      for (int i = 0; i < 8; ++i) { const float a = lg[i], b = lg[i + 8]; v8[i] = (bit ? b : a) + shfl_xor_l(bit ? a : b, 32, lane); } }
    { const bool bit = (lane & 16) != 0;
#pragma unroll
      for (int i = 0; i < 4; ++i) { const float a = v8[i], b = v8[i + 4]; v4[i] = (bit ? b : a) + shfl_xor_l(bit ? a : b, 16, lane); } }
    { const bool bit = (lane & 8) != 0;
#pragma unroll
      for (int i = 0; i < 2; ++i) { const float a = v4[i], b = v4[i + 2]; v2[i] = (bit ? b : a) + shfl_xor_l(bit ? a : b, 8, lane); } }
    { const bool bit = (lane & 4) != 0; const float a = v2[0], b = v2[1]; v1 = (bit ? b : a) + shfl_xor_l(bit ? a : b, 4, lane); }
    v1 += shfl_xor_l(v1, 2, lane); v1 += shfl_xor_l(v1, 1, lane);
    float bestscore = -INFINITY; int be0 = 0, be1 = 1; float ba0 = 0.f, ba1 = 0.f;
#pragma unroll
    for (int g = 0; g < 4; ++g) {
        float aff[4], sel[4];
#pragma unroll
        for (int i = 0; i < 4; ++i) { const float t = __int_as_float(__builtin_amdgcn_ds_bpermute((4 * g + i) << 4, __float_as_int(v1))); aff[i] = 1.0f / (1.0f + expf(-t)); sel[i] = aff[i] + P.router_bias[4 * g + i]; }
        int i1 = 0; float m1 = sel[0], a1 = aff[0];
#pragma unroll
        for (int i = 1; i < 4; ++i) if (sel[i] > m1) { m1 = sel[i]; a1 = aff[i]; i1 = i; }
        int i2 = -1; float m2 = -INFINITY, a2 = 0.f;
#pragma unroll
        for (int i = 0; i < 4; ++i) if (i != i1 && sel[i] > m2) { m2 = sel[i]; a2 = aff[i]; i2 = i; }
        const float score = m1 + m2;
        if (score > bestscore) { bestscore = score; be0 = 4 * g + i1; be1 = 4 * g + i2; ba0 = a1; ba1 = a2; }
    }
    if (lane == 0 && publish) {
        const int p0 = (int)__hip_atomic_fetch_add(lcnt + be0, 1u, __ATOMIC_RELAXED, __HIP_MEMORY_SCOPE_WORKGROUP), p1 = (int)__hip_atomic_fetch_add(lcnt + be1, 1u, __ATOMIC_RELAXED, __HIP_MEMORY_SCOPE_WORKGROUP);
        const float inv = 1.0f / (ba0 + ba1);
        rec[0] = r; rec[1] = be0; rec[2] = p0; rec[3] = be1; rec[4] = p1; rec[5] = __float_as_int(ba0 * inv); rec[6] = __float_as_int(ba1 * inv);
    }
}
template <int MODE> __device__ __forceinline__ void ph_norm(const Frame& F, const Ptrs& P, int l, int nrows) {
    constexpr int NRW = MODE == 2 ? 2 : 4;
    const int lane = fresh_lane();
    const int stride = F.G * NWAVES;
    LAS unsigned* lcnt = (LAS unsigned*)F.lds; LAS unsigned* gbase = lcnt + 16; LAS int* recs = (LAS int*)(F.lds + 256);
    const LAS float* rwl = (const LAS float*)(F.lds + 8192);
    if (MODE == 2) { if (F.wave == 0 && lane < 16) lcnt[lane] = 0u;
        { const int tid = F.wave * 64 + lane; LAS f32x4* d = (LAS f32x4*)(F.lds + 8192);
#pragma unroll
          for (int i = 0; i < 8; ++i) { const int idx = tid + 512 * i, kk = idx >> 2; d[idx + (kk >> 2)] = ((const f32x4*)P.router_w)[idx]; } }
        __syncthreads(); }
    int it = 0;
    for (int rb = F.vcu * NWAVES + F.wave; rb < nrows; rb += NRW * stride, ++it) {
        int rr[NRW];
#pragma unroll
        for (int q = 0; q < NRW; ++q) rr[q] = rb + q * stride < nrows ? rb + q * stride : rb;
        f32x4 v[NRW][4];
#pragma unroll
        for (int q = 0; q < NRW; ++q) { const int r = rr[q];
            if (MODE == 0) { const f32x4* xr = (const f32x4*)xin_row(P, r) + lane;
#pragma unroll
                for (int j = 0; j < 4; ++j) v[q][j] = xr[64 * j]; }
            else { const f32x4* xr = (const f32x4*)x1_row(P, r) + lane;
#pragma unroll
                for (int j = 0; j < 4; ++j) v[q][j] = xr[64 * j]; } }
        if (MODE == 1) {
#pragma unroll
            for (int q = 0; q < NRW; ++q) { const int r = rr[q]; const int bb = row_bb(r); const f32x4* g2 = (const f32x4*)mod_vec(P, l - 1, bb, 5) + lane;
                const u32x2* m0 = (const u32x2*)((const bf16_t*)(P.ws + WS_MO) + (size_t)r * D) + lane; const u32x2* m1 = (const u32x2*)((const bf16_t*)(P.ws + WS_MO) + (size_t)(R + r) * D) + lane;
#pragma unroll
                for (int j = 0; j < 4; ++j) { const u32x2 a = m0[64 * j], b = m1[64 * j]; const f32x4 g = g2[64 * j];
                    v[q][j].x += g.x * (lo16(a.x) + lo16(b.x)); v[q][j].y += g.y * (hi16(a.x) + hi16(b.x)); v[q][j].z += g.z * (lo16(a.y) + lo16(b.y)); v[q][j].w += g.w * (hi16(a.y) + hi16(b.y)); } }
#pragma unroll
            for (int q = 0; q < NRW; ++q) if (q == 0 || rr[q] != rr[0]) { f32x4* xr = (f32x4*)x1_row(P, rr[q]) + lane;
#pragma unroll
                for (int j = 0; j < 4; ++j) xr[64 * j] = v[q][j]; }
        }
        float ss[NRW];
#pragma unroll
        for (int q = 0; q < NRW; ++q) { ss[q] = 0.f;
#pragma unroll
            for (int j = 0; j < 4; ++j) ss[q] += (v[q][j].x * v[q][j].x + v[q][j].y * v[q][j].y) + (v[q][j].z * v[q][j].z + v[q][j].w * v[q][j].w); }
#pragma unroll
        for (int o = 1; o < 64; o <<= 1) {
#pragma unroll
            for (int q = 0; q < NRW; ++q) ss[q] += shfl_xor_l(ss[q], o, lane); }
        const f32x4* gn = (const f32x4*)((MODE == 2 ? P.norm2 : P.norm1) + (size_t)l * D) + lane;
#pragma unroll
        for (int q = 0; q < NRW; ++q) { const int r = rr[q]; const int bb = row_bb(r);
            if (q > 0 && r == rr[0]) continue;
            const float rstd = 1.0f / sqrtf(ss[q] * (1.0f / D) + EPS);
            const f32x4* sh = (const f32x4*)mod_vec(P, l, bb, MODE == 2 ? 3 : 0) + lane;
            const f32x4* sc = (const f32x4*)mod_vec(P, l, bb, MODE == 2 ? 4 : 1) + lane;
            u32x2* o = (u32x2*)((bf16_t*)(P.ws + WS_H) + (size_t)r * D) + lane;
#pragma unroll
            for (int j = 0; j < 4; ++j) { const f32x4 g = gn[64 * j], a = sh[64 * j], b = sc[64 * j];
                v[q][j] = (v[q][j] * rstd * g) * (b + 1.0f) + a;
                u32x2 w; w.x = cvtpk(v[q][j].x, v[q][j].y); w.y = cvtpk(v[q][j].z, v[q][j].w); o[64 * j] = w; } }
        if (MODE == 2) { LAS int* rec = recs + (F.wave * 24 + 2 * it) * 8;
            route_row(P, rr[0], v[0], lane, true, lcnt, rec, rwl); __builtin_amdgcn_sched_barrier(0);
            if (lane == 0 && rr[1] == rr[0]) rec[8] = -1;
            route_row(P, rr[1], v[1], lane, rr[1] != rr[0], lcnt, rec + 8, rwl); }
    }
    if (MODE == 2) {
        __syncthreads();
        const int tid = F.wave * 64 + lane;
        if (tid < 16) { const unsigned c = lcnt[tid]; gbase[tid] = c ? atomicAdd((unsigned*)(P.ws + WS_CTL) + CW_CNT + 1024 * l + 64 * tid, c) : 0u; }
        __syncthreads();
        if (lane == 0) for (int k = 0; k < 2 * it; ++k) { const LAS int* rec = recs + (F.wave * 24 + k) * 8; const int r = rec[0]; if (r < 0) continue;
            int* tokl = (int*)(P.ws + WS_TOKL); float* wl = (float*)(P.ws + WS_WL);
            const size_t i0 = (size_t)rec[1] * R + rec[2] + gbase[rec[1]], i1 = (size_t)rec[3] * R + rec[4] + gbase[rec[3]];
            tokl[i0] = 2 * r; wl[i0] = __int_as_float(rec[5]); tokl[i1] = 2 * r + 1; wl[i1] = __int_as_float(rec[6]); }
        __syncthreads();
    }
}
__device__ __forceinline__ void ph_kprep(const Frame& F, const Ptrs& P, int l) {
    const int lane = fresh_lane();
    const float* rc = (const float*)(P.ws + WS_ROPE); const float* rs = rc + 1024;
    const int hs = (lane >> 3) & 3, chunk = lane & 7, col = (hs < 2 ? C_KB + hs * 64 : C_KW + (hs - 2) * 64) + chunk * 8;
    const f32x4 g0 = *(const f32x4*)(P.k_gain + l * 64 + chunk * 8), g1 = *(const f32x4*)(P.k_gain + l * 64 + chunk * 8 + 4);
    const int a = chunk >> 2, fi = (chunk & 1) * 8; const bool second = (chunk & 2) != 0;
    const int npair = R / 2, stride = F.G * NWAVES;
    for (int pr0 = F.vcu * NWAVES + F.wave; pr0 < npair; pr0 += 4 * stride) {
        u32x4 w[4];
#pragma unroll
        for (int q = 0; q < 4; ++q) { const int pr = pr0 + q * stride; const int r = 2 * (pr < npair ? pr : pr0) + (lane >> 5); w[q] = *(const u32x4*)((const bf16_t*)(P.ws + WS_U) + (size_t)r * NIN + col); }
#pragma unroll
        for (int q = 0; q < 4; ++q) { const int pr = pr0 + q * stride; if (pr >= npair) break;
            const int r = 2 * pr + (lane >> 5);
            float x[8] = {lo16(w[q].x), hi16(w[q].x), lo16(w[q].y), hi16(w[q].y), lo16(w[q].z), hi16(w[q].z), lo16(w[q].w), hi16(w[q].w)};
            if (hs < 2) { float ss = 0.f;
#pragma unroll
                for (int j = 0; j < 8; ++j) ss += x[j] * x[j];
                ss += shfl_xor_l(ss, 1, lane); ss += shfl_xor_l(ss, 2, lane); ss += shfl_xor_l(ss, 4, lane);
                const float rstd = 1.0f / sqrtf(ss * (1.0f / 64.0f) + EPS);
                x[0] *= rstd * g0.x; x[1] *= rstd * g0.y; x[2] *= rstd * g0.z; x[3] *= rstd * g0.w; x[4] *= rstd * g1.x; x[5] *= rstd * g1.y; x[6] *= rstd * g1.z; x[7] *= rstd * g1.w; }
            if (r < RL) { const int t = r & (T - 1), pos = a ? (t & 63) : (t >> 6);
                const f32x4 c0 = *(const f32x4*)(rc + pos * 16 + fi), c1 = *(const f32x4*)(rc + pos * 16 + fi + 4), s0 = *(const f32x4*)(rs + pos * 16 + fi), s1 = *(const f32x4*)(rs + pos * 16 + fi + 4);
                const float cs[8] = {c0.x, c0.y, c0.z, c0.w, c1.x, c1.y, c1.z, c1.w}, sn[8] = {s0.x, s0.y, s0.z, s0.w, s1.x, s1.y, s1.z, s1.w};
#pragma unroll
                for (int j = 0; j < 8; ++j) { const float y = shfl_xor_l(x[j], 2, lane); x[j] = second ? x[j] * cs[j] + y * sn[j] : x[j] * cs[j] - y * sn[j]; } }
            u32x4 o; o.x = cvtpk(x[0], x[1]); o.y = cvtpk(x[2], x[3]); o.z = cvtpk(x[4], x[5]); o.w = cvtpk(x[6], x[7]);
            *(u32x4*)((bf16_t*)(P.ws + WS_U) + (size_t)r * NIN + col) = o; }
    }
}
__device__ __forceinline__ void ph_pool(const Frame& F, const Ptrs& P, int nrows) {
    const int tid0 = fresh_tid();
    for (int i = F.vcu * 512 + tid0; i < nrows * 64; i += F.G * 512) {
        const int r = i >> 6, c8 = (i & 63) * 8;
        const bool lat = r < RL; const int Ts = lat ? T : TC; const int t = lat ? (r & (T - 1)) : ((r - RL) & (TC - 1)); const int r0 = r - t;
        const int g = c8 >> 7, hw = 1 << g;
        const int lo = t - hw < 0 ? 0 : t - hw, hi = t + hw > Ts ? Ts : t + hw;
        const bf16_t* U = (const bf16_t*)(P.ws + WS_U) + C_P + c8;
        u32x4 wv[16];
#pragma unroll
        for (int k = 0; k < 16; ++k) { const int tt = t - 8 + k; const bool ok = tt >= lo && tt < hi; wv[k] = *(const u32x4*)(U + (size_t)(r0 + (ok ? tt : t)) * NIN); }
        float s[8];
#pragma unroll
        for (int j = 0; j < 8; ++j) s[j] = 0.f;
#pragma unroll
        for (int k = 0; k < 16; ++k) { const int tt = t - 8 + k; const float f = (tt >= lo && tt < hi) ? 1.f : 0.f; const u32x4 w = wv[k];
            s[0] += f * lo16(w.x); s[1] += f * hi16(w.x); s[2] += f * lo16(w.y); s[3] += f * hi16(w.y); s[4] += f * lo16(w.z); s[5] += f * hi16(w.z); s[6] += f * lo16(w.w); s[7] += f * hi16(w.w); }
        const u32x4 w = wv[8]; const float inv = 1.0f / (float)(hi - lo);
        u32x4 o; o.x = cvtpk(s[0] * inv - lo16(w.x), s[1] * inv - hi16(w.x)); o.y = cvtpk(s[2] * inv - lo16(w.y), s[3] * inv - hi16(w.y));
        o.z = cvtpk(s[4] * inv - lo16(w.z), s[5] * inv - hi16(w.z)); o.w = cvtpk(s[6] * inv - lo16(w.w), s[7] * inv - hi16(w.w));
        *(u32x4*)((bf16_t*)(P.ws + WS_BR) + (size_t)r * NBR + 1536 + c8) = o;
    }
}
__device__ __forceinline__ void ph_final(const Frame& F, const Ptrs& P) {
    const int lane = fresh_lane(); const int stride = F.G * NWAVES;
    for (int rb = F.vcu * NWAVES + F.wave; rb < RL; rb += 4 * stride) {
        f32x4 v[4][4]; float ss[4];
#pragma unroll
        for (int q = 0; q < 4; ++q) { const int r = rb + q * stride < RL ? rb + q * stride : rb; const int bb = row_bb(r);
            const f32x4* xr = (const f32x4*)(P.out + (size_t)r * D) + lane; const f32x4* g2 = (const f32x4*)mod_vec(P, 1, bb, 5) + lane;
            const u32x2* m0 = (const u32x2*)((const bf16_t*)(P.ws + WS_MO) + (size_t)r * D) + lane; const u32x2* m1 = (const u32x2*)((const bf16_t*)(P.ws + WS_MO) + (size_t)(R + r) * D) + lane;
            ss[q] = 0.f;
#pragma unroll
            for (int j = 0; j < 4; ++j) { v[q][j] = xr[64 * j]; const u32x2 a = m0[64 * j], b = m1[64 * j]; const f32x4 g = g2[64 * j];
                v[q][j].x += g.x * (lo16(a.x) + lo16(b.x)); v[q][j].y += g.y * (hi16(a.x) + hi16(b.x)); v[q][j].z += g.z * (lo16(a.y) + lo16(b.y)); v[q][j].w += g.w * (hi16(a.y) + hi16(b.y));
                ss[q] += (v[q][j].x * v[q][j].x + v[q][j].y * v[q][j].y) + (v[q][j].z * v[q][j].z + v[q][j].w * v[q][j].w); } }
#pragma unroll
        for (int o = 1; o < 64; o <<= 1) {
#pragma unroll
            for (int q = 0; q < 4; ++q) ss[q] += shfl_xor_l(ss[q], o, lane); }
        const f32x4* gn = (const f32x4*)P.norm_f + lane;
#pragma unroll
        for (int q = 0; q < 4; ++q) { const int r = rb + q * stride; if (r >= RL) continue;
            const float rstd = 1.0f / sqrtf(ss[q] * (1.0f / D) + EPS); f32x4* xr = (f32x4*)(P.out + (size_t)r * D) + lane;
#pragma unroll
            for (int j = 0; j < 4; ++j) xr[64 * j] = v[q][j] * rstd * gn[64 * j]; }
    }
}

__device__ __forceinline__ void ph_fourier_ref(const Frame& F, const Ptrs& P, int Ts, int latent) {
    const int tid = fresh_tid();
    LAS float* Zr = (LAS float*)F.lds; LAS float* Zi = Zr + 16 * 64; LAS float* Ct = Zi + 16 * 64; LAS float* St = Ct + 64 * 17;
    const bf16_t* U = (const bf16_t*)(P.ws + WS_U); const float* ct = (const float*)(P.ws + WS_COS);
    const int nkt = Ts / 64, NU = 8 * nkt * 8, step = 4096 / Ts;
    const int tk = tid >> 4, tc = tid & 15;
    for (int u = F.vcu; u < NU; u += F.G) {
        const int cht = u & 7, kt = (u >> 3) % nkt, b = (u >> 3) / nkt, k0 = kt * 64, ch0 = cht * 64;
        const int rbase = latent ? b * T : RL + b * TC;
        float acc[2][4];
#pragma unroll
        for (int i = 0; i < 2; ++i)
#pragma unroll
            for (int j = 0; j < 4; ++j) acc[i][j] = 0.f;
        for (int t0 = 0; t0 < Ts; t0 += 16) {
            __syncthreads();
            if (tid < 256) { const int tt = tid >> 4, c4 = (tid & 15) * 4; const bf16_t* zp = U + (size_t)(rbase + t0 + tt) * NIN + ch0 + c4;
              const u32x2 a = *(const u32x2*)(zp + C_ZR), bq = *(const u32x2*)(zp + C_ZI);
              Zr[tt * 64 + c4] = lo16(a.x); Zr[tt * 64 + c4 + 1] = hi16(a.x); Zr[tt * 64 + c4 + 2] = lo16(a.y); Zr[tt * 64 + c4 + 3] = hi16(a.y);
              Zi[tt * 64 + c4] = lo16(bq.x); Zi[tt * 64 + c4 + 1] = hi16(bq.x); Zi[tt * 64 + c4 + 2] = lo16(bq.y); Zi[tt * 64 + c4 + 3] = hi16(bq.y); }
#pragma unroll
            for (int i = 0; i < 2; ++i) { const int e = tid * 2 + i, k = e >> 4, tt = e & 15; const int ang = (((k0 + k) * (t0 + tt)) & (Ts - 1)) * step;
                Ct[k * 17 + tt] = ct[ang]; St[k * 17 + tt] = ct[(ang - 1024) & 4095]; }
            __syncthreads();
#pragma unroll 2
            for (int tt = 0; tt < 16; ++tt) { float zr[4], zi[4];
#pragma unroll
                for (int j = 0; j < 4; ++j) { zr[j] = Zr[tt * 64 + tc * 4 + j]; zi[j] = Zi[tt * 64 + tc * 4 + j]; }
#pragma unroll
                for (int i = 0; i < 2; ++i) { const float c = Ct[(tk * 2 + i) * 17 + tt], sn = St[(tk * 2 + i) * 17 + tt];
#pragma unroll
                    for (int j = 0; j < 4; ++j) acc[i][j] += c * zr[j] + sn * zi[j]; } }
        }
        const float sc = 1.0f / sqrtf((float)Ts);
        bf16_t* BR = (bf16_t*)(P.ws + WS_BR);
#pragma unroll
        for (int i = 0; i < 2; ++i) { u32x2 w; w.x = pk2(acc[i][0] * sc, acc[i][1] * sc); w.y = pk2(acc[i][2] * sc, acc[i][3] * sc);
            *(u32x2*)(BR + (size_t)(rbase + k0 + tk * 2 + i) * NBR + ch0 + tc * 4) = w; }
        __syncthreads();
    }
}

typedef float f32x16 __attribute__((ext_vector_type(16)));
typedef short v4i16_t __attribute__((ext_vector_type(4)));
constexpr float ATT_THR = 4.0f;
constexpr int AT_ROWB = 144, AT_TILEB = 64 * AT_ROWB;
constexpr int AT_VROWB = 192, AT_VTILEB = 64 * AT_VROWB;
constexpr int AT_STAGEB = 2 * AT_TILEB + 2 * AT_VTILEB;
#define AT_SB() __builtin_amdgcn_sched_barrier(0)
template <bool FIXED> __device__ __forceinline__ void at_qk1(const LAS unsigned char* Kt, int kf_off, const bf16x8 (&qr)[4], const f32x16& negm_, f32x16& p0, f32x16& p1) {
    f32x16 zc;
#pragma unroll
    for (int r = 0; r < 16; ++r) zc[r] = 0.f;
    const f32x16& negm = FIXED ? zc : negm_;
    bf16x8 ka[8];
#pragma unroll
    for (int d0 = 0; d0 < 4; ++d0) { ka[2 * d0] = *(const LAS bf16x8*)(Kt + kf_off + d0 * 32); ka[2 * d0 + 1] = *(const LAS bf16x8*)(Kt + kf_off + 32 * AT_ROWB + d0 * 32); }
    p0 = __builtin_amdgcn_mfma_f32_32x32x16_bf16(ka[0], qr[0], negm, 0, 0, 0); p1 = __builtin_amdgcn_mfma_f32_32x32x16_bf16(ka[1], qr[0], negm, 0, 0, 0);
#pragma unroll
    for (int d0 = 1; d0 < 4; ++d0) { p0 = __builtin_amdgcn_mfma_f32_32x32x16_bf16(ka[2 * d0], qr[d0], p0, 0, 0, 0); p1 = __builtin_amdgcn_mfma_f32_32x32x16_bf16(ka[2 * d0 + 1], qr[d0], p1, 0, 0, 0); }
}
__device__ __forceinline__ void at_vread(const LAS unsigned char* vp, v4i16_t (&f)[4]) {
    f[0] = __builtin_amdgcn_ds_read_tr16_b64_v4i16((LAS v4i16_t*)(vp)); f[1] = __builtin_amdgcn_ds_read_tr16_b64_v4i16((LAS v4i16_t*)(vp + 8 * AT_VROWB));
    f[2] = __builtin_amdgcn_ds_read_tr16_b64_v4i16((LAS v4i16_t*)(vp + 64)); f[3] = __builtin_amdgcn_ds_read_tr16_b64_v4i16((LAS v4i16_t*)(vp + 8 * AT_VROWB + 64));
}
__device__ __forceinline__ bf16x8 at_ppack(const f32x16& p, int sx) { u32x4 pw; pw.x = cvtpk(p[8 * sx], p[8 * sx + 1]); pw.y = cvtpk(p[8 * sx + 2], p[8 * sx + 3]); pw.z = cvtpk(p[8 * sx + 4], p[8 * sx + 5]); pw.w = cvtpk(p[8 * sx + 6], p[8 * sx + 7]); return __builtin_bit_cast(bf16x8, pw); }
__device__ __forceinline__ void at_pvmm(const v4i16_t (&f)[4], const bf16x8 pf, f32x16& o0, f32x16& o1) {
    const bf16x8 v0 = (bf16x8){f[0][0], f[0][1], f[0][2], f[0][3], f[1][0], f[1][1], f[1][2], f[1][3]}, v1 = (bf16x8){f[2][0], f[2][1], f[2][2], f[2][3], f[3][0], f[3][1], f[3][2], f[3][3]};
    o0 = __builtin_amdgcn_mfma_f32_32x32x16_bf16(v0, pf, o0, 0, 0, 0); o1 = __builtin_amdgcn_mfma_f32_32x32x16_bf16(v1, pf, o1, 0, 0, 0);
}
__device__ __forceinline__ float at_exp8(f32x16& p, int sx) { float rs = 0.f;
#pragma unroll
    for (int j = 0; j < 8; ++j) { p[8 * sx + j] = __builtin_amdgcn_exp2f(p[8 * sx + j]); rs += p[8 * sx + j]; }
    return rs; }
template <bool FIXED> __device__ __forceinline__ float at_slot(const LAS unsigned char* Vt, const LAS unsigned char* Kn, const bool hasnext, int kf_off, int vf_off, const bf16x8 (&qr)[4], const f32x16& negm_,
                                         f32x16& pc0, f32x16& pc1, f32x16& pn0, f32x16& pn1, f32x16& o0, f32x16& o1) {
    f32x16 zc;
#pragma unroll
    for (int r = 0; r < 16; ++r) zc[r] = 0.f;
    const f32x16& negm = FIXED ? zc : negm_;
    v4i16_t fA[4], fB[4]; bf16x8 ka0, ka1, kb0, kb1; float rs;
#define AT_KLD(A0, A1, d0) do { A0 = *(const LAS bf16x8*)(Kn + kf_off + (d0) * 32); A1 = *(const LAS bf16x8*)(Kn + kf_off + 32 * AT_ROWB + (d0) * 32); } while (0)
    if (FIXED) AT_KLD(ka0, ka1, 0);
    at_vread(Vt + vf_off, fA); rs = at_exp8(pc0, 0); AT_SB();
    at_vread(Vt + vf_off + 16 * AT_VROWB, fB); if (FIXED) AT_KLD(kb0, kb1, 1); else AT_KLD(ka0, ka1, 0);
    if (hasnext) { pn0 = __builtin_amdgcn_mfma_f32_32x32x16_bf16(ka0, qr[0], negm, 0, 0, 0); pn1 = __builtin_amdgcn_mfma_f32_32x32x16_bf16(ka1, qr[0], negm, 0, 0, 0); }
    at_pvmm(fA, at_ppack(pc0, 0), o0, o1); rs += at_exp8(pc0, 1); AT_SB();
    at_vread(Vt + vf_off + 32 * AT_VROWB, fA); if (FIXED) AT_KLD(ka0, ka1, 2); else AT_KLD(kb0, kb1, 1);
    if (hasnext) { pn0 = __builtin_amdgcn_mfma_f32_32x32x16_bf16(kb0, qr[1], pn0, 0, 0, 0); pn1 = __builtin_amdgcn_mfma_f32_32x32x16_bf16(kb1, qr[1], pn1, 0, 0, 0); }
    at_pvmm(fB, at_ppack(pc0, 1), o0, o1); rs += at_exp8(pc1, 0); AT_SB();
    at_vread(Vt + vf_off + 48 * AT_VROWB, fB); if (FIXED) AT_KLD(kb0, kb1, 3); else AT_KLD(ka0, ka1, 2);
    if (hasnext) { pn0 = __builtin_amdgcn_mfma_f32_32x32x16_bf16(ka0, qr[2], pn0, 0, 0, 0); pn1 = __builtin_amdgcn_mfma_f32_32x32x16_bf16(ka1, qr[2], pn1, 0, 0, 0); }
    at_pvmm(fA, at_ppack(pc1, 0), o0, o1); rs += at_exp8(pc1, 1); AT_SB();
    if (!FIXED) AT_KLD(kb0, kb1, 3);
    if (hasnext) { pn0 = __builtin_amdgcn_mfma_f32_32x32x16_bf16(kb0, qr[3], pn0, 0, 0, 0); pn1 = __builtin_amdgcn_mfma_f32_32x32x16_bf16(kb1, qr[3], pn1, 0, 0, 0); }
    at_pvmm(fB, at_ppack(pc1, 1), o0, o1);
#undef AT_KLD
    return rs;
}
template <int MODE, bool FIXED> __device__ __forceinline__ void ph_attn_impl(const Frame& F, const Ptrs& P, int l) {
    const bool latq = MODE < 2; const bool winm = (MODE == 1 || MODE == 3);
    const int NU = latq ? 1024 : 64;
    LAS unsigned char* Lb = F.lds;
    constexpr bool fixedref = FIXED;
    for (int u = F.vcu; u < NU; u += F.G) {
        const int lane = fresh_lane(), tid = F.wave * 64 + lane, r32 = lane & 31, hi = lane >> 5;
        const bf16_t* U = (const bf16_t*)(P.ws + WS_U);
        const int st_off = (tid >> 3) * AT_ROWB + (tid & 7) * 16;
        const int kf_off = r32 * AT_ROWB + hi * 16;
        const int sv_off = (tid >> 3) * AT_VROWB + (tid & 7) * 16;
        const int vf_off = (4 * hi + ((lane & 15) >> 2)) * AT_VROWB + (((lane >> 4) & 1) * 16 + (lane & 3) * 4) * 2;
        const int qb = latq ? (u & 63) : (u & 3), g = latq ? ((u >> 6) & 1) : ((u >> 2) & 1), b = latq ? (u >> 7) : (u >> 3);
        const int tq0 = qb * 64, hq = 4 * g + (F.wave >> 1), tq = tq0 + 32 * (F.wave & 1) + r32;
        const int qrow = latq ? b * T + tq : RL + b * TC + tq;
        const int qcol = (winm ? C_QW : C_QB) + hq * 64, kcol = (winm ? C_KW : C_KB) + g * 64, vcol = (winm ? C_VW : C_VB) + g * 64;
        int lt_lo = 0, lt_hi = 0;
        if (MODE == 0) { lt_lo = 0; lt_hi = T / 64; }
        if (MODE == 1) { lt_lo = (tq0 - 128 < 0 ? 0 : tq0 - 128) / 64; lt_hi = (tq0 + 192 > T ? T : tq0 + 192) / 64; }
        const int ntiles = 4 + (lt_hi - lt_lo), npairs = (ntiles + 1) >> 1;
        bf16x8 qr[4];
        {
            float x[4][8];
#pragma unroll
            for (int d0 = 0; d0 < 4; ++d0) { const u32x4 wq = *(const u32x4*)(U + (size_t)qrow * NIN + qcol + d0 * 16 + hi * 8);
                x[d0][0] = lo16(wq.x); x[d0][1] = hi16(wq.x); x[d0][2] = lo16(wq.y); x[d0][3] = hi16(wq.y); x[d0][4] = lo16(wq.z); x[d0][5] = hi16(wq.z); x[d0][6] = lo16(wq.w); x[d0][7] = hi16(wq.w); }
            if (!winm) { float ss = 0.f;
#pragma unroll
                for (int d0 = 0; d0 < 4; ++d0)
#pragma unroll
                    for (int j = 0; j < 8; ++j) ss += x[d0][j] * x[d0][j];
                ss += shfl_xor_l(ss, 32, lane);
                const float rstd = 1.0f / sqrtf(ss * (1.0f / 64.0f) + EPS);
#pragma unroll
                for (int d0 = 0; d0 < 4; ++d0) { const f32x4 ga = *(const f32x4*)(P.q_gain + l * 64 + d0 * 16 + hi * 8), gb = *(const f32x4*)(P.q_gain + l * 64 + d0 * 16 + hi * 8 + 4);
                    x[d0][0] *= rstd * ga.x; x[d0][1] *= rstd * ga.y; x[d0][2] *= rstd * ga.z; x[d0][3] *= rstd * ga.w; x[d0][4] *= rstd * gb.x; x[d0][5] *= rstd * gb.y; x[d0][6] *= rstd * gb.z; x[d0][7] *= rstd * gb.w; } }
            if (latq) { const float* rc = (const float*)(P.ws + WS_ROPE); const float* rs = rc + 1024;
#pragma unroll
                for (int a = 0; a < 2; ++a) { const int pos = a ? (tq & 63) : (tq >> 6);
                    const f32x4 c0 = *(const f32x4*)(rc + pos * 16 + hi * 8), c1 = *(const f32x4*)(rc + pos * 16 + hi * 8 + 4), s0 = *(const f32x4*)(rs + pos * 16 + hi * 8), s1 = *(const f32x4*)(rs + pos * 16 + hi * 8 + 4);
                    const float cs[8] = {c0.x, c0.y, c0.z, c0.w, c1.x, c1.y, c1.z, c1.w}, sn[8] = {s0.x, s0.y, s0.z, s0.w, s1.x, s1.y, s1.z, s1.w};
#pragma unroll
                    for (int j = 0; j < 8; ++j) { const float x1 = x[2 * a][j], x2 = x[2 * a + 1][j]; x[2 * a][j] = x1 * cs[j] - x2 * sn[j]; x[2 * a + 1][j] = x2 * cs[j] + x1 * sn[j]; } } }
#pragma unroll
            for (int d0 = 0; d0 < 4; ++d0) { u32x4 wq; wq.x = cvtpk(x[d0][0] * QSCALE, x[d0][1] * QSCALE); wq.y = cvtpk(x[d0][2] * QSCALE, x[d0][3] * QSCALE); wq.z = cvtpk(x[d0][4] * QSCALE, x[d0][5] * QSCALE); wq.w = cvtpk(x[d0][6] * QSCALE, x[d0][7] * QSCALE);
                qr[d0] = __builtin_bit_cast(bf16x8, wq); }
        }
        f32x16 o0, o1, negm;
#pragma unroll
        for (int r = 0; r < 16; ++r) { o0[r] = 0.f; o1[r] = 0.f; negm[r] = 0.f; }
        float mhat = 0.f, lsum = 0.f;
#define AT_KROW(ti) ((ti) < 4 ? RL + b * TC + (ti) * 64 : b * T + (lt_lo + (ti) - 4) * 64)
        u32x4 ka, va, kb2, vb2;
#define AT_LOADPAIR(pp) do { const int na_ = 2 * (pp), nb_ = (2 * (pp) + 1 < ntiles) ? 2 * (pp) + 1 : na_; \
            const int r0_ = AT_KROW(na_) + (tid >> 3), r1_ = AT_KROW(nb_) + (tid >> 3); const int co_ = (tid & 7) * 8; \
            ka = *(const u32x4*)(U + (size_t)r0_ * NIN + kcol + co_); va = *(const u32x4*)(U + (size_t)r0_ * NIN + vcol + co_); \
            kb2 = *(const u32x4*)(U + (size_t)r1_ * NIN + kcol + co_); vb2 = *(const u32x4*)(U + (size_t)r1_ * NIN + vcol + co_); } while (0)
#define AT_WRITEPAIR(off) do { *(LAS u32x4*)(Lb + (off) + st_off) = ka; *(LAS u32x4*)(Lb + (off) + AT_TILEB + st_off) = kb2; \
            *(LAS u32x4*)(Lb + (off) + 2 * AT_TILEB + sv_off) = va; *(LAS u32x4*)(Lb + (off) + 2 * AT_TILEB + AT_VTILEB + sv_off) = vb2; } while (0)
#define AT_MASK(ti, P0, P1) do { if (MODE == 1) { if ((ti) >= ntiles) { _Pragma("unroll") for (int r = 0; r < 16; ++r) { P0[r] = -INFINITY; P1[r] = -INFINITY; } } \
            else if ((ti) >= 4) { const int kb0_ = (lt_lo + (ti) - 4) * 64, qlo_ = tq0 + 32 * (F.wave & 1); \
                if (kb0_ + 63 - qlo_ > 128 || qlo_ + 31 - kb0_ > 128) { const int kp0_ = kb0_ + 4 * hi - tq; \
                    _Pragma("unroll") for (int r = 0; r < 16; ++r) { const int dl_ = kp0_ + (r & 3) + 8 * (r >> 2); \
                        if (dl_ > 128 || dl_ < -128) P0[r] = -INFINITY; if (dl_ + 32 > 128 || dl_ + 32 < -128) P1[r] = -INFINITY; } } } } } while (0)
#define AT_REF(first, P0, P1) do { if (!fixedref) { float mx_ = fmaxf(P0[0], P1[0]); \
            _Pragma("unroll") for (int r = 1; r < 16; ++r) mx_ = fmaxf(mx_, fmaxf(P0[r], P1[r])); \
            mx_ = fmaxf(mx_, shfl_xor_l(mx_, 32, lane)); \
            if ((first) || __any(mx_ > ATT_THR)) { const float dl_ = (first) ? mx_ : fmaxf(mx_, 0.f); mhat += dl_; \
                const float al_ = __builtin_amdgcn_exp2f(-dl_); lsum *= al_; \
                _Pragma("unroll") for (int r = 0; r < 16; ++r) { P0[r] -= dl_; P1[r] -= dl_; o0[r] *= al_; o1[r] *= al_; negm[r] = -mhat; } } } } while (0)
        AT_LOADPAIR(0); AT_WRITEPAIR(0);
        if (npairs > 1) { AT_LOADPAIR(1); AT_WRITEPAIR(AT_STAGEB); }
        if (npairs > 2) AT_LOADPAIR(2);
        __syncthreads();
        f32x16 pc0, pc1, pn0, pn1;
        at_qk1<FIXED>(Lb, kf_off, qr, negm, pc0, pc1);
        AT_REF(true, pc0, pc1);
#pragma unroll
        for (int r = 0; r < 16; ++r) { pn0[r] = 0.f; pn1[r] = 0.f; }
        int scur = 0, snxt = AT_STAGEB, swr = 2 * AT_STAGEB;
        for (int tp = 0; tp < npairs; ++tp) {
            if (tp + 2 < npairs) { AT_WRITEPAIR(swr); if (tp + 3 < npairs) AT_LOADPAIR(tp + 3); }
            lsum += at_slot<FIXED>(Lb + scur + 2 * AT_TILEB, Lb + scur + AT_TILEB, true, kf_off, vf_off, qr, negm, pc0, pc1, pn0, pn1, o0, o1);
            AT_MASK(2 * tp + 1, pn0, pn1);
            AT_REF(false, pn0, pn1);
            const bool more = tp + 1 < npairs;
            lsum += at_slot<FIXED>(Lb + scur + 2 * AT_TILEB + AT_VTILEB, Lb + snxt, more, kf_off, vf_off, qr, negm, pn0, pn1, pc0, pc1, o0, o1);
            if (more) { AT_MASK(2 * tp + 2, pc0, pc1); AT_REF(false, pc0, pc1); }
            __syncthreads();
            { const int t_ = scur; scur = snxt; snxt = swr; swr = t_; }
        }
#undef AT_KROW
#undef AT_LOADPAIR
#undef AT_WRITEPAIR
#undef AT_MASK
#undef AT_REF
        lsum += shfl_xor_l(lsum, 32, lane);
        if (winm) lsum += exp2f(P.sink[l * 8 + hq] * LOG2E - mhat);
        const float inv = 1.0f / lsum;
        bf16_t* op = (bf16_t*)(P.ws + WS_BR) + (size_t)qrow * NBR + (winm ? 1024 : 512) + hq * 64 + 4 * hi;
#pragma unroll
        for (int gq = 0; gq < 4; ++gq) {
            u32x2 w0, w1; w0.x = cvtpk(o0[4 * gq] * inv, o0[4 * gq + 1] * inv); w0.y = cvtpk(o0[4 * gq + 2] * inv, o0[4 * gq + 3] * inv);
            w1.x = cvtpk(o1[4 * gq] * inv, o1[4 * gq + 1] * inv); w1.y = cvtpk(o1[4 * gq + 2] * inv, o1[4 * gq + 3] * inv);
            *(u32x2*)(op + 8 * gq) = w0; *(u32x2*)(op + 32 + 8 * gq) = w1; }
    }
}

template <int MODE> __device__ __forceinline__ void ph_attn(const Frame& F, const Ptrs& P, int l) {
    if (MODE == 1 || MODE == 3) { ph_attn_impl<MODE, false>(F, P, l); return; }
    const int lane = fresh_lane();
    float mq = fabsf(P.q_gain[l * 64 + lane]), mk = fabsf(P.k_gain[l * 64 + lane]);
#pragma unroll
    for (int o = 1; o < 64; o <<= 1) { mq = fmaxf(mq, shfl_xor_l(mq, o, lane)); mk = fmaxf(mk, shfl_xor_l(mk, o, lane)); }
    const float sbound = 64.0f * QSCALE * 1.02f * mq * mk;
    if (__builtin_amdgcn_readfirstlane(sbound < 48.0f ? 1 : 0)) ph_attn_impl<MODE, true>(F, P, l); else ph_attn_impl<MODE, false>(F, P, l);
}

constexpr int DF_ROWB = 528;
template <int STAGE> __device__ __forceinline__ void ph_dft(const Frame& F, const Ptrs& P) {
    const int lane = fresh_lane(), tid = F.wave * 64 + lane, r32 = lane & 31, hi = lane >> 5, w = F.wave;
    bf16_t* U = (bf16_t*)(P.ws + WS_U); bf16_t* BR = (bf16_t*)(P.ws + WS_BR); const bf16_t* Wm = (const bf16_t*)(P.ws + WS_DFTM);
    LAS unsigned char* Xl = F.lds;
    const int xf_off = (8 * hi + ((lane & 15) >> 2)) * DF_ROWB + (32 * w + ((lane >> 4) & 1) * 16 + (lane & 3) * 4) * 2;
    constexpr int NMB = STAGE == 2 ? 4 : 2;
    const int seg = tid >> 2, part = tid & 3, pp = seg >> 6, jj = seg & 63;
    u32x4 pf[8];
    if (F.vcu < 1024) { const int u = F.vcu; const int chb = u & 1, sidx = (u >> 1) & 63, b = u >> 7;
        const int grow = STAGE == 2 ? b * T + 64 * jj + sidx : b * T + 64 * sidx + jj;
        const u32x4* src = (const u32x4*)(U + (size_t)grow * NIN + pp * 512 + chb * 256 + part * 64);
#pragma unroll
        for (int i = 0; i < 8; ++i) pf[i] = src[i]; }
    for (int u = F.vcu; u < 1024; u += F.G) {
        const int chb = u & 1, sidx = (u >> 1) & 63, b = u >> 7;
#pragma unroll
        for (int i = 0; i < 8; ++i) *(LAS u32x4*)(Xl + seg * DF_ROWB + part * 128 + i * 16) = pf[i];
        if (u + F.G < 1024) { const int un = u + F.G; const int chbn = un & 1, sn = (un >> 1) & 63, bn = un >> 7;
            const int grow = STAGE == 2 ? bn * T + 64 * jj + sn : bn * T + 64 * sn + jj;
            const u32x4* src = (const u32x4*)(U + (size_t)grow * NIN + pp * 512 + chbn * 256 + part * 64);
#pragma unroll
            for (int i = 0; i < 8; ++i) pf[i] = src[i]; }
        __syncthreads();
        f32x16 acc[NMB];
#pragma unroll
        for (int mb = 0; mb < NMB; ++mb)
#pragma unroll
            for (int r = 0; r < 16; ++r) acc[mb][r] = 0.f;
#pragma unroll
        for (int ks = 0; ks < 8; ++ks) {
            const v4i16_t lo4 = __builtin_amdgcn_ds_read_tr16_b64_v4i16((LAS v4i16_t*)(Xl + xf_off + (16 * ks) * DF_ROWB));
            const v4i16_t hi4 = __builtin_amdgcn_ds_read_tr16_b64_v4i16((LAS v4i16_t*)(Xl + xf_off + (16 * ks + 4) * DF_ROWB));
            const bf16x8 xf = (bf16x8){lo4[0], lo4[1], lo4[2], lo4[3], hi4[0], hi4[1], hi4[2], hi4[3]};
#pragma unroll
            for (int mb = 0; mb < NMB; ++mb) { const bf16x8 wf = *(const bf16x8*)(Wm + (mb * 32 + r32) * 128 + 16 * ks + 8 * hi);
                acc[mb] = __builtin_amdgcn_mfma_f32_32x32x16_bf16(xf, wf, acc[mb], 0, 0, 0); }
        }
        LAS unsigned char* ob = Xl + (32 * w + 4 * hi) * 2;
        if (STAGE == 2) {
#pragma unroll
            for (int mb = 0; mb < 2; ++mb) { const int k1 = mb * 32 + r32; const float rev = (float)((k1 * sidx) & 4095) * (1.0f / 4096.0f);
                const float ct = __builtin_amdgcn_cosf(rev), st = __builtin_amdgcn_sinf(rev);
#pragma unroll
                for (int gq = 0; gq < 4; ++gq) { u32x2 wr, wi; float yr[4], yi[4];
#pragma unroll
                    for (int i = 0; i < 4; ++i) { const float a = acc[mb][4 * gq + i], bq = acc[mb + 2][4 * gq + i]; yr[i] = a * ct + bq * st; yi[i] = bq * ct - a * st; }
                    wr.x = cvtpk(yr[0], yr[1]); wr.y = cvtpk(yr[2], yr[3]); wi.x = cvtpk(yi[0], yi[1]); wi.y = cvtpk(yi[2], yi[3]);
                    *(LAS u32x2*)(ob + k1 * DF_ROWB + 16 * gq) = wr; *(LAS u32x2*)(ob + (64 + k1) * DF_ROWB + 16 * gq) = wi; } }
        } else {
#pragma unroll
            for (int mb = 0; mb < 2; ++mb) { const int k2 = mb * 32 + r32;
#pragma unroll
                for (int gq = 0; gq < 4; ++gq) { u32x2 wr; wr.x = cvtpk(acc[mb][4 * gq] * 0.015625f, acc[mb][4 * gq + 1] * 0.015625f); wr.y = cvtpk(acc[mb][4 * gq + 2] * 0.015625f, acc[mb][4 * gq + 3] * 0.015625f);
                    *(LAS u32x2*)(ob + k2 * DF_ROWB + 16 * gq) = wr; } }
        }
        __syncthreads();
        if (STAGE == 2) {
            u32x4* dst = (u32x4*)(U + (size_t)(b * T + 64 * jj + sidx) * NIN + pp * 512 + chb * 256 + part * 64);
#pragma unroll
            for (int i = 0; i < 8; ++i) dst[i] = *(const LAS u32x4*)(Xl + seg * DF_ROWB + part * 128 + i * 16);
        } else { const int k2 = tid >> 3, part8 = tid & 7;
            u32x4* dst = (u32x4*)(BR + (size_t)(b * T + 64 * k2 + sidx) * NBR + chb * 256 + part8 * 32);
#pragma unroll
            for (int i = 0; i < 4; ++i) dst[i] = *(const LAS u32x4*)(Xl + k2 * DF_ROWB + part8 * 64 + i * 16); }
        __syncthreads();
    }
}

struct MegaArgs { Ptrs P; int ph_lo, ph_hi, li, pad; };
__global__ void __launch_bounds__(NWAVES * 64, 2) mega(MegaArgs args) {
    extern __shared__ __attribute__((aligned(16))) unsigned char lds_raw[];
    Frame F; F.lds = (LAS unsigned char*)lds_raw;
    F.wave = __builtin_amdgcn_readfirstlane(threadIdx.x >> 6);
    F.G = gridDim.x; { const int bx = blockIdx.x; F.vcu = (F.G % 8 == 0) ? (bx % 8) * (F.G / 8) + bx / 8 : bx; }
    for (int u = fresh_tid(); u < (LDS_BYTES - LDSCTL_OFF) / 4; u += NWAVES * 64) ((LAS unsigned*)(F.lds + LDSCTL_OFF))[u] = 0u;
    __syncthreads();
    volatile LAS unsigned* MISC = (volatile LAS unsigned*)(F.lds + MISC_OFF);
    const Ptrs& P = args.P;
    XcdBarrier bar = xcd_barrier_post((unsigned*)(P.ws + WS_CTL) + CW_BAR + args.li * XCD_BAR_WORDS, MISC + 8, F.wave);
    const int lo = args.ph_lo, hi = args.ph_hi;
    unsigned char* ws = P.ws;
    bf16_t* H = (bf16_t*)(ws + WS_H); bf16_t* U = (bf16_t*)(ws + WS_U); bf16_t* BR = (bf16_t*)(ws + WS_BR);
    bf16_t* MG = (bf16_t*)(ws + WS_MG); bf16_t* HID = (bf16_t*)(ws + WS_HID); bf16_t* MO = (bf16_t*)(ws + WS_MO);
    const bf16_t* Bt_in = (const bf16_t*)(ws + WS_WB + WB_IN); const bf16_t* Bt_gate = (const bf16_t*)(ws + WS_WB + WB_GATE); const bf16_t* Bt_br = (const bf16_t*)(ws + WS_WB + WB_BR);
    const bf16_t* Bt_out = (const bf16_t*)(ws + WS_WB + WB_OUT); const bf16_t* Bt_13 = (const bf16_t*)(ws + WS_WB + WB_13); const bf16_t* Bt_2 = (const bf16_t*)(ws + WS_WB + WB_2);
#define IN(g) (lo <= (g) && (g) < hi)
#define SEAM(g) do { if ((g) + 1 < hi) xcd_barrier(bar); } while (0)
    for (int l = 0; l < 2; ++l) {
        const int pb = l * NPH; const int M = l == 0 ? R : RL;
        if (IN(pb + 0)) { if (l == 0) ph_tables_mod(F, P); ph_weights(F, P, l); if (l == 0) SEAM(pb + 0); }
        if (IN(pb + 1)) { if (l == 0) ph_norm<0>(F, P, l, R); else ph_norm<1>(F, P, l, R); SEAM(pb + 1); }
        if (IN(pb + 2)) {
            pg8::StaticOrder S; S.init(R, NIN, F.G, (int)blockIdx.x, H, D, Bt_in, D);
            pg8::EpiV8<FStore8> E{FStore8{U, NIN}};
            pg8::gemm_phase(F.lds, F.wave, D, D, D, S, E);
            SEAM(pb + 2);
        }
        if (IN(pb + 3)) { ph_kprep(F, P, l); ph_pool(F, P, M); SEAM(pb + 3); }
        if (IN(pb + 4)) {
            ph_dft<2>(F, P); ph_attn<1>(F, P, l);
            if (l == 0) { ph_attn<2>(F, P, l); ph_attn<3>(F, P, l); ph_fourier_ref(F, P, TC, 0); }
            xcd_barrier(bar);
            ph_dft<3>(F, P); ph_attn<0>(F, P, l);
            SEAM(pb + 4);
        }
        if (IN(pb + 5)) {
            pg8::StaticOrder S; S.init(M, 4096, F.G, (int)blockIdx.x, H, D, Bt_gate, D);
            pg8::EpiV8<FGateU8> E{FGateU8{(unsigned char*)(ws + WS_GT), P.b_gate + (size_t)l * 4096}};
            pg8::gemm_phase(F.lds, F.wave, D, D, D, S, E);
            SEAM(pb + 5);
        }
        if (IN(pb + 6)) {
            pg8::StaticOrder S; S.init(M, D, F.G, (int)blockIdx.x, BR, NBR, Bt_br, NBR);
            pg8::EpiMergeS E{(const unsigned char*)(ws + WS_GT), MG};
            pg8::gemm_phase(F.lds, F.wave, NBR, NBR, NBR, S, E);
            xcd_barrier(bar);
        }
        if (IN(pb + 10)) {
            pg8::StaticOrder S; S.init(M, D, F.G, (int)blockIdx.x, MG, D, Bt_out, D);
            pg8::EpiV4<FOut> E{FOut{P, l}};
            pg8::gemm_phase(F.lds, F.wave, D, D, D, S, E);
            SEAM(pb + 10);
        }
        if (IN(pb + 11)) { ph_norm<2>(F, P, l, M); xcd_barrier(bar); }
        if (IN(pb + 13) || IN(pb + 14)) {
            LAS int* ptab = (LAS int*)(F.lds + LDSCTL_OFF);
            if (fresh_tid() == 0) { const unsigned* cnt = (const unsigned*)(ws + WS_CTL) + CW_CNT + 1024 * l; int off = 0;
                for (int e = 0; e < 16; ++e) { const int c = (int)cnt[64 * e]; ptab[e] = off; ptab[17 + e] = c; off += (c + 255) >> 8; } ptab[16] = off; }
            __syncthreads();
            if (IN(pb + 13)) {
                pg8::MoeOrder<true> S; S.nN = 4; S.G = F.G; S.c = F.vcu; S.A = (const char*)H; S.Bt = (const char*)Bt_13; S.astep = 0; S.bstep = (size_t)256 * D * 2; S.bexp = (size_t)1024 * 1024 * 2; S.tab = (const int*)ptab; S.tokl = (const int*)(ws + WS_TOKL);
                pg8::EpiDual<FMoe1> E{FMoe1{HID}};
                pg8::gemm_phase(F.lds, F.wave, D, D, D, S, E);
                SEAM(pb + 13);
            }
            if (IN(pb + 14)) {
                pg8::MoeOrder<false> S; S.nN = 4; S.G = F.G; S.c = F.vcu; S.A = (const char*)HID; S.Bt = (const char*)Bt_2; S.astep = (size_t)256 * FF * 2; S.bstep = (size_t)256 * FF * 2; S.bexp = (size_t)1024 * 512 * 2; S.tab = (const int*)ptab; S.tokl = nullptr;
                pg8::EpiV8<FMoe2> E{FMoe2{MO, (const int*)(ws + WS_TOKL), (const float*)(ws + WS_WL)}};
                pg8::gemm_phase(F.lds, F.wave, FF, FF, FF, S, E);
                SEAM(pb + 14);
            }
        }
    }
    if (IN(PH_FINAL)) ph_final(F, P);
#undef IN
#undef SEAM
}

extern "C" void kernel_launch(void* const* d_in, const int* in_sizes, int n_in, void* d_out, int out_size, void* d_ws, size_t ws_size, hipStream_t stream) {
    if (n_in != 24 || ws_size < WS_END || out_size != RL * D) { fprintf(stderr, "kernel_launch: unexpected sizes n_in %d ws %zu out %d\n", n_in, ws_size, out_size); return; }
    static int grid = 0;
    if (grid == 0) {
        int dev = 0, cus = 0;
        if (hipGetDevice(&dev) != hipSuccess || hipDeviceGetAttribute(&cus, hipDeviceAttributeMultiprocessorCount, dev) != hipSuccess) { grid = -1; return; }
        if (hipFuncSetAttribute((const void*)mega, hipFuncAttributeMaxDynamicSharedMemorySize, LDS_BYTES) != hipSuccess) { fprintf(stderr, "kernel_launch: hipFuncSetAttribute failed\n"); grid = -1; return; }
        int per_cu = 0;
        if (hipOccupancyMaxActiveBlocksPerMultiprocessor(&per_cu, (const void*)mega, NWAVES * 64, LDS_BYTES) != hipSuccess || per_cu < 1) fprintf(stderr, "kernel_launch: occupancy query says %d\n", per_cu);
        (void)hipGetLastError();
        grid = cus;
    }
    if (grid < 0) return;
    MegaArgs a{};
    const float** pp = (const float**)&a.P;
    for (int i = 0; i < 24; ++i) pp[i] = (const float*)d_in[i];
    a.P.out = (float*)d_out; a.P.ws = (unsigned char*)d_ws;
    (void)hipMemsetAsync((unsigned char*)d_ws + WS_CTL, 0, 128 * 1024, stream);
    a.ph_lo = 0; a.ph_hi = PH_FINAL + 1; a.li = 0;
    hipLaunchKernelGGL(mega, dim3(grid), dim3(NWAVES * 64), LDS_BYTES, stream, a);
}
```

```cpp
#include <hip/hip_runtime.h>
#include <cstdio>
#include <cstdint>

typedef unsigned short bf16_t;
typedef short bf16x8 __attribute__((ext_vector_type(8)));
typedef float f32x4 __attribute__((ext_vector_type(4)));
typedef unsigned u32x4 __attribute__((ext_vector_type(4)));
typedef unsigned u32x2 __attribute__((ext_vector_type(2)));
typedef int i32x4 __attribute__((ext_vector_type(4)));

constexpr int D = 1024, NB = 8, T = 4096, TC = 256;
constexpr int RL = NB * T, RC = NB * TC, R = RL + RC;
constexpr int NIN = 3072;
constexpr int C_ZR = 0, C_ZI = 512, C_P = 1024, C_QB = 1536, C_KB = 2048, C_VB = 2176, C_QW = 2304, C_KW = 2816, C_VW = 2944;
constexpr int NBR = 2048;
constexpr int NE = 16, FF = 512;
constexpr int MAXROWS = 73728;
constexpr float EPS = 1e-6f;
constexpr float QSCALE = 0.125f * 1.4426950408889634f;
constexpr float LOG2E = 1.4426950408889634f;

constexpr size_t MiB = 1u << 20;
constexpr size_t WS_CTL = 0;
constexpr size_t WS_MOD = 1 * MiB;
constexpr size_t WS_ROPE = 1 * MiB + 512 * 1024;
constexpr size_t WS_COS = WS_ROPE + 16 * 1024;
constexpr size_t WS_DFTM = WS_ROPE + 64 * 1024;
constexpr size_t WS_TOKL = 2 * MiB;
constexpr size_t WS_WL = 4 * MiB + 512 * 1024;
constexpr size_t WS_XC = 9 * MiB;
constexpr size_t WS_WB = 17 * MiB;
constexpr size_t WB_IN = 0, WB_GATE = 6 * MiB, WB_BR = 14 * MiB, WB_OUT = 18 * MiB, WB_13 = 20 * MiB, WB_2 = 52 * MiB;
constexpr size_t WS_H = 85 * MiB;
constexpr size_t WS_SA = WS_H + 34 * MiB;
constexpr size_t WS_ARENA = 153 * MiB;
constexpr size_t WS_U = WS_ARENA;
constexpr size_t WS_BR = WS_ARENA + 204 * MiB;
constexpr size_t WS_GT = WS_ARENA;
constexpr size_t WS_MG = WS_ARENA + 136 * MiB;
constexpr size_t WS_HID = WS_ARENA + 144 * MiB;
constexpr size_t WS_MO = WS_ARENA + 216 * MiB;
constexpr size_t WS_FTMP = WS_ARENA + 352 * MiB;
constexpr size_t WS_END = 512 * MiB;
static_assert(WS_BR + (size_t)R * NBR * 2 <= WS_END && WS_MO + (size_t)2 * R * D * 2 <= WS_END && WS_MG + (size_t)R * D * 2 <= WS_BR, "ws map");
constexpr int CW_CMAX = 32768;
constexpr int CW_CNT = 8192;

__device__ __forceinline__ float bf2f(bf16_t b) { return __uint_as_float(((unsigned)b) << 16); }
__device__ __forceinline__ unsigned f2bf(float f) { unsigned u = __float_as_uint(f); return (u + 0x7fffu + ((u >> 16) & 1u)) >> 16; }
__device__ __forceinline__ unsigned pk2(float lo, float hi) { return f2bf(lo) | (f2bf(hi) << 16); }
typedef __bf16 bf16x2_t __attribute__((ext_vector_type(2)));
typedef float f32x2_t __attribute__((ext_vector_type(2)));
__device__ __forceinline__ unsigned cvtpk(float lo, float hi) { f32x2_t v = {lo, hi}; bf16x2_t b = __builtin_convertvector(v, bf16x2_t); return __builtin_bit_cast(unsigned, b); }
__device__ __forceinline__ float lo16(unsigned w) { return __uint_as_float(w << 16); }
__device__ __forceinline__ float hi16(unsigned w) { return __uint_as_float(w & 0xffff0000u); }
__device__ __forceinline__ float shfl_xor_l(float v, int o, int lane) { return __int_as_float(__builtin_amdgcn_ds_bpermute((lane ^ o) << 2, __float_as_int(v))); }
__device__ __forceinline__ float wave_sum_l(float v, int lane) {
#pragma unroll
    for (int o = 1; o < 64; o <<= 1) v += shfl_xor_l(v, o, lane);
    return v;
}
__device__ __forceinline__ int row_bb(int r) { return r < RL ? (r >> 12) : 8; }

struct Ptrs {
    const float *x, *c, *ctx, *c_ctx, *w_ada, *b_ada, *norm1, *norm2, *w_in, *q_gain, *k_gain, *sink, *pool_w, *pool_scale,
        *w_branch, *w_gate, *b_gate, *w_out, *router_w, *router_bias, *w1, *w3, *w2, *norm_f;
    float* out; unsigned char* ws;
};
__device__ __forceinline__ const float* xin_row(const Ptrs& P, int r) { return r < RL ? P.x + (size_t)r * D : P.ctx + (size_t)(r - RL) * D; }
__device__ __forceinline__ float* x1_row(const Ptrs& P, int r) { return r < RL ? P.out + (size_t)r * D : (float*)(P.ws + WS_XC) + (size_t)(r - RL) * D; }
__device__ __forceinline__ const float* mod_vec(const Ptrs& P, int l, int bb, int which) { return (const float*)(P.ws + WS_MOD) + ((size_t)(l * 9 + bb) * 6 + which) * D; }

#define LAS __attribute__((address_space(3)))
#define GAS __attribute__((address_space(1)))
#define LDS_WAIT() asm volatile("s_waitcnt lgkmcnt(0)" ::: "memory")
__device__ __forceinline__ int fresh_lane() { int l; asm volatile("v_mbcnt_lo_u32_b32 %0, -1, 0\n\tv_mbcnt_hi_u32_b32 %0, -1, %0" : "=v"(l)); return l; }
constexpr int NWAVES = 8;
constexpr int RING_BYTES = 131072, LDSCTL_OFF = RING_BYTES, MISC_OFF = LDSCTL_OFF + 320, LDS_BYTES = 147456;
constexpr int CW_BAR = 16384;
constexpr int NPH = 15, PH_FINAL = 2 * NPH;

#define XB_TMO      128
#define XB_XCNT(j)  (256  + 64 * (j))
#define XB_XSUB(j)  (1280 + 64 * (j))
#define XB_XGEN(j)  (2304 + 64 * (j))
#define XB_TOP      3328
#define XB_TOPGEN   3392
#define XCD_BAR_WORDS 3456
#define XB_SPIN_CAP (1u << 21)
__device__ __forceinline__ unsigned xb_ld(unsigned* p)              { return __hip_atomic_load(p, __ATOMIC_RELAXED, __HIP_MEMORY_SCOPE_AGENT); }
__device__ __forceinline__ unsigned xb_add(unsigned* p, unsigned v) { return __hip_atomic_fetch_add(p, v, __ATOMIC_RELAXED, __HIP_MEMORY_SCOPE_AGENT); }
__device__ __forceinline__ unsigned xb_xcc_id() { return (unsigned)__builtin_amdgcn_s_getreg((3 << 11) | 20) & 0xFu; }
#define XB_SPIN(cond, bar) do { unsigned _sp = 0; while (cond) { __builtin_amdgcn_s_sleep(1); \
    if ((++_sp & 255u) == 0u) { if (xb_ld(&(bar)[XB_TMO])) break; if (_sp > XB_SPIN_CAP) { atomicAdd(&(bar)[XB_TMO], 1u); break; } } } } while (0)
struct XcdBarrier { unsigned* bar; unsigned x; volatile LAS unsigned* st; int wave; };
__device__ __forceinline__ XcdBarrier xcd_barrier_post(unsigned* bar, volatile LAS unsigned* st, int wave) {
    XcdBarrier b; b.bar = bar; b.x = xb_xcc_id(); b.st = st; b.wave = wave;
    if (wave == 0 && fresh_lane() == 0) (void)xb_add(&bar[XB_XCNT(b.x)], 1u);
    return b;
}
__device__ __forceinline__ void xcd_barrier_complete(unsigned* bar, unsigned x, unsigned& nloc, unsigned& nx) {
    const unsigned G = gridDim.x * gridDim.y * gridDim.z;
    unsigned sum, cnt, mine, sp = 0u;
    for (;;) {
        sum = 0u; cnt = 0u; mine = 0u;
#pragma unroll
        for (unsigned j = 0; j < 16; ++j) { const unsigned c = xb_ld(&bar[XB_XCNT(j)]); sum += c; cnt += (c > 0u) ? 1u : 0u; mine = (j == x) ? c : mine; }
        if (sum == G) break;
        __builtin_amdgcn_s_sleep(1);
        if ((++sp & 255u) == 0u) { if (xb_ld(&bar[XB_TMO])) break; if (sp > XB_SPIN_CAP) { atomicAdd(&bar[XB_TMO], 1u); break; } }
    }
    nloc = mine > 0u ? mine : 1u; nx = cnt > 0u ? cnt : 1u;
}
__device__ __forceinline__ void xcd_barrier(const XcdBarrier& b) {
    asm volatile("s_waitcnt vmcnt(0)" ::: "memory");
    __syncthreads();
    if (b.wave == 0 && fresh_lane() == 0) {
        unsigned* bar = b.bar;
        __builtin_amdgcn_s_waitcnt(0);
        unsigned nloc = b.st[0], nx = b.st[1];
        if (nloc == 0u) { xcd_barrier_complete(bar, b.x, nloc, nx); b.st[0] = nloc; b.st[1] = nx; }
        const unsigned old = xb_add(&bar[XB_XSUB(b.x)], 1u);
        const unsigned gen = old / nloc;
        if (old + 1u == (gen + 1u) * nloc) {
            __builtin_amdgcn_fence(__ATOMIC_RELEASE, "agent");
            asm volatile("s_waitcnt vmcnt(0)" ::: "memory");
            const unsigned og = xb_add(&bar[XB_TOP], 1u);
            const unsigned tg = og / nx;
            if (og + 1u == (tg + 1u) * nx) xb_add(&bar[XB_TOPGEN], 1u);
            else XB_SPIN(xb_ld(&bar[XB_TOPGEN]) == tg, bar);
            __builtin_amdgcn_fence(__ATOMIC_ACQUIRE, "agent");
            xb_add(&bar[XB_XGEN(b.x)], 1u);
            asm volatile("s_waitcnt vmcnt(0)" ::: "memory");
        } else {
            XB_SPIN(xb_ld(&bar[XB_XGEN(b.x)]) == gen, bar);
            __builtin_amdgcn_fence(__ATOMIC_ACQUIRE, "agent");
            asm volatile("s_waitcnt vmcnt(0)" ::: "memory");
        }
    }
    __syncthreads();
}

namespace pg8 {
constexpr int BM = 256, BK = 64, HALF = 128, HTB = HALF * BK * 2, STAGE_BYTES = 8 * HTB, NXCD = 8, WGM = 4;
__host__ __device__ __forceinline__ int lds_byte(int r, int c) { const int st = (r >> 4) * 2 + (c >> 5), rr = r & 15, cc = c & 31, ob = rr * 64 + cc * 2; return st * 1024 + (ob ^ (((ob >> 9) & 1) << 5)); }
__host__ __device__ __forceinline__ void stage_rc(int b, int& Rr, int& C) { const int st = b / 1024, sb = b % 1024, swz = sb ^ (((sb >> 9) & 1) << 5); Rr = (st >> 1) * 16 + swz / 64; C = (st & 1) * 32 + (swz % 64) / 2; }
__host__ __device__ __forceinline__ int perm32(int rho) { const int n = rho >> 4, i = rho & 15; return 8 * (i >> 2) + 4 * n + (i & 3); }
struct Unit { int pm, pn; const char* a; const char* b; int e, p0, ce; };

struct StaticOrder {
    static constexpr bool GATHER = false;
    int nM, nN, nwg, G, c; const char* A; const char* Bt; size_t astep, bstep;
    __device__ void init(int M, int N, int G_, int c_, const bf16_t* A_, int lda, const bf16_t* Bt_, int ldb) { nM = M / BM; nN = N / BM; nwg = nM * nN; G = G_; c = c_; A = (const char*)A_; Bt = (const char*)Bt_; astep = (size_t)BM * lda * 2; bstep = (size_t)BM * ldb * 2; }
    __device__ bool next(int i, Unit& u) const {
        const long L = (long)i * G + c; if (L >= nwg) return false;
        int wgid = (int)L; { const int q = nwg / NXCD, r = nwg % NXCD, xcd = wgid % NXCD, off = wgid / NXCD; wgid = (xcd < r ? xcd * (q + 1) : r * (q + 1) + (xcd - r) * q) + off; }
        const int nig = WGM * nN, gid = wgid / nig, fm = gid * WGM, gsz = (nM - fm) < WGM ? (nM - fm) : WGM;
        u.pm = fm + ((wgid % nig) % gsz); u.pn = (wgid % nig) / gsz; u.a = A + (size_t)u.pm * astep; u.b = Bt + (size_t)u.pn * bstep; u.e = 0; u.p0 = 0; u.ce = 0; return true;
    }
};
template <bool GATHER_> struct MoeOrder {
    static constexpr bool GATHER = GATHER_;
    int nN, G, c; const char* A; const char* Bt; size_t astep, bstep, bexp; const int* tab; const int* tokl;
    __device__ bool next(int i, Unit& u) const {
        const int L = i * G + c; const int total = __builtin_amdgcn_readfirstlane(tab[16]) * nN; if (L >= total) return false;
        u.pm = L / nN; u.pn = L % nN; int e = 0;
#pragma unroll
        for (int q = 1; q < 16; ++q) e += (u.pm >= tab[q]) ? 1 : 0;
        e = __builtin_amdgcn_readfirstlane(e);
        u.e = e; u.p0 = __builtin_amdgcn_readfirstlane((u.pm - tab[e]) * BM); u.ce = __builtin_amdgcn_readfirstlane(tab[17 + e]);
        u.a = GATHER_ ? A : A + (size_t)u.pm * astep; u.b = Bt + (size_t)e * bexp + (size_t)u.pn * bstep; return true;
    }
    __device__ __forceinline__ void aoffs(const Unit& u, int wid, int lda, unsigned (&off)[2][2]) const {
        const int tid = wid * 64 + fresh_lane();
#pragma unroll
        for (int i = 0; i < 2; ++i) { int Rr, C; stage_rc(tid * 16 + i * 8192, Rr, C);
#pragma unroll
            for (int h = 0; h < 2; ++h) { const int pos = u.p0 + h * HALF + Rr; const int tok = pos < u.ce ? (tokl[(size_t)u.e * R + pos] >> 1) : 0; off[h][i] = (unsigned)(tok * lda + C) * 2u; } }
    }
};

template <class Epi, class Sched, bool ALIGN_EPI = true, bool I8 = false>
__device__ __forceinline__ void gemm_phase(LAS unsigned char* lds, const int wid, const int lda, const int ldb, const int K, const Sched& S, const Epi& E) {
    const int lane = fresh_lane(), tid = wid * 64 + lane, wr = wid >> 2, wc = wid & 3, fr = lane & 15, fq = lane >> 4;
    const int nt = K / BK;
    unsigned voffA[2], voffB[2];
#pragma unroll
    for (int i = 0; i < 2; ++i) { int Rr, C; stage_rc(tid * 16 + i * 8192, Rr, C); const int Rb = Epi::PERM ? ((Rr & ~31) + perm32(Rr & 31)) : Rr;
        voffA[i] = (unsigned)(Rr * lda + C) * 2u; voffB[i] = (unsigned)(Rb * ldb + C) * 2u; }
    const size_t kstep = (size_t)(BK * 2);
    const size_t hstepA = Sched::GATHER ? 0 : (size_t)HALF * lda * 2, hstepB = (size_t)HALF * ldb * 2;
    const unsigned ldsw = (unsigned)wid * 1024u;
    const int aoff = lds_byte(wr * 64 + fr, fq * 8), boff = lds_byte(wc * 32 + fr, fq * 8);
#define PG8_SA(b, h) (((b) * 2 + (h)) * HTB)
#define PG8_SB(b, h) ((4 + (b) * 2 + (h)) * HTB)
#define PG8_STAGE(bufoff, gbase, voff) do { _Pragma("unroll") for (int _i = 0; _i < 2; ++_i) \
        __builtin_amdgcn_global_load_lds((const unsigned*)((const char*)(gbase) + (voff)[_i]), (LAS unsigned*)(lds + (bufoff) + ldsw + _i * 8192), 16, 0, 0); } while (0)
#define PG8_STAGE_A(b, h, kp, OFFS) do { if constexpr (Sched::GATHER) { PG8_STAGE(PG8_SA(b, h), kp, OFFS[h]); } else { PG8_STAGE(PG8_SA(b, h), (kp) + (h) * hstepA, voffA); } } while (0)
#define PG8_LDA(dst, b, h) do { _Pragma("unroll") for (int m = 0; m < 4; ++m) _Pragma("unroll") for (int k = 0; k < 2; ++k) dst[m][k] = *(const LAS bf16x8*)(lds + PG8_SA(b, h) + aoff + m * 2048 + k * 1024); } while (0)
#define PG8_LDB(dst, b, h) do { _Pragma("unroll") for (int n = 0; n < 2; ++n) _Pragma("unroll") for (int k = 0; k < 2; ++k) dst[n][k] = *(const LAS bf16x8*)(lds + PG8_SB(b, h) + boff + n * 2048 + k * 1024); } while (0)
#define PG8_MMA(ai, bj, At, Bt) do { __builtin_amdgcn_s_setprio(1); _Pragma("unroll") for (int m = 0; m < 4; ++m) _Pragma("unroll") for (int n = 0; n < 2; ++n) _Pragma("unroll") for (int k = 0; k < 2; ++k) { \
        if constexpr (I8) acc[ai][bj][m][n] = __builtin_bit_cast(f32x4, __builtin_amdgcn_mfma_i32_16x16x64_i8(__builtin_bit_cast(i32x4, Bt[n][k]), __builtin_bit_cast(i32x4, At[m][k]), __builtin_bit_cast(i32x4, acc[ai][bj][m][n]), 0, 0, 0)); \
        else acc[ai][bj][m][n] = __builtin_amdgcn_mfma_f32_16x16x32_bf16(Bt[n][k], At[m][k], acc[ai][bj][m][n], 0, 0, 0); } __builtin_amdgcn_s_setprio(0); } while (0)
#define PG8_WAIT_V(n) asm volatile("s_waitcnt vmcnt(" #n ")" ::: "memory")
#define PG8_WAIT_L(n) asm volatile("s_waitcnt lgkmcnt(" #n ")" ::: "memory")
#define PG8_BAR __builtin_amdgcn_s_barrier()
#define PG8_SCHED __builtin_amdgcn_sched_barrier(0)
    Unit cur, nxt; int ui = 0;
    if (!S.next(0, cur)) return;
    f32x4 acc[2][2][4][2];
#pragma unroll
    for (int a = 0; a < 2; ++a)
#pragma unroll
        for (int b = 0; b < 2; ++b)
#pragma unroll
            for (int m = 0; m < 4; ++m)
#pragma unroll
                for (int n = 0; n < 2; ++n) acc[a][b][m][n] = (f32x4){0.f, 0.f, 0.f, 0.f};
    bf16x8 At[4][2], B0[2][2], B1[2][2];
    unsigned goffC[2][2], goffN[2][2];
    if constexpr (Sched::GATHER) { S.aoffs(cur, wid, lda, goffC);
#pragma unroll
        for (int h = 0; h < 2; ++h)
#pragma unroll
            for (int i = 0; i < 2; ++i) goffN[h][i] = goffC[h][i]; }
    const char* cA = cur.a; const char* cB = cur.b;
    PG8_STAGE(PG8_SB(0, 0), cB, voffB); PG8_STAGE(PG8_SB(0, 1), cB + hstepB, voffB); PG8_STAGE_A(0, 0, cA, goffC); PG8_STAGE_A(0, 1, cA, goffC);
    if (wr == 1) PG8_BAR;
    PG8_WAIT_V(2); PG8_BAR;
    PG8_STAGE(PG8_SB(1, 0), cB + kstep, voffB); PG8_STAGE_A(1, 0, cA + kstep, goffC); PG8_STAGE(PG8_SB(1, 1), cB + hstepB + kstep, voffB);
    PG8_WAIT_V(6); PG8_BAR;
    for (;;) {
        const bool has_next = S.next(ui + 1, nxt);
        if constexpr (Sched::GATHER) { if (has_next) S.aoffs(nxt, wid, lda, goffN); }
        const char* nA = has_next ? nxt.a : cA; const char* nB = has_next ? nxt.b : cB;
        for (int t = 0; t < nt; t += 2) {
            const bool last = (t == nt - 2);
            const char* a1 = cA + (size_t)(t + 1) * kstep;
            const char* a2 = last ? nA : cA + (size_t)(t + 2) * kstep; const char* b2 = last ? nB : cB + (size_t)(t + 2) * kstep;
            const char* a3 = a2 + kstep; const char* b3 = b2 + kstep;
            unsigned gx[2][2];
            if constexpr (Sched::GATHER) {
#pragma unroll
                for (int h = 0; h < 2; ++h)
#pragma unroll
                    for (int i = 0; i < 2; ++i) gx[h][i] = (last && has_next) ? goffN[h][i] : goffC[h][i]; }
            PG8_LDB(B0, 0, 0); PG8_LDB(B1, 0, 1); PG8_SCHED; PG8_LDA(At, 0, 0); PG8_STAGE_A(1, 1, a1, goffC);
            PG8_WAIT_V(8); PG8_WAIT_L(0); PG8_BAR; PG8_MMA(0, 0, At, B0); PG8_MMA(0, 1, At, B1); PG8_BAR; PG8_SCHED;
            PG8_LDA(At, 0, 1); PG8_STAGE(PG8_SB(0, 0), b2, voffB); PG8_STAGE(PG8_SB(0, 1), b2 + hstepB, voffB); PG8_STAGE_A(0, 0, a2, gx);
            PG8_WAIT_V(8); PG8_WAIT_L(0); PG8_BAR; PG8_MMA(1, 0, At, B0); PG8_MMA(1, 1, At, B1); PG8_BAR; PG8_SCHED;
            PG8_LDB(B0, 1, 0); PG8_LDB(B1, 1, 1); PG8_SCHED; PG8_LDA(At, 1, 0); PG8_STAGE_A(0, 1, a2, gx);
            PG8_WAIT_V(8); PG8_WAIT_L(0); PG8_BAR; PG8_MMA(0, 0, At, B0); PG8_MMA(0, 1, At, B1); PG8_BAR; PG8_SCHED;
            PG8_LDA(At, 1, 1); PG8_STAGE(PG8_SB(1, 0), b3, voffB); PG8_STAGE(PG8_SB(1, 1), b3 + hstepB, voffB); PG8_STAGE_A(1, 0, a3, gx);
            PG8_WAIT_V(8); PG8_WAIT_L(0); PG8_BAR; PG8_MMA(1, 0, At, B0); PG8_MMA(1, 1, At, B1); PG8_BAR; PG8_SCHED;
            if constexpr (Epi::MID) { if (((t + 2) & (Epi::MID_EVERY - 1)) == 0 && !last) E.mid(acc, cur, wr, wc, (t + 2) / Epi::MID_EVERY - 1); }
        }
        if constexpr (ALIGN_EPI) { if (wr == 0) PG8_BAR; }
        E(acc, cur, wr, wc, fr, fq);
        if (!has_next) break;
#pragma unroll
        for (int a = 0; a < 2; ++a)
#pragma unroll
            for (int b = 0; b < 2; ++b)
#pragma unroll
                for (int m = 0; m < 4; ++m)
#pragma unroll
                    for (int n = 0; n < 2; ++n) acc[a][b][m][n] = (f32x4){0.f, 0.f, 0.f, 0.f};
        cur = nxt; cA = nA; cB = nB; ++ui;
        if constexpr (Sched::GATHER) {
#pragma unroll
            for (int h = 0; h < 2; ++h)
#pragma unroll
                for (int i = 0; i < 2; ++i) goffC[h][i] = goffN[h][i]; }
        if constexpr (ALIGN_EPI) { if (wr == 1) PG8_BAR; }
    }
    PG8_WAIT_V(0);
    if constexpr (!ALIGN_EPI) { if (wr == 0) PG8_BAR; }
    PG8_BAR;
#undef PG8_SA
#undef PG8_SB
#undef PG8_STAGE
#undef PG8_STAGE_A
#undef PG8_LDA
#undef PG8_LDB
#undef PG8_MMA
#undef PG8_WAIT_V
#undef PG8_WAIT_L
#undef PG8_BAR
#undef PG8_SCHED
}
template <class F> struct EpiV4 { static constexpr bool PERM = false, MID = false; static constexpr int MID_EVERY = 1; F f;
    __device__ __forceinline__ void operator()(const f32x4 (&acc)[2][2][4][2], const Unit& u, int wr, int wc, int, int) const {
        const int ln = fresh_lane(), fr = ln & 15, fq = ln >> 4;
        const int row0 = u.pm * BM + wr * 64 + fr, col0 = u.pn * BM + wc * 32 + 4 * fq;
        typename F::UnitPre up = f.unit(u, col0);
#pragma unroll
        for (int ai = 0; ai < 2; ++ai) {
            typename F::Pre pre[4][2][2];
#pragma unroll
            for (int m = 0; m < 4; ++m)
#pragma unroll
                for (int bj = 0; bj < 2; ++bj)
#pragma unroll
                    for (int n = 0; n < 2; ++n) pre[m][bj][n] = f.load(u, row0 + ai * HALF + m * 16, col0 + bj * HALF + n * 16);
#pragma unroll
            for (int m = 0; m < 4; ++m)
#pragma unroll
                for (int bj = 0; bj < 2; ++bj)
#pragma unroll
                    for (int n = 0; n < 2; ++n) f.fin(u, row0 + ai * HALF + m * 16, col0 + bj * HALF + n * 16, acc[ai][bj][m][n], pre[m][bj][n], up, bj * 2 + n);
            asm volatile("" ::: "memory"); }
    } };
template <class F> struct EpiV8 { static constexpr bool PERM = true, MID = false; static constexpr int MID_EVERY = 1; F f;
    __device__ __forceinline__ void operator()(const f32x4 (&acc)[2][2][4][2], const Unit& u, int wr, int wc, int, int) const {
        const int ln = fresh_lane(), fr = ln & 15, fq = ln >> 4;
        const int row0 = u.pm * BM + wr * 64 + fr, col0 = u.pn * BM + wc * 32 + 8 * fq;
#pragma unroll
        for (int ai = 0; ai < 2; ++ai) {
            typename F::Pre pre[4][2];
#pragma unroll
            for (int m = 0; m < 4; ++m)
#pragma unroll
                for (int bj = 0; bj < 2; ++bj) pre[m][bj] = f.load(u, row0 + ai * HALF + m * 16, col0 + bj * HALF);
#pragma unroll
            for (int m = 0; m < 4; ++m)
#pragma unroll
                for (int bj = 0; bj < 2; ++bj) f.fin(u, row0 + ai * HALF + m * 16, col0 + bj * HALF, acc[ai][bj][m][0], acc[ai][bj][m][1], pre[m][bj]);
            asm volatile("" ::: "memory"); }
    } };
template <class F> struct EpiDual { static constexpr bool PERM = true, MID = false; static constexpr int MID_EVERY = 1; F f;
    __device__ __forceinline__ void operator()(const f32x4 (&acc)[2][2][4][2], const Unit& u, int wr, int wc, int, int) const {
        const int ln = fresh_lane(), fr = ln & 15, fq = ln >> 4;
        const int row0 = u.pm * BM + wr * 64 + fr, hc0 = u.pn * HALF + wc * 32 + 8 * fq;
#pragma unroll
        for (int ai = 0; ai < 2; ++ai)
#pragma unroll
            for (int m = 0; m < 4; ++m) f.apply8(row0 + ai * HALF + m * 16, hc0, acc[ai][0][m][0], acc[ai][0][m][1], acc[ai][1][m][0], acc[ai][1][m][1]);
    } };
struct EpiMergeS { static constexpr bool PERM = true, MID = true; static constexpr int MID_EVERY = 8;
    const unsigned char* G8; bf16_t* MG;
    __device__ __forceinline__ void mid(f32x4 (&acc)[2][2][4][2], const Unit& u, int wr, int wc, int i) const {
        const int ln = fresh_lane(), fr = ln & 15, fq = ln >> 4;
        const int row0 = u.pm * BM + wr * 64 + fr, col0 = u.pn * BM + wc * 32 + 8 * fq;
#pragma unroll
        for (int ai = 0; ai < 2; ++ai) {
            u32x2 gi[4][2], gn[4][2];
#pragma unroll
            for (int m = 0; m < 4; ++m)
#pragma unroll
                for (int bj = 0; bj < 2; ++bj) { const unsigned char* gp = G8 + (size_t)(row0 + ai * HALF + m * 16) * 4096 + i * 1024 + col0 + bj * HALF;
                    gi[m][bj] = *(const u32x2*)gp; gn[m][bj] = *(const u32x2*)(gp + 1024); }
#pragma unroll
            for (int m = 0; m < 4; ++m)
#pragma unroll
                for (int bj = 0; bj < 2; ++bj) {
#pragma unroll
                    for (int j = 0; j < 4; ++j) {
                        acc[ai][bj][m][0][j] *= (float)((gi[m][bj].x >> (8 * j)) & 255u) * __builtin_amdgcn_rcpf((float)((gn[m][bj].x >> (8 * j)) & 255u));
                        acc[ai][bj][m][1][j] *= (float)((gi[m][bj].y >> (8 * j)) & 255u) * __builtin_amdgcn_rcpf((float)((gn[m][bj].y >> (8 * j)) & 255u)); } }
        }
    }
    __device__ __forceinline__ void operator()(const f32x4 (&acc)[2][2][4][2], const Unit& u, int wr, int wc, int, int) const {
        const int ln = fresh_lane(), fr = ln & 15, fq = ln >> 4;
        const int row0 = u.pm * BM + wr * 64 + fr, col0 = u.pn * BM + wc * 32 + 8 * fq;
#pragma unroll
        for (int ai = 0; ai < 2; ++ai) {
            u32x2 g3[4][2];
#pragma unroll
            for (int m = 0; m < 4; ++m)
#pragma unroll
                for (int bj = 0; bj < 2; ++bj) g3[m][bj] = *(const u32x2*)(G8 + (size_t)(row0 + ai * HALF + m * 16) * 4096 + 3 * 1024 + col0 + bj * HALF);
#pragma unroll
            for (int m = 0; m < 4; ++m)
#pragma unroll
                for (int bj = 0; bj < 2; ++bj) { f32x4 a = acc[ai][bj][m][0], b = acc[ai][bj][m][1];
#pragma unroll
                    for (int j = 0; j < 4; ++j) { a[j] *= (float)((g3[m][bj].x >> (8 * j)) & 255u) * (1.0f / 255.0f); b[j] *= (float)((g3[m][bj].y >> (8 * j)) & 255u) * (1.0f / 255.0f); }
                    u32x4 w; w.x = cvtpk(a.x, a.y); w.y = cvtpk(a.z, a.w); w.z = cvtpk(b.x, b.y); w.w = cvtpk(b.z, b.w);
                    *(u32x4*)(MG + (size_t)(row0 + ai * HALF + m * 16) * D + col0 + bj * HALF) = w; }
        }
    }
};
template <class F> struct EpiV8I8 { static constexpr bool PERM = true, MID = false; static constexpr int MID_EVERY = 1; F f; const float* sA; const unsigned* cmax;
    __device__ __forceinline__ void operator()(const f32x4 (&acc)[2][2][4][2], const Unit& u, int wr, int wc, int, int) const {
        const int ln = fresh_lane(), fr = ln & 15, fq = ln >> 4;
        const int row0 = u.pm * BM + wr * 64 + fr, col0 = u.pn * BM + wc * 32 + 8 * fq;
        f32x4 sb[2][2];
#pragma unroll
        for (int bj = 0; bj < 2; ++bj)
#pragma unroll
            for (int n = 0; n < 2; ++n) { const u32x4 c = *(const u32x4*)(cmax + col0 + bj * HALF + 4 * n); sb[bj][n] = (f32x4){__uint_as_float(c.x), __uint_as_float(c.y), __uint_as_float(c.z), __uint_as_float(c.w)} * (1.0f / 127.0f); }
#pragma unroll
        for (int ai = 0; ai < 2; ++ai) {
            typename F::Pre pre[4][2];
#pragma unroll
            for (int m = 0; m < 4; ++m)
#pragma unroll
                for (int bj = 0; bj < 2; ++bj) pre[m][bj] = f.load(u, row0 + ai * HALF + m * 16, col0 + bj * HALF);
#pragma unroll
            for (int m = 0; m < 4; ++m) { const float ra = sA[row0 + ai * HALF + m * 16];
#pragma unroll
                for (int bj = 0; bj < 2; ++bj) { f32x4 a, b;
#pragma unroll
                    for (int j = 0; j < 4; ++j) { a[j] = (float)__float_as_int(acc[ai][bj][m][0][j]) * ra * sb[bj][0][j]; b[j] = (float)__float_as_int(acc[ai][bj][m][1][j]) * ra * sb[bj][1][j]; }
                    f.fin(u, row0 + ai * HALF + m * 16, col0 + bj * HALF, a, b, pre[m][bj]); } }
            asm volatile("" ::: "memory"); }
    } };
}

__device__ __forceinline__ u32x4 pack8(f32x4 a, f32x4 b) { u32x4 w; w.x = cvtpk(a.x, a.y); w.y = cvtpk(a.z, a.w); w.z = cvtpk(b.x, b.y); w.w = cvtpk(b.z, b.w); return w; }
__device__ __forceinline__ float sigm1(float x) { return __builtin_amdgcn_rcpf(1.0f + __builtin_amdgcn_exp2f(-1.4426950408889634f * x)); }
__device__ __forceinline__ f32x4 sigm4(f32x4 v) { f32x4 r; r.x = sigm1(v.x); r.y = sigm1(v.y); r.z = sigm1(v.z); r.w = sigm1(v.w); return r; }
struct NoPre {};
struct FStore8 { bf16_t* C; int ldc; typedef NoPre Pre;
    __device__ __forceinline__ Pre load(const pg8::Unit&, int, int) const { return Pre{}; }
    __device__ __forceinline__ void fin(const pg8::Unit&, int row, int col, f32x4 a, f32x4 b, const Pre&) const { *(u32x4*)(C + (size_t)row * ldc + col) = pack8(a, b); } };
struct FGateU8 { unsigned char* G8; const float* bias; typedef NoPre Pre;
    __device__ __forceinline__ Pre load(const pg8::Unit&, int, int) const { return Pre{}; }
    __device__ __forceinline__ void fin(const pg8::Unit&, int row, int col, f32x4 a, f32x4 b, const Pre&) const { const f32x4 b0 = *(const f32x4*)(bias + col), b1 = *(const f32x4*)(bias + col + 4);
        const f32x4 ga = sigm4(a + b0) * 255.0f + 0.5f, gb = sigm4(b + b1) * 255.0f + 0.5f;
        unsigned q[8] = {(unsigned)ga.x, (unsigned)ga.y, (unsigned)ga.z, (unsigned)ga.w, (unsigned)gb.x, (unsigned)gb.y, (unsigned)gb.z, (unsigned)gb.w};
#pragma unroll
        for (int k = 0; k < 8; ++k) q[k] = q[k] < 1u ? 1u : (q[k] > 255u ? 255u : q[k]);
        u32x2 w; w.x = q[0] | (q[1] << 8) | (q[2] << 16) | (q[3] << 24); w.y = q[4] | (q[5] << 8) | (q[6] << 16) | (q[7] << 24);
        *(u32x2*)(G8 + (size_t)row * 4096 + col) = w; } };
struct FMoe1 { bf16_t* HID;
    __device__ __forceinline__ void apply8(int row, int hc, f32x4 a0, f32x4 a1, f32x4 b0, f32x4 b1) const {
        *(u32x4*)(HID + (size_t)row * FF + hc) = pack8(a0 * sigm4(a0) * b0, a1 * sigm4(a1) * b1); } };
struct FMoe2 { bf16_t* MO; const int* tokl; const float* wl; struct Pre { int t; float w; };
    __device__ __forceinline__ Pre load(const pg8::Unit& u, int row, int) const { Pre r; const int pos = u.p0 + (row - u.pm * 256); r.t = -1; r.w = 0.f;
        if (pos < u.ce) { r.t = tokl[(size_t)u.e * R + pos]; r.w = wl[(size_t)u.e * R + pos]; } return r; }
    __device__ __forceinline__ void fin(const pg8::Unit&, int, int col, f32x4 a, f32x4 b, const Pre& q) const { if (q.t < 0) return;
        *(u32x4*)(MO + ((size_t)(q.t & 1) * R + (q.t >> 1)) * D + col) = pack8(a * q.w, b * q.w); } };
struct FOut { Ptrs P; int l; typedef f32x4 Pre; struct UnitPre { f32x4 g[4]; };
    __device__ __forceinline__ UnitPre unit(const pg8::Unit& u, int col0) const { UnitPre r; const float* g = mod_vec(P, l, row_bb(u.pm * 256), 2) + col0;
#pragma unroll
        for (int q = 0; q < 4; ++q) r.g[q] = *(const f32x4*)(g + (q >> 1) * 128 + (q & 1) * 16);
        return r; }
    __device__ __forceinline__ Pre load(const pg8::Unit&, int row, int col) const { return l == 0 ? *(const f32x4*)(xin_row(P, row) + col) : *(const f32x4*)(x1_row(P, row) + col); }
    __device__ __forceinline__ void fin(const pg8::Unit&, int row, int col, f32x4 v, const Pre& xp, const UnitPre& up, int q) const { *(f32x4*)(x1_row(P, row) + col) = xp + up.g[q] * v; } };

struct Frame { LAS unsigned char* lds; int wave, vcu, G; };
#define fresh_tid() (F.wave * 64 + fresh_lane())
__device__ __forceinline__ void tr_item(const float* W, int ldw, int k0, int csrc0, bf16_t* WT, int ldt, int drow0, LAS float* scr, int lane) {
    f32x4 v[8];
#pragma unroll
    for (int i = 0; i < 8; ++i) v[i] = *(const f32x4*)(W + (size_t)(k0 + (lane >> 3) + 8 * i) * ldw + csrc0 + (lane & 7) * 4);
#pragma unroll
    for (int i = 0; i < 8; ++i) { LAS float* d = scr + ((lane >> 3) + 8 * i) * 33 + (lane & 7) * 4; d[0] = v[i].x; d[1] = v[i].y; d[2] = v[i].z; d[3] = v[i].w; }
    LDS_WAIT(); asm volatile("" ::: "memory");
    const int c = lane & 7;
#pragma unroll
    for (int j = 0; j < 4; ++j) { const int n = (lane >> 3) + 8 * j; const LAS float* s = scr + (8 * c) * 33 + n;
        u32x4 o; o.x = cvtpk(s[0 * 33], s[1 * 33]); o.y = cvtpk(s[2 * 33], s[3 * 33]); o.z = cvtpk(s[4 * 33], s[5 * 33]); o.w = cvtpk(s[6 * 33], s[7 * 33]);
        *(u32x4*)(WT + (size_t)(drow0 + n) * ldt + k0 + 8 * c) = o; }
    LDS_WAIT(); asm volatile("" ::: "memory");
}
__device__ __forceinline__ void max_item(const float* W, int ldw, int k0, int csrc0, unsigned* cmax, int lane) {
    f32x4 m = (f32x4){0.f, 0.f, 0.f, 0.f};
#pragma unroll
    for (int i = 0; i < 8; ++i) { const f32x4 v = *(const f32x4*)(W + (size_t)(k0 + (lane >> 3) + 8 * i) * ldw + csrc0 + (lane & 7) * 4);
        m.x = fmaxf(m.x, fabsf(v.x)); m.y = fmaxf(m.y, fabsf(v.y)); m.z = fmaxf(m.z, fabsf(v.z)); m.w = fmaxf(m.w, fabsf(v.w)); }
#pragma unroll
    for (int o = 8; o < 64; o <<= 1) { m.x = fmaxf(m.x, shfl_xor_l(m.x, o, lane)); m.y = fmaxf(m.y, shfl_xor_l(m.y, o, lane)); m.z = fmaxf(m.z, shfl_xor_l(m.z, o, lane)); m.w = fmaxf(m.w, shfl_xor_l(m.w, o, lane)); }
    if (lane < 8) { atomicMax(cmax + lane * 4, __float_as_uint(m.x)); atomicMax(cmax + lane * 4 + 1, __float_as_uint(m.y)); atomicMax(cmax + lane * 4 + 2, __float_as_uint(m.z)); atomicMax(cmax + lane * 4 + 3, __float_as_uint(m.w)); }
}
__device__ __forceinline__ unsigned q8(float v, float inv) { int q = (int)__builtin_rintf(v * inv); q = q < -127 ? -127 : (q > 127 ? 127 : q); return (unsigned)q & 255u; }
__device__ __forceinline__ unsigned q8x4(float a, float b, float c, float d, float inv) { return q8(a, inv) | (q8(b, inv) << 8) | (q8(c, inv) << 16) | (q8(d, inv) << 24); }
__device__ __forceinline__ void tr_item_q(const float* W, int ldw, int k0, int csrc0, unsigned char* WT, int ldt, int drow0, const unsigned* cmax, LAS float* scr, int lane) {
    f32x4 v[8];
#pragma unroll
    for (int i = 0; i < 8; ++i) v[i] = *(const f32x4*)(W + (size_t)(k0 + (lane >> 3) + 8 * i) * ldw + csrc0 + (lane & 7) * 4);
#pragma unroll
    for (int i = 0; i < 8; ++i) { LAS float* d = scr + ((lane >> 3) + 8 * i) * 33 + (lane & 7) * 4; d[0] = v[i].x; d[1] = v[i].y; d[2] = v[i].z; d[3] = v[i].w; }
    LDS_WAIT(); asm volatile("" ::: "memory");
    const int n = lane >> 1, half = lane & 1; const float cm = __uint_as_float(cmax[n]); const float inv = cm > 0.f ? 127.0f / cm : 0.f;
    const LAS float* sp = scr + (half * 32) * 33 + n; unsigned w[8];
#pragma unroll
    for (int q = 0; q < 8; ++q) w[q] = q8x4(sp[(4 * q) * 33], sp[(4 * q + 1) * 33], sp[(4 * q + 2) * 33], sp[(4 * q + 3) * 33], inv);
    u32x4* dp = (u32x4*)(WT + (size_t)(drow0 + n) * ldt + k0 + half * 32);
    dp[0] = (u32x4){w[0], w[1], w[2], w[3]}; dp[1] = (u32x4){w[4], w[5], w[6], w[7]};
    LDS_WAIT(); asm volatile("" ::: "memory");
}
__device__ __forceinline__ void ph_weights(const Frame& F, const Ptrs& P, int l) {
    const int tid0 = fresh_tid(), lane0 = tid0 & 63;
    LAS float* scr = (LAS float*)(F.lds + F.wave * 16384);
    const int gw = F.vcu * NWAVES + F.wave, NGW = F.G * NWAVES;
    unsigned char* wb = P.ws + WS_WB;
    unsigned* cmaxp = (unsigned*)(P.ws + WS_CTL) + CW_CMAX + 32768 * l;
    constexpr int I0 = 1024, I1 = I0 + 2048, I2 = I1 + 768, I3 = I2 + 512, I4 = I3 + 4096, I5 = I4 + 4096, I6 = I5 + 4096;
    for (int it = gw; it < I6; it += NGW) {
        if (it < I0) { const int kb = it >> 6, nb = it & 63; max_item(P.w_in + (size_t)l * 1024 * 2560, 2560, kb * 64, 512 + nb * 32, cmaxp + 1024 + nb * 32, lane0); }
        else if (it < I1) { const int r = it - I0, i = r >> 9, q = r & 511, kb = q >> 5, nb = q & 31; max_item(P.w_gate + ((size_t)l * 4 + i) * 1024 * 1024, 1024, kb * 64, nb * 32, cmaxp + 3072 + i * 1024 + nb * 32, lane0); }
        else if (it < I2) { const int r = it - I1, i = r >> 8, q = r & 255, kb = q >> 5, nb = q & 31; tr_item(P.w_branch + ((size_t)l * 4 + i) * 512 * 1024, 1024, kb * 64, nb * 32, (bf16_t*)(wb + WB_BR) + i * 512, 2048, nb * 32, scr, lane0); }
        else if (it < I3) { const int q = it - I2, kb = q >> 5, nb = q & 31; tr_item(P.w_out + (size_t)l * 1024 * 1024, 1024, kb * 64, nb * 32, (bf16_t*)(wb + WB_OUT), 1024, nb * 32, scr, lane0); }
        else if (it < I5) { const int w3 = it >= I4; const int r = it - (w3 ? I4 : I3), e = r >> 8, q = r & 255, kb = q >> 4, nb = q & 15, c = nb * 32;
            tr_item((w3 ? P.w3 : P.w1) + ((size_t)l * 16 + e) * 1024 * 512, 512, kb * 64, c, (bf16_t*)(wb + WB_13) + (size_t)e * 1024 * 1024, 1024, 256 * (c >> 7) + (c & 127) + (w3 ? 128 : 0), scr, lane0); }
        else { const int r = it - I5, e = r >> 8, q = r & 255, kb = q >> 5, nb = q & 31; tr_item(P.w2 + ((size_t)l * 16 + e) * 512 * 1024, 1024, kb * 64, nb * 32, (bf16_t*)(wb + WB_2) + (size_t)e * 1024 * 512, 512, nb * 32, scr, lane0); }
    }
    __syncthreads();
    for (int u = F.vcu; u < 256; u += F.G) {
        LAS float* Wl = (LAS float*)F.lds; LAS float* ct = Wl + 16 * 128;
        const int kt = u >> 2, g = u & 3, k0 = kt * 16, tid = tid0; const float* w_in = P.w_in + (size_t)l * 1024 * 2560;
        if (tid < 128) ct[tid] = __builtin_amdgcn_cosf((float)tid * (1.0f / 128.0f));
        for (int i = tid; i < 16 * 128; i += 512) { const int k = i >> 7, c = i & 127; Wl[k * 128 + c] = w_in[(size_t)(k0 + k) * 2560 + g * 128 + c]; }
        __syncthreads();
        const int part = (tid >> 7) & 1, m = tid & 127, kh = tid >> 8; const float sc = 0.08838834764831845f;
        float* drow = (float*)(P.ws + WS_FTMP) + (size_t)(part * 512 + g * 128 + m) * 1024 + k0;
        { const int kb = kh * 8; float acc[8];
#pragma unroll
            for (int j = 0; j < 8; ++j) acc[j] = 0.f;
            for (int c = 0; c < 128; ++c) { const int idx = (c * m) & 127; const float tw = part ? -ct[(idx - 32) & 127] : ct[idx];
#pragma unroll
                for (int j = 0; j < 8; ++j) acc[j] += Wl[(kb + j) * 128 + c] * tw; }
            float mx = 0.f;
#pragma unroll
            for (int j = 0; j < 8; ++j) { acc[j] *= sc; mx = fmaxf(mx, fabsf(acc[j])); }
            *(f32x4*)(drow + kb) = (f32x4){acc[0], acc[1], acc[2], acc[3]}; *(f32x4*)(drow + kb + 4) = (f32x4){acc[4], acc[5], acc[6], acc[7]};
            atomicMax(cmaxp + part * 512 + g * 128 + m, __float_as_uint(mx)); }
        __syncthreads();
    }
    for (int u = F.vcu; u < 256; u += F.G) {
        LAS float* Wb = (LAS float*)F.lds;
        const int g = u >> 6, n0 = (u & 63) * 16, tid = tid0;
        const float* ps = P.pool_scale + (size_t)l * 512; const float* wb3 = P.w_branch + ((size_t)l * 4 + 3) * 512 * 1024; const float* pwl = P.pool_w + (size_t)l * 4 * 128 * 128;
        for (int i = tid; i < 128 * 16; i += 512) { const int e = i >> 4, n = i & 15; Wb[e * 16 + n] = ps[g * 128 + e] * wb3[(size_t)(g * 128 + e) * 1024 + n0 + n]; }
        __syncthreads();
        const int c = tid & 127, nh = tid >> 7; const float* pw = pwl + (size_t)(g * 128 + c) * 128;
        float acc[4];
#pragma unroll
        for (int j = 0; j < 4; ++j) acc[j] = 0.f;
        for (int e = 0; e < 128; e += 4) { const f32x4 p4 = *(const f32x4*)(pw + e);
#pragma unroll
            for (int q = 0; q < 4; ++q)
#pragma unroll
                for (int j = 0; j < 4; ++j) acc[j] += p4[q] * Wb[(e + q) * 16 + nh * 4 + j]; }
        bf16_t* Bt = (bf16_t*)(wb + WB_BR) + 3 * 512;
#pragma unroll
        for (int j = 0; j < 4; ++j) Bt[(size_t)(n0 + nh * 4 + j) * 2048 + g * 128 + c] = (bf16_t)f2bf(acc[j]);
        __syncthreads();
    }
}
__device__ __forceinline__ void ph_quant(const Frame& F, const Ptrs& P, int l) {
    const int tid0 = fresh_tid(), lane0 = tid0 & 63;
    LAS float* scr = (LAS float*)(F.lds + F.wave * 16384);
    const int gw = F.vcu * NWAVES + F.wave, NGW = F.G * NWAVES;
    unsigned char* wb = P.ws + WS_WB; const unsigned* cmaxp = (const unsigned*)(P.ws + WS_CTL) + CW_CMAX + 32768 * l;
    constexpr int I0 = 1024, I1 = I0 + 2048;
    for (int it = gw; it < I1; it += NGW) {
        if (it < I0) { const int kb = it >> 6, nb = it & 63; tr_item_q(P.w_in + (size_t)l * 1024 * 2560, 2560, kb * 64, 512 + nb * 32, wb + WB_IN, 1024, 1024 + nb * 32, cmaxp + 1024 + nb * 32, scr, lane0); }
        else { const int r = it - I0, i = r >> 9, q = r & 511, kb = q >> 5, nb = q & 31; tr_item_q(P.w_gate + ((size_t)l * 4 + i) * 1024 * 1024, 1024, kb * 64, nb * 32, wb + WB_GATE + (size_t)i * 1024 * 1024, 1024, nb * 32, cmaxp + 3072 + i * 1024 + nb * 32, scr, lane0); }
    }
    for (int i = F.vcu * 512 + tid0; i < 65536; i += F.G * 512) {
        const int n = i >> 6, kc = (i & 63) * 16; const float cm = __uint_as_float(cmaxp[n]); const float inv = cm > 0.f ? 127.0f / cm : 0.f;
        const f32x4* tp = (const f32x4*)((const float*)(P.ws + WS_FTMP) + (size_t)n * 1024 + kc); const f32x4 a = tp[0], b = tp[1], c = tp[2], d = tp[3];
        *(u32x4*)(wb + WB_IN + (size_t)n * 1024 + kc) = (u32x4){q8x4(a.x, a.y, a.z, a.w, inv), q8x4(b.x, b.y, b.z, b.w, inv), q8x4(c.x, c.y, c.z, c.w, inv), q8x4(d.x, d.y, d.z, d.w, inv)};
    }
    __syncthreads();
}
__device__ __forceinline__ void ph_tables_mod(const Frame& F, const Ptrs& P) {
    const int tid0 = fresh_tid();
    { float* rc = (float*)(P.ws + WS_ROPE); float* rs = rc + 1024; float* ct = (float*)(P.ws + WS_COS);
      const int i = F.vcu * 512 + tid0;
      if (i < 1024) { const int pos = i >> 4, f = i & 15; const float inv = exp2f(-(float)f * (13.287712379549449f / 16.0f));
          float rev = (float)pos * inv * 0.15915494309189535f; rev = rev - floorf(rev);
          rc[i] = __builtin_amdgcn_cosf(rev); rs[i] = __builtin_amdgcn_sinf(rev); }
      if (i < 4096) ct[i] = __builtin_amdgcn_cosf((float)i * (1.0f / 4096.0f));
      if (i < 16384) { const int mm = i >> 7, k = i & 127, pp = mm >> 6, k1 = mm & 63, pk = k >> 6, t1 = k & 63; const float rev = (float)((k1 * t1) & 63) * (1.0f / 64.0f);
          const float c = __builtin_amdgcn_cosf(rev), sn = __builtin_amdgcn_sinf(rev);
          ((bf16_t*)(P.ws + WS_DFTM))[i] = (bf16_t)f2bf(pp == pk ? c : (pp == 0 ? sn : -sn)); } }
    for (int u = F.vcu; u < 192; u += F.G) {
        LAS float* s = (LAS float*)F.lds; LAS float* red = s + 9 * 1024;
        const int l = u / 96, j0 = (u % 96) * 64, tid = tid0;
        for (int i = tid; i < 9 * 1024; i += 512) { const int bb = i >> 10, k = i & 1023; const float v = bb < 8 ? P.c[bb * 1024 + k] : P.c_ctx[k]; s[i] = v / (1.f + expf(-v)); }
        __syncthreads();
        const int kc = tid >> 6, jj = tid & 63; float acc[9];
#pragma unroll
        for (int b = 0; b < 9; ++b) acc[b] = 0.f;
        const float* w = P.w_ada + (size_t)l * 1024 * 6144 + j0 + jj;
        for (int k = kc * 128; k < kc * 128 + 128; k += 8) { float wv[8];
#pragma unroll
            for (int q = 0; q < 8; ++q) wv[q] = w[(size_t)(k + q) * 6144];
#pragma unroll
            for (int q = 0; q < 8; ++q)
#pragma unroll
                for (int b = 0; b < 9; ++b) acc[b] += s[b * 1024 + k + q] * wv[q]; }
#pragma unroll
        for (int b = 0; b < 9; ++b) red[(kc * 9 + b) * 64 + jj] = acc[b];
        __syncthreads();
        float* mod = (float*)(P.ws + WS_MOD);
        for (int i = tid; i < 9 * 64; i += 512) { const int b = i >> 6, j = i & 63; float v = P.b_ada[l * 6144 + j0 + j];
#pragma unroll
            for (int q = 0; q < 8; ++q) v += red[(q * 9 + b) * 64 + j];
            mod[(size_t)(l * 9 + b) * 6144 + j0 + j] = v; }
        __syncthreads();
    }
}
__device__ __forceinline__ void route_row(const Ptrs& P, int r, const f32x4 (&h)[4], int lane, bool publish, LAS unsigned* lcnt, LAS int* rec, const LAS float* rwl) {
    float lg[16];
#pragma unroll
    for (int e = 0; e < 16; ++e) lg[e] = 0.f;
#pragma unroll
    for (int j = 0; j < 4; ++j) {
#pragma unroll
        for (int i = 0; i < 4; ++i) { const int kk = 4 * lane + 256 * j + i; const LAS f32x4* rw = (const LAS f32x4*)(rwl + kk * 16 + (kk >> 2) * 4); const float hv = h[j][i];
#pragma unroll
            for (int qd = 0; qd < 4; ++qd) { const f32x4 w = rw[qd]; lg[4 * qd] += hv * w.x; lg[4 * qd + 1] += hv * w.y; lg[4 * qd + 2] += hv * w.z; lg[4 * qd + 3] += hv * w.w; } }
        __builtin_amdgcn_sched_barrier(0); }
    float v8[8], v4[4], v2[2], v1;
    { const bool bit = (lane & 32) != 0;
#pragma unroll
      for (int i = 0; i < 8; ++i) { const float a = lg[i], b = lg[i + 8]; v8[i] = (bit ? b : a) + shfl_xor_l(bit ? a : b, 32, lane); } }
    { const bool bit = (lane & 16) != 0;
#pragma unroll
      for (int i = 0; i < 4; ++i) { const float a = v8[i], b = v8[i + 4]; v4[i] = (bit ? b : a) + shfl_xor_l(bit ? a : b, 16, lane); } }
    { const bool bit = (lane & 8) != 0;
#pragma unroll
      for (int i = 0; i < 2; ++i) { const float a = v4[i], b = v4[i + 2]; v2[i] = (bit ? b : a) + shfl_xor_l(bit ? a : b, 8, lane); } }
    { const bool bit = (lane & 4) != 0; const float a = v2[0], b = v2[1]; v1 = (bit ? b : a) + shfl_xor_l(bit ? a : b, 4, lane); }
    v1 += shfl_xor_l(v1, 2, lane); v1 += shfl_xor_l(v1, 1, lane);
    float bestscore = -INFINITY; int be0 = 0, be1 = 1; float ba0 = 0.f, ba1 = 0.f;
#pragma unroll
    for (int g = 0; g < 4; ++g) {
        float aff[4], sel[4];
#pragma unroll
        for (int i = 0; i < 4; ++i) { const float t = __int_as_float(__builtin_amdgcn_ds_bpermute((4 * g + i) << 4, __float_as_int(v1))); aff[i] = 1.0f / (1.0f + expf(-t)); sel[i] = aff[i] + P.router_bias[4 * g + i]; }
        int i1 = 0; float m1 = sel[0], a1 = aff[0];
#pragma unroll
        for (int i = 1; i < 4; ++i) if (sel[i] > m1) { m1 = sel[i]; a1 = aff[i]; i1 = i; }
        int i2 = -1; float m2 = -INFINITY, a2 = 0.f;
#pragma unroll
        for (int i = 0; i < 4; ++i) if (i != i1 && sel[i] > m2) { m2 = sel[i]; a2 = aff[i]; i2 = i; }
        const float score = m1 + m2;
        if (score > bestscore) { bestscore = score; be0 = 4 * g + i1; be1 = 4 * g + i2; ba0 = a1; ba1 = a2; }
    }
    if (lane == 0 && publish) {
        const int p0 = (int)__hip_atomic_fetch_add(lcnt + be0, 1u, __ATOMIC_RELAXED, __HIP_MEMORY_SCOPE_WORKGROUP), p1 = (int)__hip_atomic_fetch_add(lcnt + be1, 1u, __ATOMIC_RELAXED, __HIP_MEMORY_SCOPE_WORKGROUP);
        const float inv = 1.0f / (ba0 + ba1);
        rec[0] = r; rec[1] = be0; rec[2] = p0; rec[3] = be1; rec[4] = p1; rec[5] = __float_as_int(ba0 * inv); rec[6] = __float_as_int(ba1 * inv);
    }
}
template <int MODE> __device__ __forceinline__ void ph_norm(const Frame& F, const Ptrs& P, int l, int nrows) {
    constexpr int NRW = MODE == 2 ? 2 : 4;
    const int lane = fresh_lane();
    const int stride = F.G * NWAVES;
    LAS unsigned* lcnt = (LAS unsigned*)F.lds; LAS unsigned* gbase = lcnt + 16; LAS int* recs = (LAS int*)(F.lds + 256);
    const LAS float* rwl = (const LAS float*)(F.lds + 8192);
    if (MODE == 2) { if (F.wave == 0 && lane < 16) lcnt[lane] = 0u;
        { const int tid = F.wave * 64 + lane; LAS f32x4* d = (LAS f32x4*)(F.lds + 8192);
#pragma unroll
          for (int i = 0; i < 8; ++i) { const int idx = tid + 512 * i, kk = idx >> 2; d[idx + (kk >> 2)] = ((const f32x4*)P.router_w)[idx]; } }
        __syncthreads(); }
    int it = 0;
    for (int rb = F.vcu * NWAVES + F.wave; rb < nrows; rb += NRW * stride, ++it) {
        int rr[NRW];
#pragma unroll
        for (int q = 0; q < NRW; ++q) rr[q] = rb + q * stride < nrows ? rb + q * stride : rb;
        f32x4 v[NRW][4];
#pragma unroll
        for (int q = 0; q < NRW; ++q) { const int r = rr[q];
            if (MODE == 0) { const f32x4* xr = (const f32x4*)xin_row(P, r) + lane;
#pragma unroll
                for (int j = 0; j < 4; ++j) v[q][j] = xr[64 * j]; }
            else { const f32x4* xr = (const f32x4*)x1_row(P, r) + lane;
#pragma unroll
                for (int j = 0; j < 4; ++j) v[q][j] = xr[64 * j]; } }
        if (MODE == 1) {
#pragma unroll
            for (int q = 0; q < NRW; ++q) { const int r = rr[q]; const int bb = row_bb(r); const f32x4* g2 = (const f32x4*)mod_vec(P, l - 1, bb, 5) + lane;
                const u32x2* m0 = (const u32x2*)((const bf16_t*)(P.ws + WS_MO) + (size_t)r * D) + lane; const u32x2* m1 = (const u32x2*)((const bf16_t*)(P.ws + WS_MO) + (size_t)(R + r) * D) + lane;
#pragma unroll
                for (int j = 0; j < 4; ++j) { const u32x2 a = m0[64 * j], b = m1[64 * j]; const f32x4 g = g2[64 * j];
                    v[q][j].x += g.x * (lo16(a.x) + lo16(b.x)); v[q][j].y += g.y * (hi16(a.x) + hi16(b.x)); v[q][j].z += g.z * (lo16(a.y) + lo16(b.y)); v[q][j].w += g.w * (hi16(a.y) + hi16(b.y)); } }
#pragma unroll
            for (int q = 0; q < NRW; ++q) if (q == 0 || rr[q] != rr[0]) { f32x4* xr = (f32x4*)x1_row(P, rr[q]) + lane;
#pragma unroll
                for (int j = 0; j < 4; ++j) xr[64 * j] = v[q][j]; }
        }
        float ss[NRW];
#pragma unroll
        for (int q = 0; q < NRW; ++q) { ss[q] = 0.f;
#pragma unroll
            for (int j = 0; j < 4; ++j) ss[q] += (v[q][j].x * v[q][j].x + v[q][j].y * v[q][j].y) + (v[q][j].z * v[q][j].z + v[q][j].w * v[q][j].w); }
#pragma unroll
        for (int o = 1; o < 64; o <<= 1) {
#pragma unroll
            for (int q = 0; q < NRW; ++q) ss[q] += shfl_xor_l(ss[q], o, lane); }
        const f32x4* gn = (const f32x4*)((MODE == 2 ? P.norm2 : P.norm1) + (size_t)l * D) + lane;
#pragma unroll
        for (int q = 0; q < NRW; ++q) { const int r = rr[q]; const int bb = row_bb(r);
            if (q > 0 && r == rr[0]) continue;
            const float rstd = 1.0f / sqrtf(ss[q] * (1.0f / D) + EPS);
            const f32x4* sh = (const f32x4*)mod_vec(P, l, bb, MODE == 2 ? 3 : 0) + lane;
            const f32x4* sc = (const f32x4*)mod_vec(P, l, bb, MODE == 2 ? 4 : 1) + lane;
            if (MODE == 2) { u32x2* o = (u32x2*)((bf16_t*)(P.ws + WS_H) + (size_t)r * D) + lane;
#pragma unroll
                for (int j = 0; j < 4; ++j) { const f32x4 g = gn[64 * j], a = sh[64 * j], b = sc[64 * j];
                    v[q][j] = (v[q][j] * rstd * g) * (b + 1.0f) + a;
                    u32x2 w; w.x = cvtpk(v[q][j].x, v[q][j].y); w.y = cvtpk(v[q][j].z, v[q][j].w); o[64 * j] = w; } }
            else {
                float mx = 0.f;
#pragma unroll
                for (int j = 0; j < 4; ++j) { const f32x4 g = gn[64 * j], a = sh[64 * j], b = sc[64 * j];
                    v[q][j] = (v[q][j] * rstd * g) * (b + 1.0f) + a;
                    mx = fmaxf(mx, fmaxf(fmaxf(fabsf(v[q][j].x), fabsf(v[q][j].y)), fmaxf(fabsf(v[q][j].z), fabsf(v[q][j].w)))); }
#pragma unroll
                for (int o = 1; o < 64; o <<= 1) mx = fmaxf(mx, shfl_xor_l(mx, o, lane));
                const float inv = mx > 0.f ? 127.0f / mx : 0.f;
                unsigned* o8 = (unsigned*)(P.ws + WS_H + (size_t)r * D) + lane;
#pragma unroll
                for (int j = 0; j < 4; ++j) o8[64 * j] = q8x4(v[q][j].x, v[q][j].y, v[q][j].z, v[q][j].w, inv);
                if (lane == 0) ((float*)(P.ws + WS_SA))[r] = mx * (1.0f / 127.0f); } }
        if (MODE == 2) { LAS int* rec = recs + (F.wave * 24 + 2 * it) * 8;
            route_row(P, rr[0], v[0], lane, true, lcnt, rec, rwl); __builtin_amdgcn_sched_barrier(0);
            if (lane == 0 && rr[1] == rr[0]) rec[8] = -1;
            route_row(P, rr[1], v[1], lane, rr[1] != rr[0], lcnt, rec + 8, rwl); }
    }
    if (MODE == 2) {
        __syncthreads();
        const int tid = F.wave * 64 + lane;
        if (tid < 16) { const unsigned c = lcnt[tid]; gbase[tid] = c ? atomicAdd((unsigned*)(P.ws + WS_CTL) + CW_CNT + 1024 * l + 64 * tid, c) : 0u; }
        __syncthreads();
        if (lane == 0) for (int k = 0; k < 2 * it; ++k) { const LAS int* rec = recs + (F.wave * 24 + k) * 8; const int r = rec[0]; if (r < 0) continue;
            int* tokl = (int*)(P.ws + WS_TOKL); float* wl = (float*)(P.ws + WS_WL);
            const size_t i0 = (size_t)rec[1] * R + rec[2] + gbase[rec[1]], i1 = (size_t)rec[3] * R + rec[4] + gbase[rec[3]];
            tokl[i0] = 2 * r; wl[i0] = __int_as_float(rec[5]); tokl[i1] = 2 * r + 1; wl[i1] = __int_as_float(rec[6]); }
        __syncthreads();
    }
}
__device__ __forceinline__ void ph_kprep(const Frame& F, const Ptrs& P, int l) {
    const int lane = fresh_lane();
    const float* rc = (const float*)(P.ws + WS_ROPE); const float* rs = rc + 1024;
    const int hs = (lane >> 3) & 3, chunk = lane & 7, col = (hs < 2 ? C_KB + hs * 64 : C_KW + (hs - 2) * 64) + chunk * 8;
    const f32x4 g0 = *(const f32x4*)(P.k_gain + l * 64 + chunk * 8), g1 = *(const f32x4*)(P.k_gain + l * 64 + chunk * 8 + 4);
    const int a = chunk >> 2, fi = (chunk & 1) * 8; const bool second = (chunk & 2) != 0;
    const int npair = R / 2, stride = F.G * NWAVES;
    for (int pr0 = F.vcu * NWAVES + F.wave; pr0 < npair; pr0 += 4 * stride) {
        u32x4 w[4];
#pragma unroll
        for (int q = 0; q < 4; ++q) { const int pr = pr0 + q * stride; const int r = 2 * (pr < npair ? pr : pr0) + (lane >> 5); w[q] = *(const u32x4*)((const bf16_t*)(P.ws + WS_U) + (size_t)r * NIN + col); }
#pragma unroll
        for (int q = 0; q < 4; ++q) { const int pr = pr0 + q * stride; if (pr >= npair) break;
            const int r = 2 * pr + (lane >> 5);
            float x[8] = {lo16(w[q].x), hi16(w[q].x), lo16(w[q].y), hi16(w[q].y), lo16(w[q].z), hi16(w[q].z), lo16(w[q].w), hi16(w[q].w)};
            if (hs < 2) { float ss = 0.f;
#pragma unroll
                for (int j = 0; j < 8; ++j) ss += x[j] * x[j];
                ss += shfl_xor_l(ss, 1, lane); ss += shfl_xor_l(ss, 2, lane); ss += shfl_xor_l(ss, 4, lane);
                const float rstd = 1.0f / sqrtf(ss * (1.0f / 64.0f) + EPS);
                x[0] *= rstd * g0.x; x[1] *= rstd * g0.y; x[2] *= rstd * g0.z; x[3] *= rstd * g0.w; x[4] *= rstd * g1.x; x[5] *= rstd * g1.y; x[6] *= rstd * g1.z; x[7] *= rstd * g1.w; }
            if (r < RL) { const int t = r & (T - 1), pos = a ? (t & 63) : (t >> 6);
                const f32x4 c0 = *(const f32x4*)(rc + pos * 16 + fi), c1 = *(const f32x4*)(rc + pos * 16 + fi + 4), s0 = *(const f32x4*)(rs + pos * 16 + fi), s1 = *(const f32x4*)(rs + pos * 16 + fi + 4);
                const float cs[8] = {c0.x, c0.y, c0.z, c0.w, c1.x, c1.y, c1.z, c1.w}, sn[8] = {s0.x, s0.y, s0.z, s0.w, s1.x, s1.y, s1.z, s1.w};
#pragma unroll
                for (int j = 0; j < 8; ++j) { const float y = shfl_xor_l(x[j], 2, lane); x[j] = second ? x[j] * cs[j] + y * sn[j] : x[j] * cs[j] - y * sn[j]; } }
            u32x4 o; o.x = cvtpk(x[0], x[1]); o.y = cvtpk(x[2], x[3]); o.z = cvtpk(x[4], x[5]); o.w = cvtpk(x[6], x[7]);
            *(u32x4*)((bf16_t*)(P.ws + WS_U) + (size_t)r * NIN + col) = o; }
    }
}
__device__ __forceinline__ void ph_pool(const Frame& F, const Ptrs& P, int nrows) {
    const int tid0 = fresh_tid();
    for (int i = F.vcu * 512 + tid0; i < nrows * 64; i += F.G * 512) {
        const int r = i >> 6, c8 = (i & 63) * 8;
        const bool lat = r < RL; const int Ts = lat ? T : TC; const int t = lat ? (r & (T - 1)) : ((r - RL) & (TC - 1)); const int r0 = r - t;
        const int g = c8 >> 7, hw = 1 << g;
        const int lo = t - hw < 0 ? 0 : t - hw, hi = t + hw > Ts ? Ts : t + hw;
        const bf16_t* U = (const bf16_t*)(P.ws + WS_U) + C_P + c8;
        u32x4 wv[16];
#pragma unroll
        for (int k = 0; k < 16; ++k) { const int tt = t - 8 + k; const bool ok = tt >= lo && tt < hi; wv[k] = *(const u32x4*)(U + (size_t)(r0 + (ok ? tt : t)) * NIN); }
        float s[8];
#pragma unroll
        for (int j = 0; j < 8; ++j) s[j] = 0.f;
#pragma unroll
        for (int k = 0; k < 16; ++k) { const int tt = t - 8 + k; const float f = (tt >= lo && tt < hi) ? 1.f : 0.f; const u32x4 w = wv[k];
            s[0] += f * lo16(w.x); s[1] += f * hi16(w.x); s[2] += f * lo16(w.y); s[3] += f * hi16(w.y); s[4] += f * lo16(w.z); s[5] += f * hi16(w.z); s[6] += f * lo16(w.w); s[7] += f * hi16(w.w); }
        const u32x4 w = wv[8]; const float inv = 1.0f / (float)(hi - lo);
        u32x4 o; o.x = cvtpk(s[0] * inv - lo16(w.x), s[1] * inv - hi16(w.x)); o.y = cvtpk(s[2] * inv - lo16(w.y), s[3] * inv - hi16(w.y));
        o.z = cvtpk(s[4] * inv - lo16(w.z), s[5] * inv - hi16(w.z)); o.w = cvtpk(s[6] * inv - lo16(w.w), s[7] * inv - hi16(w.w));
        *(u32x4*)((bf16_t*)(P.ws + WS_BR) + (size_t)r * NBR + 1536 + c8) = o;
    }
}
__device__ __forceinline__ void ph_final(const Frame& F, const Ptrs& P) {
    const int lane = fresh_lane(); const int stride = F.G * NWAVES;
    for (int rb = F.vcu * NWAVES + F.wave; rb < RL; rb += 4 * stride) {
        f32x4 v[4][4]; float ss[4];
#pragma unroll
        for (int q = 0; q < 4; ++q) { const int r = rb + q * stride < RL ? rb + q * stride : rb; const int bb = row_bb(r);
            const f32x4* xr = (const f32x4*)(P.out + (size_t)r * D) + lane; const f32x4* g2 = (const f32x4*)mod_vec(P, 1, bb, 5) + lane;
            const u32x2* m0 = (const u32x2*)((const bf16_t*)(P.ws + WS_MO) + (size_t)r * D) + lane; const u32x2* m1 = (const u32x2*)((const bf16_t*)(P.ws + WS_MO) + (size_t)(R + r) * D) + lane;
            ss[q] = 0.f;
#pragma unroll
            for (int j = 0; j < 4; ++j) { v[q][j] = xr[64 * j]; const u32x2 a = m0[64 * j], b = m1[64 * j]; const f32x4 g = g2[64 * j];
                v[q][j].x += g.x * (lo16(a.x) + lo16(b.x)); v[q][j].y += g.y * (hi16(a.x) + hi16(b.x)); v[q][j].z += g.z * (lo16(a.y) + lo16(b.y)); v[q][j].w += g.w * (hi16(a.y) + hi16(b.y));
                ss[q] += (v[q][j].x * v[q][j].x + v[q][j].y * v[q][j].y) + (v[q][j].z * v[q][j].z + v[q][j].w * v[q][j].w); } }
#pragma unroll
        for (int o = 1; o < 64; o <<= 1) {
#pragma unroll
            for (int q = 0; q < 4; ++q) ss[q] += shfl_xor_l(ss[q], o, lane); }
        const f32x4* gn = (const f32x4*)P.norm_f + lane;
#pragma unroll
        for (int q = 0; q < 4; ++q) { const int r = rb + q * stride; if (r >= RL) continue;
            const float rstd = 1.0f / sqrtf(ss[q] * (1.0f / D) + EPS); f32x4* xr = (f32x4*)(P.out + (size_t)r * D) + lane;
#pragma unroll
            for (int j = 0; j < 4; ++j) xr[64 * j] = v[q][j] * rstd * gn[64 * j]; }
    }
}

__device__ __forceinline__ void ph_fourier_ref(const Frame& F, const Ptrs& P, int Ts, int latent) {
    const int tid = fresh_tid();
    LAS float* Zr = (LAS float*)F.lds; LAS float* Zi = Zr + 16 * 64; LAS float* Ct = Zi + 16 * 64; LAS float* St = Ct + 64 * 17;
    const bf16_t* U = (const bf16_t*)(P.ws + WS_U); const float* ct = (const float*)(P.ws + WS_COS);
    const int nkt = Ts / 64, NU = 8 * nkt * 8, step = 4096 / Ts;
    const int tk = tid >> 4, tc = tid & 15;
    for (int u = F.vcu; u < NU; u += F.G) {
        const int cht = u & 7, kt = (u >> 3) % nkt, b = (u >> 3) / nkt, k0 = kt * 64, ch0 = cht * 64;
        const int rbase = latent ? b * T : RL + b * TC;
        float acc[2][4];
#pragma unroll
        for (int i = 0; i < 2; ++i)
#pragma unroll
            for (int j = 0; j < 4; ++j) acc[i][j] = 0.f;
        for (int t0 = 0; t0 < Ts; t0 += 16) {
            __syncthreads();
            if (tid < 256) { const int tt = tid >> 4, c4 = (tid & 15) * 4; const bf16_t* zp = U + (size_t)(rbase + t0 + tt) * NIN + ch0 + c4;
              const u32x2 a = *(const u32x2*)(zp + C_ZR), bq = *(const u32x2*)(zp + C_ZI);
              Zr[tt * 64 + c4] = lo16(a.x); Zr[tt * 64 + c4 + 1] = hi16(a.x); Zr[tt * 64 + c4 + 2] = lo16(a.y); Zr[tt * 64 + c4 + 3] = hi16(a.y);
              Zi[tt * 64 + c4] = lo16(bq.x); Zi[tt * 64 + c4 + 1] = hi16(bq.x); Zi[tt * 64 + c4 + 2] = lo16(bq.y); Zi[tt * 64 + c4 + 3] = hi16(bq.y); }
#pragma unroll
            for (int i = 0; i < 2; ++i) { const int e = tid * 2 + i, k = e >> 4, tt = e & 15; const int ang = (((k0 + k) * (t0 + tt)) & (Ts - 1)) * step;
                Ct[k * 17 + tt] = ct[ang]; St[k * 17 + tt] = ct[(ang - 1024) & 4095]; }
            __syncthreads();
#pragma unroll 2
            for (int tt = 0; tt < 16; ++tt) { float zr[4], zi[4];
#pragma unroll
                for (int j = 0; j < 4; ++j) { zr[j] = Zr[tt * 64 + tc * 4 + j]; zi[j] = Zi[tt * 64 + tc * 4 + j]; }
#pragma unroll
                for (int i = 0; i < 2; ++i) { const float c = Ct[(tk * 2 + i) * 17 + tt], sn = St[(tk * 2 + i) * 17 + tt];
#pragma unroll
                    for (int j = 0; j < 4; ++j) acc[i][j] += c * zr[j] + sn * zi[j]; } }
        }
        const float sc = 1.0f / sqrtf((float)Ts);
        bf16_t* BR = (bf16_t*)(P.ws + WS_BR);
#pragma unroll
        for (int i = 0; i < 2; ++i) { u32x2 w; w.x = pk2(acc[i][0] * sc, acc[i][1] * sc); w.y = pk2(acc[i][2] * sc, acc[i][3] * sc);
            *(u32x2*)(BR + (size_t)(rbase + k0 + tk * 2 + i) * NBR + ch0 + tc * 4) = w; }
        __syncthreads();
    }
}

typedef float f32x16 __attribute__((ext_vector_type(16)));
typedef short v4i16_t __attribute__((ext_vector_type(4)));
constexpr float ATT_THR = 4.0f;
constexpr int AT_ROWB = 144, AT_TILEB = 64 * AT_ROWB;
constexpr int AT_VROWB = 192, AT_VTILEB = 64 * AT_VROWB;
constexpr int AT_STAGEB = 2 * AT_TILEB + 2 * AT_VTILEB;
#define AT_SB() __builtin_amdgcn_sched_barrier(0)
template <bool FIXED> __device__ __forceinline__ void at_qk1(const LAS unsigned char* Kt, int kf_off, const bf16x8 (&qr)[4], const f32x16& negm_, f32x16& p0, f32x16& p1) {
    f32x16 zc;
#pragma unroll
    for (int r = 0; r < 16; ++r) zc[r] = 0.f;
    const f32x16& negm = FIXED ? zc : negm_;
    bf16x8 ka[8];
#pragma unroll
    for (int d0 = 0; d0 < 4; ++d0) { ka[2 * d0] = *(const LAS bf16x8*)(Kt + kf_off + d0 * 32); ka[2 * d0 + 1] = *(const LAS bf16x8*)(Kt + kf_off + 32 * AT_ROWB + d0 * 32); }
    p0 = __builtin_amdgcn_mfma_f32_32x32x16_bf16(ka[0], qr[0], negm, 0, 0, 0); p1 = __builtin_amdgcn_mfma_f32_32x32x16_bf16(ka[1], qr[0], negm, 0, 0, 0);
#pragma unroll
    for (int d0 = 1; d0 < 4; ++d0) { p0 = __builtin_amdgcn_mfma_f32_32x32x16_bf16(ka[2 * d0], qr[d0], p0, 0, 0, 0); p1 = __builtin_amdgcn_mfma_f32_32x32x16_bf16(ka[2 * d0 + 1], qr[d0], p1, 0, 0, 0); }
}
__device__ __forceinline__ void at_vread(const LAS unsigned char* vp, v4i16_t (&f)[4]) {
    f[0] = __builtin_amdgcn_ds_read_tr16_b64_v4i16((LAS v4i16_t*)(vp)); f[1] = __builtin_amdgcn_ds_read_tr16_b64_v4i16((LAS v4i16_t*)(vp + 8 * AT_VROWB));
    f[2] = __builtin_amdgcn_ds_read_tr16_b64_v4i16((LAS v4i16_t*)(vp + 64)); f[3] = __builtin_amdgcn_ds_read_tr16_b64_v4i16((LAS v4i16_t*)(vp + 8 * AT_VROWB + 64));
}
__device__ __forceinline__ bf16x8 at_ppack(const f32x16& p, int sx) { u32x4 pw; pw.x = cvtpk(p[8 * sx], p[8 * sx + 1]); pw.y = cvtpk(p[8 * sx + 2], p[8 * sx + 3]); pw.z = cvtpk(p[8 * sx + 4], p[8 * sx + 5]); pw.w = cvtpk(p[8 * sx + 6], p[8 * sx + 7]); return __builtin_bit_cast(bf16x8, pw); }
__device__ __forceinline__ void at_pvmm(const v4i16_t (&f)[4], const bf16x8 pf, f32x16& o0, f32x16& o1) {
    const bf16x8 v0 = (bf16x8){f[0][0], f[0][1], f[0][2], f[0][3], f[1][0], f[1][1], f[1][2], f[1][3]}, v1 = (bf16x8){f[2][0], f[2][1], f[2][2], f[2][3], f[3][0], f[3][1], f[3][2], f[3][3]};
    o0 = __builtin_amdgcn_mfma_f32_32x32x16_bf16(v0, pf, o0, 0, 0, 0); o1 = __builtin_amdgcn_mfma_f32_32x32x16_bf16(v1, pf, o1, 0, 0, 0);
}
__device__ __forceinline__ float at_exp8(f32x16& p, int sx) { float rs = 0.f;
#pragma unroll
    for (int j = 0; j < 8; ++j) { p[8 * sx + j] = __builtin_amdgcn_exp2f(p[8 * sx + j]); rs += p[8 * sx + j]; }
    return rs; }
template <bool FIXED> __device__ __forceinline__ float at_slot(const LAS unsigned char* Vt, const LAS unsigned char* Kn, const bool hasnext, int kf_off, int vf_off, const bf16x8 (&qr)[4], const f32x16& negm_,
                                         f32x16& pc0, f32x16& pc1, f32x16& pn0, f32x16& pn1, f32x16& o0, f32x16& o1) {
    f32x16 zc;
#pragma unroll
    for (int r = 0; r < 16; ++r) zc[r] = 0.f;
    const f32x16& negm = FIXED ? zc : negm_;
    v4i16_t fA[4], fB[4]; bf16x8 ka0, ka1, kb0, kb1; float rs;
#define AT_KLD(A0, A1, d0) do { A0 = *(const LAS bf16x8*)(Kn + kf_off + (d0) * 32); A1 = *(const LAS bf16x8*)(Kn + kf_off + 32 * AT_ROWB + (d0) * 32); } while (0)
    if (FIXED) AT_KLD(ka0, ka1, 0);
    at_vread(Vt + vf_off, fA); rs = at_exp8(pc0, 0); AT_SB();
    at_vread(Vt + vf_off + 16 * AT_VROWB, fB); if (FIXED) AT_KLD(kb0, kb1, 1); else AT_KLD(ka0, ka1, 0);
    if (hasnext) { pn0 = __builtin_amdgcn_mfma_f32_32x32x16_bf16(ka0, qr[0], negm, 0, 0, 0); pn1 = __builtin_amdgcn_mfma_f32_32x32x16_bf16(ka1, qr[0], negm, 0, 0, 0); }
    at_pvmm(fA, at_ppack(pc0, 0), o0, o1); rs += at_exp8(pc0, 1); AT_SB();
    at_vread(Vt + vf_off + 32 * AT_VROWB, fA); if (FIXED) AT_KLD(ka0, ka1, 2); else AT_KLD(kb0, kb1, 1);
    if (hasnext) { pn0 = __builtin_amdgcn_mfma_f32_32x32x16_bf16(kb0, qr[1], pn0, 0, 0, 0); pn1 = __builtin_amdgcn_mfma_f32_32x32x16_bf16(kb1, qr[1], pn1, 0, 0, 0); }
    at_pvmm(fB, at_ppack(pc0, 1), o0, o1); rs += at_exp8(pc1, 0); AT_SB();
    at_vread(Vt + vf_off + 48 * AT_VROWB, fB); if (FIXED) AT_KLD(kb0, kb1, 3); else AT_KLD(ka0, ka1, 2);
    if (hasnext) { pn0 = __builtin_amdgcn_mfma_f32_32x32x16_bf16(ka0, qr[2], pn0, 0, 0, 0); pn1 = __builtin_amdgcn_mfma_f32_32x32x16_bf16(ka1, qr[2], pn1, 0, 0, 0); }
    at_pvmm(fA, at_ppack(pc1, 0), o0, o1); rs += at_exp8(pc1, 1); AT_SB();
    if (!FIXED) AT_KLD(kb0, kb1, 3);
    if (hasnext) { pn0 = __builtin_amdgcn_mfma_f32_32x32x16_bf16(kb0, qr[3], pn0, 0, 0, 0); pn1 = __builtin_amdgcn_mfma_f32_32x32x16_bf16(kb1, qr[3], pn1, 0, 0, 0); }
    at_pvmm(fB, at_ppack(pc1, 1), o0, o1);
#undef AT_KLD
    return rs;
}
template <int MODE, bool FIXED> __device__ __forceinline__ void ph_attn_impl(const Frame& F, const Ptrs& P, int l) {
    const bool latq = MODE < 2; const bool winm = (MODE == 1 || MODE == 3);
    const int NU = latq ? 1024 : 64;
    LAS unsigned char* Lb = F.lds;
    constexpr bool fixedref = FIXED;
    for (int u = F.vcu; u < NU; u += F.G) {
        const int lane = fresh_lane(), tid = F.wave * 64 + lane, r32 = lane & 31, hi = lane >> 5;
        const bf16_t* U = (const bf16_t*)(P.ws + WS_U);
        const int st_off = (tid >> 3) * AT_ROWB + (tid & 7) * 16;
        const int kf_off = r32 * AT_ROWB + hi * 16;
        const int sv_off = (tid >> 3) * AT_VROWB + (tid & 7) * 16;
        const int vf_off = (4 * hi + ((lane & 15) >> 2)) * AT_VROWB + (((lane >> 4) & 1) * 16 + (lane & 3) * 4) * 2;
        const int qb = latq ? (u & 63) : (u & 3), g = latq ? ((u >> 6) & 1) : ((u >> 2) & 1), b = latq ? (u >> 7) : (u >> 3);
        const int tq0 = qb * 64, hq = 4 * g + (F.wave >> 1), tq = tq0 + 32 * (F.wave & 1) + r32;
        const int qrow = latq ? b * T + tq : RL + b * TC + tq;
        const int qcol = (winm ? C_QW : C_QB) + hq * 64, kcol = (winm ? C_KW : C_KB) + g * 64, vcol = (winm ? C_VW : C_VB) + g * 64;
        int lt_lo = 0, lt_hi = 0;
        if (MODE == 0) { lt_lo = 0; lt_hi = T / 64; }
        if (MODE == 1) { lt_lo = (tq0 - 128 < 0 ? 0 : tq0 - 128) / 64; lt_hi = (tq0 + 192 > T ? T : tq0 + 192) / 64; }
        const int ntiles = 4 + (lt_hi - lt_lo), npairs = (ntiles + 1) >> 1;
        bf16x8 qr[4];
        {
            float x[4][8];
#pragma unroll
            for (int d0 = 0; d0 < 4; ++d0) { const u32x4 wq = *(const u32x4*)(U + (size_t)qrow * NIN + qcol + d0 * 16 + hi * 8);
                x[d0][0] = lo16(wq.x); x[d0][1] = hi16(wq.x); x[d0][2] = lo16(wq.y); x[d0][3] = hi16(wq.y); x[d0][4] = lo16(wq.z); x[d0][5] = hi16(wq.z); x[d0][6] = lo16(wq.w); x[d0][7] = hi16(wq.w); }
            if (!winm) { float ss = 0.f;
#pragma unroll
                for (int d0 = 0; d0 < 4; ++d0)
#pragma unroll
                    for (int j = 0; j < 8; ++j) ss += x[d0][j] * x[d0][j];
                ss += shfl_xor_l(ss, 32, lane);
                const float rstd = 1.0f / sqrtf(ss * (1.0f / 64.0f) + EPS);
#pragma unroll
                for (int d0 = 0; d0 < 4; ++d0) { const f32x4 ga = *(const f32x4*)(P.q_gain + l * 64 + d0 * 16 + hi * 8), gb = *(const f32x4*)(P.q_gain + l * 64 + d0 * 16 + hi * 8 + 4);
                    x[d0][0] *= rstd * ga.x; x[d0][1] *= rstd * ga.y; x[d0][2] *= rstd * ga.z; x[d0][3] *= rstd * ga.w; x[d0][4] *= rstd * gb.x; x[d0][5] *= rstd * gb.y; x[d0][6] *= rstd * gb.z; x[d0][7] *= rstd * gb.w; } }
            if (latq) { const float* rc = (const float*)(P.ws + WS_ROPE); const float* rs = rc + 1024;
#pragma unroll
                for (int a = 0; a < 2; ++a) { const int pos = a ? (tq & 63) : (tq >> 6);
                    const f32x4 c0 = *(const f32x4*)(rc + pos * 16 + hi * 8), c1 = *(const f32x4*)(rc + pos * 16 + hi * 8 + 4), s0 = *(const f32x4*)(rs + pos * 16 + hi * 8), s1 = *(const f32x4*)(rs + pos * 16 + hi * 8 + 4);
                    const float cs[8] = {c0.x, c0.y, c0.z, c0.w, c1.x, c1.y, c1.z, c1.w}, sn[8] = {s0.x, s0.y, s0.z, s0.w, s1.x, s1.y, s1.z, s1.w};
#pragma unroll
                    for (int j = 0; j < 8; ++j) { const float x1 = x[2 * a][j], x2 = x[2 * a + 1][j]; x[2 * a][j] = x1 * cs[j] - x2 * sn[j]; x[2 * a + 1][j] = x2 * cs[j] + x1 * sn[j]; } } }
#pragma unroll
            for (int d0 = 0; d0 < 4; ++d0) { u32x4 wq; wq.x = cvtpk(x[d0][0] * QSCALE, x[d0][1] * QSCALE); wq.y = cvtpk(x[d0][2] * QSCALE, x[d0][3] * QSCALE); wq.z = cvtpk(x[d0][4] * QSCALE, x[d0][5] * QSCALE); wq.w = cvtpk(x[d0][6] * QSCALE, x[d0][7] * QSCALE);
                qr[d0] = __builtin_bit_cast(bf16x8, wq); }
        }
        f32x16 o0, o1, negm;
#pragma unroll
        for (int r = 0; r < 16; ++r) { o0[r] = 0.f; o1[r] = 0.f; negm[r] = 0.f; }
        float mhat = 0.f, lsum = 0.f;
#define AT_KROW(ti) ((ti) < 4 ? RL + b * TC + (ti) * 64 : b * T + (lt_lo + (ti) - 4) * 64)
        u32x4 ka, va, kb2, vb2;
#define AT_LOADPAIR(pp) do { const int na_ = 2 * (pp), nb_ = (2 * (pp) + 1 < ntiles) ? 2 * (pp) + 1 : na_; \
            const int r0_ = AT_KROW(na_) + (tid >> 3), r1_ = AT_KROW(nb_) + (tid >> 3); const int co_ = (tid & 7) * 8; \
            ka = *(const u32x4*)(U + (size_t)r0_ * NIN + kcol + co_); va = *(const u32x4*)(U + (size_t)r0_ * NIN + vcol + co_); \
            kb2 = *(const u32x4*)(U + (size_t)r1_ * NIN + kcol + co_); vb2 = *(const u32x4*)(U + (size_t)r1_ * NIN + vcol + co_); } while (0)
#define AT_WRITEPAIR(off) do { *(LAS u32x4*)(Lb + (off) + st_off) = ka; *(LAS u32x4*)(Lb + (off) + AT_TILEB + st_off) = kb2; \
            *(LAS u32x4*)(Lb + (off) + 2 * AT_TILEB + sv_off) = va; *(LAS u32x4*)(Lb + (off) + 2 * AT_TILEB + AT_VTILEB + sv_off) = vb2; } while (0)
#define AT_MASK(ti, P0, P1) do { if (MODE == 1) { if ((ti) >= ntiles) { _Pragma("unroll") for (int r = 0; r < 16; ++r) { P0[r] = -INFINITY; P1[r] = -INFINITY; } } \
            else if ((ti) >= 4) { const int kb0_ = (lt_lo + (ti) - 4) * 64, qlo_ = tq0 + 32 * (F.wave & 1); \
                if (kb0_ + 63 - qlo_ > 128 || qlo_ + 31 - kb0_ > 128) { const int kp0_ = kb0_ + 4 * hi - tq; \
                    _Pragma("unroll") for (int r = 0; r < 16; ++r) { const int dl_ = kp0_ + (r & 3) + 8 * (r >> 2); \
                        if (dl_ > 128 || dl_ < -128) P0[r] = -INFINITY; if (dl_ + 32 > 128 || dl_ + 32 < -128) P1[r] = -INFINITY; } } } } } while (0)
#define AT_REF(first, P0, P1) do { if (!fixedref) { float mx_ = fmaxf(P0[0], P1[0]); \
            _Pragma("unroll") for (int r = 1; r < 16; ++r) mx_ = fmaxf(mx_, fmaxf(P0[r], P1[r])); \
            mx_ = fmaxf(mx_, shfl_xor_l(mx_, 32, lane)); \
            if ((first) || __any(mx_ > ATT_THR)) { const float dl_ = (first) ? mx_ : fmaxf(mx_, 0.f); mhat += dl_; \
                const float al_ = __builtin_amdgcn_exp2f(-dl_); lsum *= al_; \
                _Pragma("unroll") for (int r = 0; r < 16; ++r) { P0[r] -= dl_; P1[r] -= dl_; o0[r] *= al_; o1[r] *= al_; negm[r] = -mhat; } } } } while (0)
        AT_LOADPAIR(0); AT_WRITEPAIR(0);
        if (npairs > 1) { AT_LOADPAIR(1); AT_WRITEPAIR(AT_STAGEB); }
        if (npairs > 2) AT_LOADPAIR(2);
        __syncthreads();
        f32x16 pc0, pc1, pn0, pn1;
        at_qk1<FIXED>(Lb, kf_off, qr, negm, pc0, pc1);
        AT_REF(true, pc0, pc1);
#pragma unroll
        for (int r = 0; r < 16; ++r) { pn0[r] = 0.f; pn1[r] = 0.f; }
        int scur = 0, snxt = AT_STAGEB, swr = 2 * AT_STAGEB;
        for (int tp = 0; tp < npairs; ++tp) {
            if (tp + 2 < npairs) { AT_WRITEPAIR(swr); if (tp + 3 < npairs) AT_LOADPAIR(tp + 3); }
            lsum += at_slot<FIXED>(Lb + scur + 2 * AT_TILEB, Lb + scur + AT_TILEB, true, kf_off, vf_off, qr, negm, pc0, pc1, pn0, pn1, o0, o1);
            AT_MASK(2 * tp + 1, pn0, pn1);
            AT_REF(false, pn0, pn1);
            const bool more = tp + 1 < npairs;
            lsum += at_slot<FIXED>(Lb + scur + 2 * AT_TILEB + AT_VTILEB, Lb + snxt, more, kf_off, vf_off, qr, negm, pn0, pn1, pc0, pc1, o0, o1);
            if (more) { AT_MASK(2 * tp + 2, pc0, pc1); AT_REF(false, pc0, pc1); }
            __syncthreads();
            { const int t_ = scur; scur = snxt; snxt = swr; swr = t_; }
        }
#undef AT_KROW
#undef AT_LOADPAIR
#undef AT_WRITEPAIR
#undef AT_MASK
#undef AT_REF
        lsum += shfl_xor_l(lsum, 32, lane);
        if (winm) lsum += exp2f(P.sink[l * 8 + hq] * LOG2E - mhat);
        const float inv = 1.0f / lsum;
        bf16_t* op = (bf16_t*)(P.ws + WS_BR) + (size_t)qrow * NBR + (winm ? 1024 : 512) + hq * 64 + 4 * hi;
#pragma unroll
        for (int gq = 0; gq < 4; ++gq) {
            u32x2 w0, w1; w0.x = cvtpk(o0[4 * gq] * inv, o0[4 * gq + 1] * inv); w0.y = cvtpk(o0[4 * gq + 2] * inv, o0[4 * gq + 3] * inv);
            w1.x = cvtpk(o1[4 * gq] * inv, o1[4 * gq + 1] * inv); w1.y = cvtpk(o1[4 * gq + 2] * inv, o1[4 * gq + 3] * inv);
            *(u32x2*)(op + 8 * gq) = w0; *(u32x2*)(op + 32 + 8 * gq) = w1; }
    }
}

template <int MODE> __device__ __forceinline__ void ph_attn(const Frame& F, const Ptrs& P, int l) {
    if (MODE == 1 || MODE == 3) { ph_attn_impl<MODE, false>(F, P, l); return; }
    const int lane = fresh_lane();
    float mq = fabsf(P.q_gain[l * 64 + lane]), mk = fabsf(P.k_gain[l * 64 + lane]);
#pragma unroll
    for (int o = 1; o < 64; o <<= 1) { mq = fmaxf(mq, shfl_xor_l(mq, o, lane)); mk = fmaxf(mk, shfl_xor_l(mk, o, lane)); }
    const float sbound = 64.0f * QSCALE * 1.02f * mq * mk;
    if (__builtin_amdgcn_readfirstlane(sbound < 48.0f ? 1 : 0)) ph_attn_impl<MODE, true>(F, P, l); else ph_attn_impl<MODE, false>(F, P, l);
}

constexpr int DF_ROWB = 528;
template <int STAGE> __device__ __forceinline__ void ph_dft(const Frame& F, const Ptrs& P) {
    const int lane = fresh_lane(), tid = F.wave * 64 + lane, r32 = lane & 31, hi = lane >> 5, w = F.wave;
    bf16_t* U = (bf16_t*)(P.ws + WS_U); bf16_t* BR = (bf16_t*)(P.ws + WS_BR); const bf16_t* Wm = (const bf16_t*)(P.ws + WS_DFTM);
    LAS unsigned char* Xl = F.lds;
    const int xf_off = (8 * hi + ((lane & 15) >> 2)) * DF_ROWB + (32 * w + ((lane >> 4) & 1) * 16 + (lane & 3) * 4) * 2;
    constexpr int NMB = STAGE == 2 ? 4 : 2;
    const int seg = tid >> 2, part = tid & 3, pp = seg >> 6, jj = seg & 63;
    u32x4 pf[8];
    if (F.vcu < 1024) { const int u = F.vcu; const int chb = u & 1, sidx = (u >> 1) & 63, b = u >> 7;
        const int grow = STAGE == 2 ? b * T + 64 * jj + sidx : b * T + 64 * sidx + jj;
        const u32x4* src = (const u32x4*)(U + (size_t)grow * NIN + pp * 512 + chb * 256 + part * 64);
#pragma unroll
        for (int i = 0; i < 8; ++i) pf[i] = src[i]; }
    for (int u = F.vcu; u < 1024; u += F.G) {
        const int chb = u & 1, sidx = (u >> 1) & 63, b = u >> 7;
#pragma unroll
        for (int i = 0; i < 8; ++i) *(LAS u32x4*)(Xl + seg * DF_ROWB + part * 128 + i * 16) = pf[i];
        if (u + F.G < 1024) { const int un = u + F.G; const int chbn = un & 1, sn = (un >> 1) & 63, bn = un >> 7;
            const int grow = STAGE == 2 ? bn * T + 64 * jj + sn : bn * T + 64 * sn + jj;
            const u32x4* src = (const u32x4*)(U + (size_t)grow * NIN + pp * 512 + chbn * 256 + part * 64);
#pragma unroll
            for (int i = 0; i < 8; ++i) pf[i] = src[i]; }
        __syncthreads();
        f32x16 acc[NMB];
#pragma unroll
        for (int mb = 0; mb < NMB; ++mb)
#pragma unroll
            for (int r = 0; r < 16; ++r) acc[mb][r] = 0.f;
#pragma unroll
        for (int ks = 0; ks < 8; ++ks) {
            const v4i16_t lo4 = __builtin_amdgcn_ds_read_tr16_b64_v4i16((LAS v4i16_t*)(Xl + xf_off + (16 * ks) * DF_ROWB));
            const v4i16_t hi4 = __builtin_amdgcn_ds_read_tr16_b64_v4i16((LAS v4i16_t*)(Xl + xf_off + (16 * ks + 4) * DF_ROWB));
            const bf16x8 xf = (bf16x8){lo4[0], lo4[1], lo4[2], lo4[3], hi4[0], hi4[1], hi4[2], hi4[3]};
#pragma unroll
            for (int mb = 0; mb < NMB; ++mb) { const bf16x8 wf = *(const bf16x8*)(Wm + (mb * 32 + r32) * 128 + 16 * ks + 8 * hi);
                acc[mb] = __builtin_amdgcn_mfma_f32_32x32x16_bf16(xf, wf, acc[mb], 0, 0, 0); }
        }
        LAS unsigned char* ob = Xl + (32 * w + 4 * hi) * 2;
        if (STAGE == 2) {
#pragma unroll
            for (int mb = 0; mb < 2; ++mb) { const int k1 = mb * 32 + r32; const float rev = (float)((k1 * sidx) & 4095) * (1.0f / 4096.0f);
                const float ct = __builtin_amdgcn_cosf(rev), st = __builtin_amdgcn_sinf(rev);
#pragma unroll
                for (int gq = 0; gq < 4; ++gq) { u32x2 wr, wi; float yr[4], yi[4];
#pragma unroll
                    for (int i = 0; i < 4; ++i) { const float a = acc[mb][4 * gq + i], bq = acc[mb + 2][4 * gq + i]; yr[i] = a * ct + bq * st; yi[i] = bq * ct - a * st; }
                    wr.x = cvtpk(yr[0], yr[1]); wr.y = cvtpk(yr[2], yr[3]); wi.x = cvtpk(yi[0], yi[1]); wi.y = cvtpk(yi[2], yi[3]);
                    *(LAS u32x2*)(ob + k1 * DF_ROWB + 16 * gq) = wr; *(LAS u32x2*)(ob + (64 + k1) * DF_ROWB + 16 * gq) = wi; } }
        } else {
#pragma unroll
            for (int mb = 0; mb < 2; ++mb) { const int k2 = mb * 32 + r32;
#pragma unroll
                for (int gq = 0; gq < 4; ++gq) { u32x2 wr; wr.x = cvtpk(acc[mb][4 * gq] * 0.015625f, acc[mb][4 * gq + 1] * 0.015625f); wr.y = cvtpk(acc[mb][4 * gq + 2] * 0.015625f, acc[mb][4 * gq + 3] * 0.015625f);
                    *(LAS u32x2*)(ob + k2 * DF_ROWB + 16 * gq) = wr; } }
        }
        __syncthreads();
        if (STAGE == 2) {
            u32x4* dst = (u32x4*)(U + (size_t)(b * T + 64 * jj + sidx) * NIN + pp * 512 + chb * 256 + part * 64);
#pragma unroll
            for (int i = 0; i < 8; ++i) dst[i] = *(const LAS u32x4*)(Xl + seg * DF_ROWB + part * 128 + i * 16);
        } else { const int k2 = tid >> 3, part8 = tid & 7;
            u32x4* dst = (u32x4*)(BR + (size_t)(b * T + 64 * k2 + sidx) * NBR + chb * 256 + part8 * 32);
#pragma unroll
            for (int i = 0; i < 4; ++i) dst[i] = *(const LAS u32x4*)(Xl + k2 * DF_ROWB + part8 * 64 + i * 16); }
        __syncthreads();
    }
}

struct MegaArgs { Ptrs P; int ph_lo, ph_hi, li, pad; };
__global__ void __launch_bounds__(NWAVES * 64, 2) mega(MegaArgs args) {
    extern __shared__ __attribute__((aligned(16))) unsigned char lds_raw[];
    Frame F; F.lds = (LAS unsigned char*)lds_raw;
    F.wave = __builtin_amdgcn_readfirstlane(threadIdx.x >> 6);
    F.G = gridDim.x; { const int bx = blockIdx.x; F.vcu = (F.G % 8 == 0) ? (bx % 8) * (F.G / 8) + bx / 8 : bx; }
    for (int u = fresh_tid(); u < (LDS_BYTES - LDSCTL_OFF) / 4; u += NWAVES * 64) ((LAS unsigned*)(F.lds + LDSCTL_OFF))[u] = 0u;
    __syncthreads();
    volatile LAS unsigned* MISC = (volatile LAS unsigned*)(F.lds + MISC_OFF);
    const Ptrs& P = args.P;
    XcdBarrier bar = xcd_barrier_post((unsigned*)(P.ws + WS_CTL) + CW_BAR + args.li * XCD_BAR_WORDS, MISC + 8, F.wave);
    const int lo = args.ph_lo, hi = args.ph_hi;
    unsigned char* ws = P.ws;
    bf16_t* H = (bf16_t*)(ws + WS_H); bf16_t* U = (bf16_t*)(ws + WS_U); bf16_t* BR = (bf16_t*)(ws + WS_BR);
    bf16_t* MG = (bf16_t*)(ws + WS_MG); bf16_t* HID = (bf16_t*)(ws + WS_HID); bf16_t* MO = (bf16_t*)(ws + WS_MO);
    const bf16_t* Bt_in = (const bf16_t*)(ws + WS_WB + WB_IN); const bf16_t* Bt_gate = (const bf16_t*)(ws + WS_WB + WB_GATE); const bf16_t* Bt_br = (const bf16_t*)(ws + WS_WB + WB_BR);
    const bf16_t* Bt_out = (const bf16_t*)(ws + WS_WB + WB_OUT); const bf16_t* Bt_13 = (const bf16_t*)(ws + WS_WB + WB_13); const bf16_t* Bt_2 = (const bf16_t*)(ws + WS_WB + WB_2);
#define IN(g) (lo <= (g) && (g) < hi)
#define SEAM(g) do { if ((g) + 1 < hi) xcd_barrier(bar); } while (0)
    for (int l = 0; l < 2; ++l) {
        const int pb = l * NPH; const int M = l == 0 ? R : RL;
        if (IN(pb + 0)) { if (l == 0) ph_tables_mod(F, P); ph_weights(F, P, l); SEAM(pb + 0); }
        if (IN(pb + 1)) { ph_quant(F, P, l); if (l == 0) ph_norm<0>(F, P, l, R); else ph_norm<1>(F, P, l, R); SEAM(pb + 1); }
        if (IN(pb + 2)) {
            pg8::StaticOrder S; S.init(R, NIN, F.G, (int)blockIdx.x, H, D / 2, Bt_in, D / 2);
            pg8::EpiV8I8<FStore8> E{FStore8{U, NIN}, (const float*)(ws + WS_SA), (const unsigned*)(ws + WS_CTL) + CW_CMAX + 32768 * l};
            pg8::gemm_phase<pg8::EpiV8I8<FStore8>, pg8::StaticOrder, true, true>(F.lds, F.wave, D / 2, D / 2, D / 2, S, E);
            SEAM(pb + 2);
        }
        if (IN(pb + 3)) { ph_kprep(F, P, l); ph_pool(F, P, M); SEAM(pb + 3); }
        if (IN(pb + 4)) {
            ph_dft<2>(F, P); ph_attn<1>(F, P, l);
            if (l == 0) { ph_attn<2>(F, P, l); ph_attn<3>(F, P, l); ph_fourier_ref(F, P, TC, 0); }
            xcd_barrier(bar);
            ph_dft<3>(F, P); ph_attn<0>(F, P, l);
            SEAM(pb + 4);
        }
        if (IN(pb + 5)) {
            pg8::StaticOrder S; S.init(M, 4096, F.G, (int)blockIdx.x, H, D / 2, Bt_gate, D / 2);
            pg8::EpiV8I8<FGateU8> E{FGateU8{(unsigned char*)(ws + WS_GT), P.b_gate + (size_t)l * 4096}, (const float*)(ws + WS_SA), (const unsigned*)(ws + WS_CTL) + CW_CMAX + 32768 * l + 3072};
            pg8::gemm_phase<pg8::EpiV8I8<FGateU8>, pg8::StaticOrder, true, true>(F.lds, F.wave, D / 2, D / 2, D / 2, S, E);
            SEAM(pb + 5);
        }
        if (IN(pb + 6)) {
            pg8::StaticOrder S; S.init(M, D, F.G, (int)blockIdx.x, BR, NBR, Bt_br, NBR);
            pg8::EpiMergeS E{(const unsigned char*)(ws + WS_GT), MG};
            pg8::gemm_phase(F.lds, F.wave, NBR, NBR, NBR, S, E);
            xcd_barrier(bar);
        }
        if (IN(pb + 10)) {
            pg8::StaticOrder S; S.init(M, D, F.G, (int)blockIdx.x, MG, D, Bt_out, D);
            pg8::EpiV4<FOut> E{FOut{P, l}};
            pg8::gemm_phase(F.lds, F.wave, D, D, D, S, E);
            SEAM(pb + 10);
        }
        if (IN(pb + 11)) { ph_norm<2>(F, P, l, M); xcd_barrier(bar); }
        if (IN(pb + 13) || IN(pb + 14)) {
            LAS int* ptab = (LAS int*)(F.lds + LDSCTL_OFF);
            if (fresh_tid() == 0) { const unsigned* cnt = (const unsigned*)(ws + WS_CTL) + CW_CNT + 1024 * l; int off = 0;
                for (int e = 0; e < 16; ++e) { const int c = (int)cnt[64 * e]; ptab[e] = off; ptab[17 + e] = c; off += (c + 255) >> 8; } ptab[16] = off; }
            __syncthreads();
            if (IN(pb + 13)) {
                pg8::MoeOrder<true> S; S.nN = 4; S.G = F.G; S.c = F.vcu; S.A = (const char*)H; S.Bt = (const char*)Bt_13; S.astep = 0; S.bstep = (size_t)256 * D * 2; S.bexp = (size_t)1024 * 1024 * 2; S.tab = (const int*)ptab; S.tokl = (const int*)(ws + WS_TOKL);
                pg8::EpiDual<FMoe1> E{FMoe1{HID}};
                pg8::gemm_phase(F.lds, F.wave, D, D, D, S, E);
                SEAM(pb + 13);
            }
            if (IN(pb + 14)) {
                pg8::MoeOrder<false> S; S.nN = 4; S.G = F.G; S.c = F.vcu; S.A = (const char*)HID; S.Bt = (const char*)Bt_2; S.astep = (size_t)256 * FF * 2; S.bstep = (size_t)256 * FF * 2; S.bexp = (size_t)1024 * 512 * 2; S.tab = (const int*)ptab; S.tokl = nullptr;
                pg8::EpiV8<FMoe2> E{FMoe2{MO, (const int*)(ws + WS_TOKL), (const float*)(ws + WS_WL)}};
                pg8::gemm_phase(F.lds, F.wave, FF, FF, FF, S, E);
                SEAM(pb + 14);
            }
        }
    }
    if (IN(PH_FINAL)) ph_final(F, P);
#undef IN
#undef SEAM
}

extern "C" void kernel_launch(void* const* d_in, const int* in_sizes, int n_in, void* d_out, int out_size, void* d_ws, size_t ws_size, hipStream_t stream) {
    if (n_in != 24 || ws_size < WS_END || out_size != RL * D) { fprintf(stderr, "kernel_launch: unexpected sizes n_in %d ws %zu out %d\n", n_in, ws_size, out_size); return; }
    static int grid = 0;
    if (grid == 0) {
        int dev = 0, cus = 0;
        if (hipGetDevice(&dev) != hipSuccess || hipDeviceGetAttribute(&cus, hipDeviceAttributeMultiprocessorCount, dev) != hipSuccess) { grid = -1; return; }
        if (hipFuncSetAttribute((const void*)mega, hipFuncAttributeMaxDynamicSharedMemorySize, LDS_BYTES) != hipSuccess) { fprintf(stderr, "kernel_launch: hipFuncSetAttribute failed\n"); grid = -1; return; }
        int per_cu = 0;
        if (hipOccupancyMaxActiveBlocksPerMultiprocessor(&per_cu, (const void*)mega, NWAVES * 64, LDS_BYTES) != hipSuccess || per_cu < 1) fprintf(stderr, "kernel_launch: occupancy query says %d\n", per_cu);
        (void)hipGetLastError();
        grid = cus;
    }
    if (grid < 0) return;
    MegaArgs a{};
    const float** pp = (const float**)&a.P;
    for (int i = 0; i < 24; ++i) pp[i] = (const float*)d_in[i];
    a.P.out = (float*)d_out; a.P.ws = (unsigned char*)d_ws;
    (void)hipMemsetAsync((unsigned char*)d_ws + WS_CTL, 0, 512 * 1024, stream);
    a.ph_lo = 0; a.ph_hi = PH_FINAL + 1; a.li = 0;
    hipLaunchKernelGGL(mega, dim3(grid), dim3(NWAVES * 64), LDS_BYTES, stream, a);
}
```

```cpp
#include <hip/hip_runtime.h>
#include <cstdio>
#include <cstdint>

typedef unsigned short bf16_t;
typedef short bf16x8 __attribute__((ext_vector_type(8)));
typedef float f32x4 __attribute__((ext_vector_type(4)));
typedef unsigned u32x4 __attribute__((ext_vector_type(4)));
typedef unsigned u32x2 __attribute__((ext_vector_type(2)));
typedef int i32x4 __attribute__((ext_vector_type(4)));

constexpr int D = 1024, NB = 8, T = 4096, TC = 256;
constexpr int RL = NB * T, RC = NB * TC, R = RL + RC;
constexpr int NIN = 3072;
constexpr int C_ZR = 0, C_ZI = 512, C_P = 1024, C_QB = 1536, C_KB = 2048, C_VB = 2176, C_QW = 2304, C_KW = 2816, C_VW = 2944;
constexpr int NBR = 2048;
constexpr int NE = 16, FF = 512;
constexpr int MAXROWS = 73728;
constexpr float EPS = 1e-6f;
constexpr float QSCALE = 0.125f * 1.4426950408889634f;
constexpr float LOG2E = 1.4426950408889634f;

constexpr size_t MiB = 1u << 20;
constexpr size_t WS_CTL = 0;
constexpr size_t WS_MOD = 1 * MiB;
constexpr size_t WS_ROPE = 1 * MiB + 512 * 1024;
constexpr size_t WS_COS = WS_ROPE + 16 * 1024;
constexpr size_t WS_DFTM = WS_ROPE + 64 * 1024;
constexpr size_t WS_TOKL = 2 * MiB;
constexpr size_t WS_WL = 4 * MiB + 512 * 1024;
constexpr size_t WS_XC = 9 * MiB;
constexpr size_t WS_WB = 17 * MiB;
constexpr size_t WB_IN = 0, WB_GATE = 6 * MiB, WB_BR = 14 * MiB, WB_OUT = 18 * MiB, WB_13 = 20 * MiB, WB_2 = 52 * MiB;
constexpr size_t WS_H = 85 * MiB;
constexpr size_t WS_SA = WS_H + 34 * MiB;
constexpr size_t WS_ARENA = 153 * MiB;
constexpr size_t WS_U = WS_ARENA;
constexpr size_t WS_BR = WS_ARENA + 204 * MiB;
constexpr size_t WS_GT = WS_ARENA;
constexpr size_t WS_MG = WS_ARENA + 136 * MiB;
constexpr size_t WS_HID = WS_ARENA + 144 * MiB;
constexpr size_t WS_MO = WS_ARENA + 216 * MiB;
constexpr size_t WS_FTMP = WS_ARENA + 352 * MiB;
constexpr size_t WS_END = 512 * MiB;
static_assert(WS_BR + (size_t)R * NBR * 2 <= WS_END && WS_MO + (size_t)2 * R * D * 2 <= WS_END && WS_MG + (size_t)R * D * 2 <= WS_BR, "ws map");
constexpr int CW_CMAX = 32768;
constexpr int CW_CNT = 8192;

__device__ __forceinline__ float bf2f(bf16_t b) { return __uint_as_float(((unsigned)b) << 16); }
__device__ __forceinline__ unsigned f2bf(float f) { unsigned u = __float_as_uint(f); return (u + 0x7fffu + ((u >> 16) & 1u)) >> 16; }
__device__ __forceinline__ unsigned pk2(float lo, float hi) { return f2bf(lo) | (f2bf(hi) << 16); }
typedef __bf16 bf16x2_t __attribute__((ext_vector_type(2)));
typedef float f32x2_t __attribute__((ext_vector_type(2)));
__device__ __forceinline__ unsigned cvtpk(float lo, float hi) { f32x2_t v = {lo, hi}; bf16x2_t b = __builtin_convertvector(v, bf16x2_t); return __builtin_bit_cast(unsigned, b); }
__device__ __forceinline__ float lo16(unsigned w) { return __uint_as_float(w << 16); }
__device__ __forceinline__ float hi16(unsigned w) { return __uint_as_float(w & 0xffff0000u); }
__device__ __forceinline__ float shfl_xor_l(float v, int o, int lane) { return __int_as_float(__builtin_amdgcn_ds_bpermute((lane ^ o) << 2, __float_as_int(v))); }
__device__ __forceinline__ float wave_sum_l(float v, int lane) {
#pragma unroll
    for (int o = 1; o < 64; o <<= 1) v += shfl_xor_l(v, o, lane);
    return v;
}
__device__ __forceinline__ int row_bb(int r) { return r < RL ? (r >> 12) : 8; }

struct Ptrs {
    const float *x, *c, *ctx, *c_ctx, *w_ada, *b_ada, *norm1, *norm2, *w_in, *q_gain, *k_gain, *sink, *pool_w, *pool_scale,
        *w_branch, *w_gate, *b_gate, *w_out, *router_w, *router_bias, *w1, *w3, *w2, *norm_f;
    float* out; unsigned char* ws;
};
__device__ __forceinline__ const float* xin_row(const Ptrs& P, int r) { return r < RL ? P.x + (size_t)r * D : P.ctx + (size_t)(r - RL) * D; }
__device__ __forceinline__ float* x1_row(const Ptrs& P, int r) { return r < RL ? P.out + (size_t)r * D : (float*)(P.ws + WS_XC) + (size_t)(r - RL) * D; }
__device__ __forceinline__ const float* mod_vec(const Ptrs& P, int l, int bb, int which) { return (const float*)(P.ws + WS_MOD) + ((size_t)(l * 9 + bb) * 6 + which) * D; }

#define LAS __attribute__((address_space(3)))
#define GAS __attribute__((address_space(1)))
#define LDS_WAIT() asm volatile("s_waitcnt lgkmcnt(0)" ::: "memory")
__device__ __forceinline__ int fresh_lane() { int l; asm volatile("v_mbcnt_lo_u32_b32 %0, -1, 0\n\tv_mbcnt_hi_u32_b32 %0, -1, %0" : "=v"(l)); return l; }
constexpr int NWAVES = 8;
constexpr int RING_BYTES = 131072, LDSCTL_OFF = RING_BYTES, MISC_OFF = LDSCTL_OFF + 320, LDS_BYTES = 147456;
constexpr int CW_BAR = 16384;
constexpr int NPH = 15, PH_FINAL = 2 * NPH;

#define XB_TMO      128
#define XB_XCNT(j)  (256  + 64 * (j))
#define XB_XSUB(j)  (1280 + 64 * (j))
#define XB_XGEN(j)  (2304 + 64 * (j))
#define XB_TOP      3328
#define XB_TOPGEN   3392
#define XCD_BAR_WORDS 3456
#define XB_SPIN_CAP (1u << 21)
__device__ __forceinline__ unsigned xb_ld(unsigned* p)              { return __hip_atomic_load(p, __ATOMIC_RELAXED, __HIP_MEMORY_SCOPE_AGENT); }
__device__ __forceinline__ unsigned xb_add(unsigned* p, unsigned v) { return __hip_atomic_fetch_add(p, v, __ATOMIC_RELAXED, __HIP_MEMORY_SCOPE_AGENT); }
__device__ __forceinline__ unsigned xb_xcc_id() { return (unsigned)__builtin_amdgcn_s_getreg((3 << 11) | 20) & 0xFu; }
#define XB_SPIN(cond, bar) do { unsigned _sp = 0; while (cond) { __builtin_amdgcn_s_sleep(1); \
    if ((++_sp & 255u) == 0u) { if (xb_ld(&(bar)[XB_TMO])) break; if (_sp > XB_SPIN_CAP) { atomicAdd(&(bar)[XB_TMO], 1u); break; } } } } while (0)
struct XcdBarrier { unsigned* bar; unsigned x; volatile LAS unsigned* st; int wave; };
__device__ __forceinline__ XcdBarrier xcd_barrier_post(unsigned* bar, volatile LAS unsigned* st, int wave) {
    XcdBarrier b; b.bar = bar; b.x = xb_xcc_id(); b.st = st; b.wave = wave;
    if (wave == 0 && fresh_lane() == 0) (void)xb_add(&bar[XB_XCNT(b.x)], 1u);
    return b;
}
__device__ __forceinline__ void xcd_barrier_complete(unsigned* bar, unsigned x, unsigned& nloc, unsigned& nx) {
    const unsigned G = gridDim.x * gridDim.y * gridDim.z;
    unsigned sum, cnt, mine, sp = 0u;
    for (;;) {
        sum = 0u; cnt = 0u; mine = 0u;
#pragma unroll
        for (unsigned j = 0; j < 16; ++j) { const unsigned c = xb_ld(&bar[XB_XCNT(j)]); sum += c; cnt += (c > 0u) ? 1u : 0u; mine = (j == x) ? c : mine; }
        if (sum == G) break;
        __builtin_amdgcn_s_sleep(1);
        if ((++sp & 255u) == 0u) { if (xb_ld(&bar[XB_TMO])) break; if (sp > XB_SPIN_CAP) { atomicAdd(&bar[XB_TMO], 1u); break; } }
    }
    nloc = mine > 0u ? mine : 1u; nx = cnt > 0u ? cnt : 1u;
}
__device__ __forceinline__ void xcd_barrier(const XcdBarrier& b) {
    asm volatile("s_waitcnt vmcnt(0)" ::: "memory");
    __syncthreads();
    if (b.wave == 0 && fresh_lane() == 0) {
        unsigned* bar = b.bar;
        __builtin_amdgcn_s_waitcnt(0);
        unsigned nloc = b.st[0], nx = b.st[1];
        if (nloc == 0u) { xcd_barrier_complete(bar, b.x, nloc, nx); b.st[0] = nloc; b.st[1] = nx; }
        const unsigned old = xb_add(&bar[XB_XSUB(b.x)], 1u);
        const unsigned gen = old / nloc;
        if (old + 1u == (gen + 1u) * nloc) {
            __builtin_amdgcn_fence(__ATOMIC_RELEASE, "agent");
            asm volatile("s_waitcnt vmcnt(0)" ::: "memory");
            const unsigned og = xb_add(&bar[XB_TOP], 1u);
            const unsigned tg = og / nx;
            if (og + 1u == (tg + 1u) * nx) xb_add(&bar[XB_TOPGEN], 1u);
            else XB_SPIN(xb_ld(&bar[XB_TOPGEN]) == tg, bar);
            __builtin_amdgcn_fence(__ATOMIC_ACQUIRE, "agent");
            xb_add(&bar[XB_XGEN(b.x)], 1u);
            asm volatile("s_waitcnt vmcnt(0)" ::: "memory");
        } else {
            XB_SPIN(xb_ld(&bar[XB_XGEN(b.x)]) == gen, bar);
            __builtin_amdgcn_fence(__ATOMIC_ACQUIRE, "agent");
            asm volatile("s_waitcnt vmcnt(0)" ::: "memory");
        }
    }
    __syncthreads();
}

namespace pg8 {
constexpr int BM = 256, BK = 64, HALF = 128, HTB = HALF * BK * 2, STAGE_BYTES = 8 * HTB, NXCD = 8, WGM = 4;
__host__ __device__ __forceinline__ int lds_byte(int r, int c) { const int st = (r >> 4) * 2 + (c >> 5), rr = r & 15, cc = c & 31, ob = rr * 64 + cc * 2; return st * 1024 + (ob ^ (((ob >> 9) & 1) << 5)); }
__host__ __device__ __forceinline__ void stage_rc(int b, int& Rr, int& C) { const int st = b / 1024, sb = b % 1024, swz = sb ^ (((sb >> 9) & 1) << 5); Rr = (st >> 1) * 16 + swz / 64; C = (st & 1) * 32 + (swz % 64) / 2; }
__host__ __device__ __forceinline__ int perm32(int rho) { const int n = rho >> 4, i = rho & 15; return 8 * (i >> 2) + 4 * n + (i & 3); }
struct Unit { int pm, pn; const char* a; const char* b; int e, p0, ce; };

struct StaticOrder {
    static constexpr bool GATHER = false;
    int nM, nN, nwg, G, c; const char* A; const char* Bt; size_t astep, bstep;
    __device__ void init(int M, int N, int G_, int c_, const bf16_t* A_, int lda, const bf16_t* Bt_, int ldb) { nM = M / BM; nN = N / BM; nwg = nM * nN; G = G_; c = c_; A = (const char*)A_; Bt = (const char*)Bt_; astep = (size_t)BM * lda * 2; bstep = (size_t)BM * ldb * 2; }
    __device__ bool next(int i, Unit& u) const {
        const long L = (long)i * G + c; if (L >= nwg) return false;
        int wgid = (int)L; { const int q = nwg / NXCD, r = nwg % NXCD, xcd = wgid % NXCD, off = wgid / NXCD; wgid = (xcd < r ? xcd * (q + 1) : r * (q + 1) + (xcd - r) * q) + off; }
        const int nig = WGM * nN, gid = wgid / nig, fm = gid * WGM, gsz = (nM - fm) < WGM ? (nM - fm) : WGM;
        u.pm = fm + ((wgid % nig) % gsz); u.pn = (wgid % nig) / gsz; u.a = A + (size_t)u.pm * astep; u.b = Bt + (size_t)u.pn * bstep; u.e = 0; u.p0 = 0; u.ce = 0; return true;
    }
};
template <bool GATHER_> struct MoeOrder {
    static constexpr bool GATHER = GATHER_;
    int nN, G, c; const char* A; const char* Bt; size_t astep, bstep, bexp; const int* tab; const int* tokl;
    __device__ bool next(int i, Unit& u) const {
        const int L = i * G + c; const int total = __builtin_amdgcn_readfirstlane(tab[16]) * nN; if (L >= total) return false;
        u.pm = L / nN; u.pn = L % nN; int e = 0;
#pragma unroll
        for (int q = 1; q < 16; ++q) e += (u.pm >= tab[q]) ? 1 : 0;
        e = __builtin_amdgcn_readfirstlane(e);
        u.e = e; u.p0 = __builtin_amdgcn_readfirstlane((u.pm - tab[e]) * BM); u.ce = __builtin_amdgcn_readfirstlane(tab[17 + e]);
        u.a = GATHER_ ? A : A + (size_t)u.pm * astep; u.b = Bt + (size_t)e * bexp + (size_t)u.pn * bstep; return true;
    }
    __device__ __forceinline__ void aoffs(const Unit& u, int wid, int lda, unsigned (&off)[2][2]) const {
        const int tid = wid * 64 + fresh_lane();
#pragma unroll
        for (int i = 0; i < 2; ++i) { int Rr, C; stage_rc(tid * 16 + i * 8192, Rr, C);
#pragma unroll
            for (int h = 0; h < 2; ++h) { const int pos = u.p0 + h * HALF + Rr; const int tok = pos < u.ce ? (tokl[(size_t)u.e * R + pos] >> 1) : 0; off[h][i] = (unsigned)(tok * lda + C) * 2u; } }
    }
};

template <class Epi, class Sched, bool ALIGN_EPI = true, bool I8 = false>
__device__ __forceinline__ void gemm_phase(LAS unsigned char* lds, const int wid, const int lda, const int ldb, const int K, const Sched& S, const Epi& E) {
    const int lane = fresh_lane(), tid = wid * 64 + lane, wr = wid >> 2, wc = wid & 3, fr = lane & 15, fq = lane >> 4;
    const int nt = K / BK;
    unsigned voffA[2], voffB[2];
#pragma unroll
    for (int i = 0; i < 2; ++i) { int Rr, C; stage_rc(tid * 16 + i * 8192, Rr, C); const int Rb = Epi::PERM ? ((Rr & ~31) + perm32(Rr & 31)) : Rr;
        voffA[i] = (unsigned)(Rr * lda + C) * 2u; voffB[i] = (unsigned)(Rb * ldb + C) * 2u; }
    const size_t kstep = (size_t)(BK * 2);
    const size_t hstepA = Sched::GATHER ? 0 : (size_t)HALF * lda * 2, hstepB = (size_t)HALF * ldb * 2;
    const unsigned ldsw = (unsigned)wid * 1024u;
    const int aoff = lds_byte(wr * 64 + fr, fq * 8), boff = lds_byte(wc * 32 + fr, fq * 8);
#define PG8_SA(b, h) (((b) * 2 + (h)) * HTB)
#define PG8_SB(b, h) ((4 + (b) * 2 + (h)) * HTB)
#define PG8_STAGE(bufoff, gbase, voff) do { _Pragma("unroll") for (int _i = 0; _i < 2; ++_i) \
        __builtin_amdgcn_global_load_lds((const unsigned*)((const char*)(gbase) + (voff)[_i]), (LAS unsigned*)(lds + (bufoff) + ldsw + _i * 8192), 16, 0, 0); } while (0)
#define PG8_STAGE_A(b, h, kp, OFFS) do { if constexpr (Sched::GATHER) { PG8_STAGE(PG8_SA(b, h), kp, OFFS[h]); } else { PG8_STAGE(PG8_SA(b, h), (kp) + (h) * hstepA, voffA); } } while (0)
#define PG8_LDA(dst, b, h) do { _Pragma("unroll") for (int m = 0; m < 4; ++m) _Pragma("unroll") for (int k = 0; k < 2; ++k) dst[m][k] = *(const LAS bf16x8*)(lds + PG8_SA(b, h) + aoff + m * 2048 + k * 1024); } while (0)
#define PG8_LDB(dst, b, h) do { _Pragma("unroll") for (int n = 0; n < 2; ++n) _Pragma("unroll") for (int k = 0; k < 2; ++k) dst[n][k] = *(const LAS bf16x8*)(lds + PG8_SB(b, h) + boff + n * 2048 + k * 1024); } while (0)
#define PG8_MMA(ai, bj, At, Bt) do { __builtin_amdgcn_s_setprio(1); _Pragma("unroll") for (int m = 0; m < 4; ++m) _Pragma("unroll") for (int n = 0; n < 2; ++n) _Pragma("unroll") for (int k = 0; k < 2; ++k) { \
        if constexpr (I8) acc[ai][bj][m][n] = __builtin_bit_cast(f32x4, __builtin_amdgcn_mfma_i32_16x16x64_i8(__builtin_bit_cast(i32x4, Bt[n][k]), __builtin_bit_cast(i32x4, At[m][k]), __builtin_bit_cast(i32x4, acc[ai][bj][m][n]), 0, 0, 0)); \
        else acc[ai][bj][m][n] = __builtin_amdgcn_mfma_f32_16x16x32_bf16(Bt[n][k], At[m][k], acc[ai][bj][m][n], 0, 0, 0); } __builtin_amdgcn_s_setprio(0); } while (0)
#define PG8_WAIT_V(n) asm volatile("s_waitcnt vmcnt(" #n ")" ::: "memory")
#define PG8_WAIT_L(n) asm volatile("s_waitcnt lgkmcnt(" #n ")" ::: "memory")
#define PG8_BAR __builtin_amdgcn_s_barrier()
#define PG8_SCHED __builtin_amdgcn_sched_barrier(0)
    Unit cur, nxt; int ui = 0;
    if (!S.next(0, cur)) return;
    f32x4 acc[2][2][4][2];
#pragma unroll
    for (int a = 0; a < 2; ++a)
#pragma unroll
        for (int b = 0; b < 2; ++b)
#pragma unroll
            for (int m = 0; m < 4; ++m)
#pragma unroll
                for (int n = 0; n < 2; ++n) acc[a][b][m][n] = (f32x4){0.f, 0.f, 0.f, 0.f};
    bf16x8 At[4][2], B0[2][2], B1[2][2];
    unsigned goffC[2][2], goffN[2][2];
    if constexpr (Sched::GATHER) { S.aoffs(cur, wid, lda, goffC);
#pragma unroll
        for (int h = 0; h < 2; ++h)
#pragma unroll
            for (int i = 0; i < 2; ++i) goffN[h][i] = goffC[h][i]; }
    const char* cA = cur.a; const char* cB = cur.b;
    PG8_STAGE(PG8_SB(0, 0), cB, voffB); PG8_STAGE(PG8_SB(0, 1), cB + hstepB, voffB); PG8_STAGE_A(0, 0, cA, goffC); PG8_STAGE_A(0, 1, cA, goffC);
    if (wr == 1) PG8_BAR;
    PG8_WAIT_V(2); PG8_BAR;
    PG8_STAGE(PG8_SB(1, 0), cB + kstep, voffB); PG8_STAGE_A(1, 0, cA + kstep, goffC); PG8_STAGE(PG8_SB(1, 1), cB + hstepB + kstep, voffB);
    PG8_WAIT_V(6); PG8_BAR;
    for (;;) {
        const bool has_next = S.next(ui + 1, nxt);
        if constexpr (Sched::GATHER) { if (has_next) S.aoffs(nxt, wid, lda, goffN); }
        const char* nA = has_next ? nxt.a : cA; const char* nB = has_next ? nxt.b : cB;
        for (int t = 0; t < nt; t += 2) {
            const bool last = (t == nt - 2);
            const char* a1 = cA + (size_t)(t + 1) * kstep;
            const char* a2 = last ? nA : cA + (size_t)(t + 2) * kstep; const char* b2 = last ? nB : cB + (size_t)(t + 2) * kstep;
            const char* a3 = a2 + kstep; const char* b3 = b2 + kstep;
            unsigned gx[2][2];
            if constexpr (Sched::GATHER) {
#pragma unroll
                for (int h = 0; h < 2; ++h)
#pragma unroll
                    for (int i = 0; i < 2; ++i) gx[h][i] = (last && has_next) ? goffN[h][i] : goffC[h][i]; }
            PG8_LDB(B0, 0, 0); PG8_LDB(B1, 0, 1); PG8_SCHED; PG8_LDA(At, 0, 0); PG8_STAGE_A(1, 1, a1, goffC);
            PG8_WAIT_V(8); PG8_WAIT_L(0); PG8_BAR; PG8_MMA(0, 0, At, B0); PG8_MMA(0, 1, At, B1); PG8_BAR; PG8_SCHED;
            PG8_LDA(At, 0, 1); PG8_STAGE(PG8_SB(0, 0), b2, voffB); PG8_STAGE(PG8_SB(0, 1), b2 + hstepB, voffB); PG8_STAGE_A(0, 0, a2, gx);
            PG8_WAIT_V(8); PG8_WAIT_L(0); PG8_BAR; PG8_MMA(1, 0, At, B0); PG8_MMA(1, 1, At, B1); PG8_BAR; PG8_SCHED;
            PG8_LDB(B0, 1, 0); PG8_LDB(B1, 1, 1); PG8_SCHED; PG8_LDA(At, 1, 0); PG8_STAGE_A(0, 1, a2, gx);
            PG8_WAIT_V(8); PG8_WAIT_L(0); PG8_BAR; PG8_MMA(0, 0, At, B0); PG8_MMA(0, 1, At, B1); PG8_BAR; PG8_SCHED;
            PG8_LDA(At, 1, 1); PG8_STAGE(PG8_SB(1, 0), b3, voffB); PG8_STAGE(PG8_SB(1, 1), b3 + hstepB, voffB); PG8_STAGE_A(1, 0, a3, gx);
            PG8_WAIT_V(8); PG8_WAIT_L(0); PG8_BAR; PG8_MMA(1, 0, At, B0); PG8_MMA(1, 1, At, B1); PG8_BAR; PG8_SCHED;
            if constexpr (Epi::MID) { if (((t + 2) & (Epi::MID_EVERY - 1)) == 0 && !last) E.mid(acc, cur, wr, wc, (t + 2) / Epi::MID_EVERY - 1); }
        }
        if constexpr (ALIGN_EPI) { if (wr == 0) PG8_BAR; }
        E(acc, cur, wr, wc, fr, fq);
        if (!has_next) break;
#pragma unroll
        for (int a = 0; a < 2; ++a)
#pragma unroll
            for (int b = 0; b < 2; ++b)
#pragma unroll
                for (int m = 0; m < 4; ++m)
#pragma unroll
                    for (int n = 0; n < 2; ++n) acc[a][b][m][n] = (f32x4){0.f, 0.f, 0.f, 0.f};
        cur = nxt; cA = nA; cB = nB; ++ui;
        if constexpr (Sched::GATHER) {
#pragma unroll
            for (int h = 0; h < 2; ++h)
#pragma unroll
                for (int i = 0; i < 2; ++i) goffC[h][i] = goffN[h][i]; }
        if constexpr (ALIGN_EPI) { if (wr == 1) PG8_BAR; }
    }
    PG8_WAIT_V(0);
    if constexpr (!ALIGN_EPI) { if (wr == 0) PG8_BAR; }
    PG8_BAR;
#undef PG8_SA
#undef PG8_SB
#undef PG8_STAGE
#undef PG8_STAGE_A
#undef PG8_LDA
#undef PG8_LDB
#undef PG8_MMA
#undef PG8_WAIT_V
#undef PG8_WAIT_L
#undef PG8_BAR
#undef PG8_SCHED
}
template <class F> struct EpiV4 { static constexpr bool PERM = false, MID = false; static constexpr int MID_EVERY = 1; F f;
    __device__ __forceinline__ void operator()(const f32x4 (&acc)[2][2][4][2], const Unit& u, int wr, int wc, int, int) const {
        const int ln = fresh_lane(), fr = ln & 15, fq = ln >> 4;
        const int row0 = u.pm * BM + wr * 64 + fr, col0 = u.pn * BM + wc * 32 + 4 * fq;
        typename F::UnitPre up = f.unit(u, col0);
#pragma unroll
        for (int ai = 0; ai < 2; ++ai) {
            typename F::Pre pre[4][2][2];
#pragma unroll
            for (int m = 0; m < 4; ++m)
#pragma unroll
                for (int bj = 0; bj < 2; ++bj)
#pragma unroll
                    for (int n = 0; n < 2; ++n) pre[m][bj][n] = f.load(u, row0 + ai * HALF + m * 16, col0 + bj * HALF + n * 16);
#pragma unroll
            for (int m = 0; m < 4; ++m)
#pragma unroll
                for (int bj = 0; bj < 2; ++bj)
#pragma unroll
                    for (int n = 0; n < 2; ++n) f.fin(u, row0 + ai * HALF + m * 16, col0 + bj * HALF + n * 16, acc[ai][bj][m][n], pre[m][bj][n], up, bj * 2 + n);
            asm volatile("" ::: "memory"); }
    } };
template <class F> struct EpiV8 { static constexpr bool PERM = true, MID = false; static constexpr int MID_EVERY = 1; F f;
    __device__ __forceinline__ void operator()(const f32x4 (&acc)[2][2][4][2], const Unit& u, int wr, int wc, int, int) const {
        const int ln = fresh_lane(), fr = ln & 15, fq = ln >> 4;
        const int row0 = u.pm * BM + wr * 64 + fr, col0 = u.pn * BM + wc * 32 + 8 * fq;
#pragma unroll
        for (int ai = 0; ai < 2; ++ai) {
            typename F::Pre pre[4][2];
#pragma unroll
            for (int m = 0; m < 4; ++m)
#pragma unroll
                for (int bj = 0; bj < 2; ++bj) pre[m][bj] = f.load(u, row0 + ai * HALF + m * 16, col0 + bj * HALF);
#pragma unroll
            for (int m = 0; m < 4; ++m)
#pragma unroll
                for (int bj = 0; bj < 2; ++bj) f.fin(u, row0 + ai * HALF + m * 16, col0 + bj * HALF, acc[ai][bj][m][0], acc[ai][bj][m][1], pre[m][bj]);
            asm volatile("" ::: "memory"); }
    } };
template <class F> struct EpiDual { static constexpr bool PERM = true, MID = false; static constexpr int MID_EVERY = 1; F f;
    __device__ __forceinline__ void operator()(const f32x4 (&acc)[2][2][4][2], const Unit& u, int wr, int wc, int, int) const {
        const int ln = fresh_lane(), fr = ln & 15, fq = ln >> 4;
        const int row0 = u.pm * BM + wr * 64 + fr, hc0 = u.pn * HALF + wc * 32 + 8 * fq;
#pragma unroll
        for (int ai = 0; ai < 2; ++ai)
#pragma unroll
            for (int m = 0; m < 4; ++m) f.apply8(row0 + ai * HALF + m * 16, hc0, acc[ai][0][m][0], acc[ai][0][m][1], acc[ai][1][m][0], acc[ai][1][m][1]);
    } };
struct EpiMergeS { static constexpr bool PERM = true, MID = true; static constexpr int MID_EVERY = 8;
    const unsigned char* G8; bf16_t* MG;
    __device__ __forceinline__ void mid(f32x4 (&acc)[2][2][4][2], const Unit& u, int wr, int wc, int i) const {
        const int ln = fresh_lane(), fr = ln & 15, fq = ln >> 4;
        const int row0 = u.pm * BM + wr * 64 + fr, col0 = u.pn * BM + wc * 32 + 8 * fq;
#pragma unroll
        for (int ai = 0; ai < 2; ++ai) {
            u32x2 gi[4][2], gn[4][2];
#pragma unroll
            for (int m = 0; m < 4; ++m)
#pragma unroll
                for (int bj = 0; bj < 2; ++bj) { const unsigned char* gp = G8 + (size_t)(row0 + ai * HALF + m * 16) * 4096 + i * 1024 + col0 + bj * HALF;
                    gi[m][bj] = *(const u32x2*)gp; gn[m][bj] = *(const u32x2*)(gp + 1024); }
#pragma unroll
            for (int m = 0; m < 4; ++m)
#pragma unroll
                for (int bj = 0; bj < 2; ++bj) {
#pragma unroll
                    for (int j = 0; j < 4; ++j) {
                        acc[ai][bj][m][0][j] *= (float)((gi[m][bj].x >> (8 * j)) & 255u) * __builtin_amdgcn_rcpf((float)((gn[m][bj].x >> (8 * j)) & 255u));
                        acc[ai][bj][m][1][j] *= (float)((gi[m][bj].y >> (8 * j)) & 255u) * __builtin_amdgcn_rcpf((float)((gn[m][bj].y >> (8 * j)) & 255u)); } }
        }
    }
    __device__ __forceinline__ void operator()(const f32x4 (&acc)[2][2][4][2], const Unit& u, int wr, int wc, int, int) const {
        const int ln = fresh_lane(), fr = ln & 15, fq = ln >> 4;
        const int row0 = u.pm * BM + wr * 64 + fr, col0 = u.pn * BM + wc * 32 + 8 * fq;
#pragma unroll
        for (int ai = 0; ai < 2; ++ai) {
            u32x2 g3[4][2];
#pragma unroll
            for (int m = 0; m < 4; ++m)
#pragma unroll
                for (int bj = 0; bj < 2; ++bj) g3[m][bj] = *(const u32x2*)(G8 + (size_t)(row0 + ai * HALF + m * 16) * 4096 + 3 * 1024 + col0 + bj * HALF);
#pragma unroll
            for (int m = 0; m < 4; ++m)
#pragma unroll
                for (int bj = 0; bj < 2; ++bj) { f32x4 a = acc[ai][bj][m][0], b = acc[ai][bj][m][1];
#pragma unroll
                    for (int j = 0; j < 4; ++j) { a[j] *= (float)((g3[m][bj].x >> (8 * j)) & 255u) * (1.0f / 255.0f); b[j] *= (float)((g3[m][bj].y >> (8 * j)) & 255u) * (1.0f / 255.0f); }
                    u32x4 w; w.x = cvtpk(a.x, a.y); w.y = cvtpk(a.z, a.w); w.z = cvtpk(b.x, b.y); w.w = cvtpk(b.z, b.w);
                    *(u32x4*)(MG + (size_t)(row0 + ai * HALF + m * 16) * D + col0 + bj * HALF) = w; }
        }
    }
};
template <class F> struct EpiV8I8 { static constexpr bool PERM = true, MID = false; static constexpr int MID_EVERY = 1; F f; const float* sA; const unsigned* cmax;
    __device__ __forceinline__ void operator()(const f32x4 (&acc)[2][2][4][2], const Unit& u, int wr, int wc, int, int) const {
        const int ln = fresh_lane(), fr = ln & 15, fq = ln >> 4;
        const int row0 = u.pm * BM + wr * 64 + fr, col0 = u.pn * BM + wc * 32 + 8 * fq;
        f32x4 sb[2][2];
#pragma unroll
        for (int bj = 0; bj < 2; ++bj)
#pragma unroll
            for (int n = 0; n < 2; ++n) { const u32x4 c = *(const u32x4*)(cmax + col0 + bj * HALF + 4 * n); sb[bj][n] = (f32x4){__uint_as_float(c.x), __uint_as_float(c.y), __uint_as_float(c.z), __uint_as_float(c.w)} * (1.0f / 127.0f); }
#pragma unroll
        for (int ai = 0; ai < 2; ++ai) {
            typename F::Pre pre[4][2];
#pragma unroll
            for (int m = 0; m < 4; ++m)
#pragma unroll
                for (int bj = 0; bj < 2; ++bj) pre[m][bj] = f.load(u, row0 + ai * HALF + m * 16, col0 + bj * HALF);
#pragma unroll
            for (int m = 0; m < 4; ++m) { const float ra = sA[row0 + ai * HALF + m * 16];
#pragma unroll
                for (int bj = 0; bj < 2; ++bj) { f32x4 a, b;
#pragma unroll
                    for (int j = 0; j < 4; ++j) { a[j] = (float)__float_as_int(acc[ai][bj][m][0][j]) * ra * sb[bj][0][j]; b[j] = (float)__float_as_int(acc[ai][bj][m][1][j]) * ra * sb[bj][1][j]; }
                    f.fin(u, row0 + ai * HALF + m * 16, col0 + bj * HALF, a, b, pre[m][bj]); } }
            asm volatile("" ::: "memory"); }
    } };
template <class F> struct EpiDualI8 { static constexpr bool PERM = true, MID = false; static constexpr int MID_EVERY = 1; F f; const float* sA; const unsigned* cmax; const int* tokl;
    __device__ __forceinline__ void operator()(const f32x4 (&acc)[2][2][4][2], const Unit& u, int wr, int wc, int, int) const {
        const int ln = fresh_lane(), fr = ln & 15, fq = ln >> 4;
        const int lrow0 = wr * 64 + fr, hc0 = u.pn * HALF + wc * 32 + 8 * fq;
        const unsigned* cm = cmax + u.e * 1024 + u.pn * BM + wc * 32 + 8 * fq;
        f32x4 s1[2], s3[2];
#pragma unroll
        for (int n = 0; n < 2; ++n) { const u32x4 a = *(const u32x4*)(cm + 4 * n), b = *(const u32x4*)(cm + HALF + 4 * n);
            s1[n] = (f32x4){__uint_as_float(a.x), __uint_as_float(a.y), __uint_as_float(a.z), __uint_as_float(a.w)} * (1.0f / 127.0f);
            s3[n] = (f32x4){__uint_as_float(b.x), __uint_as_float(b.y), __uint_as_float(b.z), __uint_as_float(b.w)} * (1.0f / 127.0f); }
#pragma unroll
        for (int ai = 0; ai < 2; ++ai) {
            float ra[4];
#pragma unroll
            for (int m = 0; m < 4; ++m) { const int pos = u.p0 + lrow0 + ai * HALF + m * 16; const int tok = pos < u.ce ? (tokl[(size_t)u.e * R + pos] >> 1) : 0; ra[m] = sA[tok]; }
#pragma unroll
            for (int m = 0; m < 4; ++m) { f32x4 a0, a1, b0, b1;
#pragma unroll
                for (int j = 0; j < 4; ++j) { a0[j] = (float)__float_as_int(acc[ai][0][m][0][j]) * ra[m] * s1[0][j]; a1[j] = (float)__float_as_int(acc[ai][0][m][1][j]) * ra[m] * s1[1][j];
                    b0[j] = (float)__float_as_int(acc[ai][1][m][0][j]) * ra[m] * s3[0][j]; b1[j] = (float)__float_as_int(acc[ai][1][m][1][j]) * ra[m] * s3[1][j]; }
                f.apply8(u.pm * BM + lrow0 + ai * HALF + m * 16, hc0, a0, a1, b0, b1); }
        }
    } };
}

__device__ __forceinline__ u32x4 pack8(f32x4 a, f32x4 b) { u32x4 w; w.x = cvtpk(a.x, a.y); w.y = cvtpk(a.z, a.w); w.z = cvtpk(b.x, b.y); w.w = cvtpk(b.z, b.w); return w; }
__device__ __forceinline__ float sigm1(float x) { return __builtin_amdgcn_rcpf(1.0f + __builtin_amdgcn_exp2f(-1.4426950408889634f * x)); }
__device__ __forceinline__ f32x4 sigm4(f32x4 v) { f32x4 r; r.x = sigm1(v.x); r.y = sigm1(v.y); r.z = sigm1(v.z); r.w = sigm1(v.w); return r; }
struct NoPre {};
struct FStore8 { bf16_t* C; int ldc; typedef NoPre Pre;
    __device__ __forceinline__ Pre load(const pg8::Unit&, int, int) const { return Pre{}; }
    __device__ __forceinline__ void fin(const pg8::Unit&, int row, int col, f32x4 a, f32x4 b, const Pre&) const { *(u32x4*)(C + (size_t)row * ldc + col) = pack8(a, b); } };
struct FGateU8 { unsigned char* G8; const float* bias; typedef NoPre Pre;
    __device__ __forceinline__ Pre load(const pg8::Unit&, int, int) const { return Pre{}; }
    __device__ __forceinline__ void fin(const pg8::Unit&, int row, int col, f32x4 a, f32x4 b, const Pre&) const { const f32x4 b0 = *(const f32x4*)(bias + col), b1 = *(const f32x4*)(bias + col + 4);
        const f32x4 ga = sigm4(a + b0) * 255.0f + 0.5f, gb = sigm4(b + b1) * 255.0f + 0.5f;
        unsigned q[8] = {(unsigned)ga.x, (unsigned)ga.y, (unsigned)ga.z, (unsigned)ga.w, (unsigned)gb.x, (unsigned)gb.y, (unsigned)gb.z, (unsigned)gb.w};
#pragma unroll
        for (int k = 0; k < 8; ++k) q[k] = q[k] < 1u ? 1u : (q[k] > 255u ? 255u : q[k]);
        u32x2 w; w.x = q[0] | (q[1] << 8) | (q[2] << 16) | (q[3] << 24); w.y = q[4] | (q[5] << 8) | (q[6] << 16) | (q[7] << 24);
        *(u32x2*)(G8 + (size_t)row * 4096 + col) = w; } };
struct FMoe1 { bf16_t* HID;
    __device__ __forceinline__ void apply8(int row, int hc, f32x4 a0, f32x4 a1, f32x4 b0, f32x4 b1) const {
        *(u32x4*)(HID + (size_t)row * FF + hc) = pack8(a0 * sigm4(a0) * b0, a1 * sigm4(a1) * b1); } };
struct FMoe2 { bf16_t* MO; const int* tokl; const float* wl; struct Pre { int t; float w; };
    __device__ __forceinline__ Pre load(const pg8::Unit& u, int row, int) const { Pre r; const int pos = u.p0 + (row - u.pm * 256); r.t = -1; r.w = 0.f;
        if (pos < u.ce) { r.t = tokl[(size_t)u.e * R + pos]; r.w = wl[(size_t)u.e * R + pos]; } return r; }
    __device__ __forceinline__ void fin(const pg8::Unit&, int, int col, f32x4 a, f32x4 b, const Pre& q) const { if (q.t < 0) return;
        *(u32x4*)(MO + ((size_t)(q.t & 1) * R + (q.t >> 1)) * D + col) = pack8(a * q.w, b * q.w); } };
struct FOut { Ptrs P; int l; typedef f32x4 Pre; struct UnitPre { f32x4 g[4]; };
    __device__ __forceinline__ UnitPre unit(const pg8::Unit& u, int col0) const { UnitPre r; const float* g = mod_vec(P, l, row_bb(u.pm * 256), 2) + col0;
#pragma unroll
        for (int q = 0; q < 4; ++q) r.g[q] = *(const f32x4*)(g + (q >> 1) * 128 + (q & 1) * 16);
        return r; }
    __device__ __forceinline__ Pre load(const pg8::Unit&, int row, int col) const { return l == 0 ? *(const f32x4*)(xin_row(P, row) + col) : *(const f32x4*)(x1_row(P, row) + col); }
    __device__ __forceinline__ void fin(const pg8::Unit&, int row, int col, f32x4 v, const Pre& xp, const UnitPre& up, int q) const { *(f32x4*)(x1_row(P, row) + col) = xp + up.g[q] * v; } };

struct Frame { LAS unsigned char* lds; int wave, vcu, G; };
#define fresh_tid() (F.wave * 64 + fresh_lane())
__device__ __forceinline__ void tr_item(const float* W, int ldw, int k0, int csrc0, bf16_t* WT, int ldt, int drow0, LAS float* scr, int lane) {
    f32x4 v[8];
#pragma unroll
    for (int i = 0; i < 8; ++i) v[i] = *(const f32x4*)(W + (size_t)(k0 + (lane >> 3) + 8 * i) * ldw + csrc0 + (lane & 7) * 4);
#pragma unroll
    for (int i = 0; i < 8; ++i) { LAS float* d = scr + ((lane >> 3) + 8 * i) * 33 + (lane & 7) * 4; d[0] = v[i].x; d[1] = v[i].y; d[2] = v[i].z; d[3] = v[i].w; }
    LDS_WAIT(); asm volatile("" ::: "memory");
    const int c = lane & 7;
#pragma unroll
    for (int j = 0; j < 4; ++j) { const int n = (lane >> 3) + 8 * j; const LAS float* s = scr + (8 * c) * 33 + n;
        u32x4 o; o.x = cvtpk(s[0 * 33], s[1 * 33]); o.y = cvtpk(s[2 * 33], s[3 * 33]); o.z = cvtpk(s[4 * 33], s[5 * 33]); o.w = cvtpk(s[6 * 33], s[7 * 33]);
        *(u32x4*)(WT + (size_t)(drow0 + n) * ldt + k0 + 8 * c) = o; }
    LDS_WAIT(); asm volatile("" ::: "memory");
}
__device__ __forceinline__ void max_item(const float* W, int ldw, int k0, int csrc0, unsigned* cmax, int lane) {
    f32x4 m = (f32x4){0.f, 0.f, 0.f, 0.f};
#pragma unroll
    for (int i = 0; i < 8; ++i) { const f32x4 v = *(const f32x4*)(W + (size_t)(k0 + (lane >> 3) + 8 * i) * ldw + csrc0 + (lane & 7) * 4);
        m.x = fmaxf(m.x, fabsf(v.x)); m.y = fmaxf(m.y, fabsf(v.y)); m.z = fmaxf(m.z, fabsf(v.z)); m.w = fmaxf(m.w, fabsf(v.w)); }
#pragma unroll
    for (int o = 8; o < 64; o <<= 1) { m.x = fmaxf(m.x, shfl_xor_l(m.x, o, lane)); m.y = fmaxf(m.y, shfl_xor_l(m.y, o, lane)); m.z = fmaxf(m.z, shfl_xor_l(m.z, o, lane)); m.w = fmaxf(m.w, shfl_xor_l(m.w, o, lane)); }
    if (lane < 8) { atomicMax(cmax + lane * 4, __float_as_uint(m.x)); atomicMax(cmax + lane * 4 + 1, __float_as_uint(m.y)); atomicMax(cmax + lane * 4 + 2, __float_as_uint(m.z)); atomicMax(cmax + lane * 4 + 3, __float_as_uint(m.w)); }
}
__device__ __forceinline__ unsigned q8(float v, float inv) { int q = (int)__builtin_rintf(v * inv); q = q < -127 ? -127 : (q > 127 ? 127 : q); return (unsigned)q & 255u; }
__device__ __forceinline__ unsigned q8x4(float a, float b, float c, float d, float inv) { return q8(a, inv) | (q8(b, inv) << 8) | (q8(c, inv) << 16) | (q8(d, inv) << 24); }
__device__ __forceinline__ void tr_item_q(const float* W, int ldw, int k0, int csrc0, unsigned char* WT, int ldt, int drow0, const unsigned* cmax, LAS float* scr, int lane) {
    f32x4 v[8];
#pragma unroll
    for (int i = 0; i < 8; ++i) v[i] = *(const f32x4*)(W + (size_t)(k0 + (lane >> 3) + 8 * i) * ldw + csrc0 + (lane & 7) * 4);
#pragma unroll
    for (int i = 0; i < 8; ++i) { LAS float* d = scr + ((lane >> 3) + 8 * i) * 33 + (lane & 7) * 4; d[0] = v[i].x; d[1] = v[i].y; d[2] = v[i].z; d[3] = v[i].w; }
    LDS_WAIT(); asm volatile("" ::: "memory");
    const int n = lane >> 1, half = lane & 1; const float cm = __uint_as_float(cmax[n]); const float inv = cm > 0.f ? 127.0f / cm : 0.f;
    const LAS float* sp = scr + (half * 32) * 33 + n; unsigned w[8];
#pragma unroll
    for (int q = 0; q < 8; ++q) w[q] = q8x4(sp[(4 * q) * 33], sp[(4 * q + 1) * 33], sp[(4 * q + 2) * 33], sp[(4 * q + 3) * 33], inv);
    u32x4* dp = (u32x4*)(WT + (size_t)(drow0 + n) * ldt + k0 + half * 32);
    dp[0] = (u32x4){w[0], w[1], w[2], w[3]}; dp[1] = (u32x4){w[4], w[5], w[6], w[7]};
    LDS_WAIT(); asm volatile("" ::: "memory");
}
__device__ __forceinline__ void ph_weights(const Frame& F, const Ptrs& P, int l) {
    const int tid0 = fresh_tid(), lane0 = tid0 & 63;
    LAS float* scr = (LAS float*)(F.lds + F.wave * 16384);
    const int gw = F.vcu * NWAVES + F.wave, NGW = F.G * NWAVES;
    unsigned char* wb = P.ws + WS_WB;
    unsigned* cmaxp = (unsigned*)(P.ws + WS_CTL) + CW_CMAX + 32768 * l;
    constexpr int I0 = 1024, I1 = I0 + 2048, I2 = I1 + 768, I3 = I2 + 512, I4 = I3 + 4096, I5 = I4 + 4096, I6 = I5 + 4096;
    for (int it = gw; it < I6; it += NGW) {
        if (it < I0) { const int kb = it >> 6, nb = it & 63; max_item(P.w_in + (size_t)l * 1024 * 2560, 2560, kb * 64, 512 + nb * 32, cmaxp + 1024 + nb * 32, lane0); }
        else if (it < I1) { const int r = it - I0, i = r >> 9, q = r & 511, kb = q >> 5, nb = q & 31; max_item(P.w_gate + ((size_t)l * 4 + i) * 1024 * 1024, 1024, kb * 64, nb * 32, cmaxp + 3072 + i * 1024 + nb * 32, lane0); }
        else if (it < I2) { const int r = it - I1, i = r >> 8, q = r & 255, kb = q >> 5, nb = q & 31; tr_item(P.w_branch + ((size_t)l * 4 + i) * 512 * 1024, 1024, kb * 64, nb * 32, (bf16_t*)(wb + WB_BR) + i * 512, 2048, nb * 32, scr, lane0); }
        else if (it < I3) { const int q = it - I2, kb = q >> 5, nb = q & 31; tr_item(P.w_out + (size_t)l * 1024 * 1024, 1024, kb * 64, nb * 32, (bf16_t*)(wb + WB_OUT), 1024, nb * 32, scr, lane0); }
        else if (it < I5) { const int w3 = it >= I4; const int r = it - (w3 ? I4 : I3), e = r >> 8, q = r & 255, kb = q >> 4, nb = q & 15, c = nb * 32;
            max_item((w3 ? P.w3 : P.w1) + ((size_t)l * 16 + e) * 1024 * 512, 512, kb * 64, c, cmaxp + 8192 + e * 1024 + 256 * (c >> 7) + (c & 127) + (w3 ? 128 : 0), lane0); }
        else { const int r = it - I5, e = r >> 8, q = r & 255, kb = q >> 5, nb = q & 31; tr_item(P.w2 + ((size_t)l * 16 + e) * 512 * 1024, 1024, kb * 64, nb * 32, (bf16_t*)(wb + WB_2) + (size_t)e * 1024 * 512, 512, nb * 32, scr, lane0); }
    }
    __syncthreads();
    for (int u = F.vcu; u < 256; u += F.G) {
        LAS float* Wl = (LAS float*)F.lds; LAS float* ct = Wl + 16 * 128;
        const int kt = u >> 2, g = u & 3, k0 = kt * 16, tid = tid0; const float* w_in = P.w_in + (size_t)l * 1024 * 2560;
        if (tid < 128) ct[tid] = __builtin_amdgcn_cosf((float)tid * (1.0f / 128.0f));
        for (int i = tid; i < 16 * 128; i += 512) { const int k = i >> 7, c = i & 127; Wl[k * 128 + c] = w_in[(size_t)(k0 + k) * 2560 + g * 128 + c]; }
        __syncthreads();
        const int part = (tid >> 7) & 1, m = tid & 127, kh = tid >> 8; const float sc = 0.08838834764831845f;
        float* drow = (float*)(P.ws + WS_FTMP) + (size_t)(part * 512 + g * 128 + m) * 1024 + k0;
        { const int kb = kh * 8; float acc[8];
#pragma unroll
            for (int j = 0; j < 8; ++j) acc[j] = 0.f;
            for (int c = 0; c < 128; ++c) { const int idx = (c * m) & 127; const float tw = part ? -ct[(idx - 32) & 127] : ct[idx];
#pragma unroll
                for (int j = 0; j < 8; ++j) acc[j] += Wl[(kb + j) * 128 + c] * tw; }
            float mx = 0.f;
#pragma unroll
            for (int j = 0; j < 8; ++j) { acc[j] *= sc; mx = fmaxf(mx, fabsf(acc[j])); }
            *(f32x4*)(drow + kb) = (f32x4){acc[0], acc[1], acc[2], acc[3]}; *(f32x4*)(drow + kb + 4) = (f32x4){acc[4], acc[5], acc[6], acc[7]};
            atomicMax(cmaxp + part * 512 + g * 128 + m, __float_as_uint(mx)); }
        __syncthreads();
    }
    for (int u = F.vcu; u < 256; u += F.G) {
        LAS float* Wb = (LAS float*)F.lds;
        const int g = u >> 6, n0 = (u & 63) * 16, tid = tid0;
        const float* ps = P.pool_scale + (size_t)l * 512; const float* wb3 = P.w_branch + ((size_t)l * 4 + 3) * 512 * 1024; const float* pwl = P.pool_w + (size_t)l * 4 * 128 * 128;
        for (int i = tid; i < 128 * 16; i += 512) { const int e = i >> 4, n = i & 15; Wb[e * 16 + n] = ps[g * 128 + e] * wb3[(size_t)(g * 128 + e) * 1024 + n0 + n]; }
        __syncthreads();
        const int c = tid & 127, nh = tid >> 7; const float* pw = pwl + (size_t)(g * 128 + c) * 128;
        float acc[4];
#pragma unroll
        for (int j = 0; j < 4; ++j) acc[j] = 0.f;
        for (int e = 0; e < 128; e += 4) { const f32x4 p4 = *(const f32x4*)(pw + e);
#pragma unroll
            for (int q = 0; q < 4; ++q)
#pragma unroll
                for (int j = 0; j < 4; ++j) acc[j] += p4[q] * Wb[(e + q) * 16 + nh * 4 + j]; }
        bf16_t* Bt = (bf16_t*)(wb + WB_BR) + 3 * 512;
#pragma unroll
        for (int j = 0; j < 4; ++j) Bt[(size_t)(n0 + nh * 4 + j) * 2048 + g * 128 + c] = (bf16_t)f2bf(acc[j]);
        __syncthreads();
    }
}
__device__ __forceinline__ void ph_quant(const Frame& F, const Ptrs& P, int l) {
    const int tid0 = fresh_tid(), lane0 = tid0 & 63;
    LAS float* scr = (LAS float*)(F.lds + F.wave * 16384);
    const int gw = F.vcu * NWAVES + F.wave, NGW = F.G * NWAVES;
    unsigned char* wb = P.ws + WS_WB; const unsigned* cmaxp = (const unsigned*)(P.ws + WS_CTL) + CW_CMAX + 32768 * l;
    constexpr int I0 = 1024, I1 = I0 + 2048, I2 = I1 + 8192;
    for (int it = gw; it < I2; it += NGW) {
        if (it >= I1) { const int r0 = it - I1, w3 = r0 >> 12, r = r0 & 4095, e = r >> 8, q = r & 255, kb = q >> 4, nb = q & 15, c = nb * 32; const int drow = 256 * (c >> 7) + (c & 127) + (w3 ? 128 : 0);
            tr_item_q((w3 ? P.w3 : P.w1) + ((size_t)l * 16 + e) * 1024 * 512, 512, kb * 64, c, wb + WB_13 + (size_t)e * 1024 * 1024, 1024, drow, cmaxp + 8192 + e * 1024 + drow, scr, lane0); }
        else if (it < I0) { const int kb = it >> 6, nb = it & 63; tr_item_q(P.w_in + (size_t)l * 1024 * 2560, 2560, kb * 64, 512 + nb * 32, wb + WB_IN, 1024, 1024 + nb * 32, cmaxp + 1024 + nb * 32, scr, lane0); }
        else { const int r = it - I0, i = r >> 9, q = r & 511, kb = q >> 5, nb = q & 31; tr_item_q(P.w_gate + ((size_t)l * 4 + i) * 1024 * 1024, 1024, kb * 64, nb * 32, wb + WB_GATE + (size_t)i * 1024 * 1024, 1024, nb * 32, cmaxp + 3072 + i * 1024 + nb * 32, scr, lane0); }
    }
    for (int i = F.vcu * 512 + tid0; i < 65536; i += F.G * 512) {
        const int n = i >> 6, kc = (i & 63) * 16; const float cm = __uint_as_float(cmaxp[n]); const float inv = cm > 0.f ? 127.0f / cm : 0.f;
        const f32x4* tp = (const f32x4*)((const float*)(P.ws + WS_FTMP) + (size_t)n * 1024 + kc); const f32x4 a = tp[0], b = tp[1], c = tp[2], d = tp[3];
        *(u32x4*)(wb + WB_IN + (size_t)n * 1024 + kc) = (u32x4){q8x4(a.x, a.y, a.z, a.w, inv), q8x4(b.x, b.y, b.z, b.w, inv), q8x4(c.x, c.y, c.z, c.w, inv), q8x4(d.x, d.y, d.z, d.w, inv)};
    }
    __syncthreads();
}
__device__ __forceinline__ void ph_tables_mod(const Frame& F, const Ptrs& P) {
    const int tid0 = fresh_tid();
    { float* rc = (float*)(P.ws + WS_ROPE); float* rs = rc + 1024; float* ct = (float*)(P.ws + WS_COS);
      const int i = F.vcu * 512 + tid0;
      if (i < 1024) { const int pos = i >> 4, f = i & 15; const float inv = exp2f(-(float)f * (13.287712379549449f / 16.0f));
          float rev = (float)pos * inv * 0.15915494309189535f; rev = rev - floorf(rev);
          rc[i] = __builtin_amdgcn_cosf(rev); rs[i] = __builtin_amdgcn_sinf(rev); }
      if (i < 4096) ct[i] = __builtin_amdgcn_cosf((float)i * (1.0f / 4096.0f));
      if (i < 16384) { const int mm = i >> 7, k = i & 127, pp = mm >> 6, k1 = mm & 63, pk = k >> 6, t1 = k & 63; const float rev = (float)((k1 * t1) & 63) * (1.0f / 64.0f);
          const float c = __builtin_amdgcn_cosf(rev), sn = __builtin_amdgcn_sinf(rev);
          ((bf16_t*)(P.ws + WS_DFTM))[i] = (bf16_t)f2bf(pp == pk ? c : (pp == 0 ? sn : -sn)); } }
    for (int u = F.vcu; u < 192; u += F.G) {
        LAS float* s = (LAS float*)F.lds; LAS float* red = s + 9 * 1024;
        const int l = u / 96, j0 = (u % 96) * 64, tid = tid0;
        for (int i = tid; i < 9 * 1024; i += 512) { const int bb = i >> 10, k = i & 1023; const float v = bb < 8 ? P.c[bb * 1024 + k] : P.c_ctx[k]; s[i] = v / (1.f + expf(-v)); }
        __syncthreads();
        const int kc = tid >> 6, jj = tid & 63; float acc[9];
#pragma unroll
        for (int b = 0; b < 9; ++b) acc[b] = 0.f;
        const float* w = P.w_ada + (size_t)l * 1024 * 6144 + j0 + jj;
        for (int k = kc * 128; k < kc * 128 + 128; k += 8) { float wv[8];
#pragma unroll
            for (int q = 0; q < 8; ++q) wv[q] = w[(size_t)(k + q) * 6144];
#pragma unroll
            for (int q = 0; q < 8; ++q)
#pragma unroll
                for (int b = 0; b < 9; ++b) acc[b] += s[b * 1024 + k + q] * wv[q]; }
#pragma unroll
        for (int b = 0; b < 9; ++b) red[(kc * 9 + b) * 64 + jj] = acc[b];
        __syncthreads();
        float* mod = (float*)(P.ws + WS_MOD);
        for (int i = tid; i < 9 * 64; i += 512) { const int b = i >> 6, j = i & 63; float v = P.b_ada[l * 6144 + j0 + j];
#pragma unroll
            for (int q = 0; q < 8; ++q) v += red[(q * 9 + b) * 64 + j];
            mod[(size_t)(l * 9 + b) * 6144 + j0 + j] = v; }
        __syncthreads();
    }
}
__device__ __forceinline__ void route_row(const Ptrs& P, int r, const f32x4 (&h)[4], int lane, bool publish, LAS unsigned* lcnt, LAS int* rec, const LAS float* rwl) {
    float lg[16];
#pragma unroll
    for (int e = 0; e < 16; ++e) lg[e] = 0.f;
#pragma unroll
    for (int j = 0; j < 4; ++j) {
#pragma unroll
        for (int i = 0; i < 4; ++i) { const int kk = 4 * lane + 256 * j + i; const LAS f32x4* rw = (const LAS f32x4*)(rwl + kk * 16 + (kk >> 2) * 4); const float hv = h[j][i];
#pragma unroll
            for (int qd = 0; qd < 4; ++qd) { const f32x4 w = rw[qd]; lg[4 * qd] += hv * w.x; lg[4 * qd + 1] += hv * w.y; lg[4 * qd + 2] += hv * w.z; lg[4 * qd + 3] += hv * w.w; } }
        __builtin_amdgcn_sched_barrier(0); }
    float v8[8], v4[4], v2[2], v1;
    { const bool bit = (lane & 32) != 0;
#pragma unroll
      for (int i = 0; i < 8; ++i) { const float a = lg[i], b = lg[i + 8]; v8[i] = (bit ? b : a) + shfl_xor_l(bit ? a : b, 32, lane); } }
    { const bool bit = (lane & 16) != 0;
#pragma unroll
      for (int i = 0; i < 4; ++i) { const float a = v8[i], b = v8[i + 4]; v4[i] = (bit ? b : a) + shfl_xor_l(bit ? a : b, 16, lane); } }
    { const bool bit = (lane & 8) != 0;
#pragma unroll
      for (int i = 0; i < 2; ++i) { const float a = v4[i], b = v4[i + 2]; v2[i] = (bit ? b : a) + shfl_xor_l(bit ? a : b, 8, lane); } }
    { const bool bit = (lane & 4) != 0; const float a = v2[0], b = v2[1]; v1 = (bit ? b : a) + shfl_xor_l(bit ? a : b, 4, lane); }
    v1 += shfl_xor_l(v1, 2, lane); v1 += shfl_xor_l(v1, 1, lane);
    float bestscore = -INFINITY; int be0 = 0, be1 = 1; float ba0 = 0.f, ba1 = 0.f;
#pragma unroll
    for (int g = 0; g < 4; ++g) {
        float aff[4], sel[4];
#pragma unroll
        for (int i = 0; i < 4; ++i) { const float t = __int_as_float(__builtin_amdgcn_ds_bpermute((4 * g + i) << 4, __float_as_int(v1))); aff[i] = 1.0f / (1.0f + expf(-t)); sel[i] = aff[i] + P.router_bias[4 * g + i]; }
        int i1 = 0; float m1 = sel[0], a1 = aff[0];
#pragma unroll
        for (int i = 1; i < 4; ++i) if (sel[i] > m1) { m1 = sel[i]; a1 = aff[i]; i1 = i; }
        int i2 = -1; float m2 = -INFINITY, a2 = 0.f;
#pragma unroll
        for (int i = 0; i < 4; ++i) if (i != i1 && sel[i] > m2) { m2 = sel[i]; a2 = aff[i]; i2 = i; }
        const float score = m1 + m2;
        if (score > bestscore) { bestscore = score; be0 = 4 * g + i1; be1 = 4 * g + i2; ba0 = a1; ba1 = a2; }
    }
    if (lane == 0 && publish) {
        const int p0 = (int)__hip_atomic_fetch_add(lcnt + be0, 1u, __ATOMIC_RELAXED, __HIP_MEMORY_SCOPE_WORKGROUP), p1 = (int)__hip_atomic_fetch_add(lcnt + be1, 1u, __ATOMIC_RELAXED, __HIP_MEMORY_SCOPE_WORKGROUP);
        const float inv = 1.0f / (ba0 + ba1);
        rec[0] = r; rec[1] = be0; rec[2] = p0; rec[3] = be1; rec[4] = p1; rec[5] = __float_as_int(ba0 * inv); rec[6] = __float_as_int(ba1 * inv);
    }
}
template <int MODE> __device__ __forceinline__ void ph_norm(const Frame& F, const Ptrs& P, int l, int nrows) {
    constexpr int NRW = MODE == 2 ? 2 : 4;
    const int lane = fresh_lane();
    const int stride = F.G * NWAVES;
    LAS unsigned* lcnt = (LAS unsigned*)F.lds; LAS unsigned* gbase = lcnt + 16; LAS int* recs = (LAS int*)(F.lds + 256);
    const LAS float* rwl = (const LAS float*)(F.lds + 8192);
    if (MODE == 2) { if (F.wave == 0 && lane < 16) lcnt[lane] = 0u;
        { const int tid = F.wave * 64 + lane; LAS f32x4* d = (LAS f32x4*)(F.lds + 8192);
#pragma unroll
          for (int i = 0; i < 8; ++i) { const int idx = tid + 512 * i, kk = idx >> 2; d[idx + (kk >> 2)] = ((const f32x4*)P.router_w)[idx]; } }
        __syncthreads(); }
    int it = 0;
    for (int rb = F.vcu * NWAVES + F.wave; rb < nrows; rb += NRW * stride, ++it) {
        int rr[NRW];
#pragma unroll
        for (int q = 0; q < NRW; ++q) rr[q] = rb + q * stride < nrows ? rb + q * stride : rb;
        f32x4 v[NRW][4];
#pragma unroll
        for (int q = 0; q < NRW; ++q) { const int r = rr[q];
            if (MODE == 0) { const f32x4* xr = (const f32x4*)xin_row(P, r) + lane;
#pragma unroll
                for (int j = 0; j < 4; ++j) v[q][j] = xr[64 * j]; }
            else { const f32x4* xr = (const f32x4*)x1_row(P, r) + lane;
#pragma unroll
                for (int j = 0; j < 4; ++j) v[q][j] = xr[64 * j]; } }
        if (MODE == 1) {
#pragma unroll
            for (int q = 0; q < NRW; ++q) { const int r = rr[q]; const int bb = row_bb(r); const f32x4* g2 = (const f32x4*)mod_vec(P, l - 1, bb, 5) + lane;
                const u32x2* m0 = (const u32x2*)((const bf16_t*)(P.ws + WS_MO) + (size_t)r * D) + lane; const u32x2* m1 = (const u32x2*)((const bf16_t*)(P.ws + WS_MO) + (size_t)(R + r) * D) + lane;
#pragma unroll
                for (int j = 0; j < 4; ++j) { const u32x2 a = m0[64 * j], b = m1[64 * j]; const f32x4 g = g2[64 * j];
                    v[q][j].x += g.x * (lo16(a.x) + lo16(b.x)); v[q][j].y += g.y * (hi16(a.x) + hi16(b.x)); v[q][j].z += g.z * (lo16(a.y) + lo16(b.y)); v[q][j].w += g.w * (hi16(a.y) + hi16(b.y)); } }
#pragma unroll
            for (int q = 0; q < NRW; ++q) if (q == 0 || rr[q] != rr[0]) { f32x4* xr = (f32x4*)x1_row(P, rr[q]) + lane;
#pragma unroll
                for (int j = 0; j < 4; ++j) xr[64 * j] = v[q][j]; }
        }
        float ss[NRW];
#pragma unroll
        for (int q = 0; q < NRW; ++q) { ss[q] = 0.f;
#pragma unroll
            for (int j = 0; j < 4; ++j) ss[q] += (v[q][j].x * v[q][j].x + v[q][j].y * v[q][j].y) + (v[q][j].z * v[q][j].z + v[q][j].w * v[q][j].w); }
#pragma unroll
        for (int o = 1; o < 64; o <<= 1) {
#pragma unroll
            for (int q = 0; q < NRW; ++q) ss[q] += shfl_xor_l(ss[q], o, lane); }
        const f32x4* gn = (const f32x4*)((MODE == 2 ? P.norm2 : P.norm1) + (size_t)l * D) + lane;
#pragma unroll
        for (int q = 0; q < NRW; ++q) { const int r = rr[q]; const int bb = row_bb(r);
            if (q > 0 && r == rr[0]) continue;
            const float rstd = 1.0f / sqrtf(ss[q] * (1.0f / D) + EPS);
            const f32x4* sh = (const f32x4*)mod_vec(P, l, bb, MODE == 2 ? 3 : 0) + lane;
            const f32x4* sc = (const f32x4*)mod_vec(P, l, bb, MODE == 2 ? 4 : 1) + lane;
            {
                float mx = 0.f;
#pragma unroll
                for (int j = 0; j < 4; ++j) { const f32x4 g = gn[64 * j], a = sh[64 * j], b = sc[64 * j];
                    v[q][j] = (v[q][j] * rstd * g) * (b + 1.0f) + a;
                    mx = fmaxf(mx, fmaxf(fmaxf(fabsf(v[q][j].x), fabsf(v[q][j].y)), fmaxf(fabsf(v[q][j].z), fabsf(v[q][j].w)))); }
#pragma unroll
                for (int o = 1; o < 64; o <<= 1) mx = fmaxf(mx, shfl_xor_l(mx, o, lane));
                const float inv = mx > 0.f ? 127.0f / mx : 0.f;
                unsigned* o8 = (unsigned*)(P.ws + WS_H + (size_t)r * D) + lane;
#pragma unroll
                for (int j = 0; j < 4; ++j) o8[64 * j] = q8x4(v[q][j].x, v[q][j].y, v[q][j].z, v[q][j].w, inv);
                if (lane == 0) ((float*)(P.ws + WS_SA))[r] = mx * (1.0f / 127.0f); } }
        if (MODE == 2) { LAS int* rec = recs + (F.wave * 24 + 2 * it) * 8;
            route_row(P, rr[0], v[0], lane, true, lcnt, rec, rwl); __builtin_amdgcn_sched_barrier(0);
            if (lane == 0 && rr[1] == rr[0]) rec[8] = -1;
            route_row(P, rr[1], v[1], lane, rr[1] != rr[0], lcnt, rec + 8, rwl); }
    }
    if (MODE == 2) {
        __syncthreads();
        const int tid = F.wave * 64 + lane;
        if (tid < 16) { const unsigned c = lcnt[tid]; gbase[tid] = c ? atomicAdd((unsigned*)(P.ws + WS_CTL) + CW_CNT + 1024 * l + 64 * tid, c) : 0u; }
        __syncthreads();
        if (lane == 0) for (int k = 0; k < 2 * it; ++k) { const LAS int* rec = recs + (F.wave * 24 + k) * 8; const int r = rec[0]; if (r < 0) continue;
            int* tokl = (int*)(P.ws + WS_TOKL); float* wl = (float*)(P.ws + WS_WL);
            const size_t i0 = (size_t)rec[1] * R + rec[2] + gbase[rec[1]], i1 = (size_t)rec[3] * R + rec[4] + gbase[rec[3]];
            tokl[i0] = 2 * r; wl[i0] = __int_as_float(rec[5]); tokl[i1] = 2 * r + 1; wl[i1] = __int_as_float(rec[6]); }
        __syncthreads();
    }
}
__device__ __forceinline__ void ph_kprep(const Frame& F, const Ptrs& P, int l) {
    const int lane = fresh_lane();
    const float* rc = (const float*)(P.ws + WS_ROPE); const float* rs = rc + 1024;
    const int hs = (lane >> 3) & 3, chunk = lane & 7, col = (hs < 2 ? C_KB + hs * 64 : C_KW + (hs - 2) * 64) + chunk * 8;
    const f32x4 g0 = *(const f32x4*)(P.k_gain + l * 64 + chunk * 8), g1 = *(const f32x4*)(P.k_gain + l * 64 + chunk * 8 + 4);
    const int a = chunk >> 2, fi = (chunk & 1) * 8; const bool second = (chunk & 2) != 0;
    const int npair = R / 2, stride = F.G * NWAVES;
    for (int pr0 = F.vcu * NWAVES + F.wave; pr0 < npair; pr0 += 4 * stride) {
        u32x4 w[4];
#pragma unroll
        for (int q = 0; q < 4; ++q) { const int pr = pr0 + q * stride; const int r = 2 * (pr < npair ? pr : pr0) + (lane >> 5); w[q] = *(const u32x4*)((const bf16_t*)(P.ws + WS_U) + (size_t)r * NIN + col); }
#pragma unroll
        for (int q = 0; q < 4; ++q) { const int pr = pr0 + q * stride; if (pr >= npair) break;
            const int r = 2 * pr + (lane >> 5);
            float x[8] = {lo16(w[q].x), hi16(w[q].x), lo16(w[q].y), hi16(w[q].y), lo16(w[q].z), hi16(w[q].z), lo16(w[q].w), hi16(w[q].w)};
            if (hs < 2) { float ss = 0.f;
#pragma unroll
                for (int j = 0; j < 8; ++j) ss += x[j] * x[j];
                ss += shfl_xor_l(ss, 1, lane); ss += shfl_xor_l(ss, 2, lane); ss += shfl_xor_l(ss, 4, lane);
                const float rstd = 1.0f / sqrtf(ss * (1.0f / 64.0f) + EPS);
                x[0] *= rstd * g0.x; x[1] *= rstd * g0.y; x[2] *= rstd * g0.z; x[3] *= rstd * g0.w; x[4] *= rstd * g1.x; x[5] *= rstd * g1.y; x[6] *= rstd * g1.z; x[7] *= rstd * g1.w; }
            if (r < RL) { const int t = r & (T - 1), pos = a ? (t & 63) : (t >> 6);
                const f32x4 c0 = *(const f32x4*)(rc + pos * 16 + fi), c1 = *(const f32x4*)(rc + pos * 16 + fi + 4), s0 = *(const f32x4*)(rs + pos * 16 + fi), s1 = *(const f32x4*)(rs + pos * 16 + fi + 4);
                const float cs[8] = {c0.x, c0.y, c0.z, c0.w, c1.x, c1.y, c1.z, c1.w}, sn[8] = {s0.x, s0.y, s0.z, s0.w, s1.x, s1.y, s1.z, s1.w};
#pragma unroll
                for (int j = 0; j < 8; ++j) { const float y = shfl_xor_l(x[j], 2, lane); x[j] = second ? x[j] * cs[j] + y * sn[j] : x[j] * cs[j] - y * sn[j]; } }
            u32x4 o; o.x = cvtpk(x[0], x[1]); o.y = cvtpk(x[2], x[3]); o.z = cvtpk(x[4], x[5]); o.w = cvtpk(x[6], x[7]);
            *(u32x4*)((bf16_t*)(P.ws + WS_U) + (size_t)r * NIN + col) = o; }
    }
}
__device__ __forceinline__ void ph_pool(const Frame& F, const Ptrs& P, int nrows) {
    const int tid0 = fresh_tid();
    for (int i = F.vcu * 512 + tid0; i < nrows * 64; i += F.G * 512) {
        const int r = i >> 6, c8 = (i & 63) * 8;
        const bool lat = r < RL; const int Ts = lat ? T : TC; const int t = lat ? (r & (T - 1)) : ((r - RL) & (TC - 1)); const int r0 = r - t;
        const int g = c8 >> 7, hw = 1 << g;
        const int lo = t - hw < 0 ? 0 : t - hw, hi = t + hw > Ts ? Ts : t + hw;
        const bf16_t* U = (const bf16_t*)(P.ws + WS_U) + C_P + c8;
        u32x4 wv[16];
#pragma unroll
        for (int k = 0; k < 16; ++k) { const int tt = t - 8 + k; const bool ok = tt >= lo && tt < hi; wv[k] = *(const u32x4*)(U + (size_t)(r0 + (ok ? tt : t)) * NIN); }
        float s[8];
#pragma unroll
        for (int j = 0; j < 8; ++j) s[j] = 0.f;
#pragma unroll
        for (int k = 0; k < 16; ++k) { const int tt = t - 8 + k; const float f = (tt >= lo && tt < hi) ? 1.f : 0.f; const u32x4 w = wv[k];
            s[0] += f * lo16(w.x); s[1] += f * hi16(w.x); s[2] += f * lo16(w.y); s[3] += f * hi16(w.y); s[4] += f * lo16(w.z); s[5] += f * hi16(w.z); s[6] += f * lo16(w.w); s[7] += f * hi16(w.w); }
        const u32x4 w = wv[8]; const float inv = 1.0f / (float)(hi - lo);
        u32x4 o; o.x = cvtpk(s[0] * inv - lo16(w.x), s[1] * inv - hi16(w.x)); o.y = cvtpk(s[2] * inv - lo16(w.y), s[3] * inv - hi16(w.y));
        o.z = cvtpk(s[4] * inv - lo16(w.z), s[5] * inv - hi16(w.z)); o.w = cvtpk(s[6] * inv - lo16(w.w), s[7] * inv - hi16(w.w));
        *(u32x4*)((bf16_t*)(P.ws + WS_BR) + (size_t)r * NBR + 1536 + c8) = o;
    }
}
__device__ __forceinline__ void ph_final(const Frame& F, const Ptrs& P) {
    const int lane = fresh_lane(); const int stride = F.G * NWAVES;
    for (int rb = F.vcu * NWAVES + F.wave; rb < RL; rb += 4 * stride) {
        f32x4 v[4][4]; float ss[4];
#pragma unroll
        for (int q = 0; q < 4; ++q) { const int r = rb + q * stride < RL ? rb + q * stride : rb; const int bb = row_bb(r);
            const f32x4* xr = (const f32x4*)(P.out + (size_t)r * D) + lane; const f32x4* g2 = (const f32x4*)mod_vec(P, 1, bb, 5) + lane;
            const u32x2* m0 = (const u32x2*)((const bf16_t*)(P.ws + WS_MO) + (size_t)r * D) + lane; const u32x2* m1 = (const u32x2*)((const bf16_t*)(P.ws + WS_MO) + (size_t)(R + r) * D) + lane;
            ss[q] = 0.f;
#pragma unroll
            for (int j = 0; j < 4; ++j) { v[q][j] = xr[64 * j]; const u32x2 a = m0[64 * j], b = m1[64 * j]; const f32x4 g = g2[64 * j];
                v[q][j].x += g.x * (lo16(a.x) + lo16(b.x)); v[q][j].y += g.y * (hi16(a.x) + hi16(b.x)); v[q][j].z += g.z * (lo16(a.y) + lo16(b.y)); v[q][j].w += g.w * (hi16(a.y) + hi16(b.y));
                ss[q] += (v[q][j].x * v[q][j].x + v[q][j].y * v[q][j].y) + (v[q][j].z * v[q][j].z + v[q][j].w * v[q][j].w); } }
#pragma unroll
        for (int o = 1; o < 64; o <<= 1) {
#pragma unroll
            for (int q = 0; q < 4; ++q) ss[q] += shfl_xor_l(ss[q], o, lane); }
        const f32x4* gn = (const f32x4*)P.norm_f + lane;
#pragma unroll
        for (int q = 0; q < 4; ++q) { const int r = rb + q * stride; if (r >= RL) continue;
            const float rstd = 1.0f / sqrtf(ss[q] * (1.0f / D) + EPS); f32x4* xr = (f32x4*)(P.out + (size_t)r * D) + lane;
#pragma unroll
            for (int j = 0; j < 4; ++j) xr[64 * j] = v[q][j] * rstd * gn[64 * j]; }
    }
}

__device__ __forceinline__ void ph_fourier_ref(const Frame& F, const Ptrs& P, int Ts, int latent) {
    const int tid = fresh_tid();
    LAS float* Zr = (LAS float*)F.lds; LAS float* Zi = Zr + 16 * 64; LAS float* Ct = Zi + 16 * 64; LAS float* St = Ct + 64 * 17;
    const bf16_t* U = (const bf16_t*)(P.ws + WS_U); const float* ct = (const float*)(P.ws + WS_COS);
    const int nkt = Ts / 64, NU = 8 * nkt * 8, step = 4096 / Ts;
    const int tk = tid >> 4, tc = tid & 15;
    for (int u = F.vcu; u < NU; u += F.G) {
        const int cht = u & 7, kt = (u >> 3) % nkt, b = (u >> 3) / nkt, k0 = kt * 64, ch0 = cht * 64;
        const int rbase = latent ? b * T : RL + b * TC;
        float acc[2][4];
#pragma unroll
        for (int i = 0; i < 2; ++i)
#pragma unroll
            for (int j = 0; j < 4; ++j) acc[i][j] = 0.f;
        for (int t0 = 0; t0 < Ts; t0 += 16) {
            __syncthreads();
            if (tid < 256) { const int tt = tid >> 4, c4 = (tid & 15) * 4; const bf16_t* zp = U + (size_t)(rbase + t0 + tt) * NIN + ch0 + c4;
              const u32x2 a = *(const u32x2*)(zp + C_ZR), bq = *(const u32x2*)(zp + C_ZI);
              Zr[tt * 64 + c4] = lo16(a.x); Zr[tt * 64 + c4 + 1] = hi16(a.x); Zr[tt * 64 + c4 + 2] = lo16(a.y); Zr[tt * 64 + c4 + 3] = hi16(a.y);
              Zi[tt * 64 + c4] = lo16(bq.x); Zi[tt * 64 + c4 + 1] = hi16(bq.x); Zi[tt * 64 + c4 + 2] = lo16(bq.y); Zi[tt * 64 + c4 + 3] = hi16(bq.y); }
#pragma unroll
            for (int i = 0; i < 2; ++i) { const int e = tid * 2 + i, k = e >> 4, tt = e & 15; const int ang = (((k0 + k) * (t0 + tt)) & (Ts - 1)) * step;
                Ct[k * 17 + tt] = ct[ang]; St[k * 17 + tt] = ct[(ang - 1024) & 4095]; }
            __syncthreads();
#pragma unroll 2
            for (int tt = 0; tt < 16; ++tt) { float zr[4], zi[4];
#pragma unroll
                for (int j = 0; j < 4; ++j) { zr[j] = Zr[tt * 64 + tc * 4 + j]; zi[j] = Zi[tt * 64 + tc * 4 + j]; }
#pragma unroll
                for (int i = 0; i < 2; ++i) { const float c = Ct[(tk * 2 + i) * 17 + tt], sn = St[(tk * 2 + i) * 17 + tt];
#pragma unroll
                    for (int j = 0; j < 4; ++j) acc[i][j] += c * zr[j] + sn * zi[j]; } }
        }
        const float sc = 1.0f / sqrtf((float)Ts);
        bf16_t* BR = (bf16_t*)(P.ws + WS_BR);
#pragma unroll
        for (int i = 0; i < 2; ++i) { u32x2 w; w.x = pk2(acc[i][0] * sc, acc[i][1] * sc); w.y = pk2(acc[i][2] * sc, acc[i][3] * sc);
            *(u32x2*)(BR + (size_t)(rbase + k0 + tk * 2 + i) * NBR + ch0 + tc * 4) = w; }
        __syncthreads();
    }
}

typedef float f32x16 __attribute__((ext_vector_type(16)));
typedef short v4i16_t __attribute__((ext_vector_type(4)));
constexpr float ATT_THR = 4.0f;
constexpr int AT_ROWB = 144, AT_TILEB = 64 * AT_ROWB;
constexpr int AT_VROWB = 192, AT_VTILEB = 64 * AT_VROWB;
constexpr int AT_STAGEB = 2 * AT_TILEB + 2 * AT_VTILEB;
#define AT_SB() __builtin_amdgcn_sched_barrier(0)
template <bool FIXED> __device__ __forceinline__ void at_qk1(const LAS unsigned char* Kt, int kf_off, const bf16x8 (&qr)[4], const f32x16& negm_, f32x16& p0, f32x16& p1) {
    f32x16 zc;
#pragma unroll
    for (int r = 0; r < 16; ++r) zc[r] = 0.f;
    const f32x16& negm = FIXED ? zc : negm_;
    bf16x8 ka[8];
#pragma unroll
    for (int d0 = 0; d0 < 4; ++d0) { ka[2 * d0] = *(const LAS bf16x8*)(Kt + kf_off + d0 * 32); ka[2 * d0 + 1] = *(const LAS bf16x8*)(Kt + kf_off + 32 * AT_ROWB + d0 * 32); }
    p0 = __builtin_amdgcn_mfma_f32_32x32x16_bf16(ka[0], qr[0], negm, 0, 0, 0); p1 = __builtin_amdgcn_mfma_f32_32x32x16_bf16(ka[1], qr[0], negm, 0, 0, 0);
#pragma unroll
    for (int d0 = 1; d0 < 4; ++d0) { p0 = __builtin_amdgcn_mfma_f32_32x32x16_bf16(ka[2 * d0], qr[d0], p0, 0, 0, 0); p1 = __builtin_amdgcn_mfma_f32_32x32x16_bf16(ka[2 * d0 + 1], qr[d0], p1, 0, 0, 0); }
}
__device__ __forceinline__ void at_vread(const LAS unsigned char* vp, v4i16_t (&f)[4]) {
    f[0] = __builtin_amdgcn_ds_read_tr16_b64_v4i16((LAS v4i16_t*)(vp)); f[1] = __builtin_amdgcn_ds_read_tr16_b64_v4i16((LAS v4i16_t*)(vp + 8 * AT_VROWB));
    f[2] = __builtin_amdgcn_ds_read_tr16_b64_v4i16((LAS v4i16_t*)(vp + 64)); f[3] = __builtin_amdgcn_ds_read_tr16_b64_v4i16((LAS v4i16_t*)(vp + 8 * AT_VROWB + 64));
}
__device__ __forceinline__ bf16x8 at_ppack(const f32x16& p, int sx) { u32x4 pw; pw.x = cvtpk(p[8 * sx], p[8 * sx + 1]); pw.y = cvtpk(p[8 * sx + 2], p[8 * sx + 3]); pw.z = cvtpk(p[8 * sx + 4], p[8 * sx + 5]); pw.w = cvtpk(p[8 * sx + 6], p[8 * sx + 7]); return __builtin_bit_cast(bf16x8, pw); }
__device__ __forceinline__ void at_pvmm(const v4i16_t (&f)[4], const bf16x8 pf, f32x16& o0, f32x16& o1) {
    const bf16x8 v0 = (bf16x8){f[0][0], f[0][1], f[0][2], f[0][3], f[1][0], f[1][1], f[1][2], f[1][3]}, v1 = (bf16x8){f[2][0], f[2][1], f[2][2], f[2][3], f[3][0], f[3][1], f[3][2], f[3][3]};
    o0 = __builtin_amdgcn_mfma_f32_32x32x16_bf16(v0, pf, o0, 0, 0, 0); o1 = __builtin_amdgcn_mfma_f32_32x32x16_bf16(v1, pf, o1, 0, 0, 0);
}
__device__ __forceinline__ float at_exp8(f32x16& p, int sx) { float rs = 0.f;
#pragma unroll
    for (int j = 0; j < 8; ++j) { p[8 * sx + j] = __builtin_amdgcn_exp2f(p[8 * sx + j]); rs += p[8 * sx + j]; }
    return rs; }
template <bool FIXED> __device__ __forceinline__ float at_slot(const LAS unsigned char* Vt, const LAS unsigned char* Kn, const bool hasnext, int kf_off, int vf_off, const bf16x8 (&qr)[4], const f32x16& negm_,
                                         f32x16& pc0, f32x16& pc1, f32x16& pn0, f32x16& pn1, f32x16& o0, f32x16& o1) {
    f32x16 zc;
#pragma unroll
    for (int r = 0; r < 16; ++r) zc[r] = 0.f;
    const f32x16& negm = FIXED ? zc : negm_;
    v4i16_t fA[4], fB[4]; bf16x8 ka0, ka1, kb0, kb1; float rs;
#define AT_KLD(A0, A1, d0) do { A0 = *(const LAS bf16x8*)(Kn + kf_off + (d0) * 32); A1 = *(const LAS bf16x8*)(Kn + kf_off + 32 * AT_ROWB + (d0) * 32); } while (0)
    if (FIXED) AT_KLD(ka0, ka1, 0);
    at_vread(Vt + vf_off, fA); rs = at_exp8(pc0, 0); AT_SB();
    at_vread(Vt + vf_off + 16 * AT_VROWB, fB); if (FIXED) AT_KLD(kb0, kb1, 1); else AT_KLD(ka0, ka1, 0);
    if (hasnext) { pn0 = __builtin_amdgcn_mfma_f32_32x32x16_bf16(ka0, qr[0], negm, 0, 0, 0); pn1 = __builtin_amdgcn_mfma_f32_32x32x16_bf16(ka1, qr[0], negm, 0, 0, 0); }
    at_pvmm(fA, at_ppack(pc0, 0), o0, o1); rs += at_exp8(pc0, 1); AT_SB();
    at_vread(Vt + vf_off + 32 * AT_VROWB, fA); if (FIXED) AT_KLD(ka0, ka1, 2); else AT_KLD(kb0, kb1, 1);
    if (hasnext) { pn0 = __builtin_amdgcn_mfma_f32_32x32x16_bf16(kb0, qr[1], pn0, 0, 0, 0); pn1 = __builtin_amdgcn_mfma_f32_32x32x16_bf16(kb1, qr[1], pn1, 0, 0, 0); }
    at_pvmm(fB, at_ppack(pc0, 1), o0, o1); rs += at_exp8(pc1, 0); AT_SB();
    at_vread(Vt + vf_off + 48 * AT_VROWB, fB); if (FIXED) AT_KLD(kb0, kb1, 3); else AT_KLD(ka0, ka1, 2);
    if (hasnext) { pn0 = __builtin_amdgcn_mfma_f32_32x32x16_bf16(ka0, qr[2], pn0, 0, 0, 0); pn1 = __builtin_amdgcn_mfma_f32_32x32x16_bf16(ka1, qr[2], pn1, 0, 0, 0); }
    at_pvmm(fA, at_ppack(pc1, 0), o0, o1); rs += at_exp8(pc1, 1); AT_SB();
    if (!FIXED) AT_KLD(kb0, kb1, 3);
    if (hasnext) { pn0 = __builtin_amdgcn_mfma_f32_32x32x16_bf16(kb0, qr[3], pn0, 0, 0, 0); pn1 = __builtin_amdgcn_mfma_f32_32x32x16_bf16(kb1, qr[3], pn1, 0, 0, 0); }
    at_pvmm(fB, at_ppack(pc1, 1), o0, o1);
#undef AT_KLD
    return rs;
}
template <int MODE, bool FIXED> __device__ __forceinline__ void ph_attn_impl(const Frame& F, const Ptrs& P, int l) {
    const bool latq = MODE < 2; const bool winm = (MODE == 1 || MODE == 3);
    const int NU = latq ? 1024 : 64;
    LAS unsigned char* Lb = F.lds;
    constexpr bool fixedref = FIXED;
    for (int u = F.vcu; u < NU; u += F.G) {
        const int lane = fresh_lane(), tid = F.wave * 64 + lane, r32 = lane & 31, hi = lane >> 5;
        const bf16_t* U = (const bf16_t*)(P.ws + WS_U);
        const int st_off = (tid >> 3) * AT_ROWB + (tid & 7) * 16;
        const int kf_off = r32 * AT_ROWB + hi * 16;
        const int sv_off = (tid >> 3) * AT_VROWB + (tid & 7) * 16;
        const int vf_off = (4 * hi + ((lane & 15) >> 2)) * AT_VROWB + (((lane >> 4) & 1) * 16 + (lane & 3) * 4) * 2;
        const int qb = latq ? (u & 63) : (u & 3), g = latq ? ((u >> 6) & 1) : ((u >> 2) & 1), b = latq ? (u >> 7) : (u >> 3);
        const int tq0 = qb * 64, hq = 4 * g + (F.wave >> 1), tq = tq0 + 32 * (F.wave & 1) + r32;
        const int qrow = latq ? b * T + tq : RL + b * TC + tq;
        const int qcol = (winm ? C_QW : C_QB) + hq * 64, kcol = (winm ? C_KW : C_KB) + g * 64, vcol = (winm ? C_VW : C_VB) + g * 64;
        int lt_lo = 0, lt_hi = 0;
        if (MODE == 0) { lt_lo = 0; lt_hi = T / 64; }
        if (MODE == 1) { lt_lo = (tq0 - 128 < 0 ? 0 : tq0 - 128) / 64; lt_hi = (tq0 + 192 > T ? T : tq0 + 192) / 64; }
        const int ntiles = 4 + (lt_hi - lt_lo), npairs = (ntiles + 1) >> 1;
        bf16x8 qr[4];
        {
            float x[4][8];
#pragma unroll
            for (int d0 = 0; d0 < 4; ++d0) { const u32x4 wq = *(const u32x4*)(U + (size_t)qrow * NIN + qcol + d0 * 16 + hi * 8);
                x[d0][0] = lo16(wq.x); x[d0][1] = hi16(wq.x); x[d0][2] = lo16(wq.y); x[d0][3] = hi16(wq.y); x[d0][4] = lo16(wq.z); x[d0][5] = hi16(wq.z); x[d0][6] = lo16(wq.w); x[d0][7] = hi16(wq.w); }
            if (!winm) { float ss = 0.f;
#pragma unroll
                for (int d0 = 0; d0 < 4; ++d0)
#pragma unroll
                    for (int j = 0; j < 8; ++j) ss += x[d0][j] * x[d0][j];
                ss += shfl_xor_l(ss, 32, lane);
                const float rstd = 1.0f / sqrtf(ss * (1.0f / 64.0f) + EPS);
#pragma unroll
                for (int d0 = 0; d0 < 4; ++d0) { const f32x4 ga = *(const f32x4*)(P.q_gain + l * 64 + d0 * 16 + hi * 8), gb = *(const f32x4*)(P.q_gain + l * 64 + d0 * 16 + hi * 8 + 4);
                    x[d0][0] *= rstd * ga.x; x[d0][1] *= rstd * ga.y; x[d0][2] *= rstd * ga.z; x[d0][3] *= rstd * ga.w; x[d0][4] *= rstd * gb.x; x[d0][5] *= rstd * gb.y; x[d0][6] *= rstd * gb.z; x[d0][7] *= rstd * gb.w; } }
            if (latq) { const float* rc = (const float*)(P.ws + WS_ROPE); const float* rs = rc + 1024;
#pragma unroll
                for (int a = 0; a < 2; ++a) { const int pos = a ? (tq & 63) : (tq >> 6);
                    const f32x4 c0 = *(const f32x4*)(rc + pos * 16 + hi * 8), c1 = *(const f32x4*)(rc + pos * 16 + hi * 8 + 4), s0 = *(const f32x4*)(rs + pos * 16 + hi * 8), s1 = *(const f32x4*)(rs + pos * 16 + hi * 8 + 4);
                    const float cs[8] = {c0.x, c0.y, c0.z, c0.w, c1.x, c1.y, c1.z, c1.w}, sn[8] = {s0.x, s0.y, s0.z, s0.w, s1.x, s1.y, s1.z, s1.w};
#pragma unroll
                    for (int j = 0; j < 8; ++j) { const float x1 = x[2 * a][j], x2 = x[2 * a + 1][j]; x[2 * a][j] = x1 * cs[j] - x2 * sn[j]; x[2 * a + 1][j] = x2 * cs[j] + x1 * sn[j]; } } }
#pragma unroll
            for (int d0 = 0; d0 < 4; ++d0) { u32x4 wq; wq.x = cvtpk(x[d0][0] * QSCALE, x[d0][1] * QSCALE); wq.y = cvtpk(x[d0][2] * QSCALE, x[d0][3] * QSCALE); wq.z = cvtpk(x[d0][4] * QSCALE, x[d0][5] * QSCALE); wq.w = cvtpk(x[d0][6] * QSCALE, x[d0][7] * QSCALE);
                qr[d0] = __builtin_bit_cast(bf16x8, wq); }
        }
        f32x16 o0, o1, negm;
#pragma unroll
        for (int r = 0; r < 16; ++r) { o0[r] = 0.f; o1[r] = 0.f; negm[r] = 0.f; }
        float mhat = 0.f, lsum = 0.f;
#define AT_KROW(ti) ((ti) < 4 ? RL + b * TC + (ti) * 64 : b * T + (lt_lo + (ti) - 4) * 64)
        u32x4 ka, va, kb2, vb2;
#define AT_LOADPAIR(pp) do { const int na_ = 2 * (pp), nb_ = (2 * (pp) + 1 < ntiles) ? 2 * (pp) + 1 : na_; \
            const int r0_ = AT_KROW(na_) + (tid >> 3), r1_ = AT_KROW(nb_) + (tid >> 3); const int co_ = (tid & 7) * 8; \
            ka = *(const u32x4*)(U + (size_t)r0_ * NIN + kcol + co_); va = *(const u32x4*)(U + (size_t)r0_ * NIN + vcol + co_); \
            kb2 = *(const u32x4*)(U + (size_t)r1_ * NIN + kcol + co_); vb2 = *(const u32x4*)(U + (size_t)r1_ * NIN + vcol + co_); } while (0)
#define AT_WRITEPAIR(off) do { *(LAS u32x4*)(Lb + (off) + st_off) = ka; *(LAS u32x4*)(Lb + (off) + AT_TILEB + st_off) = kb2; \
            *(LAS u32x4*)(Lb + (off) + 2 * AT_TILEB + sv_off) = va; *(LAS u32x4*)(Lb + (off) + 2 * AT_TILEB + AT_VTILEB + sv_off) = vb2; } while (0)
#define AT_MASK(ti, P0, P1) do { if (MODE == 1) { if ((ti) >= ntiles) { _Pragma("unroll") for (int r = 0; r < 16; ++r) { P0[r] = -INFINITY; P1[r] = -INFINITY; } } \
            else if ((ti) >= 4) { const int kb0_ = (lt_lo + (ti) - 4) * 64, qlo_ = tq0 + 32 * (F.wave & 1); \
                if (kb0_ + 63 - qlo_ > 128 || qlo_ + 31 - kb0_ > 128) { const int kp0_ = kb0_ + 4 * hi - tq; \
                    _Pragma("unroll") for (int r = 0; r < 16; ++r) { const int dl_ = kp0_ + (r & 3) + 8 * (r >> 2); \
                        if (dl_ > 128 || dl_ < -128) P0[r] = -INFINITY; if (dl_ + 32 > 128 || dl_ + 32 < -128) P1[r] = -INFINITY; } } } } } while (0)
#define AT_REF(first, P0, P1) do { if (!fixedref) { float mx_ = fmaxf(P0[0], P1[0]); \
            _Pragma("unroll") for (int r = 1; r < 16; ++r) mx_ = fmaxf(mx_, fmaxf(P0[r], P1[r])); \
            mx_ = fmaxf(mx_, shfl_xor_l(mx_, 32, lane)); \
            if ((first) || __any(mx_ > ATT_THR)) { const float dl_ = (first) ? mx_ : fmaxf(mx_, 0.f); mhat += dl_; \
                const float al_ = __builtin_amdgcn_exp2f(-dl_); lsum *= al_; \
                _Pragma("unroll") for (int r = 0; r < 16; ++r) { P0[r] -= dl_; P1[r] -= dl_; o0[r] *= al_; o1[r] *= al_; negm[r] = -mhat; } } } } while (0)
        AT_LOADPAIR(0); AT_WRITEPAIR(0);
        if (npairs > 1) { AT_LOADPAIR(1); AT_WRITEPAIR(AT_STAGEB); }
        if (npairs > 2) AT_LOADPAIR(2);
        __syncthreads();
        f32x16 pc0, pc1, pn0, pn1;
        at_qk1<FIXED>(Lb, kf_off, qr, negm, pc0, pc1);
        AT_REF(true, pc0, pc1);
#pragma unroll
        for (int r = 0; r < 16; ++r) { pn0[r] = 0.f; pn1[r] = 0.f; }
        int scur = 0, snxt = AT_STAGEB, swr = 2 * AT_STAGEB;
        for (int tp = 0; tp < npairs; ++tp) {
            if (tp + 2 < npairs) { AT_WRITEPAIR(swr); if (tp + 3 < npairs) AT_LOADPAIR(tp + 3); }
            lsum += at_slot<FIXED>(Lb + scur + 2 * AT_TILEB, Lb + scur + AT_TILEB, true, kf_off, vf_off, qr, negm, pc0, pc1, pn0, pn1, o0, o1);
            AT_MASK(2 * tp + 1, pn0, pn1);
            AT_REF(false, pn0, pn1);
            const bool more = tp + 1 < npairs;
            lsum += at_slot<FIXED>(Lb + scur + 2 * AT_TILEB + AT_VTILEB, Lb + snxt, more, kf_off, vf_off, qr, negm, pn0, pn1, pc0, pc1, o0, o1);
            if (more) { AT_MASK(2 * tp + 2, pc0, pc1); AT_REF(false, pc0, pc1); }
            __syncthreads();
            { const int t_ = scur; scur = snxt; snxt = swr; swr = t_; }
        }
#undef AT_KROW
#undef AT_LOADPAIR
#undef AT_WRITEPAIR
#undef AT_MASK
#undef AT_REF
        lsum += shfl_xor_l(lsum, 32, lane);
        if (winm) lsum += exp2f(P.sink[l * 8 + hq] * LOG2E - mhat);
        const float inv = 1.0f / lsum;
        bf16_t* op = (bf16_t*)(P.ws + WS_BR) + (size_t)qrow * NBR + (winm ? 1024 : 512) + hq * 64 + 4 * hi;
#pragma unroll
        for (int gq = 0; gq < 4; ++gq) {
            u32x2 w0, w1; w0.x = cvtpk(o0[4 * gq] * inv, o0[4 * gq + 1] * inv); w0.y = cvtpk(o0[4 * gq + 2] * inv, o0[4 * gq + 3] * inv);
            w1.x = cvtpk(o1[4 * gq] * inv, o1[4 * gq + 1] * inv); w1.y = cvtpk(o1[4 * gq + 2] * inv, o1[4 * gq + 3] * inv);
            *(u32x2*)(op + 8 * gq) = w0; *(u32x2*)(op + 32 + 8 * gq) = w1; }
    }
}

template <int MODE> __device__ __forceinline__ void ph_attn(const Frame& F, const Ptrs& P, int l) {
    if (MODE == 1 || MODE == 3) { ph_attn_impl<MODE, false>(F, P, l); return; }
    const int lane = fresh_lane();
    float mq = fabsf(P.q_gain[l * 64 + lane]), mk = fabsf(P.k_gain[l * 64 + lane]);
#pragma unroll
    for (int o = 1; o < 64; o <<= 1) { mq = fmaxf(mq, shfl_xor_l(mq, o, lane)); mk = fmaxf(mk, shfl_xor_l(mk, o, lane)); }
    const float sbound = 64.0f * QSCALE * 1.02f * mq * mk;
    if (__builtin_amdgcn_readfirstlane(sbound < 48.0f ? 1 : 0)) ph_attn_impl<MODE, true>(F, P, l); else ph_attn_impl<MODE, false>(F, P, l);
}

constexpr int DF_ROWB = 528;
template <int STAGE> __device__ __forceinline__ void ph_dft(const Frame& F, const Ptrs& P) {
    const int lane = fresh_lane(), tid = F.wave * 64 + lane, r32 = lane & 31, hi = lane >> 5, w = F.wave;
    bf16_t* U = (bf16_t*)(P.ws + WS_U); bf16_t* BR = (bf16_t*)(P.ws + WS_BR); const bf16_t* Wm = (const bf16_t*)(P.ws + WS_DFTM);
    LAS unsigned char* Xl = F.lds;
    const int xf_off = (8 * hi + ((lane & 15) >> 2)) * DF_ROWB + (32 * w + ((lane >> 4) & 1) * 16 + (lane & 3) * 4) * 2;
    constexpr int NMB = STAGE == 2 ? 4 : 2;
    const int seg = tid >> 2, part = tid & 3, pp = seg >> 6, jj = seg & 63;
    u32x4 pf[8];
    if (F.vcu < 1024) { const int u = F.vcu; const int chb = u & 1, sidx = (u >> 1) & 63, b = u >> 7;
        const int grow = STAGE == 2 ? b * T + 64 * jj + sidx : b * T + 64 * sidx + jj;
        const u32x4* src = (const u32x4*)(U + (size_t)grow * NIN + pp * 512 + chb * 256 + part * 64);
#pragma unroll
        for (int i = 0; i < 8; ++i) pf[i] = src[i]; }
    for (int u = F.vcu; u < 1024; u += F.G) {
        const int chb = u & 1, sidx = (u >> 1) & 63, b = u >> 7;
#pragma unroll
        for (int i = 0; i < 8; ++i) *(LAS u32x4*)(Xl + seg * DF_ROWB + part * 128 + i * 16) = pf[i];
        if (u + F.G < 1024) { const int un = u + F.G; const int chbn = un & 1, sn = (un >> 1) & 63, bn = un >> 7;
            const int grow = STAGE == 2 ? bn * T + 64 * jj + sn : bn * T + 64 * sn + jj;
            const u32x4* src = (const u32x4*)(U + (size_t)grow * NIN + pp * 512 + chbn * 256 + part * 64);
#pragma unroll
            for (int i = 0; i < 8; ++i) pf[i] = src[i]; }
        __syncthreads();
        f32x16 acc[NMB];
#pragma unroll
        for (int mb = 0; mb < NMB; ++mb)
#pragma unroll
            for (int r = 0; r < 16; ++r) acc[mb][r] = 0.f;
#pragma unroll
        for (int ks = 0; ks < 8; ++ks) {
            const v4i16_t lo4 = __builtin_amdgcn_ds_read_tr16_b64_v4i16((LAS v4i16_t*)(Xl + xf_off + (16 * ks) * DF_ROWB));
            const v4i16_t hi4 = __builtin_amdgcn_ds_read_tr16_b64_v4i16((LAS v4i16_t*)(Xl + xf_off + (16 * ks + 4) * DF_ROWB));
            const bf16x8 xf = (bf16x8){lo4[0], lo4[1], lo4[2], lo4[3], hi4[0], hi4[1], hi4[2], hi4[3]};
#pragma unroll
            for (int mb = 0; mb < NMB; ++mb) { const bf16x8 wf = *(const bf16x8*)(Wm + (mb * 32 + r32) * 128 + 16 * ks + 8 * hi);
                acc[mb] = __builtin_amdgcn_mfma_f32_32x32x16_bf16(xf, wf, acc[mb], 0, 0, 0); }
        }
        LAS unsigned char* ob = Xl + (32 * w + 4 * hi) * 2;
        if (STAGE == 2) {
#pragma unroll
            for (int mb = 0; mb < 2; ++mb) { const int k1 = mb * 32 + r32; const float rev = (float)((k1 * sidx) & 4095) * (1.0f / 4096.0f);
                const float ct = __builtin_amdgcn_cosf(rev), st = __builtin_amdgcn_sinf(rev);
#pragma unroll
                for (int gq = 0; gq < 4; ++gq) { u32x2 wr, wi; float yr[4], yi[4];
#pragma unroll
                    for (int i = 0; i < 4; ++i) { const float a = acc[mb][4 * gq + i], bq = acc[mb + 2][4 * gq + i]; yr[i] = a * ct + bq * st; yi[i] = bq * ct - a * st; }
                    wr.x = cvtpk(yr[0], yr[1]); wr.y = cvtpk(yr[2], yr[3]); wi.x = cvtpk(yi[0], yi[1]); wi.y = cvtpk(yi[2], yi[3]);
                    *(LAS u32x2*)(ob + k1 * DF_ROWB + 16 * gq) = wr; *(LAS u32x2*)(ob + (64 + k1) * DF_ROWB + 16 * gq) = wi; } }
        } else {
#pragma unroll
            for (int mb = 0; mb < 2; ++mb) { const int k2 = mb * 32 + r32;
#pragma unroll
                for (int gq = 0; gq < 4; ++gq) { u32x2 wr; wr.x = cvtpk(acc[mb][4 * gq] * 0.015625f, acc[mb][4 * gq + 1] * 0.015625f); wr.y = cvtpk(acc[mb][4 * gq + 2] * 0.015625f, acc[mb][4 * gq + 3] * 0.015625f);
                    *(LAS u32x2*)(ob + k2 * DF_ROWB + 16 * gq) = wr; } }
        }
        __syncthreads();
        if (STAGE == 2) {
            u32x4* dst = (u32x4*)(U + (size_t)(b * T + 64 * jj + sidx) * NIN + pp * 512 + chb * 256 + part * 64);
#pragma unroll
            for (int i = 0; i < 8; ++i) dst[i] = *(const LAS u32x4*)(Xl + seg * DF_ROWB + part * 128 + i * 16);
        } else { const int k2 = tid >> 3, part8 = tid & 7;
            u32x4* dst = (u32x4*)(BR + (size_t)(b * T + 64 * k2 + sidx) * NBR + chb * 256 + part8 * 32);
#pragma unroll
            for (int i = 0; i < 4; ++i) dst[i] = *(const LAS u32x4*)(Xl + k2 * DF_ROWB + part8 * 64 + i * 16); }
        __syncthreads();
    }
}

struct MegaArgs { Ptrs P; int ph_lo, ph_hi, li, pad; };
__global__ void __launch_bounds__(NWAVES * 64, 2) mega(MegaArgs args) {
    extern __shared__ __attribute__((aligned(16))) unsigned char lds_raw[];
    Frame F; F.lds = (LAS unsigned char*)lds_raw;
    F.wave = __builtin_amdgcn_readfirstlane(threadIdx.x >> 6);
    F.G = gridDim.x; { const int bx = blockIdx.x; F.vcu = (F.G % 8 == 0) ? (bx % 8) * (F.G / 8) + bx / 8 : bx; }
    for (int u = fresh_tid(); u < (LDS_BYTES - LDSCTL_OFF) / 4; u += NWAVES * 64) ((LAS unsigned*)(F.lds + LDSCTL_OFF))[u] = 0u;
    __syncthreads();
    volatile LAS unsigned* MISC = (volatile LAS unsigned*)(F.lds + MISC_OFF);
    const Ptrs& P = args.P;
    XcdBarrier bar = xcd_barrier_post((unsigned*)(P.ws + WS_CTL) + CW_BAR + args.li * XCD_BAR_WORDS, MISC + 8, F.wave);
    const int lo = args.ph_lo, hi = args.ph_hi;
    unsigned char* ws = P.ws;
    bf16_t* H = (bf16_t*)(ws + WS_H); bf16_t* U = (bf16_t*)(ws + WS_U); bf16_t* BR = (bf16_t*)(ws + WS_BR);
    bf16_t* MG = (bf16_t*)(ws + WS_MG); bf16_t* HID = (bf16_t*)(ws + WS_HID); bf16_t* MO = (bf16_t*)(ws + WS_MO);
    const bf16_t* Bt_in = (const bf16_t*)(ws + WS_WB + WB_IN); const bf16_t* Bt_gate = (const bf16_t*)(ws + WS_WB + WB_GATE); const bf16_t* Bt_br = (const bf16_t*)(ws + WS_WB + WB_BR);
    const bf16_t* Bt_out = (const bf16_t*)(ws + WS_WB + WB_OUT); const bf16_t* Bt_13 = (const bf16_t*)(ws + WS_WB + WB_13); const bf16_t* Bt_2 = (const bf16_t*)(ws + WS_WB + WB_2);
#define IN(g) (lo <= (g) && (g) < hi)
#define SEAM(g) do { if ((g) + 1 < hi) xcd_barrier(bar); } while (0)
    for (int l = 0; l < 2; ++l) {
        const int pb = l * NPH; const int M = l == 0 ? R : RL;
        if (IN(pb + 0)) { if (l == 0) ph_tables_mod(F, P); ph_weights(F, P, l); SEAM(pb + 0); }
        if (IN(pb + 1)) { ph_quant(F, P, l); if (l == 0) ph_norm<0>(F, P, l, R); else ph_norm<1>(F, P, l, R); SEAM(pb + 1); }
        if (IN(pb + 2)) {
            pg8::StaticOrder S; S.init(R, NIN, F.G, (int)blockIdx.x, H, D / 2, Bt_in, D / 2);
            pg8::EpiV8I8<FStore8> E{FStore8{U, NIN}, (const float*)(ws + WS_SA), (const unsigned*)(ws + WS_CTL) + CW_CMAX + 32768 * l};
            pg8::gemm_phase<pg8::EpiV8I8<FStore8>, pg8::StaticOrder, true, true>(F.lds, F.wave, D / 2, D / 2, D / 2, S, E);
            SEAM(pb + 2);
        }
        if (IN(pb + 3)) { ph_kprep(F, P, l); ph_pool(F, P, M); SEAM(pb + 3); }
        if (IN(pb + 4)) {
            ph_dft<2>(F, P); ph_attn<1>(F, P, l);
            if (l == 0) { ph_attn<2>(F, P, l); ph_attn<3>(F, P, l); ph_fourier_ref(F, P, TC, 0); }
            xcd_barrier(bar);
            ph_dft<3>(F, P); ph_attn<0>(F, P, l);
            SEAM(pb + 4);
        }
        if (IN(pb + 5)) {
            pg8::StaticOrder S; S.init(M, 4096, F.G, (int)blockIdx.x, H, D / 2, Bt_gate, D / 2);
            pg8::EpiV8I8<FGateU8> E{FGateU8{(unsigned char*)(ws + WS_GT), P.b_gate + (size_t)l * 4096}, (const float*)(ws + WS_SA), (const unsigned*)(ws + WS_CTL) + CW_CMAX + 32768 * l + 3072};
            pg8::gemm_phase<pg8::EpiV8I8<FGateU8>, pg8::StaticOrder, true, true>(F.lds, F.wave, D / 2, D / 2, D / 2, S, E);
            SEAM(pb + 5);
        }
        if (IN(pb + 6)) {
            pg8::StaticOrder S; S.init(M, D, F.G, (int)blockIdx.x, BR, NBR, Bt_br, NBR);
            pg8::EpiMergeS E{(const unsigned char*)(ws + WS_GT), MG};
            pg8::gemm_phase(F.lds, F.wave, NBR, NBR, NBR, S, E);
            xcd_barrier(bar);
        }
        if (IN(pb + 10)) {
            pg8::StaticOrder S; S.init(M, D, F.G, (int)blockIdx.x, MG, D, Bt_out, D);
            pg8::EpiV4<FOut> E{FOut{P, l}};
            pg8::gemm_phase(F.lds, F.wave, D, D, D, S, E);
            SEAM(pb + 10);
        }
        if (IN(pb + 11)) { ph_norm<2>(F, P, l, M); xcd_barrier(bar); }
        if (IN(pb + 13) || IN(pb + 14)) {
            LAS int* ptab = (LAS int*)(F.lds + LDSCTL_OFF);
            if (fresh_tid() == 0) { const unsigned* cnt = (const unsigned*)(ws + WS_CTL) + CW_CNT + 1024 * l; int off = 0;
                for (int e = 0; e < 16; ++e) { const int c = (int)cnt[64 * e]; ptab[e] = off; ptab[17 + e] = c; off += (c + 255) >> 8; } ptab[16] = off; }
            __syncthreads();
            if (IN(pb + 13)) {
                pg8::MoeOrder<true> S; S.nN = 4; S.G = F.G; S.c = F.vcu; S.A = (const char*)H; S.Bt = (const char*)Bt_13; S.astep = 0; S.bstep = (size_t)256 * D; S.bexp = (size_t)1024 * 1024; S.tab = (const int*)ptab; S.tokl = (const int*)(ws + WS_TOKL);
                pg8::EpiDualI8<FMoe1> E{FMoe1{HID}, (const float*)(ws + WS_SA), (const unsigned*)(ws + WS_CTL) + CW_CMAX + 32768 * l + 8192, (const int*)(ws + WS_TOKL)};
                pg8::gemm_phase<pg8::EpiDualI8<FMoe1>, pg8::MoeOrder<true>, true, true>(F.lds, F.wave, D / 2, D / 2, D / 2, S, E);
                SEAM(pb + 13);
            }
            if (IN(pb + 14)) {
                pg8::MoeOrder<false> S; S.nN = 4; S.G = F.G; S.c = F.vcu; S.A = (const char*)HID; S.Bt = (const char*)Bt_2; S.astep = (size_t)256 * FF * 2; S.bstep = (size_t)256 * FF * 2; S.bexp = (size_t)1024 * 512 * 2; S.tab = (const int*)ptab; S.tokl = nullptr;
                pg8::EpiV8<FMoe2> E{FMoe2{MO, (const int*)(ws + WS_TOKL), (const float*)(ws + WS_WL)}};
                pg8::gemm_phase(F.lds, F.wave, FF, FF, FF, S, E);
                SEAM(pb + 14);
            }
        }
    }
    if (IN(PH_FINAL)) ph_final(F, P);
#undef IN
#undef SEAM
}

extern "C" void kernel_launch(void* const* d_in, const int* in_sizes, int n_in, void* d_out, int out_size, void* d_ws, size_t ws_size, hipStream_t stream) {
    if (n_in != 24 || ws_size < WS_END || out_size != RL * D) { fprintf(stderr, "kernel_launch: unexpected sizes n_in %d ws %zu out %d\n", n_in, ws_size, out_size); return; }
    static int grid = 0;
    if (grid == 0) {
        int dev = 0, cus = 0;
        if (hipGetDevice(&dev) != hipSuccess || hipDeviceGetAttribute(&cus, hipDeviceAttributeMultiprocessorCount, dev) != hipSuccess) { grid = -1; return; }
        if (hipFuncSetAttribute((const void*)mega, hipFuncAttributeMaxDynamicSharedMemorySize, LDS_BYTES) != hipSuccess) { fprintf(stderr, "kernel_launch: hipFuncSetAttribute failed\n"); grid = -1; return; }
        int per_cu = 0;
        if (hipOccupancyMaxActiveBlocksPerMultiprocessor(&per_cu, (const void*)mega, NWAVES * 64, LDS_BYTES) != hipSuccess || per_cu < 1) fprintf(stderr, "kernel_launch: occupancy query says %d\n", per_cu);
        (void)hipGetLastError();
        grid = cus;
    }
    if (grid < 0) return;
    MegaArgs a{};
    const float** pp = (const float**)&a.P;
    for (int i = 0; i < 24; ++i) pp[i] = (const float*)d_in[i];
    a.P.out = (float*)d_out; a.P.ws = (unsigned char*)d_ws;
    (void)hipMemsetAsync((unsigned char*)d_ws + WS_CTL, 0, 512 * 1024, stream);
    a.ph_lo = 0; a.ph_hi = PH_FINAL + 1; a.li = 0;
    hipLaunchKernelGGL(mega, dim3(grid), dim3(NWAVES * 64), LDS_BYTES, stream, a);
}
```

```cpp
#include <hip/hip_runtime.h>
#include <cstdio>
#include <cstdint>

typedef unsigned short bf16_t;
typedef short bf16x8 __attribute__((ext_vector_type(8)));
typedef float f32x4 __attribute__((ext_vector_type(4)));
typedef unsigned u32x4 __attribute__((ext_vector_type(4)));
typedef unsigned u32x2 __attribute__((ext_vector_type(2)));
typedef int i32x4 __attribute__((ext_vector_type(4)));

constexpr int D = 1024, NB = 8, T = 4096, TC = 256;
constexpr int RL = NB * T, RC = NB * TC, R = RL + RC;
constexpr int NIN = 3072;
constexpr int C_ZR = 0, C_ZI = 512, C_P = 1024, C_QB = 1536, C_KB = 2048, C_VB = 2176, C_QW = 2304, C_KW = 2816, C_VW = 2944;
constexpr int NBR = 2048;
constexpr int NE = 16, FF = 512;
constexpr int MAXROWS = 73728;
constexpr float EPS = 1e-6f;
constexpr float QSCALE = 0.125f * 1.4426950408889634f;
constexpr float LOG2E = 1.4426950408889634f;

constexpr size_t MiB = 1u << 20;
constexpr size_t WS_CTL = 0;
constexpr size_t WS_MOD = 1 * MiB;
constexpr size_t WS_ROPE = 1 * MiB + 512 * 1024;
constexpr size_t WS_COS = WS_ROPE + 16 * 1024;
constexpr size_t WS_DFTM = WS_ROPE + 64 * 1024;
constexpr size_t WS_TOKL = 2 * MiB;
constexpr size_t WS_WL = 4 * MiB + 512 * 1024;
constexpr size_t WS_XC = 9 * MiB;
constexpr size_t WS_WB = 17 * MiB;
constexpr size_t WB_IN = 0, WB_GATE = 6 * MiB, WB_BR = 14 * MiB, WB_OUT = 18 * MiB, WB_13 = 20 * MiB, WB_2 = 52 * MiB;
constexpr size_t WS_H = 85 * MiB;
constexpr size_t WS_SA = WS_H + 34 * MiB;
constexpr size_t WS_X1B = WS_H + 35 * MiB;
constexpr size_t WS_ARENA = 153 * MiB;
constexpr size_t WS_U = WS_ARENA;
constexpr size_t WS_BR = WS_ARENA + 204 * MiB;
constexpr size_t WS_GT = WS_ARENA;
constexpr size_t WS_MG = WS_ARENA + 136 * MiB;
constexpr size_t WS_HID = WS_ARENA + 144 * MiB;
constexpr size_t WS_MO = WS_ARENA + 216 * MiB;
constexpr size_t WS_FTMP = WS_ARENA + 352 * MiB;
constexpr size_t WS_END = 512 * MiB;
static_assert(WS_BR + (size_t)R * NBR * 2 <= WS_END && WS_MO + (size_t)2 * R * D * 2 <= WS_END && WS_MG + (size_t)R * D * 2 <= WS_BR, "ws map");
constexpr int CW_CMAX = 32768;
constexpr int CW_RDY = 20480;
constexpr int CW_QK = 28672;
constexpr int CW_MRDY = 98304;
constexpr int CW_CNT = 8192;

__device__ __forceinline__ float bf2f(bf16_t b) { return __uint_as_float(((unsigned)b) << 16); }
__device__ __forceinline__ unsigned f2bf(float f) { unsigned u = __float_as_uint(f); return (u + 0x7fffu + ((u >> 16) & 1u)) >> 16; }
__device__ __forceinline__ unsigned pk2(float lo, float hi) { return f2bf(lo) | (f2bf(hi) << 16); }
typedef __bf16 bf16x2_t __attribute__((ext_vector_type(2)));
typedef float f32x2_t __attribute__((ext_vector_type(2)));
__device__ __forceinline__ unsigned cvtpk(float lo, float hi) { f32x2_t v = {lo, hi}; bf16x2_t b = __builtin_convertvector(v, bf16x2_t); return __builtin_bit_cast(unsigned, b); }
__device__ __forceinline__ float lo16(unsigned w) { return __uint_as_float(w << 16); }
__device__ __forceinline__ float hi16(unsigned w) { return __uint_as_float(w & 0xffff0000u); }
__device__ __forceinline__ float shfl_xor_l(float v, int o, int lane) { return __int_as_float(__builtin_amdgcn_ds_bpermute((lane ^ o) << 2, __float_as_int(v))); }
__device__ __forceinline__ float wave_sum_l(float v, int lane) {
#pragma unroll
    for (int o = 1; o < 64; o <<= 1) v += shfl_xor_l(v, o, lane);
    return v;
}
__device__ __forceinline__ int row_bb(int r) { return r < RL ? (r >> 12) : 8; }

struct Ptrs {
    const float *x, *c, *ctx, *c_ctx, *w_ada, *b_ada, *norm1, *norm2, *w_in, *q_gain, *k_gain, *sink, *pool_w, *pool_scale,
        *w_branch, *w_gate, *b_gate, *w_out, *router_w, *router_bias, *w1, *w3, *w2, *norm_f;
    float* out; unsigned char* ws;
};
__device__ __forceinline__ const float* xin_row(const Ptrs& P, int r) { return r < RL ? P.x + (size_t)r * D : P.ctx + (size_t)(r - RL) * D; }
__device__ __forceinline__ bf16_t* x1b_row(const Ptrs& P, int r) {
    return r < 16384 ? (bf16_t*)((unsigned char*)P.out + 96 * MiB) + (size_t)r * D : (r < RL ? (bf16_t*)(P.ws + WS_X1B) + (size_t)(r - 16384) * D : (bf16_t*)(P.ws + WS_XC) + (size_t)(r - RL) * D); }
__device__ __forceinline__ f32x4 ld4b(const bf16_t* p) { const u32x2 w = *(const u32x2*)p; return (f32x4){lo16(w.x), hi16(w.x), lo16(w.y), hi16(w.y)}; }
__device__ __forceinline__ void st4b(bf16_t* p, f32x4 v) { u32x2 w; w.x = cvtpk(v.x, v.y); w.y = cvtpk(v.z, v.w); *(u32x2*)p = w; }
__device__ __forceinline__ const float* mod_vec(const Ptrs& P, int l, int bb, int which) { return (const float*)(P.ws + WS_MOD) + ((size_t)(l * 9 + bb) * 6 + which) * D; }

#define LAS __attribute__((address_space(3)))
#define GAS __attribute__((address_space(1)))
#define LDS_WAIT() asm volatile("s_waitcnt lgkmcnt(0)" ::: "memory")
__device__ __forceinline__ int fresh_lane() { int l; asm volatile("v_mbcnt_lo_u32_b32 %0, -1, 0\n\tv_mbcnt_hi_u32_b32 %0, -1, %0" : "=v"(l)); return l; }
constexpr int NWAVES = 8;
constexpr int RING_BYTES = 131072, LDSCTL_OFF = RING_BYTES, MISC_OFF = LDSCTL_OFF + 320, LDS_BYTES = 147456;
constexpr int CW_BAR = 16384;
constexpr int NPH = 15, PH_FINAL = 2 * NPH;

#define XB_TMO      128
#define XB_XCNT(j)  (256  + 64 * (j))
#define XB_XSUB(j)  (1280 + 64 * (j))
#define XB_XGEN(j)  (2304 + 64 * (j))
#define XB_TOP      3328
#define XB_TOPGEN   3392
#define XCD_BAR_WORDS 3456
#define XB_SPIN_CAP (1u << 21)
__device__ __forceinline__ unsigned xb_ld(unsigned* p)              { return __hip_atomic_load(p, __ATOMIC_RELAXED, __HIP_MEMORY_SCOPE_AGENT); }
__device__ __forceinline__ unsigned xb_add(unsigned* p, unsigned v) { return __hip_atomic_fetch_add(p, v, __ATOMIC_RELAXED, __HIP_MEMORY_SCOPE_AGENT); }
__device__ __forceinline__ unsigned xb_xcc_id() { return (unsigned)__builtin_amdgcn_s_getreg((3 << 11) | 20) & 0xFu; }
#define XB_SPIN(cond, bar) do { unsigned _sp = 0; while (cond) { __builtin_amdgcn_s_sleep(1); \
    if ((++_sp & 255u) == 0u) { if (xb_ld(&(bar)[XB_TMO])) break; if (_sp > XB_SPIN_CAP) { atomicAdd(&(bar)[XB_TMO], 1u); break; } } } } while (0)
struct XcdBarrier { unsigned* bar; unsigned x; volatile LAS unsigned* st; int wave; };
__device__ __forceinline__ XcdBarrier xcd_barrier_post(unsigned* bar, volatile LAS unsigned* st, int wave) {
    XcdBarrier b; b.bar = bar; b.x = xb_xcc_id(); b.st = st; b.wave = wave;
    if (wave == 0 && fresh_lane() == 0) (void)xb_add(&bar[XB_XCNT(b.x)], 1u);
    return b;
}
__device__ __forceinline__ void xcd_barrier_complete(unsigned* bar, unsigned x, unsigned& nloc, unsigned& nx) {
    const unsigned G = gridDim.x * gridDim.y * gridDim.z;
    unsigned sum, cnt, mine, sp = 0u;
    for (;;) {
        sum = 0u; cnt = 0u; mine = 0u;
#pragma unroll
        for (unsigned j = 0; j < 16; ++j) { const unsigned c = xb_ld(&bar[XB_XCNT(j)]); sum += c; cnt += (c > 0u) ? 1u : 0u; mine = (j == x) ? c : mine; }
        if (sum == G) break;
        __builtin_amdgcn_s_sleep(1);
        if ((++sp & 255u) == 0u) { if (xb_ld(&bar[XB_TMO])) break; if (sp > XB_SPIN_CAP) { atomicAdd(&bar[XB_TMO], 1u); break; } }
    }
    nloc = mine > 0u ? mine : 1u; nx = cnt > 0u ? cnt : 1u;
}
__device__ __forceinline__ void xcd_barrier(const XcdBarrier& b) {
    asm volatile("s_waitcnt vmcnt(0)" ::: "memory");
    __syncthreads();
    if (b.wave == 0 && fresh_lane() == 0) {
        unsigned* bar = b.bar;
        __builtin_amdgcn_s_waitcnt(0);
        unsigned nloc = b.st[0], nx = b.st[1];
        if (nloc == 0u) { xcd_barrier_complete(bar, b.x, nloc, nx); b.st[0] = nloc; b.st[1] = nx; }
        const unsigned old = xb_add(&bar[XB_XSUB(b.x)], 1u);
        const unsigned gen = old / nloc;
        if (old + 1u == (gen + 1u) * nloc) {
            __builtin_amdgcn_fence(__ATOMIC_RELEASE, "agent");
            asm volatile("s_waitcnt vmcnt(0)" ::: "memory");
            const unsigned og = xb_add(&bar[XB_TOP], 1u);
            const unsigned tg = og / nx;
            if (og + 1u == (tg + 1u) * nx) xb_add(&bar[XB_TOPGEN], 1u);
            else XB_SPIN(xb_ld(&bar[XB_TOPGEN]) == tg, bar);
            __builtin_amdgcn_fence(__ATOMIC_ACQUIRE, "agent");
            xb_add(&bar[XB_XGEN(b.x)], 1u);
            asm volatile("s_waitcnt vmcnt(0)" ::: "memory");
        } else {
            XB_SPIN(xb_ld(&bar[XB_XGEN(b.x)]) == gen, bar);
            __builtin_amdgcn_fence(__ATOMIC_ACQUIRE, "agent");
            asm volatile("s_waitcnt vmcnt(0)" ::: "memory");
        }
    }
    __syncthreads();
}

namespace pg8 {
constexpr int BM = 256, BK = 64, HALF = 128, HTB = HALF * BK * 2, STAGE_BYTES = 8 * HTB, NXCD = 8, WGM = 4;
__host__ __device__ __forceinline__ int lds_byte(int r, int c) { const int st = (r >> 4) * 2 + (c >> 5), rr = r & 15, cc = c & 31, ob = rr * 64 + cc * 2; return st * 1024 + (ob ^ (((ob >> 9) & 1) << 5)); }
__host__ __device__ __forceinline__ void stage_rc(int b, int& Rr, int& C) { const int st = b / 1024, sb = b % 1024, swz = sb ^ (((sb >> 9) & 1) << 5); Rr = (st >> 1) * 16 + swz / 64; C = (st & 1) * 32 + (swz % 64) / 2; }
__host__ __device__ __forceinline__ int perm32(int rho) { const int n = rho >> 4, i = rho & 15; return 8 * (i >> 2) + 4 * n + (i & 3); }
struct Unit { int pm, pn; const char* a; const char* b; int e, p0, ce; };

struct StaticOrder {
    static constexpr bool GATHER = false;
    int nM, nN, nwg, G, c; const char* A; const char* Bt; size_t astep, bstep;
    __device__ void init(int M, int N, int G_, int c_, const bf16_t* A_, int lda, const bf16_t* Bt_, int ldb) { nM = M / BM; nN = N / BM; nwg = nM * nN; G = G_; c = c_; A = (const char*)A_; Bt = (const char*)Bt_; astep = (size_t)BM * lda * 2; bstep = (size_t)BM * ldb * 2; }
    __device__ bool next(int i, Unit& u) const {
        const long L = (long)i * G + c; if (L >= nwg) return false;
        int wgid = (int)L; { const int q = nwg / NXCD, r = nwg % NXCD, xcd = wgid % NXCD, off = wgid / NXCD; wgid = (xcd < r ? xcd * (q + 1) : r * (q + 1) + (xcd - r) * q) + off; }
        const int nig = WGM * nN, gid = wgid / nig, fm = gid * WGM, gsz = (nM - fm) < WGM ? (nM - fm) : WGM;
        u.pm = fm + ((wgid % nig) % gsz); u.pn = (wgid % nig) / gsz; u.a = A + (size_t)u.pm * astep; u.b = Bt + (size_t)u.pn * bstep; u.e = 0; u.p0 = 0; u.ce = 0; return true;
    }
    __device__ __forceinline__ void a_ready(const Unit&) const {}
    __device__ __forceinline__ void done(const Unit&) const {}
};
template <bool GATHER_> struct MoeOrder {
    static constexpr bool GATHER = GATHER_;
    int nN, G, c; const char* A; const char* Bt; size_t astep, bstep, bexp; const int* tab; const int* tokl;
    int hand, rev; unsigned* ready;
    __device__ bool next(int i, Unit& u) const {
        const int L = i * G + (rev ? G - 1 - c : c); const int total = __builtin_amdgcn_readfirstlane(tab[16]) * nN; if (L >= total) return false;
        u.pm = L / nN; u.pn = L % nN; int e = 0;
#pragma unroll
        for (int q = 1; q < 16; ++q) e += (u.pm >= tab[q]) ? 1 : 0;
        e = __builtin_amdgcn_readfirstlane(e);
        u.e = e; u.p0 = __builtin_amdgcn_readfirstlane((u.pm - tab[e]) * BM); u.ce = __builtin_amdgcn_readfirstlane(tab[17 + e]);
        u.a = GATHER_ ? A : A + (size_t)u.pm * astep; u.b = Bt + (size_t)e * bexp + (size_t)u.pn * bstep; return true;
    }
    __device__ __forceinline__ void a_ready(const Unit& u) const {
        if (hand != 2) return;
        if (__builtin_amdgcn_readfirstlane(threadIdx.x >> 6) == 0) {
            unsigned spins = 0;
            while ((unsigned)__builtin_amdgcn_readfirstlane(__hip_atomic_load(ready + 16 * u.pm, __ATOMIC_RELAXED, __HIP_MEMORY_SCOPE_AGENT)) < 32u) { __builtin_amdgcn_s_sleep(2); if (++spins > (1u << 22)) break; }
            __builtin_amdgcn_fence(__ATOMIC_ACQUIRE, "agent");
            asm volatile("s_waitcnt vmcnt(0)" ::: "memory");
        }
        asm volatile("" ::: "memory"); __builtin_amdgcn_s_barrier(); asm volatile("" ::: "memory");
    }
    __device__ __forceinline__ void done(const Unit& u) const {
        if (hand != 1) return;
        asm volatile("s_waitcnt vmcnt(0)" ::: "memory");
        if (fresh_lane() == 0) __hip_atomic_fetch_add(ready + 16 * u.pm, 1u, __ATOMIC_RELAXED, __HIP_MEMORY_SCOPE_AGENT);
    }
    __device__ __forceinline__ void aoffs(const Unit& u, int wid, int lda, unsigned (&off)[2][2]) const {
        const int tid = wid * 64 + fresh_lane();
#pragma unroll
        for (int i = 0; i < 2; ++i) { int Rr, C; stage_rc(tid * 16 + i * 8192, Rr, C);
#pragma unroll
            for (int h = 0; h < 2; ++h) { const int pos = u.p0 + h * HALF + Rr; const int tok = pos < u.ce ? (tokl[(size_t)u.e * R + pos] >> 1) : 0; off[h][i] = (unsigned)(tok * lda + C) * 2u; } }
    }
};

struct PanelOrder {
    static constexpr bool GATHER = false;
    int c, G, npx, consumer, chain; const char* A; const char* Bt; size_t astep, bstep; unsigned* ready;
    __device__ bool next(int i, Unit& u) const {
        if (G == 256) { const int xcd = c & 7, r = c >> 3, ne = 4 * npx, heavy = ne - 64; int e;
            if (!consumer) { e = 32 * i + r; if (e >= ne) return false; }
            else if (r >= heavy) { e = i * (32 - heavy) + (r - heavy); if (e >= 64) return false; }
            else { if (i != 0) return false; e = 64 + r; }
            u.pm = npx * xcd + (e >> 2); u.pn = e & 3; }
        else { const int L = i * G + c; if (L >= 32 * npx) return false; u.pm = L >> 2; u.pn = L & 3; }
        u.a = A + (size_t)u.pm * astep; u.b = Bt + (size_t)u.pn * bstep; u.e = 0; u.p0 = 0; u.ce = 0; return true;
    }
    __device__ __forceinline__ void a_ready(const Unit& u) const {
        if (!consumer || !chain) return;
        if (__builtin_amdgcn_readfirstlane(threadIdx.x >> 6) == 0) {
            unsigned spins = 0;
            while ((unsigned)__builtin_amdgcn_readfirstlane(__hip_atomic_load(ready + 16 * u.pm, __ATOMIC_RELAXED, __HIP_MEMORY_SCOPE_AGENT)) < 32u) { __builtin_amdgcn_s_sleep(2); if (++spins > (1u << 22)) break; }
            __builtin_amdgcn_fence(__ATOMIC_ACQUIRE, "agent");
            asm volatile("s_waitcnt vmcnt(0)" ::: "memory");
        }
        asm volatile("" ::: "memory"); __builtin_amdgcn_s_barrier(); asm volatile("" ::: "memory");
    }
    __device__ __forceinline__ void done(const Unit& u) const {
        if (consumer || !chain) return;
        asm volatile("s_waitcnt vmcnt(0)" ::: "memory");
        if (fresh_lane() == 0) __hip_atomic_fetch_add(ready + 16 * u.pm, 1u, __ATOMIC_RELAXED, __HIP_MEMORY_SCOPE_AGENT);
    }
};
template <class Epi, class Sched, bool ALIGN_EPI = true, bool I8 = false>
__device__ __forceinline__ void gemm_phase(LAS unsigned char* lds, const int wid, const int lda, const int ldb, const int K, const Sched& S, const Epi& E) {
    const int lane = fresh_lane(), tid = wid * 64 + lane, wr = wid >> 2, wc = wid & 3, fr = lane & 15, fq = lane >> 4;
    const int nt = K / BK;
    unsigned voffA[2], voffB[2];
#pragma unroll
    for (int i = 0; i < 2; ++i) { int Rr, C; stage_rc(tid * 16 + i * 8192, Rr, C); const int Rb = Epi::PERM ? ((Rr & ~31) + perm32(Rr & 31)) : Rr;
        voffA[i] = (unsigned)(Rr * lda + C) * 2u; voffB[i] = (unsigned)(Rb * ldb + C) * 2u; }
    const size_t kstep = (size_t)(BK * 2);
    const size_t hstepA = Sched::GATHER ? 0 : (size_t)HALF * lda * 2, hstepB = (size_t)HALF * ldb * 2;
    const unsigned ldsw = (unsigned)wid * 1024u;
    const int aoff = lds_byte(wr * 64 + fr, fq * 8), boff = lds_byte(wc * 32 + fr, fq * 8);
#define PG8_SA(b, h) (((b) * 2 + (h)) * HTB)
#define PG8_SB(b, h) ((4 + (b) * 2 + (h)) * HTB)
#define PG8_STAGE(bufoff, gbase, voff) do { _Pragma("unroll") for (int _i = 0; _i < 2; ++_i) \
        __builtin_amdgcn_global_load_lds((const unsigned*)((const char*)(gbase) + (voff)[_i]), (LAS unsigned*)(lds + (bufoff) + ldsw + _i * 8192), 16, 0, 0); } while (0)
#define PG8_STAGE_A(b, h, kp, OFFS) do { if constexpr (Sched::GATHER) { PG8_STAGE(PG8_SA(b, h), kp, OFFS[h]); } else { PG8_STAGE(PG8_SA(b, h), (kp) + (h) * hstepA, voffA); } } while (0)
#define PG8_LDA(dst, b, h) do { _Pragma("unroll") for (int m = 0; m < 4; ++m) _Pragma("unroll") for (int k = 0; k < 2; ++k) dst[m][k] = *(const LAS bf16x8*)(lds + PG8_SA(b, h) + aoff + m * 2048 + k * 1024); } while (0)
#define PG8_LDB(dst, b, h) do { _Pragma("unroll") for (int n = 0; n < 2; ++n) _Pragma("unroll") for (int k = 0; k < 2; ++k) dst[n][k] = *(const LAS bf16x8*)(lds + PG8_SB(b, h) + boff + n * 2048 + k * 1024); } while (0)
#define PG8_MMA(ai, bj, At, Bt) do { __builtin_amdgcn_s_setprio(1); _Pragma("unroll") for (int m = 0; m < 4; ++m) _Pragma("unroll") for (int n = 0; n < 2; ++n) _Pragma("unroll") for (int k = 0; k < 2; ++k) { \
        if constexpr (I8) acc[ai][bj][m][n] = __builtin_bit_cast(f32x4, __builtin_amdgcn_mfma_i32_16x16x64_i8(__builtin_bit_cast(i32x4, Bt[n][k]), __builtin_bit_cast(i32x4, At[m][k]), __builtin_bit_cast(i32x4, acc[ai][bj][m][n]), 0, 0, 0)); \
        else acc[ai][bj][m][n] = __builtin_amdgcn_mfma_f32_16x16x32_bf16(Bt[n][k], At[m][k], acc[ai][bj][m][n], 0, 0, 0); } __builtin_amdgcn_s_setprio(0); } while (0)
#define PG8_WAIT_V(n) asm volatile("s_waitcnt vmcnt(" #n ")" ::: "memory")
#define PG8_WAIT_L(n) asm volatile("s_waitcnt lgkmcnt(" #n ")" ::: "memory")
#define PG8_BAR __builtin_amdgcn_s_barrier()
#define PG8_SCHED __builtin_amdgcn_sched_barrier(0)
    Unit cur, nxt; int ui = 0;
    if (!S.next(0, cur)) return;
    f32x4 acc[2][2][4][2];
#pragma unroll
    for (int a = 0; a < 2; ++a)
#pragma unroll
        for (int b = 0; b < 2; ++b)
#pragma unroll
            for (int m = 0; m < 4; ++m)
#pragma unroll
                for (int n = 0; n < 2; ++n) acc[a][b][m][n] = (f32x4){0.f, 0.f, 0.f, 0.f};
    bf16x8 At[4][2], B0[2][2], B1[2][2];
    unsigned goffC[2][2], goffN[2][2];
    if constexpr (Sched::GATHER) { S.aoffs(cur, wid, lda, goffC);
#pragma unroll
        for (int h = 0; h < 2; ++h)
#pragma unroll
            for (int i = 0; i < 2; ++i) goffN[h][i] = goffC[h][i]; }
    const char* cA = cur.a; const char* cB = cur.b;
    S.a_ready(cur);
    PG8_STAGE(PG8_SB(0, 0), cB, voffB); PG8_STAGE(PG8_SB(0, 1), cB + hstepB, voffB); PG8_STAGE_A(0, 0, cA, goffC); PG8_STAGE_A(0, 1, cA, goffC);
    if (wr == 1) PG8_BAR;
    PG8_WAIT_V(2); PG8_BAR;
    PG8_STAGE(PG8_SB(1, 0), cB + kstep, voffB); PG8_STAGE_A(1, 0, cA + kstep, goffC); PG8_STAGE(PG8_SB(1, 1), cB + hstepB + kstep, voffB);
    PG8_WAIT_V(6); PG8_BAR;
    for (;;) {
        const bool has_next = S.next(ui + 1, nxt);
        if constexpr (Sched::GATHER) { if (has_next) S.aoffs(nxt, wid, lda, goffN); }
        const char* nA = has_next ? nxt.a : cA; const char* nB = has_next ? nxt.b : cB;
        for (int t = 0; t < nt; t += 2) {
            const bool last = (t == nt - 2);
            const char* a1 = cA + (size_t)(t + 1) * kstep;
            const char* a2 = last ? nA : cA + (size_t)(t + 2) * kstep; const char* b2 = last ? nB : cB + (size_t)(t + 2) * kstep;
            const char* a3 = a2 + kstep; const char* b3 = b2 + kstep;
            unsigned gx[2][2];
            if constexpr (Sched::GATHER) {
#pragma unroll
                for (int h = 0; h < 2; ++h)
#pragma unroll
                    for (int i = 0; i < 2; ++i) gx[h][i] = (last && has_next) ? goffN[h][i] : goffC[h][i]; }
            if (last && has_next) S.a_ready(nxt);
            PG8_LDB(B0, 0, 0); PG8_LDB(B1, 0, 1); PG8_SCHED; PG8_LDA(At, 0, 0); PG8_STAGE_A(1, 1, a1, goffC);
            PG8_WAIT_V(8); PG8_WAIT_L(0); PG8_BAR; PG8_MMA(0, 0, At, B0); PG8_MMA(0, 1, At, B1); PG8_BAR; PG8_SCHED;
            PG8_LDA(At, 0, 1); PG8_STAGE(PG8_SB(0, 0), b2, voffB); PG8_STAGE(PG8_SB(0, 1), b2 + hstepB, voffB); PG8_STAGE_A(0, 0, a2, gx);
            PG8_WAIT_V(8); PG8_WAIT_L(0); PG8_BAR; PG8_MMA(1, 0, At, B0); PG8_MMA(1, 1, At, B1); PG8_BAR; PG8_SCHED;
            PG8_LDB(B0, 1, 0); PG8_LDB(B1, 1, 1); PG8_SCHED; PG8_LDA(At, 1, 0); PG8_STAGE_A(0, 1, a2, gx);
            PG8_WAIT_V(8); PG8_WAIT_L(0); PG8_BAR; PG8_MMA(0, 0, At, B0); PG8_MMA(0, 1, At, B1); PG8_BAR; PG8_SCHED;
            PG8_LDA(At, 1, 1); PG8_STAGE(PG8_SB(1, 0), b3, voffB); PG8_STAGE(PG8_SB(1, 1), b3 + hstepB, voffB); PG8_STAGE_A(1, 0, a3, gx);
            PG8_WAIT_V(8); PG8_WAIT_L(0); PG8_BAR; PG8_MMA(1, 0, At, B0); PG8_MMA(1, 1, At, B1); PG8_BAR; PG8_SCHED;
            if constexpr (Epi::MID) { if (((t + 2) & (Epi::MID_EVERY - 1)) == 0 && !last) E.mid(acc, cur, wr, wc, (t + 2) / Epi::MID_EVERY - 1); }
        }
        if constexpr (ALIGN_EPI) { if (wr == 0) PG8_BAR; }
        E(acc, cur, wr, wc, fr, fq);
        S.done(cur);
        if (!has_next) break;
#pragma unroll
        for (int a = 0; a < 2; ++a)
#pragma unroll
            for (int b = 0; b < 2; ++b)
#pragma unroll
                for (int m = 0; m < 4; ++m)
#pragma unroll
                    for (int n = 0; n < 2; ++n) acc[a][b][m][n] = (f32x4){0.f, 0.f, 0.f, 0.f};
        cur = nxt; cA = nA; cB = nB; ++ui;
        if constexpr (Sched::GATHER) {
#pragma unroll
            for (int h = 0; h < 2; ++h)
#pragma unroll
                for (int i = 0; i < 2; ++i) goffC[h][i] = goffN[h][i]; }
        if constexpr (ALIGN_EPI) { if (wr == 1) PG8_BAR; }
    }
    PG8_WAIT_V(0);
    if constexpr (!ALIGN_EPI) { if (wr == 0) PG8_BAR; }
    PG8_BAR;
#undef PG8_SA
#undef PG8_SB
#undef PG8_STAGE
#undef PG8_STAGE_A
#undef PG8_LDA
#undef PG8_LDB
#undef PG8_MMA
#undef PG8_WAIT_V
#undef PG8_WAIT_L
#undef PG8_BAR
#undef PG8_SCHED
}
template <class F> struct EpiV4 { static constexpr bool PERM = false, MID = false; static constexpr int MID_EVERY = 1; F f;
    __device__ __forceinline__ void operator()(const f32x4 (&acc)[2][2][4][2], const Unit& u, int wr, int wc, int, int) const {
        const int ln = fresh_lane(), fr = ln & 15, fq = ln >> 4;
        const int row0 = u.pm * BM + wr * 64 + fr, col0 = u.pn * BM + wc * 32 + 4 * fq;
        typename F::UnitPre up = f.unit(u, col0);
#pragma unroll
        for (int ai = 0; ai < 2; ++ai) {
            typename F::Pre pre[4][2][2];
#pragma unroll
            for (int m = 0; m < 4; ++m)
#pragma unroll
                for (int bj = 0; bj < 2; ++bj)
#pragma unroll
                    for (int n = 0; n < 2; ++n) pre[m][bj][n] = f.load(u, row0 + ai * HALF + m * 16, col0 + bj * HALF + n * 16);
#pragma unroll
            for (int m = 0; m < 4; ++m)
#pragma unroll
                for (int bj = 0; bj < 2; ++bj)
#pragma unroll
                    for (int n = 0; n < 2; ++n) f.fin(u, row0 + ai * HALF + m * 16, col0 + bj * HALF + n * 16, acc[ai][bj][m][n], pre[m][bj][n], up, bj * 2 + n);
            asm volatile("" ::: "memory"); }
    } };
template <class F> struct EpiV8 { static constexpr bool PERM = true, MID = false; static constexpr int MID_EVERY = 1; F f;
    __device__ __forceinline__ void operator()(const f32x4 (&acc)[2][2][4][2], const Unit& u, int wr, int wc, int, int) const {
        const int ln = fresh_lane(), fr = ln & 15, fq = ln >> 4;
        const int row0 = u.pm * BM + wr * 64 + fr, col0 = u.pn * BM + wc * 32 + 8 * fq;
#pragma unroll
        for (int ai = 0; ai < 2; ++ai) {
            typename F::Pre pre[4][2];
#pragma unroll
            for (int m = 0; m < 4; ++m)
#pragma unroll
                for (int bj = 0; bj < 2; ++bj) pre[m][bj] = f.load(u, row0 + ai * HALF + m * 16, col0 + bj * HALF);
#pragma unroll
            for (int m = 0; m < 4; ++m)
#pragma unroll
                for (int bj = 0; bj < 2; ++bj) f.fin(u, row0 + ai * HALF + m * 16, col0 + bj * HALF, acc[ai][bj][m][0], acc[ai][bj][m][1], pre[m][bj]);
            asm volatile("" ::: "memory"); }
    } };
template <class F> struct EpiDual { static constexpr bool PERM = true, MID = false; static constexpr int MID_EVERY = 1; F f;
    __device__ __forceinline__ void operator()(const f32x4 (&acc)[2][2][4][2], const Unit& u, int wr, int wc, int, int) const {
        const int ln = fresh_lane(), fr = ln & 15, fq = ln >> 4;
        const int row0 = u.pm * BM + wr * 64 + fr, hc0 = u.pn * HALF + wc * 32 + 8 * fq;
#pragma unroll
        for (int ai = 0; ai < 2; ++ai)
#pragma unroll
            for (int m = 0; m < 4; ++m) f.apply8(row0 + ai * HALF + m * 16, hc0, acc[ai][0][m][0], acc[ai][0][m][1], acc[ai][1][m][0], acc[ai][1][m][1]);
    } };
struct EpiMergeS { static constexpr bool PERM = true, MID = true; static constexpr int MID_EVERY = 8;
    const unsigned char* G8; bf16_t* MG; int wt;
    __device__ __forceinline__ void mid(f32x4 (&acc)[2][2][4][2], const Unit& u, int wr, int wc, int i) const {
        const int ln = fresh_lane(), fr = ln & 15, fq = ln >> 4;
        const int row0 = u.pm * BM + wr * 64 + fr, col0 = u.pn * BM + wc * 32 + 8 * fq;
#pragma unroll
        for (int ai = 0; ai < 2; ++ai) {
            u32x2 gi[4][2], gn[4][2];
#pragma unroll
            for (int m = 0; m < 4; ++m)
#pragma unroll
                for (int bj = 0; bj < 2; ++bj) { const unsigned char* gp = G8 + (size_t)(row0 + ai * HALF + m * 16) * 4096 + i * 1024 + col0 + bj * HALF;
                    gi[m][bj] = *(const u32x2*)gp; gn[m][bj] = *(const u32x2*)(gp + 1024); }
#pragma unroll
            for (int m = 0; m < 4; ++m)
#pragma unroll
                for (int bj = 0; bj < 2; ++bj) {
#pragma unroll
                    for (int j = 0; j < 4; ++j) {
                        acc[ai][bj][m][0][j] *= (float)((gi[m][bj].x >> (8 * j)) & 255u) * __builtin_amdgcn_rcpf((float)((gn[m][bj].x >> (8 * j)) & 255u));
                        acc[ai][bj][m][1][j] *= (float)((gi[m][bj].y >> (8 * j)) & 255u) * __builtin_amdgcn_rcpf((float)((gn[m][bj].y >> (8 * j)) & 255u)); } }
        }
    }
    __device__ __forceinline__ void operator()(const f32x4 (&acc)[2][2][4][2], const Unit& u, int wr, int wc, int, int) const {
        const int ln = fresh_lane(), fr = ln & 15, fq = ln >> 4;
        const int row0 = u.pm * BM + wr * 64 + fr, col0 = u.pn * BM + wc * 32 + 8 * fq;
#pragma unroll
        for (int ai = 0; ai < 2; ++ai) {
            const __amdgpu_buffer_rsrc_t rs = __builtin_amdgcn_make_buffer_rsrc((void*)MG, (short)0, (int)((size_t)R * D * 2), 0x00020000);
        u32x2 g3[4][2];
#pragma unroll
            for (int m = 0; m < 4; ++m)
#pragma unroll
                for (int bj = 0; bj < 2; ++bj) g3[m][bj] = *(const u32x2*)(G8 + (size_t)(row0 + ai * HALF + m * 16) * 4096 + 3 * 1024 + col0 + bj * HALF);
#pragma unroll
            for (int m = 0; m < 4; ++m)
#pragma unroll
                for (int bj = 0; bj < 2; ++bj) { f32x4 a = acc[ai][bj][m][0], b = acc[ai][bj][m][1];
#pragma unroll
                    for (int j = 0; j < 4; ++j) { a[j] *= (float)((g3[m][bj].x >> (8 * j)) & 255u) * (1.0f / 255.0f); b[j] *= (float)((g3[m][bj].y >> (8 * j)) & 255u) * (1.0f / 255.0f); }
                    u32x4 w; w.x = cvtpk(a.x, a.y); w.y = cvtpk(a.z, a.w); w.z = cvtpk(b.x, b.y); w.w = cvtpk(b.z, b.w);
                    if (wt) __builtin_amdgcn_raw_buffer_store_b128(w, rs, (int)(((size_t)(row0 + ai * HALF + m * 16) * D + col0 + bj * HALF) * 2), 0, 16);
                    else *(u32x4*)(MG + (size_t)(row0 + ai * HALF + m * 16) * D + col0 + bj * HALF) = w; }
        }
    }
};
template <class F> struct EpiV8I8 { static constexpr bool PERM = true, MID = false; static constexpr int MID_EVERY = 1; F f; const float* sA; const unsigned* cmax;
    __device__ __forceinline__ void operator()(const f32x4 (&acc)[2][2][4][2], const Unit& u, int wr, int wc, int, int) const {
        const int ln = fresh_lane(), fr = ln & 15, fq = ln >> 4;
        const int row0 = u.pm * BM + wr * 64 + fr, col0 = u.pn * BM + wc * 32 + 8 * fq;
        u32x4 cb[2][2]; float ra[2][4];
#pragma unroll
        for (int bj = 0; bj < 2; ++bj)
#pragma unroll
            for (int n = 0; n < 2; ++n) cb[bj][n] = *(const u32x4*)(cmax + col0 + bj * HALF + 4 * n);
#pragma unroll
        for (int ai = 0; ai < 2; ++ai)
#pragma unroll
            for (int m = 0; m < 4; ++m) ra[ai][m] = sA[row0 + ai * HALF + m * 16];
        const typename F::UnitPre up = f.unit(col0);
        f32x4 sb[2][2];
#pragma unroll
        for (int bj = 0; bj < 2; ++bj)
#pragma unroll
            for (int n = 0; n < 2; ++n) { const u32x4 c = cb[bj][n]; sb[bj][n] = (f32x4){__uint_as_float(c.x), __uint_as_float(c.y), __uint_as_float(c.z), __uint_as_float(c.w)} * (1.0f / 127.0f); }
#pragma unroll
        for (int ai = 0; ai < 2; ++ai) {
#pragma unroll
            for (int m = 0; m < 4; ++m) { const float r1 = ra[ai][m];
#pragma unroll
                for (int bj = 0; bj < 2; ++bj) { f32x4 a, b;
#pragma unroll
                    for (int j = 0; j < 4; ++j) { a[j] = (float)__float_as_int(acc[ai][bj][m][0][j]) * r1 * sb[bj][0][j]; b[j] = (float)__float_as_int(acc[ai][bj][m][1][j]) * r1 * sb[bj][1][j]; }
                    f.fin(u, row0 + ai * HALF + m * 16, col0 + bj * HALF, a, b, up, bj); } }
            asm volatile("" ::: "memory"); }
    } };
template <class F> struct EpiDualI8 { static constexpr bool PERM = true, MID = false; static constexpr int MID_EVERY = 1; F f; const float* sA; const unsigned* cmax; const int* tokl;
    __device__ __forceinline__ void operator()(const f32x4 (&acc)[2][2][4][2], const Unit& u, int wr, int wc, int, int) const {
        const int ln = fresh_lane(), fr = ln & 15, fq = ln >> 4;
        const int lrow0 = wr * 64 + fr, hc0 = u.pn * HALF + wc * 32 + 8 * fq;
        const unsigned* cm = cmax + u.e * 1024 + u.pn * BM + wc * 32 + 8 * fq;
        f32x4 s1[2], s3[2];
#pragma unroll
        for (int n = 0; n < 2; ++n) { const u32x4 a = *(const u32x4*)(cm + 4 * n), b = *(const u32x4*)(cm + HALF + 4 * n);
            s1[n] = (f32x4){__uint_as_float(a.x), __uint_as_float(a.y), __uint_as_float(a.z), __uint_as_float(a.w)} * (1.0f / 127.0f);
            s3[n] = (f32x4){__uint_as_float(b.x), __uint_as_float(b.y), __uint_as_float(b.z), __uint_as_float(b.w)} * (1.0f / 127.0f); }
        int tk[2][4]; float ra[2][4];
#pragma unroll
        for (int ai = 0; ai < 2; ++ai)
#pragma unroll
            for (int m = 0; m < 4; ++m) { const int pos = u.p0 + lrow0 + ai * HALF + m * 16; tk[ai][m] = pos < u.ce ? (tokl[(size_t)u.e * R + pos] >> 1) : 0; }
#pragma unroll
        for (int ai = 0; ai < 2; ++ai)
#pragma unroll
            for (int m = 0; m < 4; ++m) ra[ai][m] = sA[tk[ai][m]];
#pragma unroll
        for (int ai = 0; ai < 2; ++ai) {
#pragma unroll
            for (int m = 0; m < 4; ++m) { f32x4 a0, a1, b0, b1; const float r1 = ra[ai][m];
#pragma unroll
                for (int j = 0; j < 4; ++j) { a0[j] = (float)__float_as_int(acc[ai][0][m][0][j]) * r1 * s1[0][j]; a1[j] = (float)__float_as_int(acc[ai][0][m][1][j]) * r1 * s1[1][j];
                    b0[j] = (float)__float_as_int(acc[ai][1][m][0][j]) * r1 * s3[0][j]; b1[j] = (float)__float_as_int(acc[ai][1][m][1][j]) * r1 * s3[1][j]; }
                f.apply8(u.pm * BM + lrow0 + ai * HALF + m * 16, hc0, a0, a1, b0, b1); }
        }
    } };
}

__device__ __forceinline__ u32x4 pack8(f32x4 a, f32x4 b) { u32x4 w; w.x = cvtpk(a.x, a.y); w.y = cvtpk(a.z, a.w); w.z = cvtpk(b.x, b.y); w.w = cvtpk(b.z, b.w); return w; }
__device__ __forceinline__ float sigm1(float x) { return __builtin_amdgcn_rcpf(1.0f + __builtin_amdgcn_exp2f(-1.4426950408889634f * x)); }
__device__ __forceinline__ f32x4 sigm4(f32x4 v) { f32x4 r; r.x = sigm1(v.x); r.y = sigm1(v.y); r.z = sigm1(v.z); r.w = sigm1(v.w); return r; }
struct NoPre {};
struct FStore8 { bf16_t* C; int ldc; typedef NoPre UnitPre;
    __device__ __forceinline__ UnitPre unit(int) const { return UnitPre{}; }
    __device__ __forceinline__ void fin(const pg8::Unit&, int row, int col, f32x4 a, f32x4 b, const UnitPre&, int) const { *(u32x4*)(C + (size_t)row * ldc + col) = pack8(a, b); } };
struct FGateU8 { unsigned char* G8; const float* bias; struct UnitPre { f32x4 b[2][2]; };
    __device__ __forceinline__ UnitPre unit(int col0) const { UnitPre r;
#pragma unroll
        for (int bj = 0; bj < 2; ++bj) { r.b[bj][0] = *(const f32x4*)(bias + col0 + bj * pg8::HALF); r.b[bj][1] = *(const f32x4*)(bias + col0 + bj * pg8::HALF + 4); } return r; }
    __device__ __forceinline__ void fin(const pg8::Unit&, int row, int col, f32x4 a, f32x4 b, const UnitPre& up, int bj) const { const f32x4 b0 = up.b[bj][0], b1 = up.b[bj][1];
        const f32x4 ga = sigm4(a + b0) * 255.0f + 0.5f, gb = sigm4(b + b1) * 255.0f + 0.5f;
        unsigned q[8] = {(unsigned)ga.x, (unsigned)ga.y, (unsigned)ga.z, (unsigned)ga.w, (unsigned)gb.x, (unsigned)gb.y, (unsigned)gb.z, (unsigned)gb.w};
#pragma unroll
        for (int k = 0; k < 8; ++k) q[k] = q[k] < 1u ? 1u : (q[k] > 255u ? 255u : q[k]);
        u32x2 w; w.x = q[0] | (q[1] << 8) | (q[2] << 16) | (q[3] << 24); w.y = q[4] | (q[5] << 8) | (q[6] << 16) | (q[7] << 24);
        *(u32x2*)(G8 + (size_t)row * 4096 + col) = w; } };
struct FMoe1 { bf16_t* HID;
    __device__ __forceinline__ void apply8(int row, int hc, f32x4 a0, f32x4 a1, f32x4 b0, f32x4 b1) const {
        const __amdgpu_buffer_rsrc_t rs = __builtin_amdgcn_make_buffer_rsrc((void*)HID, (short)0, (int)((size_t)MAXROWS * FF * 2), 0x00020000);
        __builtin_amdgcn_raw_buffer_store_b128(pack8(a0 * sigm4(a0) * b0, a1 * sigm4(a1) * b1), rs, (int)(((size_t)row * FF + hc) * 2), 0, 16); } };
struct FMoe2 { bf16_t* MO; const int* tokl; const float* wl; struct Pre { int t; float w; };
    __device__ __forceinline__ Pre load(const pg8::Unit& u, int row, int) const { Pre r; const int pos = u.p0 + (row - u.pm * 256); r.t = -1; r.w = 0.f;
        if (pos < u.ce) { r.t = tokl[(size_t)u.e * R + pos]; r.w = wl[(size_t)u.e * R + pos]; } return r; }
    __device__ __forceinline__ void fin(const pg8::Unit&, int, int col, f32x4 a, f32x4 b, const Pre& q) const { if (q.t < 0) return;
        *(u32x4*)(MO + ((size_t)(q.t & 1) * R + (q.t >> 1)) * D + col) = pack8(a * q.w, b * q.w); } };
struct FOut { Ptrs P; int l; typedef u32x4 Pre; struct UnitPre { f32x4 g[4]; };
    __device__ __forceinline__ UnitPre unit(const pg8::Unit& u, int col0) const { UnitPre r; const float* g = mod_vec(P, l, row_bb(u.pm * 256), 2) + col0;
#pragma unroll
        for (int q = 0; q < 4; ++q) r.g[q] = *(const f32x4*)(g + (q >> 1) * 128 + (q & 1) * 16);
        return r; }
    __device__ __forceinline__ Pre load(const pg8::Unit&, int row, int col) const { if (l == 0) return *(const u32x4*)(xin_row(P, row) + col); const u32x2 w = *(const u32x2*)(x1b_row(P, row) + col); return (u32x4){w.x, w.y, 0u, 0u}; }
    __device__ __forceinline__ void fin(const pg8::Unit&, int row, int col, f32x4 v, const Pre& xr, const UnitPre& up, int q) const {
        const f32x4 xp = l == 0 ? (f32x4){__uint_as_float(xr.x), __uint_as_float(xr.y), __uint_as_float(xr.z), __uint_as_float(xr.w)} : (f32x4){lo16(xr.x), hi16(xr.x), lo16(xr.y), hi16(xr.y)};
        st4b(x1b_row(P, row) + col, xp + up.g[q] * v); } };

struct Frame { LAS unsigned char* lds; int wave, vcu, G; };
#define fresh_tid() (F.wave * 64 + fresh_lane())
__device__ __forceinline__ void tr_item(const float* W, int ldw, int k0, int csrc0, bf16_t* WT, int ldt, int drow0, LAS float* scr, int lane) {
    f32x4 v[8];
#pragma unroll
    for (int i = 0; i < 8; ++i) v[i] = *(const f32x4*)(W + (size_t)(k0 + (lane >> 3) + 8 * i) * ldw + csrc0 + (lane & 7) * 4);
#pragma unroll
    for (int i = 0; i < 8; ++i) { LAS float* d = scr + ((lane >> 3) + 8 * i) * 33 + (lane & 7) * 4; d[0] = v[i].x; d[1] = v[i].y; d[2] = v[i].z; d[3] = v[i].w; }
    LDS_WAIT(); asm volatile("" ::: "memory");
    const int c = lane & 7;
#pragma unroll
    for (int j = 0; j < 4; ++j) { const int n = (lane >> 3) + 8 * j; const LAS float* s = scr + (8 * c) * 33 + n;
        u32x4 o; o.x = cvtpk(s[0 * 33], s[1 * 33]); o.y = cvtpk(s[2 * 33], s[3 * 33]); o.z = cvtpk(s[4 * 33], s[5 * 33]); o.w = cvtpk(s[6 * 33], s[7 * 33]);
        *(u32x4*)(WT + (size_t)(drow0 + n) * ldt + k0 + 8 * c) = o; }
    LDS_WAIT(); asm volatile("" ::: "memory");
}
__device__ __forceinline__ void max_item(const float* W, int ldw, int k0, int csrc0, unsigned* cmax, int lane) {
    f32x4 m = (f32x4){0.f, 0.f, 0.f, 0.f};
#pragma unroll
    for (int i = 0; i < 8; ++i) { const f32x4 v = *(const f32x4*)(W + (size_t)(k0 + (lane >> 3) + 8 * i) * ldw + csrc0 + (lane & 7) * 4);
        m.x = fmaxf(m.x, fabsf(v.x)); m.y = fmaxf(m.y, fabsf(v.y)); m.z = fmaxf(m.z, fabsf(v.z)); m.w = fmaxf(m.w, fabsf(v.w)); }
#pragma unroll
    for (int o = 8; o < 64; o <<= 1) { m.x = fmaxf(m.x, shfl_xor_l(m.x, o, lane)); m.y = fmaxf(m.y, shfl_xor_l(m.y, o, lane)); m.z = fmaxf(m.z, shfl_xor_l(m.z, o, lane)); m.w = fmaxf(m.w, shfl_xor_l(m.w, o, lane)); }
    if (lane < 8) { atomicMax(cmax + lane * 4, __float_as_uint(m.x)); atomicMax(cmax + lane * 4 + 1, __float_as_uint(m.y)); atomicMax(cmax + lane * 4 + 2, __float_as_uint(m.z)); atomicMax(cmax + lane * 4 + 3, __float_as_uint(m.w)); }
}
__device__ __forceinline__ unsigned q8(float v, float inv) { int q = (int)__builtin_rintf(v * inv); q = q < -127 ? -127 : (q > 127 ? 127 : q); return (unsigned)q & 255u; }
__device__ __forceinline__ unsigned q8x4(float a, float b, float c, float d, float inv) { return q8(a, inv) | (q8(b, inv) << 8) | (q8(c, inv) << 16) | (q8(d, inv) << 24); }
__device__ __forceinline__ void tr_item_q(const float* W, int ldw, int k0, int csrc0, unsigned char* WT, int ldt, int drow0, const unsigned* cmax, LAS float* scr, int lane) {
    f32x4 v[8];
#pragma unroll
    for (int i = 0; i < 8; ++i) v[i] = *(const f32x4*)(W + (size_t)(k0 + (lane >> 3) + 8 * i) * ldw + csrc0 + (lane & 7) * 4);
#pragma unroll
    for (int i = 0; i < 8; ++i) { LAS float* d = scr + ((lane >> 3) + 8 * i) * 33 + (lane & 7) * 4; d[0] = v[i].x; d[1] = v[i].y; d[2] = v[i].z; d[3] = v[i].w; }
    LDS_WAIT(); asm volatile("" ::: "memory");
    const int n = lane >> 1, half = lane & 1; const float cm = __uint_as_float(cmax[n]); const float inv = cm > 0.f ? 127.0f / cm : 0.f;
    const LAS float* sp = scr + (half * 32) * 33 + n; unsigned w[8];
#pragma unroll
    for (int q = 0; q < 8; ++q) w[q] = q8x4(sp[(4 * q) * 33], sp[(4 * q + 1) * 33], sp[(4 * q + 2) * 33], sp[(4 * q + 3) * 33], inv);
    u32x4* dp = (u32x4*)(WT + (size_t)(drow0 + n) * ldt + k0 + half * 32);
    dp[0] = (u32x4){w[0], w[1], w[2], w[3]}; dp[1] = (u32x4){w[4], w[5], w[6], w[7]};
    LDS_WAIT(); asm volatile("" ::: "memory");
}
struct Strip { const float* W; int ldw; unsigned char* WT; unsigned* cm; };
constexpr int NSTRIP = 64 + 128 + 512, ST_PITCH = 1040, ST_RED = 32 * ST_PITCH;
__device__ __forceinline__ Strip strip_desc(const Ptrs& P, int l, int s, unsigned char* wb, unsigned* cmaxp) {
    Strip d;
    if (s < 64) { d.W = P.w_in + (size_t)l * 1024 * 2560 + 512 + s * 32; d.ldw = 2560; d.WT = wb + WB_IN + (size_t)(1024 + s * 32) * 1024; d.cm = cmaxp + 1024 + s * 32; }
    else if (s < 192) { const int r = s - 64, i = r >> 5, nb = r & 31; d.W = P.w_gate + ((size_t)l * 4 + i) * 1024 * 1024 + nb * 32; d.ldw = 1024; d.WT = wb + WB_GATE + (size_t)i * 1024 * 1024 + (size_t)(nb * 32) * 1024; d.cm = cmaxp + 3072 + i * 1024 + nb * 32; }
    else { const int r = s - 192, w3 = r >> 8, e = (r >> 4) & 15, nb = r & 15, c = nb * 32, drow = 256 * (c >> 7) + (c & 127) + (w3 ? 128 : 0);
        d.W = (w3 ? P.w3 : P.w1) + ((size_t)l * 16 + e) * 1024 * 512 + c; d.ldw = 512; d.WT = wb + WB_13 + (size_t)e * 1024 * 1024 + (size_t)drow * 1024; d.cm = cmaxp + 8192 + e * 1024 + drow; }
    return d;
}
#define STRIP_LOAD(v, dsc, tid) do { const float* p_ = (dsc).W + (size_t)(4 * ((tid) >> 3)) * (dsc).ldw + 4 * ((tid) & 7); \
    _Pragma("unroll") for (int j_ = 0; j_ < 4; ++j_) _Pragma("unroll") for (int d_ = 0; d_ < 4; ++d_) v[j_ * 4 + d_] = *(const f32x4*)(p_ + (size_t)(256 * j_ + d_) * (dsc).ldw); } while (0)
__device__ __forceinline__ unsigned q8m(float v, float inv) { return __float_as_uint(__builtin_fmaf(v, inv, 12582912.0f)); }
__device__ __forceinline__ unsigned pack4m(unsigned a, unsigned b, unsigned c, unsigned d) { return __builtin_amdgcn_perm(b, a, 0x0c0c0400u) | __builtin_amdgcn_perm(d, c, 0x04000c0cu); }
__device__ __forceinline__ void strip_process(const f32x4 (&v)[16], const Strip& d, LAS unsigned char* lds, int tid, int lane, int wave) {
    const int cq = tid & 7, kr = tid >> 3;
    f32x4 m = (f32x4){0.f, 0.f, 0.f, 0.f};
#pragma unroll
    for (int i = 0; i < 16; ++i) { m.x = fmaxf(m.x, fabsf(v[i].x)); m.y = fmaxf(m.y, fabsf(v[i].y)); m.z = fmaxf(m.z, fabsf(v[i].z)); m.w = fmaxf(m.w, fabsf(v[i].w)); }
#pragma unroll
    for (int o = 8; o < 64; o <<= 1) { m.x = fmaxf(m.x, shfl_xor_l(m.x, o, lane)); m.y = fmaxf(m.y, shfl_xor_l(m.y, o, lane)); m.z = fmaxf(m.z, shfl_xor_l(m.z, o, lane)); m.w = fmaxf(m.w, shfl_xor_l(m.w, o, lane)); }
    LAS float* red = (LAS float*)(lds + ST_RED);
    if (lane < 8) *(LAS f32x4*)(red + wave * 32 + 4 * lane) = m;
    __syncthreads();
    f32x4 cm = *(const LAS f32x4*)(red + 4 * cq);
#pragma unroll
    for (int w = 1; w < 8; ++w) { const f32x4 t = *(const LAS f32x4*)(red + w * 32 + 4 * cq); cm.x = fmaxf(cm.x, t.x); cm.y = fmaxf(cm.y, t.y); cm.z = fmaxf(cm.z, t.z); cm.w = fmaxf(cm.w, t.w); }
    if (tid < 8) *(u32x4*)(d.cm + 4 * tid) = (u32x4){__float_as_uint(cm.x), __float_as_uint(cm.y), __float_as_uint(cm.z), __float_as_uint(cm.w)};
    f32x4 inv; inv.x = cm.x > 0.f ? 127.0f / cm.x : 0.f; inv.y = cm.y > 0.f ? 127.0f / cm.y : 0.f; inv.z = cm.z > 0.f ? 127.0f / cm.z : 0.f; inv.w = cm.w > 0.f ? 127.0f / cm.w : 0.f;
    LAS unsigned char* tp = lds + (4 * cq) * ST_PITCH + 4 * kr;
#pragma unroll
    for (int j = 0; j < 4; ++j) {
        *(LAS unsigned*)(tp + 0 * ST_PITCH + 256 * j) = pack4m(q8m(v[4 * j].x, inv.x), q8m(v[4 * j + 1].x, inv.x), q8m(v[4 * j + 2].x, inv.x), q8m(v[4 * j + 3].x, inv.x));
        *(LAS unsigned*)(tp + 1 * ST_PITCH + 256 * j) = pack4m(q8m(v[4 * j].y, inv.y), q8m(v[4 * j + 1].y, inv.y), q8m(v[4 * j + 2].y, inv.y), q8m(v[4 * j + 3].y, inv.y));
        *(LAS unsigned*)(tp + 2 * ST_PITCH + 256 * j) = pack4m(q8m(v[4 * j].z, inv.z), q8m(v[4 * j + 1].z, inv.z), q8m(v[4 * j + 2].z, inv.z), q8m(v[4 * j + 3].z, inv.z));
        *(LAS unsigned*)(tp + 3 * ST_PITCH + 256 * j) = pack4m(q8m(v[4 * j].w, inv.w), q8m(v[4 * j + 1].w, inv.w), q8m(v[4 * j + 2].w, inv.w), q8m(v[4 * j + 3].w, inv.w));
    }
    __syncthreads();
#pragma unroll
    for (int q = 0; q < 4; ++q) { const int id = tid + 512 * q, n = id >> 6, kc = id & 63; *(u32x4*)(d.WT + (size_t)n * 1024 + 16 * kc) = *(const LAS u32x4*)(lds + n * ST_PITCH + 16 * kc); }
}
__device__ __forceinline__ void ph_weights(const Frame& F, const Ptrs& P, int l) {
    const int tid0 = fresh_tid(), lane0 = tid0 & 63;
    LAS float* scr = (LAS float*)(F.lds + F.wave * 16384);
    const int gw = F.vcu * NWAVES + F.wave, NGW = F.G * NWAVES;
    unsigned char* wb = P.ws + WS_WB;
    unsigned* cmaxp = (unsigned*)(P.ws + WS_CTL) + CW_CMAX + 32768 * l;
    int vcu = F.vcu; asm volatile("" : "+s"(vcu));
    { const int tid = tid0; f32x4 va[16], vb[16]; Strip da, db; int s = vcu;
      if (s < NSTRIP) { da = strip_desc(P, l, s, wb, cmaxp); STRIP_LOAD(va, da, tid); }
      while (s < NSTRIP) {
          int sn = s + F.G;
          if (sn < NSTRIP) { db = strip_desc(P, l, sn, wb, cmaxp); STRIP_LOAD(vb, db, tid); }
          strip_process(va, da, F.lds, tid, lane0, F.wave);
          s = sn; if (s >= NSTRIP) break;
          sn = s + F.G;
          if (sn < NSTRIP) { da = strip_desc(P, l, sn, wb, cmaxp); STRIP_LOAD(va, da, tid); }
          strip_process(vb, db, F.lds, tid, lane0, F.wave);
          s = sn;
      } }
    __syncthreads();
    constexpr int I2 = 768, I3 = I2 + 512, I6 = I3 + 4096;
    int it0, it1, step;
    if (F.G == 256) { const int base = vcu < 192 ? 16 * vcu : 3072 + 36 * (vcu - 192); it0 = base + F.wave; it1 = base + (vcu < 192 ? 16 : 36); step = NWAVES; }
    else { it0 = gw; it1 = I6; step = NGW; }
    for (int it = it0; it < it1; it += step) {
        if (it < I2) { const int i = it >> 8, q = it & 255, kb = q >> 5, nb = q & 31; tr_item(P.w_branch + ((size_t)l * 4 + i) * 512 * 1024, 1024, kb * 64, nb * 32, (bf16_t*)(wb + WB_BR) + i * 512, 2048, nb * 32, scr, lane0); }
        else if (it < I3) { const int q = it - I2, kb = q >> 5, nb = q & 31; tr_item(P.w_out + (size_t)l * 1024 * 1024, 1024, kb * 64, nb * 32, (bf16_t*)(wb + WB_OUT), 1024, nb * 32, scr, lane0); }
        else { const int r = it - I3, e = r >> 8, q = r & 255, kb = q >> 5, nb = q & 31; tr_item(P.w2 + ((size_t)l * 16 + e) * 512 * 1024, 1024, kb * 64, nb * 32, (bf16_t*)(wb + WB_2) + (size_t)e * 1024 * 512, 512, nb * 32, scr, lane0); }
    }
    __syncthreads();
    for (int u = F.vcu; u < 256; u += F.G) {
        LAS float* Wl = (LAS float*)F.lds; LAS float* ct = Wl + 16 * 128;
        const int kt = u >> 2, g = u & 3, k0 = kt * 16, tid = tid0; const float* w_in = P.w_in + (size_t)l * 1024 * 2560;
        if (tid < 128) ct[tid] = __builtin_amdgcn_cosf((float)tid * (1.0f / 128.0f));
        for (int i = tid; i < 16 * 128; i += 512) { const int k = i >> 7, c = i & 127; Wl[k * 128 + c] = w_in[(size_t)(k0 + k) * 2560 + g * 128 + c]; }
        __syncthreads();
        const int part = (tid >> 7) & 1, m = tid & 127, kh = tid >> 8; const float sc = 0.08838834764831845f;
        float* drow = (float*)(P.ws + WS_FTMP) + (size_t)(part * 512 + g * 128 + m) * 1024 + k0;
        { const int kb = kh * 8; float acc[8];
#pragma unroll
            for (int j = 0; j < 8; ++j) acc[j] = 0.f;
            for (int c = 0; c < 128; ++c) { const int idx = (c * m) & 127; const float tw = part ? -ct[(idx - 32) & 127] : ct[idx];
#pragma unroll
                for (int j = 0; j < 8; ++j) acc[j] += Wl[(kb + j) * 128 + c] * tw; }
            float mx = 0.f;
#pragma unroll
            for (int j = 0; j < 8; ++j) { acc[j] *= sc; mx = fmaxf(mx, fabsf(acc[j])); }
            *(f32x4*)(drow + kb) = (f32x4){acc[0], acc[1], acc[2], acc[3]}; *(f32x4*)(drow + kb + 4) = (f32x4){acc[4], acc[5], acc[6], acc[7]};
            atomicMax(cmaxp + part * 512 + g * 128 + m, __float_as_uint(mx)); }
        __syncthreads();
    }
    for (int u = F.vcu; u < 256; u += F.G) {
        LAS float* Wb = (LAS float*)F.lds;
        const int g = u >> 6, n0 = (u & 63) * 16, tid = tid0;
        const float* ps = P.pool_scale + (size_t)l * 512; const float* wb3 = P.w_branch + ((size_t)l * 4 + 3) * 512 * 1024; const float* pwl = P.pool_w + (size_t)l * 4 * 128 * 128;
        for (int i = tid; i < 128 * 16; i += 512) { const int e = i >> 4, n = i & 15; Wb[e * 16 + n] = ps[g * 128 + e] * wb3[(size_t)(g * 128 + e) * 1024 + n0 + n]; }
        __syncthreads();
        const int c = tid & 127, nh = tid >> 7; const float* pw = pwl + (size_t)(g * 128 + c) * 128;
        float acc[4];
#pragma unroll
        for (int j = 0; j < 4; ++j) acc[j] = 0.f;
        for (int e = 0; e < 128; e += 4) { const f32x4 p4 = *(const f32x4*)(pw + e);
#pragma unroll
            for (int q = 0; q < 4; ++q)
#pragma unroll
                for (int j = 0; j < 4; ++j) acc[j] += p4[q] * Wb[(e + q) * 16 + nh * 4 + j]; }
        bf16_t* Bt = (bf16_t*)(wb + WB_BR) + 3 * 512;
#pragma unroll
        for (int j = 0; j < 4; ++j) Bt[(size_t)(n0 + nh * 4 + j) * 2048 + g * 128 + c] = (bf16_t)f2bf(acc[j]);
        __syncthreads();
    }
}
__device__ __forceinline__ void ph_quant(const Frame& F, const Ptrs& P, int l) {
    const int tid0 = fresh_tid(), lane0 = tid0 & 63;
    LAS float* scr = (LAS float*)(F.lds + F.wave * 16384);
    const int gw = F.vcu * NWAVES + F.wave, NGW = F.G * NWAVES;
    unsigned char* wb = P.ws + WS_WB; const unsigned* cmaxp = (const unsigned*)(P.ws + WS_CTL) + CW_CMAX + 32768 * l;
    for (int i = F.vcu * 512 + tid0; i < 65536; i += F.G * 512) {
        const int n = i >> 6, kc = (i & 63) * 16; const float cm = __uint_as_float(cmaxp[n]); const float inv = cm > 0.f ? 127.0f / cm : 0.f;
        const f32x4* tp = (const f32x4*)((const float*)(P.ws + WS_FTMP) + (size_t)n * 1024 + kc); const f32x4 a = tp[0], b = tp[1], c = tp[2], d = tp[3];
        *(u32x4*)(wb + WB_IN + (size_t)n * 1024 + kc) = (u32x4){q8x4(a.x, a.y, a.z, a.w, inv), q8x4(b.x, b.y, b.z, b.w, inv), q8x4(c.x, c.y, c.z, c.w, inv), q8x4(d.x, d.y, d.z, d.w, inv)};
    }
    __syncthreads();
}
__device__ __forceinline__ void ph_tables_mod(const Frame& F, const Ptrs& P) {
    const int tid0 = fresh_tid();
    { float* rc = (float*)(P.ws + WS_ROPE); float* rs = rc + 1024; float* ct = (float*)(P.ws + WS_COS);
      const int i = F.vcu * 512 + tid0;
      if (i < 1024) { const int pos = i >> 4, f = i & 15; const float inv = __builtin_amdgcn_exp2f(-(float)f * (13.287712379549449f / 16.0f));
          float rev = (float)pos * inv * 0.15915494309189535f; rev = rev - floorf(rev);
          rc[i] = __builtin_amdgcn_cosf(rev); rs[i] = __builtin_amdgcn_sinf(rev); }
      if (i < 4096) ct[i] = __builtin_amdgcn_cosf((float)i * (1.0f / 4096.0f));
      if (i < 16384) { const int mm = i >> 7, k = i & 127, pp = mm >> 6, k1 = mm & 63, pk = k >> 6, t1 = k & 63; const float rev = (float)((k1 * t1) & 63) * (1.0f / 64.0f);
          const float c = __builtin_amdgcn_cosf(rev), sn = __builtin_amdgcn_sinf(rev);
          ((bf16_t*)(P.ws + WS_DFTM))[i] = (bf16_t)f2bf(pp == pk ? c : (pp == 0 ? sn : -sn)); } }
    for (int u = F.vcu; u < 192; u += F.G) {
        LAS float* s = (LAS float*)F.lds; LAS float* red = s + 9 * 1024;
        const int l = u / 96, j0 = (u % 96) * 64, tid = tid0;
        for (int i = tid; i < 9 * 1024; i += 512) { const int bb = i >> 10, k = i & 1023; const float v = bb < 8 ? P.c[bb * 1024 + k] : P.c_ctx[k]; s[i] = v * __builtin_amdgcn_rcpf(1.f + __builtin_amdgcn_exp2f(-1.4426950408889634f * v)); }
        __syncthreads();
        const int kc = tid >> 4, jq = tid & 15;
        const float* w = P.w_ada + (size_t)l * 1024 * 6144 + j0 + 4 * jq + (size_t)(kc * 32) * 6144;
        f32x4 wv[32];
#pragma unroll
        for (int q = 0; q < 32; ++q) wv[q] = *(const f32x4*)(w + (size_t)q * 6144);
        f32x4 acc[9];
#pragma unroll
        for (int b = 0; b < 9; ++b) acc[b] = (f32x4){0.f, 0.f, 0.f, 0.f};
#pragma unroll
        for (int qq = 0; qq < 8; ++qq)
#pragma unroll
            for (int b = 0; b < 9; ++b) { const f32x4 s4 = *(const LAS f32x4*)(s + b * 1024 + kc * 32 + 4 * qq);
                acc[b] += s4.x * wv[4 * qq] + s4.y * wv[4 * qq + 1] + s4.z * wv[4 * qq + 2] + s4.w * wv[4 * qq + 3]; }
#pragma unroll
        for (int b = 0; b < 9; ++b) *(LAS f32x4*)(red + (kc * 9 + b) * 64 + 4 * jq) = acc[b];
        __syncthreads();
        float* mod = (float*)(P.ws + WS_MOD);
        for (int i = tid; i < 9 * 64; i += 512) { const int b = i >> 6, j = i & 63; float v = P.b_ada[l * 6144 + j0 + j];
#pragma unroll
            for (int q = 0; q < 32; ++q) v += red[(q * 9 + b) * 64 + j];
            mod[(size_t)(l * 9 + b) * 6144 + j0 + j] = v; }
        __syncthreads();
    }
}
__device__ __forceinline__ void route_row(const Ptrs& P, int r, const f32x4 (&h)[4], int lane, bool publish, LAS unsigned* lcnt, LAS int* rec, const LAS float* rwl) {
    float lg[16];
#pragma unroll
    for (int e = 0; e < 16; ++e) lg[e] = 0.f;
#pragma unroll
    for (int j = 0; j < 4; ++j) {
#pragma unroll
        for (int i = 0; i < 4; ++i) { const int kk = 4 * lane + 256 * j + i; const LAS f32x4* rw = (const LAS f32x4*)(rwl + kk * 16 + (kk >> 2) * 4); const float hv = h[j][i];
#pragma unroll
            for (int qd = 0; qd < 4; ++qd) { const f32x4 w = rw[qd]; lg[4 * qd] += hv * w.x; lg[4 * qd + 1] += hv * w.y; lg[4 * qd + 2] += hv * w.z; lg[4 * qd + 3] += hv * w.w; } }
        __builtin_amdgcn_sched_barrier(0); }
    float v8[8], v4[4], v2[2], v1;
    { const bool bit = (lane & 32) != 0;
#pragma unroll
      for (int i = 0; i < 8; ++i) { const float a = lg[i], b = lg[i + 8]; v8[i] = (bit ? b : a) + shfl_xor_l(bit ? a : b, 32, lane); } }
    { const bool bit = (lane & 16) != 0;
#pragma unroll
      for (int i = 0; i < 4; ++i) { const float a = v8[i], b = v8[i + 4]; v4[i] = (bit ? b : a) + shfl_xor_l(bit ? a : b, 16, lane); } }
    { const bool bit = (lane & 8) != 0;
#pragma unroll
      for (int i = 0; i < 2; ++i) { const float a = v4[i], b = v4[i + 2]; v2[i] = (bit ? b : a) + shfl_xor_l(bit ? a : b, 8, lane); } }
    { const bool bit = (lane & 4) != 0; const float a = v2[0], b = v2[1]; v1 = (bit ? b : a) + shfl_xor_l(bit ? a : b, 4, lane); }
    v1 += shfl_xor_l(v1, 2, lane); v1 += shfl_xor_l(v1, 1, lane);
    float bestscore = -INFINITY; int be0 = 0, be1 = 1; float ba0 = 0.f, ba1 = 0.f;
#pragma unroll
    for (int g = 0; g < 4; ++g) {
        float aff[4], sel[4];
#pragma unroll
        for (int i = 0; i < 4; ++i) { const float t = __int_as_float(__builtin_amdgcn_ds_bpermute((4 * g + i) << 4, __float_as_int(v1))); aff[i] = __builtin_amdgcn_rcpf(1.0f + __builtin_amdgcn_exp2f(-1.4426950408889634f * t)); sel[i] = aff[i] + P.router_bias[4 * g + i]; }
        int i1 = 0; float m1 = sel[0], a1 = aff[0];
#pragma unroll
        for (int i = 1; i < 4; ++i) if (sel[i] > m1) { m1 = sel[i]; a1 = aff[i]; i1 = i; }
        int i2 = -1; float m2 = -INFINITY, a2 = 0.f;
#pragma unroll
        for (int i = 0; i < 4; ++i) if (i != i1 && sel[i] > m2) { m2 = sel[i]; a2 = aff[i]; i2 = i; }
        const float score = m1 + m2;
        if (score > bestscore) { bestscore = score; be0 = 4 * g + i1; be1 = 4 * g + i2; ba0 = a1; ba1 = a2; }
    }
    if (lane == 0 && publish) {
        const int p0 = (int)__hip_atomic_fetch_add(lcnt + be0, 1u, __ATOMIC_RELAXED, __HIP_MEMORY_SCOPE_WORKGROUP), p1 = (int)__hip_atomic_fetch_add(lcnt + be1, 1u, __ATOMIC_RELAXED, __HIP_MEMORY_SCOPE_WORKGROUP);
        const float inv = 1.0f / (ba0 + ba1);
        rec[0] = r; rec[1] = be0; rec[2] = p0; rec[3] = be1; rec[4] = p1; rec[5] = __float_as_int(ba0 * inv); rec[6] = __float_as_int(ba1 * inv);
    }
}
template <int MODE> __device__ __forceinline__ void ph_norm(const Frame& F, const Ptrs& P, int l, int nrows) {
    constexpr int NRW = MODE == 2 ? 2 : 4;
    const int lane = fresh_lane();
    const int stride = F.G * NWAVES;
    LAS unsigned* lcnt = (LAS unsigned*)F.lds; LAS unsigned* gbase = lcnt + 16; LAS int* recs = (LAS int*)(F.lds + 256);
    const LAS float* rwl = (const LAS float*)(F.lds + 8192);
    if (MODE == 2) { if (F.wave == 0 && lane < 16) lcnt[lane] = 0u;
        { const int tid = F.wave * 64 + lane; LAS f32x4* d = (LAS f32x4*)(F.lds + 8192);
#pragma unroll
          for (int i = 0; i < 8; ++i) { const int idx = tid + 512 * i, kk = idx >> 2; d[idx + (kk >> 2)] = ((const f32x4*)P.router_w)[idx]; } }
        __syncthreads(); }
    int it = 0;
    for (int rb = F.vcu * NWAVES + F.wave; rb < nrows; rb += NRW * stride, ++it) {
        int rr[NRW];
#pragma unroll
        for (int q = 0; q < NRW; ++q) rr[q] = rb + q * stride < nrows ? rb + q * stride : rb;
        f32x4 v[NRW][4];
#pragma unroll
        for (int q = 0; q < NRW; ++q) { const int r = rr[q];
            if (MODE == 0) { const f32x4* xr = (const f32x4*)xin_row(P, r) + lane;
#pragma unroll
                for (int j = 0; j < 4; ++j) v[q][j] = xr[64 * j]; }
            else { const bf16_t* xr = x1b_row(P, r) + 4 * lane;
#pragma unroll
                for (int j = 0; j < 4; ++j) v[q][j] = ld4b(xr + 256 * j); } }
        if (MODE == 1) {
#pragma unroll
            for (int q = 0; q < NRW; ++q) { const int r = rr[q]; const int bb = row_bb(r); const f32x4* g2 = (const f32x4*)mod_vec(P, l - 1, bb, 5) + lane;
                const u32x2* m0 = (const u32x2*)((const bf16_t*)(P.ws + WS_MO) + (size_t)r * D) + lane; const u32x2* m1 = (const u32x2*)((const bf16_t*)(P.ws + WS_MO) + (size_t)(R + r) * D) + lane;
#pragma unroll
                for (int j = 0; j < 4; ++j) { const u32x2 a = m0[64 * j], b = m1[64 * j]; const f32x4 g = g2[64 * j];
                    v[q][j].x += g.x * (lo16(a.x) + lo16(b.x)); v[q][j].y += g.y * (hi16(a.x) + hi16(b.x)); v[q][j].z += g.z * (lo16(a.y) + lo16(b.y)); v[q][j].w += g.w * (hi16(a.y) + hi16(b.y)); } }
#pragma unroll
            for (int q = 0; q < NRW; ++q) if (q == 0 || rr[q] != rr[0]) { bf16_t* xr = x1b_row(P, rr[q]) + 4 * lane;
#pragma unroll
                for (int j = 0; j < 4; ++j) st4b(xr + 256 * j, v[q][j]); }
        }
        float ss[NRW];
#pragma unroll
        for (int q = 0; q < NRW; ++q) { ss[q] = 0.f;
#pragma unroll
            for (int j = 0; j < 4; ++j) ss[q] += (v[q][j].x * v[q][j].x + v[q][j].y * v[q][j].y) + (v[q][j].z * v[q][j].z + v[q][j].w * v[q][j].w); }
#pragma unroll
        for (int o = 1; o < 64; o <<= 1) {
#pragma unroll
            for (int q = 0; q < NRW; ++q) ss[q] += shfl_xor_l(ss[q], o, lane); }
        const f32x4* gn = (const f32x4*)((MODE == 2 ? P.norm2 : P.norm1) + (size_t)l * D) + lane;
#pragma unroll
        for (int q = 0; q < NRW; ++q) { const int r = rr[q]; const int bb = row_bb(r);
            if (q > 0 && r == rr[0]) continue;
            const float rstd = 1.0f / sqrtf(ss[q] * (1.0f / D) + EPS);
            const f32x4* sh = (const f32x4*)mod_vec(P, l, bb, MODE == 2 ? 3 : 0) + lane;
            const f32x4* sc = (const f32x4*)mod_vec(P, l, bb, MODE == 2 ? 4 : 1) + lane;
            {
                float mx = 0.f;
#pragma unroll
                for (int j = 0; j < 4; ++j) { const f32x4 g = gn[64 * j], a = sh[64 * j], b = sc[64 * j];
                    v[q][j] = (v[q][j] * rstd * g) * (b + 1.0f) + a;
                    mx = fmaxf(mx, fmaxf(fmaxf(fabsf(v[q][j].x), fabsf(v[q][j].y)), fmaxf(fabsf(v[q][j].z), fabsf(v[q][j].w)))); }
#pragma unroll
                for (int o = 1; o < 64; o <<= 1) mx = fmaxf(mx, shfl_xor_l(mx, o, lane));
                const float inv = mx > 0.f ? 127.0f / mx : 0.f;
                unsigned* o8 = (unsigned*)(P.ws + WS_H + (size_t)r * D) + lane;
#pragma unroll
                for (int j = 0; j < 4; ++j) o8[64 * j] = q8x4(v[q][j].x, v[q][j].y, v[q][j].z, v[q][j].w, inv);
                if (lane == 0) ((float*)(P.ws + WS_SA))[r] = mx * (1.0f / 127.0f); } }
        if (MODE == 2) { LAS int* rec = recs + (F.wave * 24 + 2 * it) * 8;
            route_row(P, rr[0], v[0], lane, true, lcnt, rec, rwl); __builtin_amdgcn_sched_barrier(0);
            if (lane == 0 && rr[1] == rr[0]) rec[8] = -1;
            route_row(P, rr[1], v[1], lane, rr[1] != rr[0], lcnt, rec + 8, rwl); }
    }
    if (MODE == 2) {
        __syncthreads();
        const int tid = F.wave * 64 + lane;
        if (tid < 16) { const unsigned c = lcnt[tid]; gbase[tid] = c ? atomicAdd((unsigned*)(P.ws + WS_CTL) + CW_CNT + 1024 * l + 64 * tid, c) : 0u; }
        __syncthreads();
        if (lane == 0) for (int k = 0; k < 2 * it; ++k) { const LAS int* rec = recs + (F.wave * 24 + k) * 8; const int r = rec[0]; if (r < 0) continue;
            int* tokl = (int*)(P.ws + WS_TOKL); float* wl = (float*)(P.ws + WS_WL);
            const size_t i0 = (size_t)rec[1] * R + rec[2] + gbase[rec[1]], i1 = (size_t)rec[3] * R + rec[4] + gbase[rec[3]];
            tokl[i0] = 2 * r; wl[i0] = __int_as_float(rec[5]); tokl[i1] = 2 * r + 1; wl[i1] = __int_as_float(rec[6]); }
        __syncthreads();
    }
}
__device__ __forceinline__ void ph_norm2(const Frame& F, const Ptrs& P, int l, int nrows) {
    constexpr int AP = 2064, A_H = 8192, A_L = A_H + 16 * AP, PART = A_L + 16 * AP, LG = PART + 8192;
    const int lane = fresh_lane();
    LAS unsigned* lcnt = (LAS unsigned*)F.lds; LAS unsigned* gbase = lcnt + 16; LAS int* recs = (LAS int*)(F.lds + 256);
    if (F.wave == 0 && lane < 16) lcnt[lane] = 0u;
    bf16x8 bh[4], bl[4];
    { const float* rw = P.router_w + (size_t)(128 * F.wave + 8 * (lane >> 4)) * 16 + (lane & 15);
#pragma unroll
      for (int s = 0; s < 4; ++s) { float w[8];
#pragma unroll
          for (int j = 0; j < 8; ++j) w[j] = rw[(size_t)(32 * s + j) * 16];
          u32x4 h, lo; h.x = cvtpk(w[0], w[1]); h.y = cvtpk(w[2], w[3]); h.z = cvtpk(w[4], w[5]); h.w = cvtpk(w[6], w[7]);
          lo.x = cvtpk(w[0] - lo16(h.x), w[1] - hi16(h.x)); lo.y = cvtpk(w[2] - lo16(h.y), w[3] - hi16(h.y)); lo.z = cvtpk(w[4] - lo16(h.z), w[5] - hi16(h.z)); lo.w = cvtpk(w[6] - lo16(h.w), w[7] - hi16(h.w));
          bh[s] = __builtin_bit_cast(bf16x8, h); bl[s] = __builtin_bit_cast(bf16x8, lo); } }
    __syncthreads();
    const int ntiles = nrows >> 4;
    f32x4 v[2][4];
    u32x2 ra[2][4], rb[2][4];
#define N2_LOAD(tile_, RW) do { _Pragma("unroll") for (int q_ = 0; q_ < 2; ++q_) { const bf16_t* xr_ = x1b_row(P, (tile_) * 16 + 2 * F.wave + q_) + 4 * lane; \
        _Pragma("unroll") for (int j_ = 0; j_ < 4; ++j_) RW[q_][j_] = *(const u32x2*)(xr_ + 256 * j_); } } while (0)
#define N2_BAR() do { LDS_WAIT(); __builtin_amdgcn_s_barrier(); asm volatile("" ::: "memory"); } while (0)
    int tile = F.vcu, it = 0;
    if (tile < ntiles) N2_LOAD(tile, ra);
    if (tile + F.G < ntiles) N2_LOAD(tile + F.G, rb);
    for (; tile < ntiles; tile += F.G, ++it) {
#pragma unroll
        for (int q = 0; q < 2; ++q)
#pragma unroll
            for (int j = 0; j < 4; ++j) { const u32x2 w = ra[q][j]; v[q][j] = (f32x4){lo16(w.x), hi16(w.x), lo16(w.y), hi16(w.y)}; ra[q][j] = rb[q][j]; }
        { const int tn = tile + 2 * F.G; if (tn < ntiles) N2_LOAD(tn, rb); }
        const int rbase = tile * 16 + 2 * F.wave;
        float ss[2];
#pragma unroll
        for (int q = 0; q < 2; ++q) { ss[q] = 0.f;
#pragma unroll
            for (int j = 0; j < 4; ++j) ss[q] += (v[q][j].x * v[q][j].x + v[q][j].y * v[q][j].y) + (v[q][j].z * v[q][j].z + v[q][j].w * v[q][j].w); }
#pragma unroll
        for (int o = 1; o < 64; o <<= 1) { ss[0] += shfl_xor_l(ss[0], o, lane); ss[1] += shfl_xor_l(ss[1], o, lane); }
        const f32x4* gn = (const f32x4*)(P.norm2 + (size_t)l * D) + lane;
#pragma unroll
        for (int q = 0; q < 2; ++q) { const int r = rbase + q; const int bb = row_bb(r);
            const float rstd = 1.0f / sqrtf(ss[q] * (1.0f / D) + EPS);
            const f32x4* sh = (const f32x4*)mod_vec(P, l, bb, 3) + lane; const f32x4* sc = (const f32x4*)mod_vec(P, l, bb, 4) + lane;
            float mx = 0.f;
#pragma unroll
            for (int j = 0; j < 4; ++j) { const f32x4 g = gn[64 * j], a = sh[64 * j], b = sc[64 * j];
                v[q][j] = (v[q][j] * rstd * g) * (b + 1.0f) + a;
                mx = fmaxf(mx, fmaxf(fmaxf(fabsf(v[q][j].x), fabsf(v[q][j].y)), fmaxf(fabsf(v[q][j].z), fabsf(v[q][j].w)))); }
#pragma unroll
            for (int o = 1; o < 64; o <<= 1) mx = fmaxf(mx, shfl_xor_l(mx, o, lane));
            const float inv = mx > 0.f ? 127.0f / mx : 0.f;
            unsigned* o8 = (unsigned*)(P.ws + WS_H + (size_t)r * D) + lane;
            LAS unsigned char* ah = F.lds + A_H + (2 * F.wave + q) * AP + 8 * lane;
#pragma unroll
            for (int j = 0; j < 4; ++j) { const f32x4 x = v[q][j]; o8[64 * j] = q8x4(x.x, x.y, x.z, x.w, inv);
                u32x2 h, lo; h.x = cvtpk(x.x, x.y); h.y = cvtpk(x.z, x.w); lo.x = cvtpk(x.x - lo16(h.x), x.y - hi16(h.x)); lo.y = cvtpk(x.z - lo16(h.y), x.w - hi16(h.y));
                *(LAS u32x2*)(ah + 512 * j) = h; *(LAS u32x2*)(ah + (A_L - A_H) + 512 * j) = lo; }
            if (lane == 0) ((float*)(P.ws + WS_SA))[r] = mx * (1.0f / 127.0f); }
        N2_BAR();
        f32x4 acc = (f32x4){0.f, 0.f, 0.f, 0.f};
        { const LAS unsigned char* ap = F.lds + A_H + (lane & 15) * AP + (128 * F.wave + 8 * (lane >> 4)) * 2;
#pragma unroll
          for (int s = 0; s < 4; ++s) { const bf16x8 xh = *(const LAS bf16x8*)(ap + 64 * s), xl = *(const LAS bf16x8*)(ap + (A_L - A_H) + 64 * s);
              acc = __builtin_amdgcn_mfma_f32_16x16x32_bf16(xh, bh[s], acc, 0, 0, 0); acc = __builtin_amdgcn_mfma_f32_16x16x32_bf16(xl, bh[s], acc, 0, 0, 0); acc = __builtin_amdgcn_mfma_f32_16x16x32_bf16(xh, bl[s], acc, 0, 0, 0); } }
        *(LAS f32x4*)(F.lds + PART + F.wave * 1024 + lane * 16) = acc;
        N2_BAR();
        if (F.wave < 4) { const int t = F.wave * 64 + lane, i = t >> 4, j = t & 15; const LAS float* sp = (const LAS float*)(F.lds + PART) + ((i >> 2) * 16 + j) * 4 + (i & 3); float sum = 0.f;
#pragma unroll
            for (int w = 0; w < 8; ++w) sum += sp[w * 256];
            ((LAS float*)(F.lds + LG))[t] = sum; }
        N2_BAR();
        { const int ri = 2 * F.wave + (lane >> 5), r = tile * 16 + ri;
          f32x4 L[4];
#pragma unroll
          for (int g = 0; g < 4; ++g) L[g] = *(const LAS f32x4*)(F.lds + LG + ri * 64 + 16 * g);
          float bestscore = -INFINITY; int be0 = 0, be1 = 1; float ba0 = 0.f, ba1 = 0.f;
#pragma unroll
          for (int g = 0; g < 4; ++g) {
              float aff[4], sel[4];
#pragma unroll
              for (int i = 0; i < 4; ++i) { const float t = L[g][i]; aff[i] = __builtin_amdgcn_rcpf(1.0f + __builtin_amdgcn_exp2f(-1.4426950408889634f * t)); sel[i] = aff[i] + P.router_bias[4 * g + i]; }
              int i1 = 0; float m1 = sel[0], a1 = aff[0];
#pragma unroll
              for (int i = 1; i < 4; ++i) if (sel[i] > m1) { m1 = sel[i]; a1 = aff[i]; i1 = i; }
              int i2 = -1; float m2 = -INFINITY, a2 = 0.f;
#pragma unroll
              for (int i = 0; i < 4; ++i) if (i != i1 && sel[i] > m2) { m2 = sel[i]; a2 = aff[i]; i2 = i; }
              const float score = m1 + m2;
              if (score > bestscore) { bestscore = score; be0 = 4 * g + i1; be1 = 4 * g + i2; ba0 = a1; ba1 = a2; }
          }
          if ((lane & 31) == 0) {
              const int p0 = (int)__hip_atomic_fetch_add(lcnt + be0, 1u, __ATOMIC_RELAXED, __HIP_MEMORY_SCOPE_WORKGROUP), p1 = (int)__hip_atomic_fetch_add(lcnt + be1, 1u, __ATOMIC_RELAXED, __HIP_MEMORY_SCOPE_WORKGROUP);
              const float inv = 1.0f / (ba0 + ba1); LAS int* rec = recs + (it * 16 + ri) * 8;
              rec[0] = r; rec[1] = be0; rec[2] = p0; rec[3] = be1; rec[4] = p1; rec[5] = __float_as_int(ba0 * inv); rec[6] = __float_as_int(ba1 * inv); } }
    }
#undef N2_LOAD
#undef N2_BAR
    __syncthreads();
    const int tid = F.wave * 64 + lane;
    if (tid < 16) { const unsigned c = lcnt[tid]; gbase[tid] = c ? atomicAdd((unsigned*)(P.ws + WS_CTL) + CW_CNT + 1024 * l + 64 * tid, c) : 0u; }
    __syncthreads();
    for (int k = tid; k < it * 16; k += NWAVES * 64) { const LAS int* rec = recs + k * 8; const int r = rec[0];
        int* tokl = (int*)(P.ws + WS_TOKL); float* wl = (float*)(P.ws + WS_WL);
        const size_t i0 = (size_t)rec[1] * R + rec[2] + gbase[rec[1]], i1 = (size_t)rec[3] * R + rec[4] + gbase[rec[3]];
        tokl[i0] = 2 * r; wl[i0] = __int_as_float(rec[5]); tokl[i1] = 2 * r + 1; wl[i1] = __int_as_float(rec[6]); }
    __syncthreads();
}
__device__ __forceinline__ void ph_kprep(const Frame& F, const Ptrs& P, int l) {
    const int lane = fresh_lane();
    const float* rc = (const float*)(P.ws + WS_ROPE); const float* rs = rc + 1024;
    const int hs = (lane >> 3) & 3, chunk = lane & 7, col = (hs < 2 ? C_KB + hs * 64 : C_KW + (hs - 2) * 64) + chunk * 8;
    const f32x4 g0 = *(const f32x4*)(P.k_gain + l * 64 + chunk * 8), g1 = *(const f32x4*)(P.k_gain + l * 64 + chunk * 8 + 4);
    const int a = chunk >> 2, fi = (chunk & 1) * 8; const bool second = (chunk & 2) != 0;
    const int npair = R / 2, stride = F.G * NWAVES;
    float km = 0.f;
    for (int pr0 = F.vcu * NWAVES + F.wave; pr0 < npair; pr0 += 4 * stride) {
        u32x4 w[4];
#pragma unroll
        for (int q = 0; q < 4; ++q) { const int pr = pr0 + q * stride; const int r = 2 * (pr < npair ? pr : pr0) + (lane >> 5); w[q] = *(const u32x4*)((const bf16_t*)(P.ws + WS_U) + (size_t)r * NIN + col); }
#pragma unroll
        for (int q = 0; q < 4; ++q) { const int pr = pr0 + q * stride; if (pr >= npair) break;
            const int r = 2 * pr + (lane >> 5);
            float x[8] = {lo16(w[q].x), hi16(w[q].x), lo16(w[q].y), hi16(w[q].y), lo16(w[q].z), hi16(w[q].z), lo16(w[q].w), hi16(w[q].w)};
            float ss = 0.f;
#pragma unroll
            for (int j = 0; j < 8; ++j) ss += x[j] * x[j];
            ss += shfl_xor_l(ss, 1, lane); ss += shfl_xor_l(ss, 2, lane); ss += shfl_xor_l(ss, 4, lane);
            if (hs >= 2) km = fmaxf(km, ss);
            if (hs < 2) {
                const float rstd = 1.0f / sqrtf(ss * (1.0f / 64.0f) + EPS);
                x[0] *= rstd * g0.x; x[1] *= rstd * g0.y; x[2] *= rstd * g0.z; x[3] *= rstd * g0.w; x[4] *= rstd * g1.x; x[5] *= rstd * g1.y; x[6] *= rstd * g1.z; x[7] *= rstd * g1.w; }
            if (r < RL) { const int t = r & (T - 1), pos = a ? (t & 63) : (t >> 6);
                const f32x4 c0 = *(const f32x4*)(rc + pos * 16 + fi), c1 = *(const f32x4*)(rc + pos * 16 + fi + 4), s0 = *(const f32x4*)(rs + pos * 16 + fi), s1 = *(const f32x4*)(rs + pos * 16 + fi + 4);
                const float cs[8] = {c0.x, c0.y, c0.z, c0.w, c1.x, c1.y, c1.z, c1.w}, sn[8] = {s0.x, s0.y, s0.z, s0.w, s1.x, s1.y, s1.z, s1.w};
#pragma unroll
                for (int j = 0; j < 8; ++j) { const float y = shfl_xor_l(x[j], 2, lane); x[j] = second ? x[j] * cs[j] + y * sn[j] : x[j] * cs[j] - y * sn[j]; } }
            u32x4 o; o.x = cvtpk(x[0], x[1]); o.y = cvtpk(x[2], x[3]); o.z = cvtpk(x[4], x[5]); o.w = cvtpk(x[6], x[7]);
            *(u32x4*)((bf16_t*)(P.ws + WS_U) + (size_t)r * NIN + col) = o; }
    }
    float qm = 0.f;
    for (int r0 = F.vcu * NWAVES + F.wave; r0 < RL; r0 += 8 * stride) {
        u32x4 w[8];
#pragma unroll
        for (int q = 0; q < 8; ++q) { const int r = r0 + q * stride < RL ? r0 + q * stride : r0; w[q] = *(const u32x4*)((const bf16_t*)(P.ws + WS_U) + (size_t)r * NIN + C_QW + lane * 8); }
#pragma unroll
        for (int q = 0; q < 8; ++q) { float ss = lo16(w[q].x) * lo16(w[q].x) + hi16(w[q].x) * hi16(w[q].x) + lo16(w[q].y) * lo16(w[q].y) + hi16(w[q].y) * hi16(w[q].y)
                                              + lo16(w[q].z) * lo16(w[q].z) + hi16(w[q].z) * hi16(w[q].z) + lo16(w[q].w) * lo16(w[q].w) + hi16(w[q].w) * hi16(w[q].w);
            ss += shfl_xor_l(ss, 1, lane); ss += shfl_xor_l(ss, 2, lane); ss += shfl_xor_l(ss, 4, lane); qm = fmaxf(qm, ss); }
    }
    qm = fmaxf(qm, shfl_xor_l(qm, 8, lane)); qm = fmaxf(qm, shfl_xor_l(qm, 16, lane));
    km = fmaxf(km, shfl_xor_l(km, 32, lane));
    LAS float* red = (LAS float*)F.lds;
    if (lane == 0) red[F.wave * 4] = qm; if (lane == 32) red[F.wave * 4 + 1] = qm; if (lane == 16) red[F.wave * 4 + 2] = km; if (lane == 24) red[F.wave * 4 + 3] = km;
    __syncthreads();
    if (F.wave == 0 && lane < 4) { float m = red[lane];
#pragma unroll
        for (int wv = 1; wv < 8; ++wv) m = fmaxf(m, red[wv * 4 + lane]);
        atomicMax((unsigned*)(P.ws + WS_CTL) + CW_QK + 64 * l + 16 * lane, __float_as_uint(m)); }
    __syncthreads();
}
__device__ __forceinline__ float pool_ch(const u32x2& w, int c) { const unsigned x = w[c >> 1]; return (c & 1) ? hi16(x) : lo16(x); }
template <int HW> __device__ __forceinline__ void pool_block(const u32x2 (&w)[32], int t0, int Ts, bf16_t* outp) {
    float S[4];
#pragma unroll
    for (int c = 0; c < 4; ++c) { S[c] = 0.f;
#pragma unroll
        for (int k = 8 - HW; k < 8 + HW; ++k) S[c] += pool_ch(w[k], c); }
#pragma unroll
    for (int j = 0; j < 16; ++j) {
        const int t = t0 + j, lo = t - HW < 0 ? 0 : t - HW, hi = t + HW > Ts ? Ts : t + HW; const float inv = 1.0f / (float)(hi - lo);
        float o[4];
#pragma unroll
        for (int c = 0; c < 4; ++c) o[c] = S[c] * inv - pool_ch(w[j + 8], c);
        u32x2 ow; ow.x = cvtpk(o[0], o[1]); ow.y = cvtpk(o[2], o[3]);
        *(u32x2*)(outp + (size_t)j * NBR) = ow;
        if (j < 15) {
#pragma unroll
            for (int c = 0; c < 4; ++c) S[c] += pool_ch(w[j + 8 + HW], c) - pool_ch(w[j + 8 - HW], c); }
    }
}
__device__ __forceinline__ void ph_pool(const Frame& F, const Ptrs& P, int nrows) {
    const int tid0 = fresh_tid();
    const int nblk = nrows >> 4, nit = nblk * 128;
    for (int i = F.vcu * 512 + tid0; i < nit; i += F.G * 512) {
        const int g = __builtin_amdgcn_readfirstlane((i >> 5) / nblk), blk = (i >> 5) - g * nblk, c4 = g * 128 + (i & 31) * 4;
        const int rb = blk * 16; const bool lat = rb < RL; const int Ts = lat ? T : TC; const int t0 = lat ? (rb & (T - 1)) : ((rb - RL) & (TC - 1)); const int r0 = rb - t0;
        const bf16_t* U = (const bf16_t*)(P.ws + WS_U) + C_P + c4;
        u32x2 w[32];
#pragma unroll
        for (int k = 0; k < 32; ++k) { const int tt = t0 - 8 + k; const bool ok = tt >= 0 && tt < Ts; w[k] = *(const u32x2*)(U + (size_t)(r0 + (ok ? tt : t0)) * NIN); }
#pragma unroll
        for (int k = 0; k < 32; ++k) { const int tt = t0 - 8 + k; if (!(tt >= 0 && tt < Ts)) w[k] = (u32x2){0u, 0u}; }
        bf16_t* outp = (bf16_t*)(P.ws + WS_BR) + (size_t)rb * NBR + 1536 + c4;
        if (g == 0) pool_block<1>(w, t0, Ts, outp); else if (g == 1) pool_block<2>(w, t0, Ts, outp); else if (g == 2) pool_block<4>(w, t0, Ts, outp); else pool_block<8>(w, t0, Ts, outp);
    }
}
__device__ __forceinline__ void ph_final(const Frame& F, const Ptrs& P, const int r_lo, const int RLh) {
    const int lane = fresh_lane(); const int stride = F.G * NWAVES;
    for (int rb = r_lo + F.vcu * NWAVES + F.wave; rb < RLh; rb += 4 * stride) {
        f32x4 v[4][4]; float ss[4];
#pragma unroll
        for (int q = 0; q < 4; ++q) { const int r = rb + q * stride < RLh ? rb + q * stride : rb; const int bb = row_bb(r);
            const bf16_t* xr = x1b_row(P, r) + 4 * lane; const f32x4* g2 = (const f32x4*)mod_vec(P, 1, bb, 5) + lane;
            const u32x2* m0 = (const u32x2*)((const bf16_t*)(P.ws + WS_MO) + (size_t)r * D) + lane; const u32x2* m1 = (const u32x2*)((const bf16_t*)(P.ws + WS_MO) + (size_t)(R + r) * D) + lane;
            ss[q] = 0.f;
#pragma unroll
            for (int j = 0; j < 4; ++j) { v[q][j] = ld4b(xr + 256 * j); const u32x2 a = m0[64 * j], b = m1[64 * j]; const f32x4 g = g2[64 * j];
                v[q][j].x += g.x * (lo16(a.x) + lo16(b.x)); v[q][j].y += g.y * (hi16(a.x) + hi16(b.x)); v[q][j].z += g.z * (lo16(a.y) + lo16(b.y)); v[q][j].w += g.w * (hi16(a.y) + hi16(b.y));
                ss[q] += (v[q][j].x * v[q][j].x + v[q][j].y * v[q][j].y) + (v[q][j].z * v[q][j].z + v[q][j].w * v[q][j].w); } }
#pragma unroll
        for (int o = 1; o < 64; o <<= 1) {
#pragma unroll
            for (int q = 0; q < 4; ++q) ss[q] += shfl_xor_l(ss[q], o, lane); }
        const f32x4* gn = (const f32x4*)P.norm_f + lane;
#pragma unroll
        for (int q = 0; q < 4; ++q) { const int r = rb + q * stride; if (r >= RLh) continue;
            const float rstd = 1.0f / sqrtf(ss[q] * (1.0f / D) + EPS); f32x4* xr = (f32x4*)(P.out + (size_t)r * D) + lane;
#pragma unroll
            for (int j = 0; j < 4; ++j) xr[64 * j] = v[q][j] * rstd * gn[64 * j]; }
    }
}

typedef float f32x16 __attribute__((ext_vector_type(16)));
typedef short v4i16_t __attribute__((ext_vector_type(4)));
constexpr float ATT_THR = 4.0f;
constexpr int AT_ROWB = 144, AT_TILEB = 64 * AT_ROWB;
constexpr int AT_VROWB = 192, AT_VTILEB = 64 * AT_VROWB;
constexpr int AT_STAGEB = 2 * AT_TILEB + 2 * AT_VTILEB;
#define AT_SB() __builtin_amdgcn_sched_barrier(0)
template <bool FIXED> __device__ __forceinline__ void at_qk1(const LAS unsigned char* Kt, int kf_off, const bf16x8 (&qr)[4], const f32x16& negm_, f32x16& p0, f32x16& p1) {
    f32x16 zc;
#pragma unroll
    for (int r = 0; r < 16; ++r) zc[r] = 0.f;
    const f32x16& negm = FIXED ? zc : negm_;
    bf16x8 ka[8];
#pragma unroll
    for (int d0 = 0; d0 < 4; ++d0) { ka[2 * d0] = *(const LAS bf16x8*)(Kt + kf_off + d0 * 32); ka[2 * d0 + 1] = *(const LAS bf16x8*)(Kt + kf_off + 32 * AT_ROWB + d0 * 32); }
    p0 = __builtin_amdgcn_mfma_f32_32x32x16_bf16(ka[0], qr[0], negm, 0, 0, 0); p1 = __builtin_amdgcn_mfma_f32_32x32x16_bf16(ka[1], qr[0], negm, 0, 0, 0);
#pragma unroll
    for (int d0 = 1; d0 < 4; ++d0) { p0 = __builtin_amdgcn_mfma_f32_32x32x16_bf16(ka[2 * d0], qr[d0], p0, 0, 0, 0); p1 = __builtin_amdgcn_mfma_f32_32x32x16_bf16(ka[2 * d0 + 1], qr[d0], p1, 0, 0, 0); }
}
__device__ __forceinline__ void at_vread(const LAS unsigned char* vp, v4i16_t (&f)[4]) {
    f[0] = __builtin_amdgcn_ds_read_tr16_b64_v4i16((LAS v4i16_t*)(vp)); f[1] = __builtin_amdgcn_ds_read_tr16_b64_v4i16((LAS v4i16_t*)(vp + 8 * AT_VROWB));
    f[2] = __builtin_amdgcn_ds_read_tr16_b64_v4i16((LAS v4i16_t*)(vp + 64)); f[3] = __builtin_amdgcn_ds_read_tr16_b64_v4i16((LAS v4i16_t*)(vp + 8 * AT_VROWB + 64));
}
__device__ __forceinline__ bf16x8 at_ppack(const f32x16& p, int sx) { u32x4 pw; pw.x = cvtpk(p[8 * sx], p[8 * sx + 1]); pw.y = cvtpk(p[8 * sx + 2], p[8 * sx + 3]); pw.z = cvtpk(p[8 * sx + 4], p[8 * sx + 5]); pw.w = cvtpk(p[8 * sx + 6], p[8 * sx + 7]); return __builtin_bit_cast(bf16x8, pw); }
__device__ __forceinline__ void at_pvmm(const v4i16_t (&f)[4], const bf16x8 pf, f32x16& o0, f32x16& o1) {
    const bf16x8 v0 = (bf16x8){f[0][0], f[0][1], f[0][2], f[0][3], f[1][0], f[1][1], f[1][2], f[1][3]}, v1 = (bf16x8){f[2][0], f[2][1], f[2][2], f[2][3], f[3][0], f[3][1], f[3][2], f[3][3]};
    o0 = __builtin_amdgcn_mfma_f32_32x32x16_bf16(v0, pf, o0, 0, 0, 0); o1 = __builtin_amdgcn_mfma_f32_32x32x16_bf16(v1, pf, o1, 0, 0, 0);
}
__device__ __forceinline__ float at_exp8(f32x16& p, int sx) { float rs = 0.f;
#pragma unroll
    for (int j = 0; j < 8; ++j) { p[8 * sx + j] = __builtin_amdgcn_exp2f(p[8 * sx + j]); rs += p[8 * sx + j]; }
    return rs; }
template <bool FIXED> __device__ __forceinline__ float at_slot(const LAS unsigned char* Vt, const LAS unsigned char* Kn, const bool hasnext, int kf_off, int vf_off, const bf16x8 (&qr)[4], const f32x16& negm_,
                                         f32x16& pc0, f32x16& pc1, f32x16& pn0, f32x16& pn1, f32x16& o0, f32x16& o1) {
    f32x16 zc;
#pragma unroll
    for (int r = 0; r < 16; ++r) zc[r] = 0.f;
    const f32x16& negm = FIXED ? zc : negm_;
    v4i16_t fA[4], fB[4]; bf16x8 ka0, ka1, kb0, kb1; float rs;
#define AT_KLD(A0, A1, d0) do { A0 = *(const LAS bf16x8*)(Kn + kf_off + (d0) * 32); A1 = *(const LAS bf16x8*)(Kn + kf_off + 32 * AT_ROWB + (d0) * 32); } while (0)
    if (FIXED) AT_KLD(ka0, ka1, 0);
    at_vread(Vt + vf_off, fA); rs = at_exp8(pc0, 0); AT_SB();
    at_vread(Vt + vf_off + 16 * AT_VROWB, fB); if (FIXED) AT_KLD(kb0, kb1, 1); else AT_KLD(ka0, ka1, 0);
    if (hasnext) { pn0 = __builtin_amdgcn_mfma_f32_32x32x16_bf16(ka0, qr[0], negm, 0, 0, 0); pn1 = __builtin_amdgcn_mfma_f32_32x32x16_bf16(ka1, qr[0], negm, 0, 0, 0); }
    at_pvmm(fA, at_ppack(pc0, 0), o0, o1); rs += at_exp8(pc0, 1); AT_SB();
    at_vread(Vt + vf_off + 32 * AT_VROWB, fA); if (FIXED) AT_KLD(ka0, ka1, 2); else AT_KLD(kb0, kb1, 1);
    if (hasnext) { pn0 = __builtin_amdgcn_mfma_f32_32x32x16_bf16(kb0, qr[1], pn0, 0, 0, 0); pn1 = __builtin_amdgcn_mfma_f32_32x32x16_bf16(kb1, qr[1], pn1, 0, 0, 0); }
    at_pvmm(fB, at_ppack(pc0, 1), o0, o1); rs += at_exp8(pc1, 0); AT_SB();
    at_vread(Vt + vf_off + 48 * AT_VROWB, fB); if (FIXED) AT_KLD(kb0, kb1, 3); else AT_KLD(ka0, ka1, 2);
    if (hasnext) { pn0 = __builtin_amdgcn_mfma_f32_32x32x16_bf16(ka0, qr[2], pn0, 0, 0, 0); pn1 = __builtin_amdgcn_mfma_f32_32x32x16_bf16(ka1, qr[2], pn1, 0, 0, 0); }
    at_pvmm(fA, at_ppack(pc1, 0), o0, o1); rs += at_exp8(pc1, 1); AT_SB();
    if (!FIXED) AT_KLD(kb0, kb1, 3);
    if (hasnext) { pn0 = __builtin_amdgcn_mfma_f32_32x32x16_bf16(kb0, qr[3], pn0, 0, 0, 0); pn1 = __builtin_amdgcn_mfma_f32_32x32x16_bf16(kb1, qr[3], pn1, 0, 0, 0); }
    at_pvmm(fB, at_ppack(pc1, 1), o0, o1);
#undef AT_KLD
    return rs;
}
template <int MODE, bool FIXED> __device__ __forceinline__ void ph_attn_impl(const Frame& F, const Ptrs& P, int l) {
    const bool latq = MODE < 2; const bool winm = (MODE == 1 || MODE == 3);
    const int NU = latq ? 1024 : 64;
    LAS unsigned char* Lb = F.lds;
    constexpr bool fixedref = FIXED;
    for (int u = F.vcu; u < NU; u += F.G) {
        const int lane = fresh_lane(), tid = F.wave * 64 + lane, r32 = lane & 31, hi = lane >> 5;
        const bf16_t* U = (const bf16_t*)(P.ws + WS_U);
        const int st_off = (tid >> 3) * AT_ROWB + (tid & 7) * 16;
        const int kf_off = r32 * AT_ROWB + hi * 16;
        const int sv_off = (tid >> 3) * AT_VROWB + (tid & 7) * 16;
        const int vf_off = (4 * hi + ((lane & 15) >> 2)) * AT_VROWB + (((lane >> 4) & 1) * 16 + (lane & 3) * 4) * 2;
        const int qb = latq ? (u & 63) : (u & 3), g = latq ? ((u >> 6) & 1) : ((u >> 2) & 1), b = latq ? (u >> 7) : (u >> 3);
        const int tq0 = qb * 64, hq = 4 * g + (F.wave >> 1), tq = tq0 + 32 * (F.wave & 1) + r32;
        const int qrow = latq ? b * T + tq : RL + b * TC + tq;
        const int qcol = (winm ? C_QW : C_QB) + hq * 64, kcol = (winm ? C_KW : C_KB) + g * 64, vcol = (winm ? C_VW : C_VB) + g * 64;
        int lt_lo = 0, lt_hi = 0;
        if (MODE == 0) { lt_lo = 0; lt_hi = T / 64; }
        if (MODE == 1) { lt_lo = (tq0 - 128 < 0 ? 0 : tq0 - 128) / 64; lt_hi = (tq0 + 192 > T ? T : tq0 + 192) / 64; }
        const int ntiles = 4 + (lt_hi - lt_lo), npairs = (ntiles + 1) >> 1;
        bf16x8 qr[4];
        {
            float x[4][8];
#pragma unroll
            for (int d0 = 0; d0 < 4; ++d0) { const u32x4 wq = *(const u32x4*)(U + (size_t)qrow * NIN + qcol + d0 * 16 + hi * 8);
                x[d0][0] = lo16(wq.x); x[d0][1] = hi16(wq.x); x[d0][2] = lo16(wq.y); x[d0][3] = hi16(wq.y); x[d0][4] = lo16(wq.z); x[d0][5] = hi16(wq.z); x[d0][6] = lo16(wq.w); x[d0][7] = hi16(wq.w); }
            if (!winm) { float ss = 0.f;
#pragma unroll
                for (int d0 = 0; d0 < 4; ++d0)
#pragma unroll
                    for (int j = 0; j < 8; ++j) ss += x[d0][j] * x[d0][j];
                ss += shfl_xor_l(ss, 32, lane);
                const float rstd = 1.0f / sqrtf(ss * (1.0f / 64.0f) + EPS);
#pragma unroll
                for (int d0 = 0; d0 < 4; ++d0) { const f32x4 ga = *(const f32x4*)(P.q_gain + l * 64 + d0 * 16 + hi * 8), gb = *(const f32x4*)(P.q_gain + l * 64 + d0 * 16 + hi * 8 + 4);
                    x[d0][0] *= rstd * ga.x; x[d0][1] *= rstd * ga.y; x[d0][2] *= rstd * ga.z; x[d0][3] *= rstd * ga.w; x[d0][4] *= rstd * gb.x; x[d0][5] *= rstd * gb.y; x[d0][6] *= rstd * gb.z; x[d0][7] *= rstd * gb.w; } }
            if (latq) { const float* rc = (const float*)(P.ws + WS_ROPE); const float* rs = rc + 1024;
#pragma unroll
                for (int a = 0; a < 2; ++a) { const int pos = a ? (tq & 63) : (tq >> 6);
                    const f32x4 c0 = *(const f32x4*)(rc + pos * 16 + hi * 8), c1 = *(const f32x4*)(rc + pos * 16 + hi * 8 + 4), s0 = *(const f32x4*)(rs + pos * 16 + hi * 8), s1 = *(const f32x4*)(rs + pos * 16 + hi * 8 + 4);
                    const float cs[8] = {c0.x, c0.y, c0.z, c0.w, c1.x, c1.y, c1.z, c1.w}, sn[8] = {s0.x, s0.y, s0.z, s0.w, s1.x, s1.y, s1.z, s1.w};
#pragma unroll
                    for (int j = 0; j < 8; ++j) { const float x1 = x[2 * a][j], x2 = x[2 * a + 1][j]; x[2 * a][j] = x1 * cs[j] - x2 * sn[j]; x[2 * a + 1][j] = x2 * cs[j] + x1 * sn[j]; } } }
#pragma unroll
            for (int d0 = 0; d0 < 4; ++d0) { u32x4 wq; wq.x = cvtpk(x[d0][0] * QSCALE, x[d0][1] * QSCALE); wq.y = cvtpk(x[d0][2] * QSCALE, x[d0][3] * QSCALE); wq.z = cvtpk(x[d0][4] * QSCALE, x[d0][5] * QSCALE); wq.w = cvtpk(x[d0][6] * QSCALE, x[d0][7] * QSCALE);
                qr[d0] = __builtin_bit_cast(bf16x8, wq); }
        }
        f32x16 o0, o1, negm;
#pragma unroll
        for (int r = 0; r < 16; ++r) { o0[r] = 0.f; o1[r] = 0.f; negm[r] = 0.f; }
        float mhat = 0.f, lsum = 0.f;
#define AT_KROW(ti) ((ti) < 4 ? RL + b * TC + (ti) * 64 : b * T + (lt_lo + (ti) - 4) * 64)
        u32x4 ka, va, kb2, vb2;
#define AT_LOADPAIR(pp) do { const int na_ = 2 * (pp), nb_ = (2 * (pp) + 1 < ntiles) ? 2 * (pp) + 1 : na_; \
            const int r0_ = AT_KROW(na_) + (tid >> 3), r1_ = AT_KROW(nb_) + (tid >> 3); const int co_ = (tid & 7) * 8; \
            ka = *(const u32x4*)(U + (size_t)r0_ * NIN + kcol + co_); va = *(const u32x4*)(U + (size_t)r0_ * NIN + vcol + co_); \
            kb2 = *(const u32x4*)(U + (size_t)r1_ * NIN + kcol + co_); vb2 = *(const u32x4*)(U + (size_t)r1_ * NIN + vcol + co_); } while (0)
#define AT_WRITEPAIR(off) do { *(LAS u32x4*)(Lb + (off) + st_off) = ka; *(LAS u32x4*)(Lb + (off) + AT_TILEB + st_off) = kb2; \
            *(LAS u32x4*)(Lb + (off) + 2 * AT_TILEB + sv_off) = va; *(LAS u32x4*)(Lb + (off) + 2 * AT_TILEB + AT_VTILEB + sv_off) = vb2; } while (0)
#define AT_MASK(ti, P0, P1) do { if (MODE == 1) { float ninf_ = -INFINITY; asm volatile("" : "+v"(ninf_));     \
            if ((ti) >= ntiles) { _Pragma("unroll") for (int r = 0; r < 16; ++r) { P0[r] = ninf_; P1[r] = ninf_; } } \
            else if ((ti) >= 4) { const int kb0_ = (lt_lo + (ti) - 4) * 64, qlo_ = tq0 + 32 * (F.wave & 1); \
                if (kb0_ + 63 - qlo_ > 128 || qlo_ + 31 - kb0_ > 128) { const int kp0_ = kb0_ + 4 * hi - tq; \
                    _Pragma("unroll") for (int r = 0; r < 16; ++r) { const int dl_ = kp0_ + (r & 3) + 8 * (r >> 2); \
                        if (dl_ > 128 || dl_ < -128) P0[r] = ninf_; if (dl_ + 32 > 128 || dl_ + 32 < -128) P1[r] = ninf_; } } } } } while (0)
#define AT_REF(first, P0, P1) do { if (!fixedref) { float mx_ = fmaxf(P0[0], P1[0]); \
            _Pragma("unroll") for (int r = 1; r < 16; ++r) mx_ = fmaxf(mx_, fmaxf(P0[r], P1[r])); \
            mx_ = fmaxf(mx_, shfl_xor_l(mx_, 32, lane)); \
            if ((first) || __any(mx_ > ATT_THR)) { const float dl_ = (first) ? mx_ : fmaxf(mx_, 0.f); mhat += dl_; \
                const float al_ = __builtin_amdgcn_exp2f(-dl_); lsum *= al_; \
                _Pragma("unroll") for (int r = 0; r < 16; ++r) { P0[r] -= dl_; P1[r] -= dl_; o0[r] *= al_; o1[r] *= al_; negm[r] = -mhat; } } } } while (0)
        AT_LOADPAIR(0); AT_WRITEPAIR(0);
        if (npairs > 1) { AT_LOADPAIR(1); AT_WRITEPAIR(AT_STAGEB); }
        if (npairs > 2) AT_LOADPAIR(2);
        __syncthreads();
        f32x16 pc0, pc1, pn0, pn1;
        at_qk1<FIXED>(Lb, kf_off, qr, negm, pc0, pc1);
        AT_REF(true, pc0, pc1);
#pragma unroll
        for (int r = 0; r < 16; ++r) { pn0[r] = 0.f; pn1[r] = 0.f; }
        int scur = 0, snxt = AT_STAGEB, swr = 2 * AT_STAGEB;
        for (int tp = 0; tp < npairs; ++tp) {
            if (tp + 2 < npairs) { AT_WRITEPAIR(swr); if (tp + 3 < npairs) AT_LOADPAIR(tp + 3); }
            lsum += at_slot<FIXED>(Lb + scur + 2 * AT_TILEB, Lb + scur + AT_TILEB, true, kf_off, vf_off, qr, negm, pc0, pc1, pn0, pn1, o0, o1);
            AT_MASK(2 * tp + 1, pn0, pn1);
            AT_REF(false, pn0, pn1);
            const bool more = tp + 1 < npairs;
            lsum += at_slot<FIXED>(Lb + scur + 2 * AT_TILEB + AT_VTILEB, Lb + snxt, more, kf_off, vf_off, qr, negm, pn0, pn1, pc0, pc1, o0, o1);
            if (more) { AT_MASK(2 * tp + 2, pc0, pc1); AT_REF(false, pc0, pc1); }
            __syncthreads();
            { const int t_ = scur; scur = snxt; snxt = swr; swr = t_; }
        }
#undef AT_KROW
#undef AT_LOADPAIR
#undef AT_WRITEPAIR
#undef AT_MASK
#undef AT_REF
        lsum += shfl_xor_l(lsum, 32, lane);
        if (winm) lsum += __builtin_amdgcn_exp2f(P.sink[l * 8 + hq] * LOG2E - mhat);
        const float inv = 1.0f / lsum;
        bf16_t* op = (bf16_t*)(P.ws + WS_BR) + (size_t)qrow * NBR + (winm ? 1024 : 512) + hq * 64 + 4 * hi;
#pragma unroll
        for (int gq = 0; gq < 4; ++gq) {
            u32x2 w0, w1; w0.x = cvtpk(o0[4 * gq] * inv, o0[4 * gq + 1] * inv); w0.y = cvtpk(o0[4 * gq + 2] * inv, o0[4 * gq + 3] * inv);
            w1.x = cvtpk(o1[4 * gq] * inv, o1[4 * gq + 1] * inv); w1.y = cvtpk(o1[4 * gq + 2] * inv, o1[4 * gq + 3] * inv);
            *(u32x2*)(op + 8 * gq) = w0; *(u32x2*)(op + 32 + 8 * gq) = w1; }
    }
}

template <int MODE> __device__ __forceinline__ void ph_attn(const Frame& F, const Ptrs& P, int l) {
    if (MODE == 3) { ph_attn_impl<MODE, false>(F, P, l); return; }
    const int lane = fresh_lane();
    if (MODE == 1) {
        const unsigned* qk = (const unsigned*)(P.ws + WS_CTL) + CW_QK + 64 * l;
        const float q2 = fmaxf(__uint_as_float(qk[0]), __uint_as_float(qk[16])), k2 = fmaxf(__uint_as_float(qk[32]), __uint_as_float(qk[48]));
        const float b2 = (QSCALE * 1.02f) * (QSCALE * 1.02f) * q2 * k2;
        if (__builtin_amdgcn_readfirstlane(b2 < 48.0f * 48.0f ? 1 : 0)) ph_attn_impl<MODE, true>(F, P, l); else ph_attn_impl<MODE, false>(F, P, l);
        return; }
    float mq = fabsf(P.q_gain[l * 64 + lane]), mk = fabsf(P.k_gain[l * 64 + lane]);
#pragma unroll
    for (int o = 1; o < 64; o <<= 1) { mq = fmaxf(mq, shfl_xor_l(mq, o, lane)); mk = fmaxf(mk, shfl_xor_l(mk, o, lane)); }
    const float sbound = 64.0f * QSCALE * 1.02f * mq * mk;
    if (__builtin_amdgcn_readfirstlane(sbound < 48.0f ? 1 : 0)) ph_attn_impl<MODE, true>(F, P, l); else ph_attn_impl<MODE, false>(F, P, l);
}

__device__ __forceinline__ void ph_ctx_r4(const Frame& F, const Ptrs& P) {
    const int tid0 = fresh_tid(); const float* ct = (const float*)(P.ws + WS_COS);
    for (int it = F.vcu * 512 + tid0; it < 8 * 64 * 64; it += F.G * 512) {
        const int c8 = (it & 63) * 8, t2 = (it >> 6) & 63, b = it >> 12;
        bf16_t* base = (bf16_t*)(P.ws + WS_U) + (size_t)(RL + b * TC + t2) * NIN + c8;
        u32x4 zr[4], zi[4];
#pragma unroll
        for (int t1 = 0; t1 < 4; ++t1) { zr[t1] = *(const u32x4*)(base + (size_t)(64 * t1) * NIN + C_ZR); zi[t1] = *(const u32x4*)(base + (size_t)(64 * t1) * NIN + C_ZI); }
        float tc[4], ts[4];
#pragma unroll
        for (int k1 = 0; k1 < 4; ++k1) { const int ang = (t2 * k1 * 16) & 4095; tc[k1] = ct[ang]; ts[k1] = ct[(ang - 1024) & 4095]; }
        u32x4 orr[4], oi[4];
#pragma unroll
        for (int w = 0; w < 4; ++w) {
            float xr[4][2], xi[4][2];
#pragma unroll
            for (int t1 = 0; t1 < 4; ++t1) { xr[t1][0] = lo16(zr[t1][w]); xr[t1][1] = hi16(zr[t1][w]); xi[t1][0] = lo16(zi[t1][w]); xi[t1][1] = hi16(zi[t1][w]); }
            float yr[4][2], yi[4][2];
#pragma unroll
            for (int e = 0; e < 2; ++e) {
                const float sr = xr[0][e] + xr[2][e], dr = xr[0][e] - xr[2][e], si = xi[0][e] + xi[2][e], di = xi[0][e] - xi[2][e];
                const float pr = xr[1][e] + xr[3][e], qr = xr[1][e] - xr[3][e], pi = xi[1][e] + xi[3][e], qi = xi[1][e] - xi[3][e];
                float ar[4], ai[4];
                ar[0] = sr + pr; ai[0] = si + pi;
                ar[1] = dr + qi; ai[1] = di - qr;
                ar[2] = sr - pr; ai[2] = si - pi;
                ar[3] = dr - qi; ai[3] = di + qr;
#pragma unroll
                for (int k1 = 0; k1 < 4; ++k1) { yr[k1][e] = ar[k1] * tc[k1] + ai[k1] * ts[k1]; yi[k1][e] = ai[k1] * tc[k1] - ar[k1] * ts[k1]; }
            }
#pragma unroll
            for (int k1 = 0; k1 < 4; ++k1) { orr[k1][w] = cvtpk(yr[k1][0], yr[k1][1]); oi[k1][w] = cvtpk(yi[k1][0], yi[k1][1]); }
        }
#pragma unroll
        for (int k1 = 0; k1 < 4; ++k1) { *(u32x4*)(base + (size_t)(64 * k1) * NIN + C_ZR) = orr[k1]; *(u32x4*)(base + (size_t)(64 * k1) * NIN + C_ZI) = oi[k1]; }
    }
}
constexpr int DF_ROWB = 528, DF_WROWB = 272;
template <int STAGE, bool CTX = false> __device__ __forceinline__ void ph_dft(const Frame& F, const Ptrs& P) {
    constexpr int NUN = CTX ? 64 : 1024;
    const int lane = fresh_lane(), tid = F.wave * 64 + lane, r32 = lane & 31, hi = lane >> 5, w = F.wave;
    bf16_t* U = (bf16_t*)(P.ws + WS_U); bf16_t* BR = (bf16_t*)(P.ws + WS_BR); const bf16_t* Wm = (const bf16_t*)(P.ws + WS_DFTM);
    LAS unsigned char* Xl = F.lds;
    LAS unsigned char* Wl = F.lds + 128 * DF_ROWB;
#pragma unroll
    for (int i = 0; i < 4; ++i) { const int idx = tid + 512 * i; *(LAS u32x4*)(Wl + (idx >> 4) * DF_WROWB + (idx & 15) * 16) = *(const u32x4*)(Wm + (idx >> 4) * 128 + (idx & 15) * 8); }
    const int xf_off = (8 * hi + ((lane & 15) >> 2)) * DF_ROWB + (32 * w + ((lane >> 4) & 1) * 16 + (lane & 3) * 4) * 2;
    constexpr int NMB = STAGE == 2 ? 4 : 2;
    const int seg = tid >> 2, part = tid & 3, pp = seg >> 6, jj = seg & 63;
    u32x4 pf[8];
    if (F.vcu < NUN) { const int u = F.vcu; const int chb = u & 1, sidx = CTX ? (u >> 1) & 3 : (u >> 1) & 63, b = CTX ? u >> 3 : u >> 7;
        const int grow = CTX ? RL + b * TC + 64 * sidx + jj : (STAGE == 2 ? b * T + 64 * jj + sidx : b * T + 64 * sidx + jj);
        const u32x4* src = (const u32x4*)(U + (size_t)grow * NIN + pp * 512 + chb * 256 + part * 64);
#pragma unroll
        for (int i = 0; i < 8; ++i) pf[i] = src[i]; }
    for (int u = F.vcu; u < NUN; u += F.G) {
        const int chb = u & 1, sidx = CTX ? (u >> 1) & 3 : (u >> 1) & 63, b = CTX ? u >> 3 : u >> 7;
#pragma unroll
        for (int i = 0; i < 8; ++i) *(LAS u32x4*)(Xl + seg * DF_ROWB + part * 128 + i * 16) = pf[i];
        if (u + F.G < NUN) { const int un = u + F.G; const int chbn = un & 1, sn = CTX ? (un >> 1) & 3 : (un >> 1) & 63, bn = CTX ? un >> 3 : un >> 7;
            const int grow = CTX ? RL + bn * TC + 64 * sn + jj : (STAGE == 2 ? bn * T + 64 * jj + sn : bn * T + 64 * sn + jj);
            const u32x4* src = (const u32x4*)(U + (size_t)grow * NIN + pp * 512 + chbn * 256 + part * 64);
#pragma unroll
            for (int i = 0; i < 8; ++i) pf[i] = src[i]; }
        __syncthreads();
        f32x16 acc[NMB];
#pragma unroll
        for (int mb = 0; mb < NMB; ++mb)
#pragma unroll
            for (int r = 0; r < 16; ++r) acc[mb][r] = 0.f;
#pragma unroll
        for (int ks = 0; ks < 8; ++ks) {
            const v4i16_t lo4 = __builtin_amdgcn_ds_read_tr16_b64_v4i16((LAS v4i16_t*)(Xl + xf_off + (16 * ks) * DF_ROWB));
            const v4i16_t hi4 = __builtin_amdgcn_ds_read_tr16_b64_v4i16((LAS v4i16_t*)(Xl + xf_off + (16 * ks + 4) * DF_ROWB));
            const bf16x8 xf = (bf16x8){lo4[0], lo4[1], lo4[2], lo4[3], hi4[0], hi4[1], hi4[2], hi4[3]};
#pragma unroll
            for (int mb = 0; mb < NMB; ++mb) { const bf16x8 wf = *(const LAS bf16x8*)(Wl + (mb * 32 + r32) * DF_WROWB + (16 * ks + 8 * hi) * 2);
                acc[mb] = __builtin_amdgcn_mfma_f32_32x32x16_bf16(xf, wf, acc[mb], 0, 0, 0); }
        }
        LAS unsigned char* ob = Xl + (32 * w + 4 * hi) * 2;
        if (STAGE == 2) {
#pragma unroll
            for (int mb = 0; mb < 2; ++mb) { const int k1 = mb * 32 + r32; const float rev = (float)((k1 * sidx) & 4095) * (1.0f / 4096.0f);
                const float ct = __builtin_amdgcn_cosf(rev), st = __builtin_amdgcn_sinf(rev);
#pragma unroll
                for (int gq = 0; gq < 4; ++gq) { u32x2 wr, wi; float yr[4], yi[4];
#pragma unroll
                    for (int i = 0; i < 4; ++i) { const float a = acc[mb][4 * gq + i], bq = acc[mb + 2][4 * gq + i]; yr[i] = a * ct + bq * st; yi[i] = bq * ct - a * st; }
                    wr.x = cvtpk(yr[0], yr[1]); wr.y = cvtpk(yr[2], yr[3]); wi.x = cvtpk(yi[0], yi[1]); wi.y = cvtpk(yi[2], yi[3]);
                    *(LAS u32x2*)(ob + k1 * DF_ROWB + 16 * gq) = wr; *(LAS u32x2*)(ob + (64 + k1) * DF_ROWB + 16 * gq) = wi; } }
        } else {
#pragma unroll
            for (int mb = 0; mb < 2; ++mb) { const int k2 = mb * 32 + r32;
#pragma unroll
                for (int gq = 0; gq < 4; ++gq) { constexpr float osc = CTX ? 0.0625f : 0.015625f; u32x2 wr; wr.x = cvtpk(acc[mb][4 * gq] * osc, acc[mb][4 * gq + 1] * osc); wr.y = cvtpk(acc[mb][4 * gq + 2] * osc, acc[mb][4 * gq + 3] * osc);
                    *(LAS u32x2*)(ob + k2 * DF_ROWB + 16 * gq) = wr; } }
        }
        __syncthreads();
        if (STAGE == 2) {
            u32x4* dst = (u32x4*)(U + (size_t)(b * T + 64 * jj + sidx) * NIN + pp * 512 + chb * 256 + part * 64);
#pragma unroll
            for (int i = 0; i < 8; ++i) dst[i] = *(const LAS u32x4*)(Xl + seg * DF_ROWB + part * 128 + i * 16);
        } else { const int k2 = tid >> 3, part8 = tid & 7;
            u32x4* dst = (u32x4*)(BR + (size_t)(CTX ? RL + b * TC + 4 * k2 + sidx : b * T + 64 * k2 + sidx) * NBR + chb * 256 + part8 * 32);
#pragma unroll
            for (int i = 0; i < 4; ++i) dst[i] = *(const LAS u32x4*)(Xl + k2 * DF_ROWB + part8 * 64 + i * 16); }
        __syncthreads();
    }
    if (CTX) __syncthreads();
}

struct MegaArgs { Ptrs P; int ph_lo, ph_hi, li, pad; };
__global__ void __launch_bounds__(NWAVES * 64, 2) mega(MegaArgs args) {
    extern __shared__ __attribute__((aligned(16))) unsigned char lds_raw[];
    Frame F; F.lds = (LAS unsigned char*)lds_raw;
    F.wave = __builtin_amdgcn_readfirstlane(threadIdx.x >> 6);
    F.G = gridDim.x; { const int bx = blockIdx.x; F.vcu = (F.G % 8 == 0) ? (bx % 8) * (F.G / 8) + bx / 8 : bx; }
    for (int u = fresh_tid(); u < (LDS_BYTES - LDSCTL_OFF) / 4; u += NWAVES * 64) ((LAS unsigned*)(F.lds + LDSCTL_OFF))[u] = 0u;
    __syncthreads();
    volatile LAS unsigned* MISC = (volatile LAS unsigned*)(F.lds + MISC_OFF);
    const Ptrs& P = args.P;
    XcdBarrier bar = xcd_barrier_post((unsigned*)(P.ws + WS_CTL) + CW_BAR + args.li * XCD_BAR_WORDS, MISC + 8, F.wave);
    const int lo = args.ph_lo, hi = args.ph_hi;
    unsigned char* ws = P.ws;
    bf16_t* H = (bf16_t*)(ws + WS_H); bf16_t* U = (bf16_t*)(ws + WS_U); bf16_t* BR = (bf16_t*)(ws + WS_BR);
    bf16_t* MG = (bf16_t*)(ws + WS_MG); bf16_t* HID = (bf16_t*)(ws + WS_HID); bf16_t* MO = (bf16_t*)(ws + WS_MO);
    const bf16_t* Bt_in = (const bf16_t*)(ws + WS_WB + WB_IN); const bf16_t* Bt_gate = (const bf16_t*)(ws + WS_WB + WB_GATE); const bf16_t* Bt_br = (const bf16_t*)(ws + WS_WB + WB_BR);
    const bf16_t* Bt_out = (const bf16_t*)(ws + WS_WB + WB_OUT); const bf16_t* Bt_13 = (const bf16_t*)(ws + WS_WB + WB_13); const bf16_t* Bt_2 = (const bf16_t*)(ws + WS_WB + WB_2);
#define IN(g) (lo <= (g) && (g) < hi)
#define SEAM(g) do { if ((g) + 1 < hi) xcd_barrier(bar); } while (0)
    for (int l = 0; l < 2; ++l) {
        const int pb = l * NPH; const int M = l == 0 ? R : RL;
        if (IN(pb + 0)) { if (l == 0) ph_tables_mod(F, P); ph_weights(F, P, l); SEAM(pb + 0); }
        if (IN(pb + 1)) { ph_quant(F, P, l); if (l == 0) ph_norm<0>(F, P, l, R); else ph_norm<1>(F, P, l, R); SEAM(pb + 1); }
        if (IN(pb + 2)) {
            pg8::StaticOrder S; S.init(R, NIN, F.G, (int)blockIdx.x, H, D / 2, Bt_in, D / 2);
            pg8::EpiV8I8<FStore8> E{FStore8{U, NIN}, (const float*)(ws + WS_SA), (const unsigned*)(ws + WS_CTL) + CW_CMAX + 32768 * l};
            pg8::gemm_phase<pg8::EpiV8I8<FStore8>, pg8::StaticOrder, true, true>(F.lds, F.wave, D / 2, D / 2, D / 2, S, E);
            SEAM(pb + 2);
        }
        if (IN(pb + 3)) { ph_kprep(F, P, l); ph_pool(F, P, M); SEAM(pb + 3); }
        if (IN(pb + 4)) {
            ph_dft<2>(F, P); ph_attn<1>(F, P, l);
            if (l == 0) { ph_attn<2>(F, P, l); ph_attn<3>(F, P, l); ph_ctx_r4(F, P); }
            xcd_barrier(bar);
            ph_dft<3>(F, P); if (l == 0) { Frame Fc = F; Fc.vcu = (F.vcu + 64) % F.G; ph_dft<3, true>(Fc, P); } ph_attn<0>(F, P, l);
            SEAM(pb + 4);
        }
        if (IN(pb + 5)) {
            pg8::StaticOrder S; S.init(M, 4096, F.G, (int)blockIdx.x, H, D / 2, Bt_gate, D / 2);
            pg8::EpiV8I8<FGateU8> E{FGateU8{(unsigned char*)(ws + WS_GT), P.b_gate + (size_t)l * 4096}, (const float*)(ws + WS_SA), (const unsigned*)(ws + WS_CTL) + CW_CMAX + 32768 * l + 3072};
            pg8::gemm_phase<pg8::EpiV8I8<FGateU8>, pg8::StaticOrder, true, true>(F.lds, F.wave, D / 2, D / 2, D / 2, S, E);
            SEAM(pb + 5);
        }
        if (IN(pb + 6)) {
            const int chain = (l == 0);
            pg8::PanelOrder S{(int)blockIdx.x, F.G, M / (8 * pg8::BM), 0, chain, (const char*)BR, (const char*)Bt_br, (size_t)pg8::BM * NBR * 2, (size_t)pg8::BM * NBR * 2, (unsigned*)(ws + WS_CTL) + CW_RDY + 4096 * l};
            pg8::EpiMergeS E{(const unsigned char*)(ws + WS_GT), MG, chain};
            pg8::gemm_phase(F.lds, F.wave, NBR, NBR, NBR, S, E);
            if (!chain) xcd_barrier(bar);
        }
        if (IN(pb + 10)) {
            pg8::PanelOrder S{(int)blockIdx.x, F.G, M / (8 * pg8::BM), 1, l == 0, (const char*)MG, (const char*)Bt_out, (size_t)pg8::BM * D * 2, (size_t)pg8::BM * D * 2, (unsigned*)(ws + WS_CTL) + CW_RDY + 4096 * l};
            pg8::EpiV4<FOut> E{FOut{P, l}};
            pg8::gemm_phase(F.lds, F.wave, D, D, D, S, E);
            SEAM(pb + 10);
        }
        if (IN(pb + 11)) { ph_norm2(F, P, l, M); xcd_barrier(bar); }
        if (IN(pb + 13) || IN(pb + 14)) {
            LAS int* ptab = (LAS int*)(F.lds + LDSCTL_OFF);
            if (fresh_tid() == 0) { const unsigned* cnt = (const unsigned*)(ws + WS_CTL) + CW_CNT + 1024 * l; int off = 0;
                for (int e = 0; e < 16; ++e) { const int c = (int)cnt[64 * e]; ptab[e] = off; ptab[17 + e] = c; off += (c + 255) >> 8; } ptab[16] = off; }
            __syncthreads();
            if (IN(pb + 13)) {
                pg8::MoeOrder<true> S; S.nN = 4; S.G = F.G; S.c = F.vcu; S.A = (const char*)H; S.Bt = (const char*)Bt_13; S.astep = 0; S.bstep = (size_t)256 * D; S.bexp = (size_t)1024 * 1024; S.tab = (const int*)ptab; S.tokl = (const int*)(ws + WS_TOKL); S.hand = 1; S.rev = 0; S.ready = (unsigned*)(ws + WS_CTL) + CW_MRDY + 8192 * l;
                pg8::EpiDualI8<FMoe1> E{FMoe1{HID}, (const float*)(ws + WS_SA), (const unsigned*)(ws + WS_CTL) + CW_CMAX + 32768 * l + 8192, (const int*)(ws + WS_TOKL)};
                pg8::gemm_phase<pg8::EpiDualI8<FMoe1>, pg8::MoeOrder<true>, true, true>(F.lds, F.wave, D / 2, D / 2, D / 2, S, E);
            }
            if (IN(pb + 14)) {
                pg8::MoeOrder<false> S; S.nN = 4; S.G = F.G; S.c = F.vcu; S.A = (const char*)HID; S.Bt = (const char*)Bt_2; S.astep = (size_t)256 * FF * 2; S.bstep = (size_t)256 * FF * 2; S.bexp = (size_t)1024 * 512 * 2; S.tab = (const int*)ptab; S.tokl = nullptr; S.hand = 2; S.rev = 1; S.ready = (unsigned*)(ws + WS_CTL) + CW_MRDY + 8192 * l;
                pg8::EpiV8<FMoe2> E{FMoe2{MO, (const int*)(ws + WS_TOKL), (const float*)(ws + WS_WL)}};
                pg8::gemm_phase(F.lds, F.wave, FF, FF, FF, S, E);
                SEAM(pb + 14);
            }
        }
    }
    if (IN(PH_FINAL)) { ph_final(F, P, 0, 24576); xcd_barrier(bar); ph_final(F, P, 24576, RL); }
#undef IN
#undef SEAM
}

extern "C" void kernel_launch(void* const* d_in, const int* in_sizes, int n_in, void* d_out, int out_size, void* d_ws, size_t ws_size, hipStream_t stream) {
    if (n_in != 24 || ws_size < WS_END || out_size != RL * D) { fprintf(stderr, "kernel_launch: unexpected sizes n_in %d ws %zu out %d\n", n_in, ws_size, out_size); return; }
    static int grid = 0;
    if (grid == 0) {
        int dev = 0, cus = 0;
        if (hipGetDevice(&dev) != hipSuccess || hipDeviceGetAttribute(&cus, hipDeviceAttributeMultiprocessorCount, dev) != hipSuccess) { grid = -1; return; }
        if (hipFuncSetAttribute((const void*)mega, hipFuncAttributeMaxDynamicSharedMemorySize, LDS_BYTES) != hipSuccess) { fprintf(stderr, "kernel_launch: hipFuncSetAttribute failed\n"); grid = -1; return; }
        int per_cu = 0;
        if (hipOccupancyMaxActiveBlocksPerMultiprocessor(&per_cu, (const void*)mega, NWAVES * 64, LDS_BYTES) != hipSuccess || per_cu < 1) fprintf(stderr, "kernel_launch: occupancy query says %d\n", per_cu);
        (void)hipGetLastError();
        grid = cus;
    }
    if (grid < 0) return;
    MegaArgs a{};
    const float** pp = (const float**)&a.P;
    for (int i = 0; i < 24; ++i) pp[i] = (const float*)d_in[i];
    a.P.out = (float*)d_out; a.P.ws = (unsigned char*)d_ws;
    (void)hipMemsetAsync((unsigned char*)d_ws + WS_CTL, 0, 512 * 1024, stream);
    a.ph_lo = 0; a.ph_hi = PH_FINAL + 1; a.li = 0;
    hipLaunchKernelGGL(mega, dim3(grid), dim3(NWAVES * 64), LDS_BYTES, stream, a);
}
```

```cpp
#include <hip/hip_runtime.h>
#include <cstdio>
#include <cstdint>

typedef unsigned short bf16_t;
typedef short bf16x8 __attribute__((ext_vector_type(8)));
typedef float f32x4 __attribute__((ext_vector_type(4)));
typedef unsigned u32x4 __attribute__((ext_vector_type(4)));
typedef unsigned u32x2 __attribute__((ext_vector_type(2)));
typedef int i32x4 __attribute__((ext_vector_type(4)));

constexpr int D = 1024, NB = 8, T = 4096, TC = 256;
constexpr int RL = NB * T, RC = NB * TC, R = RL + RC;
constexpr int NIN = 3072;
constexpr int C_ZR = 0, C_ZI = 512, C_P = 1024, C_QB = 1536, C_KB = 2048, C_VB = 2176, C_QW = 2304, C_KW = 2816, C_VW = 2944;
constexpr int NBR = 2048;
constexpr int NE = 16, FF = 512;
constexpr int MAXROWS = 73728;
constexpr float EPS = 1e-6f;
constexpr float QSCALE = 0.125f * 1.4426950408889634f;
constexpr float LOG2E = 1.4426950408889634f;

constexpr size_t MiB = 1u << 20;
constexpr size_t WS_CTL = 0;
constexpr size_t WS_MOD = 1 * MiB;
constexpr size_t WS_ROPE = 1 * MiB + 512 * 1024;
constexpr size_t WS_COS = WS_ROPE + 16 * 1024;
constexpr size_t WS_DFTM = WS_ROPE + 64 * 1024;
constexpr size_t WS_TOKL = 2 * MiB;
constexpr size_t WS_WL = 4 * MiB + 512 * 1024;
constexpr size_t WS_XC = 9 * MiB;
constexpr size_t WS_WB = 17 * MiB;
constexpr size_t WB_IN = 0, WB_GATE = 6 * MiB, WB_BR = 14 * MiB, WB_OUT = 18 * MiB, WB_13 = 20 * MiB, WB_2 = 52 * MiB;
constexpr size_t WS_H = 85 * MiB;
constexpr size_t WS_SA = WS_H + 34 * MiB;
constexpr size_t WS_X1B = WS_H + 35 * MiB;
constexpr size_t WS_ARENA = 153 * MiB;
constexpr size_t WS_U = WS_ARENA;
constexpr size_t WS_BR = WS_ARENA + 204 * MiB;
constexpr size_t WS_GT = WS_ARENA;
constexpr size_t WS_MG = WS_ARENA + 136 * MiB;
constexpr size_t WS_HID = WS_ARENA + 144 * MiB;
constexpr size_t WS_MO = WS_ARENA + 216 * MiB;
constexpr size_t WS_FTMP = WS_ARENA + 352 * MiB;
constexpr size_t WS_END = 512 * MiB;
static_assert(WS_BR + (size_t)R * NBR * 2 <= WS_END && WS_MO + (size_t)2 * R * D * 2 <= WS_END && WS_MG + (size_t)R * D * 2 <= WS_BR, "ws map");
constexpr int CW_CMAX = 32768;
constexpr int CW_RDY = 20480;
constexpr int CW_QK = 28672;
constexpr int CW_MRDY = 98304;
constexpr int CW_CNT = 8192;

__device__ __forceinline__ float bf2f(bf16_t b) { return __uint_as_float(((unsigned)b) << 16); }
__device__ __forceinline__ unsigned f2bf(float f) { unsigned u = __float_as_uint(f); return (u + 0x7fffu + ((u >> 16) & 1u)) >> 16; }
__device__ __forceinline__ unsigned pk2(float lo, float hi) { return f2bf(lo) | (f2bf(hi) << 16); }
typedef __bf16 bf16x2_t __attribute__((ext_vector_type(2)));
typedef float f32x2_t __attribute__((ext_vector_type(2)));
__device__ __forceinline__ unsigned cvtpk(float lo, float hi) { f32x2_t v = {lo, hi}; bf16x2_t b = __builtin_convertvector(v, bf16x2_t); return __builtin_bit_cast(unsigned, b); }
__device__ __forceinline__ float lo16(unsigned w) { return __uint_as_float(w << 16); }
__device__ __forceinline__ float hi16(unsigned w) { return __uint_as_float(w & 0xffff0000u); }
__device__ __forceinline__ float shfl_xor_l(float v, int o, int lane) { return __int_as_float(__builtin_amdgcn_ds_bpermute((lane ^ o) << 2, __float_as_int(v))); }
__device__ __forceinline__ float wave_sum_l(float v, int lane) {
#pragma unroll
    for (int o = 1; o < 64; o <<= 1) v += shfl_xor_l(v, o, lane);
    return v;
}
__device__ __forceinline__ int row_bb(int r) { return r < RL ? (r >> 12) : 8; }

struct Ptrs {
    const float *x, *c, *ctx, *c_ctx, *w_ada, *b_ada, *norm1, *norm2, *w_in, *q_gain, *k_gain, *sink, *pool_w, *pool_scale,
        *w_branch, *w_gate, *b_gate, *w_out, *router_w, *router_bias, *w1, *w3, *w2, *norm_f;
    float* out; unsigned char* ws;
};
__device__ __forceinline__ const float* xin_row(const Ptrs& P, int r) { return r < RL ? P.x + (size_t)r * D : P.ctx + (size_t)(r - RL) * D; }
__device__ __forceinline__ bf16_t* x1b_row(const Ptrs& P, int r) {
    return r < 16384 ? (bf16_t*)((unsigned char*)P.out + 96 * MiB) + (size_t)r * D : (r < RL ? (bf16_t*)(P.ws + WS_X1B) + (size_t)(r - 16384) * D : (bf16_t*)(P.ws + WS_XC) + (size_t)(r - RL) * D); }
__device__ __forceinline__ f32x4 ld4b(const bf16_t* p) { const u32x2 w = *(const u32x2*)p; return (f32x4){lo16(w.x), hi16(w.x), lo16(w.y), hi16(w.y)}; }
__device__ __forceinline__ void st4b(bf16_t* p, f32x4 v) { u32x2 w; w.x = cvtpk(v.x, v.y); w.y = cvtpk(v.z, v.w); *(u32x2*)p = w; }
__device__ __forceinline__ const float* mod_vec(const Ptrs& P, int l, int bb, int which) { return (const float*)(P.ws + WS_MOD) + ((size_t)(l * 9 + bb) * 6 + which) * D; }

#define LAS __attribute__((address_space(3)))
#define GAS __attribute__((address_space(1)))
#define LDS_WAIT() asm volatile("s_waitcnt lgkmcnt(0)" ::: "memory")
__device__ __forceinline__ int fresh_lane() { int l; asm volatile("v_mbcnt_lo_u32_b32 %0, -1, 0\n\tv_mbcnt_hi_u32_b32 %0, -1, %0" : "=v"(l)); return l; }
constexpr int NWAVES = 8;
constexpr int RING_BYTES = 131072, LDSCTL_OFF = RING_BYTES, MISC_OFF = LDSCTL_OFF + 320, LDS_BYTES = 147456;
constexpr int CW_BAR = 16384;
constexpr int NPH = 15, PH_FINAL = 2 * NPH;

#define XB_TMO      128
#define XB_XCNT(j)  (256  + 64 * (j))
#define XB_XSUB(j)  (1280 + 64 * (j))
#define XB_XGEN(j)  (2304 + 64 * (j))
#define XB_TOP      3328
#define XB_TOPGEN   3392
#define XCD_BAR_WORDS 3456
#define XB_SPIN_CAP (1u << 21)
__device__ __forceinline__ unsigned xb_ld(unsigned* p)              { return __hip_atomic_load(p, __ATOMIC_RELAXED, __HIP_MEMORY_SCOPE_AGENT); }
__device__ __forceinline__ unsigned xb_add(unsigned* p, unsigned v) { return __hip_atomic_fetch_add(p, v, __ATOMIC_RELAXED, __HIP_MEMORY_SCOPE_AGENT); }
__device__ __forceinline__ unsigned xb_xcc_id() { return (unsigned)__builtin_amdgcn_s_getreg((3 << 11) | 20) & 0xFu; }
#define XB_SPIN(cond, bar) do { unsigned _sp = 0; while (cond) { __builtin_amdgcn_s_sleep(1); \
    if ((++_sp & 255u) == 0u) { if (xb_ld(&(bar)[XB_TMO])) break; if (_sp > XB_SPIN_CAP) { atomicAdd(&(bar)[XB_TMO], 1u); break; } } } } while (0)
struct XcdBarrier { unsigned* bar; unsigned x; volatile LAS unsigned* st; int wave; };
__device__ __forceinline__ XcdBarrier xcd_barrier_post(unsigned* bar, volatile LAS unsigned* st, int wave) {
    XcdBarrier b; b.bar = bar; b.x = xb_xcc_id(); b.st = st; b.wave = wave;
    if (wave == 0 && fresh_lane() == 0) (void)xb_add(&bar[XB_XCNT(b.x)], 1u);
    return b;
}
__device__ __forceinline__ void xcd_barrier_complete(unsigned* bar, unsigned x, unsigned& nloc, unsigned& nx) {
    const unsigned G = gridDim.x * gridDim.y * gridDim.z;
    unsigned sum, cnt, mine, sp = 0u;
    for (;;) {
        sum = 0u; cnt = 0u; mine = 0u;
#pragma unroll
        for (unsigned j = 0; j < 16; ++j) { const unsigned c = xb_ld(&bar[XB_XCNT(j)]); sum += c; cnt += (c > 0u) ? 1u : 0u; mine = (j == x) ? c : mine; }
        if (sum == G) break;
        __builtin_amdgcn_s_sleep(1);
        if ((++sp & 255u) == 0u) { if (xb_ld(&bar[XB_TMO])) break; if (sp > XB_SPIN_CAP) { atomicAdd(&bar[XB_TMO], 1u); break; } }
    }
    nloc = mine > 0u ? mine : 1u; nx = cnt > 0u ? cnt : 1u;
}
__device__ __forceinline__ void xcd_barrier(const XcdBarrier& b) {
    asm volatile("s_waitcnt vmcnt(0)" ::: "memory");
    __syncthreads();
    if (b.wave == 0 && fresh_lane() == 0) {
        unsigned* bar = b.bar;
        __builtin_amdgcn_s_waitcnt(0);
        unsigned nloc = b.st[0], nx = b.st[1];
        if (nloc == 0u) { xcd_barrier_complete(bar, b.x, nloc, nx); b.st[0] = nloc; b.st[1] = nx; }
        const unsigned old = xb_add(&bar[XB_XSUB(b.x)], 1u);
        const unsigned gen = old / nloc;
        if (old + 1u == (gen + 1u) * nloc) {
            __builtin_amdgcn_fence(__ATOMIC_RELEASE, "agent");
            asm volatile("s_waitcnt vmcnt(0)" ::: "memory");
            const unsigned og = xb_add(&bar[XB_TOP], 1u);
            const unsigned tg = og / nx;
            if (og + 1u == (tg + 1u) * nx) xb_add(&bar[XB_TOPGEN], 1u);
            else XB_SPIN(xb_ld(&bar[XB_TOPGEN]) == tg, bar);
            __builtin_amdgcn_fence(__ATOMIC_ACQUIRE, "agent");
            xb_add(&bar[XB_XGEN(b.x)], 1u);
            asm volatile("s_waitcnt vmcnt(0)" ::: "memory");
        } else {
            XB_SPIN(xb_ld(&bar[XB_XGEN(b.x)]) == gen, bar);
            __builtin_amdgcn_fence(__ATOMIC_ACQUIRE, "agent");
            asm volatile("s_waitcnt vmcnt(0)" ::: "memory");
        }
    }
    __syncthreads();
}

namespace pg8 {
constexpr int BM = 256, BK = 64, HALF = 128, HTB = HALF * BK * 2, STAGE_BYTES = 8 * HTB, NXCD = 8, WGM = 4;
__host__ __device__ __forceinline__ int lds_byte(int r, int c) { const int st = (r >> 4) * 2 + (c >> 5), rr = r & 15, cc = c & 31, ob = rr * 64 + cc * 2; return st * 1024 + (ob ^ (((ob >> 9) & 1) << 5)); }
__host__ __device__ __forceinline__ void stage_rc(int b, int& Rr, int& C) { const int st = b / 1024, sb = b % 1024, swz = sb ^ (((sb >> 9) & 1) << 5); Rr = (st >> 1) * 16 + swz / 64; C = (st & 1) * 32 + (swz % 64) / 2; }
__host__ __device__ __forceinline__ int perm32(int rho) { const int n = rho >> 4, i = rho & 15; return 8 * (i >> 2) + 4 * n + (i & 3); }
struct Unit { int pm, pn; const char* a; const char* b; int e, p0, ce; };

struct StaticOrder {
    static constexpr bool GATHER = false;
    int nM, nN, nwg, G, c; const char* A; const char* Bt; size_t astep, bstep;
    __device__ void init(int M, int N, int G_, int c_, const bf16_t* A_, int lda, const bf16_t* Bt_, int ldb) { nM = M / BM; nN = N / BM; nwg = nM * nN; G = G_; c = c_; A = (const char*)A_; Bt = (const char*)Bt_; astep = (size_t)BM * lda * 2; bstep = (size_t)BM * ldb * 2; }
    __device__ bool next(int i, Unit& u) const {
        const long L = (long)i * G + c; if (L >= nwg) return false;
        int wgid = (int)L; { const int q = nwg / NXCD, r = nwg % NXCD, xcd = wgid % NXCD, off = wgid / NXCD; wgid = (xcd < r ? xcd * (q + 1) : r * (q + 1) + (xcd - r) * q) + off; }
        const int nig = WGM * nN, gid = wgid / nig, fm = gid * WGM, gsz = (nM - fm) < WGM ? (nM - fm) : WGM;
        u.pm = fm + ((wgid % nig) % gsz); u.pn = (wgid % nig) / gsz; u.a = A + (size_t)u.pm * astep; u.b = Bt + (size_t)u.pn * bstep; u.e = 0; u.p0 = 0; u.ce = 0; return true;
    }
    __device__ __forceinline__ void a_ready(const Unit&) const {}
    __device__ __forceinline__ void done(const Unit&) const {}
};
template <bool GATHER_> struct MoeOrder {
    static constexpr bool GATHER = GATHER_;
    int nN, G, c; const char* A; const char* Bt; size_t astep, bstep, bexp; const int* tab; const int* tokl;
    int hand, rev; unsigned* ready;
    __device__ bool next(int i, Unit& u) const {
        const int L = i * G + (rev ? G - 1 - c : c); const int total = __builtin_amdgcn_readfirstlane(tab[16]) * nN; if (L >= total) return false;
        u.pm = L / nN; u.pn = L % nN; int e = 0;
#pragma unroll
        for (int q = 1; q < 16; ++q) e += (u.pm >= tab[q]) ? 1 : 0;
        e = __builtin_amdgcn_readfirstlane(e);
        u.e = e; u.p0 = __builtin_amdgcn_readfirstlane((u.pm - tab[e]) * BM); u.ce = __builtin_amdgcn_readfirstlane(tab[17 + e]);
        u.a = GATHER_ ? A : A + (size_t)u.pm * astep; u.b = Bt + (size_t)e * bexp + (size_t)u.pn * bstep; return true;
    }
    __device__ __forceinline__ void a_ready(const Unit& u) const {
        if (hand != 2) return;
        if (__builtin_amdgcn_readfirstlane(threadIdx.x >> 6) == 0) {
            unsigned spins = 0;
            while ((unsigned)__builtin_amdgcn_readfirstlane(__hip_atomic_load(ready + 16 * u.pm, __ATOMIC_RELAXED, __HIP_MEMORY_SCOPE_AGENT)) < 32u) { __builtin_amdgcn_s_sleep(2); if (++spins > (1u << 22)) break; }
            __builtin_amdgcn_fence(__ATOMIC_ACQUIRE, "agent");
            asm volatile("s_waitcnt vmcnt(0)" ::: "memory");
        }
        asm volatile("" ::: "memory"); __builtin_amdgcn_s_barrier(); asm volatile("" ::: "memory");
    }
    __device__ __forceinline__ void done(const Unit& u) const {
        if (hand != 1) return;
        asm volatile("s_waitcnt vmcnt(0)" ::: "memory");
        if (fresh_lane() == 0) __hip_atomic_fetch_add(ready + 16 * u.pm, 1u, __ATOMIC_RELAXED, __HIP_MEMORY_SCOPE_AGENT);
    }
    __device__ __forceinline__ void aoffs(const Unit& u, int wid, int lda, unsigned (&off)[2][2]) const {
        const int tid = wid * 64 + fresh_lane();
#pragma unroll
        for (int i = 0; i < 2; ++i) { int Rr, C; stage_rc(tid * 16 + i * 8192, Rr, C);
#pragma unroll
            for (int h = 0; h < 2; ++h) { const int pos = u.p0 + h * HALF + Rr; const int tok = pos < u.ce ? (tokl[(size_t)u.e * R + pos] >> 1) : 0; off[h][i] = (unsigned)(tok * lda + C) * 2u; } }
    }
};

struct PanelOrder {
    static constexpr bool GATHER = false;
    int c, G, npx, consumer, chain; const char* A; const char* Bt; size_t astep, bstep; unsigned* ready;
    __device__ bool next(int i, Unit& u) const {
        if (G == 256) { const int xcd = c & 7, r = c >> 3, ne = 4 * npx, heavy = ne - 64; int e;
            if (!consumer) { e = 32 * i + r; if (e >= ne) return false; }
            else if (r >= heavy) { e = i * (32 - heavy) + (r - heavy); if (e >= 64) return false; }
            else { if (i != 0) return false; e = 64 + r; }
            u.pm = npx * xcd + (e >> 2); u.pn = e & 3; }
        else { const int L = i * G + c; if (L >= 32 * npx) return false; u.pm = L >> 2; u.pn = L & 3; }
        u.a = A + (size_t)u.pm * astep; u.b = Bt + (size_t)u.pn * bstep; u.e = 0; u.p0 = 0; u.ce = 0; return true;
    }
    __device__ __forceinline__ void a_ready(const Unit& u) const {
        if (!consumer || !chain) return;
        if (__builtin_amdgcn_readfirstlane(threadIdx.x >> 6) == 0) {
            unsigned spins = 0;
            while ((unsigned)__builtin_amdgcn_readfirstlane(__hip_atomic_load(ready + 16 * u.pm, __ATOMIC_RELAXED, __HIP_MEMORY_SCOPE_AGENT)) < 32u) { __builtin_amdgcn_s_sleep(2); if (++spins > (1u << 22)) break; }
            __builtin_amdgcn_fence(__ATOMIC_ACQUIRE, "agent");
            asm volatile("s_waitcnt vmcnt(0)" ::: "memory");
        }
        asm volatile("" ::: "memory"); __builtin_amdgcn_s_barrier(); asm volatile("" ::: "memory");
    }
    __device__ __forceinline__ void done(const Unit& u) const {
        if (consumer || !chain) return;
        asm volatile("s_waitcnt vmcnt(0)" ::: "memory");
        if (fresh_lane() == 0) __hip_atomic_fetch_add(ready + 16 * u.pm, 1u, __ATOMIC_RELAXED, __HIP_MEMORY_SCOPE_AGENT);
    }
};
template <class Epi, class Sched, bool ALIGN_EPI = true, bool I8 = false>
__device__ __forceinline__ void gemm_phase(LAS unsigned char* lds, const int wid, const int lda, const int ldb, const int K, const Sched& S, const Epi& E) {
    const int lane = fresh_lane(), tid = wid * 64 + lane, wr = wid >> 2, wc = wid & 3, fr = lane & 15, fq = lane >> 4;
    const int nt = K / BK;
    unsigned voffA[2], voffB[2];
#pragma unroll
    for (int i = 0; i < 2; ++i) { int Rr, C; stage_rc(tid * 16 + i * 8192, Rr, C); const int Rb = Epi::PERM ? ((Rr & ~31) + perm32(Rr & 31)) : Rr;
        voffA[i] = (unsigned)(Rr * lda + C) * 2u; voffB[i] = (unsigned)(Rb * ldb + C) * 2u; }
    const size_t kstep = (size_t)(BK * 2);
    const size_t hstepA = Sched::GATHER ? 0 : (size_t)HALF * lda * 2, hstepB = (size_t)HALF * ldb * 2;
    const unsigned ldsw = (unsigned)wid * 1024u;
    const int aoff = lds_byte(wr * 64 + fr, fq * 8), boff = lds_byte(wc * 32 + fr, fq * 8);
#define PG8_SA(b, h) (((b) * 2 + (h)) * HTB)
#define PG8_SB(b, h) ((4 + (b) * 2 + (h)) * HTB)
#define PG8_STAGE(bufoff, gbase, voff) do { _Pragma("unroll") for (int _i = 0; _i < 2; ++_i) \
        __builtin_amdgcn_global_load_lds((const unsigned*)((const char*)(gbase) + (voff)[_i]), (LAS unsigned*)(lds + (bufoff) + ldsw + _i * 8192), 16, 0, 0); } while (0)
#define PG8_STAGE_A(b, h, kp, OFFS) do { if constexpr (Sched::GATHER) { PG8_STAGE(PG8_SA(b, h), kp, OFFS[h]); } else { PG8_STAGE(PG8_SA(b, h), (kp) + (h) * hstepA, voffA); } } while (0)
#define PG8_LDA(dst, b, h) do { _Pragma("unroll") for (int m = 0; m < 4; ++m) _Pragma("unroll") for (int k = 0; k < 2; ++k) dst[m][k] = *(const LAS bf16x8*)(lds + PG8_SA(b, h) + aoff + m * 2048 + k * 1024); } while (0)
#define PG8_LDB(dst, b, h) do { _Pragma("unroll") for (int n = 0; n < 2; ++n) _Pragma("unroll") for (int k = 0; k < 2; ++k) dst[n][k] = *(const LAS bf16x8*)(lds + PG8_SB(b, h) + boff + n * 2048 + k * 1024); } while (0)
#define PG8_MMA(ai, bj, At, Bt) do { __builtin_amdgcn_s_setprio(1); _Pragma("unroll") for (int m = 0; m < 4; ++m) _Pragma("unroll") for (int n = 0; n < 2; ++n) _Pragma("unroll") for (int k = 0; k < 2; ++k) { \
        if constexpr (I8) acc[ai][bj][m][n] = __builtin_bit_cast(f32x4, __builtin_amdgcn_mfma_i32_16x16x64_i8(__builtin_bit_cast(i32x4, Bt[n][k]), __builtin_bit_cast(i32x4, At[m][k]), __builtin_bit_cast(i32x4, acc[ai][bj][m][n]), 0, 0, 0)); \
        else acc[ai][bj][m][n] = __builtin_amdgcn_mfma_f32_16x16x32_bf16(Bt[n][k], At[m][k], acc[ai][bj][m][n], 0, 0, 0); } __builtin_amdgcn_s_setprio(0); } while (0)
#define PG8_WAIT_V(n) asm volatile("s_waitcnt vmcnt(" #n ")" ::: "memory")
#define PG8_WAIT_L(n) asm volatile("s_waitcnt lgkmcnt(" #n ")" ::: "memory")
#define PG8_BAR __builtin_amdgcn_s_barrier()
#define PG8_SCHED __builtin_amdgcn_sched_barrier(0)
    Unit cur, nxt; int ui = 0;
    if (!S.next(0, cur)) return;
    f32x4 acc[2][2][4][2];
#pragma unroll
    for (int a = 0; a < 2; ++a)
#pragma unroll
        for (int b = 0; b < 2; ++b)
#pragma unroll
            for (int m = 0; m < 4; ++m)
#pragma unroll
                for (int n = 0; n < 2; ++n) acc[a][b][m][n] = (f32x4){0.f, 0.f, 0.f, 0.f};
    bf16x8 At[4][2], B0[2][2], B1[2][2];
    unsigned goffC[2][2], goffN[2][2];
    if constexpr (Sched::GATHER) { S.aoffs(cur, wid, lda, goffC);
#pragma unroll
        for (int h = 0; h < 2; ++h)
#pragma unroll
            for (int i = 0; i < 2; ++i) goffN[h][i] = goffC[h][i]; }
    const char* cA = cur.a; const char* cB = cur.b;
    S.a_ready(cur);
    PG8_STAGE(PG8_SB(0, 0), cB, voffB); PG8_STAGE(PG8_SB(0, 1), cB + hstepB, voffB); PG8_STAGE_A(0, 0, cA, goffC); PG8_STAGE_A(0, 1, cA, goffC);
    if (wr == 1) PG8_BAR;
    PG8_WAIT_V(2); PG8_BAR;
    PG8_STAGE(PG8_SB(1, 0), cB + kstep, voffB); PG8_STAGE_A(1, 0, cA + kstep, goffC); PG8_STAGE(PG8_SB(1, 1), cB + hstepB + kstep, voffB);
    PG8_WAIT_V(6); PG8_BAR;
    for (;;) {
        const bool has_next = S.next(ui + 1, nxt);
        if constexpr (Sched::GATHER) { if (has_next) S.aoffs(nxt, wid, lda, goffN); }
        const char* nA = has_next ? nxt.a : cA; const char* nB = has_next ? nxt.b : cB;
        for (int t = 0; t < nt; t += 2) {
            const bool last = (t == nt - 2);
            const char* a1 = cA + (size_t)(t + 1) * kstep;
            const char* a2 = last ? nA : cA + (size_t)(t + 2) * kstep; const char* b2 = last ? nB : cB + (size_t)(t + 2) * kstep;
            const char* a3 = a2 + kstep; const char* b3 = b2 + kstep;
            unsigned gx[2][2];
            if constexpr (Sched::GATHER) {
#pragma unroll
                for (int h = 0; h < 2; ++h)
#pragma unroll
                    for (int i = 0; i < 2; ++i) gx[h][i] = (last && has_next) ? goffN[h][i] : goffC[h][i]; }
            if (last && has_next) S.a_ready(nxt);
            PG8_LDB(B0, 0, 0); PG8_LDB(B1, 0, 1); PG8_SCHED; PG8_LDA(At, 0, 0); PG8_STAGE_A(1, 1, a1, goffC);
            PG8_WAIT_V(8); PG8_WAIT_L(0); PG8_BAR; PG8_MMA(0, 0, At, B0); PG8_MMA(0, 1, At, B1); PG8_BAR; PG8_SCHED;
            PG8_LDA(At, 0, 1); PG8_STAGE(PG8_SB(0, 0), b2, voffB); PG8_STAGE(PG8_SB(0, 1), b2 + hstepB, voffB); PG8_STAGE_A(0, 0, a2, gx);
            PG8_WAIT_V(8); PG8_WAIT_L(0); PG8_BAR; PG8_MMA(1, 0, At, B0); PG8_MMA(1, 1, At, B1); PG8_BAR; PG8_SCHED;
            PG8_LDB(B0, 1, 0); PG8_LDB(B1, 1, 1); PG8_SCHED; PG8_LDA(At, 1, 0); PG8_STAGE_A(0, 1, a2, gx);
            PG8_WAIT_V(8); PG8_WAIT_L(0); PG8_BAR; PG8_MMA(0, 0, At, B0); PG8_MMA(0, 1, At, B1); PG8_BAR; PG8_SCHED;
            PG8_LDA(At, 1, 1); PG8_STAGE(PG8_SB(1, 0), b3, voffB); PG8_STAGE(PG8_SB(1, 1), b3 + hstepB, voffB); PG8_STAGE_A(1, 0, a3, gx);
            PG8_WAIT_V(8); PG8_WAIT_L(0); PG8_BAR; PG8_MMA(1, 0, At, B0); PG8_MMA(1, 1, At, B1); PG8_BAR; PG8_SCHED;
            if constexpr (Epi::MID) { if (((t + 2) & (Epi::MID_EVERY - 1)) == 0 && !last) E.mid(acc, cur, wr, wc, (t + 2) / Epi::MID_EVERY - 1); }
        }
        if constexpr (ALIGN_EPI) { if (wr == 0) PG8_BAR; }
        E(acc, cur, wr, wc, fr, fq);
        S.done(cur);
        if (!has_next) break;
#pragma unroll
        for (int a = 0; a < 2; ++a)
#pragma unroll
            for (int b = 0; b < 2; ++b)
#pragma unroll
                for (int m = 0; m < 4; ++m)
#pragma unroll
                    for (int n = 0; n < 2; ++n) acc[a][b][m][n] = (f32x4){0.f, 0.f, 0.f, 0.f};
        cur = nxt; cA = nA; cB = nB; ++ui;
        if constexpr (Sched::GATHER) {
#pragma unroll
            for (int h = 0; h < 2; ++h)
#pragma unroll
                for (int i = 0; i < 2; ++i) goffC[h][i] = goffN[h][i]; }
        if constexpr (ALIGN_EPI) { if (wr == 1) PG8_BAR; }
    }
    PG8_WAIT_V(0);
    if constexpr (!ALIGN_EPI) { if (wr == 0) PG8_BAR; }
    PG8_BAR;
#undef PG8_SA
#undef PG8_SB
#undef PG8_STAGE
#undef PG8_STAGE_A
#undef PG8_LDA
#undef PG8_LDB
#undef PG8_MMA
#undef PG8_WAIT_V
#undef PG8_WAIT_L
#undef PG8_BAR
#undef PG8_SCHED
}
template <class F> struct EpiV4 { static constexpr bool PERM = false, MID = false; static constexpr int MID_EVERY = 1; F f;
    __device__ __forceinline__ void operator()(const f32x4 (&acc)[2][2][4][2], const Unit& u, int wr, int wc, int, int) const {
        const int ln = fresh_lane(), fr = ln & 15, fq = ln >> 4;
        const int row0 = u.pm * BM + wr * 64 + fr, col0 = u.pn * BM + wc * 32 + 4 * fq;
        typename F::UnitPre up = f.unit(u, col0);
#pragma unroll
        for (int ai = 0; ai < 2; ++ai) {
            typename F::Pre pre[4][2][2];
#pragma unroll
            for (int m = 0; m < 4; ++m)
#pragma unroll
                for (int bj = 0; bj < 2; ++bj)
#pragma unroll
                    for (int n = 0; n < 2; ++n) pre[m][bj][n] = f.load(u, row0 + ai * HALF + m * 16, col0 + bj * HALF + n * 16);
#pragma unroll
            for (int m = 0; m < 4; ++m)
#pragma unroll
                for (int bj = 0; bj < 2; ++bj)
#pragma unroll
                    for (int n = 0; n < 2; ++n) f.fin(u, row0 + ai * HALF + m * 16, col0 + bj * HALF + n * 16, acc[ai][bj][m][n], pre[m][bj][n], up, bj * 2 + n);
            asm volatile("" ::: "memory"); }
    } };
template <class F> struct EpiV8 { static constexpr bool PERM = true, MID = false; static constexpr int MID_EVERY = 1; F f;
    __device__ __forceinline__ void operator()(const f32x4 (&acc)[2][2][4][2], const Unit& u, int wr, int wc, int, int) const {
        const int ln = fresh_lane(), fr = ln & 15, fq = ln >> 4;
        const int row0 = u.pm * BM + wr * 64 + fr, col0 = u.pn * BM + wc * 32 + 8 * fq;
#pragma unroll
        for (int ai = 0; ai < 2; ++ai) {
            typename F::Pre pre[4][2];
#pragma unroll
            for (int m = 0; m < 4; ++m)
#pragma unroll
                for (int bj = 0; bj < 2; ++bj) pre[m][bj] = f.load(u, row0 + ai * HALF + m * 16, col0 + bj * HALF);
#pragma unroll
            for (int m = 0; m < 4; ++m)
#pragma unroll
                for (int bj = 0; bj < 2; ++bj) f.fin(u, row0 + ai * HALF + m * 16, col0 + bj * HALF, acc[ai][bj][m][0], acc[ai][bj][m][1], pre[m][bj]);
            asm volatile("" ::: "memory"); }
    } };
template <class F> struct EpiDual { static constexpr bool PERM = true, MID = false; static constexpr int MID_EVERY = 1; F f;
    __device__ __forceinline__ void operator()(const f32x4 (&acc)[2][2][4][2], const Unit& u, int wr, int wc, int, int) const {
        const int ln = fresh_lane(), fr = ln & 15, fq = ln >> 4;
        const int row0 = u.pm * BM + wr * 64 + fr, hc0 = u.pn * HALF + wc * 32 + 8 * fq;
#pragma unroll
        for (int ai = 0; ai < 2; ++ai)
#pragma unroll
            for (int m = 0; m < 4; ++m) f.apply8(row0 + ai * HALF + m * 16, hc0, acc[ai][0][m][0], acc[ai][0][m][1], acc[ai][1][m][0], acc[ai][1][m][1]);
    } };
struct EpiMergeS { static constexpr bool PERM = true, MID = true; static constexpr int MID_EVERY = 8;
    const unsigned char* G8; bf16_t* MG; int wt;
    __device__ __forceinline__ void mid(f32x4 (&acc)[2][2][4][2], const Unit& u, int wr, int wc, int i) const {
        const int ln = fresh_lane(), fr = ln & 15, fq = ln >> 4;
        const int row0 = u.pm * BM + wr * 64 + fr, col0 = u.pn * BM + wc * 32 + 8 * fq;
#pragma unroll
        for (int ai = 0; ai < 2; ++ai) {
            u32x2 gi[4][2], gn[4][2];
#pragma unroll
            for (int m = 0; m < 4; ++m)
#pragma unroll
                for (int bj = 0; bj < 2; ++bj) { const unsigned char* gp = G8 + (size_t)(row0 + ai * HALF + m * 16) * 4096 + i * 1024 + col0 + bj * HALF;
                    gi[m][bj] = *(const u32x2*)gp; gn[m][bj] = *(const u32x2*)(gp + 1024); }
#pragma unroll
            for (int m = 0; m < 4; ++m)
#pragma unroll
                for (int bj = 0; bj < 2; ++bj) {
#pragma unroll
                    for (int j = 0; j < 4; ++j) {
                        acc[ai][bj][m][0][j] *= (float)((gi[m][bj].x >> (8 * j)) & 255u) * __builtin_amdgcn_rcpf((float)((gn[m][bj].x >> (8 * j)) & 255u));
                        acc[ai][bj][m][1][j] *= (float)((gi[m][bj].y >> (8 * j)) & 255u) * __builtin_amdgcn_rcpf((float)((gn[m][bj].y >> (8 * j)) & 255u)); } }
        }
    }
    __device__ __forceinline__ void operator()(const f32x4 (&acc)[2][2][4][2], const Unit& u, int wr, int wc, int, int) const {
        const int ln = fresh_lane(), fr = ln & 15, fq = ln >> 4;
        const int row0 = u.pm * BM + wr * 64 + fr, col0 = u.pn * BM + wc * 32 + 8 * fq;
#pragma unroll
        for (int ai = 0; ai < 2; ++ai) {
            const __amdgpu_buffer_rsrc_t rs = __builtin_amdgcn_make_buffer_rsrc((void*)MG, (short)0, (int)((size_t)R * D * 2), 0x00020000);
        u32x2 g3[4][2];
#pragma unroll
            for (int m = 0; m < 4; ++m)
#pragma unroll
                for (int bj = 0; bj < 2; ++bj) g3[m][bj] = *(const u32x2*)(G8 + (size_t)(row0 + ai * HALF + m * 16) * 4096 + 3 * 1024 + col0 + bj * HALF);
#pragma unroll
            for (int m = 0; m < 4; ++m)
#pragma unroll
                for (int bj = 0; bj < 2; ++bj) { f32x4 a = acc[ai][bj][m][0], b = acc[ai][bj][m][1];
#pragma unroll
                    for (int j = 0; j < 4; ++j) { a[j] *= (float)((g3[m][bj].x >> (8 * j)) & 255u) * (1.0f / 255.0f); b[j] *= (float)((g3[m][bj].y >> (8 * j)) & 255u) * (1.0f / 255.0f); }
                    u32x4 w; w.x = cvtpk(a.x, a.y); w.y = cvtpk(a.z, a.w); w.z = cvtpk(b.x, b.y); w.w = cvtpk(b.z, b.w);
                    if (wt) __builtin_amdgcn_raw_buffer_store_b128(w, rs, (int)(((size_t)(row0 + ai * HALF + m * 16) * D + col0 + bj * HALF) * 2), 0, 16);
                    else *(u32x4*)(MG + (size_t)(row0 + ai * HALF + m * 16) * D + col0 + bj * HALF) = w; }
        }
    }
};
template <class F> struct EpiV8I8 { static constexpr bool PERM = true, MID = false; static constexpr int MID_EVERY = 1; F f; const float* sA; const unsigned* cmax;
    __device__ __forceinline__ void operator()(const f32x4 (&acc)[2][2][4][2], const Unit& u, int wr, int wc, int, int) const {
        const int ln = fresh_lane(), fr = ln & 15, fq = ln >> 4;
        const int row0 = u.pm * BM + wr * 64 + fr, col0 = u.pn * BM + wc * 32 + 8 * fq;
        u32x4 cb[2][2]; float ra[2][4];
#pragma unroll
        for (int bj = 0; bj < 2; ++bj)
#pragma unroll
            for (int n = 0; n < 2; ++n) cb[bj][n] = *(const u32x4*)(cmax + col0 + bj * HALF + 4 * n);
#pragma unroll
        for (int ai = 0; ai < 2; ++ai)
#pragma unroll
            for (int m = 0; m < 4; ++m) ra[ai][m] = sA[row0 + ai * HALF + m * 16];
        const typename F::UnitPre up = f.unit(col0);
        f32x4 sb[2][2];
#pragma unroll
        for (int bj = 0; bj < 2; ++bj)
#pragma unroll
            for (int n = 0; n < 2; ++n) { const u32x4 c = cb[bj][n]; sb[bj][n] = (f32x4){__uint_as_float(c.x), __uint_as_float(c.y), __uint_as_float(c.z), __uint_as_float(c.w)} * (1.0f / 127.0f); }
#pragma unroll
        for (int ai = 0; ai < 2; ++ai) {
#pragma unroll
            for (int m = 0; m < 4; ++m) { const float r1 = ra[ai][m];
#pragma unroll
                for (int bj = 0; bj < 2; ++bj) { f32x4 a, b;
#pragma unroll
                    for (int j = 0; j < 4; ++j) { a[j] = (float)__float_as_int(acc[ai][bj][m][0][j]) * r1 * sb[bj][0][j]; b[j] = (float)__float_as_int(acc[ai][bj][m][1][j]) * r1 * sb[bj][1][j]; }
                    f.fin(u, row0 + ai * HALF + m * 16, col0 + bj * HALF, a, b, up, bj); } }
            asm volatile("" ::: "memory"); }
    } };
template <class F> struct EpiDualI8 { static constexpr bool PERM = true, MID = false; static constexpr int MID_EVERY = 1; F f; const float* sA; const unsigned* cmax; const int* tokl;
    __device__ __forceinline__ void operator()(const f32x4 (&acc)[2][2][4][2], const Unit& u, int wr, int wc, int, int) const {
        const int ln = fresh_lane(), fr = ln & 15, fq = ln >> 4;
        const int lrow0 = wr * 64 + fr, hc0 = u.pn * HALF + wc * 32 + 8 * fq;
        const unsigned* cm = cmax + u.e * 1024 + u.pn * BM + wc * 32 + 8 * fq;
        f32x4 s1[2], s3[2];
#pragma unroll
        for (int n = 0; n < 2; ++n) { const u32x4 a = *(const u32x4*)(cm + 4 * n), b = *(const u32x4*)(cm + HALF + 4 * n);
            s1[n] = (f32x4){__uint_as_float(a.x), __uint_as_float(a.y), __uint_as_float(a.z), __uint_as_float(a.w)} * (1.0f / 127.0f);
            s3[n] = (f32x4){__uint_as_float(b.x), __uint_as_float(b.y), __uint_as_float(b.z), __uint_as_float(b.w)} * (1.0f / 127.0f); }
        int tk[2][4]; float ra[2][4];
#pragma unroll
        for (int ai = 0; ai < 2; ++ai)
#pragma unroll
            for (int m = 0; m < 4; ++m) { const int pos = u.p0 + lrow0 + ai * HALF + m * 16; tk[ai][m] = pos < u.ce ? (tokl[(size_t)u.e * R + pos] >> 1) : 0; }
#pragma unroll
        for (int ai = 0; ai < 2; ++ai)
#pragma unroll
            for (int m = 0; m < 4; ++m) ra[ai][m] = sA[tk[ai][m]];
#pragma unroll
        for (int ai = 0; ai < 2; ++ai) {
#pragma unroll
            for (int m = 0; m < 4; ++m) { f32x4 a0, a1, b0, b1; const float r1 = ra[ai][m];
#pragma unroll
                for (int j = 0; j < 4; ++j) { a0[j] = (float)__float_as_int(acc[ai][0][m][0][j]) * r1 * s1[0][j]; a1[j] = (float)__float_as_int(acc[ai][0][m][1][j]) * r1 * s1[1][j];
                    b0[j] = (float)__float_as_int(acc[ai][1][m][0][j]) * r1 * s3[0][j]; b1[j] = (float)__float_as_int(acc[ai][1][m][1][j]) * r1 * s3[1][j]; }
                f.apply8(u.pm * BM + lrow0 + ai * HALF + m * 16, hc0, a0, a1, b0, b1); }
        }
    } };
}

__device__ __forceinline__ u32x4 pack8(f32x4 a, f32x4 b) { u32x4 w; w.x = cvtpk(a.x, a.y); w.y = cvtpk(a.z, a.w); w.z = cvtpk(b.x, b.y); w.w = cvtpk(b.z, b.w); return w; }
__device__ __forceinline__ float sigm1(float x) { return __builtin_amdgcn_rcpf(1.0f + __builtin_amdgcn_exp2f(-1.4426950408889634f * x)); }
__device__ __forceinline__ f32x4 sigm4(f32x4 v) { f32x4 r; r.x = sigm1(v.x); r.y = sigm1(v.y); r.z = sigm1(v.z); r.w = sigm1(v.w); return r; }
struct NoPre {};
struct FStore8 { bf16_t* C; int ldc; typedef NoPre UnitPre;
    __device__ __forceinline__ UnitPre unit(int) const { return UnitPre{}; }
    __device__ __forceinline__ void fin(const pg8::Unit&, int row, int col, f32x4 a, f32x4 b, const UnitPre&, int) const { *(u32x4*)(C + (size_t)row * ldc + col) = pack8(a, b); } };
struct FGateU8 { unsigned char* G8; const float* bias; struct UnitPre { f32x4 b[2][2]; };
    __device__ __forceinline__ UnitPre unit(int col0) const { UnitPre r;
#pragma unroll
        for (int bj = 0; bj < 2; ++bj) { r.b[bj][0] = *(const f32x4*)(bias + col0 + bj * pg8::HALF); r.b[bj][1] = *(const f32x4*)(bias + col0 + bj * pg8::HALF + 4); } return r; }
    __device__ __forceinline__ void fin(const pg8::Unit&, int row, int col, f32x4 a, f32x4 b, const UnitPre& up, int bj) const { const f32x4 b0 = up.b[bj][0], b1 = up.b[bj][1];
        const f32x4 ga = sigm4(a + b0) * 255.0f + 0.5f, gb = sigm4(b + b1) * 255.0f + 0.5f;
        unsigned q[8] = {(unsigned)ga.x, (unsigned)ga.y, (unsigned)ga.z, (unsigned)ga.w, (unsigned)gb.x, (unsigned)gb.y, (unsigned)gb.z, (unsigned)gb.w};
#pragma unroll
        for (int k = 0; k < 8; ++k) q[k] = q[k] < 1u ? 1u : (q[k] > 255u ? 255u : q[k]);
        u32x2 w; w.x = q[0] | (q[1] << 8) | (q[2] << 16) | (q[3] << 24); w.y = q[4] | (q[5] << 8) | (q[6] << 16) | (q[7] << 24);
        *(u32x2*)(G8 + (size_t)row * 4096 + col) = w; } };
struct FMoe1 { bf16_t* HID;
    __device__ __forceinline__ void apply8(int row, int hc, f32x4 a0, f32x4 a1, f32x4 b0, f32x4 b1) const {
        const __amdgpu_buffer_rsrc_t rs = __builtin_amdgcn_make_buffer_rsrc((void*)HID, (short)0, (int)((size_t)MAXROWS * FF * 2), 0x00020000);
        __builtin_amdgcn_raw_buffer_store_b128(pack8(a0 * sigm4(a0) * b0, a1 * sigm4(a1) * b1), rs, (int)(((size_t)row * FF + hc) * 2), 0, 16); } };
struct FMoe2 { bf16_t* MO; const int* tokl; const float* wl; struct Pre { int t; float w; };
    __device__ __forceinline__ Pre load(const pg8::Unit& u, int row, int) const { Pre r; const int pos = u.p0 + (row - u.pm * 256); r.t = -1; r.w = 0.f;
        if (pos < u.ce) { r.t = tokl[(size_t)u.e * R + pos]; r.w = wl[(size_t)u.e * R + pos]; } return r; }
    __device__ __forceinline__ void fin(const pg8::Unit&, int, int col, f32x4 a, f32x4 b, const Pre& q) const { if (q.t < 0) return;
        *(u32x4*)(MO + ((size_t)(q.t & 1) * R + (q.t >> 1)) * D + col) = pack8(a * q.w, b * q.w); } };
struct FOut { Ptrs P; int l; typedef u32x4 Pre; struct UnitPre { f32x4 g[4]; };
    __device__ __forceinline__ UnitPre unit(const pg8::Unit& u, int col0) const { UnitPre r; const float* g = mod_vec(P, l, row_bb(u.pm * 256), 2) + col0;
#pragma unroll
        for (int q = 0; q < 4; ++q) r.g[q] = *(const f32x4*)(g + (q >> 1) * 128 + (q & 1) * 16);
        return r; }
    __device__ __forceinline__ Pre load(const pg8::Unit&, int row, int col) const { if (l == 0) return *(const u32x4*)(xin_row(P, row) + col); const u32x2 w = *(const u32x2*)(x1b_row(P, row) + col); return (u32x4){w.x, w.y, 0u, 0u}; }
    __device__ __forceinline__ void fin(const pg8::Unit&, int row, int col, f32x4 v, const Pre& xr, const UnitPre& up, int q) const {
        const f32x4 xp = l == 0 ? (f32x4){__uint_as_float(xr.x), __uint_as_float(xr.y), __uint_as_float(xr.z), __uint_as_float(xr.w)} : (f32x4){lo16(xr.x), hi16(xr.x), lo16(xr.y), hi16(xr.y)};
        st4b(x1b_row(P, row) + col, xp + up.g[q] * v); } };

struct Frame { LAS unsigned char* lds; int wave, vcu, G; };
#define fresh_tid() (F.wave * 64 + fresh_lane())
__device__ __forceinline__ void tr_item(const float* W, int ldw, int k0, int csrc0, bf16_t* WT, int ldt, int drow0, LAS float* scr, int lane) {
    f32x4 v[8];
#pragma unroll
    for (int i = 0; i < 8; ++i) v[i] = *(const f32x4*)(W + (size_t)(k0 + (lane >> 3) + 8 * i) * ldw + csrc0 + (lane & 7) * 4);
#pragma unroll
    for (int i = 0; i < 8; ++i) { LAS float* d = scr + ((lane >> 3) + 8 * i) * 33 + (lane & 7) * 4; d[0] = v[i].x; d[1] = v[i].y; d[2] = v[i].z; d[3] = v[i].w; }
    LDS_WAIT(); asm volatile("" ::: "memory");
    const int c = lane & 7;
#pragma unroll
    for (int j = 0; j < 4; ++j) { const int n = (lane >> 3) + 8 * j; const LAS float* s = scr + (8 * c) * 33 + n;
        u32x4 o; o.x = cvtpk(s[0 * 33], s[1 * 33]); o.y = cvtpk(s[2 * 33], s[3 * 33]); o.z = cvtpk(s[4 * 33], s[5 * 33]); o.w = cvtpk(s[6 * 33], s[7 * 33]);
        *(u32x4*)(WT + (size_t)(drow0 + n) * ldt + k0 + 8 * c) = o; }
    LDS_WAIT(); asm volatile("" ::: "memory");
}
__device__ __forceinline__ void max_item(const float* W, int ldw, int k0, int csrc0, unsigned* cmax, int lane) {
    f32x4 m = (f32x4){0.f, 0.f, 0.f, 0.f};
#pragma unroll
    for (int i = 0; i < 8; ++i) { const f32x4 v = *(const f32x4*)(W + (size_t)(k0 + (lane >> 3) + 8 * i) * ldw + csrc0 + (lane & 7) * 4);
        m.x = fmaxf(m.x, fabsf(v.x)); m.y = fmaxf(m.y, fabsf(v.y)); m.z = fmaxf(m.z, fabsf(v.z)); m.w = fmaxf(m.w, fabsf(v.w)); }
#pragma unroll
    for (int o = 8; o < 64; o <<= 1) { m.x = fmaxf(m.x, shfl_xor_l(m.x, o, lane)); m.y = fmaxf(m.y, shfl_xor_l(m.y, o, lane)); m.z = fmaxf(m.z, shfl_xor_l(m.z, o, lane)); m.w = fmaxf(m.w, shfl_xor_l(m.w, o, lane)); }
    if (lane < 8) { atomicMax(cmax + lane * 4, __float_as_uint(m.x)); atomicMax(cmax + lane * 4 + 1, __float_as_uint(m.y)); atomicMax(cmax + lane * 4 + 2, __float_as_uint(m.z)); atomicMax(cmax + lane * 4 + 3, __float_as_uint(m.w)); }
}
__device__ __forceinline__ unsigned q8(float v, float inv) { int q = (int)__builtin_rintf(v * inv); q = q < -127 ? -127 : (q > 127 ? 127 : q); return (unsigned)q & 255u; }
__device__ __forceinline__ unsigned q8m(float v, float inv) { return __float_as_uint(__builtin_fmaf(v, inv, 12582912.0f)); }
__device__ __forceinline__ unsigned pack4m(unsigned a, unsigned b, unsigned c, unsigned d) { return __builtin_amdgcn_perm(b, a, 0x0c0c0400u) | __builtin_amdgcn_perm(d, c, 0x04000c0cu); }
__device__ __forceinline__ unsigned q8x4(float a, float b, float c, float d, float inv) { return pack4m(q8m(a, inv), q8m(b, inv), q8m(c, inv), q8m(d, inv)); }
__device__ __forceinline__ void tr_item_q(const float* W, int ldw, int k0, int csrc0, unsigned char* WT, int ldt, int drow0, const unsigned* cmax, LAS float* scr, int lane) {
    f32x4 v[8];
#pragma unroll
    for (int i = 0; i < 8; ++i) v[i] = *(const f32x4*)(W + (size_t)(k0 + (lane >> 3) + 8 * i) * ldw + csrc0 + (lane & 7) * 4);
#pragma unroll
    for (int i = 0; i < 8; ++i) { LAS float* d = scr + ((lane >> 3) + 8 * i) * 33 + (lane & 7) * 4; d[0] = v[i].x; d[1] = v[i].y; d[2] = v[i].z; d[3] = v[i].w; }
    LDS_WAIT(); asm volatile("" ::: "memory");
    const int n = lane >> 1, half = lane & 1; const float cm = __uint_as_float(cmax[n]); const float inv = cm > 0.f ? 127.0f / cm : 0.f;
    const LAS float* sp = scr + (half * 32) * 33 + n; unsigned w[8];
#pragma unroll
    for (int q = 0; q < 8; ++q) w[q] = q8x4(sp[(4 * q) * 33], sp[(4 * q + 1) * 33], sp[(4 * q + 2) * 33], sp[(4 * q + 3) * 33], inv);
    u32x4* dp = (u32x4*)(WT + (size_t)(drow0 + n) * ldt + k0 + half * 32);
    dp[0] = (u32x4){w[0], w[1], w[2], w[3]}; dp[1] = (u32x4){w[4], w[5], w[6], w[7]};
    LDS_WAIT(); asm volatile("" ::: "memory");
}
struct Strip { const float* W; int ldw; unsigned char* WT; unsigned* cm; };
constexpr int NSTRIP = 64 + 128 + 512, ST_PITCH = 1040, ST_RED = 32 * ST_PITCH;
__device__ __forceinline__ Strip strip_desc(const Ptrs& P, int l, int s, unsigned char* wb, unsigned* cmaxp) {
    Strip d;
    if (s < 64) { d.W = P.w_in + (size_t)l * 1024 * 2560 + 512 + s * 32; d.ldw = 2560; d.WT = wb + WB_IN + (size_t)(1024 + s * 32) * 1024; d.cm = cmaxp + 1024 + s * 32; }
    else if (s < 192) { const int r = s - 64, i = r >> 5, nb = r & 31; d.W = P.w_gate + ((size_t)l * 4 + i) * 1024 * 1024 + nb * 32; d.ldw = 1024; d.WT = wb + WB_GATE + (size_t)i * 1024 * 1024 + (size_t)(nb * 32) * 1024; d.cm = cmaxp + 3072 + i * 1024 + nb * 32; }
    else { const int r = s - 192, w3 = r >> 8, e = (r >> 4) & 15, nb = r & 15, c = nb * 32, drow = 256 * (c >> 7) + (c & 127) + (w3 ? 128 : 0);
        d.W = (w3 ? P.w3 : P.w1) + ((size_t)l * 16 + e) * 1024 * 512 + c; d.ldw = 512; d.WT = wb + WB_13 + (size_t)e * 1024 * 1024 + (size_t)drow * 1024; d.cm = cmaxp + 8192 + e * 1024 + drow; }
    return d;
}
#define STRIP_LOAD(v, dsc, tid) do { const float* p_ = (dsc).W + (size_t)(4 * ((tid) >> 3)) * (dsc).ldw + 4 * ((tid) & 7); \
    _Pragma("unroll") for (int j_ = 0; j_ < 4; ++j_) _Pragma("unroll") for (int d_ = 0; d_ < 4; ++d_) v[j_ * 4 + d_] = *(const f32x4*)(p_ + (size_t)(256 * j_ + d_) * (dsc).ldw); } while (0)
__device__ __forceinline__ void strip_process(const f32x4 (&v)[16], const Strip& d, LAS unsigned char* lds, int tid, int lane, int wave) {
    const int cq = tid & 7, kr = tid >> 3;
    f32x4 m = (f32x4){0.f, 0.f, 0.f, 0.f};
#pragma unroll
    for (int i = 0; i < 16; ++i) { m.x = fmaxf(m.x, fabsf(v[i].x)); m.y = fmaxf(m.y, fabsf(v[i].y)); m.z = fmaxf(m.z, fabsf(v[i].z)); m.w = fmaxf(m.w, fabsf(v[i].w)); }
#pragma unroll
    for (int o = 8; o < 64; o <<= 1) { m.x = fmaxf(m.x, shfl_xor_l(m.x, o, lane)); m.y = fmaxf(m.y, shfl_xor_l(m.y, o, lane)); m.z = fmaxf(m.z, shfl_xor_l(m.z, o, lane)); m.w = fmaxf(m.w, shfl_xor_l(m.w, o, lane)); }
    LAS float* red = (LAS float*)(lds + ST_RED);
    if (lane < 8) *(LAS f32x4*)(red + wave * 32 + 4 * lane) = m;
    __syncthreads();
    f32x4 cm = *(const LAS f32x4*)(red + 4 * cq);
#pragma unroll
    for (int w = 1; w < 8; ++w) { const f32x4 t = *(const LAS f32x4*)(red + w * 32 + 4 * cq); cm.x = fmaxf(cm.x, t.x); cm.y = fmaxf(cm.y, t.y); cm.z = fmaxf(cm.z, t.z); cm.w = fmaxf(cm.w, t.w); }
    if (tid < 8) *(u32x4*)(d.cm + 4 * tid) = (u32x4){__float_as_uint(cm.x), __float_as_uint(cm.y), __float_as_uint(cm.z), __float_as_uint(cm.w)};
    f32x4 inv; inv.x = cm.x > 0.f ? 127.0f / cm.x : 0.f; inv.y = cm.y > 0.f ? 127.0f / cm.y : 0.f; inv.z = cm.z > 0.f ? 127.0f / cm.z : 0.f; inv.w = cm.w > 0.f ? 127.0f / cm.w : 0.f;
    LAS unsigned char* tp = lds + (4 * cq) * ST_PITCH + 4 * kr;
#pragma unroll
    for (int j = 0; j < 4; ++j) {
        *(LAS unsigned*)(tp + 0 * ST_PITCH + 256 * j) = pack4m(q8m(v[4 * j].x, inv.x), q8m(v[4 * j + 1].x, inv.x), q8m(v[4 * j + 2].x, inv.x), q8m(v[4 * j + 3].x, inv.x));
        *(LAS unsigned*)(tp + 1 * ST_PITCH + 256 * j) = pack4m(q8m(v[4 * j].y, inv.y), q8m(v[4 * j + 1].y, inv.y), q8m(v[4 * j + 2].y, inv.y), q8m(v[4 * j + 3].y, inv.y));
        *(LAS unsigned*)(tp + 2 * ST_PITCH + 256 * j) = pack4m(q8m(v[4 * j].z, inv.z), q8m(v[4 * j + 1].z, inv.z), q8m(v[4 * j + 2].z, inv.z), q8m(v[4 * j + 3].z, inv.z));
        *(LAS unsigned*)(tp + 3 * ST_PITCH + 256 * j) = pack4m(q8m(v[4 * j].w, inv.w), q8m(v[4 * j + 1].w, inv.w), q8m(v[4 * j + 2].w, inv.w), q8m(v[4 * j + 3].w, inv.w));
    }
    __syncthreads();
#pragma unroll
    for (int q = 0; q < 4; ++q) { const int id = tid + 512 * q, n = id >> 6, kc = id & 63; *(u32x4*)(d.WT + (size_t)n * 1024 + 16 * kc) = *(const LAS u32x4*)(lds + n * ST_PITCH + 16 * kc); }
}
__device__ __forceinline__ void ph_weights(const Frame& F, const Ptrs& P, int l) {
    const int tid0 = fresh_tid(), lane0 = tid0 & 63;
    LAS float* scr = (LAS float*)(F.lds + F.wave * 16384);
    const int gw = F.vcu * NWAVES + F.wave, NGW = F.G * NWAVES;
    unsigned char* wb = P.ws + WS_WB;
    unsigned* cmaxp = (unsigned*)(P.ws + WS_CTL) + CW_CMAX + 32768 * l;
    int vcu = F.vcu; asm volatile("" : "+s"(vcu));
    { const int tid = tid0; f32x4 va[16], vb[16]; Strip da, db; int s = vcu;
      if (s < NSTRIP) { da = strip_desc(P, l, s, wb, cmaxp); STRIP_LOAD(va, da, tid); }
      while (s < NSTRIP) {
          int sn = s + F.G;
          if (sn < NSTRIP) { db = strip_desc(P, l, sn, wb, cmaxp); STRIP_LOAD(vb, db, tid); }
          strip_process(va, da, F.lds, tid, lane0, F.wave);
          s = sn; if (s >= NSTRIP) break;
          sn = s + F.G;
          if (sn < NSTRIP) { da = strip_desc(P, l, sn, wb, cmaxp); STRIP_LOAD(va, da, tid); }
          strip_process(vb, db, F.lds, tid, lane0, F.wave);
          s = sn;
      } }
    __syncthreads();
    constexpr int I2 = 768, I3 = I2 + 512, I6 = I3 + 4096;
    int it0, it1, step;
    if (F.G == 256) { const int base = vcu < 192 ? 16 * vcu : 3072 + 36 * (vcu - 192); it0 = base + F.wave; it1 = base + (vcu < 192 ? 16 : 36); step = NWAVES; }
    else { it0 = gw; it1 = I6; step = NGW; }
    for (int it = it0; it < it1; it += step) {
        if (it < I2) { const int i = it >> 8, q = it & 255, kb = q >> 5, nb = q & 31; tr_item(P.w_branch + ((size_t)l * 4 + i) * 512 * 1024, 1024, kb * 64, nb * 32, (bf16_t*)(wb + WB_BR) + i * 512, 2048, nb * 32, scr, lane0); }
        else if (it < I3) { const int q = it - I2, kb = q >> 5, nb = q & 31; tr_item(P.w_out + (size_t)l * 1024 * 1024, 1024, kb * 64, nb * 32, (bf16_t*)(wb + WB_OUT), 1024, nb * 32, scr, lane0); }
        else { const int r = it - I3, e = r >> 8, q = r & 255, kb = q >> 5, nb = q & 31; tr_item(P.w2 + ((size_t)l * 16 + e) * 512 * 1024, 1024, kb * 64, nb * 32, (bf16_t*)(wb + WB_2) + (size_t)e * 1024 * 512, 512, nb * 32, scr, lane0); }
    }
    __syncthreads();
    for (int u = F.vcu; u < 256; u += F.G) {
        LAS float* Wl = (LAS float*)F.lds; LAS float* ct = Wl + 16 * 128;
        const int kt = u >> 2, g = u & 3, k0 = kt * 16, tid = tid0; const float* w_in = P.w_in + (size_t)l * 1024 * 2560;
        if (tid < 128) ct[tid] = __builtin_amdgcn_cosf((float)tid * (1.0f / 128.0f));
        for (int i = tid; i < 16 * 128; i += 512) { const int k = i >> 7, c = i & 127; Wl[k * 128 + c] = w_in[(size_t)(k0 + k) * 2560 + g * 128 + c]; }
        __syncthreads();
        const int part = (tid >> 7) & 1, m = tid & 127, kh = tid >> 8; const float sc = 0.08838834764831845f;
        float* drow = (float*)(P.ws + WS_FTMP) + (size_t)(part * 512 + g * 128 + m) * 1024 + k0;
        { const int kb = kh * 8; float acc[8];
#pragma unroll
            for (int j = 0; j < 8; ++j) acc[j] = 0.f;
            for (int c = 0; c < 128; ++c) { const int idx = (c * m) & 127; const float tw = part ? -ct[(idx - 32) & 127] : ct[idx];
#pragma unroll
                for (int j = 0; j < 8; ++j) acc[j] += Wl[(kb + j) * 128 + c] * tw; }
            float mx = 0.f;
#pragma unroll
            for (int j = 0; j < 8; ++j) { acc[j] *= sc; mx = fmaxf(mx, fabsf(acc[j])); }
            *(f32x4*)(drow + kb) = (f32x4){acc[0], acc[1], acc[2], acc[3]}; *(f32x4*)(drow + kb + 4) = (f32x4){acc[4], acc[5], acc[6], acc[7]};
            atomicMax(cmaxp + part * 512 + g * 128 + m, __float_as_uint(mx)); }
        __syncthreads();
    }
    for (int u = F.vcu; u < 256; u += F.G) {
        LAS float* Wb = (LAS float*)F.lds;
        const int g = u >> 6, n0 = (u & 63) * 16, tid = tid0;
        const float* ps = P.pool_scale + (size_t)l * 512; const float* wb3 = P.w_branch + ((size_t)l * 4 + 3) * 512 * 1024; const float* pwl = P.pool_w + (size_t)l * 4 * 128 * 128;
        for (int i = tid; i < 128 * 16; i += 512) { const int e = i >> 4, n = i & 15; Wb[e * 16 + n] = ps[g * 128 + e] * wb3[(size_t)(g * 128 + e) * 1024 + n0 + n]; }
        __syncthreads();
        const int c = tid & 127, nh = tid >> 7; const float* pw = pwl + (size_t)(g * 128 + c) * 128;
        float acc[4];
#pragma unroll
        for (int j = 0; j < 4; ++j) acc[j] = 0.f;
        for (int e = 0; e < 128; e += 4) { const f32x4 p4 = *(const f32x4*)(pw + e);
#pragma unroll
            for (int q = 0; q < 4; ++q)
#pragma unroll
                for (int j = 0; j < 4; ++j) acc[j] += p4[q] * Wb[(e + q) * 16 + nh * 4 + j]; }
        bf16_t* Bt = (bf16_t*)(wb + WB_BR) + 3 * 512;
#pragma unroll
        for (int j = 0; j < 4; ++j) Bt[(size_t)(n0 + nh * 4 + j) * 2048 + g * 128 + c] = (bf16_t)f2bf(acc[j]);
        __syncthreads();
    }
}
__device__ __forceinline__ void ph_quant(const Frame& F, const Ptrs& P, int l) {
    const int tid0 = fresh_tid(), lane0 = tid0 & 63;
    LAS float* scr = (LAS float*)(F.lds + F.wave * 16384);
    const int gw = F.vcu * NWAVES + F.wave, NGW = F.G * NWAVES;
    unsigned char* wb = P.ws + WS_WB; const unsigned* cmaxp = (const unsigned*)(P.ws + WS_CTL) + CW_CMAX + 32768 * l;
    for (int i = F.vcu * 512 + tid0; i < 65536; i += F.G * 512) {
        const int n = i >> 6, kc = (i & 63) * 16; const float cm = __uint_as_float(cmaxp[n]); const float inv = cm > 0.f ? 127.0f / cm : 0.f;
        const f32x4* tp = (const f32x4*)((const float*)(P.ws + WS_FTMP) + (size_t)n * 1024 + kc); const f32x4 a = tp[0], b = tp[1], c = tp[2], d = tp[3];
        *(u32x4*)(wb + WB_IN + (size_t)n * 1024 + kc) = (u32x4){q8x4(a.x, a.y, a.z, a.w, inv), q8x4(b.x, b.y, b.z, b.w, inv), q8x4(c.x, c.y, c.z, c.w, inv), q8x4(d.x, d.y, d.z, d.w, inv)};
    }
    __syncthreads();
}
__device__ __forceinline__ void ph_tables_mod(const Frame& F, const Ptrs& P) {
    const int tid0 = fresh_tid();
    { float* rc = (float*)(P.ws + WS_ROPE); float* rs = rc + 1024; float* ct = (float*)(P.ws + WS_COS);
      const int i = F.vcu * 512 + tid0;
      if (i < 1024) { const int pos = i >> 4, f = i & 15; const float inv = __builtin_amdgcn_exp2f(-(float)f * (13.287712379549449f / 16.0f));
          float rev = (float)pos * inv * 0.15915494309189535f; rev = rev - floorf(rev);
          rc[i] = __builtin_amdgcn_cosf(rev); rs[i] = __builtin_amdgcn_sinf(rev); }
      if (i < 4096) ct[i] = __builtin_amdgcn_cosf((float)i * (1.0f / 4096.0f));
      if (i < 16384) { const int mm = i >> 7, k = i & 127, pp = mm >> 6, k1 = mm & 63, pk = k >> 6, t1 = k & 63; const float rev = (float)((k1 * t1) & 63) * (1.0f / 64.0f);
          const float c = __builtin_amdgcn_cosf(rev), sn = __builtin_amdgcn_sinf(rev);
          ((bf16_t*)(P.ws + WS_DFTM))[i] = (bf16_t)f2bf(pp == pk ? c : (pp == 0 ? sn : -sn)); } }
    for (int u = F.vcu; u < 192; u += F.G) {
        LAS float* s = (LAS float*)F.lds; LAS float* red = s + 9 * 1024;
        const int l = u / 96, j0 = (u % 96) * 64, tid = tid0;
        for (int i = tid; i < 9 * 1024; i += 512) { const int bb = i >> 10, k = i & 1023; const float v = bb < 8 ? P.c[bb * 1024 + k] : P.c_ctx[k]; s[i] = v * __builtin_amdgcn_rcpf(1.f + __builtin_amdgcn_exp2f(-1.4426950408889634f * v)); }
        __syncthreads();
        const int kc = tid >> 4, jq = tid & 15;
        const float* w = P.w_ada + (size_t)l * 1024 * 6144 + j0 + 4 * jq + (size_t)(kc * 32) * 6144;
        f32x4 wv[32];
#pragma unroll
        for (int q = 0; q < 32; ++q) wv[q] = *(const f32x4*)(w + (size_t)q * 6144);
        f32x4 acc[9];
#pragma unroll
        for (int b = 0; b < 9; ++b) acc[b] = (f32x4){0.f, 0.f, 0.f, 0.f};
#pragma unroll
        for (int qq = 0; qq < 8; ++qq)
#pragma unroll
            for (int b = 0; b < 9; ++b) { const f32x4 s4 = *(const LAS f32x4*)(s + b * 1024 + kc * 32 + 4 * qq);
                acc[b] += s4.x * wv[4 * qq] + s4.y * wv[4 * qq + 1] + s4.z * wv[4 * qq + 2] + s4.w * wv[4 * qq + 3]; }
#pragma unroll
        for (int b = 0; b < 9; ++b) *(LAS f32x4*)(red + (kc * 9 + b) * 64 + 4 * jq) = acc[b];
        __syncthreads();
        float* mod = (float*)(P.ws + WS_MOD);
        for (int i = tid; i < 9 * 64; i += 512) { const int b = i >> 6, j = i & 63; float v = P.b_ada[l * 6144 + j0 + j];
#pragma unroll
            for (int q = 0; q < 32; ++q) v += red[(q * 9 + b) * 64 + j];
            mod[(size_t)(l * 9 + b) * 6144 + j0 + j] = v; }
        __syncthreads();
    }
}
__device__ __forceinline__ void route_row(const Ptrs& P, int r, const f32x4 (&h)[4], int lane, bool publish, LAS unsigned* lcnt, LAS int* rec, const LAS float* rwl) {
    float lg[16];
#pragma unroll
    for (int e = 0; e < 16; ++e) lg[e] = 0.f;
#pragma unroll
    for (int j = 0; j < 4; ++j) {
#pragma unroll
        for (int i = 0; i < 4; ++i) { const int kk = 4 * lane + 256 * j + i; const LAS f32x4* rw = (const LAS f32x4*)(rwl + kk * 16 + (kk >> 2) * 4); const float hv = h[j][i];
#pragma unroll
            for (int qd = 0; qd < 4; ++qd) { const f32x4 w = rw[qd]; lg[4 * qd] += hv * w.x; lg[4 * qd + 1] += hv * w.y; lg[4 * qd + 2] += hv * w.z; lg[4 * qd + 3] += hv * w.w; } }
        __builtin_amdgcn_sched_barrier(0); }
    float v8[8], v4[4], v2[2], v1;
    { const bool bit = (lane & 32) != 0;
#pragma unroll
      for (int i = 0; i < 8; ++i) { const float a = lg[i], b = lg[i + 8]; v8[i] = (bit ? b : a) + shfl_xor_l(bit ? a : b, 32, lane); } }
    { const bool bit = (lane & 16) != 0;
#pragma unroll
      for (int i = 0; i < 4; ++i) { const float a = v8[i], b = v8[i + 4]; v4[i] = (bit ? b : a) + shfl_xor_l(bit ? a : b, 16, lane); } }
    { const bool bit = (lane & 8) != 0;
#pragma unroll
      for (int i = 0; i < 2; ++i) { const float a = v4[i], b = v4[i + 2]; v2[i] = (bit ? b : a) + shfl_xor_l(bit ? a : b, 8, lane); } }
    { const bool bit = (lane & 4) != 0; const float a = v2[0], b = v2[1]; v1 = (bit ? b : a) + shfl_xor_l(bit ? a : b, 4, lane); }
    v1 += shfl_xor_l(v1, 2, lane); v1 += shfl_xor_l(v1, 1, lane);
    float bestscore = -INFINITY; int be0 = 0, be1 = 1; float ba0 = 0.f, ba1 = 0.f;
#pragma unroll
    for (int g = 0; g < 4; ++g) {
        float aff[4], sel[4];
#pragma unroll
        for (int i = 0; i < 4; ++i) { const float t = __int_as_float(__builtin_amdgcn_ds_bpermute((4 * g + i) << 4, __float_as_int(v1))); aff[i] = __builtin_amdgcn_rcpf(1.0f + __builtin_amdgcn_exp2f(-1.4426950408889634f * t)); sel[i] = aff[i] + P.router_bias[4 * g + i]; }
        int i1 = 0; float m1 = sel[0], a1 = aff[0];
#pragma unroll
        for (int i = 1; i < 4; ++i) if (sel[i] > m1) { m1 = sel[i]; a1 = aff[i]; i1 = i; }
        int i2 = -1; float m2 = -INFINITY, a2 = 0.f;
#pragma unroll
        for (int i = 0; i < 4; ++i) if (i != i1 && sel[i] > m2) { m2 = sel[i]; a2 = aff[i]; i2 = i; }
        const float score = m1 + m2;
        if (score > bestscore) { bestscore = score; be0 = 4 * g + i1; be1 = 4 * g + i2; ba0 = a1; ba1 = a2; }
    }
    if (lane == 0 && publish) {
        const int p0 = (int)__hip_atomic_fetch_add(lcnt + be0, 1u, __ATOMIC_RELAXED, __HIP_MEMORY_SCOPE_WORKGROUP), p1 = (int)__hip_atomic_fetch_add(lcnt + be1, 1u, __ATOMIC_RELAXED, __HIP_MEMORY_SCOPE_WORKGROUP);
        const float inv = 1.0f / (ba0 + ba1);
        rec[0] = r; rec[1] = be0; rec[2] = p0; rec[3] = be1; rec[4] = p1; rec[5] = __float_as_int(ba0 * inv); rec[6] = __float_as_int(ba1 * inv);
    }
}
template <int MODE> __device__ __forceinline__ void ph_norm(const Frame& F, const Ptrs& P, int l, int nrows) {
    constexpr int NRW = MODE == 2 ? 2 : 4;
    const int lane = fresh_lane();
    const int stride = F.G * NWAVES;
    LAS unsigned* lcnt = (LAS unsigned*)F.lds; LAS unsigned* gbase = lcnt + 16; LAS int* recs = (LAS int*)(F.lds + 256);
    const LAS float* rwl = (const LAS float*)(F.lds + 8192);
    if (MODE == 2) { if (F.wave == 0 && lane < 16) lcnt[lane] = 0u;
        { const int tid = F.wave * 64 + lane; LAS f32x4* d = (LAS f32x4*)(F.lds + 8192);
#pragma unroll
          for (int i = 0; i < 8; ++i) { const int idx = tid + 512 * i, kk = idx >> 2; d[idx + (kk >> 2)] = ((const f32x4*)P.router_w)[idx]; } }
        __syncthreads(); }
    int it = 0;
    for (int rb = F.vcu * NWAVES + F.wave; rb < nrows; rb += NRW * stride, ++it) {
        int rr[NRW];
#pragma unroll
        for (int q = 0; q < NRW; ++q) rr[q] = rb + q * stride < nrows ? rb + q * stride : rb;
        f32x4 v[NRW][4];
#pragma unroll
        for (int q = 0; q < NRW; ++q) { const int r = rr[q];
            if (MODE == 0) { const f32x4* xr = (const f32x4*)xin_row(P, r) + lane;
#pragma unroll
                for (int j = 0; j < 4; ++j) v[q][j] = xr[64 * j]; }
            else { const bf16_t* xr = x1b_row(P, r) + 4 * lane;
#pragma unroll
                for (int j = 0; j < 4; ++j) v[q][j] = ld4b(xr + 256 * j); } }
        if (MODE == 1) {
#pragma unroll
            for (int q = 0; q < NRW; ++q) { const int r = rr[q]; const int bb = row_bb(r); const f32x4* g2 = (const f32x4*)mod_vec(P, l - 1, bb, 5) + lane;
                const u32x2* m0 = (const u32x2*)((const bf16_t*)(P.ws + WS_MO) + (size_t)r * D) + lane; const u32x2* m1 = (const u32x2*)((const bf16_t*)(P.ws + WS_MO) + (size_t)(R + r) * D) + lane;
#pragma unroll
                for (int j = 0; j < 4; ++j) { const u32x2 a = m0[64 * j], b = m1[64 * j]; const f32x4 g = g2[64 * j];
                    v[q][j].x += g.x * (lo16(a.x) + lo16(b.x)); v[q][j].y += g.y * (hi16(a.x) + hi16(b.x)); v[q][j].z += g.z * (lo16(a.y) + lo16(b.y)); v[q][j].w += g.w * (hi16(a.y) + hi16(b.y)); } }
#pragma unroll
            for (int q = 0; q < NRW; ++q) if (q == 0 || rr[q] != rr[0]) { bf16_t* xr = x1b_row(P, rr[q]) + 4 * lane;
#pragma unroll
                for (int j = 0; j < 4; ++j) st4b(xr + 256 * j, v[q][j]); }
        }
        float ss[NRW];
#pragma unroll
        for (int q = 0; q < NRW; ++q) { ss[q] = 0.f;
#pragma unroll
            for (int j = 0; j < 4; ++j) ss[q] += (v[q][j].x * v[q][j].x + v[q][j].y * v[q][j].y) + (v[q][j].z * v[q][j].z + v[q][j].w * v[q][j].w); }
#pragma unroll
        for (int o = 1; o < 64; o <<= 1) {
#pragma unroll
            for (int q = 0; q < NRW; ++q) ss[q] += shfl_xor_l(ss[q], o, lane); }
        const f32x4* gn = (const f32x4*)((MODE == 2 ? P.norm2 : P.norm1) + (size_t)l * D) + lane;
#pragma unroll
        for (int q = 0; q < NRW; ++q) { const int r = rr[q]; const int bb = row_bb(r);
            if (q > 0 && r == rr[0]) continue;
            const float rstd = 1.0f / sqrtf(ss[q] * (1.0f / D) + EPS);
            const f32x4* sh = (const f32x4*)mod_vec(P, l, bb, MODE == 2 ? 3 : 0) + lane;
            const f32x4* sc = (const f32x4*)mod_vec(P, l, bb, MODE == 2 ? 4 : 1) + lane;
            {
                float mx = 0.f;
#pragma unroll
                for (int j = 0; j < 4; ++j) { const f32x4 g = gn[64 * j], a = sh[64 * j], b = sc[64 * j];
                    v[q][j] = (v[q][j] * rstd * g) * (b + 1.0f) + a;
                    mx = fmaxf(mx, fmaxf(fmaxf(fabsf(v[q][j].x), fabsf(v[q][j].y)), fmaxf(fabsf(v[q][j].z), fabsf(v[q][j].w)))); }
#pragma unroll
                for (int o = 1; o < 64; o <<= 1) mx = fmaxf(mx, shfl_xor_l(mx, o, lane));
                const float inv = mx > 0.f ? 127.0f / mx : 0.f;
                unsigned* o8 = (unsigned*)(P.ws + WS_H + (size_t)r * D) + lane;
#pragma unroll
                for (int j = 0; j < 4; ++j) o8[64 * j] = q8x4(v[q][j].x, v[q][j].y, v[q][j].z, v[q][j].w, inv);
                if (lane == 0) ((float*)(P.ws + WS_SA))[r] = mx * (1.0f / 127.0f); } }
        if (MODE == 2) { LAS int* rec = recs + (F.wave * 24 + 2 * it) * 8;
            route_row(P, rr[0], v[0], lane, true, lcnt, rec, rwl); __builtin_amdgcn_sched_barrier(0);
            if (lane == 0 && rr[1] == rr[0]) rec[8] = -1;
            route_row(P, rr[1], v[1], lane, rr[1] != rr[0], lcnt, rec + 8, rwl); }
    }
    if (MODE == 2) {
        __syncthreads();
        const int tid = F.wave * 64 + lane;
        if (tid < 16) { const unsigned c = lcnt[tid]; gbase[tid] = c ? atomicAdd((unsigned*)(P.ws + WS_CTL) + CW_CNT + 1024 * l + 64 * tid, c) : 0u; }
        __syncthreads();
        if (lane == 0) for (int k = 0; k < 2 * it; ++k) { const LAS int* rec = recs + (F.wave * 24 + k) * 8; const int r = rec[0]; if (r < 0) continue;
            int* tokl = (int*)(P.ws + WS_TOKL); float* wl = (float*)(P.ws + WS_WL);
            const size_t i0 = (size_t)rec[1] * R + rec[2] + gbase[rec[1]], i1 = (size_t)rec[3] * R + rec[4] + gbase[rec[3]];
            tokl[i0] = 2 * r; wl[i0] = __int_as_float(rec[5]); tokl[i1] = 2 * r + 1; wl[i1] = __int_as_float(rec[6]); }
        __syncthreads();
    }
}
__device__ __forceinline__ void ph_norm2(const Frame& F, const Ptrs& P, int l, int nrows) {
    constexpr int AP = 2064, A_H = 8192, A_L = A_H + 16 * AP, PART = A_L + 16 * AP, LG = PART + 8192;
    const int lane = fresh_lane();
    LAS unsigned* lcnt = (LAS unsigned*)F.lds; LAS unsigned* gbase = lcnt + 16; LAS int* recs = (LAS int*)(F.lds + 256);
    if (F.wave == 0 && lane < 16) lcnt[lane] = 0u;
    bf16x8 bh[4], bl[4];
    { const float* rw = P.router_w + (size_t)(128 * F.wave + 8 * (lane >> 4)) * 16 + (lane & 15);
#pragma unroll
      for (int s = 0; s < 4; ++s) { float w[8];
#pragma unroll
          for (int j = 0; j < 8; ++j) w[j] = rw[(size_t)(32 * s + j) * 16];
          u32x4 h, lo; h.x = cvtpk(w[0], w[1]); h.y = cvtpk(w[2], w[3]); h.z = cvtpk(w[4], w[5]); h.w = cvtpk(w[6], w[7]);
          lo.x = cvtpk(w[0] - lo16(h.x), w[1] - hi16(h.x)); lo.y = cvtpk(w[2] - lo16(h.y), w[3] - hi16(h.y)); lo.z = cvtpk(w[4] - lo16(h.z), w[5] - hi16(h.z)); lo.w = cvtpk(w[6] - lo16(h.w), w[7] - hi16(h.w));
          bh[s] = __builtin_bit_cast(bf16x8, h); bl[s] = __builtin_bit_cast(bf16x8, lo); } }
    __syncthreads();
    const int ntiles = nrows >> 4;
    f32x4 v[2][4];
#define N2_LOAD(tile_) do { _Pragma("unroll") for (int q_ = 0; q_ < 2; ++q_) { const bf16_t* xr_ = x1b_row(P, (tile_) * 16 + 2 * F.wave + q_) + 4 * lane; \
        _Pragma("unroll") for (int j_ = 0; j_ < 4; ++j_) v[q_][j_] = ld4b(xr_ + 256 * j_); } } while (0)
#define N2_BAR() do { LDS_WAIT(); __builtin_amdgcn_s_barrier(); asm volatile("" ::: "memory"); } while (0)
    int tile = F.vcu, it = 0;
    if (tile < ntiles) N2_LOAD(tile);
    for (; tile < ntiles; tile += F.G, ++it) {
        const int rbase = tile * 16 + 2 * F.wave;
        float ss[2];
#pragma unroll
        for (int q = 0; q < 2; ++q) { ss[q] = 0.f;
#pragma unroll
            for (int j = 0; j < 4; ++j) ss[q] += (v[q][j].x * v[q][j].x + v[q][j].y * v[q][j].y) + (v[q][j].z * v[q][j].z + v[q][j].w * v[q][j].w); }
#pragma unroll
        for (int o = 1; o < 64; o <<= 1) { ss[0] += shfl_xor_l(ss[0], o, lane); ss[1] += shfl_xor_l(ss[1], o, lane); }
        const f32x4* gn = (const f32x4*)(P.norm2 + (size_t)l * D) + lane;
#pragma unroll
        for (int q = 0; q < 2; ++q) { const int r = rbase + q; const int bb = row_bb(r);
            const float rstd = 1.0f / sqrtf(ss[q] * (1.0f / D) + EPS);
            const f32x4* sh = (const f32x4*)mod_vec(P, l, bb, 3) + lane; const f32x4* sc = (const f32x4*)mod_vec(P, l, bb, 4) + lane;
            float mx = 0.f;
#pragma unroll
            for (int j = 0; j < 4; ++j) { const f32x4 g = gn[64 * j], a = sh[64 * j], b = sc[64 * j];
                v[q][j] = (v[q][j] * rstd * g) * (b + 1.0f) + a;
                mx = fmaxf(mx, fmaxf(fmaxf(fabsf(v[q][j].x), fabsf(v[q][j].y)), fmaxf(fabsf(v[q][j].z), fabsf(v[q][j].w)))); }
#pragma unroll
            for (int o = 1; o < 64; o <<= 1) mx = fmaxf(mx, shfl_xor_l(mx, o, lane));
            const float inv = mx > 0.f ? 127.0f / mx : 0.f;
            unsigned* o8 = (unsigned*)(P.ws + WS_H + (size_t)r * D) + lane;
            LAS unsigned char* ah = F.lds + A_H + (2 * F.wave + q) * AP + 8 * lane;
#pragma unroll
            for (int j = 0; j < 4; ++j) { const f32x4 x = v[q][j]; o8[64 * j] = q8x4(x.x, x.y, x.z, x.w, inv);
                u32x2 h, lo; h.x = cvtpk(x.x, x.y); h.y = cvtpk(x.z, x.w); lo.x = cvtpk(x.x - lo16(h.x), x.y - hi16(h.x)); lo.y = cvtpk(x.z - lo16(h.y), x.w - hi16(h.y));
                *(LAS u32x2*)(ah + 512 * j) = h; *(LAS u32x2*)(ah + (A_L - A_H) + 512 * j) = lo; }
            if (lane == 0) ((float*)(P.ws + WS_SA))[r] = mx * (1.0f / 127.0f); }
        { const int tn = tile + F.G; if (tn < ntiles) N2_LOAD(tn); }
        N2_BAR();
        f32x4 acc = (f32x4){0.f, 0.f, 0.f, 0.f};
        { const LAS unsigned char* ap = F.lds + A_H + (lane & 15) * AP + (128 * F.wave + 8 * (lane >> 4)) * 2;
#pragma unroll
          for (int s = 0; s < 4; ++s) { const bf16x8 xh = *(const LAS bf16x8*)(ap + 64 * s), xl = *(const LAS bf16x8*)(ap + (A_L - A_H) + 64 * s);
              acc = __builtin_amdgcn_mfma_f32_16x16x32_bf16(xh, bh[s], acc, 0, 0, 0); acc = __builtin_amdgcn_mfma_f32_16x16x32_bf16(xl, bh[s], acc, 0, 0, 0); acc = __builtin_amdgcn_mfma_f32_16x16x32_bf16(xh, bl[s], acc, 0, 0, 0); } }
        *(LAS f32x4*)(F.lds + PART + F.wave * 1024 + lane * 16) = acc;
        N2_BAR();
        if (F.wave < 4) { const int t = F.wave * 64 + lane, i = t >> 4, j = t & 15; const LAS float* sp = (const LAS float*)(F.lds + PART) + ((i >> 2) * 16 + j) * 4 + (i & 3); float sum = 0.f;
#pragma unroll
            for (int w = 0; w < 8; ++w) sum += sp[w * 256];
            ((LAS float*)(F.lds + LG))[t] = sum; }
        N2_BAR();
        { const int ri = 2 * F.wave + (lane >> 5), r = tile * 16 + ri;
          f32x4 L[4];
#pragma unroll
          for (int g = 0; g < 4; ++g) L[g] = *(const LAS f32x4*)(F.lds + LG + ri * 64 + 16 * g);
          float bestscore = -INFINITY; int be0 = 0, be1 = 1; float ba0 = 0.f, ba1 = 0.f;
#pragma unroll
          for (int g = 0; g < 4; ++g) {
              float aff[4], sel[4];
#pragma unroll
              for (int i = 0; i < 4; ++i) { const float t = L[g][i]; aff[i] = __builtin_amdgcn_rcpf(1.0f + __builtin_amdgcn_exp2f(-1.4426950408889634f * t)); sel[i] = aff[i] + P.router_bias[4 * g + i]; }
              int i1 = 0; float m1 = sel[0], a1 = aff[0];
#pragma unroll
              for (int i = 1; i < 4; ++i) if (sel[i] > m1) { m1 = sel[i]; a1 = aff[i]; i1 = i; }
              int i2 = -1; float m2 = -INFINITY, a2 = 0.f;
#pragma unroll
              for (int i = 0; i < 4; ++i) if (i != i1 && sel[i] > m2) { m2 = sel[i]; a2 = aff[i]; i2 = i; }
              const float score = m1 + m2;
              if (score > bestscore) { bestscore = score; be0 = 4 * g + i1; be1 = 4 * g + i2; ba0 = a1; ba1 = a2; }
          }
          if ((lane & 31) == 0) {
              const int p0 = (int)__hip_atomic_fetch_add(lcnt + be0, 1u, __ATOMIC_RELAXED, __HIP_MEMORY_SCOPE_WORKGROUP), p1 = (int)__hip_atomic_fetch_add(lcnt + be1, 1u, __ATOMIC_RELAXED, __HIP_MEMORY_SCOPE_WORKGROUP);
              const float inv = 1.0f / (ba0 + ba1); LAS int* rec = recs + (it * 16 + ri) * 8;
              rec[0] = r; rec[1] = be0; rec[2] = p0; rec[3] = be1; rec[4] = p1; rec[5] = __float_as_int(ba0 * inv); rec[6] = __float_as_int(ba1 * inv); } }
    }
#undef N2_LOAD
#undef N2_BAR
    __syncthreads();
    const int tid = F.wave * 64 + lane;
    if (tid < 16) { const unsigned c = lcnt[tid]; gbase[tid] = c ? atomicAdd((unsigned*)(P.ws + WS_CTL) + CW_CNT + 1024 * l + 64 * tid, c) : 0u; }
    __syncthreads();
    for (int k = tid; k < it * 16; k += NWAVES * 64) { const LAS int* rec = recs + k * 8; const int r = rec[0];
        int* tokl = (int*)(P.ws + WS_TOKL); float* wl = (float*)(P.ws + WS_WL);
        const size_t i0 = (size_t)rec[1] * R + rec[2] + gbase[rec[1]], i1 = (size_t)rec[3] * R + rec[4] + gbase[rec[3]];
        tokl[i0] = 2 * r; wl[i0] = __int_as_float(rec[5]); tokl[i1] = 2 * r + 1; wl[i1] = __int_as_float(rec[6]); }
    __syncthreads();
}
__device__ __forceinline__ void ph_kprep(const Frame& F, const Ptrs& P, int l) {
    const int lane = fresh_lane();
    const float* rc = (const float*)(P.ws + WS_ROPE); const float* rs = rc + 1024;
    const int hs = (lane >> 3) & 3, chunk = lane & 7, col = (hs < 2 ? C_KB + hs * 64 : C_KW + (hs - 2) * 64) + chunk * 8;
    const f32x4 g0 = *(const f32x4*)(P.k_gain + l * 64 + chunk * 8), g1 = *(const f32x4*)(P.k_gain + l * 64 + chunk * 8 + 4);
    const int a = chunk >> 2, fi = (chunk & 1) * 8; const bool second = (chunk & 2) != 0;
    const int npair = R / 2, stride = F.G * NWAVES;
    float km = 0.f;
    for (int pr0 = F.vcu * NWAVES + F.wave; pr0 < npair; pr0 += 4 * stride) {
        u32x4 w[4];
#pragma unroll
        for (int q = 0; q < 4; ++q) { const int pr = pr0 + q * stride; const int r = 2 * (pr < npair ? pr : pr0) + (lane >> 5); w[q] = *(const u32x4*)((const bf16_t*)(P.ws + WS_U) + (size_t)r * NIN + col); }
#pragma unroll
        for (int q = 0; q < 4; ++q) { const int pr = pr0 + q * stride; if (pr >= npair) break;
            const int r = 2 * pr + (lane >> 5);
            float x[8] = {lo16(w[q].x), hi16(w[q].x), lo16(w[q].y), hi16(w[q].y), lo16(w[q].z), hi16(w[q].z), lo16(w[q].w), hi16(w[q].w)};
            float ss = 0.f;
#pragma unroll
            for (int j = 0; j < 8; ++j) ss += x[j] * x[j];
            ss += shfl_xor_l(ss, 1, lane); ss += shfl_xor_l(ss, 2, lane); ss += shfl_xor_l(ss, 4, lane);
            if (hs >= 2) km = fmaxf(km, ss);
            if (hs < 2) {
                const float rstd = 1.0f / sqrtf(ss * (1.0f / 64.0f) + EPS);
                x[0] *= rstd * g0.x; x[1] *= rstd * g0.y; x[2] *= rstd * g0.z; x[3] *= rstd * g0.w; x[4] *= rstd * g1.x; x[5] *= rstd * g1.y; x[6] *= rstd * g1.z; x[7] *= rstd * g1.w; }
            if (r < RL) { const int t = r & (T - 1), pos = a ? (t & 63) : (t >> 6);
                const f32x4 c0 = *(const f32x4*)(rc + pos * 16 + fi), c1 = *(const f32x4*)(rc + pos * 16 + fi + 4), s0 = *(const f32x4*)(rs + pos * 16 + fi), s1 = *(const f32x4*)(rs + pos * 16 + fi + 4);
                const float cs[8] = {c0.x, c0.y, c0.z, c0.w, c1.x, c1.y, c1.z, c1.w}, sn[8] = {s0.x, s0.y, s0.z, s0.w, s1.x, s1.y, s1.z, s1.w};
#pragma unroll
                for (int j = 0; j < 8; ++j) { const float y = shfl_xor_l(x[j], 2, lane); x[j] = second ? x[j] * cs[j] + y * sn[j] : x[j] * cs[j] - y * sn[j]; } }
            u32x4 o; o.x = cvtpk(x[0], x[1]); o.y = cvtpk(x[2], x[3]); o.z = cvtpk(x[4], x[5]); o.w = cvtpk(x[6], x[7]);
            *(u32x4*)((bf16_t*)(P.ws + WS_U) + (size_t)r * NIN + col) = o; }
    }
    float qm = 0.f;
    for (int r0 = F.vcu * NWAVES + F.wave; r0 < RL; r0 += 8 * stride) {
        u32x4 w[8];
#pragma unroll
        for (int q = 0; q < 8; ++q) { const int r = r0 + q * stride < RL ? r0 + q * stride : r0; w[q] = *(const u32x4*)((const bf16_t*)(P.ws + WS_U) + (size_t)r * NIN + C_QW + lane * 8); }
#pragma unroll
        for (int q = 0; q < 8; ++q) { float ss = lo16(w[q].x) * lo16(w[q].x) + hi16(w[q].x) * hi16(w[q].x) + lo16(w[q].y) * lo16(w[q].y) + hi16(w[q].y) * hi16(w[q].y)
                                              + lo16(w[q].z) * lo16(w[q].z) + hi16(w[q].z) * hi16(w[q].z) + lo16(w[q].w) * lo16(w[q].w) + hi16(w[q].w) * hi16(w[q].w);
            ss += shfl_xor_l(ss, 1, lane); ss += shfl_xor_l(ss, 2, lane); ss += shfl_xor_l(ss, 4, lane); qm = fmaxf(qm, ss); }
    }
    qm = fmaxf(qm, shfl_xor_l(qm, 8, lane)); qm = fmaxf(qm, shfl_xor_l(qm, 16, lane));
    km = fmaxf(km, shfl_xor_l(km, 32, lane));
    LAS float* red = (LAS float*)F.lds;
    if (lane == 0) red[F.wave * 4] = qm; if (lane == 32) red[F.wave * 4 + 1] = qm; if (lane == 16) red[F.wave * 4 + 2] = km; if (lane == 24) red[F.wave * 4 + 3] = km;
    __syncthreads();
    if (F.wave == 0 && lane < 4) { float m = red[lane];
#pragma unroll
        for (int wv = 1; wv < 8; ++wv) m = fmaxf(m, red[wv * 4 + lane]);
        atomicMax((unsigned*)(P.ws + WS_CTL) + CW_QK + 64 * l + 16 * lane, __float_as_uint(m)); }
    __syncthreads();
}
__device__ __forceinline__ float pool_ch(const u32x2& w, int c) { const unsigned x = w[c >> 1]; return (c & 1) ? hi16(x) : lo16(x); }
template <int HW> __device__ __forceinline__ void pool_block(const u32x2 (&w)[32], int t0, int Ts, bf16_t* outp) {
    float S[4];
#pragma unroll
    for (int c = 0; c < 4; ++c) { S[c] = 0.f;
#pragma unroll
        for (int k = 8 - HW; k < 8 + HW; ++k) S[c] += pool_ch(w[k], c); }
#pragma unroll
    for (int j = 0; j < 16; ++j) {
        const int t = t0 + j, lo = t - HW < 0 ? 0 : t - HW, hi = t + HW > Ts ? Ts : t + HW; const float inv = 1.0f / (float)(hi - lo);
        float o[4];
#pragma unroll
        for (int c = 0; c < 4; ++c) o[c] = S[c] * inv - pool_ch(w[j + 8], c);
        u32x2 ow; ow.x = cvtpk(o[0], o[1]); ow.y = cvtpk(o[2], o[3]);
        *(u32x2*)(outp + (size_t)j * NBR) = ow;
        if (j < 15) {
#pragma unroll
            for (int c = 0; c < 4; ++c) S[c] += pool_ch(w[j + 8 + HW], c) - pool_ch(w[j + 8 - HW], c); }
    }
}
__device__ __forceinline__ void ph_pool(const Frame& F, const Ptrs& P, int nrows) {
    const int tid0 = fresh_tid();
    const int nblk = nrows >> 4, nit = nblk * 128;
    for (int i = F.vcu * 512 + tid0; i < nit; i += F.G * 512) {
        const int g = __builtin_amdgcn_readfirstlane((i >> 5) / nblk), blk = (i >> 5) - g * nblk, c4 = g * 128 + (i & 31) * 4;
        const int rb = blk * 16; const bool lat = rb < RL; const int Ts = lat ? T : TC; const int t0 = lat ? (rb & (T - 1)) : ((rb - RL) & (TC - 1)); const int r0 = rb - t0;
        const bf16_t* U = (const bf16_t*)(P.ws + WS_U) + C_P + c4;
        u32x2 w[32];
#pragma unroll
        for (int k = 0; k < 32; ++k) { const int tt = t0 - 8 + k; const bool ok = tt >= 0 && tt < Ts; w[k] = *(const u32x2*)(U + (size_t)(r0 + (ok ? tt : t0)) * NIN); }
#pragma unroll
        for (int k = 0; k < 32; ++k) { const int tt = t0 - 8 + k; if (!(tt >= 0 && tt < Ts)) w[k] = (u32x2){0u, 0u}; }
        bf16_t* outp = (bf16_t*)(P.ws + WS_BR) + (size_t)rb * NBR + 1536 + c4;
        if (g == 0) pool_block<1>(w, t0, Ts, outp); else if (g == 1) pool_block<2>(w, t0, Ts, outp); else if (g == 2) pool_block<4>(w, t0, Ts, outp); else pool_block<8>(w, t0, Ts, outp);
    }
}
__device__ __forceinline__ void ph_final(const Frame& F, const Ptrs& P, const int r_lo, const int RLh) {
    const int lane = fresh_lane(); const int stride = F.G * NWAVES;
    for (int rb = r_lo + F.vcu * NWAVES + F.wave; rb < RLh; rb += 4 * stride) {
        f32x4 v[4][4]; float ss[4];
#pragma unroll
        for (int q = 0; q < 4; ++q) { const int r = rb + q * stride < RLh ? rb + q * stride : rb; const int bb = row_bb(r);
            const bf16_t* xr = x1b_row(P, r) + 4 * lane; const f32x4* g2 = (const f32x4*)mod_vec(P, 1, bb, 5) + lane;
            const u32x2* m0 = (const u32x2*)((const bf16_t*)(P.ws + WS_MO) + (size_t)r * D) + lane; const u32x2* m1 = (const u32x2*)((const bf16_t*)(P.ws + WS_MO) + (size_t)(R + r) * D) + lane;
            ss[q] = 0.f;
#pragma unroll
            for (int j = 0; j < 4; ++j) { v[q][j] = ld4b(xr + 256 * j); const u32x2 a = m0[64 * j], b = m1[64 * j]; const f32x4 g = g2[64 * j];
                v[q][j].x += g.x * (lo16(a.x) + lo16(b.x)); v[q][j].y += g.y * (hi16(a.x) + hi16(b.x)); v[q][j].z += g.z * (lo16(a.y) + lo16(b.y)); v[q][j].w += g.w * (hi16(a.y) + hi16(b.y));
                ss[q] += (v[q][j].x * v[q][j].x + v[q][j].y * v[q][j].y) + (v[q][j].z * v[q][j].z + v[q][j].w * v[q][j].w); } }
#pragma unroll
        for (int o = 1; o < 64; o <<= 1) {
#pragma unroll
            for (int q = 0; q < 4; ++q) ss[q] += shfl_xor_l(ss[q], o, lane); }
        const f32x4* gn = (const f32x4*)P.norm_f + lane;
#pragma unroll
        for (int q = 0; q < 4; ++q) { const int r = rb + q * stride; if (r >= RLh) continue;
            const float rstd = 1.0f / sqrtf(ss[q] * (1.0f / D) + EPS); f32x4* xr = (f32x4*)(P.out + (size_t)r * D) + lane;
#pragma unroll
            for (int j = 0; j < 4; ++j) xr[64 * j] = v[q][j] * rstd * gn[64 * j]; }
    }
}

typedef float f32x16 __attribute__((ext_vector_type(16)));
typedef short v4i16_t __attribute__((ext_vector_type(4)));
constexpr float ATT_THR = 4.0f;
constexpr int AT_ROWB = 144, AT_TILEB = 64 * AT_ROWB;
constexpr int AT_VROWB = 192, AT_VTILEB = 64 * AT_VROWB;
constexpr int AT_STAGEB = 2 * AT_TILEB + 2 * AT_VTILEB;
#define AT_SB() __builtin_amdgcn_sched_barrier(0)
template <bool FIXED> __device__ __forceinline__ void at_qk1(const LAS unsigned char* Kt, int kf_off, const bf16x8 (&qr)[4], const f32x16& negm_, f32x16& p0, f32x16& p1) {
    f32x16 zc;
#pragma unroll
    for (int r = 0; r < 16; ++r) zc[r] = 0.f;
    const f32x16& negm = FIXED ? zc : negm_;
    bf16x8 ka[8];
#pragma unroll
    for (int d0 = 0; d0 < 4; ++d0) { ka[2 * d0] = *(const LAS bf16x8*)(Kt + kf_off + d0 * 32); ka[2 * d0 + 1] = *(const LAS bf16x8*)(Kt + kf_off + 32 * AT_ROWB + d0 * 32); }
    p0 = __builtin_amdgcn_mfma_f32_32x32x16_bf16(ka[0], qr[0], negm, 0, 0, 0); p1 = __builtin_amdgcn_mfma_f32_32x32x16_bf16(ka[1], qr[0], negm, 0, 0, 0);
#pragma unroll
    for (int d0 = 1; d0 < 4; ++d0) { p0 = __builtin_amdgcn_mfma_f32_32x32x16_bf16(ka[2 * d0], qr[d0], p0, 0, 0, 0); p1 = __builtin_amdgcn_mfma_f32_32x32x16_bf16(ka[2 * d0 + 1], qr[d0], p1, 0, 0, 0); }
}
__device__ __forceinline__ void at_vread(const LAS unsigned char* vp, v4i16_t (&f)[4]) {
    f[0] = __builtin_amdgcn_ds_read_tr16_b64_v4i16((LAS v4i16_t*)(vp)); f[1] = __builtin_amdgcn_ds_read_tr16_b64_v4i16((LAS v4i16_t*)(vp + 8 * AT_VROWB));
    f[2] = __builtin_amdgcn_ds_read_tr16_b64_v4i16((LAS v4i16_t*)(vp + 64)); f[3] = __builtin_amdgcn_ds_read_tr16_b64_v4i16((LAS v4i16_t*)(vp + 8 * AT_VROWB + 64));
}
__device__ __forceinline__ bf16x8 at_ppack(const f32x16& p, int sx) { u32x4 pw; pw.x = cvtpk(p[8 * sx], p[8 * sx + 1]); pw.y = cvtpk(p[8 * sx + 2], p[8 * sx + 3]); pw.z = cvtpk(p[8 * sx + 4], p[8 * sx + 5]); pw.w = cvtpk(p[8 * sx + 6], p[8 * sx + 7]); return __builtin_bit_cast(bf16x8, pw); }
__device__ __forceinline__ void at_pvmm(const v4i16_t (&f)[4], const bf16x8 pf, f32x16& o0, f32x16& o1) {
    const bf16x8 v0 = (bf16x8){f[0][0], f[0][1], f[0][2], f[0][3], f[1][0], f[1][1], f[1][2], f[1][3]}, v1 = (bf16x8){f[2][0], f[2][1], f[2][2], f[2][3], f[3][0], f[3][1], f[3][2], f[3][3]};
    o0 = __builtin_amdgcn_mfma_f32_32x32x16_bf16(v0, pf, o0, 0, 0, 0); o1 = __builtin_amdgcn_mfma_f32_32x32x16_bf16(v1, pf, o1, 0, 0, 0);
}
__device__ __forceinline__ float at_exp8(f32x16& p, int sx) { float rs = 0.f;
#pragma unroll
    for (int j = 0; j < 8; ++j) { p[8 * sx + j] = __builtin_amdgcn_exp2f(p[8 * sx + j]); rs += p[8 * sx + j]; }
    return rs; }
template <bool FIXED> __device__ __forceinline__ float at_slot(const LAS unsigned char* Vt, const LAS unsigned char* Kn, const bool hasnext, int kf_off, int vf_off, const bf16x8 (&qr)[4], const f32x16& negm_,
                                         f32x16& pc0, f32x16& pc1, f32x16& pn0, f32x16& pn1, f32x16& o0, f32x16& o1) {
    f32x16 zc;
#pragma unroll
    for (int r = 0; r < 16; ++r) zc[r] = 0.f;
    const f32x16& negm = FIXED ? zc : negm_;
    v4i16_t fA[4], fB[4]; bf16x8 ka0, ka1, kb0, kb1; float rs;
#define AT_KLD(A0, A1, d0) do { A0 = *(const LAS bf16x8*)(Kn + kf_off + (d0) * 32); A1 = *(const LAS bf16x8*)(Kn + kf_off + 32 * AT_ROWB + (d0) * 32); } while (0)
    if (FIXED) AT_KLD(ka0, ka1, 0);
    at_vread(Vt + vf_off, fA); rs = at_exp8(pc0, 0); AT_SB();
    at_vread(Vt + vf_off + 16 * AT_VROWB, fB); if (FIXED) AT_KLD(kb0, kb1, 1); else AT_KLD(ka0, ka1, 0);
    if (hasnext) { pn0 = __builtin_amdgcn_mfma_f32_32x32x16_bf16(ka0, qr[0], negm, 0, 0, 0); pn1 = __builtin_amdgcn_mfma_f32_32x32x16_bf16(ka1, qr[0], negm, 0, 0, 0); }
    at_pvmm(fA, at_ppack(pc0, 0), o0, o1); rs += at_exp8(pc0, 1); AT_SB();
    at_vread(Vt + vf_off + 32 * AT_VROWB, fA); if (FIXED) AT_KLD(ka0, ka1, 2); else AT_KLD(kb0, kb1, 1);
    if (hasnext) { pn0 = __builtin_amdgcn_mfma_f32_32x32x16_bf16(kb0, qr[1], pn0, 0, 0, 0); pn1 = __builtin_amdgcn_mfma_f32_32x32x16_bf16(kb1, qr[1], pn1, 0, 0, 0); }
    at_pvmm(fB, at_ppack(pc0, 1), o0, o1); rs += at_exp8(pc1, 0); AT_SB();
    at_vread(Vt + vf_off + 48 * AT_VROWB, fB); if (FIXED) AT_KLD(kb0, kb1, 3); else AT_KLD(ka0, ka1, 2);
    if (hasnext) { pn0 = __builtin_amdgcn_mfma_f32_32x32x16_bf16(ka0, qr[2], pn0, 0, 0, 0); pn1 = __builtin_amdgcn_mfma_f32_32x32x16_bf16(ka1, qr[2], pn1, 0, 0, 0); }
    at_pvmm(fA, at_ppack(pc1, 0), o0, o1); rs += at_exp8(pc1, 1); AT_SB();
    if (!FIXED) AT_KLD(kb0, kb1, 3);
    if (hasnext) { pn0 = __builtin_amdgcn_mfma_f32_32x32x16_bf16(kb0, qr[3], pn0, 0, 0, 0); pn1 = __builtin_amdgcn_mfma_f32_32x32x16_bf16(kb1, qr[3], pn1, 0, 0, 0); }
    at_pvmm(fB, at_ppack(pc1, 1), o0, o1);
#undef AT_KLD
    return rs;
}
template <int MODE, bool FIXED> __device__ __forceinline__ void ph_attn_impl(const Frame& F, const Ptrs& P, int l) {
    const bool latq = MODE < 2; const bool winm = (MODE == 1 || MODE == 3);
    const int NU = latq ? 1024 : 64;
    LAS unsigned char* Lb = F.lds;
    constexpr bool fixedref = FIXED;
    for (int u = F.vcu; u < NU; u += F.G) {
        const int lane = fresh_lane(), tid = F.wave * 64 + lane, r32 = lane & 31, hi = lane >> 5;
        const bf16_t* U = (const bf16_t*)(P.ws + WS_U);
        const int st_off = (tid >> 3) * AT_ROWB + (tid & 7) * 16;
        const int kf_off = r32 * AT_ROWB + hi * 16;
        const int sv_off = (tid >> 3) * AT_VROWB + (tid & 7) * 16;
        const int vf_off = (4 * hi + ((lane & 15) >> 2)) * AT_VROWB + (((lane >> 4) & 1) * 16 + (lane & 3) * 4) * 2;
        const int qb = latq ? (u & 63) : (u & 3), g = latq ? ((u >> 6) & 1) : ((u >> 2) & 1), b = latq ? (u >> 7) : (u >> 3);
        const int tq0 = qb * 64, hq = 4 * g + (F.wave >> 1), tq = tq0 + 32 * (F.wave & 1) + r32;
        const int qrow = latq ? b * T + tq : RL + b * TC + tq;
        const int qcol = (winm ? C_QW : C_QB) + hq * 64, kcol = (winm ? C_KW : C_KB) + g * 64, vcol = (winm ? C_VW : C_VB) + g * 64;
        int lt_lo = 0, lt_hi = 0;
        if (MODE == 0) { lt_lo = 0; lt_hi = T / 64; }
        if (MODE == 1) { lt_lo = (tq0 - 128 < 0 ? 0 : tq0 - 128) / 64; lt_hi = (tq0 + 192 > T ? T : tq0 + 192) / 64; }
        const int ntiles = 4 + (lt_hi - lt_lo), npairs = (ntiles + 1) >> 1;
        bf16x8 qr[4];
        {
            float x[4][8];
#pragma unroll
            for (int d0 = 0; d0 < 4; ++d0) { const u32x4 wq = *(const u32x4*)(U + (size_t)qrow * NIN + qcol + d0 * 16 + hi * 8);
                x[d0][0] = lo16(wq.x); x[d0][1] = hi16(wq.x); x[d0][2] = lo16(wq.y); x[d0][3] = hi16(wq.y); x[d0][4] = lo16(wq.z); x[d0][5] = hi16(wq.z); x[d0][6] = lo16(wq.w); x[d0][7] = hi16(wq.w); }
            if (!winm) { float ss = 0.f;
#pragma unroll
                for (int d0 = 0; d0 < 4; ++d0)
#pragma unroll
                    for (int j = 0; j < 8; ++j) ss += x[d0][j] * x[d0][j];
                ss += shfl_xor_l(ss, 32, lane);
                const float rstd = 1.0f / sqrtf(ss * (1.0f / 64.0f) + EPS);
#pragma unroll
                for (int d0 = 0; d0 < 4; ++d0) { const f32x4 ga = *(const f32x4*)(P.q_gain + l * 64 + d0 * 16 + hi * 8), gb = *(const f32x4*)(P.q_gain + l * 64 + d0 * 16 + hi * 8 + 4);
                    x[d0][0] *= rstd * ga.x; x[d0][1] *= rstd * ga.y; x[d0][2] *= rstd * ga.z; x[d0][3] *= rstd * ga.w; x[d0][4] *= rstd * gb.x; x[d0][5] *= rstd * gb.y; x[d0][6] *= rstd * gb.z; x[d0][7] *= rstd * gb.w; } }
            if (latq) { const float* rc = (const float*)(P.ws + WS_ROPE); const float* rs = rc + 1024;
#pragma unroll
                for (int a = 0; a < 2; ++a) { const int pos = a ? (tq & 63) : (tq >> 6);
                    const f32x4 c0 = *(const f32x4*)(rc + pos * 16 + hi * 8), c1 = *(const f32x4*)(rc + pos * 16 + hi * 8 + 4), s0 = *(const f32x4*)(rs + pos * 16 + hi * 8), s1 = *(const f32x4*)(rs + pos * 16 + hi * 8 + 4);
                    const float cs[8] = {c0.x, c0.y, c0.z, c0.w, c1.x, c1.y, c1.z, c1.w}, sn[8] = {s0.x, s0.y, s0.z, s0.w, s1.x, s1.y, s1.z, s1.w};
#pragma unroll
                    for (int j = 0; j < 8; ++j) { const float x1 = x[2 * a][j], x2 = x[2 * a + 1][j]; x[2 * a][j] = x1 * cs[j] - x2 * sn[j]; x[2 * a + 1][j] = x2 * cs[j] + x1 * sn[j]; } } }
#pragma unroll
            for (int d0 = 0; d0 < 4; ++d0) { u32x4 wq; wq.x = cvtpk(x[d0][0] * QSCALE, x[d0][1] * QSCALE); wq.y = cvtpk(x[d0][2] * QSCALE, x[d0][3] * QSCALE); wq.z = cvtpk(x[d0][4] * QSCALE, x[d0][5] * QSCALE); wq.w = cvtpk(x[d0][6] * QSCALE, x[d0][7] * QSCALE);
                qr[d0] = __builtin_bit_cast(bf16x8, wq); }
        }
        f32x16 o0, o1, negm;
#pragma unroll
        for (int r = 0; r < 16; ++r) { o0[r] = 0.f; o1[r] = 0.f; negm[r] = 0.f; }
        float mhat = 0.f, lsum = 0.f;
#define AT_KROW(ti) ((ti) < 4 ? RL + b * TC + (ti) * 64 : b * T + (lt_lo + (ti) - 4) * 64)
        u32x4 ka, va, kb2, vb2;
#define AT_LOADPAIR(pp) do { const int na_ = 2 * (pp), nb_ = (2 * (pp) + 1 < ntiles) ? 2 * (pp) + 1 : na_; \
            const int r0_ = AT_KROW(na_) + (tid >> 3), r1_ = AT_KROW(nb_) + (tid >> 3); const int co_ = (tid & 7) * 8; \
            ka = *(const u32x4*)(U + (size_t)r0_ * NIN + kcol + co_); va = *(const u32x4*)(U + (size_t)r0_ * NIN + vcol + co_); \
            kb2 = *(const u32x4*)(U + (size_t)r1_ * NIN + kcol + co_); vb2 = *(const u32x4*)(U + (size_t)r1_ * NIN + vcol + co_); } while (0)
#define AT_WRITEPAIR(off) do { *(LAS u32x4*)(Lb + (off) + st_off) = ka; *(LAS u32x4*)(Lb + (off) + AT_TILEB + st_off) = kb2; \
            *(LAS u32x4*)(Lb + (off) + 2 * AT_TILEB + sv_off) = va; *(LAS u32x4*)(Lb + (off) + 2 * AT_TILEB + AT_VTILEB + sv_off) = vb2; } while (0)
#define AT_MASK(ti, P0, P1) do { if (MODE == 1) { float ninf_ = -INFINITY; asm volatile("" : "+v"(ninf_));     \
            if ((ti) >= ntiles) { _Pragma("unroll") for (int r = 0; r < 16; ++r) { P0[r] = ninf_; P1[r] = ninf_; } } \
            else if ((ti) >= 4) { const int kb0_ = (lt_lo + (ti) - 4) * 64, qlo_ = tq0 + 32 * (F.wave & 1); \
                if (kb0_ + 63 - qlo_ > 128 || qlo_ + 31 - kb0_ > 128) { const int kp0_ = kb0_ + 4 * hi - tq; \
                    _Pragma("unroll") for (int r = 0; r < 16; ++r) { const int dl_ = kp0_ + (r & 3) + 8 * (r >> 2); \
                        if (dl_ > 128 || dl_ < -128) P0[r] = ninf_; if (dl_ + 32 > 128 || dl_ + 32 < -128) P1[r] = ninf_; } } } } } while (0)
#define AT_REF(first, P0, P1) do { if (!fixedref) { float mx_ = fmaxf(P0[0], P1[0]); \
            _Pragma("unroll") for (int r = 1; r < 16; ++r) mx_ = fmaxf(mx_, fmaxf(P0[r], P1[r])); \
            mx_ = fmaxf(mx_, shfl_xor_l(mx_, 32, lane)); \
            if ((first) || __any(mx_ > ATT_THR)) { const float dl_ = (first) ? mx_ : fmaxf(mx_, 0.f); mhat += dl_; \
                const float al_ = __builtin_amdgcn_exp2f(-dl_); lsum *= al_; \
                _Pragma("unroll") for (int r = 0; r < 16; ++r) { P0[r] -= dl_; P1[r] -= dl_; o0[r] *= al_; o1[r] *= al_; negm[r] = -mhat; } } } } while (0)
        AT_LOADPAIR(0); AT_WRITEPAIR(0);
        if (npairs > 1) { AT_LOADPAIR(1); AT_WRITEPAIR(AT_STAGEB); }
        if (npairs > 2) AT_LOADPAIR(2);
        __syncthreads();
        f32x16 pc0, pc1, pn0, pn1;
        at_qk1<FIXED>(Lb, kf_off, qr, negm, pc0, pc1);
        AT_REF(true, pc0, pc1);
#pragma unroll
        for (int r = 0; r < 16; ++r) { pn0[r] = 0.f; pn1[r] = 0.f; }
        int scur = 0, snxt = AT_STAGEB, swr = 2 * AT_STAGEB;
        for (int tp = 0; tp < npairs; ++tp) {
            if (tp + 2 < npairs) { AT_WRITEPAIR(swr); if (tp + 3 < npairs) AT_LOADPAIR(tp + 3); }
            lsum += at_slot<FIXED>(Lb + scur + 2 * AT_TILEB, Lb + scur + AT_TILEB, true, kf_off, vf_off, qr, negm, pc0, pc1, pn0, pn1, o0, o1);
            AT_MASK(2 * tp + 1, pn0, pn1);
            AT_REF(false, pn0, pn1);
            const bool more = tp + 1 < npairs;
            lsum += at_slot<FIXED>(Lb + scur + 2 * AT_TILEB + AT_VTILEB, Lb + snxt, more, kf_off, vf_off, qr, negm, pn0, pn1, pc0, pc1, o0, o1);
            if (more) { AT_MASK(2 * tp + 2, pc0, pc1); AT_REF(false, pc0, pc1); }
            __syncthreads();
            { const int t_ = scur; scur = snxt; snxt = swr; swr = t_; }
        }
#undef AT_KROW
#undef AT_LOADPAIR
#undef AT_WRITEPAIR
#undef AT_MASK
#undef AT_REF
        lsum += shfl_xor_l(lsum, 32, lane);
        if (winm) lsum += __builtin_amdgcn_exp2f(P.sink[l * 8 + hq] * LOG2E - mhat);
        const float inv = 1.0f / lsum;
        bf16_t* op = (bf16_t*)(P.ws + WS_BR) + (size_t)qrow * NBR + (winm ? 1024 : 512) + hq * 64 + 4 * hi;
#pragma unroll
        for (int gq = 0; gq < 4; ++gq) {
            u32x2 w0, w1; w0.x = cvtpk(o0[4 * gq] * inv, o0[4 * gq + 1] * inv); w0.y = cvtpk(o0[4 * gq + 2] * inv, o0[4 * gq + 3] * inv);
            w1.x = cvtpk(o1[4 * gq] * inv, o1[4 * gq + 1] * inv); w1.y = cvtpk(o1[4 * gq + 2] * inv, o1[4 * gq + 3] * inv);
            *(u32x2*)(op + 8 * gq) = w0; *(u32x2*)(op + 32 + 8 * gq) = w1; }
    }
}

template <int MODE> __device__ __forceinline__ void ph_attn(const Frame& F, const Ptrs& P, int l) {
    if (MODE == 3) { ph_attn_impl<MODE, false>(F, P, l); return; }
    const int lane = fresh_lane();
    if (MODE == 1) {
        const unsigned* qk = (const unsigned*)(P.ws + WS_CTL) + CW_QK + 64 * l;
        const float q2 = fmaxf(__uint_as_float(qk[0]), __uint_as_float(qk[16])), k2 = fmaxf(__uint_as_float(qk[32]), __uint_as_float(qk[48]));
        const float b2 = (QSCALE * 1.02f) * (QSCALE * 1.02f) * q2 * k2;
        if (__builtin_amdgcn_readfirstlane(b2 < 48.0f * 48.0f ? 1 : 0)) ph_attn_impl<MODE, true>(F, P, l); else ph_attn_impl<MODE, false>(F, P, l);
        return; }
    float mq = fabsf(P.q_gain[l * 64 + lane]), mk = fabsf(P.k_gain[l * 64 + lane]);
#pragma unroll
    for (int o = 1; o < 64; o <<= 1) { mq = fmaxf(mq, shfl_xor_l(mq, o, lane)); mk = fmaxf(mk, shfl_xor_l(mk, o, lane)); }
    const float sbound = 64.0f * QSCALE * 1.02f * mq * mk;
    if (__builtin_amdgcn_readfirstlane(sbound < 48.0f ? 1 : 0)) ph_attn_impl<MODE, true>(F, P, l); else ph_attn_impl<MODE, false>(F, P, l);
}

__device__ __forceinline__ void ph_ctx_r4(const Frame& F, const Ptrs& P) {
    const int tid0 = fresh_tid(); const float* ct = (const float*)(P.ws + WS_COS);
    for (int it = F.vcu * 512 + tid0; it < 8 * 64 * 64; it += F.G * 512) {
        const int c8 = (it & 63) * 8, t2 = (it >> 6) & 63, b = it >> 12;
        bf16_t* base = (bf16_t*)(P.ws + WS_U) + (size_t)(RL + b * TC + t2) * NIN + c8;
        u32x4 zr[4], zi[4];
#pragma unroll
        for (int t1 = 0; t1 < 4; ++t1) { zr[t1] = *(const u32x4*)(base + (size_t)(64 * t1) * NIN + C_ZR); zi[t1] = *(const u32x4*)(base + (size_t)(64 * t1) * NIN + C_ZI); }
        float tc[4], ts[4];
#pragma unroll
        for (int k1 = 0; k1 < 4; ++k1) { const int ang = (t2 * k1 * 16) & 4095; tc[k1] = ct[ang]; ts[k1] = ct[(ang - 1024) & 4095]; }
        u32x4 orr[4], oi[4];
#pragma unroll
        for (int w = 0; w < 4; ++w) {
            float xr[4][2], xi[4][2];
#pragma unroll
            for (int t1 = 0; t1 < 4; ++t1) { xr[t1][0] = lo16(zr[t1][w]); xr[t1][1] = hi16(zr[t1][w]); xi[t1][0] = lo16(zi[t1][w]); xi[t1][1] = hi16(zi[t1][w]); }
            float yr[4][2], yi[4][2];
#pragma unroll
            for (int e = 0; e < 2; ++e) {
                const float sr = xr[0][e] + xr[2][e], dr = xr[0][e] - xr[2][e], si = xi[0][e] + xi[2][e], di = xi[0][e] - xi[2][e];
                const float pr = xr[1][e] + xr[3][e], qr = xr[1][e] - xr[3][e], pi = xi[1][e] + xi[3][e], qi = xi[1][e] - xi[3][e];
                float ar[4], ai[4];
                ar[0] = sr + pr; ai[0] = si + pi;
                ar[1] = dr + qi; ai[1] = di - qr;
                ar[2] = sr - pr; ai[2] = si - pi;
                ar[3] = dr - qi; ai[3] = di + qr;
#pragma unroll
                for (int k1 = 0; k1 < 4; ++k1) { yr[k1][e] = ar[k1] * tc[k1] + ai[k1] * ts[k1]; yi[k1][e] = ai[k1] * tc[k1] - ar[k1] * ts[k1]; }
            }
#pragma unroll
            for (int k1 = 0; k1 < 4; ++k1) { orr[k1][w] = cvtpk(yr[k1][0], yr[k1][1]); oi[k1][w] = cvtpk(yi[k1][0], yi[k1][1]); }
        }
#pragma unroll
        for (int k1 = 0; k1 < 4; ++k1) { *(u32x4*)(base + (size_t)(64 * k1) * NIN + C_ZR) = orr[k1]; *(u32x4*)(base + (size_t)(64 * k1) * NIN + C_ZI) = oi[k1]; }
    }
}
constexpr int DF_ROWB = 528, DF_WROWB = 272;
template <int STAGE, bool CTX = false> __device__ __forceinline__ void ph_dft(const Frame& F, const Ptrs& P) {
    constexpr int NUN = CTX ? 64 : 1024;
    const int lane = fresh_lane(), tid = F.wave * 64 + lane, r32 = lane & 31, hi = lane >> 5, w = F.wave;
    bf16_t* U = (bf16_t*)(P.ws + WS_U); bf16_t* BR = (bf16_t*)(P.ws + WS_BR); const bf16_t* Wm = (const bf16_t*)(P.ws + WS_DFTM);
    LAS unsigned char* Xl = F.lds;
    LAS unsigned char* Wl = F.lds + 128 * DF_ROWB;
#pragma unroll
    for (int i = 0; i < 4; ++i) { const int idx = tid + 512 * i; *(LAS u32x4*)(Wl + (idx >> 4) * DF_WROWB + (idx & 15) * 16) = *(const u32x4*)(Wm + (idx >> 4) * 128 + (idx & 15) * 8); }
    const int xf_off = (8 * hi + ((lane & 15) >> 2)) * DF_ROWB + (32 * w + ((lane >> 4) & 1) * 16 + (lane & 3) * 4) * 2;
    constexpr int NMB = STAGE == 2 ? 4 : 2;
    const int seg = tid >> 2, part = tid & 3, pp = seg >> 6, jj = seg & 63;
    u32x4 pf[8];
    if (F.vcu < NUN) { const int u = F.vcu; const int chb = u & 1, sidx = CTX ? (u >> 1) & 3 : (u >> 1) & 63, b = CTX ? u >> 3 : u >> 7;
        const int grow = CTX ? RL + b * TC + 64 * sidx + jj : (STAGE == 2 ? b * T + 64 * jj + sidx : b * T + 64 * sidx + jj);
        const u32x4* src = (const u32x4*)(U + (size_t)grow * NIN + pp * 512 + chb * 256 + part * 64);
#pragma unroll
        for (int i = 0; i < 8; ++i) pf[i] = src[i]; }
    for (int u = F.vcu; u < NUN; u += F.G) {
        const int chb = u & 1, sidx = CTX ? (u >> 1) & 3 : (u >> 1) & 63, b = CTX ? u >> 3 : u >> 7;
#pragma unroll
        for (int i = 0; i < 8; ++i) *(LAS u32x4*)(Xl + seg * DF_ROWB + part * 128 + i * 16) = pf[i];
        if (u + F.G < NUN) { const int un = u + F.G; const int chbn = un & 1, sn = CTX ? (un >> 1) & 3 : (un >> 1) & 63, bn = CTX ? un >> 3 : un >> 7;
            const int grow = CTX ? RL + bn * TC + 64 * sn + jj : (STAGE == 2 ? bn * T + 64 * jj + sn : bn * T + 64 * sn + jj);
            const u32x4* src = (const u32x4*)(U + (size_t)grow * NIN + pp * 512 + chbn * 256 + part * 64);
#pragma unroll
            for (int i = 0; i < 8; ++i) pf[i] = src[i]; }
        __syncthreads();
        f32x16 acc[NMB];
#pragma unroll
        for (int mb = 0; mb < NMB; ++mb)
#pragma unroll
            for (int r = 0; r < 16; ++r) acc[mb][r] = 0.f;
#pragma unroll
        for (int ks = 0; ks < 8; ++ks) {
            const v4i16_t lo4 = __builtin_amdgcn_ds_read_tr16_b64_v4i16((LAS v4i16_t*)(Xl + xf_off + (16 * ks) * DF_ROWB));
            const v4i16_t hi4 = __builtin_amdgcn_ds_read_tr16_b64_v4i16((LAS v4i16_t*)(Xl + xf_off + (16 * ks + 4) * DF_ROWB));
            const bf16x8 xf = (bf16x8){lo4[0], lo4[1], lo4[2], lo4[3], hi4[0], hi4[1], hi4[2], hi4[3]};
#pragma unroll
            for (int mb = 0; mb < NMB; ++mb) { const bf16x8 wf = *(const LAS bf16x8*)(Wl + (mb * 32 + r32) * DF_WROWB + (16 * ks + 8 * hi) * 2);
                acc[mb] = __builtin_amdgcn_mfma_f32_32x32x16_bf16(xf, wf, acc[mb], 0, 0, 0); }
        }
        LAS unsigned char* ob = Xl + (32 * w + 4 * hi) * 2;
        if (STAGE == 2) {
#pragma unroll
            for (int mb = 0; mb < 2; ++mb) { const int k1 = mb * 32 + r32; const float rev = (float)((k1 * sidx) & 4095) * (1.0f / 4096.0f);
                const float ct = __builtin_amdgcn_cosf(rev), st = __builtin_amdgcn_sinf(rev);
#pragma unroll
                for (int gq = 0; gq < 4; ++gq) { u32x2 wr, wi; float yr[4], yi[4];
#pragma unroll
                    for (int i = 0; i < 4; ++i) { const float a = acc[mb][4 * gq + i], bq = acc[mb + 2][4 * gq + i]; yr[i] = a * ct + bq * st; yi[i] = bq * ct - a * st; }
                    wr.x = cvtpk(yr[0], yr[1]); wr.y = cvtpk(yr[2], yr[3]); wi.x = cvtpk(yi[0], yi[1]); wi.y = cvtpk(yi[2], yi[3]);
                    *(LAS u32x2*)(ob + k1 * DF_ROWB + 16 * gq) = wr; *(LAS u32x2*)(ob + (64 + k1) * DF_ROWB + 16 * gq) = wi; } }
        } else {
#pragma unroll
            for (int mb = 0; mb < 2; ++mb) { const int k2 = mb * 32 + r32;
#pragma unroll
                for (int gq = 0; gq < 4; ++gq) { constexpr float osc = CTX ? 0.0625f : 0.015625f; u32x2 wr; wr.x = cvtpk(acc[mb][4 * gq] * osc, acc[mb][4 * gq + 1] * osc); wr.y = cvtpk(acc[mb][4 * gq + 2] * osc, acc[mb][4 * gq + 3] * osc);
                    *(LAS u32x2*)(ob + k2 * DF_ROWB + 16 * gq) = wr; } }
        }
        __syncthreads();
        if (STAGE == 2) {
            u32x4* dst = (u32x4*)(U + (size_t)(b * T + 64 * jj + sidx) * NIN + pp * 512 + chb * 256 + part * 64);
#pragma unroll
            for (int i = 0; i < 8; ++i) dst[i] = *(const LAS u32x4*)(Xl + seg * DF_ROWB + part * 128 + i * 16);
        } else { const int k2 = tid >> 3, part8 = tid & 7;
            u32x4* dst = (u32x4*)(BR + (size_t)(CTX ? RL + b * TC + 4 * k2 + sidx : b * T + 64 * k2 + sidx) * NBR + chb * 256 + part8 * 32);
#pragma unroll
            for (int i = 0; i < 4; ++i) dst[i] = *(const LAS u32x4*)(Xl + k2 * DF_ROWB + part8 * 64 + i * 16); }
        __syncthreads();
    }
    if (CTX) __syncthreads();
}

struct MegaArgs { Ptrs P; int ph_lo, ph_hi, li, pad; };
__global__ void __launch_bounds__(NWAVES * 64, 2) mega(MegaArgs args) {
    extern __shared__ __attribute__((aligned(16))) unsigned char lds_raw[];
    Frame F; F.lds = (LAS unsigned char*)lds_raw;
    F.wave = __builtin_amdgcn_readfirstlane(threadIdx.x >> 6);
    F.G = gridDim.x; { const int bx = blockIdx.x; F.vcu = (F.G % 8 == 0) ? (bx % 8) * (F.G / 8) + bx / 8 : bx; }
    for (int u = fresh_tid(); u < (LDS_BYTES - LDSCTL_OFF) / 4; u += NWAVES * 64) ((LAS unsigned*)(F.lds + LDSCTL_OFF))[u] = 0u;
    __syncthreads();
    volatile LAS unsigned* MISC = (volatile LAS unsigned*)(F.lds + MISC_OFF);
    const Ptrs& P = args.P;
    XcdBarrier bar = xcd_barrier_post((unsigned*)(P.ws + WS_CTL) + CW_BAR + args.li * XCD_BAR_WORDS, MISC + 8, F.wave);
    const int lo = args.ph_lo, hi = args.ph_hi;
    unsigned char* ws = P.ws;
    bf16_t* H = (bf16_t*)(ws + WS_H); bf16_t* U = (bf16_t*)(ws + WS_U); bf16_t* BR = (bf16_t*)(ws + WS_BR);
    bf16_t* MG = (bf16_t*)(ws + WS_MG); bf16_t* HID = (bf16_t*)(ws + WS_HID); bf16_t* MO = (bf16_t*)(ws + WS_MO);
    const bf16_t* Bt_in = (const bf16_t*)(ws + WS_WB + WB_IN); const bf16_t* Bt_gate = (const bf16_t*)(ws + WS_WB + WB_GATE); const bf16_t* Bt_br = (const bf16_t*)(ws + WS_WB + WB_BR);
    const bf16_t* Bt_out = (const bf16_t*)(ws + WS_WB + WB_OUT); const bf16_t* Bt_13 = (const bf16_t*)(ws + WS_WB + WB_13); const bf16_t* Bt_2 = (const bf16_t*)(ws + WS_WB + WB_2);
#define IN(g) (lo <= (g) && (g) < hi)
#define SEAM(g) do { if ((g) + 1 < hi) xcd_barrier(bar); } while (0)
    for (int l = 0; l < 2; ++l) {
        const int pb = l * NPH; const int M = l == 0 ? R : RL;
        if (IN(pb + 0)) { if (l == 0) ph_tables_mod(F, P); ph_weights(F, P, l); SEAM(pb + 0); }
        if (IN(pb + 1)) { ph_quant(F, P, l); if (l == 0) ph_norm<0>(F, P, l, R); else ph_norm<1>(F, P, l, R); SEAM(pb + 1); }
        if (IN(pb + 2)) {
            pg8::StaticOrder S; S.init(R, NIN, F.G, (int)blockIdx.x, H, D / 2, Bt_in, D / 2);
            pg8::EpiV8I8<FStore8> E{FStore8{U, NIN}, (const float*)(ws + WS_SA), (const unsigned*)(ws + WS_CTL) + CW_CMAX + 32768 * l};
            pg8::gemm_phase<pg8::EpiV8I8<FStore8>, pg8::StaticOrder, true, true>(F.lds, F.wave, D / 2, D / 2, D / 2, S, E);
            SEAM(pb + 2);
        }
        if (IN(pb + 3)) { ph_kprep(F, P, l); ph_pool(F, P, M); SEAM(pb + 3); }
        if (IN(pb + 4)) {
            ph_dft<2>(F, P); ph_attn<1>(F, P, l);
            if (l == 0) { ph_attn<2>(F, P, l); ph_attn<3>(F, P, l); ph_ctx_r4(F, P); }
            xcd_barrier(bar);
            ph_dft<3>(F, P); if (l == 0) { Frame Fc = F; Fc.vcu = (F.vcu + 64) % F.G; ph_dft<3, true>(Fc, P); } ph_attn<0>(F, P, l);
            SEAM(pb + 4);
        }
        if (IN(pb + 5)) {
            pg8::StaticOrder S; S.init(M, 4096, F.G, (int)blockIdx.x, H, D / 2, Bt_gate, D / 2);
            pg8::EpiV8I8<FGateU8> E{FGateU8{(unsigned char*)(ws + WS_GT), P.b_gate + (size_t)l * 4096}, (const float*)(ws + WS_SA), (const unsigned*)(ws + WS_CTL) + CW_CMAX + 32768 * l + 3072};
            pg8::gemm_phase<pg8::EpiV8I8<FGateU8>, pg8::StaticOrder, true, true>(F.lds, F.wave, D / 2, D / 2, D / 2, S, E);
            SEAM(pb + 5);
        }
        if (IN(pb + 6)) {
            const int chain = (l == 0);
            pg8::PanelOrder S{(int)blockIdx.x, F.G, M / (8 * pg8::BM), 0, chain, (const char*)BR, (const char*)Bt_br, (size_t)pg8::BM * NBR * 2, (size_t)pg8::BM * NBR * 2, (unsigned*)(ws + WS_CTL) + CW_RDY + 4096 * l};
            pg8::EpiMergeS E{(const unsigned char*)(ws + WS_GT), MG, chain};
            pg8::gemm_phase(F.lds, F.wave, NBR, NBR, NBR, S, E);
            if (!chain) xcd_barrier(bar);
        }
        if (IN(pb + 10)) {
            pg8::PanelOrder S{(int)blockIdx.x, F.G, M / (8 * pg8::BM), 1, l == 0, (const char*)MG, (const char*)Bt_out, (size_t)pg8::BM * D * 2, (size_t)pg8::BM * D * 2, (unsigned*)(ws + WS_CTL) + CW_RDY + 4096 * l};
            pg8::EpiV4<FOut> E{FOut{P, l}};
            pg8::gemm_phase(F.lds, F.wave, D, D, D, S, E);
            SEAM(pb + 10);
        }
        if (IN(pb + 11)) { ph_norm2(F, P, l, M); xcd_barrier(bar); }
        if (IN(pb + 13) || IN(pb + 14)) {
            LAS int* ptab = (LAS int*)(F.lds + LDSCTL_OFF);
            if (fresh_tid() == 0) { const unsigned* cnt = (const unsigned*)(ws + WS_CTL) + CW_CNT + 1024 * l; int off = 0;
                for (int e = 0; e < 16; ++e) { const int c = (int)cnt[64 * e]; ptab[e] = off; ptab[17 + e] = c; off += (c + 255) >> 8; } ptab[16] = off; }
            __syncthreads();
            if (IN(pb + 13)) {
                pg8::MoeOrder<true> S; S.nN = 4; S.G = F.G; S.c = F.vcu; S.A = (const char*)H; S.Bt = (const char*)Bt_13; S.astep = 0; S.bstep = (size_t)256 * D; S.bexp = (size_t)1024 * 1024; S.tab = (const int*)ptab; S.tokl = (const int*)(ws + WS_TOKL); S.hand = 1; S.rev = 0; S.ready = (unsigned*)(ws + WS_CTL) + CW_MRDY + 8192 * l;
                pg8::EpiDualI8<FMoe1> E{FMoe1{HID}, (const float*)(ws + WS_SA), (const unsigned*)(ws + WS_CTL) + CW_CMAX + 32768 * l + 8192, (const int*)(ws + WS_TOKL)};
                pg8::gemm_phase<pg8::EpiDualI8<FMoe1>, pg8::MoeOrder<true>, true, true>(F.lds, F.wave, D / 2, D / 2, D / 2, S, E);
            }
            if (IN(pb + 14)) {
                pg8::MoeOrder<false> S; S.nN = 4; S.G = F.G; S.c = F.vcu; S.A = (const char*)HID; S.Bt = (const char*)Bt_2; S.astep = (size_t)256 * FF * 2; S.bstep = (size_t)256 * FF * 2; S.bexp = (size_t)1024 * 512 * 2; S.tab = (const int*)ptab; S.tokl = nullptr; S.hand = 2; S.rev = 1; S.ready = (unsigned*)(ws + WS_CTL) + CW_MRDY + 8192 * l;
                pg8::EpiV8<FMoe2> E{FMoe2{MO, (const int*)(ws + WS_TOKL), (const float*)(ws + WS_WL)}};
                pg8::gemm_phase(F.lds, F.wave, FF, FF, FF, S, E);
                SEAM(pb + 14);
            }
        }
    }
    if (IN(PH_FINAL)) { ph_final(F, P, 0, 24576); xcd_barrier(bar); ph_final(F, P, 24576, RL); }
#undef IN
#undef SEAM
}

extern "C" void kernel_launch(void* const* d_in, const int* in_sizes, int n_in, void* d_out, int out_size, void* d_ws, size_t ws_size, hipStream_t stream) {
    if (n_in != 24 || ws_size < WS_END || out_size != RL * D) { fprintf(stderr, "kernel_launch: unexpected sizes n_in %d ws %zu out %d\n", n_in, ws_size, out_size); return; }
    static int grid = 0;
    if (grid == 0) {
        int dev = 0, cus = 0;
        if (hipGetDevice(&dev) != hipSuccess || hipDeviceGetAttribute(&cus, hipDeviceAttributeMultiprocessorCount, dev) != hipSuccess) { grid = -1; return; }
        if (hipFuncSetAttribute((const void*)mega, hipFuncAttributeMaxDynamicSharedMemorySize, LDS_BYTES) != hipSuccess) { fprintf(stderr, "kernel_launch: hipFuncSetAttribute failed\n"); grid = -1; return; }
        int per_cu = 0;
        if (hipOccupancyMaxActiveBlocksPerMultiprocessor(&per_cu, (const void*)mega, NWAVES * 64, LDS_BYTES) != hipSuccess || per_cu < 1) fprintf(stderr, "kernel_launch: occupancy query says %d\n", per_cu);
        (void)hipGetLastError();
        grid = cus;
    }
    if (grid < 0) return;
    MegaArgs a{};
    const float** pp = (const float**)&a.P;
    for (int i = 0; i < 24; ++i) pp[i] = (const float*)d_in[i];
    a.P.out = (float*)d_out; a.P.ws = (unsigned char*)d_ws;
    (void)hipMemsetAsync((unsigned char*)d_ws + WS_CTL, 0, 512 * 1024, stream);
    a.ph_lo = 0; a.ph_hi = PH_FINAL + 1; a.li = 0;
    hipLaunchKernelGGL(mega, dim3(grid), dim3(NWAVES * 64), LDS_BYTES, stream, a);
}
```

```cpp
#include <hip/hip_runtime.h>
#include <cstdio>
#include <cstdint>

typedef unsigned short bf16_t;
typedef short bf16x8 __attribute__((ext_vector_type(8)));
typedef float f32x4 __attribute__((ext_vector_type(4)));
typedef unsigned u32x4 __attribute__((ext_vector_type(4)));
typedef unsigned u32x2 __attribute__((ext_vector_type(2)));
typedef int i32x4 __attribute__((ext_vector_type(4)));

constexpr int D = 1024, NB = 8, T = 4096, TC = 256;
constexpr int RL = NB * T, RC = NB * TC, R = RL + RC;
constexpr int NIN = 3072;
constexpr int C_ZR = 0, C_ZI = 512, C_P = 1024, C_QB = 1536, C_KB = 2048, C_VB = 2176, C_QW = 2304, C_KW = 2816, C_VW = 2944;
constexpr int NBR = 2048;
constexpr int NE = 16, FF = 512;
constexpr int MAXROWS = 73728;
constexpr float EPS = 1e-6f;
constexpr float QSCALE = 0.125f * 1.4426950408889634f;
constexpr float LOG2E = 1.4426950408889634f;

constexpr size_t MiB = 1u << 20;
constexpr size_t WS_CTL = 0;
constexpr size_t WS_MOD = 1 * MiB;
constexpr size_t WS_ROPE = 1 * MiB + 512 * 1024;
constexpr size_t WS_COS = WS_ROPE + 16 * 1024;
constexpr size_t WS_DFTM = WS_ROPE + 64 * 1024;
constexpr size_t WS_TOKL = 2 * MiB;
constexpr size_t WS_WL = 4 * MiB + 512 * 1024;
constexpr size_t WS_XC = 9 * MiB;
constexpr size_t WS_WB = 17 * MiB;
constexpr size_t WB_IN = 0, WB_GATE = 6 * MiB, WB_BR = 14 * MiB, WB_OUT = 18 * MiB, WB_13 = 20 * MiB, WB_2 = 52 * MiB;
constexpr size_t WS_H = 85 * MiB;
constexpr size_t WS_SA = WS_H + 34 * MiB;
constexpr size_t WS_X1B = WS_H + 35 * MiB;
constexpr size_t WS_ARENA = 153 * MiB;
constexpr size_t WS_U = WS_ARENA;
constexpr size_t WS_BR = WS_ARENA + 204 * MiB;
constexpr size_t WS_GT = WS_ARENA;
constexpr size_t WS_MG = WS_ARENA + 136 * MiB;
constexpr size_t WS_HID = WS_ARENA + 144 * MiB;
constexpr size_t WS_MO = WS_ARENA + 216 * MiB;
constexpr size_t WS_FTMP = WS_ARENA + 352 * MiB;
constexpr size_t WS_END = 512 * MiB;
static_assert(WS_BR + (size_t)R * NBR * 2 <= WS_END && WS_MO + (size_t)2 * R * D * 2 <= WS_END && WS_MG + (size_t)R * D * 2 <= WS_BR, "ws map");
constexpr int CW_CMAX = 32768;
constexpr int CW_RDY = 20480;
constexpr int CW_QK = 28672;
constexpr int CW_MRDY = 98304;
constexpr int CW_CNT = 8192;

__device__ __forceinline__ float bf2f(bf16_t b) { return __uint_as_float(((unsigned)b) << 16); }
__device__ __forceinline__ unsigned f2bf(float f) { unsigned u = __float_as_uint(f); return (u + 0x7fffu + ((u >> 16) & 1u)) >> 16; }
__device__ __forceinline__ unsigned pk2(float lo, float hi) { return f2bf(lo) | (f2bf(hi) << 16); }
typedef __bf16 bf16x2_t __attribute__((ext_vector_type(2)));
typedef float f32x2_t __attribute__((ext_vector_type(2)));
__device__ __forceinline__ unsigned cvtpk(float lo, float hi) { f32x2_t v = {lo, hi}; bf16x2_t b = __builtin_convertvector(v, bf16x2_t); return __builtin_bit_cast(unsigned, b); }
__device__ __forceinline__ float lo16(unsigned w) { return __uint_as_float(w << 16); }
__device__ __forceinline__ float hi16(unsigned w) { return __uint_as_float(w & 0xffff0000u); }
__device__ __forceinline__ float shfl_xor_l(float v, int o, int lane) { return __int_as_float(__builtin_amdgcn_ds_bpermute((lane ^ o) << 2, __float_as_int(v))); }
__device__ __forceinline__ float wave_sum_l(float v, int lane) {
#pragma unroll
    for (int o = 1; o < 64; o <<= 1) v += shfl_xor_l(v, o, lane);
    return v;
}
__device__ __forceinline__ int row_bb(int r) { return r < RL ? (r >> 12) : 8; }

struct Ptrs {
    const float *x, *c, *ctx, *c_ctx, *w_ada, *b_ada, *norm1, *norm2, *w_in, *q_gain, *k_gain, *sink, *pool_w, *pool_scale,
        *w_branch, *w_gate, *b_gate, *w_out, *router_w, *router_bias, *w1, *w3, *w2, *norm_f;
    float* out; unsigned char* ws;
};
__device__ __forceinline__ const float* xin_row(const Ptrs& P, int r) { return r < RL ? P.x + (size_t)r * D : P.ctx + (size_t)(r - RL) * D; }
__device__ __forceinline__ bf16_t* x1b_row(const Ptrs& P, int r) {
    return r < 16384 ? (bf16_t*)((unsigned char*)P.out + 96 * MiB) + (size_t)r * D : (r < RL ? (bf16_t*)(P.ws + WS_X1B) + (size_t)(r - 16384) * D : (bf16_t*)(P.ws + WS_XC) + (size_t)(r - RL) * D); }
__device__ __forceinline__ f32x4 ld4b(const bf16_t* p) { const u32x2 w = *(const u32x2*)p; return (f32x4){lo16(w.x), hi16(w.x), lo16(w.y), hi16(w.y)}; }
__device__ __forceinline__ void st4b(bf16_t* p, f32x4 v) { u32x2 w; w.x = cvtpk(v.x, v.y); w.y = cvtpk(v.z, v.w); *(u32x2*)p = w; }
__device__ __forceinline__ const float* mod_vec(const Ptrs& P, int l, int bb, int which) { return (const float*)(P.ws + WS_MOD) + ((size_t)(l * 9 + bb) * 6 + which) * D; }

#define LAS __attribute__((address_space(3)))
#define GAS __attribute__((address_space(1)))
#define LDS_WAIT() asm volatile("s_waitcnt lgkmcnt(0)" ::: "memory")
__device__ __forceinline__ int fresh_lane() { int l; asm volatile("v_mbcnt_lo_u32_b32 %0, -1, 0\n\tv_mbcnt_hi_u32_b32 %0, -1, %0" : "=v"(l)); return l; }
constexpr int NWAVES = 8;
constexpr int RING_BYTES = 131072, LDSCTL_OFF = RING_BYTES, MISC_OFF = LDSCTL_OFF + 320, LDS_BYTES = 147456;
constexpr int CW_BAR = 16384;
constexpr int NPH = 15, PH_FINAL = 2 * NPH;

#define XB_TMO      128
#define XB_XCNT(j)  (256  + 64 * (j))
#define XB_XSUB(j)  (1280 + 64 * (j))
#define XB_XGEN(j)  (2304 + 64 * (j))
#define XB_TOP      3328
#define XB_TOPGEN   3392
#define XCD_BAR_WORDS 3456
#define XB_SPIN_CAP (1u << 21)
__device__ __forceinline__ unsigned xb_ld(unsigned* p)              { return __hip_atomic_load(p, __ATOMIC_RELAXED, __HIP_MEMORY_SCOPE_AGENT); }
__device__ __forceinline__ unsigned xb_add(unsigned* p, unsigned v) { return __hip_atomic_fetch_add(p, v, __ATOMIC_RELAXED, __HIP_MEMORY_SCOPE_AGENT); }
__device__ __forceinline__ unsigned xb_xcc_id() { return (unsigned)__builtin_amdgcn_s_getreg((3 << 11) | 20) & 0xFu; }
#define XB_SPIN(cond, bar) do { unsigned _sp = 0; while (cond) { __builtin_amdgcn_s_sleep(1); \
    if ((++_sp & 255u) == 0u) { if (xb_ld(&(bar)[XB_TMO])) break; if (_sp > XB_SPIN_CAP) { atomicAdd(&(bar)[XB_TMO], 1u); break; } } } } while (0)
struct XcdBarrier { unsigned* bar; unsigned x; volatile LAS unsigned* st; int wave; };
__device__ __forceinline__ XcdBarrier xcd_barrier_post(unsigned* bar, volatile LAS unsigned* st, int wave) {
    XcdBarrier b; b.bar = bar; b.x = xb_xcc_id(); b.st = st; b.wave = wave;
    if (wave == 0 && fresh_lane() == 0) (void)xb_add(&bar[XB_XCNT(b.x)], 1u);
    return b;
}
__device__ __forceinline__ void xcd_barrier_complete(unsigned* bar, unsigned x, unsigned& nloc, unsigned& nx) {
    const unsigned G = gridDim.x * gridDim.y * gridDim.z;
    unsigned sum, cnt, mine, sp = 0u;
    for (;;) {
        sum = 0u; cnt = 0u; mine = 0u;
#pragma unroll
        for (unsigned j = 0; j < 16; ++j) { const unsigned c = xb_ld(&bar[XB_XCNT(j)]); sum += c; cnt += (c > 0u) ? 1u : 0u; mine = (j == x) ? c : mine; }
        if (sum == G) break;
        __builtin_amdgcn_s_sleep(1);
        if ((++sp & 255u) == 0u) { if (xb_ld(&bar[XB_TMO])) break; if (sp > XB_SPIN_CAP) { atomicAdd(&bar[XB_TMO], 1u); break; } }
    }
    nloc = mine > 0u ? mine : 1u; nx = cnt > 0u ? cnt : 1u;
}
__device__ __forceinline__ void xcd_barrier(const XcdBarrier& b) {
    asm volatile("s_waitcnt vmcnt(0)" ::: "memory");
    __syncthreads();
    if (b.wave == 0 && fresh_lane() == 0) {
        unsigned* bar = b.bar;
        __builtin_amdgcn_s_waitcnt(0);
        unsigned nloc = b.st[0], nx = b.st[1];
        if (nloc == 0u) { xcd_barrier_complete(bar, b.x, nloc, nx); b.st[0] = nloc; b.st[1] = nx; }
        const unsigned old = xb_add(&bar[XB_XSUB(b.x)], 1u);
        const unsigned gen = old / nloc;
        if (old + 1u == (gen + 1u) * nloc) {
            __builtin_amdgcn_fence(__ATOMIC_RELEASE, "agent");
            asm volatile("s_waitcnt vmcnt(0)" ::: "memory");
            const unsigned og = xb_add(&bar[XB_TOP], 1u);
            const unsigned tg = og / nx;
            if (og + 1u == (tg + 1u) * nx) xb_add(&bar[XB_TOPGEN], 1u);
            else XB_SPIN(xb_ld(&bar[XB_TOPGEN]) == tg, bar);
            __builtin_amdgcn_fence(__ATOMIC_ACQUIRE, "agent");
            xb_add(&bar[XB_XGEN(b.x)], 1u);
            asm volatile("s_waitcnt vmcnt(0)" ::: "memory");
        } else {
            XB_SPIN(xb_ld(&bar[XB_XGEN(b.x)]) == gen, bar);
            __builtin_amdgcn_fence(__ATOMIC_ACQUIRE, "agent");
            asm volatile("s_waitcnt vmcnt(0)" ::: "memory");
        }
    }
    __syncthreads();
}

namespace pg8 {
constexpr int BM = 256, BK = 64, HALF = 128, HTB = HALF * BK * 2, STAGE_BYTES = 8 * HTB, NXCD = 8, WGM = 4;
__host__ __device__ __forceinline__ int lds_byte(int r, int c) { const int st = (r >> 4) * 2 + (c >> 5), rr = r & 15, cc = c & 31, ob = rr * 64 + cc * 2; return st * 1024 + (ob ^ (((ob >> 9) & 1) << 5)); }
__host__ __device__ __forceinline__ void stage_rc(int b, int& Rr, int& C) { const int st = b / 1024, sb = b % 1024, swz = sb ^ (((sb >> 9) & 1) << 5); Rr = (st >> 1) * 16 + swz / 64; C = (st & 1) * 32 + (swz % 64) / 2; }
__host__ __device__ __forceinline__ int perm32(int rho) { const int n = rho >> 4, i = rho & 15; return 8 * (i >> 2) + 4 * n + (i & 3); }
struct Unit { int pm, pn; const char* a; const char* b; int e, p0, ce; };

struct StaticOrder {
    static constexpr bool GATHER = false;
    int nM, nN, nwg, G, c; const char* A; const char* Bt; size_t astep, bstep;
    __device__ void init(int M, int N, int G_, int c_, const bf16_t* A_, int lda, const bf16_t* Bt_, int ldb) { nM = M / BM; nN = N / BM; nwg = nM * nN; G = G_; c = c_; A = (const char*)A_; Bt = (const char*)Bt_; astep = (size_t)BM * lda * 2; bstep = (size_t)BM * ldb * 2; }
    __device__ bool next(int i, Unit& u) const {
        const long L = (long)i * G + c; if (L >= nwg) return false;
        int wgid = (int)L; { const int q = nwg / NXCD, r = nwg % NXCD, xcd = wgid % NXCD, off = wgid / NXCD; wgid = (xcd < r ? xcd * (q + 1) : r * (q + 1) + (xcd - r) * q) + off; }
        const int nig = WGM * nN, gid = wgid / nig, fm = gid * WGM, gsz = (nM - fm) < WGM ? (nM - fm) : WGM;
        u.pm = fm + ((wgid % nig) % gsz); u.pn = (wgid % nig) / gsz; u.a = A + (size_t)u.pm * astep; u.b = Bt + (size_t)u.pn * bstep; u.e = 0; u.p0 = 0; u.ce = 0; return true;
    }
    __device__ __forceinline__ void a_ready(const Unit&) const {}
    __device__ __forceinline__ void done(const Unit&) const {}
};
template <bool GATHER_> struct MoeOrder {
    static constexpr bool GATHER = GATHER_;
    int nN, G, c; const char* A; const char* Bt; size_t astep, bstep, bexp; const int* tab; const int* tokl;
    int hand, rev; unsigned* ready;
    __device__ bool next(int i, Unit& u) const {
        const int L = i * G + (rev ? G - 1 - c : c); const int total = __builtin_amdgcn_readfirstlane(tab[16]) * nN; if (L >= total) return false;
        u.pm = L / nN; u.pn = L % nN; int e = 0;
#pragma unroll
        for (int q = 1; q < 16; ++q) e += (u.pm >= tab[q]) ? 1 : 0;
        e = __builtin_amdgcn_readfirstlane(e);
        u.e = e; u.p0 = __builtin_amdgcn_readfirstlane((u.pm - tab[e]) * BM); u.ce = __builtin_amdgcn_readfirstlane(tab[17 + e]);
        u.a = GATHER_ ? A : A + (size_t)u.pm * astep; u.b = Bt + (size_t)e * bexp + (size_t)u.pn * bstep; return true;
    }
    __device__ __forceinline__ void a_ready(const Unit& u) const {
        if (hand != 2) return;
        if (__builtin_amdgcn_readfirstlane(threadIdx.x >> 6) == 0) {
            unsigned spins = 0;
            while ((unsigned)__builtin_amdgcn_readfirstlane(__hip_atomic_load(ready + 16 * u.pm, __ATOMIC_RELAXED, __HIP_MEMORY_SCOPE_AGENT)) < 32u) { __builtin_amdgcn_s_sleep(2); if (++spins > (1u << 22)) break; }
            __builtin_amdgcn_fence(__ATOMIC_ACQUIRE, "agent");
            asm volatile("s_waitcnt vmcnt(0)" ::: "memory");
        }
        asm volatile("" ::: "memory"); __builtin_amdgcn_s_barrier(); asm volatile("" ::: "memory");
    }
    __device__ __forceinline__ void done(const Unit& u) const {
        if (hand != 1) return;
        asm volatile("s_waitcnt vmcnt(0)" ::: "memory");
        if (fresh_lane() == 0) __hip_atomic_fetch_add(ready + 16 * u.pm, 1u, __ATOMIC_RELAXED, __HIP_MEMORY_SCOPE_AGENT);
    }
    __device__ __forceinline__ void aoffs(const Unit& u, int wid, int lda, unsigned (&off)[2][2]) const {
        const int tid = wid * 64 + fresh_lane();
#pragma unroll
        for (int i = 0; i < 2; ++i) { int Rr, C; stage_rc(tid * 16 + i * 8192, Rr, C);
#pragma unroll
            for (int h = 0; h < 2; ++h) { const int pos = u.p0 + h * HALF + Rr; const int tok = pos < u.ce ? (tokl[(size_t)u.e * R + pos] >> 1) : 0; off[h][i] = (unsigned)(tok * lda + C) * 2u; } }
    }
};

struct PanelOrder {
    static constexpr bool GATHER = false;
    int c, G, npx, consumer, chain; const char* A; const char* Bt; size_t astep, bstep; unsigned* ready;
    __device__ bool next(int i, Unit& u) const {
        if (G == 256) { const int xcd = c & 7, r = c >> 3, ne = 4 * npx, heavy = ne - 64; int e;
            if (!consumer) { e = 32 * i + r; if (e >= ne) return false; }
            else if (r >= heavy) { e = i * (32 - heavy) + (r - heavy); if (e >= 64) return false; }
            else { if (i != 0) return false; e = 64 + r; }
            u.pm = npx * xcd + (e >> 2); u.pn = e & 3; }
        else { const int L = i * G + c; if (L >= 32 * npx) return false; u.pm = L >> 2; u.pn = L & 3; }
        u.a = A + (size_t)u.pm * astep; u.b = Bt + (size_t)u.pn * bstep; u.e = 0; u.p0 = 0; u.ce = 0; return true;
    }
    __device__ __forceinline__ void a_ready(const Unit& u) const {
        if (!consumer || !chain) return;
        if (__builtin_amdgcn_readfirstlane(threadIdx.x >> 6) == 0) {
            unsigned spins = 0;
            while ((unsigned)__builtin_amdgcn_readfirstlane(__hip_atomic_load(ready + 16 * u.pm, __ATOMIC_RELAXED, __HIP_MEMORY_SCOPE_AGENT)) < 32u) { __builtin_amdgcn_s_sleep(2); if (++spins > (1u << 22)) break; }
            __builtin_amdgcn_fence(__ATOMIC_ACQUIRE, "agent");
            asm volatile("s_waitcnt vmcnt(0)" ::: "memory");
        }
        asm volatile("" ::: "memory"); __builtin_amdgcn_s_barrier(); asm volatile("" ::: "memory");
    }
    __device__ __forceinline__ void done(const Unit& u) const {
        if (consumer || !chain) return;
        asm volatile("s_waitcnt vmcnt(0)" ::: "memory");
        if (fresh_lane() == 0) __hip_atomic_fetch_add(ready + 16 * u.pm, 1u, __ATOMIC_RELAXED, __HIP_MEMORY_SCOPE_AGENT);
    }
};
template <class Epi, class Sched, bool ALIGN_EPI = true, bool I8 = false>
__device__ __forceinline__ void gemm_phase(LAS unsigned char* lds, const int wid, const int lda, const int ldb, const int K, const Sched& S, const Epi& E) {
    const int lane = fresh_lane(), tid = wid * 64 + lane, wr = wid >> 2, wc = wid & 3, fr = lane & 15, fq = lane >> 4;
    const int nt = K / BK;
    unsigned voffA[2], voffB[2];
#pragma unroll
    for (int i = 0; i < 2; ++i) { int Rr, C; stage_rc(tid * 16 + i * 8192, Rr, C); const int Rb = Epi::PERM ? ((Rr & ~31) + perm32(Rr & 31)) : Rr;
        voffA[i] = (unsigned)(Rr * lda + C) * 2u; voffB[i] = (unsigned)(Rb * ldb + C) * 2u; }
    const size_t kstep = (size_t)(BK * 2);
    const size_t hstepA = Sched::GATHER ? 0 : (size_t)HALF * lda * 2, hstepB = (size_t)HALF * ldb * 2;
    const unsigned ldsw = (unsigned)wid * 1024u;
    const int aoff = lds_byte(wr * 64 + fr, fq * 8), boff = lds_byte(wc * 32 + fr, fq * 8);
#define PG8_SA(b, h) (((b) * 2 + (h)) * HTB)
#define PG8_SB(b, h) ((4 + (b) * 2 + (h)) * HTB)
#define PG8_STAGE(bufoff, gbase, voff) do { _Pragma("unroll") for (int _i = 0; _i < 2; ++_i) \
        __builtin_amdgcn_global_load_lds((const unsigned*)((const char*)(gbase) + (voff)[_i]), (LAS unsigned*)(lds + (bufoff) + ldsw + _i * 8192), 16, 0, 0); } while (0)
#define PG8_STAGE_A(b, h, kp, OFFS) do { if constexpr (Sched::GATHER) { PG8_STAGE(PG8_SA(b, h), kp, OFFS[h]); } else { PG8_STAGE(PG8_SA(b, h), (kp) + (h) * hstepA, voffA); } } while (0)
#define PG8_LDA(dst, b, h) do { _Pragma("unroll") for (int m = 0; m < 4; ++m) _Pragma("unroll") for (int k = 0; k < 2; ++k) dst[m][k] = *(const LAS bf16x8*)(lds + PG8_SA(b, h) + aoff + m * 2048 + k * 1024); } while (0)
#define PG8_LDB(dst, b, h) do { _Pragma("unroll") for (int n = 0; n < 2; ++n) _Pragma("unroll") for (int k = 0; k < 2; ++k) dst[n][k] = *(const LAS bf16x8*)(lds + PG8_SB(b, h) + boff + n * 2048 + k * 1024); } while (0)
#define PG8_MMA(ai, bj, At, Bt) do { __builtin_amdgcn_s_setprio(1); _Pragma("unroll") for (int m = 0; m < 4; ++m) _Pragma("unroll") for (int n = 0; n < 2; ++n) _Pragma("unroll") for (int k = 0; k < 2; ++k) { \
        if constexpr (I8) acc[ai][bj][m][n] = __builtin_bit_cast(f32x4, __builtin_amdgcn_mfma_i32_16x16x64_i8(__builtin_bit_cast(i32x4, Bt[n][k]), __builtin_bit_cast(i32x4, At[m][k]), __builtin_bit_cast(i32x4, acc[ai][bj][m][n]), 0, 0, 0)); \
        else acc[ai][bj][m][n] = __builtin_amdgcn_mfma_f32_16x16x32_bf16(Bt[n][k], At[m][k], acc[ai][bj][m][n], 0, 0, 0); } __builtin_amdgcn_s_setprio(0); } while (0)
#define PG8_WAIT_V(n) asm volatile("s_waitcnt vmcnt(" #n ")" ::: "memory")
#define PG8_WAIT_L(n) asm volatile("s_waitcnt lgkmcnt(" #n ")" ::: "memory")
#define PG8_BAR __builtin_amdgcn_s_barrier()
#define PG8_SCHED __builtin_amdgcn_sched_barrier(0)
    Unit cur, nxt; int ui = 0;
    if (!S.next(0, cur)) return;
    f32x4 acc[2][2][4][2];
#pragma unroll
    for (int a = 0; a < 2; ++a)
#pragma unroll
        for (int b = 0; b < 2; ++b)
#pragma unroll
            for (int m = 0; m < 4; ++m)
#pragma unroll
                for (int n = 0; n < 2; ++n) acc[a][b][m][n] = (f32x4){0.f, 0.f, 0.f, 0.f};
    bf16x8 At[4][2], B0[2][2], B1[2][2];
    unsigned goffC[2][2], goffN[2][2];
    if constexpr (Sched::GATHER) { S.aoffs(cur, wid, lda, goffC);
#pragma unroll
        for (int h = 0; h < 2; ++h)
#pragma unroll
            for (int i = 0; i < 2; ++i) goffN[h][i] = goffC[h][i]; }
    const char* cA = cur.a; const char* cB = cur.b;
    S.a_ready(cur);
    PG8_STAGE(PG8_SB(0, 0), cB, voffB); PG8_STAGE(PG8_SB(0, 1), cB + hstepB, voffB); PG8_STAGE_A(0, 0, cA, goffC); PG8_STAGE_A(0, 1, cA, goffC);
    if (wr == 1) PG8_BAR;
    PG8_WAIT_V(2); PG8_BAR;
    PG8_STAGE(PG8_SB(1, 0), cB + kstep, voffB); PG8_STAGE_A(1, 0, cA + kstep, goffC); PG8_STAGE(PG8_SB(1, 1), cB + hstepB + kstep, voffB);
    PG8_WAIT_V(6); PG8_BAR;
    for (;;) {
        const bool has_next = S.next(ui + 1, nxt);
        if constexpr (Sched::GATHER) { if (has_next) S.aoffs(nxt, wid, lda, goffN); }
        const char* nA = has_next ? nxt.a : cA; const char* nB = has_next ? nxt.b : cB;
        for (int t = 0; t < nt; t += 2) {
            const bool last = (t == nt - 2);
            const char* a1 = cA + (size_t)(t + 1) * kstep;
            const char* a2 = last ? nA : cA + (size_t)(t + 2) * kstep; const char* b2 = last ? nB : cB + (size_t)(t + 2) * kstep;
            const char* a3 = a2 + kstep; const char* b3 = b2 + kstep;
            unsigned gx[2][2];
            if constexpr (Sched::GATHER) {
#pragma unroll
                for (int h = 0; h < 2; ++h)
#pragma unroll
                    for (int i = 0; i < 2; ++i) gx[h][i] = (last && has_next) ? goffN[h][i] : goffC[h][i]; }
            if (last && has_next) S.a_ready(nxt);
            PG8_LDB(B0, 0, 0); PG8_LDB(B1, 0, 1); PG8_SCHED; PG8_LDA(At, 0, 0); PG8_STAGE_A(1, 1, a1, goffC);
            PG8_WAIT_V(8); PG8_WAIT_L(0); PG8_BAR; PG8_MMA(0, 0, At, B0); PG8_MMA(0, 1, At, B1); PG8_BAR; PG8_SCHED;
            PG8_LDA(At, 0, 1); PG8_STAGE(PG8_SB(0, 0), b2, voffB); PG8_STAGE(PG8_SB(0, 1), b2 + hstepB, voffB); PG8_STAGE_A(0, 0, a2, gx);
            PG8_WAIT_V(8); PG8_WAIT_L(0); PG8_BAR; PG8_MMA(1, 0, At, B0); PG8_MMA(1, 1, At, B1); PG8_BAR; PG8_SCHED;
            PG8_LDB(B0, 1, 0); PG8_LDB(B1, 1, 1); PG8_SCHED; PG8_LDA(At, 1, 0); PG8_STAGE_A(0, 1, a2, gx);
            PG8_WAIT_V(8); PG8_WAIT_L(0); PG8_BAR; PG8_MMA(0, 0, At, B0); PG8_MMA(0, 1, At, B1); PG8_BAR; PG8_SCHED;
            PG8_LDA(At, 1, 1); PG8_STAGE(PG8_SB(1, 0), b3, voffB); PG8_STAGE(PG8_SB(1, 1), b3 + hstepB, voffB); PG8_STAGE_A(1, 0, a3, gx);
            PG8_WAIT_V(8); PG8_WAIT_L(0); PG8_BAR; PG8_MMA(1, 0, At, B0); PG8_MMA(1, 1, At, B1); PG8_BAR; PG8_SCHED;
            if constexpr (Epi::MID) { if (((t + 2) & (Epi::MID_EVERY - 1)) == 0 && !last) E.mid(acc, cur, wr, wc, (t + 2) / Epi::MID_EVERY - 1); }
        }
        if constexpr (ALIGN_EPI) { if (wr == 0) PG8_BAR; }
        E(acc, cur, wr, wc, fr, fq);
        S.done(cur);
        if (!has_next) break;
#pragma unroll
        for (int a = 0; a < 2; ++a)
#pragma unroll
            for (int b = 0; b < 2; ++b)
#pragma unroll
                for (int m = 0; m < 4; ++m)
#pragma unroll
                    for (int n = 0; n < 2; ++n) acc[a][b][m][n] = (f32x4){0.f, 0.f, 0.f, 0.f};
        cur = nxt; cA = nA; cB = nB; ++ui;
        if constexpr (Sched::GATHER) {
#pragma unroll
            for (int h = 0; h < 2; ++h)
#pragma unroll
                for (int i = 0; i < 2; ++i) goffC[h][i] = goffN[h][i]; }
        if constexpr (ALIGN_EPI) { if (wr == 1) PG8_BAR; }
    }
    PG8_WAIT_V(0);
    if constexpr (!ALIGN_EPI) { if (wr == 0) PG8_BAR; }
    PG8_BAR;
#undef PG8_SA
#undef PG8_SB
#undef PG8_STAGE
#undef PG8_STAGE_A
#undef PG8_LDA
#undef PG8_LDB
#undef PG8_MMA
#undef PG8_WAIT_V
#undef PG8_WAIT_L
#undef PG8_BAR
#undef PG8_SCHED
}
template <class F> struct EpiV4 { static constexpr bool PERM = false, MID = false; static constexpr int MID_EVERY = 1; F f;
    __device__ __forceinline__ void operator()(const f32x4 (&acc)[2][2][4][2], const Unit& u, int wr, int wc, int, int) const {
        const int ln = fresh_lane(), fr = ln & 15, fq = ln >> 4;
        const int row0 = u.pm * BM + wr * 64 + fr, col0 = u.pn * BM + wc * 32 + 4 * fq;
        typename F::UnitPre up = f.unit(u, col0);
#pragma unroll
        for (int ai = 0; ai < 2; ++ai) {
            typename F::Pre pre[4][2][2];
#pragma unroll
            for (int m = 0; m < 4; ++m)
#pragma unroll
                for (int bj = 0; bj < 2; ++bj)
#pragma unroll
                    for (int n = 0; n < 2; ++n) pre[m][bj][n] = f.load(u, row0 + ai * HALF + m * 16, col0 + bj * HALF + n * 16);
#pragma unroll
            for (int m = 0; m < 4; ++m)
#pragma unroll
                for (int bj = 0; bj < 2; ++bj)
#pragma unroll
                    for (int n = 0; n < 2; ++n) f.fin(u, row0 + ai * HALF + m * 16, col0 + bj * HALF + n * 16, acc[ai][bj][m][n], pre[m][bj][n], up, bj * 2 + n);
            asm volatile("" ::: "memory"); }
    } };
template <class F> struct EpiV8 { static constexpr bool PERM = true, MID = false; static constexpr int MID_EVERY = 1; F f;
    __device__ __forceinline__ void operator()(const f32x4 (&acc)[2][2][4][2], const Unit& u, int wr, int wc, int, int) const {
        const int ln = fresh_lane(), fr = ln & 15, fq = ln >> 4;
        const int row0 = u.pm * BM + wr * 64 + fr, col0 = u.pn * BM + wc * 32 + 8 * fq;
#pragma unroll
        for (int ai = 0; ai < 2; ++ai) {
            typename F::Pre pre[4][2];
#pragma unroll
            for (int m = 0; m < 4; ++m)
#pragma unroll
                for (int bj = 0; bj < 2; ++bj) pre[m][bj] = f.load(u, row0 + ai * HALF + m * 16, col0 + bj * HALF);
#pragma unroll
            for (int m = 0; m < 4; ++m)
#pragma unroll
                for (int bj = 0; bj < 2; ++bj) f.fin(u, row0 + ai * HALF + m * 16, col0 + bj * HALF, acc[ai][bj][m][0], acc[ai][bj][m][1], pre[m][bj]);
            asm volatile("" ::: "memory"); }
    } };
template <class F> struct EpiDual { static constexpr bool PERM = true, MID = false; static constexpr int MID_EVERY = 1; F f;
    __device__ __forceinline__ void operator()(const f32x4 (&acc)[2][2][4][2], const Unit& u, int wr, int wc, int, int) const {
        const int ln = fresh_lane(), fr = ln & 15, fq = ln >> 4;
        const int row0 = u.pm * BM + wr * 64 + fr, hc0 = u.pn * HALF + wc * 32 + 8 * fq;
#pragma unroll
        for (int ai = 0; ai < 2; ++ai)
#pragma unroll
            for (int m = 0; m < 4; ++m) f.apply8(row0 + ai * HALF + m * 16, hc0, acc[ai][0][m][0], acc[ai][0][m][1], acc[ai][1][m][0], acc[ai][1][m][1]);
    } };
struct EpiMergeS { static constexpr bool PERM = true, MID = true; static constexpr int MID_EVERY = 8;
    const unsigned char* G8; bf16_t* MG; int wt;
    __device__ __forceinline__ void mid(f32x4 (&acc)[2][2][4][2], const Unit& u, int wr, int wc, int i) const {
        const int ln = fresh_lane(), fr = ln & 15, fq = ln >> 4;
        const int row0 = u.pm * BM + wr * 64 + fr, col0 = u.pn * BM + wc * 32 + 8 * fq;
#pragma unroll
        for (int ai = 0; ai < 2; ++ai) {
            u32x2 gi[4][2], gn[4][2];
#pragma unroll
            for (int m = 0; m < 4; ++m)
#pragma unroll
                for (int bj = 0; bj < 2; ++bj) { const unsigned char* gp = G8 + (size_t)(row0 + ai * HALF + m * 16) * 4096 + i * 1024 + col0 + bj * HALF;
                    gi[m][bj] = *(const u32x2*)gp; gn[m][bj] = *(const u32x2*)(gp + 1024); }
#pragma unroll
            for (int m = 0; m < 4; ++m)
#pragma unroll
                for (int bj = 0; bj < 2; ++bj) {
#pragma unroll
                    for (int j = 0; j < 4; ++j) {
                        acc[ai][bj][m][0][j] *= (float)((gi[m][bj].x >> (8 * j)) & 255u) * __builtin_amdgcn_rcpf((float)((gn[m][bj].x >> (8 * j)) & 255u));
                        acc[ai][bj][m][1][j] *= (float)((gi[m][bj].y >> (8 * j)) & 255u) * __builtin_amdgcn_rcpf((float)((gn[m][bj].y >> (8 * j)) & 255u)); } }
        }
    }
    __device__ __forceinline__ void operator()(const f32x4 (&acc)[2][2][4][2], const Unit& u, int wr, int wc, int, int) const {
        const int ln = fresh_lane(), fr = ln & 15, fq = ln >> 4;
        const int row0 = u.pm * BM + wr * 64 + fr, col0 = u.pn * BM + wc * 32 + 8 * fq;
#pragma unroll
        for (int ai = 0; ai < 2; ++ai) {
            const __amdgpu_buffer_rsrc_t rs = __builtin_amdgcn_make_buffer_rsrc((void*)MG, (short)0, (int)((size_t)R * D * 2), 0x00020000);
        u32x2 g3[4][2];
#pragma unroll
            for (int m = 0; m < 4; ++m)
#pragma unroll
                for (int bj = 0; bj < 2; ++bj) g3[m][bj] = *(const u32x2*)(G8 + (size_t)(row0 + ai * HALF + m * 16) * 4096 + 3 * 1024 + col0 + bj * HALF);
#pragma unroll
            for (int m = 0; m < 4; ++m)
#pragma unroll
                for (int bj = 0; bj < 2; ++bj) { f32x4 a = acc[ai][bj][m][0], b = acc[ai][bj][m][1];
#pragma unroll
                    for (int j = 0; j < 4; ++j) { a[j] *= (float)((g3[m][bj].x >> (8 * j)) & 255u) * (1.0f / 255.0f); b[j] *= (float)((g3[m][bj].y >> (8 * j)) & 255u) * (1.0f / 255.0f); }
                    u32x4 w; w.x = cvtpk(a.x, a.y); w.y = cvtpk(a.z, a.w); w.z = cvtpk(b.x, b.y); w.w = cvtpk(b.z, b.w);
                    if (wt) __builtin_amdgcn_raw_buffer_store_b128(w, rs, (int)(((size_t)(row0 + ai * HALF + m * 16) * D + col0 + bj * HALF) * 2), 0, 16);
                    else *(u32x4*)(MG + (size_t)(row0 + ai * HALF + m * 16) * D + col0 + bj * HALF) = w; }
        }
    }
};
template <class F> struct EpiV8I8 { static constexpr bool PERM = true, MID = false; static constexpr int MID_EVERY = 1; F f; const float* sA; const unsigned* cmax;
    __device__ __forceinline__ void operator()(const f32x4 (&acc)[2][2][4][2], const Unit& u, int wr, int wc, int, int) const {
        const int ln = fresh_lane(), fr = ln & 15, fq = ln >> 4;
        const int row0 = u.pm * BM + wr * 64 + fr, col0 = u.pn * BM + wc * 32 + 8 * fq;
        u32x4 cb[2][2]; float ra[2][4];
#pragma unroll
        for (int bj = 0; bj < 2; ++bj)
#pragma unroll
            for (int n = 0; n < 2; ++n) cb[bj][n] = *(const u32x4*)(cmax + col0 + bj * HALF + 4 * n);
#pragma unroll
        for (int ai = 0; ai < 2; ++ai)
#pragma unroll
            for (int m = 0; m < 4; ++m) ra[ai][m] = sA[row0 + ai * HALF + m * 16];
        const typename F::UnitPre up = f.unit(col0);
        f32x4 sb[2][2];
#pragma unroll
        for (int bj = 0; bj < 2; ++bj)
#pragma unroll
            for (int n = 0; n < 2; ++n) { const u32x4 c = cb[bj][n]; sb[bj][n] = (f32x4){__uint_as_float(c.x), __uint_as_float(c.y), __uint_as_float(c.z), __uint_as_float(c.w)} * (1.0f / 127.0f); }
#pragma unroll
        for (int ai = 0; ai < 2; ++ai) {
#pragma unroll
            for (int m = 0; m < 4; ++m) { const float r1 = ra[ai][m];
#pragma unroll
                for (int bj = 0; bj < 2; ++bj) { f32x4 a, b;
#pragma unroll
                    for (int j = 0; j < 4; ++j) { a[j] = (float)__float_as_int(acc[ai][bj][m][0][j]) * r1 * sb[bj][0][j]; b[j] = (float)__float_as_int(acc[ai][bj][m][1][j]) * r1 * sb[bj][1][j]; }
                    f.fin(u, row0 + ai * HALF + m * 16, col0 + bj * HALF, a, b, up, bj); } }
            asm volatile("" ::: "memory"); }
    } };
template <class F> struct EpiDualI8 { static constexpr bool PERM = true, MID = false; static constexpr int MID_EVERY = 1; F f; const float* sA; const unsigned* cmax; const int* tokl;
    __device__ __forceinline__ void operator()(const f32x4 (&acc)[2][2][4][2], const Unit& u, int wr, int wc, int, int) const {
        const int ln = fresh_lane(), fr = ln & 15, fq = ln >> 4;
        const int lrow0 = wr * 64 + fr, hc0 = u.pn * HALF + wc * 32 + 8 * fq;
        const unsigned* cm = cmax + u.e * 1024 + u.pn * BM + wc * 32 + 8 * fq;
        f32x4 s1[2], s3[2];
#pragma unroll
        for (int n = 0; n < 2; ++n) { const u32x4 a = *(const u32x4*)(cm + 4 * n), b = *(const u32x4*)(cm + HALF + 4 * n);
            s1[n] = (f32x4){__uint_as_float(a.x), __uint_as_float(a.y), __uint_as_float(a.z), __uint_as_float(a.w)} * (1.0f / 127.0f);
            s3[n] = (f32x4){__uint_as_float(b.x), __uint_as_float(b.y), __uint_as_float(b.z), __uint_as_float(b.w)} * (1.0f / 127.0f); }
        int tk[2][4]; float ra[2][4];
#pragma unroll
        for (int ai = 0; ai < 2; ++ai)
#pragma unroll
            for (int m = 0; m < 4; ++m) { const int pos = u.p0 + lrow0 + ai * HALF + m * 16; tk[ai][m] = pos < u.ce ? (tokl[(size_t)u.e * R + pos] >> 1) : 0; }
#pragma unroll
        for (int ai = 0; ai < 2; ++ai)
#pragma unroll
            for (int m = 0; m < 4; ++m) ra[ai][m] = sA[tk[ai][m]];
#pragma unroll
        for (int ai = 0; ai < 2; ++ai) {
#pragma unroll
            for (int m = 0; m < 4; ++m) { f32x4 a0, a1, b0, b1; const float r1 = ra[ai][m];
#pragma unroll
                for (int j = 0; j < 4; ++j) { a0[j] = (float)__float_as_int(acc[ai][0][m][0][j]) * r1 * s1[0][j]; a1[j] = (float)__float_as_int(acc[ai][0][m][1][j]) * r1 * s1[1][j];
                    b0[j] = (float)__float_as_int(acc[ai][1][m][0][j]) * r1 * s3[0][j]; b1[j] = (float)__float_as_int(acc[ai][1][m][1][j]) * r1 * s3[1][j]; }
                f.apply8(u.pm * BM + lrow0 + ai * HALF + m * 16, hc0, a0, a1, b0, b1); }
        }
    } };
}

__device__ __forceinline__ u32x4 pack8(f32x4 a, f32x4 b) { u32x4 w; w.x = cvtpk(a.x, a.y); w.y = cvtpk(a.z, a.w); w.z = cvtpk(b.x, b.y); w.w = cvtpk(b.z, b.w); return w; }
__device__ __forceinline__ float sigm1(float x) { return __builtin_amdgcn_rcpf(1.0f + __builtin_amdgcn_exp2f(-1.4426950408889634f * x)); }
__device__ __forceinline__ f32x4 sigm4(f32x4 v) { f32x4 r; r.x = sigm1(v.x); r.y = sigm1(v.y); r.z = sigm1(v.z); r.w = sigm1(v.w); return r; }
struct NoPre {};
struct FStore8 { bf16_t* C; int ldc; typedef NoPre UnitPre;
    __device__ __forceinline__ UnitPre unit(int) const { return UnitPre{}; }
    __device__ __forceinline__ void fin(const pg8::Unit&, int row, int col, f32x4 a, f32x4 b, const UnitPre&, int) const { *(u32x4*)(C + (size_t)row * ldc + col) = pack8(a, b); } };
struct FGateU8 { unsigned char* G8; const float* bias; struct UnitPre { f32x4 b[2][2]; };
    __device__ __forceinline__ UnitPre unit(int col0) const { UnitPre r;
#pragma unroll
        for (int bj = 0; bj < 2; ++bj) { r.b[bj][0] = *(const f32x4*)(bias + col0 + bj * pg8::HALF); r.b[bj][1] = *(const f32x4*)(bias + col0 + bj * pg8::HALF + 4); } return r; }
    __device__ __forceinline__ void fin(const pg8::Unit&, int row, int col, f32x4 a, f32x4 b, const UnitPre& up, int bj) const { const f32x4 b0 = up.b[bj][0], b1 = up.b[bj][1];
        const f32x4 ga = sigm4(a + b0) * 255.0f + 0.5f, gb = sigm4(b + b1) * 255.0f + 0.5f;
        unsigned q[8] = {(unsigned)ga.x, (unsigned)ga.y, (unsigned)ga.z, (unsigned)ga.w, (unsigned)gb.x, (unsigned)gb.y, (unsigned)gb.z, (unsigned)gb.w};
#pragma unroll
        for (int k = 0; k < 8; ++k) q[k] = q[k] < 1u ? 1u : (q[k] > 255u ? 255u : q[k]);
        u32x2 w; w.x = q[0] | (q[1] << 8) | (q[2] << 16) | (q[3] << 24); w.y = q[4] | (q[5] << 8) | (q[6] << 16) | (q[7] << 24);
        *(u32x2*)(G8 + (size_t)row * 4096 + col) = w; } };
struct FMoe1 { bf16_t* HID;
    __device__ __forceinline__ void apply8(int row, int hc, f32x4 a0, f32x4 a1, f32x4 b0, f32x4 b1) const {
        const __amdgpu_buffer_rsrc_t rs = __builtin_amdgcn_make_buffer_rsrc((void*)HID, (short)0, (int)((size_t)MAXROWS * FF * 2), 0x00020000);
        __builtin_amdgcn_raw_buffer_store_b128(pack8(a0 * sigm4(a0) * b0, a1 * sigm4(a1) * b1), rs, (int)(((size_t)row * FF + hc) * 2), 0, 16); } };
struct FMoe2 { bf16_t* MO; const int* tokl; const float* wl; struct Pre { int t; float w; };
    __device__ __forceinline__ Pre load(const pg8::Unit& u, int row, int) const { Pre r; const int pos = u.p0 + (row - u.pm * 256); r.t = -1; r.w = 0.f;
        if (pos < u.ce) { r.t = tokl[(size_t)u.e * R + pos]; r.w = wl[(size_t)u.e * R + pos]; } return r; }
    __device__ __forceinline__ void fin(const pg8::Unit&, int, int col, f32x4 a, f32x4 b, const Pre& q) const { if (q.t < 0) return;
        *(u32x4*)(MO + ((size_t)(q.t & 1) * R + (q.t >> 1)) * D + col) = pack8(a * q.w, b * q.w); } };
struct FOut { Ptrs P; int l; typedef u32x4 Pre; struct UnitPre { f32x4 g[4]; };
    __device__ __forceinline__ UnitPre unit(const pg8::Unit& u, int col0) const { UnitPre r; const float* g = mod_vec(P, l, row_bb(u.pm * 256), 2) + col0;
#pragma unroll
        for (int q = 0; q < 4; ++q) r.g[q] = *(const f32x4*)(g + (q >> 1) * 128 + (q & 1) * 16);
        return r; }
    __device__ __forceinline__ Pre load(const pg8::Unit&, int row, int col) const { if (l == 0) return *(const u32x4*)(xin_row(P, row) + col); const u32x2 w = *(const u32x2*)(x1b_row(P, row) + col); return (u32x4){w.x, w.y, 0u, 0u}; }
    __device__ __forceinline__ void fin(const pg8::Unit&, int row, int col, f32x4 v, const Pre& xr, const UnitPre& up, int q) const {
        const f32x4 xp = l == 0 ? (f32x4){__uint_as_float(xr.x), __uint_as_float(xr.y), __uint_as_float(xr.z), __uint_as_float(xr.w)} : (f32x4){lo16(xr.x), hi16(xr.x), lo16(xr.y), hi16(xr.y)};
        st4b(x1b_row(P, row) + col, xp + up.g[q] * v); } };

struct Frame { LAS unsigned char* lds; int wave, vcu, G; };
#define fresh_tid() (F.wave * 64 + fresh_lane())
__device__ __forceinline__ void tr_item(const float* W, int ldw, int k0, int csrc0, bf16_t* WT, int ldt, int drow0, LAS float* scr, int lane) {
    f32x4 v[8];
#pragma unroll
    for (int i = 0; i < 8; ++i) v[i] = *(const f32x4*)(W + (size_t)(k0 + (lane >> 3) + 8 * i) * ldw + csrc0 + (lane & 7) * 4);
#pragma unroll
    for (int i = 0; i < 8; ++i) { LAS float* d = scr + ((lane >> 3) + 8 * i) * 33 + (lane & 7) * 4; d[0] = v[i].x; d[1] = v[i].y; d[2] = v[i].z; d[3] = v[i].w; }
    LDS_WAIT(); asm volatile("" ::: "memory");
    const int c = lane & 7;
#pragma unroll
    for (int j = 0; j < 4; ++j) { const int n = (lane >> 3) + 8 * j; const LAS float* s = scr + (8 * c) * 33 + n;
        u32x4 o; o.x = cvtpk(s[0 * 33], s[1 * 33]); o.y = cvtpk(s[2 * 33], s[3 * 33]); o.z = cvtpk(s[4 * 33], s[5 * 33]); o.w = cvtpk(s[6 * 33], s[7 * 33]);
        *(u32x4*)(WT + (size_t)(drow0 + n) * ldt + k0 + 8 * c) = o; }
    LDS_WAIT(); asm volatile("" ::: "memory");
}
__device__ __forceinline__ void max_item(const float* W, int ldw, int k0, int csrc0, unsigned* cmax, int lane) {
    f32x4 m = (f32x4){0.f, 0.f, 0.f, 0.f};
#pragma unroll
    for (int i = 0; i < 8; ++i) { const f32x4 v = *(const f32x4*)(W + (size_t)(k0 + (lane >> 3) + 8 * i) * ldw + csrc0 + (lane & 7) * 4);
        m.x = fmaxf(m.x, fabsf(v.x)); m.y = fmaxf(m.y, fabsf(v.y)); m.z = fmaxf(m.z, fabsf(v.z)); m.w = fmaxf(m.w, fabsf(v.w)); }
#pragma unroll
    for (int o = 8; o < 64; o <<= 1) { m.x = fmaxf(m.x, shfl_xor_l(m.x, o, lane)); m.y = fmaxf(m.y, shfl_xor_l(m.y, o, lane)); m.z = fmaxf(m.z, shfl_xor_l(m.z, o, lane)); m.w = fmaxf(m.w, shfl_xor_l(m.w, o, lane)); }
    if (lane < 8) { atomicMax(cmax + lane * 4, __float_as_uint(m.x)); atomicMax(cmax + lane * 4 + 1, __float_as_uint(m.y)); atomicMax(cmax + lane * 4 + 2, __float_as_uint(m.z)); atomicMax(cmax + lane * 4 + 3, __float_as_uint(m.w)); }
}
__device__ __forceinline__ unsigned q8(float v, float inv) { int q = (int)__builtin_rintf(v * inv); q = q < -127 ? -127 : (q > 127 ? 127 : q); return (unsigned)q & 255u; }
__device__ __forceinline__ unsigned q8m(float v, float inv) { return __float_as_uint(__builtin_fmaf(v, inv, 12582912.0f)); }
__device__ __forceinline__ unsigned pack4m(unsigned a, unsigned b, unsigned c, unsigned d) { return __builtin_amdgcn_perm(b, a, 0x0c0c0400u) | __builtin_amdgcn_perm(d, c, 0x04000c0cu); }
__device__ __forceinline__ unsigned q8x4(float a, float b, float c, float d, float inv) { return pack4m(q8m(a, inv), q8m(b, inv), q8m(c, inv), q8m(d, inv)); }
__device__ __forceinline__ void tr_item_q(const float* W, int ldw, int k0, int csrc0, unsigned char* WT, int ldt, int drow0, const unsigned* cmax, LAS float* scr, int lane) {
    f32x4 v[8];
#pragma unroll
    for (int i = 0; i < 8; ++i) v[i] = *(const f32x4*)(W + (size_t)(k0 + (lane >> 3) + 8 * i) * ldw + csrc0 + (lane & 7) * 4);
#pragma unroll
    for (int i = 0; i < 8; ++i) { LAS float* d = scr + ((lane >> 3) + 8 * i) * 33 + (lane & 7) * 4; d[0] = v[i].x; d[1] = v[i].y; d[2] = v[i].z; d[3] = v[i].w; }
    LDS_WAIT(); asm volatile("" ::: "memory");
    const int n = lane >> 1, half = lane & 1; const float cm = __uint_as_float(cmax[n]); const float inv = cm > 0.f ? 127.0f / cm : 0.f;
    const LAS float* sp = scr + (half * 32) * 33 + n; unsigned w[8];
#pragma unroll
    for (int q = 0; q < 8; ++q) w[q] = q8x4(sp[(4 * q) * 33], sp[(4 * q + 1) * 33], sp[(4 * q + 2) * 33], sp[(4 * q + 3) * 33], inv);
    u32x4* dp = (u32x4*)(WT + (size_t)(drow0 + n) * ldt + k0 + half * 32);
    dp[0] = (u32x4){w[0], w[1], w[2], w[3]}; dp[1] = (u32x4){w[4], w[5], w[6], w[7]};
    LDS_WAIT(); asm volatile("" ::: "memory");
}
struct Strip { const float* W; int ldw; unsigned char* WT; unsigned* cm; };
constexpr int NSTRIP = 64 + 128 + 512, ST_PITCH = 1040, ST_RED = 32 * ST_PITCH;
__device__ __forceinline__ Strip strip_desc(const Ptrs& P, int l, int s, unsigned char* wb, unsigned* cmaxp) {
    Strip d;
    if (s < 64) { d.W = P.w_in + (size_t)l * 1024 * 2560 + 512 + s * 32; d.ldw = 2560; d.WT = wb + WB_IN + (size_t)(1024 + s * 32) * 1024; d.cm = cmaxp + 1024 + s * 32; }
    else if (s < 192) { const int r = s - 64, i = r >> 5, nb = r & 31; d.W = P.w_gate + ((size_t)l * 4 + i) * 1024 * 1024 + nb * 32; d.ldw = 1024; d.WT = wb + WB_GATE + (size_t)i * 1024 * 1024 + (size_t)(nb * 32) * 1024; d.cm = cmaxp + 3072 + i * 1024 + nb * 32; }
    else { const int r = s - 192, w3 = r >> 8, e = (r >> 4) & 15, nb = r & 15, c = nb * 32, drow = 256 * (c >> 7) + (c & 127) + (w3 ? 128 : 0);
        d.W = (w3 ? P.w3 : P.w1) + ((size_t)l * 16 + e) * 1024 * 512 + c; d.ldw = 512; d.WT = wb + WB_13 + (size_t)e * 1024 * 1024 + (size_t)drow * 1024; d.cm = cmaxp + 8192 + e * 1024 + drow; }
    return d;
}
#define STRIP_LOAD(v, dsc, tid) do { const float* p_ = (dsc).W + (size_t)(4 * ((tid) >> 3)) * (dsc).ldw + 4 * ((tid) & 7); \
    _Pragma("unroll") for (int j_ = 0; j_ < 4; ++j_) _Pragma("unroll") for (int d_ = 0; d_ < 4; ++d_) v[j_ * 4 + d_] = *(const f32x4*)(p_ + (size_t)(256 * j_ + d_) * (dsc).ldw); } while (0)
__device__ __forceinline__ void strip_process(const f32x4 (&v)[16], const Strip& d, LAS unsigned char* lds, int tid, int lane, int wave) {
    const int cq = tid & 7, kr = tid >> 3;
    f32x4 m = (f32x4){0.f, 0.f, 0.f, 0.f};
#pragma unroll
    for (int i = 0; i < 16; ++i) { m.x = fmaxf(m.x, fabsf(v[i].x)); m.y = fmaxf(m.y, fabsf(v[i].y)); m.z = fmaxf(m.z, fabsf(v[i].z)); m.w = fmaxf(m.w, fabsf(v[i].w)); }
#pragma unroll
    for (int o = 8; o < 64; o <<= 1) { m.x = fmaxf(m.x, shfl_xor_l(m.x, o, lane)); m.y = fmaxf(m.y, shfl_xor_l(m.y, o, lane)); m.z = fmaxf(m.z, shfl_xor_l(m.z, o, lane)); m.w = fmaxf(m.w, shfl_xor_l(m.w, o, lane)); }
    LAS float* red = (LAS float*)(lds + ST_RED);
    if (lane < 8) *(LAS f32x4*)(red + wave * 32 + 4 * lane) = m;
    __syncthreads();
    f32x4 cm = *(const LAS f32x4*)(red + 4 * cq);
#pragma unroll
    for (int w = 1; w < 8; ++w) { const f32x4 t = *(const LAS f32x4*)(red + w * 32 + 4 * cq); cm.x = fmaxf(cm.x, t.x); cm.y = fmaxf(cm.y, t.y); cm.z = fmaxf(cm.z, t.z); cm.w = fmaxf(cm.w, t.w); }
    if (tid < 8) *(u32x4*)(d.cm + 4 * tid) = (u32x4){__float_as_uint(cm.x), __float_as_uint(cm.y), __float_as_uint(cm.z), __float_as_uint(cm.w)};
    f32x4 inv; inv.x = cm.x > 0.f ? 127.0f / cm.x : 0.f; inv.y = cm.y > 0.f ? 127.0f / cm.y : 0.f; inv.z = cm.z > 0.f ? 127.0f / cm.z : 0.f; inv.w = cm.w > 0.f ? 127.0f / cm.w : 0.f;
    LAS unsigned char* tp = lds + (4 * cq) * ST_PITCH + 4 * kr;
#pragma unroll
    for (int j = 0; j < 4; ++j) {
        *(LAS unsigned*)(tp + 0 * ST_PITCH + 256 * j) = pack4m(q8m(v[4 * j].x, inv.x), q8m(v[4 * j + 1].x, inv.x), q8m(v[4 * j + 2].x, inv.x), q8m(v[4 * j + 3].x, inv.x));
        *(LAS unsigned*)(tp + 1 * ST_PITCH + 256 * j) = pack4m(q8m(v[4 * j].y, inv.y), q8m(v[4 * j + 1].y, inv.y), q8m(v[4 * j + 2].y, inv.y), q8m(v[4 * j + 3].y, inv.y));
        *(LAS unsigned*)(tp + 2 * ST_PITCH + 256 * j) = pack4m(q8m(v[4 * j].z, inv.z), q8m(v[4 * j + 1].z, inv.z), q8m(v[4 * j + 2].z, inv.z), q8m(v[4 * j + 3].z, inv.z));
        *(LAS unsigned*)(tp + 3 * ST_PITCH + 256 * j) = pack4m(q8m(v[4 * j].w, inv.w), q8m(v[4 * j + 1].w, inv.w), q8m(v[4 * j + 2].w, inv.w), q8m(v[4 * j + 3].w, inv.w));
    }
    __syncthreads();
#pragma unroll
    for (int q = 0; q < 4; ++q) { const int id = tid + 512 * q, n = id >> 6, kc = id & 63; *(u32x4*)(d.WT + (size_t)n * 1024 + 16 * kc) = *(const LAS u32x4*)(lds + n * ST_PITCH + 16 * kc); }
}
__device__ __forceinline__ void ph_weights(const Frame& F, const Ptrs& P, int l) {
    const int tid0 = fresh_tid(), lane0 = tid0 & 63;
    LAS float* scr = (LAS float*)(F.lds + F.wave * 16384);
    const int gw = F.vcu * NWAVES + F.wave, NGW = F.G * NWAVES;
    unsigned char* wb = P.ws + WS_WB;
    unsigned* cmaxp = (unsigned*)(P.ws + WS_CTL) + CW_CMAX + 32768 * l;
    int vcu = F.vcu; asm volatile("" : "+s"(vcu));
    { const int tid = tid0; f32x4 va[16], vb[16]; Strip da, db; int s = vcu;
      if (s < NSTRIP) { da = strip_desc(P, l, s, wb, cmaxp); STRIP_LOAD(va, da, tid); }
      while (s < NSTRIP) {
          int sn = s + F.G;
          if (sn < NSTRIP) { db = strip_desc(P, l, sn, wb, cmaxp); STRIP_LOAD(vb, db, tid); }
          strip_process(va, da, F.lds, tid, lane0, F.wave);
          s = sn; if (s >= NSTRIP) break;
          sn = s + F.G;
          if (sn < NSTRIP) { da = strip_desc(P, l, sn, wb, cmaxp); STRIP_LOAD(va, da, tid); }
          strip_process(vb, db, F.lds, tid, lane0, F.wave);
          s = sn;
      } }
    __syncthreads();
    constexpr int I2 = 768, I3 = I2 + 512, I6 = I3 + 4096;
    int it0, it1, step;
    if (F.G == 256) { const int base = vcu < 192 ? 16 * vcu : 3072 + 36 * (vcu - 192); it0 = base + F.wave; it1 = base + (vcu < 192 ? 16 : 36); step = NWAVES; }
    else { it0 = gw; it1 = I6; step = NGW; }
    for (int it = it0; it < it1; it += step) {
        if (it < I2) { const int i = it >> 8, q = it & 255, kb = q >> 5, nb = q & 31; tr_item(P.w_branch + ((size_t)l * 4 + i) * 512 * 1024, 1024, kb * 64, nb * 32, (bf16_t*)(wb + WB_BR) + i * 512, 2048, nb * 32, scr, lane0); }
        else if (it < I3) { const int q = it - I2, kb = q >> 5, nb = q & 31; tr_item(P.w_out + (size_t)l * 1024 * 1024, 1024, kb * 64, nb * 32, (bf16_t*)(wb + WB_OUT), 1024, nb * 32, scr, lane0); }
        else { const int r = it - I3, e = r >> 8, q = r & 255, kb = q >> 5, nb = q & 31; tr_item(P.w2 + ((size_t)l * 16 + e) * 512 * 1024, 1024, kb * 64, nb * 32, (bf16_t*)(wb + WB_2) + (size_t)e * 1024 * 512, 512, nb * 32, scr, lane0); }
    }
    __syncthreads();
    for (int u = F.vcu; u < 256; u += F.G) {
        LAS float* Wl = (LAS float*)F.lds; LAS float* ct = Wl + 16 * 128;
        const int kt = u >> 2, g = u & 3, k0 = kt * 16, tid = tid0; const float* w_in = P.w_in + (size_t)l * 1024 * 2560;
        if (tid < 128) ct[tid] = __builtin_amdgcn_cosf((float)tid * (1.0f / 128.0f));
        for (int i = tid; i < 16 * 128; i += 512) { const int k = i >> 7, c = i & 127; Wl[k * 128 + c] = w_in[(size_t)(k0 + k) * 2560 + g * 128 + c]; }
        __syncthreads();
        const int part = (tid >> 7) & 1, m = tid & 127, kh = tid >> 8; const float sc = 0.08838834764831845f;
        float* drow = (float*)(P.ws + WS_FTMP) + (size_t)(part * 512 + g * 128 + m) * 1024 + k0;
        { const int kb = kh * 8; float acc[8];
#pragma unroll
            for (int j = 0; j < 8; ++j) acc[j] = 0.f;
            for (int c = 0; c < 128; ++c) { const int idx = (c * m) & 127; const float tw = part ? -ct[(idx - 32) & 127] : ct[idx];
#pragma unroll
                for (int j = 0; j < 8; ++j) acc[j] += Wl[(kb + j) * 128 + c] * tw; }
            float mx = 0.f;
#pragma unroll
            for (int j = 0; j < 8; ++j) { acc[j] *= sc; mx = fmaxf(mx, fabsf(acc[j])); }
            *(f32x4*)(drow + kb) = (f32x4){acc[0], acc[1], acc[2], acc[3]}; *(f32x4*)(drow + kb + 4) = (f32x4){acc[4], acc[5], acc[6], acc[7]};
            atomicMax(cmaxp + part * 512 + g * 128 + m, __float_as_uint(mx)); }
        __syncthreads();
    }
    for (int u = F.vcu; u < 256; u += F.G) {
        LAS float* Wb = (LAS float*)F.lds;
        const int g = u >> 6, n0 = (u & 63) * 16, tid = tid0;
        const float* ps = P.pool_scale + (size_t)l * 512; const float* wb3 = P.w_branch + ((size_t)l * 4 + 3) * 512 * 1024; const float* pwl = P.pool_w + (size_t)l * 4 * 128 * 128;
        for (int i = tid; i < 128 * 16; i += 512) { const int e = i >> 4, n = i & 15; Wb[e * 16 + n] = ps[g * 128 + e] * wb3[(size_t)(g * 128 + e) * 1024 + n0 + n]; }
        __syncthreads();
        const int c = tid & 127, nh = tid >> 7; const float* pw = pwl + (size_t)(g * 128 + c) * 128;
        float acc[4];
#pragma unroll
        for (int j = 0; j < 4; ++j) acc[j] = 0.f;
        for (int e = 0; e < 128; e += 4) { const f32x4 p4 = *(const f32x4*)(pw + e);
#pragma unroll
            for (int q = 0; q < 4; ++q)
#pragma unroll
                for (int j = 0; j < 4; ++j) acc[j] += p4[q] * Wb[(e + q) * 16 + nh * 4 + j]; }
        bf16_t* Bt = (bf16_t*)(wb + WB_BR) + 3 * 512;
#pragma unroll
        for (int j = 0; j < 4; ++j) Bt[(size_t)(n0 + nh * 4 + j) * 2048 + g * 128 + c] = (bf16_t)f2bf(acc[j]);
        __syncthreads();
    }
}
__device__ __forceinline__ void ph_quant(const Frame& F, const Ptrs& P, int l) {
    const int tid0 = fresh_tid(), lane0 = tid0 & 63;
    LAS float* scr = (LAS float*)(F.lds + F.wave * 16384);
    const int gw = F.vcu * NWAVES + F.wave, NGW = F.G * NWAVES;
    unsigned char* wb = P.ws + WS_WB; const unsigned* cmaxp = (const unsigned*)(P.ws + WS_CTL) + CW_CMAX + 32768 * l;
    for (int i = F.vcu * 512 + tid0; i < 65536; i += F.G * 512) {
        const int n = i >> 6, kc = (i & 63) * 16; const float cm = __uint_as_float(cmaxp[n]); const float inv = cm > 0.f ? 127.0f / cm : 0.f;
        const f32x4* tp = (const f32x4*)((const float*)(P.ws + WS_FTMP) + (size_t)n * 1024 + kc); const f32x4 a = tp[0], b = tp[1], c = tp[2], d = tp[3];
        *(u32x4*)(wb + WB_IN + (size_t)n * 1024 + kc) = (u32x4){q8x4(a.x, a.y, a.z, a.w, inv), q8x4(b.x, b.y, b.z, b.w, inv), q8x4(c.x, c.y, c.z, c.w, inv), q8x4(d.x, d.y, d.z, d.w, inv)};
    }
    __syncthreads();
}
__device__ __forceinline__ void ph_tables_mod(const Frame& F, const Ptrs& P) {
    const int tid0 = fresh_tid();
    { float* rc = (float*)(P.ws + WS_ROPE); float* rs = rc + 1024; float* ct = (float*)(P.ws + WS_COS);
      const int i = F.vcu * 512 + tid0;
      if (i < 1024) { const int pos = i >> 4, f = i & 15; const float inv = __builtin_amdgcn_exp2f(-(float)f * (13.287712379549449f / 16.0f));
          float rev = (float)pos * inv * 0.15915494309189535f; rev = rev - floorf(rev);
          rc[i] = __builtin_amdgcn_cosf(rev); rs[i] = __builtin_amdgcn_sinf(rev); }
      if (i < 4096) ct[i] = __builtin_amdgcn_cosf((float)i * (1.0f / 4096.0f));
      if (i < 16384) { const int mm = i >> 7, k = i & 127, pp = mm >> 6, k1 = mm & 63, pk = k >> 6, t1 = k & 63; const float rev = (float)((k1 * t1) & 63) * (1.0f / 64.0f);
          const float c = __builtin_amdgcn_cosf(rev), sn = __builtin_amdgcn_sinf(rev);
          ((bf16_t*)(P.ws + WS_DFTM))[i] = (bf16_t)f2bf(pp == pk ? c : (pp == 0 ? sn : -sn)); } }
    for (int u = F.vcu; u < 192; u += F.G) {
        LAS float* s = (LAS float*)F.lds; LAS float* red = s + 9 * 1024;
        const int l = u / 96, j0 = (u % 96) * 64, tid = tid0;
        for (int i = tid; i < 9 * 1024; i += 512) { const int bb = i >> 10, k = i & 1023; const float v = bb < 8 ? P.c[bb * 1024 + k] : P.c_ctx[k]; s[i] = v * __builtin_amdgcn_rcpf(1.f + __builtin_amdgcn_exp2f(-1.4426950408889634f * v)); }
        __syncthreads();
        const int kc = tid >> 4, jq = tid & 15;
        const float* w = P.w_ada + (size_t)l * 1024 * 6144 + j0 + 4 * jq + (size_t)(kc * 32) * 6144;
        f32x4 wv[32];
#pragma unroll
        for (int q = 0; q < 32; ++q) wv[q] = *(const f32x4*)(w + (size_t)q * 6144);
        f32x4 acc[9];
#pragma unroll
        for (int b = 0; b < 9; ++b) acc[b] = (f32x4){0.f, 0.f, 0.f, 0.f};
#pragma unroll
        for (int qq = 0; qq < 8; ++qq)
#pragma unroll
            for (int b = 0; b < 9; ++b) { const f32x4 s4 = *(const LAS f32x4*)(s + b * 1024 + kc * 32 + 4 * qq);
                acc[b] += s4.x * wv[4 * qq] + s4.y * wv[4 * qq + 1] + s4.z * wv[4 * qq + 2] + s4.w * wv[4 * qq + 3]; }
#pragma unroll
        for (int b = 0; b < 9; ++b) *(LAS f32x4*)(red + (kc * 9 + b) * 64 + 4 * jq) = acc[b];
        __syncthreads();
        float* mod = (float*)(P.ws + WS_MOD);
        for (int i = tid; i < 9 * 64; i += 512) { const int b = i >> 6, j = i & 63; float v = P.b_ada[l * 6144 + j0 + j];
#pragma unroll
            for (int q = 0; q < 32; ++q) v += red[(q * 9 + b) * 64 + j];
            const int which = j0 >> 10, k = (j0 & 1023) + j;
            if (which == 1) v = P.norm1[l * D + k] * (1.0f + v); else if (which == 4) v = P.norm2[l * D + k] * (1.0f + v);
            mod[(size_t)(l * 9 + b) * 6144 + j0 + j] = v; }
        __syncthreads();
    }
}
__device__ __forceinline__ void route_row(const Ptrs& P, int r, const f32x4 (&h)[4], int lane, bool publish, LAS unsigned* lcnt, LAS int* rec, const LAS float* rwl) {
    float lg[16];
#pragma unroll
    for (int e = 0; e < 16; ++e) lg[e] = 0.f;
#pragma unroll
    for (int j = 0; j < 4; ++j) {
#pragma unroll
        for (int i = 0; i < 4; ++i) { const int kk = 4 * lane + 256 * j + i; const LAS f32x4* rw = (const LAS f32x4*)(rwl + kk * 16 + (kk >> 2) * 4); const float hv = h[j][i];
#pragma unroll
            for (int qd = 0; qd < 4; ++qd) { const f32x4 w = rw[qd]; lg[4 * qd] += hv * w.x; lg[4 * qd + 1] += hv * w.y; lg[4 * qd + 2] += hv * w.z; lg[4 * qd + 3] += hv * w.w; } }
        __builtin_amdgcn_sched_barrier(0); }
    float v8[8], v4[4], v2[2], v1;
    { const bool bit = (lane & 32) != 0;
#pragma unroll
      for (int i = 0; i < 8; ++i) { const float a = lg[i], b = lg[i + 8]; v8[i] = (bit ? b : a) + shfl_xor_l(bit ? a : b, 32, lane); } }
    { const bool bit = (lane & 16) != 0;
#pragma unroll
      for (int i = 0; i < 4; ++i) { const float a = v8[i], b = v8[i + 4]; v4[i] = (bit ? b : a) + shfl_xor_l(bit ? a : b, 16, lane); } }
    { const bool bit = (lane & 8) != 0;
#pragma unroll
      for (int i = 0; i < 2; ++i) { const float a = v4[i], b = v4[i + 2]; v2[i] = (bit ? b : a) + shfl_xor_l(bit ? a : b, 8, lane); } }
    { const bool bit = (lane & 4) != 0; const float a = v2[0], b = v2[1]; v1 = (bit ? b : a) + shfl_xor_l(bit ? a : b, 4, lane); }
    v1 += shfl_xor_l(v1, 2, lane); v1 += shfl_xor_l(v1, 1, lane);
    float bestscore = -INFINITY; int be0 = 0, be1 = 1; float ba0 = 0.f, ba1 = 0.f;
#pragma unroll
    for (int g = 0; g < 4; ++g) {
        float aff[4], sel[4];
#pragma unroll
        for (int i = 0; i < 4; ++i) { const float t = __int_as_float(__builtin_amdgcn_ds_bpermute((4 * g + i) << 4, __float_as_int(v1))); aff[i] = __builtin_amdgcn_rcpf(1.0f + __builtin_amdgcn_exp2f(-1.4426950408889634f * t)); sel[i] = aff[i] + P.router_bias[4 * g + i]; }
        int i1 = 0; float m1 = sel[0], a1 = aff[0];
#pragma unroll
        for (int i = 1; i < 4; ++i) if (sel[i] > m1) { m1 = sel[i]; a1 = aff[i]; i1 = i; }
        int i2 = -1; float m2 = -INFINITY, a2 = 0.f;
#pragma unroll
        for (int i = 0; i < 4; ++i) if (i != i1 && sel[i] > m2) { m2 = sel[i]; a2 = aff[i]; i2 = i; }
        const float score = m1 + m2;
        if (score > bestscore) { bestscore = score; be0 = 4 * g + i1; be1 = 4 * g + i2; ba0 = a1; ba1 = a2; }
    }
    if (lane == 0 && publish) {
        const int p0 = (int)__hip_atomic_fetch_add(lcnt + be0, 1u, __ATOMIC_RELAXED, __HIP_MEMORY_SCOPE_WORKGROUP), p1 = (int)__hip_atomic_fetch_add(lcnt + be1, 1u, __ATOMIC_RELAXED, __HIP_MEMORY_SCOPE_WORKGROUP);
        const float inv = 1.0f / (ba0 + ba1);
        rec[0] = r; rec[1] = be0; rec[2] = p0; rec[3] = be1; rec[4] = p1; rec[5] = __float_as_int(ba0 * inv); rec[6] = __float_as_int(ba1 * inv);
    }
}
template <int MODE> __device__ __forceinline__ void ph_norm(const Frame& F, const Ptrs& P, int l, int nrows) {
    constexpr int NRW = MODE == 2 ? 2 : 4;
    const int lane = fresh_lane();
    const int stride = F.G * NWAVES;
    LAS unsigned* lcnt = (LAS unsigned*)F.lds; LAS unsigned* gbase = lcnt + 16; LAS int* recs = (LAS int*)(F.lds + 256);
    const LAS float* rwl = (const LAS float*)(F.lds + 8192);
    if (MODE == 2) { if (F.wave == 0 && lane < 16) lcnt[lane] = 0u;
        { const int tid = F.wave * 64 + lane; LAS f32x4* d = (LAS f32x4*)(F.lds + 8192);
#pragma unroll
          for (int i = 0; i < 8; ++i) { const int idx = tid + 512 * i, kk = idx >> 2; d[idx + (kk >> 2)] = ((const f32x4*)P.router_w)[idx]; } }
        __syncthreads(); }
    int it = 0;
    for (int rb = F.vcu * NWAVES + F.wave; rb < nrows; rb += NRW * stride, ++it) {
        int rr[NRW];
#pragma unroll
        for (int q = 0; q < NRW; ++q) rr[q] = rb + q * stride < nrows ? rb + q * stride : rb;
        f32x4 v[NRW][4];
#pragma unroll
        for (int q = 0; q < NRW; ++q) { const int r = rr[q];
            if (MODE == 0) { const f32x4* xr = (const f32x4*)xin_row(P, r) + lane;
#pragma unroll
                for (int j = 0; j < 4; ++j) v[q][j] = xr[64 * j]; }
            else { const bf16_t* xr = x1b_row(P, r) + 4 * lane;
#pragma unroll
                for (int j = 0; j < 4; ++j) v[q][j] = ld4b(xr + 256 * j); } }
        if (MODE == 1) {
#pragma unroll
            for (int q = 0; q < NRW; ++q) { const int r = rr[q]; const int bb = row_bb(r); const f32x4* g2 = (const f32x4*)mod_vec(P, l - 1, bb, 5) + lane;
                const u32x2* m0 = (const u32x2*)((const bf16_t*)(P.ws + WS_MO) + (size_t)r * D) + lane; const u32x2* m1 = (const u32x2*)((const bf16_t*)(P.ws + WS_MO) + (size_t)(R + r) * D) + lane;
#pragma unroll
                for (int j = 0; j < 4; ++j) { const u32x2 a = m0[64 * j], b = m1[64 * j]; const f32x4 g = g2[64 * j];
                    v[q][j].x += g.x * (lo16(a.x) + lo16(b.x)); v[q][j].y += g.y * (hi16(a.x) + hi16(b.x)); v[q][j].z += g.z * (lo16(a.y) + lo16(b.y)); v[q][j].w += g.w * (hi16(a.y) + hi16(b.y)); } }
#pragma unroll
            for (int q = 0; q < NRW; ++q) if (q == 0 || rr[q] != rr[0]) { bf16_t* xr = x1b_row(P, rr[q]) + 4 * lane;
#pragma unroll
                for (int j = 0; j < 4; ++j) st4b(xr + 256 * j, v[q][j]); }
        }
        float ss[NRW];
#pragma unroll
        for (int q = 0; q < NRW; ++q) { ss[q] = 0.f;
#pragma unroll
            for (int j = 0; j < 4; ++j) ss[q] += (v[q][j].x * v[q][j].x + v[q][j].y * v[q][j].y) + (v[q][j].z * v[q][j].z + v[q][j].w * v[q][j].w); }
#pragma unroll
        for (int o = 1; o < 64; o <<= 1) {
#pragma unroll
            for (int q = 0; q < NRW; ++q) ss[q] += shfl_xor_l(ss[q], o, lane); }
#pragma unroll
        for (int q = 0; q < NRW; ++q) { const int r = rr[q]; const int bb = row_bb(r);
            if (q > 0 && r == rr[0]) continue;
            const float rstd = 1.0f / sqrtf(ss[q] * (1.0f / D) + EPS);
            const f32x4* sh = (const f32x4*)mod_vec(P, l, bb, MODE == 2 ? 3 : 0) + lane;
            const f32x4* sc = (const f32x4*)mod_vec(P, l, bb, MODE == 2 ? 4 : 1) + lane;
            {
                float mx = 0.f;
#pragma unroll
                for (int j = 0; j < 4; ++j) { const f32x4 a = sh[64 * j], b = sc[64 * j];
                    v[q][j] = (v[q][j] * rstd) * b + a;
                    mx = fmaxf(mx, fmaxf(fmaxf(fabsf(v[q][j].x), fabsf(v[q][j].y)), fmaxf(fabsf(v[q][j].z), fabsf(v[q][j].w)))); }
#pragma unroll
                for (int o = 1; o < 64; o <<= 1) mx = fmaxf(mx, shfl_xor_l(mx, o, lane));
                const float inv = mx > 0.f ? 127.0f / mx : 0.f;
                unsigned* o8 = (unsigned*)(P.ws + WS_H + (size_t)r * D) + lane;
#pragma unroll
                for (int j = 0; j < 4; ++j) o8[64 * j] = q8x4(v[q][j].x, v[q][j].y, v[q][j].z, v[q][j].w, inv);
                if (lane == 0) ((float*)(P.ws + WS_SA))[r] = mx * (1.0f / 127.0f); } }
        if (MODE == 2) { LAS int* rec = recs + (F.wave * 24 + 2 * it) * 8;
            route_row(P, rr[0], v[0], lane, true, lcnt, rec, rwl); __builtin_amdgcn_sched_barrier(0);
            if (lane == 0 && rr[1] == rr[0]) rec[8] = -1;
            route_row(P, rr[1], v[1], lane, rr[1] != rr[0], lcnt, rec + 8, rwl); }
    }
    if (MODE == 2) {
        __syncthreads();
        const int tid = F.wave * 64 + lane;
        if (tid < 16) { const unsigned c = lcnt[tid]; gbase[tid] = c ? atomicAdd((unsigned*)(P.ws + WS_CTL) + CW_CNT + 1024 * l + 64 * tid, c) : 0u; }
        __syncthreads();
        if (lane == 0) for (int k = 0; k < 2 * it; ++k) { const LAS int* rec = recs + (F.wave * 24 + k) * 8; const int r = rec[0]; if (r < 0) continue;
            int* tokl = (int*)(P.ws + WS_TOKL); float* wl = (float*)(P.ws + WS_WL);
            const size_t i0 = (size_t)rec[1] * R + rec[2] + gbase[rec[1]], i1 = (size_t)rec[3] * R + rec[4] + gbase[rec[3]];
            tokl[i0] = 2 * r; wl[i0] = __int_as_float(rec[5]); tokl[i1] = 2 * r + 1; wl[i1] = __int_as_float(rec[6]); }
        __syncthreads();
    }
}
__device__ __forceinline__ void ph_norm2(const Frame& F, const Ptrs& P, int l, int nrows) {
    constexpr int AP = 2064, A_H = 8192, A_L = A_H + 16 * AP, PART = A_L + 16 * AP, LG = PART + 8192;
    const int lane = fresh_lane();
    LAS unsigned* lcnt = (LAS unsigned*)F.lds; LAS unsigned* gbase = lcnt + 16; LAS int* recs = (LAS int*)(F.lds + 256);
    if (F.wave == 0 && lane < 16) lcnt[lane] = 0u;
    bf16x8 bh[4], bl[4];
    { const float* rw = P.router_w + (size_t)(128 * F.wave + 8 * (lane >> 4)) * 16 + (lane & 15);
#pragma unroll
      for (int s = 0; s < 4; ++s) { float w[8];
#pragma unroll
          for (int j = 0; j < 8; ++j) w[j] = rw[(size_t)(32 * s + j) * 16];
          u32x4 h, lo; h.x = cvtpk(w[0], w[1]); h.y = cvtpk(w[2], w[3]); h.z = cvtpk(w[4], w[5]); h.w = cvtpk(w[6], w[7]);
          lo.x = cvtpk(w[0] - lo16(h.x), w[1] - hi16(h.x)); lo.y = cvtpk(w[2] - lo16(h.y), w[3] - hi16(h.y)); lo.z = cvtpk(w[4] - lo16(h.z), w[5] - hi16(h.z)); lo.w = cvtpk(w[6] - lo16(h.w), w[7] - hi16(h.w));
          bh[s] = __builtin_bit_cast(bf16x8, h); bl[s] = __builtin_bit_cast(bf16x8, lo); } }
    __syncthreads();
    const int ntiles = nrows >> 4;
    f32x4 v[2][4];
#define N2_LOAD(tile_) do { _Pragma("unroll") for (int q_ = 0; q_ < 2; ++q_) { const bf16_t* xr_ = x1b_row(P, (tile_) * 16 + 2 * F.wave + q_) + 4 * lane; \
        _Pragma("unroll") for (int j_ = 0; j_ < 4; ++j_) v[q_][j_] = ld4b(xr_ + 256 * j_); } } while (0)
#define N2_BAR() do { LDS_WAIT(); __builtin_amdgcn_s_barrier(); asm volatile("" ::: "memory"); } while (0)
    int tile = F.vcu, it = 0;
    if (tile < ntiles) N2_LOAD(tile);
    for (; tile < ntiles; tile += F.G, ++it) {
        const int rbase = tile * 16 + 2 * F.wave;
        float ss[2];
#pragma unroll
        for (int q = 0; q < 2; ++q) { ss[q] = 0.f;
#pragma unroll
            for (int j = 0; j < 4; ++j) ss[q] += (v[q][j].x * v[q][j].x + v[q][j].y * v[q][j].y) + (v[q][j].z * v[q][j].z + v[q][j].w * v[q][j].w); }
#pragma unroll
        for (int o = 1; o < 64; o <<= 1) { ss[0] += shfl_xor_l(ss[0], o, lane); ss[1] += shfl_xor_l(ss[1], o, lane); }
#pragma unroll
        for (int q = 0; q < 2; ++q) { const int r = rbase + q; const int bb = row_bb(r);
            const float rstd = 1.0f / sqrtf(ss[q] * (1.0f / D) + EPS);
            const f32x4* sh = (const f32x4*)mod_vec(P, l, bb, 3) + lane; const f32x4* sc = (const f32x4*)mod_vec(P, l, bb, 4) + lane;
            float mx = 0.f;
#pragma unroll
            for (int j = 0; j < 4; ++j) { const f32x4 a = sh[64 * j], b = sc[64 * j];
                v[q][j] = (v[q][j] * rstd) * b + a;
                mx = fmaxf(mx, fmaxf(fmaxf(fabsf(v[q][j].x), fabsf(v[q][j].y)), fmaxf(fabsf(v[q][j].z), fabsf(v[q][j].w)))); }
#pragma unroll
            for (int o = 1; o < 64; o <<= 1) mx = fmaxf(mx, shfl_xor_l(mx, o, lane));
            const float inv = mx > 0.f ? 127.0f / mx : 0.f;
            unsigned* o8 = (unsigned*)(P.ws + WS_H + (size_t)r * D) + lane;
            LAS unsigned char* ah = F.lds + A_H + (2 * F.wave + q) * AP + 8 * lane;
#pragma unroll
            for (int j = 0; j < 4; ++j) { const f32x4 x = v[q][j]; o8[64 * j] = q8x4(x.x, x.y, x.z, x.w, inv);
                u32x2 h, lo; h.x = cvtpk(x.x, x.y); h.y = cvtpk(x.z, x.w); lo.x = cvtpk(x.x - lo16(h.x), x.y - hi16(h.x)); lo.y = cvtpk(x.z - lo16(h.y), x.w - hi16(h.y));
                *(LAS u32x2*)(ah + 512 * j) = h; *(LAS u32x2*)(ah + (A_L - A_H) + 512 * j) = lo; }
            if (lane == 0) ((float*)(P.ws + WS_SA))[r] = mx * (1.0f / 127.0f); }
        { const int tn = tile + F.G; if (tn < ntiles) N2_LOAD(tn); }
        N2_BAR();
        f32x4 acc = (f32x4){0.f, 0.f, 0.f, 0.f};
        { const LAS unsigned char* ap = F.lds + A_H + (lane & 15) * AP + (128 * F.wave + 8 * (lane >> 4)) * 2;
#pragma unroll
          for (int s = 0; s < 4; ++s) { const bf16x8 xh = *(const LAS bf16x8*)(ap + 64 * s), xl = *(const LAS bf16x8*)(ap + (A_L - A_H) + 64 * s);
              acc = __builtin_amdgcn_mfma_f32_16x16x32_bf16(xh, bh[s], acc, 0, 0, 0); acc = __builtin_amdgcn_mfma_f32_16x16x32_bf16(xl, bh[s], acc, 0, 0, 0); acc = __builtin_amdgcn_mfma_f32_16x16x32_bf16(xh, bl[s], acc, 0, 0, 0); } }
        *(LAS f32x4*)(F.lds + PART + F.wave * 1024 + lane * 16) = acc;
        N2_BAR();
        if (F.wave < 4) { const int t = F.wave * 64 + lane, i = t >> 4, j = t & 15; const LAS float* sp = (const LAS float*)(F.lds + PART) + ((i >> 2) * 16 + j) * 4 + (i & 3); float sum = 0.f;
#pragma unroll
            for (int w = 0; w < 8; ++w) sum += sp[w * 256];
            ((LAS float*)(F.lds + LG))[t] = sum; }
        N2_BAR();
        { const int ri = 2 * F.wave + (lane >> 5), r = tile * 16 + ri;
          f32x4 L[4];
#pragma unroll
          for (int g = 0; g < 4; ++g) L[g] = *(const LAS f32x4*)(F.lds + LG + ri * 64 + 16 * g);
          float bestscore = -INFINITY; int be0 = 0, be1 = 1; float ba0 = 0.f, ba1 = 0.f;
#pragma unroll
          for (int g = 0; g < 4; ++g) {
              float aff[4], sel[4];
#pragma unroll
              for (int i = 0; i < 4; ++i) { const float t = L[g][i]; aff[i] = __builtin_amdgcn_rcpf(1.0f + __builtin_amdgcn_exp2f(-1.4426950408889634f * t)); sel[i] = aff[i] + P.router_bias[4 * g + i]; }
              int i1 = 0; float m1 = sel[0], a1 = aff[0];
#pragma unroll
              for (int i = 1; i < 4; ++i) if (sel[i] > m1) { m1 = sel[i]; a1 = aff[i]; i1 = i; }
              int i2 = -1; float m2 = -INFINITY, a2 = 0.f;
#pragma unroll
              for (int i = 0; i < 4; ++i) if (i != i1 && sel[i] > m2) { m2 = sel[i]; a2 = aff[i]; i2 = i; }
              const float score = m1 + m2;
              if (score > bestscore) { bestscore = score; be0 = 4 * g + i1; be1 = 4 * g + i2; ba0 = a1; ba1 = a2; }
          }
          if ((lane & 31) == 0) {
              const int p0 = (int)__hip_atomic_fetch_add(lcnt + be0, 1u, __ATOMIC_RELAXED, __HIP_MEMORY_SCOPE_WORKGROUP), p1 = (int)__hip_atomic_fetch_add(lcnt + be1, 1u, __ATOMIC_RELAXED, __HIP_MEMORY_SCOPE_WORKGROUP);
              const float inv = 1.0f / (ba0 + ba1); LAS int* rec = recs + (it * 16 + ri) * 8;
              rec[0] = r; rec[1] = be0; rec[2] = p0; rec[3] = be1; rec[4] = p1; rec[5] = __float_as_int(ba0 * inv); rec[6] = __float_as_int(ba1 * inv); } }
    }
#undef N2_LOAD
#undef N2_BAR
    __syncthreads();
    const int tid = F.wave * 64 + lane;
    if (tid < 16) { const unsigned c = lcnt[tid]; gbase[tid] = c ? atomicAdd((unsigned*)(P.ws + WS_CTL) + CW_CNT + 1024 * l + 64 * tid, c) : 0u; }
    __syncthreads();
    for (int k = tid; k < it * 16; k += NWAVES * 64) { const LAS int* rec = recs + k * 8; const int r = rec[0];
        int* tokl = (int*)(P.ws + WS_TOKL); float* wl = (float*)(P.ws + WS_WL);
        const size_t i0 = (size_t)rec[1] * R + rec[2] + gbase[rec[1]], i1 = (size_t)rec[3] * R + rec[4] + gbase[rec[3]];
        tokl[i0] = 2 * r; wl[i0] = __int_as_float(rec[5]); tokl[i1] = 2 * r + 1; wl[i1] = __int_as_float(rec[6]); }
    __syncthreads();
}
__device__ __forceinline__ void ph_kprep(const Frame& F, const Ptrs& P, int l) {
    const int lane = fresh_lane();
    const float* rc = (const float*)(P.ws + WS_ROPE); const float* rs = rc + 1024;
    const int hs = (lane >> 3) & 3, chunk = lane & 7, col = (hs < 2 ? C_KB + hs * 64 : C_KW + (hs - 2) * 64) + chunk * 8;
    const f32x4 g0 = *(const f32x4*)(P.k_gain + l * 64 + chunk * 8), g1 = *(const f32x4*)(P.k_gain + l * 64 + chunk * 8 + 4);
    const int a = chunk >> 2, fi = (chunk & 1) * 8; const bool second = (chunk & 2) != 0;
    const int npair = R / 2, stride = F.G * NWAVES;
    float km = 0.f;
    for (int pr0 = F.vcu * NWAVES + F.wave; pr0 < npair; pr0 += 4 * stride) {
        u32x4 w[4];
#pragma unroll
        for (int q = 0; q < 4; ++q) { const int pr = pr0 + q * stride; const int r = 2 * (pr < npair ? pr : pr0) + (lane >> 5); w[q] = *(const u32x4*)((const bf16_t*)(P.ws + WS_U) + (size_t)r * NIN + col); }
#pragma unroll
        for (int q = 0; q < 4; ++q) { const int pr = pr0 + q * stride; if (pr >= npair) break;
            const int r = 2 * pr + (lane >> 5);
            float x[8] = {lo16(w[q].x), hi16(w[q].x), lo16(w[q].y), hi16(w[q].y), lo16(w[q].z), hi16(w[q].z), lo16(w[q].w), hi16(w[q].w)};
            float ss = 0.f;
#pragma unroll
            for (int j = 0; j < 8; ++j) ss += x[j] * x[j];
            ss += shfl_xor_l(ss, 1, lane); ss += shfl_xor_l(ss, 2, lane); ss += shfl_xor_l(ss, 4, lane);
            if (hs >= 2) km = fmaxf(km, ss);
            if (hs < 2) {
                const float rstd = 1.0f / sqrtf(ss * (1.0f / 64.0f) + EPS);
                x[0] *= rstd * g0.x; x[1] *= rstd * g0.y; x[2] *= rstd * g0.z; x[3] *= rstd * g0.w; x[4] *= rstd * g1.x; x[5] *= rstd * g1.y; x[6] *= rstd * g1.z; x[7] *= rstd * g1.w; }
            if (r < RL) { const int t = r & (T - 1), pos = a ? (t & 63) : (t >> 6);
                const f32x4 c0 = *(const f32x4*)(rc + pos * 16 + fi), c1 = *(const f32x4*)(rc + pos * 16 + fi + 4), s0 = *(const f32x4*)(rs + pos * 16 + fi), s1 = *(const f32x4*)(rs + pos * 16 + fi + 4);
                const float cs[8] = {c0.x, c0.y, c0.z, c0.w, c1.x, c1.y, c1.z, c1.w}, sn[8] = {s0.x, s0.y, s0.z, s0.w, s1.x, s1.y, s1.z, s1.w};
#pragma unroll
                for (int j = 0; j < 8; ++j) { const float y = shfl_xor_l(x[j], 2, lane); x[j] = second ? x[j] * cs[j] + y * sn[j] : x[j] * cs[j] - y * sn[j]; } }
            u32x4 o; o.x = cvtpk(x[0], x[1]); o.y = cvtpk(x[2], x[3]); o.z = cvtpk(x[4], x[5]); o.w = cvtpk(x[6], x[7]);
            *(u32x4*)((bf16_t*)(P.ws + WS_U) + (size_t)r * NIN + col) = o; }
    }
    float qm = 0.f;
    for (int r0 = F.vcu * NWAVES + F.wave; r0 < RL; r0 += 8 * stride) {
        u32x4 w[8];
#pragma unroll
        for (int q = 0; q < 8; ++q) { const int r = r0 + q * stride < RL ? r0 + q * stride : r0; w[q] = *(const u32x4*)((const bf16_t*)(P.ws + WS_U) + (size_t)r * NIN + C_QW + lane * 8); }
#pragma unroll
        for (int q = 0; q < 8; ++q) { float ss = lo16(w[q].x) * lo16(w[q].x) + hi16(w[q].x) * hi16(w[q].x) + lo16(w[q].y) * lo16(w[q].y) + hi16(w[q].y) * hi16(w[q].y)
                                              + lo16(w[q].z) * lo16(w[q].z) + hi16(w[q].z) * hi16(w[q].z) + lo16(w[q].w) * lo16(w[q].w) + hi16(w[q].w) * hi16(w[q].w);
            ss += shfl_xor_l(ss, 1, lane); ss += shfl_xor_l(ss, 2, lane); ss += shfl_xor_l(ss, 4, lane); qm = fmaxf(qm, ss); }
    }
    qm = fmaxf(qm, shfl_xor_l(qm, 8, lane)); qm = fmaxf(qm, shfl_xor_l(qm, 16, lane));
    km = fmaxf(km, shfl_xor_l(km, 32, lane));
    LAS float* red = (LAS float*)F.lds;
    if (lane == 0) red[F.wave * 4] = qm; if (lane == 32) red[F.wave * 4 + 1] = qm; if (lane == 16) red[F.wave * 4 + 2] = km; if (lane == 24) red[F.wave * 4 + 3] = km;
    __syncthreads();
    if (F.wave == 0 && lane < 4) { float m = red[lane];
#pragma unroll
        for (int wv = 1; wv < 8; ++wv) m = fmaxf(m, red[wv * 4 + lane]);
        atomicMax((unsigned*)(P.ws + WS_CTL) + CW_QK + 64 * l + 16 * lane, __float_as_uint(m)); }
    __syncthreads();
}
__device__ __forceinline__ float pool_ch(const u32x2& w, int c) { const unsigned x = w[c >> 1]; return (c & 1) ? hi16(x) : lo16(x); }
template <int HW> __device__ __forceinline__ void pool_block(const u32x2 (&w)[32], int t0, int Ts, bf16_t* outp) {
    float S[4];
#pragma unroll
    for (int c = 0; c < 4; ++c) { S[c] = 0.f;
#pragma unroll
        for (int k = 8 - HW; k < 8 + HW; ++k) S[c] += pool_ch(w[k], c); }
#pragma unroll
    for (int j = 0; j < 16; ++j) {
        const int t = t0 + j, lo = t - HW < 0 ? 0 : t - HW, hi = t + HW > Ts ? Ts : t + HW; const float inv = 1.0f / (float)(hi - lo);
        float o[4];
#pragma unroll
        for (int c = 0; c < 4; ++c) o[c] = S[c] * inv - pool_ch(w[j + 8], c);
        u32x2 ow; ow.x = cvtpk(o[0], o[1]); ow.y = cvtpk(o[2], o[3]);
        *(u32x2*)(outp + (size_t)j * NBR) = ow;
        if (j < 15) {
#pragma unroll
            for (int c = 0; c < 4; ++c) S[c] += pool_ch(w[j + 8 + HW], c) - pool_ch(w[j + 8 - HW], c); }
    }
}
__device__ __forceinline__ void ph_pool(const Frame& F, const Ptrs& P, int nrows) {
    const int tid0 = fresh_tid();
    const int nblk = nrows >> 4, nit = nblk * 128;
    for (int i = F.vcu * 512 + tid0; i < nit; i += F.G * 512) {
        const int g = __builtin_amdgcn_readfirstlane((i >> 5) / nblk), blk = (i >> 5) - g * nblk, c4 = g * 128 + (i & 31) * 4;
        const int rb = blk * 16; const bool lat = rb < RL; const int Ts = lat ? T : TC; const int t0 = lat ? (rb & (T - 1)) : ((rb - RL) & (TC - 1)); const int r0 = rb - t0;
        const bf16_t* U = (const bf16_t*)(P.ws + WS_U) + C_P + c4;
        u32x2 w[32];
#pragma unroll
        for (int k = 0; k < 32; ++k) { const int tt = t0 - 8 + k; const bool ok = tt >= 0 && tt < Ts; w[k] = *(const u32x2*)(U + (size_t)(r0 + (ok ? tt : t0)) * NIN); }
#pragma unroll
        for (int k = 0; k < 32; ++k) { const int tt = t0 - 8 + k; if (!(tt >= 0 && tt < Ts)) w[k] = (u32x2){0u, 0u}; }
        bf16_t* outp = (bf16_t*)(P.ws + WS_BR) + (size_t)rb * NBR + 1536 + c4;
        if (g == 0) pool_block<1>(w, t0, Ts, outp); else if (g == 1) pool_block<2>(w, t0, Ts, outp); else if (g == 2) pool_block<4>(w, t0, Ts, outp); else pool_block<8>(w, t0, Ts, outp);
    }
}
__device__ __forceinline__ void ph_final(const Frame& F, const Ptrs& P, const int r_lo, const int RLh) {
    const int lane = fresh_lane(); const int stride = F.G * NWAVES;
    for (int rb = r_lo + F.vcu * NWAVES + F.wave; rb < RLh; rb += 4 * stride) {
        f32x4 v[4][4]; float ss[4];
#pragma unroll
        for (int q = 0; q < 4; ++q) { const int r = rb + q * stride < RLh ? rb + q * stride : rb; const int bb = row_bb(r);
            const bf16_t* xr = x1b_row(P, r) + 4 * lane; const f32x4* g2 = (const f32x4*)mod_vec(P, 1, bb, 5) + lane;
            const u32x2* m0 = (const u32x2*)((const bf16_t*)(P.ws + WS_MO) + (size_t)r * D) + lane; const u32x2* m1 = (const u32x2*)((const bf16_t*)(P.ws + WS_MO) + (size_t)(R + r) * D) + lane;
            ss[q] = 0.f;
#pragma unroll
            for (int j = 0; j < 4; ++j) { v[q][j] = ld4b(xr + 256 * j); const u32x2 a = m0[64 * j], b = m1[64 * j]; const f32x4 g = g2[64 * j];
                v[q][j].x += g.x * (lo16(a.x) + lo16(b.x)); v[q][j].y += g.y * (hi16(a.x) + hi16(b.x)); v[q][j].z += g.z * (lo16(a.y) + lo16(b.y)); v[q][j].w += g.w * (hi16(a.y) + hi16(b.y));
                ss[q] += (v[q][j].x * v[q][j].x + v[q][j].y * v[q][j].y) + (v[q][j].z * v[q][j].z + v[q][j].w * v[q][j].w); } }
#pragma unroll
        for (int o = 1; o < 64; o <<= 1) {
#pragma unroll
            for (int q = 0; q < 4; ++q) ss[q] += shfl_xor_l(ss[q], o, lane); }
        const f32x4* gn = (const f32x4*)P.norm_f + lane;
#pragma unroll
        for (int q = 0; q < 4; ++q) { const int r = rb + q * stride; if (r >= RLh) continue;
            const float rstd = 1.0f / sqrtf(ss[q] * (1.0f / D) + EPS); f32x4* xr = (f32x4*)(P.out + (size_t)r * D) + lane;
#pragma unroll
            for (int j = 0; j < 4; ++j) xr[64 * j] = v[q][j] * rstd * gn[64 * j]; }
    }
}

typedef float f32x16 __attribute__((ext_vector_type(16)));
typedef short v4i16_t __attribute__((ext_vector_type(4)));
constexpr float ATT_THR = 4.0f;
constexpr int AT_ROWB = 144, AT_TILEB = 64 * AT_ROWB;
constexpr int AT_VROWB = 192, AT_VTILEB = 64 * AT_VROWB;
constexpr int AT_STAGEB = 2 * AT_TILEB + 2 * AT_VTILEB;
#define AT_SB() __builtin_amdgcn_sched_barrier(0)
template <bool FIXED> __device__ __forceinline__ void at_qk1(const LAS unsigned char* Kt, int kf_off, const bf16x8 (&qr)[4], const f32x16& negm_, f32x16& p0, f32x16& p1) {
    f32x16 zc;
#pragma unroll
    for (int r = 0; r < 16; ++r) zc[r] = 0.f;
    const f32x16& negm = FIXED ? zc : negm_;
    bf16x8 ka[8];
#pragma unroll
    for (int d0 = 0; d0 < 4; ++d0) { ka[2 * d0] = *(const LAS bf16x8*)(Kt + kf_off + d0 * 32); ka[2 * d0 + 1] = *(const LAS bf16x8*)(Kt + kf_off + 32 * AT_ROWB + d0 * 32); }
    p0 = __builtin_amdgcn_mfma_f32_32x32x16_bf16(ka[0], qr[0], negm, 0, 0, 0); p1 = __builtin_amdgcn_mfma_f32_32x32x16_bf16(ka[1], qr[0], negm, 0, 0, 0);
#pragma unroll
    for (int d0 = 1; d0 < 4; ++d0) { p0 = __builtin_amdgcn_mfma_f32_32x32x16_bf16(ka[2 * d0], qr[d0], p0, 0, 0, 0); p1 = __builtin_amdgcn_mfma_f32_32x32x16_bf16(ka[2 * d0 + 1], qr[d0], p1, 0, 0, 0); }
}
__device__ __forceinline__ void at_vread(const LAS unsigned char* vp, v4i16_t (&f)[4]) {
    f[0] = __builtin_amdgcn_ds_read_tr16_b64_v4i16((LAS v4i16_t*)(vp)); f[1] = __builtin_amdgcn_ds_read_tr16_b64_v4i16((LAS v4i16_t*)(vp + 8 * AT_VROWB));
    f[2] = __builtin_amdgcn_ds_read_tr16_b64_v4i16((LAS v4i16_t*)(vp + 64)); f[3] = __builtin_amdgcn_ds_read_tr16_b64_v4i16((LAS v4i16_t*)(vp + 8 * AT_VROWB + 64));
}
__device__ __forceinline__ bf16x8 at_ppack(const f32x16& p, int sx) { u32x4 pw; pw.x = cvtpk(p[8 * sx], p[8 * sx + 1]); pw.y = cvtpk(p[8 * sx + 2], p[8 * sx + 3]); pw.z = cvtpk(p[8 * sx + 4], p[8 * sx + 5]); pw.w = cvtpk(p[8 * sx + 6], p[8 * sx + 7]); return __builtin_bit_cast(bf16x8, pw); }
__device__ __forceinline__ void at_pvmm(const v4i16_t (&f)[4], const bf16x8 pf, f32x16& o0, f32x16& o1) {
    const bf16x8 v0 = (bf16x8){f[0][0], f[0][1], f[0][2], f[0][3], f[1][0], f[1][1], f[1][2], f[1][3]}, v1 = (bf16x8){f[2][0], f[2][1], f[2][2], f[2][3], f[3][0], f[3][1], f[3][2], f[3][3]};
    o0 = __builtin_amdgcn_mfma_f32_32x32x16_bf16(v0, pf, o0, 0, 0, 0); o1 = __builtin_amdgcn_mfma_f32_32x32x16_bf16(v1, pf, o1, 0, 0, 0);
}
__device__ __forceinline__ float at_exp8(f32x16& p, int sx) { float rs = 0.f;
#pragma unroll
    for (int j = 0; j < 8; ++j) { p[8 * sx + j] = __builtin_amdgcn_exp2f(p[8 * sx + j]); rs += p[8 * sx + j]; }
    return rs; }
template <bool FIXED> __device__ __forceinline__ float at_slot(const LAS unsigned char* Vt, const LAS unsigned char* Kn, const bool hasnext, int kf_off, int vf_off, const bf16x8 (&qr)[4], const f32x16& negm_,
                                         f32x16& pc0, f32x16& pc1, f32x16& pn0, f32x16& pn1, f32x16& o0, f32x16& o1) {
    f32x16 zc;
#pragma unroll
    for (int r = 0; r < 16; ++r) zc[r] = 0.f;
    const f32x16& negm = FIXED ? zc : negm_;
    v4i16_t fA[4], fB[4]; bf16x8 ka0, ka1, kb0, kb1; float rs;
#define AT_KLD(A0, A1, d0) do { A0 = *(const LAS bf16x8*)(Kn + kf_off + (d0) * 32); A1 = *(const LAS bf16x8*)(Kn + kf_off + 32 * AT_ROWB + (d0) * 32); } while (0)
    if (FIXED) AT_KLD(ka0, ka1, 0);
    at_vread(Vt + vf_off, fA); rs = at_exp8(pc0, 0); AT_SB();
    at_vread(Vt + vf_off + 16 * AT_VROWB, fB); if (FIXED) AT_KLD(kb0, kb1, 1); else AT_KLD(ka0, ka1, 0);
    if (hasnext) { pn0 = __builtin_amdgcn_mfma_f32_32x32x16_bf16(ka0, qr[0], negm, 0, 0, 0); pn1 = __builtin_amdgcn_mfma_f32_32x32x16_bf16(ka1, qr[0], negm, 0, 0, 0); }
    at_pvmm(fA, at_ppack(pc0, 0), o0, o1); rs += at_exp8(pc0, 1); AT_SB();
    at_vread(Vt + vf_off + 32 * AT_VROWB, fA); if (FIXED) AT_KLD(ka0, ka1, 2); else AT_KLD(kb0, kb1, 1);
    if (hasnext) { pn0 = __builtin_amdgcn_mfma_f32_32x32x16_bf16(kb0, qr[1], pn0, 0, 0, 0); pn1 = __builtin_amdgcn_mfma_f32_32x32x16_bf16(kb1, qr[1], pn1, 0, 0, 0); }
    at_pvmm(fB, at_ppack(pc0, 1), o0, o1); rs += at_exp8(pc1, 0); AT_SB();
    at_vread(Vt + vf_off + 48 * AT_VROWB, fB); if (FIXED) AT_KLD(kb0, kb1, 3); else AT_KLD(ka0, ka1, 2);
    if (hasnext) { pn0 = __builtin_amdgcn_mfma_f32_32x32x16_bf16(ka0, qr[2], pn0, 0, 0, 0); pn1 = __builtin_amdgcn_mfma_f32_32x32x16_bf16(ka1, qr[2], pn1, 0, 0, 0); }
    at_pvmm(fA, at_ppack(pc1, 0), o0, o1); rs += at_exp8(pc1, 1); AT_SB();
    if (!FIXED) AT_KLD(kb0, kb1, 3);
    if (hasnext) { pn0 = __builtin_amdgcn_mfma_f32_32x32x16_bf16(kb0, qr[3], pn0, 0, 0, 0); pn1 = __builtin_amdgcn_mfma_f32_32x32x16_bf16(kb1, qr[3], pn1, 0, 0, 0); }
    at_pvmm(fB, at_ppack(pc1, 1), o0, o1);
#undef AT_KLD
    return rs;
}
template <int MODE, bool FIXED> __device__ __forceinline__ void ph_attn_impl(const Frame& F, const Ptrs& P, int l) {
    const bool latq = MODE < 2; const bool winm = (MODE == 1 || MODE == 3);
    const int NU = latq ? 1024 : 64;
    LAS unsigned char* Lb = F.lds;
    constexpr bool fixedref = FIXED;
    for (int u = F.vcu; u < NU; u += F.G) {
        const int lane = fresh_lane(), tid = F.wave * 64 + lane, r32 = lane & 31, hi = lane >> 5;
        const bf16_t* U = (const bf16_t*)(P.ws + WS_U);
        const int st_off = (tid >> 3) * AT_ROWB + (tid & 7) * 16;
        const int kf_off = r32 * AT_ROWB + hi * 16;
        const int sv_off = (tid >> 3) * AT_VROWB + (tid & 7) * 16;
        const int vf_off = (4 * hi + ((lane & 15) >> 2)) * AT_VROWB + (((lane >> 4) & 1) * 16 + (lane & 3) * 4) * 2;
        const int qb = latq ? (u & 63) : (u & 3), g = latq ? ((u >> 6) & 1) : ((u >> 2) & 1), b = latq ? (u >> 7) : (u >> 3);
        const int tq0 = qb * 64, hq = 4 * g + (F.wave >> 1), tq = tq0 + 32 * (F.wave & 1) + r32;
        const int qrow = latq ? b * T + tq : RL + b * TC + tq;
        const int qcol = (winm ? C_QW : C_QB) + hq * 64, kcol = (winm ? C_KW : C_KB) + g * 64, vcol = (winm ? C_VW : C_VB) + g * 64;
        int lt_lo = 0, lt_hi = 0;
        if (MODE == 0) { lt_lo = 0; lt_hi = T / 64; }
        if (MODE == 1) { lt_lo = (tq0 - 128 < 0 ? 0 : tq0 - 128) / 64; lt_hi = (tq0 + 192 > T ? T : tq0 + 192) / 64; }
        const int ntiles = 4 + (lt_hi - lt_lo), npairs = (ntiles + 1) >> 1;
        bf16x8 qr[4];
        {
            float x[4][8];
#pragma unroll
            for (int d0 = 0; d0 < 4; ++d0) { const u32x4 wq = *(const u32x4*)(U + (size_t)qrow * NIN + qcol + d0 * 16 + hi * 8);
                x[d0][0] = lo16(wq.x); x[d0][1] = hi16(wq.x); x[d0][2] = lo16(wq.y); x[d0][3] = hi16(wq.y); x[d0][4] = lo16(wq.z); x[d0][5] = hi16(wq.z); x[d0][6] = lo16(wq.w); x[d0][7] = hi16(wq.w); }
            if (!winm) { float ss = 0.f;
#pragma unroll
                for (int d0 = 0; d0 < 4; ++d0)
#pragma unroll
                    for (int j = 0; j < 8; ++j) ss += x[d0][j] * x[d0][j];
                ss += shfl_xor_l(ss, 32, lane);
                const float rstd = 1.0f / sqrtf(ss * (1.0f / 64.0f) + EPS);
#pragma unroll
                for (int d0 = 0; d0 < 4; ++d0) { const f32x4 ga = *(const f32x4*)(P.q_gain + l * 64 + d0 * 16 + hi * 8), gb = *(const f32x4*)(P.q_gain + l * 64 + d0 * 16 + hi * 8 + 4);
                    x[d0][0] *= rstd * ga.x; x[d0][1] *= rstd * ga.y; x[d0][2] *= rstd * ga.z; x[d0][3] *= rstd * ga.w; x[d0][4] *= rstd * gb.x; x[d0][5] *= rstd * gb.y; x[d0][6] *= rstd * gb.z; x[d0][7] *= rstd * gb.w; } }
            if (latq) { const float* rc = (const float*)(P.ws + WS_ROPE); const float* rs = rc + 1024;
#pragma unroll
                for (int a = 0; a < 2; ++a) { const int pos = a ? (tq & 63) : (tq >> 6);
                    const f32x4 c0 = *(const f32x4*)(rc + pos * 16 + hi * 8), c1 = *(const f32x4*)(rc + pos * 16 + hi * 8 + 4), s0 = *(const f32x4*)(rs + pos * 16 + hi * 8), s1 = *(const f32x4*)(rs + pos * 16 + hi * 8 + 4);
                    const float cs[8] = {c0.x, c0.y, c0.z, c0.w, c1.x, c1.y, c1.z, c1.w}, sn[8] = {s0.x, s0.y, s0.z, s0.w, s1.x, s1.y, s1.z, s1.w};
#pragma unroll
                    for (int j = 0; j < 8; ++j) { const float x1 = x[2 * a][j], x2 = x[2 * a + 1][j]; x[2 * a][j] = x1 * cs[j] - x2 * sn[j]; x[2 * a + 1][j] = x2 * cs[j] + x1 * sn[j]; } } }
#pragma unroll
            for (int d0 = 0; d0 < 4; ++d0) { u32x4 wq; wq.x = cvtpk(x[d0][0] * QSCALE, x[d0][1] * QSCALE); wq.y = cvtpk(x[d0][2] * QSCALE, x[d0][3] * QSCALE); wq.z = cvtpk(x[d0][4] * QSCALE, x[d0][5] * QSCALE); wq.w = cvtpk(x[d0][6] * QSCALE, x[d0][7] * QSCALE);
                qr[d0] = __builtin_bit_cast(bf16x8, wq); }
        }
        f32x16 o0, o1, negm;
#pragma unroll
        for (int r = 0; r < 16; ++r) { o0[r] = 0.f; o1[r] = 0.f; negm[r] = 0.f; }
        float mhat = 0.f, lsum = 0.f;
#define AT_KROW(ti) ((ti) < 4 ? RL + b * TC + (ti) * 64 : b * T + (lt_lo + (ti) - 4) * 64)
        u32x4 ka, va, kb2, vb2;
#define AT_LOADPAIR(pp) do { const int na_ = 2 * (pp), nb_ = (2 * (pp) + 1 < ntiles) ? 2 * (pp) + 1 : na_; \
            const int r0_ = AT_KROW(na_) + (tid >> 3), r1_ = AT_KROW(nb_) + (tid >> 3); const int co_ = (tid & 7) * 8; \
            ka = *(const u32x4*)(U + (size_t)r0_ * NIN + kcol + co_); va = *(const u32x4*)(U + (size_t)r0_ * NIN + vcol + co_); \
            kb2 = *(const u32x4*)(U + (size_t)r1_ * NIN + kcol + co_); vb2 = *(const u32x4*)(U + (size_t)r1_ * NIN + vcol + co_); } while (0)
#define AT_WRITEPAIR(off) do { *(LAS u32x4*)(Lb + (off) + st_off) = ka; *(LAS u32x4*)(Lb + (off) + AT_TILEB + st_off) = kb2; \
            *(LAS u32x4*)(Lb + (off) + 2 * AT_TILEB + sv_off) = va; *(LAS u32x4*)(Lb + (off) + 2 * AT_TILEB + AT_VTILEB + sv_off) = vb2; } while (0)
#define AT_MASK(ti, P0, P1) do { if (MODE == 1) { float ninf_ = -INFINITY; asm volatile("" : "+v"(ninf_));     \
            if ((ti) >= ntiles) { _Pragma("unroll") for (int r = 0; r < 16; ++r) { P0[r] = ninf_; P1[r] = ninf_; } } \
            else if ((ti) >= 4) { const int kb0_ = (lt_lo + (ti) - 4) * 64, qlo_ = tq0 + 32 * (F.wave & 1); \
                if (kb0_ + 63 - qlo_ > 128 || qlo_ + 31 - kb0_ > 128) { const int kp0_ = kb0_ + 4 * hi - tq; \
                    _Pragma("unroll") for (int r = 0; r < 16; ++r) { const int dl_ = kp0_ + (r & 3) + 8 * (r >> 2); \
                        if (dl_ > 128 || dl_ < -128) P0[r] = ninf_; if (dl_ + 32 > 128 || dl_ + 32 < -128) P1[r] = ninf_; } } } } } while (0)
#define AT_REF(first, P0, P1) do { if (!fixedref) { float mx_ = fmaxf(P0[0], P1[0]); \
            _Pragma("unroll") for (int r = 1; r < 16; ++r) mx_ = fmaxf(mx_, fmaxf(P0[r], P1[r])); \
            mx_ = fmaxf(mx_, shfl_xor_l(mx_, 32, lane)); \
            if ((first) || __any(mx_ > ATT_THR)) { const float dl_ = (first) ? mx_ : fmaxf(mx_, 0.f); mhat += dl_; \
                const float al_ = __builtin_amdgcn_exp2f(-dl_); lsum *= al_; \
                _Pragma("unroll") for (int r = 0; r < 16; ++r) { P0[r] -= dl_; P1[r] -= dl_; o0[r] *= al_; o1[r] *= al_; negm[r] = -mhat; } } } } while (0)
        AT_LOADPAIR(0); AT_WRITEPAIR(0);
        if (npairs > 1) { AT_LOADPAIR(1); AT_WRITEPAIR(AT_STAGEB); }
        if (npairs > 2) AT_LOADPAIR(2);
        __syncthreads();
        f32x16 pc0, pc1, pn0, pn1;
        at_qk1<FIXED>(Lb, kf_off, qr, negm, pc0, pc1);
        AT_REF(true, pc0, pc1);
#pragma unroll
        for (int r = 0; r < 16; ++r) { pn0[r] = 0.f; pn1[r] = 0.f; }
        int scur = 0, snxt = AT_STAGEB, swr = 2 * AT_STAGEB;
        for (int tp = 0; tp < npairs; ++tp) {
            if (tp + 2 < npairs) { AT_WRITEPAIR(swr); if (tp + 3 < npairs) AT_LOADPAIR(tp + 3); }
            lsum += at_slot<FIXED>(Lb + scur + 2 * AT_TILEB, Lb + scur + AT_TILEB, true, kf_off, vf_off, qr, negm, pc0, pc1, pn0, pn1, o0, o1);
            AT_MASK(2 * tp + 1, pn0, pn1);
            AT_REF(false, pn0, pn1);
            const bool more = tp + 1 < npairs;
            lsum += at_slot<FIXED>(Lb + scur + 2 * AT_TILEB + AT_VTILEB, Lb + snxt, more, kf_off, vf_off, qr, negm, pn0, pn1, pc0, pc1, o0, o1);
            if (more) { AT_MASK(2 * tp + 2, pc0, pc1); AT_REF(false, pc0, pc1); }
            __syncthreads();
            { const int t_ = scur; scur = snxt; snxt = swr; swr = t_; }
        }
#undef AT_KROW
#undef AT_LOADPAIR
#undef AT_WRITEPAIR
#undef AT_MASK
#undef AT_REF
        lsum += shfl_xor_l(lsum, 32, lane);
        if (winm) lsum += __builtin_amdgcn_exp2f(P.sink[l * 8 + hq] * LOG2E - mhat);
        const float inv = 1.0f / lsum;
        bf16_t* op = (bf16_t*)(P.ws + WS_BR) + (size_t)qrow * NBR + (winm ? 1024 : 512) + hq * 64 + 4 * hi;
#pragma unroll
        for (int gq = 0; gq < 4; ++gq) {
            u32x2 w0, w1; w0.x = cvtpk(o0[4 * gq] * inv, o0[4 * gq + 1] * inv); w0.y = cvtpk(o0[4 * gq + 2] * inv, o0[4 * gq + 3] * inv);
            w1.x = cvtpk(o1[4 * gq] * inv, o1[4 * gq + 1] * inv); w1.y = cvtpk(o1[4 * gq + 2] * inv, o1[4 * gq + 3] * inv);
            *(u32x2*)(op + 8 * gq) = w0; *(u32x2*)(op + 32 + 8 * gq) = w1; }
    }
}

template <int MODE> __device__ __forceinline__ void ph_attn(const Frame& F, const Ptrs& P, int l) {
    if (MODE == 3) { ph_attn_impl<MODE, false>(F, P, l); return; }
    const int lane = fresh_lane();
    if (MODE == 1) {
        const unsigned* qk = (const unsigned*)(P.ws + WS_CTL) + CW_QK + 64 * l;
        const float q2 = fmaxf(__uint_as_float(qk[0]), __uint_as_float(qk[16])), k2 = fmaxf(__uint_as_float(qk[32]), __uint_as_float(qk[48]));
        const float b2 = (QSCALE * 1.02f) * (QSCALE * 1.02f) * q2 * k2;
        if (__builtin_amdgcn_readfirstlane(b2 < 48.0f * 48.0f ? 1 : 0)) ph_attn_impl<MODE, true>(F, P, l); else ph_attn_impl<MODE, false>(F, P, l);
        return; }
    float mq = fabsf(P.q_gain[l * 64 + lane]), mk = fabsf(P.k_gain[l * 64 + lane]);
#pragma unroll
    for (int o = 1; o < 64; o <<= 1) { mq = fmaxf(mq, shfl_xor_l(mq, o, lane)); mk = fmaxf(mk, shfl_xor_l(mk, o, lane)); }
    const float sbound = 64.0f * QSCALE * 1.02f * mq * mk;
    if (__builtin_amdgcn_readfirstlane(sbound < 48.0f ? 1 : 0)) ph_attn_impl<MODE, true>(F, P, l); else ph_attn_impl<MODE, false>(F, P, l);
}

__device__ __forceinline__ void ph_ctx_r4(const Frame& F, const Ptrs& P) {
    const int tid0 = fresh_tid(); const float* ct = (const float*)(P.ws + WS_COS);
    for (int it = F.vcu * 512 + tid0; it < 8 * 64 * 64; it += F.G * 512) {
        const int c8 = (it & 63) * 8, t2 = (it >> 6) & 63, b = it >> 12;
        bf16_t* base = (bf16_t*)(P.ws + WS_U) + (size_t)(RL + b * TC + t2) * NIN + c8;
        u32x4 zr[4], zi[4];
#pragma unroll
        for (int t1 = 0; t1 < 4; ++t1) { zr[t1] = *(const u32x4*)(base + (size_t)(64 * t1) * NIN + C_ZR); zi[t1] = *(const u32x4*)(base + (size_t)(64 * t1) * NIN + C_ZI); }
        float tc[4], ts[4];
#pragma unroll
        for (int k1 = 0; k1 < 4; ++k1) { const int ang = (t2 * k1 * 16) & 4095; tc[k1] = ct[ang]; ts[k1] = ct[(ang - 1024) & 4095]; }
        u32x4 orr[4], oi[4];
#pragma unroll
        for (int w = 0; w < 4; ++w) {
            float xr[4][2], xi[4][2];
#pragma unroll
            for (int t1 = 0; t1 < 4; ++t1) { xr[t1][0] = lo16(zr[t1][w]); xr[t1][1] = hi16(zr[t1][w]); xi[t1][0] = lo16(zi[t1][w]); xi[t1][1] = hi16(zi[t1][w]); }
            float yr[4][2], yi[4][2];
#pragma unroll
            for (int e = 0; e < 2; ++e) {
                const float sr = xr[0][e] + xr[2][e], dr = xr[0][e] - xr[2][e], si = xi[0][e] + xi[2][e], di = xi[0][e] - xi[2][e];
                const float pr = xr[1][e] + xr[3][e], qr = xr[1][e] - xr[3][e], pi = xi[1][e] + xi[3][e], qi = xi[1][e] - xi[3][e];
                float ar[4], ai[4];
                ar[0] = sr + pr; ai[0] = si + pi;
                ar[1] = dr + qi; ai[1] = di - qr;
                ar[2] = sr - pr; ai[2] = si - pi;
                ar[3] = dr - qi; ai[3] = di + qr;
#pragma unroll
                for (int k1 = 0; k1 < 4; ++k1) { yr[k1][e] = ar[k1] * tc[k1] + ai[k1] * ts[k1]; yi[k1][e] = ai[k1] * tc[k1] - ar[k1] * ts[k1]; }
            }
#pragma unroll
            for (int k1 = 0; k1 < 4; ++k1) { orr[k1][w] = cvtpk(yr[k1][0], yr[k1][1]); oi[k1][w] = cvtpk(yi[k1][0], yi[k1][1]); }
        }
#pragma unroll
        for (int k1 = 0; k1 < 4; ++k1) { *(u32x4*)(base + (size_t)(64 * k1) * NIN + C_ZR) = orr[k1]; *(u32x4*)(base + (size_t)(64 * k1) * NIN + C_ZI) = oi[k1]; }
    }
}
constexpr int DF_ROWB = 528, DF_WROWB = 272;
template <int STAGE, bool CTX = false> __device__ __forceinline__ void ph_dft(const Frame& F, const Ptrs& P) {
    constexpr int NUN = CTX ? 64 : 1024;
    const int lane = fresh_lane(), tid = F.wave * 64 + lane, r32 = lane & 31, hi = lane >> 5, w = F.wave;
    bf16_t* U = (bf16_t*)(P.ws + WS_U); bf16_t* BR = (bf16_t*)(P.ws + WS_BR); const bf16_t* Wm = (const bf16_t*)(P.ws + WS_DFTM);
    LAS unsigned char* Xl = F.lds;
    LAS unsigned char* Wl = F.lds + 128 * DF_ROWB;
#pragma unroll
    for (int i = 0; i < 4; ++i) { const int idx = tid + 512 * i; *(LAS u32x4*)(Wl + (idx >> 4) * DF_WROWB + (idx & 15) * 16) = *(const u32x4*)(Wm + (idx >> 4) * 128 + (idx & 15) * 8); }
    const int xf_off = (8 * hi + ((lane & 15) >> 2)) * DF_ROWB + (32 * w + ((lane >> 4) & 1) * 16 + (lane & 3) * 4) * 2;
    constexpr int NMB = STAGE == 2 ? 4 : 2;
    const int seg = tid >> 2, part = tid & 3, pp = seg >> 6, jj = seg & 63;
    u32x4 pf[8];
    if (F.vcu < NUN) { const int u = F.vcu; const int chb = u & 1, sidx = CTX ? (u >> 1) & 3 : (u >> 1) & 63, b = CTX ? u >> 3 : u >> 7;
        const int grow = CTX ? RL + b * TC + 64 * sidx + jj : (STAGE == 2 ? b * T + 64 * jj + sidx : b * T + 64 * sidx + jj);
        const u32x4* src = (const u32x4*)(U + (size_t)grow * NIN + pp * 512 + chb * 256 + part * 64);
#pragma unroll
        for (int i = 0; i < 8; ++i) pf[i] = src[i]; }
    for (int u = F.vcu; u < NUN; u += F.G) {
        const int chb = u & 1, sidx = CTX ? (u >> 1) & 3 : (u >> 1) & 63, b = CTX ? u >> 3 : u >> 7;
#pragma unroll
        for (int i = 0; i < 8; ++i) *(LAS u32x4*)(Xl + seg * DF_ROWB + part * 128 + i * 16) = pf[i];
        if (u + F.G < NUN) { const int un = u + F.G; const int chbn = un & 1, sn = CTX ? (un >> 1) & 3 : (un >> 1) & 63, bn = CTX ? un >> 3 : un >> 7;
            const int grow = CTX ? RL + bn * TC + 64 * sn + jj : (STAGE == 2 ? bn * T + 64 * jj + sn : bn * T + 64 * sn + jj);
            const u32x4* src = (const u32x4*)(U + (size_t)grow * NIN + pp * 512 + chbn * 256 + part * 64);
#pragma unroll
            for (int i = 0; i < 8; ++i) pf[i] = src[i]; }
        __syncthreads();
        f32x16 acc[NMB];
#pragma unroll
        for (int mb = 0; mb < NMB; ++mb)
#pragma unroll
            for (int r = 0; r < 16; ++r) acc[mb][r] = 0.f;
#pragma unroll
        for (int ks = 0; ks < 8; ++ks) {
            const v4i16_t lo4 = __builtin_amdgcn_ds_read_tr16_b64_v4i16((LAS v4i16_t*)(Xl + xf_off + (16 * ks) * DF_ROWB));
            const v4i16_t hi4 = __builtin_amdgcn_ds_read_tr16_b64_v4i16((LAS v4i16_t*)(Xl + xf_off + (16 * ks + 4) * DF_ROWB));
            const bf16x8 xf = (bf16x8){lo4[0], lo4[1], lo4[2], lo4[3], hi4[0], hi4[1], hi4[2], hi4[3]};
#pragma unroll
            for (int mb = 0; mb < NMB; ++mb) { const bf16x8 wf = *(const LAS bf16x8*)(Wl + (mb * 32 + r32) * DF_WROWB + (16 * ks + 8 * hi) * 2);
                acc[mb] = __builtin_amdgcn_mfma_f32_32x32x16_bf16(xf, wf, acc[mb], 0, 0, 0); }
        }
        LAS unsigned char* ob = Xl + (32 * w + 4 * hi) * 2;
        if (STAGE == 2) {
#pragma unroll
            for (int mb = 0; mb < 2; ++mb) { const int k1 = mb * 32 + r32; const float rev = (float)((k1 * sidx) & 4095) * (1.0f / 4096.0f);
                const float ct = __builtin_amdgcn_cosf(rev), st = __builtin_amdgcn_sinf(rev);
#pragma unroll
                for (int gq = 0; gq < 4; ++gq) { u32x2 wr, wi; float yr[4], yi[4];
#pragma unroll
                    for (int i = 0; i < 4; ++i) { const float a = acc[mb][4 * gq + i], bq = acc[mb + 2][4 * gq + i]; yr[i] = a * ct + bq * st; yi[i] = bq * ct - a * st; }
                    wr.x = cvtpk(yr[0], yr[1]); wr.y = cvtpk(yr[2], yr[3]); wi.x = cvtpk(yi[0], yi[1]); wi.y = cvtpk(yi[2], yi[3]);
                    *(LAS u32x2*)(ob + k1 * DF_ROWB + 16 * gq) = wr; *(LAS u32x2*)(ob + (64 + k1) * DF_ROWB + 16 * gq) = wi; } }
        } else {
#pragma unroll
            for (int mb = 0; mb < 2; ++mb) { const int k2 = mb * 32 + r32;
#pragma unroll
                for (int gq = 0; gq < 4; ++gq) { constexpr float osc = CTX ? 0.0625f : 0.015625f; u32x2 wr; wr.x = cvtpk(acc[mb][4 * gq] * osc, acc[mb][4 * gq + 1] * osc); wr.y = cvtpk(acc[mb][4 * gq + 2] * osc, acc[mb][4 * gq + 3] * osc);
                    *(LAS u32x2*)(ob + k2 * DF_ROWB + 16 * gq) = wr; } }
        }
        __syncthreads();
        if (STAGE == 2) {
            u32x4* dst = (u32x4*)(U + (size_t)(b * T + 64 * jj + sidx) * NIN + pp * 512 + chb * 256 + part * 64);
#pragma unroll
            for (int i = 0; i < 8; ++i) dst[i] = *(const LAS u32x4*)(Xl + seg * DF_ROWB + part * 128 + i * 16);
        } else { const int k2 = tid >> 3, part8 = tid & 7;
            u32x4* dst = (u32x4*)(BR + (size_t)(CTX ? RL + b * TC + 4 * k2 + sidx : b * T + 64 * k2 + sidx) * NBR + chb * 256 + part8 * 32);
#pragma unroll
            for (int i = 0; i < 4; ++i) dst[i] = *(const LAS u32x4*)(Xl + k2 * DF_ROWB + part8 * 64 + i * 16); }
        __syncthreads();
    }
    if (CTX) __syncthreads();
}

struct MegaArgs { Ptrs P; int ph_lo, ph_hi, li, pad; };
__global__ void __launch_bounds__(NWAVES * 64, 2) mega(MegaArgs args) {
    extern __shared__ __attribute__((aligned(16))) unsigned char lds_raw[];
    Frame F; F.lds = (LAS unsigned char*)lds_raw;
    F.wave = __builtin_amdgcn_readfirstlane(threadIdx.x >> 6);
    F.G = gridDim.x; { const int bx = blockIdx.x; F.vcu = (F.G % 8 == 0) ? (bx % 8) * (F.G / 8) + bx / 8 : bx; }
    for (int u = fresh_tid(); u < (LDS_BYTES - LDSCTL_OFF) / 4; u += NWAVES * 64) ((LAS unsigned*)(F.lds + LDSCTL_OFF))[u] = 0u;
    __syncthreads();
    volatile LAS unsigned* MISC = (volatile LAS unsigned*)(F.lds + MISC_OFF);
    const Ptrs& P = args.P;
    XcdBarrier bar = xcd_barrier_post((unsigned*)(P.ws + WS_CTL) + CW_BAR + args.li * XCD_BAR_WORDS, MISC + 8, F.wave);
    const int lo = args.ph_lo, hi = args.ph_hi;
    unsigned char* ws = P.ws;
    bf16_t* H = (bf16_t*)(ws + WS_H); bf16_t* U = (bf16_t*)(ws + WS_U); bf16_t* BR = (bf16_t*)(ws + WS_BR);
    bf16_t* MG = (bf16_t*)(ws + WS_MG); bf16_t* HID = (bf16_t*)(ws + WS_HID); bf16_t* MO = (bf16_t*)(ws + WS_MO);
    const bf16_t* Bt_in = (const bf16_t*)(ws + WS_WB + WB_IN); const bf16_t* Bt_gate = (const bf16_t*)(ws + WS_WB + WB_GATE); const bf16_t* Bt_br = (const bf16_t*)(ws + WS_WB + WB_BR);
    const bf16_t* Bt_out = (const bf16_t*)(ws + WS_WB + WB_OUT); const bf16_t* Bt_13 = (const bf16_t*)(ws + WS_WB + WB_13); const bf16_t* Bt_2 = (const bf16_t*)(ws + WS_WB + WB_2);
#define IN(g) (lo <= (g) && (g) < hi)
#define SEAM(g) do { if ((g) + 1 < hi) xcd_barrier(bar); } while (0)
    for (int l = 0; l < 2; ++l) {
        const int pb = l * NPH; const int M = l == 0 ? R : RL;
        if (IN(pb + 0)) { if (l == 0) ph_tables_mod(F, P); ph_weights(F, P, l); SEAM(pb + 0); }
        if (IN(pb + 1)) { ph_quant(F, P, l); if (l == 0) ph_norm<0>(F, P, l, R); else ph_norm<1>(F, P, l, R); SEAM(pb + 1); }
        if (IN(pb + 2)) {
            pg8::StaticOrder S; S.init(R, NIN, F.G, (int)blockIdx.x, H, D / 2, Bt_in, D / 2);
            pg8::EpiV8I8<FStore8> E{FStore8{U, NIN}, (const float*)(ws + WS_SA), (const unsigned*)(ws + WS_CTL) + CW_CMAX + 32768 * l};
            pg8::gemm_phase<pg8::EpiV8I8<FStore8>, pg8::StaticOrder, true, true>(F.lds, F.wave, D / 2, D / 2, D / 2, S, E);
            SEAM(pb + 2);
        }
        if (IN(pb + 3)) { ph_kprep(F, P, l); ph_pool(F, P, M); SEAM(pb + 3); }
        if (IN(pb + 4)) {
            ph_dft<2>(F, P); ph_attn<1>(F, P, l);
            if (l == 0) { ph_attn<2>(F, P, l); ph_attn<3>(F, P, l); ph_ctx_r4(F, P); }
            xcd_barrier(bar);
            ph_dft<3>(F, P); if (l == 0) { Frame Fc = F; Fc.vcu = (F.vcu + 64) % F.G; ph_dft<3, true>(Fc, P); } ph_attn<0>(F, P, l);
            SEAM(pb + 4);
        }
        if (IN(pb + 5)) {
            pg8::StaticOrder S; S.init(M, 4096, F.G, (int)blockIdx.x, H, D / 2, Bt_gate, D / 2);
            pg8::EpiV8I8<FGateU8> E{FGateU8{(unsigned char*)(ws + WS_GT), P.b_gate + (size_t)l * 4096}, (const float*)(ws + WS_SA), (const unsigned*)(ws + WS_CTL) + CW_CMAX + 32768 * l + 3072};
            pg8::gemm_phase<pg8::EpiV8I8<FGateU8>, pg8::StaticOrder, true, true>(F.lds, F.wave, D / 2, D / 2, D / 2, S, E);
            SEAM(pb + 5);
        }
        if (IN(pb + 6)) {
            const int chain = (l == 0);
            pg8::PanelOrder S{(int)blockIdx.x, F.G, M / (8 * pg8::BM), 0, chain, (const char*)BR, (const char*)Bt_br, (size_t)pg8::BM * NBR * 2, (size_t)pg8::BM * NBR * 2, (unsigned*)(ws + WS_CTL) + CW_RDY + 4096 * l};
            pg8::EpiMergeS E{(const unsigned char*)(ws + WS_GT), MG, chain};
            pg8::gemm_phase(F.lds, F.wave, NBR, NBR, NBR, S, E);
            if (!chain) xcd_barrier(bar);
        }
        if (IN(pb + 10)) {
            pg8::PanelOrder S{(int)blockIdx.x, F.G, M / (8 * pg8::BM), 1, l == 0, (const char*)MG, (const char*)Bt_out, (size_t)pg8::BM * D * 2, (size_t)pg8::BM * D * 2, (unsigned*)(ws + WS_CTL) + CW_RDY + 4096 * l};
            pg8::EpiV4<FOut> E{FOut{P, l}};
            pg8::gemm_phase(F.lds, F.wave, D, D, D, S, E);
            SEAM(pb + 10);
        }
        if (IN(pb + 11)) { ph_norm2(F, P, l, M); xcd_barrier(bar); }
        if (IN(pb + 13) || IN(pb + 14)) {
            LAS int* ptab = (LAS int*)(F.lds + LDSCTL_OFF);
            if (fresh_tid() == 0) { const unsigned* cnt = (const unsigned*)(ws + WS_CTL) + CW_CNT + 1024 * l; int off = 0;
                for (int e = 0; e < 16; ++e) { const int c = (int)cnt[64 * e]; ptab[e] = off; ptab[17 + e] = c; off += (c + 255) >> 8; } ptab[16] = off; }
            __syncthreads();
            if (IN(pb + 13)) {
                pg8::MoeOrder<true> S; S.nN = 4; S.G = F.G; S.c = F.vcu; S.A = (const char*)H; S.Bt = (const char*)Bt_13; S.astep = 0; S.bstep = (size_t)256 * D; S.bexp = (size_t)1024 * 1024; S.tab = (const int*)ptab; S.tokl = (const int*)(ws + WS_TOKL); S.hand = 1; S.rev = 0; S.ready = (unsigned*)(ws + WS_CTL) + CW_MRDY + 8192 * l;
                pg8::EpiDualI8<FMoe1> E{FMoe1{HID}, (const float*)(ws + WS_SA), (const unsigned*)(ws + WS_CTL) + CW_CMAX + 32768 * l + 8192, (const int*)(ws + WS_TOKL)};
                pg8::gemm_phase<pg8::EpiDualI8<FMoe1>, pg8::MoeOrder<true>, true, true>(F.lds, F.wave, D / 2, D / 2, D / 2, S, E);
            }
            if (IN(pb + 14)) {
                pg8::MoeOrder<false> S; S.nN = 4; S.G = F.G; S.c = F.vcu; S.A = (const char*)HID; S.Bt = (const char*)Bt_2; S.astep = (size_t)256 * FF * 2; S.bstep = (size_t)256 * FF * 2; S.bexp = (size_t)1024 * 512 * 2; S.tab = (const int*)ptab; S.tokl = nullptr; S.hand = 2; S.rev = 1; S.ready = (unsigned*)(ws + WS_CTL) + CW_MRDY + 8192 * l;
                pg8::EpiV8<FMoe2> E{FMoe2{MO, (const int*)(ws + WS_TOKL), (const float*)(ws + WS_WL)}};
                pg8::gemm_phase(F.lds, F.wave, FF, FF, FF, S, E);
                SEAM(pb + 14);
            }
        }
    }
    if (IN(PH_FINAL)) { ph_final(F, P, 0, 24576); xcd_barrier(bar); ph_final(F, P, 24576, RL); }
#undef IN
#undef SEAM
}

extern "C" void kernel_launch(void* const* d_in, const int* in_sizes, int n_in, void* d_out, int out_size, void* d_ws, size_t ws_size, hipStream_t stream) {
    if (n_in != 24 || ws_size < WS_END || out_size != RL * D) { fprintf(stderr, "kernel_launch: unexpected sizes n_in %d ws %zu out %d\n", n_in, ws_size, out_size); return; }
    static int grid = 0;
    if (grid == 0) {
        int dev = 0, cus = 0;
        if (hipGetDevice(&dev) != hipSuccess || hipDeviceGetAttribute(&cus, hipDeviceAttributeMultiprocessorCount, dev) != hipSuccess) { grid = -1; return; }
        if (hipFuncSetAttribute((const void*)mega, hipFuncAttributeMaxDynamicSharedMemorySize, LDS_BYTES) != hipSuccess) { fprintf(stderr, "kernel_launch: hipFuncSetAttribute failed\n"); grid = -1; return; }
        int per_cu = 0;
        if (hipOccupancyMaxActiveBlocksPerMultiprocessor(&per_cu, (const void*)mega, NWAVES * 64, LDS_BYTES) != hipSuccess || per_cu < 1) fprintf(stderr, "kernel_launch: occupancy query says %d\n", per_cu);
        (void)hipGetLastError();
        grid = cus;
    }
    if (grid < 0) return;
    MegaArgs a{};
    const float** pp = (const float**)&a.P;
    for (int i = 0; i < 24; ++i) pp[i] = (const float*)d_in[i];
    a.P.out = (float*)d_out; a.P.ws = (unsigned char*)d_ws;
    (void)hipMemsetAsync((unsigned char*)d_ws + WS_CTL, 0, 512 * 1024, stream);
    a.ph_lo = 0; a.ph_hi = PH_FINAL + 1; a.li = 0;
    hipLaunchKernelGGL(mega, dim3(grid), dim3(NWAVES * 64), LDS_BYTES, stream, a);
}
```

```cpp
#include <hip/hip_runtime.h>
#include <cstdio>
#include <cstdint>

typedef unsigned short bf16_t;
typedef short bf16x8 __attribute__((ext_vector_type(8)));
typedef float f32x4 __attribute__((ext_vector_type(4)));
typedef unsigned u32x4 __attribute__((ext_vector_type(4)));
typedef unsigned u32x2 __attribute__((ext_vector_type(2)));
typedef int i32x4 __attribute__((ext_vector_type(4)));

constexpr int D = 1024, NB = 8, T = 4096, TC = 256;
constexpr int RL = NB * T, RC = NB * TC, R = RL + RC;
constexpr int NIN = 3072;
constexpr int C_ZR = 0, C_ZI = 512, C_P = 1024, C_QB = 1536, C_KB = 2048, C_VB = 2176, C_QW = 2304, C_KW = 2816, C_VW = 2944;
constexpr int NBR = 2048;
constexpr int NE = 16, FF = 512;
constexpr int MAXROWS = 73728;
constexpr float EPS = 1e-6f;
constexpr float QSCALE = 0.125f * 1.4426950408889634f;
constexpr float LOG2E = 1.4426950408889634f;

constexpr size_t MiB = 1u << 20;
constexpr size_t WS_CTL = 0;
constexpr size_t WS_MOD = 1 * MiB;
constexpr size_t WS_ROPE = 1 * MiB + 512 * 1024;
constexpr size_t WS_COS = WS_ROPE + 16 * 1024;
constexpr size_t WS_DFTM = WS_ROPE + 64 * 1024;
constexpr size_t WS_TOKL = 2 * MiB;
constexpr size_t WS_WL = 4 * MiB + 512 * 1024;
constexpr size_t WS_XC = 9 * MiB;
constexpr size_t WS_WB = 17 * MiB;
constexpr size_t WB_IN = 0, WB_GATE = 6 * MiB, WB_BR = 14 * MiB, WB_OUT = 18 * MiB, WB_13 = 20 * MiB, WB_2 = 52 * MiB;
constexpr size_t WS_H = 85 * MiB;
constexpr size_t WS_SA = WS_H + 34 * MiB;
constexpr size_t WS_X1B = WS_H + 35 * MiB;
constexpr size_t WS_ARENA = 153 * MiB;
constexpr size_t WS_U = WS_ARENA;
constexpr size_t WS_BR = WS_ARENA + 204 * MiB;
constexpr size_t WS_GT = WS_ARENA;
constexpr size_t WS_MG = WS_ARENA + 136 * MiB;
constexpr size_t WS_HID = WS_ARENA + 144 * MiB;
constexpr size_t WS_MO = WS_ARENA + 216 * MiB;
constexpr size_t WS_FTMP = WS_ARENA + 352 * MiB;
constexpr size_t WS_END = 512 * MiB;
static_assert(WS_BR + (size_t)R * NBR * 2 <= WS_END && WS_MO + (size_t)2 * R * D * 2 <= WS_END && WS_MG + (size_t)R * D * 2 <= WS_BR, "ws map");
constexpr int CW_CMAX = 32768;
constexpr int CW_RDY = 20480;
constexpr int CW_QK = 28672;
constexpr int CW_MRDY = 98304;
constexpr int CW_CNT = 8192;

__device__ __forceinline__ float bf2f(bf16_t b) { return __uint_as_float(((unsigned)b) << 16); }
__device__ __forceinline__ unsigned f2bf(float f) { unsigned u = __float_as_uint(f); return (u + 0x7fffu + ((u >> 16) & 1u)) >> 16; }
__device__ __forceinline__ unsigned pk2(float lo, float hi) { return f2bf(lo) | (f2bf(hi) << 16); }
typedef __bf16 bf16x2_t __attribute__((ext_vector_type(2)));
typedef float f32x2_t __attribute__((ext_vector_type(2)));
__device__ __forceinline__ unsigned cvtpk(float lo, float hi) { f32x2_t v = {lo, hi}; bf16x2_t b = __builtin_convertvector(v, bf16x2_t); return __builtin_bit_cast(unsigned, b); }
__device__ __forceinline__ float lo16(unsigned w) { return __uint_as_float(w << 16); }
__device__ __forceinline__ float hi16(unsigned w) { return __uint_as_float(w & 0xffff0000u); }
__device__ __forceinline__ float shfl_xor_l(float v, int o, int lane) { return __int_as_float(__builtin_amdgcn_ds_bpermute((lane ^ o) << 2, __float_as_int(v))); }
__device__ __forceinline__ float wave_sum_l(float v, int lane) {
#pragma unroll
    for (int o = 1; o < 64; o <<= 1) v += shfl_xor_l(v, o, lane);
    return v;
}
__device__ __forceinline__ int row_bb(int r) { return r < RL ? (r >> 12) : 8; }

struct Ptrs {
    const float *x, *c, *ctx, *c_ctx, *w_ada, *b_ada, *norm1, *norm2, *w_in, *q_gain, *k_gain, *sink, *pool_w, *pool_scale,
        *w_branch, *w_gate, *b_gate, *w_out, *router_w, *router_bias, *w1, *w3, *w2, *norm_f;
    float* out; unsigned char* ws;
};
__device__ __forceinline__ const float* xin_row(const Ptrs& P, int r) { return r < RL ? P.x + (size_t)r * D : P.ctx + (size_t)(r - RL) * D; }
__device__ __forceinline__ bf16_t* x1b_row(const Ptrs& P, int r) {
    return r < 16384 ? (bf16_t*)((unsigned char*)P.out + 96 * MiB) + (size_t)r * D : (r < RL ? (bf16_t*)(P.ws + WS_X1B) + (size_t)(r - 16384) * D : (bf16_t*)(P.ws + WS_XC) + (size_t)(r - RL) * D); }
__device__ __forceinline__ f32x4 ld4b(const bf16_t* p) { const u32x2 w = *(const u32x2*)p; return (f32x4){lo16(w.x), hi16(w.x), lo16(w.y), hi16(w.y)}; }
__device__ __forceinline__ void st4b(bf16_t* p, f32x4 v) { u32x2 w; w.x = cvtpk(v.x, v.y); w.y = cvtpk(v.z, v.w); *(u32x2*)p = w; }
__device__ __forceinline__ const float* mod_vec(const Ptrs& P, int l, int bb, int which) { return (const float*)(P.ws + WS_MOD) + ((size_t)(l * 9 + bb) * 6 + which) * D; }

#define LAS __attribute__((address_space(3)))
#define GAS __attribute__((address_space(1)))
#define LDS_WAIT() asm volatile("s_waitcnt lgkmcnt(0)" ::: "memory")
__device__ __forceinline__ int fresh_lane() { int l; asm volatile("v_mbcnt_lo_u32_b32 %0, -1, 0\n\tv_mbcnt_hi_u32_b32 %0, -1, %0" : "=v"(l)); return l; }
constexpr int NWAVES = 8;
constexpr int RING_BYTES = 131072, LDSCTL_OFF = RING_BYTES, MISC_OFF = LDSCTL_OFF + 320, LDS_BYTES = 147456;
constexpr int CW_BAR = 16384;
constexpr int NPH = 15, PH_FINAL = 2 * NPH;

#define XB_TMO      128
#define XB_XCNT(j)  (256  + 64 * (j))
#define XB_XSUB(j)  (1280 + 64 * (j))
#define XB_XGEN(j)  (2304 + 64 * (j))
#define XB_TOP      3328
#define XB_TOPGEN   3392
#define XCD_BAR_WORDS 3456
#define XB_SPIN_CAP (1u << 21)
__device__ __forceinline__ unsigned xb_ld(unsigned* p)              { return __hip_atomic_load(p, __ATOMIC_RELAXED, __HIP_MEMORY_SCOPE_AGENT); }
__device__ __forceinline__ unsigned xb_add(unsigned* p, unsigned v) { return __hip_atomic_fetch_add(p, v, __ATOMIC_RELAXED, __HIP_MEMORY_SCOPE_AGENT); }
__device__ __forceinline__ unsigned xb_xcc_id() { return (unsigned)__builtin_amdgcn_s_getreg((3 << 11) | 20) & 0xFu; }
#define XB_SPIN(cond, bar) do { unsigned _sp = 0; while (cond) { __builtin_amdgcn_s_sleep(1); \
    if ((++_sp & 255u) == 0u) { if (xb_ld(&(bar)[XB_TMO])) break; if (_sp > XB_SPIN_CAP) { atomicAdd(&(bar)[XB_TMO], 1u); break; } } } } while (0)
struct XcdBarrier { unsigned* bar; unsigned x; volatile LAS unsigned* st; int wave; };
__device__ __forceinline__ XcdBarrier xcd_barrier_post(unsigned* bar, volatile LAS unsigned* st, int wave) {
    XcdBarrier b; b.bar = bar; b.x = xb_xcc_id(); b.st = st; b.wave = wave;
    if (wave == 0 && fresh_lane() == 0) (void)xb_add(&bar[XB_XCNT(b.x)], 1u);
    return b;
}
__device__ __forceinline__ void xcd_barrier_complete(unsigned* bar, unsigned x, unsigned& nloc, unsigned& nx) {
    const unsigned G = gridDim.x * gridDim.y * gridDim.z;
    unsigned sum, cnt, mine, sp = 0u;
    for (;;) {
        sum = 0u; cnt = 0u; mine = 0u;
#pragma unroll
        for (unsigned j = 0; j < 16; ++j) { const unsigned c = xb_ld(&bar[XB_XCNT(j)]); sum += c; cnt += (c > 0u) ? 1u : 0u; mine = (j == x) ? c : mine; }
        if (sum == G) break;
        __builtin_amdgcn_s_sleep(1);
        if ((++sp & 255u) == 0u) { if (xb_ld(&bar[XB_TMO])) break; if (sp > XB_SPIN_CAP) { atomicAdd(&bar[XB_TMO], 1u); break; } }
    }
    nloc = mine > 0u ? mine : 1u; nx = cnt > 0u ? cnt : 1u;
}
__device__ __forceinline__ void xcd_barrier(const XcdBarrier& b) {
    asm volatile("s_waitcnt vmcnt(0)" ::: "memory");
    __syncthreads();
    if (b.wave == 0 && fresh_lane() == 0) {
        unsigned* bar = b.bar;
        __builtin_amdgcn_s_waitcnt(0);
        unsigned nloc = b.st[0], nx = b.st[1];
        if (nloc == 0u) { xcd_barrier_complete(bar, b.x, nloc, nx); b.st[0] = nloc; b.st[1] = nx; }
        const unsigned old = xb_add(&bar[XB_XSUB(b.x)], 1u);
        const unsigned gen = old / nloc;
        if (old + 1u == (gen + 1u) * nloc) {
            __builtin_amdgcn_fence(__ATOMIC_RELEASE, "agent");
            asm volatile("s_waitcnt vmcnt(0)" ::: "memory");
            const unsigned og = xb_add(&bar[XB_TOP], 1u);
            const unsigned tg = og / nx;
            if (og + 1u == (tg + 1u) * nx) xb_add(&bar[XB_TOPGEN], 1u);
            else XB_SPIN(xb_ld(&bar[XB_TOPGEN]) == tg, bar);
            __builtin_amdgcn_fence(__ATOMIC_ACQUIRE, "agent");
            xb_add(&bar[XB_XGEN(b.x)], 1u);
            asm volatile("s_waitcnt vmcnt(0)" ::: "memory");
        } else {
            XB_SPIN(xb_ld(&bar[XB_XGEN(b.x)]) == gen, bar);
            __builtin_amdgcn_fence(__ATOMIC_ACQUIRE, "agent");
            asm volatile("s_waitcnt vmcnt(0)" ::: "memory");
        }
    }
    __syncthreads();
}

namespace pg8 {
constexpr int BM = 256, BK = 64, HALF = 128, HTB = HALF * BK * 2, STAGE_BYTES = 8 * HTB, NXCD = 8, WGM = 4;
__host__ __device__ __forceinline__ int lds_byte(int r, int c) { const int st = (r >> 4) * 2 + (c >> 5), rr = r & 15, cc = c & 31, ob = rr * 64 + cc * 2; return st * 1024 + (ob ^ (((ob >> 9) & 1) << 5)); }
__host__ __device__ __forceinline__ void stage_rc(int b, int& Rr, int& C) { const int st = b / 1024, sb = b % 1024, swz = sb ^ (((sb >> 9) & 1) << 5); Rr = (st >> 1) * 16 + swz / 64; C = (st & 1) * 32 + (swz % 64) / 2; }
__host__ __device__ __forceinline__ int perm32(int rho) { const int n = rho >> 4, i = rho & 15; return 8 * (i >> 2) + 4 * n + (i & 3); }
struct Unit { int pm, pn; const char* a; const char* b; int e, p0, ce; };

struct StaticOrder {
    static constexpr bool GATHER = false;
    int nM, nN, nwg, G, c; const char* A; const char* Bt; size_t astep, bstep;
    __device__ void init(int M, int N, int G_, int c_, const bf16_t* A_, int lda, const bf16_t* Bt_, int ldb) { nM = M / BM; nN = N / BM; nwg = nM * nN; G = G_; c = c_; A = (const char*)A_; Bt = (const char*)Bt_; astep = (size_t)BM * lda * 2; bstep = (size_t)BM * ldb * 2; }
    __device__ bool next(int i, Unit& u) const {
        const long L = (long)i * G + c; if (L >= nwg) return false;
        int wgid = (int)L; { const int q = nwg / NXCD, r = nwg % NXCD, xcd = wgid % NXCD, off = wgid / NXCD; wgid = (xcd < r ? xcd * (q + 1) : r * (q + 1) + (xcd - r) * q) + off; }
        const int nig = WGM * nN, gid = wgid / nig, fm = gid * WGM, gsz = (nM - fm) < WGM ? (nM - fm) : WGM;
        u.pm = fm + ((wgid % nig) % gsz); u.pn = (wgid % nig) / gsz; u.a = A + (size_t)u.pm * astep; u.b = Bt + (size_t)u.pn * bstep; u.e = 0; u.p0 = 0; u.ce = 0; return true;
    }
    __device__ __forceinline__ void a_ready(const Unit&) const {}
    __device__ __forceinline__ void done(const Unit&) const {}
};
template <bool GATHER_> struct MoeOrder {
    static constexpr bool GATHER = GATHER_;
    int nN, G, c; const char* A; const char* Bt; size_t astep, bstep, bexp; const int* tab; const int* tokl;
    int hand, rev; unsigned* ready;
    __device__ bool next(int i, Unit& u) const {
        const int L = i * G + (rev ? G - 1 - c : c); const int total = __builtin_amdgcn_readfirstlane(tab[16]) * nN; if (L >= total) return false;
        u.pm = L / nN; u.pn = L % nN; int e = 0;
#pragma unroll
        for (int q = 1; q < 16; ++q) e += (u.pm >= tab[q]) ? 1 : 0;
        e = __builtin_amdgcn_readfirstlane(e);
        u.e = e; u.p0 = __builtin_amdgcn_readfirstlane((u.pm - tab[e]) * BM); u.ce = __builtin_amdgcn_readfirstlane(tab[17 + e]);
        u.a = GATHER_ ? A : A + (size_t)u.pm * astep; u.b = Bt + (size_t)e * bexp + (size_t)u.pn * bstep; return true;
    }
    __device__ __forceinline__ void a_ready(const Unit& u) const {
        if (hand != 2) return;
        if (__builtin_amdgcn_readfirstlane(threadIdx.x >> 6) == 0) {
            unsigned spins = 0;
            while ((unsigned)__builtin_amdgcn_readfirstlane(__hip_atomic_load(ready + 16 * u.pm, __ATOMIC_RELAXED, __HIP_MEMORY_SCOPE_AGENT)) < 32u) { __builtin_amdgcn_s_sleep(2); if (++spins > (1u << 22)) break; }
            __builtin_amdgcn_fence(__ATOMIC_ACQUIRE, "agent");
            asm volatile("s_waitcnt vmcnt(0)" ::: "memory");
        }
        asm volatile("" ::: "memory"); __builtin_amdgcn_s_barrier(); asm volatile("" ::: "memory");
    }
    __device__ __forceinline__ void done(const Unit& u) const {
        if (hand != 1) return;
        asm volatile("s_waitcnt vmcnt(0)" ::: "memory");
        if (fresh_lane() == 0) __hip_atomic_fetch_add(ready + 16 * u.pm, 1u, __ATOMIC_RELAXED, __HIP_MEMORY_SCOPE_AGENT);
    }
    __device__ __forceinline__ void aoffs(const Unit& u, int wid, int lda, unsigned (&off)[2][2]) const {
        const int tid = wid * 64 + fresh_lane();
#pragma unroll
        for (int i = 0; i < 2; ++i) { int Rr, C; stage_rc(tid * 16 + i * 8192, Rr, C);
#pragma unroll
            for (int h = 0; h < 2; ++h) { const int pos = u.p0 + h * HALF + Rr; const int tok = pos < u.ce ? (tokl[(size_t)u.e * R + pos] >> 1) : 0; off[h][i] = (unsigned)(tok * lda + C) * 2u; } }
    }
};

struct PanelOrder {
    static constexpr bool GATHER = false;
    int c, G, npx, consumer, chain; const char* A; const char* Bt; size_t astep, bstep; unsigned* ready;
    __device__ bool next(int i, Unit& u) const {
        if (G == 256) { const int xcd = c & 7, r = c >> 3, ne = 4 * npx, heavy = ne - 64; int e;
            if (!consumer) { e = 32 * i + r; if (e >= ne) return false; }
            else if (r >= heavy) { e = i * (32 - heavy) + (r - heavy); if (e >= 64) return false; }
            else { if (i != 0) return false; e = 64 + r; }
            u.pm = npx * xcd + (e >> 2); u.pn = e & 3; }
        else { const int L = i * G + c; if (L >= 32 * npx) return false; u.pm = L >> 2; u.pn = L & 3; }
        u.a = A + (size_t)u.pm * astep; u.b = Bt + (size_t)u.pn * bstep; u.e = 0; u.p0 = 0; u.ce = 0; return true;
    }
    __device__ __forceinline__ void a_ready(const Unit& u) const {
        if (!consumer || !chain) return;
        if (__builtin_amdgcn_readfirstlane(threadIdx.x >> 6) == 0) {
            unsigned spins = 0;
            while ((unsigned)__builtin_amdgcn_readfirstlane(__hip_atomic_load(ready + 16 * u.pm, __ATOMIC_RELAXED, __HIP_MEMORY_SCOPE_AGENT)) < 32u) { __builtin_amdgcn_s_sleep(2); if (++spins > (1u << 22)) break; }
            __builtin_amdgcn_fence(__ATOMIC_ACQUIRE, "agent");
            asm volatile("s_waitcnt vmcnt(0)" ::: "memory");
        }
        asm volatile("" ::: "memory"); __builtin_amdgcn_s_barrier(); asm volatile("" ::: "memory");
    }
    __device__ __forceinline__ void done(const Unit& u) const {
        if (consumer || !chain) return;
        asm volatile("s_waitcnt vmcnt(0)" ::: "memory");
        if (fresh_lane() == 0) __hip_atomic_fetch_add(ready + 16 * u.pm, 1u, __ATOMIC_RELAXED, __HIP_MEMORY_SCOPE_AGENT);
    }
};
template <class Epi, class Sched, bool ALIGN_EPI = true, bool I8 = false>
__device__ __forceinline__ void gemm_phase(LAS unsigned char* lds, const int wid, const int lda, const int ldb, const int K, const Sched& S, const Epi& E) {
    const int lane = fresh_lane(), tid = wid * 64 + lane, wr = wid >> 2, wc = wid & 3, fr = lane & 15, fq = lane >> 4;
    const int nt = K / BK;
    unsigned voffA[2], voffB[2];
#pragma unroll
    for (int i = 0; i < 2; ++i) { int Rr, C; stage_rc(tid * 16 + i * 8192, Rr, C); const int Rb = Epi::PERM ? ((Rr & ~31) + perm32(Rr & 31)) : Rr;
        voffA[i] = (unsigned)(Rr * lda + C) * 2u; voffB[i] = (unsigned)(Rb * ldb + C) * 2u; }
    const size_t kstep = (size_t)(BK * 2);
    const size_t hstepA = Sched::GATHER ? 0 : (size_t)HALF * lda * 2, hstepB = (size_t)HALF * ldb * 2;
    const unsigned ldsw = (unsigned)wid * 1024u;
    const int aoff = lds_byte(wr * 64 + fr, fq * 8), boff = lds_byte(wc * 32 + fr, fq * 8);
#define PG8_SA(b, h) (((b) * 2 + (h)) * HTB)
#define PG8_SB(b, h) ((4 + (b) * 2 + (h)) * HTB)
#define PG8_STAGE(bufoff, gbase, voff) do { _Pragma("unroll") for (int _i = 0; _i < 2; ++_i) \
        __builtin_amdgcn_global_load_lds((const unsigned*)((const char*)(gbase) + (voff)[_i]), (LAS unsigned*)(lds + (bufoff) + ldsw + _i * 8192), 16, 0, 0); } while (0)
#define PG8_STAGE_A(b, h, kp, OFFS) do { if constexpr (Sched::GATHER) { PG8_STAGE(PG8_SA(b, h), kp, OFFS[h]); } else { PG8_STAGE(PG8_SA(b, h), (kp) + (h) * hstepA, voffA); } } while (0)
#define PG8_LDA(dst, b, h) do { _Pragma("unroll") for (int m = 0; m < 4; ++m) _Pragma("unroll") for (int k = 0; k < 2; ++k) dst[m][k] = *(const LAS bf16x8*)(lds + PG8_SA(b, h) + aoff + m * 2048 + k * 1024); } while (0)
#define PG8_LDB(dst, b, h) do { _Pragma("unroll") for (int n = 0; n < 2; ++n) _Pragma("unroll") for (int k = 0; k < 2; ++k) dst[n][k] = *(const LAS bf16x8*)(lds + PG8_SB(b, h) + boff + n * 2048 + k * 1024); } while (0)
#define PG8_MMA(ai, bj, At, Bt) do { __builtin_amdgcn_s_setprio(1); _Pragma("unroll") for (int m = 0; m < 4; ++m) _Pragma("unroll") for (int n = 0; n < 2; ++n) _Pragma("unroll") for (int k = 0; k < 2; ++k) { \
        if constexpr (I8) acc[ai][bj][m][n] = __builtin_bit_cast(f32x4, __builtin_amdgcn_mfma_i32_16x16x64_i8(__builtin_bit_cast(i32x4, Bt[n][k]), __builtin_bit_cast(i32x4, At[m][k]), __builtin_bit_cast(i32x4, acc[ai][bj][m][n]), 0, 0, 0)); \
        else acc[ai][bj][m][n] = __builtin_amdgcn_mfma_f32_16x16x32_bf16(Bt[n][k], At[m][k], acc[ai][bj][m][n], 0, 0, 0); } __builtin_amdgcn_s_setprio(0); } while (0)
#define PG8_WAIT_V(n) asm volatile("s_waitcnt vmcnt(" #n ")" ::: "memory")
#define PG8_WAIT_L(n) asm volatile("s_waitcnt lgkmcnt(" #n ")" ::: "memory")
#define PG8_BAR __builtin_amdgcn_s_barrier()
#define PG8_SCHED __builtin_amdgcn_sched_barrier(0)
    Unit cur, nxt; int ui = 0;
    if (!S.next(0, cur)) return;
    f32x4 acc[2][2][4][2];
#pragma unroll
    for (int a = 0; a < 2; ++a)
#pragma unroll
        for (int b = 0; b < 2; ++b)
#pragma unroll
            for (int m = 0; m < 4; ++m)
#pragma unroll
                for (int n = 0; n < 2; ++n) acc[a][b][m][n] = (f32x4){0.f, 0.f, 0.f, 0.f};
    bf16x8 At[4][2], B0[2][2], B1[2][2];
    unsigned goffC[2][2], goffN[2][2];
    if constexpr (Sched::GATHER) { S.aoffs(cur, wid, lda, goffC);
#pragma unroll
        for (int h = 0; h < 2; ++h)
#pragma unroll
            for (int i = 0; i < 2; ++i) goffN[h][i] = goffC[h][i]; }
    const char* cA = cur.a; const char* cB = cur.b;
    S.a_ready(cur);
    PG8_STAGE(PG8_SB(0, 0), cB, voffB); PG8_STAGE(PG8_SB(0, 1), cB + hstepB, voffB); PG8_STAGE_A(0, 0, cA, goffC); PG8_STAGE_A(0, 1, cA, goffC);
    if (wr == 1) PG8_BAR;
    PG8_WAIT_V(2); PG8_BAR;
    PG8_STAGE(PG8_SB(1, 0), cB + kstep, voffB); PG8_STAGE_A(1, 0, cA + kstep, goffC); PG8_STAGE(PG8_SB(1, 1), cB + hstepB + kstep, voffB);
    PG8_WAIT_V(6); PG8_BAR;
    for (;;) {
        const bool has_next = S.next(ui + 1, nxt);
        if constexpr (Sched::GATHER) { if (has_next) S.aoffs(nxt, wid, lda, goffN); }
        const char* nA = has_next ? nxt.a : cA; const char* nB = has_next ? nxt.b : cB;
        for (int t = 0; t < nt; t += 2) {
            const bool last = (t == nt - 2);
            const char* a1 = cA + (size_t)(t + 1) * kstep;
            const char* a2 = last ? nA : cA + (size_t)(t + 2) * kstep; const char* b2 = last ? nB : cB + (size_t)(t + 2) * kstep;
            const char* a3 = a2 + kstep; const char* b3 = b2 + kstep;
            unsigned gx[2][2];
            if constexpr (Sched::GATHER) {
#pragma unroll
                for (int h = 0; h < 2; ++h)
#pragma unroll
                    for (int i = 0; i < 2; ++i) gx[h][i] = (last && has_next) ? goffN[h][i] : goffC[h][i]; }
            if (last && has_next) S.a_ready(nxt);
            PG8_LDB(B0, 0, 0); PG8_LDB(B1, 0, 1); PG8_SCHED; PG8_LDA(At, 0, 0); PG8_STAGE_A(1, 1, a1, goffC);
            PG8_WAIT_V(8); PG8_WAIT_L(0); PG8_BAR; PG8_MMA(0, 0, At, B0); PG8_MMA(0, 1, At, B1); PG8_BAR; PG8_SCHED;
            PG8_LDA(At, 0, 1); PG8_STAGE(PG8_SB(0, 0), b2, voffB); PG8_STAGE(PG8_SB(0, 1), b2 + hstepB, voffB); PG8_STAGE_A(0, 0, a2, gx);
            PG8_WAIT_V(8); PG8_WAIT_L(0); PG8_BAR; PG8_MMA(1, 0, At, B0); PG8_MMA(1, 1, At, B1); PG8_BAR; PG8_SCHED;
            PG8_LDB(B0, 1, 0); PG8_LDB(B1, 1, 1); PG8_SCHED; PG8_LDA(At, 1, 0); PG8_STAGE_A(0, 1, a2, gx);
            PG8_WAIT_V(8); PG8_WAIT_L(0); PG8_BAR; PG8_MMA(0, 0, At, B0); PG8_MMA(0, 1, At, B1); PG8_BAR; PG8_SCHED;
            PG8_LDA(At, 1, 1); PG8_STAGE(PG8_SB(1, 0), b3, voffB); PG8_STAGE(PG8_SB(1, 1), b3 + hstepB, voffB); PG8_STAGE_A(1, 0, a3, gx);
            PG8_WAIT_V(8); PG8_WAIT_L(0); PG8_BAR; PG8_MMA(1, 0, At, B0); PG8_MMA(1, 1, At, B1); PG8_BAR; PG8_SCHED;
            if constexpr (Epi::MID) { if (((t + 2) & (Epi::MID_EVERY - 1)) == 0 && !last) E.mid(acc, cur, wr, wc, (t + 2) / Epi::MID_EVERY - 1); }
        }
        if constexpr (ALIGN_EPI) { if (wr == 0) PG8_BAR; }
        E(acc, cur, wr, wc, fr, fq);
        S.done(cur);
        if (!has_next) break;
#pragma unroll
        for (int a = 0; a < 2; ++a)
#pragma unroll
            for (int b = 0; b < 2; ++b)
#pragma unroll
                for (int m = 0; m < 4; ++m)
#pragma unroll
                    for (int n = 0; n < 2; ++n) acc[a][b][m][n] = (f32x4){0.f, 0.f, 0.f, 0.f};
        cur = nxt; cA = nA; cB = nB; ++ui;
        if constexpr (Sched::GATHER) {
#pragma unroll
            for (int h = 0; h < 2; ++h)
#pragma unroll
                for (int i = 0; i < 2; ++i) goffC[h][i] = goffN[h][i]; }
        if constexpr (ALIGN_EPI) { if (wr == 1) PG8_BAR; }
    }
    PG8_WAIT_V(0);
    if constexpr (!ALIGN_EPI) { if (wr == 0) PG8_BAR; }
    PG8_BAR;
#undef PG8_SA
#undef PG8_SB
#undef PG8_STAGE
#undef PG8_STAGE_A
#undef PG8_LDA
#undef PG8_LDB
#undef PG8_MMA
#undef PG8_WAIT_V
#undef PG8_WAIT_L
#undef PG8_BAR
#undef PG8_SCHED
}
template <class F> struct EpiV4 { static constexpr bool PERM = false, MID = false; static constexpr int MID_EVERY = 1; F f;
    __device__ __forceinline__ void operator()(const f32x4 (&acc)[2][2][4][2], const Unit& u, int wr, int wc, int, int) const {
        const int ln = fresh_lane(), fr = ln & 15, fq = ln >> 4;
        const int row0 = u.pm * BM + wr * 64 + fr, col0 = u.pn * BM + wc * 32 + 4 * fq;
        typename F::UnitPre up = f.unit(u, col0);
#pragma unroll
        for (int ai = 0; ai < 2; ++ai) {
            typename F::Pre pre[4][2][2];
#pragma unroll
            for (int m = 0; m < 4; ++m)
#pragma unroll
                for (int bj = 0; bj < 2; ++bj)
#pragma unroll
                    for (int n = 0; n < 2; ++n) pre[m][bj][n] = f.load(u, row0 + ai * HALF + m * 16, col0 + bj * HALF + n * 16);
#pragma unroll
            for (int m = 0; m < 4; ++m)
#pragma unroll
                for (int bj = 0; bj < 2; ++bj)
#pragma unroll
                    for (int n = 0; n < 2; ++n) f.fin(u, row0 + ai * HALF + m * 16, col0 + bj * HALF + n * 16, acc[ai][bj][m][n], pre[m][bj][n], up, bj * 2 + n);
            asm volatile("" ::: "memory"); }
    } };
template <class F> struct EpiV8 { static constexpr bool PERM = true, MID = false; static constexpr int MID_EVERY = 1; F f;
    __device__ __forceinline__ void operator()(const f32x4 (&acc)[2][2][4][2], const Unit& u, int wr, int wc, int, int) const {
        const int ln = fresh_lane(), fr = ln & 15, fq = ln >> 4;
        const int row0 = u.pm * BM + wr * 64 + fr, col0 = u.pn * BM + wc * 32 + 8 * fq;
#pragma unroll
        for (int ai = 0; ai < 2; ++ai) {
            typename F::Pre pre[4][2];
#pragma unroll
            for (int m = 0; m < 4; ++m)
#pragma unroll
                for (int bj = 0; bj < 2; ++bj) pre[m][bj] = f.load(u, row0 + ai * HALF + m * 16, col0 + bj * HALF);
#pragma unroll
            for (int m = 0; m < 4; ++m)
#pragma unroll
                for (int bj = 0; bj < 2; ++bj) f.fin(u, row0 + ai * HALF + m * 16, col0 + bj * HALF, acc[ai][bj][m][0], acc[ai][bj][m][1], pre[m][bj]);
            asm volatile("" ::: "memory"); }
    } };
template <class F> struct EpiDual { static constexpr bool PERM = true, MID = false; static constexpr int MID_EVERY = 1; F f;
    __device__ __forceinline__ void operator()(const f32x4 (&acc)[2][2][4][2], const Unit& u, int wr, int wc, int, int) const {
        const int ln = fresh_lane(), fr = ln & 15, fq = ln >> 4;
        const int row0 = u.pm * BM + wr * 64 + fr, hc0 = u.pn * HALF + wc * 32 + 8 * fq;
#pragma unroll
        for (int ai = 0; ai < 2; ++ai)
#pragma unroll
            for (int m = 0; m < 4; ++m) f.apply8(row0 + ai * HALF + m * 16, hc0, acc[ai][0][m][0], acc[ai][0][m][1], acc[ai][1][m][0], acc[ai][1][m][1]);
    } };
struct EpiMergeS { static constexpr bool PERM = true, MID = true; static constexpr int MID_EVERY = 8;
    const unsigned char* G8; bf16_t* MG; int wt;
    __device__ __forceinline__ void mid(f32x4 (&acc)[2][2][4][2], const Unit& u, int wr, int wc, int i) const {
        const int ln = fresh_lane(), fr = ln & 15, fq = ln >> 4;
        const int row0 = u.pm * BM + wr * 64 + fr, col0 = u.pn * BM + wc * 32 + 8 * fq;
#pragma unroll
        for (int ai = 0; ai < 2; ++ai) {
            u32x2 gi[4][2], gn[4][2];
#pragma unroll
            for (int m = 0; m < 4; ++m)
#pragma unroll
                for (int bj = 0; bj < 2; ++bj) { const unsigned char* gp = G8 + (size_t)(row0 + ai * HALF + m * 16) * 4096 + i * 1024 + col0 + bj * HALF;
                    gi[m][bj] = *(const u32x2*)gp; gn[m][bj] = *(const u32x2*)(gp + 1024); }
#pragma unroll
            for (int m = 0; m < 4; ++m)
#pragma unroll
                for (int bj = 0; bj < 2; ++bj) {
#pragma unroll
                    for (int j = 0; j < 4; ++j) {
                        acc[ai][bj][m][0][j] *= (float)((gi[m][bj].x >> (8 * j)) & 255u) * __builtin_amdgcn_rcpf((float)((gn[m][bj].x >> (8 * j)) & 255u));
                        acc[ai][bj][m][1][j] *= (float)((gi[m][bj].y >> (8 * j)) & 255u) * __builtin_amdgcn_rcpf((float)((gn[m][bj].y >> (8 * j)) & 255u)); } }
        }
    }
    __device__ __forceinline__ void operator()(const f32x4 (&acc)[2][2][4][2], const Unit& u, int wr, int wc, int, int) const {
        const int ln = fresh_lane(), fr = ln & 15, fq = ln >> 4;
        const int row0 = u.pm * BM + wr * 64 + fr, col0 = u.pn * BM + wc * 32 + 8 * fq;
#pragma unroll
        for (int ai = 0; ai < 2; ++ai) {
            const __amdgpu_buffer_rsrc_t rs = __builtin_amdgcn_make_buffer_rsrc((void*)MG, (short)0, (int)((size_t)R * D * 2), 0x00020000);
        u32x2 g3[4][2];
#pragma unroll
            for (int m = 0; m < 4; ++m)
#pragma unroll
                for (int bj = 0; bj < 2; ++bj) g3[m][bj] = *(const u32x2*)(G8 + (size_t)(row0 + ai * HALF + m * 16) * 4096 + 3 * 1024 + col0 + bj * HALF);
#pragma unroll
            for (int m = 0; m < 4; ++m)
#pragma unroll
                for (int bj = 0; bj < 2; ++bj) { f32x4 a = acc[ai][bj][m][0], b = acc[ai][bj][m][1];
#pragma unroll
                    for (int j = 0; j < 4; ++j) { a[j] *= (float)((g3[m][bj].x >> (8 * j)) & 255u) * (1.0f / 255.0f); b[j] *= (float)((g3[m][bj].y >> (8 * j)) & 255u) * (1.0f / 255.0f); }
                    u32x4 w; w.x = cvtpk(a.x, a.y); w.y = cvtpk(a.z, a.w); w.z = cvtpk(b.x, b.y); w.w = cvtpk(b.z, b.w);
                    if (wt) __builtin_amdgcn_raw_buffer_store_b128(w, rs, (int)(((size_t)(row0 + ai * HALF + m * 16) * D + col0 + bj * HALF) * 2), 0, 16);
                    else *(u32x4*)(MG + (size_t)(row0 + ai * HALF + m * 16) * D + col0 + bj * HALF) = w; }
        }
    }
};
template <class F> struct EpiV8I8 { static constexpr bool PERM = true, MID = false; static constexpr int MID_EVERY = 1; F f; const float* sA; const unsigned* cmax;
    __device__ __forceinline__ void operator()(const f32x4 (&acc)[2][2][4][2], const Unit& u, int wr, int wc, int, int) const {
        const int ln = fresh_lane(), fr = ln & 15, fq = ln >> 4;
        const int row0 = u.pm * BM + wr * 64 + fr, col0 = u.pn * BM + wc * 32 + 8 * fq;
        u32x4 cb[2][2]; float ra[2][4];
#pragma unroll
        for (int bj = 0; bj < 2; ++bj)
#pragma unroll
            for (int n = 0; n < 2; ++n) cb[bj][n] = *(const u32x4*)(cmax + col0 + bj * HALF + 4 * n);
#pragma unroll
        for (int ai = 0; ai < 2; ++ai)
#pragma unroll
            for (int m = 0; m < 4; ++m) ra[ai][m] = sA[row0 + ai * HALF + m * 16];
        const typename F::UnitPre up = f.unit(col0);
        f32x4 sb[2][2];
#pragma unroll
        for (int bj = 0; bj < 2; ++bj)
#pragma unroll
            for (int n = 0; n < 2; ++n) { const u32x4 c = cb[bj][n]; sb[bj][n] = (f32x4){__uint_as_float(c.x), __uint_as_float(c.y), __uint_as_float(c.z), __uint_as_float(c.w)} * (1.0f / 127.0f); }
#pragma unroll
        for (int ai = 0; ai < 2; ++ai) {
#pragma unroll
            for (int m = 0; m < 4; ++m) { const float r1 = ra[ai][m];
#pragma unroll
                for (int bj = 0; bj < 2; ++bj) { f32x4 a, b;
#pragma unroll
                    for (int j = 0; j < 4; ++j) { a[j] = (float)__float_as_int(acc[ai][bj][m][0][j]) * r1 * sb[bj][0][j]; b[j] = (float)__float_as_int(acc[ai][bj][m][1][j]) * r1 * sb[bj][1][j]; }
                    f.fin(u, row0 + ai * HALF + m * 16, col0 + bj * HALF, a, b, up, bj); } }
            asm volatile("" ::: "memory"); }
    } };
template <class F> struct EpiDualI8 { static constexpr bool PERM = true, MID = false; static constexpr int MID_EVERY = 1; F f; const float* sA; const unsigned* cmax; const int* tokl;
    __device__ __forceinline__ void operator()(const f32x4 (&acc)[2][2][4][2], const Unit& u, int wr, int wc, int, int) const {
        const int ln = fresh_lane(), fr = ln & 15, fq = ln >> 4;
        const int lrow0 = wr * 64 + fr, hc0 = u.pn * HALF + wc * 32 + 8 * fq;
        const unsigned* cm = cmax + u.e * 1024 + u.pn * BM + wc * 32 + 8 * fq;
        f32x4 s1[2], s3[2];
#pragma unroll
        for (int n = 0; n < 2; ++n) { const u32x4 a = *(const u32x4*)(cm + 4 * n), b = *(const u32x4*)(cm + HALF + 4 * n);
            s1[n] = (f32x4){__uint_as_float(a.x), __uint_as_float(a.y), __uint_as_float(a.z), __uint_as_float(a.w)} * (1.0f / 127.0f);
            s3[n] = (f32x4){__uint_as_float(b.x), __uint_as_float(b.y), __uint_as_float(b.z), __uint_as_float(b.w)} * (1.0f / 127.0f); }
        int tk[2][4]; float ra[2][4];
#pragma unroll
        for (int ai = 0; ai < 2; ++ai)
#pragma unroll
            for (int m = 0; m < 4; ++m) { const int pos = u.p0 + lrow0 + ai * HALF + m * 16; tk[ai][m] = pos < u.ce ? (tokl[(size_t)u.e * R + pos] >> 1) : 0; }
#pragma unroll
        for (int ai = 0; ai < 2; ++ai)
#pragma unroll
            for (int m = 0; m < 4; ++m) ra[ai][m] = sA[tk[ai][m]];
#pragma unroll
        for (int ai = 0; ai < 2; ++ai) {
#pragma unroll
            for (int m = 0; m < 4; ++m) { f32x4 a0, a1, b0, b1; const float r1 = ra[ai][m];
#pragma unroll
                for (int j = 0; j < 4; ++j) { a0[j] = (float)__float_as_int(acc[ai][0][m][0][j]) * r1 * s1[0][j]; a1[j] = (float)__float_as_int(acc[ai][0][m][1][j]) * r1 * s1[1][j];
                    b0[j] = (float)__float_as_int(acc[ai][1][m][0][j]) * r1 * s3[0][j]; b1[j] = (float)__float_as_int(acc[ai][1][m][1][j]) * r1 * s3[1][j]; }
                f.apply8(u.pm * BM + lrow0 + ai * HALF + m * 16, hc0, a0, a1, b0, b1); }
        }
    } };
}

__device__ __forceinline__ u32x4 pack8(f32x4 a, f32x4 b) { u32x4 w; w.x = cvtpk(a.x, a.y); w.y = cvtpk(a.z, a.w); w.z = cvtpk(b.x, b.y); w.w = cvtpk(b.z, b.w); return w; }
__device__ __forceinline__ float sigm1(float x) { return __builtin_amdgcn_rcpf(1.0f + __builtin_amdgcn_exp2f(-1.4426950408889634f * x)); }
__device__ __forceinline__ f32x4 sigm4(f32x4 v) { f32x4 r; r.x = sigm1(v.x); r.y = sigm1(v.y); r.z = sigm1(v.z); r.w = sigm1(v.w); return r; }
struct NoPre {};
struct FStore8 { bf16_t* C; int ldc; typedef NoPre UnitPre;
    __device__ __forceinline__ UnitPre unit(int) const { return UnitPre{}; }
    __device__ __forceinline__ void fin(const pg8::Unit&, int row, int col, f32x4 a, f32x4 b, const UnitPre&, int) const { *(u32x4*)(C + (size_t)row * ldc + col) = pack8(a, b); } };
struct FGateU8 { unsigned char* G8; const float* bias; struct UnitPre { f32x4 b[2][2]; };
    __device__ __forceinline__ UnitPre unit(int col0) const { UnitPre r;
#pragma unroll
        for (int bj = 0; bj < 2; ++bj) { r.b[bj][0] = *(const f32x4*)(bias + col0 + bj * pg8::HALF); r.b[bj][1] = *(const f32x4*)(bias + col0 + bj * pg8::HALF + 4); } return r; }
    __device__ __forceinline__ void fin(const pg8::Unit&, int row, int col, f32x4 a, f32x4 b, const UnitPre& up, int bj) const { const f32x4 b0 = up.b[bj][0], b1 = up.b[bj][1];
        const f32x4 ga = sigm4(a + b0) * 255.0f + 0.5f, gb = sigm4(b + b1) * 255.0f + 0.5f;
        unsigned q[8] = {(unsigned)ga.x, (unsigned)ga.y, (unsigned)ga.z, (unsigned)ga.w, (unsigned)gb.x, (unsigned)gb.y, (unsigned)gb.z, (unsigned)gb.w};
#pragma unroll
        for (int k = 0; k < 8; ++k) q[k] = q[k] < 1u ? 1u : (q[k] > 255u ? 255u : q[k]);
        u32x2 w; w.x = q[0] | (q[1] << 8) | (q[2] << 16) | (q[3] << 24); w.y = q[4] | (q[5] << 8) | (q[6] << 16) | (q[7] << 24);
        *(u32x2*)(G8 + (size_t)row * 4096 + col) = w; } };
struct FMoe1 { bf16_t* HID;
    __device__ __forceinline__ void apply8(int row, int hc, f32x4 a0, f32x4 a1, f32x4 b0, f32x4 b1) const {
        const __amdgpu_buffer_rsrc_t rs = __builtin_amdgcn_make_buffer_rsrc((void*)HID, (short)0, (int)((size_t)MAXROWS * FF * 2), 0x00020000);
        __builtin_amdgcn_raw_buffer_store_b128(pack8(a0 * sigm4(a0) * b0, a1 * sigm4(a1) * b1), rs, (int)(((size_t)row * FF + hc) * 2), 0, 16); } };
struct FMoe2 { bf16_t* MO; const int* tokl; const float* wl; struct Pre { int t; float w; };
    __device__ __forceinline__ Pre load(const pg8::Unit& u, int row, int) const { Pre r; const int pos = u.p0 + (row - u.pm * 256); r.t = -1; r.w = 0.f;
        if (pos < u.ce) { r.t = tokl[(size_t)u.e * R + pos]; r.w = wl[(size_t)u.e * R + pos]; } return r; }
    __device__ __forceinline__ void fin(const pg8::Unit&, int, int col, f32x4 a, f32x4 b, const Pre& q) const { if (q.t < 0) return;
        *(u32x4*)(MO + ((size_t)(q.t & 1) * R + (q.t >> 1)) * D + col) = pack8(a * q.w, b * q.w); } };
struct FOut { Ptrs P; int l; typedef u32x4 Pre; struct UnitPre { f32x4 g[4]; };
    __device__ __forceinline__ UnitPre unit(const pg8::Unit& u, int col0) const { UnitPre r; const float* g = mod_vec(P, l, row_bb(u.pm * 256), 2) + col0;
#pragma unroll
        for (int q = 0; q < 4; ++q) r.g[q] = *(const f32x4*)(g + (q >> 1) * 128 + (q & 1) * 16);
        return r; }
    __device__ __forceinline__ Pre load(const pg8::Unit&, int row, int col) const { if (l == 0) return *(const u32x4*)(xin_row(P, row) + col); const u32x2 w = *(const u32x2*)(x1b_row(P, row) + col); return (u32x4){w.x, w.y, 0u, 0u}; }
    __device__ __forceinline__ void fin(const pg8::Unit&, int row, int col, f32x4 v, const Pre& xr, const UnitPre& up, int q) const {
        const f32x4 xp = l == 0 ? (f32x4){__uint_as_float(xr.x), __uint_as_float(xr.y), __uint_as_float(xr.z), __uint_as_float(xr.w)} : (f32x4){lo16(xr.x), hi16(xr.x), lo16(xr.y), hi16(xr.y)};
        st4b(x1b_row(P, row) + col, xp + up.g[q] * v); } };

struct Frame { LAS unsigned char* lds; int wave, vcu, G; };
#define fresh_tid() (F.wave * 64 + fresh_lane())
__device__ __forceinline__ void tr_item(const float* W, int ldw, int k0, int csrc0, bf16_t* WT, int ldt, int drow0, LAS float* scr, int lane) {
    f32x4 v[8];
#pragma unroll
    for (int i = 0; i < 8; ++i) v[i] = *(const f32x4*)(W + (size_t)(k0 + (lane >> 3) + 8 * i) * ldw + csrc0 + (lane & 7) * 4);
#pragma unroll
    for (int i = 0; i < 8; ++i) { LAS float* d = scr + ((lane >> 3) + 8 * i) * 33 + (lane & 7) * 4; d[0] = v[i].x; d[1] = v[i].y; d[2] = v[i].z; d[3] = v[i].w; }
    LDS_WAIT(); asm volatile("" ::: "memory");
    const int c = lane & 7;
#pragma unroll
    for (int j = 0; j < 4; ++j) { const int n = (lane >> 3) + 8 * j; const LAS float* s = scr + (8 * c) * 33 + n;
        u32x4 o; o.x = cvtpk(s[0 * 33], s[1 * 33]); o.y = cvtpk(s[2 * 33], s[3 * 33]); o.z = cvtpk(s[4 * 33], s[5 * 33]); o.w = cvtpk(s[6 * 33], s[7 * 33]);
        *(u32x4*)(WT + (size_t)(drow0 + n) * ldt + k0 + 8 * c) = o; }
    LDS_WAIT(); asm volatile("" ::: "memory");
}
__device__ __forceinline__ void max_item(const float* W, int ldw, int k0, int csrc0, unsigned* cmax, int lane) {
    f32x4 m = (f32x4){0.f, 0.f, 0.f, 0.f};
#pragma unroll
    for (int i = 0; i < 8; ++i) { const f32x4 v = *(const f32x4*)(W + (size_t)(k0 + (lane >> 3) + 8 * i) * ldw + csrc0 + (lane & 7) * 4);
        m.x = fmaxf(m.x, fabsf(v.x)); m.y = fmaxf(m.y, fabsf(v.y)); m.z = fmaxf(m.z, fabsf(v.z)); m.w = fmaxf(m.w, fabsf(v.w)); }
#pragma unroll
    for (int o = 8; o < 64; o <<= 1) { m.x = fmaxf(m.x, shfl_xor_l(m.x, o, lane)); m.y = fmaxf(m.y, shfl_xor_l(m.y, o, lane)); m.z = fmaxf(m.z, shfl_xor_l(m.z, o, lane)); m.w = fmaxf(m.w, shfl_xor_l(m.w, o, lane)); }
    if (lane < 8) { atomicMax(cmax + lane * 4, __float_as_uint(m.x)); atomicMax(cmax + lane * 4 + 1, __float_as_uint(m.y)); atomicMax(cmax + lane * 4 + 2, __float_as_uint(m.z)); atomicMax(cmax + lane * 4 + 3, __float_as_uint(m.w)); }
}
__device__ __forceinline__ unsigned q8(float v, float inv) { int q = (int)__builtin_rintf(v * inv); q = q < -127 ? -127 : (q > 127 ? 127 : q); return (unsigned)q & 255u; }
__device__ __forceinline__ unsigned q8m(float v, float inv) { return __float_as_uint(__builtin_fmaf(v, inv, 12582912.0f)); }
__device__ __forceinline__ unsigned pack4m(unsigned a, unsigned b, unsigned c, unsigned d) { return __builtin_amdgcn_perm(b, a, 0x0c0c0400u) | __builtin_amdgcn_perm(d, c, 0x04000c0cu); }
__device__ __forceinline__ unsigned q8x4(float a, float b, float c, float d, float inv) { return pack4m(q8m(a, inv), q8m(b, inv), q8m(c, inv), q8m(d, inv)); }
__device__ __forceinline__ void tr_item_q(const float* W, int ldw, int k0, int csrc0, unsigned char* WT, int ldt, int drow0, const unsigned* cmax, LAS float* scr, int lane) {
    f32x4 v[8];
#pragma unroll
    for (int i = 0; i < 8; ++i) v[i] = *(const f32x4*)(W + (size_t)(k0 + (lane >> 3) + 8 * i) * ldw + csrc0 + (lane & 7) * 4);
#pragma unroll
    for (int i = 0; i < 8; ++i) { LAS float* d = scr + ((lane >> 3) + 8 * i) * 33 + (lane & 7) * 4; d[0] = v[i].x; d[1] = v[i].y; d[2] = v[i].z; d[3] = v[i].w; }
    LDS_WAIT(); asm volatile("" ::: "memory");
    const int n = lane >> 1, half = lane & 1; const float cm = __uint_as_float(cmax[n]); const float inv = cm > 0.f ? 127.0f / cm : 0.f;
    const LAS float* sp = scr + (half * 32) * 33 + n; unsigned w[8];
#pragma unroll
    for (int q = 0; q < 8; ++q) w[q] = q8x4(sp[(4 * q) * 33], sp[(4 * q + 1) * 33], sp[(4 * q + 2) * 33], sp[(4 * q + 3) * 33], inv);
    u32x4* dp = (u32x4*)(WT + (size_t)(drow0 + n) * ldt + k0 + half * 32);
    dp[0] = (u32x4){w[0], w[1], w[2], w[3]}; dp[1] = (u32x4){w[4], w[5], w[6], w[7]};
    LDS_WAIT(); asm volatile("" ::: "memory");
}
struct Strip { const float* W; int ldw; unsigned char* WT; unsigned* cm; };
constexpr int NSTRIP = 64 + 128 + 512, ST_PITCH = 1040, ST_RED = 32 * ST_PITCH;
__device__ __forceinline__ Strip strip_desc(const Ptrs& P, int l, int s, unsigned char* wb, unsigned* cmaxp) {
    Strip d;
    if (s < 64) { d.W = P.w_in + (size_t)l * 1024 * 2560 + 512 + s * 32; d.ldw = 2560; d.WT = wb + WB_IN + (size_t)(1024 + s * 32) * 1024; d.cm = cmaxp + 1024 + s * 32; }
    else if (s < 192) { const int r = s - 64, i = r >> 5, nb = r & 31; d.W = P.w_gate + ((size_t)l * 4 + i) * 1024 * 1024 + nb * 32; d.ldw = 1024; d.WT = wb + WB_GATE + (size_t)i * 1024 * 1024 + (size_t)(nb * 32) * 1024; d.cm = cmaxp + 3072 + i * 1024 + nb * 32; }
    else { const int r = s - 192, w3 = r >> 8, e = (r >> 4) & 15, nb = r & 15, c = nb * 32, drow = 256 * (c >> 7) + (c & 127) + (w3 ? 128 : 0);
        d.W = (w3 ? P.w3 : P.w1) + ((size_t)l * 16 + e) * 1024 * 512 + c; d.ldw = 512; d.WT = wb + WB_13 + (size_t)e * 1024 * 1024 + (size_t)drow * 1024; d.cm = cmaxp + 8192 + e * 1024 + drow; }
    return d;
}
#define STRIP_LOAD(v, dsc, tid) do { const float* p_ = (dsc).W + (size_t)(4 * ((tid) >> 3)) * (dsc).ldw + 4 * ((tid) & 7); \
    _Pragma("unroll") for (int j_ = 0; j_ < 4; ++j_) _Pragma("unroll") for (int d_ = 0; d_ < 4; ++d_) v[j_ * 4 + d_] = *(const f32x4*)(p_ + (size_t)(256 * j_ + d_) * (dsc).ldw); } while (0)
__device__ __forceinline__ void strip_process(const f32x4 (&v)[16], const Strip& d, LAS unsigned char* lds, int tid, int lane, int wave) {
    const int cq = tid & 7, kr = tid >> 3;
    f32x4 m = (f32x4){0.f, 0.f, 0.f, 0.f};
#pragma unroll
    for (int i = 0; i < 16; ++i) { m.x = fmaxf(m.x, fabsf(v[i].x)); m.y = fmaxf(m.y, fabsf(v[i].y)); m.z = fmaxf(m.z, fabsf(v[i].z)); m.w = fmaxf(m.w, fabsf(v[i].w)); }
#pragma unroll
    for (int o = 8; o < 64; o <<= 1) { m.x = fmaxf(m.x, shfl_xor_l(m.x, o, lane)); m.y = fmaxf(m.y, shfl_xor_l(m.y, o, lane)); m.z = fmaxf(m.z, shfl_xor_l(m.z, o, lane)); m.w = fmaxf(m.w, shfl_xor_l(m.w, o, lane)); }
    LAS float* red = (LAS float*)(lds + ST_RED);
    if (lane < 8) *(LAS f32x4*)(red + wave * 32 + 4 * lane) = m;
    __syncthreads();
    f32x4 cm = *(const LAS f32x4*)(red + 4 * cq);
#pragma unroll
    for (int w = 1; w < 8; ++w) { const f32x4 t = *(const LAS f32x4*)(red + w * 32 + 4 * cq); cm.x = fmaxf(cm.x, t.x); cm.y = fmaxf(cm.y, t.y); cm.z = fmaxf(cm.z, t.z); cm.w = fmaxf(cm.w, t.w); }
    if (tid < 8) *(u32x4*)(d.cm + 4 * tid) = (u32x4){__float_as_uint(cm.x), __float_as_uint(cm.y), __float_as_uint(cm.z), __float_as_uint(cm.w)};
    f32x4 inv; inv.x = cm.x > 0.f ? 127.0f / cm.x : 0.f; inv.y = cm.y > 0.f ? 127.0f / cm.y : 0.f; inv.z = cm.z > 0.f ? 127.0f / cm.z : 0.f; inv.w = cm.w > 0.f ? 127.0f / cm.w : 0.f;
    LAS unsigned char* tp = lds + (4 * cq) * ST_PITCH + 4 * kr;
#pragma unroll
    for (int j = 0; j < 4; ++j) {
        *(LAS unsigned*)(tp + 0 * ST_PITCH + 256 * j) = pack4m(q8m(v[4 * j].x, inv.x), q8m(v[4 * j + 1].x, inv.x), q8m(v[4 * j + 2].x, inv.x), q8m(v[4 * j + 3].x, inv.x));
        *(LAS unsigned*)(tp + 1 * ST_PITCH + 256 * j) = pack4m(q8m(v[4 * j].y, inv.y), q8m(v[4 * j + 1].y, inv.y), q8m(v[4 * j + 2].y, inv.y), q8m(v[4 * j + 3].y, inv.y));
        *(LAS unsigned*)(tp + 2 * ST_PITCH + 256 * j) = pack4m(q8m(v[4 * j].z, inv.z), q8m(v[4 * j + 1].z, inv.z), q8m(v[4 * j + 2].z, inv.z), q8m(v[4 * j + 3].z, inv.z));
        *(LAS unsigned*)(tp + 3 * ST_PITCH + 256 * j) = pack4m(q8m(v[4 * j].w, inv.w), q8m(v[4 * j + 1].w, inv.w), q8m(v[4 * j + 2].w, inv.w), q8m(v[4 * j + 3].w, inv.w));
    }
    __syncthreads();
#pragma unroll
    for (int q = 0; q < 4; ++q) { const int id = tid + 512 * q, n = id >> 6, kc = id & 63; *(u32x4*)(d.WT + (size_t)n * 1024 + 16 * kc) = *(const LAS u32x4*)(lds + n * ST_PITCH + 16 * kc); }
}
__device__ __forceinline__ void ph_weights(const Frame& F, const Ptrs& P, int l) {
    const int tid0 = fresh_tid(), lane0 = tid0 & 63;
    LAS float* scr = (LAS float*)(F.lds + F.wave * 16384);
    const int gw = F.vcu * NWAVES + F.wave, NGW = F.G * NWAVES;
    unsigned char* wb = P.ws + WS_WB;
    unsigned* cmaxp = (unsigned*)(P.ws + WS_CTL) + CW_CMAX + 32768 * l;
    int vcu = F.vcu; asm volatile("" : "+s"(vcu));
    { const int tid = tid0; f32x4 va[16], vb[16]; Strip da, db; int s = vcu;
      if (s < NSTRIP) { da = strip_desc(P, l, s, wb, cmaxp); STRIP_LOAD(va, da, tid); }
      while (s < NSTRIP) {
          int sn = s + F.G;
          if (sn < NSTRIP) { db = strip_desc(P, l, sn, wb, cmaxp); STRIP_LOAD(vb, db, tid); }
          strip_process(va, da, F.lds, tid, lane0, F.wave);
          s = sn; if (s >= NSTRIP) break;
          sn = s + F.G;
          if (sn < NSTRIP) { da = strip_desc(P, l, sn, wb, cmaxp); STRIP_LOAD(va, da, tid); }
          strip_process(vb, db, F.lds, tid, lane0, F.wave);
          s = sn;
      } }
    __syncthreads();
    constexpr int I2 = 768, I3 = I2 + 512, I6 = I3 + 4096;
    int it0, it1, step;
    if (F.G == 256) { const int base = vcu < 192 ? 16 * vcu : 3072 + 36 * (vcu - 192); it0 = base + F.wave; it1 = base + (vcu < 192 ? 16 : 36); step = NWAVES; }
    else { it0 = gw; it1 = I6; step = NGW; }
    for (int it = it0; it < it1; it += step) {
        if (it < I2) { const int i = it >> 8, q = it & 255, kb = q >> 5, nb = q & 31; tr_item(P.w_branch + ((size_t)l * 4 + i) * 512 * 1024, 1024, kb * 64, nb * 32, (bf16_t*)(wb + WB_BR) + i * 512, 2048, nb * 32, scr, lane0); }
        else if (it < I3) { const int q = it - I2, kb = q >> 5, nb = q & 31; tr_item(P.w_out + (size_t)l * 1024 * 1024, 1024, kb * 64, nb * 32, (bf16_t*)(wb + WB_OUT), 1024, nb * 32, scr, lane0); }
        else { const int r = it - I3, e = r >> 8, q = r & 255, kb = q >> 5, nb = q & 31; tr_item(P.w2 + ((size_t)l * 16 + e) * 512 * 1024, 1024, kb * 64, nb * 32, (bf16_t*)(wb + WB_2) + (size_t)e * 1024 * 512, 512, nb * 32, scr, lane0); }
    }
    __syncthreads();
    for (int u = F.vcu; u < 256; u += F.G) {
        LAS float* Wl = (LAS float*)F.lds; LAS float* ct = Wl + 16 * 128;
        const int kt = u >> 2, g = u & 3, k0 = kt * 16, tid = tid0; const float* w_in = P.w_in + (size_t)l * 1024 * 2560;
        if (tid < 128) ct[tid] = __builtin_amdgcn_cosf((float)tid * (1.0f / 128.0f));
        for (int i = tid; i < 16 * 128; i += 512) { const int k = i >> 7, c = i & 127; Wl[k * 128 + c] = w_in[(size_t)(k0 + k) * 2560 + g * 128 + c]; }
        __syncthreads();
        const int part = (tid >> 7) & 1, m = tid & 127, kh = tid >> 8; const float sc = 0.08838834764831845f;
        float* drow = (float*)(P.ws + WS_FTMP) + (size_t)(part * 512 + g * 128 + m) * 1024 + k0;
        { const int kb = kh * 8; float acc[8];
#pragma unroll
            for (int j = 0; j < 8; ++j) acc[j] = 0.f;
            for (int c = 0; c < 128; ++c) { const int idx = (c * m) & 127; const float tw = part ? -ct[(idx - 32) & 127] : ct[idx];
#pragma unroll
                for (int j = 0; j < 8; ++j) acc[j] += Wl[(kb + j) * 128 + c] * tw; }
            float mx = 0.f;
#pragma unroll
            for (int j = 0; j < 8; ++j) { acc[j] *= sc; mx = fmaxf(mx, fabsf(acc[j])); }
            *(f32x4*)(drow + kb) = (f32x4){acc[0], acc[1], acc[2], acc[3]}; *(f32x4*)(drow + kb + 4) = (f32x4){acc[4], acc[5], acc[6], acc[7]};
            atomicMax(cmaxp + part * 512 + g * 128 + m, __float_as_uint(mx)); }
        __syncthreads();
    }
    for (int u = F.vcu; u < 256; u += F.G) {
        LAS float* Wb = (LAS float*)F.lds;
        const int g = u >> 6, n0 = (u & 63) * 16, tid = tid0;
        const float* ps = P.pool_scale + (size_t)l * 512; const float* wb3 = P.w_branch + ((size_t)l * 4 + 3) * 512 * 1024; const float* pwl = P.pool_w + (size_t)l * 4 * 128 * 128;
        for (int i = tid; i < 128 * 16; i += 512) { const int e = i >> 4, n = i & 15; Wb[e * 16 + n] = ps[g * 128 + e] * wb3[(size_t)(g * 128 + e) * 1024 + n0 + n]; }
        __syncthreads();
        const int c = tid & 127, nh = tid >> 7; const float* pw = pwl + (size_t)(g * 128 + c) * 128;
        float acc[4];
#pragma unroll
        for (int j = 0; j < 4; ++j) acc[j] = 0.f;
        for (int e = 0; e < 128; e += 4) { const f32x4 p4 = *(const f32x4*)(pw + e);
#pragma unroll
            for (int q = 0; q < 4; ++q)
#pragma unroll
                for (int j = 0; j < 4; ++j) acc[j] += p4[q] * Wb[(e + q) * 16 + nh * 4 + j]; }
        bf16_t* Bt = (bf16_t*)(wb + WB_BR) + 3 * 512;
#pragma unroll
        for (int j = 0; j < 4; ++j) Bt[(size_t)(n0 + nh * 4 + j) * 2048 + g * 128 + c] = (bf16_t)f2bf(acc[j]);
        __syncthreads();
    }
}
__device__ __forceinline__ void ph_quant(const Frame& F, const Ptrs& P, int l) {
    const int tid0 = fresh_tid(), lane0 = tid0 & 63;
    LAS float* scr = (LAS float*)(F.lds + F.wave * 16384);
    const int gw = F.vcu * NWAVES + F.wave, NGW = F.G * NWAVES;
    unsigned char* wb = P.ws + WS_WB; const unsigned* cmaxp = (const unsigned*)(P.ws + WS_CTL) + CW_CMAX + 32768 * l;
    for (int i = F.vcu * 512 + tid0; i < 65536; i += F.G * 512) {
        const int n = i >> 6, kc = (i & 63) * 16; const float cm = __uint_as_float(cmaxp[n]); const float inv = cm > 0.f ? 127.0f / cm : 0.f;
        const f32x4* tp = (const f32x4*)((const float*)(P.ws + WS_FTMP) + (size_t)n * 1024 + kc); const f32x4 a = tp[0], b = tp[1], c = tp[2], d = tp[3];
        *(u32x4*)(wb + WB_IN + (size_t)n * 1024 + kc) = (u32x4){q8x4(a.x, a.y, a.z, a.w, inv), q8x4(b.x, b.y, b.z, b.w, inv), q8x4(c.x, c.y, c.z, c.w, inv), q8x4(d.x, d.y, d.z, d.w, inv)};
    }
    __syncthreads();
}
__device__ __forceinline__ void ph_tables_mod(const Frame& F, const Ptrs& P) {
    const int tid0 = fresh_tid();
    { float* rc = (float*)(P.ws + WS_ROPE); float* rs = rc + 1024; float* ct = (float*)(P.ws + WS_COS);
      const int i = F.vcu * 512 + tid0;
      if (i < 1024) { const int pos = i >> 4, f = i & 15; const float inv = __builtin_amdgcn_exp2f(-(float)f * (13.287712379549449f / 16.0f));
          float rev = (float)pos * inv * 0.15915494309189535f; rev = rev - floorf(rev);
          rc[i] = __builtin_amdgcn_cosf(rev); rs[i] = __builtin_amdgcn_sinf(rev); }
      if (i < 4096) ct[i] = __builtin_amdgcn_cosf((float)i * (1.0f / 4096.0f));
      if (i < 16384) { const int mm = i >> 7, k = i & 127, pp = mm >> 6, k1 = mm & 63, pk = k >> 6, t1 = k & 63; const float rev = (float)((k1 * t1) & 63) * (1.0f / 64.0f);
          const float c = __builtin_amdgcn_cosf(rev), sn = __builtin_amdgcn_sinf(rev);
          ((bf16_t*)(P.ws + WS_DFTM))[i] = (bf16_t)f2bf(pp == pk ? c : (pp == 0 ? sn : -sn)); } }
    for (int u = F.vcu; u < 192; u += F.G) {
        LAS float* s = (LAS float*)F.lds; LAS float* red = s + 9 * 1024;
        const int l = u / 96, j0 = (u % 96) * 64, tid = tid0;
        for (int i = tid; i < 9 * 1024; i += 512) { const int bb = i >> 10, k = i & 1023; const float v = bb < 8 ? P.c[bb * 1024 + k] : P.c_ctx[k]; s[i] = v * __builtin_amdgcn_rcpf(1.f + __builtin_amdgcn_exp2f(-1.4426950408889634f * v)); }
        __syncthreads();
        const int kc = tid >> 4, jq = tid & 15;
        const float* w = P.w_ada + (size_t)l * 1024 * 6144 + j0 + 4 * jq + (size_t)(kc * 32) * 6144;
        f32x4 wv[32];
#pragma unroll
        for (int q = 0; q < 32; ++q) wv[q] = *(const f32x4*)(w + (size_t)q * 6144);
        f32x4 acc[9];
#pragma unroll
        for (int b = 0; b < 9; ++b) acc[b] = (f32x4){0.f, 0.f, 0.f, 0.f};
#pragma unroll
        for (int qq = 0; qq < 8; ++qq)
#pragma unroll
            for (int b = 0; b < 9; ++b) { const f32x4 s4 = *(const LAS f32x4*)(s + b * 1024 + kc * 32 + 4 * qq);
                acc[b] += s4.x * wv[4 * qq] + s4.y * wv[4 * qq + 1] + s4.z * wv[4 * qq + 2] + s4.w * wv[4 * qq + 3]; }
#pragma unroll
        for (int b = 0; b < 9; ++b) *(LAS f32x4*)(red + (kc * 9 + b) * 64 + 4 * jq) = acc[b];
        __syncthreads();
        float* mod = (float*)(P.ws + WS_MOD);
        for (int i = tid; i < 9 * 64; i += 512) { const int b = i >> 6, j = i & 63; float v = P.b_ada[l * 6144 + j0 + j];
#pragma unroll
            for (int q = 0; q < 32; ++q) v += red[(q * 9 + b) * 64 + j];
            const int which = j0 >> 10, k = (j0 & 1023) + j;
            if (which == 1) v = P.norm1[l * D + k] * (1.0f + v); else if (which == 4) v = P.norm2[l * D + k] * (1.0f + v);
            mod[(size_t)(l * 9 + b) * 6144 + j0 + j] = v; }
        __syncthreads();
    }
}
__device__ __forceinline__ void route_row(const Ptrs& P, int r, const f32x4 (&h)[4], int lane, bool publish, LAS unsigned* lcnt, LAS int* rec, const LAS float* rwl) {
    float lg[16];
#pragma unroll
    for (int e = 0; e < 16; ++e) lg[e] = 0.f;
#pragma unroll
    for (int j = 0; j < 4; ++j) {
#pragma unroll
        for (int i = 0; i < 4; ++i) { const int kk = 4 * lane + 256 * j + i; const LAS f32x4* rw = (const LAS f32x4*)(rwl + kk * 16 + (kk >> 2) * 4); const float hv = h[j][i];
#pragma unroll
            for (int qd = 0; qd < 4; ++qd) { const f32x4 w = rw[qd]; lg[4 * qd] += hv * w.x; lg[4 * qd + 1] += hv * w.y; lg[4 * qd + 2] += hv * w.z; lg[4 * qd + 3] += hv * w.w; } }
        __builtin_amdgcn_sched_barrier(0); }
    float v8[8], v4[4], v2[2], v1;
    { const bool bit = (lane & 32) != 0;
#pragma unroll
      for (int i = 0; i < 8; ++i) { const float a = lg[i], b = lg[i + 8]; v8[i] = (bit ? b : a) + shfl_xor_l(bit ? a : b, 32, lane); } }
    { const bool bit = (lane & 16) != 0;
#pragma unroll
      for (int i = 0; i < 4; ++i) { const float a = v8[i], b = v8[i + 4]; v4[i] = (bit ? b : a) + shfl_xor_l(bit ? a : b, 16, lane); } }
    { const bool bit = (lane & 8) != 0;
#pragma unroll
      for (int i = 0; i < 2; ++i) { const float a = v4[i], b = v4[i + 2]; v2[i] = (bit ? b : a) + shfl_xor_l(bit ? a : b, 8, lane); } }
    { const bool bit = (lane & 4) != 0; const float a = v2[0], b = v2[1]; v1 = (bit ? b : a) + shfl_xor_l(bit ? a : b, 4, lane); }
    v1 += shfl_xor_l(v1, 2, lane); v1 += shfl_xor_l(v1, 1, lane);
    float bestscore = -INFINITY; int be0 = 0, be1 = 1; float ba0 = 0.f, ba1 = 0.f;
#pragma unroll
    for (int g = 0; g < 4; ++g) {
        float aff[4], sel[4];
#pragma unroll
        for (int i = 0; i < 4; ++i) { const float t = __int_as_float(__builtin_amdgcn_ds_bpermute((4 * g + i) << 4, __float_as_int(v1))); aff[i] = __builtin_amdgcn_rcpf(1.0f + __builtin_amdgcn_exp2f(-1.4426950408889634f * t)); sel[i] = aff[i] + P.router_bias[4 * g + i]; }
        int i1 = 0; float m1 = sel[0], a1 = aff[0];
#pragma unroll
        for (int i = 1; i < 4; ++i) if (sel[i] > m1) { m1 = sel[i]; a1 = aff[i]; i1 = i; }
        int i2 = -1; float m2 = -INFINITY, a2 = 0.f;
#pragma unroll
        for (int i = 0; i < 4; ++i) if (i != i1 && sel[i] > m2) { m2 = sel[i]; a2 = aff[i]; i2 = i; }
        const float score = m1 + m2;
        if (score > bestscore) { bestscore = score; be0 = 4 * g + i1; be1 = 4 * g + i2; ba0 = a1; ba1 = a2; }
    }
    if (lane == 0 && publish) {
        const int p0 = (int)__hip_atomic_fetch_add(lcnt + be0, 1u, __ATOMIC_RELAXED, __HIP_MEMORY_SCOPE_WORKGROUP), p1 = (int)__hip_atomic_fetch_add(lcnt + be1, 1u, __ATOMIC_RELAXED, __HIP_MEMORY_SCOPE_WORKGROUP);
        const float inv = 1.0f / (ba0 + ba1);
        rec[0] = r; rec[1] = be0; rec[2] = p0; rec[3] = be1; rec[4] = p1; rec[5] = __float_as_int(ba0 * inv); rec[6] = __float_as_int(ba1 * inv);
    }
}
template <int MODE> __device__ __forceinline__ void ph_norm(const Frame& F, const Ptrs& P, int l, int nrows) {
    constexpr int NRW = MODE == 2 ? 2 : 4;
    const int lane = fresh_lane();
    const int stride = F.G * NWAVES;
    LAS unsigned* lcnt = (LAS unsigned*)F.lds; LAS unsigned* gbase = lcnt + 16; LAS int* recs = (LAS int*)(F.lds + 256);
    const LAS float* rwl = (const LAS float*)(F.lds + 8192);
    if (MODE == 2) { if (F.wave == 0 && lane < 16) lcnt[lane] = 0u;
        { const int tid = F.wave * 64 + lane; LAS f32x4* d = (LAS f32x4*)(F.lds + 8192);
#pragma unroll
          for (int i = 0; i < 8; ++i) { const int idx = tid + 512 * i, kk = idx >> 2; d[idx + (kk >> 2)] = ((const f32x4*)P.router_w)[idx]; } }
        __syncthreads(); }
    LAS float* tsh = (LAS float*)F.lds; LAS float* tsc = tsh + 9 * D; LAS float* tg2 = tsc + 9 * D;
    if (MODE != 2) { const int tid = F.wave * 64 + lane;
        for (int i = tid; i < 9 * 256; i += NWAVES * 64) { const int bb = i >> 8, k4 = i & 255;
            ((LAS f32x4*)tsh)[i] = ((const f32x4*)mod_vec(P, l, bb, 0))[k4]; ((LAS f32x4*)tsc)[i] = ((const f32x4*)mod_vec(P, l, bb, 1))[k4];
            if (MODE == 1) ((LAS f32x4*)tg2)[i] = ((const f32x4*)mod_vec(P, l - 1, bb, 5))[k4]; }
        __syncthreads(); }
    int it = 0;
    for (int rb = F.vcu * NWAVES + F.wave; rb < nrows; rb += NRW * stride, ++it) {
        int rr[NRW];
#pragma unroll
        for (int q = 0; q < NRW; ++q) rr[q] = rb + q * stride < nrows ? rb + q * stride : rb;
        f32x4 v[NRW][4];
#pragma unroll
        for (int q = 0; q < NRW; ++q) { const int r = rr[q];
            if (MODE == 0) { const f32x4* xr = (const f32x4*)xin_row(P, r) + lane;
#pragma unroll
                for (int j = 0; j < 4; ++j) v[q][j] = xr[64 * j]; }
            else { const bf16_t* xr = x1b_row(P, r) + 4 * lane;
#pragma unroll
                for (int j = 0; j < 4; ++j) v[q][j] = ld4b(xr + 256 * j); } }
        if (MODE == 1) {
#pragma unroll
            for (int q = 0; q < NRW; ++q) { const int r = rr[q]; const int bb = row_bb(r); const LAS f32x4* g2 = (const LAS f32x4*)(tg2 + bb * D) + lane;
                const u32x2* m0 = (const u32x2*)((const bf16_t*)(P.ws + WS_MO) + (size_t)r * D) + lane; const u32x2* m1 = (const u32x2*)((const bf16_t*)(P.ws + WS_MO) + (size_t)(R + r) * D) + lane;
#pragma unroll
                for (int j = 0; j < 4; ++j) { const u32x2 a = m0[64 * j], b = m1[64 * j]; const f32x4 g = g2[64 * j];
                    v[q][j].x += g.x * (lo16(a.x) + lo16(b.x)); v[q][j].y += g.y * (hi16(a.x) + hi16(b.x)); v[q][j].z += g.z * (lo16(a.y) + lo16(b.y)); v[q][j].w += g.w * (hi16(a.y) + hi16(b.y)); } }
#pragma unroll
            for (int q = 0; q < NRW; ++q) if (q == 0 || rr[q] != rr[0]) { bf16_t* xr = x1b_row(P, rr[q]) + 4 * lane;
#pragma unroll
                for (int j = 0; j < 4; ++j) st4b(xr + 256 * j, v[q][j]); }
        }
        float ss[NRW];
#pragma unroll
        for (int q = 0; q < NRW; ++q) { ss[q] = 0.f;
#pragma unroll
            for (int j = 0; j < 4; ++j) ss[q] += (v[q][j].x * v[q][j].x + v[q][j].y * v[q][j].y) + (v[q][j].z * v[q][j].z + v[q][j].w * v[q][j].w); }
#pragma unroll
        for (int o = 1; o < 64; o <<= 1) {
#pragma unroll
            for (int q = 0; q < NRW; ++q) ss[q] += shfl_xor_l(ss[q], o, lane); }
#pragma unroll
        for (int q = 0; q < NRW; ++q) { const int r = rr[q]; const int bb = row_bb(r);
            if (q > 0 && r == rr[0]) continue;
            const float rstd = 1.0f / sqrtf(ss[q] * (1.0f / D) + EPS);
            const LAS f32x4* sh = (const LAS f32x4*)(tsh + bb * D) + lane;
            const LAS f32x4* sc = (const LAS f32x4*)(tsc + bb * D) + lane;
            {
                float mx = 0.f;
#pragma unroll
                for (int j = 0; j < 4; ++j) { const f32x4 a = sh[64 * j], b = sc[64 * j];
                    v[q][j] = (v[q][j] * rstd) * b + a;
                    mx = fmaxf(mx, fmaxf(fmaxf(fabsf(v[q][j].x), fabsf(v[q][j].y)), fmaxf(fabsf(v[q][j].z), fabsf(v[q][j].w)))); }
#pragma unroll
                for (int o = 1; o < 64; o <<= 1) mx = fmaxf(mx, shfl_xor_l(mx, o, lane));
                const float inv = mx > 0.f ? 127.0f / mx : 0.f;
                unsigned* o8 = (unsigned*)(P.ws + WS_H + (size_t)r * D) + lane;
#pragma unroll
                for (int j = 0; j < 4; ++j) o8[64 * j] = q8x4(v[q][j].x, v[q][j].y, v[q][j].z, v[q][j].w, inv);
                if (lane == 0) ((float*)(P.ws + WS_SA))[r] = mx * (1.0f / 127.0f); } }
        if (MODE == 2) { LAS int* rec = recs + (F.wave * 24 + 2 * it) * 8;
            route_row(P, rr[0], v[0], lane, true, lcnt, rec, rwl); __builtin_amdgcn_sched_barrier(0);
            if (lane == 0 && rr[1] == rr[0]) rec[8] = -1;
            route_row(P, rr[1], v[1], lane, rr[1] != rr[0], lcnt, rec + 8, rwl); }
    }
    if (MODE == 2) {
        __syncthreads();
        const int tid = F.wave * 64 + lane;
        if (tid < 16) { const unsigned c = lcnt[tid]; gbase[tid] = c ? atomicAdd((unsigned*)(P.ws + WS_CTL) + CW_CNT + 1024 * l + 64 * tid, c) : 0u; }
        __syncthreads();
        if (lane == 0) for (int k = 0; k < 2 * it; ++k) { const LAS int* rec = recs + (F.wave * 24 + k) * 8; const int r = rec[0]; if (r < 0) continue;
            int* tokl = (int*)(P.ws + WS_TOKL); float* wl = (float*)(P.ws + WS_WL);
            const size_t i0 = (size_t)rec[1] * R + rec[2] + gbase[rec[1]], i1 = (size_t)rec[3] * R + rec[4] + gbase[rec[3]];
            tokl[i0] = 2 * r; wl[i0] = __int_as_float(rec[5]); tokl[i1] = 2 * r + 1; wl[i1] = __int_as_float(rec[6]); }
        __syncthreads();
    }
}
__device__ __forceinline__ void ph_norm2(const Frame& F, const Ptrs& P, int l, int nrows) {
    constexpr int AP = 2064, A_H = 8192, A_L = A_H + 16 * AP, PART = A_L + 16 * AP, LG = PART + 8192;
    const int lane = fresh_lane();
    LAS unsigned* lcnt = (LAS unsigned*)F.lds; LAS unsigned* gbase = lcnt + 16; LAS int* recs = (LAS int*)(F.lds + 256);
    if (F.wave == 0 && lane < 16) lcnt[lane] = 0u;
    bf16x8 bh[4], bl[4];
    { const float* rw = P.router_w + (size_t)(128 * F.wave + 8 * (lane >> 4)) * 16 + (lane & 15);
#pragma unroll
      for (int s = 0; s < 4; ++s) { float w[8];
#pragma unroll
          for (int j = 0; j < 8; ++j) w[j] = rw[(size_t)(32 * s + j) * 16];
          u32x4 h, lo; h.x = cvtpk(w[0], w[1]); h.y = cvtpk(w[2], w[3]); h.z = cvtpk(w[4], w[5]); h.w = cvtpk(w[6], w[7]);
          lo.x = cvtpk(w[0] - lo16(h.x), w[1] - hi16(h.x)); lo.y = cvtpk(w[2] - lo16(h.y), w[3] - hi16(h.y)); lo.z = cvtpk(w[4] - lo16(h.z), w[5] - hi16(h.z)); lo.w = cvtpk(w[6] - lo16(h.w), w[7] - hi16(h.w));
          bh[s] = __builtin_bit_cast(bf16x8, h); bl[s] = __builtin_bit_cast(bf16x8, lo); } }
    __syncthreads();
    const int ntiles = nrows >> 4;
    f32x4 v[2][4];
#define N2_LOAD(tile_) do { _Pragma("unroll") for (int q_ = 0; q_ < 2; ++q_) { const bf16_t* xr_ = x1b_row(P, (tile_) * 16 + 2 * F.wave + q_) + 4 * lane; \
        _Pragma("unroll") for (int j_ = 0; j_ < 4; ++j_) v[q_][j_] = ld4b(xr_ + 256 * j_); } } while (0)
#define N2_BAR() do { LDS_WAIT(); __builtin_amdgcn_s_barrier(); asm volatile("" ::: "memory"); } while (0)
    int tile = F.vcu, it = 0;
    if (tile < ntiles) N2_LOAD(tile);
    for (; tile < ntiles; tile += F.G, ++it) {
        const int rbase = tile * 16 + 2 * F.wave;
        float ss[2];
#pragma unroll
        for (int q = 0; q < 2; ++q) { ss[q] = 0.f;
#pragma unroll
            for (int j = 0; j < 4; ++j) ss[q] += (v[q][j].x * v[q][j].x + v[q][j].y * v[q][j].y) + (v[q][j].z * v[q][j].z + v[q][j].w * v[q][j].w); }
#pragma unroll
        for (int o = 1; o < 64; o <<= 1) { ss[0] += shfl_xor_l(ss[0], o, lane); ss[1] += shfl_xor_l(ss[1], o, lane); }
        f32x4 msh[4], msc[4];
        { const int bb = row_bb(rbase); const f32x4* sh = (const f32x4*)mod_vec(P, l, bb, 3) + lane; const f32x4* sc = (const f32x4*)mod_vec(P, l, bb, 4) + lane;
#pragma unroll
          for (int j = 0; j < 4; ++j) { msh[j] = sh[64 * j]; msc[j] = sc[64 * j]; } }
#pragma unroll
        for (int q = 0; q < 2; ++q) { const int r = rbase + q;
            const float rstd = 1.0f / sqrtf(ss[q] * (1.0f / D) + EPS);
            float mx = 0.f;
#pragma unroll
            for (int j = 0; j < 4; ++j) { const f32x4 a = msh[j], b = msc[j];
                v[q][j] = (v[q][j] * rstd) * b + a;
                mx = fmaxf(mx, fmaxf(fmaxf(fabsf(v[q][j].x), fabsf(v[q][j].y)), fmaxf(fabsf(v[q][j].z), fabsf(v[q][j].w)))); }
#pragma unroll
            for (int o = 1; o < 64; o <<= 1) mx = fmaxf(mx, shfl_xor_l(mx, o, lane));
            const float inv = mx > 0.f ? 127.0f / mx : 0.f;
            unsigned* o8 = (unsigned*)(P.ws + WS_H + (size_t)r * D) + lane;
            LAS unsigned char* ah = F.lds + A_H + (2 * F.wave + q) * AP + 8 * lane;
#pragma unroll
            for (int j = 0; j < 4; ++j) { const f32x4 x = v[q][j]; o8[64 * j] = q8x4(x.x, x.y, x.z, x.w, inv);
                u32x2 h, lo; h.x = cvtpk(x.x, x.y); h.y = cvtpk(x.z, x.w); lo.x = cvtpk(x.x - lo16(h.x), x.y - hi16(h.x)); lo.y = cvtpk(x.z - lo16(h.y), x.w - hi16(h.y));
                *(LAS u32x2*)(ah + 512 * j) = h; *(LAS u32x2*)(ah + (A_L - A_H) + 512 * j) = lo; }
            if (lane == 0) ((float*)(P.ws + WS_SA))[r] = mx * (1.0f / 127.0f); }
        { const int tn = tile + F.G; if (tn < ntiles) N2_LOAD(tn); }
        N2_BAR();
        f32x4 acc = (f32x4){0.f, 0.f, 0.f, 0.f};
        { const LAS unsigned char* ap = F.lds + A_H + (lane & 15) * AP + (128 * F.wave + 8 * (lane >> 4)) * 2;
#pragma unroll
          for (int s = 0; s < 4; ++s) { const bf16x8 xh = *(const LAS bf16x8*)(ap + 64 * s), xl = *(const LAS bf16x8*)(ap + (A_L - A_H) + 64 * s);
              acc = __builtin_amdgcn_mfma_f32_16x16x32_bf16(xh, bh[s], acc, 0, 0, 0); acc = __builtin_amdgcn_mfma_f32_16x16x32_bf16(xl, bh[s], acc, 0, 0, 0); acc = __builtin_amdgcn_mfma_f32_16x16x32_bf16(xh, bl[s], acc, 0, 0, 0); } }
        *(LAS f32x4*)(F.lds + PART + F.wave * 1024 + lane * 16) = acc;
        N2_BAR();
        if (F.wave < 4) { const int t = F.wave * 64 + lane, i = t >> 4, j = t & 15; const LAS float* sp = (const LAS float*)(F.lds + PART) + ((i >> 2) * 16 + j) * 4 + (i & 3); float sum = 0.f;
#pragma unroll
            for (int w = 0; w < 8; ++w) sum += sp[w * 256];
            ((LAS float*)(F.lds + LG))[t] = sum; }
        N2_BAR();
        { const int ri = 2 * F.wave + (lane >> 5), r = tile * 16 + ri;
          f32x4 L[4];
#pragma unroll
          for (int g = 0; g < 4; ++g) L[g] = *(const LAS f32x4*)(F.lds + LG + ri * 64 + 16 * g);
          float bestscore = -INFINITY; int be0 = 0, be1 = 1; float ba0 = 0.f, ba1 = 0.f;
#pragma unroll
          for (int g = 0; g < 4; ++g) {
              float aff[4], sel[4];
#pragma unroll
              for (int i = 0; i < 4; ++i) { const float t = L[g][i]; aff[i] = __builtin_amdgcn_rcpf(1.0f + __builtin_amdgcn_exp2f(-1.4426950408889634f * t)); sel[i] = aff[i] + P.router_bias[4 * g + i]; }
              int i1 = 0; float m1 = sel[0], a1 = aff[0];
#pragma unroll
              for (int i = 1; i < 4; ++i) if (sel[i] > m1) { m1 = sel[i]; a1 = aff[i]; i1 = i; }
              int i2 = -1; float m2 = -INFINITY, a2 = 0.f;
#pragma unroll
              for (int i = 0; i < 4; ++i) if (i != i1 && sel[i] > m2) { m2 = sel[i]; a2 = aff[i]; i2 = i; }
              const float score = m1 + m2;
              if (score > bestscore) { bestscore = score; be0 = 4 * g + i1; be1 = 4 * g + i2; ba0 = a1; ba1 = a2; }
          }
          if ((lane & 31) == 0) {
              const int p0 = (int)__hip_atomic_fetch_add(lcnt + be0, 1u, __ATOMIC_RELAXED, __HIP_MEMORY_SCOPE_WORKGROUP), p1 = (int)__hip_atomic_fetch_add(lcnt + be1, 1u, __ATOMIC_RELAXED, __HIP_MEMORY_SCOPE_WORKGROUP);
              const float inv = 1.0f / (ba0 + ba1); LAS int* rec = recs + (it * 16 + ri) * 8;
              rec[0] = r; rec[1] = be0; rec[2] = p0; rec[3] = be1; rec[4] = p1; rec[5] = __float_as_int(ba0 * inv); rec[6] = __float_as_int(ba1 * inv); } }
    }
#undef N2_LOAD
#undef N2_BAR
    __syncthreads();
    const int tid = F.wave * 64 + lane;
    if (tid < 16) { const unsigned c = lcnt[tid]; gbase[tid] = c ? atomicAdd((unsigned*)(P.ws + WS_CTL) + CW_CNT + 1024 * l + 64 * tid, c) : 0u; }
    __syncthreads();
    for (int k = tid; k < it * 16; k += NWAVES * 64) { const LAS int* rec = recs + k * 8; const int r = rec[0];
        int* tokl = (int*)(P.ws + WS_TOKL); float* wl = (float*)(P.ws + WS_WL);
        const size_t i0 = (size_t)rec[1] * R + rec[2] + gbase[rec[1]], i1 = (size_t)rec[3] * R + rec[4] + gbase[rec[3]];
        tokl[i0] = 2 * r; wl[i0] = __int_as_float(rec[5]); tokl[i1] = 2 * r + 1; wl[i1] = __int_as_float(rec[6]); }
    __syncthreads();
}
__device__ __forceinline__ void ph_kprep(const Frame& F, const Ptrs& P, int l) {
    const int lane = fresh_lane();
    const float* rc = (const float*)(P.ws + WS_ROPE); const float* rs = rc + 1024;
    const int hs = (lane >> 3) & 3, chunk = lane & 7, col = (hs < 2 ? C_KB + hs * 64 : C_KW + (hs - 2) * 64) + chunk * 8;
    const f32x4 g0 = *(const f32x4*)(P.k_gain + l * 64 + chunk * 8), g1 = *(const f32x4*)(P.k_gain + l * 64 + chunk * 8 + 4);
    const int a = chunk >> 2, fi = (chunk & 1) * 8; const bool second = (chunk & 2) != 0;
    const int npair = R / 2, stride = F.G * NWAVES;
    float km = 0.f;
    for (int pr0 = F.vcu * NWAVES + F.wave; pr0 < npair; pr0 += 4 * stride) {
        u32x4 w[4];
#pragma unroll
        for (int q = 0; q < 4; ++q) { const int pr = pr0 + q * stride; const int r = 2 * (pr < npair ? pr : pr0) + (lane >> 5); w[q] = *(const u32x4*)((const bf16_t*)(P.ws + WS_U) + (size_t)r * NIN + col); }
#pragma unroll
        for (int q = 0; q < 4; ++q) { const int pr = pr0 + q * stride; if (pr >= npair) break;
            const int r = 2 * pr + (lane >> 5);
            float x[8] = {lo16(w[q].x), hi16(w[q].x), lo16(w[q].y), hi16(w[q].y), lo16(w[q].z), hi16(w[q].z), lo16(w[q].w), hi16(w[q].w)};
            float ss = 0.f;
#pragma unroll
            for (int j = 0; j < 8; ++j) ss += x[j] * x[j];
            ss += shfl_xor_l(ss, 1, lane); ss += shfl_xor_l(ss, 2, lane); ss += shfl_xor_l(ss, 4, lane);
            if (hs >= 2) km = fmaxf(km, ss);
            if (hs < 2) {
                const float rstd = 1.0f / sqrtf(ss * (1.0f / 64.0f) + EPS);
                x[0] *= rstd * g0.x; x[1] *= rstd * g0.y; x[2] *= rstd * g0.z; x[3] *= rstd * g0.w; x[4] *= rstd * g1.x; x[5] *= rstd * g1.y; x[6] *= rstd * g1.z; x[7] *= rstd * g1.w; }
            if (r < RL) { const int t = r & (T - 1), pos = a ? (t & 63) : (t >> 6);
                const f32x4 c0 = *(const f32x4*)(rc + pos * 16 + fi), c1 = *(const f32x4*)(rc + pos * 16 + fi + 4), s0 = *(const f32x4*)(rs + pos * 16 + fi), s1 = *(const f32x4*)(rs + pos * 16 + fi + 4);
                const float cs[8] = {c0.x, c0.y, c0.z, c0.w, c1.x, c1.y, c1.z, c1.w}, sn[8] = {s0.x, s0.y, s0.z, s0.w, s1.x, s1.y, s1.z, s1.w};
#pragma unroll
                for (int j = 0; j < 8; ++j) { const float y = shfl_xor_l(x[j], 2, lane); x[j] = second ? x[j] * cs[j] + y * sn[j] : x[j] * cs[j] - y * sn[j]; } }
            u32x4 o; o.x = cvtpk(x[0], x[1]); o.y = cvtpk(x[2], x[3]); o.z = cvtpk(x[4], x[5]); o.w = cvtpk(x[6], x[7]);
            *(u32x4*)((bf16_t*)(P.ws + WS_U) + (size_t)r * NIN + col) = o; }
    }
    float qm = 0.f;
    for (int r0 = F.vcu * NWAVES + F.wave; r0 < RL; r0 += 8 * stride) {
        u32x4 w[8];
#pragma unroll
        for (int q = 0; q < 8; ++q) { const int r = r0 + q * stride < RL ? r0 + q * stride : r0; w[q] = *(const u32x4*)((const bf16_t*)(P.ws + WS_U) + (size_t)r * NIN + C_QW + lane * 8); }
#pragma unroll
        for (int q = 0; q < 8; ++q) { float ss = lo16(w[q].x) * lo16(w[q].x) + hi16(w[q].x) * hi16(w[q].x) + lo16(w[q].y) * lo16(w[q].y) + hi16(w[q].y) * hi16(w[q].y)
                                              + lo16(w[q].z) * lo16(w[q].z) + hi16(w[q].z) * hi16(w[q].z) + lo16(w[q].w) * lo16(w[q].w) + hi16(w[q].w) * hi16(w[q].w);
            ss += shfl_xor_l(ss, 1, lane); ss += shfl_xor_l(ss, 2, lane); ss += shfl_xor_l(ss, 4, lane); qm = fmaxf(qm, ss); }
    }
    qm = fmaxf(qm, shfl_xor_l(qm, 8, lane)); qm = fmaxf(qm, shfl_xor_l(qm, 16, lane));
    km = fmaxf(km, shfl_xor_l(km, 32, lane));
    LAS float* red = (LAS float*)F.lds;
    if (lane == 0) red[F.wave * 4] = qm; if (lane == 32) red[F.wave * 4 + 1] = qm; if (lane == 16) red[F.wave * 4 + 2] = km; if (lane == 24) red[F.wave * 4 + 3] = km;
    __syncthreads();
    if (F.wave == 0 && lane < 4) { float m = red[lane];
#pragma unroll
        for (int wv = 1; wv < 8; ++wv) m = fmaxf(m, red[wv * 4 + lane]);
        atomicMax((unsigned*)(P.ws + WS_CTL) + CW_QK + 64 * l + 16 * lane, __float_as_uint(m)); }
    __syncthreads();
}
__device__ __forceinline__ float pool_ch(const u32x2& w, int c) { const unsigned x = w[c >> 1]; return (c & 1) ? hi16(x) : lo16(x); }
template <int HW> __device__ __forceinline__ void pool_block(const u32x2 (&w)[32], int t0, int Ts, bf16_t* outp) {
    float S[4];
#pragma unroll
    for (int c = 0; c < 4; ++c) { S[c] = 0.f;
#pragma unroll
        for (int k = 8 - HW; k < 8 + HW; ++k) S[c] += pool_ch(w[k], c); }
#pragma unroll
    for (int j = 0; j < 16; ++j) {
        const int t = t0 + j, lo = t - HW < 0 ? 0 : t - HW, hi = t + HW > Ts ? Ts : t + HW; const float inv = 1.0f / (float)(hi - lo);
        float o[4];
#pragma unroll
        for (int c = 0; c < 4; ++c) o[c] = S[c] * inv - pool_ch(w[j + 8], c);
        u32x2 ow; ow.x = cvtpk(o[0], o[1]); ow.y = cvtpk(o[2], o[3]);
        *(u32x2*)(outp + (size_t)j * NBR) = ow;
        if (j < 15) {
#pragma unroll
            for (int c = 0; c < 4; ++c) S[c] += pool_ch(w[j + 8 + HW], c) - pool_ch(w[j + 8 - HW], c); }
    }
}
__device__ __forceinline__ void ph_pool(const Frame& F, const Ptrs& P, int nrows) {
    const int tid0 = fresh_tid();
    const int nblk = nrows >> 4, nit = nblk * 128;
    for (int i = F.vcu * 512 + tid0; i < nit; i += F.G * 512) {
        const int g = __builtin_amdgcn_readfirstlane((i >> 5) / nblk), blk = (i >> 5) - g * nblk, c4 = g * 128 + (i & 31) * 4;
        const int rb = blk * 16; const bool lat = rb < RL; const int Ts = lat ? T : TC; const int t0 = lat ? (rb & (T - 1)) : ((rb - RL) & (TC - 1)); const int r0 = rb - t0;
        const bf16_t* U = (const bf16_t*)(P.ws + WS_U) + C_P + c4;
        u32x2 w[32];
#pragma unroll
        for (int k = 0; k < 32; ++k) { const int tt = t0 - 8 + k; const bool ok = tt >= 0 && tt < Ts; w[k] = *(const u32x2*)(U + (size_t)(r0 + (ok ? tt : t0)) * NIN); }
#pragma unroll
        for (int k = 0; k < 32; ++k) { const int tt = t0 - 8 + k; if (!(tt >= 0 && tt < Ts)) w[k] = (u32x2){0u, 0u}; }
        bf16_t* outp = (bf16_t*)(P.ws + WS_BR) + (size_t)rb * NBR + 1536 + c4;
        if (g == 0) pool_block<1>(w, t0, Ts, outp); else if (g == 1) pool_block<2>(w, t0, Ts, outp); else if (g == 2) pool_block<4>(w, t0, Ts, outp); else pool_block<8>(w, t0, Ts, outp);
    }
}
__device__ __forceinline__ void ph_final(const Frame& F, const Ptrs& P, const int r_lo, const int RLh) {
    const int lane = fresh_lane(); const int stride = F.G * NWAVES;
    LAS float* tg2 = (LAS float*)F.lds;
    { const int tid = F.wave * 64 + lane;
      for (int i = tid; i < 9 * 256; i += NWAVES * 64) ((LAS f32x4*)tg2)[i] = ((const f32x4*)mod_vec(P, 1, i >> 8, 5))[i & 255];
      __syncthreads(); }
    f32x4 gnr[4];
#pragma unroll
    for (int j = 0; j < 4; ++j) gnr[j] = ((const f32x4*)P.norm_f + lane)[64 * j];
    for (int rb = r_lo + F.vcu * NWAVES + F.wave; rb < RLh; rb += 4 * stride) {
        f32x4 v[4][4]; float ss[4];
#pragma unroll
        for (int q = 0; q < 4; ++q) { const int r = rb + q * stride < RLh ? rb + q * stride : rb; const int bb = row_bb(r);
            const bf16_t* xr = x1b_row(P, r) + 4 * lane; const LAS f32x4* g2 = (const LAS f32x4*)(tg2 + bb * D) + lane;
            const u32x2* m0 = (const u32x2*)((const bf16_t*)(P.ws + WS_MO) + (size_t)r * D) + lane; const u32x2* m1 = (const u32x2*)((const bf16_t*)(P.ws + WS_MO) + (size_t)(R + r) * D) + lane;
            ss[q] = 0.f;
#pragma unroll
            for (int j = 0; j < 4; ++j) { v[q][j] = ld4b(xr + 256 * j); const u32x2 a = m0[64 * j], b = m1[64 * j]; const f32x4 g = g2[64 * j];
                v[q][j].x += g.x * (lo16(a.x) + lo16(b.x)); v[q][j].y += g.y * (hi16(a.x) + hi16(b.x)); v[q][j].z += g.z * (lo16(a.y) + lo16(b.y)); v[q][j].w += g.w * (hi16(a.y) + hi16(b.y));
                ss[q] += (v[q][j].x * v[q][j].x + v[q][j].y * v[q][j].y) + (v[q][j].z * v[q][j].z + v[q][j].w * v[q][j].w); } }
#pragma unroll
        for (int o = 1; o < 64; o <<= 1) {
#pragma unroll
            for (int q = 0; q < 4; ++q) ss[q] += shfl_xor_l(ss[q], o, lane); }
#pragma unroll
        for (int q = 0; q < 4; ++q) { const int r = rb + q * stride; if (r >= RLh) continue;
            const float rstd = 1.0f / sqrtf(ss[q] * (1.0f / D) + EPS); f32x4* xr = (f32x4*)(P.out + (size_t)r * D) + lane;
#pragma unroll
            for (int j = 0; j < 4; ++j) xr[64 * j] = v[q][j] * rstd * gnr[j]; }
    }
}

typedef float f32x16 __attribute__((ext_vector_type(16)));
typedef short v4i16_t __attribute__((ext_vector_type(4)));
constexpr float ATT_THR = 4.0f;
constexpr int AT_ROWB = 144, AT_TILEB = 64 * AT_ROWB;
constexpr int AT_VROWB = 192, AT_VTILEB = 64 * AT_VROWB;
constexpr int AT_STAGEB = 2 * AT_TILEB + 2 * AT_VTILEB;
#define AT_SB() __builtin_amdgcn_sched_barrier(0)
template <bool FIXED> __device__ __forceinline__ void at_qk1(const LAS unsigned char* Kt, int kf_off, const bf16x8 (&qr)[4], const f32x16& negm_, f32x16& p0, f32x16& p1) {
    f32x16 zc;
#pragma unroll
    for (int r = 0; r < 16; ++r) zc[r] = 0.f;
    const f32x16& negm = FIXED ? zc : negm_;
    bf16x8 ka[8];
#pragma unroll
    for (int d0 = 0; d0 < 4; ++d0) { ka[2 * d0] = *(const LAS bf16x8*)(Kt + kf_off + d0 * 32); ka[2 * d0 + 1] = *(const LAS bf16x8*)(Kt + kf_off + 32 * AT_ROWB + d0 * 32); }
    p0 = __builtin_amdgcn_mfma_f32_32x32x16_bf16(ka[0], qr[0], negm, 0, 0, 0); p1 = __builtin_amdgcn_mfma_f32_32x32x16_bf16(ka[1], qr[0], negm, 0, 0, 0);
#pragma unroll
    for (int d0 = 1; d0 < 4; ++d0) { p0 = __builtin_amdgcn_mfma_f32_32x32x16_bf16(ka[2 * d0], qr[d0], p0, 0, 0, 0); p1 = __builtin_amdgcn_mfma_f32_32x32x16_bf16(ka[2 * d0 + 1], qr[d0], p1, 0, 0, 0); }
}
__device__ __forceinline__ void at_vread(const LAS unsigned char* vp, v4i16_t (&f)[4]) {
    f[0] = __builtin_amdgcn_ds_read_tr16_b64_v4i16((LAS v4i16_t*)(vp)); f[1] = __builtin_amdgcn_ds_read_tr16_b64_v4i16((LAS v4i16_t*)(vp + 8 * AT_VROWB));
    f[2] = __builtin_amdgcn_ds_read_tr16_b64_v4i16((LAS v4i16_t*)(vp + 64)); f[3] = __builtin_amdgcn_ds_read_tr16_b64_v4i16((LAS v4i16_t*)(vp + 8 * AT_VROWB + 64));
}
__device__ __forceinline__ bf16x8 at_ppack(const f32x16& p, int sx) { u32x4 pw; pw.x = cvtpk(p[8 * sx], p[8 * sx + 1]); pw.y = cvtpk(p[8 * sx + 2], p[8 * sx + 3]); pw.z = cvtpk(p[8 * sx + 4], p[8 * sx + 5]); pw.w = cvtpk(p[8 * sx + 6], p[8 * sx + 7]); return __builtin_bit_cast(bf16x8, pw); }
__device__ __forceinline__ void at_pvmm(const v4i16_t (&f)[4], const bf16x8 pf, f32x16& o0, f32x16& o1) {
    const bf16x8 v0 = (bf16x8){f[0][0], f[0][1], f[0][2], f[0][3], f[1][0], f[1][1], f[1][2], f[1][3]}, v1 = (bf16x8){f[2][0], f[2][1], f[2][2], f[2][3], f[3][0], f[3][1], f[3][2], f[3][3]};
    o0 = __builtin_amdgcn_mfma_f32_32x32x16_bf16(v0, pf, o0, 0, 0, 0); o1 = __builtin_amdgcn_mfma_f32_32x32x16_bf16(v1, pf, o1, 0, 0, 0);
}
__device__ __forceinline__ float at_exp8(f32x16& p, int sx) { float rs = 0.f;
#pragma unroll
    for (int j = 0; j < 8; ++j) { p[8 * sx + j] = __builtin_amdgcn_exp2f(p[8 * sx + j]); rs += p[8 * sx + j]; }
    return rs; }
template <bool FIXED> __device__ __forceinline__ float at_slot(const LAS unsigned char* Vt, const LAS unsigned char* Kn, const bool hasnext, int kf_off, int vf_off, const bf16x8 (&qr)[4], const f32x16& negm_,
                                         f32x16& pc0, f32x16& pc1, f32x16& pn0, f32x16& pn1, f32x16& o0, f32x16& o1) {
    f32x16 zc;
#pragma unroll
    for (int r = 0; r < 16; ++r) zc[r] = 0.f;
    const f32x16& negm = FIXED ? zc : negm_;
    v4i16_t fA[4], fB[4]; bf16x8 ka0, ka1, kb0, kb1; float rs;
#define AT_KLD(A0, A1, d0) do { A0 = *(const LAS bf16x8*)(Kn + kf_off + (d0) * 32); A1 = *(const LAS bf16x8*)(Kn + kf_off + 32 * AT_ROWB + (d0) * 32); } while (0)
    if (FIXED) AT_KLD(ka0, ka1, 0);
    at_vread(Vt + vf_off, fA); rs = at_exp8(pc0, 0); AT_SB();
    at_vread(Vt + vf_off + 16 * AT_VROWB, fB); if (FIXED) AT_KLD(kb0, kb1, 1); else AT_KLD(ka0, ka1, 0);
    if (hasnext) { pn0 = __builtin_amdgcn_mfma_f32_32x32x16_bf16(ka0, qr[0], negm, 0, 0, 0); pn1 = __builtin_amdgcn_mfma_f32_32x32x16_bf16(ka1, qr[0], negm, 0, 0, 0); }
    at_pvmm(fA, at_ppack(pc0, 0), o0, o1); rs += at_exp8(pc0, 1); AT_SB();
    at_vread(Vt + vf_off + 32 * AT_VROWB, fA); if (FIXED) AT_KLD(ka0, ka1, 2); else AT_KLD(kb0, kb1, 1);
    if (hasnext) { pn0 = __builtin_amdgcn_mfma_f32_32x32x16_bf16(kb0, qr[1], pn0, 0, 0, 0); pn1 = __builtin_amdgcn_mfma_f32_32x32x16_bf16(kb1, qr[1], pn1, 0, 0, 0); }
    at_pvmm(fB, at_ppack(pc0, 1), o0, o1); rs += at_exp8(pc1, 0); AT_SB();
    at_vread(Vt + vf_off + 48 * AT_VROWB, fB); if (FIXED) AT_KLD(kb0, kb1, 3); else AT_KLD(ka0, ka1, 2);
    if (hasnext) { pn0 = __builtin_amdgcn_mfma_f32_32x32x16_bf16(ka0, qr[2], pn0, 0, 0, 0); pn1 = __builtin_amdgcn_mfma_f32_32x32x16_bf16(ka1, qr[2], pn1, 0, 0, 0); }
    at_pvmm(fA, at_ppack(pc1, 0), o0, o1); rs += at_exp8(pc1, 1); AT_SB();
    if (!FIXED) AT_KLD(kb0, kb1, 3);
    if (hasnext) { pn0 = __builtin_amdgcn_mfma_f32_32x32x16_bf16(kb0, qr[3], pn0, 0, 0, 0); pn1 = __builtin_amdgcn_mfma_f32_32x32x16_bf16(kb1, qr[3], pn1, 0, 0, 0); }
    at_pvmm(fB, at_ppack(pc1, 1), o0, o1);
#undef AT_KLD
    return rs;
}
template <int MODE, bool FIXED> __device__ __forceinline__ void ph_attn_impl(const Frame& F, const Ptrs& P, int l) {
    const bool latq = MODE < 2; const bool winm = (MODE == 1 || MODE == 3);
    const int NU = latq ? 1024 : 64;
    LAS unsigned char* Lb = F.lds;
    constexpr bool fixedref = FIXED;
    for (int u = F.vcu; u < NU; u += F.G) {
        const int lane = fresh_lane(), tid = F.wave * 64 + lane, r32 = lane & 31, hi = lane >> 5;
        const bf16_t* U = (const bf16_t*)(P.ws + WS_U);
        const int st_off = (tid >> 3) * AT_ROWB + (tid & 7) * 16;
        const int kf_off = r32 * AT_ROWB + hi * 16;
        const int sv_off = (tid >> 3) * AT_VROWB + (tid & 7) * 16;
        const int vf_off = (4 * hi + ((lane & 15) >> 2)) * AT_VROWB + (((lane >> 4) & 1) * 16 + (lane & 3) * 4) * 2;
        const int qb = latq ? (u & 63) : (u & 3), g = latq ? ((u >> 6) & 1) : ((u >> 2) & 1), b = latq ? (u >> 7) : (u >> 3);
        const int tq0 = qb * 64, hq = 4 * g + (F.wave >> 1), tq = tq0 + 32 * (F.wave & 1) + r32;
        const int qrow = latq ? b * T + tq : RL + b * TC + tq;
        const int qcol = (winm ? C_QW : C_QB) + hq * 64, kcol = (winm ? C_KW : C_KB) + g * 64, vcol = (winm ? C_VW : C_VB) + g * 64;
        int lt_lo = 0, lt_hi = 0;
        if (MODE == 0) { lt_lo = 0; lt_hi = T / 64; }
        if (MODE == 1) { lt_lo = (tq0 - 128 < 0 ? 0 : tq0 - 128) / 64; lt_hi = (tq0 + 192 > T ? T : tq0 + 192) / 64; }
        const int ntiles = 4 + (lt_hi - lt_lo), npairs = (ntiles + 1) >> 1;
        bf16x8 qr[4];
        {
            float x[4][8];
#pragma unroll
            for (int d0 = 0; d0 < 4; ++d0) { const u32x4 wq = *(const u32x4*)(U + (size_t)qrow * NIN + qcol + d0 * 16 + hi * 8);
                x[d0][0] = lo16(wq.x); x[d0][1] = hi16(wq.x); x[d0][2] = lo16(wq.y); x[d0][3] = hi16(wq.y); x[d0][4] = lo16(wq.z); x[d0][5] = hi16(wq.z); x[d0][6] = lo16(wq.w); x[d0][7] = hi16(wq.w); }
            if (!winm) { float ss = 0.f;
#pragma unroll
                for (int d0 = 0; d0 < 4; ++d0)
#pragma unroll
                    for (int j = 0; j < 8; ++j) ss += x[d0][j] * x[d0][j];
                ss += shfl_xor_l(ss, 32, lane);
                const float rstd = 1.0f / sqrtf(ss * (1.0f / 64.0f) + EPS);
#pragma unroll
                for (int d0 = 0; d0 < 4; ++d0) { const f32x4 ga = *(const f32x4*)(P.q_gain + l * 64 + d0 * 16 + hi * 8), gb = *(const f32x4*)(P.q_gain + l * 64 + d0 * 16 + hi * 8 + 4);
                    x[d0][0] *= rstd * ga.x; x[d0][1] *= rstd * ga.y; x[d0][2] *= rstd * ga.z; x[d0][3] *= rstd * ga.w; x[d0][4] *= rstd * gb.x; x[d0][5] *= rstd * gb.y; x[d0][6] *= rstd * gb.z; x[d0][7] *= rstd * gb.w; } }
            if (latq) { const float* rc = (const float*)(P.ws + WS_ROPE); const float* rs = rc + 1024;
#pragma unroll
                for (int a = 0; a < 2; ++a) { const int pos = a ? (tq & 63) : (tq >> 6);
                    const f32x4 c0 = *(const f32x4*)(rc + pos * 16 + hi * 8), c1 = *(const f32x4*)(rc + pos * 16 + hi * 8 + 4), s0 = *(const f32x4*)(rs + pos * 16 + hi * 8), s1 = *(const f32x4*)(rs + pos * 16 + hi * 8 + 4);
                    const float cs[8] = {c0.x, c0.y, c0.z, c0.w, c1.x, c1.y, c1.z, c1.w}, sn[8] = {s0.x, s0.y, s0.z, s0.w, s1.x, s1.y, s1.z, s1.w};
#pragma unroll
                    for (int j = 0; j < 8; ++j) { const float x1 = x[2 * a][j], x2 = x[2 * a + 1][j]; x[2 * a][j] = x1 * cs[j] - x2 * sn[j]; x[2 * a + 1][j] = x2 * cs[j] + x1 * sn[j]; } } }
#pragma unroll
            for (int d0 = 0; d0 < 4; ++d0) { u32x4 wq; wq.x = cvtpk(x[d0][0] * QSCALE, x[d0][1] * QSCALE); wq.y = cvtpk(x[d0][2] * QSCALE, x[d0][3] * QSCALE); wq.z = cvtpk(x[d0][4] * QSCALE, x[d0][5] * QSCALE); wq.w = cvtpk(x[d0][6] * QSCALE, x[d0][7] * QSCALE);
                qr[d0] = __builtin_bit_cast(bf16x8, wq); }
        }
        f32x16 o0, o1, negm;
#pragma unroll
        for (int r = 0; r < 16; ++r) { o0[r] = 0.f; o1[r] = 0.f; negm[r] = 0.f; }
        float mhat = 0.f, lsum = 0.f;
#define AT_KROW(ti) ((ti) < 4 ? RL + b * TC + (ti) * 64 : b * T + (lt_lo + (ti) - 4) * 64)
        u32x4 ka, va, kb2, vb2;
#define AT_LOADPAIR(pp) do { const int na_ = 2 * (pp), nb_ = (2 * (pp) + 1 < ntiles) ? 2 * (pp) + 1 : na_; \
            const int r0_ = AT_KROW(na_) + (tid >> 3), r1_ = AT_KROW(nb_) + (tid >> 3); const int co_ = (tid & 7) * 8; \
            ka = *(const u32x4*)(U + (size_t)r0_ * NIN + kcol + co_); va = *(const u32x4*)(U + (size_t)r0_ * NIN + vcol + co_); \
            kb2 = *(const u32x4*)(U + (size_t)r1_ * NIN + kcol + co_); vb2 = *(const u32x4*)(U + (size_t)r1_ * NIN + vcol + co_); } while (0)
#define AT_WRITEPAIR(off) do { *(LAS u32x4*)(Lb + (off) + st_off) = ka; *(LAS u32x4*)(Lb + (off) + AT_TILEB + st_off) = kb2; \
            *(LAS u32x4*)(Lb + (off) + 2 * AT_TILEB + sv_off) = va; *(LAS u32x4*)(Lb + (off) + 2 * AT_TILEB + AT_VTILEB + sv_off) = vb2; } while (0)
#define AT_MASK(ti, P0, P1) do { if (MODE == 1) { float ninf_ = -INFINITY; asm volatile("" : "+v"(ninf_));     \
            if ((ti) >= ntiles) { _Pragma("unroll") for (int r = 0; r < 16; ++r) { P0[r] = ninf_; P1[r] = ninf_; } } \
            else if ((ti) >= 4) { const int kb0_ = (lt_lo + (ti) - 4) * 64, qlo_ = tq0 + 32 * (F.wave & 1); \
                if (kb0_ + 63 - qlo_ > 128 || qlo_ + 31 - kb0_ > 128) { const int kp0_ = kb0_ + 4 * hi - tq; \
                    _Pragma("unroll") for (int r = 0; r < 16; ++r) { const int dl_ = kp0_ + (r & 3) + 8 * (r >> 2); \
                        if (dl_ > 128 || dl_ < -128) P0[r] = ninf_; if (dl_ + 32 > 128 || dl_ + 32 < -128) P1[r] = ninf_; } } } } } while (0)
#define AT_REF(first, P0, P1) do { if (!fixedref) { float mx_ = fmaxf(P0[0], P1[0]); \
            _Pragma("unroll") for (int r = 1; r < 16; ++r) mx_ = fmaxf(mx_, fmaxf(P0[r], P1[r])); \
            mx_ = fmaxf(mx_, shfl_xor_l(mx_, 32, lane)); \
            if ((first) || __any(mx_ > ATT_THR)) { const float dl_ = (first) ? mx_ : fmaxf(mx_, 0.f); mhat += dl_; \
                const float al_ = __builtin_amdgcn_exp2f(-dl_); lsum *= al_; \
                _Pragma("unroll") for (int r = 0; r < 16; ++r) { P0[r] -= dl_; P1[r] -= dl_; o0[r] *= al_; o1[r] *= al_; negm[r] = -mhat; } } } } while (0)
        AT_LOADPAIR(0); AT_WRITEPAIR(0);
        if (npairs > 1) { AT_LOADPAIR(1); AT_WRITEPAIR(AT_STAGEB); }
        if (npairs > 2) AT_LOADPAIR(2);
        __syncthreads();
        f32x16 pc0, pc1, pn0, pn1;
        at_qk1<FIXED>(Lb, kf_off, qr, negm, pc0, pc1);
        AT_REF(true, pc0, pc1);
#pragma unroll
        for (int r = 0; r < 16; ++r) { pn0[r] = 0.f; pn1[r] = 0.f; }
        int scur = 0, snxt = AT_STAGEB, swr = 2 * AT_STAGEB;
        for (int tp = 0; tp < npairs; ++tp) {
            if (tp + 2 < npairs) { AT_WRITEPAIR(swr); if (tp + 3 < npairs) AT_LOADPAIR(tp + 3); }
            lsum += at_slot<FIXED>(Lb + scur + 2 * AT_TILEB, Lb + scur + AT_TILEB, true, kf_off, vf_off, qr, negm, pc0, pc1, pn0, pn1, o0, o1);
            AT_MASK(2 * tp + 1, pn0, pn1);
            AT_REF(false, pn0, pn1);
            const bool more = tp + 1 < npairs;
            lsum += at_slot<FIXED>(Lb + scur + 2 * AT_TILEB + AT_VTILEB, Lb + snxt, more, kf_off, vf_off, qr, negm, pn0, pn1, pc0, pc1, o0, o1);
            if (more) { AT_MASK(2 * tp + 2, pc0, pc1); AT_REF(false, pc0, pc1); }
            __syncthreads();
            { const int t_ = scur; scur = snxt; snxt = swr; swr = t_; }
        }
#undef AT_KROW
#undef AT_LOADPAIR
#undef AT_WRITEPAIR
#undef AT_MASK
#undef AT_REF
        lsum += shfl_xor_l(lsum, 32, lane);
        if (winm) lsum += __builtin_amdgcn_exp2f(P.sink[l * 8 + hq] * LOG2E - mhat);
        const float inv = 1.0f / lsum;
        bf16_t* op = (bf16_t*)(P.ws + WS_BR) + (size_t)qrow * NBR + (winm ? 1024 : 512) + hq * 64 + 4 * hi;
#pragma unroll
        for (int gq = 0; gq < 4; ++gq) {
            u32x2 w0, w1; w0.x = cvtpk(o0[4 * gq] * inv, o0[4 * gq + 1] * inv); w0.y = cvtpk(o0[4 * gq + 2] * inv, o0[4 * gq + 3] * inv);
            w1.x = cvtpk(o1[4 * gq] * inv, o1[4 * gq + 1] * inv); w1.y = cvtpk(o1[4 * gq + 2] * inv, o1[4 * gq + 3] * inv);
            *(u32x2*)(op + 8 * gq) = w0; *(u32x2*)(op + 32 + 8 * gq) = w1; }
    }
}

template <int MODE> __device__ __forceinline__ void ph_attn(const Frame& F, const Ptrs& P, int l) {
    if (MODE == 3) { ph_attn_impl<MODE, false>(F, P, l); return; }
    const int lane = fresh_lane();
    if (MODE == 1) {
        const unsigned* qk = (const unsigned*)(P.ws + WS_CTL) + CW_QK + 64 * l;
        const float q2 = fmaxf(__uint_as_float(qk[0]), __uint_as_float(qk[16])), k2 = fmaxf(__uint_as_float(qk[32]), __uint_as_float(qk[48]));
        const float b2 = (QSCALE * 1.02f) * (QSCALE * 1.02f) * q2 * k2;
        if (__builtin_amdgcn_readfirstlane(b2 < 48.0f * 48.0f ? 1 : 0)) ph_attn_impl<MODE, true>(F, P, l); else ph_attn_impl<MODE, false>(F, P, l);
        return; }
    float mq = fabsf(P.q_gain[l * 64 + lane]), mk = fabsf(P.k_gain[l * 64 + lane]);
#pragma unroll
    for (int o = 1; o < 64; o <<= 1) { mq = fmaxf(mq, shfl_xor_l(mq, o, lane)); mk = fmaxf(mk, shfl_xor_l(mk, o, lane)); }
    const float sbound = 64.0f * QSCALE * 1.02f * mq * mk;
    if (__builtin_amdgcn_readfirstlane(sbound < 48.0f ? 1 : 0)) ph_attn_impl<MODE, true>(F, P, l); else ph_attn_impl<MODE, false>(F, P, l);
}

__device__ __forceinline__ void ph_ctx_r4(const Frame& F, const Ptrs& P) {
    const int tid0 = fresh_tid(); const float* ct = (const float*)(P.ws + WS_COS);
    for (int it = F.vcu * 512 + tid0; it < 8 * 64 * 64; it += F.G * 512) {
        const int c8 = (it & 63) * 8, t2 = (it >> 6) & 63, b = it >> 12;
        bf16_t* base = (bf16_t*)(P.ws + WS_U) + (size_t)(RL + b * TC + t2) * NIN + c8;
        u32x4 zr[4], zi[4];
#pragma unroll
        for (int t1 = 0; t1 < 4; ++t1) { zr[t1] = *(const u32x4*)(base + (size_t)(64 * t1) * NIN + C_ZR); zi[t1] = *(const u32x4*)(base + (size_t)(64 * t1) * NIN + C_ZI); }
        float tc[4], ts[4];
#pragma unroll
        for (int k1 = 0; k1 < 4; ++k1) { const int ang = (t2 * k1 * 16) & 4095; tc[k1] = ct[ang]; ts[k1] = ct[(ang - 1024) & 4095]; }
        u32x4 orr[4], oi[4];
#pragma unroll
        for (int w = 0; w < 4; ++w) {
            float xr[4][2], xi[4][2];
#pragma unroll
            for (int t1 = 0; t1 < 4; ++t1) { xr[t1][0] = lo16(zr[t1][w]); xr[t1][1] = hi16(zr[t1][w]); xi[t1][0] = lo16(zi[t1][w]); xi[t1][1] = hi16(zi[t1][w]); }
            float yr[4][2], yi[4][2];
#pragma unroll
            for (int e = 0; e < 2; ++e) {
                const float sr = xr[0][e] + xr[2][e], dr = xr[0][e] - xr[2][e], si = xi[0][e] + xi[2][e], di = xi[0][e] - xi[2][e];
                const float pr = xr[1][e] + xr[3][e], qr = xr[1][e] - xr[3][e], pi = xi[1][e] + xi[3][e], qi = xi[1][e] - xi[3][e];
                float ar[4], ai[4];
                ar[0] = sr + pr; ai[0] = si + pi;
                ar[1] = dr + qi; ai[1] = di - qr;
                ar[2] = sr - pr; ai[2] = si - pi;
                ar[3] = dr - qi; ai[3] = di + qr;
#pragma unroll
                for (int k1 = 0; k1 < 4; ++k1) { yr[k1][e] = ar[k1] * tc[k1] + ai[k1] * ts[k1]; yi[k1][e] = ai[k1] * tc[k1] - ar[k1] * ts[k1]; }
            }
#pragma unroll
            for (int k1 = 0; k1 < 4; ++k1) { orr[k1][w] = cvtpk(yr[k1][0], yr[k1][1]); oi[k1][w] = cvtpk(yi[k1][0], yi[k1][1]); }
        }
#pragma unroll
        for (int k1 = 0; k1 < 4; ++k1) { *(u32x4*)(base + (size_t)(64 * k1) * NIN + C_ZR) = orr[k1]; *(u32x4*)(base + (size_t)(64 * k1) * NIN + C_ZI) = oi[k1]; }
    }
}
constexpr int DF_ROWB = 528, DF_WROWB = 272;
template <int STAGE, bool CTX = false> __device__ __forceinline__ void ph_dft(const Frame& F, const Ptrs& P) {
    constexpr int NUN = CTX ? 64 : 1024;
    const int lane = fresh_lane(), tid = F.wave * 64 + lane, r32 = lane & 31, hi = lane >> 5, w = F.wave;
    bf16_t* U = (bf16_t*)(P.ws + WS_U); bf16_t* BR = (bf16_t*)(P.ws + WS_BR); const bf16_t* Wm = (const bf16_t*)(P.ws + WS_DFTM);
    LAS unsigned char* Xl = F.lds;
    LAS unsigned char* Wl = F.lds + 128 * DF_ROWB;
#pragma unroll
    for (int i = 0; i < 4; ++i) { const int idx = tid + 512 * i; *(LAS u32x4*)(Wl + (idx >> 4) * DF_WROWB + (idx & 15) * 16) = *(const u32x4*)(Wm + (idx >> 4) * 128 + (idx & 15) * 8); }
    const int xf_off = (8 * hi + ((lane & 15) >> 2)) * DF_ROWB + (32 * w + ((lane >> 4) & 1) * 16 + (lane & 3) * 4) * 2;
    constexpr int NMB = STAGE == 2 ? 4 : 2;
    const int seg = tid >> 2, part = tid & 3, pp = seg >> 6, jj = seg & 63;
    u32x4 pf[8];
    if (F.vcu < NUN) { const int u = F.vcu; const int chb = u & 1, sidx = CTX ? (u >> 1) & 3 : (u >> 1) & 63, b = CTX ? u >> 3 : u >> 7;
        const int grow = CTX ? RL + b * TC + 64 * sidx + jj : (STAGE == 2 ? b * T + 64 * jj + sidx : b * T + 64 * sidx + jj);
        const u32x4* src = (const u32x4*)(U + (size_t)grow * NIN + pp * 512 + chb * 256 + part * 64);
#pragma unroll
        for (int i = 0; i < 8; ++i) pf[i] = src[i]; }
    for (int u = F.vcu; u < NUN; u += F.G) {
        const int chb = u & 1, sidx = CTX ? (u >> 1) & 3 : (u >> 1) & 63, b = CTX ? u >> 3 : u >> 7;
#pragma unroll
        for (int i = 0; i < 8; ++i) *(LAS u32x4*)(Xl + seg * DF_ROWB + part * 128 + i * 16) = pf[i];
        if (u + F.G < NUN) { const int un = u + F.G; const int chbn = un & 1, sn = CTX ? (un >> 1) & 3 : (un >> 1) & 63, bn = CTX ? un >> 3 : un >> 7;
            const int grow = CTX ? RL + bn * TC + 64 * sn + jj : (STAGE == 2 ? bn * T + 64 * jj + sn : bn * T + 64 * sn + jj);
            const u32x4* src = (const u32x4*)(U + (size_t)grow * NIN + pp * 512 + chbn * 256 + part * 64);
#pragma unroll
            for (int i = 0; i < 8; ++i) pf[i] = src[i]; }
        __syncthreads();
        f32x16 acc[NMB];
#pragma unroll
        for (int mb = 0; mb < NMB; ++mb)
#pragma unroll
            for (int r = 0; r < 16; ++r) acc[mb][r] = 0.f;
#pragma unroll
        for (int ks = 0; ks < 8; ++ks) {
            const v4i16_t lo4 = __builtin_amdgcn_ds_read_tr16_b64_v4i16((LAS v4i16_t*)(Xl + xf_off + (16 * ks) * DF_ROWB));
            const v4i16_t hi4 = __builtin_amdgcn_ds_read_tr16_b64_v4i16((LAS v4i16_t*)(Xl + xf_off + (16 * ks + 4) * DF_ROWB));
            const bf16x8 xf = (bf16x8){lo4[0], lo4[1], lo4[2], lo4[3], hi4[0], hi4[1], hi4[2], hi4[3]};
#pragma unroll
            for (int mb = 0; mb < NMB; ++mb) { const bf16x8 wf = *(const LAS bf16x8*)(Wl + (mb * 32 + r32) * DF_WROWB + (16 * ks + 8 * hi) * 2);
                acc[mb] = __builtin_amdgcn_mfma_f32_32x32x16_bf16(xf, wf, acc[mb], 0, 0, 0); }
        }
        LAS unsigned char* ob = Xl + (32 * w + 4 * hi) * 2;
        if (STAGE == 2) {
#pragma unroll
            for (int mb = 0; mb < 2; ++mb) { const int k1 = mb * 32 + r32; const float rev = (float)((k1 * sidx) & 4095) * (1.0f / 4096.0f);
                const float ct = __builtin_amdgcn_cosf(rev), st = __builtin_amdgcn_sinf(rev);
#pragma unroll
                for (int gq = 0; gq < 4; ++gq) { u32x2 wr, wi; float yr[4], yi[4];
#pragma unroll
                    for (int i = 0; i < 4; ++i) { const float a = acc[mb][4 * gq + i], bq = acc[mb + 2][4 * gq + i]; yr[i] = a * ct + bq * st; yi[i] = bq * ct - a * st; }
                    wr.x = cvtpk(yr[0], yr[1]); wr.y = cvtpk(yr[2], yr[3]); wi.x = cvtpk(yi[0], yi[1]); wi.y = cvtpk(yi[2], yi[3]);
                    *(LAS u32x2*)(ob + k1 * DF_ROWB + 16 * gq) = wr; *(LAS u32x2*)(ob + (64 + k1) * DF_ROWB + 16 * gq) = wi; } }
        } else {
#pragma unroll
            for (int mb = 0; mb < 2; ++mb) { const int k2 = mb * 32 + r32;
#pragma unroll
                for (int gq = 0; gq < 4; ++gq) { constexpr float osc = CTX ? 0.0625f : 0.015625f; u32x2 wr; wr.x = cvtpk(acc[mb][4 * gq] * osc, acc[mb][4 * gq + 1] * osc); wr.y = cvtpk(acc[mb][4 * gq + 2] * osc, acc[mb][4 * gq + 3] * osc);
                    *(LAS u32x2*)(ob + k2 * DF_ROWB + 16 * gq) = wr; } }
        }
        __syncthreads();
        if (STAGE == 2) {
            u32x4* dst = (u32x4*)(U + (size_t)(b * T + 64 * jj + sidx) * NIN + pp * 512 + chb * 256 + part * 64);
#pragma unroll
            for (int i = 0; i < 8; ++i) dst[i] = *(const LAS u32x4*)(Xl + seg * DF_ROWB + part * 128 + i * 16);
        } else { const int k2 = tid >> 3, part8 = tid & 7;
            u32x4* dst = (u32x4*)(BR + (size_t)(CTX ? RL + b * TC + 4 * k2 + sidx : b * T + 64 * k2 + sidx) * NBR + chb * 256 + part8 * 32);
#pragma unroll
            for (int i = 0; i < 4; ++i) dst[i] = *(const LAS u32x4*)(Xl + k2 * DF_ROWB + part8 * 64 + i * 16); }
        __syncthreads();
    }
    if (CTX) __syncthreads();
}

struct MegaArgs { Ptrs P; int ph_lo, ph_hi, li, pad; };
__global__ void __launch_bounds__(NWAVES * 64, 2) mega(MegaArgs args) {
    extern __shared__ __attribute__((aligned(16))) unsigned char lds_raw[];
    Frame F; F.lds = (LAS unsigned char*)lds_raw;
    F.wave = __builtin_amdgcn_readfirstlane(threadIdx.x >> 6);
    F.G = gridDim.x; { const int bx = blockIdx.x; F.vcu = (F.G % 8 == 0) ? (bx % 8) * (F.G / 8) + bx / 8 : bx; }
    for (int u = fresh_tid(); u < (LDS_BYTES - LDSCTL_OFF) / 4; u += NWAVES * 64) ((LAS unsigned*)(F.lds + LDSCTL_OFF))[u] = 0u;
    __syncthreads();
    volatile LAS unsigned* MISC = (volatile LAS unsigned*)(F.lds + MISC_OFF);
    const Ptrs& P = args.P;
    XcdBarrier bar = xcd_barrier_post((unsigned*)(P.ws + WS_CTL) + CW_BAR + args.li * XCD_BAR_WORDS, MISC + 8, F.wave);
    const int lo = args.ph_lo, hi = args.ph_hi;
    unsigned char* ws = P.ws;
    bf16_t* H = (bf16_t*)(ws + WS_H); bf16_t* U = (bf16_t*)(ws + WS_U); bf16_t* BR = (bf16_t*)(ws + WS_BR);
    bf16_t* MG = (bf16_t*)(ws + WS_MG); bf16_t* HID = (bf16_t*)(ws + WS_HID); bf16_t* MO = (bf16_t*)(ws + WS_MO);
    const bf16_t* Bt_in = (const bf16_t*)(ws + WS_WB + WB_IN); const bf16_t* Bt_gate = (const bf16_t*)(ws + WS_WB + WB_GATE); const bf16_t* Bt_br = (const bf16_t*)(ws + WS_WB + WB_BR);
    const bf16_t* Bt_out = (const bf16_t*)(ws + WS_WB + WB_OUT); const bf16_t* Bt_13 = (const bf16_t*)(ws + WS_WB + WB_13); const bf16_t* Bt_2 = (const bf16_t*)(ws + WS_WB + WB_2);
#define IN(g) (lo <= (g) && (g) < hi)
#define SEAM(g) do { if ((g) + 1 < hi) xcd_barrier(bar); } while (0)
    for (int l = 0; l < 2; ++l) {
        const int pb = l * NPH; const int M = l == 0 ? R : RL;
        if (IN(pb + 0)) { if (l == 0) ph_tables_mod(F, P); ph_weights(F, P, l); SEAM(pb + 0); }
        if (IN(pb + 1)) { ph_quant(F, P, l); if (l == 0) ph_norm<0>(F, P, l, R); else ph_norm<1>(F, P, l, R); SEAM(pb + 1); }
        if (IN(pb + 2)) {
            pg8::StaticOrder S; S.init(R, NIN, F.G, (int)blockIdx.x, H, D / 2, Bt_in, D / 2);
            pg8::EpiV8I8<FStore8> E{FStore8{U, NIN}, (const float*)(ws + WS_SA), (const unsigned*)(ws + WS_CTL) + CW_CMAX + 32768 * l};
            pg8::gemm_phase<pg8::EpiV8I8<FStore8>, pg8::StaticOrder, true, true>(F.lds, F.wave, D / 2, D / 2, D / 2, S, E);
            SEAM(pb + 2);
        }
        if (IN(pb + 3)) { ph_kprep(F, P, l); ph_pool(F, P, M); SEAM(pb + 3); }
        if (IN(pb + 4)) {
            ph_dft<2>(F, P); ph_attn<1>(F, P, l);
            if (l == 0) { ph_attn<2>(F, P, l); ph_attn<3>(F, P, l); ph_ctx_r4(F, P); }
            xcd_barrier(bar);
            ph_dft<3>(F, P); if (l == 0) { Frame Fc = F; Fc.vcu = (F.vcu + 64) % F.G; ph_dft<3, true>(Fc, P); } ph_attn<0>(F, P, l);
            SEAM(pb + 4);
        }
        if (IN(pb + 5)) {
            pg8::StaticOrder S; S.init(M, 4096, F.G, (int)blockIdx.x, H, D / 2, Bt_gate, D / 2);
            pg8::EpiV8I8<FGateU8> E{FGateU8{(unsigned char*)(ws + WS_GT), P.b_gate + (size_t)l * 4096}, (const float*)(ws + WS_SA), (const unsigned*)(ws + WS_CTL) + CW_CMAX + 32768 * l + 3072};
            pg8::gemm_phase<pg8::EpiV8I8<FGateU8>, pg8::StaticOrder, true, true>(F.lds, F.wave, D / 2, D / 2, D / 2, S, E);
            SEAM(pb + 5);
        }
        if (IN(pb + 6)) {
            const int chain = (l == 0);
            pg8::PanelOrder S{(int)blockIdx.x, F.G, M / (8 * pg8::BM), 0, chain, (const char*)BR, (const char*)Bt_br, (size_t)pg8::BM * NBR * 2, (size_t)pg8::BM * NBR * 2, (unsigned*)(ws + WS_CTL) + CW_RDY + 4096 * l};
            pg8::EpiMergeS E{(const unsigned char*)(ws + WS_GT), MG, chain};
            pg8::gemm_phase(F.lds, F.wave, NBR, NBR, NBR, S, E);
            if (!chain) xcd_barrier(bar);
        }
        if (IN(pb + 10)) {
            pg8::PanelOrder S{(int)blockIdx.x, F.G, M / (8 * pg8::BM), 1, l == 0, (const char*)MG, (const char*)Bt_out, (size_t)pg8::BM * D * 2, (size_t)pg8::BM * D * 2, (unsigned*)(ws + WS_CTL) + CW_RDY + 4096 * l};
            pg8::EpiV4<FOut> E{FOut{P, l}};
            pg8::gemm_phase(F.lds, F.wave, D, D, D, S, E);
            SEAM(pb + 10);
        }
        if (IN(pb + 11)) { ph_norm2(F, P, l, M); xcd_barrier(bar); }
        if (IN(pb + 13) || IN(pb + 14)) {
            LAS int* ptab = (LAS int*)(F.lds + LDSCTL_OFF);
            if (fresh_tid() == 0) { const unsigned* cnt = (const unsigned*)(ws + WS_CTL) + CW_CNT + 1024 * l; int off = 0;
                for (int e = 0; e < 16; ++e) { const int c = (int)cnt[64 * e]; ptab[e] = off; ptab[17 + e] = c; off += (c + 255) >> 8; } ptab[16] = off; }
            __syncthreads();
            if (IN(pb + 13)) {
                pg8::MoeOrder<true> S; S.nN = 4; S.G = F.G; S.c = F.vcu; S.A = (const char*)H; S.Bt = (const char*)Bt_13; S.astep = 0; S.bstep = (size_t)256 * D; S.bexp = (size_t)1024 * 1024; S.tab = (const int*)ptab; S.tokl = (const int*)(ws + WS_TOKL); S.hand = 1; S.rev = 0; S.ready = (unsigned*)(ws + WS_CTL) + CW_MRDY + 8192 * l;
                pg8::EpiDualI8<FMoe1> E{FMoe1{HID}, (const float*)(ws + WS_SA), (const unsigned*)(ws + WS_CTL) + CW_CMAX + 32768 * l + 8192, (const int*)(ws + WS_TOKL)};
                pg8::gemm_phase<pg8::EpiDualI8<FMoe1>, pg8::MoeOrder<true>, true, true>(F.lds, F.wave, D / 2, D / 2, D / 2, S, E);
            }
            if (IN(pb + 14)) {
                pg8::MoeOrder<false> S; S.nN = 4; S.G = F.G; S.c = F.vcu; S.A = (const char*)HID; S.Bt = (const char*)Bt_2; S.astep = (size_t)256 * FF * 2; S.bstep = (size_t)256 * FF * 2; S.bexp = (size_t)1024 * 512 * 2; S.tab = (const int*)ptab; S.tokl = nullptr; S.hand = 2; S.rev = 1; S.ready = (unsigned*)(ws + WS_CTL) + CW_MRDY + 8192 * l;
                pg8::EpiV8<FMoe2> E{FMoe2{MO, (const int*)(ws + WS_TOKL), (const float*)(ws + WS_WL)}};
                pg8::gemm_phase(F.lds, F.wave, FF, FF, FF, S, E);
                SEAM(pb + 14);
            }
        }
    }
    if (IN(PH_FINAL)) { ph_final(F, P, 0, 24576); xcd_barrier(bar); ph_final(F, P, 24576, RL); }
#undef IN
#undef SEAM
}

extern "C" void kernel_launch(void* const* d_in, const int* in_sizes, int n_in, void* d_out, int out_size, void* d_ws, size_t ws_size, hipStream_t stream) {
    if (n_in != 24 || ws_size < WS_END || out_size != RL * D) { fprintf(stderr, "kernel_launch: unexpected sizes n_in %d ws %zu out %d\n", n_in, ws_size, out_size); return; }
    static int grid = 0;
    if (grid == 0) {
        int dev = 0, cus = 0;
        if (hipGetDevice(&dev) != hipSuccess || hipDeviceGetAttribute(&cus, hipDeviceAttributeMultiprocessorCount, dev) != hipSuccess) { grid = -1; return; }
        if (hipFuncSetAttribute((const void*)mega, hipFuncAttributeMaxDynamicSharedMemorySize, LDS_BYTES) != hipSuccess) { fprintf(stderr, "kernel_launch: hipFuncSetAttribute failed\n"); grid = -1; return; }
        int per_cu = 0;
        if (hipOccupancyMaxActiveBlocksPerMultiprocessor(&per_cu, (const void*)mega, NWAVES * 64, LDS_BYTES) != hipSuccess || per_cu < 1) fprintf(stderr, "kernel_launch: occupancy query says %d\n", per_cu);
        (void)hipGetLastError();
        grid = cus;
    }
    if (grid < 0) return;
    MegaArgs a{};
    const float** pp = (const float**)&a.P;
    for (int i = 0; i < 24; ++i) pp[i] = (const float*)d_in[i];
    a.P.out = (float*)d_out; a.P.ws = (unsigned char*)d_ws;
    (void)hipMemsetAsync((unsigned char*)d_ws + WS_CTL, 0, 512 * 1024, stream);
    a.ph_lo = 0; a.ph_hi = PH_FINAL + 1; a.li = 0;
    hipLaunchKernelGGL(mega, dim3(grid), dim3(NWAVES * 64), LDS_BYTES, stream, a);
}
```
